# Optimizing an MI355X kernel written in HIP

```python
import jax, jax.numpy as jnp
from jax import lax
import numpy as np

D_MODEL = 1024
BATCH = 8
SEQ = 4096
DEPTH = 2
DEC_BATCH = 4
DEC_SEQ = 4096
PAST_LEN = 128

GRID_W = 64
HEAD_DIM = 64
D_RWKV = 512
N_RWKV_HEADS = D_RWKV // HEAD_DIM
D_NAT = 512
N_NAT_HEADS = D_NAT // HEAD_DIM
LORA_W = 64
LORA_A = 64
LORA_G = 128
N_DIR = 2
WIN_H = 8
WIN_W = 16
N_MEM = 256
N_XATTN_HEADS = 4
XATTN_HEAD_DIM = D_MODEL // N_XATTN_HEADS
D_FF = 4 * D_MODEL
NORM_EPS = 1e-6
GN_EPS = 1e-5 * HEAD_DIM

RWKV_SPLITS = [D_RWKV, 2 * D_RWKV, 3 * D_RWKV,
               3 * D_RWKV + N_DIR * LORA_W,
               3 * D_RWKV + N_DIR * LORA_W + N_DIR * LORA_A]
RWKV_COLS = 3 * D_RWKV + N_DIR * LORA_W + N_DIR * LORA_A + LORA_G
NAT_COLS = 3 * D_NAT
GATE_COLS = 2 * D_MODEL
D_IN = RWKV_COLS + NAT_COLS + GATE_COLS

kernel_name = "rwkv7_natten_hybrid_encoder"


def rmsnorm(x, g):
    xf = x.astype(jnp.float32)
    y = xf * lax.rsqrt(jnp.mean(xf * xf, axis=-1, keepdims=True) + NORM_EPS)
    return (y * g.astype(jnp.float32)).astype(x.dtype)


def centred_shift(p, mu_prev, mu_next):
    zero = jnp.zeros_like(p[:, :1])
    p_prev = jnp.concatenate([zero, p[:, :-1]], axis=1)
    p_next = jnp.concatenate([p[:, 1:], zero], axis=1)
    return p + mu_prev * (p_prev - p) + mu_next * (p_next - p)


def _wkv7_step(S, inp):
    r, w, k, v, a, b = inp
    Sa = jnp.einsum('bhij,bhj->bhi', S, a)
    S = S * w[:, :, None, :] + Sa[..., None] * b[:, :, None, :] + v[..., None] * k[:, :, None, :]
    return S, jnp.einsum('bhij,bhj->bhi', S, r)


def wkv7_scan(r, w, k, v, a, b, reverse):
    B, T, H, N = r.shape
    xs = tuple(jnp.moveaxis(t, 1, 0) for t in (r, w, k, v, a, b))
    S0 = jnp.zeros((B, H, N, N), jnp.float32)
    _, y = lax.scan(_wkv7_step, S0, xs, reverse=reverse)
    return jnp.moveaxis(y, 0, 1)


def rwkv7_branch(p, mu_prev, mu_next, w0, w_up, a0, a_up, g_up, k_k, k_a, r_k, gn_g, gn_b):
    B, T, _ = p.shape
    H, N = N_RWKV_HEADS, HEAD_DIM
    f32 = jnp.float32
    p = centred_shift(p.astype(f32), mu_prev.astype(f32), mu_next.astype(f32))
    r, k, v, wd, ad, gd = jnp.split(p, RWKV_SPLITS, axis=-1)
    wd = wd.reshape(B, T, N_DIR, LORA_W)
    ad = ad.reshape(B, T, N_DIR, LORA_A)
    w_raw = w0.astype(f32) + jnp.einsum('btdl,dlc->btdc', jnp.tanh(wd), w_up.astype(f32))
    decay = jnp.exp(-jnp.exp(-jax.nn.softplus(-w_raw) - 0.5))
    a = jax.nn.sigmoid(a0.astype(f32) + jnp.einsum('btdl,dlc->btdc', ad, a_up.astype(f32)))
    g = jax.nn.sigmoid(gd) @ g_up.astype(f32)
    heads = lambda t: t.reshape(B, T, H, N)
    kk = heads(k * k_k.astype(f32))
    kk = kk / jnp.maximum(jnp.sqrt(jnp.sum(kk * kk, axis=-1, keepdims=True)), 1e-12)
    kk = kk.reshape(B, T, D_RWKV)
    rh, vh = heads(r), heads(v)
    out = jnp.zeros((B, T, H, N), f32)
    bonus = jnp.zeros((B, T, H, 1), f32)
    for d, rev in ((0, False), (1, True)):
        a_d = a[:, :, d]
        k_d = k * (1.0 + (a_d - 1.0) * k_a.astype(f32))
        out = out + wkv7_scan(rh, heads(decay[:, :, d]), heads(k_d), vh,
                              heads(-kk), heads(kk * a_d), rev)
        bonus = bonus + jnp.sum(rh * heads(k_d) * r_k.astype(f32), axis=-1, keepdims=True)
    mean = jnp.mean(out, axis=-1, keepdims=True)
    var = jnp.mean(jnp.square(out - mean), axis=-1, keepdims=True)
    out = ((out - mean) * lax.rsqrt(var + GN_EPS)).reshape(B, T, D_RWKV)
    out = out * gn_g.astype(f32) + gn_b.astype(f32)
    out = out + (bonus * vh).reshape(B, T, D_RWKV)
    return out * g


def neighbourhood_attention(q, k, v, rpb):
    B, T, _ = q.shape
    rows = T // GRID_W
    kh = min(WIN_H, rows)
    kw = WIN_W
    H, N = N_NAT_HEADS, HEAD_DIM
    f32 = jnp.float32
    grid = lambda t: t.reshape(B, rows, GRID_W, H, N).transpose(0, 3, 1, 2, 4)
    qg, kg, vg = grid(q), grid(k), grid(v)
    cols = np.arange(GRID_W)
    col_start = np.clip(cols - kw // 2, 0, GRID_W - kw)
    col_idx = col_start[:, None] + np.arange(kw)[None, :]
    dj = col_idx - cols[:, None] + (WIN_W - 1)
    row_start = np.clip(np.arange(rows) - kh // 2, 0, rows - kh).astype(np.int32)
    rpb_cols = rpb.astype(f32)[:, :, dj]
    scale = HEAD_DIM ** -0.5

    def one_row(args):
        i, rs, q_row = args
        k_rows = lax.dynamic_slice_in_dim(kg, rs, kh, axis=2)
        v_rows = lax.dynamic_slice_in_dim(vg, rs, kh, axis=2)
        k_win = k_rows[:, :, :, col_idx].astype(f32)
        v_win = v_rows[:, :, :, col_idx].astype(f32)
        di = rs + jnp.arange(kh) - i + (WIN_H - 1)
        bias = rpb_cols[:, di].transpose(0, 2, 1, 3)
        s = jnp.einsum('bhwn,bhrwcn->bhwrc', q_row.astype(f32), k_win) * scale + bias[None]
        pr = jax.nn.softmax(s.reshape(B, H, GRID_W, kh * kw), axis=-1).reshape(B, H, GRID_W, kh, kw)
        return jnp.einsum('bhwrc,bhrwcn->bhwn', pr, v_win).astype(q.dtype)

    out = lax.map(one_row, (jnp.arange(rows, dtype=jnp.int32), jnp.asarray(row_start),
                            jnp.moveaxis(qg, 2, 0)))
    return out.transpose(1, 0, 3, 2, 4).reshape(B, T, D_NAT)


def memory_cross_attention(h, mem, g_mem, w_q, w_kv, w_o):
    B, T, _ = h.shape
    M = mem.shape[1]
    q = (h @ w_q).reshape(B, T, N_XATTN_HEADS, XATTN_HEAD_DIM)
    k, v = jnp.split(rmsnorm(mem, g_mem) @ w_kv, 2, axis=-1)
    k = k.reshape(B, M, N_XATTN_HEADS, XATTN_HEAD_DIM)
    v = v.reshape(B, M, N_XATTN_HEADS, XATTN_HEAD_DIM)
    s = jnp.einsum('bthd,bmhd->bhtm', q.astype(jnp.float32), k.astype(jnp.float32)) * XATTN_HEAD_DIM ** -0.5
    pr = jax.nn.softmax(s, axis=-1)
    o = jnp.einsum('bhtm,bmhd->bthd', pr, v.astype(jnp.float32)).reshape(B, T, D_MODEL)
    return o.astype(h.dtype) @ w_o


def trunk(x, mem, norm_mix, w_in, mu_prev, mu_next, w0, w_up, a0, a_up, g_up, k_k, k_a, r_k,
          gn_g, gn_b, rpb, w_br_rwkv, w_br_nat, w_out, norm_x, norm_mem, w_xq, w_xkv, w_xo,
          norm_ff, w_ff1, w_ff2, norm_final):
    for l in range(DEPTH):
        p = rmsnorm(x, norm_mix[l]) @ w_in[l]
        p_rwkv = p[..., :RWKV_COLS]
        p_nat = p[..., RWKV_COLS:RWKV_COLS + NAT_COLS]
        gate_r, gate_n = jnp.split(p[..., RWKV_COLS + NAT_COLS:], 2, axis=-1)
        y_r = rwkv7_branch(p_rwkv, mu_prev[l], mu_next[l], w0[l], w_up[l], a0[l], a_up[l],
                           g_up[l], k_k[l], k_a[l], r_k[l], gn_g[l], gn_b[l]).astype(x.dtype)
        nq, nk, nv = jnp.split(p_nat, 3, axis=-1)
        y_n = neighbourhood_attention(nq, nk, nv, rpb[l])
        mixed = jax.nn.sigmoid(gate_r) * (y_r @ w_br_rwkv[l]) + jax.nn.sigmoid(gate_n) * (y_n @ w_br_nat[l])
        x = x + mixed @ w_out[l]
        x = x + memory_cross_attention(rmsnorm(x, norm_x[l]), mem, norm_mem[l], w_xq[l], w_xkv[l], w_xo[l])
        hf = rmsnorm(x, norm_ff[l]) @ w_ff1[l]
        x = x + jnp.square(jax.nn.relu(hf)) @ w_ff2[l]
    return rmsnorm(x, norm_final)


def setup_inputs(seed: int = 0) -> dict:
    key = jax.random.key(seed)
    ks = iter(jax.random.split(key, 40))
    nrm = lambda shape, s: jax.random.normal(next(ks), shape, jnp.float32) * s
    uni = lambda shape, lo, hi: jax.random.uniform(next(ks), shape, jnp.float32, lo, hi)
    L, D = DEPTH, D_MODEL
    return {
        "x_prompt": nrm((BATCH, SEQ, D), 1.0),
        "x_sample": nrm((DEC_BATCH, DEC_SEQ, D), 1.0),
        "mem_prompt": nrm((BATCH, N_MEM, D), 1.0),
        "mem_sample": nrm((DEC_BATCH, N_MEM, D), 1.0),
        "norm_mix": 1.0 + nrm((L, D), 0.05),
        "w_in": nrm((L, D, D_IN), D ** -0.5),
        "mu_prev": uni((L, RWKV_COLS), 0.0, 0.5),
        "mu_next": uni((L, RWKV_COLS), 0.0, 0.5),
        "w0": uni((L, N_DIR, D_RWKV), -3.0, 1.0),
        "w_up": nrm((L, N_DIR, LORA_W, D_RWKV), 0.1 * LORA_W ** -0.5),
        "a0": nrm((L, N_DIR, D_RWKV), 0.1),
        "a_up": nrm((L, N_DIR, LORA_A, D_RWKV), 0.5 * LORA_A ** -0.5),
        "g_up": nrm((L, LORA_G, D_RWKV), LORA_G ** -0.5),
        "k_k": 0.85 + nrm((L, D_RWKV), 0.05),
        "k_a": 1.0 + nrm((L, D_RWKV), 0.05),
        "r_k": nrm((L, N_RWKV_HEADS, HEAD_DIM), 0.1),
        "gn_g": 1.0 + nrm((L, D_RWKV), 0.05),
        "gn_b": nrm((L, D_RWKV), 0.01),
        "rpb": nrm((L, N_NAT_HEADS, 2 * WIN_H - 1, 2 * WIN_W - 1), 0.1),
        "w_br_rwkv": nrm((L, D_RWKV, D), D_RWKV ** -0.5),
        "w_br_nat": nrm((L, D_NAT, D), D_NAT ** -0.5),
        "w_out": nrm((L, D, D), D ** -0.5),
        "norm_x": 1.0 + nrm((L, D), 0.05),
        "norm_mem": 1.0 + nrm((L, D), 0.05),
        "w_xq": nrm((L, D, D), D ** -0.5),
        "w_xkv": nrm((L, D, 2 * D), D ** -0.5),
        "w_xo": nrm((L, D, D), D ** -0.5),
        "norm_ff": 1.0 + nrm((L, D), 0.05),
        "w_ff1": nrm((L, D, D_FF), D ** -0.5),
        "w_ff2": nrm((L, D_FF, D), D_FF ** -0.5),
        "norm_final": 1.0 + nrm((D,), 0.05),
    }


def reference(x_prompt, x_sample, mem_prompt, mem_sample, norm_mix, w_in, mu_prev, mu_next, w0, w_up,
              a0, a_up, g_up, k_k, k_a, r_k, gn_g, gn_b, rpb, w_br_rwkv, w_br_nat, w_out, norm_x,
              norm_mem, w_xq, w_xkv, w_xo, norm_ff, w_ff1, w_ff2, norm_final):
    y_prompt = trunk(x_prompt, mem_prompt, norm_mix, w_in, mu_prev, mu_next, w0, w_up, a0, a_up, g_up,
                     k_k, k_a, r_k, gn_g, gn_b, rpb, w_br_rwkv, w_br_nat, w_out, norm_x, norm_mem,
                     w_xq, w_xkv, w_xo, norm_ff, w_ff1, w_ff2, norm_final)
    y_sample = trunk(x_sample, mem_sample, norm_mix, w_in, mu_prev, mu_next, w0, w_up, a0, a_up, g_up,
                     k_k, k_a, r_k, gn_g, gn_b, rpb, w_br_rwkv, w_br_nat, w_out, norm_x, norm_mem,
                     w_xq, w_xkv, w_xo, norm_ff, w_ff1, w_ff2, norm_final)
    return (y_prompt, y_sample)
```

```cpp
#include <hip/hip_runtime.h>
#include <hip/hip_cooperative_groups.h>
#include <stdint.h>
namespace cg = cooperative_groups;

typedef unsigned short u16;
typedef __attribute__((ext_vector_type(8))) short bf16x8;
typedef __attribute__((ext_vector_type(4))) float f32x4;
typedef __attribute__((ext_vector_type(8))) _Float16 h16x8;
typedef __attribute__((ext_vector_type(4))) unsigned int u32x4;
typedef __attribute__((ext_vector_type(2))) unsigned int u32x2;

#define DEVI __device__ __forceinline__

constexpr int NTOK = 49152;
constexpr int SEQ_T = 4096;
constexpr int PRW = 1920;
constexpr int NPH_LAYER = 16;
constexpr int NPHASES = 2 * NPH_LAYER + 1;
constexpr int SMEM_BYTES = 73728;

constexpr size_t OFF_WB = 0;
constexpr size_t WB_BYTES = 20381696ull * 2;
constexpr size_t OFF_H = OFF_WB + WB_BYTES;
constexpr size_t OFF_PR = OFF_H + (size_t)NTOK * 1024 * 2;
constexpr size_t OFF_NQ = OFF_PR + (size_t)NTOK * PRW * 2;
constexpr size_t OFF_NK = OFF_NQ + (size_t)NTOK * 512 * 2;
constexpr size_t OFF_NV = OFF_NK + (size_t)NTOK * 512 * 2;
constexpr size_t OFF_KVK = OFF_NV + (size_t)NTOK * 512 * 2;
constexpr size_t OFF_KVT = OFF_KVK + (size_t)3072 * 1024 * 2;
constexpr size_t OFF_MEMH = OFF_KVT + (size_t)3072 * 1024 * 2;
constexpr size_t OFF_BONUS = OFF_MEMH + (size_t)3072 * 1024 * 2;
constexpr size_t WS_NEED = OFF_BONUS + (size_t)NTOK * 16 * 4;

constexpr size_t W_IN = 0;
constexpr size_t W_BRR = W_IN + (size_t)5504 * 1024;
constexpr size_t W_BRN = W_BRR + (size_t)1024 * 512;
constexpr size_t W_OUT = W_BRN + (size_t)1024 * 512;
constexpr size_t W_XQ = W_OUT + (size_t)1024 * 1024;
constexpr size_t W_XKV = W_XQ + (size_t)1024 * 1024;
constexpr size_t W_XO = W_XKV + (size_t)2048 * 1024;
constexpr size_t W_FF1 = W_XO + (size_t)1024 * 1024;
constexpr size_t W_FF2 = W_FF1 + (size_t)4096 * 1024;
constexpr size_t W_GUP = W_FF2 + (size_t)4096 * 1024;

enum { I_XP = 0, I_XS, I_MP, I_MS, I_NORM_MIX, I_W_IN, I_MU_PREV, I_MU_NEXT, I_W0, I_W_UP, I_A0, I_A_UP,
       I_G_UP, I_K_K, I_K_A, I_R_K, I_GN_G, I_GN_B, I_RPB, I_W_BR_RWKV, I_W_BR_NAT, I_W_OUT, I_NORM_X,
       I_NORM_MEM, I_W_XQ, I_W_XKV, I_W_XO, I_NORM_FF, I_W_FF1, I_W_FF2, I_NORM_FINAL };

struct Params {
  const float* in[31];
  float* X;
  char* ws;
};

DEVI u16 f2bf(float f) {
  uint32_t u = __float_as_uint(f);
  u += 0x7FFFu + ((u >> 16) & 1u);
  return (u16)(u >> 16);
}
DEVI float bf2f(u16 h) { return __uint_as_float(((uint32_t)h) << 16); }
DEVI uint32_t pack2(float a, float b) { return (uint32_t)f2bf(a) | ((uint32_t)f2bf(b) << 16); }
DEVI float sigm(float x) { return 1.f / (1.f + __expf(-x)); }
DEVI void unpack8(u32x4 u, float* o) {
  o[0] = __uint_as_float(u.x << 16); o[1] = __uint_as_float(u.x & 0xffff0000u);
  o[2] = __uint_as_float(u.y << 16); o[3] = __uint_as_float(u.y & 0xffff0000u);
  o[4] = __uint_as_float(u.z << 16); o[5] = __uint_as_float(u.z & 0xffff0000u);
  o[6] = __uint_as_float(u.w << 16); o[7] = __uint_as_float(u.w & 0xffff0000u);
}
DEVI void load8bf(const u16* p, float* o) { unpack8(*(const u32x4*)p, o); }
DEVI float wave_sum(float v) {
  v += __shfl_xor(v, 32); v += __shfl_xor(v, 16); v += __shfl_xor(v, 8);
  v += __shfl_xor(v, 4); v += __shfl_xor(v, 2); v += __shfl_xor(v, 1);
  return v;
}
DEVI float red16_sum(float v) {
  v += __shfl_xor(v, 1); v += __shfl_xor(v, 2); v += __shfl_xor(v, 4); v += __shfl_xor(v, 8);
  return v;
}
DEVI float red16_max(float v) {
  v = fmaxf(v, __shfl_xor(v, 1)); v = fmaxf(v, __shfl_xor(v, 2));
  v = fmaxf(v, __shfl_xor(v, 4)); v = fmaxf(v, __shfl_xor(v, 8));
  return v;
}

DEVI void conv_tile(int tid_, const float* src, int K, int N, u16* dst, int tile, char* smem) {
  float (*s)[65] = (float (*)[65])smem;
  const int nN = N >> 6;
  const int tk = tile / nN, tn = tile - tk * nN;
  const int tx = tid_ & 63, ty = tid_ >> 6;
  for (int r = ty; r < 64; r += 4) s[r][tx] = src[(size_t)(tk * 64 + r) * N + tn * 64 + tx];
  __syncthreads();
  for (int r = ty; r < 64; r += 4) dst[(size_t)(tn * 64 + r) * K + tk * 64 + tx] = f2bf(s[tx][r]);
  __syncthreads();
}

DEVI void phase_conv(int tid_, const Params& p, int l, char* smem) {
  u16* WB = (u16*)(p.ws + OFF_WB);
  const int c0 = 1376, c1 = c0 + 128, c2 = c1 + 128, c3 = c2 + 256, c4 = c3 + 256, c5 = c4 + 512,
            c6 = c5 + 256, c7 = c6 + 1024, c8 = c7 + 1024, c9 = c8 + 16;
  for (int t = blockIdx.x; t < c9; t += gridDim.x) {
    if (t < c0) conv_tile(tid_, p.in[I_W_IN] + (size_t)l * 1024 * 5504, 1024, 5504, WB + W_IN, t, smem);
    else if (t < c1) conv_tile(tid_, p.in[I_W_BR_RWKV] + (size_t)l * 512 * 1024, 512, 1024, WB + W_BRR, t - c0, smem);
    else if (t < c2) conv_tile(tid_, p.in[I_W_BR_NAT] + (size_t)l * 512 * 1024, 512, 1024, WB + W_BRN, t - c1, smem);
    else if (t < c3) conv_tile(tid_, p.in[I_W_OUT] + (size_t)l * 1024 * 1024, 1024, 1024, WB + W_OUT, t - c2, smem);
    else if (t < c4) conv_tile(tid_, p.in[I_W_XQ] + (size_t)l * 1024 * 1024, 1024, 1024, WB + W_XQ, t - c3, smem);
    else if (t < c5) conv_tile(tid_, p.in[I_W_XKV] + (size_t)l * 1024 * 2048, 1024, 2048, WB + W_XKV, t - c4, smem);
    else if (t < c6) conv_tile(tid_, p.in[I_W_XO] + (size_t)l * 1024 * 1024, 1024, 1024, WB + W_XO, t - c5, smem);
    else if (t < c7) conv_tile(tid_, p.in[I_W_FF1] + (size_t)l * 1024 * 4096, 1024, 4096, WB + W_FF1, t - c6, smem);
    else if (t < c8) conv_tile(tid_, p.in[I_W_FF2] + (size_t)l * 4096 * 1024, 4096, 1024, WB + W_FF2, t - c7, smem);
    else conv_tile(tid_, p.in[I_G_UP] + (size_t)l * 128 * 512, 128, 512, WB + W_GUP, t - c8, smem);
  }
}

DEVI void norm_row_bf16(int tid_, const float* src, const float* g, u16* dst, float* xcopy) {
  const int lane = tid_ & 63;
  float4 v[4];
  float ss = 0.f;
#pragma unroll
  for (int i = 0; i < 4; ++i) {
    v[i] = ((const float4*)src)[lane + i * 64];
    ss += v[i].x * v[i].x + v[i].y * v[i].y + v[i].z * v[i].z + v[i].w * v[i].w;
  }
  ss = wave_sum(ss);
  const float rs = rsqrtf(ss * (1.f / 1024.f) + 1e-6f);
#pragma unroll
  for (int i = 0; i < 4; ++i) {
    float4 gg = ((const float4*)g)[lane + i * 64];
    u32x2 o;
    o.x = pack2(v[i].x * rs * gg.x, v[i].y * rs * gg.y);
    o.y = pack2(v[i].z * rs * gg.z, v[i].w * rs * gg.w);
    ((u32x2*)dst)[lane + i * 64] = o;
    if (xcopy) ((float4*)xcopy)[lane + i * 64] = v[i];
  }
}

DEVI void phase_norm(int tid_, const Params& p, const float* g, bool from_input) {
  u16* H = (u16*)(p.ws + OFF_H);
  const int wid = tid_ >> 6;
  for (int r = blockIdx.x * 4 + wid; r < NTOK; r += gridDim.x * 4) {
    const float* src;
    if (from_input) src = (r < 32768) ? p.in[I_XP] + (size_t)r * 1024 : p.in[I_XS] + (size_t)(r - 32768) * 1024;
    else src = p.X + (size_t)r * 1024;
    norm_row_bf16(tid_, src, g, H + (size_t)r * 1024, from_input ? p.X + (size_t)r * 1024 : nullptr);
  }
}
DEVI void phase_norm_mem(int tid_, const Params& p, const float* g) {
  u16* MH = (u16*)(p.ws + OFF_MEMH);
  const int wid = tid_ >> 6;
  for (int r = blockIdx.x * 4 + wid; r < 3072; r += gridDim.x * 4) {
    const float* src = (r < 2048) ? p.in[I_MP] + (size_t)r * 1024 : p.in[I_MS] + (size_t)(r - 2048) * 1024;
    norm_row_bf16(tid_, src, g, MH + (size_t)r * 1024, nullptr);
  }
}
DEVI void phase_final_norm(int tid_, const Params& p) {
  const float* g = p.in[I_NORM_FINAL];
  const int wid = tid_ >> 6, lane = tid_ & 63;
  for (int r = blockIdx.x * 4 + wid; r < NTOK; r += gridDim.x * 4) {
    float* row = p.X + (size_t)r * 1024;
    float4 v[4];
    float ss = 0.f;
#pragma unroll
    for (int i = 0; i < 4; ++i) {
      v[i] = ((const float4*)row)[lane + i * 64];
      ss += v[i].x * v[i].x + v[i].y * v[i].y + v[i].z * v[i].z + v[i].w * v[i].w;
    }
    ss = wave_sum(ss);
    const float rs = rsqrtf(ss * (1.f / 1024.f) + 1e-6f);
#pragma unroll
    for (int i = 0; i < 4; ++i) {
      float4 gg = ((const float4*)g)[lane + i * 64];
      float4 o;
      o.x = v[i].x * rs * gg.x; o.y = v[i].y * rs * gg.y; o.z = v[i].z * rs * gg.z; o.w = v[i].w * rs * gg.w;
      ((float4*)row)[lane + i * 64] = o;
    }
  }
}

constexpr int LDSW = 72;

template <int NW>
DEVI void gemm_kloop(int tid_, f32x4 (&acc)[4][NW], const u16* __restrict__ A, int lda, const u16* __restrict__ Bt, int ldb,
                     int K, char* smem) {
  u16* sA = (u16*)smem;
  u16* sB = sA + 128 * LDSW;
  const int tid = tid_, lane = tid & 63, wid = tid >> 6;
  const int wr = wid >> 1, wc = wid & 1, fr = lane & 15, fq = lane >> 4;
  const int lrow = tid >> 3, lkc = tid & 7;
  u32x4 ra[4], rb[NW];
  const u16* ga = A + (size_t)lrow * lda + lkc * 8;
  const u16* gb = Bt + (size_t)lrow * ldb + lkc * 8;
#pragma unroll
  for (int i = 0; i < 4; ++i) ra[i] = *(const u32x4*)(ga + (size_t)(i * 32) * lda);
#pragma unroll
  for (int i = 0; i < NW; ++i) rb[i] = *(const u32x4*)(gb + (size_t)(i * 32) * ldb);
  for (int k0 = 0; k0 < K; k0 += 64) {
    __syncthreads();
#pragma unroll
    for (int i = 0; i < 4; ++i) *(u32x4*)(sA + (lrow + i * 32) * LDSW + lkc * 8) = ra[i];
#pragma unroll
    for (int i = 0; i < NW; ++i) *(u32x4*)(sB + (lrow + i * 32) * LDSW + lkc * 8) = rb[i];
    __syncthreads();
    if (k0 + 64 < K) {
#pragma unroll
      for (int i = 0; i < 4; ++i) ra[i] = *(const u32x4*)(ga + (size_t)(i * 32) * lda + k0 + 64);
#pragma unroll
      for (int i = 0; i < NW; ++i) rb[i] = *(const u32x4*)(gb + (size_t)(i * 32) * ldb + k0 + 64);
    }
#pragma unroll
    for (int ks = 0; ks < 2; ++ks) {
      bf16x8 af[4], bfr[NW];
#pragma unroll
      for (int m = 0; m < 4; ++m) af[m] = *(const bf16x8*)(sA + (wr * 64 + m * 16 + fr) * LDSW + ks * 32 + fq * 8);
#pragma unroll
      for (int n = 0; n < NW; ++n) bfr[n] = *(const bf16x8*)(sB + (wc * 16 * NW + n * 16 + fr) * LDSW + ks * 32 + fq * 8);
#pragma unroll
      for (int m = 0; m < 4; ++m)
#pragma unroll
        for (int n = 0; n < NW; ++n) acc[m][n] = __builtin_amdgcn_mfma_f32_16x16x32_bf16(af[m], bfr[n], acc[m][n], 0, 0, 0);
    }
  }
}

template <int NW>
DEVI void zero_acc(f32x4 (&acc)[4][NW]) {
#pragma unroll
  for (int m = 0; m < 4; ++m)
#pragma unroll
    for (int n = 0; n < NW; ++n) acc[m][n] = (f32x4){0.f, 0.f, 0.f, 0.f};
}

template <class Epi>
DEVI void gemm_phase(int tid_, const u16* A, int lda, const u16* Bt, int ldb, int K, int M, int N, char* smem, Epi epi) {
  const int nN = N >> 7, nM = M >> 7;
  const int lane = tid_ & 63, wid = tid_ >> 6;
  const int wr = wid >> 1, wc = wid & 1, fr = lane & 15, fq = lane >> 4;
  for (int t = blockIdx.x; t < nM * nN; t += gridDim.x) {
    const int tm = t / nN, tn = t - tm * nN;
    const int m0 = tm << 7, n0 = tn << 7;
    f32x4 acc[4][4];
    zero_acc(acc);
    gemm_kloop<4>(tid_, acc, A + (size_t)m0 * lda, lda, Bt + (size_t)n0 * ldb, ldb, K, smem);
#pragma unroll
    for (int m = 0; m < 4; ++m)
#pragma unroll
      for (int n = 0; n < 4; ++n) epi(m0 + wr * 64 + m * 16 + fq * 4, n0 + wc * 64 + n * 16 + fr, acc[m][n]);
  }
}

DEVI void phase_p_gemm(int tid_, const Params& p, char* smem) {
  u16* WB = (u16*)(p.ws + OFF_WB);
  const u16* H = (const u16*)(p.ws + OFF_H);
  u16* PR = (u16*)(p.ws + OFF_PR);
  u16* NQ = (u16*)(p.ws + OFF_NQ);
  u16* NK = (u16*)(p.ws + OFF_NK);
  u16* NVT = (u16*)(p.ws + OFF_NV);
  gemm_phase(tid_, H, 1024, WB + W_IN, 1024, 1024, NTOK, 3456, smem, [&](int r0, int c, f32x4 v) {
    if (c < 1920) {
#pragma unroll
      for (int j = 0; j < 4; ++j) PR[(size_t)(r0 + j) * PRW + c] = f2bf(v[j]);
    } else if (c < 2432) {
#pragma unroll
      for (int j = 0; j < 4; ++j) NQ[(size_t)(r0 + j) * 512 + (c - 1920)] = f2bf(v[j]);
    } else if (c < 2944) {
#pragma unroll
      for (int j = 0; j < 4; ++j) NK[(size_t)(r0 + j) * 512 + (c - 2432)] = f2bf(v[j]);
    } else {
      const int cc = c - 2944;
      const int s = r0 >> 12, t = r0 & 4095;
      u32x2 o;
      o.x = pack2(v[0], v[1]); o.y = pack2(v[2], v[3]);
      *(u32x2*)(NVT + ((size_t)(s * 512 + cc)) * 4096 + t) = o;
    }
  });
  const u16* MH = (const u16*)(p.ws + OFF_MEMH);
  u16* KVK = (u16*)(p.ws + OFF_KVK);
  u16* KVT = (u16*)(p.ws + OFF_KVT);
  gemm_phase(tid_, MH, 1024, WB + W_XKV, 1024, 1024, 3072, 2048, smem, [&](int r0, int c, f32x4 v) {
    if (c < 1024) {
#pragma unroll
      for (int j = 0; j < 4; ++j) KVK[(size_t)(r0 + j) * 1024 + c] = f2bf(v[j]);
    } else {
      const int cc = c - 1024;
      const int s = r0 >> 8, m = r0 & 255;
      u32x2 o;
      o.x = pack2(v[0], v[1]); o.y = pack2(v[2], v[3]);
      *(u32x2*)(KVT + ((size_t)(s * 1024 + cc)) * 256 + m) = o;
    }
  });
}

DEVI void phase_nat(int tid_, const Params& p, int l, char* smem) {
  u16* NQ = (u16*)(p.ws + OFF_NQ);
  const u16* NK = (const u16*)(p.ws + OFF_NK);
  const u16* NVT = (const u16*)(p.ws + OFF_NV);
  const float* rpb = p.in[I_RPB] + (size_t)l * 8 * 15 * 31;
  const int lane = tid_ & 63, g = tid_ >> 6, fr = lane & 15, fq = lane >> 4;
  u16* Pw = (u16*)smem + g * (16 * 264);
  const int cb = (g == 0) ? 0 : (g == 1) ? 8 : (g == 2) ? 24 : 32;
  for (int t = blockIdx.x; t < 12 * 64 * 8; t += gridDim.x) {
    const int h = t & 7, ri = (t >> 3) & 63, s = t >> 9;
    int rs = ri - 4; rs = rs < 0 ? 0 : (rs > 56 ? 56 : rs);
    const size_t tokq = (size_t)s * 4096 + ri * 64 + g * 16;
    bf16x8 aq[2];
    aq[0] = *(const bf16x8*)(NQ + (tokq + fr) * 512 + h * 64 + fq * 8);
    aq[1] = *(const bf16x8*)(NQ + (tokq + fr) * 512 + h * 64 + 32 + fq * 8);
    f32x4 acc[16];
#pragma unroll
    for (int n = 0; n < 16; ++n) {
      acc[n] = (f32x4){0.f, 0.f, 0.f, 0.f};
      const int r = n >> 1, col = cb + (n & 1) * 16 + fr;
      const u16* kp = NK + ((size_t)s * 4096 + (rs + r) * 64 + col) * 512 + h * 64 + fq * 8;
      bf16x8 b0 = *(const bf16x8*)kp;
      bf16x8 b1 = *(const bf16x8*)(kp + 32);
      acc[n] = __builtin_amdgcn_mfma_f32_16x16x32_bf16(aq[0], b0, acc[n], 0, 0, 0);
      acc[n] = __builtin_amdgcn_mfma_f32_16x16x32_bf16(aq[1], b1, acc[n], 0, 0, 0);
    }
    float mx[4], sm[4];
#pragma unroll
    for (int j = 0; j < 4; ++j) {
      const int c = g * 16 + fq * 4 + j;
      int cs = c - 8; cs = cs < 0 ? 0 : (cs > 48 ? 48 : cs);
      float m = -1e30f;
#pragma unroll
      for (int n = 0; n < 16; ++n) {
        const int r = n >> 1, kc = cb + (n & 1) * 16 + fr;
        const bool valid = (kc >= cs) && (kc < cs + 16);
        float sc = -1e30f;
        if (valid) {
          const int di = rs + r - ri + 7, dj = kc - c + 15;
          sc = acc[n][j] * 0.125f + rpb[(h * 15 + di) * 31 + dj];
        }
        acc[n][j] = sc;
        m = fmaxf(m, sc);
      }
      mx[j] = red16_max(m);
    }
#pragma unroll
    for (int j = 0; j < 4; ++j) {
      float ssum = 0.f;
#pragma unroll
      for (int n = 0; n < 16; ++n) {
        float e = __expf(acc[n][j] - mx[j]);
        acc[n][j] = e;
        ssum += e;
      }
      sm[j] = 1.f / red16_sum(ssum);
    }
    __syncthreads();
#pragma unroll
    for (int n = 0; n < 16; ++n)
#pragma unroll
      for (int j = 0; j < 4; ++j) Pw[(fq * 4 + j) * 264 + n * 16 + fr] = f2bf(acc[n][j]);
    __syncthreads();
    f32x4 o[4];
#pragma unroll
    for (int n = 0; n < 4; ++n) o[n] = (f32x4){0.f, 0.f, 0.f, 0.f};
#pragma unroll
    for (int ks = 0; ks < 8; ++ks) {
      bf16x8 ap = *(const bf16x8*)(Pw + fr * 264 + ks * 32 + fq * 8);
#pragma unroll
      for (int n = 0; n < 4; ++n) {
        bf16x8 bv = *(const bf16x8*)(NVT + ((size_t)(s * 512 + h * 64 + n * 16 + fr)) * 4096 + (rs + ks) * 64 + cb + fq * 8);
        o[n] = __builtin_amdgcn_mfma_f32_16x16x32_bf16(ap, bv, o[n], 0, 0, 0);
      }
    }
#pragma unroll
    for (int n = 0; n < 4; ++n)
#pragma unroll
      for (int j = 0; j < 4; ++j)
        NQ[(tokq + fq * 4 + j) * 512 + h * 64 + n * 16 + fr] = f2bf(o[n][j] * sm[j]);
  }
}

DEVI void phase_scan(int tid_, const Params& p, int l, char* smem) {
  const u16* PR = (const u16*)(p.ws + OFF_PR);
  _Float16* YF = (_Float16*)(p.ws + OFF_NK);
  _Float16* YB = (_Float16*)(p.ws + OFF_NV);
  float* BON = (float*)(p.ws + OFF_BONUS);
  float* OPS = (float*)smem;
  float* VV = OPS + 32 * 5 * 64;
  float* TW = VV + 32 * 64;
  float* AD = TW + 32 * 64;
  float* YL = AD + 32 * 64;
  const float* mu_p = p.in[I_MU_PREV] + (size_t)l * 1920;
  const float* mu_n = p.in[I_MU_NEXT] + (size_t)l * 1920;
  const int tid = tid_;
  for (int blk = blockIdx.x; blk < 192; blk += gridDim.x) {
    const int s = blk >> 4, h = (blk >> 1) & 7, d = blk & 1;
    const float* w0 = p.in[I_W0] + (size_t)(l * 2 + d) * 512 + h * 64;
    const float* a0 = p.in[I_A0] + (size_t)(l * 2 + d) * 512 + h * 64;
    const float* wup = p.in[I_W_UP] + (size_t)(l * 2 + d) * 64 * 512 + h * 64;
    const float* aup = p.in[I_A_UP] + (size_t)(l * 2 + d) * 64 * 512 + h * 64;
    const float* kk_w = p.in[I_K_K] + (size_t)l * 512 + h * 64;
    const float* ka_w = p.in[I_K_A] + (size_t)l * 512 + h * 64;
    const float* rk_w = p.in[I_R_K] + (size_t)(l * 8 + h) * 64;
    _Float16* Y = d ? YB : YF;
    float S[16];
#pragma unroll
    for (int j = 0; j < 16; ++j) S[j] = 0.f;
    const int pn = tid >> 3, part = tid & 7, j0 = part * 8;
    const int si = tid >> 2, jg = tid & 3;
#pragma unroll 1
    for (int ch = 0; ch < 128; ++ch) {
      const int n = ch * 32 + pn;
      const int t = d ? (4095 - n) : n;
      const size_t tok = (size_t)s * 4096 + t;
#pragma unroll 1
      for (int gi = 0; gi < 5; ++gi) {
        const int col = (gi < 3) ? (gi * 512 + h * 64 + j0) : (1536 + (gi - 3) * 128 + d * 64 + j0);
        float* dst = (gi == 0) ? (OPS + (pn * 5 + 4) * 64 + j0)
                   : (gi == 1) ? (OPS + (pn * 5 + 3) * 64 + j0)
                   : (gi == 2) ? (VV + pn * 64 + j0)
                   : (gi == 3) ? (TW + pn * 64 + j0) : (AD + pn * 64 + j0);
        float cur[8], prv[8], nxt[8];
        load8bf(PR + tok * PRW + col, cur);
        if (t > 0) load8bf(PR + (tok - 1) * PRW + col, prv);
        else {
#pragma unroll
          for (int e = 0; e < 8; ++e) prv[e] = 0.f;
        }
        if (t < 4095) load8bf(PR + (tok + 1) * PRW + col, nxt);
        else {
#pragma unroll
          for (int e = 0; e < 8; ++e) nxt[e] = 0.f;
        }
        const f32x4 mp0 = *(const f32x4*)(mu_p + col), mp1 = *(const f32x4*)(mu_p + col + 4);
        const f32x4 mn0 = *(const f32x4*)(mu_n + col), mn1 = *(const f32x4*)(mu_n + col + 4);
        f32x4 x0, x1;
#pragma unroll
        for (int e = 0; e < 4; ++e) {
          x0[e] = cur[e] + mp0[e] * (prv[e] - cur[e]) + mn0[e] * (nxt[e] - cur[e]);
          x1[e] = cur[4 + e] + mp1[e] * (prv[4 + e] - cur[4 + e]) + mn1[e] * (nxt[4 + e] - cur[4 + e]);
        }
        if (gi == 3) {
#pragma unroll
          for (int e = 0; e < 4; ++e) { x0[e] = tanhf(x0[e]); x1[e] = tanhf(x1[e]); }
        }
        *(f32x4*)dst = x0;
        *(f32x4*)(dst + 4) = x1;
      }
      __syncthreads();
      {
        float wr_[8], ap_[8];
        *(float4*)&wr_[0] = *(const float4*)(w0 + j0); *(float4*)&wr_[4] = *(const float4*)(w0 + j0 + 4);
        *(float4*)&ap_[0] = *(const float4*)(a0 + j0); *(float4*)&ap_[4] = *(const float4*)(a0 + j0 + 4);
#pragma unroll 2
        for (int li = 0; li < 64; ++li) {
          const float tw = TW[pn * 64 + li], ad = AD[pn * 64 + li];
          const float4 u0 = *(const float4*)(wup + (size_t)li * 512 + j0), u1 = *(const float4*)(wup + (size_t)li * 512 + j0 + 4);
          const float4 q0 = *(const float4*)(aup + (size_t)li * 512 + j0), q1 = *(const float4*)(aup + (size_t)li * 512 + j0 + 4);
          wr_[0] += tw * u0.x; wr_[1] += tw * u0.y; wr_[2] += tw * u0.z; wr_[3] += tw * u0.w;
          wr_[4] += tw * u1.x; wr_[5] += tw * u1.y; wr_[6] += tw * u1.z; wr_[7] += tw * u1.w;
          ap_[0] += ad * q0.x; ap_[1] += ad * q0.y; ap_[2] += ad * q0.z; ap_[3] += ad * q0.w;
          ap_[4] += ad * q1.x; ap_[5] += ad * q1.y; ap_[6] += ad * q1.z; ap_[7] += ad * q1.w;
        }
        float kkv[8], kr[8], rr[8], ss = 0.f;
        *(f32x4*)&kr[0] = *(const f32x4*)(OPS + (pn * 5 + 3) * 64 + j0); *(f32x4*)&kr[4] = *(const f32x4*)(OPS + (pn * 5 + 3) * 64 + j0 + 4);
        *(f32x4*)&rr[0] = *(const f32x4*)(OPS + (pn * 5 + 4) * 64 + j0); *(f32x4*)&rr[4] = *(const f32x4*)(OPS + (pn * 5 + 4) * 64 + j0 + 4);
#pragma unroll
        for (int e = 0; e < 8; ++e) { kkv[e] = kr[e] * kk_w[j0 + e]; ss += kkv[e] * kkv[e]; }
        ss += __shfl_xor(ss, 1); ss += __shfl_xor(ss, 2); ss += __shfl_xor(ss, 4);
        const float inv = 1.f / fmaxf(sqrtf(ss), 1e-12f);
        float bsum = 0.f;
#pragma unroll
        for (int e = 0; e < 8; ++e) {
          const float sw = 1.f / (1.f + expf(-wr_[e]));
          const float dec = expf(-0.6065306597126334f * sw);
          const float av = 1.f / (1.f + expf(-ap_[e]));
          const float kn = kkv[e] * inv;
          const float kd = kr[e] * (1.f + (av - 1.f) * ka_w[j0 + e]);
          bsum += rr[e] * kd * rk_w[j0 + e];
          OPS[(pn * 5 + 0) * 64 + j0 + e] = -kn;
          OPS[(pn * 5 + 1) * 64 + j0 + e] = dec;
          OPS[(pn * 5 + 2) * 64 + j0 + e] = kn * av;
          OPS[(pn * 5 + 3) * 64 + j0 + e] = kd;
        }
        bsum += __shfl_xor(bsum, 1); bsum += __shfl_xor(bsum, 2); bsum += __shfl_xor(bsum, 4);
        if (part == 0) BON[(tok * 8 + h) * 2 + d] = bsum;
      }
      __syncthreads();
#pragma unroll 1
      for (int nn = 0; nn < 32; ++nn) {
        const float* op = OPS + nn * 320 + jg * 16;
        float av[16], wv[16], bv[16], kv[16], rv[16];
#pragma unroll
        for (int q = 0; q < 4; ++q) {
          *(float4*)&av[q * 4] = *(const float4*)(op + q * 4);
          *(float4*)&wv[q * 4] = *(const float4*)(op + 64 + q * 4);
          *(float4*)&bv[q * 4] = *(const float4*)(op + 128 + q * 4);
          *(float4*)&kv[q * 4] = *(const float4*)(op + 192 + q * 4);
          *(float4*)&rv[q * 4] = *(const float4*)(op + 256 + q * 4);
        }
        const float v = VV[nn * 64 + si];
        float sa = 0.f;
#pragma unroll
        for (int j = 0; j < 16; ++j) sa += S[j] * av[j];
        sa += __shfl_xor(sa, 1); sa += __shfl_xor(sa, 2);
        float y = 0.f;
#pragma unroll
        for (int j = 0; j < 16; ++j) {
          S[j] = S[j] * wv[j] + (sa * bv[j] + v * kv[j]);
          y += S[j] * rv[j];
        }
        y += __shfl_xor(y, 1); y += __shfl_xor(y, 2);
        if (jg == 0) YL[nn * 64 + si] = y;
      }
      __syncthreads();
      {
        h16x8 o;
#pragma unroll
        for (int e = 0; e < 8; ++e) o[e] = (_Float16)YL[pn * 64 + j0 + e];
        *(h16x8*)(Y + tok * 512 + h * 64 + j0) = o;
      }
    }
    __syncthreads();
  }
}

DEVI void phase_rwkv_post(int tid_, const Params& p, int l, char* smem) {
  u16* PR = (u16*)(p.ws + OFF_PR);
  const _Float16* YF = (const _Float16*)(p.ws + OFF_NK);
  const _Float16* YB = (const _Float16*)(p.ws + OFF_NV);
  const float* BON = (const float*)(p.ws + OFF_BONUS);
  const u16* GUPT = (const u16*)(p.ws + OFF_WB) + W_GUP;
  const float* mu_p = p.in[I_MU_PREV] + (size_t)l * 1920;
  const float* mu_n = p.in[I_MU_NEXT] + (size_t)l * 1920;
  const float* gng = p.in[I_GN_G] + (size_t)l * 512;
  const float* gnb = p.in[I_GN_B] + (size_t)l * 512;
  u16* As = (u16*)smem;
  const int tid = tid_, lane = tid & 63, w = tid >> 6, fr = lane & 15, fq = lane >> 4;
  for (int tile = blockIdx.x; tile < NTOK / 64; tile += gridDim.x) {
    const size_t tok0 = (size_t)tile * 64;
    {
      const int row = tid >> 2, part = tid & 3;
      const size_t tok = tok0 + row;
      const int t = (int)(tok & 4095);
#pragma unroll
      for (int q = 0; q < 4; ++q) {
        const int col = 1792 + part * 32 + q * 8;
        float cur[8], prv[8], nxt[8];
        load8bf(PR + tok * PRW + col, cur);
        if (t > 0) load8bf(PR + (tok - 1) * PRW + col, prv);
        else {
#pragma unroll
          for (int e = 0; e < 8; ++e) prv[e] = 0.f;
        }
        if (t < 4095) load8bf(PR + (tok + 1) * PRW + col, nxt);
        else {
#pragma unroll
          for (int e = 0; e < 8; ++e) nxt[e] = 0.f;
        }
        float o[8];
#pragma unroll
        for (int e = 0; e < 8; ++e) {
          const float x = cur[e] + mu_p[col + e] * (prv[e] - cur[e]) + mu_n[col + e] * (nxt[e] - cur[e]);
          o[e] = sigm(x);
        }
        u32x4 pk;
        pk.x = pack2(o[0], o[1]); pk.y = pack2(o[2], o[3]); pk.z = pack2(o[4], o[5]); pk.w = pack2(o[6], o[7]);
        *(u32x4*)(As + row * 136 + part * 32 + q * 8) = pk;
      }
    }
    __syncthreads();
#pragma unroll 1
    for (int chh = 0; chh < 2; ++chh) {
      f32x4 acc[16];
#pragma unroll
      for (int n = 0; n < 16; ++n) acc[n] = (f32x4){0.f, 0.f, 0.f, 0.f};
#pragma unroll
      for (int ks = 0; ks < 4; ++ks) {
        bf16x8 af = *(const bf16x8*)(As + (w * 16 + fr) * 136 + ks * 32 + fq * 8);
#pragma unroll
        for (int n = 0; n < 16; ++n) {
          bf16x8 bg = *(const bf16x8*)(GUPT + (size_t)(chh * 256 + n * 16 + fr) * 128 + ks * 32 + fq * 8);
          acc[n] = __builtin_amdgcn_mfma_f32_16x16x32_bf16(af, bg, acc[n], 0, 0, 0);
        }
      }
#pragma unroll
      for (int hl = 0; hl < 4; ++hl) {
        const int head = chh * 4 + hl;
#pragma unroll
        for (int j = 0; j < 4; ++j) {
          const size_t tok = tok0 + w * 16 + fq * 4 + j;
          const int t = (int)(tok & 4095);
          float o[4], sum = 0.f;
#pragma unroll
          for (int q = 0; q < 4; ++q) {
            const int col = head * 64 + q * 16 + fr;
            o[q] = (float)YF[tok * 512 + col] + (float)YB[tok * 512 + col];
            sum += o[q];
          }
          const float mean = red16_sum(sum) * (1.f / 64.f);
          float vs = 0.f;
#pragma unroll
          for (int q = 0; q < 4; ++q) { const float dlt = o[q] - mean; vs += dlt * dlt; }
          const float var = red16_sum(vs) * (1.f / 64.f);
          const float rstd = rsqrtf(var + 64e-5f);
          const float bon = BON[(tok * 8 + head) * 2] + BON[(tok * 8 + head) * 2 + 1];
#pragma unroll
          for (int q = 0; q < 4; ++q) {
            const int col = head * 64 + q * 16 + fr;
            const int vc = 1024 + col;
            const float cur = bf2f(PR[tok * PRW + vc]);
            const float prv = (t > 0) ? bf2f(PR[(tok - 1) * PRW + vc]) : 0.f;
            const float nxt = (t < 4095) ? bf2f(PR[(tok + 1) * PRW + vc]) : 0.f;
            const float vsh = cur + mu_p[vc] * (prv - cur) + mu_n[vc] * (nxt - cur);
            const float yv = ((o[q] - mean) * rstd * gng[col] + gnb[col] + bon * vsh) * acc[hl * 4 + q][j];
            PR[tok * PRW + col] = f2bf(yv);
          }
        }
      }
    }
    __syncthreads();
  }
}

DEVI void phase_merge(int tid_, const Params& p, char* smem) {
  const u16* WB = (const u16*)(p.ws + OFF_WB);
  const u16* H = (const u16*)(p.ws + OFF_H);
  u16* PR = (u16*)(p.ws + OFF_PR);
  const u16* NQ = (const u16*)(p.ws + OFF_NQ);
  const int lane = tid_ & 63, wid = tid_ >> 6;
  const int wr = wid >> 1, wc = wid & 1, fr = lane & 15, fq = lane >> 4;
  for (int t = blockIdx.x; t < 384 * 16; t += gridDim.x) {
    const int tm = t >> 4, tn = t & 15;
    const int m0 = tm << 7, n0 = tn << 6;
    f32x4 g[4][2], acc[4][2];
    uint32_t mp[4][2][2];
    zero_acc(g);
    gemm_kloop<2>(tid_, g, H + (size_t)m0 * 1024, 1024, WB + W_IN + (size_t)(3456 + n0) * 1024, 1024, 1024, smem);
    zero_acc(acc);
    gemm_kloop<2>(tid_, acc, PR + (size_t)m0 * PRW, PRW, WB + W_BRR + (size_t)n0 * 512, 512, 512, smem);
#pragma unroll
    for (int m = 0; m < 4; ++m)
#pragma unroll
      for (int n = 0; n < 2; ++n) {
        mp[m][n][0] = pack2(sigm(g[m][n][0]) * acc[m][n][0], sigm(g[m][n][1]) * acc[m][n][1]);
        mp[m][n][1] = pack2(sigm(g[m][n][2]) * acc[m][n][2], sigm(g[m][n][3]) * acc[m][n][3]);
      }
    zero_acc(g);
    gemm_kloop<2>(tid_, g, H + (size_t)m0 * 1024, 1024, WB + W_IN + (size_t)(4480 + n0) * 1024, 1024, 1024, smem);
    zero_acc(acc);
    gemm_kloop<2>(tid_, acc, NQ + (size_t)m0 * 512, 512, WB + W_BRN + (size_t)n0 * 512, 512, 512, smem);
#pragma unroll
    for (int m = 0; m < 4; ++m)
#pragma unroll
      for (int n = 0; n < 2; ++n) {
        const int r0 = m0 + wr * 64 + m * 16 + fq * 4, c = n0 + wc * 32 + n * 16 + fr;
        float pv[4];
        pv[0] = __uint_as_float(mp[m][n][0] << 16); pv[1] = __uint_as_float(mp[m][n][0] & 0xffff0000u);
        pv[2] = __uint_as_float(mp[m][n][1] << 16); pv[3] = __uint_as_float(mp[m][n][1] & 0xffff0000u);
#pragma unroll
        for (int j = 0; j < 4; ++j)
          PR[(size_t)(r0 + j) * PRW + 512 + c] = f2bf(pv[j] + sigm(g[m][n][j]) * acc[m][n][j]);
      }
  }
}

DEVI void phase_xattn(int tid_, const Params& p, char* smem) {
  const u16* Q = (const u16*)(p.ws + OFF_PR);
  u16* O = (u16*)(p.ws + OFF_NQ);
  const u16* KVK = (const u16*)(p.ws + OFF_KVK);
  const u16* KVT = (const u16*)(p.ws + OFF_KVT);
  const int lane = tid_ & 63, w = tid_ >> 6, fr = lane & 15, fq = lane >> 4;
  u16* Pw = (u16*)smem + w * (16 * 264);
  for (int t = blockIdx.x; t < (NTOK / 64) * 4; t += gridDim.x) {
    const int hh = t & 3;
    const size_t tok0 = (size_t)(t >> 2) * 64 + w * 16;
    const int s = (int)(tok0 >> 12);
    f32x4 acc[16];
#pragma unroll
    for (int n = 0; n < 16; ++n) acc[n] = (f32x4){0.f, 0.f, 0.f, 0.f};
#pragma unroll 2
    for (int ks = 0; ks < 8; ++ks) {
      bf16x8 aq = *(const bf16x8*)(Q + (tok0 + fr) * 1024 + hh * 256 + ks * 32 + fq * 8);
#pragma unroll
      for (int n = 0; n < 16; ++n) {
        bf16x8 bk = *(const bf16x8*)(KVK + (size_t)(s * 256 + n * 16 + fr) * 1024 + hh * 256 + ks * 32 + fq * 8);
        acc[n] = __builtin_amdgcn_mfma_f32_16x16x32_bf16(aq, bk, acc[n], 0, 0, 0);
      }
    }
    float sm[4];
#pragma unroll
    for (int j = 0; j < 4; ++j) {
      float m = -1e30f;
#pragma unroll
      for (int n = 0; n < 16; ++n) { acc[n][j] *= 0.0625f; m = fmaxf(m, acc[n][j]); }
      m = red16_max(m);
      float ssum = 0.f;
#pragma unroll
      for (int n = 0; n < 16; ++n) { const float e = __expf(acc[n][j] - m); acc[n][j] = e; ssum += e; }
      sm[j] = 1.f / red16_sum(ssum);
    }
    __syncthreads();
#pragma unroll
    for (int n = 0; n < 16; ++n)
#pragma unroll
      for (int j = 0; j < 4; ++j) Pw[(fq * 4 + j) * 264 + n * 16 + fr] = f2bf(acc[n][j]);
    __syncthreads();
#pragma unroll
    for (int n = 0; n < 16; ++n) acc[n] = (f32x4){0.f, 0.f, 0.f, 0.f};
#pragma unroll 2
    for (int ks = 0; ks < 8; ++ks) {
      bf16x8 ap = *(const bf16x8*)(Pw + fr * 264 + ks * 32 + fq * 8);
#pragma unroll
      for (int n = 0; n < 16; ++n) {
        bf16x8 bv = *(const bf16x8*)(KVT + (size_t)(s * 1024 + hh * 256 + n * 16 + fr) * 256 + ks * 32 + fq * 8);
        acc[n] = __builtin_amdgcn_mfma_f32_16x16x32_bf16(ap, bv, acc[n], 0, 0, 0);
      }
    }
#pragma unroll
    for (int n = 0; n < 16; ++n)
#pragma unroll
      for (int j = 0; j < 4; ++j)
        O[(tok0 + fq * 4 + j) * 1024 + hh * 256 + n * 16 + fr] = f2bf(acc[n][j] * sm[j]);
  }
}

DEVI void run_phase(int tid_, const Params& p, int ph, char* smem) {
  if (ph == 2 * NPH_LAYER) { phase_final_norm(tid_, p); return; }
  const int l = ph / NPH_LAYER, q = ph % NPH_LAYER;
  u16* WB = (u16*)(p.ws + OFF_WB);
  u16* H = (u16*)(p.ws + OFF_H);
  u16* PR = (u16*)(p.ws + OFF_PR);
  u16* NQ = (u16*)(p.ws + OFF_NQ);
  float* X = p.X;
  auto epi_res = [&](int r0, int c, f32x4 v) {
#pragma unroll
    for (int j = 0; j < 4; ++j) X[(size_t)(r0 + j) * 1024 + c] += v[j];
  };
  switch (q) {
    case 0:
      phase_conv(tid_, p, l, smem);
      phase_norm(tid_, p, p.in[I_NORM_MIX] + (size_t)l * 1024, l == 0);
      phase_norm_mem(tid_, p, p.in[I_NORM_MEM] + (size_t)l * 1024);
      break;
    case 1: phase_p_gemm(tid_, p, smem); break;
    case 2: phase_nat(tid_, p, l, smem); break;
    case 3: phase_scan(tid_, p, l, smem); break;
    case 4: phase_rwkv_post(tid_, p, l, smem); break;
    case 5: phase_merge(tid_, p, smem); break;
    case 6: gemm_phase(tid_, PR + 512, PRW, WB + W_OUT, 1024, 1024, NTOK, 1024, smem, epi_res); break;
    case 7: phase_norm(tid_, p, p.in[I_NORM_X] + (size_t)l * 1024, false); break;
    case 8:
      gemm_phase(tid_, H, 1024, WB + W_XQ, 1024, 1024, NTOK, 1024, smem, [&](int r0, int c, f32x4 v) {
#pragma unroll
        for (int j = 0; j < 4; ++j) PR[(size_t)(r0 + j) * 1024 + c] = f2bf(v[j]);
      });
      break;
    case 9: phase_xattn(tid_, p, smem); break;
    case 10: gemm_phase(tid_, NQ, 1024, WB + W_XO, 1024, 1024, NTOK, 1024, smem, epi_res); break;
    case 11: phase_norm(tid_, p, p.in[I_NORM_FF] + (size_t)l * 1024, false); break;
    case 12:
    case 14: {
      const int hf = (q == 14);
      gemm_phase(tid_, H, 1024, WB + W_FF1 + (size_t)hf * 2048 * 1024, 1024, 1024, NTOK, 2048, smem,
                 [&](int r0, int c, f32x4 v) {
#pragma unroll
                   for (int j = 0; j < 4; ++j) {
                     const float x = fmaxf(v[j], 0.f);
                     PR[(size_t)(r0 + j) * 2048 + c] = f2bf(x * x);
                   }
                 });
    } break;
    case 13:
    case 15: {
      const int hf = (q == 15);
      gemm_phase(tid_, PR, 2048, WB + W_FF2 + (size_t)hf * 2048, 4096, 2048, NTOK, 1024, smem, epi_res);
    } break;
  }
}

__global__ void __launch_bounds__(256, 2) mega_kernel(Params p, int ph0, int ph1) {
  __shared__ __attribute__((aligned(16))) char smem[SMEM_BYTES];
  for (int ph = ph0; ph < ph1; ++ph) {
    if (ph > ph0) cg::this_grid().sync();
    int tid_ = threadIdx.x;
    asm volatile("" : "+v"(tid_));
    run_phase(tid_, p, ph, smem);
  }
}

extern "C" void kernel_launch(void* const* d_in, const int* in_sizes, int n_in, void* d_out, int out_size, void* d_ws,
                              size_t ws_size, hipStream_t stream) {
  if (ws_size < WS_NEED || n_in < 31) return;
  Params p{};
  for (int i = 0; i < 31; ++i) p.in[i] = (const float*)d_in[i];
  p.X = (float*)d_out;
  p.ws = (char*)d_ws;
  for (int ph = 0; ph < NPHASES; ++ph) {
    hipLaunchKernelGGL(mega_kernel, dim3(512), dim3(256), 0, stream, p, ph, ph + 1);
  }
}
```

```cpp
#include <hip/hip_runtime.h>
#include <hip/hip_cooperative_groups.h>
#include <stdint.h>
namespace cg = cooperative_groups;

typedef unsigned short u16;
typedef __attribute__((ext_vector_type(8))) short bf16x8;
typedef __attribute__((ext_vector_type(4))) float f32x4;
typedef __attribute__((ext_vector_type(8))) _Float16 h16x8;
typedef __attribute__((ext_vector_type(4))) unsigned int u32x4;
typedef __attribute__((ext_vector_type(2))) unsigned int u32x2;

#define DEVI __device__ __forceinline__

constexpr int NTOK = 49152;
constexpr int SEQ_T = 4096;
constexpr int PRW = 1920;
constexpr int NPH_LAYER = 16;
constexpr int NPHASES = 2 * NPH_LAYER + 1;
constexpr int SMEM_BYTES = 73728;

constexpr size_t OFF_WB = 0;
constexpr size_t WB_BYTES = 20381696ull * 2;
constexpr size_t OFF_H = OFF_WB + WB_BYTES;
constexpr size_t OFF_PR = OFF_H + (size_t)NTOK * 1024 * 2;
constexpr size_t OFF_NQ = OFF_PR + (size_t)NTOK * PRW * 2;
constexpr size_t OFF_NK = OFF_NQ + (size_t)NTOK * 512 * 2;
constexpr size_t OFF_NV = OFF_NK + (size_t)NTOK * 512 * 2;
constexpr size_t OFF_KVK = OFF_NV + (size_t)NTOK * 512 * 2;
constexpr size_t OFF_KVT = OFF_KVK + (size_t)3072 * 1024 * 2;
constexpr size_t OFF_MEMH = OFF_KVT + (size_t)3072 * 1024 * 2;
constexpr size_t OFF_BONUS = OFF_MEMH + (size_t)3072 * 1024 * 2;
constexpr size_t WS_NEED = OFF_BONUS + (size_t)NTOK * 16 * 4;

constexpr size_t W_IN = 0;
constexpr size_t W_BRR = W_IN + (size_t)5504 * 1024;
constexpr size_t W_BRN = W_BRR + (size_t)1024 * 512;
constexpr size_t W_OUT = W_BRN + (size_t)1024 * 512;
constexpr size_t W_XQ = W_OUT + (size_t)1024 * 1024;
constexpr size_t W_XKV = W_XQ + (size_t)1024 * 1024;
constexpr size_t W_XO = W_XKV + (size_t)2048 * 1024;
constexpr size_t W_FF1 = W_XO + (size_t)1024 * 1024;
constexpr size_t W_FF2 = W_FF1 + (size_t)4096 * 1024;
constexpr size_t W_GUP = W_FF2 + (size_t)4096 * 1024;

enum { I_XP = 0, I_XS, I_MP, I_MS, I_NORM_MIX, I_W_IN, I_MU_PREV, I_MU_NEXT, I_W0, I_W_UP, I_A0, I_A_UP,
       I_G_UP, I_K_K, I_K_A, I_R_K, I_GN_G, I_GN_B, I_RPB, I_W_BR_RWKV, I_W_BR_NAT, I_W_OUT, I_NORM_X,
       I_NORM_MEM, I_W_XQ, I_W_XKV, I_W_XO, I_NORM_FF, I_W_FF1, I_W_FF2, I_NORM_FINAL };

struct Params {
  const float* in[31];
  float* X;
  char* ws;
};

DEVI u16 f2bf(float f) {
  uint32_t u = __float_as_uint(f);
  u += 0x7FFFu + ((u >> 16) & 1u);
  return (u16)(u >> 16);
}
DEVI float bf2f(u16 h) { return __uint_as_float(((uint32_t)h) << 16); }
DEVI uint32_t pack2(float a, float b) { return (uint32_t)f2bf(a) | ((uint32_t)f2bf(b) << 16); }
DEVI float sigm(float x) { return 1.f / (1.f + __expf(-x)); }
DEVI void unpack8(u32x4 u, float* o) {
  o[0] = __uint_as_float(u.x << 16); o[1] = __uint_as_float(u.x & 0xffff0000u);
  o[2] = __uint_as_float(u.y << 16); o[3] = __uint_as_float(u.y & 0xffff0000u);
  o[4] = __uint_as_float(u.z << 16); o[5] = __uint_as_float(u.z & 0xffff0000u);
  o[6] = __uint_as_float(u.w << 16); o[7] = __uint_as_float(u.w & 0xffff0000u);
}
DEVI void load8bf(const u16* p, float* o) { unpack8(*(const u32x4*)p, o); }
DEVI float wave_sum(float v) {
  v += __shfl_xor(v, 32); v += __shfl_xor(v, 16); v += __shfl_xor(v, 8);
  v += __shfl_xor(v, 4); v += __shfl_xor(v, 2); v += __shfl_xor(v, 1);
  return v;
}
DEVI float red16_sum(float v) {
  v += __shfl_xor(v, 1); v += __shfl_xor(v, 2); v += __shfl_xor(v, 4); v += __shfl_xor(v, 8);
  return v;
}
DEVI float red16_max(float v) {
  v = fmaxf(v, __shfl_xor(v, 1)); v = fmaxf(v, __shfl_xor(v, 2));
  v = fmaxf(v, __shfl_xor(v, 4)); v = fmaxf(v, __shfl_xor(v, 8));
  return v;
}

DEVI void conv_tile(int tid_, const float* src, int K, int N, u16* dst, int tile, char* smem) {
  float (*s)[65] = (float (*)[65])smem;
  const int nN = N >> 6;
  const int tk = tile / nN, tn = tile - tk * nN;
  const int tx = tid_ & 63, ty = tid_ >> 6;
  for (int r = ty; r < 64; r += 4) s[r][tx] = src[(size_t)(tk * 64 + r) * N + tn * 64 + tx];
  __syncthreads();
  for (int r = ty; r < 64; r += 4) dst[(size_t)(tn * 64 + r) * K + tk * 64 + tx] = f2bf(s[tx][r]);
  __syncthreads();
}

DEVI void phase_conv(int tid_, const Params& p, int l, char* smem) {
  u16* WB = (u16*)(p.ws + OFF_WB);
  const int c0 = 1376, c1 = c0 + 128, c2 = c1 + 128, c3 = c2 + 256, c4 = c3 + 256, c5 = c4 + 512,
            c6 = c5 + 256, c7 = c6 + 1024, c8 = c7 + 1024, c9 = c8 + 16;
  for (int t = blockIdx.x; t < c9; t += gridDim.x) {
    if (t < c0) conv_tile(tid_, p.in[I_W_IN] + (size_t)l * 1024 * 5504, 1024, 5504, WB + W_IN, t, smem);
    else if (t < c1) conv_tile(tid_, p.in[I_W_BR_RWKV] + (size_t)l * 512 * 1024, 512, 1024, WB + W_BRR, t - c0, smem);
    else if (t < c2) conv_tile(tid_, p.in[I_W_BR_NAT] + (size_t)l * 512 * 1024, 512, 1024, WB + W_BRN, t - c1, smem);
    else if (t < c3) conv_tile(tid_, p.in[I_W_OUT] + (size_t)l * 1024 * 1024, 1024, 1024, WB + W_OUT, t - c2, smem);
    else if (t < c4) conv_tile(tid_, p.in[I_W_XQ] + (size_t)l * 1024 * 1024, 1024, 1024, WB + W_XQ, t - c3, smem);
    else if (t < c5) conv_tile(tid_, p.in[I_W_XKV] + (size_t)l * 1024 * 2048, 1024, 2048, WB + W_XKV, t - c4, smem);
    else if (t < c6) conv_tile(tid_, p.in[I_W_XO] + (size_t)l * 1024 * 1024, 1024, 1024, WB + W_XO, t - c5, smem);
    else if (t < c7) conv_tile(tid_, p.in[I_W_FF1] + (size_t)l * 1024 * 4096, 1024, 4096, WB + W_FF1, t - c6, smem);
    else if (t < c8) conv_tile(tid_, p.in[I_W_FF2] + (size_t)l * 4096 * 1024, 4096, 1024, WB + W_FF2, t - c7, smem);
    else conv_tile(tid_, p.in[I_G_UP] + (size_t)l * 128 * 512, 128, 512, WB + W_GUP, t - c8, smem);
  }
}

DEVI void norm_row_bf16(int tid_, const float* src, const float* g, u16* dst, float* xcopy) {
  const int lane = tid_ & 63;
  float4 v[4];
  float ss = 0.f;
#pragma unroll
  for (int i = 0; i < 4; ++i) {
    v[i] = ((const float4*)src)[lane + i * 64];
    ss += v[i].x * v[i].x + v[i].y * v[i].y + v[i].z * v[i].z + v[i].w * v[i].w;
  }
  ss = wave_sum(ss);
  const float rs = rsqrtf(ss * (1.f / 1024.f) + 1e-6f);
#pragma unroll
  for (int i = 0; i < 4; ++i) {
    float4 gg = ((const float4*)g)[lane + i * 64];
    u32x2 o;
    o.x = pack2(v[i].x * rs * gg.x, v[i].y * rs * gg.y);
    o.y = pack2(v[i].z * rs * gg.z, v[i].w * rs * gg.w);
    ((u32x2*)dst)[lane + i * 64] = o;
    if (xcopy) ((float4*)xcopy)[lane + i * 64] = v[i];
  }
}

DEVI void phase_norm(int tid_, const Params& p, const float* g, bool from_input) {
  u16* H = (u16*)(p.ws + OFF_H);
  const int wid = tid_ >> 6;
  for (int r = blockIdx.x * 4 + wid; r < NTOK; r += gridDim.x * 4) {
    const float* src;
    if (from_input) src = (r < 32768) ? p.in[I_XP] + (size_t)r * 1024 : p.in[I_XS] + (size_t)(r - 32768) * 1024;
    else src = p.X + (size_t)r * 1024;
    norm_row_bf16(tid_, src, g, H + (size_t)r * 1024, from_input ? p.X + (size_t)r * 1024 : nullptr);
  }
}
DEVI void phase_norm_mem(int tid_, const Params& p, const float* g) {
  u16* MH = (u16*)(p.ws + OFF_MEMH);
  const int wid = tid_ >> 6;
  for (int r = blockIdx.x * 4 + wid; r < 3072; r += gridDim.x * 4) {
    const float* src = (r < 2048) ? p.in[I_MP] + (size_t)r * 1024 : p.in[I_MS] + (size_t)(r - 2048) * 1024;
    norm_row_bf16(tid_, src, g, MH + (size_t)r * 1024, nullptr);
  }
}
DEVI void phase_final_norm(int tid_, const Params& p) {
  const float* g = p.in[I_NORM_FINAL];
  const int wid = tid_ >> 6, lane = tid_ & 63;
  for (int r = blockIdx.x * 4 + wid; r < NTOK; r += gridDim.x * 4) {
    float* row = p.X + (size_t)r * 1024;
    float4 v[4];
    float ss = 0.f;
#pragma unroll
    for (int i = 0; i < 4; ++i) {
      v[i] = ((const float4*)row)[lane + i * 64];
      ss += v[i].x * v[i].x + v[i].y * v[i].y + v[i].z * v[i].z + v[i].w * v[i].w;
    }
    ss = wave_sum(ss);
    const float rs = rsqrtf(ss * (1.f / 1024.f) + 1e-6f);
#pragma unroll
    for (int i = 0; i < 4; ++i) {
      float4 gg = ((const float4*)g)[lane + i * 64];
      float4 o;
      o.x = v[i].x * rs * gg.x; o.y = v[i].y * rs * gg.y; o.z = v[i].z * rs * gg.z; o.w = v[i].w * rs * gg.w;
      ((float4*)row)[lane + i * 64] = o;
    }
  }
}

constexpr int LDSW = 72;

template <int NW>
DEVI void gemm_kloop(int tid_, f32x4 (&acc)[4][NW], const u16* __restrict__ A, int lda, const u16* __restrict__ Bt, int ldb,
                     int K, char* smem) {
  u16* sA = (u16*)smem;
  u16* sB = sA + 128 * LDSW;
  const int tid = tid_, lane = tid & 63, wid = tid >> 6;
  const int wr = wid >> 1, wc = wid & 1, fr = lane & 15, fq = lane >> 4;
  const int lrow = tid >> 3, lkc = tid & 7;
  u32x4 ra[4], rb[NW];
  const u16* ga = A + (size_t)lrow * lda + lkc * 8;
  const u16* gb = Bt + (size_t)lrow * ldb + lkc * 8;
#pragma unroll
  for (int i = 0; i < 4; ++i) ra[i] = *(const u32x4*)(ga + (size_t)(i * 32) * lda);
#pragma unroll
  for (int i = 0; i < NW; ++i) rb[i] = *(const u32x4*)(gb + (size_t)(i * 32) * ldb);
  for (int k0 = 0; k0 < K; k0 += 64) {
    __syncthreads();
#pragma unroll
    for (int i = 0; i < 4; ++i) *(u32x4*)(sA + (lrow + i * 32) * LDSW + lkc * 8) = ra[i];
#pragma unroll
    for (int i = 0; i < NW; ++i) *(u32x4*)(sB + (lrow + i * 32) * LDSW + lkc * 8) = rb[i];
    __syncthreads();
    if (k0 + 64 < K) {
#pragma unroll
      for (int i = 0; i < 4; ++i) ra[i] = *(const u32x4*)(ga + (size_t)(i * 32) * lda + k0 + 64);
#pragma unroll
      for (int i = 0; i < NW; ++i) rb[i] = *(const u32x4*)(gb + (size_t)(i * 32) * ldb + k0 + 64);
    }
#pragma unroll
    for (int ks = 0; ks < 2; ++ks) {
      bf16x8 af[4], bfr[NW];
#pragma unroll
      for (int m = 0; m < 4; ++m) af[m] = *(const bf16x8*)(sA + (wr * 64 + m * 16 + fr) * LDSW + ks * 32 + fq * 8);
#pragma unroll
      for (int n = 0; n < NW; ++n) bfr[n] = *(const bf16x8*)(sB + (wc * 16 * NW + n * 16 + fr) * LDSW + ks * 32 + fq * 8);
#pragma unroll
      for (int m = 0; m < 4; ++m)
#pragma unroll
        for (int n = 0; n < NW; ++n) acc[m][n] = __builtin_amdgcn_mfma_f32_16x16x32_bf16(af[m], bfr[n], acc[m][n], 0, 0, 0);
    }
  }
}

template <int NW>
DEVI void zero_acc(f32x4 (&acc)[4][NW]) {
#pragma unroll
  for (int m = 0; m < 4; ++m)
#pragma unroll
    for (int n = 0; n < NW; ++n) acc[m][n] = (f32x4){0.f, 0.f, 0.f, 0.f};
}

template <class Epi>
DEVI void gemm_phase(int tid_, const u16* A, int lda, const u16* Bt, int ldb, int K, int M, int N, char* smem, Epi epi) {
  const int nN = N >> 7, nM = M >> 7;
  const int lane = tid_ & 63, wid = tid_ >> 6;
  const int wr = wid >> 1, wc = wid & 1, fr = lane & 15, fq = lane >> 4;
  for (int t = blockIdx.x; t < nM * nN; t += gridDim.x) {
    const int tm = t / nN, tn = t - tm * nN;
    const int m0 = tm << 7, n0 = tn << 7;
    f32x4 acc[4][4];
    zero_acc(acc);
    gemm_kloop<4>(tid_, acc, A + (size_t)m0 * lda, lda, Bt + (size_t)n0 * ldb, ldb, K, smem);
#pragma unroll
    for (int m = 0; m < 4; ++m)
#pragma unroll
      for (int n = 0; n < 4; ++n) epi(m0 + wr * 64 + m * 16 + fq * 4, n0 + wc * 64 + n * 16 + fr, acc[m][n]);
  }
}

DEVI void phase_p_gemm(int tid_, const Params& p, char* smem) {
  u16* WB = (u16*)(p.ws + OFF_WB);
  const u16* H = (const u16*)(p.ws + OFF_H);
  u16* PR = (u16*)(p.ws + OFF_PR);
  u16* NQ = (u16*)(p.ws + OFF_NQ);
  u16* NK = (u16*)(p.ws + OFF_NK);
  u16* NVT = (u16*)(p.ws + OFF_NV);
  gemm_phase(tid_, H, 1024, WB + W_IN, 1024, 1024, NTOK, 3456, smem, [&](int r0, int c, f32x4 v) {
    if (c < 1920) {
#pragma unroll
      for (int j = 0; j < 4; ++j) PR[(size_t)(r0 + j) * PRW + c] = f2bf(v[j]);
    } else if (c < 2432) {
#pragma unroll
      for (int j = 0; j < 4; ++j) NQ[(size_t)(r0 + j) * 512 + (c - 1920)] = f2bf(v[j]);
    } else if (c < 2944) {
#pragma unroll
      for (int j = 0; j < 4; ++j) NK[(size_t)(r0 + j) * 512 + (c - 2432)] = f2bf(v[j]);
    } else {
      const int cc = c - 2944;
      const int s = r0 >> 12, t = r0 & 4095;
      u32x2 o;
      o.x = pack2(v[0], v[1]); o.y = pack2(v[2], v[3]);
      *(u32x2*)(NVT + ((size_t)(s * 512 + cc)) * 4096 + t) = o;
    }
  });
  const u16* MH = (const u16*)(p.ws + OFF_MEMH);
  u16* KVK = (u16*)(p.ws + OFF_KVK);
  u16* KVT = (u16*)(p.ws + OFF_KVT);
  gemm_phase(tid_, MH, 1024, WB + W_XKV, 1024, 1024, 3072, 2048, smem, [&](int r0, int c, f32x4 v) {
    if (c < 1024) {
#pragma unroll
      for (int j = 0; j < 4; ++j) KVK[(size_t)(r0 + j) * 1024 + c] = f2bf(v[j]);
    } else {
      const int cc = c - 1024;
      const int s = r0 >> 8, m = r0 & 255;
      u32x2 o;
      o.x = pack2(v[0], v[1]); o.y = pack2(v[2], v[3]);
      *(u32x2*)(KVT + ((size_t)(s * 1024 + cc)) * 256 + m) = o;
    }
  });
}

DEVI void phase_nat(int tid_, const Params& p, int l, char* smem) {
  u16* NQ = (u16*)(p.ws + OFF_NQ);
  const u16* NK = (const u16*)(p.ws + OFF_NK);
  const u16* NVT = (const u16*)(p.ws + OFF_NV);
  const float* rpb = p.in[I_RPB] + (size_t)l * 8 * 15 * 31;
  const int lane = tid_ & 63, g = tid_ >> 6, fr = lane & 15, fq = lane >> 4;
  u16* Pw = (u16*)smem + g * (16 * 264);
  const int cb = (g == 0) ? 0 : (g == 1) ? 8 : (g == 2) ? 24 : 32;
  for (int t = blockIdx.x; t < 12 * 64 * 8; t += gridDim.x) {
    const int h = t & 7, ri = (t >> 3) & 63, s = t >> 9;
    int rs = ri - 4; rs = rs < 0 ? 0 : (rs > 56 ? 56 : rs);
    const size_t tokq = (size_t)s * 4096 + ri * 64 + g * 16;
    bf16x8 aq[2];
    aq[0] = *(const bf16x8*)(NQ + (tokq + fr) * 512 + h * 64 + fq * 8);
    aq[1] = *(const bf16x8*)(NQ + (tokq + fr) * 512 + h * 64 + 32 + fq * 8);
    f32x4 acc[16];
#pragma unroll
    for (int n = 0; n < 16; ++n) {
      acc[n] = (f32x4){0.f, 0.f, 0.f, 0.f};
      const int r = n >> 1, col = cb + (n & 1) * 16 + fr;
      const u16* kp = NK + ((size_t)s * 4096 + (rs + r) * 64 + col) * 512 + h * 64 + fq * 8;
      bf16x8 b0 = *(const bf16x8*)kp;
      bf16x8 b1 = *(const bf16x8*)(kp + 32);
      acc[n] = __builtin_amdgcn_mfma_f32_16x16x32_bf16(aq[0], b0, acc[n], 0, 0, 0);
      acc[n] = __builtin_amdgcn_mfma_f32_16x16x32_bf16(aq[1], b1, acc[n], 0, 0, 0);
    }
    float mx[4], sm[4];
#pragma unroll
    for (int j = 0; j < 4; ++j) {
      const int c = g * 16 + fq * 4 + j;
      int cs = c - 8; cs = cs < 0 ? 0 : (cs > 48 ? 48 : cs);
      float m = -1e30f;
#pragma unroll
      for (int n = 0; n < 16; ++n) {
        const int r = n >> 1, kc = cb + (n & 1) * 16 + fr;
        const bool valid = (kc >= cs) && (kc < cs + 16);
        float sc = -1e30f;
        if (valid) {
          const int di = rs + r - ri + 7, dj = kc - c + 15;
          sc = acc[n][j] * 0.125f + rpb[(h * 15 + di) * 31 + dj];
        }
        acc[n][j] = sc;
        m = fmaxf(m, sc);
      }
      mx[j] = red16_max(m);
    }
#pragma unroll
    for (int j = 0; j < 4; ++j) {
      float ssum = 0.f;
#pragma unroll
      for (int n = 0; n < 16; ++n) {
        float e = __expf(acc[n][j] - mx[j]);
        acc[n][j] = e;
        ssum += e;
      }
      sm[j] = 1.f / red16_sum(ssum);
    }
    __syncthreads();
#pragma unroll
    for (int n = 0; n < 16; ++n)
#pragma unroll
      for (int j = 0; j < 4; ++j) Pw[(fq * 4 + j) * 264 + n * 16 + fr] = f2bf(acc[n][j]);
    __syncthreads();
    f32x4 o[4];
#pragma unroll
    for (int n = 0; n < 4; ++n) o[n] = (f32x4){0.f, 0.f, 0.f, 0.f};
#pragma unroll
    for (int ks = 0; ks < 8; ++ks) {
      bf16x8 ap = *(const bf16x8*)(Pw + fr * 264 + ks * 32 + fq * 8);
#pragma unroll
      for (int n = 0; n < 4; ++n) {
        bf16x8 bv = *(const bf16x8*)(NVT + ((size_t)(s * 512 + h * 64 + n * 16 + fr)) * 4096 + (rs + ks) * 64 + cb + fq * 8);
        o[n] = __builtin_amdgcn_mfma_f32_16x16x32_bf16(ap, bv, o[n], 0, 0, 0);
      }
    }
#pragma unroll
    for (int n = 0; n < 4; ++n)
#pragma unroll
      for (int j = 0; j < 4; ++j)
        NQ[(tokq + fq * 4 + j) * 512 + h * 64 + n * 16 + fr] = f2bf(o[n][j] * sm[j]);
  }
}

DEVI void phase_scan(int tid_, const Params& p, int l, char* smem) {
  const u16* PR = (const u16*)(p.ws + OFF_PR);
  _Float16* YF = (_Float16*)(p.ws + OFF_NK);
  _Float16* YB = (_Float16*)(p.ws + OFF_NV);
  float* BON = (float*)(p.ws + OFF_BONUS);
  float* OPS = (float*)smem;
  float* VV = OPS + 32 * 5 * 64;
  float* TW = VV + 32 * 64;
  float* AD = TW + 32 * 64;
  float* YL = AD + 32 * 64;
  const float* mu_p = p.in[I_MU_PREV] + (size_t)l * 1920;
  const float* mu_n = p.in[I_MU_NEXT] + (size_t)l * 1920;
  const int tid = tid_;
  for (int blk = blockIdx.x; blk < 192; blk += gridDim.x) {
    const int s = blk >> 4, h = (blk >> 1) & 7, d = blk & 1;
    const float* w0 = p.in[I_W0] + (size_t)(l * 2 + d) * 512 + h * 64;
    const float* a0 = p.in[I_A0] + (size_t)(l * 2 + d) * 512 + h * 64;
    const float* wup = p.in[I_W_UP] + (size_t)(l * 2 + d) * 64 * 512 + h * 64;
    const float* aup = p.in[I_A_UP] + (size_t)(l * 2 + d) * 64 * 512 + h * 64;
    const float* kk_w = p.in[I_K_K] + (size_t)l * 512 + h * 64;
    const float* ka_w = p.in[I_K_A] + (size_t)l * 512 + h * 64;
    const float* rk_w = p.in[I_R_K] + (size_t)(l * 8 + h) * 64;
    _Float16* Y = d ? YB : YF;
    float S[16];
#pragma unroll
    for (int j = 0; j < 16; ++j) S[j] = 0.f;
    const int pn = tid >> 3, part = tid & 7, j0 = part * 8;
    const int si = tid >> 2, jg = tid & 3;
#pragma unroll 1
    for (int ch = 0; ch < 128; ++ch) {
      const int n = ch * 32 + pn;
      const int t = d ? (4095 - n) : n;
      const size_t tok = (size_t)s * 4096 + t;
#pragma unroll 1
      for (int gi = 0; gi < 5; ++gi) {
        const int col = (gi < 3) ? (gi * 512 + h * 64 + j0) : (1536 + (gi - 3) * 128 + d * 64 + j0);
        float* dst = (gi == 0) ? (OPS + (pn * 5 + 4) * 64 + j0)
                   : (gi == 1) ? (OPS + (pn * 5 + 3) * 64 + j0)
                   : (gi == 2) ? (VV + pn * 64 + j0)
                   : (gi == 3) ? (TW + pn * 64 + j0) : (AD + pn * 64 + j0);
        float cur[8], prv[8], nxt[8];
        load8bf(PR + tok * PRW + col, cur);
        if (t > 0) load8bf(PR + (tok - 1) * PRW + col, prv);
        else {
#pragma unroll
          for (int e = 0; e < 8; ++e) prv[e] = 0.f;
        }
        if (t < 4095) load8bf(PR + (tok + 1) * PRW + col, nxt);
        else {
#pragma unroll
          for (int e = 0; e < 8; ++e) nxt[e] = 0.f;
        }
        const f32x4 mp0 = *(const f32x4*)(mu_p + col), mp1 = *(const f32x4*)(mu_p + col + 4);
        const f32x4 mn0 = *(const f32x4*)(mu_n + col), mn1 = *(const f32x4*)(mu_n + col + 4);
        f32x4 x0, x1;
#pragma unroll
        for (int e = 0; e < 4; ++e) {
          x0[e] = cur[e] + mp0[e] * (prv[e] - cur[e]) + mn0[e] * (nxt[e] - cur[e]);
          x1[e] = cur[4 + e] + mp1[e] * (prv[4 + e] - cur[4 + e]) + mn1[e] * (nxt[4 + e] - cur[4 + e]);
        }
        if (gi == 3) {
#pragma unroll
          for (int e = 0; e < 4; ++e) { x0[e] = tanhf(x0[e]); x1[e] = tanhf(x1[e]); }
        }
        *(f32x4*)dst = x0;
        *(f32x4*)(dst + 4) = x1;
      }
      __syncthreads();
      {
        float wr_[8], ap_[8];
        *(float4*)&wr_[0] = *(const float4*)(w0 + j0); *(float4*)&wr_[4] = *(const float4*)(w0 + j0 + 4);
        *(float4*)&ap_[0] = *(const float4*)(a0 + j0); *(float4*)&ap_[4] = *(const float4*)(a0 + j0 + 4);
#pragma unroll 2
        for (int li = 0; li < 64; ++li) {
          const float tw = TW[pn * 64 + li], ad = AD[pn * 64 + li];
          const float4 u0 = *(const float4*)(wup + (size_t)li * 512 + j0), u1 = *(const float4*)(wup + (size_t)li * 512 + j0 + 4);
          const float4 q0 = *(const float4*)(aup + (size_t)li * 512 + j0), q1 = *(const float4*)(aup + (size_t)li * 512 + j0 + 4);
          wr_[0] += tw * u0.x; wr_[1] += tw * u0.y; wr_[2] += tw * u0.z; wr_[3] += tw * u0.w;
          wr_[4] += tw * u1.x; wr_[5] += tw * u1.y; wr_[6] += tw * u1.z; wr_[7] += tw * u1.w;
          ap_[0] += ad * q0.x; ap_[1] += ad * q0.y; ap_[2] += ad * q0.z; ap_[3] += ad * q0.w;
          ap_[4] += ad * q1.x; ap_[5] += ad * q1.y; ap_[6] += ad * q1.z; ap_[7] += ad * q1.w;
        }
        float kkv[8], kr[8], rr[8], ss = 0.f;
        *(f32x4*)&kr[0] = *(const f32x4*)(OPS + (pn * 5 + 3) * 64 + j0); *(f32x4*)&kr[4] = *(const f32x4*)(OPS + (pn * 5 + 3) * 64 + j0 + 4);
        *(f32x4*)&rr[0] = *(const f32x4*)(OPS + (pn * 5 + 4) * 64 + j0); *(f32x4*)&rr[4] = *(const f32x4*)(OPS + (pn * 5 + 4) * 64 + j0 + 4);
#pragma unroll
        for (int e = 0; e < 8; ++e) { kkv[e] = kr[e] * kk_w[j0 + e]; ss += kkv[e] * kkv[e]; }
        ss += __shfl_xor(ss, 1); ss += __shfl_xor(ss, 2); ss += __shfl_xor(ss, 4);
        const float inv = 1.f / fmaxf(sqrtf(ss), 1e-12f);
        float bsum = 0.f;
#pragma unroll
        for (int e = 0; e < 8; ++e) {
          const float sw = 1.f / (1.f + expf(-wr_[e]));
          const float dec = expf(-0.6065306597126334f * sw);
          const float av = 1.f / (1.f + expf(-ap_[e]));
          const float kn = kkv[e] * inv;
          const float kd = kr[e] * (1.f + (av - 1.f) * ka_w[j0 + e]);
          bsum += rr[e] * kd * rk_w[j0 + e];
          OPS[(pn * 5 + 0) * 64 + j0 + e] = -kn;
          OPS[(pn * 5 + 1) * 64 + j0 + e] = dec;
          OPS[(pn * 5 + 2) * 64 + j0 + e] = kn * av;
          OPS[(pn * 5 + 3) * 64 + j0 + e] = kd;
        }
        bsum += __shfl_xor(bsum, 1); bsum += __shfl_xor(bsum, 2); bsum += __shfl_xor(bsum, 4);
        if (part == 0) BON[(tok * 8 + h) * 2 + d] = bsum;
      }
      __syncthreads();
#pragma unroll 1
      for (int nn = 0; nn < 32; ++nn) {
        const float* op = OPS + nn * 320 + jg * 16;
        float av[16], wv[16], bv[16], kv[16], rv[16];
#pragma unroll
        for (int q = 0; q < 4; ++q) {
          *(float4*)&av[q * 4] = *(const float4*)(op + q * 4);
          *(float4*)&wv[q * 4] = *(const float4*)(op + 64 + q * 4);
          *(float4*)&bv[q * 4] = *(const float4*)(op + 128 + q * 4);
          *(float4*)&kv[q * 4] = *(const float4*)(op + 192 + q * 4);
          *(float4*)&rv[q * 4] = *(const float4*)(op + 256 + q * 4);
        }
        const float v = VV[nn * 64 + si];
        float sa = 0.f;
#pragma unroll
        for (int j = 0; j < 16; ++j) sa += S[j] * av[j];
        sa += __shfl_xor(sa, 1); sa += __shfl_xor(sa, 2);
        float y = 0.f;
#pragma unroll
        for (int j = 0; j < 16; ++j) {
          S[j] = S[j] * wv[j] + (sa * bv[j] + v * kv[j]);
          y += S[j] * rv[j];
        }
        y += __shfl_xor(y, 1); y += __shfl_xor(y, 2);
        if (jg == 0) YL[nn * 64 + si] = y;
      }
      __syncthreads();
      {
        h16x8 o;
#pragma unroll
        for (int e = 0; e < 8; ++e) o[e] = (_Float16)YL[pn * 64 + j0 + e];
        *(h16x8*)(Y + tok * 512 + h * 64 + j0) = o;
      }
    }
    __syncthreads();
  }
}

DEVI void phase_rwkv_post(int tid_, const Params& p, int l, char* smem) {
  u16* PR = (u16*)(p.ws + OFF_PR);
  const _Float16* YF = (const _Float16*)(p.ws + OFF_NK);
  const _Float16* YB = (const _Float16*)(p.ws + OFF_NV);
  const float* BON = (const float*)(p.ws + OFF_BONUS);
  const u16* GUPT = (const u16*)(p.ws + OFF_WB) + W_GUP;
  const float* mu_p = p.in[I_MU_PREV] + (size_t)l * 1920;
  const float* mu_n = p.in[I_MU_NEXT] + (size_t)l * 1920;
  const float* gng = p.in[I_GN_G] + (size_t)l * 512;
  const float* gnb = p.in[I_GN_B] + (size_t)l * 512;
  u16* As = (u16*)smem;
  const int tid = tid_, lane = tid & 63, w = tid >> 6, fr = lane & 15, fq = lane >> 4;
  for (int tile = blockIdx.x; tile < NTOK / 64; tile += gridDim.x) {
    const size_t tok0 = (size_t)tile * 64;
    {
      const int row = tid >> 2, part = tid & 3;
      const size_t tok = tok0 + row;
      const int t = (int)(tok & 4095);
#pragma unroll
      for (int q = 0; q < 4; ++q) {
        const int col = 1792 + part * 32 + q * 8;
        float cur[8], prv[8], nxt[8];
        load8bf(PR + tok * PRW + col, cur);
        if (t > 0) load8bf(PR + (tok - 1) * PRW + col, prv);
        else {
#pragma unroll
          for (int e = 0; e < 8; ++e) prv[e] = 0.f;
        }
        if (t < 4095) load8bf(PR + (tok + 1) * PRW + col, nxt);
        else {
#pragma unroll
          for (int e = 0; e < 8; ++e) nxt[e] = 0.f;
        }
        float o[8];
#pragma unroll
        for (int e = 0; e < 8; ++e) {
          const float x = cur[e] + mu_p[col + e] * (prv[e] - cur[e]) + mu_n[col + e] * (nxt[e] - cur[e]);
          o[e] = sigm(x);
        }
        u32x4 pk;
        pk.x = pack2(o[0], o[1]); pk.y = pack2(o[2], o[3]); pk.z = pack2(o[4], o[5]); pk.w = pack2(o[6], o[7]);
        *(u32x4*)(As + row * 136 + part * 32 + q * 8) = pk;
      }
    }
    __syncthreads();
#pragma unroll 1
    for (int chh = 0; chh < 2; ++chh) {
      f32x4 acc[16];
#pragma unroll
      for (int n = 0; n < 16; ++n) acc[n] = (f32x4){0.f, 0.f, 0.f, 0.f};
#pragma unroll
      for (int ks = 0; ks < 4; ++ks) {
        bf16x8 af = *(const bf16x8*)(As + (w * 16 + fr) * 136 + ks * 32 + fq * 8);
#pragma unroll
        for (int n = 0; n < 16; ++n) {
          bf16x8 bg = *(const bf16x8*)(GUPT + (size_t)(chh * 256 + n * 16 + fr) * 128 + ks * 32 + fq * 8);
          acc[n] = __builtin_amdgcn_mfma_f32_16x16x32_bf16(af, bg, acc[n], 0, 0, 0);
        }
      }
#pragma unroll
      for (int hl = 0; hl < 4; ++hl) {
        const int head = chh * 4 + hl;
#pragma unroll
        for (int j = 0; j < 4; ++j) {
          const size_t tok = tok0 + w * 16 + fq * 4 + j;
          const int t = (int)(tok & 4095);
          float o[4], sum = 0.f;
#pragma unroll
          for (int q = 0; q < 4; ++q) {
            const int col = head * 64 + q * 16 + fr;
            o[q] = (float)YF[tok * 512 + col] + (float)YB[tok * 512 + col];
            sum += o[q];
          }
          const float mean = red16_sum(sum) * (1.f / 64.f);
          float vs = 0.f;
#pragma unroll
          for (int q = 0; q < 4; ++q) { const float dlt = o[q] - mean; vs += dlt * dlt; }
          const float var = red16_sum(vs) * (1.f / 64.f);
          const float rstd = rsqrtf(var + 64e-5f);
          const float bon = BON[(tok * 8 + head) * 2] + BON[(tok * 8 + head) * 2 + 1];
#pragma unroll
          for (int q = 0; q < 4; ++q) {
            const int col = head * 64 + q * 16 + fr;
            const int vc = 1024 + col;
            const float cur = bf2f(PR[tok * PRW + vc]);
            const float prv = (t > 0) ? bf2f(PR[(tok - 1) * PRW + vc]) : 0.f;
            const float nxt = (t < 4095) ? bf2f(PR[(tok + 1) * PRW + vc]) : 0.f;
            const float vsh = cur + mu_p[vc] * (prv - cur) + mu_n[vc] * (nxt - cur);
            const float yv = ((o[q] - mean) * rstd * gng[col] + gnb[col] + bon * vsh) * acc[hl * 4 + q][j];
            PR[tok * PRW + col] = f2bf(yv);
          }
        }
      }
    }
    __syncthreads();
  }
}

DEVI void phase_merge(int tid_, const Params& p, char* smem) {
  const u16* WB = (const u16*)(p.ws + OFF_WB);
  const u16* H = (const u16*)(p.ws + OFF_H);
  u16* PR = (u16*)(p.ws + OFF_PR);
  const u16* NQ = (const u16*)(p.ws + OFF_NQ);
  const int lane = tid_ & 63, wid = tid_ >> 6;
  const int wr = wid >> 1, wc = wid & 1, fr = lane & 15, fq = lane >> 4;
  for (int t = blockIdx.x; t < 384 * 16; t += gridDim.x) {
    const int tm = t >> 4, tn = t & 15;
    const int m0 = tm << 7, n0 = tn << 6;
    f32x4 g[4][2], acc[4][2];
    uint32_t mp[4][2][2];
    zero_acc(g);
    gemm_kloop<2>(tid_, g, H + (size_t)m0 * 1024, 1024, WB + W_IN + (size_t)(3456 + n0) * 1024, 1024, 1024, smem);
    zero_acc(acc);
    gemm_kloop<2>(tid_, acc, PR + (size_t)m0 * PRW, PRW, WB + W_BRR + (size_t)n0 * 512, 512, 512, smem);
#pragma unroll
    for (int m = 0; m < 4; ++m)
#pragma unroll
      for (int n = 0; n < 2; ++n) {
        mp[m][n][0] = pack2(sigm(g[m][n][0]) * acc[m][n][0], sigm(g[m][n][1]) * acc[m][n][1]);
        mp[m][n][1] = pack2(sigm(g[m][n][2]) * acc[m][n][2], sigm(g[m][n][3]) * acc[m][n][3]);
      }
    zero_acc(g);
    gemm_kloop<2>(tid_, g, H + (size_t)m0 * 1024, 1024, WB + W_IN + (size_t)(4480 + n0) * 1024, 1024, 1024, smem);
    zero_acc(acc);
    gemm_kloop<2>(tid_, acc, NQ + (size_t)m0 * 512, 512, WB + W_BRN + (size_t)n0 * 512, 512, 512, smem);
#pragma unroll
    for (int m = 0; m < 4; ++m)
#pragma unroll
      for (int n = 0; n < 2; ++n) {
        const int r0 = m0 + wr * 64 + m * 16 + fq * 4, c = n0 + wc * 32 + n * 16 + fr;
        float pv[4];
        pv[0] = __uint_as_float(mp[m][n][0] << 16); pv[1] = __uint_as_float(mp[m][n][0] & 0xffff0000u);
        pv[2] = __uint_as_float(mp[m][n][1] << 16); pv[3] = __uint_as_float(mp[m][n][1] & 0xffff0000u);
#pragma unroll
        for (int j = 0; j < 4; ++j)
          PR[(size_t)(r0 + j) * PRW + 512 + c] = f2bf(pv[j] + sigm(g[m][n][j]) * acc[m][n][j]);
      }
  }
}

DEVI void phase_xattn(int tid_, const Params& p, char* smem) {
  const u16* Q = (const u16*)(p.ws + OFF_PR);
  u16* O = (u16*)(p.ws + OFF_NQ);
  const u16* KVK = (const u16*)(p.ws + OFF_KVK);
  const u16* KVT = (const u16*)(p.ws + OFF_KVT);
  const int lane = tid_ & 63, w = tid_ >> 6, fr = lane & 15, fq = lane >> 4;
  u16* Pw = (u16*)smem + w * (16 * 264);
  for (int t = blockIdx.x; t < (NTOK / 64) * 4; t += gridDim.x) {
    const int hh = t & 3;
    const size_t tok0 = (size_t)(t >> 2) * 64 + w * 16;
    const int s = (int)(tok0 >> 12);
    f32x4 acc[16];
#pragma unroll
    for (int n = 0; n < 16; ++n) acc[n] = (f32x4){0.f, 0.f, 0.f, 0.f};
#pragma unroll 2
    for (int ks = 0; ks < 8; ++ks) {
      bf16x8 aq = *(const bf16x8*)(Q + (tok0 + fr) * 1024 + hh * 256 + ks * 32 + fq * 8);
#pragma unroll
      for (int n = 0; n < 16; ++n) {
        bf16x8 bk = *(const bf16x8*)(KVK + (size_t)(s * 256 + n * 16 + fr) * 1024 + hh * 256 + ks * 32 + fq * 8);
        acc[n] = __builtin_amdgcn_mfma_f32_16x16x32_bf16(aq, bk, acc[n], 0, 0, 0);
      }
    }
    float sm[4];
#pragma unroll
    for (int j = 0; j < 4; ++j) {
      float m = -1e30f;
#pragma unroll
      for (int n = 0; n < 16; ++n) { acc[n][j] *= 0.0625f; m = fmaxf(m, acc[n][j]); }
      m = red16_max(m);
      float ssum = 0.f;
#pragma unroll
      for (int n = 0; n < 16; ++n) { const float e = __expf(acc[n][j] - m); acc[n][j] = e; ssum += e; }
      sm[j] = 1.f / red16_sum(ssum);
    }
    __syncthreads();
#pragma unroll
    for (int n = 0; n < 16; ++n)
#pragma unroll
      for (int j = 0; j < 4; ++j) Pw[(fq * 4 + j) * 264 + n * 16 + fr] = f2bf(acc[n][j]);
    __syncthreads();
#pragma unroll
    for (int n = 0; n < 16; ++n) acc[n] = (f32x4){0.f, 0.f, 0.f, 0.f};
#pragma unroll 2
    for (int ks = 0; ks < 8; ++ks) {
      bf16x8 ap = *(const bf16x8*)(Pw + fr * 264 + ks * 32 + fq * 8);
#pragma unroll
      for (int n = 0; n < 16; ++n) {
        bf16x8 bv = *(const bf16x8*)(KVT + (size_t)(s * 1024 + hh * 256 + n * 16 + fr) * 256 + ks * 32 + fq * 8);
        acc[n] = __builtin_amdgcn_mfma_f32_16x16x32_bf16(ap, bv, acc[n], 0, 0, 0);
      }
    }
#pragma unroll
    for (int n = 0; n < 16; ++n)
#pragma unroll
      for (int j = 0; j < 4; ++j)
        O[(tok0 + fq * 4 + j) * 1024 + hh * 256 + n * 16 + fr] = f2bf(acc[n][j] * sm[j]);
  }
}

DEVI void run_phase(int tid_, const Params& p, int ph, char* smem) {
  if (ph == 2 * NPH_LAYER) { phase_final_norm(tid_, p); return; }
  const int l = ph / NPH_LAYER, q = ph % NPH_LAYER;
  u16* WB = (u16*)(p.ws + OFF_WB);
  u16* H = (u16*)(p.ws + OFF_H);
  u16* PR = (u16*)(p.ws + OFF_PR);
  u16* NQ = (u16*)(p.ws + OFF_NQ);
  float* X = p.X;
  auto epi_res = [&](int r0, int c, f32x4 v) {
#pragma unroll
    for (int j = 0; j < 4; ++j) X[(size_t)(r0 + j) * 1024 + c] += v[j];
  };
  switch (q) {
    case 0:
      phase_conv(tid_, p, l, smem);
      phase_norm(tid_, p, p.in[I_NORM_MIX] + (size_t)l * 1024, l == 0);
      phase_norm_mem(tid_, p, p.in[I_NORM_MEM] + (size_t)l * 1024);
      break;
    case 1: phase_p_gemm(tid_, p, smem); break;
    case 2: phase_nat(tid_, p, l, smem); break;
    case 3: phase_scan(tid_, p, l, smem); break;
    case 4: phase_rwkv_post(tid_, p, l, smem); break;
    case 5: phase_merge(tid_, p, smem); break;
    case 6: gemm_phase(tid_, PR + 512, PRW, WB + W_OUT, 1024, 1024, NTOK, 1024, smem, epi_res); break;
    case 7: phase_norm(tid_, p, p.in[I_NORM_X] + (size_t)l * 1024, false); break;
    case 8:
      gemm_phase(tid_, H, 1024, WB + W_XQ, 1024, 1024, NTOK, 1024, smem, [&](int r0, int c, f32x4 v) {
#pragma unroll
        for (int j = 0; j < 4; ++j) PR[(size_t)(r0 + j) * 1024 + c] = f2bf(v[j]);
      });
      break;
    case 9: phase_xattn(tid_, p, smem); break;
    case 10: gemm_phase(tid_, NQ, 1024, WB + W_XO, 1024, 1024, NTOK, 1024, smem, epi_res); break;
    case 11: phase_norm(tid_, p, p.in[I_NORM_FF] + (size_t)l * 1024, false); break;
    case 12:
    case 14: {
      const int hf = (q == 14);
      gemm_phase(tid_, H, 1024, WB + W_FF1 + (size_t)hf * 2048 * 1024, 1024, 1024, NTOK, 2048, smem,
                 [&](int r0, int c, f32x4 v) {
#pragma unroll
                   for (int j = 0; j < 4; ++j) {
                     const float x = fmaxf(v[j], 0.f);
                     PR[(size_t)(r0 + j) * 2048 + c] = f2bf(x * x);
                   }
                 });
    } break;
    case 13:
    case 15: {
      const int hf = (q == 15);
      gemm_phase(tid_, PR, 2048, WB + W_FF2 + (size_t)hf * 2048, 4096, 2048, NTOK, 1024, smem, epi_res);
    } break;
  }
}

__global__ void __launch_bounds__(256, 2) mega_kernel(Params p, int ph0, int ph1) {
  __shared__ __attribute__((aligned(16))) char smem[SMEM_BYTES];
  for (int ph = ph0; ph < ph1; ++ph) {
    if (ph > ph0) cg::this_grid().sync();
    int tid_ = threadIdx.x;
    asm volatile("" : "+v"(tid_));
    run_phase(tid_, p, ph, smem);
  }
}

extern "C" void kernel_launch(void* const* d_in, const int* in_sizes, int n_in, void* d_out, int out_size, void* d_ws,
                              size_t ws_size, hipStream_t stream) {
  if (ws_size < WS_NEED || n_in < 31) return;
  Params p{};
  for (int i = 0; i < 31; ++i) p.in[i] = (const float*)d_in[i];
  p.X = (float*)d_out;
  p.ws = (char*)d_ws;
  static int grid_blocks = 0;
  if (!grid_blocks) {
    int dev = 0, cus = 0, per_cu = 0;
    hipGetDevice(&dev);
    hipDeviceGetAttribute(&cus, hipDeviceAttributeMultiprocessorCount, dev);
    hipOccupancyMaxActiveBlocksPerMultiprocessor(&per_cu, mega_kernel, 256, 0);
    if (per_cu > 2) per_cu = 2;
    if (per_cu < 1) per_cu = 1;
    grid_blocks = cus * per_cu;
  }
  int ph0 = 0, ph1 = NPHASES;
  void* args[] = {&p, &ph0, &ph1};
  hipLaunchCooperativeKernel((void*)mega_kernel, dim3(grid_blocks), dim3(256), args, 0, stream);
}
```

```cpp
#include <hip/hip_runtime.h>
#include <hip/hip_cooperative_groups.h>
#include <stdint.h>
namespace cg = cooperative_groups;

typedef unsigned short u16;
typedef __attribute__((ext_vector_type(8))) short bf16x8;
typedef __attribute__((ext_vector_type(4))) float f32x4;
typedef __attribute__((ext_vector_type(8))) _Float16 h16x8;
typedef __attribute__((ext_vector_type(4))) unsigned int u32x4;
typedef __attribute__((ext_vector_type(2))) unsigned int u32x2;

#define DEVI __device__ __forceinline__

constexpr int NTOK = 49152;
constexpr int SEQ_T = 4096;
constexpr int PRW = 1920;
constexpr int NPH_LAYER = 16;
constexpr int NPHASES = 2 * NPH_LAYER + 1;
constexpr int SMEM_BYTES = 78720;

constexpr size_t OFF_WB = 0;
constexpr size_t WB_BYTES = 20512768ull * 2;
constexpr size_t OFF_H = OFF_WB + WB_BYTES;
constexpr size_t OFF_PR = OFF_H + (size_t)NTOK * 1024 * 2;
constexpr size_t OFF_NQ = OFF_PR + (size_t)NTOK * PRW * 2;
constexpr size_t OFF_NK = OFF_NQ + (size_t)NTOK * 512 * 2;
constexpr size_t OFF_NV = OFF_NK + (size_t)NTOK * 512 * 2;
constexpr size_t OFF_KVK = OFF_NV + (size_t)NTOK * 512 * 2;
constexpr size_t OFF_KVT = OFF_KVK + (size_t)3072 * 1024 * 2;
constexpr size_t OFF_MEMH = OFF_KVT + (size_t)3072 * 1024 * 2;
constexpr size_t OFF_BONUS = OFF_MEMH + (size_t)3072 * 1024 * 2;
constexpr size_t WS_NEED = OFF_BONUS + (size_t)NTOK * 16 * 4;

constexpr size_t W_IN = 0;
constexpr size_t W_BRR = W_IN + (size_t)5504 * 1024;
constexpr size_t W_BRN = W_BRR + (size_t)1024 * 512;
constexpr size_t W_OUT = W_BRN + (size_t)1024 * 512;
constexpr size_t W_XQ = W_OUT + (size_t)1024 * 1024;
constexpr size_t W_XKV = W_XQ + (size_t)1024 * 1024;
constexpr size_t W_XO = W_XKV + (size_t)2048 * 1024;
constexpr size_t W_FF1 = W_XO + (size_t)1024 * 1024;
constexpr size_t W_FF2 = W_FF1 + (size_t)4096 * 1024;
constexpr size_t W_GUP = W_FF2 + (size_t)4096 * 1024;
constexpr size_t W_WUP = W_GUP + (size_t)512 * 128;
constexpr size_t W_AUP = W_WUP + (size_t)2 * 512 * 64;

enum { I_XP = 0, I_XS, I_MP, I_MS, I_NORM_MIX, I_W_IN, I_MU_PREV, I_MU_NEXT, I_W0, I_W_UP, I_A0, I_A_UP,
       I_G_UP, I_K_K, I_K_A, I_R_K, I_GN_G, I_GN_B, I_RPB, I_W_BR_RWKV, I_W_BR_NAT, I_W_OUT, I_NORM_X,
       I_NORM_MEM, I_W_XQ, I_W_XKV, I_W_XO, I_NORM_FF, I_W_FF1, I_W_FF2, I_NORM_FINAL };

struct Params {
  const float* in[31];
  float* X;
  char* ws;
};

DEVI u16 f2bf(float f) {
  uint32_t u = __float_as_uint(f);
  u += 0x7FFFu + ((u >> 16) & 1u);
  return (u16)(u >> 16);
}
DEVI float bf2f(u16 h) { return __uint_as_float(((uint32_t)h) << 16); }
DEVI uint32_t pack2(float a, float b) { return (uint32_t)f2bf(a) | ((uint32_t)f2bf(b) << 16); }
DEVI float sigm(float x) { return 1.f / (1.f + __expf(-x)); }
DEVI void unpack8(u32x4 u, float* o) {
  o[0] = __uint_as_float(u.x << 16); o[1] = __uint_as_float(u.x & 0xffff0000u);
  o[2] = __uint_as_float(u.y << 16); o[3] = __uint_as_float(u.y & 0xffff0000u);
  o[4] = __uint_as_float(u.z << 16); o[5] = __uint_as_float(u.z & 0xffff0000u);
  o[6] = __uint_as_float(u.w << 16); o[7] = __uint_as_float(u.w & 0xffff0000u);
}
DEVI void load8bf(const u16* p, float* o) { unpack8(*(const u32x4*)p, o); }
DEVI float wave_sum(float v) {
  v += __shfl_xor(v, 32); v += __shfl_xor(v, 16); v += __shfl_xor(v, 8);
  v += __shfl_xor(v, 4); v += __shfl_xor(v, 2); v += __shfl_xor(v, 1);
  return v;
}
DEVI float red16_sum(float v) {
  v += __shfl_xor(v, 1); v += __shfl_xor(v, 2); v += __shfl_xor(v, 4); v += __shfl_xor(v, 8);
  return v;
}
DEVI float red16_max(float v) {
  v = fmaxf(v, __shfl_xor(v, 1)); v = fmaxf(v, __shfl_xor(v, 2));
  v = fmaxf(v, __shfl_xor(v, 4)); v = fmaxf(v, __shfl_xor(v, 8));
  return v;
}

DEVI void conv_tile(int tid_, const float* src, int K, int N, u16* dst, int tile, char* smem) {
  float (*s)[65] = (float (*)[65])smem;
  const int nN = N >> 6;
  const int tk = tile / nN, tn = tile - tk * nN;
  const int tx = tid_ & 63, ty = tid_ >> 6;
  for (int r = ty; r < 64; r += 4) s[r][tx] = src[(size_t)(tk * 64 + r) * N + tn * 64 + tx];
  __syncthreads();
  for (int r = ty; r < 64; r += 4) dst[(size_t)(tn * 64 + r) * K + tk * 64 + tx] = f2bf(s[tx][r]);
  __syncthreads();
}

DEVI void phase_conv(int tid_, const Params& p, int l, char* smem) {
  u16* WB = (u16*)(p.ws + OFF_WB);
  const int c0 = 1376, c1 = c0 + 128, c2 = c1 + 128, c3 = c2 + 256, c4 = c3 + 256, c5 = c4 + 512,
            c6 = c5 + 256, c7 = c6 + 1024, c8 = c7 + 1024, c9 = c8 + 16, c10 = c9 + 16, c11 = c10 + 16;
  for (int t = blockIdx.x; t < c11; t += gridDim.x) {
    if (t < c0) conv_tile(tid_, p.in[I_W_IN] + (size_t)l * 1024 * 5504, 1024, 5504, WB + W_IN, t, smem);
    else if (t < c1) conv_tile(tid_, p.in[I_W_BR_RWKV] + (size_t)l * 512 * 1024, 512, 1024, WB + W_BRR, t - c0, smem);
    else if (t < c2) conv_tile(tid_, p.in[I_W_BR_NAT] + (size_t)l * 512 * 1024, 512, 1024, WB + W_BRN, t - c1, smem);
    else if (t < c3) conv_tile(tid_, p.in[I_W_OUT] + (size_t)l * 1024 * 1024, 1024, 1024, WB + W_OUT, t - c2, smem);
    else if (t < c4) conv_tile(tid_, p.in[I_W_XQ] + (size_t)l * 1024 * 1024, 1024, 1024, WB + W_XQ, t - c3, smem);
    else if (t < c5) conv_tile(tid_, p.in[I_W_XKV] + (size_t)l * 1024 * 2048, 1024, 2048, WB + W_XKV, t - c4, smem);
    else if (t < c6) conv_tile(tid_, p.in[I_W_XO] + (size_t)l * 1024 * 1024, 1024, 1024, WB + W_XO, t - c5, smem);
    else if (t < c7) conv_tile(tid_, p.in[I_W_FF1] + (size_t)l * 1024 * 4096, 1024, 4096, WB + W_FF1, t - c6, smem);
    else if (t < c8) conv_tile(tid_, p.in[I_W_FF2] + (size_t)l * 4096 * 1024, 4096, 1024, WB + W_FF2, t - c7, smem);
    else if (t < c9) conv_tile(tid_, p.in[I_G_UP] + (size_t)l * 128 * 512, 128, 512, WB + W_GUP, t - c8, smem);
    else if (t < c10) { const int dd = (t - c9) >> 3; conv_tile(tid_, p.in[I_W_UP] + (size_t)(l * 2 + dd) * 64 * 512, 64, 512, WB + W_WUP + (size_t)dd * 512 * 64, (t - c9) & 7, smem); }
    else { const int dd = (t - c10) >> 3; conv_tile(tid_, p.in[I_A_UP] + (size_t)(l * 2 + dd) * 64 * 512, 64, 512, WB + W_AUP + (size_t)dd * 512 * 64, (t - c10) & 7, smem); }
  }
}

DEVI void norm_row_bf16(int tid_, const float* src, const float* g, u16* dst, float* xcopy) {
  const int lane = tid_ & 63;
  float4 v[4];
  float ss = 0.f;
#pragma unroll
  for (int i = 0; i < 4; ++i) {
    v[i] = ((const float4*)src)[lane + i * 64];
    ss += v[i].x * v[i].x + v[i].y * v[i].y + v[i].z * v[i].z + v[i].w * v[i].w;
  }
  ss = wave_sum(ss);
  const float rs = rsqrtf(ss * (1.f / 1024.f) + 1e-6f);
#pragma unroll
  for (int i = 0; i < 4; ++i) {
    float4 gg = ((const float4*)g)[lane + i * 64];
    u32x2 o;
    o.x = pack2(v[i].x * rs * gg.x, v[i].y * rs * gg.y);
    o.y = pack2(v[i].z * rs * gg.z, v[i].w * rs * gg.w);
    ((u32x2*)dst)[lane + i * 64] = o;
    if (xcopy) ((float4*)xcopy)[lane + i * 64] = v[i];
  }
}

DEVI void phase_norm(int tid_, const Params& p, const float* g, bool from_input) {
  u16* H = (u16*)(p.ws + OFF_H);
  const int wid = tid_ >> 6;
  for (int r = blockIdx.x * 4 + wid; r < NTOK; r += gridDim.x * 4) {
    const float* src;
    if (from_input) src = (r < 32768) ? p.in[I_XP] + (size_t)r * 1024 : p.in[I_XS] + (size_t)(r - 32768) * 1024;
    else src = p.X + (size_t)r * 1024;
    norm_row_bf16(tid_, src, g, H + (size_t)r * 1024, from_input ? p.X + (size_t)r * 1024 : nullptr);
  }
}
DEVI void phase_norm_mem(int tid_, const Params& p, const float* g) {
  u16* MH = (u16*)(p.ws + OFF_MEMH);
  const int wid = tid_ >> 6;
  for (int r = blockIdx.x * 4 + wid; r < 3072; r += gridDim.x * 4) {
    const float* src = (r < 2048) ? p.in[I_MP] + (size_t)r * 1024 : p.in[I_MS] + (size_t)(r - 2048) * 1024;
    norm_row_bf16(tid_, src, g, MH + (size_t)r * 1024, nullptr);
  }
}
DEVI void phase_final_norm(int tid_, const Params& p) {
  const float* g = p.in[I_NORM_FINAL];
  const int wid = tid_ >> 6, lane = tid_ & 63;
  for (int r = blockIdx.x * 4 + wid; r < NTOK; r += gridDim.x * 4) {
    float* row = p.X + (size_t)r * 1024;
    float4 v[4];
    float ss = 0.f;
#pragma unroll
    for (int i = 0; i < 4; ++i) {
      v[i] = ((const float4*)row)[lane + i * 64];
      ss += v[i].x * v[i].x + v[i].y * v[i].y + v[i].z * v[i].z + v[i].w * v[i].w;
    }
    ss = wave_sum(ss);
    const float rs = rsqrtf(ss * (1.f / 1024.f) + 1e-6f);
#pragma unroll
    for (int i = 0; i < 4; ++i) {
      float4 gg = ((const float4*)g)[lane + i * 64];
      float4 o;
      o.x = v[i].x * rs * gg.x; o.y = v[i].y * rs * gg.y; o.z = v[i].z * rs * gg.z; o.w = v[i].w * rs * gg.w;
      ((float4*)row)[lane + i * 64] = o;
    }
  }
}

constexpr int LDSW = 72;

template <int NW>
DEVI void gemm_kloop(int tid_, f32x4 (&acc)[4][NW], const u16* __restrict__ A, int lda, const u16* __restrict__ Bt, int ldb,
                     int K, char* smem) {
  u16* sA = (u16*)smem;
  u16* sB = sA + 128 * LDSW;
  const int tid = tid_, lane = tid & 63, wid = tid >> 6;
  const int wr = wid >> 1, wc = wid & 1, fr = lane & 15, fq = lane >> 4;
  const int lrow = tid >> 3, lkc = tid & 7;
  u32x4 ra[4], rb[NW];
  const u16* ga = A + (size_t)lrow * lda + lkc * 8;
  const u16* gb = Bt + (size_t)lrow * ldb + lkc * 8;
#pragma unroll
  for (int i = 0; i < 4; ++i) ra[i] = *(const u32x4*)(ga + (size_t)(i * 32) * lda);
#pragma unroll
  for (int i = 0; i < NW; ++i) rb[i] = *(const u32x4*)(gb + (size_t)(i * 32) * ldb);
  for (int k0 = 0; k0 < K; k0 += 64) {
    __syncthreads();
#pragma unroll
    for (int i = 0; i < 4; ++i) *(u32x4*)(sA + (lrow + i * 32) * LDSW + lkc * 8) = ra[i];
#pragma unroll
    for (int i = 0; i < NW; ++i) *(u32x4*)(sB + (lrow + i * 32) * LDSW + lkc * 8) = rb[i];
    __syncthreads();
    if (k0 + 64 < K) {
#pragma unroll
      for (int i = 0; i < 4; ++i) ra[i] = *(const u32x4*)(ga + (size_t)(i * 32) * lda + k0 + 64);
#pragma unroll
      for (int i = 0; i < NW; ++i) rb[i] = *(const u32x4*)(gb + (size_t)(i * 32) * ldb + k0 + 64);
    }
#pragma unroll
    for (int ks = 0; ks < 2; ++ks) {
      bf16x8 af[4], bfr[NW];
#pragma unroll
      for (int m = 0; m < 4; ++m) af[m] = *(const bf16x8*)(sA + (wr * 64 + m * 16 + fr) * LDSW + ks * 32 + fq * 8);
#pragma unroll
      for (int n = 0; n < NW; ++n) bfr[n] = *(const bf16x8*)(sB + (wc * 16 * NW + n * 16 + fr) * LDSW + ks * 32 + fq * 8);
#pragma unroll
      for (int m = 0; m < 4; ++m)
#pragma unroll
        for (int n = 0; n < NW; ++n) acc[m][n] = __builtin_amdgcn_mfma_f32_16x16x32_bf16(af[m], bfr[n], acc[m][n], 0, 0, 0);
    }
  }
}

template <int NW>
DEVI void zero_acc(f32x4 (&acc)[4][NW]) {
#pragma unroll
  for (int m = 0; m < 4; ++m)
#pragma unroll
    for (int n = 0; n < NW; ++n) acc[m][n] = (f32x4){0.f, 0.f, 0.f, 0.f};
}

template <class Epi>
DEVI void gemm_phase(int tid_, const u16* A, int lda, const u16* Bt, int ldb, int K, int M, int N, char* smem, Epi epi) {
  const int nN = N >> 7, nM = M >> 7;
  const int lane = tid_ & 63, wid = tid_ >> 6;
  const int wr = wid >> 1, wc = wid & 1, fr = lane & 15, fq = lane >> 4;
  for (int t = blockIdx.x; t < nM * nN; t += gridDim.x) {
    const int tm = t / nN, tn = t - tm * nN;
    const int m0 = tm << 7, n0 = tn << 7;
    f32x4 acc[4][4];
    zero_acc(acc);
    gemm_kloop<4>(tid_, acc, A + (size_t)m0 * lda, lda, Bt + (size_t)n0 * ldb, ldb, K, smem);
#pragma unroll
    for (int m = 0; m < 4; ++m)
#pragma unroll
      for (int n = 0; n < 4; ++n) epi(m0 + wr * 64 + m * 16 + fq * 4, n0 + wc * 64 + n * 16 + fr, acc[m][n]);
  }
}

DEVI void phase_p_gemm(int tid_, const Params& p, char* smem) {
  u16* WB = (u16*)(p.ws + OFF_WB);
  const u16* H = (const u16*)(p.ws + OFF_H);
  u16* PR = (u16*)(p.ws + OFF_PR);
  u16* NQ = (u16*)(p.ws + OFF_NQ);
  u16* NK = (u16*)(p.ws + OFF_NK);
  u16* NVT = (u16*)(p.ws + OFF_NV);
  gemm_phase(tid_, H, 1024, WB + W_IN, 1024, 1024, NTOK, 3456, smem, [&](int r0, int c, f32x4 v) {
    if (c < 1920) {
#pragma unroll
      for (int j = 0; j < 4; ++j) PR[(size_t)(r0 + j) * PRW + c] = f2bf(v[j]);
    } else if (c < 2432) {
#pragma unroll
      for (int j = 0; j < 4; ++j) NQ[(size_t)(r0 + j) * 512 + (c - 1920)] = f2bf(v[j]);
    } else if (c < 2944) {
#pragma unroll
      for (int j = 0; j < 4; ++j) NK[(size_t)(r0 + j) * 512 + (c - 2432)] = f2bf(v[j]);
    } else {
      const int cc = c - 2944;
      const int s = r0 >> 12, t = r0 & 4095;
      u32x2 o;
      o.x = pack2(v[0], v[1]); o.y = pack2(v[2], v[3]);
      *(u32x2*)(NVT + ((size_t)(s * 512 + cc)) * 4096 + t) = o;
    }
  });
  const u16* MH = (const u16*)(p.ws + OFF_MEMH);
  u16* KVK = (u16*)(p.ws + OFF_KVK);
  u16* KVT = (u16*)(p.ws + OFF_KVT);
  gemm_phase(tid_, MH, 1024, WB + W_XKV, 1024, 1024, 3072, 2048, smem, [&](int r0, int c, f32x4 v) {
    if (c < 1024) {
#pragma unroll
      for (int j = 0; j < 4; ++j) KVK[(size_t)(r0 + j) * 1024 + c] = f2bf(v[j]);
    } else {
      const int cc = c - 1024;
      const int s = r0 >> 8, m = r0 & 255;
      u32x2 o;
      o.x = pack2(v[0], v[1]); o.y = pack2(v[2], v[3]);
      *(u32x2*)(KVT + ((size_t)(s * 1024 + cc)) * 256 + m) = o;
    }
  });
}

DEVI void phase_nat(int tid_, const Params& p, int l, char* smem) {
  u16* NQ = (u16*)(p.ws + OFF_NQ);
  const u16* NK = (const u16*)(p.ws + OFF_NK);
  const u16* NVT = (const u16*)(p.ws + OFF_NV);
  const float* rpb = p.in[I_RPB] + (size_t)l * 8 * 15 * 31;
  const int lane = tid_ & 63, g = tid_ >> 6, fr = lane & 15, fq = lane >> 4;
  u16* Pw = (u16*)smem + g * (16 * 264);
  const int cb = (g == 0) ? 0 : (g == 1) ? 8 : (g == 2) ? 24 : 32;
  for (int t = blockIdx.x; t < 12 * 64 * 8; t += gridDim.x) {
    const int h = t & 7, ri = (t >> 3) & 63, s = t >> 9;
    int rs = ri - 4; rs = rs < 0 ? 0 : (rs > 56 ? 56 : rs);
    const size_t tokq = (size_t)s * 4096 + ri * 64 + g * 16;
    bf16x8 aq[2];
    aq[0] = *(const bf16x8*)(NQ + (tokq + fr) * 512 + h * 64 + fq * 8);
    aq[1] = *(const bf16x8*)(NQ + (tokq + fr) * 512 + h * 64 + 32 + fq * 8);
    f32x4 acc[16];
#pragma unroll
    for (int n = 0; n < 16; ++n) {
      acc[n] = (f32x4){0.f, 0.f, 0.f, 0.f};
      const int r = n >> 1, col = cb + (n & 1) * 16 + fr;
      const u16* kp = NK + ((size_t)s * 4096 + (rs + r) * 64 + col) * 512 + h * 64 + fq * 8;
      bf16x8 b0 = *(const bf16x8*)kp;
      bf16x8 b1 = *(const bf16x8*)(kp + 32);
      acc[n] = __builtin_amdgcn_mfma_f32_16x16x32_bf16(aq[0], b0, acc[n], 0, 0, 0);
      acc[n] = __builtin_amdgcn_mfma_f32_16x16x32_bf16(aq[1], b1, acc[n], 0, 0, 0);
    }
    float mx[4], sm[4];
#pragma unroll
    for (int j = 0; j < 4; ++j) {
      const int c = g * 16 + fq * 4 + j;
      int cs = c - 8; cs = cs < 0 ? 0 : (cs > 48 ? 48 : cs);
      float m = -1e30f;
#pragma unroll
      for (int n = 0; n < 16; ++n) {
        const int r = n >> 1, kc = cb + (n & 1) * 16 + fr;
        const bool valid = (kc >= cs) && (kc < cs + 16);
        float sc = -1e30f;
        if (valid) {
          const int di = rs + r - ri + 7, dj = kc - c + 15;
          sc = acc[n][j] * 0.125f + rpb[(h * 15 + di) * 31 + dj];
        }
        acc[n][j] = sc;
        m = fmaxf(m, sc);
      }
      mx[j] = red16_max(m);
    }
#pragma unroll
    for (int j = 0; j < 4; ++j) {
      float ssum = 0.f;
#pragma unroll
      for (int n = 0; n < 16; ++n) {
        float e = __expf(acc[n][j] - mx[j]);
        acc[n][j] = e;
        ssum += e;
      }
      sm[j] = 1.f / red16_sum(ssum);
    }
    __syncthreads();
#pragma unroll
    for (int n = 0; n < 16; ++n)
#pragma unroll
      for (int j = 0; j < 4; ++j) Pw[(fq * 4 + j) * 264 + n * 16 + fr] = f2bf(acc[n][j]);
    __syncthreads();
    f32x4 o[4];
#pragma unroll
    for (int n = 0; n < 4; ++n) o[n] = (f32x4){0.f, 0.f, 0.f, 0.f};
#pragma unroll
    for (int ks = 0; ks < 8; ++ks) {
      bf16x8 ap = *(const bf16x8*)(Pw + fr * 264 + ks * 32 + fq * 8);
#pragma unroll
      for (int n = 0; n < 4; ++n) {
        bf16x8 bv = *(const bf16x8*)(NVT + ((size_t)(s * 512 + h * 64 + n * 16 + fr)) * 4096 + (rs + ks) * 64 + cb + fq * 8);
        o[n] = __builtin_amdgcn_mfma_f32_16x16x32_bf16(ap, bv, o[n], 0, 0, 0);
      }
    }
#pragma unroll
    for (int n = 0; n < 4; ++n)
#pragma unroll
      for (int j = 0; j < 4; ++j)
        NQ[(tokq + fq * 4 + j) * 512 + h * 64 + n * 16 + fr] = f2bf(o[n][j] * sm[j]);
  }
}

constexpr int SC_OPS = 0;
constexpr int SC_VV = 40960;
constexpr int SC_WR = 49152;
constexpr int SC_AP = 57344;
constexpr int SC_TW = 65536;
constexpr int SC_AD = 70144;
constexpr int SC_NRM = 74752;
constexpr int SC_MU = 74880;
constexpr int SC_CST = 77440;

typedef __attribute__((ext_vector_type(2))) float f32x2;

template <int CTRL>
DEVI float dpp_mov(float x) {
  return __int_as_float(__builtin_amdgcn_update_dpp(0, __float_as_int(x), CTRL, 0xF, 0xF, true));
}
DEVI float red8(float x) {
  x += dpp_mov<0xB1>(x);
  x += dpp_mov<0x4E>(x);
  x += dpp_mov<0x141>(x);
  return x;
}
DEVI f32x2 lo2(f32x4 v) { return __builtin_shufflevector(v, v, 0, 1); }
DEVI f32x2 hi2(f32x4 v) { return __builtin_shufflevector(v, v, 2, 3); }

struct ScanOps {
  f32x2 a[4], w[4], b[4], k[4], r[4];
  float v0, v1;
};
DEVI void scan_load(ScanOps& o, const float* OPS, const float* VV, int nn, int jg, int i0) {
  const float* base = OPS + nn * 64 + jg * 8;
  f32x4 t0, t1;
  t0 = *(const f32x4*)(base); t1 = *(const f32x4*)(base + 4);
  o.a[0] = lo2(t0); o.a[1] = hi2(t0); o.a[2] = lo2(t1); o.a[3] = hi2(t1);
  t0 = *(const f32x4*)(base + 2048); t1 = *(const f32x4*)(base + 2048 + 4);
  o.w[0] = lo2(t0); o.w[1] = hi2(t0); o.w[2] = lo2(t1); o.w[3] = hi2(t1);
  t0 = *(const f32x4*)(base + 4096); t1 = *(const f32x4*)(base + 4096 + 4);
  o.b[0] = lo2(t0); o.b[1] = hi2(t0); o.b[2] = lo2(t1); o.b[3] = hi2(t1);
  t0 = *(const f32x4*)(base + 6144); t1 = *(const f32x4*)(base + 6144 + 4);
  o.k[0] = lo2(t0); o.k[1] = hi2(t0); o.k[2] = lo2(t1); o.k[3] = hi2(t1);
  t0 = *(const f32x4*)(base + 8192); t1 = *(const f32x4*)(base + 8192 + 4);
  o.r[0] = lo2(t0); o.r[1] = hi2(t0); o.r[2] = lo2(t1); o.r[3] = hi2(t1);
  o.v0 = VV[nn * 64 + i0];
  o.v1 = VV[nn * 64 + i0 + 8];
}
DEVI void scan_step(const ScanOps& o, f32x2 (&S0)[4], f32x2 (&S1)[4], float* YL, int nn, int jg, int i0) {
  f32x2 d0 = S0[0] * o.a[0], d0b = S0[2] * o.a[2];
  f32x2 d1 = S1[0] * o.a[0], d1b = S1[2] * o.a[2];
  d0 = S0[1] * o.a[1] + d0; d0b = S0[3] * o.a[3] + d0b;
  d1 = S1[1] * o.a[1] + d1; d1b = S1[3] * o.a[3] + d1b;
  d0 += d0b; d1 += d1b;
  const float sa0 = red8(d0.x + d0.y);
  const float sa1 = red8(d1.x + d1.y);
  f32x2 e0 = {0.f, 0.f}, e1 = {0.f, 0.f};
#pragma unroll
  for (int q = 0; q < 4; ++q) {
    const f32x2 u0 = sa0 * o.b[q] + o.v0 * o.k[q];
    const f32x2 u1 = sa1 * o.b[q] + o.v1 * o.k[q];
    S0[q] = S0[q] * o.w[q] + u0;
    S1[q] = S1[q] * o.w[q] + u1;
    e0 = S0[q] * o.r[q] + e0;
    e1 = S1[q] * o.r[q] + e1;
  }
  const float y0 = red8(e0.x + e0.y);
  const float y1 = red8(e1.x + e1.y);
  if (jg == 0) { YL[nn * 64 + i0] = y0; YL[nn * 64 + i0 + 8] = y1; }
}

DEVI void phase_scan(int tid_, const Params& p, int l, char* smem) {
  const u16* PR = (const u16*)(p.ws + OFF_PR);
  _Float16* YF = (_Float16*)(p.ws + OFF_NK);
  _Float16* YB = (_Float16*)(p.ws + OFF_NV);
  float* BON = (float*)(p.ws + OFF_BONUS);
  const u16* WB = (const u16*)(p.ws + OFF_WB);
  float* OPS = (float*)(smem + SC_OPS);
  u16* RAW = (u16*)(smem + SC_OPS);
  float* VV = (float*)(smem + SC_VV);
  float* WR = (float*)(smem + SC_WR);
  float* AP = (float*)(smem + SC_AP);
  float* YL = WR;
  u16* TWb = (u16*)(smem + SC_TW);
  u16* ADb = (u16*)(smem + SC_AD);
  float* NRM = (float*)(smem + SC_NRM);
  float* MU = (float*)(smem + SC_MU);
  float* CST = (float*)(smem + SC_CST);
  const float* mu_p = p.in[I_MU_PREV] + (size_t)l * 1920;
  const float* mu_n = p.in[I_MU_NEXT] + (size_t)l * 1920;
  const int tid = tid_, lane = tid & 63, w = tid >> 6, fr = lane & 15, fq = lane >> 4;
  const int pn = tid >> 3, j0 = (tid & 7) * 8;
  const int jg = lane & 7, i0 = w * 16 + (lane >> 3);
  const int hr = (tid >= 40) ? 1 : 0, hc = tid - hr * 40;
  for (int blk = blockIdx.x; blk < 192; blk += gridDim.x) {
    const int s = blk >> 4, h = (blk >> 1) & 7, d = blk & 1;
    __syncthreads();
    for (int i = tid; i < 640; i += 256) {
      const int which = (i >= 320) ? 1 : 0, c = i - which * 320;
      const int g = c >> 6, e = c & 63;
      const int col = (g < 3) ? (g * 512 + h * 64 + e) : (1536 + (g - 3) * 128 + d * 64 + e);
      MU[i] = which ? mu_n[col] : mu_p[col];
    }
    for (int i = tid; i < 320; i += 256) {
      const int which = i >> 6, e = i & 63;
      float v;
      if (which == 0) v = p.in[I_W0][(size_t)(l * 2 + d) * 512 + h * 64 + e];
      else if (which == 1) v = p.in[I_A0][(size_t)(l * 2 + d) * 512 + h * 64 + e];
      else if (which == 2) v = p.in[I_K_K][(size_t)l * 512 + h * 64 + e];
      else if (which == 3) v = p.in[I_K_A][(size_t)l * 512 + h * 64 + e];
      else v = p.in[I_R_K][(size_t)(l * 8 + h) * 64 + e];
      CST[i] = v;
    }
    bf16x8 bw[2], ba[2];
#pragma unroll
    for (int ks = 0; ks < 2; ++ks) {
      bw[ks] = *(const bf16x8*)(WB + W_WUP + (size_t)(d * 512 + h * 64 + w * 16 + fr) * 64 + ks * 32 + fq * 8);
      ba[ks] = *(const bf16x8*)(WB + W_AUP + (size_t)(d * 512 + h * 64 + w * 16 + fr) * 64 + ks * 32 + fq * 8);
    }
    _Float16* Y = d ? YB : YF;
    f32x2 S0[4], S1[4];
#pragma unroll
    for (int q = 0; q < 4; ++q) { S0[q] = (f32x2){0.f, 0.f}; S1[q] = (f32x2){0.f, 0.f}; }
    u32x4 G[5], GH;
    {
      const int t = d ? (4095 - pn) : pn;
      const size_t tok = (size_t)s * 4096 + t;
#pragma unroll
      for (int g = 0; g < 5; ++g) {
        const int col = (g < 3) ? (g * 512 + h * 64) : (1536 + (g - 3) * 128 + d * 64);
        G[g] = *(const u32x4*)(PR + tok * PRW + col + j0);
      }
      GH = (u32x4){0u, 0u, 0u, 0u};
      if (tid < 80) {
        const int tlo = d ? (4095 - 31) : 0;
        const int th = hr ? (tlo + 32) : (tlo - 1);
        const int g = hc >> 3;
        const int col = (g < 3) ? (g * 512 + h * 64) : (1536 + (g - 3) * 128 + d * 64);
        if (th >= 0 && th <= 4095) GH = *(const u32x4*)(PR + ((size_t)s * 4096 + th) * PRW + col + (hc & 7) * 8);
      }
    }
#pragma unroll 1
    for (int ch = 0; ch < 128; ++ch) {
      const int n = ch * 32 + pn;
      const int t = d ? (4095 - n) : n;
      const size_t tok = (size_t)s * 4096 + t;
      const int tlo = d ? (4095 - (ch * 32 + 31)) : (ch * 32);
      const int rrow = t - tlo + 1;
#pragma unroll
      for (int g = 0; g < 5; ++g) *(u32x4*)(RAW + rrow * 320 + g * 64 + j0) = G[g];
      if (tid < 80) *(u32x4*)(RAW + (hr ? 33 : 0) * 320 + (hc >> 3) * 64 + (hc & 7) * 8) = GH;
      __syncthreads();
      if (ch + 1 < 128) {
        const int n2 = n + 32;
        const int t2 = d ? (4095 - n2) : n2;
        const size_t tok2 = (size_t)s * 4096 + t2;
#pragma unroll
        for (int g = 0; g < 5; ++g) {
          const int col = (g < 3) ? (g * 512 + h * 64) : (1536 + (g - 3) * 128 + d * 64);
          G[g] = *(const u32x4*)(PR + tok2 * PRW + col + j0);
        }
        GH = (u32x4){0u, 0u, 0u, 0u};
        if (tid < 80) {
          const int tlo2 = d ? (tlo - 32) : (tlo + 32);
          const int th = hr ? (tlo2 + 32) : (tlo2 - 1);
          const int g = hc >> 3;
          const int col = (g < 3) ? (g * 512 + h * 64) : (1536 + (g - 3) * 128 + d * 64);
          if (th >= 0 && th <= 4095) GH = *(const u32x4*)(PR + ((size_t)s * 4096 + th) * PRW + col + (hc & 7) * 8);
        }
      }
#pragma unroll
      for (int g = 0; g < 5; ++g) {
        float cur[8], prv[8], nxt[8];
        load8bf(RAW + rrow * 320 + g * 64 + j0, cur);
        load8bf(RAW + (rrow - 1) * 320 + g * 64 + j0, prv);
        load8bf(RAW + (rrow + 1) * 320 + g * 64 + j0, nxt);
        const f32x4 mp0 = *(const f32x4*)(MU + g * 64 + j0), mp1 = *(const f32x4*)(MU + g * 64 + j0 + 4);
        const f32x4 mn0 = *(const f32x4*)(MU + 320 + g * 64 + j0), mn1 = *(const f32x4*)(MU + 320 + g * 64 + j0 + 4);
        f32x4 x0, x1;
#pragma unroll
        for (int e = 0; e < 4; ++e) {
          x0[e] = cur[e] + mp0[e] * (prv[e] - cur[e]) + mn0[e] * (nxt[e] - cur[e]);
          x1[e] = cur[4 + e] + mp1[e] * (prv[4 + e] - cur[4 + e]) + mn1[e] * (nxt[4 + e] - cur[4 + e]);
        }
        if (g == 0) {
          *(f32x4*)(OPS + 4 * 2048 + pn * 64 + j0) = x0; *(f32x4*)(OPS + 4 * 2048 + pn * 64 + j0 + 4) = x1;
        } else if (g == 1) {
          *(f32x4*)(OPS + 3 * 2048 + pn * 64 + j0) = x0; *(f32x4*)(OPS + 3 * 2048 + pn * 64 + j0 + 4) = x1;
          const f32x4 kk0 = *(const f32x4*)(CST + 128 + j0), kk1 = *(const f32x4*)(CST + 128 + j0 + 4);
          float ss = 0.f;
#pragma unroll
          for (int e = 0; e < 4; ++e) { const float a_ = x0[e] * kk0[e], b_ = x1[e] * kk1[e]; ss += a_ * a_ + b_ * b_; }
          ss = red8(ss);
          if ((tid & 7) == 0) NRM[pn] = 1.f / fmaxf(sqrtf(ss), 1e-12f);
        } else if (g == 2) {
          *(f32x4*)(VV + pn * 64 + j0) = x0; *(f32x4*)(VV + pn * 64 + j0 + 4) = x1;
        } else if (g == 3) {
          u32x4 pk;
          pk.x = pack2(tanhf(x0[0]), tanhf(x0[1])); pk.y = pack2(tanhf(x0[2]), tanhf(x0[3]));
          pk.z = pack2(tanhf(x1[0]), tanhf(x1[1])); pk.w = pack2(tanhf(x1[2]), tanhf(x1[3]));
          *(u32x4*)(TWb + pn * 72 + j0) = pk;
        } else {
          u32x4 pk;
          pk.x = pack2(x0[0], x0[1]); pk.y = pack2(x0[2], x0[3]);
          pk.z = pack2(x1[0], x1[1]); pk.w = pack2(x1[2], x1[3]);
          *(u32x4*)(ADb + pn * 72 + j0) = pk;
        }
      }
      __syncthreads();
#pragma unroll
      for (int m = 0; m < 2; ++m) {
        f32x4 cw = {0.f, 0.f, 0.f, 0.f}, ca = {0.f, 0.f, 0.f, 0.f};
#pragma unroll
        for (int ks = 0; ks < 2; ++ks) {
          const bf16x8 aw = *(const bf16x8*)(TWb + (m * 16 + fr) * 72 + ks * 32 + fq * 8);
          const bf16x8 aa = *(const bf16x8*)(ADb + (m * 16 + fr) * 72 + ks * 32 + fq * 8);
          cw = __builtin_amdgcn_mfma_f32_16x16x32_bf16(aw, bw[ks], cw, 0, 0, 0);
          ca = __builtin_amdgcn_mfma_f32_16x16x32_bf16(aa, ba[ks], ca, 0, 0, 0);
        }
#pragma unroll
        for (int jj = 0; jj < 4; ++jj) {
          WR[(m * 16 + fq * 4 + jj) * 64 + w * 16 + fr] = cw[jj];
          AP[(m * 16 + fq * 4 + jj) * 64 + w * 16 + fr] = ca[jj];
        }
      }
      __syncthreads();
      {
        const float inv = NRM[pn];
        float bsum = 0.f;
#pragma unroll
        for (int hq = 0; hq < 2; ++hq) {
          const int jb = j0 + hq * 4;
          const f32x4 wr_ = *(const f32x4*)(WR + pn * 64 + jb) + *(const f32x4*)(CST + jb);
          const f32x4 ap_ = *(const f32x4*)(AP + pn * 64 + jb) + *(const f32x4*)(CST + 64 + jb);
          const f32x4 kr = *(const f32x4*)(OPS + 3 * 2048 + pn * 64 + jb);
          const f32x4 rr = *(const f32x4*)(OPS + 4 * 2048 + pn * 64 + jb);
          const f32x4 kkw = *(const f32x4*)(CST + 128 + jb), kaw = *(const f32x4*)(CST + 192 + jb), rkw = *(const f32x4*)(CST + 256 + jb);
          f32x4 o0, o1, o2, o3;
#pragma unroll
          for (int e = 0; e < 4; ++e) {
            const float sw = 1.f / (1.f + expf(-wr_[e]));
            const float dec = expf(-0.6065306597126334f * sw);
            const float av = 1.f / (1.f + expf(-ap_[e]));
            const float kn = kr[e] * kkw[e] * inv;
            const float kd = kr[e] * (1.f + (av - 1.f) * kaw[e]);
            bsum += rr[e] * kd * rkw[e];
            o0[e] = -kn; o1[e] = dec; o2[e] = kn * av; o3[e] = kd;
          }
          *(f32x4*)(OPS + 0 * 2048 + pn * 64 + jb) = o0;
          *(f32x4*)(OPS + 1 * 2048 + pn * 64 + jb) = o1;
          *(f32x4*)(OPS + 2 * 2048 + pn * 64 + jb) = o2;
          *(f32x4*)(OPS + 3 * 2048 + pn * 64 + jb) = o3;
        }
        bsum = red8(bsum);
        if ((tid & 7) == 0) BON[(tok * 8 + h) * 2 + d] = bsum;
      }
      __syncthreads();
      {
        ScanOps oa, ob;
        scan_load(oa, OPS, VV, 0, jg, i0);
#pragma unroll 1
        for (int nn = 0; nn < 32; nn += 2) {
          scan_load(ob, OPS, VV, nn + 1, jg, i0);
          scan_step(oa, S0, S1, YL, nn, jg, i0);
          scan_load(oa, OPS, VV, (nn + 2) & 31, jg, i0);
          scan_step(ob, S0, S1, YL, nn + 1, jg, i0);
        }
      }
      __syncthreads();
      {
        h16x8 o;
#pragma unroll
        for (int e = 0; e < 8; ++e) o[e] = (_Float16)YL[pn * 64 + j0 + e];
        *(h16x8*)(Y + tok * 512 + h * 64 + j0) = o;
      }
    }
    __syncthreads();
  }
}

DEVI void phase_rwkv_post(int tid_, const Params& p, int l, char* smem) {
  u16* PR = (u16*)(p.ws + OFF_PR);
  const _Float16* YF = (const _Float16*)(p.ws + OFF_NK);
  const _Float16* YB = (const _Float16*)(p.ws + OFF_NV);
  const float* BON = (const float*)(p.ws + OFF_BONUS);
  const u16* GUPT = (const u16*)(p.ws + OFF_WB) + W_GUP;
  const float* mu_p = p.in[I_MU_PREV] + (size_t)l * 1920;
  const float* mu_n = p.in[I_MU_NEXT] + (size_t)l * 1920;
  const float* gng = p.in[I_GN_G] + (size_t)l * 512;
  const float* gnb = p.in[I_GN_B] + (size_t)l * 512;
  u16* As = (u16*)smem;
  const int tid = tid_, lane = tid & 63, w = tid >> 6, fr = lane & 15, fq = lane >> 4;
  for (int tile = blockIdx.x; tile < NTOK / 64; tile += gridDim.x) {
    const size_t tok0 = (size_t)tile * 64;
    {
      const int row = tid >> 2, part = tid & 3;
      const size_t tok = tok0 + row;
      const int t = (int)(tok & 4095);
#pragma unroll
      for (int q = 0; q < 4; ++q) {
        const int col = 1792 + part * 32 + q * 8;
        float cur[8], prv[8], nxt[8];
        load8bf(PR + tok * PRW + col, cur);
        if (t > 0) load8bf(PR + (tok - 1) * PRW + col, prv);
        else {
#pragma unroll
          for (int e = 0; e < 8; ++e) prv[e] = 0.f;
        }
        if (t < 4095) load8bf(PR + (tok + 1) * PRW + col, nxt);
        else {
#pragma unroll
          for (int e = 0; e < 8; ++e) nxt[e] = 0.f;
        }
        float o[8];
#pragma unroll
        for (int e = 0; e < 8; ++e) {
          const float x = cur[e] + mu_p[col + e] * (prv[e] - cur[e]) + mu_n[col + e] * (nxt[e] - cur[e]);
          o[e] = sigm(x);
        }
        u32x4 pk;
        pk.x = pack2(o[0], o[1]); pk.y = pack2(o[2], o[3]); pk.z = pack2(o[4], o[5]); pk.w = pack2(o[6], o[7]);
        *(u32x4*)(As + row * 136 + part * 32 + q * 8) = pk;
      }
    }
    __syncthreads();
#pragma unroll 1
    for (int chh = 0; chh < 2; ++chh) {
      f32x4 acc[16];
#pragma unroll
      for (int n = 0; n < 16; ++n) acc[n] = (f32x4){0.f, 0.f, 0.f, 0.f};
#pragma unroll
      for (int ks = 0; ks < 4; ++ks) {
        bf16x8 af = *(const bf16x8*)(As + (w * 16 + fr) * 136 + ks * 32 + fq * 8);
#pragma unroll
        for (int n = 0; n < 16; ++n) {
          bf16x8 bg = *(const bf16x8*)(GUPT + (size_t)(chh * 256 + n * 16 + fr) * 128 + ks * 32 + fq * 8);
          acc[n] = __builtin_amdgcn_mfma_f32_16x16x32_bf16(af, bg, acc[n], 0, 0, 0);
        }
      }
#pragma unroll
      for (int hl = 0; hl < 4; ++hl) {
        const int head = chh * 4 + hl;
#pragma unroll
        for (int j = 0; j < 4; ++j) {
          const size_t tok = tok0 + w * 16 + fq * 4 + j;
          const int t = (int)(tok & 4095);
          float o[4], sum = 0.f;
#pragma unroll
          for (int q = 0; q < 4; ++q) {
            const int col = head * 64 + q * 16 + fr;
            o[q] = (float)YF[tok * 512 + col] + (float)YB[tok * 512 + col];
            sum += o[q];
          }
          const float mean = red16_sum(sum) * (1.f / 64.f);
          float vs = 0.f;
#pragma unroll
          for (int q = 0; q < 4; ++q) { const float dlt = o[q] - mean; vs += dlt * dlt; }
          const float var = red16_sum(vs) * (1.f / 64.f);
          const float rstd = rsqrtf(var + 64e-5f);
          const float bon = BON[(tok * 8 + head) * 2] + BON[(tok * 8 + head) * 2 + 1];
#pragma unroll
          for (int q = 0; q < 4; ++q) {
            const int col = head * 64 + q * 16 + fr;
            const int vc = 1024 + col;
            const float cur = bf2f(PR[tok * PRW + vc]);
            const float prv = (t > 0) ? bf2f(PR[(tok - 1) * PRW + vc]) : 0.f;
            const float nxt = (t < 4095) ? bf2f(PR[(tok + 1) * PRW + vc]) : 0.f;
            const float vsh = cur + mu_p[vc] * (prv - cur) + mu_n[vc] * (nxt - cur);
            const float yv = ((o[q] - mean) * rstd * gng[col] + gnb[col] + bon * vsh) * acc[hl * 4 + q][j];
            PR[tok * PRW + col] = f2bf(yv);
          }
        }
      }
    }
    __syncthreads();
  }
}

DEVI void phase_merge(int tid_, const Params& p, char* smem) {
  const u16* WB = (const u16*)(p.ws + OFF_WB);
  const u16* H = (const u16*)(p.ws + OFF_H);
  u16* PR = (u16*)(p.ws + OFF_PR);
  const u16* NQ = (const u16*)(p.ws + OFF_NQ);
  const int lane = tid_ & 63, wid = tid_ >> 6;
  const int wr = wid >> 1, wc = wid & 1, fr = lane & 15, fq = lane >> 4;
  for (int t = blockIdx.x; t < 384 * 16; t += gridDim.x) {
    const int tm = t >> 4, tn = t & 15;
    const int m0 = tm << 7, n0 = tn << 6;
    f32x4 g[4][2], acc[4][2];
    uint32_t mp[4][2][2];
    zero_acc(g);
    gemm_kloop<2>(tid_, g, H + (size_t)m0 * 1024, 1024, WB + W_IN + (size_t)(3456 + n0) * 1024, 1024, 1024, smem);
    zero_acc(acc);
    gemm_kloop<2>(tid_, acc, PR + (size_t)m0 * PRW, PRW, WB + W_BRR + (size_t)n0 * 512, 512, 512, smem);
#pragma unroll
    for (int m = 0; m < 4; ++m)
#pragma unroll
      for (int n = 0; n < 2; ++n) {
        mp[m][n][0] = pack2(sigm(g[m][n][0]) * acc[m][n][0], sigm(g[m][n][1]) * acc[m][n][1]);
        mp[m][n][1] = pack2(sigm(g[m][n][2]) * acc[m][n][2], sigm(g[m][n][3]) * acc[m][n][3]);
      }
    zero_acc(g);
    gemm_kloop<2>(tid_, g, H + (size_t)m0 * 1024, 1024, WB + W_IN + (size_t)(4480 + n0) * 1024, 1024, 1024, smem);
    zero_acc(acc);
    gemm_kloop<2>(tid_, acc, NQ + (size_t)m0 * 512, 512, WB + W_BRN + (size_t)n0 * 512, 512, 512, smem);
#pragma unroll
    for (int m = 0; m < 4; ++m)
#pragma unroll
      for (int n = 0; n < 2; ++n) {
        const int r0 = m0 + wr * 64 + m * 16 + fq * 4, c = n0 + wc * 32 + n * 16 + fr;
        float pv[4];
        pv[0] = __uint_as_float(mp[m][n][0] << 16); pv[1] = __uint_as_float(mp[m][n][0] & 0xffff0000u);
        pv[2] = __uint_as_float(mp[m][n][1] << 16); pv[3] = __uint_as_float(mp[m][n][1] & 0xffff0000u);
#pragma unroll
        for (int j = 0; j < 4; ++j)
          PR[(size_t)(r0 + j) * PRW + 512 + c] = f2bf(pv[j] + sigm(g[m][n][j]) * acc[m][n][j]);
      }
  }
}

DEVI void phase_xattn(int tid_, const Params& p, char* smem) {
  const u16* Q = (const u16*)(p.ws + OFF_PR);
  u16* O = (u16*)(p.ws + OFF_NQ);
  const u16* KVK = (const u16*)(p.ws + OFF_KVK);
  const u16* KVT = (const u16*)(p.ws + OFF_KVT);
  const int lane = tid_ & 63, w = tid_ >> 6, fr = lane & 15, fq = lane >> 4;
  u16* Pw = (u16*)smem + w * (16 * 264);
  for (int t = blockIdx.x; t < (NTOK / 64) * 4; t += gridDim.x) {
    const int hh = t & 3;
    const size_t tok0 = (size_t)(t >> 2) * 64 + w * 16;
    const int s = (int)(tok0 >> 12);
    f32x4 acc[16];
#pragma unroll
    for (int n = 0; n < 16; ++n) acc[n] = (f32x4){0.f, 0.f, 0.f, 0.f};
#pragma unroll 2
    for (int ks = 0; ks < 8; ++ks) {
      bf16x8 aq = *(const bf16x8*)(Q + (tok0 + fr) * 1024 + hh * 256 + ks * 32 + fq * 8);
#pragma unroll
      for (int n = 0; n < 16; ++n) {
        bf16x8 bk = *(const bf16x8*)(KVK + (size_t)(s * 256 + n * 16 + fr) * 1024 + hh * 256 + ks * 32 + fq * 8);
        acc[n] = __builtin_amdgcn_mfma_f32_16x16x32_bf16(aq, bk, acc[n], 0, 0, 0);
      }
    }
    float sm[4];
#pragma unroll
    for (int j = 0; j < 4; ++j) {
      float m = -1e30f;
#pragma unroll
      for (int n = 0; n < 16; ++n) { acc[n][j] *= 0.0625f; m = fmaxf(m, acc[n][j]); }
      m = red16_max(m);
      float ssum = 0.f;
#pragma unroll
      for (int n = 0; n < 16; ++n) { const float e = __expf(acc[n][j] - m); acc[n][j] = e; ssum += e; }
      sm[j] = 1.f / red16_sum(ssum);
    }
    __syncthreads();
#pragma unroll
    for (int n = 0; n < 16; ++n)
#pragma unroll
      for (int j = 0; j < 4; ++j) Pw[(fq * 4 + j) * 264 + n * 16 + fr] = f2bf(acc[n][j]);
    __syncthreads();
#pragma unroll
    for (int n = 0; n < 16; ++n) acc[n] = (f32x4){0.f, 0.f, 0.f, 0.f};
#pragma unroll 2
    for (int ks = 0; ks < 8; ++ks) {
      bf16x8 ap = *(const bf16x8*)(Pw + fr * 264 + ks * 32 + fq * 8);
#pragma unroll
      for (int n = 0; n < 16; ++n) {
        bf16x8 bv = *(const bf16x8*)(KVT + (size_t)(s * 1024 + hh * 256 + n * 16 + fr) * 256 + ks * 32 + fq * 8);
        acc[n] = __builtin_amdgcn_mfma_f32_16x16x32_bf16(ap, bv, acc[n], 0, 0, 0);
      }
    }
#pragma unroll
    for (int n = 0; n < 16; ++n)
#pragma unroll
      for (int j = 0; j < 4; ++j)
        O[(tok0 + fq * 4 + j) * 1024 + hh * 256 + n * 16 + fr] = f2bf(acc[n][j] * sm[j]);
  }
}

DEVI void run_phase(int tid_, const Params& p, int ph, char* smem) {
  if (ph == 2 * NPH_LAYER) { phase_final_norm(tid_, p); return; }
  const int l = ph / NPH_LAYER, q = ph % NPH_LAYER;
  u16* WB = (u16*)(p.ws + OFF_WB);
  u16* H = (u16*)(p.ws + OFF_H);
  u16* PR = (u16*)(p.ws + OFF_PR);
  u16* NQ = (u16*)(p.ws + OFF_NQ);
  float* X = p.X;
  auto epi_res = [&](int r0, int c, f32x4 v) {
#pragma unroll
    for (int j = 0; j < 4; ++j) X[(size_t)(r0 + j) * 1024 + c] += v[j];
  };
  switch (q) {
    case 0:
      phase_conv(tid_, p, l, smem);
      phase_norm(tid_, p, p.in[I_NORM_MIX] + (size_t)l * 1024, l == 0);
      phase_norm_mem(tid_, p, p.in[I_NORM_MEM] + (size_t)l * 1024);
      break;
    case 1: phase_p_gemm(tid_, p, smem); break;
    case 2: phase_nat(tid_, p, l, smem); break;
    case 3: phase_scan(tid_, p, l, smem); break;
    case 4: phase_rwkv_post(tid_, p, l, smem); break;
    case 5: phase_merge(tid_, p, smem); break;
    case 6: gemm_phase(tid_, PR + 512, PRW, WB + W_OUT, 1024, 1024, NTOK, 1024, smem, epi_res); break;
    case 7: phase_norm(tid_, p, p.in[I_NORM_X] + (size_t)l * 1024, false); break;
    case 8:
      gemm_phase(tid_, H, 1024, WB + W_XQ, 1024, 1024, NTOK, 1024, smem, [&](int r0, int c, f32x4 v) {
#pragma unroll
        for (int j = 0; j < 4; ++j) PR[(size_t)(r0 + j) * 1024 + c] = f2bf(v[j]);
      });
      break;
    case 9: phase_xattn(tid_, p, smem); break;
    case 10: gemm_phase(tid_, NQ, 1024, WB + W_XO, 1024, 1024, NTOK, 1024, smem, epi_res); break;
    case 11: phase_norm(tid_, p, p.in[I_NORM_FF] + (size_t)l * 1024, false); break;
    case 12:
    case 14: {
      const int hf = (q == 14);
      gemm_phase(tid_, H, 1024, WB + W_FF1 + (size_t)hf * 2048 * 1024, 1024, 1024, NTOK, 2048, smem,
                 [&](int r0, int c, f32x4 v) {
#pragma unroll
                   for (int j = 0; j < 4; ++j) {
                     const float x = fmaxf(v[j], 0.f);
                     PR[(size_t)(r0 + j) * 2048 + c] = f2bf(x * x);
                   }
                 });
    } break;
    case 13:
    case 15: {
      const int hf = (q == 15);
      gemm_phase(tid_, PR, 2048, WB + W_FF2 + (size_t)hf * 2048, 4096, 2048, NTOK, 1024, smem, epi_res);
    } break;
  }
}

__global__ void __launch_bounds__(256, 2) mega_kernel(Params p, int ph0, int ph1) {
  __shared__ __attribute__((aligned(16))) char smem[SMEM_BYTES];
  for (int ph = ph0; ph < ph1; ++ph) {
    if (ph > ph0) cg::this_grid().sync();
    int tid_ = threadIdx.x;
    asm volatile("" : "+v"(tid_));
    run_phase(tid_, p, ph, smem);
  }
}

extern "C" void kernel_launch(void* const* d_in, const int* in_sizes, int n_in, void* d_out, int out_size, void* d_ws,
                              size_t ws_size, hipStream_t stream) {
  if (ws_size < WS_NEED || n_in < 31) return;
  Params p{};
  for (int i = 0; i < 31; ++i) p.in[i] = (const float*)d_in[i];
  p.X = (float*)d_out;
  p.ws = (char*)d_ws;
  static int grid_blocks = 0;
  if (!grid_blocks) {
    int dev = 0, cus = 0, per_cu = 0;
    hipGetDevice(&dev);
    hipDeviceGetAttribute(&cus, hipDeviceAttributeMultiprocessorCount, dev);
    hipOccupancyMaxActiveBlocksPerMultiprocessor(&per_cu, mega_kernel, 256, 0);
    if (per_cu > 2) per_cu = 2;
    if (per_cu < 1) per_cu = 1;
    grid_blocks = cus * per_cu;
  }
  int ph0 = 0, ph1 = NPHASES;
  void* args[] = {&p, &ph0, &ph1};
  hipLaunchCooperativeKernel((void*)mega_kernel, dim3(grid_blocks), dim3(256), args, 0, stream);
}
```

```cpp
#include <hip/hip_runtime.h>
#include <hip/hip_cooperative_groups.h>
#include <stdint.h>
namespace cg = cooperative_groups;

typedef unsigned short u16;
typedef __attribute__((ext_vector_type(8))) short bf16x8;
typedef __attribute__((ext_vector_type(4))) float f32x4;
typedef __attribute__((ext_vector_type(8))) _Float16 h16x8;
typedef __attribute__((ext_vector_type(4))) unsigned int u32x4;
typedef __attribute__((ext_vector_type(2))) unsigned int u32x2;

#define DEVI __device__ __forceinline__

constexpr int NTOK = 49152;
constexpr int SEQ_T = 4096;
constexpr int PRW = 1920;
constexpr int NPH_LAYER = 16;
constexpr int NPHASES = 2 * NPH_LAYER + 1;
constexpr int SMEM_BYTES = 78720;

constexpr size_t OFF_WB = 0;
constexpr size_t WB_BYTES = 20512768ull * 2;
constexpr size_t OFF_H = OFF_WB + WB_BYTES;
constexpr size_t OFF_PR = OFF_H + (size_t)NTOK * 1024 * 2;
constexpr size_t OFF_NQ = OFF_PR + (size_t)NTOK * PRW * 2;
constexpr size_t OFF_NK = OFF_NQ + (size_t)NTOK * 512 * 2;
constexpr size_t OFF_NV = OFF_NK + (size_t)NTOK * 512 * 2;
constexpr size_t OFF_KVK = OFF_NV + (size_t)NTOK * 512 * 2;
constexpr size_t OFF_KVT = OFF_KVK + (size_t)3072 * 1024 * 2;
constexpr size_t OFF_MEMH = OFF_KVT + (size_t)3072 * 1024 * 2;
constexpr size_t OFF_BONUS = OFF_MEMH + (size_t)3072 * 1024 * 2;
constexpr size_t OFF_BAR = OFF_BONUS + (size_t)NTOK * 16 * 4;
constexpr size_t WS_NEED = OFF_BAR + 16384;

constexpr size_t W_IN = 0;
constexpr size_t W_BRR = W_IN + (size_t)5504 * 1024;
constexpr size_t W_BRN = W_BRR + (size_t)1024 * 512;
constexpr size_t W_OUT = W_BRN + (size_t)1024 * 512;
constexpr size_t W_XQ = W_OUT + (size_t)1024 * 1024;
constexpr size_t W_XKV = W_XQ + (size_t)1024 * 1024;
constexpr size_t W_XO = W_XKV + (size_t)2048 * 1024;
constexpr size_t W_FF1 = W_XO + (size_t)1024 * 1024;
constexpr size_t W_FF2 = W_FF1 + (size_t)4096 * 1024;
constexpr size_t W_GUP = W_FF2 + (size_t)4096 * 1024;
constexpr size_t W_WUP = W_GUP + (size_t)512 * 128;
constexpr size_t W_AUP = W_WUP + (size_t)2 * 512 * 64;

enum { I_XP = 0, I_XS, I_MP, I_MS, I_NORM_MIX, I_W_IN, I_MU_PREV, I_MU_NEXT, I_W0, I_W_UP, I_A0, I_A_UP,
       I_G_UP, I_K_K, I_K_A, I_R_K, I_GN_G, I_GN_B, I_RPB, I_W_BR_RWKV, I_W_BR_NAT, I_W_OUT, I_NORM_X,
       I_NORM_MEM, I_W_XQ, I_W_XKV, I_W_XO, I_NORM_FF, I_W_FF1, I_W_FF2, I_NORM_FINAL };

struct Params {
  const float* in[31];
  float* X;
  char* ws;
};

DEVI u16 f2bf(float f) {
  uint32_t u = __float_as_uint(f);
  u += 0x7FFFu + ((u >> 16) & 1u);
  return (u16)(u >> 16);
}
DEVI float bf2f(u16 h) { return __uint_as_float(((uint32_t)h) << 16); }
DEVI uint32_t pack2(float a, float b) { return (uint32_t)f2bf(a) | ((uint32_t)f2bf(b) << 16); }
DEVI float sigm(float x) { return 1.f / (1.f + __expf(-x)); }
DEVI void unpack8(u32x4 u, float* o) {
  o[0] = __uint_as_float(u.x << 16); o[1] = __uint_as_float(u.x & 0xffff0000u);
  o[2] = __uint_as_float(u.y << 16); o[3] = __uint_as_float(u.y & 0xffff0000u);
  o[4] = __uint_as_float(u.z << 16); o[5] = __uint_as_float(u.z & 0xffff0000u);
  o[6] = __uint_as_float(u.w << 16); o[7] = __uint_as_float(u.w & 0xffff0000u);
}
DEVI void load8bf(const u16* p, float* o) { unpack8(*(const u32x4*)p, o); }
DEVI float wave_sum(float v) {
  v += __shfl_xor(v, 32); v += __shfl_xor(v, 16); v += __shfl_xor(v, 8);
  v += __shfl_xor(v, 4); v += __shfl_xor(v, 2); v += __shfl_xor(v, 1);
  return v;
}
DEVI float red16_sum(float v) {
  v += __shfl_xor(v, 1); v += __shfl_xor(v, 2); v += __shfl_xor(v, 4); v += __shfl_xor(v, 8);
  return v;
}
DEVI float red16_max(float v) {
  v = fmaxf(v, __shfl_xor(v, 1)); v = fmaxf(v, __shfl_xor(v, 2));
  v = fmaxf(v, __shfl_xor(v, 4)); v = fmaxf(v, __shfl_xor(v, 8));
  return v;
}

DEVI void conv_tile(int tid_, const float* src, int K, int N, u16* dst, int tile, char* smem) {
  float (*s)[65] = (float (*)[65])smem;
  const int nN = N >> 6;
  const int tk = tile / nN, tn = tile - tk * nN;
  const int tx = tid_ & 63, ty = tid_ >> 6;
  for (int r = ty; r < 64; r += 4) s[r][tx] = src[(size_t)(tk * 64 + r) * N + tn * 64 + tx];
  __syncthreads();
  for (int r = ty; r < 64; r += 4) dst[(size_t)(tn * 64 + r) * K + tk * 64 + tx] = f2bf(s[tx][r]);
  __syncthreads();
}

DEVI void phase_conv(int tid_, const Params& p, int l, char* smem) {
  u16* WB = (u16*)(p.ws + OFF_WB);
  const int c0 = 1376, c1 = c0 + 128, c2 = c1 + 128, c3 = c2 + 256, c4 = c3 + 256, c5 = c4 + 512,
            c6 = c5 + 256, c7 = c6 + 1024, c8 = c7 + 1024, c9 = c8 + 16, c10 = c9 + 16, c11 = c10 + 16;
  for (int t = blockIdx.x; t < c11; t += gridDim.x) {
    if (t < c0) conv_tile(tid_, p.in[I_W_IN] + (size_t)l * 1024 * 5504, 1024, 5504, WB + W_IN, t, smem);
    else if (t < c1) conv_tile(tid_, p.in[I_W_BR_RWKV] + (size_t)l * 512 * 1024, 512, 1024, WB + W_BRR, t - c0, smem);
    else if (t < c2) conv_tile(tid_, p.in[I_W_BR_NAT] + (size_t)l * 512 * 1024, 512, 1024, WB + W_BRN, t - c1, smem);
    else if (t < c3) conv_tile(tid_, p.in[I_W_OUT] + (size_t)l * 1024 * 1024, 1024, 1024, WB + W_OUT, t - c2, smem);
    else if (t < c4) conv_tile(tid_, p.in[I_W_XQ] + (size_t)l * 1024 * 1024, 1024, 1024, WB + W_XQ, t - c3, smem);
    else if (t < c5) conv_tile(tid_, p.in[I_W_XKV] + (size_t)l * 1024 * 2048, 1024, 2048, WB + W_XKV, t - c4, smem);
    else if (t < c6) conv_tile(tid_, p.in[I_W_XO] + (size_t)l * 1024 * 1024, 1024, 1024, WB + W_XO, t - c5, smem);
    else if (t < c7) conv_tile(tid_, p.in[I_W_FF1] + (size_t)l * 1024 * 4096, 1024, 4096, WB + W_FF1, t - c6, smem);
    else if (t < c8) conv_tile(tid_, p.in[I_W_FF2] + (size_t)l * 4096 * 1024, 4096, 1024, WB + W_FF2, t - c7, smem);
    else if (t < c9) conv_tile(tid_, p.in[I_G_UP] + (size_t)l * 128 * 512, 128, 512, WB + W_GUP, t - c8, smem);
    else if (t < c10) { const int dd = (t - c9) >> 3; conv_tile(tid_, p.in[I_W_UP] + (size_t)(l * 2 + dd) * 64 * 512, 64, 512, WB + W_WUP + (size_t)dd * 512 * 64, (t - c9) & 7, smem); }
    else { const int dd = (t - c10) >> 3; conv_tile(tid_, p.in[I_A_UP] + (size_t)(l * 2 + dd) * 64 * 512, 64, 512, WB + W_AUP + (size_t)dd * 512 * 64, (t - c10) & 7, smem); }
  }
}

DEVI void norm_row_bf16(int tid_, const float* src, const float* g, u16* dst, float* xcopy) {
  const int lane = tid_ & 63;
  float4 v[4];
  float ss = 0.f;
#pragma unroll
  for (int i = 0; i < 4; ++i) {
    v[i] = ((const float4*)src)[lane + i * 64];
    ss += v[i].x * v[i].x + v[i].y * v[i].y + v[i].z * v[i].z + v[i].w * v[i].w;
  }
  ss = wave_sum(ss);
  const float rs = rsqrtf(ss * (1.f / 1024.f) + 1e-6f);
#pragma unroll
  for (int i = 0; i < 4; ++i) {
    float4 gg = ((const float4*)g)[lane + i * 64];
    u32x2 o;
    o.x = pack2(v[i].x * rs * gg.x, v[i].y * rs * gg.y);
    o.y = pack2(v[i].z * rs * gg.z, v[i].w * rs * gg.w);
    ((u32x2*)dst)[lane + i * 64] = o;
    if (xcopy) ((float4*)xcopy)[lane + i * 64] = v[i];
  }
}

DEVI void phase_norm(int tid_, const Params& p, const float* g, bool from_input) {
  u16* H = (u16*)(p.ws + OFF_H);
  const int wid = tid_ >> 6;
  for (int r = blockIdx.x * 4 + wid; r < NTOK; r += gridDim.x * 4) {
    const float* src;
    if (from_input) src = (r < 32768) ? p.in[I_XP] + (size_t)r * 1024 : p.in[I_XS] + (size_t)(r - 32768) * 1024;
    else src = p.X + (size_t)r * 1024;
    norm_row_bf16(tid_, src, g, H + (size_t)r * 1024, from_input ? p.X + (size_t)r * 1024 : nullptr);
  }
}
DEVI void phase_norm_mem(int tid_, const Params& p, const float* g) {
  u16* MH = (u16*)(p.ws + OFF_MEMH);
  const int wid = tid_ >> 6;
  for (int r = blockIdx.x * 4 + wid; r < 3072; r += gridDim.x * 4) {
    const float* src = (r < 2048) ? p.in[I_MP] + (size_t)r * 1024 : p.in[I_MS] + (size_t)(r - 2048) * 1024;
    norm_row_bf16(tid_, src, g, MH + (size_t)r * 1024, nullptr);
  }
}
DEVI void phase_final_norm(int tid_, const Params& p) {
  const float* g = p.in[I_NORM_FINAL];
  const int wid = tid_ >> 6, lane = tid_ & 63;
  for (int r = blockIdx.x * 4 + wid; r < NTOK; r += gridDim.x * 4) {
    float* row = p.X + (size_t)r * 1024;
    float4 v[4];
    float ss = 0.f;
#pragma unroll
    for (int i = 0; i < 4; ++i) {
      v[i] = ((const float4*)row)[lane + i * 64];
      ss += v[i].x * v[i].x + v[i].y * v[i].y + v[i].z * v[i].z + v[i].w * v[i].w;
    }
    ss = wave_sum(ss);
    const float rs = rsqrtf(ss * (1.f / 1024.f) + 1e-6f);
#pragma unroll
    for (int i = 0; i < 4; ++i) {
      float4 gg = ((const float4*)g)[lane + i * 64];
      float4 o;
      o.x = v[i].x * rs * gg.x; o.y = v[i].y * rs * gg.y; o.z = v[i].z * rs * gg.z; o.w = v[i].w * rs * gg.w;
      ((float4*)row)[lane + i * 64] = o;
    }
  }
}

constexpr int LDSW = 72;

template <int NW>
DEVI void gemm_kloop(int tid_, f32x4 (&acc)[4][NW], const u16* __restrict__ A, int lda, const u16* __restrict__ Bt, int ldb,
                     int K, char* smem) {
  u16* sA = (u16*)smem;
  u16* sB = sA + 128 * LDSW;
  const int tid = tid_, lane = tid & 63, wid = tid >> 6;
  const int wr = wid >> 1, wc = wid & 1, fr = lane & 15, fq = lane >> 4;
  const int lrow = tid >> 3, lkc = tid & 7;
  u32x4 ra[4], rb[NW];
  const u16* ga = A + (size_t)lrow * lda + lkc * 8;
  const u16* gb = Bt + (size_t)lrow * ldb + lkc * 8;
#pragma unroll
  for (int i = 0; i < 4; ++i) ra[i] = *(const u32x4*)(ga + (size_t)(i * 32) * lda);
#pragma unroll
  for (int i = 0; i < NW; ++i) rb[i] = *(const u32x4*)(gb + (size_t)(i * 32) * ldb);
  for (int k0 = 0; k0 < K; k0 += 64) {
    __syncthreads();
#pragma unroll
    for (int i = 0; i < 4; ++i) *(u32x4*)(sA + (lrow + i * 32) * LDSW + lkc * 8) = ra[i];
#pragma unroll
    for (int i = 0; i < NW; ++i) *(u32x4*)(sB + (lrow + i * 32) * LDSW + lkc * 8) = rb[i];
    __syncthreads();
    if (k0 + 64 < K) {
#pragma unroll
      for (int i = 0; i < 4; ++i) ra[i] = *(const u32x4*)(ga + (size_t)(i * 32) * lda + k0 + 64);
#pragma unroll
      for (int i = 0; i < NW; ++i) rb[i] = *(const u32x4*)(gb + (size_t)(i * 32) * ldb + k0 + 64);
    }
#pragma unroll
    for (int ks = 0; ks < 2; ++ks) {
      bf16x8 af[4], bfr[NW];
#pragma unroll
      for (int m = 0; m < 4; ++m) af[m] = *(const bf16x8*)(sA + (wr * 64 + m * 16 + fr) * LDSW + ks * 32 + fq * 8);
#pragma unroll
      for (int n = 0; n < NW; ++n) bfr[n] = *(const bf16x8*)(sB + (wc * 16 * NW + n * 16 + fr) * LDSW + ks * 32 + fq * 8);
#pragma unroll
      for (int m = 0; m < 4; ++m)
#pragma unroll
        for (int n = 0; n < NW; ++n) acc[m][n] = __builtin_amdgcn_mfma_f32_16x16x32_bf16(af[m], bfr[n], acc[m][n], 0, 0, 0);
    }
  }
}

template <int NW>
DEVI void zero_acc(f32x4 (&acc)[4][NW]) {
#pragma unroll
  for (int m = 0; m < 4; ++m)
#pragma unroll
    for (int n = 0; n < NW; ++n) acc[m][n] = (f32x4){0.f, 0.f, 0.f, 0.f};
}

template <class Epi>
DEVI void gemm_phase(int tid_, const u16* A, int lda, const u16* Bt, int ldb, int K, int M, int N, char* smem, Epi epi) {
  const int nN = N >> 7, nM = M >> 7;
  const int lane = tid_ & 63, wid = tid_ >> 6;
  const int wr = wid >> 1, wc = wid & 1, fr = lane & 15, fq = lane >> 4;
  for (int t = blockIdx.x; t < nM * nN; t += gridDim.x) {
    const int tm = t / nN, tn = t - tm * nN;
    const int m0 = tm << 7, n0 = tn << 7;
    f32x4 acc[4][4];
    zero_acc(acc);
    gemm_kloop<4>(tid_, acc, A + (size_t)m0 * lda, lda, Bt + (size_t)n0 * ldb, ldb, K, smem);
#pragma unroll
    for (int m = 0; m < 4; ++m)
#pragma unroll
      for (int n = 0; n < 4; ++n) epi(m0 + wr * 64 + m * 16 + fq * 4, n0 + wc * 64 + n * 16 + fr, acc[m][n]);
  }
}

DEVI void phase_p_gemm(int tid_, const Params& p, char* smem) {
  u16* WB = (u16*)(p.ws + OFF_WB);
  const u16* H = (const u16*)(p.ws + OFF_H);
  u16* PR = (u16*)(p.ws + OFF_PR);
  u16* NQ = (u16*)(p.ws + OFF_NQ);
  u16* NK = (u16*)(p.ws + OFF_NK);
  u16* NVT = (u16*)(p.ws + OFF_NV);
  gemm_phase(tid_, H, 1024, WB + W_IN, 1024, 1024, NTOK, 3456, smem, [&](int r0, int c, f32x4 v) {
    if (c < 1920) {
#pragma unroll
      for (int j = 0; j < 4; ++j) PR[(size_t)(r0 + j) * PRW + c] = f2bf(v[j]);
    } else if (c < 2432) {
#pragma unroll
      for (int j = 0; j < 4; ++j) NQ[(size_t)(r0 + j) * 512 + (c - 1920)] = f2bf(v[j]);
    } else if (c < 2944) {
#pragma unroll
      for (int j = 0; j < 4; ++j) NK[(size_t)(r0 + j) * 512 + (c - 2432)] = f2bf(v[j]);
    } else {
      const int cc = c - 2944;
      const int s = r0 >> 12, t = r0 & 4095;
      u32x2 o;
      o.x = pack2(v[0], v[1]); o.y = pack2(v[2], v[3]);
      *(u32x2*)(NVT + ((size_t)(s * 512 + cc)) * 4096 + t) = o;
    }
  });
  const u16* MH = (const u16*)(p.ws + OFF_MEMH);
  u16* KVK = (u16*)(p.ws + OFF_KVK);
  u16* KVT = (u16*)(p.ws + OFF_KVT);
  gemm_phase(tid_, MH, 1024, WB + W_XKV, 1024, 1024, 3072, 2048, smem, [&](int r0, int c, f32x4 v) {
    if (c < 1024) {
#pragma unroll
      for (int j = 0; j < 4; ++j) KVK[(size_t)(r0 + j) * 1024 + c] = f2bf(v[j]);
    } else {
      const int cc = c - 1024;
      const int s = r0 >> 8, m = r0 & 255;
      u32x2 o;
      o.x = pack2(v[0], v[1]); o.y = pack2(v[2], v[3]);
      *(u32x2*)(KVT + ((size_t)(s * 1024 + cc)) * 256 + m) = o;
    }
  });
}

DEVI void phase_nat(int tid_, const Params& p, int l, char* smem) {
  u16* NQ = (u16*)(p.ws + OFF_NQ);
  const u16* NK = (const u16*)(p.ws + OFF_NK);
  const u16* NVT = (const u16*)(p.ws + OFF_NV);
  const float* rpb = p.in[I_RPB] + (size_t)l * 8 * 15 * 31;
  const int lane = tid_ & 63, g = tid_ >> 6, fr = lane & 15, fq = lane >> 4;
  u16* Pw = (u16*)smem + g * (16 * 264);
  const int cb = (g == 0) ? 0 : (g == 1) ? 8 : (g == 2) ? 24 : 32;
  for (int t = blockIdx.x; t < 12 * 64 * 8; t += gridDim.x) {
    const int h = t & 7, ri = (t >> 3) & 63, s = t >> 9;
    int rs = ri - 4; rs = rs < 0 ? 0 : (rs > 56 ? 56 : rs);
    const size_t tokq = (size_t)s * 4096 + ri * 64 + g * 16;
    bf16x8 aq[2];
    aq[0] = *(const bf16x8*)(NQ + (tokq + fr) * 512 + h * 64 + fq * 8);
    aq[1] = *(const bf16x8*)(NQ + (tokq + fr) * 512 + h * 64 + 32 + fq * 8);
    f32x4 acc[16];
#pragma unroll
    for (int n = 0; n < 16; ++n) {
      acc[n] = (f32x4){0.f, 0.f, 0.f, 0.f};
      const int r = n >> 1, col = cb + (n & 1) * 16 + fr;
      const u16* kp = NK + ((size_t)s * 4096 + (rs + r) * 64 + col) * 512 + h * 64 + fq * 8;
      bf16x8 b0 = *(const bf16x8*)kp;
      bf16x8 b1 = *(const bf16x8*)(kp + 32);
      acc[n] = __builtin_amdgcn_mfma_f32_16x16x32_bf16(aq[0], b0, acc[n], 0, 0, 0);
      acc[n] = __builtin_amdgcn_mfma_f32_16x16x32_bf16(aq[1], b1, acc[n], 0, 0, 0);
    }
    float mx[4], sm[4];
#pragma unroll
    for (int j = 0; j < 4; ++j) {
      const int c = g * 16 + fq * 4 + j;
      int cs = c - 8; cs = cs < 0 ? 0 : (cs > 48 ? 48 : cs);
      float m = -1e30f;
#pragma unroll
      for (int n = 0; n < 16; ++n) {
        const int r = n >> 1, kc = cb + (n & 1) * 16 + fr;
        const bool valid = (kc >= cs) && (kc < cs + 16);
        float sc = -1e30f;
        if (valid) {
          const int di = rs + r - ri + 7, dj = kc - c + 15;
          sc = acc[n][j] * 0.125f + rpb[(h * 15 + di) * 31 + dj];
        }
        acc[n][j] = sc;
        m = fmaxf(m, sc);
      }
      mx[j] = red16_max(m);
    }
#pragma unroll
    for (int j = 0; j < 4; ++j) {
      float ssum = 0.f;
#pragma unroll
      for (int n = 0; n < 16; ++n) {
        float e = __expf(acc[n][j] - mx[j]);
        acc[n][j] = e;
        ssum += e;
      }
      sm[j] = 1.f / red16_sum(ssum);
    }
    __syncthreads();
#pragma unroll
    for (int n = 0; n < 16; ++n)
#pragma unroll
      for (int j = 0; j < 4; ++j) Pw[(fq * 4 + j) * 264 + n * 16 + fr] = f2bf(acc[n][j]);
    __syncthreads();
    f32x4 o[4];
#pragma unroll
    for (int n = 0; n < 4; ++n) o[n] = (f32x4){0.f, 0.f, 0.f, 0.f};
#pragma unroll
    for (int ks = 0; ks < 8; ++ks) {
      bf16x8 ap = *(const bf16x8*)(Pw + fr * 264 + ks * 32 + fq * 8);
#pragma unroll
      for (int n = 0; n < 4; ++n) {
        bf16x8 bv = *(const bf16x8*)(NVT + ((size_t)(s * 512 + h * 64 + n * 16 + fr)) * 4096 + (rs + ks) * 64 + cb + fq * 8);
        o[n] = __builtin_amdgcn_mfma_f32_16x16x32_bf16(ap, bv, o[n], 0, 0, 0);
      }
    }
#pragma unroll
    for (int n = 0; n < 4; ++n)
#pragma unroll
      for (int j = 0; j < 4; ++j)
        NQ[(tokq + fq * 4 + j) * 512 + h * 64 + n * 16 + fr] = f2bf(o[n][j] * sm[j]);
  }
}

constexpr int SC_OPS = 0;
constexpr int SC_VV = 40960;
constexpr int SC_WR = 49152;
constexpr int SC_AP = 57344;
constexpr int SC_TW = 65536;
constexpr int SC_AD = 70144;
constexpr int SC_NRM = 74752;
constexpr int SC_MU = 74880;
constexpr int SC_CST = 77440;

typedef __attribute__((ext_vector_type(2))) float f32x2;

template <int CTRL>
DEVI float dpp_mov(float x) {
  return __int_as_float(__builtin_amdgcn_update_dpp(0, __float_as_int(x), CTRL, 0xF, 0xF, true));
}
DEVI float red8(float x) {
  x += dpp_mov<0xB1>(x);
  x += dpp_mov<0x4E>(x);
  x += dpp_mov<0x141>(x);
  return x;
}
DEVI f32x2 lo2(f32x4 v) { return __builtin_shufflevector(v, v, 0, 1); }
DEVI f32x2 hi2(f32x4 v) { return __builtin_shufflevector(v, v, 2, 3); }

struct ScanOps {
  f32x2 a[4], w[4], b[4], k[4], r[4];
  float v0, v1;
};
DEVI void scan_load(ScanOps& o, const float* OPS, const float* VV, int nn, int jg, int i0) {
  const float* base = OPS + nn * 64 + jg * 8;
  f32x4 t0, t1;
  t0 = *(const f32x4*)(base); t1 = *(const f32x4*)(base + 4);
  o.a[0] = lo2(t0); o.a[1] = hi2(t0); o.a[2] = lo2(t1); o.a[3] = hi2(t1);
  t0 = *(const f32x4*)(base + 2048); t1 = *(const f32x4*)(base + 2048 + 4);
  o.w[0] = lo2(t0); o.w[1] = hi2(t0); o.w[2] = lo2(t1); o.w[3] = hi2(t1);
  t0 = *(const f32x4*)(base + 4096); t1 = *(const f32x4*)(base + 4096 + 4);
  o.b[0] = lo2(t0); o.b[1] = hi2(t0); o.b[2] = lo2(t1); o.b[3] = hi2(t1);
  t0 = *(const f32x4*)(base + 6144); t1 = *(const f32x4*)(base + 6144 + 4);
  o.k[0] = lo2(t0); o.k[1] = hi2(t0); o.k[2] = lo2(t1); o.k[3] = hi2(t1);
  t0 = *(const f32x4*)(base + 8192); t1 = *(const f32x4*)(base + 8192 + 4);
  o.r[0] = lo2(t0); o.r[1] = hi2(t0); o.r[2] = lo2(t1); o.r[3] = hi2(t1);
  o.v0 = VV[nn * 64 + i0];
  o.v1 = VV[nn * 64 + i0 + 8];
}
DEVI void scan_step(const ScanOps& o, f32x2 (&S0)[4], f32x2 (&S1)[4], float* YL, int nn, int jg, int i0) {
  f32x2 d0 = S0[0] * o.a[0], d0b = S0[2] * o.a[2];
  f32x2 d1 = S1[0] * o.a[0], d1b = S1[2] * o.a[2];
  d0 = S0[1] * o.a[1] + d0; d0b = S0[3] * o.a[3] + d0b;
  d1 = S1[1] * o.a[1] + d1; d1b = S1[3] * o.a[3] + d1b;
  d0 += d0b; d1 += d1b;
  const float sa0 = red8(d0.x + d0.y);
  const float sa1 = red8(d1.x + d1.y);
  f32x2 e0 = {0.f, 0.f}, e1 = {0.f, 0.f};
#pragma unroll
  for (int q = 0; q < 4; ++q) {
    const f32x2 u0 = sa0 * o.b[q] + o.v0 * o.k[q];
    const f32x2 u1 = sa1 * o.b[q] + o.v1 * o.k[q];
    S0[q] = S0[q] * o.w[q] + u0;
    S1[q] = S1[q] * o.w[q] + u1;
    e0 = S0[q] * o.r[q] + e0;
    e1 = S1[q] * o.r[q] + e1;
  }
  const float y0 = red8(e0.x + e0.y);
  const float y1 = red8(e1.x + e1.y);
  if (jg == 0) { YL[nn * 64 + i0] = y0; YL[nn * 64 + i0 + 8] = y1; }
}

DEVI void phase_scan(int tid_, const Params& p, int l, char* smem) {
  const u16* PR = (const u16*)(p.ws + OFF_PR);
  _Float16* YF = (_Float16*)(p.ws + OFF_NK);
  _Float16* YB = (_Float16*)(p.ws + OFF_NV);
  float* BON = (float*)(p.ws + OFF_BONUS);
  const u16* WB = (const u16*)(p.ws + OFF_WB);
  float* OPS = (float*)(smem + SC_OPS);
  u16* RAW = (u16*)(smem + SC_OPS);
  float* VV = (float*)(smem + SC_VV);
  float* WR = (float*)(smem + SC_WR);
  float* AP = (float*)(smem + SC_AP);
  float* YL = WR;
  u16* TWb = (u16*)(smem + SC_TW);
  u16* ADb = (u16*)(smem + SC_AD);
  float* NRM = (float*)(smem + SC_NRM);
  float* MU = (float*)(smem + SC_MU);
  float* CST = (float*)(smem + SC_CST);
  const float* mu_p = p.in[I_MU_PREV] + (size_t)l * 1920;
  const float* mu_n = p.in[I_MU_NEXT] + (size_t)l * 1920;
  const int tid = tid_, lane = tid & 63, w = tid >> 6, fr = lane & 15, fq = lane >> 4;
  const int pn = tid >> 3, j0 = (tid & 7) * 8;
  const int jg = lane & 7, i0 = w * 16 + (lane >> 3);
  const int hr = (tid >= 40) ? 1 : 0, hc = tid - hr * 40;
  for (int blk = blockIdx.x; blk < 192; blk += gridDim.x) {
    const int s = blk >> 4, h = (blk >> 1) & 7, d = blk & 1;
    __syncthreads();
    for (int i = tid; i < 640; i += 256) {
      const int which = (i >= 320) ? 1 : 0, c = i - which * 320;
      const int g = c >> 6, e = c & 63;
      const int col = (g < 3) ? (g * 512 + h * 64 + e) : (1536 + (g - 3) * 128 + d * 64 + e);
      MU[i] = which ? mu_n[col] : mu_p[col];
    }
    for (int i = tid; i < 320; i += 256) {
      const int which = i >> 6, e = i & 63;
      float v;
      if (which == 0) v = p.in[I_W0][(size_t)(l * 2 + d) * 512 + h * 64 + e];
      else if (which == 1) v = p.in[I_A0][(size_t)(l * 2 + d) * 512 + h * 64 + e];
      else if (which == 2) v = p.in[I_K_K][(size_t)l * 512 + h * 64 + e];
      else if (which == 3) v = p.in[I_K_A][(size_t)l * 512 + h * 64 + e];
      else v = p.in[I_R_K][(size_t)(l * 8 + h) * 64 + e];
      CST[i] = v;
    }
    bf16x8 bw[2], ba[2];
#pragma unroll
    for (int ks = 0; ks < 2; ++ks) {
      bw[ks] = *(const bf16x8*)(WB + W_WUP + (size_t)(d * 512 + h * 64 + w * 16 + fr) * 64 + ks * 32 + fq * 8);
      ba[ks] = *(const bf16x8*)(WB + W_AUP + (size_t)(d * 512 + h * 64 + w * 16 + fr) * 64 + ks * 32 + fq * 8);
    }
    _Float16* Y = d ? YB : YF;
    f32x2 S0[4], S1[4];
#pragma unroll
    for (int q = 0; q < 4; ++q) { S0[q] = (f32x2){0.f, 0.f}; S1[q] = (f32x2){0.f, 0.f}; }
    u32x4 G[5], GH;
    {
      const int t = d ? (4095 - pn) : pn;
      const size_t tok = (size_t)s * 4096 + t;
#pragma unroll
      for (int g = 0; g < 5; ++g) {
        const int col = (g < 3) ? (g * 512 + h * 64) : (1536 + (g - 3) * 128 + d * 64);
        G[g] = *(const u32x4*)(PR + tok * PRW + col + j0);
      }
      GH = (u32x4){0u, 0u, 0u, 0u};
      if (tid < 80) {
        const int tlo = d ? (4095 - 31) : 0;
        const int th = hr ? (tlo + 32) : (tlo - 1);
        const int g = hc >> 3;
        const int col = (g < 3) ? (g * 512 + h * 64) : (1536 + (g - 3) * 128 + d * 64);
        if (th >= 0 && th <= 4095) GH = *(const u32x4*)(PR + ((size_t)s * 4096 + th) * PRW + col + (hc & 7) * 8);
      }
    }
#pragma unroll 1
    for (int ch = 0; ch < 128; ++ch) {
      const int n = ch * 32 + pn;
      const int t = d ? (4095 - n) : n;
      const size_t tok = (size_t)s * 4096 + t;
      const int tlo = d ? (4095 - (ch * 32 + 31)) : (ch * 32);
      const int rrow = t - tlo + 1;
#pragma unroll
      for (int g = 0; g < 5; ++g) *(u32x4*)(RAW + rrow * 320 + g * 64 + j0) = G[g];
      if (tid < 80) *(u32x4*)(RAW + (hr ? 33 : 0) * 320 + (hc >> 3) * 64 + (hc & 7) * 8) = GH;
      __syncthreads();
      if (ch + 1 < 128) {
        const int n2 = n + 32;
        const int t2 = d ? (4095 - n2) : n2;
        const size_t tok2 = (size_t)s * 4096 + t2;
#pragma unroll
        for (int g = 0; g < 5; ++g) {
          const int col = (g < 3) ? (g * 512 + h * 64) : (1536 + (g - 3) * 128 + d * 64);
          G[g] = *(const u32x4*)(PR + tok2 * PRW + col + j0);
        }
        GH = (u32x4){0u, 0u, 0u, 0u};
        if (tid < 80) {
          const int tlo2 = d ? (tlo - 32) : (tlo + 32);
          const int th = hr ? (tlo2 + 32) : (tlo2 - 1);
          const int g = hc >> 3;
          const int col = (g < 3) ? (g * 512 + h * 64) : (1536 + (g - 3) * 128 + d * 64);
          if (th >= 0 && th <= 4095) GH = *(const u32x4*)(PR + ((size_t)s * 4096 + th) * PRW + col + (hc & 7) * 8);
        }
      }
#pragma unroll
      for (int g = 0; g < 5; ++g) {
        float cur[8], prv[8], nxt[8];
        load8bf(RAW + rrow * 320 + g * 64 + j0, cur);
        load8bf(RAW + (rrow - 1) * 320 + g * 64 + j0, prv);
        load8bf(RAW + (rrow + 1) * 320 + g * 64 + j0, nxt);
        const f32x4 mp0 = *(const f32x4*)(MU + g * 64 + j0), mp1 = *(const f32x4*)(MU + g * 64 + j0 + 4);
        const f32x4 mn0 = *(const f32x4*)(MU + 320 + g * 64 + j0), mn1 = *(const f32x4*)(MU + 320 + g * 64 + j0 + 4);
        f32x4 x0, x1;
#pragma unroll
        for (int e = 0; e < 4; ++e) {
          x0[e] = cur[e] + mp0[e] * (prv[e] - cur[e]) + mn0[e] * (nxt[e] - cur[e]);
          x1[e] = cur[4 + e] + mp1[e] * (prv[4 + e] - cur[4 + e]) + mn1[e] * (nxt[4 + e] - cur[4 + e]);
        }
        if (g == 0) {
          *(f32x4*)(OPS + 4 * 2048 + pn * 64 + j0) = x0; *(f32x4*)(OPS + 4 * 2048 + pn * 64 + j0 + 4) = x1;
        } else if (g == 1) {
          *(f32x4*)(OPS + 3 * 2048 + pn * 64 + j0) = x0; *(f32x4*)(OPS + 3 * 2048 + pn * 64 + j0 + 4) = x1;
          const f32x4 kk0 = *(const f32x4*)(CST + 128 + j0), kk1 = *(const f32x4*)(CST + 128 + j0 + 4);
          float ss = 0.f;
#pragma unroll
          for (int e = 0; e < 4; ++e) { const float a_ = x0[e] * kk0[e], b_ = x1[e] * kk1[e]; ss += a_ * a_ + b_ * b_; }
          ss = red8(ss);
          if ((tid & 7) == 0) NRM[pn] = 1.f / fmaxf(sqrtf(ss), 1e-12f);
        } else if (g == 2) {
          *(f32x4*)(VV + pn * 64 + j0) = x0; *(f32x4*)(VV + pn * 64 + j0 + 4) = x1;
        } else if (g == 3) {
          u32x4 pk;
          pk.x = pack2(tanhf(x0[0]), tanhf(x0[1])); pk.y = pack2(tanhf(x0[2]), tanhf(x0[3]));
          pk.z = pack2(tanhf(x1[0]), tanhf(x1[1])); pk.w = pack2(tanhf(x1[2]), tanhf(x1[3]));
          *(u32x4*)(TWb + pn * 72 + j0) = pk;
        } else {
          u32x4 pk;
          pk.x = pack2(x0[0], x0[1]); pk.y = pack2(x0[2], x0[3]);
          pk.z = pack2(x1[0], x1[1]); pk.w = pack2(x1[2], x1[3]);
          *(u32x4*)(ADb + pn * 72 + j0) = pk;
        }
      }
      __syncthreads();
#pragma unroll
      for (int m = 0; m < 2; ++m) {
        f32x4 cw = {0.f, 0.f, 0.f, 0.f}, ca = {0.f, 0.f, 0.f, 0.f};
#pragma unroll
        for (int ks = 0; ks < 2; ++ks) {
          const bf16x8 aw = *(const bf16x8*)(TWb + (m * 16 + fr) * 72 + ks * 32 + fq * 8);
          const bf16x8 aa = *(const bf16x8*)(ADb + (m * 16 + fr) * 72 + ks * 32 + fq * 8);
          cw = __builtin_amdgcn_mfma_f32_16x16x32_bf16(aw, bw[ks], cw, 0, 0, 0);
          ca = __builtin_amdgcn_mfma_f32_16x16x32_bf16(aa, ba[ks], ca, 0, 0, 0);
        }
#pragma unroll
        for (int jj = 0; jj < 4; ++jj) {
          WR[(m * 16 + fq * 4 + jj) * 64 + w * 16 + fr] = cw[jj];
          AP[(m * 16 + fq * 4 + jj) * 64 + w * 16 + fr] = ca[jj];
        }
      }
      __syncthreads();
      {
        const float inv = NRM[pn];
        float bsum = 0.f;
#pragma unroll
        for (int hq = 0; hq < 2; ++hq) {
          const int jb = j0 + hq * 4;
          const f32x4 wr_ = *(const f32x4*)(WR + pn * 64 + jb) + *(const f32x4*)(CST + jb);
          const f32x4 ap_ = *(const f32x4*)(AP + pn * 64 + jb) + *(const f32x4*)(CST + 64 + jb);
          const f32x4 kr = *(const f32x4*)(OPS + 3 * 2048 + pn * 64 + jb);
          const f32x4 rr = *(const f32x4*)(OPS + 4 * 2048 + pn * 64 + jb);
          const f32x4 kkw = *(const f32x4*)(CST + 128 + jb), kaw = *(const f32x4*)(CST + 192 + jb), rkw = *(const f32x4*)(CST + 256 + jb);
          f32x4 o0, o1, o2, o3;
#pragma unroll
          for (int e = 0; e < 4; ++e) {
            const float sw = 1.f / (1.f + expf(-wr_[e]));
            const float dec = expf(-0.6065306597126334f * sw);
            const float av = 1.f / (1.f + expf(-ap_[e]));
            const float kn = kr[e] * kkw[e] * inv;
            const float kd = kr[e] * (1.f + (av - 1.f) * kaw[e]);
            bsum += rr[e] * kd * rkw[e];
            o0[e] = -kn; o1[e] = dec; o2[e] = kn * av; o3[e] = kd;
          }
          *(f32x4*)(OPS + 0 * 2048 + pn * 64 + jb) = o0;
          *(f32x4*)(OPS + 1 * 2048 + pn * 64 + jb) = o1;
          *(f32x4*)(OPS + 2 * 2048 + pn * 64 + jb) = o2;
          *(f32x4*)(OPS + 3 * 2048 + pn * 64 + jb) = o3;
        }
        bsum = red8(bsum);
        if ((tid & 7) == 0) BON[(tok * 8 + h) * 2 + d] = bsum;
      }
      __syncthreads();
      {
        ScanOps oa, ob;
        scan_load(oa, OPS, VV, 0, jg, i0);
#pragma unroll 1
        for (int nn = 0; nn < 32; nn += 2) {
          scan_load(ob, OPS, VV, nn + 1, jg, i0);
          scan_step(oa, S0, S1, YL, nn, jg, i0);
          scan_load(oa, OPS, VV, (nn + 2) & 31, jg, i0);
          scan_step(ob, S0, S1, YL, nn + 1, jg, i0);
        }
      }
      __syncthreads();
      {
        h16x8 o;
#pragma unroll
        for (int e = 0; e < 8; ++e) o[e] = (_Float16)YL[pn * 64 + j0 + e];
        *(h16x8*)(Y + tok * 512 + h * 64 + j0) = o;
      }
    }
    __syncthreads();
  }
}

DEVI void phase_rwkv_post(int tid_, const Params& p, int l, char* smem) {
  u16* PR = (u16*)(p.ws + OFF_PR);
  const _Float16* YF = (const _Float16*)(p.ws + OFF_NK);
  const _Float16* YB = (const _Float16*)(p.ws + OFF_NV);
  const float* BON = (const float*)(p.ws + OFF_BONUS);
  const u16* GUPT = (const u16*)(p.ws + OFF_WB) + W_GUP;
  const float* mu_p = p.in[I_MU_PREV] + (size_t)l * 1920;
  const float* mu_n = p.in[I_MU_NEXT] + (size_t)l * 1920;
  const float* gng = p.in[I_GN_G] + (size_t)l * 512;
  const float* gnb = p.in[I_GN_B] + (size_t)l * 512;
  u16* As = (u16*)smem;
  const int tid = tid_, lane = tid & 63, w = tid >> 6, fr = lane & 15, fq = lane >> 4;
  for (int tile = blockIdx.x; tile < NTOK / 64; tile += gridDim.x) {
    const size_t tok0 = (size_t)tile * 64;
    {
      const int row = tid >> 2, part = tid & 3;
      const size_t tok = tok0 + row;
      const int t = (int)(tok & 4095);
#pragma unroll
      for (int q = 0; q < 4; ++q) {
        const int col = 1792 + part * 32 + q * 8;
        float cur[8], prv[8], nxt[8];
        load8bf(PR + tok * PRW + col, cur);
        if (t > 0) load8bf(PR + (tok - 1) * PRW + col, prv);
        else {
#pragma unroll
          for (int e = 0; e < 8; ++e) prv[e] = 0.f;
        }
        if (t < 4095) load8bf(PR + (tok + 1) * PRW + col, nxt);
        else {
#pragma unroll
          for (int e = 0; e < 8; ++e) nxt[e] = 0.f;
        }
        float o[8];
#pragma unroll
        for (int e = 0; e < 8; ++e) {
          const float x = cur[e] + mu_p[col + e] * (prv[e] - cur[e]) + mu_n[col + e] * (nxt[e] - cur[e]);
          o[e] = sigm(x);
        }
        u32x4 pk;
        pk.x = pack2(o[0], o[1]); pk.y = pack2(o[2], o[3]); pk.z = pack2(o[4], o[5]); pk.w = pack2(o[6], o[7]);
        *(u32x4*)(As + row * 136 + part * 32 + q * 8) = pk;
      }
    }
    __syncthreads();
#pragma unroll 1
    for (int chh = 0; chh < 2; ++chh) {
      f32x4 acc[16];
#pragma unroll
      for (int n = 0; n < 16; ++n) acc[n] = (f32x4){0.f, 0.f, 0.f, 0.f};
#pragma unroll
      for (int ks = 0; ks < 4; ++ks) {
        bf16x8 af = *(const bf16x8*)(As + (w * 16 + fr) * 136 + ks * 32 + fq * 8);
#pragma unroll
        for (int n = 0; n < 16; ++n) {
          bf16x8 bg = *(const bf16x8*)(GUPT + (size_t)(chh * 256 + n * 16 + fr) * 128 + ks * 32 + fq * 8);
          acc[n] = __builtin_amdgcn_mfma_f32_16x16x32_bf16(af, bg, acc[n], 0, 0, 0);
        }
      }
#pragma unroll
      for (int hl = 0; hl < 4; ++hl) {
        const int head = chh * 4 + hl;
#pragma unroll
        for (int j = 0; j < 4; ++j) {
          const size_t tok = tok0 + w * 16 + fq * 4 + j;
          const int t = (int)(tok & 4095);
          float o[4], sum = 0.f;
#pragma unroll
          for (int q = 0; q < 4; ++q) {
            const int col = head * 64 + q * 16 + fr;
            o[q] = (float)YF[tok * 512 + col] + (float)YB[tok * 512 + col];
            sum += o[q];
          }
          const float mean = red16_sum(sum) * (1.f / 64.f);
          float vs = 0.f;
#pragma unroll
          for (int q = 0; q < 4; ++q) { const float dlt = o[q] - mean; vs += dlt * dlt; }
          const float var = red16_sum(vs) * (1.f / 64.f);
          const float rstd = rsqrtf(var + 64e-5f);
          const float bon = BON[(tok * 8 + head) * 2] + BON[(tok * 8 + head) * 2 + 1];
#pragma unroll
          for (int q = 0; q < 4; ++q) {
            const int col = head * 64 + q * 16 + fr;
            const int vc = 1024 + col;
            const float cur = bf2f(PR[tok * PRW + vc]);
            const float prv = (t > 0) ? bf2f(PR[(tok - 1) * PRW + vc]) : 0.f;
            const float nxt = (t < 4095) ? bf2f(PR[(tok + 1) * PRW + vc]) : 0.f;
            const float vsh = cur + mu_p[vc] * (prv - cur) + mu_n[vc] * (nxt - cur);
            const float yv = ((o[q] - mean) * rstd * gng[col] + gnb[col] + bon * vsh) * acc[hl * 4 + q][j];
            PR[tok * PRW + col] = f2bf(yv);
          }
        }
      }
    }
    __syncthreads();
  }
}

DEVI void phase_merge(int tid_, const Params& p, char* smem) {
  const u16* WB = (const u16*)(p.ws + OFF_WB);
  const u16* H = (const u16*)(p.ws + OFF_H);
  u16* PR = (u16*)(p.ws + OFF_PR);
  const u16* NQ = (const u16*)(p.ws + OFF_NQ);
  const int lane = tid_ & 63, wid = tid_ >> 6;
  const int wr = wid >> 1, wc = wid & 1, fr = lane & 15, fq = lane >> 4;
  for (int t = blockIdx.x; t < 384 * 16; t += gridDim.x) {
    const int tm = t >> 4, tn = t & 15;
    const int m0 = tm << 7, n0 = tn << 6;
    f32x4 g[4][2], acc[4][2];
    uint32_t mp[4][2][2];
    zero_acc(g);
    gemm_kloop<2>(tid_, g, H + (size_t)m0 * 1024, 1024, WB + W_IN + (size_t)(3456 + n0) * 1024, 1024, 1024, smem);
    zero_acc(acc);
    gemm_kloop<2>(tid_, acc, PR + (size_t)m0 * PRW, PRW, WB + W_BRR + (size_t)n0 * 512, 512, 512, smem);
#pragma unroll
    for (int m = 0; m < 4; ++m)
#pragma unroll
      for (int n = 0; n < 2; ++n) {
        mp[m][n][0] = pack2(sigm(g[m][n][0]) * acc[m][n][0], sigm(g[m][n][1]) * acc[m][n][1]);
        mp[m][n][1] = pack2(sigm(g[m][n][2]) * acc[m][n][2], sigm(g[m][n][3]) * acc[m][n][3]);
      }
    zero_acc(g);
    gemm_kloop<2>(tid_, g, H + (size_t)m0 * 1024, 1024, WB + W_IN + (size_t)(4480 + n0) * 1024, 1024, 1024, smem);
    zero_acc(acc);
    gemm_kloop<2>(tid_, acc, NQ + (size_t)m0 * 512, 512, WB + W_BRN + (size_t)n0 * 512, 512, 512, smem);
#pragma unroll
    for (int m = 0; m < 4; ++m)
#pragma unroll
      for (int n = 0; n < 2; ++n) {
        const int r0 = m0 + wr * 64 + m * 16 + fq * 4, c = n0 + wc * 32 + n * 16 + fr;
        float pv[4];
        pv[0] = __uint_as_float(mp[m][n][0] << 16); pv[1] = __uint_as_float(mp[m][n][0] & 0xffff0000u);
        pv[2] = __uint_as_float(mp[m][n][1] << 16); pv[3] = __uint_as_float(mp[m][n][1] & 0xffff0000u);
#pragma unroll
        for (int j = 0; j < 4; ++j)
          PR[(size_t)(r0 + j) * PRW + 512 + c] = f2bf(pv[j] + sigm(g[m][n][j]) * acc[m][n][j]);
      }
  }
}

DEVI void phase_xattn(int tid_, const Params& p, char* smem) {
  const u16* Q = (const u16*)(p.ws + OFF_PR);
  u16* O = (u16*)(p.ws + OFF_NQ);
  const u16* KVK = (const u16*)(p.ws + OFF_KVK);
  const u16* KVT = (const u16*)(p.ws + OFF_KVT);
  const int lane = tid_ & 63, w = tid_ >> 6, fr = lane & 15, fq = lane >> 4;
  u16* Pw = (u16*)smem + w * (16 * 264);
  for (int t = blockIdx.x; t < (NTOK / 64) * 4; t += gridDim.x) {
    const int hh = t & 3;
    const size_t tok0 = (size_t)(t >> 2) * 64 + w * 16;
    const int s = (int)(tok0 >> 12);
    f32x4 acc[16];
#pragma unroll
    for (int n = 0; n < 16; ++n) acc[n] = (f32x4){0.f, 0.f, 0.f, 0.f};
#pragma unroll 2
    for (int ks = 0; ks < 8; ++ks) {
      bf16x8 aq = *(const bf16x8*)(Q + (tok0 + fr) * 1024 + hh * 256 + ks * 32 + fq * 8);
#pragma unroll
      for (int n = 0; n < 16; ++n) {
        bf16x8 bk = *(const bf16x8*)(KVK + (size_t)(s * 256 + n * 16 + fr) * 1024 + hh * 256 + ks * 32 + fq * 8);
        acc[n] = __builtin_amdgcn_mfma_f32_16x16x32_bf16(aq, bk, acc[n], 0, 0, 0);
      }
    }
    float sm[4];
#pragma unroll
    for (int j = 0; j < 4; ++j) {
      float m = -1e30f;
#pragma unroll
      for (int n = 0; n < 16; ++n) { acc[n][j] *= 0.0625f; m = fmaxf(m, acc[n][j]); }
      m = red16_max(m);
      float ssum = 0.f;
#pragma unroll
      for (int n = 0; n < 16; ++n) { const float e = __expf(acc[n][j] - m); acc[n][j] = e; ssum += e; }
      sm[j] = 1.f / red16_sum(ssum);
    }
    __syncthreads();
#pragma unroll
    for (int n = 0; n < 16; ++n)
#pragma unroll
      for (int j = 0; j < 4; ++j) Pw[(fq * 4 + j) * 264 + n * 16 + fr] = f2bf(acc[n][j]);
    __syncthreads();
#pragma unroll
    for (int n = 0; n < 16; ++n) acc[n] = (f32x4){0.f, 0.f, 0.f, 0.f};
#pragma unroll 2
    for (int ks = 0; ks < 8; ++ks) {
      bf16x8 ap = *(const bf16x8*)(Pw + fr * 264 + ks * 32 + fq * 8);
#pragma unroll
      for (int n = 0; n < 16; ++n) {
        bf16x8 bv = *(const bf16x8*)(KVT + (size_t)(s * 1024 + hh * 256 + n * 16 + fr) * 256 + ks * 32 + fq * 8);
        acc[n] = __builtin_amdgcn_mfma_f32_16x16x32_bf16(ap, bv, acc[n], 0, 0, 0);
      }
    }
#pragma unroll
    for (int n = 0; n < 16; ++n)
#pragma unroll
      for (int j = 0; j < 4; ++j)
        O[(tok0 + fq * 4 + j) * 1024 + hh * 256 + n * 16 + fr] = f2bf(acc[n][j] * sm[j]);
  }
}

DEVI void run_phase(int tid_, const Params& p, int ph, char* smem) {
  if (ph == 2 * NPH_LAYER) { phase_final_norm(tid_, p); return; }
  const int l = ph / NPH_LAYER, q = ph % NPH_LAYER;
  u16* WB = (u16*)(p.ws + OFF_WB);
  u16* H = (u16*)(p.ws + OFF_H);
  u16* PR = (u16*)(p.ws + OFF_PR);
  u16* NQ = (u16*)(p.ws + OFF_NQ);
  float* X = p.X;
  auto epi_res = [&](int r0, int c, f32x4 v) {
#pragma unroll
    for (int j = 0; j < 4; ++j) X[(size_t)(r0 + j) * 1024 + c] += v[j];
  };
  switch (q) {
    case 0:
      phase_conv(tid_, p, l, smem);
      phase_norm(tid_, p, p.in[I_NORM_MIX] + (size_t)l * 1024, l == 0);
      phase_norm_mem(tid_, p, p.in[I_NORM_MEM] + (size_t)l * 1024);
      break;
    case 1: phase_p_gemm(tid_, p, smem); break;
    case 2: phase_nat(tid_, p, l, smem); break;
    case 3: phase_scan(tid_, p, l, smem); break;
    case 4: phase_rwkv_post(tid_, p, l, smem); break;
    case 5: phase_merge(tid_, p, smem); break;
    case 6: gemm_phase(tid_, PR + 512, PRW, WB + W_OUT, 1024, 1024, NTOK, 1024, smem, epi_res); break;
    case 7: phase_norm(tid_, p, p.in[I_NORM_X] + (size_t)l * 1024, false); break;
    case 8:
      gemm_phase(tid_, H, 1024, WB + W_XQ, 1024, 1024, NTOK, 1024, smem, [&](int r0, int c, f32x4 v) {
#pragma unroll
        for (int j = 0; j < 4; ++j) PR[(size_t)(r0 + j) * 1024 + c] = f2bf(v[j]);
      });
      break;
    case 9: phase_xattn(tid_, p, smem); break;
    case 10: gemm_phase(tid_, NQ, 1024, WB + W_XO, 1024, 1024, NTOK, 1024, smem, epi_res); break;
    case 11: phase_norm(tid_, p, p.in[I_NORM_FF] + (size_t)l * 1024, false); break;
    case 12:
    case 14: {
      const int hf = (q == 14);
      gemm_phase(tid_, H, 1024, WB + W_FF1 + (size_t)hf * 2048 * 1024, 1024, 1024, NTOK, 2048, smem,
                 [&](int r0, int c, f32x4 v) {
#pragma unroll
                   for (int j = 0; j < 4; ++j) {
                     const float x = fmaxf(v[j], 0.f);
                     PR[(size_t)(r0 + j) * 2048 + c] = f2bf(x * x);
                   }
                 });
    } break;
    case 13:
    case 15: {
      const int hf = (q == 15);
      gemm_phase(tid_, PR, 2048, WB + W_FF2 + (size_t)hf * 2048, 4096, 2048, NTOK, 1024, smem, epi_res);
    } break;
  }
}


#define XB_TMO      128
#define XB_XCNT(j)  (256  + 64 * (j))
#define XB_XSUB(j)  (1280 + 64 * (j))
#define XB_XGEN(j)  (2304 + 64 * (j))
#define XB_TOP      3328
#define XB_TOPGEN   3392
#define XCD_BAR_WORDS 3456
#define XB_SPIN_CAP (1u << 20)
#define LAS __attribute__((address_space(3)))

DEVI unsigned xb_ld(unsigned* p) { return __hip_atomic_load(p, __ATOMIC_RELAXED, __HIP_MEMORY_SCOPE_AGENT); }
DEVI unsigned xb_add(unsigned* p, unsigned v) { return __hip_atomic_fetch_add(p, v, __ATOMIC_RELAXED, __HIP_MEMORY_SCOPE_AGENT); }
DEVI unsigned xb_xcc_id() { return (unsigned)__builtin_amdgcn_s_getreg((3 << 11) | 20) & 0xFu; }
#define XB_SPIN(cond, bar) do { unsigned _sp = 0; while (cond) { __builtin_amdgcn_s_sleep(1); \
    if ((++_sp & 255u) == 0u) { if (xb_ld(&(bar)[XB_TMO])) break; if (_sp > XB_SPIN_CAP) { atomicAdd(&(bar)[XB_TMO], 1u); break; } } } } while (0)

struct XcdBarrier {
  unsigned* bar; unsigned x;
  volatile LAS unsigned* st;
};
DEVI XcdBarrier xcd_barrier_post(unsigned* bar, volatile LAS unsigned* st) {
  XcdBarrier b; b.bar = bar; b.x = xb_xcc_id(); b.st = st;
  if (threadIdx.x == 0) (void)xb_add(&bar[XB_XCNT(b.x)], 1u);
  return b;
}
DEVI void xcd_barrier_complete(unsigned* bar, unsigned x, unsigned& nloc, unsigned& nx) {
  const unsigned G = gridDim.x * gridDim.y * gridDim.z;
  unsigned sum, cnt, mine, sp = 0u;
  for (;;) {
    sum = 0u; cnt = 0u; mine = 0u;
#pragma unroll
    for (unsigned j = 0; j < 16; ++j) { const unsigned c = xb_ld(&bar[XB_XCNT(j)]); sum += c; cnt += (c > 0u) ? 1u : 0u; mine = (j == x) ? c : mine; }
    if (sum == G) break;
    __builtin_amdgcn_s_sleep(1);
    if ((++sp & 255u) == 0u) { if (xb_ld(&bar[XB_TMO])) break; if (sp > XB_SPIN_CAP) { atomicAdd(&bar[XB_TMO], 1u); break; } }
  }
  nloc = mine > 0u ? mine : 1u; nx = cnt > 0u ? cnt : 1u;
}
DEVI void xcd_barrier(const XcdBarrier& b) {
  asm volatile("s_waitcnt vmcnt(0)" ::: "memory");
  __syncthreads();
  if (threadIdx.x == 0) {
    unsigned* bar = b.bar;
    __builtin_amdgcn_s_waitcnt(0);
    unsigned nloc = b.st[0], nx = b.st[1];
    if (nloc == 0u) { xcd_barrier_complete(bar, b.x, nloc, nx); b.st[0] = nloc; b.st[1] = nx; }
    const unsigned old = xb_add(&bar[XB_XSUB(b.x)], 1u);
    const unsigned gen = old / nloc;
    if (old + 1u == (gen + 1u) * nloc) {
      __builtin_amdgcn_fence(__ATOMIC_RELEASE, "agent");
      asm volatile("s_waitcnt vmcnt(0)" ::: "memory");
      const unsigned og = xb_add(&bar[XB_TOP], 1u);
      const unsigned tg = og / nx;
      if (og + 1u == (tg + 1u) * nx) xb_add(&bar[XB_TOPGEN], 1u);
      else XB_SPIN(xb_ld(&bar[XB_TOPGEN]) == tg, bar);
      __builtin_amdgcn_fence(__ATOMIC_ACQUIRE, "agent");
      xb_add(&bar[XB_XGEN(b.x)], 1u);
      asm volatile("s_waitcnt vmcnt(0)" ::: "memory");
    } else {
      XB_SPIN(xb_ld(&bar[XB_XGEN(b.x)]) == gen, bar);
      __builtin_amdgcn_fence(__ATOMIC_ACQUIRE, "agent");
      asm volatile("s_waitcnt vmcnt(0)" ::: "memory");
    }
  }
  __syncthreads();
}

__global__ void __launch_bounds__(256, 2) mega_kernel(Params p, int ph0, int ph1) {
  __shared__ __attribute__((aligned(16))) char smem[SMEM_BYTES];
  __shared__ __attribute__((aligned(16))) unsigned xb_words[4];
  if (threadIdx.x == 0) { xb_words[0] = 0u; xb_words[1] = 0u; xb_words[2] = 0u; xb_words[3] = 0u; }
  __syncthreads();
  XcdBarrier xb = xcd_barrier_post((unsigned*)(p.ws + OFF_BAR), (volatile LAS unsigned*)xb_words);
  for (int ph = ph0; ph < ph1; ++ph) {
    if (ph == ph0 + 1) cg::this_grid().sync();
    else if (ph > ph0) xcd_barrier(xb);
    int tid_ = threadIdx.x;
    asm volatile("" : "+v"(tid_));
    run_phase(tid_, p, ph, smem);
  }
}

extern "C" void kernel_launch(void* const* d_in, const int* in_sizes, int n_in, void* d_out, int out_size, void* d_ws,
                              size_t ws_size, hipStream_t stream) {
  if (ws_size < WS_NEED || n_in < 31) return;
  Params p{};
  for (int i = 0; i < 31; ++i) p.in[i] = (const float*)d_in[i];
  p.X = (float*)d_out;
  p.ws = (char*)d_ws;
  static int grid_blocks = 0;
  if (!grid_blocks) {
    int dev = 0, cus = 0, per_cu = 0;
    hipGetDevice(&dev);
    hipDeviceGetAttribute(&cus, hipDeviceAttributeMultiprocessorCount, dev);
    hipOccupancyMaxActiveBlocksPerMultiprocessor(&per_cu, mega_kernel, 256, 0);
    if (per_cu > 2) per_cu = 2;
    if (per_cu < 1) per_cu = 1;
    grid_blocks = cus * per_cu;
  }
  hipMemsetAsync((char*)d_ws + OFF_BAR, 0, 16384, stream);
  int ph0 = 0, ph1 = NPHASES;
  void* args[] = {&p, &ph0, &ph1};
  hipLaunchCooperativeKernel((void*)mega_kernel, dim3(grid_blocks), dim3(256), args, 0, stream);
}
```

```cpp
#include <hip/hip_runtime.h>
#include <hip/hip_cooperative_groups.h>
#include <stdint.h>
namespace cg = cooperative_groups;

typedef unsigned short u16;
typedef __attribute__((ext_vector_type(8))) short bf16x8;
typedef __attribute__((ext_vector_type(4))) float f32x4;
typedef __attribute__((ext_vector_type(8))) _Float16 h16x8;
typedef __attribute__((ext_vector_type(4))) unsigned int u32x4;
typedef __attribute__((ext_vector_type(2))) unsigned int u32x2;

#define DEVI __device__ __forceinline__

constexpr int NTOK = 49152;
constexpr int SEQ_T = 4096;
constexpr int PRW = 1920;
constexpr int NPH_LAYER = 16;
constexpr int NPHASES = 2 * NPH_LAYER + 1;
constexpr int SMEM_BYTES = 78720;

constexpr size_t OFF_WB = 0;
constexpr size_t WB_BYTES = 20512768ull * 2;
constexpr size_t OFF_H = OFF_WB + WB_BYTES;
constexpr size_t OFF_PR = OFF_H + (size_t)NTOK * 1024 * 2;
constexpr size_t OFF_NQ = OFF_PR + (size_t)NTOK * PRW * 2;
constexpr size_t OFF_NK = OFF_NQ + (size_t)NTOK * 512 * 2;
constexpr size_t OFF_NV = OFF_NK + (size_t)NTOK * 512 * 2;
constexpr size_t OFF_KVK = OFF_NV + (size_t)NTOK * 512 * 2;
constexpr size_t OFF_KVT = OFF_KVK + (size_t)3072 * 1024 * 2;
constexpr size_t OFF_MEMH = OFF_KVT + (size_t)3072 * 1024 * 2;
constexpr size_t OFF_BONUS = OFF_MEMH + (size_t)3072 * 1024 * 2;
constexpr size_t OFF_BAR = OFF_BONUS + (size_t)NTOK * 16 * 4;
constexpr size_t WS_NEED = OFF_BAR + 16384;

constexpr size_t W_IN = 0;
constexpr size_t W_BRR = W_IN + (size_t)5504 * 1024;
constexpr size_t W_BRN = W_BRR + (size_t)1024 * 512;
constexpr size_t W_OUT = W_BRN + (size_t)1024 * 512;
constexpr size_t W_XQ = W_OUT + (size_t)1024 * 1024;
constexpr size_t W_XKV = W_XQ + (size_t)1024 * 1024;
constexpr size_t W_XO = W_XKV + (size_t)2048 * 1024;
constexpr size_t W_FF1 = W_XO + (size_t)1024 * 1024;
constexpr size_t W_FF2 = W_FF1 + (size_t)4096 * 1024;
constexpr size_t W_GUP = W_FF2 + (size_t)4096 * 1024;
constexpr size_t W_WUP = W_GUP + (size_t)512 * 128;
constexpr size_t W_AUP = W_WUP + (size_t)2 * 512 * 64;

enum { I_XP = 0, I_XS, I_MP, I_MS, I_NORM_MIX, I_W_IN, I_MU_PREV, I_MU_NEXT, I_W0, I_W_UP, I_A0, I_A_UP,
       I_G_UP, I_K_K, I_K_A, I_R_K, I_GN_G, I_GN_B, I_RPB, I_W_BR_RWKV, I_W_BR_NAT, I_W_OUT, I_NORM_X,
       I_NORM_MEM, I_W_XQ, I_W_XKV, I_W_XO, I_NORM_FF, I_W_FF1, I_W_FF2, I_NORM_FINAL };

struct Params {
  const float* in[31];
  float* X;
  char* ws;
};

DEVI u16 f2bf(float f) {
  uint32_t u = __float_as_uint(f);
  u += 0x7FFFu + ((u >> 16) & 1u);
  return (u16)(u >> 16);
}
DEVI float bf2f(u16 h) { return __uint_as_float(((uint32_t)h) << 16); }
DEVI uint32_t pack2(float a, float b) { return (uint32_t)f2bf(a) | ((uint32_t)f2bf(b) << 16); }
DEVI float sigm(float x) { return 1.f / (1.f + __expf(-x)); }
DEVI void unpack8(u32x4 u, float* o) {
  o[0] = __uint_as_float(u.x << 16); o[1] = __uint_as_float(u.x & 0xffff0000u);
  o[2] = __uint_as_float(u.y << 16); o[3] = __uint_as_float(u.y & 0xffff0000u);
  o[4] = __uint_as_float(u.z << 16); o[5] = __uint_as_float(u.z & 0xffff0000u);
  o[6] = __uint_as_float(u.w << 16); o[7] = __uint_as_float(u.w & 0xffff0000u);
}
DEVI void load8bf(const u16* p, float* o) { unpack8(*(const u32x4*)p, o); }
DEVI float wave_sum(float v) {
  v += __shfl_xor(v, 32); v += __shfl_xor(v, 16); v += __shfl_xor(v, 8);
  v += __shfl_xor(v, 4); v += __shfl_xor(v, 2); v += __shfl_xor(v, 1);
  return v;
}
DEVI float red16_sum(float v) {
  v += __shfl_xor(v, 1); v += __shfl_xor(v, 2); v += __shfl_xor(v, 4); v += __shfl_xor(v, 8);
  return v;
}
DEVI float red16_max(float v) {
  v = fmaxf(v, __shfl_xor(v, 1)); v = fmaxf(v, __shfl_xor(v, 2));
  v = fmaxf(v, __shfl_xor(v, 4)); v = fmaxf(v, __shfl_xor(v, 8));
  return v;
}

DEVI void conv_tile(int tid_, const float* src, int K, int N, u16* dst, int tile, char* smem) {
  float (*s)[65] = (float (*)[65])smem;
  const int nN = N >> 6;
  const int tk = tile / nN, tn = tile - tk * nN;
  const int tx = tid_ & 63, ty = tid_ >> 6;
  for (int r = ty; r < 64; r += 4) s[r][tx] = src[(size_t)(tk * 64 + r) * N + tn * 64 + tx];
  __syncthreads();
  for (int r = ty; r < 64; r += 4) dst[(size_t)(tn * 64 + r) * K + tk * 64 + tx] = f2bf(s[tx][r]);
  __syncthreads();
}

DEVI void phase_conv(int tid_, const Params& p, int l, char* smem) {
  u16* WB = (u16*)(p.ws + OFF_WB);
  const int c0 = 1376, c1 = c0 + 128, c2 = c1 + 128, c3 = c2 + 256, c4 = c3 + 256, c5 = c4 + 512,
            c6 = c5 + 256, c7 = c6 + 1024, c8 = c7 + 1024, c9 = c8 + 16, c10 = c9 + 16, c11 = c10 + 16;
  for (int t = blockIdx.x; t < c11; t += gridDim.x) {
    if (t < c0) conv_tile(tid_, p.in[I_W_IN] + (size_t)l * 1024 * 5504, 1024, 5504, WB + W_IN, t, smem);
    else if (t < c1) conv_tile(tid_, p.in[I_W_BR_RWKV] + (size_t)l * 512 * 1024, 512, 1024, WB + W_BRR, t - c0, smem);
    else if (t < c2) conv_tile(tid_, p.in[I_W_BR_NAT] + (size_t)l * 512 * 1024, 512, 1024, WB + W_BRN, t - c1, smem);
    else if (t < c3) conv_tile(tid_, p.in[I_W_OUT] + (size_t)l * 1024 * 1024, 1024, 1024, WB + W_OUT, t - c2, smem);
    else if (t < c4) conv_tile(tid_, p.in[I_W_XQ] + (size_t)l * 1024 * 1024, 1024, 1024, WB + W_XQ, t - c3, smem);
    else if (t < c5) conv_tile(tid_, p.in[I_W_XKV] + (size_t)l * 1024 * 2048, 1024, 2048, WB + W_XKV, t - c4, smem);
    else if (t < c6) conv_tile(tid_, p.in[I_W_XO] + (size_t)l * 1024 * 1024, 1024, 1024, WB + W_XO, t - c5, smem);
    else if (t < c7) conv_tile(tid_, p.in[I_W_FF1] + (size_t)l * 1024 * 4096, 1024, 4096, WB + W_FF1, t - c6, smem);
    else if (t < c8) conv_tile(tid_, p.in[I_W_FF2] + (size_t)l * 4096 * 1024, 4096, 1024, WB + W_FF2, t - c7, smem);
    else if (t < c9) conv_tile(tid_, p.in[I_G_UP] + (size_t)l * 128 * 512, 128, 512, WB + W_GUP, t - c8, smem);
    else if (t < c10) { const int dd = (t - c9) >> 3; conv_tile(tid_, p.in[I_W_UP] + (size_t)(l * 2 + dd) * 64 * 512, 64, 512, WB + W_WUP + (size_t)dd * 512 * 64, (t - c9) & 7, smem); }
    else { const int dd = (t - c10) >> 3; conv_tile(tid_, p.in[I_A_UP] + (size_t)(l * 2 + dd) * 64 * 512, 64, 512, WB + W_AUP + (size_t)dd * 512 * 64, (t - c10) & 7, smem); }
  }
}

DEVI void norm_row_bf16(int tid_, const float* src, const float* g, u16* dst, float* xcopy) {
  const int lane = tid_ & 63;
  float4 v[4];
  float ss = 0.f;
#pragma unroll
  for (int i = 0; i < 4; ++i) {
    v[i] = ((const float4*)src)[lane + i * 64];
    ss += v[i].x * v[i].x + v[i].y * v[i].y + v[i].z * v[i].z + v[i].w * v[i].w;
  }
  ss = wave_sum(ss);
  const float rs = rsqrtf(ss * (1.f / 1024.f) + 1e-6f);
#pragma unroll
  for (int i = 0; i < 4; ++i) {
    float4 gg = ((const float4*)g)[lane + i * 64];
    u32x2 o;
    o.x = pack2(v[i].x * rs * gg.x, v[i].y * rs * gg.y);
    o.y = pack2(v[i].z * rs * gg.z, v[i].w * rs * gg.w);
    ((u32x2*)dst)[lane + i * 64] = o;
    if (xcopy) ((float4*)xcopy)[lane + i * 64] = v[i];
  }
}

DEVI void phase_norm(int tid_, const Params& p, const float* g, bool from_input) {
  u16* H = (u16*)(p.ws + OFF_H);
  const int wid = tid_ >> 6;
  for (int r = blockIdx.x * 4 + wid; r < NTOK; r += gridDim.x * 4) {
    const float* src;
    if (from_input) src = (r < 32768) ? p.in[I_XP] + (size_t)r * 1024 : p.in[I_XS] + (size_t)(r - 32768) * 1024;
    else src = p.X + (size_t)r * 1024;
    norm_row_bf16(tid_, src, g, H + (size_t)r * 1024, from_input ? p.X + (size_t)r * 1024 : nullptr);
  }
}
DEVI void phase_norm_mem(int tid_, const Params& p, const float* g) {
  u16* MH = (u16*)(p.ws + OFF_MEMH);
  const int wid = tid_ >> 6;
  for (int r = blockIdx.x * 4 + wid; r < 3072; r += gridDim.x * 4) {
    const float* src = (r < 2048) ? p.in[I_MP] + (size_t)r * 1024 : p.in[I_MS] + (size_t)(r - 2048) * 1024;
    norm_row_bf16(tid_, src, g, MH + (size_t)r * 1024, nullptr);
  }
}
DEVI void phase_final_norm(int tid_, const Params& p) {
  const float* g = p.in[I_NORM_FINAL];
  const int wid = tid_ >> 6, lane = tid_ & 63;
  for (int r = blockIdx.x * 4 + wid; r < NTOK; r += gridDim.x * 4) {
    float* row = p.X + (size_t)r * 1024;
    float4 v[4];
    float ss = 0.f;
#pragma unroll
    for (int i = 0; i < 4; ++i) {
      v[i] = ((const float4*)row)[lane + i * 64];
      ss += v[i].x * v[i].x + v[i].y * v[i].y + v[i].z * v[i].z + v[i].w * v[i].w;
    }
    ss = wave_sum(ss);
    const float rs = rsqrtf(ss * (1.f / 1024.f) + 1e-6f);
#pragma unroll
    for (int i = 0; i < 4; ++i) {
      float4 gg = ((const float4*)g)[lane + i * 64];
      float4 o;
      o.x = v[i].x * rs * gg.x; o.y = v[i].y * rs * gg.y; o.z = v[i].z * rs * gg.z; o.w = v[i].w * rs * gg.w;
      ((float4*)row)[lane + i * 64] = o;
    }
  }
}

template <int NW, bool SWAP>
DEVI void gemm_kloop(int tid_, f32x4 (&acc)[4][NW], const u16* __restrict__ A, int lda, const u16* __restrict__ Bt, int ldb,
                     int K, char* smem) {
  constexpr int BUFSZ = 16384 + NW * 4096;
  const int tid = tid_, lane = tid & 63, wid = tid >> 6;
  const int wr = wid >> 1, wc = wid & 1, fr = lane & 15, fq = lane >> 4;
  const int lrow = lane >> 3, lphys = lane & 7, lhi = lane >> 4;
  const u16* ga[4];
  const u16* gb[NW];
#pragma unroll
  for (int q = 0; q < 4; ++q) {
    const int kc = lphys ^ (4 * (q & 1) + lhi);
    ga[q] = A + (size_t)((wid * 4 + q) * 8 + lrow) * lda + kc * 8;
  }
#pragma unroll
  for (int q = 0; q < NW; ++q) {
    const int kc = lphys ^ (4 * (q & 1) + lhi);
    gb[q] = Bt + (size_t)((wid * NW + q) * 8 + lrow) * ldb + kc * 8;
  }
  const int swz = (fr >> 1) & 7;
  __syncthreads();
#pragma unroll
  for (int q = 0; q < 4; ++q)
    __builtin_amdgcn_global_load_lds((const unsigned*)ga[q], (__attribute__((address_space(3))) unsigned*)(smem + (wid * 4 + q) * 1024 + lane * 16), 16, 0, 0);
#pragma unroll
  for (int q = 0; q < NW; ++q)
    __builtin_amdgcn_global_load_lds((const unsigned*)gb[q], (__attribute__((address_space(3))) unsigned*)(smem + 16384 + (wid * NW + q) * 1024 + lane * 16), 16, 0, 0);
  const int nk = K >> 6;
  for (int kt = 0; kt < nk; ++kt) {
    asm volatile("s_waitcnt vmcnt(0)" ::: "memory");
    __syncthreads();
    if (kt + 1 < nk) {
      char* nb = smem + ((kt + 1) & 1) * BUFSZ;
#pragma unroll
      for (int q = 0; q < 4; ++q)
        __builtin_amdgcn_global_load_lds((const unsigned*)(ga[q] + (kt + 1) * 64), (__attribute__((address_space(3))) unsigned*)(nb + (wid * 4 + q) * 1024 + lane * 16), 16, 0, 0);
#pragma unroll
      for (int q = 0; q < NW; ++q)
        __builtin_amdgcn_global_load_lds((const unsigned*)(gb[q] + (kt + 1) * 64), (__attribute__((address_space(3))) unsigned*)(nb + 16384 + (wid * NW + q) * 1024 + lane * 16), 16, 0, 0);
    }
    const char* sA = smem + (kt & 1) * BUFSZ;
    const char* sB = sA + 16384;
#pragma unroll
    for (int ks = 0; ks < 2; ++ks) {
      bf16x8 af[4], bfr[NW];
      const int ch = ((ks * 4 + fq) ^ swz) * 16;
#pragma unroll
      for (int m = 0; m < 4; ++m) af[m] = *(const bf16x8*)(sA + (wr * 64 + m * 16 + fr) * 128 + ch);
#pragma unroll
      for (int n = 0; n < NW; ++n) bfr[n] = *(const bf16x8*)(sB + (wc * 16 * NW + n * 16 + fr) * 128 + ch);
#pragma unroll
      for (int m = 0; m < 4; ++m)
#pragma unroll
        for (int n = 0; n < NW; ++n) {
          if (SWAP) acc[m][n] = __builtin_amdgcn_mfma_f32_16x16x32_bf16(bfr[n], af[m], acc[m][n], 0, 0, 0);
          else acc[m][n] = __builtin_amdgcn_mfma_f32_16x16x32_bf16(af[m], bfr[n], acc[m][n], 0, 0, 0);
        }
    }
  }
}

DEVI int launder(int x) { asm volatile("" : "+v"(x)); return x; }

template <int NW>
DEVI void zero_acc(f32x4 (&acc)[4][NW]) {
#pragma unroll
  for (int m = 0; m < 4; ++m)
#pragma unroll
    for (int n = 0; n < NW; ++n) acc[m][n] = (f32x4){0.f, 0.f, 0.f, 0.f};
}

struct NoEpi { DEVI void operator()(int, int, f32x4) const {} };

template <class EpiS, class EpiN>
DEVI void gemm_phase(int tid_, const u16* A, int lda, const u16* Bt, int ldb, int K, int M, int N, char* smem, int ns_from,
                     EpiS epiS, EpiN epiN) {
  const int nN = N >> 7, nM = M >> 7;
  const int lane = tid_ & 63, wid = tid_ >> 6;
  const int wr = wid >> 1, wc = wid & 1, fr = lane & 15, fq = lane >> 4;
  for (int t = blockIdx.x; t < nM * nN; t += gridDim.x) {
    const int tm = t / nN, tn = t - tm * nN;
    const int m0 = tm << 7, n0 = tn << 7;
    f32x4 acc[4][4];
    zero_acc(acc);
    if (n0 < ns_from) {
      gemm_kloop<4, true>(tid_, acc, A + (size_t)m0 * lda, lda, Bt + (size_t)n0 * ldb, ldb, K, smem);
#pragma unroll
      for (int m = 0; m < 4; ++m)
#pragma unroll
        for (int n = 0; n < 4; ++n) epiS(m0 + wr * 64 + m * 16 + fr, n0 + wc * 64 + n * 16 + fq * 4, acc[m][n]);
    } else {
      gemm_kloop<4, false>(tid_, acc, A + (size_t)m0 * lda, lda, Bt + (size_t)n0 * ldb, ldb, K, smem);
#pragma unroll
      for (int m = 0; m < 4; ++m)
#pragma unroll
        for (int n = 0; n < 4; ++n) epiN(m0 + wr * 64 + m * 16 + fq * 4, n0 + wc * 64 + n * 16 + fr, acc[m][n]);
    }
  }
}

DEVI void store4bf(u16* dst, f32x4 v) {
  u32x2 o;
  o.x = pack2(v[0], v[1]); o.y = pack2(v[2], v[3]);
  *(u32x2*)dst = o;
}

DEVI void phase_p_gemm(int tid_, const Params& p, char* smem) {
  u16* WB = (u16*)(p.ws + OFF_WB);
  const u16* H = (const u16*)(p.ws + OFF_H);
  u16* PR = (u16*)(p.ws + OFF_PR);
  u16* NQ = (u16*)(p.ws + OFF_NQ);
  u16* NK = (u16*)(p.ws + OFF_NK);
  u16* NVT = (u16*)(p.ws + OFF_NV);
  gemm_phase(tid_, H, 1024, WB + W_IN, 1024, 1024, NTOK, 3456, smem, 2944,
    [&](int r, int c0, f32x4 v) {
      if (c0 < 1920) store4bf(PR + (size_t)r * PRW + c0, v);
      else if (c0 < 2432) store4bf(NQ + (size_t)r * 512 + (c0 - 1920), v);
      else store4bf(NK + (size_t)r * 512 + (c0 - 2432), v);
    },
    [&](int r0, int c, f32x4 v) {
      const int cc = c - 2944;
      const int s = r0 >> 12, t = r0 & 4095;
      store4bf(NVT + ((size_t)(s * 512 + cc)) * 4096 + t, v);
    });
  const u16* MH = (const u16*)(p.ws + OFF_MEMH);
  u16* KVK = (u16*)(p.ws + OFF_KVK);
  u16* KVT = (u16*)(p.ws + OFF_KVT);
  gemm_phase(tid_, MH, 1024, WB + W_XKV, 1024, 1024, 3072, 2048, smem, 1024,
    [&](int r, int c0, f32x4 v) { store4bf(KVK + (size_t)r * 1024 + c0, v); },
    [&](int r0, int c, f32x4 v) {
      const int cc = c - 1024;
      const int s = r0 >> 8, m = r0 & 255;
      store4bf(KVT + ((size_t)(s * 1024 + cc)) * 256 + m, v);
    });
}

DEVI void phase_nat(int tid_, const Params& p, int l, char* smem) {
  u16* NQ = (u16*)(p.ws + OFF_NQ);
  const u16* NK = (const u16*)(p.ws + OFF_NK);
  const u16* NVT = (const u16*)(p.ws + OFF_NV);
  const float* rpb = p.in[I_RPB] + (size_t)l * 8 * 15 * 31;
  const int lane = tid_ & 63, g = tid_ >> 6, fr = lane & 15, fq = lane >> 4;
  u16* Pw = (u16*)smem + g * (16 * 264);
  const int cb = (g == 0) ? 0 : (g == 1) ? 8 : (g == 2) ? 24 : 32;
  for (int t = blockIdx.x; t < 12 * 64 * 8; t += gridDim.x) {
    const int h = t & 7, ri = (t >> 3) & 63, s = t >> 9;
    int rs = ri - 4; rs = rs < 0 ? 0 : (rs > 56 ? 56 : rs);
    const size_t tokq = (size_t)s * 4096 + ri * 64 + g * 16;
    bf16x8 aq[2];
    aq[0] = *(const bf16x8*)(NQ + (tokq + fr) * 512 + h * 64 + fq * 8);
    aq[1] = *(const bf16x8*)(NQ + (tokq + fr) * 512 + h * 64 + 32 + fq * 8);
    f32x4 acc[16];
#pragma unroll
    for (int n = 0; n < 16; ++n) {
      acc[n] = (f32x4){0.f, 0.f, 0.f, 0.f};
      const int r = n >> 1, col = cb + (n & 1) * 16 + fr;
      const u16* kp = NK + ((size_t)s * 4096 + (rs + r) * 64 + col) * 512 + h * 64 + fq * 8;
      bf16x8 b0 = *(const bf16x8*)kp;
      bf16x8 b1 = *(const bf16x8*)(kp + 32);
      acc[n] = __builtin_amdgcn_mfma_f32_16x16x32_bf16(aq[0], b0, acc[n], 0, 0, 0);
      acc[n] = __builtin_amdgcn_mfma_f32_16x16x32_bf16(aq[1], b1, acc[n], 0, 0, 0);
    }
    float mx[4], sm[4];
#pragma unroll
    for (int j = 0; j < 4; ++j) {
      const int c = g * 16 + fq * 4 + j;
      int cs = c - 8; cs = cs < 0 ? 0 : (cs > 48 ? 48 : cs);
      float m = -1e30f;
#pragma unroll
      for (int n = 0; n < 16; ++n) {
        const int r = n >> 1, kc = cb + (n & 1) * 16 + fr;
        const bool valid = (kc >= cs) && (kc < cs + 16);
        float sc = -1e30f;
        if (valid) {
          const int di = rs + r - ri + 7, dj = kc - c + 15;
          sc = acc[n][j] * 0.125f + rpb[(h * 15 + di) * 31 + dj];
        }
        acc[n][j] = sc;
        m = fmaxf(m, sc);
      }
      mx[j] = red16_max(m);
    }
#pragma unroll
    for (int j = 0; j < 4; ++j) {
      float ssum = 0.f;
#pragma unroll
      for (int n = 0; n < 16; ++n) {
        float e = __expf(acc[n][j] - mx[j]);
        acc[n][j] = e;
        ssum += e;
      }
      sm[j] = 1.f / red16_sum(ssum);
    }
    __syncthreads();
#pragma unroll
    for (int n = 0; n < 16; ++n)
#pragma unroll
      for (int j = 0; j < 4; ++j) Pw[(fq * 4 + j) * 264 + n * 16 + fr] = f2bf(acc[n][j]);
    __syncthreads();
    f32x4 o[4];
#pragma unroll
    for (int n = 0; n < 4; ++n) o[n] = (f32x4){0.f, 0.f, 0.f, 0.f};
#pragma unroll
    for (int ks = 0; ks < 8; ++ks) {
      bf16x8 ap = *(const bf16x8*)(Pw + fr * 264 + ks * 32 + fq * 8);
#pragma unroll
      for (int n = 0; n < 4; ++n) {
        bf16x8 bv = *(const bf16x8*)(NVT + ((size_t)(s * 512 + h * 64 + n * 16 + fr)) * 4096 + (rs + ks) * 64 + cb + fq * 8);
        o[n] = __builtin_amdgcn_mfma_f32_16x16x32_bf16(ap, bv, o[n], 0, 0, 0);
      }
    }
#pragma unroll
    for (int n = 0; n < 4; ++n)
#pragma unroll
      for (int j = 0; j < 4; ++j)
        NQ[(tokq + fq * 4 + j) * 512 + h * 64 + n * 16 + fr] = f2bf(o[n][j] * sm[j]);
  }
}

constexpr int SC_OPS = 0;
constexpr int SC_VV = 40960;
constexpr int SC_WR = 49152;
constexpr int SC_AP = 57344;
constexpr int SC_TW = 65536;
constexpr int SC_AD = 70144;
constexpr int SC_NRM = 74752;
constexpr int SC_MU = 74880;
constexpr int SC_CST = 77440;

typedef __attribute__((ext_vector_type(2))) float f32x2;

template <int CTRL>
DEVI float dpp_mov(float x) {
  return __int_as_float(__builtin_amdgcn_update_dpp(0, __float_as_int(x), CTRL, 0xF, 0xF, true));
}
DEVI float red8(float x) {
  x += dpp_mov<0xB1>(x);
  x += dpp_mov<0x4E>(x);
  x += dpp_mov<0x141>(x);
  return x;
}
DEVI f32x2 lo2(f32x4 v) { return __builtin_shufflevector(v, v, 0, 1); }
DEVI f32x2 hi2(f32x4 v) { return __builtin_shufflevector(v, v, 2, 3); }

struct ScanOps {
  f32x2 a[4], w[4], b[4], k[4], r[4];
  float v0, v1;
};
DEVI void scan_load(ScanOps& o, const float* OPS, const float* VV, int nn, int jg, int i0) {
  const float* base = OPS + nn * 64 + jg * 8;
  f32x4 t0, t1;
  t0 = *(const f32x4*)(base); t1 = *(const f32x4*)(base + 4);
  o.a[0] = lo2(t0); o.a[1] = hi2(t0); o.a[2] = lo2(t1); o.a[3] = hi2(t1);
  t0 = *(const f32x4*)(base + 2048); t1 = *(const f32x4*)(base + 2048 + 4);
  o.w[0] = lo2(t0); o.w[1] = hi2(t0); o.w[2] = lo2(t1); o.w[3] = hi2(t1);
  t0 = *(const f32x4*)(base + 4096); t1 = *(const f32x4*)(base + 4096 + 4);
  o.b[0] = lo2(t0); o.b[1] = hi2(t0); o.b[2] = lo2(t1); o.b[3] = hi2(t1);
  t0 = *(const f32x4*)(base + 6144); t1 = *(const f32x4*)(base + 6144 + 4);
  o.k[0] = lo2(t0); o.k[1] = hi2(t0); o.k[2] = lo2(t1); o.k[3] = hi2(t1);
  t0 = *(const f32x4*)(base + 8192); t1 = *(const f32x4*)(base + 8192 + 4);
  o.r[0] = lo2(t0); o.r[1] = hi2(t0); o.r[2] = lo2(t1); o.r[3] = hi2(t1);
  o.v0 = VV[nn * 64 + i0];
  o.v1 = VV[nn * 64 + i0 + 8];
}
DEVI void scan_step(const ScanOps& o, f32x2 (&S0)[4], f32x2 (&S1)[4], float* YL, int nn, int jg, int i0) {
  f32x2 d0 = S0[0] * o.a[0], d0b = S0[2] * o.a[2];
  f32x2 d1 = S1[0] * o.a[0], d1b = S1[2] * o.a[2];
  d0 = S0[1] * o.a[1] + d0; d0b = S0[3] * o.a[3] + d0b;
  d1 = S1[1] * o.a[1] + d1; d1b = S1[3] * o.a[3] + d1b;
  d0 += d0b; d1 += d1b;
  const float sa0 = red8(d0.x + d0.y);
  const float sa1 = red8(d1.x + d1.y);
  f32x2 e0 = {0.f, 0.f}, e1 = {0.f, 0.f};
#pragma unroll
  for (int q = 0; q < 4; ++q) {
    const f32x2 u0 = sa0 * o.b[q] + o.v0 * o.k[q];
    const f32x2 u1 = sa1 * o.b[q] + o.v1 * o.k[q];
    S0[q] = S0[q] * o.w[q] + u0;
    S1[q] = S1[q] * o.w[q] + u1;
    e0 = S0[q] * o.r[q] + e0;
    e1 = S1[q] * o.r[q] + e1;
  }
  const float y0 = red8(e0.x + e0.y);
  const float y1 = red8(e1.x + e1.y);
  if (jg == 0) { YL[nn * 64 + i0] = y0; YL[nn * 64 + i0 + 8] = y1; }
}

DEVI void phase_scan(int tid_, const Params& p, int l, char* smem) {
  const u16* PR = (const u16*)(p.ws + OFF_PR);
  _Float16* YF = (_Float16*)(p.ws + OFF_NK);
  _Float16* YB = (_Float16*)(p.ws + OFF_NV);
  float* BON = (float*)(p.ws + OFF_BONUS);
  const u16* WB = (const u16*)(p.ws + OFF_WB);
  float* OPS = (float*)(smem + SC_OPS);
  u16* RAW = (u16*)(smem + SC_OPS);
  float* VV = (float*)(smem + SC_VV);
  float* WR = (float*)(smem + SC_WR);
  float* AP = (float*)(smem + SC_AP);
  float* YL = WR;
  u16* TWb = (u16*)(smem + SC_TW);
  u16* ADb = (u16*)(smem + SC_AD);
  float* NRM = (float*)(smem + SC_NRM);
  float* MU = (float*)(smem + SC_MU);
  float* CST = (float*)(smem + SC_CST);
  const float* mu_p = p.in[I_MU_PREV] + (size_t)l * 1920;
  const float* mu_n = p.in[I_MU_NEXT] + (size_t)l * 1920;
  const int tid = tid_, lane = tid & 63, w = tid >> 6, fr = lane & 15, fq = lane >> 4;
  const int pn = tid >> 3, j0 = (tid & 7) * 8;
  const int jg = lane & 7, i0 = w * 16 + (lane >> 3);
  const int hr = (tid >= 40) ? 1 : 0, hc = tid - hr * 40;
  for (int blk = blockIdx.x; blk < 192; blk += gridDim.x) {
    const int s = blk >> 4, h = (blk >> 1) & 7, d = blk & 1;
    __syncthreads();
    for (int i = tid; i < 640; i += 256) {
      const int which = (i >= 320) ? 1 : 0, c = i - which * 320;
      const int g = c >> 6, e = c & 63;
      const int col = (g < 3) ? (g * 512 + h * 64 + e) : (1536 + (g - 3) * 128 + d * 64 + e);
      MU[i] = which ? mu_n[col] : mu_p[col];
    }
    for (int i = tid; i < 320; i += 256) {
      const int which = i >> 6, e = i & 63;
      float v;
      if (which == 0) v = p.in[I_W0][(size_t)(l * 2 + d) * 512 + h * 64 + e];
      else if (which == 1) v = p.in[I_A0][(size_t)(l * 2 + d) * 512 + h * 64 + e];
      else if (which == 2) v = p.in[I_K_K][(size_t)l * 512 + h * 64 + e];
      else if (which == 3) v = p.in[I_K_A][(size_t)l * 512 + h * 64 + e];
      else v = p.in[I_R_K][(size_t)(l * 8 + h) * 64 + e];
      CST[i] = v;
    }
    bf16x8 bw[2], ba[2];
#pragma unroll
    for (int ks = 0; ks < 2; ++ks) {
      bw[ks] = *(const bf16x8*)(WB + W_WUP + (size_t)(d * 512 + h * 64 + w * 16 + fr) * 64 + ks * 32 + fq * 8);
      ba[ks] = *(const bf16x8*)(WB + W_AUP + (size_t)(d * 512 + h * 64 + w * 16 + fr) * 64 + ks * 32 + fq * 8);
    }
    _Float16* Y = d ? YB : YF;
    f32x2 S0[4], S1[4];
#pragma unroll
    for (int q = 0; q < 4; ++q) { S0[q] = (f32x2){0.f, 0.f}; S1[q] = (f32x2){0.f, 0.f}; }
    u32x4 G[5], GH;
    {
      const int t = d ? (4095 - pn) : pn;
      const size_t tok = (size_t)s * 4096 + t;
#pragma unroll
      for (int g = 0; g < 5; ++g) {
        const int col = (g < 3) ? (g * 512 + h * 64) : (1536 + (g - 3) * 128 + d * 64);
        G[g] = *(const u32x4*)(PR + tok * PRW + col + j0);
      }
      GH = (u32x4){0u, 0u, 0u, 0u};
      if (tid < 80) {
        const int tlo = d ? (4095 - 31) : 0;
        const int th = hr ? (tlo + 32) : (tlo - 1);
        const int g = hc >> 3;
        const int col = (g < 3) ? (g * 512 + h * 64) : (1536 + (g - 3) * 128 + d * 64);
        if (th >= 0 && th <= 4095) GH = *(const u32x4*)(PR + ((size_t)s * 4096 + th) * PRW + col + (hc & 7) * 8);
      }
    }
#pragma unroll 1
    for (int ch = 0; ch < 128; ++ch) {
      const int n = ch * 32 + pn;
      const int t = d ? (4095 - n) : n;
      const size_t tok = (size_t)s * 4096 + t;
      const int tlo = d ? (4095 - (ch * 32 + 31)) : (ch * 32);
      const int rrow = t - tlo + 1;
#pragma unroll
      for (int g = 0; g < 5; ++g) *(u32x4*)(RAW + rrow * 320 + g * 64 + j0) = G[g];
      if (tid < 80) *(u32x4*)(RAW + (hr ? 33 : 0) * 320 + (hc >> 3) * 64 + (hc & 7) * 8) = GH;
      __syncthreads();
      if (ch + 1 < 128) {
        const int n2 = n + 32;
        const int t2 = d ? (4095 - n2) : n2;
        const size_t tok2 = (size_t)s * 4096 + t2;
#pragma unroll
        for (int g = 0; g < 5; ++g) {
          const int col = (g < 3) ? (g * 512 + h * 64) : (1536 + (g - 3) * 128 + d * 64);
          G[g] = *(const u32x4*)(PR + tok2 * PRW + col + j0);
        }
        GH = (u32x4){0u, 0u, 0u, 0u};
        if (tid < 80) {
          const int tlo2 = d ? (tlo - 32) : (tlo + 32);
          const int th = hr ? (tlo2 + 32) : (tlo2 - 1);
          const int g = hc >> 3;
          const int col = (g < 3) ? (g * 512 + h * 64) : (1536 + (g - 3) * 128 + d * 64);
          if (th >= 0 && th <= 4095) GH = *(const u32x4*)(PR + ((size_t)s * 4096 + th) * PRW + col + (hc & 7) * 8);
        }
      }
#pragma unroll
      for (int g = 0; g < 5; ++g) {
        float cur[8], prv[8], nxt[8];
        load8bf(RAW + rrow * 320 + g * 64 + j0, cur);
        load8bf(RAW + (rrow - 1) * 320 + g * 64 + j0, prv);
        load8bf(RAW + (rrow + 1) * 320 + g * 64 + j0, nxt);
        const f32x4 mp0 = *(const f32x4*)(MU + g * 64 + j0), mp1 = *(const f32x4*)(MU + g * 64 + j0 + 4);
        const f32x4 mn0 = *(const f32x4*)(MU + 320 + g * 64 + j0), mn1 = *(const f32x4*)(MU + 320 + g * 64 + j0 + 4);
        f32x4 x0, x1;
#pragma unroll
        for (int e = 0; e < 4; ++e) {
          x0[e] = cur[e] + mp0[e] * (prv[e] - cur[e]) + mn0[e] * (nxt[e] - cur[e]);
          x1[e] = cur[4 + e] + mp1[e] * (prv[4 + e] - cur[4 + e]) + mn1[e] * (nxt[4 + e] - cur[4 + e]);
        }
        if (g == 0) {
          *(f32x4*)(OPS + 4 * 2048 + pn * 64 + j0) = x0; *(f32x4*)(OPS + 4 * 2048 + pn * 64 + j0 + 4) = x1;
        } else if (g == 1) {
          *(f32x4*)(OPS + 3 * 2048 + pn * 64 + j0) = x0; *(f32x4*)(OPS + 3 * 2048 + pn * 64 + j0 + 4) = x1;
          const f32x4 kk0 = *(const f32x4*)(CST + 128 + j0), kk1 = *(const f32x4*)(CST + 128 + j0 + 4);
          float ss = 0.f;
#pragma unroll
          for (int e = 0; e < 4; ++e) { const float a_ = x0[e] * kk0[e], b_ = x1[e] * kk1[e]; ss += a_ * a_ + b_ * b_; }
          ss = red8(ss);
          if ((tid & 7) == 0) NRM[pn] = 1.f / fmaxf(sqrtf(ss), 1e-12f);
        } else if (g == 2) {
          *(f32x4*)(VV + pn * 64 + j0) = x0; *(f32x4*)(VV + pn * 64 + j0 + 4) = x1;
        } else if (g == 3) {
          u32x4 pk;
          pk.x = pack2(tanhf(x0[0]), tanhf(x0[1])); pk.y = pack2(tanhf(x0[2]), tanhf(x0[3]));
          pk.z = pack2(tanhf(x1[0]), tanhf(x1[1])); pk.w = pack2(tanhf(x1[2]), tanhf(x1[3]));
          *(u32x4*)(TWb + pn * 72 + j0) = pk;
        } else {
          u32x4 pk;
          pk.x = pack2(x0[0], x0[1]); pk.y = pack2(x0[2], x0[3]);
          pk.z = pack2(x1[0], x1[1]); pk.w = pack2(x1[2], x1[3]);
          *(u32x4*)(ADb + pn * 72 + j0) = pk;
        }
      }
      __syncthreads();
#pragma unroll
      for (int m = 0; m < 2; ++m) {
        f32x4 cw = {0.f, 0.f, 0.f, 0.f}, ca = {0.f, 0.f, 0.f, 0.f};
#pragma unroll
        for (int ks = 0; ks < 2; ++ks) {
          const bf16x8 aw = *(const bf16x8*)(TWb + (m * 16 + fr) * 72 + ks * 32 + fq * 8);
          const bf16x8 aa = *(const bf16x8*)(ADb + (m * 16 + fr) * 72 + ks * 32 + fq * 8);
          cw = __builtin_amdgcn_mfma_f32_16x16x32_bf16(aw, bw[ks], cw, 0, 0, 0);
          ca = __builtin_amdgcn_mfma_f32_16x16x32_bf16(aa, ba[ks], ca, 0, 0, 0);
        }
#pragma unroll
        for (int jj = 0; jj < 4; ++jj) {
          WR[(m * 16 + fq * 4 + jj) * 64 + w * 16 + fr] = cw[jj];
          AP[(m * 16 + fq * 4 + jj) * 64 + w * 16 + fr] = ca[jj];
        }
      }
      __syncthreads();
      {
        const float inv = NRM[pn];
        float bsum = 0.f;
#pragma unroll
        for (int hq = 0; hq < 2; ++hq) {
          const int jb = j0 + hq * 4;
          const f32x4 wr_ = *(const f32x4*)(WR + pn * 64 + jb) + *(const f32x4*)(CST + jb);
          const f32x4 ap_ = *(const f32x4*)(AP + pn * 64 + jb) + *(const f32x4*)(CST + 64 + jb);
          const f32x4 kr = *(const f32x4*)(OPS + 3 * 2048 + pn * 64 + jb);
          const f32x4 rr = *(const f32x4*)(OPS + 4 * 2048 + pn * 64 + jb);
          const f32x4 kkw = *(const f32x4*)(CST + 128 + jb), kaw = *(const f32x4*)(CST + 192 + jb), rkw = *(const f32x4*)(CST + 256 + jb);
          f32x4 o0, o1, o2, o3;
#pragma unroll
          for (int e = 0; e < 4; ++e) {
            const float sw = 1.f / (1.f + expf(-wr_[e]));
            const float dec = expf(-0.6065306597126334f * sw);
            const float av = 1.f / (1.f + expf(-ap_[e]));
            const float kn = kr[e] * kkw[e] * inv;
            const float kd = kr[e] * (1.f + (av - 1.f) * kaw[e]);
            bsum += rr[e] * kd * rkw[e];
            o0[e] = -kn; o1[e] = dec; o2[e] = kn * av; o3[e] = kd;
          }
          *(f32x4*)(OPS + 0 * 2048 + pn * 64 + jb) = o0;
          *(f32x4*)(OPS + 1 * 2048 + pn * 64 + jb) = o1;
          *(f32x4*)(OPS + 2 * 2048 + pn * 64 + jb) = o2;
          *(f32x4*)(OPS + 3 * 2048 + pn * 64 + jb) = o3;
        }
        bsum = red8(bsum);
        if ((tid & 7) == 0) BON[(tok * 8 + h) * 2 + d] = bsum;
      }
      __syncthreads();
      {
        ScanOps oa, ob;
        scan_load(oa, OPS, VV, 0, jg, i0);
#pragma unroll 1
        for (int nn = 0; nn < 32; nn += 2) {
          scan_load(ob, OPS, VV, nn + 1, jg, i0);
          scan_step(oa, S0, S1, YL, nn, jg, i0);
          scan_load(oa, OPS, VV, (nn + 2) & 31, jg, i0);
          scan_step(ob, S0, S1, YL, nn + 1, jg, i0);
        }
      }
      __syncthreads();
      {
        h16x8 o;
#pragma unroll
        for (int e = 0; e < 8; ++e) o[e] = (_Float16)YL[pn * 64 + j0 + e];
        *(h16x8*)(Y + tok * 512 + h * 64 + j0) = o;
      }
    }
    __syncthreads();
  }
}

DEVI void phase_rwkv_post(int tid_, const Params& p, int l, char* smem) {
  u16* PR = (u16*)(p.ws + OFF_PR);
  const _Float16* YF = (const _Float16*)(p.ws + OFF_NK);
  const _Float16* YB = (const _Float16*)(p.ws + OFF_NV);
  const float* BON = (const float*)(p.ws + OFF_BONUS);
  const u16* GUPT = (const u16*)(p.ws + OFF_WB) + W_GUP;
  const float* mu_p = p.in[I_MU_PREV] + (size_t)l * 1920;
  const float* mu_n = p.in[I_MU_NEXT] + (size_t)l * 1920;
  const float* gng = p.in[I_GN_G] + (size_t)l * 512;
  const float* gnb = p.in[I_GN_B] + (size_t)l * 512;
  u16* As = (u16*)smem;
  const int tid = tid_, lane = tid & 63, w = tid >> 6, fr = lane & 15, fq = lane >> 4;
  for (int tile = blockIdx.x; tile < NTOK / 64; tile += gridDim.x) {
    const size_t tok0 = (size_t)tile * 64;
    {
      const int row = tid >> 2, part = tid & 3;
      const size_t tok = tok0 + row;
      const int t = (int)(tok & 4095);
#pragma unroll
      for (int q = 0; q < 4; ++q) {
        const int col = 1792 + part * 32 + q * 8;
        float cur[8], prv[8], nxt[8];
        load8bf(PR + tok * PRW + col, cur);
        if (t > 0) load8bf(PR + (tok - 1) * PRW + col, prv);
        else {
#pragma unroll
          for (int e = 0; e < 8; ++e) prv[e] = 0.f;
        }
        if (t < 4095) load8bf(PR + (tok + 1) * PRW + col, nxt);
        else {
#pragma unroll
          for (int e = 0; e < 8; ++e) nxt[e] = 0.f;
        }
        float o[8];
#pragma unroll
        for (int e = 0; e < 8; ++e) {
          const float x = cur[e] + mu_p[col + e] * (prv[e] - cur[e]) + mu_n[col + e] * (nxt[e] - cur[e]);
          o[e] = sigm(x);
        }
        u32x4 pk;
        pk.x = pack2(o[0], o[1]); pk.y = pack2(o[2], o[3]); pk.z = pack2(o[4], o[5]); pk.w = pack2(o[6], o[7]);
        *(u32x4*)(As + row * 136 + part * 32 + q * 8) = pk;
      }
    }
    __syncthreads();
#pragma unroll 1
    for (int chh = 0; chh < 2; ++chh) {
      f32x4 acc[16];
#pragma unroll
      for (int n = 0; n < 16; ++n) acc[n] = (f32x4){0.f, 0.f, 0.f, 0.f};
#pragma unroll
      for (int ks = 0; ks < 4; ++ks) {
        bf16x8 af = *(const bf16x8*)(As + (w * 16 + fr) * 136 + ks * 32 + fq * 8);
#pragma unroll
        for (int n = 0; n < 16; ++n) {
          bf16x8 bg = *(const bf16x8*)(GUPT + (size_t)(chh * 256 + n * 16 + fr) * 128 + ks * 32 + fq * 8);
          acc[n] = __builtin_amdgcn_mfma_f32_16x16x32_bf16(af, bg, acc[n], 0, 0, 0);
        }
      }
#pragma unroll
      for (int hl = 0; hl < 4; ++hl) {
        const int head = chh * 4 + hl;
#pragma unroll
        for (int j = 0; j < 4; ++j) {
          const size_t tok = tok0 + w * 16 + fq * 4 + j;
          const int t = (int)(tok & 4095);
          float o[4], sum = 0.f;
#pragma unroll
          for (int q = 0; q < 4; ++q) {
            const int col = head * 64 + q * 16 + fr;
            o[q] = (float)YF[tok * 512 + col] + (float)YB[tok * 512 + col];
            sum += o[q];
          }
          const float mean = red16_sum(sum) * (1.f / 64.f);
          float vs = 0.f;
#pragma unroll
          for (int q = 0; q < 4; ++q) { const float dlt = o[q] - mean; vs += dlt * dlt; }
          const float var = red16_sum(vs) * (1.f / 64.f);
          const float rstd = rsqrtf(var + 64e-5f);
          const float bon = BON[(tok * 8 + head) * 2] + BON[(tok * 8 + head) * 2 + 1];
#pragma unroll
          for (int q = 0; q < 4; ++q) {
            const int col = head * 64 + q * 16 + fr;
            const int vc = 1024 + col;
            const float cur = bf2f(PR[tok * PRW + vc]);
            const float prv = (t > 0) ? bf2f(PR[(tok - 1) * PRW + vc]) : 0.f;
            const float nxt = (t < 4095) ? bf2f(PR[(tok + 1) * PRW + vc]) : 0.f;
            const float vsh = cur + mu_p[vc] * (prv - cur) + mu_n[vc] * (nxt - cur);
            const float yv = ((o[q] - mean) * rstd * gng[col] + gnb[col] + bon * vsh) * acc[hl * 4 + q][j];
            PR[tok * PRW + col] = f2bf(yv);
          }
        }
      }
    }
    __syncthreads();
  }
}

DEVI void phase_merge(int tid_, const Params& p, char* smem) {
  const u16* WB = (const u16*)(p.ws + OFF_WB);
  const u16* H = (const u16*)(p.ws + OFF_H);
  u16* PR = (u16*)(p.ws + OFF_PR);
  const u16* NQ = (const u16*)(p.ws + OFF_NQ);
  const int lane = tid_ & 63, wid = tid_ >> 6;
  const int wr = wid >> 1, wc = wid & 1, fr = lane & 15, fq = lane >> 4;
  for (int t = blockIdx.x; t < 384 * 16; t += gridDim.x) {
    const int tm = t >> 4, tn = t & 15;
    const int m0 = tm << 7, n0 = tn << 6;
    f32x4 g[4][2], acc[4][2];
    uint32_t mp[4][2][2];
    zero_acc(g);
    gemm_kloop<2, true>(launder(tid_), g, H + (size_t)m0 * 1024, 1024, WB + W_IN + (size_t)(3456 + n0) * 1024, 1024, 1024, smem);
    zero_acc(acc);
    gemm_kloop<2, true>(launder(tid_), acc, PR + (size_t)m0 * PRW, PRW, WB + W_BRR + (size_t)n0 * 512, 512, 512, smem);
#pragma unroll
    for (int m = 0; m < 4; ++m)
#pragma unroll
      for (int n = 0; n < 2; ++n) {
        mp[m][n][0] = pack2(sigm(g[m][n][0]) * acc[m][n][0], sigm(g[m][n][1]) * acc[m][n][1]);
        mp[m][n][1] = pack2(sigm(g[m][n][2]) * acc[m][n][2], sigm(g[m][n][3]) * acc[m][n][3]);
      }
    zero_acc(g);
    gemm_kloop<2, true>(launder(tid_), g, H + (size_t)m0 * 1024, 1024, WB + W_IN + (size_t)(4480 + n0) * 1024, 1024, 1024, smem);
    zero_acc(acc);
    gemm_kloop<2, true>(launder(tid_), acc, NQ + (size_t)m0 * 512, 512, WB + W_BRN + (size_t)n0 * 512, 512, 512, smem);
#pragma unroll
    for (int m = 0; m < 4; ++m)
#pragma unroll
      for (int n = 0; n < 2; ++n) {
        const int r = m0 + wr * 64 + m * 16 + fr, c0 = n0 + wc * 32 + n * 16 + fq * 4;
        f32x4 o;
        o[0] = __uint_as_float(mp[m][n][0] << 16) + sigm(g[m][n][0]) * acc[m][n][0];
        o[1] = __uint_as_float(mp[m][n][0] & 0xffff0000u) + sigm(g[m][n][1]) * acc[m][n][1];
        o[2] = __uint_as_float(mp[m][n][1] << 16) + sigm(g[m][n][2]) * acc[m][n][2];
        o[3] = __uint_as_float(mp[m][n][1] & 0xffff0000u) + sigm(g[m][n][3]) * acc[m][n][3];
        store4bf(PR + (size_t)r * PRW + 512 + c0, o);
      }
  }
}

DEVI void phase_xattn(int tid_, const Params& p, char* smem) {
  const u16* Q = (const u16*)(p.ws + OFF_PR);
  u16* O = (u16*)(p.ws + OFF_NQ);
  const u16* KVK = (const u16*)(p.ws + OFF_KVK);
  const u16* KVT = (const u16*)(p.ws + OFF_KVT);
  const int lane = tid_ & 63, w = tid_ >> 6, fr = lane & 15, fq = lane >> 4;
  u16* Pw = (u16*)smem + w * (16 * 264);
  for (int t = blockIdx.x; t < (NTOK / 64) * 4; t += gridDim.x) {
    const int hh = t & 3;
    const size_t tok0 = (size_t)(t >> 2) * 64 + w * 16;
    const int s = (int)(tok0 >> 12);
    f32x4 acc[16];
#pragma unroll
    for (int n = 0; n < 16; ++n) acc[n] = (f32x4){0.f, 0.f, 0.f, 0.f};
#pragma unroll 2
    for (int ks = 0; ks < 8; ++ks) {
      bf16x8 aq = *(const bf16x8*)(Q + (tok0 + fr) * 1024 + hh * 256 + ks * 32 + fq * 8);
#pragma unroll
      for (int n = 0; n < 16; ++n) {
        bf16x8 bk = *(const bf16x8*)(KVK + (size_t)(s * 256 + n * 16 + fr) * 1024 + hh * 256 + ks * 32 + fq * 8);
        acc[n] = __builtin_amdgcn_mfma_f32_16x16x32_bf16(aq, bk, acc[n], 0, 0, 0);
      }
    }
    float sm[4];
#pragma unroll
    for (int j = 0; j < 4; ++j) {
      float m = -1e30f;
#pragma unroll
      for (int n = 0; n < 16; ++n) { acc[n][j] *= 0.0625f; m = fmaxf(m, acc[n][j]); }
      m = red16_max(m);
      float ssum = 0.f;
#pragma unroll
      for (int n = 0; n < 16; ++n) { const float e = __expf(acc[n][j] - m); acc[n][j] = e; ssum += e; }
      sm[j] = 1.f / red16_sum(ssum);
    }
    __syncthreads();
#pragma unroll
    for (int n = 0; n < 16; ++n)
#pragma unroll
      for (int j = 0; j < 4; ++j) Pw[(fq * 4 + j) * 264 + n * 16 + fr] = f2bf(acc[n][j]);
    __syncthreads();
#pragma unroll
    for (int n = 0; n < 16; ++n) acc[n] = (f32x4){0.f, 0.f, 0.f, 0.f};
#pragma unroll 2
    for (int ks = 0; ks < 8; ++ks) {
      bf16x8 ap = *(const bf16x8*)(Pw + fr * 264 + ks * 32 + fq * 8);
#pragma unroll
      for (int n = 0; n < 16; ++n) {
        bf16x8 bv = *(const bf16x8*)(KVT + (size_t)(s * 1024 + hh * 256 + n * 16 + fr) * 256 + ks * 32 + fq * 8);
        acc[n] = __builtin_amdgcn_mfma_f32_16x16x32_bf16(ap, bv, acc[n], 0, 0, 0);
      }
    }
#pragma unroll
    for (int n = 0; n < 16; ++n)
#pragma unroll
      for (int j = 0; j < 4; ++j)
        O[(tok0 + fq * 4 + j) * 1024 + hh * 256 + n * 16 + fr] = f2bf(acc[n][j] * sm[j]);
  }
}

DEVI void run_phase(int tid_, const Params& p, int ph, char* smem) {
  if (ph == 2 * NPH_LAYER) { phase_final_norm(tid_, p); return; }
  const int l = ph / NPH_LAYER, q = ph % NPH_LAYER;
  u16* WB = (u16*)(p.ws + OFF_WB);
  u16* H = (u16*)(p.ws + OFF_H);
  u16* PR = (u16*)(p.ws + OFF_PR);
  u16* NQ = (u16*)(p.ws + OFF_NQ);
  float* X = p.X;
  auto epi_res = [&](int r, int c0, f32x4 v) {
    f32x4* px = (f32x4*)(X + (size_t)r * 1024 + c0);
    *px = *px + v;
  };
  constexpr int NONS = 1 << 30;
  switch (q) {
    case 0:
      phase_conv(tid_, p, l, smem);
      phase_norm(tid_, p, p.in[I_NORM_MIX] + (size_t)l * 1024, l == 0);
      phase_norm_mem(tid_, p, p.in[I_NORM_MEM] + (size_t)l * 1024);
      break;
    case 1: phase_p_gemm(tid_, p, smem); break;
    case 2: phase_nat(tid_, p, l, smem); break;
    case 3: phase_scan(tid_, p, l, smem); break;
    case 4: phase_rwkv_post(tid_, p, l, smem); break;
    case 5: phase_merge(tid_, p, smem); break;
    case 6: gemm_phase(tid_, PR + 512, PRW, WB + W_OUT, 1024, 1024, NTOK, 1024, smem, NONS, epi_res, NoEpi()); break;
    case 7: phase_norm(tid_, p, p.in[I_NORM_X] + (size_t)l * 1024, false); break;
    case 8:
      gemm_phase(tid_, H, 1024, WB + W_XQ, 1024, 1024, NTOK, 1024, smem, NONS,
                 [&](int r, int c0, f32x4 v) { store4bf(PR + (size_t)r * 1024 + c0, v); }, NoEpi());
      break;
    case 9: phase_xattn(tid_, p, smem); break;
    case 10: gemm_phase(tid_, NQ, 1024, WB + W_XO, 1024, 1024, NTOK, 1024, smem, NONS, epi_res, NoEpi()); break;
    case 11: phase_norm(tid_, p, p.in[I_NORM_FF] + (size_t)l * 1024, false); break;
    case 12:
    case 14: {
      const int hf = (q == 14);
      gemm_phase(tid_, H, 1024, WB + W_FF1 + (size_t)hf * 2048 * 1024, 1024, 1024, NTOK, 2048, smem, NONS,
                 [&](int r, int c0, f32x4 v) {
                   f32x4 o;
#pragma unroll
                   for (int j = 0; j < 4; ++j) { const float x = fmaxf(v[j], 0.f); o[j] = x * x; }
                   store4bf(PR + (size_t)r * 2048 + c0, o);
                 }, NoEpi());
    } break;
    case 13:
    case 15: {
      const int hf = (q == 15);
      gemm_phase(tid_, PR, 2048, WB + W_FF2 + (size_t)hf * 2048, 4096, 2048, NTOK, 1024, smem, NONS, epi_res, NoEpi());
    } break;
  }
}

#define XB_TMO      128
#define XB_XCNT(j)  (256  + 64 * (j))
#define XB_XSUB(j)  (1280 + 64 * (j))
#define XB_XGEN(j)  (2304 + 64 * (j))
#define XB_TOP      3328
#define XB_TOPGEN   3392
#define XCD_BAR_WORDS 3456
#define XB_SPIN_CAP (1u << 20)
#define LAS __attribute__((address_space(3)))

DEVI unsigned xb_ld(unsigned* p) { return __hip_atomic_load(p, __ATOMIC_RELAXED, __HIP_MEMORY_SCOPE_AGENT); }
DEVI unsigned xb_add(unsigned* p, unsigned v) { return __hip_atomic_fetch_add(p, v, __ATOMIC_RELAXED, __HIP_MEMORY_SCOPE_AGENT); }
DEVI unsigned xb_xcc_id() { return (unsigned)__builtin_amdgcn_s_getreg((3 << 11) | 20) & 0xFu; }
#define XB_SPIN(cond, bar) do { unsigned _sp = 0; while (cond) { __builtin_amdgcn_s_sleep(1); \
    if ((++_sp & 255u) == 0u) { if (xb_ld(&(bar)[XB_TMO])) break; if (_sp > XB_SPIN_CAP) { atomicAdd(&(bar)[XB_TMO], 1u); break; } } } } while (0)

struct XcdBarrier {
  unsigned* bar; unsigned x;
  volatile LAS unsigned* st;
};
DEVI XcdBarrier xcd_barrier_post(unsigned* bar, volatile LAS unsigned* st) {
  XcdBarrier b; b.bar = bar; b.x = xb_xcc_id(); b.st = st;
  if (threadIdx.x == 0) (void)xb_add(&bar[XB_XCNT(b.x)], 1u);
  return b;
}
DEVI void xcd_barrier_complete(unsigned* bar, unsigned x, unsigned& nloc, unsigned& nx) {
  const unsigned G = gridDim.x * gridDim.y * gridDim.z;
  unsigned sum, cnt, mine, sp = 0u;
  for (;;) {
    sum = 0u; cnt = 0u; mine = 0u;
#pragma unroll
    for (unsigned j = 0; j < 16; ++j) { const unsigned c = xb_ld(&bar[XB_XCNT(j)]); sum += c; cnt += (c > 0u) ? 1u : 0u; mine = (j == x) ? c : mine; }
    if (sum == G) break;
    __builtin_amdgcn_s_sleep(1);
    if ((++sp & 255u) == 0u) { if (xb_ld(&bar[XB_TMO])) break; if (sp > XB_SPIN_CAP) { atomicAdd(&bar[XB_TMO], 1u); break; } }
  }
  nloc = mine > 0u ? mine : 1u; nx = cnt > 0u ? cnt : 1u;
}
DEVI void xcd_barrier(const XcdBarrier& b) {
  asm volatile("s_waitcnt vmcnt(0)" ::: "memory");
  __syncthreads();
  if (threadIdx.x == 0) {
    unsigned* bar = b.bar;
    __builtin_amdgcn_s_waitcnt(0);
    unsigned nloc = b.st[0], nx = b.st[1];
    if (nloc == 0u) { xcd_barrier_complete(bar, b.x, nloc, nx); b.st[0] = nloc; b.st[1] = nx; }
    const unsigned old = xb_add(&bar[XB_XSUB(b.x)], 1u);
    const unsigned gen = old / nloc;
    if (old + 1u == (gen + 1u) * nloc) {
      __builtin_amdgcn_fence(__ATOMIC_RELEASE, "agent");
      asm volatile("s_waitcnt vmcnt(0)" ::: "memory");
      const unsigned og = xb_add(&bar[XB_TOP], 1u);
      const unsigned tg = og / nx;
      if (og + 1u == (tg + 1u) * nx) xb_add(&bar[XB_TOPGEN], 1u);
      else XB_SPIN(xb_ld(&bar[XB_TOPGEN]) == tg, bar);
      __builtin_amdgcn_fence(__ATOMIC_ACQUIRE, "agent");
      xb_add(&bar[XB_XGEN(b.x)], 1u);
      asm volatile("s_waitcnt vmcnt(0)" ::: "memory");
    } else {
      XB_SPIN(xb_ld(&bar[XB_XGEN(b.x)]) == gen, bar);
      __builtin_amdgcn_fence(__ATOMIC_ACQUIRE, "agent");
      asm volatile("s_waitcnt vmcnt(0)" ::: "memory");
    }
  }
  __syncthreads();
}

__global__ void __launch_bounds__(256, 2) mega_kernel(Params p, int ph0, int ph1) {
  __shared__ __attribute__((aligned(16))) char smem[SMEM_BYTES];
  __shared__ __attribute__((aligned(16))) unsigned xb_words[4];
  if (threadIdx.x == 0) { xb_words[0] = 0u; xb_words[1] = 0u; xb_words[2] = 0u; xb_words[3] = 0u; }
  __syncthreads();
  XcdBarrier xb = xcd_barrier_post((unsigned*)(p.ws + OFF_BAR), (volatile LAS unsigned*)xb_words);
  for (int ph = ph0; ph < ph1; ++ph) {
    if (ph == ph0 + 1) cg::this_grid().sync();
    else if (ph > ph0) xcd_barrier(xb);
    int tid_ = threadIdx.x;
    asm volatile("" : "+v"(tid_));
    run_phase(tid_, p, ph, smem);
  }
}

extern "C" void kernel_launch(void* const* d_in, const int* in_sizes, int n_in, void* d_out, int out_size, void* d_ws,
                              size_t ws_size, hipStream_t stream) {
  if (ws_size < WS_NEED || n_in < 31) return;
  Params p{};
  for (int i = 0; i < 31; ++i) p.in[i] = (const float*)d_in[i];
  p.X = (float*)d_out;
  p.ws = (char*)d_ws;
  static int grid_blocks = 0;
  if (!grid_blocks) {
    int dev = 0, cus = 0, per_cu = 0;
    hipGetDevice(&dev);
    hipDeviceGetAttribute(&cus, hipDeviceAttributeMultiprocessorCount, dev);
    hipOccupancyMaxActiveBlocksPerMultiprocessor(&per_cu, mega_kernel, 256, 0);
    if (per_cu > 2) per_cu = 2;
    if (per_cu < 1) per_cu = 1;
    grid_blocks = cus * per_cu;
  }
  hipMemsetAsync((char*)d_ws + OFF_BAR, 0, 16384, stream);
  int ph0 = 0, ph1 = NPHASES;
  void* args[] = {&p, &ph0, &ph1};
  hipLaunchCooperativeKernel((void*)mega_kernel, dim3(grid_blocks), dim3(256), args, 0, stream);
}
```

```cpp
#include <hip/hip_runtime.h>
#include <hip/hip_cooperative_groups.h>
#include <stdint.h>
namespace cg = cooperative_groups;

typedef unsigned short u16;
typedef __attribute__((ext_vector_type(8))) short bf16x8;
typedef __attribute__((ext_vector_type(4))) float f32x4;
typedef __attribute__((ext_vector_type(8))) _Float16 h16x8;
typedef __attribute__((ext_vector_type(4))) unsigned int u32x4;
typedef __attribute__((ext_vector_type(2))) unsigned int u32x2;

#define DEVI __device__ __forceinline__

constexpr int NTOK = 49152;
constexpr int SEQ_T = 4096;
constexpr int PRW = 1920;
constexpr int NPH_LAYER = 16;
constexpr int NPHASES = 2 * NPH_LAYER + 1;
constexpr int SMEM_BYTES = 78720;

constexpr size_t OFF_WB = 0;
constexpr size_t WB_BYTES = 20512768ull * 2;
constexpr size_t OFF_H = OFF_WB + WB_BYTES;
constexpr size_t OFF_PR = OFF_H + (size_t)NTOK * 1024 * 2;
constexpr size_t OFF_NQ = OFF_PR + (size_t)NTOK * PRW * 2;
constexpr size_t OFF_NK = OFF_NQ + (size_t)NTOK * 512 * 2;
constexpr size_t OFF_NV = OFF_NK + (size_t)NTOK * 512 * 2;
constexpr size_t OFF_KVK = OFF_NV + (size_t)NTOK * 512 * 2;
constexpr size_t OFF_KVT = OFF_KVK + (size_t)3072 * 1024 * 2;
constexpr size_t OFF_MEMH = OFF_KVT + (size_t)3072 * 1024 * 2;
constexpr size_t OFF_BONUS = OFF_MEMH + (size_t)3072 * 1024 * 2;
constexpr size_t OFF_BAR = OFF_BONUS + (size_t)NTOK * 16 * 4;
constexpr size_t WS_NEED = OFF_BAR + 16384;

constexpr size_t W_IN = 0;
constexpr size_t W_BRR = W_IN + (size_t)5504 * 1024;
constexpr size_t W_BRN = W_BRR + (size_t)1024 * 512;
constexpr size_t W_OUT = W_BRN + (size_t)1024 * 512;
constexpr size_t W_XQ = W_OUT + (size_t)1024 * 1024;
constexpr size_t W_XKV = W_XQ + (size_t)1024 * 1024;
constexpr size_t W_XO = W_XKV + (size_t)2048 * 1024;
constexpr size_t W_FF1 = W_XO + (size_t)1024 * 1024;
constexpr size_t W_FF2 = W_FF1 + (size_t)4096 * 1024;
constexpr size_t W_GUP = W_FF2 + (size_t)4096 * 1024;
constexpr size_t W_WUP = W_GUP + (size_t)512 * 128;
constexpr size_t W_AUP = W_WUP + (size_t)2 * 512 * 64;

enum { I_XP = 0, I_XS, I_MP, I_MS, I_NORM_MIX, I_W_IN, I_MU_PREV, I_MU_NEXT, I_W0, I_W_UP, I_A0, I_A_UP,
       I_G_UP, I_K_K, I_K_A, I_R_K, I_GN_G, I_GN_B, I_RPB, I_W_BR_RWKV, I_W_BR_NAT, I_W_OUT, I_NORM_X,
       I_NORM_MEM, I_W_XQ, I_W_XKV, I_W_XO, I_NORM_FF, I_W_FF1, I_W_FF2, I_NORM_FINAL };

struct Params {
  const float* in[31];
  float* X;
  char* ws;
};

DEVI u16 f2bf(float f) {
  uint32_t u = __float_as_uint(f);
  u += 0x7FFFu + ((u >> 16) & 1u);
  return (u16)(u >> 16);
}
DEVI float bf2f(u16 h) { return __uint_as_float(((uint32_t)h) << 16); }
DEVI uint32_t pack2(float a, float b) { return (uint32_t)f2bf(a) | ((uint32_t)f2bf(b) << 16); }
DEVI float sigm(float x) { return 1.f / (1.f + __expf(-x)); }
DEVI void unpack8(u32x4 u, float* o) {
  o[0] = __uint_as_float(u.x << 16); o[1] = __uint_as_float(u.x & 0xffff0000u);
  o[2] = __uint_as_float(u.y << 16); o[3] = __uint_as_float(u.y & 0xffff0000u);
  o[4] = __uint_as_float(u.z << 16); o[5] = __uint_as_float(u.z & 0xffff0000u);
  o[6] = __uint_as_float(u.w << 16); o[7] = __uint_as_float(u.w & 0xffff0000u);
}
DEVI void load8bf(const u16* p, float* o) { unpack8(*(const u32x4*)p, o); }
DEVI float wave_sum(float v) {
  v += __shfl_xor(v, 32); v += __shfl_xor(v, 16); v += __shfl_xor(v, 8);
  v += __shfl_xor(v, 4); v += __shfl_xor(v, 2); v += __shfl_xor(v, 1);
  return v;
}
DEVI float red16_sum(float v) {
  v += __shfl_xor(v, 1); v += __shfl_xor(v, 2); v += __shfl_xor(v, 4); v += __shfl_xor(v, 8);
  return v;
}
DEVI float red16_max(float v) {
  v = fmaxf(v, __shfl_xor(v, 1)); v = fmaxf(v, __shfl_xor(v, 2));
  v = fmaxf(v, __shfl_xor(v, 4)); v = fmaxf(v, __shfl_xor(v, 8));
  return v;
}

DEVI void conv_tile(int tid_, const float* src, int K, int N, u16* dst, int tile, char* smem) {
  float (*s)[65] = (float (*)[65])smem;
  const int nN = N >> 6;
  const int tk = tile / nN, tn = tile - tk * nN;
  const int tx = tid_ & 63, ty = tid_ >> 6;
  for (int r = ty; r < 64; r += 4) s[r][tx] = src[(size_t)(tk * 64 + r) * N + tn * 64 + tx];
  __syncthreads();
  for (int r = ty; r < 64; r += 4) dst[(size_t)(tn * 64 + r) * K + tk * 64 + tx] = f2bf(s[tx][r]);
  __syncthreads();
}

DEVI void phase_conv(int tid_, const Params& p, int l, char* smem) {
  u16* WB = (u16*)(p.ws + OFF_WB);
  const int c0 = 1376, c1 = c0 + 128, c2 = c1 + 128, c3 = c2 + 256, c4 = c3 + 256, c5 = c4 + 512,
            c6 = c5 + 256, c7 = c6 + 1024, c8 = c7 + 1024, c9 = c8 + 16, c10 = c9 + 16, c11 = c10 + 16;
  for (int t = blockIdx.x; t < c11; t += gridDim.x) {
    if (t < c0) conv_tile(tid_, p.in[I_W_IN] + (size_t)l * 1024 * 5504, 1024, 5504, WB + W_IN, t, smem);
    else if (t < c1) conv_tile(tid_, p.in[I_W_BR_RWKV] + (size_t)l * 512 * 1024, 512, 1024, WB + W_BRR, t - c0, smem);
    else if (t < c2) conv_tile(tid_, p.in[I_W_BR_NAT] + (size_t)l * 512 * 1024, 512, 1024, WB + W_BRN, t - c1, smem);
    else if (t < c3) conv_tile(tid_, p.in[I_W_OUT] + (size_t)l * 1024 * 1024, 1024, 1024, WB + W_OUT, t - c2, smem);
    else if (t < c4) conv_tile(tid_, p.in[I_W_XQ] + (size_t)l * 1024 * 1024, 1024, 1024, WB + W_XQ, t - c3, smem);
    else if (t < c5) conv_tile(tid_, p.in[I_W_XKV] + (size_t)l * 1024 * 2048, 1024, 2048, WB + W_XKV, t - c4, smem);
    else if (t < c6) conv_tile(tid_, p.in[I_W_XO] + (size_t)l * 1024 * 1024, 1024, 1024, WB + W_XO, t - c5, smem);
    else if (t < c7) conv_tile(tid_, p.in[I_W_FF1] + (size_t)l * 1024 * 4096, 1024, 4096, WB + W_FF1, t - c6, smem);
    else if (t < c8) conv_tile(tid_, p.in[I_W_FF2] + (size_t)l * 4096 * 1024, 4096, 1024, WB + W_FF2, t - c7, smem);
    else if (t < c9) conv_tile(tid_, p.in[I_G_UP] + (size_t)l * 128 * 512, 128, 512, WB + W_GUP, t - c8, smem);
    else if (t < c10) { const int dd = (t - c9) >> 3; conv_tile(tid_, p.in[I_W_UP] + (size_t)(l * 2 + dd) * 64 * 512, 64, 512, WB + W_WUP + (size_t)dd * 512 * 64, (t - c9) & 7, smem); }
    else { const int dd = (t - c10) >> 3; conv_tile(tid_, p.in[I_A_UP] + (size_t)(l * 2 + dd) * 64 * 512, 64, 512, WB + W_AUP + (size_t)dd * 512 * 64, (t - c10) & 7, smem); }
  }
}

DEVI void norm_row_bf16(int tid_, const float* src, const float* g, u16* dst, float* xcopy) {
  const int lane = tid_ & 63;
  float4 v[4];
  float ss = 0.f;
#pragma unroll
  for (int i = 0; i < 4; ++i) {
    v[i] = ((const float4*)src)[lane + i * 64];
    ss += v[i].x * v[i].x + v[i].y * v[i].y + v[i].z * v[i].z + v[i].w * v[i].w;
  }
  ss = wave_sum(ss);
  const float rs = rsqrtf(ss * (1.f / 1024.f) + 1e-6f);
#pragma unroll
  for (int i = 0; i < 4; ++i) {
    float4 gg = ((const float4*)g)[lane + i * 64];
    u32x2 o;
    o.x = pack2(v[i].x * rs * gg.x, v[i].y * rs * gg.y);
    o.y = pack2(v[i].z * rs * gg.z, v[i].w * rs * gg.w);
    ((u32x2*)dst)[lane + i * 64] = o;
    if (xcopy) ((float4*)xcopy)[lane + i * 64] = v[i];
  }
}

DEVI void phase_norm(int tid_, const Params& p, const float* g, bool from_input) {
  u16* H = (u16*)(p.ws + OFF_H);
  const int wid = tid_ >> 6;
  for (int r = blockIdx.x * 4 + wid; r < NTOK; r += gridDim.x * 4) {
    const float* src;
    if (from_input) src = (r < 32768) ? p.in[I_XP] + (size_t)r * 1024 : p.in[I_XS] + (size_t)(r - 32768) * 1024;
    else src = p.X + (size_t)r * 1024;
    norm_row_bf16(tid_, src, g, H + (size_t)r * 1024, from_input ? p.X + (size_t)r * 1024 : nullptr);
  }
}
DEVI void phase_norm_mem(int tid_, const Params& p, const float* g) {
  u16* MH = (u16*)(p.ws + OFF_MEMH);
  const int wid = tid_ >> 6;
  for (int r = blockIdx.x * 4 + wid; r < 3072; r += gridDim.x * 4) {
    const float* src = (r < 2048) ? p.in[I_MP] + (size_t)r * 1024 : p.in[I_MS] + (size_t)(r - 2048) * 1024;
    norm_row_bf16(tid_, src, g, MH + (size_t)r * 1024, nullptr);
  }
}
DEVI void phase_final_norm(int tid_, const Params& p) {
  const float* g = p.in[I_NORM_FINAL];
  const int wid = tid_ >> 6, lane = tid_ & 63;
  for (int r = blockIdx.x * 4 + wid; r < NTOK; r += gridDim.x * 4) {
    float* row = p.X + (size_t)r * 1024;
    float4 v[4];
    float ss = 0.f;
#pragma unroll
    for (int i = 0; i < 4; ++i) {
      v[i] = ((const float4*)row)[lane + i * 64];
      ss += v[i].x * v[i].x + v[i].y * v[i].y + v[i].z * v[i].z + v[i].w * v[i].w;
    }
    ss = wave_sum(ss);
    const float rs = rsqrtf(ss * (1.f / 1024.f) + 1e-6f);
#pragma unroll
    for (int i = 0; i < 4; ++i) {
      float4 gg = ((const float4*)g)[lane + i * 64];
      float4 o;
      o.x = v[i].x * rs * gg.x; o.y = v[i].y * rs * gg.y; o.z = v[i].z * rs * gg.z; o.w = v[i].w * rs * gg.w;
      ((float4*)row)[lane + i * 64] = o;
    }
  }
}

template <int OFF>
DEVI bf16x8 lds_rd128(uint32_t addr) {
  bf16x8 r;
  asm volatile("ds_read_b128 %0, %1 offset:%2" : "=v"(r) : "v"(addr), "n"(OFF));
  return r;
}

template <int NW, bool SWAP>
DEVI void gemm_kloop(int tid_, f32x4 (&acc)[4][NW], const u16* __restrict__ A, int lda, const u16* __restrict__ Bt, int ldb,
                     int K, char* smem) {
  constexpr int STG = 8192 + NW * 2048;
  constexpr int NB = NW / 2;
  const int tid = tid_, lane = tid & 63, wid = tid >> 6;
  const int wr = wid >> 1, wc = wid & 1, fr = lane & 15, fq = lane >> 4;
  const int lrow = lane >> 2, lphys = lane & 3, lhi = lane >> 4;
  const int gsw = (4 - lhi) & 3;
  const u16* ga[2];
  const u16* gb[NB];
#pragma unroll
  for (int q = 0; q < 2; ++q) ga[q] = A + (size_t)((wid * 2 + q) * 16 + lrow) * lda + (lphys ^ gsw) * 8;
#pragma unroll
  for (int q = 0; q < NB; ++q) gb[q] = Bt + (size_t)((wid * NB + q) * 16 + lrow) * ldb + (lphys ^ gsw) * 8;
  const int rsw = (4 - ((fr >> 2) & 3)) & 3;
  const int ch = (fq ^ rsw) * 16;
  const int nk = K >> 5;
  const uint32_t lds_base = (uint32_t)(size_t)(__attribute__((address_space(3))) char*)smem;
  const uint32_t aoff = (uint32_t)((wr * 64 + fr) * 64 + ch);
  const uint32_t boff = (uint32_t)(8192 + (wc * 16 * NW + fr) * 64 + ch);
  asm volatile("s_waitcnt vmcnt(0)" ::: "memory");
  __syncthreads();
#define GEMM_ISSUE(kt_)                                                                                              \
  do {                                                                                                               \
    char* nb_ = smem + ((kt_) & 3) * STG;                                                                            \
    _Pragma("unroll") for (int q = 0; q < 2; ++q) __builtin_amdgcn_global_load_lds(                                  \
        (const unsigned*)(ga[q] + (kt_) * 32),                                                                       \
        (__attribute__((address_space(3))) unsigned*)(nb_ + (wid * 2 + q) * 1024 + lane * 16), 16, 0, 0);            \
    _Pragma("unroll") for (int q = 0; q < NB; ++q) __builtin_amdgcn_global_load_lds(                                 \
        (const unsigned*)(gb[q] + (kt_) * 32),                                                                       \
        (__attribute__((address_space(3))) unsigned*)(nb_ + 8192 + (wid * NB + q) * 1024 + lane * 16), 16, 0, 0);    \
  } while (0)
  GEMM_ISSUE(0);
  if (nk > 1) GEMM_ISSUE(1);
  if (nk > 2) GEMM_ISSUE(2);
  for (int kt = 0; kt < nk; ++kt) {
    if (kt + 2 < nk) {
      if (NW == 4) asm volatile("s_waitcnt vmcnt(8)" ::: "memory");
      else asm volatile("s_waitcnt vmcnt(6)" ::: "memory");
    } else if (kt + 1 < nk) {
      if (NW == 4) asm volatile("s_waitcnt vmcnt(4)" ::: "memory");
      else asm volatile("s_waitcnt vmcnt(3)" ::: "memory");
    } else {
      asm volatile("s_waitcnt vmcnt(0)" ::: "memory");
    }
    __builtin_amdgcn_s_barrier();
    asm volatile("" ::: "memory");
    if (kt + 3 < nk) GEMM_ISSUE(kt + 3);
    const uint32_t sb = lds_base + (kt & 3) * STG;
    bf16x8 af[4], bfr[4];
    af[0] = lds_rd128<0>(sb + aoff); af[1] = lds_rd128<1024>(sb + aoff);
    af[2] = lds_rd128<2048>(sb + aoff); af[3] = lds_rd128<3072>(sb + aoff);
    bfr[0] = lds_rd128<0>(sb + boff); bfr[1] = lds_rd128<1024>(sb + boff);
    if (NW == 4) {
      bfr[2] = lds_rd128<2048>(sb + boff); bfr[3] = lds_rd128<3072>(sb + boff);
      asm volatile("s_waitcnt lgkmcnt(0)" : "+v"(af[0]), "+v"(af[1]), "+v"(af[2]), "+v"(af[3]),
                   "+v"(bfr[0]), "+v"(bfr[1]), "+v"(bfr[2]), "+v"(bfr[3]));
    } else {
      asm volatile("s_waitcnt lgkmcnt(0)" : "+v"(af[0]), "+v"(af[1]), "+v"(af[2]), "+v"(af[3]), "+v"(bfr[0]), "+v"(bfr[1]));
    }
#pragma unroll
    for (int m = 0; m < 4; ++m)
#pragma unroll
      for (int n = 0; n < NW; ++n) {
        if (SWAP) acc[m][n] = __builtin_amdgcn_mfma_f32_16x16x32_bf16(bfr[n], af[m], acc[m][n], 0, 0, 0);
        else acc[m][n] = __builtin_amdgcn_mfma_f32_16x16x32_bf16(af[m], bfr[n], acc[m][n], 0, 0, 0);
      }
  }
#undef GEMM_ISSUE
}

DEVI int launder(int x) { asm volatile("" : "+v"(x)); return x; }

template <int NW>
DEVI void zero_acc(f32x4 (&acc)[4][NW]) {
#pragma unroll
  for (int m = 0; m < 4; ++m)
#pragma unroll
    for (int n = 0; n < NW; ++n) acc[m][n] = (f32x4){0.f, 0.f, 0.f, 0.f};
}

struct NoEpi { DEVI void operator()(int, int, f32x4) const {} };

template <class EpiS, class EpiN>
DEVI void gemm_phase(int tid_, const u16* A, int lda, const u16* Bt, int ldb, int K, int M, int N, char* smem, int ns_from,
                     EpiS epiS, EpiN epiN) {
  const int nN = N >> 7, nM = M >> 7;
  const int lane = tid_ & 63, wid = tid_ >> 6;
  const int wr = wid >> 1, wc = wid & 1, fr = lane & 15, fq = lane >> 4;
  const int xcd = blockIdx.x & 7, jloc = blockIdx.x >> 3, nloc = gridDim.x >> 3;
  for (int lt = jloc; lt < (nM >> 3) * nN; lt += nloc) {
    const int tml = lt / nN, tn = lt - tml * nN;
    const int tm = tml * 8 + xcd;
    const int m0 = tm << 7, n0 = tn << 7;
    f32x4 acc[4][4];
    zero_acc(acc);
    if (n0 < ns_from) {
      gemm_kloop<4, true>(tid_, acc, A + (size_t)m0 * lda, lda, Bt + (size_t)n0 * ldb, ldb, K, smem);
#pragma unroll
      for (int m = 0; m < 4; ++m)
#pragma unroll
        for (int n = 0; n < 4; ++n) epiS(m0 + wr * 64 + m * 16 + fr, n0 + wc * 64 + n * 16 + fq * 4, acc[m][n]);
    } else {
      gemm_kloop<4, false>(tid_, acc, A + (size_t)m0 * lda, lda, Bt + (size_t)n0 * ldb, ldb, K, smem);
#pragma unroll
      for (int m = 0; m < 4; ++m)
#pragma unroll
        for (int n = 0; n < 4; ++n) epiN(m0 + wr * 64 + m * 16 + fq * 4, n0 + wc * 64 + n * 16 + fr, acc[m][n]);
    }
  }
}


template <bool SWAP>
DEVI void gemm_kloop_big(int tid_, f32x4 (&acc)[8][4], const u16* __restrict__ A, int lda, const u16* __restrict__ Bt,
                         int ldb, int K, char* smem) {
  constexpr int STG = 16384 + 8192;
  const int tid = tid_, lane = tid & 63, wid = tid >> 6;
  const int wr = wid >> 1, wc = wid & 1, fr = lane & 15, fq = lane >> 4;
  const int lrow = lane >> 2, lphys = lane & 3, lhi = lane >> 4;
  const int gsw = (4 - lhi) & 3;
  const u16* ga = A + (size_t)(wid * 64 + lrow) * lda + (lphys ^ gsw) * 8;
  const u16* gb = Bt + (size_t)(wid * 32 + lrow) * ldb + (lphys ^ gsw) * 8;
  const size_t a16 = (size_t)16 * lda, b16 = (size_t)16 * ldb;
  const int rsw = (4 - ((fr >> 2) & 3)) & 3;
  const int ch = (fq ^ rsw) * 16;
  const int nk = K >> 5;
  const uint32_t lds_base = (uint32_t)(size_t)(__attribute__((address_space(3))) char*)smem;
  const uint32_t aoff = (uint32_t)((wr * 128 + fr) * 64 + ch);
  const uint32_t boff = (uint32_t)(16384 + (wc * 64 + fr) * 64 + ch);
  asm volatile("s_waitcnt vmcnt(0)" ::: "memory");
  __syncthreads();
#define GEMMB_ISSUE(kt_, buf_)                                                                                       \
  do {                                                                                                               \
    char* nb_ = smem + (buf_) * STG;                                                                                 \
    _Pragma("unroll") for (int q = 0; q < 4; ++q) __builtin_amdgcn_global_load_lds(                                  \
        (const unsigned*)(ga + q * a16 + (kt_) * 32),                                                                \
        (__attribute__((address_space(3))) unsigned*)(nb_ + (wid * 4 + q) * 1024 + lane * 16), 16, 0, 0);            \
    _Pragma("unroll") for (int q = 0; q < 2; ++q) __builtin_amdgcn_global_load_lds(                                  \
        (const unsigned*)(gb + q * b16 + (kt_) * 32),                                                                \
        (__attribute__((address_space(3))) unsigned*)(nb_ + 16384 + (wid * 2 + q) * 1024 + lane * 16), 16, 0, 0);   \
  } while (0)
  GEMMB_ISSUE(0, 0);
  if (nk > 1) GEMMB_ISSUE(1, 1);
  int cb = 0;
  for (int kt = 0; kt < nk; ++kt) {
    if (kt + 1 < nk) asm volatile("s_waitcnt vmcnt(6)" ::: "memory");
    else asm volatile("s_waitcnt vmcnt(0)" ::: "memory");
    __builtin_amdgcn_s_barrier();
    asm volatile("" ::: "memory");
    const int nbuf = (cb == 0) ? 2 : cb - 1;
    if (kt + 2 < nk) GEMMB_ISSUE(kt + 2, nbuf);
    const uint32_t sb = lds_base + cb * STG;
    bf16x8 a0[4], a1[4], bb[4];
    a0[0] = lds_rd128<0>(sb + aoff); a0[1] = lds_rd128<1024>(sb + aoff);
    a0[2] = lds_rd128<2048>(sb + aoff); a0[3] = lds_rd128<3072>(sb + aoff);
    bb[0] = lds_rd128<0>(sb + boff); bb[1] = lds_rd128<1024>(sb + boff);
    bb[2] = lds_rd128<2048>(sb + boff); bb[3] = lds_rd128<3072>(sb + boff);
    a1[0] = lds_rd128<4096>(sb + aoff); a1[1] = lds_rd128<5120>(sb + aoff);
    a1[2] = lds_rd128<6144>(sb + aoff); a1[3] = lds_rd128<7168>(sb + aoff);
    asm volatile("s_waitcnt lgkmcnt(4)" : "+v"(a0[0]), "+v"(a0[1]), "+v"(a0[2]), "+v"(a0[3]),
                 "+v"(bb[0]), "+v"(bb[1]), "+v"(bb[2]), "+v"(bb[3]));
#pragma unroll
    for (int m = 0; m < 4; ++m)
#pragma unroll
      for (int n = 0; n < 4; ++n) {
        if (SWAP) acc[m][n] = __builtin_amdgcn_mfma_f32_16x16x32_bf16(bb[n], a0[m], acc[m][n], 0, 0, 0);
        else acc[m][n] = __builtin_amdgcn_mfma_f32_16x16x32_bf16(a0[m], bb[n], acc[m][n], 0, 0, 0);
      }
    asm volatile("s_waitcnt lgkmcnt(0)" : "+v"(a1[0]), "+v"(a1[1]), "+v"(a1[2]), "+v"(a1[3]));
#pragma unroll
    for (int m = 0; m < 4; ++m)
#pragma unroll
      for (int n = 0; n < 4; ++n) {
        if (SWAP) acc[4 + m][n] = __builtin_amdgcn_mfma_f32_16x16x32_bf16(bb[n], a1[m], acc[4 + m][n], 0, 0, 0);
        else acc[4 + m][n] = __builtin_amdgcn_mfma_f32_16x16x32_bf16(a1[m], bb[n], acc[4 + m][n], 0, 0, 0);
      }
    cb = (cb == 2) ? 0 : cb + 1;
  }
#undef GEMMB_ISSUE
}

template <class EpiS, class EpiN>
DEVI void gemm_phase_big(int tid_, const u16* A, int lda, const u16* Bt, int ldb, int K, int M, int N, char* smem,
                         int ns_from, EpiS epiS, EpiN epiN) {
  const int nN = N >> 7, nM = M >> 8;
  const int lane = tid_ & 63, wid = tid_ >> 6;
  const int wr = wid >> 1, wc = wid & 1, fr = lane & 15, fq = lane >> 4;
  const int xcd = blockIdx.x & 7, jloc = blockIdx.x >> 3, nloc = gridDim.x >> 3;
  for (int lt = jloc; lt < (nM >> 3) * nN; lt += nloc) {
    const int tml = lt / nN, tn = lt - tml * nN;
    const int tm = tml * 8 + xcd;
    const int m0 = tm << 8, n0 = tn << 7;
    f32x4 acc[8][4];
#pragma unroll
    for (int m = 0; m < 8; ++m)
#pragma unroll
      for (int n = 0; n < 4; ++n) acc[m][n] = (f32x4){0.f, 0.f, 0.f, 0.f};
    if (n0 < ns_from) {
      gemm_kloop_big<true>(launder(tid_), acc, A + (size_t)m0 * lda, lda, Bt + (size_t)n0 * ldb, ldb, K, smem);
#pragma unroll
      for (int m = 0; m < 8; ++m)
#pragma unroll
        for (int n = 0; n < 4; ++n) epiS(m0 + wr * 128 + m * 16 + fr, n0 + wc * 64 + n * 16 + fq * 4, acc[m][n]);
    } else {
      gemm_kloop_big<false>(launder(tid_), acc, A + (size_t)m0 * lda, lda, Bt + (size_t)n0 * ldb, ldb, K, smem);
#pragma unroll
      for (int m = 0; m < 8; ++m)
#pragma unroll
        for (int n = 0; n < 4; ++n) epiN(m0 + wr * 128 + m * 16 + fq * 4, n0 + wc * 64 + n * 16 + fr, acc[m][n]);
    }
  }
}

DEVI void store4bf(u16* dst, f32x4 v) {
  u32x2 o;
  o.x = pack2(v[0], v[1]); o.y = pack2(v[2], v[3]);
  *(u32x2*)dst = o;
}

DEVI void phase_p_gemm(int tid_, const Params& p, char* smem) {
  u16* WB = (u16*)(p.ws + OFF_WB);
  const u16* H = (const u16*)(p.ws + OFF_H);
  u16* PR = (u16*)(p.ws + OFF_PR);
  u16* NQ = (u16*)(p.ws + OFF_NQ);
  u16* NK = (u16*)(p.ws + OFF_NK);
  u16* NVT = (u16*)(p.ws + OFF_NV);
  gemm_phase_big(tid_, H, 1024, WB + W_IN, 1024, 1024, NTOK, 3456, smem, 2944,
    [&](int r, int c0, f32x4 v) {
      if (c0 < 1920) store4bf(PR + (size_t)r * PRW + c0, v);
      else if (c0 < 2432) store4bf(NQ + (size_t)r * 512 + (c0 - 1920), v);
      else store4bf(NK + (size_t)r * 512 + (c0 - 2432), v);
    },
    [&](int r0, int c, f32x4 v) {
      const int cc = c - 2944;
      const int s = r0 >> 12, t = r0 & 4095;
      store4bf(NVT + ((size_t)(s * 512 + cc)) * 4096 + t, v);
    });
  const u16* MH = (const u16*)(p.ws + OFF_MEMH);
  u16* KVK = (u16*)(p.ws + OFF_KVK);
  u16* KVT = (u16*)(p.ws + OFF_KVT);
  gemm_phase(tid_, MH, 1024, WB + W_XKV, 1024, 1024, 3072, 2048, smem, 1024,
    [&](int r, int c0, f32x4 v) { store4bf(KVK + (size_t)r * 1024 + c0, v); },
    [&](int r0, int c, f32x4 v) {
      const int cc = c - 1024;
      const int s = r0 >> 8, m = r0 & 255;
      store4bf(KVT + ((size_t)(s * 1024 + cc)) * 256 + m, v);
    });
}

DEVI void phase_nat(int tid_, const Params& p, int l, char* smem) {
  u16* NQ = (u16*)(p.ws + OFF_NQ);
  const u16* NK = (const u16*)(p.ws + OFF_NK);
  const u16* NVT = (const u16*)(p.ws + OFF_NV);
  const float* rpb = p.in[I_RPB] + (size_t)l * 8 * 15 * 31;
  const int lane = tid_ & 63, g = tid_ >> 6, fr = lane & 15, fq = lane >> 4;
  u16* Pw = (u16*)smem + g * (16 * 264);
  const int cb = (g == 0) ? 0 : (g == 1) ? 8 : (g == 2) ? 24 : 32;
  for (int t = blockIdx.x; t < 12 * 64 * 8; t += gridDim.x) {
    const int h = t & 7, ri = (t >> 3) & 63, s = t >> 9;
    int rs = ri - 4; rs = rs < 0 ? 0 : (rs > 56 ? 56 : rs);
    const size_t tokq = (size_t)s * 4096 + ri * 64 + g * 16;
    bf16x8 aq[2];
    aq[0] = *(const bf16x8*)(NQ + (tokq + fr) * 512 + h * 64 + fq * 8);
    aq[1] = *(const bf16x8*)(NQ + (tokq + fr) * 512 + h * 64 + 32 + fq * 8);
    f32x4 acc[16];
#pragma unroll
    for (int n = 0; n < 16; ++n) {
      acc[n] = (f32x4){0.f, 0.f, 0.f, 0.f};
      const int r = n >> 1, col = cb + (n & 1) * 16 + fr;
      const u16* kp = NK + ((size_t)s * 4096 + (rs + r) * 64 + col) * 512 + h * 64 + fq * 8;
      bf16x8 b0 = *(const bf16x8*)kp;
      bf16x8 b1 = *(const bf16x8*)(kp + 32);
      acc[n] = __builtin_amdgcn_mfma_f32_16x16x32_bf16(aq[0], b0, acc[n], 0, 0, 0);
      acc[n] = __builtin_amdgcn_mfma_f32_16x16x32_bf16(aq[1], b1, acc[n], 0, 0, 0);
    }
    float mx[4], sm[4];
#pragma unroll
    for (int j = 0; j < 4; ++j) {
      const int c = g * 16 + fq * 4 + j;
      int cs = c - 8; cs = cs < 0 ? 0 : (cs > 48 ? 48 : cs);
      float m = -1e30f;
#pragma unroll
      for (int n = 0; n < 16; ++n) {
        const int r = n >> 1, kc = cb + (n & 1) * 16 + fr;
        const bool valid = (kc >= cs) && (kc < cs + 16);
        float sc = -1e30f;
        if (valid) {
          const int di = rs + r - ri + 7, dj = kc - c + 15;
          sc = acc[n][j] * 0.125f + rpb[(h * 15 + di) * 31 + dj];
        }
        acc[n][j] = sc;
        m = fmaxf(m, sc);
      }
      mx[j] = red16_max(m);
    }
#pragma unroll
    for (int j = 0; j < 4; ++j) {
      float ssum = 0.f;
#pragma unroll
      for (int n = 0; n < 16; ++n) {
        float e = __expf(acc[n][j] - mx[j]);
        acc[n][j] = e;
        ssum += e;
      }
      sm[j] = 1.f / red16_sum(ssum);
    }
    __syncthreads();
#pragma unroll
    for (int n = 0; n < 16; ++n)
#pragma unroll
      for (int j = 0; j < 4; ++j) Pw[(fq * 4 + j) * 264 + n * 16 + fr] = f2bf(acc[n][j]);
    __syncthreads();
    f32x4 o[4];
#pragma unroll
    for (int n = 0; n < 4; ++n) o[n] = (f32x4){0.f, 0.f, 0.f, 0.f};
#pragma unroll
    for (int ks = 0; ks < 8; ++ks) {
      bf16x8 ap = *(const bf16x8*)(Pw + fr * 264 + ks * 32 + fq * 8);
#pragma unroll
      for (int n = 0; n < 4; ++n) {
        bf16x8 bv = *(const bf16x8*)(NVT + ((size_t)(s * 512 + h * 64 + n * 16 + fr)) * 4096 + (rs + ks) * 64 + cb + fq * 8);
        o[n] = __builtin_amdgcn_mfma_f32_16x16x32_bf16(ap, bv, o[n], 0, 0, 0);
      }
    }
#pragma unroll
    for (int n = 0; n < 4; ++n)
#pragma unroll
      for (int j = 0; j < 4; ++j)
        NQ[(tokq + fq * 4 + j) * 512 + h * 64 + n * 16 + fr] = f2bf(o[n][j] * sm[j]);
  }
}

constexpr int SC_OPS = 0;
constexpr int SC_VV = 40960;
constexpr int SC_WR = 49152;
constexpr int SC_AP = 57344;
constexpr int SC_TW = 65536;
constexpr int SC_AD = 70144;
constexpr int SC_NRM = 74752;
constexpr int SC_MU = 74880;
constexpr int SC_CST = 77440;

typedef __attribute__((ext_vector_type(2))) float f32x2;

template <int CTRL>
DEVI float dpp_mov(float x) {
  return __int_as_float(__builtin_amdgcn_update_dpp(0, __float_as_int(x), CTRL, 0xF, 0xF, true));
}
DEVI float red8(float x) {
  x += dpp_mov<0xB1>(x);
  x += dpp_mov<0x4E>(x);
  x += dpp_mov<0x141>(x);
  return x;
}
DEVI f32x2 lo2(f32x4 v) { return __builtin_shufflevector(v, v, 0, 1); }
DEVI f32x2 hi2(f32x4 v) { return __builtin_shufflevector(v, v, 2, 3); }

struct ScanOps {
  f32x2 a[4], w[4], b[4], k[4], r[4];
  float v0, v1;
};
DEVI void scan_load(ScanOps& o, const float* OPS, const float* VV, int nn, int jg, int i0) {
  const float* base = OPS + nn * 64 + jg * 8;
  f32x4 t0, t1;
  t0 = *(const f32x4*)(base); t1 = *(const f32x4*)(base + 4);
  o.a[0] = lo2(t0); o.a[1] = hi2(t0); o.a[2] = lo2(t1); o.a[3] = hi2(t1);
  t0 = *(const f32x4*)(base + 2048); t1 = *(const f32x4*)(base + 2048 + 4);
  o.w[0] = lo2(t0); o.w[1] = hi2(t0); o.w[2] = lo2(t1); o.w[3] = hi2(t1);
  t0 = *(const f32x4*)(base + 4096); t1 = *(const f32x4*)(base + 4096 + 4);
  o.b[0] = lo2(t0); o.b[1] = hi2(t0); o.b[2] = lo2(t1); o.b[3] = hi2(t1);
  t0 = *(const f32x4*)(base + 6144); t1 = *(const f32x4*)(base + 6144 + 4);
  o.k[0] = lo2(t0); o.k[1] = hi2(t0); o.k[2] = lo2(t1); o.k[3] = hi2(t1);
  t0 = *(const f32x4*)(base + 8192); t1 = *(const f32x4*)(base + 8192 + 4);
  o.r[0] = lo2(t0); o.r[1] = hi2(t0); o.r[2] = lo2(t1); o.r[3] = hi2(t1);
  o.v0 = VV[nn * 64 + i0];
  o.v1 = VV[nn * 64 + i0 + 8];
}
DEVI void scan_step(const ScanOps& o, f32x2 (&S0)[4], f32x2 (&S1)[4], float* YL, int nn, int jg, int i0) {
  f32x2 d0 = S0[0] * o.a[0], d0b = S0[2] * o.a[2];
  f32x2 d1 = S1[0] * o.a[0], d1b = S1[2] * o.a[2];
  d0 = S0[1] * o.a[1] + d0; d0b = S0[3] * o.a[3] + d0b;
  d1 = S1[1] * o.a[1] + d1; d1b = S1[3] * o.a[3] + d1b;
  d0 += d0b; d1 += d1b;
  const float sa0 = red8(d0.x + d0.y);
  const float sa1 = red8(d1.x + d1.y);
  f32x2 e0 = {0.f, 0.f}, e1 = {0.f, 0.f};
#pragma unroll
  for (int q = 0; q < 4; ++q) {
    const f32x2 u0 = sa0 * o.b[q] + o.v0 * o.k[q];
    const f32x2 u1 = sa1 * o.b[q] + o.v1 * o.k[q];
    S0[q] = S0[q] * o.w[q] + u0;
    S1[q] = S1[q] * o.w[q] + u1;
    e0 = S0[q] * o.r[q] + e0;
    e1 = S1[q] * o.r[q] + e1;
  }
  const float y0 = red8(e0.x + e0.y);
  const float y1 = red8(e1.x + e1.y);
  if (jg == 0) { YL[nn * 64 + i0] = y0; YL[nn * 64 + i0 + 8] = y1; }
}

DEVI void phase_scan(int tid_, const Params& p, int l, char* smem) {
  const u16* PR = (const u16*)(p.ws + OFF_PR);
  _Float16* YF = (_Float16*)(p.ws + OFF_NK);
  _Float16* YB = (_Float16*)(p.ws + OFF_NV);
  float* BON = (float*)(p.ws + OFF_BONUS);
  const u16* WB = (const u16*)(p.ws + OFF_WB);
  float* OPS = (float*)(smem + SC_OPS);
  u16* RAW = (u16*)(smem + SC_OPS);
  float* VV = (float*)(smem + SC_VV);
  float* WR = (float*)(smem + SC_WR);
  float* AP = (float*)(smem + SC_AP);
  float* YL = WR;
  u16* TWb = (u16*)(smem + SC_TW);
  u16* ADb = (u16*)(smem + SC_AD);
  float* NRM = (float*)(smem + SC_NRM);
  float* MU = (float*)(smem + SC_MU);
  float* CST = (float*)(smem + SC_CST);
  const float* mu_p = p.in[I_MU_PREV] + (size_t)l * 1920;
  const float* mu_n = p.in[I_MU_NEXT] + (size_t)l * 1920;
  const int tid = tid_, lane = tid & 63, w = tid >> 6, fr = lane & 15, fq = lane >> 4;
  const int pn = tid >> 3, j0 = (tid & 7) * 8;
  const int jg = lane & 7, i0 = w * 16 + (lane >> 3);
  const int hr = (tid >= 40) ? 1 : 0, hc = tid - hr * 40;
  for (int blk = blockIdx.x; blk < 192; blk += gridDim.x) {
    const int s = blk >> 4, h = (blk >> 1) & 7, d = blk & 1;
    __syncthreads();
    for (int i = tid; i < 640; i += 256) {
      const int which = (i >= 320) ? 1 : 0, c = i - which * 320;
      const int g = c >> 6, e = c & 63;
      const int col = (g < 3) ? (g * 512 + h * 64 + e) : (1536 + (g - 3) * 128 + d * 64 + e);
      MU[i] = which ? mu_n[col] : mu_p[col];
    }
    for (int i = tid; i < 320; i += 256) {
      const int which = i >> 6, e = i & 63;
      float v;
      if (which == 0) v = p.in[I_W0][(size_t)(l * 2 + d) * 512 + h * 64 + e];
      else if (which == 1) v = p.in[I_A0][(size_t)(l * 2 + d) * 512 + h * 64 + e];
      else if (which == 2) v = p.in[I_K_K][(size_t)l * 512 + h * 64 + e];
      else if (which == 3) v = p.in[I_K_A][(size_t)l * 512 + h * 64 + e];
      else v = p.in[I_R_K][(size_t)(l * 8 + h) * 64 + e];
      CST[i] = v;
    }
    bf16x8 bw[2], ba[2];
#pragma unroll
    for (int ks = 0; ks < 2; ++ks) {
      bw[ks] = *(const bf16x8*)(WB + W_WUP + (size_t)(d * 512 + h * 64 + w * 16 + fr) * 64 + ks * 32 + fq * 8);
      ba[ks] = *(const bf16x8*)(WB + W_AUP + (size_t)(d * 512 + h * 64 + w * 16 + fr) * 64 + ks * 32 + fq * 8);
    }
    _Float16* Y = d ? YB : YF;
    f32x2 S0[4], S1[4];
#pragma unroll
    for (int q = 0; q < 4; ++q) { S0[q] = (f32x2){0.f, 0.f}; S1[q] = (f32x2){0.f, 0.f}; }
    u32x4 G[5], GH;
    {
      const int t = d ? (4095 - pn) : pn;
      const size_t tok = (size_t)s * 4096 + t;
#pragma unroll
      for (int g = 0; g < 5; ++g) {
        const int col = (g < 3) ? (g * 512 + h * 64) : (1536 + (g - 3) * 128 + d * 64);
        G[g] = *(const u32x4*)(PR + tok * PRW + col + j0);
      }
      GH = (u32x4){0u, 0u, 0u, 0u};
      if (tid < 80) {
        const int tlo = d ? (4095 - 31) : 0;
        const int th = hr ? (tlo + 32) : (tlo - 1);
        const int g = hc >> 3;
        const int col = (g < 3) ? (g * 512 + h * 64) : (1536 + (g - 3) * 128 + d * 64);
        if (th >= 0 && th <= 4095) GH = *(const u32x4*)(PR + ((size_t)s * 4096 + th) * PRW + col + (hc & 7) * 8);
      }
    }
#pragma unroll 1
    for (int ch = 0; ch < 128; ++ch) {
      const int n = ch * 32 + pn;
      const int t = d ? (4095 - n) : n;
      const size_t tok = (size_t)s * 4096 + t;
      const int tlo = d ? (4095 - (ch * 32 + 31)) : (ch * 32);
      const int rrow = t - tlo + 1;
#pragma unroll
      for (int g = 0; g < 5; ++g) *(u32x4*)(RAW + rrow * 320 + g * 64 + j0) = G[g];
      if (tid < 80) *(u32x4*)(RAW + (hr ? 33 : 0) * 320 + (hc >> 3) * 64 + (hc & 7) * 8) = GH;
      __syncthreads();
      if (ch + 1 < 128) {
        const int n2 = n + 32;
        const int t2 = d ? (4095 - n2) : n2;
        const size_t tok2 = (size_t)s * 4096 + t2;
#pragma unroll
        for (int g = 0; g < 5; ++g) {
          const int col = (g < 3) ? (g * 512 + h * 64) : (1536 + (g - 3) * 128 + d * 64);
          G[g] = *(const u32x4*)(PR + tok2 * PRW + col + j0);
        }
        GH = (u32x4){0u, 0u, 0u, 0u};
        if (tid < 80) {
          const int tlo2 = d ? (tlo - 32) : (tlo + 32);
          const int th = hr ? (tlo2 + 32) : (tlo2 - 1);
          const int g = hc >> 3;
          const int col = (g < 3) ? (g * 512 + h * 64) : (1536 + (g - 3) * 128 + d * 64);
          if (th >= 0 && th <= 4095) GH = *(const u32x4*)(PR + ((size_t)s * 4096 + th) * PRW + col + (hc & 7) * 8);
        }
      }
#pragma unroll
      for (int g = 0; g < 5; ++g) {
        float cur[8], prv[8], nxt[8];
        load8bf(RAW + rrow * 320 + g * 64 + j0, cur);
        load8bf(RAW + (rrow - 1) * 320 + g * 64 + j0, prv);
        load8bf(RAW + (rrow + 1) * 320 + g * 64 + j0, nxt);
        const f32x4 mp0 = *(const f32x4*)(MU + g * 64 + j0), mp1 = *(const f32x4*)(MU + g * 64 + j0 + 4);
        const f32x4 mn0 = *(const f32x4*)(MU + 320 + g * 64 + j0), mn1 = *(const f32x4*)(MU + 320 + g * 64 + j0 + 4);
        f32x4 x0, x1;
#pragma unroll
        for (int e = 0; e < 4; ++e) {
          x0[e] = cur[e] + mp0[e] * (prv[e] - cur[e]) + mn0[e] * (nxt[e] - cur[e]);
          x1[e] = cur[4 + e] + mp1[e] * (prv[4 + e] - cur[4 + e]) + mn1[e] * (nxt[4 + e] - cur[4 + e]);
        }
        if (g == 0) {
          *(f32x4*)(OPS + 4 * 2048 + pn * 64 + j0) = x0; *(f32x4*)(OPS + 4 * 2048 + pn * 64 + j0 + 4) = x1;
        } else if (g == 1) {
          *(f32x4*)(OPS + 3 * 2048 + pn * 64 + j0) = x0; *(f32x4*)(OPS + 3 * 2048 + pn * 64 + j0 + 4) = x1;
          const f32x4 kk0 = *(const f32x4*)(CST + 128 + j0), kk1 = *(const f32x4*)(CST + 128 + j0 + 4);
          float ss = 0.f;
#pragma unroll
          for (int e = 0; e < 4; ++e) { const float a_ = x0[e] * kk0[e], b_ = x1[e] * kk1[e]; ss += a_ * a_ + b_ * b_; }
          ss = red8(ss);
          if ((tid & 7) == 0) NRM[pn] = 1.f / fmaxf(sqrtf(ss), 1e-12f);
        } else if (g == 2) {
          *(f32x4*)(VV + pn * 64 + j0) = x0; *(f32x4*)(VV + pn * 64 + j0 + 4) = x1;
        } else if (g == 3) {
          u32x4 pk;
          pk.x = pack2(tanhf(x0[0]), tanhf(x0[1])); pk.y = pack2(tanhf(x0[2]), tanhf(x0[3]));
          pk.z = pack2(tanhf(x1[0]), tanhf(x1[1])); pk.w = pack2(tanhf(x1[2]), tanhf(x1[3]));
          *(u32x4*)(TWb + pn * 72 + j0) = pk;
        } else {
          u32x4 pk;
          pk.x = pack2(x0[0], x0[1]); pk.y = pack2(x0[2], x0[3]);
          pk.z = pack2(x1[0], x1[1]); pk.w = pack2(x1[2], x1[3]);
          *(u32x4*)(ADb + pn * 72 + j0) = pk;
        }
      }
      __syncthreads();
#pragma unroll
      for (int m = 0; m < 2; ++m) {
        f32x4 cw = {0.f, 0.f, 0.f, 0.f}, ca = {0.f, 0.f, 0.f, 0.f};
#pragma unroll
        for (int ks = 0; ks < 2; ++ks) {
          const bf16x8 aw = *(const bf16x8*)(TWb + (m * 16 + fr) * 72 + ks * 32 + fq * 8);
          const bf16x8 aa = *(const bf16x8*)(ADb + (m * 16 + fr) * 72 + ks * 32 + fq * 8);
          cw = __builtin_amdgcn_mfma_f32_16x16x32_bf16(aw, bw[ks], cw, 0, 0, 0);
          ca = __builtin_amdgcn_mfma_f32_16x16x32_bf16(aa, ba[ks], ca, 0, 0, 0);
        }
#pragma unroll
        for (int jj = 0; jj < 4; ++jj) {
          WR[(m * 16 + fq * 4 + jj) * 64 + w * 16 + fr] = cw[jj];
          AP[(m * 16 + fq * 4 + jj) * 64 + w * 16 + fr] = ca[jj];
        }
      }
      __syncthreads();
      {
        const float inv = NRM[pn];
        float bsum = 0.f;
#pragma unroll
        for (int hq = 0; hq < 2; ++hq) {
          const int jb = j0 + hq * 4;
          const f32x4 wr_ = *(const f32x4*)(WR + pn * 64 + jb) + *(const f32x4*)(CST + jb);
          const f32x4 ap_ = *(const f32x4*)(AP + pn * 64 + jb) + *(const f32x4*)(CST + 64 + jb);
          const f32x4 kr = *(const f32x4*)(OPS + 3 * 2048 + pn * 64 + jb);
          const f32x4 rr = *(const f32x4*)(OPS + 4 * 2048 + pn * 64 + jb);
          const f32x4 kkw = *(const f32x4*)(CST + 128 + jb), kaw = *(const f32x4*)(CST + 192 + jb), rkw = *(const f32x4*)(CST + 256 + jb);
          f32x4 o0, o1, o2, o3;
#pragma unroll
          for (int e = 0; e < 4; ++e) {
            const float sw = 1.f / (1.f + expf(-wr_[e]));
            const float dec = expf(-0.6065306597126334f * sw);
            const float av = 1.f / (1.f + expf(-ap_[e]));
            const float kn = kr[e] * kkw[e] * inv;
            const float kd = kr[e] * (1.f + (av - 1.f) * kaw[e]);
            bsum += rr[e] * kd * rkw[e];
            o0[e] = -kn; o1[e] = dec; o2[e] = kn * av; o3[e] = kd;
          }
          *(f32x4*)(OPS + 0 * 2048 + pn * 64 + jb) = o0;
          *(f32x4*)(OPS + 1 * 2048 + pn * 64 + jb) = o1;
          *(f32x4*)(OPS + 2 * 2048 + pn * 64 + jb) = o2;
          *(f32x4*)(OPS + 3 * 2048 + pn * 64 + jb) = o3;
        }
        bsum = red8(bsum);
        if ((tid & 7) == 0) BON[(tok * 8 + h) * 2 + d] = bsum;
      }
      __syncthreads();
      {
        ScanOps oa, ob;
        scan_load(oa, OPS, VV, 0, jg, i0);
#pragma unroll 1
        for (int nn = 0; nn < 32; nn += 2) {
          scan_load(ob, OPS, VV, nn + 1, jg, i0);
          scan_step(oa, S0, S1, YL, nn, jg, i0);
          scan_load(oa, OPS, VV, (nn + 2) & 31, jg, i0);
          scan_step(ob, S0, S1, YL, nn + 1, jg, i0);
        }
      }
      __syncthreads();
      {
        h16x8 o;
#pragma unroll
        for (int e = 0; e < 8; ++e) o[e] = (_Float16)YL[pn * 64 + j0 + e];
        *(h16x8*)(Y + tok * 512 + h * 64 + j0) = o;
      }
    }
    __syncthreads();
  }
}

DEVI void phase_rwkv_post(int tid_, const Params& p, int l, char* smem) {
  u16* PR = (u16*)(p.ws + OFF_PR);
  const _Float16* YF = (const _Float16*)(p.ws + OFF_NK);
  const _Float16* YB = (const _Float16*)(p.ws + OFF_NV);
  const float* BON = (const float*)(p.ws + OFF_BONUS);
  const u16* GUPT = (const u16*)(p.ws + OFF_WB) + W_GUP;
  const float* mu_p = p.in[I_MU_PREV] + (size_t)l * 1920;
  const float* mu_n = p.in[I_MU_NEXT] + (size_t)l * 1920;
  const float* gng = p.in[I_GN_G] + (size_t)l * 512;
  const float* gnb = p.in[I_GN_B] + (size_t)l * 512;
  u16* As = (u16*)smem;
  const int tid = tid_, lane = tid & 63, w = tid >> 6, fr = lane & 15, fq = lane >> 4;
  for (int tile = blockIdx.x; tile < NTOK / 64; tile += gridDim.x) {
    const size_t tok0 = (size_t)tile * 64;
    {
      const int row = tid >> 2, part = tid & 3;
      const size_t tok = tok0 + row;
      const int t = (int)(tok & 4095);
#pragma unroll
      for (int q = 0; q < 4; ++q) {
        const int col = 1792 + part * 32 + q * 8;
        float cur[8], prv[8], nxt[8];
        load8bf(PR + tok * PRW + col, cur);
        if (t > 0) load8bf(PR + (tok - 1) * PRW + col, prv);
        else {
#pragma unroll
          for (int e = 0; e < 8; ++e) prv[e] = 0.f;
        }
        if (t < 4095) load8bf(PR + (tok + 1) * PRW + col, nxt);
        else {
#pragma unroll
          for (int e = 0; e < 8; ++e) nxt[e] = 0.f;
        }
        float o[8];
#pragma unroll
        for (int e = 0; e < 8; ++e) {
          const float x = cur[e] + mu_p[col + e] * (prv[e] - cur[e]) + mu_n[col + e] * (nxt[e] - cur[e]);
          o[e] = sigm(x);
        }
        u32x4 pk;
        pk.x = pack2(o[0], o[1]); pk.y = pack2(o[2], o[3]); pk.z = pack2(o[4], o[5]); pk.w = pack2(o[6], o[7]);
        *(u32x4*)(As + row * 136 + part * 32 + q * 8) = pk;
      }
    }
    __syncthreads();
#pragma unroll 1
    for (int chh = 0; chh < 2; ++chh) {
      f32x4 acc[16];
#pragma unroll
      for (int n = 0; n < 16; ++n) acc[n] = (f32x4){0.f, 0.f, 0.f, 0.f};
#pragma unroll
      for (int ks = 0; ks < 4; ++ks) {
        bf16x8 af = *(const bf16x8*)(As + (w * 16 + fr) * 136 + ks * 32 + fq * 8);
#pragma unroll
        for (int n = 0; n < 16; ++n) {
          bf16x8 bg = *(const bf16x8*)(GUPT + (size_t)(chh * 256 + n * 16 + fr) * 128 + ks * 32 + fq * 8);
          acc[n] = __builtin_amdgcn_mfma_f32_16x16x32_bf16(af, bg, acc[n], 0, 0, 0);
        }
      }
#pragma unroll
      for (int hl = 0; hl < 4; ++hl) {
        const int head = chh * 4 + hl;
#pragma unroll
        for (int j = 0; j < 4; ++j) {
          const size_t tok = tok0 + w * 16 + fq * 4 + j;
          const int t = (int)(tok & 4095);
          float o[4], sum = 0.f;
#pragma unroll
          for (int q = 0; q < 4; ++q) {
            const int col = head * 64 + q * 16 + fr;
            o[q] = (float)YF[tok * 512 + col] + (float)YB[tok * 512 + col];
            sum += o[q];
          }
          const float mean = red16_sum(sum) * (1.f / 64.f);
          float vs = 0.f;
#pragma unroll
          for (int q = 0; q < 4; ++q) { const float dlt = o[q] - mean; vs += dlt * dlt; }
          const float var = red16_sum(vs) * (1.f / 64.f);
          const float rstd = rsqrtf(var + 64e-5f);
          const float bon = BON[(tok * 8 + head) * 2] + BON[(tok * 8 + head) * 2 + 1];
#pragma unroll
          for (int q = 0; q < 4; ++q) {
            const int col = head * 64 + q * 16 + fr;
            const int vc = 1024 + col;
            const float cur = bf2f(PR[tok * PRW + vc]);
            const float prv = (t > 0) ? bf2f(PR[(tok - 1) * PRW + vc]) : 0.f;
            const float nxt = (t < 4095) ? bf2f(PR[(tok + 1) * PRW + vc]) : 0.f;
            const float vsh = cur + mu_p[vc] * (prv - cur) + mu_n[vc] * (nxt - cur);
            const float yv = ((o[q] - mean) * rstd * gng[col] + gnb[col] + bon * vsh) * acc[hl * 4 + q][j];
            PR[tok * PRW + col] = f2bf(yv);
          }
        }
      }
    }
    __syncthreads();
  }
}

DEVI void phase_merge(int tid_, const Params& p, char* smem) {
  const u16* WB = (const u16*)(p.ws + OFF_WB);
  const u16* H = (const u16*)(p.ws + OFF_H);
  u16* PR = (u16*)(p.ws + OFF_PR);
  const u16* NQ = (const u16*)(p.ws + OFF_NQ);
  const int lane = tid_ & 63, wid = tid_ >> 6;
  const int wr = wid >> 1, wc = wid & 1, fr = lane & 15, fq = lane >> 4;
  const int xcd = blockIdx.x & 7, jloc = blockIdx.x >> 3, nloc = gridDim.x >> 3;
  for (int lt = jloc; lt < 48 * 16; lt += nloc) {
    const int tm = (lt >> 4) * 8 + xcd, tn = lt & 15;
    const int m0 = tm << 7, n0 = tn << 6;
    f32x4 g[4][2], acc[4][2];
    uint32_t mp[4][2][2];
    zero_acc(g);
    gemm_kloop<2, true>(launder(tid_), g, H + (size_t)m0 * 1024, 1024, WB + W_IN + (size_t)(3456 + n0) * 1024, 1024, 1024, smem);
    zero_acc(acc);
    gemm_kloop<2, true>(launder(tid_), acc, PR + (size_t)m0 * PRW, PRW, WB + W_BRR + (size_t)n0 * 512, 512, 512, smem);
#pragma unroll
    for (int m = 0; m < 4; ++m)
#pragma unroll
      for (int n = 0; n < 2; ++n) {
        mp[m][n][0] = pack2(sigm(g[m][n][0]) * acc[m][n][0], sigm(g[m][n][1]) * acc[m][n][1]);
        mp[m][n][1] = pack2(sigm(g[m][n][2]) * acc[m][n][2], sigm(g[m][n][3]) * acc[m][n][3]);
      }
    zero_acc(g);
    gemm_kloop<2, true>(launder(tid_), g, H + (size_t)m0 * 1024, 1024, WB + W_IN + (size_t)(4480 + n0) * 1024, 1024, 1024, smem);
    zero_acc(acc);
    gemm_kloop<2, true>(launder(tid_), acc, NQ + (size_t)m0 * 512, 512, WB + W_BRN + (size_t)n0 * 512, 512, 512, smem);
#pragma unroll
    for (int m = 0; m < 4; ++m)
#pragma unroll
      for (int n = 0; n < 2; ++n) {
        const int r = m0 + wr * 64 + m * 16 + fr, c0 = n0 + wc * 32 + n * 16 + fq * 4;
        f32x4 o;
        o[0] = __uint_as_float(mp[m][n][0] << 16) + sigm(g[m][n][0]) * acc[m][n][0];
        o[1] = __uint_as_float(mp[m][n][0] & 0xffff0000u) + sigm(g[m][n][1]) * acc[m][n][1];
        o[2] = __uint_as_float(mp[m][n][1] << 16) + sigm(g[m][n][2]) * acc[m][n][2];
        o[3] = __uint_as_float(mp[m][n][1] & 0xffff0000u) + sigm(g[m][n][3]) * acc[m][n][3];
        store4bf(PR + (size_t)r * PRW + 512 + c0, o);
      }
  }
}

DEVI void phase_xattn(int tid_, const Params& p, char* smem) {
  const u16* Q = (const u16*)(p.ws + OFF_PR);
  u16* O = (u16*)(p.ws + OFF_NQ);
  const u16* KVK = (const u16*)(p.ws + OFF_KVK);
  const u16* KVT = (const u16*)(p.ws + OFF_KVT);
  const int lane = tid_ & 63, w = tid_ >> 6, fr = lane & 15, fq = lane >> 4;
  u16* Pw = (u16*)smem + w * (16 * 264);
  for (int t = blockIdx.x; t < (NTOK / 64) * 4; t += gridDim.x) {
    const int hh = t & 3;
    const size_t tok0 = (size_t)(t >> 2) * 64 + w * 16;
    const int s = (int)(tok0 >> 12);
    f32x4 acc[16];
#pragma unroll
    for (int n = 0; n < 16; ++n) acc[n] = (f32x4){0.f, 0.f, 0.f, 0.f};
#pragma unroll 2
    for (int ks = 0; ks < 8; ++ks) {
      bf16x8 aq = *(const bf16x8*)(Q + (tok0 + fr) * 1024 + hh * 256 + ks * 32 + fq * 8);
#pragma unroll
      for (int n = 0; n < 16; ++n) {
        bf16x8 bk = *(const bf16x8*)(KVK + (size_t)(s * 256 + n * 16 + fr) * 1024 + hh * 256 + ks * 32 + fq * 8);
        acc[n] = __builtin_amdgcn_mfma_f32_16x16x32_bf16(aq, bk, acc[n], 0, 0, 0);
      }
    }
    float sm[4];
#pragma unroll
    for (int j = 0; j < 4; ++j) {
      float m = -1e30f;
#pragma unroll
      for (int n = 0; n < 16; ++n) { acc[n][j] *= 0.0625f; m = fmaxf(m, acc[n][j]); }
      m = red16_max(m);
      float ssum = 0.f;
#pragma unroll
      for (int n = 0; n < 16; ++n) { const float e = __expf(acc[n][j] - m); acc[n][j] = e; ssum += e; }
      sm[j] = 1.f / red16_sum(ssum);
    }
    __syncthreads();
#pragma unroll
    for (int n = 0; n < 16; ++n)
#pragma unroll
      for (int j = 0; j < 4; ++j) Pw[(fq * 4 + j) * 264 + n * 16 + fr] = f2bf(acc[n][j]);
    __syncthreads();
#pragma unroll
    for (int n = 0; n < 16; ++n) acc[n] = (f32x4){0.f, 0.f, 0.f, 0.f};
#pragma unroll 2
    for (int ks = 0; ks < 8; ++ks) {
      bf16x8 ap = *(const bf16x8*)(Pw + fr * 264 + ks * 32 + fq * 8);
#pragma unroll
      for (int n = 0; n < 16; ++n) {
        bf16x8 bv = *(const bf16x8*)(KVT + (size_t)(s * 1024 + hh * 256 + n * 16 + fr) * 256 + ks * 32 + fq * 8);
        acc[n] = __builtin_amdgcn_mfma_f32_16x16x32_bf16(ap, bv, acc[n], 0, 0, 0);
      }
    }
#pragma unroll
    for (int n = 0; n < 16; ++n)
#pragma unroll
      for (int j = 0; j < 4; ++j)
        O[(tok0 + fq * 4 + j) * 1024 + hh * 256 + n * 16 + fr] = f2bf(acc[n][j] * sm[j]);
  }
}

DEVI void run_phase(int tid_, const Params& p, int ph, char* smem) {
  if (ph == 2 * NPH_LAYER) { phase_final_norm(tid_, p); return; }
  const int l = ph / NPH_LAYER, q = ph % NPH_LAYER;
  u16* WB = (u16*)(p.ws + OFF_WB);
  u16* H = (u16*)(p.ws + OFF_H);
  u16* PR = (u16*)(p.ws + OFF_PR);
  u16* NQ = (u16*)(p.ws + OFF_NQ);
  float* X = p.X;
  auto epi_res = [&](int r, int c0, f32x4 v) {
    f32x4* px = (f32x4*)(X + (size_t)r * 1024 + c0);
    *px = *px + v;
  };
  constexpr int NONS = 1 << 30;
  switch (q) {
    case 0:
      phase_conv(tid_, p, l, smem);
      phase_norm(tid_, p, p.in[I_NORM_MIX] + (size_t)l * 1024, l == 0);
      phase_norm_mem(tid_, p, p.in[I_NORM_MEM] + (size_t)l * 1024);
      break;
    case 1: phase_p_gemm(tid_, p, smem); break;
    case 2: phase_nat(tid_, p, l, smem); break;
    case 3: phase_scan(tid_, p, l, smem); break;
    case 4: phase_rwkv_post(tid_, p, l, smem); break;
    case 5: phase_merge(tid_, p, smem); break;
    case 6: gemm_phase_big(tid_, PR + 512, PRW, WB + W_OUT, 1024, 1024, NTOK, 1024, smem, NONS, epi_res, NoEpi()); break;
    case 7: phase_norm(tid_, p, p.in[I_NORM_X] + (size_t)l * 1024, false); break;
    case 8:
      gemm_phase_big(tid_, H, 1024, WB + W_XQ, 1024, 1024, NTOK, 1024, smem, NONS,
                 [&](int r, int c0, f32x4 v) { store4bf(PR + (size_t)r * 1024 + c0, v); }, NoEpi());
      break;
    case 9: phase_xattn(tid_, p, smem); break;
    case 10: gemm_phase_big(tid_, NQ, 1024, WB + W_XO, 1024, 1024, NTOK, 1024, smem, NONS, epi_res, NoEpi()); break;
    case 11: phase_norm(tid_, p, p.in[I_NORM_FF] + (size_t)l * 1024, false); break;
    case 12:
    case 14: {
      const int hf = (q == 14);
      gemm_phase_big(tid_, H, 1024, WB + W_FF1 + (size_t)hf * 2048 * 1024, 1024, 1024, NTOK, 2048, smem, NONS,
                 [&](int r, int c0, f32x4 v) {
                   f32x4 o;
#pragma unroll
                   for (int j = 0; j < 4; ++j) { const float x = fmaxf(v[j], 0.f); o[j] = x * x; }
                   store4bf(PR + (size_t)r * 2048 + c0, o);
                 }, NoEpi());
    } break;
    case 13:
    case 15: {
      const int hf = (q == 15);
      gemm_phase_big(tid_, PR, 2048, WB + W_FF2 + (size_t)hf * 2048, 4096, 2048, NTOK, 1024, smem, NONS, epi_res, NoEpi());
    } break;
  }
}

#define XB_TMO      128
#define XB_XCNT(j)  (256  + 64 * (j))
#define XB_XSUB(j)  (1280 + 64 * (j))
#define XB_XGEN(j)  (2304 + 64 * (j))
#define XB_TOP      3328
#define XB_TOPGEN   3392
#define XCD_BAR_WORDS 3456
#define XB_SPIN_CAP (1u << 20)
#define LAS __attribute__((address_space(3)))

DEVI unsigned xb_ld(unsigned* p) { return __hip_atomic_load(p, __ATOMIC_RELAXED, __HIP_MEMORY_SCOPE_AGENT); }
DEVI unsigned xb_add(unsigned* p, unsigned v) { return __hip_atomic_fetch_add(p, v, __ATOMIC_RELAXED, __HIP_MEMORY_SCOPE_AGENT); }
DEVI unsigned xb_xcc_id() { return (unsigned)__builtin_amdgcn_s_getreg((3 << 11) | 20) & 0xFu; }
#define XB_SPIN(cond, bar) do { unsigned _sp = 0; while (cond) { __builtin_amdgcn_s_sleep(1); \
    if ((++_sp & 255u) == 0u) { if (xb_ld(&(bar)[XB_TMO])) break; if (_sp > XB_SPIN_CAP) { atomicAdd(&(bar)[XB_TMO], 1u); break; } } } } while (0)

struct XcdBarrier {
  unsigned* bar; unsigned x;
  volatile LAS unsigned* st;
};
DEVI XcdBarrier xcd_barrier_post(unsigned* bar, volatile LAS unsigned* st) {
  XcdBarrier b; b.bar = bar; b.x = xb_xcc_id(); b.st = st;
  if (threadIdx.x == 0) (void)xb_add(&bar[XB_XCNT(b.x)], 1u);
  return b;
}
DEVI void xcd_barrier_complete(unsigned* bar, unsigned x, unsigned& nloc, unsigned& nx) {
  const unsigned G = gridDim.x * gridDim.y * gridDim.z;
  unsigned sum, cnt, mine, sp = 0u;
  for (;;) {
    sum = 0u; cnt = 0u; mine = 0u;
#pragma unroll
    for (unsigned j = 0; j < 16; ++j) { const unsigned c = xb_ld(&bar[XB_XCNT(j)]); sum += c; cnt += (c > 0u) ? 1u : 0u; mine = (j == x) ? c : mine; }
    if (sum == G) break;
    __builtin_amdgcn_s_sleep(1);
    if ((++sp & 255u) == 0u) { if (xb_ld(&bar[XB_TMO])) break; if (sp > XB_SPIN_CAP) { atomicAdd(&bar[XB_TMO], 1u); break; } }
  }
  nloc = mine > 0u ? mine : 1u; nx = cnt > 0u ? cnt : 1u;
}
DEVI void xcd_barrier(const XcdBarrier& b) {
  asm volatile("s_waitcnt vmcnt(0)" ::: "memory");
  __syncthreads();
  if (threadIdx.x == 0) {
    unsigned* bar = b.bar;
    __builtin_amdgcn_s_waitcnt(0);
    unsigned nloc = b.st[0], nx = b.st[1];
    if (nloc == 0u) { xcd_barrier_complete(bar, b.x, nloc, nx); b.st[0] = nloc; b.st[1] = nx; }
    const unsigned old = xb_add(&bar[XB_XSUB(b.x)], 1u);
    const unsigned gen = old / nloc;
    if (old + 1u == (gen + 1u) * nloc) {
      __builtin_amdgcn_fence(__ATOMIC_RELEASE, "agent");
      asm volatile("s_waitcnt vmcnt(0)" ::: "memory");
      const unsigned og = xb_add(&bar[XB_TOP], 1u);
      const unsigned tg = og / nx;
      if (og + 1u == (tg + 1u) * nx) xb_add(&bar[XB_TOPGEN], 1u);
      else XB_SPIN(xb_ld(&bar[XB_TOPGEN]) == tg, bar);
      __builtin_amdgcn_fence(__ATOMIC_ACQUIRE, "agent");
      xb_add(&bar[XB_XGEN(b.x)], 1u);
      asm volatile("s_waitcnt vmcnt(0)" ::: "memory");
    } else {
      XB_SPIN(xb_ld(&bar[XB_XGEN(b.x)]) == gen, bar);
      __builtin_amdgcn_fence(__ATOMIC_ACQUIRE, "agent");
      asm volatile("s_waitcnt vmcnt(0)" ::: "memory");
    }
  }
  __syncthreads();
}

__global__ void __launch_bounds__(256, 2) mega_kernel(Params p, int ph0, int ph1) {
  __shared__ __attribute__((aligned(16))) char smem[SMEM_BYTES];
  __shared__ __attribute__((aligned(16))) unsigned xb_words[4];
  if (threadIdx.x == 0) { xb_words[0] = 0u; xb_words[1] = 0u; xb_words[2] = 0u; xb_words[3] = 0u; }
  __syncthreads();
  XcdBarrier xb = xcd_barrier_post((unsigned*)(p.ws + OFF_BAR), (volatile LAS unsigned*)xb_words);
  for (int ph = ph0; ph < ph1; ++ph) {
    if (ph == ph0 + 1) cg::this_grid().sync();
    else if (ph > ph0) xcd_barrier(xb);
    int tid_ = threadIdx.x;
    asm volatile("" : "+v"(tid_));
    run_phase(tid_, p, ph, smem);
  }
}

extern "C" void kernel_launch(void* const* d_in, const int* in_sizes, int n_in, void* d_out, int out_size, void* d_ws,
                              size_t ws_size, hipStream_t stream) {
  if (ws_size < WS_NEED || n_in < 31) return;
  Params p{};
  for (int i = 0; i < 31; ++i) p.in[i] = (const float*)d_in[i];
  p.X = (float*)d_out;
  p.ws = (char*)d_ws;
  static int grid_blocks = 0;
  if (!grid_blocks) {
    int dev = 0, cus = 0, per_cu = 0;
    hipGetDevice(&dev);
    hipDeviceGetAttribute(&cus, hipDeviceAttributeMultiprocessorCount, dev);
    hipOccupancyMaxActiveBlocksPerMultiprocessor(&per_cu, mega_kernel, 256, 0);
    if (per_cu > 2) per_cu = 2;
    if (per_cu < 1) per_cu = 1;
    grid_blocks = cus * per_cu;
  }
  hipMemsetAsync((char*)d_ws + OFF_BAR, 0, 16384, stream);
  int ph0 = 0, ph1 = NPHASES;
  void* args[] = {&p, &ph0, &ph1};
  hipLaunchCooperativeKernel((void*)mega_kernel, dim3(grid_blocks), dim3(256), args, 0, stream);
}
```

```cpp
#include <hip/hip_runtime.h>
#include <hip/hip_cooperative_groups.h>
#include <stdint.h>
namespace cg = cooperative_groups;

typedef unsigned short u16;
typedef __attribute__((ext_vector_type(8))) short bf16x8;
typedef __attribute__((ext_vector_type(4))) float f32x4;
typedef __attribute__((ext_vector_type(8))) _Float16 h16x8;
typedef __attribute__((ext_vector_type(4))) unsigned int u32x4;
typedef __attribute__((ext_vector_type(2))) unsigned int u32x2;

#define DEVI __device__ __forceinline__

constexpr int NTOK = 49152;
constexpr int SEQ_T = 4096;
constexpr int PRW = 1920;
constexpr int NPH_LAYER = 16;
constexpr int NPHASES = 2 * NPH_LAYER + 1;
constexpr int SMEM_BYTES = 78720;

constexpr size_t OFF_WB = 0;
constexpr size_t WB_BYTES = 20512768ull * 2;
constexpr size_t OFF_H = OFF_WB + WB_BYTES;
constexpr size_t OFF_PR = OFF_H + (size_t)NTOK * 1024 * 2;
constexpr size_t OFF_NQ = OFF_PR + (size_t)NTOK * PRW * 2;
constexpr size_t OFF_NK = OFF_NQ + (size_t)NTOK * 512 * 2;
constexpr size_t OFF_NV = OFF_NK + (size_t)NTOK * 512 * 2;
constexpr size_t OFF_KVK = OFF_NV + (size_t)NTOK * 512 * 2;
constexpr size_t OFF_KVT = OFF_KVK + (size_t)3072 * 1024 * 2;
constexpr size_t OFF_MEMH = OFF_KVT + (size_t)3072 * 1024 * 2;
constexpr size_t OFF_BONUS = OFF_MEMH + (size_t)3072 * 1024 * 2;
constexpr size_t OFF_BAR = OFF_BONUS + (size_t)NTOK * 16 * 4;
constexpr size_t WS_NEED = OFF_BAR + 16384;

constexpr size_t W_IN = 0;
constexpr size_t W_BRR = W_IN + (size_t)5504 * 1024;
constexpr size_t W_BRN = W_BRR + (size_t)1024 * 512;
constexpr size_t W_OUT = W_BRN + (size_t)1024 * 512;
constexpr size_t W_XQ = W_OUT + (size_t)1024 * 1024;
constexpr size_t W_XKV = W_XQ + (size_t)1024 * 1024;
constexpr size_t W_XO = W_XKV + (size_t)2048 * 1024;
constexpr size_t W_FF1 = W_XO + (size_t)1024 * 1024;
constexpr size_t W_FF2 = W_FF1 + (size_t)4096 * 1024;
constexpr size_t W_GUP = W_FF2 + (size_t)4096 * 1024;
constexpr size_t W_WUP = W_GUP + (size_t)512 * 128;
constexpr size_t W_AUP = W_WUP + (size_t)2 * 512 * 64;

enum { I_XP = 0, I_XS, I_MP, I_MS, I_NORM_MIX, I_W_IN, I_MU_PREV, I_MU_NEXT, I_W0, I_W_UP, I_A0, I_A_UP,
       I_G_UP, I_K_K, I_K_A, I_R_K, I_GN_G, I_GN_B, I_RPB, I_W_BR_RWKV, I_W_BR_NAT, I_W_OUT, I_NORM_X,
       I_NORM_MEM, I_W_XQ, I_W_XKV, I_W_XO, I_NORM_FF, I_W_FF1, I_W_FF2, I_NORM_FINAL };

struct Params {
  const float* in[31];
  float* X;
  char* ws;
};

DEVI u16 f2bf(float f) {
  uint32_t u = __float_as_uint(f);
  u += 0x7FFFu + ((u >> 16) & 1u);
  return (u16)(u >> 16);
}
DEVI float bf2f(u16 h) { return __uint_as_float(((uint32_t)h) << 16); }
DEVI uint32_t pack2(float a, float b) { return (uint32_t)f2bf(a) | ((uint32_t)f2bf(b) << 16); }
DEVI float frcp(float x) { return __builtin_amdgcn_rcpf(x); }
DEVI float sigm(float x) { return frcp(1.f + __expf(-x)); }
DEVI float ftanh(float x) { return 1.f - 2.f * frcp(__expf(2.f * x) + 1.f); }
DEVI void unpack8(u32x4 u, float* o) {
  o[0] = __uint_as_float(u.x << 16); o[1] = __uint_as_float(u.x & 0xffff0000u);
  o[2] = __uint_as_float(u.y << 16); o[3] = __uint_as_float(u.y & 0xffff0000u);
  o[4] = __uint_as_float(u.z << 16); o[5] = __uint_as_float(u.z & 0xffff0000u);
  o[6] = __uint_as_float(u.w << 16); o[7] = __uint_as_float(u.w & 0xffff0000u);
}
DEVI void load8bf(const u16* p, float* o) { unpack8(*(const u32x4*)p, o); }
DEVI float wave_sum(float v) {
  v += __shfl_xor(v, 32); v += __shfl_xor(v, 16); v += __shfl_xor(v, 8);
  v += __shfl_xor(v, 4); v += __shfl_xor(v, 2); v += __shfl_xor(v, 1);
  return v;
}
DEVI float red16_sum(float v) {
  v += __shfl_xor(v, 1); v += __shfl_xor(v, 2); v += __shfl_xor(v, 4); v += __shfl_xor(v, 8);
  return v;
}
DEVI float red16_max(float v) {
  v = fmaxf(v, __shfl_xor(v, 1)); v = fmaxf(v, __shfl_xor(v, 2));
  v = fmaxf(v, __shfl_xor(v, 4)); v = fmaxf(v, __shfl_xor(v, 8));
  return v;
}

DEVI void conv_tile(int tid_, const float* src, int K, int N, u16* dst, int tile, char* smem) {
  float (*s)[65] = (float (*)[65])smem;
  const int nN = N >> 6;
  const int tk = tile / nN, tn = tile - tk * nN;
  const int tx = tid_ & 63, ty = tid_ >> 6;
  for (int r = ty; r < 64; r += 4) s[r][tx] = src[(size_t)(tk * 64 + r) * N + tn * 64 + tx];
  __syncthreads();
  for (int r = ty; r < 64; r += 4) dst[(size_t)(tn * 64 + r) * K + tk * 64 + tx] = f2bf(s[tx][r]);
  __syncthreads();
}

DEVI void phase_conv(int tid_, const Params& p, int l, char* smem) {
  u16* WB = (u16*)(p.ws + OFF_WB);
  const int c0 = 1376, c1 = c0 + 128, c2 = c1 + 128, c3 = c2 + 256, c4 = c3 + 256, c5 = c4 + 512,
            c6 = c5 + 256, c7 = c6 + 1024, c8 = c7 + 1024, c9 = c8 + 16, c10 = c9 + 16, c11 = c10 + 16;
  for (int t = blockIdx.x; t < c11; t += gridDim.x) {
    if (t < c0) conv_tile(tid_, p.in[I_W_IN] + (size_t)l * 1024 * 5504, 1024, 5504, WB + W_IN, t, smem);
    else if (t < c1) conv_tile(tid_, p.in[I_W_BR_RWKV] + (size_t)l * 512 * 1024, 512, 1024, WB + W_BRR, t - c0, smem);
    else if (t < c2) conv_tile(tid_, p.in[I_W_BR_NAT] + (size_t)l * 512 * 1024, 512, 1024, WB + W_BRN, t - c1, smem);
    else if (t < c3) conv_tile(tid_, p.in[I_W_OUT] + (size_t)l * 1024 * 1024, 1024, 1024, WB + W_OUT, t - c2, smem);
    else if (t < c4) conv_tile(tid_, p.in[I_W_XQ] + (size_t)l * 1024 * 1024, 1024, 1024, WB + W_XQ, t - c3, smem);
    else if (t < c5) conv_tile(tid_, p.in[I_W_XKV] + (size_t)l * 1024 * 2048, 1024, 2048, WB + W_XKV, t - c4, smem);
    else if (t < c6) conv_tile(tid_, p.in[I_W_XO] + (size_t)l * 1024 * 1024, 1024, 1024, WB + W_XO, t - c5, smem);
    else if (t < c7) conv_tile(tid_, p.in[I_W_FF1] + (size_t)l * 1024 * 4096, 1024, 4096, WB + W_FF1, t - c6, smem);
    else if (t < c8) conv_tile(tid_, p.in[I_W_FF2] + (size_t)l * 4096 * 1024, 4096, 1024, WB + W_FF2, t - c7, smem);
    else if (t < c9) conv_tile(tid_, p.in[I_G_UP] + (size_t)l * 128 * 512, 128, 512, WB + W_GUP, t - c8, smem);
    else if (t < c10) { const int dd = (t - c9) >> 3; conv_tile(tid_, p.in[I_W_UP] + (size_t)(l * 2 + dd) * 64 * 512, 64, 512, WB + W_WUP + (size_t)dd * 512 * 64, (t - c9) & 7, smem); }
    else { const int dd = (t - c10) >> 3; conv_tile(tid_, p.in[I_A_UP] + (size_t)(l * 2 + dd) * 64 * 512, 64, 512, WB + W_AUP + (size_t)dd * 512 * 64, (t - c10) & 7, smem); }
  }
}

DEVI void norm_row_bf16(int tid_, const float* src, const float* g, u16* dst, float* xcopy) {
  const int lane = tid_ & 63;
  float4 v[4];
  float ss = 0.f;
#pragma unroll
  for (int i = 0; i < 4; ++i) {
    v[i] = ((const float4*)src)[lane + i * 64];
    ss += v[i].x * v[i].x + v[i].y * v[i].y + v[i].z * v[i].z + v[i].w * v[i].w;
  }
  ss = wave_sum(ss);
  const float rs = rsqrtf(ss * (1.f / 1024.f) + 1e-6f);
#pragma unroll
  for (int i = 0; i < 4; ++i) {
    float4 gg = ((const float4*)g)[lane + i * 64];
    u32x2 o;
    o.x = pack2(v[i].x * rs * gg.x, v[i].y * rs * gg.y);
    o.y = pack2(v[i].z * rs * gg.z, v[i].w * rs * gg.w);
    ((u32x2*)dst)[lane + i * 64] = o;
    if (xcopy) ((float4*)xcopy)[lane + i * 64] = v[i];
  }
}

DEVI void phase_norm(int tid_, const Params& p, const float* g, bool from_input) {
  u16* H = (u16*)(p.ws + OFF_H);
  const int wid = tid_ >> 6;
  for (int r = blockIdx.x * 4 + wid; r < NTOK; r += gridDim.x * 4) {
    const float* src;
    if (from_input) src = (r < 32768) ? p.in[I_XP] + (size_t)r * 1024 : p.in[I_XS] + (size_t)(r - 32768) * 1024;
    else src = p.X + (size_t)r * 1024;
    norm_row_bf16(tid_, src, g, H + (size_t)r * 1024, from_input ? p.X + (size_t)r * 1024 : nullptr);
  }
}
DEVI void phase_norm_mem(int tid_, const Params& p, const float* g) {
  u16* MH = (u16*)(p.ws + OFF_MEMH);
  const int wid = tid_ >> 6;
  for (int r = blockIdx.x * 4 + wid; r < 3072; r += gridDim.x * 4) {
    const float* src = (r < 2048) ? p.in[I_MP] + (size_t)r * 1024 : p.in[I_MS] + (size_t)(r - 2048) * 1024;
    norm_row_bf16(tid_, src, g, MH + (size_t)r * 1024, nullptr);
  }
}
DEVI void phase_final_norm(int tid_, const Params& p) {
  const float* g = p.in[I_NORM_FINAL];
  const int wid = tid_ >> 6, lane = tid_ & 63;
  for (int r = blockIdx.x * 4 + wid; r < NTOK; r += gridDim.x * 4) {
    float* row = p.X + (size_t)r * 1024;
    float4 v[4];
    float ss = 0.f;
#pragma unroll
    for (int i = 0; i < 4; ++i) {
      v[i] = ((const float4*)row)[lane + i * 64];
      ss += v[i].x * v[i].x + v[i].y * v[i].y + v[i].z * v[i].z + v[i].w * v[i].w;
    }
    ss = wave_sum(ss);
    const float rs = rsqrtf(ss * (1.f / 1024.f) + 1e-6f);
#pragma unroll
    for (int i = 0; i < 4; ++i) {
      float4 gg = ((const float4*)g)[lane + i * 64];
      float4 o;
      o.x = v[i].x * rs * gg.x; o.y = v[i].y * rs * gg.y; o.z = v[i].z * rs * gg.z; o.w = v[i].w * rs * gg.w;
      ((float4*)row)[lane + i * 64] = o;
    }
  }
}

template <int OFF>
DEVI bf16x8 lds_rd128(uint32_t addr) {
  bf16x8 r;
  asm volatile("ds_read_b128 %0, %1 offset:%2" : "=v"(r) : "v"(addr), "n"(OFF));
  return r;
}

template <int NW, bool SWAP>
DEVI void gemm_kloop(int tid_, f32x4 (&acc)[4][NW], const u16* __restrict__ A, int lda, const u16* __restrict__ Bt, int ldb,
                     int K, char* smem) {
  constexpr int STG = 8192 + NW * 2048;
  constexpr int NB = NW / 2;
  const int tid = tid_, lane = tid & 63, wid = tid >> 6;
  const int wr = wid >> 1, wc = wid & 1, fr = lane & 15, fq = lane >> 4;
  const int lrow = lane >> 2, lphys = lane & 3, lhi = lane >> 4;
  const int gsw = (4 - lhi) & 3;
  const u16* ga[2];
  const u16* gb[NB];
#pragma unroll
  for (int q = 0; q < 2; ++q) ga[q] = A + (size_t)((wid * 2 + q) * 16 + lrow) * lda + (lphys ^ gsw) * 8;
#pragma unroll
  for (int q = 0; q < NB; ++q) gb[q] = Bt + (size_t)((wid * NB + q) * 16 + lrow) * ldb + (lphys ^ gsw) * 8;
  const int rsw = (4 - ((fr >> 2) & 3)) & 3;
  const int ch = (fq ^ rsw) * 16;
  const int nk = K >> 5;
  const uint32_t lds_base = (uint32_t)(size_t)(__attribute__((address_space(3))) char*)smem;
  const uint32_t aoff = (uint32_t)((wr * 64 + fr) * 64 + ch);
  const uint32_t boff = (uint32_t)(8192 + (wc * 16 * NW + fr) * 64 + ch);
  asm volatile("s_waitcnt vmcnt(0)" ::: "memory");
  __syncthreads();
#define GEMM_ISSUE(kt_)                                                                                              \
  do {                                                                                                               \
    char* nb_ = smem + ((kt_) & 3) * STG;                                                                            \
    _Pragma("unroll") for (int q = 0; q < 2; ++q) __builtin_amdgcn_global_load_lds(                                  \
        (const unsigned*)(ga[q] + (kt_) * 32),                                                                       \
        (__attribute__((address_space(3))) unsigned*)(nb_ + (wid * 2 + q) * 1024 + lane * 16), 16, 0, 0);            \
    _Pragma("unroll") for (int q = 0; q < NB; ++q) __builtin_amdgcn_global_load_lds(                                 \
        (const unsigned*)(gb[q] + (kt_) * 32),                                                                       \
        (__attribute__((address_space(3))) unsigned*)(nb_ + 8192 + (wid * NB + q) * 1024 + lane * 16), 16, 0, 0);    \
  } while (0)
  GEMM_ISSUE(0);
  if (nk > 1) GEMM_ISSUE(1);
  if (nk > 2) GEMM_ISSUE(2);
  for (int kt = 0; kt < nk; ++kt) {
    if (kt + 2 < nk) {
      if (NW == 4) asm volatile("s_waitcnt vmcnt(8)" ::: "memory");
      else asm volatile("s_waitcnt vmcnt(6)" ::: "memory");
    } else if (kt + 1 < nk) {
      if (NW == 4) asm volatile("s_waitcnt vmcnt(4)" ::: "memory");
      else asm volatile("s_waitcnt vmcnt(3)" ::: "memory");
    } else {
      asm volatile("s_waitcnt vmcnt(0)" ::: "memory");
    }
    __builtin_amdgcn_s_barrier();
    asm volatile("" ::: "memory");
    if (kt + 3 < nk) GEMM_ISSUE(kt + 3);
    const uint32_t sb = lds_base + (kt & 3) * STG;
    bf16x8 af[4], bfr[4];
    af[0] = lds_rd128<0>(sb + aoff); af[1] = lds_rd128<1024>(sb + aoff);
    af[2] = lds_rd128<2048>(sb + aoff); af[3] = lds_rd128<3072>(sb + aoff);
    bfr[0] = lds_rd128<0>(sb + boff); bfr[1] = lds_rd128<1024>(sb + boff);
    if (NW == 4) {
      bfr[2] = lds_rd128<2048>(sb + boff); bfr[3] = lds_rd128<3072>(sb + boff);
      asm volatile("s_waitcnt lgkmcnt(0)" : "+v"(af[0]), "+v"(af[1]), "+v"(af[2]), "+v"(af[3]),
                   "+v"(bfr[0]), "+v"(bfr[1]), "+v"(bfr[2]), "+v"(bfr[3]));
    } else {
      asm volatile("s_waitcnt lgkmcnt(0)" : "+v"(af[0]), "+v"(af[1]), "+v"(af[2]), "+v"(af[3]), "+v"(bfr[0]), "+v"(bfr[1]));
    }
#pragma unroll
    for (int m = 0; m < 4; ++m)
#pragma unroll
      for (int n = 0; n < NW; ++n) {
        if (SWAP) acc[m][n] = __builtin_amdgcn_mfma_f32_16x16x32_bf16(bfr[n], af[m], acc[m][n], 0, 0, 0);
        else acc[m][n] = __builtin_amdgcn_mfma_f32_16x16x32_bf16(af[m], bfr[n], acc[m][n], 0, 0, 0);
      }
  }
#undef GEMM_ISSUE
}

DEVI int launder(int x) { asm volatile("" : "+v"(x)); return x; }

template <int NW>
DEVI void zero_acc(f32x4 (&acc)[4][NW]) {
#pragma unroll
  for (int m = 0; m < 4; ++m)
#pragma unroll
    for (int n = 0; n < NW; ++n) acc[m][n] = (f32x4){0.f, 0.f, 0.f, 0.f};
}

struct NoEpi { DEVI void operator()(int, int, f32x4) const {} };

template <class EpiS, class EpiN>
DEVI void gemm_phase(int tid_, const u16* A, int lda, const u16* Bt, int ldb, int K, int M, int N, char* smem, int ns_from,
                     EpiS epiS, EpiN epiN) {
  const int nN = N >> 7, nM = M >> 7;
  const int lane = tid_ & 63, wid = tid_ >> 6;
  const int wr = wid >> 1, wc = wid & 1, fr = lane & 15, fq = lane >> 4;
  const int xcd = blockIdx.x & 7, jloc = blockIdx.x >> 3, nloc = gridDim.x >> 3;
  for (int lt = jloc; lt < (nM >> 3) * nN; lt += nloc) {
    const int tml = lt / nN, tn = lt - tml * nN;
    const int tm = tml * 8 + xcd;
    const int m0 = tm << 7, n0 = tn << 7;
    f32x4 acc[4][4];
    zero_acc(acc);
    if (n0 < ns_from) {
      gemm_kloop<4, true>(tid_, acc, A + (size_t)m0 * lda, lda, Bt + (size_t)n0 * ldb, ldb, K, smem);
#pragma unroll
      for (int m = 0; m < 4; ++m)
#pragma unroll
        for (int n = 0; n < 4; ++n) epiS(m0 + wr * 64 + m * 16 + fr, n0 + wc * 64 + n * 16 + fq * 4, acc[m][n]);
    } else {
      gemm_kloop<4, false>(tid_, acc, A + (size_t)m0 * lda, lda, Bt + (size_t)n0 * ldb, ldb, K, smem);
#pragma unroll
      for (int m = 0; m < 4; ++m)
#pragma unroll
        for (int n = 0; n < 4; ++n) epiN(m0 + wr * 64 + m * 16 + fq * 4, n0 + wc * 64 + n * 16 + fr, acc[m][n]);
    }
  }
}


template <bool SWAP>
DEVI void gemm_kloop_big(int tid_, f32x4 (&acc)[8][4], const u16* __restrict__ A, int lda, const u16* __restrict__ Bt,
                         int ldb, int K, char* smem) {
  constexpr int STG = 16384 + 8192;
  const int tid = tid_, lane = tid & 63, wid = tid >> 6;
  const int wr = wid >> 1, wc = wid & 1, fr = lane & 15, fq = lane >> 4;
  const int lrow = lane >> 2, lphys = lane & 3, lhi = lane >> 4;
  const int gsw = (4 - lhi) & 3;
  const u16* ga = A + (size_t)(wid * 64 + lrow) * lda + (lphys ^ gsw) * 8;
  const u16* gb = Bt + (size_t)(wid * 32 + lrow) * ldb + (lphys ^ gsw) * 8;
  const size_t a16 = (size_t)16 * lda, b16 = (size_t)16 * ldb;
  const int rsw = (4 - ((fr >> 2) & 3)) & 3;
  const int ch = (fq ^ rsw) * 16;
  const int nk = K >> 5;
  const uint32_t lds_base = (uint32_t)(size_t)(__attribute__((address_space(3))) char*)smem;
  const uint32_t aoff = (uint32_t)((wr * 128 + fr) * 64 + ch);
  const uint32_t boff = (uint32_t)(16384 + (wc * 64 + fr) * 64 + ch);
  asm volatile("s_waitcnt vmcnt(0)" ::: "memory");
  __syncthreads();
#define GEMMB_ISSUE(kt_, buf_)                                                                                       \
  do {                                                                                                               \
    char* nb_ = smem + (buf_) * STG;                                                                                 \
    _Pragma("unroll") for (int q = 0; q < 4; ++q) __builtin_amdgcn_global_load_lds(                                  \
        (const unsigned*)(ga + q * a16 + (kt_) * 32),                                                                \
        (__attribute__((address_space(3))) unsigned*)(nb_ + (wid * 4 + q) * 1024 + lane * 16), 16, 0, 0);            \
    _Pragma("unroll") for (int q = 0; q < 2; ++q) __builtin_amdgcn_global_load_lds(                                  \
        (const unsigned*)(gb + q * b16 + (kt_) * 32),                                                                \
        (__attribute__((address_space(3))) unsigned*)(nb_ + 16384 + (wid * 2 + q) * 1024 + lane * 16), 16, 0, 0);   \
  } while (0)
  GEMMB_ISSUE(0, 0);
  if (nk > 1) GEMMB_ISSUE(1, 1);
  int cb = 0;
  for (int kt = 0; kt < nk; ++kt) {
    if (kt + 1 < nk) asm volatile("s_waitcnt vmcnt(6)" ::: "memory");
    else asm volatile("s_waitcnt vmcnt(0)" ::: "memory");
    __builtin_amdgcn_s_barrier();
    asm volatile("" ::: "memory");
    const int nbuf = (cb == 0) ? 2 : cb - 1;
    if (kt + 2 < nk) GEMMB_ISSUE(kt + 2, nbuf);
    const uint32_t sb = lds_base + cb * STG;
    bf16x8 a0[4], a1[4], bb[4];
    a0[0] = lds_rd128<0>(sb + aoff); a0[1] = lds_rd128<1024>(sb + aoff);
    a0[2] = lds_rd128<2048>(sb + aoff); a0[3] = lds_rd128<3072>(sb + aoff);
    bb[0] = lds_rd128<0>(sb + boff); bb[1] = lds_rd128<1024>(sb + boff);
    bb[2] = lds_rd128<2048>(sb + boff); bb[3] = lds_rd128<3072>(sb + boff);
    a1[0] = lds_rd128<4096>(sb + aoff); a1[1] = lds_rd128<5120>(sb + aoff);
    a1[2] = lds_rd128<6144>(sb + aoff); a1[3] = lds_rd128<7168>(sb + aoff);
    asm volatile("s_waitcnt lgkmcnt(4)" : "+v"(a0[0]), "+v"(a0[1]), "+v"(a0[2]), "+v"(a0[3]),
                 "+v"(bb[0]), "+v"(bb[1]), "+v"(bb[2]), "+v"(bb[3]));
#pragma unroll
    for (int m = 0; m < 4; ++m)
#pragma unroll
      for (int n = 0; n < 4; ++n) {
        if (SWAP) acc[m][n] = __builtin_amdgcn_mfma_f32_16x16x32_bf16(bb[n], a0[m], acc[m][n], 0, 0, 0);
        else acc[m][n] = __builtin_amdgcn_mfma_f32_16x16x32_bf16(a0[m], bb[n], acc[m][n], 0, 0, 0);
      }
    asm volatile("s_waitcnt lgkmcnt(0)" : "+v"(a1[0]), "+v"(a1[1]), "+v"(a1[2]), "+v"(a1[3]));
#pragma unroll
    for (int m = 0; m < 4; ++m)
#pragma unroll
      for (int n = 0; n < 4; ++n) {
        if (SWAP) acc[4 + m][n] = __builtin_amdgcn_mfma_f32_16x16x32_bf16(bb[n], a1[m], acc[4 + m][n], 0, 0, 0);
        else acc[4 + m][n] = __builtin_amdgcn_mfma_f32_16x16x32_bf16(a1[m], bb[n], acc[4 + m][n], 0, 0, 0);
      }
    cb = (cb == 2) ? 0 : cb + 1;
  }
#undef GEMMB_ISSUE
}

template <class EpiS, class EpiN>
DEVI void gemm_phase_big(int tid_, const u16* A, int lda, const u16* Bt, int ldb, int K, int M, int N, char* smem,
                         int ns_from, EpiS epiS, EpiN epiN) {
  const int nN = N >> 7, nM = M >> 8;
  const int lane = tid_ & 63, wid = tid_ >> 6;
  const int wr = wid >> 1, wc = wid & 1, fr = lane & 15, fq = lane >> 4;
  const int xcd = blockIdx.x & 7, jloc = blockIdx.x >> 3, nloc = gridDim.x >> 3;
  for (int lt = jloc; lt < (nM >> 3) * nN; lt += nloc) {
    const int tml = lt / nN, tn = lt - tml * nN;
    const int tm = tml * 8 + xcd;
    const int m0 = tm << 8, n0 = tn << 7;
    f32x4 acc[8][4];
#pragma unroll
    for (int m = 0; m < 8; ++m)
#pragma unroll
      for (int n = 0; n < 4; ++n) acc[m][n] = (f32x4){0.f, 0.f, 0.f, 0.f};
    if (n0 < ns_from) {
      gemm_kloop_big<true>(launder(tid_), acc, A + (size_t)m0 * lda, lda, Bt + (size_t)n0 * ldb, ldb, K, smem);
#pragma unroll
      for (int m = 0; m < 8; ++m)
#pragma unroll
        for (int n = 0; n < 4; ++n) epiS(m0 + wr * 128 + m * 16 + fr, n0 + wc * 64 + n * 16 + fq * 4, acc[m][n]);
    } else {
      gemm_kloop_big<false>(launder(tid_), acc, A + (size_t)m0 * lda, lda, Bt + (size_t)n0 * ldb, ldb, K, smem);
#pragma unroll
      for (int m = 0; m < 8; ++m)
#pragma unroll
        for (int n = 0; n < 4; ++n) epiN(m0 + wr * 128 + m * 16 + fq * 4, n0 + wc * 64 + n * 16 + fr, acc[m][n]);
    }
  }
}

DEVI void store4bf(u16* dst, f32x4 v) {
  u32x2 o;
  o.x = pack2(v[0], v[1]); o.y = pack2(v[2], v[3]);
  *(u32x2*)dst = o;
}

DEVI void phase_p_gemm(int tid_, const Params& p, char* smem) {
  u16* WB = (u16*)(p.ws + OFF_WB);
  const u16* H = (const u16*)(p.ws + OFF_H);
  u16* PR = (u16*)(p.ws + OFF_PR);
  u16* NQ = (u16*)(p.ws + OFF_NQ);
  u16* NK = (u16*)(p.ws + OFF_NK);
  u16* NVT = (u16*)(p.ws + OFF_NV);
  gemm_phase_big(tid_, H, 1024, WB + W_IN, 1024, 1024, NTOK, 3456, smem, 2944,
    [&](int r, int c0, f32x4 v) {
      if (c0 < 1920) store4bf(PR + (size_t)r * PRW + c0, v);
      else if (c0 < 2432) store4bf(NQ + (size_t)r * 512 + (c0 - 1920), v);
      else store4bf(NK + (size_t)r * 512 + (c0 - 2432), v);
    },
    [&](int r0, int c, f32x4 v) {
      const int cc = c - 2944;
      const int s = r0 >> 12, t = r0 & 4095;
      store4bf(NVT + ((size_t)(s * 512 + cc)) * 4096 + t, v);
    });
  const u16* MH = (const u16*)(p.ws + OFF_MEMH);
  u16* KVK = (u16*)(p.ws + OFF_KVK);
  u16* KVT = (u16*)(p.ws + OFF_KVT);
  gemm_phase(tid_, MH, 1024, WB + W_XKV, 1024, 1024, 3072, 2048, smem, 1024,
    [&](int r, int c0, f32x4 v) { store4bf(KVK + (size_t)r * 1024 + c0, v); },
    [&](int r0, int c, f32x4 v) {
      const int cc = c - 1024;
      const int s = r0 >> 8, m = r0 & 255;
      store4bf(KVT + ((size_t)(s * 1024 + cc)) * 256 + m, v);
    });
}

DEVI void phase_nat(int tid_, const Params& p, int l, char* smem) {
  u16* NQ = (u16*)(p.ws + OFF_NQ);
  const u16* NK = (const u16*)(p.ws + OFF_NK);
  const u16* NVT = (const u16*)(p.ws + OFF_NV);
  const float* rpb = p.in[I_RPB] + (size_t)l * 8 * 15 * 31;
  const int lane = tid_ & 63, g = tid_ >> 6, fr = lane & 15, fq = lane >> 4;
  u16* Pw = (u16*)smem + g * (16 * 264);
  const int cb = (g == 0) ? 0 : (g == 1) ? 8 : (g == 2) ? 24 : 32;
  for (int t = blockIdx.x; t < 12 * 64 * 8; t += gridDim.x) {
    const int h = t & 7, ri = (t >> 3) & 63, s = t >> 9;
    int rs = ri - 4; rs = rs < 0 ? 0 : (rs > 56 ? 56 : rs);
    const size_t tokq = (size_t)s * 4096 + ri * 64 + g * 16;
    bf16x8 aq[2];
    aq[0] = *(const bf16x8*)(NQ + (tokq + fr) * 512 + h * 64 + fq * 8);
    aq[1] = *(const bf16x8*)(NQ + (tokq + fr) * 512 + h * 64 + 32 + fq * 8);
    f32x4 acc[16];
#pragma unroll
    for (int n = 0; n < 16; ++n) {
      acc[n] = (f32x4){0.f, 0.f, 0.f, 0.f};
      const int r = n >> 1, col = cb + (n & 1) * 16 + fr;
      const u16* kp = NK + ((size_t)s * 4096 + (rs + r) * 64 + col) * 512 + h * 64 + fq * 8;
      bf16x8 b0 = *(const bf16x8*)kp;
      bf16x8 b1 = *(const bf16x8*)(kp + 32);
      acc[n] = __builtin_amdgcn_mfma_f32_16x16x32_bf16(aq[0], b0, acc[n], 0, 0, 0);
      acc[n] = __builtin_amdgcn_mfma_f32_16x16x32_bf16(aq[1], b1, acc[n], 0, 0, 0);
    }
    float mx[4], sm[4];
#pragma unroll
    for (int j = 0; j < 4; ++j) {
      const int c = g * 16 + fq * 4 + j;
      int cs = c - 8; cs = cs < 0 ? 0 : (cs > 48 ? 48 : cs);
      float m = -1e30f;
#pragma unroll
      for (int n = 0; n < 16; ++n) {
        const int r = n >> 1, kc = cb + (n & 1) * 16 + fr;
        const bool valid = (kc >= cs) && (kc < cs + 16);
        float sc = -1e30f;
        if (valid) {
          const int di = rs + r - ri + 7, dj = kc - c + 15;
          sc = acc[n][j] * 0.125f + rpb[(h * 15 + di) * 31 + dj];
        }
        acc[n][j] = sc;
        m = fmaxf(m, sc);
      }
      mx[j] = red16_max(m);
    }
#pragma unroll
    for (int j = 0; j < 4; ++j) {
      float ssum = 0.f;
#pragma unroll
      for (int n = 0; n < 16; ++n) {
        float e = __expf(acc[n][j] - mx[j]);
        acc[n][j] = e;
        ssum += e;
      }
      sm[j] = 1.f / red16_sum(ssum);
    }
    __syncthreads();
#pragma unroll
    for (int n = 0; n < 16; ++n)
#pragma unroll
      for (int j = 0; j < 4; ++j) Pw[(fq * 4 + j) * 264 + n * 16 + fr] = f2bf(acc[n][j]);
    __syncthreads();
    f32x4 o[4];
#pragma unroll
    for (int n = 0; n < 4; ++n) o[n] = (f32x4){0.f, 0.f, 0.f, 0.f};
#pragma unroll
    for (int ks = 0; ks < 8; ++ks) {
      bf16x8 ap = *(const bf16x8*)(Pw + fr * 264 + ks * 32 + fq * 8);
#pragma unroll
      for (int n = 0; n < 4; ++n) {
        bf16x8 bv = *(const bf16x8*)(NVT + ((size_t)(s * 512 + h * 64 + n * 16 + fr)) * 4096 + (rs + ks) * 64 + cb + fq * 8);
        o[n] = __builtin_amdgcn_mfma_f32_16x16x32_bf16(ap, bv, o[n], 0, 0, 0);
      }
    }
#pragma unroll
    for (int n = 0; n < 4; ++n)
#pragma unroll
      for (int j = 0; j < 4; ++j)
        NQ[(tokq + fq * 4 + j) * 512 + h * 64 + n * 16 + fr] = f2bf(o[n][j] * sm[j]);
  }
}

constexpr int SC_OPS = 0;
constexpr int SC_VV = 40960;
constexpr int SC_WR = 49152;
constexpr int SC_AP = 57344;
constexpr int SC_TW = 65536;
constexpr int SC_AD = 70144;
constexpr int SC_NRM = 74752;
constexpr int SC_MU = 74880;
constexpr int SC_CST = 77440;

typedef __attribute__((ext_vector_type(2))) float f32x2;

template <int CTRL>
DEVI float dpp_mov(float x) {
  return __int_as_float(__builtin_amdgcn_update_dpp(0, __float_as_int(x), CTRL, 0xF, 0xF, true));
}
DEVI float red8(float x) {
  x += dpp_mov<0xB1>(x);
  x += dpp_mov<0x4E>(x);
  x += dpp_mov<0x141>(x);
  return x;
}
DEVI f32x2 lo2(f32x4 v) { return __builtin_shufflevector(v, v, 0, 1); }
DEVI f32x2 hi2(f32x4 v) { return __builtin_shufflevector(v, v, 2, 3); }

struct ScanOps {
  f32x2 a[4], w[4], b[4], k[4], r[4];
  float v0, v1;
};
DEVI void scan_load(ScanOps& o, const float* OPS, const float* VV, int nn, int jg, int i0) {
  const float* base = OPS + nn * 64 + jg * 8;
  f32x4 t0, t1;
  t0 = *(const f32x4*)(base); t1 = *(const f32x4*)(base + 4);
  o.a[0] = lo2(t0); o.a[1] = hi2(t0); o.a[2] = lo2(t1); o.a[3] = hi2(t1);
  t0 = *(const f32x4*)(base + 2048); t1 = *(const f32x4*)(base + 2048 + 4);
  o.w[0] = lo2(t0); o.w[1] = hi2(t0); o.w[2] = lo2(t1); o.w[3] = hi2(t1);
  t0 = *(const f32x4*)(base + 4096); t1 = *(const f32x4*)(base + 4096 + 4);
  o.b[0] = lo2(t0); o.b[1] = hi2(t0); o.b[2] = lo2(t1); o.b[3] = hi2(t1);
  t0 = *(const f32x4*)(base + 6144); t1 = *(const f32x4*)(base + 6144 + 4);
  o.k[0] = lo2(t0); o.k[1] = hi2(t0); o.k[2] = lo2(t1); o.k[3] = hi2(t1);
  t0 = *(const f32x4*)(base + 8192); t1 = *(const f32x4*)(base + 8192 + 4);
  o.r[0] = lo2(t0); o.r[1] = hi2(t0); o.r[2] = lo2(t1); o.r[3] = hi2(t1);
  o.v0 = VV[nn * 64 + i0];
  o.v1 = VV[nn * 64 + i0 + 8];
}
DEVI void scan_step(const ScanOps& o, f32x2 (&S0)[4], f32x2 (&S1)[4], float* YL, int nn, int jg, int i0) {
  f32x2 d0 = S0[0] * o.a[0], d0b = S0[2] * o.a[2];
  f32x2 d1 = S1[0] * o.a[0], d1b = S1[2] * o.a[2];
  d0 = S0[1] * o.a[1] + d0; d0b = S0[3] * o.a[3] + d0b;
  d1 = S1[1] * o.a[1] + d1; d1b = S1[3] * o.a[3] + d1b;
  d0 += d0b; d1 += d1b;
  const float sa0 = red8(d0.x + d0.y);
  const float sa1 = red8(d1.x + d1.y);
  f32x2 e0 = {0.f, 0.f}, e1 = {0.f, 0.f};
#pragma unroll
  for (int q = 0; q < 4; ++q) {
    const f32x2 u0 = sa0 * o.b[q] + o.v0 * o.k[q];
    const f32x2 u1 = sa1 * o.b[q] + o.v1 * o.k[q];
    S0[q] = S0[q] * o.w[q] + u0;
    S1[q] = S1[q] * o.w[q] + u1;
    e0 = S0[q] * o.r[q] + e0;
    e1 = S1[q] * o.r[q] + e1;
  }
  const float y0 = red8(e0.x + e0.y);
  const float y1 = red8(e1.x + e1.y);
  if (jg == 0) { YL[nn * 64 + i0] = y0; YL[nn * 64 + i0 + 8] = y1; }
}

DEVI void phase_scan(int tid_, const Params& p, int l, char* smem) {
  const u16* PR = (const u16*)(p.ws + OFF_PR);
  _Float16* YF = (_Float16*)(p.ws + OFF_NK);
  _Float16* YB = (_Float16*)(p.ws + OFF_NV);
  float* BON = (float*)(p.ws + OFF_BONUS);
  const u16* WB = (const u16*)(p.ws + OFF_WB);
  float* OPS = (float*)(smem + SC_OPS);
  u16* RAW = (u16*)(smem + SC_OPS);
  float* VV = (float*)(smem + SC_VV);
  float* WR = (float*)(smem + SC_WR);
  float* AP = (float*)(smem + SC_AP);
  float* YL = WR;
  u16* TWb = (u16*)(smem + SC_TW);
  u16* ADb = (u16*)(smem + SC_AD);
  float* NRM = (float*)(smem + SC_NRM);
  float* MU = (float*)(smem + SC_MU);
  float* CST = (float*)(smem + SC_CST);
  const float* mu_p = p.in[I_MU_PREV] + (size_t)l * 1920;
  const float* mu_n = p.in[I_MU_NEXT] + (size_t)l * 1920;
  const int tid = tid_, lane = tid & 63, w = tid >> 6, fr = lane & 15, fq = lane >> 4;
  const int pn = tid >> 3, j0 = (tid & 7) * 8;
  const int jg = lane & 7, i0 = w * 16 + (lane >> 3);
  const int hr = (tid >= 40) ? 1 : 0, hc = tid - hr * 40;
  for (int blk = blockIdx.x; blk < 192; blk += gridDim.x) {
    const int s = blk >> 4, h = (blk >> 1) & 7, d = blk & 1;
    __syncthreads();
    for (int i = tid; i < 640; i += 256) {
      const int which = (i >= 320) ? 1 : 0, c = i - which * 320;
      const int g = c >> 6, e = c & 63;
      const int col = (g < 3) ? (g * 512 + h * 64 + e) : (1536 + (g - 3) * 128 + d * 64 + e);
      MU[i] = which ? mu_n[col] : mu_p[col];
    }
    for (int i = tid; i < 320; i += 256) {
      const int which = i >> 6, e = i & 63;
      float v;
      if (which == 0) v = p.in[I_W0][(size_t)(l * 2 + d) * 512 + h * 64 + e];
      else if (which == 1) v = p.in[I_A0][(size_t)(l * 2 + d) * 512 + h * 64 + e];
      else if (which == 2) v = p.in[I_K_K][(size_t)l * 512 + h * 64 + e];
      else if (which == 3) v = p.in[I_K_A][(size_t)l * 512 + h * 64 + e];
      else v = p.in[I_R_K][(size_t)(l * 8 + h) * 64 + e];
      CST[i] = v;
    }
    bf16x8 bw[2], ba[2];
#pragma unroll
    for (int ks = 0; ks < 2; ++ks) {
      bw[ks] = *(const bf16x8*)(WB + W_WUP + (size_t)(d * 512 + h * 64 + w * 16 + fr) * 64 + ks * 32 + fq * 8);
      ba[ks] = *(const bf16x8*)(WB + W_AUP + (size_t)(d * 512 + h * 64 + w * 16 + fr) * 64 + ks * 32 + fq * 8);
    }
    _Float16* Y = d ? YB : YF;
    f32x2 S0[4], S1[4];
#pragma unroll
    for (int q = 0; q < 4; ++q) { S0[q] = (f32x2){0.f, 0.f}; S1[q] = (f32x2){0.f, 0.f}; }
    u32x4 G[5], GH;
    {
      const int t = d ? (4095 - pn) : pn;
      const size_t tok = (size_t)s * 4096 + t;
#pragma unroll
      for (int g = 0; g < 5; ++g) {
        const int col = (g < 3) ? (g * 512 + h * 64) : (1536 + (g - 3) * 128 + d * 64);
        G[g] = *(const u32x4*)(PR + tok * PRW + col + j0);
      }
      GH = (u32x4){0u, 0u, 0u, 0u};
      if (tid < 80) {
        const int tlo = d ? (4095 - 31) : 0;
        const int th = hr ? (tlo + 32) : (tlo - 1);
        const int g = hc >> 3;
        const int col = (g < 3) ? (g * 512 + h * 64) : (1536 + (g - 3) * 128 + d * 64);
        if (th >= 0 && th <= 4095) GH = *(const u32x4*)(PR + ((size_t)s * 4096 + th) * PRW + col + (hc & 7) * 8);
      }
    }
#pragma unroll 1
    for (int ch = 0; ch < 128; ++ch) {
      const int n = ch * 32 + pn;
      const int t = d ? (4095 - n) : n;
      const size_t tok = (size_t)s * 4096 + t;
      const int tlo = d ? (4095 - (ch * 32 + 31)) : (ch * 32);
      const int rrow = t - tlo + 1;
#pragma unroll
      for (int g = 0; g < 5; ++g) *(u32x4*)(RAW + rrow * 320 + g * 64 + j0) = G[g];
      if (tid < 80) *(u32x4*)(RAW + (hr ? 33 : 0) * 320 + (hc >> 3) * 64 + (hc & 7) * 8) = GH;
      __syncthreads();
      if (ch + 1 < 128) {
        const int n2 = n + 32;
        const int t2 = d ? (4095 - n2) : n2;
        const size_t tok2 = (size_t)s * 4096 + t2;
#pragma unroll
        for (int g = 0; g < 5; ++g) {
          const int col = (g < 3) ? (g * 512 + h * 64) : (1536 + (g - 3) * 128 + d * 64);
          G[g] = *(const u32x4*)(PR + tok2 * PRW + col + j0);
        }
        GH = (u32x4){0u, 0u, 0u, 0u};
        if (tid < 80) {
          const int tlo2 = d ? (tlo - 32) : (tlo + 32);
          const int th = hr ? (tlo2 + 32) : (tlo2 - 1);
          const int g = hc >> 3;
          const int col = (g < 3) ? (g * 512 + h * 64) : (1536 + (g - 3) * 128 + d * 64);
          if (th >= 0 && th <= 4095) GH = *(const u32x4*)(PR + ((size_t)s * 4096 + th) * PRW + col + (hc & 7) * 8);
        }
      }
#pragma unroll
      for (int g = 0; g < 5; ++g) {
        float cur[8], prv[8], nxt[8];
        load8bf(RAW + rrow * 320 + g * 64 + j0, cur);
        load8bf(RAW + (rrow - 1) * 320 + g * 64 + j0, prv);
        load8bf(RAW + (rrow + 1) * 320 + g * 64 + j0, nxt);
        const f32x4 mp0 = *(const f32x4*)(MU + g * 64 + j0), mp1 = *(const f32x4*)(MU + g * 64 + j0 + 4);
        const f32x4 mn0 = *(const f32x4*)(MU + 320 + g * 64 + j0), mn1 = *(const f32x4*)(MU + 320 + g * 64 + j0 + 4);
        f32x4 x0, x1;
#pragma unroll
        for (int e = 0; e < 4; ++e) {
          x0[e] = cur[e] + mp0[e] * (prv[e] - cur[e]) + mn0[e] * (nxt[e] - cur[e]);
          x1[e] = cur[4 + e] + mp1[e] * (prv[4 + e] - cur[4 + e]) + mn1[e] * (nxt[4 + e] - cur[4 + e]);
        }
        if (g == 0) {
          *(f32x4*)(OPS + 4 * 2048 + pn * 64 + j0) = x0; *(f32x4*)(OPS + 4 * 2048 + pn * 64 + j0 + 4) = x1;
        } else if (g == 1) {
          *(f32x4*)(OPS + 3 * 2048 + pn * 64 + j0) = x0; *(f32x4*)(OPS + 3 * 2048 + pn * 64 + j0 + 4) = x1;
          const f32x4 kk0 = *(const f32x4*)(CST + 128 + j0), kk1 = *(const f32x4*)(CST + 128 + j0 + 4);
          float ss = 0.f;
#pragma unroll
          for (int e = 0; e < 4; ++e) { const float a_ = x0[e] * kk0[e], b_ = x1[e] * kk1[e]; ss += a_ * a_ + b_ * b_; }
          ss = red8(ss);
          if ((tid & 7) == 0) NRM[pn] = frcp(fmaxf(__builtin_amdgcn_sqrtf(ss), 1e-12f));
        } else if (g == 2) {
          *(f32x4*)(VV + pn * 64 + j0) = x0; *(f32x4*)(VV + pn * 64 + j0 + 4) = x1;
        } else if (g == 3) {
          u32x4 pk;
          pk.x = pack2(ftanh(x0[0]), ftanh(x0[1])); pk.y = pack2(ftanh(x0[2]), ftanh(x0[3]));
          pk.z = pack2(ftanh(x1[0]), ftanh(x1[1])); pk.w = pack2(ftanh(x1[2]), ftanh(x1[3]));
          *(u32x4*)(TWb + pn * 72 + j0) = pk;
        } else {
          u32x4 pk;
          pk.x = pack2(x0[0], x0[1]); pk.y = pack2(x0[2], x0[3]);
          pk.z = pack2(x1[0], x1[1]); pk.w = pack2(x1[2], x1[3]);
          *(u32x4*)(ADb + pn * 72 + j0) = pk;
        }
      }
      __syncthreads();
#pragma unroll
      for (int m = 0; m < 2; ++m) {
        f32x4 cw = {0.f, 0.f, 0.f, 0.f}, ca = {0.f, 0.f, 0.f, 0.f};
#pragma unroll
        for (int ks = 0; ks < 2; ++ks) {
          const bf16x8 aw = *(const bf16x8*)(TWb + (m * 16 + fr) * 72 + ks * 32 + fq * 8);
          const bf16x8 aa = *(const bf16x8*)(ADb + (m * 16 + fr) * 72 + ks * 32 + fq * 8);
          cw = __builtin_amdgcn_mfma_f32_16x16x32_bf16(aw, bw[ks], cw, 0, 0, 0);
          ca = __builtin_amdgcn_mfma_f32_16x16x32_bf16(aa, ba[ks], ca, 0, 0, 0);
        }
#pragma unroll
        for (int jj = 0; jj < 4; ++jj) {
          WR[(m * 16 + fq * 4 + jj) * 64 + w * 16 + fr] = cw[jj];
          AP[(m * 16 + fq * 4 + jj) * 64 + w * 16 + fr] = ca[jj];
        }
      }
      __syncthreads();
      {
        const float inv = NRM[pn];
        float bsum = 0.f;
#pragma unroll
        for (int hq = 0; hq < 2; ++hq) {
          const int jb = j0 + hq * 4;
          const f32x4 wr_ = *(const f32x4*)(WR + pn * 64 + jb) + *(const f32x4*)(CST + jb);
          const f32x4 ap_ = *(const f32x4*)(AP + pn * 64 + jb) + *(const f32x4*)(CST + 64 + jb);
          const f32x4 kr = *(const f32x4*)(OPS + 3 * 2048 + pn * 64 + jb);
          const f32x4 rr = *(const f32x4*)(OPS + 4 * 2048 + pn * 64 + jb);
          const f32x4 kkw = *(const f32x4*)(CST + 128 + jb), kaw = *(const f32x4*)(CST + 192 + jb), rkw = *(const f32x4*)(CST + 256 + jb);
          f32x4 o0, o1, o2, o3;
#pragma unroll
          for (int e = 0; e < 4; ++e) {
            const float sw = sigm(wr_[e]);
            const float dec = __expf(-0.6065306597126334f * sw);
            const float av = sigm(ap_[e]);
            const float kn = kr[e] * kkw[e] * inv;
            const float kd = kr[e] * (1.f + (av - 1.f) * kaw[e]);
            bsum += rr[e] * kd * rkw[e];
            o0[e] = -kn; o1[e] = dec; o2[e] = kn * av; o3[e] = kd;
          }
          *(f32x4*)(OPS + 0 * 2048 + pn * 64 + jb) = o0;
          *(f32x4*)(OPS + 1 * 2048 + pn * 64 + jb) = o1;
          *(f32x4*)(OPS + 2 * 2048 + pn * 64 + jb) = o2;
          *(f32x4*)(OPS + 3 * 2048 + pn * 64 + jb) = o3;
        }
        bsum = red8(bsum);
        if ((tid & 7) == 0) BON[(tok * 8 + h) * 2 + d] = bsum;
      }
      __syncthreads();
      {
        ScanOps oa, ob;
        scan_load(oa, OPS, VV, 0, jg, i0);
#pragma unroll 1
        for (int nn = 0; nn < 32; nn += 2) {
          scan_load(ob, OPS, VV, nn + 1, jg, i0);
          scan_step(oa, S0, S1, YL, nn, jg, i0);
          scan_load(oa, OPS, VV, (nn + 2) & 31, jg, i0);
          scan_step(ob, S0, S1, YL, nn + 1, jg, i0);
        }
      }
      __syncthreads();
      {
        h16x8 o;
#pragma unroll
        for (int e = 0; e < 8; ++e) o[e] = (_Float16)YL[pn * 64 + j0 + e];
        *(h16x8*)(Y + tok * 512 + h * 64 + j0) = o;
      }
    }
    __syncthreads();
  }
}

DEVI void phase_rwkv_post(int tid_, const Params& p, int l, char* smem) {
  u16* PR = (u16*)(p.ws + OFF_PR);
  const _Float16* YF = (const _Float16*)(p.ws + OFF_NK);
  const _Float16* YB = (const _Float16*)(p.ws + OFF_NV);
  const float* BON = (const float*)(p.ws + OFF_BONUS);
  const u16* GUPT = (const u16*)(p.ws + OFF_WB) + W_GUP;
  const float* mu_p = p.in[I_MU_PREV] + (size_t)l * 1920;
  const float* mu_n = p.in[I_MU_NEXT] + (size_t)l * 1920;
  const float* gng = p.in[I_GN_G] + (size_t)l * 512;
  const float* gnb = p.in[I_GN_B] + (size_t)l * 512;
  u16* As = (u16*)smem;
  const int tid = tid_, lane = tid & 63, w = tid >> 6, fr = lane & 15, fq = lane >> 4;
  for (int tile = blockIdx.x; tile < NTOK / 64; tile += gridDim.x) {
    const size_t tok0 = (size_t)tile * 64;
    {
      const int row = tid >> 2, part = tid & 3;
      const size_t tok = tok0 + row;
      const int t = (int)(tok & 4095);
#pragma unroll
      for (int q = 0; q < 4; ++q) {
        const int col = 1792 + part * 32 + q * 8;
        float cur[8], prv[8], nxt[8];
        load8bf(PR + tok * PRW + col, cur);
        if (t > 0) load8bf(PR + (tok - 1) * PRW + col, prv);
        else {
#pragma unroll
          for (int e = 0; e < 8; ++e) prv[e] = 0.f;
        }
        if (t < 4095) load8bf(PR + (tok + 1) * PRW + col, nxt);
        else {
#pragma unroll
          for (int e = 0; e < 8; ++e) nxt[e] = 0.f;
        }
        float o[8];
#pragma unroll
        for (int e = 0; e < 8; ++e) {
          const float x = cur[e] + mu_p[col + e] * (prv[e] - cur[e]) + mu_n[col + e] * (nxt[e] - cur[e]);
          o[e] = sigm(x);
        }
        u32x4 pk;
        pk.x = pack2(o[0], o[1]); pk.y = pack2(o[2], o[3]); pk.z = pack2(o[4], o[5]); pk.w = pack2(o[6], o[7]);
        *(u32x4*)(As + row * 136 + part * 32 + q * 8) = pk;
      }
    }
    __syncthreads();
#pragma unroll 1
    for (int chh = 0; chh < 2; ++chh) {
      f32x4 acc[16];
#pragma unroll
      for (int n = 0; n < 16; ++n) acc[n] = (f32x4){0.f, 0.f, 0.f, 0.f};
#pragma unroll
      for (int ks = 0; ks < 4; ++ks) {
        bf16x8 af = *(const bf16x8*)(As + (w * 16 + fr) * 136 + ks * 32 + fq * 8);
#pragma unroll
        for (int n = 0; n < 16; ++n) {
          bf16x8 bg = *(const bf16x8*)(GUPT + (size_t)(chh * 256 + n * 16 + fr) * 128 + ks * 32 + fq * 8);
          acc[n] = __builtin_amdgcn_mfma_f32_16x16x32_bf16(af, bg, acc[n], 0, 0, 0);
        }
      }
#pragma unroll
      for (int hl = 0; hl < 4; ++hl) {
        const int head = chh * 4 + hl;
#pragma unroll
        for (int j = 0; j < 4; ++j) {
          const size_t tok = tok0 + w * 16 + fq * 4 + j;
          const int t = (int)(tok & 4095);
          float o[4], sum = 0.f;
#pragma unroll
          for (int q = 0; q < 4; ++q) {
            const int col = head * 64 + q * 16 + fr;
            o[q] = (float)YF[tok * 512 + col] + (float)YB[tok * 512 + col];
            sum += o[q];
          }
          const float mean = red16_sum(sum) * (1.f / 64.f);
          float vs = 0.f;
#pragma unroll
          for (int q = 0; q < 4; ++q) { const float dlt = o[q] - mean; vs += dlt * dlt; }
          const float var = red16_sum(vs) * (1.f / 64.f);
          const float rstd = rsqrtf(var + 64e-5f);
          const float bon = BON[(tok * 8 + head) * 2] + BON[(tok * 8 + head) * 2 + 1];
#pragma unroll
          for (int q = 0; q < 4; ++q) {
            const int col = head * 64 + q * 16 + fr;
            const int vc = 1024 + col;
            const float cur = bf2f(PR[tok * PRW + vc]);
            const float prv = (t > 0) ? bf2f(PR[(tok - 1) * PRW + vc]) : 0.f;
            const float nxt = (t < 4095) ? bf2f(PR[(tok + 1) * PRW + vc]) : 0.f;
            const float vsh = cur + mu_p[vc] * (prv - cur) + mu_n[vc] * (nxt - cur);
            const float yv = ((o[q] - mean) * rstd * gng[col] + gnb[col] + bon * vsh) * acc[hl * 4 + q][j];
            PR[tok * PRW + col] = f2bf(yv);
          }
        }
      }
    }
    __syncthreads();
  }
}

DEVI void phase_merge(int tid_, const Params& p, char* smem) {
  const u16* WB = (const u16*)(p.ws + OFF_WB);
  const u16* H = (const u16*)(p.ws + OFF_H);
  u16* PR = (u16*)(p.ws + OFF_PR);
  const u16* NQ = (const u16*)(p.ws + OFF_NQ);
  const int lane = tid_ & 63, wid = tid_ >> 6;
  const int wr = wid >> 1, wc = wid & 1, fr = lane & 15, fq = lane >> 4;
  const int xcd = blockIdx.x & 7, jloc = blockIdx.x >> 3, nloc = gridDim.x >> 3;
  for (int lt = jloc; lt < 48 * 16; lt += nloc) {
    const int tm = (lt >> 4) * 8 + xcd, tn = lt & 15;
    const int m0 = tm << 7, n0 = tn << 6;
    f32x4 g[4][2], acc[4][2];
    uint32_t mp[4][2][2];
    zero_acc(g);
    gemm_kloop<2, true>(launder(tid_), g, H + (size_t)m0 * 1024, 1024, WB + W_IN + (size_t)(3456 + n0) * 1024, 1024, 1024, smem);
    zero_acc(acc);
    gemm_kloop<2, true>(launder(tid_), acc, PR + (size_t)m0 * PRW, PRW, WB + W_BRR + (size_t)n0 * 512, 512, 512, smem);
#pragma unroll
    for (int m = 0; m < 4; ++m)
#pragma unroll
      for (int n = 0; n < 2; ++n) {
        mp[m][n][0] = pack2(sigm(g[m][n][0]) * acc[m][n][0], sigm(g[m][n][1]) * acc[m][n][1]);
        mp[m][n][1] = pack2(sigm(g[m][n][2]) * acc[m][n][2], sigm(g[m][n][3]) * acc[m][n][3]);
      }
    zero_acc(g);
    gemm_kloop<2, true>(launder(tid_), g, H + (size_t)m0 * 1024, 1024, WB + W_IN + (size_t)(4480 + n0) * 1024, 1024, 1024, smem);
    zero_acc(acc);
    gemm_kloop<2, true>(launder(tid_), acc, NQ + (size_t)m0 * 512, 512, WB + W_BRN + (size_t)n0 * 512, 512, 512, smem);
#pragma unroll
    for (int m = 0; m < 4; ++m)
#pragma unroll
      for (int n = 0; n < 2; ++n) {
        const int r = m0 + wr * 64 + m * 16 + fr, c0 = n0 + wc * 32 + n * 16 + fq * 4;
        f32x4 o;
        o[0] = __uint_as_float(mp[m][n][0] << 16) + sigm(g[m][n][0]) * acc[m][n][0];
        o[1] = __uint_as_float(mp[m][n][0] & 0xffff0000u) + sigm(g[m][n][1]) * acc[m][n][1];
        o[2] = __uint_as_float(mp[m][n][1] << 16) + sigm(g[m][n][2]) * acc[m][n][2];
        o[3] = __uint_as_float(mp[m][n][1] & 0xffff0000u) + sigm(g[m][n][3]) * acc[m][n][3];
        store4bf(PR + (size_t)r * PRW + 512 + c0, o);
      }
  }
}

DEVI void phase_xattn(int tid_, const Params& p, char* smem) {
  const u16* Q = (const u16*)(p.ws + OFF_PR);
  u16* O = (u16*)(p.ws + OFF_NQ);
  const u16* KVK = (const u16*)(p.ws + OFF_KVK);
  const u16* KVT = (const u16*)(p.ws + OFF_KVT);
  const int lane = tid_ & 63, w = tid_ >> 6, fr = lane & 15, fq = lane >> 4;
  u16* Pw = (u16*)smem + w * (16 * 264);
  for (int t = blockIdx.x; t < (NTOK / 64) * 4; t += gridDim.x) {
    const int hh = t & 3;
    const size_t tok0 = (size_t)(t >> 2) * 64 + w * 16;
    const int s = (int)(tok0 >> 12);
    f32x4 acc[16];
#pragma unroll
    for (int n = 0; n < 16; ++n) acc[n] = (f32x4){0.f, 0.f, 0.f, 0.f};
#pragma unroll 2
    for (int ks = 0; ks < 8; ++ks) {
      bf16x8 aq = *(const bf16x8*)(Q + (tok0 + fr) * 1024 + hh * 256 + ks * 32 + fq * 8);
#pragma unroll
      for (int n = 0; n < 16; ++n) {
        bf16x8 bk = *(const bf16x8*)(KVK + (size_t)(s * 256 + n * 16 + fr) * 1024 + hh * 256 + ks * 32 + fq * 8);
        acc[n] = __builtin_amdgcn_mfma_f32_16x16x32_bf16(aq, bk, acc[n], 0, 0, 0);
      }
    }
    float sm[4];
#pragma unroll
    for (int j = 0; j < 4; ++j) {
      float m = -1e30f;
#pragma unroll
      for (int n = 0; n < 16; ++n) { acc[n][j] *= 0.0625f; m = fmaxf(m, acc[n][j]); }
      m = red16_max(m);
      float ssum = 0.f;
#pragma unroll
      for (int n = 0; n < 16; ++n) { const float e = __expf(acc[n][j] - m); acc[n][j] = e; ssum += e; }
      sm[j] = 1.f / red16_sum(ssum);
    }
    __syncthreads();
#pragma unroll
    for (int n = 0; n < 16; ++n)
#pragma unroll
      for (int j = 0; j < 4; ++j) Pw[(fq * 4 + j) * 264 + n * 16 + fr] = f2bf(acc[n][j]);
    __syncthreads();
#pragma unroll
    for (int n = 0; n < 16; ++n) acc[n] = (f32x4){0.f, 0.f, 0.f, 0.f};
#pragma unroll 2
    for (int ks = 0; ks < 8; ++ks) {
      bf16x8 ap = *(const bf16x8*)(Pw + fr * 264 + ks * 32 + fq * 8);
#pragma unroll
      for (int n = 0; n < 16; ++n) {
        bf16x8 bv = *(const bf16x8*)(KVT + (size_t)(s * 1024 + hh * 256 + n * 16 + fr) * 256 + ks * 32 + fq * 8);
        acc[n] = __builtin_amdgcn_mfma_f32_16x16x32_bf16(ap, bv, acc[n], 0, 0, 0);
      }
    }
#pragma unroll
    for (int n = 0; n < 16; ++n)
#pragma unroll
      for (int j = 0; j < 4; ++j)
        O[(tok0 + fq * 4 + j) * 1024 + hh * 256 + n * 16 + fr] = f2bf(acc[n][j] * sm[j]);
  }
}

DEVI void run_phase(int tid_, const Params& p, int ph, char* smem) {
  if (ph == 2 * NPH_LAYER) { phase_final_norm(tid_, p); return; }
  const int l = ph / NPH_LAYER, q = ph % NPH_LAYER;
  u16* WB = (u16*)(p.ws + OFF_WB);
  u16* H = (u16*)(p.ws + OFF_H);
  u16* PR = (u16*)(p.ws + OFF_PR);
  u16* NQ = (u16*)(p.ws + OFF_NQ);
  float* X = p.X;
  auto epi_res = [&](int r, int c0, f32x4 v) {
    f32x4* px = (f32x4*)(X + (size_t)r * 1024 + c0);
    *px = *px + v;
  };
  constexpr int NONS = 1 << 30;
  switch (q) {
    case 0:
      phase_conv(tid_, p, l, smem);
      phase_norm(tid_, p, p.in[I_NORM_MIX] + (size_t)l * 1024, l == 0);
      phase_norm_mem(tid_, p, p.in[I_NORM_MEM] + (size_t)l * 1024);
      break;
    case 1: phase_p_gemm(tid_, p, smem); break;
    case 2: phase_nat(tid_, p, l, smem); break;
    case 3: phase_scan(tid_, p, l, smem); break;
    case 4: phase_rwkv_post(tid_, p, l, smem); break;
    case 5: phase_merge(tid_, p, smem); break;
    case 6: gemm_phase_big(tid_, PR + 512, PRW, WB + W_OUT, 1024, 1024, NTOK, 1024, smem, NONS, epi_res, NoEpi()); break;
    case 7: phase_norm(tid_, p, p.in[I_NORM_X] + (size_t)l * 1024, false); break;
    case 8:
      gemm_phase_big(tid_, H, 1024, WB + W_XQ, 1024, 1024, NTOK, 1024, smem, NONS,
                 [&](int r, int c0, f32x4 v) { store4bf(PR + (size_t)r * 1024 + c0, v); }, NoEpi());
      break;
    case 9: phase_xattn(tid_, p, smem); break;
    case 10: gemm_phase_big(tid_, NQ, 1024, WB + W_XO, 1024, 1024, NTOK, 1024, smem, NONS, epi_res, NoEpi()); break;
    case 11: phase_norm(tid_, p, p.in[I_NORM_FF] + (size_t)l * 1024, false); break;
    case 12:
    case 14: {
      const int hf = (q == 14);
      gemm_phase_big(tid_, H, 1024, WB + W_FF1 + (size_t)hf * 2048 * 1024, 1024, 1024, NTOK, 2048, smem, NONS,
                 [&](int r, int c0, f32x4 v) {
                   f32x4 o;
#pragma unroll
                   for (int j = 0; j < 4; ++j) { const float x = fmaxf(v[j], 0.f); o[j] = x * x; }
                   store4bf(PR + (size_t)r * 2048 + c0, o);
                 }, NoEpi());
    } break;
    case 13:
    case 15: {
      const int hf = (q == 15);
      gemm_phase_big(tid_, PR, 2048, WB + W_FF2 + (size_t)hf * 2048, 4096, 2048, NTOK, 1024, smem, NONS, epi_res, NoEpi());
    } break;
  }
}

#define XB_TMO      128
#define XB_XCNT(j)  (256  + 64 * (j))
#define XB_XSUB(j)  (1280 + 64 * (j))
#define XB_XGEN(j)  (2304 + 64 * (j))
#define XB_TOP      3328
#define XB_TOPGEN   3392
#define XCD_BAR_WORDS 3456
#define XB_SPIN_CAP (1u << 20)
#define LAS __attribute__((address_space(3)))

DEVI unsigned xb_ld(unsigned* p) { return __hip_atomic_load(p, __ATOMIC_RELAXED, __HIP_MEMORY_SCOPE_AGENT); }
DEVI unsigned xb_add(unsigned* p, unsigned v) { return __hip_atomic_fetch_add(p, v, __ATOMIC_RELAXED, __HIP_MEMORY_SCOPE_AGENT); }
DEVI unsigned xb_xcc_id() { return (unsigned)__builtin_amdgcn_s_getreg((3 << 11) | 20) & 0xFu; }
#define XB_SPIN(cond, bar) do { unsigned _sp = 0; while (cond) { __builtin_amdgcn_s_sleep(1); \
    if ((++_sp & 255u) == 0u) { if (xb_ld(&(bar)[XB_TMO])) break; if (_sp > XB_SPIN_CAP) { atomicAdd(&(bar)[XB_TMO], 1u); break; } } } } while (0)

struct XcdBarrier {
  unsigned* bar; unsigned x;
  volatile LAS unsigned* st;
};
DEVI XcdBarrier xcd_barrier_post(unsigned* bar, volatile LAS unsigned* st) {
  XcdBarrier b; b.bar = bar; b.x = xb_xcc_id(); b.st = st;
  if (threadIdx.x == 0) (void)xb_add(&bar[XB_XCNT(b.x)], 1u);
  return b;
}
DEVI void xcd_barrier_complete(unsigned* bar, unsigned x, unsigned& nloc, unsigned& nx) {
  const unsigned G = gridDim.x * gridDim.y * gridDim.z;
  unsigned sum, cnt, mine, sp = 0u;
  for (;;) {
    sum = 0u; cnt = 0u; mine = 0u;
#pragma unroll
    for (unsigned j = 0; j < 16; ++j) { const unsigned c = xb_ld(&bar[XB_XCNT(j)]); sum += c; cnt += (c > 0u) ? 1u : 0u; mine = (j == x) ? c : mine; }
    if (sum == G) break;
    __builtin_amdgcn_s_sleep(1);
    if ((++sp & 255u) == 0u) { if (xb_ld(&bar[XB_TMO])) break; if (sp > XB_SPIN_CAP) { atomicAdd(&bar[XB_TMO], 1u); break; } }
  }
  nloc = mine > 0u ? mine : 1u; nx = cnt > 0u ? cnt : 1u;
}
DEVI void xcd_barrier(const XcdBarrier& b) {
  asm volatile("s_waitcnt vmcnt(0)" ::: "memory");
  __syncthreads();
  if (threadIdx.x == 0) {
    unsigned* bar = b.bar;
    __builtin_amdgcn_s_waitcnt(0);
    unsigned nloc = b.st[0], nx = b.st[1];
    if (nloc == 0u) { xcd_barrier_complete(bar, b.x, nloc, nx); b.st[0] = nloc; b.st[1] = nx; }
    const unsigned old = xb_add(&bar[XB_XSUB(b.x)], 1u);
    const unsigned gen = old / nloc;
    if (old + 1u == (gen + 1u) * nloc) {
      __builtin_amdgcn_fence(__ATOMIC_RELEASE, "agent");
      asm volatile("s_waitcnt vmcnt(0)" ::: "memory");
      const unsigned og = xb_add(&bar[XB_TOP], 1u);
      const unsigned tg = og / nx;
      if (og + 1u == (tg + 1u) * nx) xb_add(&bar[XB_TOPGEN], 1u);
      else XB_SPIN(xb_ld(&bar[XB_TOPGEN]) == tg, bar);
      __builtin_amdgcn_fence(__ATOMIC_ACQUIRE, "agent");
      xb_add(&bar[XB_XGEN(b.x)], 1u);
      asm volatile("s_waitcnt vmcnt(0)" ::: "memory");
    } else {
      XB_SPIN(xb_ld(&bar[XB_XGEN(b.x)]) == gen, bar);
      __builtin_amdgcn_fence(__ATOMIC_ACQUIRE, "agent");
      asm volatile("s_waitcnt vmcnt(0)" ::: "memory");
    }
  }
  __syncthreads();
}

__global__ void __launch_bounds__(256, 2) mega_kernel(Params p, int ph0, int ph1) {
  __shared__ __attribute__((aligned(16))) char smem[SMEM_BYTES];
  __shared__ __attribute__((aligned(16))) unsigned xb_words[4];
  if (threadIdx.x == 0) { xb_words[0] = 0u; xb_words[1] = 0u; xb_words[2] = 0u; xb_words[3] = 0u; }
  __syncthreads();
  XcdBarrier xb = xcd_barrier_post((unsigned*)(p.ws + OFF_BAR), (volatile LAS unsigned*)xb_words);
  for (int ph = ph0; ph < ph1; ++ph) {
    if (ph == ph0 + 1) cg::this_grid().sync();
    else if (ph > ph0) xcd_barrier(xb);
    int tid_ = threadIdx.x;
    asm volatile("" : "+v"(tid_));
    run_phase(tid_, p, ph, smem);
  }
}

extern "C" void kernel_launch(void* const* d_in, const int* in_sizes, int n_in, void* d_out, int out_size, void* d_ws,
                              size_t ws_size, hipStream_t stream) {
  if (ws_size < WS_NEED || n_in < 31) return;
  Params p{};
  for (int i = 0; i < 31; ++i) p.in[i] = (const float*)d_in[i];
  p.X = (float*)d_out;
  p.ws = (char*)d_ws;
  static int grid_blocks = 0;
  if (!grid_blocks) {
    int dev = 0, cus = 0, per_cu = 0;
    hipGetDevice(&dev);
    hipDeviceGetAttribute(&cus, hipDeviceAttributeMultiprocessorCount, dev);
    hipOccupancyMaxActiveBlocksPerMultiprocessor(&per_cu, mega_kernel, 256, 0);
    if (per_cu > 2) per_cu = 2;
    if (per_cu < 1) per_cu = 1;
    grid_blocks = cus * per_cu;
  }
  hipMemsetAsync((char*)d_ws + OFF_BAR, 0, 16384, stream);
  int ph0 = 0, ph1 = NPHASES;
  void* args[] = {&p, &ph0, &ph1};
  hipLaunchCooperativeKernel((void*)mega_kernel, dim3(grid_blocks), dim3(256), args, 0, stream);
}
```

```cpp
#include <hip/hip_runtime.h>
#include <hip/hip_cooperative_groups.h>
#include <stdint.h>
namespace cg = cooperative_groups;

typedef unsigned short u16;
typedef __attribute__((ext_vector_type(8))) short bf16x8;
typedef __attribute__((ext_vector_type(4))) float f32x4;
typedef __attribute__((ext_vector_type(8))) _Float16 h16x8;
typedef __attribute__((ext_vector_type(4))) unsigned int u32x4;
typedef __attribute__((ext_vector_type(2))) unsigned int u32x2;

#define DEVI __device__ __forceinline__

constexpr int NTOK = 49152;
constexpr int SEQ_T = 4096;
constexpr int PRW = 1920;
constexpr int NPH_LAYER = 15;
constexpr int NPHASES = 2 * NPH_LAYER + 1;
constexpr int SMEM_BYTES = 78720;

constexpr size_t OFF_WB = 0;
constexpr size_t WB_BYTES = 20512768ull * 2;
constexpr size_t OFF_H = OFF_WB + WB_BYTES;
constexpr size_t OFF_PR = OFF_H + (size_t)NTOK * 1024 * 2;
constexpr size_t OFF_NQ = OFF_PR + (size_t)NTOK * PRW * 2;
constexpr size_t OFF_NK = OFF_NQ + (size_t)NTOK * 512 * 2;
constexpr size_t OFF_NV = OFF_NK + (size_t)NTOK * 512 * 2;
constexpr size_t OFF_KVK = OFF_NV + (size_t)NTOK * 512 * 2;
constexpr size_t OFF_KVT = OFF_KVK + (size_t)3072 * 1024 * 2;
constexpr size_t OFF_MEMH = OFF_KVT + (size_t)3072 * 1024 * 2;
constexpr size_t OFF_BONUS = OFF_MEMH + (size_t)3072 * 1024 * 2;
constexpr size_t OFF_BAR = OFF_BONUS + (size_t)NTOK * 16 * 4;
constexpr size_t WS_NEED = OFF_BAR + 16384;

constexpr size_t W_IN = 0;
constexpr size_t W_BRR = W_IN + (size_t)5504 * 1024;
constexpr size_t W_BRN = W_BRR + (size_t)1024 * 512;
constexpr size_t W_OUT = W_BRN + (size_t)1024 * 512;
constexpr size_t W_XQ = W_OUT + (size_t)1024 * 1024;
constexpr size_t W_XKV = W_XQ + (size_t)1024 * 1024;
constexpr size_t W_XO = W_XKV + (size_t)2048 * 1024;
constexpr size_t W_FF1 = W_XO + (size_t)1024 * 1024;
constexpr size_t W_FF2 = W_FF1 + (size_t)4096 * 1024;
constexpr size_t W_GUP = W_FF2 + (size_t)4096 * 1024;
constexpr size_t W_WUP = W_GUP + (size_t)512 * 128;
constexpr size_t W_AUP = W_WUP + (size_t)2 * 512 * 64;

enum { I_XP = 0, I_XS, I_MP, I_MS, I_NORM_MIX, I_W_IN, I_MU_PREV, I_MU_NEXT, I_W0, I_W_UP, I_A0, I_A_UP,
       I_G_UP, I_K_K, I_K_A, I_R_K, I_GN_G, I_GN_B, I_RPB, I_W_BR_RWKV, I_W_BR_NAT, I_W_OUT, I_NORM_X,
       I_NORM_MEM, I_W_XQ, I_W_XKV, I_W_XO, I_NORM_FF, I_W_FF1, I_W_FF2, I_NORM_FINAL };

struct Params {
  const float* in[31];
  float* X;
  char* ws;
};

DEVI u16 f2bf(float f) {
  uint32_t u = __float_as_uint(f);
  u += 0x7FFFu + ((u >> 16) & 1u);
  return (u16)(u >> 16);
}
DEVI float bf2f(u16 h) { return __uint_as_float(((uint32_t)h) << 16); }
DEVI uint32_t pack2(float a, float b) { return (uint32_t)f2bf(a) | ((uint32_t)f2bf(b) << 16); }
DEVI float frcp(float x) { return __builtin_amdgcn_rcpf(x); }
DEVI float sigm(float x) { return frcp(1.f + __expf(-x)); }
DEVI float ftanh(float x) { return 1.f - 2.f * frcp(__expf(2.f * x) + 1.f); }
DEVI void unpack8(u32x4 u, float* o) {
  o[0] = __uint_as_float(u.x << 16); o[1] = __uint_as_float(u.x & 0xffff0000u);
  o[2] = __uint_as_float(u.y << 16); o[3] = __uint_as_float(u.y & 0xffff0000u);
  o[4] = __uint_as_float(u.z << 16); o[5] = __uint_as_float(u.z & 0xffff0000u);
  o[6] = __uint_as_float(u.w << 16); o[7] = __uint_as_float(u.w & 0xffff0000u);
}
DEVI void load8bf(const u16* p, float* o) { unpack8(*(const u32x4*)p, o); }
DEVI float wave_sum(float v) {
  v += __shfl_xor(v, 32); v += __shfl_xor(v, 16); v += __shfl_xor(v, 8);
  v += __shfl_xor(v, 4); v += __shfl_xor(v, 2); v += __shfl_xor(v, 1);
  return v;
}
DEVI float red16_sum(float v) {
  v += __shfl_xor(v, 1); v += __shfl_xor(v, 2); v += __shfl_xor(v, 4); v += __shfl_xor(v, 8);
  return v;
}
DEVI float red16_max(float v) {
  v = fmaxf(v, __shfl_xor(v, 1)); v = fmaxf(v, __shfl_xor(v, 2));
  v = fmaxf(v, __shfl_xor(v, 4)); v = fmaxf(v, __shfl_xor(v, 8));
  return v;
}

DEVI void conv_tile(int tid_, const float* src, int K, int N, u16* dst, int tile, char* smem) {
  float (*s)[65] = (float (*)[65])smem;
  const int nN = N >> 6;
  const int tk = tile / nN, tn = tile - tk * nN;
  const int tx = tid_ & 63, ty = tid_ >> 6;
  for (int r = ty; r < 64; r += 4) s[r][tx] = src[(size_t)(tk * 64 + r) * N + tn * 64 + tx];
  __syncthreads();
  for (int r = ty; r < 64; r += 4) dst[(size_t)(tn * 64 + r) * K + tk * 64 + tx] = f2bf(s[tx][r]);
  __syncthreads();
}

DEVI void phase_conv(int tid_, const Params& p, int l, char* smem) {
  u16* WB = (u16*)(p.ws + OFF_WB);
  const int c0 = 1376, c1 = c0 + 128, c2 = c1 + 128, c3 = c2 + 256, c4 = c3 + 256, c5 = c4 + 512,
            c6 = c5 + 256, c7 = c6 + 1024, c8 = c7 + 1024, c9 = c8 + 16, c10 = c9 + 16, c11 = c10 + 16;
  for (int t = blockIdx.x; t < c11; t += gridDim.x) {
    if (t < c0) conv_tile(tid_, p.in[I_W_IN] + (size_t)l * 1024 * 5504, 1024, 5504, WB + W_IN, t, smem);
    else if (t < c1) conv_tile(tid_, p.in[I_W_BR_RWKV] + (size_t)l * 512 * 1024, 512, 1024, WB + W_BRR, t - c0, smem);
    else if (t < c2) conv_tile(tid_, p.in[I_W_BR_NAT] + (size_t)l * 512 * 1024, 512, 1024, WB + W_BRN, t - c1, smem);
    else if (t < c3) conv_tile(tid_, p.in[I_W_OUT] + (size_t)l * 1024 * 1024, 1024, 1024, WB + W_OUT, t - c2, smem);
    else if (t < c4) conv_tile(tid_, p.in[I_W_XQ] + (size_t)l * 1024 * 1024, 1024, 1024, WB + W_XQ, t - c3, smem);
    else if (t < c5) conv_tile(tid_, p.in[I_W_XKV] + (size_t)l * 1024 * 2048, 1024, 2048, WB + W_XKV, t - c4, smem);
    else if (t < c6) conv_tile(tid_, p.in[I_W_XO] + (size_t)l * 1024 * 1024, 1024, 1024, WB + W_XO, t - c5, smem);
    else if (t < c7) conv_tile(tid_, p.in[I_W_FF1] + (size_t)l * 1024 * 4096, 1024, 4096, WB + W_FF1, t - c6, smem);
    else if (t < c8) conv_tile(tid_, p.in[I_W_FF2] + (size_t)l * 4096 * 1024, 4096, 1024, WB + W_FF2, t - c7, smem);
    else if (t < c9) conv_tile(tid_, p.in[I_G_UP] + (size_t)l * 128 * 512, 128, 512, WB + W_GUP, t - c8, smem);
    else if (t < c10) { const int dd = (t - c9) >> 3; conv_tile(tid_, p.in[I_W_UP] + (size_t)(l * 2 + dd) * 64 * 512, 64, 512, WB + W_WUP + (size_t)dd * 512 * 64, (t - c9) & 7, smem); }
    else { const int dd = (t - c10) >> 3; conv_tile(tid_, p.in[I_A_UP] + (size_t)(l * 2 + dd) * 64 * 512, 64, 512, WB + W_AUP + (size_t)dd * 512 * 64, (t - c10) & 7, smem); }
  }
}

DEVI void norm_row_bf16(int tid_, const float* src, const float* g, u16* dst, float* xcopy) {
  const int lane = tid_ & 63;
  float4 v[4];
  float ss = 0.f;
#pragma unroll
  for (int i = 0; i < 4; ++i) {
    v[i] = ((const float4*)src)[lane + i * 64];
    ss += v[i].x * v[i].x + v[i].y * v[i].y + v[i].z * v[i].z + v[i].w * v[i].w;
  }
  ss = wave_sum(ss);
  const float rs = rsqrtf(ss * (1.f / 1024.f) + 1e-6f);
#pragma unroll
  for (int i = 0; i < 4; ++i) {
    float4 gg = ((const float4*)g)[lane + i * 64];
    u32x2 o;
    o.x = pack2(v[i].x * rs * gg.x, v[i].y * rs * gg.y);
    o.y = pack2(v[i].z * rs * gg.z, v[i].w * rs * gg.w);
    ((u32x2*)dst)[lane + i * 64] = o;
    if (xcopy) ((float4*)xcopy)[lane + i * 64] = v[i];
  }
}

DEVI void phase_norm(int tid_, const Params& p, const float* g, bool from_input, size_t hoff = OFF_H) {
  u16* H = (u16*)(p.ws + hoff);
  const int wid = tid_ >> 6;
  for (int r = blockIdx.x * 4 + wid; r < NTOK; r += gridDim.x * 4) {
    const float* src;
    if (from_input) src = (r < 32768) ? p.in[I_XP] + (size_t)r * 1024 : p.in[I_XS] + (size_t)(r - 32768) * 1024;
    else src = p.X + (size_t)r * 1024;
    norm_row_bf16(tid_, src, g, H + (size_t)r * 1024, from_input ? p.X + (size_t)r * 1024 : nullptr);
  }
}
DEVI void phase_norm_mem(int tid_, const Params& p, const float* g) {
  u16* MH = (u16*)(p.ws + OFF_MEMH);
  const int wid = tid_ >> 6;
  for (int r = blockIdx.x * 4 + wid; r < 3072; r += gridDim.x * 4) {
    const float* src = (r < 2048) ? p.in[I_MP] + (size_t)r * 1024 : p.in[I_MS] + (size_t)(r - 2048) * 1024;
    norm_row_bf16(tid_, src, g, MH + (size_t)r * 1024, nullptr);
  }
}
DEVI void phase_final_norm(int tid_, const Params& p) {
  const float* g = p.in[I_NORM_FINAL];
  const int wid = tid_ >> 6, lane = tid_ & 63;
  for (int r = blockIdx.x * 4 + wid; r < NTOK; r += gridDim.x * 4) {
    float* row = p.X + (size_t)r * 1024;
    float4 v[4];
    float ss = 0.f;
#pragma unroll
    for (int i = 0; i < 4; ++i) {
      v[i] = ((const float4*)row)[lane + i * 64];
      ss += v[i].x * v[i].x + v[i].y * v[i].y + v[i].z * v[i].z + v[i].w * v[i].w;
    }
    ss = wave_sum(ss);
    const float rs = rsqrtf(ss * (1.f / 1024.f) + 1e-6f);
#pragma unroll
    for (int i = 0; i < 4; ++i) {
      float4 gg = ((const float4*)g)[lane + i * 64];
      float4 o;
      o.x = v[i].x * rs * gg.x; o.y = v[i].y * rs * gg.y; o.z = v[i].z * rs * gg.z; o.w = v[i].w * rs * gg.w;
      ((float4*)row)[lane + i * 64] = o;
    }
  }
}

template <int OFF>
DEVI bf16x8 lds_rd128(uint32_t addr) {
  bf16x8 r;
  asm volatile("ds_read_b128 %0, %1 offset:%2" : "=v"(r) : "v"(addr), "n"(OFF));
  return r;
}

template <int NW, bool SWAP>
DEVI void gemm_kloop(int tid_, f32x4 (&acc)[4][NW], const u16* __restrict__ A, int lda, const u16* __restrict__ Bt, int ldb,
                     int K, char* smem) {
  constexpr int STG = 8192 + NW * 2048;
  constexpr int NB = NW / 2;
  const int tid = tid_, lane = tid & 63, wid = tid >> 6;
  const int wr = wid >> 1, wc = wid & 1, fr = lane & 15, fq = lane >> 4;
  const int lrow = lane >> 2, lphys = lane & 3, lhi = lane >> 4;
  const int gsw = (4 - lhi) & 3;
  const u16* ga[2];
  const u16* gb[NB];
#pragma unroll
  for (int q = 0; q < 2; ++q) ga[q] = A + (size_t)((wid * 2 + q) * 16 + lrow) * lda + (lphys ^ gsw) * 8;
#pragma unroll
  for (int q = 0; q < NB; ++q) gb[q] = Bt + (size_t)((wid * NB + q) * 16 + lrow) * ldb + (lphys ^ gsw) * 8;
  const int rsw = (4 - ((fr >> 2) & 3)) & 3;
  const int ch = (fq ^ rsw) * 16;
  const int nk = K >> 5;
  const uint32_t lds_base = (uint32_t)(size_t)(__attribute__((address_space(3))) char*)smem;
  const uint32_t aoff = (uint32_t)((wr * 64 + fr) * 64 + ch);
  const uint32_t boff = (uint32_t)(8192 + (wc * 16 * NW + fr) * 64 + ch);
  asm volatile("s_waitcnt vmcnt(0)" ::: "memory");
  __syncthreads();
#define GEMM_ISSUE(kt_)                                                                                              \
  do {                                                                                                               \
    char* nb_ = smem + ((kt_) & 3) * STG;                                                                            \
    _Pragma("unroll") for (int q = 0; q < 2; ++q) __builtin_amdgcn_global_load_lds(                                  \
        (const unsigned*)(ga[q] + (kt_) * 32),                                                                       \
        (__attribute__((address_space(3))) unsigned*)(nb_ + (wid * 2 + q) * 1024 + lane * 16), 16, 0, 0);            \
    _Pragma("unroll") for (int q = 0; q < NB; ++q) __builtin_amdgcn_global_load_lds(                                 \
        (const unsigned*)(gb[q] + (kt_) * 32),                                                                       \
        (__attribute__((address_space(3))) unsigned*)(nb_ + 8192 + (wid * NB + q) * 1024 + lane * 16), 16, 0, 0);    \
  } while (0)
  GEMM_ISSUE(0);
  if (nk > 1) GEMM_ISSUE(1);
  if (nk > 2) GEMM_ISSUE(2);
  for (int kt = 0; kt < nk; ++kt) {
    if (kt + 2 < nk) {
      if (NW == 4) asm volatile("s_waitcnt vmcnt(8)" ::: "memory");
      else asm volatile("s_waitcnt vmcnt(6)" ::: "memory");
    } else if (kt + 1 < nk) {
      if (NW == 4) asm volatile("s_waitcnt vmcnt(4)" ::: "memory");
      else asm volatile("s_waitcnt vmcnt(3)" ::: "memory");
    } else {
      asm volatile("s_waitcnt vmcnt(0)" ::: "memory");
    }
    __builtin_amdgcn_s_barrier();
    asm volatile("" ::: "memory");
    if (kt + 3 < nk) GEMM_ISSUE(kt + 3);
    const uint32_t sb = lds_base + (kt & 3) * STG;
    bf16x8 af[4], bfr[4];
    af[0] = lds_rd128<0>(sb + aoff); af[1] = lds_rd128<1024>(sb + aoff);
    af[2] = lds_rd128<2048>(sb + aoff); af[3] = lds_rd128<3072>(sb + aoff);
    bfr[0] = lds_rd128<0>(sb + boff); bfr[1] = lds_rd128<1024>(sb + boff);
    if (NW == 4) {
      bfr[2] = lds_rd128<2048>(sb + boff); bfr[3] = lds_rd128<3072>(sb + boff);
      asm volatile("s_waitcnt lgkmcnt(0)" : "+v"(af[0]), "+v"(af[1]), "+v"(af[2]), "+v"(af[3]),
                   "+v"(bfr[0]), "+v"(bfr[1]), "+v"(bfr[2]), "+v"(bfr[3]));
    } else {
      asm volatile("s_waitcnt lgkmcnt(0)" : "+v"(af[0]), "+v"(af[1]), "+v"(af[2]), "+v"(af[3]), "+v"(bfr[0]), "+v"(bfr[1]));
    }
#pragma unroll
    for (int m = 0; m < 4; ++m)
#pragma unroll
      for (int n = 0; n < NW; ++n) {
        if (SWAP) acc[m][n] = __builtin_amdgcn_mfma_f32_16x16x32_bf16(bfr[n], af[m], acc[m][n], 0, 0, 0);
        else acc[m][n] = __builtin_amdgcn_mfma_f32_16x16x32_bf16(af[m], bfr[n], acc[m][n], 0, 0, 0);
      }
  }
#undef GEMM_ISSUE
}

DEVI int launder(int x) { asm volatile("" : "+v"(x)); return x; }

template <int NW>
DEVI void zero_acc(f32x4 (&acc)[4][NW]) {
#pragma unroll
  for (int m = 0; m < 4; ++m)
#pragma unroll
    for (int n = 0; n < NW; ++n) acc[m][n] = (f32x4){0.f, 0.f, 0.f, 0.f};
}

struct NoEpi { DEVI void operator()(int, int, f32x4) const {} };

template <class EpiS, class EpiN>
DEVI void gemm_phase(int tid_, const u16* A, int lda, const u16* Bt, int ldb, int K, int M, int N, char* smem, int ns_from,
                     EpiS epiS, EpiN epiN) {
  const int nN = N >> 7, nM = M >> 7;
  const int lane = tid_ & 63, wid = tid_ >> 6;
  const int wr = wid >> 1, wc = wid & 1, fr = lane & 15, fq = lane >> 4;
  const int xcd = blockIdx.x & 7, jloc = blockIdx.x >> 3, nloc = gridDim.x >> 3;
  for (int lt = jloc; lt < (nM >> 3) * nN; lt += nloc) {
    const int tml = lt / nN, tn = lt - tml * nN;
    const int tm = tml * 8 + xcd;
    const int m0 = tm << 7, n0 = tn << 7;
    f32x4 acc[4][4];
    zero_acc(acc);
    if (n0 < ns_from) {
      gemm_kloop<4, true>(tid_, acc, A + (size_t)m0 * lda, lda, Bt + (size_t)n0 * ldb, ldb, K, smem);
#pragma unroll
      for (int m = 0; m < 4; ++m)
#pragma unroll
        for (int n = 0; n < 4; ++n) epiS(m0 + wr * 64 + m * 16 + fr, n0 + wc * 64 + n * 16 + fq * 4, acc[m][n]);
    } else {
      gemm_kloop<4, false>(tid_, acc, A + (size_t)m0 * lda, lda, Bt + (size_t)n0 * ldb, ldb, K, smem);
#pragma unroll
      for (int m = 0; m < 4; ++m)
#pragma unroll
        for (int n = 0; n < 4; ++n) epiN(m0 + wr * 64 + m * 16 + fq * 4, n0 + wc * 64 + n * 16 + fr, acc[m][n]);
    }
  }
}


template <bool SWAP>
DEVI void gemm_kloop_big(int tid_, f32x4 (&acc)[8][4], const u16* __restrict__ A, int lda, const u16* __restrict__ Bt,
                         int ldb, int K, char* smem) {
  constexpr int STG = 16384 + 8192;
  const int tid = tid_, lane = tid & 63, wid = tid >> 6;
  const int wr = wid >> 1, wc = wid & 1, fr = lane & 15, fq = lane >> 4;
  const int lrow = lane >> 2, lphys = lane & 3, lhi = lane >> 4;
  const int gsw = (4 - lhi) & 3;
  const u16* ga = A + (size_t)(wid * 64 + lrow) * lda + (lphys ^ gsw) * 8;
  const u16* gb = Bt + (size_t)(wid * 32 + lrow) * ldb + (lphys ^ gsw) * 8;
  const size_t a16 = (size_t)16 * lda, b16 = (size_t)16 * ldb;
  const int rsw = (4 - ((fr >> 2) & 3)) & 3;
  const int ch = (fq ^ rsw) * 16;
  const int nk = K >> 5;
  const uint32_t lds_base = (uint32_t)(size_t)(__attribute__((address_space(3))) char*)smem;
  const uint32_t aoff = (uint32_t)((wr * 128 + fr) * 64 + ch);
  const uint32_t boff = (uint32_t)(16384 + (wc * 64 + fr) * 64 + ch);
  asm volatile("s_waitcnt vmcnt(0)" ::: "memory");
  __syncthreads();
#define GEMMB_ISSUE(kt_, buf_)                                                                                       \
  do {                                                                                                               \
    char* nb_ = smem + (buf_) * STG;                                                                                 \
    _Pragma("unroll") for (int q = 0; q < 4; ++q) __builtin_amdgcn_global_load_lds(                                  \
        (const unsigned*)(ga + q * a16 + (kt_) * 32),                                                                \
        (__attribute__((address_space(3))) unsigned*)(nb_ + (wid * 4 + q) * 1024 + lane * 16), 16, 0, 0);            \
    _Pragma("unroll") for (int q = 0; q < 2; ++q) __builtin_amdgcn_global_load_lds(                                  \
        (const unsigned*)(gb + q * b16 + (kt_) * 32),                                                                \
        (__attribute__((address_space(3))) unsigned*)(nb_ + 16384 + (wid * 2 + q) * 1024 + lane * 16), 16, 0, 0);   \
  } while (0)
  GEMMB_ISSUE(0, 0);
  if (nk > 1) GEMMB_ISSUE(1, 1);
  int cb = 0;
  for (int kt = 0; kt < nk; ++kt) {
    if (kt + 1 < nk) asm volatile("s_waitcnt vmcnt(6)" ::: "memory");
    else asm volatile("s_waitcnt vmcnt(0)" ::: "memory");
    __builtin_amdgcn_s_barrier();
    asm volatile("" ::: "memory");
    const int nbuf = (cb == 0) ? 2 : cb - 1;
    if (kt + 2 < nk) GEMMB_ISSUE(kt + 2, nbuf);
    const uint32_t sb = lds_base + cb * STG;
    bf16x8 a0[4], a1[4], bb[4];
    a0[0] = lds_rd128<0>(sb + aoff); a0[1] = lds_rd128<1024>(sb + aoff);
    a0[2] = lds_rd128<2048>(sb + aoff); a0[3] = lds_rd128<3072>(sb + aoff);
    bb[0] = lds_rd128<0>(sb + boff); bb[1] = lds_rd128<1024>(sb + boff);
    bb[2] = lds_rd128<2048>(sb + boff); bb[3] = lds_rd128<3072>(sb + boff);
    a1[0] = lds_rd128<4096>(sb + aoff); a1[1] = lds_rd128<5120>(sb + aoff);
    a1[2] = lds_rd128<6144>(sb + aoff); a1[3] = lds_rd128<7168>(sb + aoff);
    asm volatile("s_waitcnt lgkmcnt(4)" : "+v"(a0[0]), "+v"(a0[1]), "+v"(a0[2]), "+v"(a0[3]),
                 "+v"(bb[0]), "+v"(bb[1]), "+v"(bb[2]), "+v"(bb[3]));
#pragma unroll
    for (int m = 0; m < 4; ++m)
#pragma unroll
      for (int n = 0; n < 4; ++n) {
        if (SWAP) acc[m][n] = __builtin_amdgcn_mfma_f32_16x16x32_bf16(bb[n], a0[m], acc[m][n], 0, 0, 0);
        else acc[m][n] = __builtin_amdgcn_mfma_f32_16x16x32_bf16(a0[m], bb[n], acc[m][n], 0, 0, 0);
      }
    asm volatile("s_waitcnt lgkmcnt(0)" : "+v"(a1[0]), "+v"(a1[1]), "+v"(a1[2]), "+v"(a1[3]));
#pragma unroll
    for (int m = 0; m < 4; ++m)
#pragma unroll
      for (int n = 0; n < 4; ++n) {
        if (SWAP) acc[4 + m][n] = __builtin_amdgcn_mfma_f32_16x16x32_bf16(bb[n], a1[m], acc[4 + m][n], 0, 0, 0);
        else acc[4 + m][n] = __builtin_amdgcn_mfma_f32_16x16x32_bf16(a1[m], bb[n], acc[4 + m][n], 0, 0, 0);
      }
    cb = (cb == 2) ? 0 : cb + 1;
  }
#undef GEMMB_ISSUE
}

template <class EpiS, class EpiN>
DEVI void gemm_phase_big(int tid_, const u16* A, int lda, const u16* Bt, int ldb, int K, int M, int N, char* smem,
                         int ns_from, EpiS epiS, EpiN epiN) {
  const int nN = N >> 7, nM = M >> 8;
  const int lane = tid_ & 63, wid = tid_ >> 6;
  const int wr = wid >> 1, wc = wid & 1, fr = lane & 15, fq = lane >> 4;
  const int xcd = blockIdx.x & 7, jloc = blockIdx.x >> 3, nloc = gridDim.x >> 3;
  for (int lt = jloc; lt < (nM >> 3) * nN; lt += nloc) {
    const int tml = lt / nN, tn = lt - tml * nN;
    const int tm = tml * 8 + xcd;
    const int m0 = tm << 8, n0 = tn << 7;
    f32x4 acc[8][4];
#pragma unroll
    for (int m = 0; m < 8; ++m)
#pragma unroll
      for (int n = 0; n < 4; ++n) acc[m][n] = (f32x4){0.f, 0.f, 0.f, 0.f};
    if (n0 < ns_from) {
      gemm_kloop_big<true>(launder(tid_), acc, A + (size_t)m0 * lda, lda, Bt + (size_t)n0 * ldb, ldb, K, smem);
#pragma unroll
      for (int m = 0; m < 8; ++m)
#pragma unroll
        for (int n = 0; n < 4; ++n) epiS(m0 + wr * 128 + m * 16 + fr, n0 + wc * 64 + n * 16 + fq * 4, acc[m][n]);
    } else {
      gemm_kloop_big<false>(launder(tid_), acc, A + (size_t)m0 * lda, lda, Bt + (size_t)n0 * ldb, ldb, K, smem);
#pragma unroll
      for (int m = 0; m < 8; ++m)
#pragma unroll
        for (int n = 0; n < 4; ++n) epiN(m0 + wr * 128 + m * 16 + fq * 4, n0 + wc * 64 + n * 16 + fr, acc[m][n]);
    }
  }
}

DEVI void store4bf(u16* dst, f32x4 v) {
  u32x2 o;
  o.x = pack2(v[0], v[1]); o.y = pack2(v[2], v[3]);
  *(u32x2*)dst = o;
}

DEVI void phase_p_gemm(int tid_, const Params& p, char* smem) {
  u16* WB = (u16*)(p.ws + OFF_WB);
  const u16* H = (const u16*)(p.ws + OFF_H);
  u16* PR = (u16*)(p.ws + OFF_PR);
  u16* NQ = (u16*)(p.ws + OFF_NQ);
  u16* NK = (u16*)(p.ws + OFF_NK);
  u16* NVT = (u16*)(p.ws + OFF_NV);
  gemm_phase_big(tid_, H, 1024, WB + W_IN, 1024, 1024, NTOK, 3456, smem, 2944,
    [&](int r, int c0, f32x4 v) {
      if (c0 < 1920) store4bf(PR + (size_t)r * PRW + c0, v);
      else if (c0 < 2432) store4bf(NQ + (size_t)r * 512 + (c0 - 1920), v);
      else store4bf(NK + (size_t)r * 512 + (c0 - 2432), v);
    },
    [&](int r0, int c, f32x4 v) {
      const int cc = c - 2944;
      const int s = r0 >> 12, t = r0 & 4095;
      store4bf(NVT + ((size_t)(s * 512 + cc)) * 4096 + t, v);
    });
  const u16* MH = (const u16*)(p.ws + OFF_MEMH);
  u16* KVK = (u16*)(p.ws + OFF_KVK);
  u16* KVT = (u16*)(p.ws + OFF_KVT);
  gemm_phase(tid_, MH, 1024, WB + W_XKV, 1024, 1024, 3072, 2048, smem, 1024,
    [&](int r, int c0, f32x4 v) { store4bf(KVK + (size_t)r * 1024 + c0, v); },
    [&](int r0, int c, f32x4 v) {
      const int cc = c - 1024;
      const int s = r0 >> 8, m = r0 & 255;
      store4bf(KVT + ((size_t)(s * 1024 + cc)) * 256 + m, v);
    });
}

DEVI void phase_nat(int tid_, const Params& p, int l, char* smem, int bfirst, int bstride) {
  u16* NQ = (u16*)(p.ws + OFF_NQ);
  const u16* NK = (const u16*)(p.ws + OFF_NK);
  const u16* NVT = (const u16*)(p.ws + OFF_NV);
  const float* rpb = p.in[I_RPB] + (size_t)l * 8 * 15 * 31;
  const int lane = tid_ & 63, g = tid_ >> 6, fr = lane & 15, fq = lane >> 4;
  u16* Pw = (u16*)smem + g * (16 * 264);
  const int cb = (g == 0) ? 0 : (g == 1) ? 8 : (g == 2) ? 24 : 32;
  for (int t = bfirst; t < 12 * 64 * 8; t += bstride) {
    const int h = t & 7, ri = (t >> 3) & 63, s = t >> 9;
    int rs = ri - 4; rs = rs < 0 ? 0 : (rs > 56 ? 56 : rs);
    const size_t tokq = (size_t)s * 4096 + ri * 64 + g * 16;
    bf16x8 aq[2];
    aq[0] = *(const bf16x8*)(NQ + (tokq + fr) * 512 + h * 64 + fq * 8);
    aq[1] = *(const bf16x8*)(NQ + (tokq + fr) * 512 + h * 64 + 32 + fq * 8);
    f32x4 acc[16];
#pragma unroll
    for (int n = 0; n < 16; ++n) {
      acc[n] = (f32x4){0.f, 0.f, 0.f, 0.f};
      const int r = n >> 1, col = cb + (n & 1) * 16 + fr;
      const u16* kp = NK + ((size_t)s * 4096 + (rs + r) * 64 + col) * 512 + h * 64 + fq * 8;
      bf16x8 b0 = *(const bf16x8*)kp;
      bf16x8 b1 = *(const bf16x8*)(kp + 32);
      acc[n] = __builtin_amdgcn_mfma_f32_16x16x32_bf16(aq[0], b0, acc[n], 0, 0, 0);
      acc[n] = __builtin_amdgcn_mfma_f32_16x16x32_bf16(aq[1], b1, acc[n], 0, 0, 0);
    }
    float mx[4], sm[4];
#pragma unroll
    for (int j = 0; j < 4; ++j) {
      const int c = g * 16 + fq * 4 + j;
      int cs = c - 8; cs = cs < 0 ? 0 : (cs > 48 ? 48 : cs);
      float m = -1e30f;
#pragma unroll
      for (int n = 0; n < 16; ++n) {
        const int r = n >> 1, kc = cb + (n & 1) * 16 + fr;
        const bool valid = (kc >= cs) && (kc < cs + 16);
        float sc = -1e30f;
        if (valid) {
          const int di = rs + r - ri + 7, dj = kc - c + 15;
          sc = acc[n][j] * 0.125f + rpb[(h * 15 + di) * 31 + dj];
        }
        acc[n][j] = sc;
        m = fmaxf(m, sc);
      }
      mx[j] = red16_max(m);
    }
#pragma unroll
    for (int j = 0; j < 4; ++j) {
      float ssum = 0.f;
#pragma unroll
      for (int n = 0; n < 16; ++n) {
        float e = __expf(acc[n][j] - mx[j]);
        acc[n][j] = e;
        ssum += e;
      }
      sm[j] = 1.f / red16_sum(ssum);
    }
    __syncthreads();
#pragma unroll
    for (int n = 0; n < 16; ++n)
#pragma unroll
      for (int j = 0; j < 4; ++j) Pw[(fq * 4 + j) * 264 + n * 16 + fr] = f2bf(acc[n][j]);
    __syncthreads();
    f32x4 o[4];
#pragma unroll
    for (int n = 0; n < 4; ++n) o[n] = (f32x4){0.f, 0.f, 0.f, 0.f};
#pragma unroll
    for (int ks = 0; ks < 8; ++ks) {
      bf16x8 ap = *(const bf16x8*)(Pw + fr * 264 + ks * 32 + fq * 8);
#pragma unroll
      for (int n = 0; n < 4; ++n) {
        bf16x8 bv = *(const bf16x8*)(NVT + ((size_t)(s * 512 + h * 64 + n * 16 + fr)) * 4096 + (rs + ks) * 64 + cb + fq * 8);
        o[n] = __builtin_amdgcn_mfma_f32_16x16x32_bf16(ap, bv, o[n], 0, 0, 0);
      }
    }
#pragma unroll
    for (int n = 0; n < 4; ++n)
#pragma unroll
      for (int j = 0; j < 4; ++j)
        NQ[(tokq + fq * 4 + j) * 512 + h * 64 + n * 16 + fr] = f2bf(o[n][j] * sm[j]);
  }
}

constexpr int SC_OPS = 0;
constexpr int SC_VV = 40960;
constexpr int SC_WR = 49152;
constexpr int SC_AP = 57344;
constexpr int SC_TW = 65536;
constexpr int SC_AD = 70144;
constexpr int SC_NRM = 74752;
constexpr int SC_MU = 74880;
constexpr int SC_CST = 77440;

typedef __attribute__((ext_vector_type(2))) float f32x2;

template <int CTRL>
DEVI float dpp_mov(float x) {
  return __int_as_float(__builtin_amdgcn_update_dpp(0, __float_as_int(x), CTRL, 0xF, 0xF, true));
}
DEVI float red8(float x) {
  x += dpp_mov<0xB1>(x);
  x += dpp_mov<0x4E>(x);
  x += dpp_mov<0x141>(x);
  return x;
}
DEVI f32x2 lo2(f32x4 v) { return __builtin_shufflevector(v, v, 0, 1); }
DEVI f32x2 hi2(f32x4 v) { return __builtin_shufflevector(v, v, 2, 3); }

struct ScanOps {
  f32x2 a[4], w[4], b[4], k[4], r[4];
  float v0, v1;
};
DEVI void scan_load(ScanOps& o, const float* OPS, const float* VV, int nn, int jg, int i0) {
  const float* base = OPS + nn * 64 + jg * 8;
  f32x4 t0, t1;
  t0 = *(const f32x4*)(base); t1 = *(const f32x4*)(base + 4);
  o.a[0] = lo2(t0); o.a[1] = hi2(t0); o.a[2] = lo2(t1); o.a[3] = hi2(t1);
  t0 = *(const f32x4*)(base + 2048); t1 = *(const f32x4*)(base + 2048 + 4);
  o.w[0] = lo2(t0); o.w[1] = hi2(t0); o.w[2] = lo2(t1); o.w[3] = hi2(t1);
  t0 = *(const f32x4*)(base + 4096); t1 = *(const f32x4*)(base + 4096 + 4);
  o.b[0] = lo2(t0); o.b[1] = hi2(t0); o.b[2] = lo2(t1); o.b[3] = hi2(t1);
  t0 = *(const f32x4*)(base + 6144); t1 = *(const f32x4*)(base + 6144 + 4);
  o.k[0] = lo2(t0); o.k[1] = hi2(t0); o.k[2] = lo2(t1); o.k[3] = hi2(t1);
  t0 = *(const f32x4*)(base + 8192); t1 = *(const f32x4*)(base + 8192 + 4);
  o.r[0] = lo2(t0); o.r[1] = hi2(t0); o.r[2] = lo2(t1); o.r[3] = hi2(t1);
  o.v0 = VV[nn * 64 + i0];
  o.v1 = VV[nn * 64 + i0 + 8];
}
DEVI void scan_step(const ScanOps& o, f32x2 (&S0)[4], f32x2 (&S1)[4], float* YL, int nn, int jg, int i0) {
  f32x2 d0 = S0[0] * o.a[0], d0b = S0[2] * o.a[2];
  f32x2 d1 = S1[0] * o.a[0], d1b = S1[2] * o.a[2];
  d0 = S0[1] * o.a[1] + d0; d0b = S0[3] * o.a[3] + d0b;
  d1 = S1[1] * o.a[1] + d1; d1b = S1[3] * o.a[3] + d1b;
  d0 += d0b; d1 += d1b;
  const float sa0 = red8(d0.x + d0.y);
  const float sa1 = red8(d1.x + d1.y);
  f32x2 e0 = {0.f, 0.f}, e1 = {0.f, 0.f};
#pragma unroll
  for (int q = 0; q < 4; ++q) {
    const f32x2 u0 = sa0 * o.b[q] + o.v0 * o.k[q];
    const f32x2 u1 = sa1 * o.b[q] + o.v1 * o.k[q];
    S0[q] = S0[q] * o.w[q] + u0;
    S1[q] = S1[q] * o.w[q] + u1;
    e0 = S0[q] * o.r[q] + e0;
    e1 = S1[q] * o.r[q] + e1;
  }
  const float y0 = red8(e0.x + e0.y);
  const float y1 = red8(e1.x + e1.y);
  if (jg == 0) { YL[nn * 64 + i0] = y0; YL[nn * 64 + i0 + 8] = y1; }
}

DEVI void phase_scan(int tid_, const Params& p, int l, char* smem, int bstride) {
  const u16* PR = (const u16*)(p.ws + OFF_PR);
  _Float16* YF = (_Float16*)(p.ws + OFF_H);
  _Float16* YB = (_Float16*)(p.ws + OFF_H + (size_t)NTOK * 512 * 2);
  float* BON = (float*)(p.ws + OFF_BONUS);
  const u16* WB = (const u16*)(p.ws + OFF_WB);
  float* OPS = (float*)(smem + SC_OPS);
  u16* RAW = (u16*)(smem + SC_OPS);
  float* VV = (float*)(smem + SC_VV);
  float* WR = (float*)(smem + SC_WR);
  float* AP = (float*)(smem + SC_AP);
  float* YL = WR;
  u16* TWb = (u16*)(smem + SC_TW);
  u16* ADb = (u16*)(smem + SC_AD);
  float* NRM = (float*)(smem + SC_NRM);
  float* MU = (float*)(smem + SC_MU);
  float* CST = (float*)(smem + SC_CST);
  const float* mu_p = p.in[I_MU_PREV] + (size_t)l * 1920;
  const float* mu_n = p.in[I_MU_NEXT] + (size_t)l * 1920;
  const int tid = tid_, lane = tid & 63, w = tid >> 6, fr = lane & 15, fq = lane >> 4;
  const int pn = tid >> 3, j0 = (tid & 7) * 8;
  const int jg = lane & 7, i0 = w * 16 + (lane >> 3);
  const int hr = (tid >= 40) ? 1 : 0, hc = tid - hr * 40;
  for (int blk = blockIdx.x; blk < 192; blk += bstride) {
    const int s = blk >> 4, h = (blk >> 1) & 7, d = blk & 1;
    __syncthreads();
    for (int i = tid; i < 640; i += 256) {
      const int which = (i >= 320) ? 1 : 0, c = i - which * 320;
      const int g = c >> 6, e = c & 63;
      const int col = (g < 3) ? (g * 512 + h * 64 + e) : (1536 + (g - 3) * 128 + d * 64 + e);
      MU[i] = which ? mu_n[col] : mu_p[col];
    }
    for (int i = tid; i < 320; i += 256) {
      const int which = i >> 6, e = i & 63;
      float v;
      if (which == 0) v = p.in[I_W0][(size_t)(l * 2 + d) * 512 + h * 64 + e];
      else if (which == 1) v = p.in[I_A0][(size_t)(l * 2 + d) * 512 + h * 64 + e];
      else if (which == 2) v = p.in[I_K_K][(size_t)l * 512 + h * 64 + e];
      else if (which == 3) v = p.in[I_K_A][(size_t)l * 512 + h * 64 + e];
      else v = p.in[I_R_K][(size_t)(l * 8 + h) * 64 + e];
      CST[i] = v;
    }
    bf16x8 bw[2], ba[2];
#pragma unroll
    for (int ks = 0; ks < 2; ++ks) {
      bw[ks] = *(const bf16x8*)(WB + W_WUP + (size_t)(d * 512 + h * 64 + w * 16 + fr) * 64 + ks * 32 + fq * 8);
      ba[ks] = *(const bf16x8*)(WB + W_AUP + (size_t)(d * 512 + h * 64 + w * 16 + fr) * 64 + ks * 32 + fq * 8);
    }
    _Float16* Y = d ? YB : YF;
    f32x2 S0[4], S1[4];
#pragma unroll
    for (int q = 0; q < 4; ++q) { S0[q] = (f32x2){0.f, 0.f}; S1[q] = (f32x2){0.f, 0.f}; }
    u32x4 G[5], GH;
    {
      const int t = d ? (4095 - pn) : pn;
      const size_t tok = (size_t)s * 4096 + t;
#pragma unroll
      for (int g = 0; g < 5; ++g) {
        const int col = (g < 3) ? (g * 512 + h * 64) : (1536 + (g - 3) * 128 + d * 64);
        G[g] = *(const u32x4*)(PR + tok * PRW + col + j0);
      }
      GH = (u32x4){0u, 0u, 0u, 0u};
      if (tid < 80) {
        const int tlo = d ? (4095 - 31) : 0;
        const int th = hr ? (tlo + 32) : (tlo - 1);
        const int g = hc >> 3;
        const int col = (g < 3) ? (g * 512 + h * 64) : (1536 + (g - 3) * 128 + d * 64);
        if (th >= 0 && th <= 4095) GH = *(const u32x4*)(PR + ((size_t)s * 4096 + th) * PRW + col + (hc & 7) * 8);
      }
    }
#pragma unroll 1
    for (int ch = 0; ch < 128; ++ch) {
      const int n = ch * 32 + pn;
      const int t = d ? (4095 - n) : n;
      const size_t tok = (size_t)s * 4096 + t;
      const int tlo = d ? (4095 - (ch * 32 + 31)) : (ch * 32);
      const int rrow = t - tlo + 1;
#pragma unroll
      for (int g = 0; g < 5; ++g) *(u32x4*)(RAW + rrow * 320 + g * 64 + j0) = G[g];
      if (tid < 80) *(u32x4*)(RAW + (hr ? 33 : 0) * 320 + (hc >> 3) * 64 + (hc & 7) * 8) = GH;
      __syncthreads();
      if (ch + 1 < 128) {
        const int n2 = n + 32;
        const int t2 = d ? (4095 - n2) : n2;
        const size_t tok2 = (size_t)s * 4096 + t2;
#pragma unroll
        for (int g = 0; g < 5; ++g) {
          const int col = (g < 3) ? (g * 512 + h * 64) : (1536 + (g - 3) * 128 + d * 64);
          G[g] = *(const u32x4*)(PR + tok2 * PRW + col + j0);
        }
        GH = (u32x4){0u, 0u, 0u, 0u};
        if (tid < 80) {
          const int tlo2 = d ? (tlo - 32) : (tlo + 32);
          const int th = hr ? (tlo2 + 32) : (tlo2 - 1);
          const int g = hc >> 3;
          const int col = (g < 3) ? (g * 512 + h * 64) : (1536 + (g - 3) * 128 + d * 64);
          if (th >= 0 && th <= 4095) GH = *(const u32x4*)(PR + ((size_t)s * 4096 + th) * PRW + col + (hc & 7) * 8);
        }
      }
#pragma unroll
      for (int g = 0; g < 5; ++g) {
        float cur[8], prv[8], nxt[8];
        load8bf(RAW + rrow * 320 + g * 64 + j0, cur);
        load8bf(RAW + (rrow - 1) * 320 + g * 64 + j0, prv);
        load8bf(RAW + (rrow + 1) * 320 + g * 64 + j0, nxt);
        const f32x4 mp0 = *(const f32x4*)(MU + g * 64 + j0), mp1 = *(const f32x4*)(MU + g * 64 + j0 + 4);
        const f32x4 mn0 = *(const f32x4*)(MU + 320 + g * 64 + j0), mn1 = *(const f32x4*)(MU + 320 + g * 64 + j0 + 4);
        f32x4 x0, x1;
#pragma unroll
        for (int e = 0; e < 4; ++e) {
          x0[e] = cur[e] + mp0[e] * (prv[e] - cur[e]) + mn0[e] * (nxt[e] - cur[e]);
          x1[e] = cur[4 + e] + mp1[e] * (prv[4 + e] - cur[4 + e]) + mn1[e] * (nxt[4 + e] - cur[4 + e]);
        }
        if (g == 0) {
          *(f32x4*)(OPS + 4 * 2048 + pn * 64 + j0) = x0; *(f32x4*)(OPS + 4 * 2048 + pn * 64 + j0 + 4) = x1;
        } else if (g == 1) {
          *(f32x4*)(OPS + 3 * 2048 + pn * 64 + j0) = x0; *(f32x4*)(OPS + 3 * 2048 + pn * 64 + j0 + 4) = x1;
          const f32x4 kk0 = *(const f32x4*)(CST + 128 + j0), kk1 = *(const f32x4*)(CST + 128 + j0 + 4);
          float ss = 0.f;
#pragma unroll
          for (int e = 0; e < 4; ++e) { const float a_ = x0[e] * kk0[e], b_ = x1[e] * kk1[e]; ss += a_ * a_ + b_ * b_; }
          ss = red8(ss);
          if ((tid & 7) == 0) NRM[pn] = frcp(fmaxf(__builtin_amdgcn_sqrtf(ss), 1e-12f));
        } else if (g == 2) {
          *(f32x4*)(VV + pn * 64 + j0) = x0; *(f32x4*)(VV + pn * 64 + j0 + 4) = x1;
        } else if (g == 3) {
          u32x4 pk;
          pk.x = pack2(ftanh(x0[0]), ftanh(x0[1])); pk.y = pack2(ftanh(x0[2]), ftanh(x0[3]));
          pk.z = pack2(ftanh(x1[0]), ftanh(x1[1])); pk.w = pack2(ftanh(x1[2]), ftanh(x1[3]));
          *(u32x4*)(TWb + pn * 72 + j0) = pk;
        } else {
          u32x4 pk;
          pk.x = pack2(x0[0], x0[1]); pk.y = pack2(x0[2], x0[3]);
          pk.z = pack2(x1[0], x1[1]); pk.w = pack2(x1[2], x1[3]);
          *(u32x4*)(ADb + pn * 72 + j0) = pk;
        }
      }
      __syncthreads();
#pragma unroll
      for (int m = 0; m < 2; ++m) {
        f32x4 cw = {0.f, 0.f, 0.f, 0.f}, ca = {0.f, 0.f, 0.f, 0.f};
#pragma unroll
        for (int ks = 0; ks < 2; ++ks) {
          const bf16x8 aw = *(const bf16x8*)(TWb + (m * 16 + fr) * 72 + ks * 32 + fq * 8);
          const bf16x8 aa = *(const bf16x8*)(ADb + (m * 16 + fr) * 72 + ks * 32 + fq * 8);
          cw = __builtin_amdgcn_mfma_f32_16x16x32_bf16(aw, bw[ks], cw, 0, 0, 0);
          ca = __builtin_amdgcn_mfma_f32_16x16x32_bf16(aa, ba[ks], ca, 0, 0, 0);
        }
#pragma unroll
        for (int jj = 0; jj < 4; ++jj) {
          WR[(m * 16 + fq * 4 + jj) * 64 + w * 16 + fr] = cw[jj];
          AP[(m * 16 + fq * 4 + jj) * 64 + w * 16 + fr] = ca[jj];
        }
      }
      __syncthreads();
      {
        const float inv = NRM[pn];
        float bsum = 0.f;
#pragma unroll
        for (int hq = 0; hq < 2; ++hq) {
          const int jb = j0 + hq * 4;
          const f32x4 wr_ = *(const f32x4*)(WR + pn * 64 + jb) + *(const f32x4*)(CST + jb);
          const f32x4 ap_ = *(const f32x4*)(AP + pn * 64 + jb) + *(const f32x4*)(CST + 64 + jb);
          const f32x4 kr = *(const f32x4*)(OPS + 3 * 2048 + pn * 64 + jb);
          const f32x4 rr = *(const f32x4*)(OPS + 4 * 2048 + pn * 64 + jb);
          const f32x4 kkw = *(const f32x4*)(CST + 128 + jb), kaw = *(const f32x4*)(CST + 192 + jb), rkw = *(const f32x4*)(CST + 256 + jb);
          f32x4 o0, o1, o2, o3;
#pragma unroll
          for (int e = 0; e < 4; ++e) {
            const float sw = sigm(wr_[e]);
            const float dec = __expf(-0.6065306597126334f * sw);
            const float av = sigm(ap_[e]);
            const float kn = kr[e] * kkw[e] * inv;
            const float kd = kr[e] * (1.f + (av - 1.f) * kaw[e]);
            bsum += rr[e] * kd * rkw[e];
            o0[e] = -kn; o1[e] = dec; o2[e] = kn * av; o3[e] = kd;
          }
          *(f32x4*)(OPS + 0 * 2048 + pn * 64 + jb) = o0;
          *(f32x4*)(OPS + 1 * 2048 + pn * 64 + jb) = o1;
          *(f32x4*)(OPS + 2 * 2048 + pn * 64 + jb) = o2;
          *(f32x4*)(OPS + 3 * 2048 + pn * 64 + jb) = o3;
        }
        bsum = red8(bsum);
        if ((tid & 7) == 0) BON[(tok * 8 + h) * 2 + d] = bsum;
      }
      __syncthreads();
      {
        ScanOps oa, ob;
        scan_load(oa, OPS, VV, 0, jg, i0);
#pragma unroll 1
        for (int nn = 0; nn < 32; nn += 2) {
          scan_load(ob, OPS, VV, nn + 1, jg, i0);
          scan_step(oa, S0, S1, YL, nn, jg, i0);
          scan_load(oa, OPS, VV, (nn + 2) & 31, jg, i0);
          scan_step(ob, S0, S1, YL, nn + 1, jg, i0);
        }
      }
      __syncthreads();
      {
        h16x8 o;
#pragma unroll
        for (int e = 0; e < 8; ++e) o[e] = (_Float16)YL[pn * 64 + j0 + e];
        *(h16x8*)(Y + tok * 512 + h * 64 + j0) = o;
      }
    }
    __syncthreads();
  }
}

DEVI void phase_rwkv_post(int tid_, const Params& p, int l, char* smem) {
  u16* PR = (u16*)(p.ws + OFF_PR);
  const _Float16* YF = (const _Float16*)(p.ws + OFF_H);
  const _Float16* YB = (const _Float16*)(p.ws + OFF_H + (size_t)NTOK * 512 * 2);
  const float* BON = (const float*)(p.ws + OFF_BONUS);
  const u16* GUPT = (const u16*)(p.ws + OFF_WB) + W_GUP;
  const float* mu_p = p.in[I_MU_PREV] + (size_t)l * 1920;
  const float* mu_n = p.in[I_MU_NEXT] + (size_t)l * 1920;
  const float* gng = p.in[I_GN_G] + (size_t)l * 512;
  const float* gnb = p.in[I_GN_B] + (size_t)l * 512;
  u16* As = (u16*)smem;
  const int tid = tid_, lane = tid & 63, w = tid >> 6, fr = lane & 15, fq = lane >> 4;
  for (int tile = blockIdx.x; tile < NTOK / 64; tile += gridDim.x) {
    const size_t tok0 = (size_t)tile * 64;
    {
      const int row = tid >> 2, part = tid & 3;
      const size_t tok = tok0 + row;
      const int t = (int)(tok & 4095);
#pragma unroll
      for (int q = 0; q < 4; ++q) {
        const int col = 1792 + part * 32 + q * 8;
        float cur[8], prv[8], nxt[8];
        load8bf(PR + tok * PRW + col, cur);
        if (t > 0) load8bf(PR + (tok - 1) * PRW + col, prv);
        else {
#pragma unroll
          for (int e = 0; e < 8; ++e) prv[e] = 0.f;
        }
        if (t < 4095) load8bf(PR + (tok + 1) * PRW + col, nxt);
        else {
#pragma unroll
          for (int e = 0; e < 8; ++e) nxt[e] = 0.f;
        }
        float o[8];
#pragma unroll
        for (int e = 0; e < 8; ++e) {
          const float x = cur[e] + mu_p[col + e] * (prv[e] - cur[e]) + mu_n[col + e] * (nxt[e] - cur[e]);
          o[e] = sigm(x);
        }
        u32x4 pk;
        pk.x = pack2(o[0], o[1]); pk.y = pack2(o[2], o[3]); pk.z = pack2(o[4], o[5]); pk.w = pack2(o[6], o[7]);
        *(u32x4*)(As + row * 136 + part * 32 + q * 8) = pk;
      }
    }
    __syncthreads();
#pragma unroll 1
    for (int chh = 0; chh < 2; ++chh) {
      f32x4 acc[16];
#pragma unroll
      for (int n = 0; n < 16; ++n) acc[n] = (f32x4){0.f, 0.f, 0.f, 0.f};
#pragma unroll
      for (int ks = 0; ks < 4; ++ks) {
        bf16x8 af = *(const bf16x8*)(As + (w * 16 + fr) * 136 + ks * 32 + fq * 8);
#pragma unroll
        for (int n = 0; n < 16; ++n) {
          bf16x8 bg = *(const bf16x8*)(GUPT + (size_t)(chh * 256 + n * 16 + fr) * 128 + ks * 32 + fq * 8);
          acc[n] = __builtin_amdgcn_mfma_f32_16x16x32_bf16(af, bg, acc[n], 0, 0, 0);
        }
      }
#pragma unroll
      for (int hl = 0; hl < 4; ++hl) {
        const int head = chh * 4 + hl;
#pragma unroll
        for (int j = 0; j < 4; ++j) {
          const size_t tok = tok0 + w * 16 + fq * 4 + j;
          const int t = (int)(tok & 4095);
          float o[4], sum = 0.f;
#pragma unroll
          for (int q = 0; q < 4; ++q) {
            const int col = head * 64 + q * 16 + fr;
            o[q] = (float)YF[tok * 512 + col] + (float)YB[tok * 512 + col];
            sum += o[q];
          }
          const float mean = red16_sum(sum) * (1.f / 64.f);
          float vs = 0.f;
#pragma unroll
          for (int q = 0; q < 4; ++q) { const float dlt = o[q] - mean; vs += dlt * dlt; }
          const float var = red16_sum(vs) * (1.f / 64.f);
          const float rstd = rsqrtf(var + 64e-5f);
          const float bon = BON[(tok * 8 + head) * 2] + BON[(tok * 8 + head) * 2 + 1];
#pragma unroll
          for (int q = 0; q < 4; ++q) {
            const int col = head * 64 + q * 16 + fr;
            const int vc = 1024 + col;
            const float cur = bf2f(PR[tok * PRW + vc]);
            const float prv = (t > 0) ? bf2f(PR[(tok - 1) * PRW + vc]) : 0.f;
            const float nxt = (t < 4095) ? bf2f(PR[(tok + 1) * PRW + vc]) : 0.f;
            const float vsh = cur + mu_p[vc] * (prv - cur) + mu_n[vc] * (nxt - cur);
            const float yv = ((o[q] - mean) * rstd * gng[col] + gnb[col] + bon * vsh) * acc[hl * 4 + q][j];
            PR[tok * PRW + col] = f2bf(yv);
          }
        }
      }
    }
    __syncthreads();
  }
}

DEVI f32x4 ld4bf(const u16* p) {
  const u32x2 u = *(const u32x2*)p;
  f32x4 o;
  o[0] = __uint_as_float(u.x << 16); o[1] = __uint_as_float(u.x & 0xffff0000u);
  o[2] = __uint_as_float(u.y << 16); o[3] = __uint_as_float(u.y & 0xffff0000u);
  return o;
}

DEVI void phase_merge(int tid_, const Params& p, char* smem) {
  const u16* WB = (const u16*)(p.ws + OFF_WB);
  const u16* H = (const u16*)(p.ws + OFF_NK);
  u16* PR = (u16*)(p.ws + OFF_PR);
  const u16* NQ = (const u16*)(p.ws + OFF_NQ);
  u16* TMP = (u16*)(p.ws + OFF_H);
  const int lane = tid_ & 63, wid = tid_ >> 6;
  const int wr = wid >> 1, wc = wid & 1, fr = lane & 15, fq = lane >> 4;
  const int xcd = blockIdx.x & 7, jloc = blockIdx.x >> 3, nloc = gridDim.x >> 3;
  for (int lt = jloc; lt < 24 * 8; lt += nloc) {
    const int tm = (lt >> 3) * 8 + xcd, tn = lt & 7;
    const int m0 = tm << 8, n0 = tn << 7;
    f32x4 acc[8][4];
#define MERGE_ZERO() _Pragma("unroll") for (int m = 0; m < 8; ++m) _Pragma("unroll") for (int n = 0; n < 4; ++n) acc[m][n] = (f32x4){0.f, 0.f, 0.f, 0.f}
#define MERGE_RC() const int r = m0 + wr * 128 + m * 16 + fr, c0 = n0 + wc * 64 + n * 16 + fq * 4
    MERGE_ZERO();
    gemm_kloop_big<true>(launder(tid_), acc, H + (size_t)m0 * 1024, 1024, WB + W_IN + (size_t)(3456 + n0) * 1024, 1024, 1024, smem);
#pragma unroll
    for (int m = 0; m < 8; ++m)
#pragma unroll
      for (int n = 0; n < 4; ++n) {
        MERGE_RC();
        f32x4 o;
#pragma unroll
        for (int j = 0; j < 4; ++j) o[j] = sigm(acc[m][n][j]);
        store4bf(PR + (size_t)r * PRW + 512 + c0, o);
      }
    MERGE_ZERO();
    gemm_kloop_big<true>(launder(tid_), acc, PR + (size_t)m0 * PRW, PRW, WB + W_BRR + (size_t)n0 * 512, 512, 512, smem);
#pragma unroll
    for (int m = 0; m < 8; ++m)
#pragma unroll
      for (int n = 0; n < 4; ++n) {
        MERGE_RC();
        u16* dst = PR + (size_t)r * PRW + 512 + c0;
        store4bf(dst, ld4bf(dst) * acc[m][n]);
      }
    MERGE_ZERO();
    gemm_kloop_big<true>(launder(tid_), acc, H + (size_t)m0 * 1024, 1024, WB + W_IN + (size_t)(4480 + n0) * 1024, 1024, 1024, smem);
#pragma unroll
    for (int m = 0; m < 8; ++m)
#pragma unroll
      for (int n = 0; n < 4; ++n) {
        MERGE_RC();
        f32x4 o;
#pragma unroll
        for (int j = 0; j < 4; ++j) o[j] = sigm(acc[m][n][j]);
        store4bf(TMP + (size_t)r * 1024 + c0, o);
      }
    MERGE_ZERO();
    gemm_kloop_big<true>(launder(tid_), acc, NQ + (size_t)m0 * 512, 512, WB + W_BRN + (size_t)n0 * 512, 512, 512, smem);
#pragma unroll
    for (int m = 0; m < 8; ++m)
#pragma unroll
      for (int n = 0; n < 4; ++n) {
        MERGE_RC();
        u16* dst = PR + (size_t)r * PRW + 512 + c0;
        store4bf(dst, ld4bf(dst) + ld4bf(TMP + (size_t)r * 1024 + c0) * acc[m][n]);
      }
#undef MERGE_ZERO
#undef MERGE_RC
  }
}

DEVI void phase_xattn(int tid_, const Params& p, char* smem) {
  const u16* Q = (const u16*)(p.ws + OFF_PR);
  u16* O = (u16*)(p.ws + OFF_NQ);
  const u16* KVK = (const u16*)(p.ws + OFF_KVK);
  const u16* KVT = (const u16*)(p.ws + OFF_KVT);
  const int lane = tid_ & 63, w = tid_ >> 6, fr = lane & 15, fq = lane >> 4;
  u16* Pw = (u16*)smem + w * (16 * 264);
  for (int t = blockIdx.x; t < (NTOK / 64) * 4; t += gridDim.x) {
    const int hh = t & 3;
    const size_t tok0 = (size_t)(t >> 2) * 64 + w * 16;
    const int s = (int)(tok0 >> 12);
    f32x4 acc[16];
#pragma unroll
    for (int n = 0; n < 16; ++n) acc[n] = (f32x4){0.f, 0.f, 0.f, 0.f};
#pragma unroll 2
    for (int ks = 0; ks < 8; ++ks) {
      bf16x8 aq = *(const bf16x8*)(Q + (tok0 + fr) * 1024 + hh * 256 + ks * 32 + fq * 8);
#pragma unroll
      for (int n = 0; n < 16; ++n) {
        bf16x8 bk = *(const bf16x8*)(KVK + (size_t)(s * 256 + n * 16 + fr) * 1024 + hh * 256 + ks * 32 + fq * 8);
        acc[n] = __builtin_amdgcn_mfma_f32_16x16x32_bf16(aq, bk, acc[n], 0, 0, 0);
      }
    }
    float sm[4];
#pragma unroll
    for (int j = 0; j < 4; ++j) {
      float m = -1e30f;
#pragma unroll
      for (int n = 0; n < 16; ++n) { acc[n][j] *= 0.0625f; m = fmaxf(m, acc[n][j]); }
      m = red16_max(m);
      float ssum = 0.f;
#pragma unroll
      for (int n = 0; n < 16; ++n) { const float e = __expf(acc[n][j] - m); acc[n][j] = e; ssum += e; }
      sm[j] = 1.f / red16_sum(ssum);
    }
    __syncthreads();
#pragma unroll
    for (int n = 0; n < 16; ++n)
#pragma unroll
      for (int j = 0; j < 4; ++j) Pw[(fq * 4 + j) * 264 + n * 16 + fr] = f2bf(acc[n][j]);
    __syncthreads();
#pragma unroll
    for (int n = 0; n < 16; ++n) acc[n] = (f32x4){0.f, 0.f, 0.f, 0.f};
#pragma unroll 2
    for (int ks = 0; ks < 8; ++ks) {
      bf16x8 ap = *(const bf16x8*)(Pw + fr * 264 + ks * 32 + fq * 8);
#pragma unroll
      for (int n = 0; n < 16; ++n) {
        bf16x8 bv = *(const bf16x8*)(KVT + (size_t)(s * 1024 + hh * 256 + n * 16 + fr) * 256 + ks * 32 + fq * 8);
        acc[n] = __builtin_amdgcn_mfma_f32_16x16x32_bf16(ap, bv, acc[n], 0, 0, 0);
      }
    }
#pragma unroll
    for (int n = 0; n < 16; ++n)
#pragma unroll
      for (int j = 0; j < 4; ++j)
        O[(tok0 + fq * 4 + j) * 1024 + hh * 256 + n * 16 + fr] = f2bf(acc[n][j] * sm[j]);
  }
}

DEVI void run_phase(int tid_, const Params& p, int ph, char* smem) {
  if (ph == 2 * NPH_LAYER) { phase_final_norm(tid_, p); return; }
  const int l = ph / NPH_LAYER, q = ph % NPH_LAYER;
  u16* WB = (u16*)(p.ws + OFF_WB);
  u16* H = (u16*)(p.ws + OFF_H);
  u16* PR = (u16*)(p.ws + OFF_PR);
  u16* NQ = (u16*)(p.ws + OFF_NQ);
  float* X = p.X;
  auto epi_res = [&](int r, int c0, f32x4 v) {
    f32x4* px = (f32x4*)(X + (size_t)r * 1024 + c0);
    *px = *px + v;
  };
  constexpr int NONS = 1 << 30;
  switch (q) {
    case 0:
      phase_conv(tid_, p, l, smem);
      phase_norm(tid_, p, p.in[I_NORM_MIX] + (size_t)l * 1024, l == 0);
      phase_norm_mem(tid_, p, p.in[I_NORM_MEM] + (size_t)l * 1024);
      break;
    case 1: phase_p_gemm(tid_, p, smem); break;
    case 2:
      if (gridDim.x >= 256) {
        if (blockIdx.x < 192) phase_scan(tid_, p, l, smem, gridDim.x);
        else phase_nat(tid_, p, l, smem, blockIdx.x - 192, gridDim.x - 192);
      } else {
        phase_scan(tid_, p, l, smem, gridDim.x);
        __syncthreads();
        phase_nat(tid_, p, l, smem, blockIdx.x, gridDim.x);
      }
      break;
    case 3:
      phase_rwkv_post(tid_, p, l, smem);
      phase_norm(tid_, p, p.in[I_NORM_MIX] + (size_t)l * 1024, false, OFF_NK);
      break;
    case 4: phase_merge(tid_, p, smem); break;
    case 5: gemm_phase_big(tid_, PR + 512, PRW, WB + W_OUT, 1024, 1024, NTOK, 1024, smem, NONS, epi_res, NoEpi()); break;
    case 6: phase_norm(tid_, p, p.in[I_NORM_X] + (size_t)l * 1024, false); break;
    case 7:
      gemm_phase_big(tid_, H, 1024, WB + W_XQ, 1024, 1024, NTOK, 1024, smem, NONS,
                 [&](int r, int c0, f32x4 v) { store4bf(PR + (size_t)r * 1024 + c0, v); }, NoEpi());
      break;
    case 8: phase_xattn(tid_, p, smem); break;
    case 9: gemm_phase_big(tid_, NQ, 1024, WB + W_XO, 1024, 1024, NTOK, 1024, smem, NONS, epi_res, NoEpi()); break;
    case 10: phase_norm(tid_, p, p.in[I_NORM_FF] + (size_t)l * 1024, false); break;
    case 11:
    case 13: {
      const int hf = (q == 13);
      gemm_phase_big(tid_, H, 1024, WB + W_FF1 + (size_t)hf * 2048 * 1024, 1024, 1024, NTOK, 2048, smem, NONS,
                 [&](int r, int c0, f32x4 v) {
                   f32x4 o;
#pragma unroll
                   for (int j = 0; j < 4; ++j) { const float x = fmaxf(v[j], 0.f); o[j] = x * x; }
                   store4bf(PR + (size_t)r * 2048 + c0, o);
                 }, NoEpi());
    } break;
    case 12:
    case 14: {
      const int hf = (q == 14);
      gemm_phase_big(tid_, PR, 2048, WB + W_FF2 + (size_t)hf * 2048, 4096, 2048, NTOK, 1024, smem, NONS, epi_res, NoEpi());
    } break;
  }
}

#define XB_TMO      128
#define XB_XCNT(j)  (256  + 64 * (j))
#define XB_XSUB(j)  (1280 + 64 * (j))
#define XB_XGEN(j)  (2304 + 64 * (j))
#define XB_TOP      3328
#define XB_TOPGEN   3392
#define XCD_BAR_WORDS 3456
#define XB_SPIN_CAP (1u << 20)
#define LAS __attribute__((address_space(3)))

DEVI unsigned xb_ld(unsigned* p) { return __hip_atomic_load(p, __ATOMIC_RELAXED, __HIP_MEMORY_SCOPE_AGENT); }
DEVI unsigned xb_add(unsigned* p, unsigned v) { return __hip_atomic_fetch_add(p, v, __ATOMIC_RELAXED, __HIP_MEMORY_SCOPE_AGENT); }
DEVI unsigned xb_xcc_id() { return (unsigned)__builtin_amdgcn_s_getreg((3 << 11) | 20) & 0xFu; }
#define XB_SPIN(cond, bar) do { unsigned _sp = 0; while (cond) { __builtin_amdgcn_s_sleep(1); \
    if ((++_sp & 255u) == 0u) { if (xb_ld(&(bar)[XB_TMO])) break; if (_sp > XB_SPIN_CAP) { atomicAdd(&(bar)[XB_TMO], 1u); break; } } } } while (0)

struct XcdBarrier {
  unsigned* bar; unsigned x;
  volatile LAS unsigned* st;
};
DEVI XcdBarrier xcd_barrier_post(unsigned* bar, volatile LAS unsigned* st) {
  XcdBarrier b; b.bar = bar; b.x = xb_xcc_id(); b.st = st;
  if (threadIdx.x == 0) (void)xb_add(&bar[XB_XCNT(b.x)], 1u);
  return b;
}
DEVI void xcd_barrier_complete(unsigned* bar, unsigned x, unsigned& nloc, unsigned& nx) {
  const unsigned G = gridDim.x * gridDim.y * gridDim.z;
  unsigned sum, cnt, mine, sp = 0u;
  for (;;) {
    sum = 0u; cnt = 0u; mine = 0u;
#pragma unroll
    for (unsigned j = 0; j < 16; ++j) { const unsigned c = xb_ld(&bar[XB_XCNT(j)]); sum += c; cnt += (c > 0u) ? 1u : 0u; mine = (j == x) ? c : mine; }
    if (sum == G) break;
    __builtin_amdgcn_s_sleep(1);
    if ((++sp & 255u) == 0u) { if (xb_ld(&bar[XB_TMO])) break; if (sp > XB_SPIN_CAP) { atomicAdd(&bar[XB_TMO], 1u); break; } }
  }
  nloc = mine > 0u ? mine : 1u; nx = cnt > 0u ? cnt : 1u;
}
DEVI void xcd_barrier(const XcdBarrier& b) {
  asm volatile("s_waitcnt vmcnt(0)" ::: "memory");
  __syncthreads();
  if (threadIdx.x == 0) {
    unsigned* bar = b.bar;
    __builtin_amdgcn_s_waitcnt(0);
    unsigned nloc = b.st[0], nx = b.st[1];
    if (nloc == 0u) { xcd_barrier_complete(bar, b.x, nloc, nx); b.st[0] = nloc; b.st[1] = nx; }
    const unsigned old = xb_add(&bar[XB_XSUB(b.x)], 1u);
    const unsigned gen = old / nloc;
    if (old + 1u == (gen + 1u) * nloc) {
      __builtin_amdgcn_fence(__ATOMIC_RELEASE, "agent");
      asm volatile("s_waitcnt vmcnt(0)" ::: "memory");
      const unsigned og = xb_add(&bar[XB_TOP], 1u);
      const unsigned tg = og / nx;
      if (og + 1u == (tg + 1u) * nx) xb_add(&bar[XB_TOPGEN], 1u);
      else XB_SPIN(xb_ld(&bar[XB_TOPGEN]) == tg, bar);
      __builtin_amdgcn_fence(__ATOMIC_ACQUIRE, "agent");
      xb_add(&bar[XB_XGEN(b.x)], 1u);
      asm volatile("s_waitcnt vmcnt(0)" ::: "memory");
    } else {
      XB_SPIN(xb_ld(&bar[XB_XGEN(b.x)]) == gen, bar);
      __builtin_amdgcn_fence(__ATOMIC_ACQUIRE, "agent");
      asm volatile("s_waitcnt vmcnt(0)" ::: "memory");
    }
  }
  __syncthreads();
}

__global__ void __launch_bounds__(256, 2) mega_kernel(Params p, int ph0, int ph1) {
  __shared__ __attribute__((aligned(16))) char smem[SMEM_BYTES];
  __shared__ __attribute__((aligned(16))) unsigned xb_words[4];
  if (threadIdx.x == 0) { xb_words[0] = 0u; xb_words[1] = 0u; xb_words[2] = 0u; xb_words[3] = 0u; }
  __syncthreads();
  XcdBarrier xb = xcd_barrier_post((unsigned*)(p.ws + OFF_BAR), (volatile LAS unsigned*)xb_words);
  for (int ph = ph0; ph < ph1; ++ph) {
    if (ph == ph0 + 1) cg::this_grid().sync();
    else if (ph > ph0) xcd_barrier(xb);
    int tid_ = threadIdx.x;
    asm volatile("" : "+v"(tid_));
    run_phase(tid_, p, ph, smem);
  }
}

extern "C" void kernel_launch(void* const* d_in, const int* in_sizes, int n_in, void* d_out, int out_size, void* d_ws,
                              size_t ws_size, hipStream_t stream) {
  if (ws_size < WS_NEED || n_in < 31) return;
  Params p{};
  for (int i = 0; i < 31; ++i) p.in[i] = (const float*)d_in[i];
  p.X = (float*)d_out;
  p.ws = (char*)d_ws;
  static int grid_blocks = 0;
  if (!grid_blocks) {
    int dev = 0, cus = 0, per_cu = 0;
    hipGetDevice(&dev);
    hipDeviceGetAttribute(&cus, hipDeviceAttributeMultiprocessorCount, dev);
    hipOccupancyMaxActiveBlocksPerMultiprocessor(&per_cu, mega_kernel, 256, 0);
    if (per_cu > 2) per_cu = 2;
    if (per_cu < 1) per_cu = 1;
    grid_blocks = cus * per_cu;
  }
  hipMemsetAsync((char*)d_ws + OFF_BAR, 0, 16384, stream);
  int ph0 = 0, ph1 = NPHASES;
  void* args[] = {&p, &ph0, &ph1};
  hipLaunchCooperativeKernel((void*)mega_kernel, dim3(grid_blocks), dim3(256), args, 0, stream);
}
```

```cpp
#include <hip/hip_runtime.h>
#include <hip/hip_cooperative_groups.h>
#include <stdint.h>
namespace cg = cooperative_groups;

typedef unsigned short u16;
typedef __attribute__((ext_vector_type(8))) short bf16x8;
typedef __attribute__((ext_vector_type(4))) float f32x4;
typedef __attribute__((ext_vector_type(8))) _Float16 h16x8;
typedef __attribute__((ext_vector_type(4))) unsigned int u32x4;
typedef __attribute__((ext_vector_type(2))) unsigned int u32x2;

#define DEVI __device__ __forceinline__

constexpr int NTOK = 49152;
constexpr int SEQ_T = 4096;
constexpr int PRW = 1920;
constexpr int NPH_LAYER = 15;
constexpr int NPHASES = 2 * NPH_LAYER + 1;
constexpr int SMEM_BYTES = 78720;

constexpr size_t OFF_WB = 0;
constexpr size_t WB_BYTES = 20512768ull * 2;
constexpr size_t OFF_H = OFF_WB + WB_BYTES;
constexpr size_t OFF_PR = OFF_H + (size_t)NTOK * 1024 * 2;
constexpr size_t OFF_NQ = OFF_PR + (size_t)NTOK * PRW * 2;
constexpr size_t OFF_NK = OFF_NQ + (size_t)NTOK * 512 * 2;
constexpr size_t OFF_NV = OFF_NK + (size_t)NTOK * 512 * 2;
constexpr size_t OFF_KVK = OFF_NV + (size_t)NTOK * 512 * 2;
constexpr size_t OFF_KVT = OFF_KVK + (size_t)3072 * 1024 * 2;
constexpr size_t OFF_MEMH = OFF_KVT + (size_t)3072 * 1024 * 2;
constexpr size_t OFF_BONUS = OFF_MEMH + (size_t)3072 * 1024 * 2;
constexpr size_t OFF_BAR = OFF_BONUS + (size_t)NTOK * 16 * 4;
constexpr size_t WS_NEED = OFF_BAR + 16384;

constexpr size_t W_IN = 0;
constexpr size_t W_BRR = W_IN + (size_t)5504 * 1024;
constexpr size_t W_BRN = W_BRR + (size_t)1024 * 512;
constexpr size_t W_OUT = W_BRN + (size_t)1024 * 512;
constexpr size_t W_XQ = W_OUT + (size_t)1024 * 1024;
constexpr size_t W_XKV = W_XQ + (size_t)1024 * 1024;
constexpr size_t W_XO = W_XKV + (size_t)2048 * 1024;
constexpr size_t W_FF1 = W_XO + (size_t)1024 * 1024;
constexpr size_t W_FF2 = W_FF1 + (size_t)4096 * 1024;
constexpr size_t W_GUP = W_FF2 + (size_t)4096 * 1024;
constexpr size_t W_WUP = W_GUP + (size_t)512 * 128;
constexpr size_t W_AUP = W_WUP + (size_t)2 * 512 * 64;

enum { I_XP = 0, I_XS, I_MP, I_MS, I_NORM_MIX, I_W_IN, I_MU_PREV, I_MU_NEXT, I_W0, I_W_UP, I_A0, I_A_UP,
       I_G_UP, I_K_K, I_K_A, I_R_K, I_GN_G, I_GN_B, I_RPB, I_W_BR_RWKV, I_W_BR_NAT, I_W_OUT, I_NORM_X,
       I_NORM_MEM, I_W_XQ, I_W_XKV, I_W_XO, I_NORM_FF, I_W_FF1, I_W_FF2, I_NORM_FINAL };

struct Params {
  const float* in[31];
  float* X;
  char* ws;
};

DEVI u16 f2bf(float f) {
  uint32_t u = __float_as_uint(f);
  u += 0x7FFFu + ((u >> 16) & 1u);
  return (u16)(u >> 16);
}
DEVI float bf2f(u16 h) { return __uint_as_float(((uint32_t)h) << 16); }
DEVI uint32_t pack2(float a, float b) { return (uint32_t)f2bf(a) | ((uint32_t)f2bf(b) << 16); }
DEVI float frcp(float x) { return __builtin_amdgcn_rcpf(x); }
DEVI float sigm(float x) { return frcp(1.f + __expf(-x)); }
DEVI float ftanh(float x) { return 1.f - 2.f * frcp(__expf(2.f * x) + 1.f); }
DEVI void unpack8(u32x4 u, float* o) {
  o[0] = __uint_as_float(u.x << 16); o[1] = __uint_as_float(u.x & 0xffff0000u);
  o[2] = __uint_as_float(u.y << 16); o[3] = __uint_as_float(u.y & 0xffff0000u);
  o[4] = __uint_as_float(u.z << 16); o[5] = __uint_as_float(u.z & 0xffff0000u);
  o[6] = __uint_as_float(u.w << 16); o[7] = __uint_as_float(u.w & 0xffff0000u);
}
DEVI void load8bf(const u16* p, float* o) { unpack8(*(const u32x4*)p, o); }
DEVI float wave_sum(float v) {
  v += __shfl_xor(v, 32); v += __shfl_xor(v, 16); v += __shfl_xor(v, 8);
  v += __shfl_xor(v, 4); v += __shfl_xor(v, 2); v += __shfl_xor(v, 1);
  return v;
}
DEVI float red16_sum(float v) {
  v += __shfl_xor(v, 1); v += __shfl_xor(v, 2); v += __shfl_xor(v, 4); v += __shfl_xor(v, 8);
  return v;
}
DEVI float red16_max(float v) {
  v = fmaxf(v, __shfl_xor(v, 1)); v = fmaxf(v, __shfl_xor(v, 2));
  v = fmaxf(v, __shfl_xor(v, 4)); v = fmaxf(v, __shfl_xor(v, 8));
  return v;
}

DEVI void conv_tile(int tid_, const float* src, int K, int N, u16* dst, int tile, char* smem) {
  float (*s)[65] = (float (*)[65])smem;
  const int nN = N >> 6;
  const int tk = tile / nN, tn = tile - tk * nN;
  const int tx = tid_ & 63, ty = tid_ >> 6;
  for (int r = ty; r < 64; r += 4) s[r][tx] = src[(size_t)(tk * 64 + r) * N + tn * 64 + tx];
  __syncthreads();
  for (int r = ty; r < 64; r += 4) dst[(size_t)(tn * 64 + r) * K + tk * 64 + tx] = f2bf(s[tx][r]);
  __syncthreads();
}

DEVI void phase_conv(int tid_, const Params& p, int l, char* smem) {
  u16* WB = (u16*)(p.ws + OFF_WB);
  const int c0 = 1376, c1 = c0 + 128, c2 = c1 + 128, c3 = c2 + 256, c4 = c3 + 256, c5 = c4 + 512,
            c6 = c5 + 256, c7 = c6 + 1024, c8 = c7 + 1024, c9 = c8 + 16, c10 = c9 + 16, c11 = c10 + 16;
  for (int t = blockIdx.x; t < c11; t += gridDim.x) {
    if (t < c0) conv_tile(tid_, p.in[I_W_IN] + (size_t)l * 1024 * 5504, 1024, 5504, WB + W_IN, t, smem);
    else if (t < c1) conv_tile(tid_, p.in[I_W_BR_RWKV] + (size_t)l * 512 * 1024, 512, 1024, WB + W_BRR, t - c0, smem);
    else if (t < c2) conv_tile(tid_, p.in[I_W_BR_NAT] + (size_t)l * 512 * 1024, 512, 1024, WB + W_BRN, t - c1, smem);
    else if (t < c3) conv_tile(tid_, p.in[I_W_OUT] + (size_t)l * 1024 * 1024, 1024, 1024, WB + W_OUT, t - c2, smem);
    else if (t < c4) conv_tile(tid_, p.in[I_W_XQ] + (size_t)l * 1024 * 1024, 1024, 1024, WB + W_XQ, t - c3, smem);
    else if (t < c5) conv_tile(tid_, p.in[I_W_XKV] + (size_t)l * 1024 * 2048, 1024, 2048, WB + W_XKV, t - c4, smem);
    else if (t < c6) conv_tile(tid_, p.in[I_W_XO] + (size_t)l * 1024 * 1024, 1024, 1024, WB + W_XO, t - c5, smem);
    else if (t < c7) conv_tile(tid_, p.in[I_W_FF1] + (size_t)l * 1024 * 4096, 1024, 4096, WB + W_FF1, t - c6, smem);
    else if (t < c8) conv_tile(tid_, p.in[I_W_FF2] + (size_t)l * 4096 * 1024, 4096, 1024, WB + W_FF2, t - c7, smem);
    else if (t < c9) conv_tile(tid_, p.in[I_G_UP] + (size_t)l * 128 * 512, 128, 512, WB + W_GUP, t - c8, smem);
    else if (t < c10) { const int dd = (t - c9) >> 3; conv_tile(tid_, p.in[I_W_UP] + (size_t)(l * 2 + dd) * 64 * 512, 64, 512, WB + W_WUP + (size_t)dd * 512 * 64, (t - c9) & 7, smem); }
    else { const int dd = (t - c10) >> 3; conv_tile(tid_, p.in[I_A_UP] + (size_t)(l * 2 + dd) * 64 * 512, 64, 512, WB + W_AUP + (size_t)dd * 512 * 64, (t - c10) & 7, smem); }
  }
}

DEVI void norm_row_bf16(int tid_, const float* src, const float* g, u16* dst, float* xcopy) {
  const int lane = tid_ & 63;
  float4 v[4];
  float ss = 0.f;
#pragma unroll
  for (int i = 0; i < 4; ++i) {
    v[i] = ((const float4*)src)[lane + i * 64];
    ss += v[i].x * v[i].x + v[i].y * v[i].y + v[i].z * v[i].z + v[i].w * v[i].w;
  }
  ss = wave_sum(ss);
  const float rs = rsqrtf(ss * (1.f / 1024.f) + 1e-6f);
#pragma unroll
  for (int i = 0; i < 4; ++i) {
    float4 gg = ((const float4*)g)[lane + i * 64];
    u32x2 o;
    o.x = pack2(v[i].x * rs * gg.x, v[i].y * rs * gg.y);
    o.y = pack2(v[i].z * rs * gg.z, v[i].w * rs * gg.w);
    ((u32x2*)dst)[lane + i * 64] = o;
    if (xcopy) ((float4*)xcopy)[lane + i * 64] = v[i];
  }
}

DEVI void phase_norm(int tid_, const Params& p, const float* g, bool from_input, size_t hoff = OFF_H) {
  u16* H = (u16*)(p.ws + hoff);
  const int wid = tid_ >> 6;
  for (int r = blockIdx.x * 4 + wid; r < NTOK; r += gridDim.x * 4) {
    const float* src;
    if (from_input) src = (r < 32768) ? p.in[I_XP] + (size_t)r * 1024 : p.in[I_XS] + (size_t)(r - 32768) * 1024;
    else src = p.X + (size_t)r * 1024;
    norm_row_bf16(tid_, src, g, H + (size_t)r * 1024, from_input ? p.X + (size_t)r * 1024 : nullptr);
  }
}
DEVI void phase_norm_mem(int tid_, const Params& p, const float* g) {
  u16* MH = (u16*)(p.ws + OFF_MEMH);
  const int wid = tid_ >> 6;
  for (int r = blockIdx.x * 4 + wid; r < 3072; r += gridDim.x * 4) {
    const float* src = (r < 2048) ? p.in[I_MP] + (size_t)r * 1024 : p.in[I_MS] + (size_t)(r - 2048) * 1024;
    norm_row_bf16(tid_, src, g, MH + (size_t)r * 1024, nullptr);
  }
}
DEVI void phase_final_norm(int tid_, const Params& p) {
  const float* g = p.in[I_NORM_FINAL];
  const int wid = tid_ >> 6, lane = tid_ & 63;
  for (int r = blockIdx.x * 4 + wid; r < NTOK; r += gridDim.x * 4) {
    float* row = p.X + (size_t)r * 1024;
    float4 v[4];
    float ss = 0.f;
#pragma unroll
    for (int i = 0; i < 4; ++i) {
      v[i] = ((const float4*)row)[lane + i * 64];
      ss += v[i].x * v[i].x + v[i].y * v[i].y + v[i].z * v[i].z + v[i].w * v[i].w;
    }
    ss = wave_sum(ss);
    const float rs = rsqrtf(ss * (1.f / 1024.f) + 1e-6f);
#pragma unroll
    for (int i = 0; i < 4; ++i) {
      float4 gg = ((const float4*)g)[lane + i * 64];
      float4 o;
      o.x = v[i].x * rs * gg.x; o.y = v[i].y * rs * gg.y; o.z = v[i].z * rs * gg.z; o.w = v[i].w * rs * gg.w;
      ((float4*)row)[lane + i * 64] = o;
    }
  }
}

template <int OFF>
DEVI bf16x8 lds_rd128(uint32_t addr) {
  bf16x8 r;
  asm volatile("ds_read_b128 %0, %1 offset:%2" : "=v"(r) : "v"(addr), "n"(OFF));
  return r;
}

template <int NW, bool SWAP>
DEVI void gemm_kloop(int tid_, f32x4 (&acc)[4][NW], const u16* __restrict__ A, int lda, const u16* __restrict__ Bt, int ldb,
                     int K, char* smem) {
  constexpr int STG = 8192 + NW * 2048;
  constexpr int NB = NW / 2;
  const int tid = tid_, lane = tid & 63, wid = tid >> 6;
  const int wr = wid >> 1, wc = wid & 1, fr = lane & 15, fq = lane >> 4;
  const int lrow = lane >> 2, lphys = lane & 3, lhi = lane >> 4;
  const int gsw = (4 - lhi) & 3;
  const u16* ga[2];
  const u16* gb[NB];
#pragma unroll
  for (int q = 0; q < 2; ++q) ga[q] = A + (size_t)((wid * 2 + q) * 16 + lrow) * lda + (lphys ^ gsw) * 8;
#pragma unroll
  for (int q = 0; q < NB; ++q) gb[q] = Bt + (size_t)((wid * NB + q) * 16 + lrow) * ldb + (lphys ^ gsw) * 8;
  const int rsw = (4 - ((fr >> 2) & 3)) & 3;
  const int ch = (fq ^ rsw) * 16;
  const int nk = K >> 5;
  const uint32_t lds_base = (uint32_t)(size_t)(__attribute__((address_space(3))) char*)smem;
  const uint32_t aoff = (uint32_t)((wr * 64 + fr) * 64 + ch);
  const uint32_t boff = (uint32_t)(8192 + (wc * 16 * NW + fr) * 64 + ch);
  asm volatile("s_waitcnt vmcnt(0)" ::: "memory");
  __syncthreads();
#define GEMM_ISSUE(kt_)                                                                                              \
  do {                                                                                                               \
    char* nb_ = smem + ((kt_) & 3) * STG;                                                                            \
    _Pragma("unroll") for (int q = 0; q < 2; ++q) __builtin_amdgcn_global_load_lds(                                  \
        (const unsigned*)(ga[q] + (kt_) * 32),                                                                       \
        (__attribute__((address_space(3))) unsigned*)(nb_ + (wid * 2 + q) * 1024 + lane * 16), 16, 0, 0);            \
    _Pragma("unroll") for (int q = 0; q < NB; ++q) __builtin_amdgcn_global_load_lds(                                 \
        (const unsigned*)(gb[q] + (kt_) * 32),                                                                       \
        (__attribute__((address_space(3))) unsigned*)(nb_ + 8192 + (wid * NB + q) * 1024 + lane * 16), 16, 0, 0);    \
  } while (0)
  GEMM_ISSUE(0);
  if (nk > 1) GEMM_ISSUE(1);
  if (nk > 2) GEMM_ISSUE(2);
  for (int kt = 0; kt < nk; ++kt) {
    if (kt + 2 < nk) {
      if (NW == 4) asm volatile("s_waitcnt vmcnt(8)" ::: "memory");
      else asm volatile("s_waitcnt vmcnt(6)" ::: "memory");
    } else if (kt + 1 < nk) {
      if (NW == 4) asm volatile("s_waitcnt vmcnt(4)" ::: "memory");
      else asm volatile("s_waitcnt vmcnt(3)" ::: "memory");
    } else {
      asm volatile("s_waitcnt vmcnt(0)" ::: "memory");
    }
    __builtin_amdgcn_s_barrier();
    asm volatile("" ::: "memory");
    if (kt + 3 < nk) GEMM_ISSUE(kt + 3);
    const uint32_t sb = lds_base + (kt & 3) * STG;
    bf16x8 af[4], bfr[4];
    af[0] = lds_rd128<0>(sb + aoff); af[1] = lds_rd128<1024>(sb + aoff);
    af[2] = lds_rd128<2048>(sb + aoff); af[3] = lds_rd128<3072>(sb + aoff);
    bfr[0] = lds_rd128<0>(sb + boff); bfr[1] = lds_rd128<1024>(sb + boff);
    if (NW == 4) {
      bfr[2] = lds_rd128<2048>(sb + boff); bfr[3] = lds_rd128<3072>(sb + boff);
      asm volatile("s_waitcnt lgkmcnt(0)" : "+v"(af[0]), "+v"(af[1]), "+v"(af[2]), "+v"(af[3]),
                   "+v"(bfr[0]), "+v"(bfr[1]), "+v"(bfr[2]), "+v"(bfr[3]));
    } else {
      asm volatile("s_waitcnt lgkmcnt(0)" : "+v"(af[0]), "+v"(af[1]), "+v"(af[2]), "+v"(af[3]), "+v"(bfr[0]), "+v"(bfr[1]));
    }
#pragma unroll
    for (int m = 0; m < 4; ++m)
#pragma unroll
      for (int n = 0; n < NW; ++n) {
        if (SWAP) acc[m][n] = __builtin_amdgcn_mfma_f32_16x16x32_bf16(bfr[n], af[m], acc[m][n], 0, 0, 0);
        else acc[m][n] = __builtin_amdgcn_mfma_f32_16x16x32_bf16(af[m], bfr[n], acc[m][n], 0, 0, 0);
      }
  }
#undef GEMM_ISSUE
}

DEVI int launder(int x) { asm volatile("" : "+v"(x)); return x; }

template <int NW>
DEVI void zero_acc(f32x4 (&acc)[4][NW]) {
#pragma unroll
  for (int m = 0; m < 4; ++m)
#pragma unroll
    for (int n = 0; n < NW; ++n) acc[m][n] = (f32x4){0.f, 0.f, 0.f, 0.f};
}

struct NoEpi { DEVI void operator()(int, int, f32x4) const {} };

template <class EpiS, class EpiN>
DEVI void gemm_phase(int tid_, const u16* A, int lda, const u16* Bt, int ldb, int K, int M, int N, char* smem, int ns_from,
                     EpiS epiS, EpiN epiN) {
  const int nN = N >> 7, nM = M >> 7;
  const int lane = tid_ & 63, wid = tid_ >> 6;
  const int wr = wid >> 1, wc = wid & 1, fr = lane & 15, fq = lane >> 4;
  const int xcd = blockIdx.x & 7, jloc = blockIdx.x >> 3, nloc = gridDim.x >> 3;
  for (int lt = jloc; lt < (nM >> 3) * nN; lt += nloc) {
    const int tml = lt / nN, tn = lt - tml * nN;
    const int tm = tml * 8 + xcd;
    const int m0 = tm << 7, n0 = tn << 7;
    f32x4 acc[4][4];
    zero_acc(acc);
    if (n0 < ns_from) {
      gemm_kloop<4, true>(tid_, acc, A + (size_t)m0 * lda, lda, Bt + (size_t)n0 * ldb, ldb, K, smem);
#pragma unroll
      for (int m = 0; m < 4; ++m)
#pragma unroll
        for (int n = 0; n < 4; ++n) epiS(m0 + wr * 64 + m * 16 + fr, n0 + wc * 64 + n * 16 + fq * 4, acc[m][n]);
    } else {
      gemm_kloop<4, false>(tid_, acc, A + (size_t)m0 * lda, lda, Bt + (size_t)n0 * ldb, ldb, K, smem);
#pragma unroll
      for (int m = 0; m < 4; ++m)
#pragma unroll
        for (int n = 0; n < 4; ++n) epiN(m0 + wr * 64 + m * 16 + fq * 4, n0 + wc * 64 + n * 16 + fr, acc[m][n]);
    }
  }
}


template <bool SWAP>
DEVI void gemm_kloop_big(int tid_, f32x4 (&acc)[8][4], const u16* __restrict__ A, int lda, const u16* __restrict__ Bt,
                         int ldb, int K, char* smem) {
  constexpr int STG = 16384 + 8192;
  const int tid = tid_, lane = tid & 63, wid = tid >> 6;
  const int wr = wid >> 1, wc = wid & 1, fr = lane & 15, fq = lane >> 4;
  const int lrow = lane >> 2, lphys = lane & 3, lhi = lane >> 4;
  const int gsw = (4 - lhi) & 3;
  const u16* ga = A + (size_t)(wid * 64 + lrow) * lda + (lphys ^ gsw) * 8;
  const u16* gb = Bt + (size_t)(wid * 32 + lrow) * ldb + (lphys ^ gsw) * 8;
  const size_t a16 = (size_t)16 * lda, b16 = (size_t)16 * ldb;
  const int rsw = (4 - ((fr >> 2) & 3)) & 3;
  const int ch = (fq ^ rsw) * 16;
  const int nk = K >> 5;
  const uint32_t lds_base = (uint32_t)(size_t)(__attribute__((address_space(3))) char*)smem;
  const uint32_t aoff = (uint32_t)((wr * 128 + fr) * 64 + ch);
  const uint32_t boff = (uint32_t)(16384 + (wc * 64 + fr) * 64 + ch);
  asm volatile("s_waitcnt vmcnt(0)" ::: "memory");
  __syncthreads();
#define GEMMB_ISSUE(kt_, buf_)                                                                                       \
  do {                                                                                                               \
    char* nb_ = smem + (buf_) * STG;                                                                                 \
    _Pragma("unroll") for (int q = 0; q < 4; ++q) __builtin_amdgcn_global_load_lds(                                  \
        (const unsigned*)(ga + q * a16 + (kt_) * 32),                                                                \
        (__attribute__((address_space(3))) unsigned*)(nb_ + (wid * 4 + q) * 1024 + lane * 16), 16, 0, 0);            \
    _Pragma("unroll") for (int q = 0; q < 2; ++q) __builtin_amdgcn_global_load_lds(                                  \
        (const unsigned*)(gb + q * b16 + (kt_) * 32),                                                                \
        (__attribute__((address_space(3))) unsigned*)(nb_ + 16384 + (wid * 2 + q) * 1024 + lane * 16), 16, 0, 0);   \
  } while (0)
  GEMMB_ISSUE(0, 0);
  if (nk > 1) GEMMB_ISSUE(1, 1);
  int cb = 0;
  for (int kt = 0; kt < nk; ++kt) {
    if (kt + 1 < nk) asm volatile("s_waitcnt vmcnt(6)" ::: "memory");
    else asm volatile("s_waitcnt vmcnt(0)" ::: "memory");
    __builtin_amdgcn_s_barrier();
    asm volatile("" ::: "memory");
    const int nbuf = (cb == 0) ? 2 : cb - 1;
    if (kt + 2 < nk) GEMMB_ISSUE(kt + 2, nbuf);
    const uint32_t sb = lds_base + cb * STG;
    bf16x8 a0[4], a1[4], bb[4];
    a0[0] = lds_rd128<0>(sb + aoff); a0[1] = lds_rd128<1024>(sb + aoff);
    a0[2] = lds_rd128<2048>(sb + aoff); a0[3] = lds_rd128<3072>(sb + aoff);
    bb[0] = lds_rd128<0>(sb + boff); bb[1] = lds_rd128<1024>(sb + boff);
    bb[2] = lds_rd128<2048>(sb + boff); bb[3] = lds_rd128<3072>(sb + boff);
    a1[0] = lds_rd128<4096>(sb + aoff); a1[1] = lds_rd128<5120>(sb + aoff);
    a1[2] = lds_rd128<6144>(sb + aoff); a1[3] = lds_rd128<7168>(sb + aoff);
    asm volatile("s_waitcnt lgkmcnt(4)" : "+v"(a0[0]), "+v"(a0[1]), "+v"(a0[2]), "+v"(a0[3]),
                 "+v"(bb[0]), "+v"(bb[1]), "+v"(bb[2]), "+v"(bb[3]));
#pragma unroll
    for (int m = 0; m < 4; ++m)
#pragma unroll
      for (int n = 0; n < 4; ++n) {
        if (SWAP) acc[m][n] = __builtin_amdgcn_mfma_f32_16x16x32_bf16(bb[n], a0[m], acc[m][n], 0, 0, 0);
        else acc[m][n] = __builtin_amdgcn_mfma_f32_16x16x32_bf16(a0[m], bb[n], acc[m][n], 0, 0, 0);
      }
    asm volatile("s_waitcnt lgkmcnt(0)" : "+v"(a1[0]), "+v"(a1[1]), "+v"(a1[2]), "+v"(a1[3]));
#pragma unroll
    for (int m = 0; m < 4; ++m)
#pragma unroll
      for (int n = 0; n < 4; ++n) {
        if (SWAP) acc[4 + m][n] = __builtin_amdgcn_mfma_f32_16x16x32_bf16(bb[n], a1[m], acc[4 + m][n], 0, 0, 0);
        else acc[4 + m][n] = __builtin_amdgcn_mfma_f32_16x16x32_bf16(a1[m], bb[n], acc[4 + m][n], 0, 0, 0);
      }
    cb = (cb == 2) ? 0 : cb + 1;
  }
#undef GEMMB_ISSUE
}

template <class EpiS, class EpiN>
DEVI void gemm_phase_big(int tid_, const u16* A, int lda, const u16* Bt, int ldb, int K, int M, int N, char* smem,
                         int ns_from, EpiS epiS, EpiN epiN) {
  const int nN = N >> 7, nM = M >> 8;
  const int lane = tid_ & 63, wid = tid_ >> 6;
  const int wr = wid >> 1, wc = wid & 1, fr = lane & 15, fq = lane >> 4;
  const int xcd = blockIdx.x & 7, jloc = blockIdx.x >> 3, nloc = gridDim.x >> 3;
  for (int lt = jloc; lt < (nM >> 3) * nN; lt += nloc) {
    const int tml = lt / nN, tn = lt - tml * nN;
    const int tm = tml * 8 + xcd;
    const int m0 = tm << 8, n0 = tn << 7;
    f32x4 acc[8][4];
#pragma unroll
    for (int m = 0; m < 8; ++m)
#pragma unroll
      for (int n = 0; n < 4; ++n) acc[m][n] = (f32x4){0.f, 0.f, 0.f, 0.f};
    if (n0 < ns_from) {
      gemm_kloop_big<true>(launder(tid_), acc, A + (size_t)m0 * lda, lda, Bt + (size_t)n0 * ldb, ldb, K, smem);
#pragma unroll
      for (int m = 0; m < 8; ++m)
#pragma unroll
        for (int n = 0; n < 4; ++n) epiS(m0 + wr * 128 + m * 16 + fr, n0 + wc * 64 + n * 16 + fq * 4, acc[m][n]);
    } else {
      gemm_kloop_big<false>(launder(tid_), acc, A + (size_t)m0 * lda, lda, Bt + (size_t)n0 * ldb, ldb, K, smem);
#pragma unroll
      for (int m = 0; m < 8; ++m)
#pragma unroll
        for (int n = 0; n < 4; ++n) epiN(m0 + wr * 128 + m * 16 + fq * 4, n0 + wc * 64 + n * 16 + fr, acc[m][n]);
    }
  }
}

DEVI void store4bf(u16* dst, f32x4 v) {
  u32x2 o;
  o.x = pack2(v[0], v[1]); o.y = pack2(v[2], v[3]);
  *(u32x2*)dst = o;
}

DEVI void phase_p_gemm(int tid_, const Params& p, char* smem) {
  u16* WB = (u16*)(p.ws + OFF_WB);
  const u16* H = (const u16*)(p.ws + OFF_H);
  u16* PR = (u16*)(p.ws + OFF_PR);
  u16* NQ = (u16*)(p.ws + OFF_NQ);
  u16* NK = (u16*)(p.ws + OFF_NK);
  u16* NVT = (u16*)(p.ws + OFF_NV);
  gemm_phase_big(tid_, H, 1024, WB + W_IN, 1024, 1024, NTOK, 3456, smem, 2944,
    [&](int r, int c0, f32x4 v) {
      if (c0 < 1920) store4bf(PR + (size_t)r * PRW + c0, v);
      else if (c0 < 2432) store4bf(NQ + (size_t)r * 512 + (c0 - 1920), v);
      else store4bf(NK + (size_t)r * 512 + (c0 - 2432), v);
    },
    [&](int r0, int c, f32x4 v) {
      const int cc = c - 2944;
      const int s = r0 >> 12, t = r0 & 4095;
      store4bf(NVT + ((size_t)(s * 512 + cc)) * 4096 + t, v);
    });
  const u16* MH = (const u16*)(p.ws + OFF_MEMH);
  u16* KVK = (u16*)(p.ws + OFF_KVK);
  u16* KVT = (u16*)(p.ws + OFF_KVT);
  gemm_phase(tid_, MH, 1024, WB + W_XKV, 1024, 1024, 3072, 2048, smem, 1024,
    [&](int r, int c0, f32x4 v) { store4bf(KVK + (size_t)r * 1024 + c0, v); },
    [&](int r0, int c, f32x4 v) {
      const int cc = c - 1024;
      const int s = r0 >> 8, m = r0 & 255;
      store4bf(KVT + ((size_t)(s * 1024 + cc)) * 256 + m, v);
    });
}

DEVI void phase_nat(int tid_, const Params& p, int l, char* smem, int bfirst, int bstride) {
  u16* NQ = (u16*)(p.ws + OFF_NQ);
  const u16* NK = (const u16*)(p.ws + OFF_NK);
  const u16* NVT = (const u16*)(p.ws + OFF_NV);
  const float* rpb = p.in[I_RPB] + (size_t)l * 8 * 15 * 31;
  const int lane = tid_ & 63, g = tid_ >> 6, fr = lane & 15, fq = lane >> 4;
  u16* Pw = (u16*)smem + g * (16 * 264);
  const int cb = (g == 0) ? 0 : (g == 1) ? 8 : (g == 2) ? 24 : 32;
  for (int t = bfirst; t < 12 * 64 * 8; t += bstride) {
    const int h = t & 7, ri = (t >> 3) & 63, s = t >> 9;
    int rs = ri - 4; rs = rs < 0 ? 0 : (rs > 56 ? 56 : rs);
    const size_t tokq = (size_t)s * 4096 + ri * 64 + g * 16;
    bf16x8 aq[2];
    aq[0] = *(const bf16x8*)(NQ + (tokq + fr) * 512 + h * 64 + fq * 8);
    aq[1] = *(const bf16x8*)(NQ + (tokq + fr) * 512 + h * 64 + 32 + fq * 8);
    f32x4 acc[16];
#pragma unroll
    for (int n = 0; n < 16; ++n) {
      acc[n] = (f32x4){0.f, 0.f, 0.f, 0.f};
      const int r = n >> 1, col = cb + (n & 1) * 16 + fr;
      const u16* kp = NK + ((size_t)s * 4096 + (rs + r) * 64 + col) * 512 + h * 64 + fq * 8;
      bf16x8 b0 = *(const bf16x8*)kp;
      bf16x8 b1 = *(const bf16x8*)(kp + 32);
      acc[n] = __builtin_amdgcn_mfma_f32_16x16x32_bf16(aq[0], b0, acc[n], 0, 0, 0);
      acc[n] = __builtin_amdgcn_mfma_f32_16x16x32_bf16(aq[1], b1, acc[n], 0, 0, 0);
    }
    float mx[4], sm[4];
#pragma unroll
    for (int j = 0; j < 4; ++j) {
      const int c = g * 16 + fq * 4 + j;
      int cs = c - 8; cs = cs < 0 ? 0 : (cs > 48 ? 48 : cs);
      float m = -1e30f;
#pragma unroll
      for (int n = 0; n < 16; ++n) {
        const int r = n >> 1, kc = cb + (n & 1) * 16 + fr;
        const bool valid = (kc >= cs) && (kc < cs + 16);
        float sc = -1e30f;
        if (valid) {
          const int di = rs + r - ri + 7, dj = kc - c + 15;
          sc = acc[n][j] * 0.125f + rpb[(h * 15 + di) * 31 + dj];
        }
        acc[n][j] = sc;
        m = fmaxf(m, sc);
      }
      mx[j] = red16_max(m);
    }
#pragma unroll
    for (int j = 0; j < 4; ++j) {
      float ssum = 0.f;
#pragma unroll
      for (int n = 0; n < 16; ++n) {
        float e = __expf(acc[n][j] - mx[j]);
        acc[n][j] = e;
        ssum += e;
      }
      sm[j] = 1.f / red16_sum(ssum);
    }
    __syncthreads();
#pragma unroll
    for (int n = 0; n < 16; ++n)
#pragma unroll
      for (int j = 0; j < 4; ++j) Pw[(fq * 4 + j) * 264 + n * 16 + fr] = f2bf(acc[n][j]);
    __syncthreads();
    f32x4 o[4];
#pragma unroll
    for (int n = 0; n < 4; ++n) o[n] = (f32x4){0.f, 0.f, 0.f, 0.f};
#pragma unroll
    for (int ks = 0; ks < 8; ++ks) {
      bf16x8 ap = *(const bf16x8*)(Pw + fr * 264 + ks * 32 + fq * 8);
#pragma unroll
      for (int n = 0; n < 4; ++n) {
        bf16x8 bv = *(const bf16x8*)(NVT + ((size_t)(s * 512 + h * 64 + n * 16 + fr)) * 4096 + (rs + ks) * 64 + cb + fq * 8);
        o[n] = __builtin_amdgcn_mfma_f32_16x16x32_bf16(ap, bv, o[n], 0, 0, 0);
      }
    }
#pragma unroll
    for (int n = 0; n < 4; ++n)
#pragma unroll
      for (int j = 0; j < 4; ++j)
        NQ[(tokq + fq * 4 + j) * 512 + h * 64 + n * 16 + fr] = f2bf(o[n][j] * sm[j]);
  }
}

constexpr int SC_OPS = 0;
constexpr int SC_VV = 40960;
constexpr int SC_WR = 49152;
constexpr int SC_AP = 57344;
constexpr int SC_TW = 65536;
constexpr int SC_AD = 70144;
constexpr int SC_NRM = 74752;
constexpr int SC_MU = 74880;
constexpr int SC_CST = 77440;

typedef __attribute__((ext_vector_type(2))) float f32x2;

template <int CTRL>
DEVI float dpp_mov(float x) {
  return __int_as_float(__builtin_amdgcn_update_dpp(0, __float_as_int(x), CTRL, 0xF, 0xF, true));
}
DEVI float red8(float x) {
  x += dpp_mov<0xB1>(x);
  x += dpp_mov<0x4E>(x);
  x += dpp_mov<0x141>(x);
  return x;
}
DEVI f32x2 lo2(f32x4 v) { return __builtin_shufflevector(v, v, 0, 1); }
DEVI f32x2 hi2(f32x4 v) { return __builtin_shufflevector(v, v, 2, 3); }

struct ScanOps {
  f32x2 a[4], w[4], b[4], k[4], r[4];
  float v0, v1;
};
DEVI void scan_load(ScanOps& o, const float* OPS, const float* VV, int nn, int jg, int i0) {
  const float* base = OPS + nn * 64 + jg * 8;
  f32x4 t0, t1;
  t0 = *(const f32x4*)(base); t1 = *(const f32x4*)(base + 4);
  o.a[0] = lo2(t0); o.a[1] = hi2(t0); o.a[2] = lo2(t1); o.a[3] = hi2(t1);
  t0 = *(const f32x4*)(base + 2048); t1 = *(const f32x4*)(base + 2048 + 4);
  o.w[0] = lo2(t0); o.w[1] = hi2(t0); o.w[2] = lo2(t1); o.w[3] = hi2(t1);
  t0 = *(const f32x4*)(base + 4096); t1 = *(const f32x4*)(base + 4096 + 4);
  o.b[0] = lo2(t0); o.b[1] = hi2(t0); o.b[2] = lo2(t1); o.b[3] = hi2(t1);
  t0 = *(const f32x4*)(base + 6144); t1 = *(const f32x4*)(base + 6144 + 4);
  o.k[0] = lo2(t0); o.k[1] = hi2(t0); o.k[2] = lo2(t1); o.k[3] = hi2(t1);
  t0 = *(const f32x4*)(base + 8192); t1 = *(const f32x4*)(base + 8192 + 4);
  o.r[0] = lo2(t0); o.r[1] = hi2(t0); o.r[2] = lo2(t1); o.r[3] = hi2(t1);
  o.v0 = VV[nn * 64 + i0];
  o.v1 = VV[nn * 64 + i0 + 8];
}
DEVI void scan_step(const ScanOps& o, f32x2 (&S0)[4], f32x2 (&S1)[4], float* YL, int nn, int jg, int i0) {
  f32x2 d0 = S0[0] * o.a[0], d0b = S0[2] * o.a[2];
  f32x2 d1 = S1[0] * o.a[0], d1b = S1[2] * o.a[2];
  d0 = S0[1] * o.a[1] + d0; d0b = S0[3] * o.a[3] + d0b;
  d1 = S1[1] * o.a[1] + d1; d1b = S1[3] * o.a[3] + d1b;
  d0 += d0b; d1 += d1b;
  const float sa0 = red8(d0.x + d0.y);
  const float sa1 = red8(d1.x + d1.y);
  f32x2 e0 = {0.f, 0.f}, e1 = {0.f, 0.f};
#pragma unroll
  for (int q = 0; q < 4; ++q) {
    const f32x2 u0 = sa0 * o.b[q] + o.v0 * o.k[q];
    const f32x2 u1 = sa1 * o.b[q] + o.v1 * o.k[q];
    S0[q] = S0[q] * o.w[q] + u0;
    S1[q] = S1[q] * o.w[q] + u1;
    e0 = S0[q] * o.r[q] + e0;
    e1 = S1[q] * o.r[q] + e1;
  }
  const float y0 = red8(e0.x + e0.y);
  const float y1 = red8(e1.x + e1.y);
  if (jg == 0) { YL[nn * 64 + i0] = y0; YL[nn * 64 + i0 + 8] = y1; }
}

DEVI void phase_scan(int tid_, const Params& p, int l, char* smem, int bstride) {
  const u16* PR = (const u16*)(p.ws + OFF_PR);
  _Float16* YF = (_Float16*)(p.ws + OFF_H);
  _Float16* YB = (_Float16*)(p.ws + OFF_H + (size_t)NTOK * 512 * 2);
  float* BON = (float*)(p.ws + OFF_BONUS);
  const u16* WB = (const u16*)(p.ws + OFF_WB);
  float* OPS = (float*)(smem + SC_OPS);
  u16* RAW = (u16*)(smem + SC_OPS);
  float* VV = (float*)(smem + SC_VV);
  float* WR = (float*)(smem + SC_WR);
  float* AP = (float*)(smem + SC_AP);
  float* YL = WR;
  u16* TWb = (u16*)(smem + SC_TW);
  u16* ADb = (u16*)(smem + SC_AD);
  float* NRM = (float*)(smem + SC_NRM);
  float* MU = (float*)(smem + SC_MU);
  float* CST = (float*)(smem + SC_CST);
  const float* mu_p = p.in[I_MU_PREV] + (size_t)l * 1920;
  const float* mu_n = p.in[I_MU_NEXT] + (size_t)l * 1920;
  const int tid = tid_, lane = tid & 63, w = tid >> 6, fr = lane & 15, fq = lane >> 4;
  const int pn = tid >> 3, j0 = (tid & 7) * 8;
  const int jg = lane & 7, i0 = w * 16 + (lane >> 3);
  const int hr = (tid >= 40) ? 1 : 0, hc = tid - hr * 40;
  for (int blk = blockIdx.x; blk < 192; blk += bstride) {
    const int s = blk >> 4, h = (blk >> 1) & 7, d = blk & 1;
    __syncthreads();
    for (int i = tid; i < 640; i += 256) {
      const int which = (i >= 320) ? 1 : 0, c = i - which * 320;
      const int g = c >> 6, e = c & 63;
      const int col = (g < 3) ? (g * 512 + h * 64 + e) : (1536 + (g - 3) * 128 + d * 64 + e);
      MU[i] = which ? mu_n[col] : mu_p[col];
    }
    for (int i = tid; i < 320; i += 256) {
      const int which = i >> 6, e = i & 63;
      float v;
      if (which == 0) v = p.in[I_W0][(size_t)(l * 2 + d) * 512 + h * 64 + e];
      else if (which == 1) v = p.in[I_A0][(size_t)(l * 2 + d) * 512 + h * 64 + e];
      else if (which == 2) v = p.in[I_K_K][(size_t)l * 512 + h * 64 + e];
      else if (which == 3) v = p.in[I_K_A][(size_t)l * 512 + h * 64 + e];
      else v = p.in[I_R_K][(size_t)(l * 8 + h) * 64 + e];
      CST[i] = v;
    }
    bf16x8 bw[2], ba[2];
#pragma unroll
    for (int ks = 0; ks < 2; ++ks) {
      bw[ks] = *(const bf16x8*)(WB + W_WUP + (size_t)(d * 512 + h * 64 + w * 16 + fr) * 64 + ks * 32 + fq * 8);
      ba[ks] = *(const bf16x8*)(WB + W_AUP + (size_t)(d * 512 + h * 64 + w * 16 + fr) * 64 + ks * 32 + fq * 8);
    }
    _Float16* Y = d ? YB : YF;
    f32x2 S0[4], S1[4];
#pragma unroll
    for (int q = 0; q < 4; ++q) { S0[q] = (f32x2){0.f, 0.f}; S1[q] = (f32x2){0.f, 0.f}; }
    u32x4 G[5], GH;
    {
      const int t = d ? (4095 - pn) : pn;
      const size_t tok = (size_t)s * 4096 + t;
#pragma unroll
      for (int g = 0; g < 5; ++g) {
        const int col = (g < 3) ? (g * 512 + h * 64) : (1536 + (g - 3) * 128 + d * 64);
        G[g] = *(const u32x4*)(PR + tok * PRW + col + j0);
      }
      GH = (u32x4){0u, 0u, 0u, 0u};
      if (tid < 80) {
        const int tlo = d ? (4095 - 31) : 0;
        const int th = hr ? (tlo + 32) : (tlo - 1);
        const int g = hc >> 3;
        const int col = (g < 3) ? (g * 512 + h * 64) : (1536 + (g - 3) * 128 + d * 64);
        if (th >= 0 && th <= 4095) GH = *(const u32x4*)(PR + ((size_t)s * 4096 + th) * PRW + col + (hc & 7) * 8);
      }
    }
#pragma unroll 1
    for (int ch = 0; ch < 128; ++ch) {
      const int n = ch * 32 + pn;
      const int t = d ? (4095 - n) : n;
      const size_t tok = (size_t)s * 4096 + t;
      const int tlo = d ? (4095 - (ch * 32 + 31)) : (ch * 32);
      const int rrow = t - tlo + 1;
#pragma unroll
      for (int g = 0; g < 5; ++g) *(u32x4*)(RAW + rrow * 320 + g * 64 + j0) = G[g];
      if (tid < 80) *(u32x4*)(RAW + (hr ? 33 : 0) * 320 + (hc >> 3) * 64 + (hc & 7) * 8) = GH;
      __syncthreads();
      if (ch + 1 < 128) {
        const int n2 = n + 32;
        const int t2 = d ? (4095 - n2) : n2;
        const size_t tok2 = (size_t)s * 4096 + t2;
#pragma unroll
        for (int g = 0; g < 5; ++g) {
          const int col = (g < 3) ? (g * 512 + h * 64) : (1536 + (g - 3) * 128 + d * 64);
          G[g] = *(const u32x4*)(PR + tok2 * PRW + col + j0);
        }
        GH = (u32x4){0u, 0u, 0u, 0u};
        if (tid < 80) {
          const int tlo2 = d ? (tlo - 32) : (tlo + 32);
          const int th = hr ? (tlo2 + 32) : (tlo2 - 1);
          const int g = hc >> 3;
          const int col = (g < 3) ? (g * 512 + h * 64) : (1536 + (g - 3) * 128 + d * 64);
          if (th >= 0 && th <= 4095) GH = *(const u32x4*)(PR + ((size_t)s * 4096 + th) * PRW + col + (hc & 7) * 8);
        }
      }
#pragma unroll
      for (int g = 0; g < 5; ++g) {
        float cur[8], prv[8], nxt[8];
        load8bf(RAW + rrow * 320 + g * 64 + j0, cur);
        load8bf(RAW + (rrow - 1) * 320 + g * 64 + j0, prv);
        load8bf(RAW + (rrow + 1) * 320 + g * 64 + j0, nxt);
        const f32x4 mp0 = *(const f32x4*)(MU + g * 64 + j0), mp1 = *(const f32x4*)(MU + g * 64 + j0 + 4);
        const f32x4 mn0 = *(const f32x4*)(MU + 320 + g * 64 + j0), mn1 = *(const f32x4*)(MU + 320 + g * 64 + j0 + 4);
        f32x4 x0, x1;
#pragma unroll
        for (int e = 0; e < 4; ++e) {
          x0[e] = cur[e] + mp0[e] * (prv[e] - cur[e]) + mn0[e] * (nxt[e] - cur[e]);
          x1[e] = cur[4 + e] + mp1[e] * (prv[4 + e] - cur[4 + e]) + mn1[e] * (nxt[4 + e] - cur[4 + e]);
        }
        if (g == 0) {
          *(f32x4*)(OPS + 4 * 2048 + pn * 64 + j0) = x0; *(f32x4*)(OPS + 4 * 2048 + pn * 64 + j0 + 4) = x1;
        } else if (g == 1) {
          *(f32x4*)(OPS + 3 * 2048 + pn * 64 + j0) = x0; *(f32x4*)(OPS + 3 * 2048 + pn * 64 + j0 + 4) = x1;
          const f32x4 kk0 = *(const f32x4*)(CST + 128 + j0), kk1 = *(const f32x4*)(CST + 128 + j0 + 4);
          float ss = 0.f;
#pragma unroll
          for (int e = 0; e < 4; ++e) { const float a_ = x0[e] * kk0[e], b_ = x1[e] * kk1[e]; ss += a_ * a_ + b_ * b_; }
          ss = red8(ss);
          if ((tid & 7) == 0) NRM[pn] = frcp(fmaxf(__builtin_amdgcn_sqrtf(ss), 1e-12f));
        } else if (g == 2) {
          *(f32x4*)(VV + pn * 64 + j0) = x0; *(f32x4*)(VV + pn * 64 + j0 + 4) = x1;
        } else if (g == 3) {
          u32x4 pk;
          pk.x = pack2(ftanh(x0[0]), ftanh(x0[1])); pk.y = pack2(ftanh(x0[2]), ftanh(x0[3]));
          pk.z = pack2(ftanh(x1[0]), ftanh(x1[1])); pk.w = pack2(ftanh(x1[2]), ftanh(x1[3]));
          *(u32x4*)(TWb + pn * 72 + j0) = pk;
        } else {
          u32x4 pk;
          pk.x = pack2(x0[0], x0[1]); pk.y = pack2(x0[2], x0[3]);
          pk.z = pack2(x1[0], x1[1]); pk.w = pack2(x1[2], x1[3]);
          *(u32x4*)(ADb + pn * 72 + j0) = pk;
        }
      }
      __syncthreads();
#pragma unroll
      for (int m = 0; m < 2; ++m) {
        f32x4 cw = {0.f, 0.f, 0.f, 0.f}, ca = {0.f, 0.f, 0.f, 0.f};
#pragma unroll
        for (int ks = 0; ks < 2; ++ks) {
          const bf16x8 aw = *(const bf16x8*)(TWb + (m * 16 + fr) * 72 + ks * 32 + fq * 8);
          const bf16x8 aa = *(const bf16x8*)(ADb + (m * 16 + fr) * 72 + ks * 32 + fq * 8);
          cw = __builtin_amdgcn_mfma_f32_16x16x32_bf16(aw, bw[ks], cw, 0, 0, 0);
          ca = __builtin_amdgcn_mfma_f32_16x16x32_bf16(aa, ba[ks], ca, 0, 0, 0);
        }
#pragma unroll
        for (int jj = 0; jj < 4; ++jj) {
          WR[(m * 16 + fq * 4 + jj) * 64 + w * 16 + fr] = cw[jj];
          AP[(m * 16 + fq * 4 + jj) * 64 + w * 16 + fr] = ca[jj];
        }
      }
      __syncthreads();
      {
        const float inv = NRM[pn];
        float bsum = 0.f;
#pragma unroll
        for (int hq = 0; hq < 2; ++hq) {
          const int jb = j0 + hq * 4;
          const f32x4 wr_ = *(const f32x4*)(WR + pn * 64 + jb) + *(const f32x4*)(CST + jb);
          const f32x4 ap_ = *(const f32x4*)(AP + pn * 64 + jb) + *(const f32x4*)(CST + 64 + jb);
          const f32x4 kr = *(const f32x4*)(OPS + 3 * 2048 + pn * 64 + jb);
          const f32x4 rr = *(const f32x4*)(OPS + 4 * 2048 + pn * 64 + jb);
          const f32x4 kkw = *(const f32x4*)(CST + 128 + jb), kaw = *(const f32x4*)(CST + 192 + jb), rkw = *(const f32x4*)(CST + 256 + jb);
          f32x4 o0, o1, o2, o3;
#pragma unroll
          for (int e = 0; e < 4; ++e) {
            const float sw = sigm(wr_[e]);
            const float dec = __expf(-0.6065306597126334f * sw);
            const float av = sigm(ap_[e]);
            const float kn = kr[e] * kkw[e] * inv;
            const float kd = kr[e] * (1.f + (av - 1.f) * kaw[e]);
            bsum += rr[e] * kd * rkw[e];
            o0[e] = -kn; o1[e] = dec; o2[e] = kn * av; o3[e] = kd;
          }
          *(f32x4*)(OPS + 0 * 2048 + pn * 64 + jb) = o0;
          *(f32x4*)(OPS + 1 * 2048 + pn * 64 + jb) = o1;
          *(f32x4*)(OPS + 2 * 2048 + pn * 64 + jb) = o2;
          *(f32x4*)(OPS + 3 * 2048 + pn * 64 + jb) = o3;
        }
        bsum = red8(bsum);
        if ((tid & 7) == 0) BON[(tok * 8 + h) * 2 + d] = bsum;
      }
      __syncthreads();
      {
        ScanOps oa, ob;
        scan_load(oa, OPS, VV, 0, jg, i0);
#pragma unroll 1
        for (int nn = 0; nn < 32; nn += 2) {
          scan_load(ob, OPS, VV, nn + 1, jg, i0);
          scan_step(oa, S0, S1, YL, nn, jg, i0);
          scan_load(oa, OPS, VV, (nn + 2) & 31, jg, i0);
          scan_step(ob, S0, S1, YL, nn + 1, jg, i0);
        }
      }
      __syncthreads();
      {
        h16x8 o;
#pragma unroll
        for (int e = 0; e < 8; ++e) o[e] = (_Float16)YL[pn * 64 + j0 + e];
        *(h16x8*)(Y + tok * 512 + h * 64 + j0) = o;
      }
    }
    __syncthreads();
  }
}

DEVI void phase_rwkv_post(int tid_, const Params& p, int l, char* smem) {
  u16* PR = (u16*)(p.ws + OFF_PR);
  const _Float16* YF = (const _Float16*)(p.ws + OFF_H);
  const _Float16* YB = (const _Float16*)(p.ws + OFF_H + (size_t)NTOK * 512 * 2);
  const float* BON = (const float*)(p.ws + OFF_BONUS);
  const u16* GUPT = (const u16*)(p.ws + OFF_WB) + W_GUP;
  const float* mu_p = p.in[I_MU_PREV] + (size_t)l * 1920;
  const float* mu_n = p.in[I_MU_NEXT] + (size_t)l * 1920;
  const float* gng = p.in[I_GN_G] + (size_t)l * 512;
  const float* gnb = p.in[I_GN_B] + (size_t)l * 512;
  u16* As = (u16*)smem;
  const int tid = tid_, lane = tid & 63, w = tid >> 6, fr = lane & 15, fq = lane >> 4;
  for (int tile = blockIdx.x; tile < NTOK / 64; tile += gridDim.x) {
    const size_t tok0 = (size_t)tile * 64;
    {
      const int row = tid >> 2, part = tid & 3;
      const size_t tok = tok0 + row;
      const int t = (int)(tok & 4095);
#pragma unroll
      for (int q = 0; q < 4; ++q) {
        const int col = 1792 + part * 32 + q * 8;
        float cur[8], prv[8], nxt[8];
        load8bf(PR + tok * PRW + col, cur);
        if (t > 0) load8bf(PR + (tok - 1) * PRW + col, prv);
        else {
#pragma unroll
          for (int e = 0; e < 8; ++e) prv[e] = 0.f;
        }
        if (t < 4095) load8bf(PR + (tok + 1) * PRW + col, nxt);
        else {
#pragma unroll
          for (int e = 0; e < 8; ++e) nxt[e] = 0.f;
        }
        float o[8];
#pragma unroll
        for (int e = 0; e < 8; ++e) {
          const float x = cur[e] + mu_p[col + e] * (prv[e] - cur[e]) + mu_n[col + e] * (nxt[e] - cur[e]);
          o[e] = sigm(x);
        }
        u32x4 pk;
        pk.x = pack2(o[0], o[1]); pk.y = pack2(o[2], o[3]); pk.z = pack2(o[4], o[5]); pk.w = pack2(o[6], o[7]);
        *(u32x4*)(As + row * 136 + part * 32 + q * 8) = pk;
      }
    }
    __syncthreads();
#pragma unroll 1
    for (int chh = 0; chh < 2; ++chh) {
      f32x4 acc[16];
#pragma unroll
      for (int n = 0; n < 16; ++n) acc[n] = (f32x4){0.f, 0.f, 0.f, 0.f};
#pragma unroll
      for (int ks = 0; ks < 4; ++ks) {
        bf16x8 af = *(const bf16x8*)(As + (w * 16 + fr) * 136 + ks * 32 + fq * 8);
#pragma unroll
        for (int n = 0; n < 16; ++n) {
          bf16x8 bg = *(const bf16x8*)(GUPT + (size_t)(chh * 256 + n * 16 + fr) * 128 + ks * 32 + fq * 8);
          acc[n] = __builtin_amdgcn_mfma_f32_16x16x32_bf16(af, bg, acc[n], 0, 0, 0);
        }
      }
#pragma unroll
      for (int hl = 0; hl < 4; ++hl) {
        const int head = chh * 4 + hl;
#pragma unroll
        for (int j = 0; j < 4; ++j) {
          const size_t tok = tok0 + w * 16 + fq * 4 + j;
          const int t = (int)(tok & 4095);
          float o[4], sum = 0.f;
#pragma unroll
          for (int q = 0; q < 4; ++q) {
            const int col = head * 64 + q * 16 + fr;
            o[q] = (float)YF[tok * 512 + col] + (float)YB[tok * 512 + col];
            sum += o[q];
          }
          const float mean = red16_sum(sum) * (1.f / 64.f);
          float vs = 0.f;
#pragma unroll
          for (int q = 0; q < 4; ++q) { const float dlt = o[q] - mean; vs += dlt * dlt; }
          const float var = red16_sum(vs) * (1.f / 64.f);
          const float rstd = rsqrtf(var + 64e-5f);
          const float bon = BON[(tok * 8 + head) * 2] + BON[(tok * 8 + head) * 2 + 1];
#pragma unroll
          for (int q = 0; q < 4; ++q) {
            const int col = head * 64 + q * 16 + fr;
            const int vc = 1024 + col;
            const float cur = bf2f(PR[tok * PRW + vc]);
            const float prv = (t > 0) ? bf2f(PR[(tok - 1) * PRW + vc]) : 0.f;
            const float nxt = (t < 4095) ? bf2f(PR[(tok + 1) * PRW + vc]) : 0.f;
            const float vsh = cur + mu_p[vc] * (prv - cur) + mu_n[vc] * (nxt - cur);
            const float yv = ((o[q] - mean) * rstd * gng[col] + gnb[col] + bon * vsh) * acc[hl * 4 + q][j];
            PR[tok * PRW + col] = f2bf(yv);
          }
        }
      }
    }
    __syncthreads();
  }
}

DEVI f32x4 ld4bf(const u16* p) {
  const u32x2 u = *(const u32x2*)p;
  f32x4 o;
  o[0] = __uint_as_float(u.x << 16); o[1] = __uint_as_float(u.x & 0xffff0000u);
  o[2] = __uint_as_float(u.y << 16); o[3] = __uint_as_float(u.y & 0xffff0000u);
  return o;
}

DEVI void phase_merge(int tid_, const Params& p, char* smem) {
  const u16* WB = (const u16*)(p.ws + OFF_WB);
  const u16* H = (const u16*)(p.ws + OFF_NK);
  u16* PR = (u16*)(p.ws + OFF_PR);
  const u16* NQ = (const u16*)(p.ws + OFF_NQ);
  u16* TMP = (u16*)(p.ws + OFF_H);
  const int lane = tid_ & 63, wid = tid_ >> 6;
  const int wr = wid >> 1, wc = wid & 1, fr = lane & 15, fq = lane >> 4;
  const int xcd = blockIdx.x & 7, jloc = blockIdx.x >> 3, nloc = gridDim.x >> 3;
  for (int lt = jloc; lt < 24 * 8; lt += nloc) {
    const int tm = (lt >> 3) * 8 + xcd, tn = lt & 7;
    const int m0 = tm << 8, n0 = tn << 7;
    f32x4 acc[8][4];
#define MERGE_ZERO() _Pragma("unroll") for (int m = 0; m < 8; ++m) _Pragma("unroll") for (int n = 0; n < 4; ++n) acc[m][n] = (f32x4){0.f, 0.f, 0.f, 0.f}
#define MERGE_RC() const int r = m0 + wr * 128 + m * 16 + fr, c0 = n0 + wc * 64 + n * 16 + fq * 4
    MERGE_ZERO();
    gemm_kloop_big<true>(launder(tid_), acc, H + (size_t)m0 * 1024, 1024, WB + W_IN + (size_t)(3456 + n0) * 1024, 1024, 1024, smem);
#pragma unroll
    for (int m = 0; m < 8; ++m)
#pragma unroll
      for (int n = 0; n < 4; ++n) {
        MERGE_RC();
        f32x4 o;
#pragma unroll
        for (int j = 0; j < 4; ++j) o[j] = sigm(acc[m][n][j]);
        store4bf(PR + (size_t)r * PRW + 512 + c0, o);
      }
    MERGE_ZERO();
    gemm_kloop_big<true>(launder(tid_), acc, PR + (size_t)m0 * PRW, PRW, WB + W_BRR + (size_t)n0 * 512, 512, 512, smem);
#pragma unroll
    for (int m = 0; m < 8; ++m)
#pragma unroll
      for (int n = 0; n < 4; ++n) {
        MERGE_RC();
        u16* dst = PR + (size_t)r * PRW + 512 + c0;
        store4bf(dst, ld4bf(dst) * acc[m][n]);
      }
    MERGE_ZERO();
    gemm_kloop_big<true>(launder(tid_), acc, H + (size_t)m0 * 1024, 1024, WB + W_IN + (size_t)(4480 + n0) * 1024, 1024, 1024, smem);
#pragma unroll
    for (int m = 0; m < 8; ++m)
#pragma unroll
      for (int n = 0; n < 4; ++n) {
        MERGE_RC();
        f32x4 o;
#pragma unroll
        for (int j = 0; j < 4; ++j) o[j] = sigm(acc[m][n][j]);
        store4bf(TMP + (size_t)r * 1024 + c0, o);
      }
    MERGE_ZERO();
    gemm_kloop_big<true>(launder(tid_), acc, NQ + (size_t)m0 * 512, 512, WB + W_BRN + (size_t)n0 * 512, 512, 512, smem);
#pragma unroll
    for (int m = 0; m < 8; ++m)
#pragma unroll
      for (int n = 0; n < 4; ++n) {
        MERGE_RC();
        u16* dst = PR + (size_t)r * PRW + 512 + c0;
        store4bf(dst, ld4bf(dst) + ld4bf(TMP + (size_t)r * 1024 + c0) * acc[m][n]);
      }
#undef MERGE_ZERO
#undef MERGE_RC
  }
}

DEVI float red4x_sum(float v) { v += __shfl_xor(v, 16); v += __shfl_xor(v, 32); return v; }
DEVI float red4x_max(float v) { v = fmaxf(v, __shfl_xor(v, 16)); v = fmaxf(v, __shfl_xor(v, 32)); return v; }

DEVI void phase_xattn(int tid_, const Params& p, char* smem) {
  const u16* Q = (const u16*)(p.ws + OFF_PR);
  u16* O = (u16*)(p.ws + OFF_NQ);
  const u16* KVK = (const u16*)(p.ws + OFF_KVK);
  const u16* KVT = (const u16*)(p.ws + OFF_KVT);
  const int lane = tid_ & 63, w = tid_ >> 6, fr = lane & 15, fq = lane >> 4;
  u16* Pw = (u16*)smem + w * (32 * 264);
  for (int t = blockIdx.x; t < (NTOK / 128) * 4; t += gridDim.x) {
    const int hh = t & 3;
    const size_t tok0 = (size_t)(t >> 2) * 128 + w * 32;
    const int s = (int)(tok0 >> 12);
    f32x4 acc[2][16];
#pragma unroll
    for (int mt = 0; mt < 2; ++mt)
#pragma unroll
      for (int n = 0; n < 16; ++n) acc[mt][n] = (f32x4){0.f, 0.f, 0.f, 0.f};
#pragma unroll 1
    for (int ks = 0; ks < 8; ++ks) {
      const bf16x8 aq0 = *(const bf16x8*)(Q + (tok0 + fr) * 1024 + hh * 256 + ks * 32 + fq * 8);
      const bf16x8 aq1 = *(const bf16x8*)(Q + (tok0 + 16 + fr) * 1024 + hh * 256 + ks * 32 + fq * 8);
#pragma unroll
      for (int n = 0; n < 16; ++n) {
        const bf16x8 bk = *(const bf16x8*)(KVK + (size_t)(s * 256 + n * 16 + fr) * 1024 + hh * 256 + ks * 32 + fq * 8);
        acc[0][n] = __builtin_amdgcn_mfma_f32_16x16x32_bf16(bk, aq0, acc[0][n], 0, 0, 0);
        acc[1][n] = __builtin_amdgcn_mfma_f32_16x16x32_bf16(bk, aq1, acc[1][n], 0, 0, 0);
      }
    }
    float sm[2];
    __syncthreads();
#pragma unroll
    for (int mt = 0; mt < 2; ++mt) {
      float m = -1e30f;
#pragma unroll
      for (int n = 0; n < 16; ++n)
#pragma unroll
        for (int j = 0; j < 4; ++j) m = fmaxf(m, acc[mt][n][j]);
      m = red4x_max(m) * 0.0625f;
      float ssum = 0.f;
#pragma unroll
      for (int n = 0; n < 16; ++n) {
        f32x4 e;
#pragma unroll
        for (int j = 0; j < 4; ++j) { e[j] = __expf(acc[mt][n][j] * 0.0625f - m); ssum += e[j]; }
        store4bf(Pw + (mt * 16 + fr) * 264 + n * 16 + fq * 4, e);
      }
      sm[mt] = 1.f / red4x_sum(ssum);
    }
    __syncthreads();
#pragma unroll
    for (int mt = 0; mt < 2; ++mt)
#pragma unroll
      for (int n = 0; n < 16; ++n) acc[mt][n] = (f32x4){0.f, 0.f, 0.f, 0.f};
#pragma unroll 1
    for (int ks = 0; ks < 8; ++ks) {
      const bf16x8 ap0 = *(const bf16x8*)(Pw + fr * 264 + ks * 32 + fq * 8);
      const bf16x8 ap1 = *(const bf16x8*)(Pw + (16 + fr) * 264 + ks * 32 + fq * 8);
#pragma unroll
      for (int n = 0; n < 16; ++n) {
        const bf16x8 bv = *(const bf16x8*)(KVT + (size_t)(s * 1024 + hh * 256 + n * 16 + fr) * 256 + ks * 32 + fq * 8);
        acc[0][n] = __builtin_amdgcn_mfma_f32_16x16x32_bf16(bv, ap0, acc[0][n], 0, 0, 0);
        acc[1][n] = __builtin_amdgcn_mfma_f32_16x16x32_bf16(bv, ap1, acc[1][n], 0, 0, 0);
      }
    }
#pragma unroll
    for (int mt = 0; mt < 2; ++mt)
#pragma unroll
      for (int n = 0; n < 16; ++n)
        store4bf(O + (tok0 + mt * 16 + fr) * 1024 + hh * 256 + n * 16 + fq * 4, acc[mt][n] * sm[mt]);
  }
}

DEVI void run_phase(int tid_, const Params& p, int ph, char* smem) {
  if (ph == 2 * NPH_LAYER) { phase_final_norm(tid_, p); return; }
  const int l = ph / NPH_LAYER, q = ph % NPH_LAYER;
  u16* WB = (u16*)(p.ws + OFF_WB);
  u16* H = (u16*)(p.ws + OFF_H);
  u16* PR = (u16*)(p.ws + OFF_PR);
  u16* NQ = (u16*)(p.ws + OFF_NQ);
  float* X = p.X;
  auto epi_res = [&](int r, int c0, f32x4 v) {
    f32x4* px = (f32x4*)(X + (size_t)r * 1024 + c0);
    *px = *px + v;
  };
  constexpr int NONS = 1 << 30;
  switch (q) {
    case 0:
      phase_conv(tid_, p, l, smem);
      phase_norm(tid_, p, p.in[I_NORM_MIX] + (size_t)l * 1024, l == 0);
      phase_norm_mem(tid_, p, p.in[I_NORM_MEM] + (size_t)l * 1024);
      break;
    case 1: phase_p_gemm(tid_, p, smem); break;
    case 2:
      if (gridDim.x >= 256) {
        if (blockIdx.x < 192) phase_scan(tid_, p, l, smem, gridDim.x);
        else phase_nat(tid_, p, l, smem, blockIdx.x - 192, gridDim.x - 192);
      } else {
        phase_scan(tid_, p, l, smem, gridDim.x);
        __syncthreads();
        phase_nat(tid_, p, l, smem, blockIdx.x, gridDim.x);
      }
      break;
    case 3:
      phase_rwkv_post(tid_, p, l, smem);
      phase_norm(tid_, p, p.in[I_NORM_MIX] + (size_t)l * 1024, false, OFF_NK);
      break;
    case 4: phase_merge(tid_, p, smem); break;
    case 5: gemm_phase_big(tid_, PR + 512, PRW, WB + W_OUT, 1024, 1024, NTOK, 1024, smem, NONS, epi_res, NoEpi()); break;
    case 6: phase_norm(tid_, p, p.in[I_NORM_X] + (size_t)l * 1024, false); break;
    case 7:
      gemm_phase_big(tid_, H, 1024, WB + W_XQ, 1024, 1024, NTOK, 1024, smem, NONS,
                 [&](int r, int c0, f32x4 v) { store4bf(PR + (size_t)r * 1024 + c0, v); }, NoEpi());
      break;
    case 8: phase_xattn(tid_, p, smem); break;
    case 9: gemm_phase_big(tid_, NQ, 1024, WB + W_XO, 1024, 1024, NTOK, 1024, smem, NONS, epi_res, NoEpi()); break;
    case 10: phase_norm(tid_, p, p.in[I_NORM_FF] + (size_t)l * 1024, false); break;
    case 11:
    case 13: {
      const int hf = (q == 13);
      gemm_phase_big(tid_, H, 1024, WB + W_FF1 + (size_t)hf * 2048 * 1024, 1024, 1024, NTOK, 2048, smem, NONS,
                 [&](int r, int c0, f32x4 v) {
                   f32x4 o;
#pragma unroll
                   for (int j = 0; j < 4; ++j) { const float x = fmaxf(v[j], 0.f); o[j] = x * x; }
                   store4bf(PR + (size_t)r * 2048 + c0, o);
                 }, NoEpi());
    } break;
    case 12:
    case 14: {
      const int hf = (q == 14);
      gemm_phase_big(tid_, PR, 2048, WB + W_FF2 + (size_t)hf * 2048, 4096, 2048, NTOK, 1024, smem, NONS, epi_res, NoEpi());
    } break;
  }
}

#define XB_TMO      128
#define XB_XCNT(j)  (256  + 64 * (j))
#define XB_XSUB(j)  (1280 + 64 * (j))
#define XB_XGEN(j)  (2304 + 64 * (j))
#define XB_TOP      3328
#define XB_TOPGEN   3392
#define XCD_BAR_WORDS 3456
#define XB_SPIN_CAP (1u << 20)
#define LAS __attribute__((address_space(3)))

DEVI unsigned xb_ld(unsigned* p) { return __hip_atomic_load(p, __ATOMIC_RELAXED, __HIP_MEMORY_SCOPE_AGENT); }
DEVI unsigned xb_add(unsigned* p, unsigned v) { return __hip_atomic_fetch_add(p, v, __ATOMIC_RELAXED, __HIP_MEMORY_SCOPE_AGENT); }
DEVI unsigned xb_xcc_id() { return (unsigned)__builtin_amdgcn_s_getreg((3 << 11) | 20) & 0xFu; }
#define XB_SPIN(cond, bar) do { unsigned _sp = 0; while (cond) { __builtin_amdgcn_s_sleep(1); \
    if ((++_sp & 255u) == 0u) { if (xb_ld(&(bar)[XB_TMO])) break; if (_sp > XB_SPIN_CAP) { atomicAdd(&(bar)[XB_TMO], 1u); break; } } } } while (0)

struct XcdBarrier {
  unsigned* bar; unsigned x;
  volatile LAS unsigned* st;
};
DEVI XcdBarrier xcd_barrier_post(unsigned* bar, volatile LAS unsigned* st) {
  XcdBarrier b; b.bar = bar; b.x = xb_xcc_id(); b.st = st;
  if (threadIdx.x == 0) (void)xb_add(&bar[XB_XCNT(b.x)], 1u);
  return b;
}
DEVI void xcd_barrier_complete(unsigned* bar, unsigned x, unsigned& nloc, unsigned& nx) {
  const unsigned G = gridDim.x * gridDim.y * gridDim.z;
  unsigned sum, cnt, mine, sp = 0u;
  for (;;) {
    sum = 0u; cnt = 0u; mine = 0u;
#pragma unroll
    for (unsigned j = 0; j < 16; ++j) { const unsigned c = xb_ld(&bar[XB_XCNT(j)]); sum += c; cnt += (c > 0u) ? 1u : 0u; mine = (j == x) ? c : mine; }
    if (sum == G) break;
    __builtin_amdgcn_s_sleep(1);
    if ((++sp & 255u) == 0u) { if (xb_ld(&bar[XB_TMO])) break; if (sp > XB_SPIN_CAP) { atomicAdd(&bar[XB_TMO], 1u); break; } }
  }
  nloc = mine > 0u ? mine : 1u; nx = cnt > 0u ? cnt : 1u;
}
DEVI void xcd_barrier(const XcdBarrier& b) {
  asm volatile("s_waitcnt vmcnt(0)" ::: "memory");
  __syncthreads();
  if (threadIdx.x == 0) {
    unsigned* bar = b.bar;
    __builtin_amdgcn_s_waitcnt(0);
    unsigned nloc = b.st[0], nx = b.st[1];
    if (nloc == 0u) { xcd_barrier_complete(bar, b.x, nloc, nx); b.st[0] = nloc; b.st[1] = nx; }
    const unsigned old = xb_add(&bar[XB_XSUB(b.x)], 1u);
    const unsigned gen = old / nloc;
    if (old + 1u == (gen + 1u) * nloc) {
      __builtin_amdgcn_fence(__ATOMIC_RELEASE, "agent");
      asm volatile("s_waitcnt vmcnt(0)" ::: "memory");
      const unsigned og = xb_add(&bar[XB_TOP], 1u);
      const unsigned tg = og / nx;
      if (og + 1u == (tg + 1u) * nx) xb_add(&bar[XB_TOPGEN], 1u);
      else XB_SPIN(xb_ld(&bar[XB_TOPGEN]) == tg, bar);
      __builtin_amdgcn_fence(__ATOMIC_ACQUIRE, "agent");
      xb_add(&bar[XB_XGEN(b.x)], 1u);
      asm volatile("s_waitcnt vmcnt(0)" ::: "memory");
    } else {
      XB_SPIN(xb_ld(&bar[XB_XGEN(b.x)]) == gen, bar);
      __builtin_amdgcn_fence(__ATOMIC_ACQUIRE, "agent");
      asm volatile("s_waitcnt vmcnt(0)" ::: "memory");
    }
  }
  __syncthreads();
}

__global__ void __launch_bounds__(256, 2) mega_kernel(Params p, int ph0, int ph1) {
  __shared__ __attribute__((aligned(16))) char smem[SMEM_BYTES];
  __shared__ __attribute__((aligned(16))) unsigned xb_words[4];
  if (threadIdx.x == 0) { xb_words[0] = 0u; xb_words[1] = 0u; xb_words[2] = 0u; xb_words[3] = 0u; }
  __syncthreads();
  XcdBarrier xb = xcd_barrier_post((unsigned*)(p.ws + OFF_BAR), (volatile LAS unsigned*)xb_words);
  for (int ph = ph0; ph < ph1; ++ph) {
    if (ph == ph0 + 1) cg::this_grid().sync();
    else if (ph > ph0) xcd_barrier(xb);
    int tid_ = threadIdx.x;
    asm volatile("" : "+v"(tid_));
    run_phase(tid_, p, ph, smem);
  }
}

extern "C" void kernel_launch(void* const* d_in, const int* in_sizes, int n_in, void* d_out, int out_size, void* d_ws,
                              size_t ws_size, hipStream_t stream) {
  if (ws_size < WS_NEED || n_in < 31) return;
  Params p{};
  for (int i = 0; i < 31; ++i) p.in[i] = (const float*)d_in[i];
  p.X = (float*)d_out;
  p.ws = (char*)d_ws;
  static int grid_blocks = 0;
  if (!grid_blocks) {
    int dev = 0, cus = 0, per_cu = 0;
    hipGetDevice(&dev);
    hipDeviceGetAttribute(&cus, hipDeviceAttributeMultiprocessorCount, dev);
    hipOccupancyMaxActiveBlocksPerMultiprocessor(&per_cu, mega_kernel, 256, 0);
    if (per_cu > 2) per_cu = 2;
    if (per_cu < 1) per_cu = 1;
    grid_blocks = cus * per_cu;
  }
  hipMemsetAsync((char*)d_ws + OFF_BAR, 0, 16384, stream);
  int ph0 = 0, ph1 = NPHASES;
  void* args[] = {&p, &ph0, &ph1};
  hipLaunchCooperativeKernel((void*)mega_kernel, dim3(grid_blocks), dim3(256), args, 0, stream);
}
```

```cpp
#include <hip/hip_runtime.h>
#include <hip/hip_cooperative_groups.h>
#include <stdint.h>
namespace cg = cooperative_groups;

typedef unsigned short u16;
typedef __attribute__((ext_vector_type(8))) short bf16x8;
typedef __attribute__((ext_vector_type(4))) float f32x4;
typedef __attribute__((ext_vector_type(8))) _Float16 h16x8;
typedef __attribute__((ext_vector_type(4))) unsigned int u32x4;
typedef __attribute__((ext_vector_type(2))) unsigned int u32x2;

#define DEVI __device__ __forceinline__

constexpr int NTOK = 49152;
constexpr int SEQ_T = 4096;
constexpr int PRW = 1920;
constexpr int NPH_LAYER = 15;
constexpr int NPHASES = 2 * NPH_LAYER + 1;
constexpr int SMEM_BYTES = 78720;

constexpr size_t OFF_WB = 0;
constexpr size_t WB_BYTES = 20512768ull * 2;
constexpr size_t OFF_H = OFF_WB + WB_BYTES;
constexpr size_t OFF_PR = OFF_H + (size_t)NTOK * 1024 * 2;
constexpr size_t OFF_NQ = OFF_PR + (size_t)NTOK * PRW * 2;
constexpr size_t OFF_NK = OFF_NQ + (size_t)NTOK * 512 * 2;
constexpr size_t OFF_NV = OFF_NK + (size_t)NTOK * 512 * 2;
constexpr size_t OFF_KVK = OFF_NV + (size_t)NTOK * 512 * 2;
constexpr size_t OFF_KVT = OFF_KVK + (size_t)3072 * 1024 * 2;
constexpr size_t OFF_MEMH = OFF_KVT + (size_t)3072 * 1024 * 2;
constexpr size_t OFF_BONUS = OFF_MEMH + (size_t)3072 * 1024 * 2;
constexpr size_t OFF_BAR = OFF_BONUS + (size_t)NTOK * 16 * 4;
constexpr size_t WS_NEED = OFF_BAR + 16384;

constexpr size_t W_IN = 0;
constexpr size_t W_BRR = W_IN + (size_t)5504 * 1024;
constexpr size_t W_BRN = W_BRR + (size_t)1024 * 512;
constexpr size_t W_OUT = W_BRN + (size_t)1024 * 512;
constexpr size_t W_XQ = W_OUT + (size_t)1024 * 1024;
constexpr size_t W_XKV = W_XQ + (size_t)1024 * 1024;
constexpr size_t W_XO = W_XKV + (size_t)2048 * 1024;
constexpr size_t W_FF1 = W_XO + (size_t)1024 * 1024;
constexpr size_t W_FF2 = W_FF1 + (size_t)4096 * 1024;
constexpr size_t W_GUP = W_FF2 + (size_t)4096 * 1024;
constexpr size_t W_WUP = W_GUP + (size_t)512 * 128;
constexpr size_t W_AUP = W_WUP + (size_t)2 * 512 * 64;

enum { I_XP = 0, I_XS, I_MP, I_MS, I_NORM_MIX, I_W_IN, I_MU_PREV, I_MU_NEXT, I_W0, I_W_UP, I_A0, I_A_UP,
       I_G_UP, I_K_K, I_K_A, I_R_K, I_GN_G, I_GN_B, I_RPB, I_W_BR_RWKV, I_W_BR_NAT, I_W_OUT, I_NORM_X,
       I_NORM_MEM, I_W_XQ, I_W_XKV, I_W_XO, I_NORM_FF, I_W_FF1, I_W_FF2, I_NORM_FINAL };

struct Params {
  const float* in[31];
  float* X;
  char* ws;
};

DEVI u16 f2bf(float f) {
  uint32_t u = __float_as_uint(f);
  u += 0x7FFFu + ((u >> 16) & 1u);
  return (u16)(u >> 16);
}
DEVI float bf2f(u16 h) { return __uint_as_float(((uint32_t)h) << 16); }
DEVI uint32_t pack2(float a, float b) { return (uint32_t)f2bf(a) | ((uint32_t)f2bf(b) << 16); }
DEVI float frcp(float x) { return __builtin_amdgcn_rcpf(x); }
DEVI float sigm(float x) { return frcp(1.f + __expf(-x)); }
DEVI float ftanh(float x) { return 1.f - 2.f * frcp(__expf(2.f * x) + 1.f); }
DEVI void unpack8(u32x4 u, float* o) {
  o[0] = __uint_as_float(u.x << 16); o[1] = __uint_as_float(u.x & 0xffff0000u);
  o[2] = __uint_as_float(u.y << 16); o[3] = __uint_as_float(u.y & 0xffff0000u);
  o[4] = __uint_as_float(u.z << 16); o[5] = __uint_as_float(u.z & 0xffff0000u);
  o[6] = __uint_as_float(u.w << 16); o[7] = __uint_as_float(u.w & 0xffff0000u);
}
DEVI void load8bf(const u16* p, float* o) { unpack8(*(const u32x4*)p, o); }
DEVI float wave_sum(float v) {
  v += __shfl_xor(v, 32); v += __shfl_xor(v, 16); v += __shfl_xor(v, 8);
  v += __shfl_xor(v, 4); v += __shfl_xor(v, 2); v += __shfl_xor(v, 1);
  return v;
}
DEVI float red16_sum(float v) {
  v += __shfl_xor(v, 1); v += __shfl_xor(v, 2); v += __shfl_xor(v, 4); v += __shfl_xor(v, 8);
  return v;
}
DEVI float red16_max(float v) {
  v = fmaxf(v, __shfl_xor(v, 1)); v = fmaxf(v, __shfl_xor(v, 2));
  v = fmaxf(v, __shfl_xor(v, 4)); v = fmaxf(v, __shfl_xor(v, 8));
  return v;
}

DEVI void conv_tile(int tid_, const float* src, int K, int N, u16* dst, int tile, char* smem) {
  float (*s)[65] = (float (*)[65])smem;
  const int nN = N >> 6;
  const int tk = tile / nN, tn = tile - tk * nN;
  const int tx = tid_ & 63, ty = tid_ >> 6;
  for (int r = ty; r < 64; r += 4) s[r][tx] = src[(size_t)(tk * 64 + r) * N + tn * 64 + tx];
  __syncthreads();
  for (int r = ty; r < 64; r += 4) dst[(size_t)(tn * 64 + r) * K + tk * 64 + tx] = f2bf(s[tx][r]);
  __syncthreads();
}

DEVI void phase_conv(int tid_, int vb_, int vg_, const Params& p, int l, char* smem) {
  u16* WB = (u16*)(p.ws + OFF_WB);
  const int c0 = 1376, c1 = c0 + 128, c2 = c1 + 128, c3 = c2 + 256, c4 = c3 + 256, c5 = c4 + 512,
            c6 = c5 + 256, c7 = c6 + 1024, c8 = c7 + 1024, c9 = c8 + 16, c10 = c9 + 16, c11 = c10 + 16;
  for (int t = vb_; t < c11; t += vg_) {
    if (t < c0) conv_tile(tid_, p.in[I_W_IN] + (size_t)l * 1024 * 5504, 1024, 5504, WB + W_IN, t, smem);
    else if (t < c1) conv_tile(tid_, p.in[I_W_BR_RWKV] + (size_t)l * 512 * 1024, 512, 1024, WB + W_BRR, t - c0, smem);
    else if (t < c2) conv_tile(tid_, p.in[I_W_BR_NAT] + (size_t)l * 512 * 1024, 512, 1024, WB + W_BRN, t - c1, smem);
    else if (t < c3) conv_tile(tid_, p.in[I_W_OUT] + (size_t)l * 1024 * 1024, 1024, 1024, WB + W_OUT, t - c2, smem);
    else if (t < c4) conv_tile(tid_, p.in[I_W_XQ] + (size_t)l * 1024 * 1024, 1024, 1024, WB + W_XQ, t - c3, smem);
    else if (t < c5) conv_tile(tid_, p.in[I_W_XKV] + (size_t)l * 1024 * 2048, 1024, 2048, WB + W_XKV, t - c4, smem);
    else if (t < c6) conv_tile(tid_, p.in[I_W_XO] + (size_t)l * 1024 * 1024, 1024, 1024, WB + W_XO, t - c5, smem);
    else if (t < c7) conv_tile(tid_, p.in[I_W_FF1] + (size_t)l * 1024 * 4096, 1024, 4096, WB + W_FF1, t - c6, smem);
    else if (t < c8) conv_tile(tid_, p.in[I_W_FF2] + (size_t)l * 4096 * 1024, 4096, 1024, WB + W_FF2, t - c7, smem);
    else if (t < c9) conv_tile(tid_, p.in[I_G_UP] + (size_t)l * 128 * 512, 128, 512, WB + W_GUP, t - c8, smem);
    else if (t < c10) { const int dd = (t - c9) >> 3; conv_tile(tid_, p.in[I_W_UP] + (size_t)(l * 2 + dd) * 64 * 512, 64, 512, WB + W_WUP + (size_t)dd * 512 * 64, (t - c9) & 7, smem); }
    else { const int dd = (t - c10) >> 3; conv_tile(tid_, p.in[I_A_UP] + (size_t)(l * 2 + dd) * 64 * 512, 64, 512, WB + W_AUP + (size_t)dd * 512 * 64, (t - c10) & 7, smem); }
  }
}

DEVI void norm_row_bf16(int tid_, const float* src, const float* g, u16* dst, float* xcopy) {
  const int lane = tid_ & 63;
  float4 v[4];
  float ss = 0.f;
#pragma unroll
  for (int i = 0; i < 4; ++i) {
    v[i] = ((const float4*)src)[lane + i * 64];
    ss += v[i].x * v[i].x + v[i].y * v[i].y + v[i].z * v[i].z + v[i].w * v[i].w;
  }
  ss = wave_sum(ss);
  const float rs = rsqrtf(ss * (1.f / 1024.f) + 1e-6f);
#pragma unroll
  for (int i = 0; i < 4; ++i) {
    float4 gg = ((const float4*)g)[lane + i * 64];
    u32x2 o;
    o.x = pack2(v[i].x * rs * gg.x, v[i].y * rs * gg.y);
    o.y = pack2(v[i].z * rs * gg.z, v[i].w * rs * gg.w);
    ((u32x2*)dst)[lane + i * 64] = o;
    if (xcopy) ((float4*)xcopy)[lane + i * 64] = v[i];
  }
}

DEVI void phase_norm(int tid_, int vb_, int vg_, const Params& p, const float* g, bool from_input, size_t hoff = OFF_H) {
  u16* H = (u16*)(p.ws + hoff);
  const int wid = tid_ >> 6;
  for (int r = vb_ * 4 + wid; r < NTOK; r += vg_ * 4) {
    const float* src;
    if (from_input) src = (r < 32768) ? p.in[I_XP] + (size_t)r * 1024 : p.in[I_XS] + (size_t)(r - 32768) * 1024;
    else src = p.X + (size_t)r * 1024;
    norm_row_bf16(tid_, src, g, H + (size_t)r * 1024, from_input ? p.X + (size_t)r * 1024 : nullptr);
  }
}
DEVI void phase_norm_mem(int tid_, int vb_, int vg_, const Params& p, const float* g) {
  u16* MH = (u16*)(p.ws + OFF_MEMH);
  const int wid = tid_ >> 6;
  for (int r = vb_ * 4 + wid; r < 3072; r += vg_ * 4) {
    const float* src = (r < 2048) ? p.in[I_MP] + (size_t)r * 1024 : p.in[I_MS] + (size_t)(r - 2048) * 1024;
    norm_row_bf16(tid_, src, g, MH + (size_t)r * 1024, nullptr);
  }
}
DEVI void phase_final_norm(int tid_, int vb_, int vg_, const Params& p) {
  const float* g = p.in[I_NORM_FINAL];
  const int wid = tid_ >> 6, lane = tid_ & 63;
  for (int r = vb_ * 4 + wid; r < NTOK; r += vg_ * 4) {
    float* row = p.X + (size_t)r * 1024;
    float4 v[4];
    float ss = 0.f;
#pragma unroll
    for (int i = 0; i < 4; ++i) {
      v[i] = ((const float4*)row)[lane + i * 64];
      ss += v[i].x * v[i].x + v[i].y * v[i].y + v[i].z * v[i].z + v[i].w * v[i].w;
    }
    ss = wave_sum(ss);
    const float rs = rsqrtf(ss * (1.f / 1024.f) + 1e-6f);
#pragma unroll
    for (int i = 0; i < 4; ++i) {
      float4 gg = ((const float4*)g)[lane + i * 64];
      float4 o;
      o.x = v[i].x * rs * gg.x; o.y = v[i].y * rs * gg.y; o.z = v[i].z * rs * gg.z; o.w = v[i].w * rs * gg.w;
      ((float4*)row)[lane + i * 64] = o;
    }
  }
}

template <int OFF>
DEVI bf16x8 lds_rd128(uint32_t addr) {
  bf16x8 r;
  asm volatile("ds_read_b128 %0, %1 offset:%2" : "=v"(r) : "v"(addr), "n"(OFF));
  return r;
}

template <int NW, bool SWAP>
DEVI void gemm_kloop(int tid_, f32x4 (&acc)[4][NW], const u16* __restrict__ A, int lda, const u16* __restrict__ Bt, int ldb,
                     int K, char* smem) {
  constexpr int STG = 8192 + NW * 2048;
  constexpr int NB = NW / 2;
  const int tid = tid_, lane = tid & 63, wid = tid >> 6;
  const int wr = wid >> 1, wc = wid & 1, fr = lane & 15, fq = lane >> 4;
  const int lrow = lane >> 2, lphys = lane & 3, lhi = lane >> 4;
  const int gsw = (4 - lhi) & 3;
  const u16* ga[2];
  const u16* gb[NB];
#pragma unroll
  for (int q = 0; q < 2; ++q) ga[q] = A + (size_t)((wid * 2 + q) * 16 + lrow) * lda + (lphys ^ gsw) * 8;
#pragma unroll
  for (int q = 0; q < NB; ++q) gb[q] = Bt + (size_t)((wid * NB + q) * 16 + lrow) * ldb + (lphys ^ gsw) * 8;
  const int rsw = (4 - ((fr >> 2) & 3)) & 3;
  const int ch = (fq ^ rsw) * 16;
  const int nk = K >> 5;
  const uint32_t lds_base = (uint32_t)(size_t)(__attribute__((address_space(3))) char*)smem;
  const uint32_t aoff = (uint32_t)((wr * 64 + fr) * 64 + ch);
  const uint32_t boff = (uint32_t)(8192 + (wc * 16 * NW + fr) * 64 + ch);
  asm volatile("s_waitcnt vmcnt(0)" ::: "memory");
  __syncthreads();
#define GEMM_ISSUE(kt_)                                                                                              \
  do {                                                                                                               \
    char* nb_ = smem + ((kt_) & 3) * STG;                                                                            \
    _Pragma("unroll") for (int q = 0; q < 2; ++q) __builtin_amdgcn_global_load_lds(                                  \
        (const unsigned*)(ga[q] + (kt_) * 32),                                                                       \
        (__attribute__((address_space(3))) unsigned*)(nb_ + (wid * 2 + q) * 1024 + lane * 16), 16, 0, 0);            \
    _Pragma("unroll") for (int q = 0; q < NB; ++q) __builtin_amdgcn_global_load_lds(                                 \
        (const unsigned*)(gb[q] + (kt_) * 32),                                                                       \
        (__attribute__((address_space(3))) unsigned*)(nb_ + 8192 + (wid * NB + q) * 1024 + lane * 16), 16, 0, 0);    \
  } while (0)
  GEMM_ISSUE(0);
  if (nk > 1) GEMM_ISSUE(1);
  if (nk > 2) GEMM_ISSUE(2);
  for (int kt = 0; kt < nk; ++kt) {
    if (kt + 2 < nk) {
      if (NW == 4) asm volatile("s_waitcnt vmcnt(8)" ::: "memory");
      else asm volatile("s_waitcnt vmcnt(6)" ::: "memory");
    } else if (kt + 1 < nk) {
      if (NW == 4) asm volatile("s_waitcnt vmcnt(4)" ::: "memory");
      else asm volatile("s_waitcnt vmcnt(3)" ::: "memory");
    } else {
      asm volatile("s_waitcnt vmcnt(0)" ::: "memory");
    }
    __builtin_amdgcn_s_barrier();
    asm volatile("" ::: "memory");
    if (kt + 3 < nk) GEMM_ISSUE(kt + 3);
    const uint32_t sb = lds_base + (kt & 3) * STG;
    bf16x8 af[4], bfr[4];
    af[0] = lds_rd128<0>(sb + aoff); af[1] = lds_rd128<1024>(sb + aoff);
    af[2] = lds_rd128<2048>(sb + aoff); af[3] = lds_rd128<3072>(sb + aoff);
    bfr[0] = lds_rd128<0>(sb + boff); bfr[1] = lds_rd128<1024>(sb + boff);
    if (NW == 4) {
      bfr[2] = lds_rd128<2048>(sb + boff); bfr[3] = lds_rd128<3072>(sb + boff);
      asm volatile("s_waitcnt lgkmcnt(0)" : "+v"(af[0]), "+v"(af[1]), "+v"(af[2]), "+v"(af[3]),
                   "+v"(bfr[0]), "+v"(bfr[1]), "+v"(bfr[2]), "+v"(bfr[3]));
    } else {
      asm volatile("s_waitcnt lgkmcnt(0)" : "+v"(af[0]), "+v"(af[1]), "+v"(af[2]), "+v"(af[3]), "+v"(bfr[0]), "+v"(bfr[1]));
    }
#pragma unroll
    for (int m = 0; m < 4; ++m)
#pragma unroll
      for (int n = 0; n < NW; ++n) {
        if (SWAP) acc[m][n] = __builtin_amdgcn_mfma_f32_16x16x32_bf16(bfr[n], af[m], acc[m][n], 0, 0, 0);
        else acc[m][n] = __builtin_amdgcn_mfma_f32_16x16x32_bf16(af[m], bfr[n], acc[m][n], 0, 0, 0);
      }
  }
#undef GEMM_ISSUE
}

DEVI int launder(int x) { asm volatile("" : "+v"(x)); return x; }

template <int NW>
DEVI void zero_acc(f32x4 (&acc)[4][NW]) {
#pragma unroll
  for (int m = 0; m < 4; ++m)
#pragma unroll
    for (int n = 0; n < NW; ++n) acc[m][n] = (f32x4){0.f, 0.f, 0.f, 0.f};
}

struct NoEpi { DEVI void operator()(int, int, f32x4) const {} };

template <class EpiS, class EpiN>
DEVI void gemm_phase(int tid_, const u16* A, int lda, const u16* Bt, int ldb, int K, int M, int N, char* smem, int ns_from,
                     EpiS epiS, EpiN epiN) {
  const int nN = N >> 7, nM = M >> 7;
  const int lane = tid_ & 63, wid = tid_ >> 6;
  const int wr = wid >> 1, wc = wid & 1, fr = lane & 15, fq = lane >> 4;
  const int xcd = blockIdx.x & 7, jloc = blockIdx.x >> 3, nloc = gridDim.x >> 3;
  for (int lt = jloc; lt < (nM >> 3) * nN; lt += nloc) {
    const int tml = lt / nN, tn = lt - tml * nN;
    const int tm = tml * 8 + xcd;
    const int m0 = tm << 7, n0 = tn << 7;
    f32x4 acc[4][4];
    zero_acc(acc);
    if (n0 < ns_from) {
      gemm_kloop<4, true>(tid_, acc, A + (size_t)m0 * lda, lda, Bt + (size_t)n0 * ldb, ldb, K, smem);
#pragma unroll
      for (int m = 0; m < 4; ++m)
#pragma unroll
        for (int n = 0; n < 4; ++n) epiS(m0 + wr * 64 + m * 16 + fr, n0 + wc * 64 + n * 16 + fq * 4, acc[m][n]);
    } else {
      gemm_kloop<4, false>(tid_, acc, A + (size_t)m0 * lda, lda, Bt + (size_t)n0 * ldb, ldb, K, smem);
#pragma unroll
      for (int m = 0; m < 4; ++m)
#pragma unroll
        for (int n = 0; n < 4; ++n) epiN(m0 + wr * 64 + m * 16 + fq * 4, n0 + wc * 64 + n * 16 + fr, acc[m][n]);
    }
  }
}


template <bool SWAP>
DEVI void gemm_kloop_big(int tid_, f32x4 (&acc)[8][4], const u16* __restrict__ A, int lda, const u16* __restrict__ Bt,
                         int ldb, int K, char* smem) {
  constexpr int STG = 16384 + 8192;
  const int tid = tid_, lane = tid & 63, wid = tid >> 6;
  const int wr = wid >> 1, wc = wid & 1, fr = lane & 15, fq = lane >> 4;
  const int lrow = lane >> 2, lphys = lane & 3, lhi = lane >> 4;
  const int gsw = (4 - lhi) & 3;
  const u16* ga = A + (size_t)(wid * 64 + lrow) * lda + (lphys ^ gsw) * 8;
  const u16* gb = Bt + (size_t)(wid * 32 + lrow) * ldb + (lphys ^ gsw) * 8;
  const size_t a16 = (size_t)16 * lda, b16 = (size_t)16 * ldb;
  const int rsw = (4 - ((fr >> 2) & 3)) & 3;
  const int ch = (fq ^ rsw) * 16;
  const int nk = K >> 5;
  const uint32_t lds_base = (uint32_t)(size_t)(__attribute__((address_space(3))) char*)smem;
  const uint32_t aoff = (uint32_t)((wr * 128 + fr) * 64 + ch);
  const uint32_t boff = (uint32_t)(16384 + (wc * 64 + fr) * 64 + ch);
  asm volatile("s_waitcnt vmcnt(0)" ::: "memory");
  __syncthreads();
#define GEMMB_ISSUE(kt_, buf_)                                                                                       \
  do {                                                                                                               \
    char* nb_ = smem + (buf_) * STG;                                                                                 \
    _Pragma("unroll") for (int q = 0; q < 4; ++q) __builtin_amdgcn_global_load_lds(                                  \
        (const unsigned*)(ga + q * a16 + (kt_) * 32),                                                                \
        (__attribute__((address_space(3))) unsigned*)(nb_ + (wid * 4 + q) * 1024 + lane * 16), 16, 0, 0);            \
    _Pragma("unroll") for (int q = 0; q < 2; ++q) __builtin_amdgcn_global_load_lds(                                  \
        (const unsigned*)(gb + q * b16 + (kt_) * 32),                                                                \
        (__attribute__((address_space(3))) unsigned*)(nb_ + 16384 + (wid * 2 + q) * 1024 + lane * 16), 16, 0, 0);   \
  } while (0)
  GEMMB_ISSUE(0, 0);
  if (nk > 1) GEMMB_ISSUE(1, 1);
  int cb = 0;
  for (int kt = 0; kt < nk; ++kt) {
    if (kt + 1 < nk) asm volatile("s_waitcnt vmcnt(6)" ::: "memory");
    else asm volatile("s_waitcnt vmcnt(0)" ::: "memory");
    __builtin_amdgcn_s_barrier();
    asm volatile("" ::: "memory");
    const int nbuf = (cb == 0) ? 2 : cb - 1;
    if (kt + 2 < nk) GEMMB_ISSUE(kt + 2, nbuf);
    const uint32_t sb = lds_base + cb * STG;
    bf16x8 a0[4], a1[4], bb[4];
    a0[0] = lds_rd128<0>(sb + aoff); a0[1] = lds_rd128<1024>(sb + aoff);
    a0[2] = lds_rd128<2048>(sb + aoff); a0[3] = lds_rd128<3072>(sb + aoff);
    bb[0] = lds_rd128<0>(sb + boff); bb[1] = lds_rd128<1024>(sb + boff);
    bb[2] = lds_rd128<2048>(sb + boff); bb[3] = lds_rd128<3072>(sb + boff);
    a1[0] = lds_rd128<4096>(sb + aoff); a1[1] = lds_rd128<5120>(sb + aoff);
    a1[2] = lds_rd128<6144>(sb + aoff); a1[3] = lds_rd128<7168>(sb + aoff);
    asm volatile("s_waitcnt lgkmcnt(4)" : "+v"(a0[0]), "+v"(a0[1]), "+v"(a0[2]), "+v"(a0[3]),
                 "+v"(bb[0]), "+v"(bb[1]), "+v"(bb[2]), "+v"(bb[3]));
#pragma unroll
    for (int m = 0; m < 4; ++m)
#pragma unroll
      for (int n = 0; n < 4; ++n) {
        if (SWAP) acc[m][n] = __builtin_amdgcn_mfma_f32_16x16x32_bf16(bb[n], a0[m], acc[m][n], 0, 0, 0);
        else acc[m][n] = __builtin_amdgcn_mfma_f32_16x16x32_bf16(a0[m], bb[n], acc[m][n], 0, 0, 0);
      }
    asm volatile("s_waitcnt lgkmcnt(0)" : "+v"(a1[0]), "+v"(a1[1]), "+v"(a1[2]), "+v"(a1[3]));
#pragma unroll
    for (int m = 0; m < 4; ++m)
#pragma unroll
      for (int n = 0; n < 4; ++n) {
        if (SWAP) acc[4 + m][n] = __builtin_amdgcn_mfma_f32_16x16x32_bf16(bb[n], a1[m], acc[4 + m][n], 0, 0, 0);
        else acc[4 + m][n] = __builtin_amdgcn_mfma_f32_16x16x32_bf16(a1[m], bb[n], acc[4 + m][n], 0, 0, 0);
      }
    cb = (cb == 2) ? 0 : cb + 1;
  }
#undef GEMMB_ISSUE
}

template <class EpiS, class EpiN>
DEVI void gemm_phase_big(int tid_, const u16* A, int lda, const u16* Bt, int ldb, int K, int M, int N, char* smem,
                         int ns_from, EpiS epiS, EpiN epiN) {
  const int nN = N >> 7, nM = M >> 8;
  const int lane = tid_ & 63, wid = tid_ >> 6;
  const int wr = wid >> 1, wc = wid & 1, fr = lane & 15, fq = lane >> 4;
  const int xcd = blockIdx.x & 7, jloc = blockIdx.x >> 3, nloc = gridDim.x >> 3;
  for (int lt = jloc; lt < (nM >> 3) * nN; lt += nloc) {
    const int tml = lt / nN, tn = lt - tml * nN;
    const int tm = tml * 8 + xcd;
    const int m0 = tm << 8, n0 = tn << 7;
    f32x4 acc[8][4];
#pragma unroll
    for (int m = 0; m < 8; ++m)
#pragma unroll
      for (int n = 0; n < 4; ++n) acc[m][n] = (f32x4){0.f, 0.f, 0.f, 0.f};
    if (n0 < ns_from) {
      gemm_kloop_big<true>(launder(tid_), acc, A + (size_t)m0 * lda, lda, Bt + (size_t)n0 * ldb, ldb, K, smem);
#pragma unroll
      for (int m = 0; m < 8; ++m)
#pragma unroll
        for (int n = 0; n < 4; ++n) epiS(m0 + wr * 128 + m * 16 + fr, n0 + wc * 64 + n * 16 + fq * 4, acc[m][n]);
    } else {
      gemm_kloop_big<false>(launder(tid_), acc, A + (size_t)m0 * lda, lda, Bt + (size_t)n0 * ldb, ldb, K, smem);
#pragma unroll
      for (int m = 0; m < 8; ++m)
#pragma unroll
        for (int n = 0; n < 4; ++n) epiN(m0 + wr * 128 + m * 16 + fq * 4, n0 + wc * 64 + n * 16 + fr, acc[m][n]);
    }
  }
}


template <bool SWAP>
DEVI void gemm_kloop8(int tid_, f32x4 (&acc)[8][4], const u16* __restrict__ A, int lda, const u16* __restrict__ Bt,
                      int ldb, int K, char* smem) {
  constexpr int STG = 32768;
  const int tid = tid_, lane = tid & 63, wid = tid >> 6;
  const int wr = wid >> 2, wc = wid & 3, fr = lane & 15, fq = lane >> 4;
  const int lrow = lane >> 2, lphys = lane & 3, lhi = lane >> 4;
  const int gsw = (4 - lhi) & 3;
  const u16* ga = A + (size_t)(wid * 32 + lrow) * lda + (lphys ^ gsw) * 8;
  const u16* gb = Bt + (size_t)(wid * 32 + lrow) * ldb + (lphys ^ gsw) * 8;
  const size_t a16 = (size_t)16 * lda, b16 = (size_t)16 * ldb;
  const int rsw = (4 - ((fr >> 2) & 3)) & 3;
  const int ch = (fq ^ rsw) * 16;
  const int nk = K >> 5;
  const uint32_t lds_base = (uint32_t)(size_t)(__attribute__((address_space(3))) char*)smem;
  const uint32_t aoff = (uint32_t)((wr * 128 + fr) * 64 + ch);
  const uint32_t boff = (uint32_t)(16384 + (wc * 64 + fr) * 64 + ch);
  asm volatile("s_waitcnt vmcnt(0)" ::: "memory");
  __syncthreads();
#define GEMM8_ISSUE(kt_)                                                                                             \
  do {                                                                                                               \
    char* nb_ = smem + ((kt_) & 3) * STG;                                                                            \
    _Pragma("unroll") for (int q = 0; q < 2; ++q) __builtin_amdgcn_global_load_lds(                                  \
        (const unsigned*)(ga + q * a16 + (kt_) * 32),                                                                \
        (__attribute__((address_space(3))) unsigned*)(nb_ + (wid * 2 + q) * 1024 + lane * 16), 16, 0, 0);            \
    _Pragma("unroll") for (int q = 0; q < 2; ++q) __builtin_amdgcn_global_load_lds(                                  \
        (const unsigned*)(gb + q * b16 + (kt_) * 32),                                                                \
        (__attribute__((address_space(3))) unsigned*)(nb_ + 16384 + (wid * 2 + q) * 1024 + lane * 16), 16, 0, 0);    \
  } while (0)
  GEMM8_ISSUE(0);
  if (nk > 1) GEMM8_ISSUE(1);
  if (nk > 2) GEMM8_ISSUE(2);
  for (int kt = 0; kt < nk; ++kt) {
    if (kt + 2 < nk) asm volatile("s_waitcnt vmcnt(8)" ::: "memory");
    else if (kt + 1 < nk) asm volatile("s_waitcnt vmcnt(4)" ::: "memory");
    else asm volatile("s_waitcnt vmcnt(0)" ::: "memory");
    __builtin_amdgcn_s_barrier();
    asm volatile("" ::: "memory");
    if (kt + 3 < nk) GEMM8_ISSUE(kt + 3);
    const uint32_t sb = lds_base + (kt & 3) * STG;
    bf16x8 a0[4], a1[4], bb[4];
    a0[0] = lds_rd128<0>(sb + aoff); a0[1] = lds_rd128<1024>(sb + aoff);
    a0[2] = lds_rd128<2048>(sb + aoff); a0[3] = lds_rd128<3072>(sb + aoff);
    bb[0] = lds_rd128<0>(sb + boff); bb[1] = lds_rd128<1024>(sb + boff);
    bb[2] = lds_rd128<2048>(sb + boff); bb[3] = lds_rd128<3072>(sb + boff);
    a1[0] = lds_rd128<4096>(sb + aoff); a1[1] = lds_rd128<5120>(sb + aoff);
    a1[2] = lds_rd128<6144>(sb + aoff); a1[3] = lds_rd128<7168>(sb + aoff);
    asm volatile("s_waitcnt lgkmcnt(4)" : "+v"(a0[0]), "+v"(a0[1]), "+v"(a0[2]), "+v"(a0[3]),
                 "+v"(bb[0]), "+v"(bb[1]), "+v"(bb[2]), "+v"(bb[3]));
#pragma unroll
    for (int m = 0; m < 4; ++m)
#pragma unroll
      for (int n = 0; n < 4; ++n) {
        if (SWAP) acc[m][n] = __builtin_amdgcn_mfma_f32_16x16x32_bf16(bb[n], a0[m], acc[m][n], 0, 0, 0);
        else acc[m][n] = __builtin_amdgcn_mfma_f32_16x16x32_bf16(a0[m], bb[n], acc[m][n], 0, 0, 0);
      }
    asm volatile("s_waitcnt lgkmcnt(0)" : "+v"(a1[0]), "+v"(a1[1]), "+v"(a1[2]), "+v"(a1[3]));
#pragma unroll
    for (int m = 0; m < 4; ++m)
#pragma unroll
      for (int n = 0; n < 4; ++n) {
        if (SWAP) acc[4 + m][n] = __builtin_amdgcn_mfma_f32_16x16x32_bf16(bb[n], a1[m], acc[4 + m][n], 0, 0, 0);
        else acc[4 + m][n] = __builtin_amdgcn_mfma_f32_16x16x32_bf16(a1[m], bb[n], acc[4 + m][n], 0, 0, 0);
      }
  }
#undef GEMM8_ISSUE
}

template <class EpiS, class EpiN>
DEVI void gemm_phase8(int tid_, const u16* A, int lda, const u16* Bt, int ldb, int K, int M, int N, char* smem,
                      int ns_from, EpiS epiS, EpiN epiN) {
  const int nN = (N + 255) >> 8, nM = M >> 8;
  const int lane = tid_ & 63, wid = tid_ >> 6;
  const int wr = wid >> 2, wc = wid & 3, fr = lane & 15, fq = lane >> 4;
  const bool xmap = ((gridDim.x & 7) == 0) && ((nM & 7) == 0);
  const int xcd = blockIdx.x & 7;
  const int first = xmap ? (int)(blockIdx.x >> 3) : (int)blockIdx.x;
  const int stride = xmap ? (int)(gridDim.x >> 3) : (int)gridDim.x;
  const int count = xmap ? (nM >> 3) * nN : nM * nN;
  for (int it = first; it < count; it += stride) {
    const int tq = it / nN, tn = it - tq * nN;
    const int tm = xmap ? tq * 8 + xcd : tq;
    const int m0 = tm << 8, n0 = tn << 8;
    const int colb = n0 + wc * 64;
    f32x4 acc[8][4];
#pragma unroll
    for (int m = 0; m < 8; ++m)
#pragma unroll
      for (int n = 0; n < 4; ++n) acc[m][n] = (f32x4){0.f, 0.f, 0.f, 0.f};
    if (colb < ns_from) {
      gemm_kloop8<true>(launder(tid_), acc, A + (size_t)m0 * lda, lda, Bt + (size_t)n0 * ldb, ldb, K, smem);
      if (colb < N) {
#pragma unroll
        for (int m = 0; m < 8; ++m)
#pragma unroll
          for (int n = 0; n < 4; ++n) epiS(m0 + wr * 128 + m * 16 + fr, colb + n * 16 + fq * 4, acc[m][n]);
      }
    } else {
      gemm_kloop8<false>(launder(tid_), acc, A + (size_t)m0 * lda, lda, Bt + (size_t)n0 * ldb, ldb, K, smem);
      if (colb < N) {
#pragma unroll
        for (int m = 0; m < 8; ++m)
#pragma unroll
          for (int n = 0; n < 4; ++n) epiN(m0 + wr * 128 + m * 16 + fq * 4, colb + n * 16 + fr, acc[m][n]);
      }
    }
  }
}

DEVI void store4bf(u16* dst, f32x4 v) {
  u32x2 o;
  o.x = pack2(v[0], v[1]); o.y = pack2(v[2], v[3]);
  *(u32x2*)dst = o;
}

DEVI void phase_p_gemm(int tid_, const Params& p, char* smem) {
  u16* WB = (u16*)(p.ws + OFF_WB);
  const u16* H = (const u16*)(p.ws + OFF_H);
  u16* PR = (u16*)(p.ws + OFF_PR);
  u16* NQ = (u16*)(p.ws + OFF_NQ);
  u16* NK = (u16*)(p.ws + OFF_NK);
  u16* NVT = (u16*)(p.ws + OFF_NV);
  gemm_phase8(tid_, H, 1024, WB + W_IN, 1024, 1024, NTOK, 3456, smem, 2944,
    [&](int r, int c0, f32x4 v) {
      if (c0 < 1920) store4bf(PR + (size_t)r * PRW + c0, v);
      else if (c0 < 2432) store4bf(NQ + (size_t)r * 512 + (c0 - 1920), v);
      else store4bf(NK + (size_t)r * 512 + (c0 - 2432), v);
    },
    [&](int r0, int c, f32x4 v) {
      const int cc = c - 2944;
      const int s = r0 >> 12, t = r0 & 4095;
      store4bf(NVT + ((size_t)(s * 512 + cc)) * 4096 + t, v);
    });
  const u16* MH = (const u16*)(p.ws + OFF_MEMH);
  u16* KVK = (u16*)(p.ws + OFF_KVK);
  u16* KVT = (u16*)(p.ws + OFF_KVT);
  gemm_phase8(tid_, MH, 1024, WB + W_XKV, 1024, 1024, 3072, 2048, smem, 1024,
    [&](int r, int c0, f32x4 v) { store4bf(KVK + (size_t)r * 1024 + c0, v); },
    [&](int r0, int c, f32x4 v) {
      const int cc = c - 1024;
      const int s = r0 >> 8, m = r0 & 255;
      store4bf(KVT + ((size_t)(s * 1024 + cc)) * 256 + m, v);
    });
}

DEVI void phase_nat(int tid_, const Params& p, int l, char* smem, int bfirst, int bstride) {
  u16* NQ = (u16*)(p.ws + OFF_NQ);
  const u16* NK = (const u16*)(p.ws + OFF_NK);
  const u16* NVT = (const u16*)(p.ws + OFF_NV);
  const float* rpb = p.in[I_RPB] + (size_t)l * 8 * 15 * 31;
  const int lane = tid_ & 63, g = tid_ >> 6, fr = lane & 15, fq = lane >> 4;
  u16* Pw = (u16*)smem + g * (16 * 264);
  const int cb = (g == 0) ? 0 : (g == 1) ? 8 : (g == 2) ? 24 : 32;
  for (int t = bfirst; t < 12 * 64 * 8; t += bstride) {
    const int h = t & 7, ri = (t >> 3) & 63, s = t >> 9;
    int rs = ri - 4; rs = rs < 0 ? 0 : (rs > 56 ? 56 : rs);
    const size_t tokq = (size_t)s * 4096 + ri * 64 + g * 16;
    bf16x8 aq[2];
    aq[0] = *(const bf16x8*)(NQ + (tokq + fr) * 512 + h * 64 + fq * 8);
    aq[1] = *(const bf16x8*)(NQ + (tokq + fr) * 512 + h * 64 + 32 + fq * 8);
    f32x4 acc[16];
#pragma unroll
    for (int n = 0; n < 16; ++n) {
      acc[n] = (f32x4){0.f, 0.f, 0.f, 0.f};
      const int r = n >> 1, col = cb + (n & 1) * 16 + fr;
      const u16* kp = NK + ((size_t)s * 4096 + (rs + r) * 64 + col) * 512 + h * 64 + fq * 8;
      bf16x8 b0 = *(const bf16x8*)kp;
      bf16x8 b1 = *(const bf16x8*)(kp + 32);
      acc[n] = __builtin_amdgcn_mfma_f32_16x16x32_bf16(aq[0], b0, acc[n], 0, 0, 0);
      acc[n] = __builtin_amdgcn_mfma_f32_16x16x32_bf16(aq[1], b1, acc[n], 0, 0, 0);
    }
    float mx[4], sm[4];
#pragma unroll
    for (int j = 0; j < 4; ++j) {
      const int c = g * 16 + fq * 4 + j;
      int cs = c - 8; cs = cs < 0 ? 0 : (cs > 48 ? 48 : cs);
      float m = -1e30f;
#pragma unroll
      for (int n = 0; n < 16; ++n) {
        const int r = n >> 1, kc = cb + (n & 1) * 16 + fr;
        const bool valid = (kc >= cs) && (kc < cs + 16);
        float sc = -1e30f;
        if (valid) {
          const int di = rs + r - ri + 7, dj = kc - c + 15;
          sc = acc[n][j] * 0.125f + rpb[(h * 15 + di) * 31 + dj];
        }
        acc[n][j] = sc;
        m = fmaxf(m, sc);
      }
      mx[j] = red16_max(m);
    }
#pragma unroll
    for (int j = 0; j < 4; ++j) {
      float ssum = 0.f;
#pragma unroll
      for (int n = 0; n < 16; ++n) {
        float e = __expf(acc[n][j] - mx[j]);
        acc[n][j] = e;
        ssum += e;
      }
      sm[j] = 1.f / red16_sum(ssum);
    }
#pragma unroll
    for (int n = 0; n < 16; ++n)
#pragma unroll
      for (int j = 0; j < 4; ++j) Pw[(fq * 4 + j) * 264 + n * 16 + fr] = f2bf(acc[n][j]);
    f32x4 o[4];
#pragma unroll
    for (int n = 0; n < 4; ++n) o[n] = (f32x4){0.f, 0.f, 0.f, 0.f};
#pragma unroll
    for (int ks = 0; ks < 8; ++ks) {
      bf16x8 ap = *(const bf16x8*)(Pw + fr * 264 + ks * 32 + fq * 8);
#pragma unroll
      for (int n = 0; n < 4; ++n) {
        bf16x8 bv = *(const bf16x8*)(NVT + ((size_t)(s * 512 + h * 64 + n * 16 + fr)) * 4096 + (rs + ks) * 64 + cb + fq * 8);
        o[n] = __builtin_amdgcn_mfma_f32_16x16x32_bf16(ap, bv, o[n], 0, 0, 0);
      }
    }
#pragma unroll
    for (int n = 0; n < 4; ++n)
#pragma unroll
      for (int j = 0; j < 4; ++j)
        NQ[(tokq + fq * 4 + j) * 512 + h * 64 + n * 16 + fr] = f2bf(o[n][j] * sm[j]);
  }
}

constexpr int SC_OPS = 0;
constexpr int SC_VV = 40960;
constexpr int SC_WR = 49152;
constexpr int SC_AP = 57344;
constexpr int SC_TW = 65536;
constexpr int SC_AD = 70144;
constexpr int SC_NRM = 74752;
constexpr int SC_MU = 74880;
constexpr int SC_CST = 77440;

typedef __attribute__((ext_vector_type(2))) float f32x2;

template <int CTRL>
DEVI float dpp_mov(float x) {
  return __int_as_float(__builtin_amdgcn_update_dpp(0, __float_as_int(x), CTRL, 0xF, 0xF, true));
}
DEVI float red8(float x) {
  x += dpp_mov<0xB1>(x);
  x += dpp_mov<0x4E>(x);
  x += dpp_mov<0x141>(x);
  return x;
}
DEVI f32x2 lo2(f32x4 v) { return __builtin_shufflevector(v, v, 0, 1); }
DEVI f32x2 hi2(f32x4 v) { return __builtin_shufflevector(v, v, 2, 3); }

struct ScanOps {
  f32x2 a[4], w[4], b[4], k[4], r[4];
  float v0, v1;
};
DEVI void scan_load(ScanOps& o, const float* OPS, const float* VV, int nn, int jg, int i0) {
  const float* base = OPS + nn * 64 + jg * 8;
  f32x4 t0, t1;
  t0 = *(const f32x4*)(base); t1 = *(const f32x4*)(base + 4);
  o.a[0] = lo2(t0); o.a[1] = hi2(t0); o.a[2] = lo2(t1); o.a[3] = hi2(t1);
  t0 = *(const f32x4*)(base + 2048); t1 = *(const f32x4*)(base + 2048 + 4);
  o.w[0] = lo2(t0); o.w[1] = hi2(t0); o.w[2] = lo2(t1); o.w[3] = hi2(t1);
  t0 = *(const f32x4*)(base + 4096); t1 = *(const f32x4*)(base + 4096 + 4);
  o.b[0] = lo2(t0); o.b[1] = hi2(t0); o.b[2] = lo2(t1); o.b[3] = hi2(t1);
  t0 = *(const f32x4*)(base + 6144); t1 = *(const f32x4*)(base + 6144 + 4);
  o.k[0] = lo2(t0); o.k[1] = hi2(t0); o.k[2] = lo2(t1); o.k[3] = hi2(t1);
  t0 = *(const f32x4*)(base + 8192); t1 = *(const f32x4*)(base + 8192 + 4);
  o.r[0] = lo2(t0); o.r[1] = hi2(t0); o.r[2] = lo2(t1); o.r[3] = hi2(t1);
  o.v0 = VV[nn * 64 + i0];
  o.v1 = VV[nn * 64 + i0 + 8];
}
DEVI void scan_step(const ScanOps& o, f32x2 (&S0)[4], f32x2 (&S1)[4], float* YL, int nn, int jg, int i0) {
  f32x2 d0 = S0[0] * o.a[0], d0b = S0[2] * o.a[2];
  f32x2 d1 = S1[0] * o.a[0], d1b = S1[2] * o.a[2];
  d0 = S0[1] * o.a[1] + d0; d0b = S0[3] * o.a[3] + d0b;
  d1 = S1[1] * o.a[1] + d1; d1b = S1[3] * o.a[3] + d1b;
  d0 += d0b; d1 += d1b;
  const float sa0 = red8(d0.x + d0.y);
  const float sa1 = red8(d1.x + d1.y);
  f32x2 e0 = {0.f, 0.f}, e1 = {0.f, 0.f};
#pragma unroll
  for (int q = 0; q < 4; ++q) {
    const f32x2 u0 = sa0 * o.b[q] + o.v0 * o.k[q];
    const f32x2 u1 = sa1 * o.b[q] + o.v1 * o.k[q];
    S0[q] = S0[q] * o.w[q] + u0;
    S1[q] = S1[q] * o.w[q] + u1;
    e0 = S0[q] * o.r[q] + e0;
    e1 = S1[q] * o.r[q] + e1;
  }
  const float y0 = red8(e0.x + e0.y);
  const float y1 = red8(e1.x + e1.y);
  if (jg == 0) { YL[nn * 64 + i0] = y0; YL[nn * 64 + i0 + 8] = y1; }
}

DEVI void phase_scan(int tid_, const Params& p, int l, char* smem, int bfirst, int bstride) {
  const u16* PR = (const u16*)(p.ws + OFF_PR);
  _Float16* YF = (_Float16*)(p.ws + OFF_H);
  _Float16* YB = (_Float16*)(p.ws + OFF_H + (size_t)NTOK * 512 * 2);
  float* BON = (float*)(p.ws + OFF_BONUS);
  const u16* WB = (const u16*)(p.ws + OFF_WB);
  float* OPS = (float*)(smem + SC_OPS);
  u16* RAW = (u16*)(smem + SC_OPS);
  float* VV = (float*)(smem + SC_VV);
  float* WR = (float*)(smem + SC_WR);
  float* AP = (float*)(smem + SC_AP);
  float* YL = WR;
  u16* TWb = (u16*)(smem + SC_TW);
  u16* ADb = (u16*)(smem + SC_AD);
  float* NRM = (float*)(smem + SC_NRM);
  float* MU = (float*)(smem + SC_MU);
  float* CST = (float*)(smem + SC_CST);
  const float* mu_p = p.in[I_MU_PREV] + (size_t)l * 1920;
  const float* mu_n = p.in[I_MU_NEXT] + (size_t)l * 1920;
  const int tid = tid_, lane = tid & 63, w = tid >> 6, fr = lane & 15, fq = lane >> 4;
  const int pn = tid >> 3, j0 = (tid & 7) * 8;
  const int jg = lane & 7, i0 = w * 16 + (lane >> 3);
  const int hr = (tid >= 40) ? 1 : 0, hc = tid - hr * 40;
  for (int blk = bfirst; blk < 192; blk += bstride) {
    const int s = blk >> 4, h = (blk >> 1) & 7, d = blk & 1;
    __syncthreads();
    for (int i = tid; i < 640; i += 256) {
      const int which = (i >= 320) ? 1 : 0, c = i - which * 320;
      const int g = c >> 6, e = c & 63;
      const int col = (g < 3) ? (g * 512 + h * 64 + e) : (1536 + (g - 3) * 128 + d * 64 + e);
      MU[i] = which ? mu_n[col] : mu_p[col];
    }
    for (int i = tid; i < 320; i += 256) {
      const int which = i >> 6, e = i & 63;
      float v;
      if (which == 0) v = p.in[I_W0][(size_t)(l * 2 + d) * 512 + h * 64 + e];
      else if (which == 1) v = p.in[I_A0][(size_t)(l * 2 + d) * 512 + h * 64 + e];
      else if (which == 2) v = p.in[I_K_K][(size_t)l * 512 + h * 64 + e];
      else if (which == 3) v = p.in[I_K_A][(size_t)l * 512 + h * 64 + e];
      else v = p.in[I_R_K][(size_t)(l * 8 + h) * 64 + e];
      CST[i] = v;
    }
    bf16x8 bw[2], ba[2];
#pragma unroll
    for (int ks = 0; ks < 2; ++ks) {
      bw[ks] = *(const bf16x8*)(WB + W_WUP + (size_t)(d * 512 + h * 64 + w * 16 + fr) * 64 + ks * 32 + fq * 8);
      ba[ks] = *(const bf16x8*)(WB + W_AUP + (size_t)(d * 512 + h * 64 + w * 16 + fr) * 64 + ks * 32 + fq * 8);
    }
    _Float16* Y = d ? YB : YF;
    f32x2 S0[4], S1[4];
#pragma unroll
    for (int q = 0; q < 4; ++q) { S0[q] = (f32x2){0.f, 0.f}; S1[q] = (f32x2){0.f, 0.f}; }
    u32x4 G[5], GH;
    {
      const int t = d ? (4095 - pn) : pn;
      const size_t tok = (size_t)s * 4096 + t;
#pragma unroll
      for (int g = 0; g < 5; ++g) {
        const int col = (g < 3) ? (g * 512 + h * 64) : (1536 + (g - 3) * 128 + d * 64);
        G[g] = *(const u32x4*)(PR + tok * PRW + col + j0);
      }
      GH = (u32x4){0u, 0u, 0u, 0u};
      if (tid < 80) {
        const int tlo = d ? (4095 - 31) : 0;
        const int th = hr ? (tlo + 32) : (tlo - 1);
        const int g = hc >> 3;
        const int col = (g < 3) ? (g * 512 + h * 64) : (1536 + (g - 3) * 128 + d * 64);
        if (th >= 0 && th <= 4095) GH = *(const u32x4*)(PR + ((size_t)s * 4096 + th) * PRW + col + (hc & 7) * 8);
      }
    }
#pragma unroll 1
    for (int ch = 0; ch < 128; ++ch) {
      const int n = ch * 32 + pn;
      const int t = d ? (4095 - n) : n;
      const size_t tok = (size_t)s * 4096 + t;
      const int tlo = d ? (4095 - (ch * 32 + 31)) : (ch * 32);
      const int rrow = t - tlo + 1;
#pragma unroll
      for (int g = 0; g < 5; ++g) *(u32x4*)(RAW + rrow * 320 + g * 64 + j0) = G[g];
      if (tid < 80) *(u32x4*)(RAW + (hr ? 33 : 0) * 320 + (hc >> 3) * 64 + (hc & 7) * 8) = GH;
      __syncthreads();
      if (ch + 1 < 128) {
        const int n2 = n + 32;
        const int t2 = d ? (4095 - n2) : n2;
        const size_t tok2 = (size_t)s * 4096 + t2;
#pragma unroll
        for (int g = 0; g < 5; ++g) {
          const int col = (g < 3) ? (g * 512 + h * 64) : (1536 + (g - 3) * 128 + d * 64);
          G[g] = *(const u32x4*)(PR + tok2 * PRW + col + j0);
        }
        GH = (u32x4){0u, 0u, 0u, 0u};
        if (tid < 80) {
          const int tlo2 = d ? (tlo - 32) : (tlo + 32);
          const int th = hr ? (tlo2 + 32) : (tlo2 - 1);
          const int g = hc >> 3;
          const int col = (g < 3) ? (g * 512 + h * 64) : (1536 + (g - 3) * 128 + d * 64);
          if (th >= 0 && th <= 4095) GH = *(const u32x4*)(PR + ((size_t)s * 4096 + th) * PRW + col + (hc & 7) * 8);
        }
      }
#pragma unroll
      for (int g = 0; g < 5; ++g) {
        float cur[8], prv[8], nxt[8];
        load8bf(RAW + rrow * 320 + g * 64 + j0, cur);
        load8bf(RAW + (rrow - 1) * 320 + g * 64 + j0, prv);
        load8bf(RAW + (rrow + 1) * 320 + g * 64 + j0, nxt);
        const f32x4 mp0 = *(const f32x4*)(MU + g * 64 + j0), mp1 = *(const f32x4*)(MU + g * 64 + j0 + 4);
        const f32x4 mn0 = *(const f32x4*)(MU + 320 + g * 64 + j0), mn1 = *(const f32x4*)(MU + 320 + g * 64 + j0 + 4);
        f32x4 x0, x1;
#pragma unroll
        for (int e = 0; e < 4; ++e) {
          x0[e] = cur[e] + mp0[e] * (prv[e] - cur[e]) + mn0[e] * (nxt[e] - cur[e]);
          x1[e] = cur[4 + e] + mp1[e] * (prv[4 + e] - cur[4 + e]) + mn1[e] * (nxt[4 + e] - cur[4 + e]);
        }
        if (g == 0) {
          *(f32x4*)(OPS + 4 * 2048 + pn * 64 + j0) = x0; *(f32x4*)(OPS + 4 * 2048 + pn * 64 + j0 + 4) = x1;
        } else if (g == 1) {
          *(f32x4*)(OPS + 3 * 2048 + pn * 64 + j0) = x0; *(f32x4*)(OPS + 3 * 2048 + pn * 64 + j0 + 4) = x1;
          const f32x4 kk0 = *(const f32x4*)(CST + 128 + j0), kk1 = *(const f32x4*)(CST + 128 + j0 + 4);
          float ss = 0.f;
#pragma unroll
          for (int e = 0; e < 4; ++e) { const float a_ = x0[e] * kk0[e], b_ = x1[e] * kk1[e]; ss += a_ * a_ + b_ * b_; }
          ss = red8(ss);
          if ((tid & 7) == 0) NRM[pn] = frcp(fmaxf(__builtin_amdgcn_sqrtf(ss), 1e-12f));
        } else if (g == 2) {
          *(f32x4*)(VV + pn * 64 + j0) = x0; *(f32x4*)(VV + pn * 64 + j0 + 4) = x1;
        } else if (g == 3) {
          u32x4 pk;
          pk.x = pack2(ftanh(x0[0]), ftanh(x0[1])); pk.y = pack2(ftanh(x0[2]), ftanh(x0[3]));
          pk.z = pack2(ftanh(x1[0]), ftanh(x1[1])); pk.w = pack2(ftanh(x1[2]), ftanh(x1[3]));
          *(u32x4*)(TWb + pn * 72 + j0) = pk;
        } else {
          u32x4 pk;
          pk.x = pack2(x0[0], x0[1]); pk.y = pack2(x0[2], x0[3]);
          pk.z = pack2(x1[0], x1[1]); pk.w = pack2(x1[2], x1[3]);
          *(u32x4*)(ADb + pn * 72 + j0) = pk;
        }
      }
      __syncthreads();
#pragma unroll
      for (int m = 0; m < 2; ++m) {
        f32x4 cw = {0.f, 0.f, 0.f, 0.f}, ca = {0.f, 0.f, 0.f, 0.f};
#pragma unroll
        for (int ks = 0; ks < 2; ++ks) {
          const bf16x8 aw = *(const bf16x8*)(TWb + (m * 16 + fr) * 72 + ks * 32 + fq * 8);
          const bf16x8 aa = *(const bf16x8*)(ADb + (m * 16 + fr) * 72 + ks * 32 + fq * 8);
          cw = __builtin_amdgcn_mfma_f32_16x16x32_bf16(aw, bw[ks], cw, 0, 0, 0);
          ca = __builtin_amdgcn_mfma_f32_16x16x32_bf16(aa, ba[ks], ca, 0, 0, 0);
        }
#pragma unroll
        for (int jj = 0; jj < 4; ++jj) {
          WR[(m * 16 + fq * 4 + jj) * 64 + w * 16 + fr] = cw[jj];
          AP[(m * 16 + fq * 4 + jj) * 64 + w * 16 + fr] = ca[jj];
        }
      }
      __syncthreads();
      {
        const float inv = NRM[pn];
        float bsum = 0.f;
#pragma unroll
        for (int hq = 0; hq < 2; ++hq) {
          const int jb = j0 + hq * 4;
          const f32x4 wr_ = *(const f32x4*)(WR + pn * 64 + jb) + *(const f32x4*)(CST + jb);
          const f32x4 ap_ = *(const f32x4*)(AP + pn * 64 + jb) + *(const f32x4*)(CST + 64 + jb);
          const f32x4 kr = *(const f32x4*)(OPS + 3 * 2048 + pn * 64 + jb);
          const f32x4 rr = *(const f32x4*)(OPS + 4 * 2048 + pn * 64 + jb);
          const f32x4 kkw = *(const f32x4*)(CST + 128 + jb), kaw = *(const f32x4*)(CST + 192 + jb), rkw = *(const f32x4*)(CST + 256 + jb);
          f32x4 o0, o1, o2, o3;
#pragma unroll
          for (int e = 0; e < 4; ++e) {
            const float sw = sigm(wr_[e]);
            const float dec = __expf(-0.6065306597126334f * sw);
            const float av = sigm(ap_[e]);
            const float kn = kr[e] * kkw[e] * inv;
            const float kd = kr[e] * (1.f + (av - 1.f) * kaw[e]);
            bsum += rr[e] * kd * rkw[e];
            o0[e] = -kn; o1[e] = dec; o2[e] = kn * av; o3[e] = kd;
          }
          *(f32x4*)(OPS + 0 * 2048 + pn * 64 + jb) = o0;
          *(f32x4*)(OPS + 1 * 2048 + pn * 64 + jb) = o1;
          *(f32x4*)(OPS + 2 * 2048 + pn * 64 + jb) = o2;
          *(f32x4*)(OPS + 3 * 2048 + pn * 64 + jb) = o3;
        }
        bsum = red8(bsum);
        if ((tid & 7) == 0) BON[(tok * 8 + h) * 2 + d] = bsum;
      }
      __syncthreads();
      {
        ScanOps oa, ob;
        scan_load(oa, OPS, VV, 0, jg, i0);
#pragma unroll 1
        for (int nn = 0; nn < 32; nn += 2) {
          scan_load(ob, OPS, VV, nn + 1, jg, i0);
          scan_step(oa, S0, S1, YL, nn, jg, i0);
          scan_load(oa, OPS, VV, (nn + 2) & 31, jg, i0);
          scan_step(ob, S0, S1, YL, nn + 1, jg, i0);
        }
      }
      __syncthreads();
      {
        h16x8 o;
#pragma unroll
        for (int e = 0; e < 8; ++e) o[e] = (_Float16)YL[pn * 64 + j0 + e];
        *(h16x8*)(Y + tok * 512 + h * 64 + j0) = o;
      }
    }
    __syncthreads();
  }
}

struct ScanOps1 {
  f32x2 a[4], w[4], b[4], k[4], r[4];
  float v0;
};
DEVI void scan_load1(ScanOps1& o, const float* OPS, const float* VV, int nn, int jg, int i0) {
  const float* base = OPS + nn * 64 + jg * 8;
  f32x4 t0, t1;
  t0 = *(const f32x4*)(base); t1 = *(const f32x4*)(base + 4);
  o.a[0] = lo2(t0); o.a[1] = hi2(t0); o.a[2] = lo2(t1); o.a[3] = hi2(t1);
  t0 = *(const f32x4*)(base + 2048); t1 = *(const f32x4*)(base + 2048 + 4);
  o.w[0] = lo2(t0); o.w[1] = hi2(t0); o.w[2] = lo2(t1); o.w[3] = hi2(t1);
  t0 = *(const f32x4*)(base + 4096); t1 = *(const f32x4*)(base + 4096 + 4);
  o.b[0] = lo2(t0); o.b[1] = hi2(t0); o.b[2] = lo2(t1); o.b[3] = hi2(t1);
  t0 = *(const f32x4*)(base + 6144); t1 = *(const f32x4*)(base + 6144 + 4);
  o.k[0] = lo2(t0); o.k[1] = hi2(t0); o.k[2] = lo2(t1); o.k[3] = hi2(t1);
  t0 = *(const f32x4*)(base + 8192); t1 = *(const f32x4*)(base + 8192 + 4);
  o.r[0] = lo2(t0); o.r[1] = hi2(t0); o.r[2] = lo2(t1); o.r[3] = hi2(t1);
  o.v0 = VV[nn * 64 + i0];
}
DEVI void scan_step1(const ScanOps1& o, f32x2 (&S0)[4], float* YL, int nn, int jg, int i0) {
  f32x2 d0 = S0[0] * o.a[0], d0b = S0[2] * o.a[2];
  d0 = S0[1] * o.a[1] + d0; d0b = S0[3] * o.a[3] + d0b;
  d0 += d0b;
  const float sa0 = red8(d0.x + d0.y);
  f32x2 e0 = {0.f, 0.f};
#pragma unroll
  for (int q = 0; q < 4; ++q) {
    const f32x2 u0 = sa0 * o.b[q] + o.v0 * o.k[q];
    S0[q] = S0[q] * o.w[q] + u0;
    e0 = S0[q] * o.r[q] + e0;
  }
  const float y0 = red8(e0.x + e0.y);
  if (jg == 0) YL[nn * 64 + i0] = y0;
}
DEVI float red16d(float x) {
  x += dpp_mov<0xB1>(x);
  x += dpp_mov<0x4E>(x);
  x += dpp_mov<0x141>(x);
  x += dpp_mov<0x140>(x);
  return x;
}
DEVI void unpack4(u32x2 u, float* o) {
  o[0] = __uint_as_float(u.x << 16); o[1] = __uint_as_float(u.x & 0xffff0000u);
  o[2] = __uint_as_float(u.y << 16); o[3] = __uint_as_float(u.y & 0xffff0000u);
}

DEVI void phase_scan8(int tid_, const Params& p, int l, char* smem, int bfirst, int bstride) {
  const u16* PR = (const u16*)(p.ws + OFF_PR);
  _Float16* YF = (_Float16*)(p.ws + OFF_H);
  _Float16* YB = (_Float16*)(p.ws + OFF_H + (size_t)NTOK * 512 * 2);
  float* BON = (float*)(p.ws + OFF_BONUS);
  const u16* WB = (const u16*)(p.ws + OFF_WB);
  float* OPS = (float*)(smem + SC_OPS);
  u16* RAW = (u16*)(smem + SC_OPS);
  float* VV = (float*)(smem + SC_VV);
  float* WR = (float*)(smem + SC_WR);
  float* AP = (float*)(smem + SC_AP);
  float* YL = WR;
  u16* TWb = (u16*)(smem + SC_TW);
  u16* ADb = (u16*)(smem + SC_AD);
  float* NRM = (float*)(smem + SC_NRM);
  float* MU = (float*)(smem + SC_MU);
  float* CST = (float*)(smem + SC_CST);
  const float* mu_p = p.in[I_MU_PREV] + (size_t)l * 1920;
  const float* mu_n = p.in[I_MU_NEXT] + (size_t)l * 1920;
  const int tid = tid_, lane = tid & 63, w = tid >> 6, fr = lane & 15, fq = lane >> 4;
  const int pn = tid >> 4, j0 = (tid & 15) * 4;
  const int jg = lane & 7, i0 = w * 8 + (lane >> 3);
  const int hr = (tid >= 80) ? 1 : 0, hc = tid - hr * 80;
  const int wm = w >> 2, wn = w & 3;
  for (int blk = bfirst; blk < 192; blk += bstride) {
    const int s = blk >> 4, h = (blk >> 1) & 7, d = blk & 1;
    __syncthreads();
    for (int i = tid; i < 640; i += 512) {
      const int which = (i >= 320) ? 1 : 0, c = i - which * 320;
      const int g = c >> 6, e = c & 63;
      const int col = (g < 3) ? (g * 512 + h * 64 + e) : (1536 + (g - 3) * 128 + d * 64 + e);
      MU[i] = which ? mu_n[col] : mu_p[col];
    }
    if (tid < 320) {
      const int which = tid >> 6, e = tid & 63;
      float v;
      if (which == 0) v = p.in[I_W0][(size_t)(l * 2 + d) * 512 + h * 64 + e];
      else if (which == 1) v = p.in[I_A0][(size_t)(l * 2 + d) * 512 + h * 64 + e];
      else if (which == 2) v = p.in[I_K_K][(size_t)l * 512 + h * 64 + e];
      else if (which == 3) v = p.in[I_K_A][(size_t)l * 512 + h * 64 + e];
      else v = p.in[I_R_K][(size_t)(l * 8 + h) * 64 + e];
      CST[tid] = v;
    }
    bf16x8 bw[2], ba[2];
#pragma unroll
    for (int ks = 0; ks < 2; ++ks) {
      bw[ks] = *(const bf16x8*)(WB + W_WUP + (size_t)(d * 512 + h * 64 + wn * 16 + fr) * 64 + ks * 32 + fq * 8);
      ba[ks] = *(const bf16x8*)(WB + W_AUP + (size_t)(d * 512 + h * 64 + wn * 16 + fr) * 64 + ks * 32 + fq * 8);
    }
    _Float16* Y = d ? YB : YF;
    f32x2 S0[4];
#pragma unroll
    for (int q = 0; q < 4; ++q) S0[q] = (f32x2){0.f, 0.f};
    u32x2 G[5], GH;
    {
      const int t = d ? (4095 - pn) : pn;
      const size_t tok = (size_t)s * 4096 + t;
#pragma unroll
      for (int g = 0; g < 5; ++g) {
        const int col = (g < 3) ? (g * 512 + h * 64) : (1536 + (g - 3) * 128 + d * 64);
        G[g] = *(const u32x2*)(PR + tok * PRW + col + j0);
      }
      GH = (u32x2){0u, 0u};
      if (tid < 160) {
        const int tlo = d ? (4095 - 31) : 0;
        const int th = hr ? (tlo + 32) : (tlo - 1);
        const int g = hc >> 4;
        const int col = (g < 3) ? (g * 512 + h * 64) : (1536 + (g - 3) * 128 + d * 64);
        if (th >= 0 && th <= 4095) GH = *(const u32x2*)(PR + ((size_t)s * 4096 + th) * PRW + col + (hc & 15) * 4);
      }
    }
#pragma unroll 1
    for (int ch = 0; ch < 128; ++ch) {
      const int n = ch * 32 + pn;
      const int t = d ? (4095 - n) : n;
      const size_t tok = (size_t)s * 4096 + t;
      const int tlo = d ? (4095 - (ch * 32 + 31)) : (ch * 32);
      const int rrow = t - tlo + 1;
#pragma unroll
      for (int g = 0; g < 5; ++g) *(u32x2*)(RAW + rrow * 320 + g * 64 + j0) = G[g];
      if (tid < 160) *(u32x2*)(RAW + (hr ? 33 : 0) * 320 + (hc >> 4) * 64 + (hc & 15) * 4) = GH;
      __syncthreads();
      if (ch + 1 < 128) {
        const int n2 = n + 32;
        const int t2 = d ? (4095 - n2) : n2;
        const size_t tok2 = (size_t)s * 4096 + t2;
#pragma unroll
        for (int g = 0; g < 5; ++g) {
          const int col = (g < 3) ? (g * 512 + h * 64) : (1536 + (g - 3) * 128 + d * 64);
          G[g] = *(const u32x2*)(PR + tok2 * PRW + col + j0);
        }
        GH = (u32x2){0u, 0u};
        if (tid < 160) {
          const int tlo2 = d ? (tlo - 32) : (tlo + 32);
          const int th = hr ? (tlo2 + 32) : (tlo2 - 1);
          const int g = hc >> 4;
          const int col = (g < 3) ? (g * 512 + h * 64) : (1536 + (g - 3) * 128 + d * 64);
          if (th >= 0 && th <= 4095) GH = *(const u32x2*)(PR + ((size_t)s * 4096 + th) * PRW + col + (hc & 15) * 4);
        }
      }
#pragma unroll
      for (int g = 0; g < 5; ++g) {
        float cur[4], prv[4], nxt[4];
        unpack4(*(const u32x2*)(RAW + rrow * 320 + g * 64 + j0), cur);
        unpack4(*(const u32x2*)(RAW + (rrow - 1) * 320 + g * 64 + j0), prv);
        unpack4(*(const u32x2*)(RAW + (rrow + 1) * 320 + g * 64 + j0), nxt);
        const f32x4 mp0 = *(const f32x4*)(MU + g * 64 + j0);
        const f32x4 mn0 = *(const f32x4*)(MU + 320 + g * 64 + j0);
        f32x4 x0;
#pragma unroll
        for (int e = 0; e < 4; ++e) x0[e] = cur[e] + mp0[e] * (prv[e] - cur[e]) + mn0[e] * (nxt[e] - cur[e]);
        if (g == 0) {
          *(f32x4*)(OPS + 4 * 2048 + pn * 64 + j0) = x0;
        } else if (g == 1) {
          *(f32x4*)(OPS + 3 * 2048 + pn * 64 + j0) = x0;
          const f32x4 kk0 = *(const f32x4*)(CST + 128 + j0);
          float ss = 0.f;
#pragma unroll
          for (int e = 0; e < 4; ++e) { const float a_ = x0[e] * kk0[e]; ss += a_ * a_; }
          ss = red16d(ss);
          if ((tid & 15) == 0) NRM[pn] = frcp(fmaxf(__builtin_amdgcn_sqrtf(ss), 1e-12f));
        } else if (g == 2) {
          *(f32x4*)(VV + pn * 64 + j0) = x0;
        } else if (g == 3) {
          u32x2 pk;
          pk.x = pack2(ftanh(x0[0]), ftanh(x0[1])); pk.y = pack2(ftanh(x0[2]), ftanh(x0[3]));
          *(u32x2*)(TWb + pn * 72 + j0) = pk;
        } else {
          u32x2 pk;
          pk.x = pack2(x0[0], x0[1]); pk.y = pack2(x0[2], x0[3]);
          *(u32x2*)(ADb + pn * 72 + j0) = pk;
        }
      }
      __syncthreads();
      {
        f32x4 cw = {0.f, 0.f, 0.f, 0.f}, ca = {0.f, 0.f, 0.f, 0.f};
#pragma unroll
        for (int ks = 0; ks < 2; ++ks) {
          const bf16x8 aw = *(const bf16x8*)(TWb + (wm * 16 + fr) * 72 + ks * 32 + fq * 8);
          const bf16x8 aa = *(const bf16x8*)(ADb + (wm * 16 + fr) * 72 + ks * 32 + fq * 8);
          cw = __builtin_amdgcn_mfma_f32_16x16x32_bf16(aw, bw[ks], cw, 0, 0, 0);
          ca = __builtin_amdgcn_mfma_f32_16x16x32_bf16(aa, ba[ks], ca, 0, 0, 0);
        }
#pragma unroll
        for (int jj = 0; jj < 4; ++jj) {
          WR[(wm * 16 + fq * 4 + jj) * 64 + wn * 16 + fr] = cw[jj];
          AP[(wm * 16 + fq * 4 + jj) * 64 + wn * 16 + fr] = ca[jj];
        }
      }
      __syncthreads();
      {
        const float inv = NRM[pn];
        float bsum = 0.f;
        const f32x4 wr_ = *(const f32x4*)(WR + pn * 64 + j0) + *(const f32x4*)(CST + j0);
        const f32x4 ap_ = *(const f32x4*)(AP + pn * 64 + j0) + *(const f32x4*)(CST + 64 + j0);
        const f32x4 kr = *(const f32x4*)(OPS + 3 * 2048 + pn * 64 + j0);
        const f32x4 rr = *(const f32x4*)(OPS + 4 * 2048 + pn * 64 + j0);
        const f32x4 kkw = *(const f32x4*)(CST + 128 + j0), kaw = *(const f32x4*)(CST + 192 + j0), rkw = *(const f32x4*)(CST + 256 + j0);
        f32x4 o0, o1, o2, o3;
#pragma unroll
        for (int e = 0; e < 4; ++e) {
          const float sw = sigm(wr_[e]);
          const float dec = __expf(-0.6065306597126334f * sw);
          const float av = sigm(ap_[e]);
          const float kn = kr[e] * kkw[e] * inv;
          const float kd = kr[e] * (1.f + (av - 1.f) * kaw[e]);
          bsum += rr[e] * kd * rkw[e];
          o0[e] = -kn; o1[e] = dec; o2[e] = kn * av; o3[e] = kd;
        }
        *(f32x4*)(OPS + 0 * 2048 + pn * 64 + j0) = o0;
        *(f32x4*)(OPS + 1 * 2048 + pn * 64 + j0) = o1;
        *(f32x4*)(OPS + 2 * 2048 + pn * 64 + j0) = o2;
        *(f32x4*)(OPS + 3 * 2048 + pn * 64 + j0) = o3;
        bsum = red16d(bsum);
        if ((tid & 15) == 0) BON[(tok * 8 + h) * 2 + d] = bsum;
      }
      __syncthreads();
      {
        ScanOps1 oa, ob;
        scan_load1(oa, OPS, VV, 0, jg, i0);
#pragma unroll 1
        for (int nn = 0; nn < 32; nn += 2) {
          scan_load1(ob, OPS, VV, nn + 1, jg, i0);
          scan_step1(oa, S0, YL, nn, jg, i0);
          scan_load1(oa, OPS, VV, (nn + 2) & 31, jg, i0);
          scan_step1(ob, S0, YL, nn + 1, jg, i0);
        }
      }
      __syncthreads();
      {
        typedef __attribute__((ext_vector_type(4))) _Float16 h16x4;
        h16x4 o;
#pragma unroll
        for (int e = 0; e < 4; ++e) o[e] = (_Float16)YL[pn * 64 + j0 + e];
        *(h16x4*)(Y + tok * 512 + h * 64 + j0) = o;
      }
    }
    __syncthreads();
  }
}

DEVI void phase_rwkv_post(int tid_, int vb_, int vg_, const Params& p, int l, char* smem) {
  u16* PR = (u16*)(p.ws + OFF_PR);
  const _Float16* YF = (const _Float16*)(p.ws + OFF_H);
  const _Float16* YB = (const _Float16*)(p.ws + OFF_H + (size_t)NTOK * 512 * 2);
  const float* BON = (const float*)(p.ws + OFF_BONUS);
  const u16* GUPT = (const u16*)(p.ws + OFF_WB) + W_GUP;
  const float* mu_p = p.in[I_MU_PREV] + (size_t)l * 1920;
  const float* mu_n = p.in[I_MU_NEXT] + (size_t)l * 1920;
  const float* gng = p.in[I_GN_G] + (size_t)l * 512;
  const float* gnb = p.in[I_GN_B] + (size_t)l * 512;
  u16* As = (u16*)smem;
  const int tid = tid_, lane = tid & 63, w = tid >> 6, fr = lane & 15, fq = lane >> 4;
  for (int tile = vb_; tile < NTOK / 64; tile += vg_) {
    const size_t tok0 = (size_t)tile * 64;
    {
      const int row = tid >> 2, part = tid & 3;
      const size_t tok = tok0 + row;
      const int t = (int)(tok & 4095);
#pragma unroll
      for (int q = 0; q < 4; ++q) {
        const int col = 1792 + part * 32 + q * 8;
        float cur[8], prv[8], nxt[8];
        load8bf(PR + tok * PRW + col, cur);
        if (t > 0) load8bf(PR + (tok - 1) * PRW + col, prv);
        else {
#pragma unroll
          for (int e = 0; e < 8; ++e) prv[e] = 0.f;
        }
        if (t < 4095) load8bf(PR + (tok + 1) * PRW + col, nxt);
        else {
#pragma unroll
          for (int e = 0; e < 8; ++e) nxt[e] = 0.f;
        }
        float o[8];
#pragma unroll
        for (int e = 0; e < 8; ++e) {
          const float x = cur[e] + mu_p[col + e] * (prv[e] - cur[e]) + mu_n[col + e] * (nxt[e] - cur[e]);
          o[e] = sigm(x);
        }
        u32x4 pk;
        pk.x = pack2(o[0], o[1]); pk.y = pack2(o[2], o[3]); pk.z = pack2(o[4], o[5]); pk.w = pack2(o[6], o[7]);
        *(u32x4*)(As + row * 136 + part * 32 + q * 8) = pk;
      }
    }
    asm volatile("" ::: "memory");
#pragma unroll 1
    for (int chh = 0; chh < 2; ++chh) {
      f32x4 acc[16];
#pragma unroll
      for (int n = 0; n < 16; ++n) acc[n] = (f32x4){0.f, 0.f, 0.f, 0.f};
#pragma unroll
      for (int ks = 0; ks < 4; ++ks) {
        bf16x8 af = *(const bf16x8*)(As + (w * 16 + fr) * 136 + ks * 32 + fq * 8);
#pragma unroll
        for (int n = 0; n < 16; ++n) {
          bf16x8 bg = *(const bf16x8*)(GUPT + (size_t)(chh * 256 + n * 16 + fr) * 128 + ks * 32 + fq * 8);
          acc[n] = __builtin_amdgcn_mfma_f32_16x16x32_bf16(af, bg, acc[n], 0, 0, 0);
        }
      }
#pragma unroll
      for (int hl = 0; hl < 4; ++hl) {
        const int head = chh * 4 + hl;
        asm volatile("" ::: "memory");
#pragma unroll
        for (int j = 0; j < 4; ++j) {
          const size_t tok = tok0 + w * 16 + fq * 4 + j;
          const int t = (int)(tok & 4095);
          float o[4], sum = 0.f;
#pragma unroll
          for (int q = 0; q < 4; ++q) {
            const int col = head * 64 + q * 16 + fr;
            o[q] = (float)YF[tok * 512 + col] + (float)YB[tok * 512 + col];
            sum += o[q];
          }
          const float mean = red16_sum(sum) * (1.f / 64.f);
          float vs = 0.f;
#pragma unroll
          for (int q = 0; q < 4; ++q) { const float dlt = o[q] - mean; vs += dlt * dlt; }
          const float var = red16_sum(vs) * (1.f / 64.f);
          const float rstd = rsqrtf(var + 64e-5f);
          const float bon = BON[(tok * 8 + head) * 2] + BON[(tok * 8 + head) * 2 + 1];
#pragma unroll
          for (int q = 0; q < 4; ++q) {
            const int col = head * 64 + q * 16 + fr;
            const int vc = 1024 + col;
            const float cur = bf2f(PR[tok * PRW + vc]);
            const float prv = (t > 0) ? bf2f(PR[(tok - 1) * PRW + vc]) : 0.f;
            const float nxt = (t < 4095) ? bf2f(PR[(tok + 1) * PRW + vc]) : 0.f;
            const float vsh = cur + mu_p[vc] * (prv - cur) + mu_n[vc] * (nxt - cur);
            const float yv = ((o[q] - mean) * rstd * gng[col] + gnb[col] + bon * vsh) * acc[hl * 4 + q][j];
            PR[tok * PRW + col] = f2bf(yv);
          }
        }
      }
    }
  }
}

DEVI f32x4 ld4bf(const u16* p) {
  const u32x2 u = *(const u32x2*)p;
  f32x4 o;
  o[0] = __uint_as_float(u.x << 16); o[1] = __uint_as_float(u.x & 0xffff0000u);
  o[2] = __uint_as_float(u.y << 16); o[3] = __uint_as_float(u.y & 0xffff0000u);
  return o;
}

DEVI void phase_merge(int tid_, const Params& p, char* smem) {
  const u16* WB = (const u16*)(p.ws + OFF_WB);
  const u16* H = (const u16*)(p.ws + OFF_NK);
  u16* PR = (u16*)(p.ws + OFF_PR);
  const u16* NQ = (const u16*)(p.ws + OFF_NQ);
  u16* TMP = (u16*)(p.ws + OFF_H);
  const int lane = tid_ & 63, wid = tid_ >> 6;
  const int wr = wid >> 2, wc = wid & 3, fr = lane & 15, fq = lane >> 4;
  const bool xmap = (gridDim.x & 7) == 0;
  const int xcd = blockIdx.x & 7;
  const int first = xmap ? (int)(blockIdx.x >> 3) : (int)blockIdx.x;
  const int stride = xmap ? (int)(gridDim.x >> 3) : (int)gridDim.x;
  const int count = xmap ? 24 * 4 : 192 * 4;
  for (int it = first; it < count; it += stride) {
    const int tm = xmap ? (it >> 2) * 8 + xcd : (it >> 2), tn = it & 3;
    const int m0 = tm << 8, n0 = tn << 8;
    f32x4 acc[8][4];
#define MERGE_ZERO() _Pragma("unroll") for (int m = 0; m < 8; ++m) _Pragma("unroll") for (int n = 0; n < 4; ++n) acc[m][n] = (f32x4){0.f, 0.f, 0.f, 0.f}
#define MERGE_RC() const int r = m0 + wr * 128 + m * 16 + fr, c0 = n0 + wc * 64 + n * 16 + fq * 4
    MERGE_ZERO();
    gemm_kloop8<true>(launder(tid_), acc, H + (size_t)m0 * 1024, 1024, WB + W_IN + (size_t)(3456 + n0) * 1024, 1024, 1024, smem);
#pragma unroll
    for (int m = 0; m < 8; ++m)
#pragma unroll
      for (int n = 0; n < 4; ++n) {
        MERGE_RC();
        f32x4 o;
#pragma unroll
        for (int j = 0; j < 4; ++j) o[j] = sigm(acc[m][n][j]);
        store4bf(PR + (size_t)r * PRW + 512 + c0, o);
      }
    MERGE_ZERO();
    gemm_kloop8<true>(launder(tid_), acc, PR + (size_t)m0 * PRW, PRW, WB + W_BRR + (size_t)n0 * 512, 512, 512, smem);
#pragma unroll
    for (int m = 0; m < 8; ++m)
#pragma unroll
      for (int n = 0; n < 4; ++n) {
        MERGE_RC();
        u16* dst = PR + (size_t)r * PRW + 512 + c0;
        store4bf(dst, ld4bf(dst) * acc[m][n]);
      }
    MERGE_ZERO();
    gemm_kloop8<true>(launder(tid_), acc, H + (size_t)m0 * 1024, 1024, WB + W_IN + (size_t)(4480 + n0) * 1024, 1024, 1024, smem);
#pragma unroll
    for (int m = 0; m < 8; ++m)
#pragma unroll
      for (int n = 0; n < 4; ++n) {
        MERGE_RC();
        f32x4 o;
#pragma unroll
        for (int j = 0; j < 4; ++j) o[j] = sigm(acc[m][n][j]);
        store4bf(TMP + (size_t)r * 1024 + c0, o);
      }
    MERGE_ZERO();
    gemm_kloop8<true>(launder(tid_), acc, NQ + (size_t)m0 * 512, 512, WB + W_BRN + (size_t)n0 * 512, 512, 512, smem);
#pragma unroll
    for (int m = 0; m < 8; ++m)
#pragma unroll
      for (int n = 0; n < 4; ++n) {
        MERGE_RC();
        u16* dst = PR + (size_t)r * PRW + 512 + c0;
        store4bf(dst, ld4bf(dst) + ld4bf(TMP + (size_t)r * 1024 + c0) * acc[m][n]);
      }
#undef MERGE_ZERO
#undef MERGE_RC
  }
}

DEVI float red4x_sum(float v) { v += __shfl_xor(v, 16); v += __shfl_xor(v, 32); return v; }
DEVI float red4x_max(float v) { v = fmaxf(v, __shfl_xor(v, 16)); v = fmaxf(v, __shfl_xor(v, 32)); return v; }

DEVI void phase_xattn(int tid_, int vb_, int vg_, const Params& p, char* smem) {
  const u16* Q = (const u16*)(p.ws + OFF_PR);
  u16* O = (u16*)(p.ws + OFF_NQ);
  const u16* KVK = (const u16*)(p.ws + OFF_KVK);
  const u16* KVT = (const u16*)(p.ws + OFF_KVT);
  const int lane = tid_ & 63, w = tid_ >> 6, fr = lane & 15, fq = lane >> 4;
  u16* Pw = (u16*)smem + w * (32 * 264);
  for (int t = vb_; t < (NTOK / 128) * 4; t += vg_) {
    const int hh = t & 3;
    const size_t tok0 = (size_t)(t >> 2) * 128 + w * 32;
    const int s = (int)(tok0 >> 12);
    f32x4 acc[2][16];
#pragma unroll
    for (int mt = 0; mt < 2; ++mt)
#pragma unroll
      for (int n = 0; n < 16; ++n) acc[mt][n] = (f32x4){0.f, 0.f, 0.f, 0.f};
#pragma unroll 1
    for (int ks = 0; ks < 8; ++ks) {
      const bf16x8 aq0 = *(const bf16x8*)(Q + (tok0 + fr) * 1024 + hh * 256 + ks * 32 + fq * 8);
      const bf16x8 aq1 = *(const bf16x8*)(Q + (tok0 + 16 + fr) * 1024 + hh * 256 + ks * 32 + fq * 8);
#pragma unroll
      for (int n = 0; n < 16; ++n) {
        const bf16x8 bk = *(const bf16x8*)(KVK + (size_t)(s * 256 + n * 16 + fr) * 1024 + hh * 256 + ks * 32 + fq * 8);
        acc[0][n] = __builtin_amdgcn_mfma_f32_16x16x32_bf16(bk, aq0, acc[0][n], 0, 0, 0);
        acc[1][n] = __builtin_amdgcn_mfma_f32_16x16x32_bf16(bk, aq1, acc[1][n], 0, 0, 0);
      }
    }
    float sm[2];
#pragma unroll
    for (int mt = 0; mt < 2; ++mt) {
      float m = -1e30f;
#pragma unroll
      for (int n = 0; n < 16; ++n)
#pragma unroll
        for (int j = 0; j < 4; ++j) m = fmaxf(m, acc[mt][n][j]);
      m = red4x_max(m) * 0.0625f;
      float ssum = 0.f;
#pragma unroll
      for (int n = 0; n < 16; ++n) {
        f32x4 e;
#pragma unroll
        for (int j = 0; j < 4; ++j) { e[j] = __expf(acc[mt][n][j] * 0.0625f - m); ssum += e[j]; }
        store4bf(Pw + (mt * 16 + fr) * 264 + n * 16 + fq * 4, e);
      }
      sm[mt] = 1.f / red4x_sum(ssum);
    }
#pragma unroll
    for (int mt = 0; mt < 2; ++mt)
#pragma unroll
      for (int n = 0; n < 16; ++n) acc[mt][n] = (f32x4){0.f, 0.f, 0.f, 0.f};
#pragma unroll 1
    for (int ks = 0; ks < 8; ++ks) {
      const bf16x8 ap0 = *(const bf16x8*)(Pw + fr * 264 + ks * 32 + fq * 8);
      const bf16x8 ap1 = *(const bf16x8*)(Pw + (16 + fr) * 264 + ks * 32 + fq * 8);
#pragma unroll
      for (int n = 0; n < 16; ++n) {
        const bf16x8 bv = *(const bf16x8*)(KVT + (size_t)(s * 1024 + hh * 256 + n * 16 + fr) * 256 + ks * 32 + fq * 8);
        acc[0][n] = __builtin_amdgcn_mfma_f32_16x16x32_bf16(bv, ap0, acc[0][n], 0, 0, 0);
        acc[1][n] = __builtin_amdgcn_mfma_f32_16x16x32_bf16(bv, ap1, acc[1][n], 0, 0, 0);
      }
    }
#pragma unroll
    for (int mt = 0; mt < 2; ++mt)
#pragma unroll
      for (int n = 0; n < 16; ++n)
        store4bf(O + (tok0 + mt * 16 + fr) * 1024 + hh * 256 + n * 16 + fq * 4, acc[mt][n] * sm[mt]);
  }
}

constexpr int HALF_SMEM = 78720;

DEVI void run_phase(int tid_, const Params& p, int ph, char* smem) {
  const int half = tid_ >> 8, vt = tid_ & 255;
  const int vb_ = blockIdx.x * 2 + half, vg_ = gridDim.x * 2;
  char* smh = smem + half * HALF_SMEM;
  if (ph == 2 * NPH_LAYER) { phase_final_norm(vt, vb_, vg_, p); return; }
  const int l = ph / NPH_LAYER, q = ph % NPH_LAYER;
  u16* WB = (u16*)(p.ws + OFF_WB);
  u16* H = (u16*)(p.ws + OFF_H);
  u16* PR = (u16*)(p.ws + OFF_PR);
  u16* NQ = (u16*)(p.ws + OFF_NQ);
  float* X = p.X;
  auto epi_res = [&](int r, int c0, f32x4 v) {
    f32x4* px = (f32x4*)(X + (size_t)r * 1024 + c0);
    *px = *px + v;
  };
  constexpr int NONS = 1 << 30;
  switch (q) {
    case 0:
      phase_conv(vt, vb_, vg_, p, l, smh);
      phase_norm(vt, vb_, vg_, p, p.in[I_NORM_MIX] + (size_t)l * 1024, l == 0);
      phase_norm_mem(vt, vb_, vg_, p, p.in[I_NORM_MEM] + (size_t)l * 1024);
      break;
    case 1: phase_p_gemm(tid_, p, smem); break;
    case 2:
      if (gridDim.x >= 224) {
        if (blockIdx.x < 192) phase_scan8(tid_, p, l, smem, blockIdx.x, gridDim.x);
        else phase_nat(vt, p, l, smh, vb_ - 384, vg_ - 384);
      } else {
        phase_scan(vt, p, l, smh, vb_, vg_);
        __syncthreads();
        phase_nat(vt, p, l, smh, vb_, vg_);
      }
      break;
    case 3:
      phase_rwkv_post(vt, vb_, vg_, p, l, smh);
      phase_norm(vt, vb_, vg_, p, p.in[I_NORM_MIX] + (size_t)l * 1024, false, OFF_NK);
      break;
    case 4: phase_merge(tid_, p, smem); break;
    case 5: gemm_phase8(tid_, PR + 512, PRW, WB + W_OUT, 1024, 1024, NTOK, 1024, smem, NONS, epi_res, NoEpi()); break;
    case 6: phase_norm(vt, vb_, vg_, p, p.in[I_NORM_X] + (size_t)l * 1024, false); break;
    case 7:
      gemm_phase8(tid_, H, 1024, WB + W_XQ, 1024, 1024, NTOK, 1024, smem, NONS,
                 [&](int r, int c0, f32x4 v) { store4bf(PR + (size_t)r * 1024 + c0, v); }, NoEpi());
      break;
    case 8: phase_xattn(vt, vb_, vg_, p, smh); break;
    case 9: gemm_phase8(tid_, NQ, 1024, WB + W_XO, 1024, 1024, NTOK, 1024, smem, NONS, epi_res, NoEpi()); break;
    case 10: phase_norm(vt, vb_, vg_, p, p.in[I_NORM_FF] + (size_t)l * 1024, false); break;
    case 11:
    case 13: {
      const int hf = (q == 13);
      gemm_phase8(tid_, H, 1024, WB + W_FF1 + (size_t)hf * 2048 * 1024, 1024, 1024, NTOK, 2048, smem, NONS,
                 [&](int r, int c0, f32x4 v) {
                   f32x4 o;
#pragma unroll
                   for (int j = 0; j < 4; ++j) { const float x = fmaxf(v[j], 0.f); o[j] = x * x; }
                   store4bf(PR + (size_t)r * 2048 + c0, o);
                 }, NoEpi());
    } break;
    case 12:
    case 14: {
      const int hf = (q == 14);
      gemm_phase8(tid_, PR, 2048, WB + W_FF2 + (size_t)hf * 2048, 4096, 2048, NTOK, 1024, smem, NONS, epi_res, NoEpi());
    } break;
  }
}

#define XB_TMO      128
#define XB_XCNT(j)  (256  + 64 * (j))
#define XB_XSUB(j)  (1280 + 64 * (j))
#define XB_XGEN(j)  (2304 + 64 * (j))
#define XB_TOP      3328
#define XB_TOPGEN   3392
#define XCD_BAR_WORDS 3456
#define XB_SPIN_CAP (1u << 20)
#define LAS __attribute__((address_space(3)))

DEVI unsigned xb_ld(unsigned* p) { return __hip_atomic_load(p, __ATOMIC_RELAXED, __HIP_MEMORY_SCOPE_AGENT); }
DEVI unsigned xb_add(unsigned* p, unsigned v) { return __hip_atomic_fetch_add(p, v, __ATOMIC_RELAXED, __HIP_MEMORY_SCOPE_AGENT); }
DEVI unsigned xb_xcc_id() { return (unsigned)__builtin_amdgcn_s_getreg((3 << 11) | 20) & 0xFu; }
#define XB_SPIN(cond, bar) do { unsigned _sp = 0; while (cond) { __builtin_amdgcn_s_sleep(1); \
    if ((++_sp & 255u) == 0u) { if (xb_ld(&(bar)[XB_TMO])) break; if (_sp > XB_SPIN_CAP) { atomicAdd(&(bar)[XB_TMO], 1u); break; } } } } while (0)

struct XcdBarrier {
  unsigned* bar; unsigned x;
  volatile LAS unsigned* st;
};
DEVI XcdBarrier xcd_barrier_post(unsigned* bar, volatile LAS unsigned* st) {
  XcdBarrier b; b.bar = bar; b.x = xb_xcc_id(); b.st = st;
  if (threadIdx.x == 0) (void)xb_add(&bar[XB_XCNT(b.x)], 1u);
  return b;
}
DEVI void xcd_barrier_complete(unsigned* bar, unsigned x, unsigned& nloc, unsigned& nx) {
  const unsigned G = gridDim.x * gridDim.y * gridDim.z;
  unsigned sum, cnt, mine, sp = 0u;
  for (;;) {
    sum = 0u; cnt = 0u; mine = 0u;
#pragma unroll
    for (unsigned j = 0; j < 16; ++j) { const unsigned c = xb_ld(&bar[XB_XCNT(j)]); sum += c; cnt += (c > 0u) ? 1u : 0u; mine = (j == x) ? c : mine; }
    if (sum == G) break;
    __builtin_amdgcn_s_sleep(1);
    if ((++sp & 255u) == 0u) { if (xb_ld(&bar[XB_TMO])) break; if (sp > XB_SPIN_CAP) { atomicAdd(&bar[XB_TMO], 1u); break; } }
  }
  nloc = mine > 0u ? mine : 1u; nx = cnt > 0u ? cnt : 1u;
}
DEVI void xcd_barrier(const XcdBarrier& b) {
  asm volatile("s_waitcnt vmcnt(0)" ::: "memory");
  __syncthreads();
  if (threadIdx.x == 0) {
    unsigned* bar = b.bar;
    __builtin_amdgcn_s_waitcnt(0);
    unsigned nloc = b.st[0], nx = b.st[1];
    if (nloc == 0u) { xcd_barrier_complete(bar, b.x, nloc, nx); b.st[0] = nloc; b.st[1] = nx; }
    const unsigned old = xb_add(&bar[XB_XSUB(b.x)], 1u);
    const unsigned gen = old / nloc;
    if (old + 1u == (gen + 1u) * nloc) {
      __builtin_amdgcn_fence(__ATOMIC_RELEASE, "agent");
      asm volatile("s_waitcnt vmcnt(0)" ::: "memory");
      const unsigned og = xb_add(&bar[XB_TOP], 1u);
      const unsigned tg = og / nx;
      if (og + 1u == (tg + 1u) * nx) xb_add(&bar[XB_TOPGEN], 1u);
      else XB_SPIN(xb_ld(&bar[XB_TOPGEN]) == tg, bar);
      __builtin_amdgcn_fence(__ATOMIC_ACQUIRE, "agent");
      xb_add(&bar[XB_XGEN(b.x)], 1u);
      asm volatile("s_waitcnt vmcnt(0)" ::: "memory");
    } else {
      XB_SPIN(xb_ld(&bar[XB_XGEN(b.x)]) == gen, bar);
      __builtin_amdgcn_fence(__ATOMIC_ACQUIRE, "agent");
      asm volatile("s_waitcnt vmcnt(0)" ::: "memory");
    }
  }
  __syncthreads();
}

__global__ void __launch_bounds__(512, 2) mega_kernel(Params p, int ph0, int ph1) {
  __shared__ __attribute__((aligned(16))) char smem[2 * HALF_SMEM];
  __shared__ __attribute__((aligned(16))) unsigned xb_words[4];
  if (threadIdx.x == 0) { xb_words[0] = 0u; xb_words[1] = 0u; xb_words[2] = 0u; xb_words[3] = 0u; }
  __syncthreads();
  XcdBarrier xb = xcd_barrier_post((unsigned*)(p.ws + OFF_BAR), (volatile LAS unsigned*)xb_words);
  for (int ph = ph0; ph < ph1; ++ph) {
    if (ph == ph0 + 1) cg::this_grid().sync();
    else if (ph > ph0) xcd_barrier(xb);
    int tid_ = threadIdx.x;
    asm volatile("" : "+v"(tid_));
    run_phase(tid_, p, ph, smem);
  }
}

extern "C" void kernel_launch(void* const* d_in, const int* in_sizes, int n_in, void* d_out, int out_size, void* d_ws,
                              size_t ws_size, hipStream_t stream) {
  if (ws_size < WS_NEED || n_in < 31) return;
  Params p{};
  for (int i = 0; i < 31; ++i) p.in[i] = (const float*)d_in[i];
  p.X = (float*)d_out;
  p.ws = (char*)d_ws;
  static int grid_blocks = 0;
  if (!grid_blocks) {
    int dev = 0, cus = 0, per_cu = 0;
    hipGetDevice(&dev);
    hipDeviceGetAttribute(&cus, hipDeviceAttributeMultiprocessorCount, dev);
    hipOccupancyMaxActiveBlocksPerMultiprocessor(&per_cu, mega_kernel, 512, 0);
    if (per_cu > 1) per_cu = 1;
    if (per_cu < 1) per_cu = 1;
    grid_blocks = cus * per_cu;
  }
  hipMemsetAsync((char*)d_ws + OFF_BAR, 0, 16384, stream);
  int ph0 = 0, ph1 = NPHASES;
  void* args[] = {&p, &ph0, &ph1};
  hipLaunchCooperativeKernel((void*)mega_kernel, dim3(grid_blocks), dim3(512), args, 0, stream);
}
```

```cpp
#include <hip/hip_runtime.h>
#include <hip/hip_cooperative_groups.h>
#include <stdint.h>
namespace cg = cooperative_groups;

typedef unsigned short u16;
typedef __attribute__((ext_vector_type(8))) short bf16x8;
typedef __attribute__((ext_vector_type(4))) float f32x4;
typedef __attribute__((ext_vector_type(8))) _Float16 h16x8;
typedef __attribute__((ext_vector_type(4))) unsigned int u32x4;
typedef __attribute__((ext_vector_type(2))) unsigned int u32x2;

#define DEVI __device__ __forceinline__

constexpr int NTOK = 49152;
constexpr int SEQ_T = 4096;
constexpr int PRW = 1920;
constexpr int NPH_LAYER = 15;
constexpr int NPHASES = 2 * NPH_LAYER + 1;
constexpr int SMEM_BYTES = 78720;

constexpr size_t OFF_WB = 0;
constexpr size_t WB_BYTES = 20512768ull * 2;
constexpr size_t OFF_H = OFF_WB + WB_BYTES;
constexpr size_t OFF_PR = OFF_H + (size_t)NTOK * 1024 * 2;
constexpr size_t OFF_NQ = OFF_PR + (size_t)NTOK * PRW * 2;
constexpr size_t OFF_NK = OFF_NQ + (size_t)NTOK * 512 * 2;
constexpr size_t OFF_NV = OFF_NK + (size_t)NTOK * 512 * 2;
constexpr size_t OFF_KVK = OFF_NV + (size_t)NTOK * 512 * 2;
constexpr size_t OFF_KVT = OFF_KVK + (size_t)3072 * 1024 * 2;
constexpr size_t OFF_MEMH = OFF_KVT + (size_t)3072 * 1024 * 2;
constexpr size_t OFF_BONUS = OFF_MEMH + (size_t)3072 * 1024 * 2;
constexpr size_t OFF_BAR = OFF_BONUS + (size_t)NTOK * 16 * 4;
constexpr size_t WS_NEED = OFF_BAR + 16384;

constexpr size_t W_IN = 0;
constexpr size_t W_BRR = W_IN + (size_t)5504 * 1024;
constexpr size_t W_BRN = W_BRR + (size_t)1024 * 512;
constexpr size_t W_OUT = W_BRN + (size_t)1024 * 512;
constexpr size_t W_XQ = W_OUT + (size_t)1024 * 1024;
constexpr size_t W_XKV = W_XQ + (size_t)1024 * 1024;
constexpr size_t W_XO = W_XKV + (size_t)2048 * 1024;
constexpr size_t W_FF1 = W_XO + (size_t)1024 * 1024;
constexpr size_t W_FF2 = W_FF1 + (size_t)4096 * 1024;
constexpr size_t W_GUP = W_FF2 + (size_t)4096 * 1024;
constexpr size_t W_WUP = W_GUP + (size_t)512 * 128;
constexpr size_t W_AUP = W_WUP + (size_t)2 * 512 * 64;

enum { I_XP = 0, I_XS, I_MP, I_MS, I_NORM_MIX, I_W_IN, I_MU_PREV, I_MU_NEXT, I_W0, I_W_UP, I_A0, I_A_UP,
       I_G_UP, I_K_K, I_K_A, I_R_K, I_GN_G, I_GN_B, I_RPB, I_W_BR_RWKV, I_W_BR_NAT, I_W_OUT, I_NORM_X,
       I_NORM_MEM, I_W_XQ, I_W_XKV, I_W_XO, I_NORM_FF, I_W_FF1, I_W_FF2, I_NORM_FINAL };

struct Params {
  const float* in[31];
  float* X;
  char* ws;
};

DEVI u16 f2bf(float f) {
  uint32_t u = __float_as_uint(f);
  u += 0x7FFFu + ((u >> 16) & 1u);
  return (u16)(u >> 16);
}
DEVI float bf2f(u16 h) { return __uint_as_float(((uint32_t)h) << 16); }
DEVI uint32_t pack2(float a, float b) { return (uint32_t)f2bf(a) | ((uint32_t)f2bf(b) << 16); }
DEVI float frcp(float x) { return __builtin_amdgcn_rcpf(x); }
DEVI float sigm(float x) { return frcp(1.f + __expf(-x)); }
DEVI float ftanh(float x) { return 1.f - 2.f * frcp(__expf(2.f * x) + 1.f); }
DEVI void unpack8(u32x4 u, float* o) {
  o[0] = __uint_as_float(u.x << 16); o[1] = __uint_as_float(u.x & 0xffff0000u);
  o[2] = __uint_as_float(u.y << 16); o[3] = __uint_as_float(u.y & 0xffff0000u);
  o[4] = __uint_as_float(u.z << 16); o[5] = __uint_as_float(u.z & 0xffff0000u);
  o[6] = __uint_as_float(u.w << 16); o[7] = __uint_as_float(u.w & 0xffff0000u);
}
DEVI void load8bf(const u16* p, float* o) { unpack8(*(const u32x4*)p, o); }
DEVI float wave_sum(float v) {
  v += __shfl_xor(v, 32); v += __shfl_xor(v, 16); v += __shfl_xor(v, 8);
  v += __shfl_xor(v, 4); v += __shfl_xor(v, 2); v += __shfl_xor(v, 1);
  return v;
}
DEVI float red4x_sum(float v) { v += __shfl_xor(v, 16); v += __shfl_xor(v, 32); return v; }
DEVI float red4x_max(float v) { v = fmaxf(v, __shfl_xor(v, 16)); v = fmaxf(v, __shfl_xor(v, 32)); return v; }
DEVI float red16_sum(float v) {
  v += __shfl_xor(v, 1); v += __shfl_xor(v, 2); v += __shfl_xor(v, 4); v += __shfl_xor(v, 8);
  return v;
}
DEVI float red16_max(float v) {
  v = fmaxf(v, __shfl_xor(v, 1)); v = fmaxf(v, __shfl_xor(v, 2));
  v = fmaxf(v, __shfl_xor(v, 4)); v = fmaxf(v, __shfl_xor(v, 8));
  return v;
}

DEVI void conv_tile(int tid_, const float* src, int K, int N, u16* dst, int tile, char* smem) {
  float (*s)[65] = (float (*)[65])smem;
  const int nN = N >> 6;
  const int tk = tile / nN, tn = tile - tk * nN;
  const int tx = tid_ & 63, ty = tid_ >> 6;
  for (int r = ty; r < 64; r += 4) s[r][tx] = src[(size_t)(tk * 64 + r) * N + tn * 64 + tx];
  __syncthreads();
  for (int r = ty; r < 64; r += 4) dst[(size_t)(tn * 64 + r) * K + tk * 64 + tx] = f2bf(s[tx][r]);
  __syncthreads();
}

DEVI void phase_conv(int tid_, int vb_, int vg_, const Params& p, int l, char* smem) {
  u16* WB = (u16*)(p.ws + OFF_WB);
  const int c0 = 1376, c1 = c0 + 128, c2 = c1 + 128, c3 = c2 + 256, c4 = c3 + 256, c5 = c4 + 512,
            c6 = c5 + 256, c7 = c6 + 1024, c8 = c7 + 1024, c9 = c8 + 16, c10 = c9 + 16, c11 = c10 + 16;
  for (int t = vb_; t < c11; t += vg_) {
    if (t < c0) conv_tile(tid_, p.in[I_W_IN] + (size_t)l * 1024 * 5504, 1024, 5504, WB + W_IN, t, smem);
    else if (t < c1) conv_tile(tid_, p.in[I_W_BR_RWKV] + (size_t)l * 512 * 1024, 512, 1024, WB + W_BRR, t - c0, smem);
    else if (t < c2) conv_tile(tid_, p.in[I_W_BR_NAT] + (size_t)l * 512 * 1024, 512, 1024, WB + W_BRN, t - c1, smem);
    else if (t < c3) conv_tile(tid_, p.in[I_W_OUT] + (size_t)l * 1024 * 1024, 1024, 1024, WB + W_OUT, t - c2, smem);
    else if (t < c4) conv_tile(tid_, p.in[I_W_XQ] + (size_t)l * 1024 * 1024, 1024, 1024, WB + W_XQ, t - c3, smem);
    else if (t < c5) conv_tile(tid_, p.in[I_W_XKV] + (size_t)l * 1024 * 2048, 1024, 2048, WB + W_XKV, t - c4, smem);
    else if (t < c6) conv_tile(tid_, p.in[I_W_XO] + (size_t)l * 1024 * 1024, 1024, 1024, WB + W_XO, t - c5, smem);
    else if (t < c7) conv_tile(tid_, p.in[I_W_FF1] + (size_t)l * 1024 * 4096, 1024, 4096, WB + W_FF1, t - c6, smem);
    else if (t < c8) conv_tile(tid_, p.in[I_W_FF2] + (size_t)l * 4096 * 1024, 4096, 1024, WB + W_FF2, t - c7, smem);
    else if (t < c9) conv_tile(tid_, p.in[I_G_UP] + (size_t)l * 128 * 512, 128, 512, WB + W_GUP, t - c8, smem);
    else if (t < c10) { const int dd = (t - c9) >> 3; conv_tile(tid_, p.in[I_W_UP] + (size_t)(l * 2 + dd) * 64 * 512, 64, 512, WB + W_WUP + (size_t)dd * 512 * 64, (t - c9) & 7, smem); }
    else { const int dd = (t - c10) >> 3; conv_tile(tid_, p.in[I_A_UP] + (size_t)(l * 2 + dd) * 64 * 512, 64, 512, WB + W_AUP + (size_t)dd * 512 * 64, (t - c10) & 7, smem); }
  }
}

DEVI void norm_row_bf16(int tid_, const float* src, const float* g, u16* dst, float* xcopy) {
  const int lane = tid_ & 63;
  float4 v[4];
  float ss = 0.f;
#pragma unroll
  for (int i = 0; i < 4; ++i) {
    v[i] = ((const float4*)src)[lane + i * 64];
    ss += v[i].x * v[i].x + v[i].y * v[i].y + v[i].z * v[i].z + v[i].w * v[i].w;
  }
  ss = wave_sum(ss);
  const float rs = rsqrtf(ss * (1.f / 1024.f) + 1e-6f);
#pragma unroll
  for (int i = 0; i < 4; ++i) {
    float4 gg = ((const float4*)g)[lane + i * 64];
    u32x2 o;
    o.x = pack2(v[i].x * rs * gg.x, v[i].y * rs * gg.y);
    o.y = pack2(v[i].z * rs * gg.z, v[i].w * rs * gg.w);
    ((u32x2*)dst)[lane + i * 64] = o;
    if (xcopy) ((float4*)xcopy)[lane + i * 64] = v[i];
  }
}

DEVI void phase_norm(int tid_, int vb_, int vg_, const Params& p, const float* g, bool from_input, size_t hoff = OFF_H) {
  u16* H = (u16*)(p.ws + hoff);
  const int wid = tid_ >> 6;
  for (int r = vb_ * 4 + wid; r < NTOK; r += vg_ * 4) {
    const float* src;
    if (from_input) src = (r < 32768) ? p.in[I_XP] + (size_t)r * 1024 : p.in[I_XS] + (size_t)(r - 32768) * 1024;
    else src = p.X + (size_t)r * 1024;
    norm_row_bf16(tid_, src, g, H + (size_t)r * 1024, from_input ? p.X + (size_t)r * 1024 : nullptr);
  }
}
DEVI void phase_norm_mem(int tid_, int vb_, int vg_, const Params& p, const float* g) {
  u16* MH = (u16*)(p.ws + OFF_MEMH);
  const int wid = tid_ >> 6;
  for (int r = vb_ * 4 + wid; r < 3072; r += vg_ * 4) {
    const float* src = (r < 2048) ? p.in[I_MP] + (size_t)r * 1024 : p.in[I_MS] + (size_t)(r - 2048) * 1024;
    norm_row_bf16(tid_, src, g, MH + (size_t)r * 1024, nullptr);
  }
}
DEVI void phase_final_norm(int tid_, int vb_, int vg_, const Params& p) {
  const float* g = p.in[I_NORM_FINAL];
  const int wid = tid_ >> 6, lane = tid_ & 63;
  for (int r = vb_ * 4 + wid; r < NTOK; r += vg_ * 4) {
    float* row = p.X + (size_t)r * 1024;
    float4 v[4];
    float ss = 0.f;
#pragma unroll
    for (int i = 0; i < 4; ++i) {
      v[i] = ((const float4*)row)[lane + i * 64];
      ss += v[i].x * v[i].x + v[i].y * v[i].y + v[i].z * v[i].z + v[i].w * v[i].w;
    }
    ss = wave_sum(ss);
    const float rs = rsqrtf(ss * (1.f / 1024.f) + 1e-6f);
#pragma unroll
    for (int i = 0; i < 4; ++i) {
      float4 gg = ((const float4*)g)[lane + i * 64];
      float4 o;
      o.x = v[i].x * rs * gg.x; o.y = v[i].y * rs * gg.y; o.z = v[i].z * rs * gg.z; o.w = v[i].w * rs * gg.w;
      ((float4*)row)[lane + i * 64] = o;
    }
  }
}

template <int OFF>
DEVI bf16x8 lds_rd128(uint32_t addr) {
  bf16x8 r;
  asm volatile("ds_read_b128 %0, %1 offset:%2" : "=v"(r) : "v"(addr), "n"(OFF));
  return r;
}

template <int NW, bool SWAP>
DEVI void gemm_kloop(int tid_, f32x4 (&acc)[4][NW], const u16* __restrict__ A, int lda, const u16* __restrict__ Bt, int ldb,
                     int K, char* smem) {
  constexpr int STG = 8192 + NW * 2048;
  constexpr int NB = NW / 2;
  const int tid = tid_, lane = tid & 63, wid = tid >> 6;
  const int wr = wid >> 1, wc = wid & 1, fr = lane & 15, fq = lane >> 4;
  const int lrow = lane >> 2, lphys = lane & 3, lhi = lane >> 4;
  const int gsw = (4 - lhi) & 3;
  const u16* ga[2];
  const u16* gb[NB];
#pragma unroll
  for (int q = 0; q < 2; ++q) ga[q] = A + (size_t)((wid * 2 + q) * 16 + lrow) * lda + (lphys ^ gsw) * 8;
#pragma unroll
  for (int q = 0; q < NB; ++q) gb[q] = Bt + (size_t)((wid * NB + q) * 16 + lrow) * ldb + (lphys ^ gsw) * 8;
  const int rsw = (4 - ((fr >> 2) & 3)) & 3;
  const int ch = (fq ^ rsw) * 16;
  const int nk = K >> 5;
  const uint32_t lds_base = (uint32_t)(size_t)(__attribute__((address_space(3))) char*)smem;
  const uint32_t aoff = (uint32_t)((wr * 64 + fr) * 64 + ch);
  const uint32_t boff = (uint32_t)(8192 + (wc * 16 * NW + fr) * 64 + ch);
  asm volatile("s_waitcnt vmcnt(0)" ::: "memory");
  __syncthreads();
#define GEMM_ISSUE(kt_)                                                                                              \
  do {                                                                                                               \
    char* nb_ = smem + ((kt_) & 3) * STG;                                                                            \
    _Pragma("unroll") for (int q = 0; q < 2; ++q) __builtin_amdgcn_global_load_lds(                                  \
        (const unsigned*)(ga[q] + (kt_) * 32),                                                                       \
        (__attribute__((address_space(3))) unsigned*)(nb_ + (wid * 2 + q) * 1024 + lane * 16), 16, 0, 0);            \
    _Pragma("unroll") for (int q = 0; q < NB; ++q) __builtin_amdgcn_global_load_lds(                                 \
        (const unsigned*)(gb[q] + (kt_) * 32),                                                                       \
        (__attribute__((address_space(3))) unsigned*)(nb_ + 8192 + (wid * NB + q) * 1024 + lane * 16), 16, 0, 0);    \
  } while (0)
  GEMM_ISSUE(0);
  if (nk > 1) GEMM_ISSUE(1);
  if (nk > 2) GEMM_ISSUE(2);
  for (int kt = 0; kt < nk; ++kt) {
    if (kt + 2 < nk) {
      if (NW == 4) asm volatile("s_waitcnt vmcnt(8)" ::: "memory");
      else asm volatile("s_waitcnt vmcnt(6)" ::: "memory");
    } else if (kt + 1 < nk) {
      if (NW == 4) asm volatile("s_waitcnt vmcnt(4)" ::: "memory");
      else asm volatile("s_waitcnt vmcnt(3)" ::: "memory");
    } else {
      asm volatile("s_waitcnt vmcnt(0)" ::: "memory");
    }
    __builtin_amdgcn_s_barrier();
    asm volatile("" ::: "memory");
    if (kt + 3 < nk) GEMM_ISSUE(kt + 3);
    const uint32_t sb = lds_base + (kt & 3) * STG;
    bf16x8 af[4], bfr[4];
    af[0] = lds_rd128<0>(sb + aoff); af[1] = lds_rd128<1024>(sb + aoff);
    af[2] = lds_rd128<2048>(sb + aoff); af[3] = lds_rd128<3072>(sb + aoff);
    bfr[0] = lds_rd128<0>(sb + boff); bfr[1] = lds_rd128<1024>(sb + boff);
    if (NW == 4) {
      bfr[2] = lds_rd128<2048>(sb + boff); bfr[3] = lds_rd128<3072>(sb + boff);
      asm volatile("s_waitcnt lgkmcnt(0)" : "+v"(af[0]), "+v"(af[1]), "+v"(af[2]), "+v"(af[3]),
                   "+v"(bfr[0]), "+v"(bfr[1]), "+v"(bfr[2]), "+v"(bfr[3]));
    } else {
      asm volatile("s_waitcnt lgkmcnt(0)" : "+v"(af[0]), "+v"(af[1]), "+v"(af[2]), "+v"(af[3]), "+v"(bfr[0]), "+v"(bfr[1]));
    }
#pragma unroll
    for (int m = 0; m < 4; ++m)
#pragma unroll
      for (int n = 0; n < NW; ++n) {
        if (SWAP) acc[m][n] = __builtin_amdgcn_mfma_f32_16x16x32_bf16(bfr[n], af[m], acc[m][n], 0, 0, 0);
        else acc[m][n] = __builtin_amdgcn_mfma_f32_16x16x32_bf16(af[m], bfr[n], acc[m][n], 0, 0, 0);
      }
  }
#undef GEMM_ISSUE
}

DEVI int launder(int x) { asm volatile("" : "+v"(x)); return x; }

template <int NW>
DEVI void zero_acc(f32x4 (&acc)[4][NW]) {
#pragma unroll
  for (int m = 0; m < 4; ++m)
#pragma unroll
    for (int n = 0; n < NW; ++n) acc[m][n] = (f32x4){0.f, 0.f, 0.f, 0.f};
}

struct NoEpi { DEVI void operator()(int, int, f32x4) const {} };

template <class EpiS, class EpiN>
DEVI void gemm_phase(int tid_, const u16* A, int lda, const u16* Bt, int ldb, int K, int M, int N, char* smem, int ns_from,
                     EpiS epiS, EpiN epiN) {
  const int nN = N >> 7, nM = M >> 7;
  const int lane = tid_ & 63, wid = tid_ >> 6;
  const int wr = wid >> 1, wc = wid & 1, fr = lane & 15, fq = lane >> 4;
  const int xcd = blockIdx.x & 7, jloc = blockIdx.x >> 3, nloc = gridDim.x >> 3;
  for (int lt = jloc; lt < (nM >> 3) * nN; lt += nloc) {
    const int tml = lt / nN, tn = lt - tml * nN;
    const int tm = tml * 8 + xcd;
    const int m0 = tm << 7, n0 = tn << 7;
    f32x4 acc[4][4];
    zero_acc(acc);
    if (n0 < ns_from) {
      gemm_kloop<4, true>(tid_, acc, A + (size_t)m0 * lda, lda, Bt + (size_t)n0 * ldb, ldb, K, smem);
#pragma unroll
      for (int m = 0; m < 4; ++m)
#pragma unroll
        for (int n = 0; n < 4; ++n) epiS(m0 + wr * 64 + m * 16 + fr, n0 + wc * 64 + n * 16 + fq * 4, acc[m][n]);
    } else {
      gemm_kloop<4, false>(tid_, acc, A + (size_t)m0 * lda, lda, Bt + (size_t)n0 * ldb, ldb, K, smem);
#pragma unroll
      for (int m = 0; m < 4; ++m)
#pragma unroll
        for (int n = 0; n < 4; ++n) epiN(m0 + wr * 64 + m * 16 + fq * 4, n0 + wc * 64 + n * 16 + fr, acc[m][n]);
    }
  }
}


template <bool SWAP>
DEVI void gemm_kloop_big(int tid_, f32x4 (&acc)[8][4], const u16* __restrict__ A, int lda, const u16* __restrict__ Bt,
                         int ldb, int K, char* smem) {
  constexpr int STG = 16384 + 8192;
  const int tid = tid_, lane = tid & 63, wid = tid >> 6;
  const int wr = wid >> 1, wc = wid & 1, fr = lane & 15, fq = lane >> 4;
  const int lrow = lane >> 2, lphys = lane & 3, lhi = lane >> 4;
  const int gsw = (4 - lhi) & 3;
  const u16* ga = A + (size_t)(wid * 64 + lrow) * lda + (lphys ^ gsw) * 8;
  const u16* gb = Bt + (size_t)(wid * 32 + lrow) * ldb + (lphys ^ gsw) * 8;
  const size_t a16 = (size_t)16 * lda, b16 = (size_t)16 * ldb;
  const int rsw = (4 - ((fr >> 2) & 3)) & 3;
  const int ch = (fq ^ rsw) * 16;
  const int nk = K >> 5;
  const uint32_t lds_base = (uint32_t)(size_t)(__attribute__((address_space(3))) char*)smem;
  const uint32_t aoff = (uint32_t)((wr * 128 + fr) * 64 + ch);
  const uint32_t boff = (uint32_t)(16384 + (wc * 64 + fr) * 64 + ch);
  asm volatile("s_waitcnt vmcnt(0)" ::: "memory");
  __syncthreads();
#define GEMMB_ISSUE(kt_, buf_)                                                                                       \
  do {                                                                                                               \
    char* nb_ = smem + (buf_) * STG;                                                                                 \
    _Pragma("unroll") for (int q = 0; q < 4; ++q) __builtin_amdgcn_global_load_lds(                                  \
        (const unsigned*)(ga + q * a16 + (kt_) * 32),                                                                \
        (__attribute__((address_space(3))) unsigned*)(nb_ + (wid * 4 + q) * 1024 + lane * 16), 16, 0, 0);            \
    _Pragma("unroll") for (int q = 0; q < 2; ++q) __builtin_amdgcn_global_load_lds(                                  \
        (const unsigned*)(gb + q * b16 + (kt_) * 32),                                                                \
        (__attribute__((address_space(3))) unsigned*)(nb_ + 16384 + (wid * 2 + q) * 1024 + lane * 16), 16, 0, 0);   \
  } while (0)
  GEMMB_ISSUE(0, 0);
  if (nk > 1) GEMMB_ISSUE(1, 1);
  int cb = 0;
  for (int kt = 0; kt < nk; ++kt) {
    if (kt + 1 < nk) asm volatile("s_waitcnt vmcnt(6)" ::: "memory");
    else asm volatile("s_waitcnt vmcnt(0)" ::: "memory");
    __builtin_amdgcn_s_barrier();
    asm volatile("" ::: "memory");
    const int nbuf = (cb == 0) ? 2 : cb - 1;
    if (kt + 2 < nk) GEMMB_ISSUE(kt + 2, nbuf);
    const uint32_t sb = lds_base + cb * STG;
    bf16x8 a0[4], a1[4], bb[4];
    a0[0] = lds_rd128<0>(sb + aoff); a0[1] = lds_rd128<1024>(sb + aoff);
    a0[2] = lds_rd128<2048>(sb + aoff); a0[3] = lds_rd128<3072>(sb + aoff);
    bb[0] = lds_rd128<0>(sb + boff); bb[1] = lds_rd128<1024>(sb + boff);
    bb[2] = lds_rd128<2048>(sb + boff); bb[3] = lds_rd128<3072>(sb + boff);
    a1[0] = lds_rd128<4096>(sb + aoff); a1[1] = lds_rd128<5120>(sb + aoff);
    a1[2] = lds_rd128<6144>(sb + aoff); a1[3] = lds_rd128<7168>(sb + aoff);
    asm volatile("s_waitcnt lgkmcnt(4)" : "+v"(a0[0]), "+v"(a0[1]), "+v"(a0[2]), "+v"(a0[3]),
                 "+v"(bb[0]), "+v"(bb[1]), "+v"(bb[2]), "+v"(bb[3]));
#pragma unroll
    for (int m = 0; m < 4; ++m)
#pragma unroll
      for (int n = 0; n < 4; ++n) {
        if (SWAP) acc[m][n] = __builtin_amdgcn_mfma_f32_16x16x32_bf16(bb[n], a0[m], acc[m][n], 0, 0, 0);
        else acc[m][n] = __builtin_amdgcn_mfma_f32_16x16x32_bf16(a0[m], bb[n], acc[m][n], 0, 0, 0);
      }
    asm volatile("s_waitcnt lgkmcnt(0)" : "+v"(a1[0]), "+v"(a1[1]), "+v"(a1[2]), "+v"(a1[3]));
#pragma unroll
    for (int m = 0; m < 4; ++m)
#pragma unroll
      for (int n = 0; n < 4; ++n) {
        if (SWAP) acc[4 + m][n] = __builtin_amdgcn_mfma_f32_16x16x32_bf16(bb[n], a1[m], acc[4 + m][n], 0, 0, 0);
        else acc[4 + m][n] = __builtin_amdgcn_mfma_f32_16x16x32_bf16(a1[m], bb[n], acc[4 + m][n], 0, 0, 0);
      }
    cb = (cb == 2) ? 0 : cb + 1;
  }
#undef GEMMB_ISSUE
}

template <class EpiS, class EpiN>
DEVI void gemm_phase_big(int tid_, const u16* A, int lda, const u16* Bt, int ldb, int K, int M, int N, char* smem,
                         int ns_from, EpiS epiS, EpiN epiN) {
  const int nN = N >> 7, nM = M >> 8;
  const int lane = tid_ & 63, wid = tid_ >> 6;
  const int wr = wid >> 1, wc = wid & 1, fr = lane & 15, fq = lane >> 4;
  const int xcd = blockIdx.x & 7, jloc = blockIdx.x >> 3, nloc = gridDim.x >> 3;
  for (int lt = jloc; lt < (nM >> 3) * nN; lt += nloc) {
    const int tml = lt / nN, tn = lt - tml * nN;
    const int tm = tml * 8 + xcd;
    const int m0 = tm << 8, n0 = tn << 7;
    f32x4 acc[8][4];
#pragma unroll
    for (int m = 0; m < 8; ++m)
#pragma unroll
      for (int n = 0; n < 4; ++n) acc[m][n] = (f32x4){0.f, 0.f, 0.f, 0.f};
    if (n0 < ns_from) {
      gemm_kloop_big<true>(launder(tid_), acc, A + (size_t)m0 * lda, lda, Bt + (size_t)n0 * ldb, ldb, K, smem);
#pragma unroll
      for (int m = 0; m < 8; ++m)
#pragma unroll
        for (int n = 0; n < 4; ++n) epiS(m0 + wr * 128 + m * 16 + fr, n0 + wc * 64 + n * 16 + fq * 4, acc[m][n]);
    } else {
      gemm_kloop_big<false>(launder(tid_), acc, A + (size_t)m0 * lda, lda, Bt + (size_t)n0 * ldb, ldb, K, smem);
#pragma unroll
      for (int m = 0; m < 8; ++m)
#pragma unroll
        for (int n = 0; n < 4; ++n) epiN(m0 + wr * 128 + m * 16 + fq * 4, n0 + wc * 64 + n * 16 + fr, acc[m][n]);
    }
  }
}


template <bool SWAP>
DEVI void gemm_kloop8(int tid_, f32x4 (&acc)[8][4], const u16* __restrict__ A, int lda, const u16* __restrict__ Bt,
                      int ldb, int K, char* smem) {
  constexpr int STG = 65536;
  const int tid = tid_, lane = tid & 63, wid = tid >> 6;
  const int wr = wid >> 2, wc = wid & 3, fr = lane & 15, fq = lane >> 4;
  const int lrow = lane >> 3, lphys = lane & 7, lhi = lane >> 4;
  const u16* ga[4];
  const u16* gb[4];
#pragma unroll
  for (int q = 0; q < 4; ++q) {
    const int kc = lphys ^ ((4 * (q & 1) + lhi) & 7);
    ga[q] = A + (size_t)((wid * 4 + q) * 8 + lrow) * lda + kc * 8;
    gb[q] = Bt + (size_t)((wid * 4 + q) * 8 + lrow) * ldb + kc * 8;
  }
  const int swz = (fr >> 1) & 7;
  const int nk = K >> 6;
  const uint32_t lds_base = (uint32_t)(size_t)(__attribute__((address_space(3))) char*)smem;
  const uint32_t arow = (uint32_t)((wr * 128 + fr) * 128);
  const uint32_t brow = (uint32_t)(32768 + (wc * 64 + fr) * 128);
  asm volatile("s_waitcnt vmcnt(0)" ::: "memory");
  __syncthreads();
#define GEMM8_ISSUE(kt_)                                                                                             \
  do {                                                                                                               \
    char* nb_ = smem + ((kt_) & 1) * STG;                                                                            \
    _Pragma("unroll") for (int q = 0; q < 4; ++q) __builtin_amdgcn_global_load_lds(                                  \
        (const unsigned*)(ga[q] + (kt_) * 64),                                                                       \
        (__attribute__((address_space(3))) unsigned*)(nb_ + (wid * 4 + q) * 1024 + lane * 16), 16, 0, 0);            \
    _Pragma("unroll") for (int q = 0; q < 4; ++q) __builtin_amdgcn_global_load_lds(                                  \
        (const unsigned*)(gb[q] + (kt_) * 64),                                                                       \
        (__attribute__((address_space(3))) unsigned*)(nb_ + 32768 + (wid * 4 + q) * 1024 + lane * 16), 16, 0, 0);    \
  } while (0)
  GEMM8_ISSUE(0);
  for (int kt = 0; kt < nk; ++kt) {
    asm volatile("s_waitcnt vmcnt(0)" ::: "memory");
    __builtin_amdgcn_s_barrier();
    asm volatile("" ::: "memory");
    if (kt + 1 < nk) GEMM8_ISSUE(kt + 1);
    const uint32_t sb = lds_base + (kt & 1) * STG;
#pragma unroll
    for (int ks = 0; ks < 2; ++ks) {
      const uint32_t chb = (uint32_t)(((ks * 4 + fq) ^ swz) * 16);
      const uint32_t aoff = sb + arow + chb, boff = sb + brow + chb;
      bf16x8 a0[4], a1[4], bb[4];
      a0[0] = lds_rd128<0>(aoff); a0[1] = lds_rd128<2048>(aoff);
      a0[2] = lds_rd128<4096>(aoff); a0[3] = lds_rd128<6144>(aoff);
      bb[0] = lds_rd128<0>(boff); bb[1] = lds_rd128<2048>(boff);
      bb[2] = lds_rd128<4096>(boff); bb[3] = lds_rd128<6144>(boff);
      a1[0] = lds_rd128<8192>(aoff); a1[1] = lds_rd128<10240>(aoff);
      a1[2] = lds_rd128<12288>(aoff); a1[3] = lds_rd128<14336>(aoff);
      asm volatile("s_waitcnt lgkmcnt(4)" : "+v"(a0[0]), "+v"(a0[1]), "+v"(a0[2]), "+v"(a0[3]),
                   "+v"(bb[0]), "+v"(bb[1]), "+v"(bb[2]), "+v"(bb[3]));
#pragma unroll
      for (int m = 0; m < 4; ++m)
#pragma unroll
        for (int n = 0; n < 4; ++n) {
          if (SWAP) acc[m][n] = __builtin_amdgcn_mfma_f32_16x16x32_bf16(bb[n], a0[m], acc[m][n], 0, 0, 0);
          else acc[m][n] = __builtin_amdgcn_mfma_f32_16x16x32_bf16(a0[m], bb[n], acc[m][n], 0, 0, 0);
        }
      asm volatile("s_waitcnt lgkmcnt(0)" : "+v"(a1[0]), "+v"(a1[1]), "+v"(a1[2]), "+v"(a1[3]));
#pragma unroll
      for (int m = 0; m < 4; ++m)
#pragma unroll
        for (int n = 0; n < 4; ++n) {
          if (SWAP) acc[4 + m][n] = __builtin_amdgcn_mfma_f32_16x16x32_bf16(bb[n], a1[m], acc[4 + m][n], 0, 0, 0);
          else acc[4 + m][n] = __builtin_amdgcn_mfma_f32_16x16x32_bf16(a1[m], bb[n], acc[4 + m][n], 0, 0, 0);
        }
    }
  }
#undef GEMM8_ISSUE
}

template <class EpiS, class EpiN>
DEVI void gemm_phase8(int tid_, const u16* A, int lda, const u16* Bt, int ldb, int K, int M, int N, char* smem,
                      int ns_from, EpiS epiS, EpiN epiN) {
  const int nN = (N + 255) >> 8, nM = M >> 8;
  const int lane = tid_ & 63, wid = tid_ >> 6;
  const int wr = wid >> 2, wc = wid & 3, fr = lane & 15, fq = lane >> 4;
  const bool xmap = ((gridDim.x & 7) == 0) && ((nM & 7) == 0);
  const int xcd = blockIdx.x & 7;
  const int first = xmap ? (int)(blockIdx.x >> 3) : (int)blockIdx.x;
  const int stride = xmap ? (int)(gridDim.x >> 3) : (int)gridDim.x;
  const int count = xmap ? (nM >> 3) * nN : nM * nN;
  for (int it = first; it < count; it += stride) {
    const int tq = it / nN, tn = it - tq * nN;
    const int tm = xmap ? tq * 8 + xcd : tq;
    const int m0 = tm << 8, n0 = tn << 8;
    const int colb = n0 + wc * 64;
    f32x4 acc[8][4];
#pragma unroll
    for (int m = 0; m < 8; ++m)
#pragma unroll
      for (int n = 0; n < 4; ++n) acc[m][n] = (f32x4){0.f, 0.f, 0.f, 0.f};
    if (colb < ns_from) {
      gemm_kloop8<true>(launder(tid_), acc, A + (size_t)m0 * lda, lda, Bt + (size_t)n0 * ldb, ldb, K, smem);
      if (colb < N) {
#pragma unroll
        for (int m = 0; m < 8; ++m)
#pragma unroll
          for (int n = 0; n < 4; ++n) epiS(m0 + wr * 128 + m * 16 + fr, colb + n * 16 + fq * 4, acc[m][n]);
      }
    } else {
      gemm_kloop8<false>(launder(tid_), acc, A + (size_t)m0 * lda, lda, Bt + (size_t)n0 * ldb, ldb, K, smem);
      if (colb < N) {
#pragma unroll
        for (int m = 0; m < 8; ++m)
#pragma unroll
          for (int n = 0; n < 4; ++n) epiN(m0 + wr * 128 + m * 16 + fq * 4, colb + n * 16 + fr, acc[m][n]);
      }
    }
  }
}

DEVI void store4bf(u16* dst, f32x4 v) {
  u32x2 o;
  o.x = pack2(v[0], v[1]); o.y = pack2(v[2], v[3]);
  *(u32x2*)dst = o;
}

DEVI void phase_p_gemm(int tid_, const Params& p, char* smem) {
  u16* WB = (u16*)(p.ws + OFF_WB);
  const u16* H = (const u16*)(p.ws + OFF_H);
  u16* PR = (u16*)(p.ws + OFF_PR);
  u16* NQ = (u16*)(p.ws + OFF_NQ);
  u16* NK = (u16*)(p.ws + OFF_NK);
  u16* NVT = (u16*)(p.ws + OFF_NV);
  gemm_phase8(tid_, H, 1024, WB + W_IN, 1024, 1024, NTOK, 3456, smem, 2944,
    [&](int r, int c0, f32x4 v) {
      if (c0 < 1920) store4bf(PR + (size_t)r * PRW + c0, v);
      else if (c0 < 2432) store4bf(NQ + (size_t)r * 512 + (c0 - 1920), v);
      else store4bf(NK + (size_t)r * 512 + (c0 - 2432), v);
    },
    [&](int r0, int c, f32x4 v) {
      const int cc = c - 2944;
      const int s = r0 >> 12, t = r0 & 4095;
      store4bf(NVT + ((size_t)(s * 512 + cc)) * 4096 + t, v);
    });
  const u16* MH = (const u16*)(p.ws + OFF_MEMH);
  u16* KVK = (u16*)(p.ws + OFF_KVK);
  u16* KVT = (u16*)(p.ws + OFF_KVT);
  gemm_phase8(tid_, MH, 1024, WB + W_XKV, 1024, 1024, 3072, 2048, smem, 1024,
    [&](int r, int c0, f32x4 v) { store4bf(KVK + (size_t)r * 1024 + c0, v); },
    [&](int r0, int c, f32x4 v) {
      const int cc = c - 1024;
      const int s = r0 >> 8, m = r0 & 255;
      store4bf(KVT + ((size_t)(s * 1024 + cc)) * 256 + m, v);
    });
}

DEVI void phase_nat(int tid_, const Params& p, int l, char* smem, int bfirst, int bstride) {
  u16* NQ = (u16*)(p.ws + OFF_NQ);
  const u16* NK = (const u16*)(p.ws + OFF_NK);
  const u16* NVT = (const u16*)(p.ws + OFF_NV);
  const float* rpb = p.in[I_RPB] + (size_t)l * 8 * 15 * 31;
  const int lane = tid_ & 63, g = tid_ >> 6, fr = lane & 15, fq = lane >> 4;
  u16* Pw = (u16*)smem + g * (16 * 264);
  const int cb = (g == 0) ? 0 : (g == 1) ? 8 : (g == 2) ? 24 : 32;
  const int c = g * 16 + fr;
  int cs = c - 8; cs = cs < 0 ? 0 : (cs > 48 ? 48 : cs);
  for (int t = bfirst; t < 12 * 64 * 8; t += bstride) {
    const int h = t & 7, ri = (t >> 3) & 63, s = t >> 9;
    int rs = ri - 4; rs = rs < 0 ? 0 : (rs > 56 ? 56 : rs);
    const size_t tokq = (size_t)s * 4096 + ri * 64 + g * 16;
    bf16x8 aq[2];
    aq[0] = *(const bf16x8*)(NQ + (tokq + fr) * 512 + h * 64 + fq * 8);
    aq[1] = *(const bf16x8*)(NQ + (tokq + fr) * 512 + h * 64 + 32 + fq * 8);
    f32x4 acc[16];
#pragma unroll
    for (int n = 0; n < 16; ++n) {
      acc[n] = (f32x4){0.f, 0.f, 0.f, 0.f};
      const int r = n >> 1, col = cb + (n & 1) * 16 + fr;
      const u16* kp = NK + ((size_t)s * 4096 + (rs + r) * 64 + col) * 512 + h * 64 + fq * 8;
      const bf16x8 b0 = *(const bf16x8*)kp;
      const bf16x8 b1 = *(const bf16x8*)(kp + 32);
      acc[n] = __builtin_amdgcn_mfma_f32_16x16x32_bf16(b0, aq[0], acc[n], 0, 0, 0);
      acc[n] = __builtin_amdgcn_mfma_f32_16x16x32_bf16(b1, aq[1], acc[n], 0, 0, 0);
    }
    float m = -1e30f;
#pragma unroll
    for (int n = 0; n < 16; ++n) {
      const int di = rs + (n >> 1) - ri + 7;
      const float* brow = rpb + (h * 15 + di) * 31 + 15 - c;
#pragma unroll
      for (int j = 0; j < 4; ++j) {
        const int kc = cb + (n & 1) * 16 + fq * 4 + j;
        float sc = -1e30f;
        if (kc >= cs && kc < cs + 16) sc = acc[n][j] * 0.125f + brow[kc];
        acc[n][j] = sc;
        m = fmaxf(m, sc);
      }
    }
    m = red4x_max(m);
    float ssum = 0.f;
#pragma unroll
    for (int n = 0; n < 16; ++n) {
      f32x4 e;
#pragma unroll
      for (int j = 0; j < 4; ++j) { e[j] = __expf(acc[n][j] - m); ssum += e[j]; }
      store4bf(Pw + fr * 264 + n * 16 + fq * 4, e);
    }
    const float sm = 1.f / red4x_sum(ssum);
    f32x4 o[4];
#pragma unroll
    for (int n = 0; n < 4; ++n) o[n] = (f32x4){0.f, 0.f, 0.f, 0.f};
#pragma unroll
    for (int ks = 0; ks < 8; ++ks) {
      const bf16x8 ap = *(const bf16x8*)(Pw + fr * 264 + ks * 32 + fq * 8);
#pragma unroll
      for (int n = 0; n < 4; ++n) {
        const bf16x8 bv = *(const bf16x8*)(NVT + ((size_t)(s * 512 + h * 64 + n * 16 + fr)) * 4096 + (rs + ks) * 64 + cb + fq * 8);
        o[n] = __builtin_amdgcn_mfma_f32_16x16x32_bf16(bv, ap, o[n], 0, 0, 0);
      }
    }
#pragma unroll
    for (int n = 0; n < 4; ++n) store4bf(NQ + (tokq + fr) * 512 + h * 64 + n * 16 + fq * 4, o[n] * sm);
  }
}

constexpr int SC_OPS = 0;
constexpr int SC_VV = 40960;
constexpr int SC_WR = 49152;
constexpr int SC_AP = 57344;
constexpr int SC_TW = 65536;
constexpr int SC_AD = 70144;
constexpr int SC_NRM = 74752;
constexpr int SC_MU = 74880;
constexpr int SC_CST = 77440;

typedef __attribute__((ext_vector_type(2))) float f32x2;

template <int CTRL>
DEVI float dpp_mov(float x) {
  return __int_as_float(__builtin_amdgcn_update_dpp(0, __float_as_int(x), CTRL, 0xF, 0xF, true));
}
DEVI float red8(float x) {
  x += dpp_mov<0xB1>(x);
  x += dpp_mov<0x4E>(x);
  x += dpp_mov<0x141>(x);
  return x;
}
DEVI f32x2 lo2(f32x4 v) { return __builtin_shufflevector(v, v, 0, 1); }
DEVI f32x2 hi2(f32x4 v) { return __builtin_shufflevector(v, v, 2, 3); }

struct ScanOps {
  f32x2 a[4], w[4], b[4], k[4], r[4];
  float v0, v1;
};
DEVI void scan_load(ScanOps& o, const float* OPS, const float* VV, int nn, int jg, int i0) {
  const float* base = OPS + nn * 64 + jg * 8;
  f32x4 t0, t1;
  t0 = *(const f32x4*)(base); t1 = *(const f32x4*)(base + 4);
  o.a[0] = lo2(t0); o.a[1] = hi2(t0); o.a[2] = lo2(t1); o.a[3] = hi2(t1);
  t0 = *(const f32x4*)(base + 2048); t1 = *(const f32x4*)(base + 2048 + 4);
  o.w[0] = lo2(t0); o.w[1] = hi2(t0); o.w[2] = lo2(t1); o.w[3] = hi2(t1);
  t0 = *(const f32x4*)(base + 4096); t1 = *(const f32x4*)(base + 4096 + 4);
  o.b[0] = lo2(t0); o.b[1] = hi2(t0); o.b[2] = lo2(t1); o.b[3] = hi2(t1);
  t0 = *(const f32x4*)(base + 6144); t1 = *(const f32x4*)(base + 6144 + 4);
  o.k[0] = lo2(t0); o.k[1] = hi2(t0); o.k[2] = lo2(t1); o.k[3] = hi2(t1);
  t0 = *(const f32x4*)(base + 8192); t1 = *(const f32x4*)(base + 8192 + 4);
  o.r[0] = lo2(t0); o.r[1] = hi2(t0); o.r[2] = lo2(t1); o.r[3] = hi2(t1);
  o.v0 = VV[nn * 64 + i0];
  o.v1 = VV[nn * 64 + i0 + 8];
}
DEVI void scan_step(const ScanOps& o, f32x2 (&S0)[4], f32x2 (&S1)[4], float* YL, int nn, int jg, int i0) {
  f32x2 d0 = S0[0] * o.a[0], d0b = S0[2] * o.a[2];
  f32x2 d1 = S1[0] * o.a[0], d1b = S1[2] * o.a[2];
  d0 = S0[1] * o.a[1] + d0; d0b = S0[3] * o.a[3] + d0b;
  d1 = S1[1] * o.a[1] + d1; d1b = S1[3] * o.a[3] + d1b;
  d0 += d0b; d1 += d1b;
  const float sa0 = red8(d0.x + d0.y);
  const float sa1 = red8(d1.x + d1.y);
  f32x2 e0 = {0.f, 0.f}, e1 = {0.f, 0.f};
#pragma unroll
  for (int q = 0; q < 4; ++q) {
    const f32x2 u0 = sa0 * o.b[q] + o.v0 * o.k[q];
    const f32x2 u1 = sa1 * o.b[q] + o.v1 * o.k[q];
    S0[q] = S0[q] * o.w[q] + u0;
    S1[q] = S1[q] * o.w[q] + u1;
    e0 = S0[q] * o.r[q] + e0;
    e1 = S1[q] * o.r[q] + e1;
  }
  const float y0 = red8(e0.x + e0.y);
  const float y1 = red8(e1.x + e1.y);
  if (jg == 0) { YL[nn * 64 + i0] = y0; YL[nn * 64 + i0 + 8] = y1; }
}

DEVI void phase_scan(int tid_, const Params& p, int l, char* smem, int bfirst, int bstride) {
  const u16* PR = (const u16*)(p.ws + OFF_PR);
  _Float16* YF = (_Float16*)(p.ws + OFF_H);
  _Float16* YB = (_Float16*)(p.ws + OFF_H + (size_t)NTOK * 512 * 2);
  float* BON = (float*)(p.ws + OFF_BONUS);
  const u16* WB = (const u16*)(p.ws + OFF_WB);
  float* OPS = (float*)(smem + SC_OPS);
  u16* RAW = (u16*)(smem + SC_OPS);
  float* VV = (float*)(smem + SC_VV);
  float* WR = (float*)(smem + SC_WR);
  float* AP = (float*)(smem + SC_AP);
  float* YL = WR;
  u16* TWb = (u16*)(smem + SC_TW);
  u16* ADb = (u16*)(smem + SC_AD);
  float* NRM = (float*)(smem + SC_NRM);
  float* MU = (float*)(smem + SC_MU);
  float* CST = (float*)(smem + SC_CST);
  const float* mu_p = p.in[I_MU_PREV] + (size_t)l * 1920;
  const float* mu_n = p.in[I_MU_NEXT] + (size_t)l * 1920;
  const int tid = tid_, lane = tid & 63, w = tid >> 6, fr = lane & 15, fq = lane >> 4;
  const int pn = tid >> 3, j0 = (tid & 7) * 8;
  const int jg = lane & 7, i0 = w * 16 + (lane >> 3);
  const int hr = (tid >= 40) ? 1 : 0, hc = tid - hr * 40;
  for (int blk = bfirst; blk < 192; blk += bstride) {
    const int s = blk >> 4, h = (blk >> 1) & 7, d = blk & 1;
    __syncthreads();
    for (int i = tid; i < 640; i += 256) {
      const int which = (i >= 320) ? 1 : 0, c = i - which * 320;
      const int g = c >> 6, e = c & 63;
      const int col = (g < 3) ? (g * 512 + h * 64 + e) : (1536 + (g - 3) * 128 + d * 64 + e);
      MU[i] = which ? mu_n[col] : mu_p[col];
    }
    for (int i = tid; i < 320; i += 256) {
      const int which = i >> 6, e = i & 63;
      float v;
      if (which == 0) v = p.in[I_W0][(size_t)(l * 2 + d) * 512 + h * 64 + e];
      else if (which == 1) v = p.in[I_A0][(size_t)(l * 2 + d) * 512 + h * 64 + e];
      else if (which == 2) v = p.in[I_K_K][(size_t)l * 512 + h * 64 + e];
      else if (which == 3) v = p.in[I_K_A][(size_t)l * 512 + h * 64 + e];
      else v = p.in[I_R_K][(size_t)(l * 8 + h) * 64 + e];
      CST[i] = v;
    }
    bf16x8 bw[2], ba[2];
#pragma unroll
    for (int ks = 0; ks < 2; ++ks) {
      bw[ks] = *(const bf16x8*)(WB + W_WUP + (size_t)(d * 512 + h * 64 + w * 16 + fr) * 64 + ks * 32 + fq * 8);
      ba[ks] = *(const bf16x8*)(WB + W_AUP + (size_t)(d * 512 + h * 64 + w * 16 + fr) * 64 + ks * 32 + fq * 8);
    }
    _Float16* Y = d ? YB : YF;
    f32x2 S0[4], S1[4];
#pragma unroll
    for (int q = 0; q < 4; ++q) { S0[q] = (f32x2){0.f, 0.f}; S1[q] = (f32x2){0.f, 0.f}; }
    u32x4 G[5], GH;
    {
      const int t = d ? (4095 - pn) : pn;
      const size_t tok = (size_t)s * 4096 + t;
#pragma unroll
      for (int g = 0; g < 5; ++g) {
        const int col = (g < 3) ? (g * 512 + h * 64) : (1536 + (g - 3) * 128 + d * 64);
        G[g] = *(const u32x4*)(PR + tok * PRW + col + j0);
      }
      GH = (u32x4){0u, 0u, 0u, 0u};
      if (tid < 80) {
        const int tlo = d ? (4095 - 31) : 0;
        const int th = hr ? (tlo + 32) : (tlo - 1);
        const int g = hc >> 3;
        const int col = (g < 3) ? (g * 512 + h * 64) : (1536 + (g - 3) * 128 + d * 64);
        if (th >= 0 && th <= 4095) GH = *(const u32x4*)(PR + ((size_t)s * 4096 + th) * PRW + col + (hc & 7) * 8);
      }
    }
#pragma unroll 1
    for (int ch = 0; ch < 128; ++ch) {
      const int n = ch * 32 + pn;
      const int t = d ? (4095 - n) : n;
      const size_t tok = (size_t)s * 4096 + t;
      const int tlo = d ? (4095 - (ch * 32 + 31)) : (ch * 32);
      const int rrow = t - tlo + 1;
#pragma unroll
      for (int g = 0; g < 5; ++g) *(u32x4*)(RAW + rrow * 320 + g * 64 + j0) = G[g];
      if (tid < 80) *(u32x4*)(RAW + (hr ? 33 : 0) * 320 + (hc >> 3) * 64 + (hc & 7) * 8) = GH;
      __syncthreads();
      if (ch + 1 < 128) {
        const int n2 = n + 32;
        const int t2 = d ? (4095 - n2) : n2;
        const size_t tok2 = (size_t)s * 4096 + t2;
#pragma unroll
        for (int g = 0; g < 5; ++g) {
          const int col = (g < 3) ? (g * 512 + h * 64) : (1536 + (g - 3) * 128 + d * 64);
          G[g] = *(const u32x4*)(PR + tok2 * PRW + col + j0);
        }
        GH = (u32x4){0u, 0u, 0u, 0u};
        if (tid < 80) {
          const int tlo2 = d ? (tlo - 32) : (tlo + 32);
          const int th = hr ? (tlo2 + 32) : (tlo2 - 1);
          const int g = hc >> 3;
          const int col = (g < 3) ? (g * 512 + h * 64) : (1536 + (g - 3) * 128 + d * 64);
          if (th >= 0 && th <= 4095) GH = *(const u32x4*)(PR + ((size_t)s * 4096 + th) * PRW + col + (hc & 7) * 8);
        }
      }
#pragma unroll
      for (int g = 0; g < 5; ++g) {
        float cur[8], prv[8], nxt[8];
        load8bf(RAW + rrow * 320 + g * 64 + j0, cur);
        load8bf(RAW + (rrow - 1) * 320 + g * 64 + j0, prv);
        load8bf(RAW + (rrow + 1) * 320 + g * 64 + j0, nxt);
        const f32x4 mp0 = *(const f32x4*)(MU + g * 64 + j0), mp1 = *(const f32x4*)(MU + g * 64 + j0 + 4);
        const f32x4 mn0 = *(const f32x4*)(MU + 320 + g * 64 + j0), mn1 = *(const f32x4*)(MU + 320 + g * 64 + j0 + 4);
        f32x4 x0, x1;
#pragma unroll
        for (int e = 0; e < 4; ++e) {
          x0[e] = cur[e] + mp0[e] * (prv[e] - cur[e]) + mn0[e] * (nxt[e] - cur[e]);
          x1[e] = cur[4 + e] + mp1[e] * (prv[4 + e] - cur[4 + e]) + mn1[e] * (nxt[4 + e] - cur[4 + e]);
        }
        if (g == 0) {
          *(f32x4*)(OPS + 4 * 2048 + pn * 64 + j0) = x0; *(f32x4*)(OPS + 4 * 2048 + pn * 64 + j0 + 4) = x1;
        } else if (g == 1) {
          *(f32x4*)(OPS + 3 * 2048 + pn * 64 + j0) = x0; *(f32x4*)(OPS + 3 * 2048 + pn * 64 + j0 + 4) = x1;
          const f32x4 kk0 = *(const f32x4*)(CST + 128 + j0), kk1 = *(const f32x4*)(CST + 128 + j0 + 4);
          float ss = 0.f;
#pragma unroll
          for (int e = 0; e < 4; ++e) { const float a_ = x0[e] * kk0[e], b_ = x1[e] * kk1[e]; ss += a_ * a_ + b_ * b_; }
          ss = red8(ss);
          if ((tid & 7) == 0) NRM[pn] = frcp(fmaxf(__builtin_amdgcn_sqrtf(ss), 1e-12f));
        } else if (g == 2) {
          *(f32x4*)(VV + pn * 64 + j0) = x0; *(f32x4*)(VV + pn * 64 + j0 + 4) = x1;
        } else if (g == 3) {
          u32x4 pk;
          pk.x = pack2(ftanh(x0[0]), ftanh(x0[1])); pk.y = pack2(ftanh(x0[2]), ftanh(x0[3]));
          pk.z = pack2(ftanh(x1[0]), ftanh(x1[1])); pk.w = pack2(ftanh(x1[2]), ftanh(x1[3]));
          *(u32x4*)(TWb + pn * 72 + j0) = pk;
        } else {
          u32x4 pk;
          pk.x = pack2(x0[0], x0[1]); pk.y = pack2(x0[2], x0[3]);
          pk.z = pack2(x1[0], x1[1]); pk.w = pack2(x1[2], x1[3]);
          *(u32x4*)(ADb + pn * 72 + j0) = pk;
        }
      }
      __syncthreads();
#pragma unroll
      for (int m = 0; m < 2; ++m) {
        f32x4 cw = {0.f, 0.f, 0.f, 0.f}, ca = {0.f, 0.f, 0.f, 0.f};
#pragma unroll
        for (int ks = 0; ks < 2; ++ks) {
          const bf16x8 aw = *(const bf16x8*)(TWb + (m * 16 + fr) * 72 + ks * 32 + fq * 8);
          const bf16x8 aa = *(const bf16x8*)(ADb + (m * 16 + fr) * 72 + ks * 32 + fq * 8);
          cw = __builtin_amdgcn_mfma_f32_16x16x32_bf16(aw, bw[ks], cw, 0, 0, 0);
          ca = __builtin_amdgcn_mfma_f32_16x16x32_bf16(aa, ba[ks], ca, 0, 0, 0);
        }
#pragma unroll
        for (int jj = 0; jj < 4; ++jj) {
          WR[(m * 16 + fq * 4 + jj) * 64 + w * 16 + fr] = cw[jj];
          AP[(m * 16 + fq * 4 + jj) * 64 + w * 16 + fr] = ca[jj];
        }
      }
      __syncthreads();
      {
        const float inv = NRM[pn];
        float bsum = 0.f;
#pragma unroll
        for (int hq = 0; hq < 2; ++hq) {
          const int jb = j0 + hq * 4;
          const f32x4 wr_ = *(const f32x4*)(WR + pn * 64 + jb) + *(const f32x4*)(CST + jb);
          const f32x4 ap_ = *(const f32x4*)(AP + pn * 64 + jb) + *(const f32x4*)(CST + 64 + jb);
          const f32x4 kr = *(const f32x4*)(OPS + 3 * 2048 + pn * 64 + jb);
          const f32x4 rr = *(const f32x4*)(OPS + 4 * 2048 + pn * 64 + jb);
          const f32x4 kkw = *(const f32x4*)(CST + 128 + jb), kaw = *(const f32x4*)(CST + 192 + jb), rkw = *(const f32x4*)(CST + 256 + jb);
          f32x4 o0, o1, o2, o3;
#pragma unroll
          for (int e = 0; e < 4; ++e) {
            const float sw = sigm(wr_[e]);
            const float dec = __expf(-0.6065306597126334f * sw);
            const float av = sigm(ap_[e]);
            const float kn = kr[e] * kkw[e] * inv;
            const float kd = kr[e] * (1.f + (av - 1.f) * kaw[e]);
            bsum += rr[e] * kd * rkw[e];
            o0[e] = -kn; o1[e] = dec; o2[e] = kn * av; o3[e] = kd;
          }
          *(f32x4*)(OPS + 0 * 2048 + pn * 64 + jb) = o0;
          *(f32x4*)(OPS + 1 * 2048 + pn * 64 + jb) = o1;
          *(f32x4*)(OPS + 2 * 2048 + pn * 64 + jb) = o2;
          *(f32x4*)(OPS + 3 * 2048 + pn * 64 + jb) = o3;
        }
        bsum = red8(bsum);
        if ((tid & 7) == 0) BON[(tok * 8 + h) * 2 + d] = bsum;
      }
      __syncthreads();
      {
        ScanOps oa, ob;
        scan_load(oa, OPS, VV, 0, jg, i0);
#pragma unroll 1
        for (int nn = 0; nn < 32; nn += 2) {
          scan_load(ob, OPS, VV, nn + 1, jg, i0);
          scan_step(oa, S0, S1, YL, nn, jg, i0);
          scan_load(oa, OPS, VV, (nn + 2) & 31, jg, i0);
          scan_step(ob, S0, S1, YL, nn + 1, jg, i0);
        }
      }
      __syncthreads();
      {
        h16x8 o;
#pragma unroll
        for (int e = 0; e < 8; ++e) o[e] = (_Float16)YL[pn * 64 + j0 + e];
        *(h16x8*)(Y + tok * 512 + h * 64 + j0) = o;
      }
    }
    __syncthreads();
  }
}

struct ScanOps1 {
  f32x2 a[4], w[4], b[4], k[4], r[4];
  float v0;
};
DEVI void scan_load1(ScanOps1& o, const float* OPS, const float* VV, int nn, int jg, int i0) {
  const float* base = OPS + nn * 64 + jg * 8;
  f32x4 t0, t1;
  t0 = *(const f32x4*)(base); t1 = *(const f32x4*)(base + 4);
  o.a[0] = lo2(t0); o.a[1] = hi2(t0); o.a[2] = lo2(t1); o.a[3] = hi2(t1);
  t0 = *(const f32x4*)(base + 2048); t1 = *(const f32x4*)(base + 2048 + 4);
  o.w[0] = lo2(t0); o.w[1] = hi2(t0); o.w[2] = lo2(t1); o.w[3] = hi2(t1);
  t0 = *(const f32x4*)(base + 4096); t1 = *(const f32x4*)(base + 4096 + 4);
  o.b[0] = lo2(t0); o.b[1] = hi2(t0); o.b[2] = lo2(t1); o.b[3] = hi2(t1);
  t0 = *(const f32x4*)(base + 6144); t1 = *(const f32x4*)(base + 6144 + 4);
  o.k[0] = lo2(t0); o.k[1] = hi2(t0); o.k[2] = lo2(t1); o.k[3] = hi2(t1);
  t0 = *(const f32x4*)(base + 8192); t1 = *(const f32x4*)(base + 8192 + 4);
  o.r[0] = lo2(t0); o.r[1] = hi2(t0); o.r[2] = lo2(t1); o.r[3] = hi2(t1);
  o.v0 = VV[nn * 64 + i0];
}
DEVI void scan_step1(const ScanOps1& o, f32x2 (&S0)[4], float* YL, int nn, int jg, int i0) {
  f32x2 d0 = S0[0] * o.a[0], d0b = S0[2] * o.a[2];
  d0 = S0[1] * o.a[1] + d0; d0b = S0[3] * o.a[3] + d0b;
  d0 += d0b;
  const float sa0 = red8(d0.x + d0.y);
  f32x2 e0 = {0.f, 0.f};
#pragma unroll
  for (int q = 0; q < 4; ++q) {
    const f32x2 u0 = sa0 * o.b[q] + o.v0 * o.k[q];
    S0[q] = S0[q] * o.w[q] + u0;
    e0 = S0[q] * o.r[q] + e0;
  }
  const float y0 = red8(e0.x + e0.y);
  if (jg == 0) YL[nn * 64 + i0] = y0;
}
DEVI float red16d(float x) {
  x += dpp_mov<0xB1>(x);
  x += dpp_mov<0x4E>(x);
  x += dpp_mov<0x141>(x);
  x += dpp_mov<0x140>(x);
  return x;
}
DEVI void unpack4(u32x2 u, float* o) {
  o[0] = __uint_as_float(u.x << 16); o[1] = __uint_as_float(u.x & 0xffff0000u);
  o[2] = __uint_as_float(u.y << 16); o[3] = __uint_as_float(u.y & 0xffff0000u);
}

DEVI void phase_scan8(int tid_, const Params& p, int l, char* smem, int bfirst, int bstride) {
  const u16* PR = (const u16*)(p.ws + OFF_PR);
  _Float16* YF = (_Float16*)(p.ws + OFF_H);
  _Float16* YB = (_Float16*)(p.ws + OFF_H + (size_t)NTOK * 512 * 2);
  float* BON = (float*)(p.ws + OFF_BONUS);
  const u16* WB = (const u16*)(p.ws + OFF_WB);
  float* OPS = (float*)(smem + SC_OPS);
  u16* RAW = (u16*)(smem + SC_OPS);
  float* VV = (float*)(smem + SC_VV);
  float* WR = (float*)(smem + SC_WR);
  float* AP = (float*)(smem + SC_AP);
  float* YL = WR;
  u16* TWb = (u16*)(smem + SC_TW);
  u16* ADb = (u16*)(smem + SC_AD);
  float* NRM = (float*)(smem + SC_NRM);
  float* MU = (float*)(smem + SC_MU);
  float* CST = (float*)(smem + SC_CST);
  const float* mu_p = p.in[I_MU_PREV] + (size_t)l * 1920;
  const float* mu_n = p.in[I_MU_NEXT] + (size_t)l * 1920;
  const int tid = tid_, lane = tid & 63, w = tid >> 6, fr = lane & 15, fq = lane >> 4;
  const int pn = tid >> 4, j0 = (tid & 15) * 4;
  const int jg = lane & 7, i0 = w * 8 + (lane >> 3);
  const int hr = (tid >= 80) ? 1 : 0, hc = tid - hr * 80;
  const int wm = w >> 2, wn = w & 3;
  for (int blk = bfirst; blk < 192; blk += bstride) {
    const int s = blk >> 4, h = (blk >> 1) & 7, d = blk & 1;
    __syncthreads();
    for (int i = tid; i < 640; i += 512) {
      const int which = (i >= 320) ? 1 : 0, c = i - which * 320;
      const int g = c >> 6, e = c & 63;
      const int col = (g < 3) ? (g * 512 + h * 64 + e) : (1536 + (g - 3) * 128 + d * 64 + e);
      MU[i] = which ? mu_n[col] : mu_p[col];
    }
    if (tid < 320) {
      const int which = tid >> 6, e = tid & 63;
      float v;
      if (which == 0) v = p.in[I_W0][(size_t)(l * 2 + d) * 512 + h * 64 + e];
      else if (which == 1) v = p.in[I_A0][(size_t)(l * 2 + d) * 512 + h * 64 + e];
      else if (which == 2) v = p.in[I_K_K][(size_t)l * 512 + h * 64 + e];
      else if (which == 3) v = p.in[I_K_A][(size_t)l * 512 + h * 64 + e];
      else v = p.in[I_R_K][(size_t)(l * 8 + h) * 64 + e];
      CST[tid] = v;
    }
    bf16x8 bw[2], ba[2];
#pragma unroll
    for (int ks = 0; ks < 2; ++ks) {
      bw[ks] = *(const bf16x8*)(WB + W_WUP + (size_t)(d * 512 + h * 64 + wn * 16 + fr) * 64 + ks * 32 + fq * 8);
      ba[ks] = *(const bf16x8*)(WB + W_AUP + (size_t)(d * 512 + h * 64 + wn * 16 + fr) * 64 + ks * 32 + fq * 8);
    }
    _Float16* Y = d ? YB : YF;
    f32x2 S0[4];
#pragma unroll
    for (int q = 0; q < 4; ++q) S0[q] = (f32x2){0.f, 0.f};
    u32x2 G[5], GH;
    {
      const int t = d ? (4095 - pn) : pn;
      const size_t tok = (size_t)s * 4096 + t;
#pragma unroll
      for (int g = 0; g < 5; ++g) {
        const int col = (g < 3) ? (g * 512 + h * 64) : (1536 + (g - 3) * 128 + d * 64);
        G[g] = *(const u32x2*)(PR + tok * PRW + col + j0);
      }
      GH = (u32x2){0u, 0u};
      if (tid < 160) {
        const int tlo = d ? (4095 - 31) : 0;
        const int th = hr ? (tlo + 32) : (tlo - 1);
        const int g = hc >> 4;
        const int col = (g < 3) ? (g * 512 + h * 64) : (1536 + (g - 3) * 128 + d * 64);
        if (th >= 0 && th <= 4095) GH = *(const u32x2*)(PR + ((size_t)s * 4096 + th) * PRW + col + (hc & 15) * 4);
      }
    }
#pragma unroll 1
    for (int ch = 0; ch < 128; ++ch) {
      const int n = ch * 32 + pn;
      const int t = d ? (4095 - n) : n;
      const size_t tok = (size_t)s * 4096 + t;
      const int tlo = d ? (4095 - (ch * 32 + 31)) : (ch * 32);
      const int rrow = t - tlo + 1;
#pragma unroll
      for (int g = 0; g < 5; ++g) *(u32x2*)(RAW + rrow * 320 + g * 64 + j0) = G[g];
      if (tid < 160) *(u32x2*)(RAW + (hr ? 33 : 0) * 320 + (hc >> 4) * 64 + (hc & 15) * 4) = GH;
      __syncthreads();
      if (ch + 1 < 128) {
        const int n2 = n + 32;
        const int t2 = d ? (4095 - n2) : n2;
        const size_t tok2 = (size_t)s * 4096 + t2;
#pragma unroll
        for (int g = 0; g < 5; ++g) {
          const int col = (g < 3) ? (g * 512 + h * 64) : (1536 + (g - 3) * 128 + d * 64);
          G[g] = *(const u32x2*)(PR + tok2 * PRW + col + j0);
        }
        GH = (u32x2){0u, 0u};
        if (tid < 160) {
          const int tlo2 = d ? (tlo - 32) : (tlo + 32);
          const int th = hr ? (tlo2 + 32) : (tlo2 - 1);
          const int g = hc >> 4;
          const int col = (g < 3) ? (g * 512 + h * 64) : (1536 + (g - 3) * 128 + d * 64);
          if (th >= 0 && th <= 4095) GH = *(const u32x2*)(PR + ((size_t)s * 4096 + th) * PRW + col + (hc & 15) * 4);
        }
      }
#pragma unroll
      for (int g = 0; g < 5; ++g) {
        float cur[4], prv[4], nxt[4];
        unpack4(*(const u32x2*)(RAW + rrow * 320 + g * 64 + j0), cur);
        unpack4(*(const u32x2*)(RAW + (rrow - 1) * 320 + g * 64 + j0), prv);
        unpack4(*(const u32x2*)(RAW + (rrow + 1) * 320 + g * 64 + j0), nxt);
        const f32x4 mp0 = *(const f32x4*)(MU + g * 64 + j0);
        const f32x4 mn0 = *(const f32x4*)(MU + 320 + g * 64 + j0);
        f32x4 x0;
#pragma unroll
        for (int e = 0; e < 4; ++e) x0[e] = cur[e] + mp0[e] * (prv[e] - cur[e]) + mn0[e] * (nxt[e] - cur[e]);
        if (g == 0) {
          *(f32x4*)(OPS + 4 * 2048 + pn * 64 + j0) = x0;
        } else if (g == 1) {
          *(f32x4*)(OPS + 3 * 2048 + pn * 64 + j0) = x0;
          const f32x4 kk0 = *(const f32x4*)(CST + 128 + j0);
          float ss = 0.f;
#pragma unroll
          for (int e = 0; e < 4; ++e) { const float a_ = x0[e] * kk0[e]; ss += a_ * a_; }
          ss = red16d(ss);
          if ((tid & 15) == 0) NRM[pn] = frcp(fmaxf(__builtin_amdgcn_sqrtf(ss), 1e-12f));
        } else if (g == 2) {
          *(f32x4*)(VV + pn * 64 + j0) = x0;
        } else if (g == 3) {
          u32x2 pk;
          pk.x = pack2(ftanh(x0[0]), ftanh(x0[1])); pk.y = pack2(ftanh(x0[2]), ftanh(x0[3]));
          *(u32x2*)(TWb + pn * 72 + j0) = pk;
        } else {
          u32x2 pk;
          pk.x = pack2(x0[0], x0[1]); pk.y = pack2(x0[2], x0[3]);
          *(u32x2*)(ADb + pn * 72 + j0) = pk;
        }
      }
      __syncthreads();
      {
        f32x4 cw = {0.f, 0.f, 0.f, 0.f}, ca = {0.f, 0.f, 0.f, 0.f};
#pragma unroll
        for (int ks = 0; ks < 2; ++ks) {
          const bf16x8 aw = *(const bf16x8*)(TWb + (wm * 16 + fr) * 72 + ks * 32 + fq * 8);
          const bf16x8 aa = *(const bf16x8*)(ADb + (wm * 16 + fr) * 72 + ks * 32 + fq * 8);
          cw = __builtin_amdgcn_mfma_f32_16x16x32_bf16(aw, bw[ks], cw, 0, 0, 0);
          ca = __builtin_amdgcn_mfma_f32_16x16x32_bf16(aa, ba[ks], ca, 0, 0, 0);
        }
#pragma unroll
        for (int jj = 0; jj < 4; ++jj) {
          WR[(wm * 16 + fq * 4 + jj) * 64 + wn * 16 + fr] = cw[jj];
          AP[(wm * 16 + fq * 4 + jj) * 64 + wn * 16 + fr] = ca[jj];
        }
      }
      __syncthreads();
      {
        const float inv = NRM[pn];
        float bsum = 0.f;
        const f32x4 wr_ = *(const f32x4*)(WR + pn * 64 + j0) + *(const f32x4*)(CST + j0);
        const f32x4 ap_ = *(const f32x4*)(AP + pn * 64 + j0) + *(const f32x4*)(CST + 64 + j0);
        const f32x4 kr = *(const f32x4*)(OPS + 3 * 2048 + pn * 64 + j0);
        const f32x4 rr = *(const f32x4*)(OPS + 4 * 2048 + pn * 64 + j0);
        const f32x4 kkw = *(const f32x4*)(CST + 128 + j0), kaw = *(const f32x4*)(CST + 192 + j0), rkw = *(const f32x4*)(CST + 256 + j0);
        f32x4 o0, o1, o2, o3;
#pragma unroll
        for (int e = 0; e < 4; ++e) {
          const float sw = sigm(wr_[e]);
          const float dec = __expf(-0.6065306597126334f * sw);
          const float av = sigm(ap_[e]);
          const float kn = kr[e] * kkw[e] * inv;
          const float kd = kr[e] * (1.f + (av - 1.f) * kaw[e]);
          bsum += rr[e] * kd * rkw[e];
          o0[e] = -kn; o1[e] = dec; o2[e] = kn * av; o3[e] = kd;
        }
        *(f32x4*)(OPS + 0 * 2048 + pn * 64 + j0) = o0;
        *(f32x4*)(OPS + 1 * 2048 + pn * 64 + j0) = o1;
        *(f32x4*)(OPS + 2 * 2048 + pn * 64 + j0) = o2;
        *(f32x4*)(OPS + 3 * 2048 + pn * 64 + j0) = o3;
        bsum = red16d(bsum);
        if ((tid & 15) == 0) BON[(tok * 8 + h) * 2 + d] = bsum;
      }
      __syncthreads();
      {
        ScanOps1 oa, ob;
        scan_load1(oa, OPS, VV, 0, jg, i0);
#pragma unroll 1
        for (int nn = 0; nn < 32; nn += 2) {
          scan_load1(ob, OPS, VV, nn + 1, jg, i0);
          scan_step1(oa, S0, YL, nn, jg, i0);
          scan_load1(oa, OPS, VV, (nn + 2) & 31, jg, i0);
          scan_step1(ob, S0, YL, nn + 1, jg, i0);
        }
      }
      __syncthreads();
      {
        typedef __attribute__((ext_vector_type(4))) _Float16 h16x4;
        h16x4 o;
#pragma unroll
        for (int e = 0; e < 4; ++e) o[e] = (_Float16)YL[pn * 64 + j0 + e];
        *(h16x4*)(Y + tok * 512 + h * 64 + j0) = o;
      }
    }
    __syncthreads();
  }
}

DEVI void phase_rwkv_post(int tid_, int vb_, int vg_, const Params& p, int l, char* smem) {
  u16* PR = (u16*)(p.ws + OFF_PR);
  const _Float16* YF = (const _Float16*)(p.ws + OFF_H);
  const _Float16* YB = (const _Float16*)(p.ws + OFF_H + (size_t)NTOK * 512 * 2);
  const float* BON = (const float*)(p.ws + OFF_BONUS);
  const u16* GUPT = (const u16*)(p.ws + OFF_WB) + W_GUP;
  const float* mu_p = p.in[I_MU_PREV] + (size_t)l * 1920;
  const float* mu_n = p.in[I_MU_NEXT] + (size_t)l * 1920;
  const float* gng = p.in[I_GN_G] + (size_t)l * 512;
  const float* gnb = p.in[I_GN_B] + (size_t)l * 512;
  u16* As = (u16*)smem;
  const int tid = tid_, lane = tid & 63, w = tid >> 6, fr = lane & 15, fq = lane >> 4;
  for (int tile = vb_; tile < NTOK / 64; tile += vg_) {
    const size_t tok0 = (size_t)tile * 64;
    {
      const int row = tid >> 2, part = tid & 3;
      const size_t tok = tok0 + row;
      const int t = (int)(tok & 4095);
#pragma unroll
      for (int q = 0; q < 4; ++q) {
        const int col = 1792 + part * 32 + q * 8;
        float cur[8], prv[8], nxt[8];
        load8bf(PR + tok * PRW + col, cur);
        if (t > 0) load8bf(PR + (tok - 1) * PRW + col, prv);
        else {
#pragma unroll
          for (int e = 0; e < 8; ++e) prv[e] = 0.f;
        }
        if (t < 4095) load8bf(PR + (tok + 1) * PRW + col, nxt);
        else {
#pragma unroll
          for (int e = 0; e < 8; ++e) nxt[e] = 0.f;
        }
        float o[8];
#pragma unroll
        for (int e = 0; e < 8; ++e) {
          const float x = cur[e] + mu_p[col + e] * (prv[e] - cur[e]) + mu_n[col + e] * (nxt[e] - cur[e]);
          o[e] = sigm(x);
        }
        u32x4 pk;
        pk.x = pack2(o[0], o[1]); pk.y = pack2(o[2], o[3]); pk.z = pack2(o[4], o[5]); pk.w = pack2(o[6], o[7]);
        *(u32x4*)(As + row * 136 + part * 32 + q * 8) = pk;
      }
    }
    asm volatile("" ::: "memory");
#pragma unroll 1
    for (int chh = 0; chh < 2; ++chh) {
      f32x4 acc[16];
#pragma unroll
      for (int n = 0; n < 16; ++n) acc[n] = (f32x4){0.f, 0.f, 0.f, 0.f};
#pragma unroll
      for (int ks = 0; ks < 4; ++ks) {
        bf16x8 af = *(const bf16x8*)(As + (w * 16 + fr) * 136 + ks * 32 + fq * 8);
#pragma unroll
        for (int n = 0; n < 16; ++n) {
          bf16x8 bg = *(const bf16x8*)(GUPT + (size_t)(chh * 256 + n * 16 + fr) * 128 + ks * 32 + fq * 8);
          acc[n] = __builtin_amdgcn_mfma_f32_16x16x32_bf16(af, bg, acc[n], 0, 0, 0);
        }
      }
#pragma unroll
      for (int hl = 0; hl < 4; ++hl) {
        const int head = chh * 4 + hl;
        asm volatile("" ::: "memory");
#pragma unroll
        for (int j = 0; j < 4; ++j) {
          const size_t tok = tok0 + w * 16 + fq * 4 + j;
          const int t = (int)(tok & 4095);
          float o[4], sum = 0.f;
#pragma unroll
          for (int q = 0; q < 4; ++q) {
            const int col = head * 64 + q * 16 + fr;
            o[q] = (float)YF[tok * 512 + col] + (float)YB[tok * 512 + col];
            sum += o[q];
          }
          const float mean = red16_sum(sum) * (1.f / 64.f);
          float vs = 0.f;
#pragma unroll
          for (int q = 0; q < 4; ++q) { const float dlt = o[q] - mean; vs += dlt * dlt; }
          const float var = red16_sum(vs) * (1.f / 64.f);
          const float rstd = rsqrtf(var + 64e-5f);
          const float bon = BON[(tok * 8 + head) * 2] + BON[(tok * 8 + head) * 2 + 1];
#pragma unroll
          for (int q = 0; q < 4; ++q) {
            const int col = head * 64 + q * 16 + fr;
            const int vc = 1024 + col;
            const float cur = bf2f(PR[tok * PRW + vc]);
            const float prv = (t > 0) ? bf2f(PR[(tok - 1) * PRW + vc]) : 0.f;
            const float nxt = (t < 4095) ? bf2f(PR[(tok + 1) * PRW + vc]) : 0.f;
            const float vsh = cur + mu_p[vc] * (prv - cur) + mu_n[vc] * (nxt - cur);
            const float yv = ((o[q] - mean) * rstd * gng[col] + gnb[col] + bon * vsh) * acc[hl * 4 + q][j];
            PR[tok * PRW + col] = f2bf(yv);
          }
        }
      }
    }
  }
}

DEVI f32x4 ld4bf(const u16* p) {
  const u32x2 u = *(const u32x2*)p;
  f32x4 o;
  o[0] = __uint_as_float(u.x << 16); o[1] = __uint_as_float(u.x & 0xffff0000u);
  o[2] = __uint_as_float(u.y << 16); o[3] = __uint_as_float(u.y & 0xffff0000u);
  return o;
}

DEVI void phase_merge(int tid_, const Params& p, char* smem) {
  const u16* WB = (const u16*)(p.ws + OFF_WB);
  const u16* H = (const u16*)(p.ws + OFF_NK);
  u16* PR = (u16*)(p.ws + OFF_PR);
  const u16* NQ = (const u16*)(p.ws + OFF_NQ);
  u16* TMP = (u16*)(p.ws + OFF_H);
  const int lane = tid_ & 63, wid = tid_ >> 6;
  const int wr = wid >> 2, wc = wid & 3, fr = lane & 15, fq = lane >> 4;
  const bool xmap = (gridDim.x & 7) == 0;
  const int xcd = blockIdx.x & 7;
  const int first = xmap ? (int)(blockIdx.x >> 3) : (int)blockIdx.x;
  const int stride = xmap ? (int)(gridDim.x >> 3) : (int)gridDim.x;
  const int count = xmap ? 24 * 4 : 192 * 4;
  for (int it = first; it < count; it += stride) {
    const int tm = xmap ? (it >> 2) * 8 + xcd : (it >> 2), tn = it & 3;
    const int m0 = tm << 8, n0 = tn << 8;
    f32x4 acc[8][4];
#define MERGE_ZERO() _Pragma("unroll") for (int m = 0; m < 8; ++m) _Pragma("unroll") for (int n = 0; n < 4; ++n) acc[m][n] = (f32x4){0.f, 0.f, 0.f, 0.f}
#define MERGE_RC() const int r = m0 + wr * 128 + m * 16 + fr, c0 = n0 + wc * 64 + n * 16 + fq * 4
    MERGE_ZERO();
    gemm_kloop8<true>(launder(tid_), acc, H + (size_t)m0 * 1024, 1024, WB + W_IN + (size_t)(3456 + n0) * 1024, 1024, 1024, smem);
#pragma unroll
    for (int m = 0; m < 8; ++m)
#pragma unroll
      for (int n = 0; n < 4; ++n) {
        MERGE_RC();
        f32x4 o;
#pragma unroll
        for (int j = 0; j < 4; ++j) o[j] = sigm(acc[m][n][j]);
        store4bf(PR + (size_t)r * PRW + 512 + c0, o);
      }
    MERGE_ZERO();
    gemm_kloop8<true>(launder(tid_), acc, PR + (size_t)m0 * PRW, PRW, WB + W_BRR + (size_t)n0 * 512, 512, 512, smem);
#pragma unroll
    for (int m = 0; m < 8; ++m)
#pragma unroll
      for (int n = 0; n < 4; ++n) {
        MERGE_RC();
        u16* dst = PR + (size_t)r * PRW + 512 + c0;
        store4bf(dst, ld4bf(dst) * acc[m][n]);
      }
    MERGE_ZERO();
    gemm_kloop8<true>(launder(tid_), acc, H + (size_t)m0 * 1024, 1024, WB + W_IN + (size_t)(4480 + n0) * 1024, 1024, 1024, smem);
#pragma unroll
    for (int m = 0; m < 8; ++m)
#pragma unroll
      for (int n = 0; n < 4; ++n) {
        MERGE_RC();
        f32x4 o;
#pragma unroll
        for (int j = 0; j < 4; ++j) o[j] = sigm(acc[m][n][j]);
        store4bf(TMP + (size_t)r * 1024 + c0, o);
      }
    MERGE_ZERO();
    gemm_kloop8<true>(launder(tid_), acc, NQ + (size_t)m0 * 512, 512, WB + W_BRN + (size_t)n0 * 512, 512, 512, smem);
#pragma unroll
    for (int m = 0; m < 8; ++m)
#pragma unroll
      for (int n = 0; n < 4; ++n) {
        MERGE_RC();
        u16* dst = PR + (size_t)r * PRW + 512 + c0;
        store4bf(dst, ld4bf(dst) + ld4bf(TMP + (size_t)r * 1024 + c0) * acc[m][n]);
      }
#undef MERGE_ZERO
#undef MERGE_RC
  }
}


DEVI void phase_xattn(int tid_, int vb_, int vg_, const Params& p, char* smem) {
  const u16* Q = (const u16*)(p.ws + OFF_PR);
  u16* O = (u16*)(p.ws + OFF_NQ);
  const u16* KVK = (const u16*)(p.ws + OFF_KVK);
  const u16* KVT = (const u16*)(p.ws + OFF_KVT);
  const int lane = tid_ & 63, w = tid_ >> 6, fr = lane & 15, fq = lane >> 4;
  u16* Pw = (u16*)smem + w * (32 * 264);
  for (int t = vb_; t < (NTOK / 128) * 4; t += vg_) {
    const int hh = t & 3;
    const size_t tok0 = (size_t)(t >> 2) * 128 + w * 32;
    const int s = (int)(tok0 >> 12);
    f32x4 acc[2][16];
#pragma unroll
    for (int mt = 0; mt < 2; ++mt)
#pragma unroll
      for (int n = 0; n < 16; ++n) acc[mt][n] = (f32x4){0.f, 0.f, 0.f, 0.f};
#pragma unroll 1
    for (int ks = 0; ks < 8; ++ks) {
      const bf16x8 aq0 = *(const bf16x8*)(Q + (tok0 + fr) * 1024 + hh * 256 + ks * 32 + fq * 8);
      const bf16x8 aq1 = *(const bf16x8*)(Q + (tok0 + 16 + fr) * 1024 + hh * 256 + ks * 32 + fq * 8);
#pragma unroll
      for (int n = 0; n < 16; ++n) {
        const bf16x8 bk = *(const bf16x8*)(KVK + (size_t)(s * 256 + n * 16 + fr) * 1024 + hh * 256 + ks * 32 + fq * 8);
        acc[0][n] = __builtin_amdgcn_mfma_f32_16x16x32_bf16(bk, aq0, acc[0][n], 0, 0, 0);
        acc[1][n] = __builtin_amdgcn_mfma_f32_16x16x32_bf16(bk, aq1, acc[1][n], 0, 0, 0);
      }
    }
    float sm[2];
#pragma unroll
    for (int mt = 0; mt < 2; ++mt) {
      float m = -1e30f;
#pragma unroll
      for (int n = 0; n < 16; ++n)
#pragma unroll
        for (int j = 0; j < 4; ++j) m = fmaxf(m, acc[mt][n][j]);
      m = red4x_max(m) * 0.0625f;
      float ssum = 0.f;
#pragma unroll
      for (int n = 0; n < 16; ++n) {
        f32x4 e;
#pragma unroll
        for (int j = 0; j < 4; ++j) { e[j] = __expf(acc[mt][n][j] * 0.0625f - m); ssum += e[j]; }
        store4bf(Pw + (mt * 16 + fr) * 264 + n * 16 + fq * 4, e);
      }
      sm[mt] = 1.f / red4x_sum(ssum);
    }
#pragma unroll
    for (int mt = 0; mt < 2; ++mt)
#pragma unroll
      for (int n = 0; n < 16; ++n) acc[mt][n] = (f32x4){0.f, 0.f, 0.f, 0.f};
#pragma unroll 1
    for (int ks = 0; ks < 8; ++ks) {
      const bf16x8 ap0 = *(const bf16x8*)(Pw + fr * 264 + ks * 32 + fq * 8);
      const bf16x8 ap1 = *(const bf16x8*)(Pw + (16 + fr) * 264 + ks * 32 + fq * 8);
#pragma unroll
      for (int n = 0; n < 16; ++n) {
        const bf16x8 bv = *(const bf16x8*)(KVT + (size_t)(s * 1024 + hh * 256 + n * 16 + fr) * 256 + ks * 32 + fq * 8);
        acc[0][n] = __builtin_amdgcn_mfma_f32_16x16x32_bf16(bv, ap0, acc[0][n], 0, 0, 0);
        acc[1][n] = __builtin_amdgcn_mfma_f32_16x16x32_bf16(bv, ap1, acc[1][n], 0, 0, 0);
      }
    }
#pragma unroll
    for (int mt = 0; mt < 2; ++mt)
#pragma unroll
      for (int n = 0; n < 16; ++n)
        store4bf(O + (tok0 + mt * 16 + fr) * 1024 + hh * 256 + n * 16 + fq * 4, acc[mt][n] * sm[mt]);
  }
}

constexpr int HALF_SMEM = 78720;

DEVI void run_phase(int tid_, const Params& p, int ph, char* smem) {
  const int half = tid_ >> 8, vt = tid_ & 255;
  const int vb_ = blockIdx.x * 2 + half, vg_ = gridDim.x * 2;
  char* smh = smem + half * HALF_SMEM;
  if (ph == 2 * NPH_LAYER) { phase_final_norm(vt, vb_, vg_, p); return; }
  const int l = ph / NPH_LAYER, q = ph % NPH_LAYER;
  u16* WB = (u16*)(p.ws + OFF_WB);
  u16* H = (u16*)(p.ws + OFF_H);
  u16* PR = (u16*)(p.ws + OFF_PR);
  u16* NQ = (u16*)(p.ws + OFF_NQ);
  float* X = p.X;
  auto epi_res = [&](int r, int c0, f32x4 v) {
    f32x4* px = (f32x4*)(X + (size_t)r * 1024 + c0);
    *px = *px + v;
  };
  constexpr int NONS = 1 << 30;
  switch (q) {
    case 0:
      phase_conv(vt, vb_, vg_, p, l, smh);
      phase_norm(vt, vb_, vg_, p, p.in[I_NORM_MIX] + (size_t)l * 1024, l == 0);
      phase_norm_mem(vt, vb_, vg_, p, p.in[I_NORM_MEM] + (size_t)l * 1024);
      break;
    case 1: phase_p_gemm(tid_, p, smem); break;
    case 2:
      if (gridDim.x >= 224) {
        if (blockIdx.x < 192) phase_scan8(tid_, p, l, smem, blockIdx.x, gridDim.x);
        else phase_nat(vt, p, l, smh, vb_ - 384, vg_ - 384);
      } else {
        phase_scan(vt, p, l, smh, vb_, vg_);
        __syncthreads();
        phase_nat(vt, p, l, smh, vb_, vg_);
      }
      break;
    case 3:
      phase_rwkv_post(vt, vb_, vg_, p, l, smh);
      phase_norm(vt, vb_, vg_, p, p.in[I_NORM_MIX] + (size_t)l * 1024, false, OFF_NK);
      break;
    case 4: phase_merge(tid_, p, smem); break;
    case 5: gemm_phase8(tid_, PR + 512, PRW, WB + W_OUT, 1024, 1024, NTOK, 1024, smem, NONS, epi_res, NoEpi()); break;
    case 6: phase_norm(vt, vb_, vg_, p, p.in[I_NORM_X] + (size_t)l * 1024, false); break;
    case 7:
      gemm_phase8(tid_, H, 1024, WB + W_XQ, 1024, 1024, NTOK, 1024, smem, NONS,
                 [&](int r, int c0, f32x4 v) { store4bf(PR + (size_t)r * 1024 + c0, v); }, NoEpi());
      break;
    case 8: phase_xattn(vt, vb_, vg_, p, smh); break;
    case 9: gemm_phase8(tid_, NQ, 1024, WB + W_XO, 1024, 1024, NTOK, 1024, smem, NONS, epi_res, NoEpi()); break;
    case 10: phase_norm(vt, vb_, vg_, p, p.in[I_NORM_FF] + (size_t)l * 1024, false); break;
    case 11:
    case 13: {
      const int hf = (q == 13);
      gemm_phase8(tid_, H, 1024, WB + W_FF1 + (size_t)hf * 2048 * 1024, 1024, 1024, NTOK, 2048, smem, NONS,
                 [&](int r, int c0, f32x4 v) {
                   f32x4 o;
#pragma unroll
                   for (int j = 0; j < 4; ++j) { const float x = fmaxf(v[j], 0.f); o[j] = x * x; }
                   store4bf(PR + (size_t)r * 2048 + c0, o);
                 }, NoEpi());
    } break;
    case 12:
    case 14: {
      const int hf = (q == 14);
      gemm_phase8(tid_, PR, 2048, WB + W_FF2 + (size_t)hf * 2048, 4096, 2048, NTOK, 1024, smem, NONS, epi_res, NoEpi());
    } break;
  }
}

#define XB_TMO      128
#define XB_XCNT(j)  (256  + 64 * (j))
#define XB_XSUB(j)  (1280 + 64 * (j))
#define XB_XGEN(j)  (2304 + 64 * (j))
#define XB_TOP      3328
#define XB_TOPGEN   3392
#define XCD_BAR_WORDS 3456
#define XB_SPIN_CAP (1u << 20)
#define LAS __attribute__((address_space(3)))

DEVI unsigned xb_ld(unsigned* p) { return __hip_atomic_load(p, __ATOMIC_RELAXED, __HIP_MEMORY_SCOPE_AGENT); }
DEVI unsigned xb_add(unsigned* p, unsigned v) { return __hip_atomic_fetch_add(p, v, __ATOMIC_RELAXED, __HIP_MEMORY_SCOPE_AGENT); }
DEVI unsigned xb_xcc_id() { return (unsigned)__builtin_amdgcn_s_getreg((3 << 11) | 20) & 0xFu; }
#define XB_SPIN(cond, bar) do { unsigned _sp = 0; while (cond) { __builtin_amdgcn_s_sleep(1); \
    if ((++_sp & 255u) == 0u) { if (xb_ld(&(bar)[XB_TMO])) break; if (_sp > XB_SPIN_CAP) { atomicAdd(&(bar)[XB_TMO], 1u); break; } } } } while (0)

struct XcdBarrier {
  unsigned* bar; unsigned x;
  volatile LAS unsigned* st;
};
DEVI XcdBarrier xcd_barrier_post(unsigned* bar, volatile LAS unsigned* st) {
  XcdBarrier b; b.bar = bar; b.x = xb_xcc_id(); b.st = st;
  if (threadIdx.x == 0) (void)xb_add(&bar[XB_XCNT(b.x)], 1u);
  return b;
}
DEVI void xcd_barrier_complete(unsigned* bar, unsigned x, unsigned& nloc, unsigned& nx) {
  const unsigned G = gridDim.x * gridDim.y * gridDim.z;
  unsigned sum, cnt, mine, sp = 0u;
  for (;;) {
    sum = 0u; cnt = 0u; mine = 0u;
#pragma unroll
    for (unsigned j = 0; j < 16; ++j) { const unsigned c = xb_ld(&bar[XB_XCNT(j)]); sum += c; cnt += (c > 0u) ? 1u : 0u; mine = (j == x) ? c : mine; }
    if (sum == G) break;
    __builtin_amdgcn_s_sleep(1);
    if ((++sp & 255u) == 0u) { if (xb_ld(&bar[XB_TMO])) break; if (sp > XB_SPIN_CAP) { atomicAdd(&bar[XB_TMO], 1u); break; } }
  }
  nloc = mine > 0u ? mine : 1u; nx = cnt > 0u ? cnt : 1u;
}
DEVI void xcd_barrier(const XcdBarrier& b) {
  asm volatile("s_waitcnt vmcnt(0)" ::: "memory");
  __syncthreads();
  if (threadIdx.x == 0) {
    unsigned* bar = b.bar;
    __builtin_amdgcn_s_waitcnt(0);
    unsigned nloc = b.st[0], nx = b.st[1];
    if (nloc == 0u) { xcd_barrier_complete(bar, b.x, nloc, nx); b.st[0] = nloc; b.st[1] = nx; }
    const unsigned old = xb_add(&bar[XB_XSUB(b.x)], 1u);
    const unsigned gen = old / nloc;
    if (old + 1u == (gen + 1u) * nloc) {
      __builtin_amdgcn_fence(__ATOMIC_RELEASE, "agent");
      asm volatile("s_waitcnt vmcnt(0)" ::: "memory");
      const unsigned og = xb_add(&bar[XB_TOP], 1u);
      const unsigned tg = og / nx;
      if (og + 1u == (tg + 1u) * nx) xb_add(&bar[XB_TOPGEN], 1u);
      else XB_SPIN(xb_ld(&bar[XB_TOPGEN]) == tg, bar);
      __builtin_amdgcn_fence(__ATOMIC_ACQUIRE, "agent");
      xb_add(&bar[XB_XGEN(b.x)], 1u);
      asm volatile("s_waitcnt vmcnt(0)" ::: "memory");
    } else {
      XB_SPIN(xb_ld(&bar[XB_XGEN(b.x)]) == gen, bar);
      __builtin_amdgcn_fence(__ATOMIC_ACQUIRE, "agent");
      asm volatile("s_waitcnt vmcnt(0)" ::: "memory");
    }
  }
  __syncthreads();
}

__global__ void __launch_bounds__(512, 2) mega_kernel(Params p, int ph0, int ph1) {
  __shared__ __attribute__((aligned(16))) char smem[2 * HALF_SMEM];
  __shared__ __attribute__((aligned(16))) unsigned xb_words[4];
  if (threadIdx.x == 0) { xb_words[0] = 0u; xb_words[1] = 0u; xb_words[2] = 0u; xb_words[3] = 0u; }
  __syncthreads();
  XcdBarrier xb = xcd_barrier_post((unsigned*)(p.ws + OFF_BAR), (volatile LAS unsigned*)xb_words);
  for (int ph = ph0; ph < ph1; ++ph) {
    if (ph == ph0 + 1) cg::this_grid().sync();
    else if (ph > ph0) xcd_barrier(xb);
    int tid_ = threadIdx.x;
    asm volatile("" : "+v"(tid_));
    run_phase(tid_, p, ph, smem);
  }
}

extern "C" void kernel_launch(void* const* d_in, const int* in_sizes, int n_in, void* d_out, int out_size, void* d_ws,
                              size_t ws_size, hipStream_t stream) {
  if (ws_size < WS_NEED || n_in < 31) return;
  Params p{};
  for (int i = 0; i < 31; ++i) p.in[i] = (const float*)d_in[i];
  p.X = (float*)d_out;
  p.ws = (char*)d_ws;
  static int grid_blocks = 0;
  if (!grid_blocks) {
    int dev = 0, cus = 0, per_cu = 0;
    hipGetDevice(&dev);
    hipDeviceGetAttribute(&cus, hipDeviceAttributeMultiprocessorCount, dev);
    hipOccupancyMaxActiveBlocksPerMultiprocessor(&per_cu, mega_kernel, 512, 0);
    if (per_cu > 1) per_cu = 1;
    if (per_cu < 1) per_cu = 1;
    grid_blocks = cus * per_cu;
  }
  hipMemsetAsync((char*)d_ws + OFF_BAR, 0, 16384, stream);
  int ph0 = 0, ph1 = NPHASES;
  void* args[] = {&p, &ph0, &ph1};
  hipLaunchCooperativeKernel((void*)mega_kernel, dim3(grid_blocks), dim3(512), args, 0, stream);
}
```

```cpp
#include <hip/hip_runtime.h>
#include <hip/hip_cooperative_groups.h>
#include <stdint.h>
namespace cg = cooperative_groups;

typedef unsigned short u16;
typedef __attribute__((ext_vector_type(8))) short bf16x8;
typedef __attribute__((ext_vector_type(4))) float f32x4;
typedef __attribute__((ext_vector_type(8))) _Float16 h16x8;
typedef __attribute__((ext_vector_type(4))) unsigned int u32x4;
typedef __attribute__((ext_vector_type(2))) unsigned int u32x2;

#define DEVI __device__ __forceinline__

constexpr int NTOK = 49152;
constexpr int SEQ_T = 4096;
constexpr int PRW = 1920;
constexpr int NPH_LAYER = 15;
constexpr int NPHASES = 2 * NPH_LAYER + 1;
constexpr int SMEM_BYTES = 78720;

constexpr size_t OFF_WB = 0;
constexpr size_t WB_BYTES = 20512768ull * 2;
constexpr size_t OFF_H = OFF_WB + WB_BYTES;
constexpr size_t OFF_PR = OFF_H + (size_t)NTOK * 1024 * 2;
constexpr size_t OFF_NQ = OFF_PR + (size_t)NTOK * PRW * 2;
constexpr size_t OFF_NK = OFF_NQ + (size_t)NTOK * 512 * 2;
constexpr size_t OFF_NV = OFF_NK + (size_t)NTOK * 512 * 2;
constexpr size_t OFF_KVK = OFF_NV + (size_t)NTOK * 512 * 2;
constexpr size_t OFF_KVT = OFF_KVK + (size_t)3072 * 1024 * 2;
constexpr size_t OFF_MEMH = OFF_KVT + (size_t)3072 * 1024 * 2;
constexpr size_t OFF_BONUS = OFF_MEMH + (size_t)3072 * 1024 * 2;
constexpr size_t OFF_BAR = OFF_BONUS + (size_t)NTOK * 16 * 4;
constexpr size_t WS_NEED = OFF_BAR + 16384;

constexpr size_t W_IN = 0;
constexpr size_t W_BRR = W_IN + (size_t)5504 * 1024;
constexpr size_t W_BRN = W_BRR + (size_t)1024 * 512;
constexpr size_t W_OUT = W_BRN + (size_t)1024 * 512;
constexpr size_t W_XQ = W_OUT + (size_t)1024 * 1024;
constexpr size_t W_XKV = W_XQ + (size_t)1024 * 1024;
constexpr size_t W_XO = W_XKV + (size_t)2048 * 1024;
constexpr size_t W_FF1 = W_XO + (size_t)1024 * 1024;
constexpr size_t W_FF2 = W_FF1 + (size_t)4096 * 1024;
constexpr size_t W_GUP = W_FF2 + (size_t)4096 * 1024;
constexpr size_t W_WUP = W_GUP + (size_t)512 * 128;
constexpr size_t W_AUP = W_WUP + (size_t)2 * 512 * 64;

enum { I_XP = 0, I_XS, I_MP, I_MS, I_NORM_MIX, I_W_IN, I_MU_PREV, I_MU_NEXT, I_W0, I_W_UP, I_A0, I_A_UP,
       I_G_UP, I_K_K, I_K_A, I_R_K, I_GN_G, I_GN_B, I_RPB, I_W_BR_RWKV, I_W_BR_NAT, I_W_OUT, I_NORM_X,
       I_NORM_MEM, I_W_XQ, I_W_XKV, I_W_XO, I_NORM_FF, I_W_FF1, I_W_FF2, I_NORM_FINAL };

struct Params {
  const float* in[31];
  float* X;
  char* ws;
};

DEVI u16 f2bf(float f) {
  uint32_t u = __float_as_uint(f);
  u += 0x7FFFu + ((u >> 16) & 1u);
  return (u16)(u >> 16);
}
DEVI float bf2f(u16 h) { return __uint_as_float(((uint32_t)h) << 16); }
DEVI uint32_t pack2(float a, float b) { return (uint32_t)f2bf(a) | ((uint32_t)f2bf(b) << 16); }
DEVI float frcp(float x) { return __builtin_amdgcn_rcpf(x); }
DEVI float sigm(float x) { return frcp(1.f + __expf(-x)); }
DEVI float ftanh(float x) { return 1.f - 2.f * frcp(__expf(2.f * x) + 1.f); }
DEVI void unpack8(u32x4 u, float* o) {
  o[0] = __uint_as_float(u.x << 16); o[1] = __uint_as_float(u.x & 0xffff0000u);
  o[2] = __uint_as_float(u.y << 16); o[3] = __uint_as_float(u.y & 0xffff0000u);
  o[4] = __uint_as_float(u.z << 16); o[5] = __uint_as_float(u.z & 0xffff0000u);
  o[6] = __uint_as_float(u.w << 16); o[7] = __uint_as_float(u.w & 0xffff0000u);
}
DEVI void load8bf(const u16* p, float* o) { unpack8(*(const u32x4*)p, o); }
DEVI float wave_sum(float v) {
  v += __shfl_xor(v, 32); v += __shfl_xor(v, 16); v += __shfl_xor(v, 8);
  v += __shfl_xor(v, 4); v += __shfl_xor(v, 2); v += __shfl_xor(v, 1);
  return v;
}
DEVI float red4x_sum(float v) { v += __shfl_xor(v, 16); v += __shfl_xor(v, 32); return v; }
DEVI float red4x_max(float v) { v = fmaxf(v, __shfl_xor(v, 16)); v = fmaxf(v, __shfl_xor(v, 32)); return v; }
DEVI float red16_sum(float v) {
  v += __shfl_xor(v, 1); v += __shfl_xor(v, 2); v += __shfl_xor(v, 4); v += __shfl_xor(v, 8);
  return v;
}
DEVI float red16_max(float v) {
  v = fmaxf(v, __shfl_xor(v, 1)); v = fmaxf(v, __shfl_xor(v, 2));
  v = fmaxf(v, __shfl_xor(v, 4)); v = fmaxf(v, __shfl_xor(v, 8));
  return v;
}

DEVI void conv_tile(int tid_, const float* src, int K, int N, u16* dst, int tile, char* smem) {
  float (*s)[65] = (float (*)[65])smem;
  const int nN = N >> 6;
  const int tk = tile / nN, tn = tile - tk * nN;
  const int tx = tid_ & 63, ty = tid_ >> 6;
  for (int r = ty; r < 64; r += 4) s[r][tx] = src[(size_t)(tk * 64 + r) * N + tn * 64 + tx];
  __syncthreads();
  for (int r = ty; r < 64; r += 4) dst[(size_t)(tn * 64 + r) * K + tk * 64 + tx] = f2bf(s[tx][r]);
  __syncthreads();
}

DEVI void phase_conv(int tid_, int vb_, int vg_, const Params& p, int l, char* smem) {
  u16* WB = (u16*)(p.ws + OFF_WB);
  const int c0 = 1376, c1 = c0 + 128, c2 = c1 + 128, c3 = c2 + 256, c4 = c3 + 256, c5 = c4 + 512,
            c6 = c5 + 256, c7 = c6 + 1024, c8 = c7 + 1024, c9 = c8 + 16, c10 = c9 + 16, c11 = c10 + 16;
  for (int t = vb_; t < c11; t += vg_) {
    if (t < c0) conv_tile(tid_, p.in[I_W_IN] + (size_t)l * 1024 * 5504, 1024, 5504, WB + W_IN, t, smem);
    else if (t < c1) conv_tile(tid_, p.in[I_W_BR_RWKV] + (size_t)l * 512 * 1024, 512, 1024, WB + W_BRR, t - c0, smem);
    else if (t < c2) conv_tile(tid_, p.in[I_W_BR_NAT] + (size_t)l * 512 * 1024, 512, 1024, WB + W_BRN, t - c1, smem);
    else if (t < c3) conv_tile(tid_, p.in[I_W_OUT] + (size_t)l * 1024 * 1024, 1024, 1024, WB + W_OUT, t - c2, smem);
    else if (t < c4) conv_tile(tid_, p.in[I_W_XQ] + (size_t)l * 1024 * 1024, 1024, 1024, WB + W_XQ, t - c3, smem);
    else if (t < c5) conv_tile(tid_, p.in[I_W_XKV] + (size_t)l * 1024 * 2048, 1024, 2048, WB + W_XKV, t - c4, smem);
    else if (t < c6) conv_tile(tid_, p.in[I_W_XO] + (size_t)l * 1024 * 1024, 1024, 1024, WB + W_XO, t - c5, smem);
    else if (t < c7) conv_tile(tid_, p.in[I_W_FF1] + (size_t)l * 1024 * 4096, 1024, 4096, WB + W_FF1, t - c6, smem);
    else if (t < c8) conv_tile(tid_, p.in[I_W_FF2] + (size_t)l * 4096 * 1024, 4096, 1024, WB + W_FF2, t - c7, smem);
    else if (t < c9) conv_tile(tid_, p.in[I_G_UP] + (size_t)l * 128 * 512, 128, 512, WB + W_GUP, t - c8, smem);
    else if (t < c10) { const int dd = (t - c9) >> 3; conv_tile(tid_, p.in[I_W_UP] + (size_t)(l * 2 + dd) * 64 * 512, 64, 512, WB + W_WUP + (size_t)dd * 512 * 64, (t - c9) & 7, smem); }
    else { const int dd = (t - c10) >> 3; conv_tile(tid_, p.in[I_A_UP] + (size_t)(l * 2 + dd) * 64 * 512, 64, 512, WB + W_AUP + (size_t)dd * 512 * 64, (t - c10) & 7, smem); }
  }
}

DEVI void norm_row_bf16(int tid_, const float* src, const float* g, u16* dst, float* xcopy) {
  const int lane = tid_ & 63;
  float4 v[4];
  float ss = 0.f;
#pragma unroll
  for (int i = 0; i < 4; ++i) {
    v[i] = ((const float4*)src)[lane + i * 64];
    ss += v[i].x * v[i].x + v[i].y * v[i].y + v[i].z * v[i].z + v[i].w * v[i].w;
  }
  ss = wave_sum(ss);
  const float rs = rsqrtf(ss * (1.f / 1024.f) + 1e-6f);
#pragma unroll
  for (int i = 0; i < 4; ++i) {
    float4 gg = ((const float4*)g)[lane + i * 64];
    u32x2 o;
    o.x = pack2(v[i].x * rs * gg.x, v[i].y * rs * gg.y);
    o.y = pack2(v[i].z * rs * gg.z, v[i].w * rs * gg.w);
    ((u32x2*)dst)[lane + i * 64] = o;
    if (xcopy) ((float4*)xcopy)[lane + i * 64] = v[i];
  }
}

DEVI void phase_norm(int tid_, int vb_, int vg_, const Params& p, const float* g, bool from_input, size_t hoff = OFF_H) {
  u16* H = (u16*)(p.ws + hoff);
  const int wid = tid_ >> 6;
  for (int r = vb_ * 4 + wid; r < NTOK; r += vg_ * 4) {
    const float* src;
    if (from_input) src = (r < 32768) ? p.in[I_XP] + (size_t)r * 1024 : p.in[I_XS] + (size_t)(r - 32768) * 1024;
    else src = p.X + (size_t)r * 1024;
    norm_row_bf16(tid_, src, g, H + (size_t)r * 1024, from_input ? p.X + (size_t)r * 1024 : nullptr);
  }
}
DEVI void phase_norm_mem(int tid_, int vb_, int vg_, const Params& p, const float* g) {
  u16* MH = (u16*)(p.ws + OFF_MEMH);
  const int wid = tid_ >> 6;
  for (int r = vb_ * 4 + wid; r < 3072; r += vg_ * 4) {
    const float* src = (r < 2048) ? p.in[I_MP] + (size_t)r * 1024 : p.in[I_MS] + (size_t)(r - 2048) * 1024;
    norm_row_bf16(tid_, src, g, MH + (size_t)r * 1024, nullptr);
  }
}
DEVI void phase_final_norm(int tid_, int vb_, int vg_, const Params& p) {
  const float* g = p.in[I_NORM_FINAL];
  const int wid = tid_ >> 6, lane = tid_ & 63;
  for (int r = vb_ * 4 + wid; r < NTOK; r += vg_ * 4) {
    float* row = p.X + (size_t)r * 1024;
    float4 v[4];
    float ss = 0.f;
#pragma unroll
    for (int i = 0; i < 4; ++i) {
      v[i] = ((const float4*)row)[lane + i * 64];
      ss += v[i].x * v[i].x + v[i].y * v[i].y + v[i].z * v[i].z + v[i].w * v[i].w;
    }
    ss = wave_sum(ss);
    const float rs = rsqrtf(ss * (1.f / 1024.f) + 1e-6f);
#pragma unroll
    for (int i = 0; i < 4; ++i) {
      float4 gg = ((const float4*)g)[lane + i * 64];
      float4 o;
      o.x = v[i].x * rs * gg.x; o.y = v[i].y * rs * gg.y; o.z = v[i].z * rs * gg.z; o.w = v[i].w * rs * gg.w;
      ((float4*)row)[lane + i * 64] = o;
    }
  }
}

template <int OFF>
DEVI bf16x8 lds_rd128(uint32_t addr) {
  bf16x8 r;
  asm volatile("ds_read_b128 %0, %1 offset:%2" : "=v"(r) : "v"(addr), "n"(OFF));
  return r;
}

template <int NW, bool SWAP>
DEVI void gemm_kloop(int tid_, f32x4 (&acc)[4][NW], const u16* __restrict__ A, int lda, const u16* __restrict__ Bt, int ldb,
                     int K, char* smem) {
  constexpr int STG = 8192 + NW * 2048;
  constexpr int NB = NW / 2;
  const int tid = tid_, lane = tid & 63, wid = tid >> 6;
  const int wr = wid >> 1, wc = wid & 1, fr = lane & 15, fq = lane >> 4;
  const int lrow = lane >> 2, lphys = lane & 3, lhi = lane >> 4;
  const int gsw = (4 - lhi) & 3;
  const u16* ga[2];
  const u16* gb[NB];
#pragma unroll
  for (int q = 0; q < 2; ++q) ga[q] = A + (size_t)((wid * 2 + q) * 16 + lrow) * lda + (lphys ^ gsw) * 8;
#pragma unroll
  for (int q = 0; q < NB; ++q) gb[q] = Bt + (size_t)((wid * NB + q) * 16 + lrow) * ldb + (lphys ^ gsw) * 8;
  const int rsw = (4 - ((fr >> 2) & 3)) & 3;
  const int ch = (fq ^ rsw) * 16;
  const int nk = K >> 5;
  const uint32_t lds_base = (uint32_t)(size_t)(__attribute__((address_space(3))) char*)smem;
  const uint32_t aoff = (uint32_t)((wr * 64 + fr) * 64 + ch);
  const uint32_t boff = (uint32_t)(8192 + (wc * 16 * NW + fr) * 64 + ch);
  asm volatile("s_waitcnt vmcnt(0)" ::: "memory");
  __syncthreads();
#define GEMM_ISSUE(kt_)                                                                                              \
  do {                                                                                                               \
    char* nb_ = smem + ((kt_) & 3) * STG;                                                                            \
    _Pragma("unroll") for (int q = 0; q < 2; ++q) __builtin_amdgcn_global_load_lds(                                  \
        (const unsigned*)(ga[q] + (kt_) * 32),                                                                       \
        (__attribute__((address_space(3))) unsigned*)(nb_ + (wid * 2 + q) * 1024 + lane * 16), 16, 0, 0);            \
    _Pragma("unroll") for (int q = 0; q < NB; ++q) __builtin_amdgcn_global_load_lds(                                 \
        (const unsigned*)(gb[q] + (kt_) * 32),                                                                       \
        (__attribute__((address_space(3))) unsigned*)(nb_ + 8192 + (wid * NB + q) * 1024 + lane * 16), 16, 0, 0);    \
  } while (0)
  GEMM_ISSUE(0);
  if (nk > 1) GEMM_ISSUE(1);
  if (nk > 2) GEMM_ISSUE(2);
  for (int kt = 0; kt < nk; ++kt) {
    if (kt + 2 < nk) {
      if (NW == 4) asm volatile("s_waitcnt vmcnt(8)" ::: "memory");
      else asm volatile("s_waitcnt vmcnt(6)" ::: "memory");
    } else if (kt + 1 < nk) {
      if (NW == 4) asm volatile("s_waitcnt vmcnt(4)" ::: "memory");
      else asm volatile("s_waitcnt vmcnt(3)" ::: "memory");
    } else {
      asm volatile("s_waitcnt vmcnt(0)" ::: "memory");
    }
    __builtin_amdgcn_s_barrier();
    asm volatile("" ::: "memory");
    if (kt + 3 < nk) GEMM_ISSUE(kt + 3);
    const uint32_t sb = lds_base + (kt & 3) * STG;
    bf16x8 af[4], bfr[4];
    af[0] = lds_rd128<0>(sb + aoff); af[1] = lds_rd128<1024>(sb + aoff);
    af[2] = lds_rd128<2048>(sb + aoff); af[3] = lds_rd128<3072>(sb + aoff);
    bfr[0] = lds_rd128<0>(sb + boff); bfr[1] = lds_rd128<1024>(sb + boff);
    if (NW == 4) {
      bfr[2] = lds_rd128<2048>(sb + boff); bfr[3] = lds_rd128<3072>(sb + boff);
      asm volatile("s_waitcnt lgkmcnt(0)" : "+v"(af[0]), "+v"(af[1]), "+v"(af[2]), "+v"(af[3]),
                   "+v"(bfr[0]), "+v"(bfr[1]), "+v"(bfr[2]), "+v"(bfr[3]));
    } else {
      asm volatile("s_waitcnt lgkmcnt(0)" : "+v"(af[0]), "+v"(af[1]), "+v"(af[2]), "+v"(af[3]), "+v"(bfr[0]), "+v"(bfr[1]));
    }
#pragma unroll
    for (int m = 0; m < 4; ++m)
#pragma unroll
      for (int n = 0; n < NW; ++n) {
        if (SWAP) acc[m][n] = __builtin_amdgcn_mfma_f32_16x16x32_bf16(bfr[n], af[m], acc[m][n], 0, 0, 0);
        else acc[m][n] = __builtin_amdgcn_mfma_f32_16x16x32_bf16(af[m], bfr[n], acc[m][n], 0, 0, 0);
      }
  }
#undef GEMM_ISSUE
}

DEVI int launder(int x) { asm volatile("" : "+v"(x)); return x; }

template <int NW>
DEVI void zero_acc(f32x4 (&acc)[4][NW]) {
#pragma unroll
  for (int m = 0; m < 4; ++m)
#pragma unroll
    for (int n = 0; n < NW; ++n) acc[m][n] = (f32x4){0.f, 0.f, 0.f, 0.f};
}

struct NoEpi { DEVI void operator()(int, int, f32x4) const {} };

template <class EpiS, class EpiN>
DEVI void gemm_phase(int tid_, const u16* A, int lda, const u16* Bt, int ldb, int K, int M, int N, char* smem, int ns_from,
                     EpiS epiS, EpiN epiN) {
  const int nN = N >> 7, nM = M >> 7;
  const int lane = tid_ & 63, wid = tid_ >> 6;
  const int wr = wid >> 1, wc = wid & 1, fr = lane & 15, fq = lane >> 4;
  const int xcd = blockIdx.x & 7, jloc = blockIdx.x >> 3, nloc = gridDim.x >> 3;
  for (int lt = jloc; lt < (nM >> 3) * nN; lt += nloc) {
    const int tml = lt / nN, tn = lt - tml * nN;
    const int tm = tml * 8 + xcd;
    const int m0 = tm << 7, n0 = tn << 7;
    f32x4 acc[4][4];
    zero_acc(acc);
    if (n0 < ns_from) {
      gemm_kloop<4, true>(tid_, acc, A + (size_t)m0 * lda, lda, Bt + (size_t)n0 * ldb, ldb, K, smem);
#pragma unroll
      for (int m = 0; m < 4; ++m)
#pragma unroll
        for (int n = 0; n < 4; ++n) epiS(m0 + wr * 64 + m * 16 + fr, n0 + wc * 64 + n * 16 + fq * 4, acc[m][n]);
    } else {
      gemm_kloop<4, false>(tid_, acc, A + (size_t)m0 * lda, lda, Bt + (size_t)n0 * ldb, ldb, K, smem);
#pragma unroll
      for (int m = 0; m < 4; ++m)
#pragma unroll
        for (int n = 0; n < 4; ++n) epiN(m0 + wr * 64 + m * 16 + fq * 4, n0 + wc * 64 + n * 16 + fr, acc[m][n]);
    }
  }
}


template <bool SWAP>
DEVI void gemm_kloop_big(int tid_, f32x4 (&acc)[8][4], const u16* __restrict__ A, int lda, const u16* __restrict__ Bt,
                         int ldb, int K, char* smem) {
  constexpr int STG = 16384 + 8192;
  const int tid = tid_, lane = tid & 63, wid = tid >> 6;
  const int wr = wid >> 1, wc = wid & 1, fr = lane & 15, fq = lane >> 4;
  const int lrow = lane >> 2, lphys = lane & 3, lhi = lane >> 4;
  const int gsw = (4 - lhi) & 3;
  const u16* ga = A + (size_t)(wid * 64 + lrow) * lda + (lphys ^ gsw) * 8;
  const u16* gb = Bt + (size_t)(wid * 32 + lrow) * ldb + (lphys ^ gsw) * 8;
  const size_t a16 = (size_t)16 * lda, b16 = (size_t)16 * ldb;
  const int rsw = (4 - ((fr >> 2) & 3)) & 3;
  const int ch = (fq ^ rsw) * 16;
  const int nk = K >> 5;
  const uint32_t lds_base = (uint32_t)(size_t)(__attribute__((address_space(3))) char*)smem;
  const uint32_t aoff = (uint32_t)((wr * 128 + fr) * 64 + ch);
  const uint32_t boff = (uint32_t)(16384 + (wc * 64 + fr) * 64 + ch);
  asm volatile("s_waitcnt vmcnt(0)" ::: "memory");
  __syncthreads();
#define GEMMB_ISSUE(kt_, buf_)                                                                                       \
  do {                                                                                                               \
    char* nb_ = smem + (buf_) * STG;                                                                                 \
    _Pragma("unroll") for (int q = 0; q < 4; ++q) __builtin_amdgcn_global_load_lds(                                  \
        (const unsigned*)(ga + q * a16 + (kt_) * 32),                                                                \
        (__attribute__((address_space(3))) unsigned*)(nb_ + (wid * 4 + q) * 1024 + lane * 16), 16, 0, 0);            \
    _Pragma("unroll") for (int q = 0; q < 2; ++q) __builtin_amdgcn_global_load_lds(                                  \
        (const unsigned*)(gb + q * b16 + (kt_) * 32),                                                                \
        (__attribute__((address_space(3))) unsigned*)(nb_ + 16384 + (wid * 2 + q) * 1024 + lane * 16), 16, 0, 0);   \
  } while (0)
  GEMMB_ISSUE(0, 0);
  if (nk > 1) GEMMB_ISSUE(1, 1);
  int cb = 0;
  for (int kt = 0; kt < nk; ++kt) {
    if (kt + 1 < nk) asm volatile("s_waitcnt vmcnt(6)" ::: "memory");
    else asm volatile("s_waitcnt vmcnt(0)" ::: "memory");
    __builtin_amdgcn_s_barrier();
    asm volatile("" ::: "memory");
    const int nbuf = (cb == 0) ? 2 : cb - 1;
    if (kt + 2 < nk) GEMMB_ISSUE(kt + 2, nbuf);
    const uint32_t sb = lds_base + cb * STG;
    bf16x8 a0[4], a1[4], bb[4];
    a0[0] = lds_rd128<0>(sb + aoff); a0[1] = lds_rd128<1024>(sb + aoff);
    a0[2] = lds_rd128<2048>(sb + aoff); a0[3] = lds_rd128<3072>(sb + aoff);
    bb[0] = lds_rd128<0>(sb + boff); bb[1] = lds_rd128<1024>(sb + boff);
    bb[2] = lds_rd128<2048>(sb + boff); bb[3] = lds_rd128<3072>(sb + boff);
    a1[0] = lds_rd128<4096>(sb + aoff); a1[1] = lds_rd128<5120>(sb + aoff);
    a1[2] = lds_rd128<6144>(sb + aoff); a1[3] = lds_rd128<7168>(sb + aoff);
    asm volatile("s_waitcnt lgkmcnt(4)" : "+v"(a0[0]), "+v"(a0[1]), "+v"(a0[2]), "+v"(a0[3]),
                 "+v"(bb[0]), "+v"(bb[1]), "+v"(bb[2]), "+v"(bb[3]));
#pragma unroll
    for (int m = 0; m < 4; ++m)
#pragma unroll
      for (int n = 0; n < 4; ++n) {
        if (SWAP) acc[m][n] = __builtin_amdgcn_mfma_f32_16x16x32_bf16(bb[n], a0[m], acc[m][n], 0, 0, 0);
        else acc[m][n] = __builtin_amdgcn_mfma_f32_16x16x32_bf16(a0[m], bb[n], acc[m][n], 0, 0, 0);
      }
    asm volatile("s_waitcnt lgkmcnt(0)" : "+v"(a1[0]), "+v"(a1[1]), "+v"(a1[2]), "+v"(a1[3]));
#pragma unroll
    for (int m = 0; m < 4; ++m)
#pragma unroll
      for (int n = 0; n < 4; ++n) {
        if (SWAP) acc[4 + m][n] = __builtin_amdgcn_mfma_f32_16x16x32_bf16(bb[n], a1[m], acc[4 + m][n], 0, 0, 0);
        else acc[4 + m][n] = __builtin_amdgcn_mfma_f32_16x16x32_bf16(a1[m], bb[n], acc[4 + m][n], 0, 0, 0);
      }
    cb = (cb == 2) ? 0 : cb + 1;
  }
#undef GEMMB_ISSUE
}

template <class EpiS, class EpiN>
DEVI void gemm_phase_big(int tid_, const u16* A, int lda, const u16* Bt, int ldb, int K, int M, int N, char* smem,
                         int ns_from, EpiS epiS, EpiN epiN) {
  const int nN = N >> 7, nM = M >> 8;
  const int lane = tid_ & 63, wid = tid_ >> 6;
  const int wr = wid >> 1, wc = wid & 1, fr = lane & 15, fq = lane >> 4;
  const int xcd = blockIdx.x & 7, jloc = blockIdx.x >> 3, nloc = gridDim.x >> 3;
  for (int lt = jloc; lt < (nM >> 3) * nN; lt += nloc) {
    const int tml = lt / nN, tn = lt - tml * nN;
    const int tm = tml * 8 + xcd;
    const int m0 = tm << 8, n0 = tn << 7;
    f32x4 acc[8][4];
#pragma unroll
    for (int m = 0; m < 8; ++m)
#pragma unroll
      for (int n = 0; n < 4; ++n) acc[m][n] = (f32x4){0.f, 0.f, 0.f, 0.f};
    if (n0 < ns_from) {
      gemm_kloop_big<true>(launder(tid_), acc, A + (size_t)m0 * lda, lda, Bt + (size_t)n0 * ldb, ldb, K, smem);
#pragma unroll
      for (int m = 0; m < 8; ++m)
#pragma unroll
        for (int n = 0; n < 4; ++n) epiS(m0 + wr * 128 + m * 16 + fr, n0 + wc * 64 + n * 16 + fq * 4, acc[m][n]);
    } else {
      gemm_kloop_big<false>(launder(tid_), acc, A + (size_t)m0 * lda, lda, Bt + (size_t)n0 * ldb, ldb, K, smem);
#pragma unroll
      for (int m = 0; m < 8; ++m)
#pragma unroll
        for (int n = 0; n < 4; ++n) epiN(m0 + wr * 128 + m * 16 + fq * 4, n0 + wc * 64 + n * 16 + fr, acc[m][n]);
    }
  }
}


template <bool SWAP>
DEVI void gemm_kloop8(int tid_, f32x4 (&acc)[8][4], const u16* __restrict__ A, int lda, const u16* __restrict__ Bt,
                      int ldb, int K, char* smem) {
  constexpr int STG = 65536;
  const int tid = tid_, lane = tid & 63, wid = tid >> 6;
  const int wr = wid >> 2, wc = wid & 3, fr = lane & 15, fq = lane >> 4;
  const int lrow = lane >> 3, lphys = lane & 7, lhi = lane >> 4;
  const u16* ga[4];
  const u16* gb[4];
#pragma unroll
  for (int q = 0; q < 4; ++q) {
    const int kc = lphys ^ ((4 * (q & 1) + lhi) & 7);
    ga[q] = A + (size_t)((wid * 4 + q) * 8 + lrow) * lda + kc * 8;
    gb[q] = Bt + (size_t)((wid * 4 + q) * 8 + lrow) * ldb + kc * 8;
  }
  const int swz = (fr >> 1) & 7;
  const int nk = K >> 6;
  const uint32_t lds_base = (uint32_t)(size_t)(__attribute__((address_space(3))) char*)smem;
  const uint32_t arow = (uint32_t)((wr * 128 + fr) * 128);
  const uint32_t brow = (uint32_t)(32768 + (wc * 64 + fr) * 128);
  asm volatile("s_waitcnt vmcnt(0)" ::: "memory");
  __syncthreads();
#define GEMM8_ISSUE(kt_)                                                                                             \
  do {                                                                                                               \
    char* nb_ = smem + ((kt_) & 1) * STG;                                                                            \
    _Pragma("unroll") for (int q = 0; q < 4; ++q) __builtin_amdgcn_global_load_lds(                                  \
        (const unsigned*)(ga[q] + (kt_) * 64),                                                                       \
        (__attribute__((address_space(3))) unsigned*)(nb_ + (wid * 4 + q) * 1024 + lane * 16), 16, 0, 0);            \
    _Pragma("unroll") for (int q = 0; q < 4; ++q) __builtin_amdgcn_global_load_lds(                                  \
        (const unsigned*)(gb[q] + (kt_) * 64),                                                                       \
        (__attribute__((address_space(3))) unsigned*)(nb_ + 32768 + (wid * 4 + q) * 1024 + lane * 16), 16, 0, 0);    \
  } while (0)
  GEMM8_ISSUE(0);
  for (int kt = 0; kt < nk; ++kt) {
    asm volatile("s_waitcnt vmcnt(0)" ::: "memory");
    __builtin_amdgcn_s_barrier();
    asm volatile("" ::: "memory");
    if (kt + 1 < nk) GEMM8_ISSUE(kt + 1);
    const uint32_t sb = lds_base + (kt & 1) * STG;
#pragma unroll
    for (int ks = 0; ks < 2; ++ks) {
      const uint32_t chb = (uint32_t)(((ks * 4 + fq) ^ swz) * 16);
      const uint32_t aoff = sb + arow + chb, boff = sb + brow + chb;
      bf16x8 a0[4], a1[4], bb[4];
      a0[0] = lds_rd128<0>(aoff); a0[1] = lds_rd128<2048>(aoff);
      a0[2] = lds_rd128<4096>(aoff); a0[3] = lds_rd128<6144>(aoff);
      bb[0] = lds_rd128<0>(boff); bb[1] = lds_rd128<2048>(boff);
      bb[2] = lds_rd128<4096>(boff); bb[3] = lds_rd128<6144>(boff);
      a1[0] = lds_rd128<8192>(aoff); a1[1] = lds_rd128<10240>(aoff);
      a1[2] = lds_rd128<12288>(aoff); a1[3] = lds_rd128<14336>(aoff);
      asm volatile("s_waitcnt lgkmcnt(4)" : "+v"(a0[0]), "+v"(a0[1]), "+v"(a0[2]), "+v"(a0[3]),
                   "+v"(bb[0]), "+v"(bb[1]), "+v"(bb[2]), "+v"(bb[3]));
#pragma unroll
      for (int m = 0; m < 4; ++m)
#pragma unroll
        for (int n = 0; n < 4; ++n) {
          if (SWAP) acc[m][n] = __builtin_amdgcn_mfma_f32_16x16x32_bf16(bb[n], a0[m], acc[m][n], 0, 0, 0);
          else acc[m][n] = __builtin_amdgcn_mfma_f32_16x16x32_bf16(a0[m], bb[n], acc[m][n], 0, 0, 0);
        }
      asm volatile("s_waitcnt lgkmcnt(0)" : "+v"(a1[0]), "+v"(a1[1]), "+v"(a1[2]), "+v"(a1[3]));
#pragma unroll
      for (int m = 0; m < 4; ++m)
#pragma unroll
        for (int n = 0; n < 4; ++n) {
          if (SWAP) acc[4 + m][n] = __builtin_amdgcn_mfma_f32_16x16x32_bf16(bb[n], a1[m], acc[4 + m][n], 0, 0, 0);
          else acc[4 + m][n] = __builtin_amdgcn_mfma_f32_16x16x32_bf16(a1[m], bb[n], acc[4 + m][n], 0, 0, 0);
        }
    }
  }
#undef GEMM8_ISSUE
}

template <class EpiS, class EpiN>
DEVI void gemm_phase8(int tid_, const u16* A, int lda, const u16* Bt, int ldb, int K, int M, int N, char* smem,
                      int ns_from, EpiS epiS, EpiN epiN) {
  const int nN = (N + 255) >> 8, nM = M >> 8;
  const int lane = tid_ & 63, wid = tid_ >> 6;
  const int wr = wid >> 2, wc = wid & 3, fr = lane & 15, fq = lane >> 4;
  const bool xmap = ((gridDim.x & 7) == 0) && ((nM & 7) == 0);
  const int xcd = blockIdx.x & 7;
  const int first = xmap ? (int)(blockIdx.x >> 3) : (int)blockIdx.x;
  const int stride = xmap ? (int)(gridDim.x >> 3) : (int)gridDim.x;
  const int count = xmap ? (nM >> 3) * nN : nM * nN;
  for (int it = first; it < count; it += stride) {
    const int tq = it / nN, tn = it - tq * nN;
    const int tm = xmap ? tq * 8 + xcd : tq;
    const int m0 = tm << 8, n0 = tn << 8;
    const int colb = n0 + wc * 64;
    f32x4 acc[8][4];
#pragma unroll
    for (int m = 0; m < 8; ++m)
#pragma unroll
      for (int n = 0; n < 4; ++n) acc[m][n] = (f32x4){0.f, 0.f, 0.f, 0.f};
    if (colb < ns_from) {
      gemm_kloop8<true>(launder(tid_), acc, A + (size_t)m0 * lda, lda, Bt + (size_t)n0 * ldb, ldb, K, smem);
      if (colb < N) {
#pragma unroll
        for (int m = 0; m < 8; ++m)
#pragma unroll
          for (int n = 0; n < 4; ++n) epiS(m0 + wr * 128 + m * 16 + fr, colb + n * 16 + fq * 4, acc[m][n]);
      }
    } else {
      gemm_kloop8<false>(launder(tid_), acc, A + (size_t)m0 * lda, lda, Bt + (size_t)n0 * ldb, ldb, K, smem);
      if (colb < N) {
#pragma unroll
        for (int m = 0; m < 8; ++m)
#pragma unroll
          for (int n = 0; n < 4; ++n) epiN(m0 + wr * 128 + m * 16 + fq * 4, colb + n * 16 + fr, acc[m][n]);
      }
    }
  }
}

DEVI void store4bf(u16* dst, f32x4 v) {
  u32x2 o;
  o.x = pack2(v[0], v[1]); o.y = pack2(v[2], v[3]);
  *(u32x2*)dst = o;
}

DEVI void phase_p_gemm(int tid_, const Params& p, char* smem) {
  u16* WB = (u16*)(p.ws + OFF_WB);
  const u16* H = (const u16*)(p.ws + OFF_H);
  u16* PR = (u16*)(p.ws + OFF_PR);
  u16* NQ = (u16*)(p.ws + OFF_NQ);
  u16* NK = (u16*)(p.ws + OFF_NK);
  u16* NVT = (u16*)(p.ws + OFF_NV);
  gemm_phase8(tid_, H, 1024, WB + W_IN, 1024, 1024, NTOK, 3456, smem, 2944,
    [&](int r, int c0, f32x4 v) {
      if (c0 < 1920) store4bf(PR + (size_t)r * PRW + c0, v);
      else if (c0 < 2432) store4bf(NQ + (size_t)r * 512 + (c0 - 1920), v);
      else store4bf(NK + (size_t)r * 512 + (c0 - 2432), v);
    },
    [&](int r0, int c, f32x4 v) {
      const int cc = c - 2944;
      const int s = r0 >> 12, t = r0 & 4095;
      store4bf(NVT + ((size_t)(s * 512 + cc)) * 4096 + t, v);
    });
  const u16* MH = (const u16*)(p.ws + OFF_MEMH);
  u16* KVK = (u16*)(p.ws + OFF_KVK);
  u16* KVT = (u16*)(p.ws + OFF_KVT);
  gemm_phase8(tid_, MH, 1024, WB + W_XKV, 1024, 1024, 3072, 2048, smem, 1024,
    [&](int r, int c0, f32x4 v) { store4bf(KVK + (size_t)r * 1024 + c0, v); },
    [&](int r0, int c, f32x4 v) {
      const int cc = c - 1024;
      const int s = r0 >> 8, m = r0 & 255;
      store4bf(KVT + ((size_t)(s * 1024 + cc)) * 256 + m, v);
    });
}

DEVI void phase_nat(int tid_, const Params& p, int l, char* smem, int bfirst, int bstride) {
  u16* NQ = (u16*)(p.ws + OFF_NQ);
  const u16* NK = (const u16*)(p.ws + OFF_NK);
  const u16* NVT = (const u16*)(p.ws + OFF_NV);
  const float* rpb = p.in[I_RPB] + (size_t)l * 8 * 15 * 31;
  const int lane = tid_ & 63, g = tid_ >> 6, fr = lane & 15, fq = lane >> 4;
  u16* Pw = (u16*)smem + g * (16 * 264);
  const int cb = (g == 0) ? 0 : (g == 1) ? 8 : (g == 2) ? 24 : 32;
  const int c = g * 16 + fr;
  int cs = c - 8; cs = cs < 0 ? 0 : (cs > 48 ? 48 : cs);
  for (int t = bfirst; t < 12 * 64 * 8; t += bstride) {
    const int h = t & 7, ri = (t >> 3) & 63, s = t >> 9;
    int rs = ri - 4; rs = rs < 0 ? 0 : (rs > 56 ? 56 : rs);
    const size_t tokq = (size_t)s * 4096 + ri * 64 + g * 16;
    bf16x8 aq[2];
    aq[0] = *(const bf16x8*)(NQ + (tokq + fr) * 512 + h * 64 + fq * 8);
    aq[1] = *(const bf16x8*)(NQ + (tokq + fr) * 512 + h * 64 + 32 + fq * 8);
    f32x4 acc[16];
#pragma unroll
    for (int n = 0; n < 16; ++n) {
      acc[n] = (f32x4){0.f, 0.f, 0.f, 0.f};
      const int r = n >> 1, col = cb + (n & 1) * 16 + fr;
      const u16* kp = NK + ((size_t)s * 4096 + (rs + r) * 64 + col) * 512 + h * 64 + fq * 8;
      const bf16x8 b0 = *(const bf16x8*)kp;
      const bf16x8 b1 = *(const bf16x8*)(kp + 32);
      acc[n] = __builtin_amdgcn_mfma_f32_16x16x32_bf16(b0, aq[0], acc[n], 0, 0, 0);
      acc[n] = __builtin_amdgcn_mfma_f32_16x16x32_bf16(b1, aq[1], acc[n], 0, 0, 0);
    }
    float m = -1e30f;
#pragma unroll
    for (int n = 0; n < 16; ++n) {
      const int di = rs + (n >> 1) - ri + 7;
      const float* brow = rpb + (h * 15 + di) * 31 + 15 - c;
#pragma unroll
      for (int j = 0; j < 4; ++j) {
        const int kc = cb + (n & 1) * 16 + fq * 4 + j;
        float sc = -1e30f;
        if (kc >= cs && kc < cs + 16) sc = acc[n][j] * 0.125f + brow[kc];
        acc[n][j] = sc;
        m = fmaxf(m, sc);
      }
    }
    m = red4x_max(m);
    float ssum = 0.f;
#pragma unroll
    for (int n = 0; n < 16; ++n) {
      f32x4 e;
#pragma unroll
      for (int j = 0; j < 4; ++j) { e[j] = __expf(acc[n][j] - m); ssum += e[j]; }
      store4bf(Pw + fr * 264 + n * 16 + fq * 4, e);
    }
    const float sm = 1.f / red4x_sum(ssum);
    f32x4 o[4];
#pragma unroll
    for (int n = 0; n < 4; ++n) o[n] = (f32x4){0.f, 0.f, 0.f, 0.f};
#pragma unroll
    for (int ks = 0; ks < 8; ++ks) {
      const bf16x8 ap = *(const bf16x8*)(Pw + fr * 264 + ks * 32 + fq * 8);
#pragma unroll
      for (int n = 0; n < 4; ++n) {
        const bf16x8 bv = *(const bf16x8*)(NVT + ((size_t)(s * 512 + h * 64 + n * 16 + fr)) * 4096 + (rs + ks) * 64 + cb + fq * 8);
        o[n] = __builtin_amdgcn_mfma_f32_16x16x32_bf16(bv, ap, o[n], 0, 0, 0);
      }
    }
#pragma unroll
    for (int n = 0; n < 4; ++n) store4bf(NQ + (tokq + fr) * 512 + h * 64 + n * 16 + fq * 4, o[n] * sm);
  }
}

constexpr int SC_OPS = 0;
constexpr int SC_VV = 40960;
constexpr int SC_WR = 49152;
constexpr int SC_AP = 57344;
constexpr int SC_TW = 65536;
constexpr int SC_AD = 70144;
constexpr int SC_NRM = 74752;
constexpr int SC_MU = 74880;
constexpr int SC_CST = 77440;

typedef __attribute__((ext_vector_type(2))) float f32x2;

template <int CTRL>
DEVI float dpp_mov(float x) {
  return __int_as_float(__builtin_amdgcn_update_dpp(0, __float_as_int(x), CTRL, 0xF, 0xF, true));
}
DEVI float red8(float x) {
  x += dpp_mov<0xB1>(x);
  x += dpp_mov<0x4E>(x);
  x += dpp_mov<0x141>(x);
  return x;
}
DEVI f32x2 lo2(f32x4 v) { return __builtin_shufflevector(v, v, 0, 1); }
DEVI f32x2 hi2(f32x4 v) { return __builtin_shufflevector(v, v, 2, 3); }

struct ScanOps {
  f32x2 a[4], w[4], b[4], k[4], r[4];
  float v0, v1;
};
DEVI void scan_load(ScanOps& o, const float* OPS, const float* VV, int nn, int jg, int i0) {
  const float* base = OPS + nn * 64 + jg * 8;
  f32x4 t0, t1;
  t0 = *(const f32x4*)(base); t1 = *(const f32x4*)(base + 4);
  o.a[0] = lo2(t0); o.a[1] = hi2(t0); o.a[2] = lo2(t1); o.a[3] = hi2(t1);
  t0 = *(const f32x4*)(base + 2048); t1 = *(const f32x4*)(base + 2048 + 4);
  o.w[0] = lo2(t0); o.w[1] = hi2(t0); o.w[2] = lo2(t1); o.w[3] = hi2(t1);
  t0 = *(const f32x4*)(base + 4096); t1 = *(const f32x4*)(base + 4096 + 4);
  o.b[0] = lo2(t0); o.b[1] = hi2(t0); o.b[2] = lo2(t1); o.b[3] = hi2(t1);
  t0 = *(const f32x4*)(base + 6144); t1 = *(const f32x4*)(base + 6144 + 4);
  o.k[0] = lo2(t0); o.k[1] = hi2(t0); o.k[2] = lo2(t1); o.k[3] = hi2(t1);
  t0 = *(const f32x4*)(base + 8192); t1 = *(const f32x4*)(base + 8192 + 4);
  o.r[0] = lo2(t0); o.r[1] = hi2(t0); o.r[2] = lo2(t1); o.r[3] = hi2(t1);
  o.v0 = VV[nn * 64 + i0];
  o.v1 = VV[nn * 64 + i0 + 8];
}
DEVI void scan_step(const ScanOps& o, f32x2 (&S0)[4], f32x2 (&S1)[4], float* YL, int nn, int jg, int i0) {
  f32x2 d0 = S0[0] * o.a[0], d0b = S0[2] * o.a[2];
  f32x2 d1 = S1[0] * o.a[0], d1b = S1[2] * o.a[2];
  d0 = S0[1] * o.a[1] + d0; d0b = S0[3] * o.a[3] + d0b;
  d1 = S1[1] * o.a[1] + d1; d1b = S1[3] * o.a[3] + d1b;
  d0 += d0b; d1 += d1b;
  const float sa0 = red8(d0.x + d0.y);
  const float sa1 = red8(d1.x + d1.y);
  f32x2 e0 = {0.f, 0.f}, e1 = {0.f, 0.f};
#pragma unroll
  for (int q = 0; q < 4; ++q) {
    const f32x2 u0 = sa0 * o.b[q] + o.v0 * o.k[q];
    const f32x2 u1 = sa1 * o.b[q] + o.v1 * o.k[q];
    S0[q] = S0[q] * o.w[q] + u0;
    S1[q] = S1[q] * o.w[q] + u1;
    e0 = S0[q] * o.r[q] + e0;
    e1 = S1[q] * o.r[q] + e1;
  }
  const float y0 = red8(e0.x + e0.y);
  const float y1 = red8(e1.x + e1.y);
  if (jg == 0) { YL[nn * 64 + i0] = y0; YL[nn * 64 + i0 + 8] = y1; }
}

DEVI void phase_scan(int tid_, const Params& p, int l, char* smem, int bfirst, int bstride) {
  const u16* PR = (const u16*)(p.ws + OFF_PR);
  _Float16* YF = (_Float16*)(p.ws + OFF_H);
  _Float16* YB = (_Float16*)(p.ws + OFF_H + (size_t)NTOK * 512 * 2);
  float* BON = (float*)(p.ws + OFF_BONUS);
  const u16* WB = (const u16*)(p.ws + OFF_WB);
  float* OPS = (float*)(smem + SC_OPS);
  u16* RAW = (u16*)(smem + SC_OPS);
  float* VV = (float*)(smem + SC_VV);
  float* WR = (float*)(smem + SC_WR);
  float* AP = (float*)(smem + SC_AP);
  float* YL = WR;
  u16* TWb = (u16*)(smem + SC_TW);
  u16* ADb = (u16*)(smem + SC_AD);
  float* NRM = (float*)(smem + SC_NRM);
  float* MU = (float*)(smem + SC_MU);
  float* CST = (float*)(smem + SC_CST);
  const float* mu_p = p.in[I_MU_PREV] + (size_t)l * 1920;
  const float* mu_n = p.in[I_MU_NEXT] + (size_t)l * 1920;
  const int tid = tid_, lane = tid & 63, w = tid >> 6, fr = lane & 15, fq = lane >> 4;
  const int pn = tid >> 3, j0 = (tid & 7) * 8;
  const int jg = lane & 7, i0 = w * 16 + (lane >> 3);
  const int hr = (tid >= 40) ? 1 : 0, hc = tid - hr * 40;
  for (int blk = bfirst; blk < 192; blk += bstride) {
    const int s = blk >> 4, h = (blk >> 1) & 7, d = blk & 1;
    __syncthreads();
    for (int i = tid; i < 640; i += 256) {
      const int which = (i >= 320) ? 1 : 0, c = i - which * 320;
      const int g = c >> 6, e = c & 63;
      const int col = (g < 3) ? (g * 512 + h * 64 + e) : (1536 + (g - 3) * 128 + d * 64 + e);
      MU[i] = which ? mu_n[col] : mu_p[col];
    }
    for (int i = tid; i < 320; i += 256) {
      const int which = i >> 6, e = i & 63;
      float v;
      if (which == 0) v = p.in[I_W0][(size_t)(l * 2 + d) * 512 + h * 64 + e];
      else if (which == 1) v = p.in[I_A0][(size_t)(l * 2 + d) * 512 + h * 64 + e];
      else if (which == 2) v = p.in[I_K_K][(size_t)l * 512 + h * 64 + e];
      else if (which == 3) v = p.in[I_K_A][(size_t)l * 512 + h * 64 + e];
      else v = p.in[I_R_K][(size_t)(l * 8 + h) * 64 + e];
      CST[i] = v;
    }
    bf16x8 bw[2], ba[2];
#pragma unroll
    for (int ks = 0; ks < 2; ++ks) {
      bw[ks] = *(const bf16x8*)(WB + W_WUP + (size_t)(d * 512 + h * 64 + w * 16 + fr) * 64 + ks * 32 + fq * 8);
      ba[ks] = *(const bf16x8*)(WB + W_AUP + (size_t)(d * 512 + h * 64 + w * 16 + fr) * 64 + ks * 32 + fq * 8);
    }
    _Float16* Y = d ? YB : YF;
    f32x2 S0[4], S1[4];
#pragma unroll
    for (int q = 0; q < 4; ++q) { S0[q] = (f32x2){0.f, 0.f}; S1[q] = (f32x2){0.f, 0.f}; }
    u32x4 G[5], GH;
    {
      const int t = d ? (4095 - pn) : pn;
      const size_t tok = (size_t)s * 4096 + t;
#pragma unroll
      for (int g = 0; g < 5; ++g) {
        const int col = (g < 3) ? (g * 512 + h * 64) : (1536 + (g - 3) * 128 + d * 64);
        G[g] = *(const u32x4*)(PR + tok * PRW + col + j0);
      }
      GH = (u32x4){0u, 0u, 0u, 0u};
      if (tid < 80) {
        const int tlo = d ? (4095 - 31) : 0;
        const int th = hr ? (tlo + 32) : (tlo - 1);
        const int g = hc >> 3;
        const int col = (g < 3) ? (g * 512 + h * 64) : (1536 + (g - 3) * 128 + d * 64);
        if (th >= 0 && th <= 4095) GH = *(const u32x4*)(PR + ((size_t)s * 4096 + th) * PRW + col + (hc & 7) * 8);
      }
    }
#pragma unroll 1
    for (int ch = 0; ch < 128; ++ch) {
      const int n = ch * 32 + pn;
      const int t = d ? (4095 - n) : n;
      const size_t tok = (size_t)s * 4096 + t;
      const int tlo = d ? (4095 - (ch * 32 + 31)) : (ch * 32);
      const int rrow = t - tlo + 1;
#pragma unroll
      for (int g = 0; g < 5; ++g) *(u32x4*)(RAW + rrow * 320 + g * 64 + j0) = G[g];
      if (tid < 80) *(u32x4*)(RAW + (hr ? 33 : 0) * 320 + (hc >> 3) * 64 + (hc & 7) * 8) = GH;
      __syncthreads();
      if (ch + 1 < 128) {
        const int n2 = n + 32;
        const int t2 = d ? (4095 - n2) : n2;
        const size_t tok2 = (size_t)s * 4096 + t2;
#pragma unroll
        for (int g = 0; g < 5; ++g) {
          const int col = (g < 3) ? (g * 512 + h * 64) : (1536 + (g - 3) * 128 + d * 64);
          G[g] = *(const u32x4*)(PR + tok2 * PRW + col + j0);
        }
        GH = (u32x4){0u, 0u, 0u, 0u};
        if (tid < 80) {
          const int tlo2 = d ? (tlo - 32) : (tlo + 32);
          const int th = hr ? (tlo2 + 32) : (tlo2 - 1);
          const int g = hc >> 3;
          const int col = (g < 3) ? (g * 512 + h * 64) : (1536 + (g - 3) * 128 + d * 64);
          if (th >= 0 && th <= 4095) GH = *(const u32x4*)(PR + ((size_t)s * 4096 + th) * PRW + col + (hc & 7) * 8);
        }
      }
#pragma unroll
      for (int g = 0; g < 5; ++g) {
        float cur[8], prv[8], nxt[8];
        load8bf(RAW + rrow * 320 + g * 64 + j0, cur);
        load8bf(RAW + (rrow - 1) * 320 + g * 64 + j0, prv);
        load8bf(RAW + (rrow + 1) * 320 + g * 64 + j0, nxt);
        const f32x4 mp0 = *(const f32x4*)(MU + g * 64 + j0), mp1 = *(const f32x4*)(MU + g * 64 + j0 + 4);
        const f32x4 mn0 = *(const f32x4*)(MU + 320 + g * 64 + j0), mn1 = *(const f32x4*)(MU + 320 + g * 64 + j0 + 4);
        f32x4 x0, x1;
#pragma unroll
        for (int e = 0; e < 4; ++e) {
          x0[e] = cur[e] + mp0[e] * (prv[e] - cur[e]) + mn0[e] * (nxt[e] - cur[e]);
          x1[e] = cur[4 + e] + mp1[e] * (prv[4 + e] - cur[4 + e]) + mn1[e] * (nxt[4 + e] - cur[4 + e]);
        }
        if (g == 0) {
          *(f32x4*)(OPS + 4 * 2048 + pn * 64 + j0) = x0; *(f32x4*)(OPS + 4 * 2048 + pn * 64 + j0 + 4) = x1;
        } else if (g == 1) {
          *(f32x4*)(OPS + 3 * 2048 + pn * 64 + j0) = x0; *(f32x4*)(OPS + 3 * 2048 + pn * 64 + j0 + 4) = x1;
          const f32x4 kk0 = *(const f32x4*)(CST + 128 + j0), kk1 = *(const f32x4*)(CST + 128 + j0 + 4);
          float ss = 0.f;
#pragma unroll
          for (int e = 0; e < 4; ++e) { const float a_ = x0[e] * kk0[e], b_ = x1[e] * kk1[e]; ss += a_ * a_ + b_ * b_; }
          ss = red8(ss);
          if ((tid & 7) == 0) NRM[pn] = frcp(fmaxf(__builtin_amdgcn_sqrtf(ss), 1e-12f));
        } else if (g == 2) {
          *(f32x4*)(VV + pn * 64 + j0) = x0; *(f32x4*)(VV + pn * 64 + j0 + 4) = x1;
        } else if (g == 3) {
          u32x4 pk;
          pk.x = pack2(ftanh(x0[0]), ftanh(x0[1])); pk.y = pack2(ftanh(x0[2]), ftanh(x0[3]));
          pk.z = pack2(ftanh(x1[0]), ftanh(x1[1])); pk.w = pack2(ftanh(x1[2]), ftanh(x1[3]));
          *(u32x4*)(TWb + pn * 72 + j0) = pk;
        } else {
          u32x4 pk;
          pk.x = pack2(x0[0], x0[1]); pk.y = pack2(x0[2], x0[3]);
          pk.z = pack2(x1[0], x1[1]); pk.w = pack2(x1[2], x1[3]);
          *(u32x4*)(ADb + pn * 72 + j0) = pk;
        }
      }
      __syncthreads();
#pragma unroll
      for (int m = 0; m < 2; ++m) {
        f32x4 cw = {0.f, 0.f, 0.f, 0.f}, ca = {0.f, 0.f, 0.f, 0.f};
#pragma unroll
        for (int ks = 0; ks < 2; ++ks) {
          const bf16x8 aw = *(const bf16x8*)(TWb + (m * 16 + fr) * 72 + ks * 32 + fq * 8);
          const bf16x8 aa = *(const bf16x8*)(ADb + (m * 16 + fr) * 72 + ks * 32 + fq * 8);
          cw = __builtin_amdgcn_mfma_f32_16x16x32_bf16(aw, bw[ks], cw, 0, 0, 0);
          ca = __builtin_amdgcn_mfma_f32_16x16x32_bf16(aa, ba[ks], ca, 0, 0, 0);
        }
#pragma unroll
        for (int jj = 0; jj < 4; ++jj) {
          WR[(m * 16 + fq * 4 + jj) * 64 + w * 16 + fr] = cw[jj];
          AP[(m * 16 + fq * 4 + jj) * 64 + w * 16 + fr] = ca[jj];
        }
      }
      __syncthreads();
      {
        const float inv = NRM[pn];
        float bsum = 0.f;
#pragma unroll
        for (int hq = 0; hq < 2; ++hq) {
          const int jb = j0 + hq * 4;
          const f32x4 wr_ = *(const f32x4*)(WR + pn * 64 + jb) + *(const f32x4*)(CST + jb);
          const f32x4 ap_ = *(const f32x4*)(AP + pn * 64 + jb) + *(const f32x4*)(CST + 64 + jb);
          const f32x4 kr = *(const f32x4*)(OPS + 3 * 2048 + pn * 64 + jb);
          const f32x4 rr = *(const f32x4*)(OPS + 4 * 2048 + pn * 64 + jb);
          const f32x4 kkw = *(const f32x4*)(CST + 128 + jb), kaw = *(const f32x4*)(CST + 192 + jb), rkw = *(const f32x4*)(CST + 256 + jb);
          f32x4 o0, o1, o2, o3;
#pragma unroll
          for (int e = 0; e < 4; ++e) {
            const float sw = sigm(wr_[e]);
            const float dec = __expf(-0.6065306597126334f * sw);
            const float av = sigm(ap_[e]);
            const float kn = kr[e] * kkw[e] * inv;
            const float kd = kr[e] * (1.f + (av - 1.f) * kaw[e]);
            bsum += rr[e] * kd * rkw[e];
            o0[e] = -kn; o1[e] = dec; o2[e] = kn * av; o3[e] = kd;
          }
          *(f32x4*)(OPS + 0 * 2048 + pn * 64 + jb) = o0;
          *(f32x4*)(OPS + 1 * 2048 + pn * 64 + jb) = o1;
          *(f32x4*)(OPS + 2 * 2048 + pn * 64 + jb) = o2;
          *(f32x4*)(OPS + 3 * 2048 + pn * 64 + jb) = o3;
        }
        bsum = red8(bsum);
        if ((tid & 7) == 0) BON[(tok * 8 + h) * 2 + d] = bsum;
      }
      __syncthreads();
      {
        ScanOps oa, ob;
        scan_load(oa, OPS, VV, 0, jg, i0);
#pragma unroll 1
        for (int nn = 0; nn < 32; nn += 2) {
          scan_load(ob, OPS, VV, nn + 1, jg, i0);
          scan_step(oa, S0, S1, YL, nn, jg, i0);
          scan_load(oa, OPS, VV, (nn + 2) & 31, jg, i0);
          scan_step(ob, S0, S1, YL, nn + 1, jg, i0);
        }
      }
      __syncthreads();
      {
        h16x8 o;
#pragma unroll
        for (int e = 0; e < 8; ++e) o[e] = (_Float16)YL[pn * 64 + j0 + e];
        *(h16x8*)(Y + tok * 512 + h * 64 + j0) = o;
      }
    }
    __syncthreads();
  }
}

struct ScanOps1 {
  f32x2 a[4], w[4], b[4], k[4], r[4];
  float v0;
};
DEVI void scan_load1(ScanOps1& o, const float* OPS, const float* VV, int nn, int jg, int i0) {
  const float* base = OPS + nn * 64 + jg * 8;
  f32x4 t0, t1;
  t0 = *(const f32x4*)(base); t1 = *(const f32x4*)(base + 4);
  o.a[0] = lo2(t0); o.a[1] = hi2(t0); o.a[2] = lo2(t1); o.a[3] = hi2(t1);
  t0 = *(const f32x4*)(base + 2048); t1 = *(const f32x4*)(base + 2048 + 4);
  o.w[0] = lo2(t0); o.w[1] = hi2(t0); o.w[2] = lo2(t1); o.w[3] = hi2(t1);
  t0 = *(const f32x4*)(base + 4096); t1 = *(const f32x4*)(base + 4096 + 4);
  o.b[0] = lo2(t0); o.b[1] = hi2(t0); o.b[2] = lo2(t1); o.b[3] = hi2(t1);
  t0 = *(const f32x4*)(base + 6144); t1 = *(const f32x4*)(base + 6144 + 4);
  o.k[0] = lo2(t0); o.k[1] = hi2(t0); o.k[2] = lo2(t1); o.k[3] = hi2(t1);
  t0 = *(const f32x4*)(base + 8192); t1 = *(const f32x4*)(base + 8192 + 4);
  o.r[0] = lo2(t0); o.r[1] = hi2(t0); o.r[2] = lo2(t1); o.r[3] = hi2(t1);
  o.v0 = VV[nn * 64 + i0];
}
DEVI void scan_step1(const ScanOps1& o, f32x2 (&S0)[4], float* YL, int nn, int jg, int i0) {
  f32x2 d0 = S0[0] * o.a[0], d0b = S0[2] * o.a[2];
  d0 = S0[1] * o.a[1] + d0; d0b = S0[3] * o.a[3] + d0b;
  d0 += d0b;
  const float sa0 = red8(d0.x + d0.y);
  f32x2 e0 = {0.f, 0.f};
#pragma unroll
  for (int q = 0; q < 4; ++q) {
    const f32x2 u0 = sa0 * o.b[q] + o.v0 * o.k[q];
    S0[q] = S0[q] * o.w[q] + u0;
    e0 = S0[q] * o.r[q] + e0;
  }
  const float y0 = red8(e0.x + e0.y);
  if (jg == 0) YL[nn * 64 + i0] = y0;
}
DEVI float red16d(float x) {
  x += dpp_mov<0xB1>(x);
  x += dpp_mov<0x4E>(x);
  x += dpp_mov<0x141>(x);
  x += dpp_mov<0x140>(x);
  return x;
}
DEVI void unpack4(u32x2 u, float* o) {
  o[0] = __uint_as_float(u.x << 16); o[1] = __uint_as_float(u.x & 0xffff0000u);
  o[2] = __uint_as_float(u.y << 16); o[3] = __uint_as_float(u.y & 0xffff0000u);
}

DEVI void phase_scan8(int tid_, const Params& p, int l, char* smem, int bfirst, int bstride) {
  const u16* PR = (const u16*)(p.ws + OFF_PR);
  _Float16* YF = (_Float16*)(p.ws + OFF_H);
  _Float16* YB = (_Float16*)(p.ws + OFF_H + (size_t)NTOK * 512 * 2);
  float* BON = (float*)(p.ws + OFF_BONUS);
  const u16* WB = (const u16*)(p.ws + OFF_WB);
  float* OPS = (float*)(smem + SC_OPS);
  u16* RAW = (u16*)(smem + SC_OPS);
  float* VV = (float*)(smem + SC_VV);
  float* WR = (float*)(smem + SC_WR);
  float* AP = (float*)(smem + SC_AP);
  float* YL = WR;
  u16* TWb = (u16*)(smem + SC_TW);
  u16* ADb = (u16*)(smem + SC_AD);
  float* NRM = (float*)(smem + SC_NRM);
  float* MU = (float*)(smem + SC_MU);
  float* CST = (float*)(smem + SC_CST);
  const float* mu_p = p.in[I_MU_PREV] + (size_t)l * 1920;
  const float* mu_n = p.in[I_MU_NEXT] + (size_t)l * 1920;
  const int tid = tid_, lane = tid & 63, w = tid >> 6, fr = lane & 15, fq = lane >> 4;
  const int pn = tid >> 4, j0 = (tid & 15) * 4;
  const int jg = lane & 7, i0 = w * 8 + (lane >> 3);
  const int hr = (tid >= 80) ? 1 : 0, hc = tid - hr * 80;
  const int wm = w >> 2, wn = w & 3;
  for (int blk = bfirst; blk < 192; blk += bstride) {
    const int s = blk >> 4, h = (blk >> 1) & 7, d = blk & 1;
    __syncthreads();
    for (int i = tid; i < 640; i += 512) {
      const int which = (i >= 320) ? 1 : 0, c = i - which * 320;
      const int g = c >> 6, e = c & 63;
      const int col = (g < 3) ? (g * 512 + h * 64 + e) : (1536 + (g - 3) * 128 + d * 64 + e);
      MU[i] = which ? mu_n[col] : mu_p[col];
    }
    if (tid < 320) {
      const int which = tid >> 6, e = tid & 63;
      float v;
      if (which == 0) v = p.in[I_W0][(size_t)(l * 2 + d) * 512 + h * 64 + e];
      else if (which == 1) v = p.in[I_A0][(size_t)(l * 2 + d) * 512 + h * 64 + e];
      else if (which == 2) v = p.in[I_K_K][(size_t)l * 512 + h * 64 + e];
      else if (which == 3) v = p.in[I_K_A][(size_t)l * 512 + h * 64 + e];
      else v = p.in[I_R_K][(size_t)(l * 8 + h) * 64 + e];
      CST[tid] = v;
    }
    bf16x8 bw[2], ba[2];
#pragma unroll
    for (int ks = 0; ks < 2; ++ks) {
      bw[ks] = *(const bf16x8*)(WB + W_WUP + (size_t)(d * 512 + h * 64 + wn * 16 + fr) * 64 + ks * 32 + fq * 8);
      ba[ks] = *(const bf16x8*)(WB + W_AUP + (size_t)(d * 512 + h * 64 + wn * 16 + fr) * 64 + ks * 32 + fq * 8);
    }
    _Float16* Y = d ? YB : YF;
    f32x2 S0[4];
#pragma unroll
    for (int q = 0; q < 4; ++q) S0[q] = (f32x2){0.f, 0.f};
    u32x2 G[5], GH;
    {
      const int t = d ? (4095 - pn) : pn;
      const size_t tok = (size_t)s * 4096 + t;
#pragma unroll
      for (int g = 0; g < 5; ++g) {
        const int col = (g < 3) ? (g * 512 + h * 64) : (1536 + (g - 3) * 128 + d * 64);
        G[g] = *(const u32x2*)(PR + tok * PRW + col + j0);
      }
      GH = (u32x2){0u, 0u};
      if (tid < 160) {
        const int tlo = d ? (4095 - 31) : 0;
        const int th = hr ? (tlo + 32) : (tlo - 1);
        const int g = hc >> 4;
        const int col = (g < 3) ? (g * 512 + h * 64) : (1536 + (g - 3) * 128 + d * 64);
        if (th >= 0 && th <= 4095) GH = *(const u32x2*)(PR + ((size_t)s * 4096 + th) * PRW + col + (hc & 15) * 4);
      }
    }
#pragma unroll 1
    for (int ch = 0; ch < 128; ++ch) {
      const int n = ch * 32 + pn;
      const int t = d ? (4095 - n) : n;
      const size_t tok = (size_t)s * 4096 + t;
      const int tlo = d ? (4095 - (ch * 32 + 31)) : (ch * 32);
      const int rrow = t - tlo + 1;
#pragma unroll
      for (int g = 0; g < 5; ++g) *(u32x2*)(RAW + rrow * 320 + g * 64 + j0) = G[g];
      if (tid < 160) *(u32x2*)(RAW + (hr ? 33 : 0) * 320 + (hc >> 4) * 64 + (hc & 15) * 4) = GH;
      __syncthreads();
      if (ch + 1 < 128) {
        const int n2 = n + 32;
        const int t2 = d ? (4095 - n2) : n2;
        const size_t tok2 = (size_t)s * 4096 + t2;
#pragma unroll
        for (int g = 0; g < 5; ++g) {
          const int col = (g < 3) ? (g * 512 + h * 64) : (1536 + (g - 3) * 128 + d * 64);
          G[g] = *(const u32x2*)(PR + tok2 * PRW + col + j0);
        }
        GH = (u32x2){0u, 0u};
        if (tid < 160) {
          const int tlo2 = d ? (tlo - 32) : (tlo + 32);
          const int th = hr ? (tlo2 + 32) : (tlo2 - 1);
          const int g = hc >> 4;
          const int col = (g < 3) ? (g * 512 + h * 64) : (1536 + (g - 3) * 128 + d * 64);
          if (th >= 0 && th <= 4095) GH = *(const u32x2*)(PR + ((size_t)s * 4096 + th) * PRW + col + (hc & 15) * 4);
        }
      }
#pragma unroll
      for (int g = 0; g < 5; ++g) {
        float cur[4], prv[4], nxt[4];
        unpack4(*(const u32x2*)(RAW + rrow * 320 + g * 64 + j0), cur);
        unpack4(*(const u32x2*)(RAW + (rrow - 1) * 320 + g * 64 + j0), prv);
        unpack4(*(const u32x2*)(RAW + (rrow + 1) * 320 + g * 64 + j0), nxt);
        const f32x4 mp0 = *(const f32x4*)(MU + g * 64 + j0);
        const f32x4 mn0 = *(const f32x4*)(MU + 320 + g * 64 + j0);
        f32x4 x0;
#pragma unroll
        for (int e = 0; e < 4; ++e) x0[e] = cur[e] + mp0[e] * (prv[e] - cur[e]) + mn0[e] * (nxt[e] - cur[e]);
        if (g == 0) {
          *(f32x4*)(OPS + 4 * 2048 + pn * 64 + j0) = x0;
        } else if (g == 1) {
          *(f32x4*)(OPS + 3 * 2048 + pn * 64 + j0) = x0;
          const f32x4 kk0 = *(const f32x4*)(CST + 128 + j0);
          float ss = 0.f;
#pragma unroll
          for (int e = 0; e < 4; ++e) { const float a_ = x0[e] * kk0[e]; ss += a_ * a_; }
          ss = red16d(ss);
          if ((tid & 15) == 0) NRM[pn] = frcp(fmaxf(__builtin_amdgcn_sqrtf(ss), 1e-12f));
        } else if (g == 2) {
          *(f32x4*)(VV + pn * 64 + j0) = x0;
        } else if (g == 3) {
          u32x2 pk;
          pk.x = pack2(ftanh(x0[0]), ftanh(x0[1])); pk.y = pack2(ftanh(x0[2]), ftanh(x0[3]));
          *(u32x2*)(TWb + pn * 72 + j0) = pk;
        } else {
          u32x2 pk;
          pk.x = pack2(x0[0], x0[1]); pk.y = pack2(x0[2], x0[3]);
          *(u32x2*)(ADb + pn * 72 + j0) = pk;
        }
      }
      __syncthreads();
      {
        f32x4 cw = {0.f, 0.f, 0.f, 0.f}, ca = {0.f, 0.f, 0.f, 0.f};
#pragma unroll
        for (int ks = 0; ks < 2; ++ks) {
          const bf16x8 aw = *(const bf16x8*)(TWb + (wm * 16 + fr) * 72 + ks * 32 + fq * 8);
          const bf16x8 aa = *(const bf16x8*)(ADb + (wm * 16 + fr) * 72 + ks * 32 + fq * 8);
          cw = __builtin_amdgcn_mfma_f32_16x16x32_bf16(aw, bw[ks], cw, 0, 0, 0);
          ca = __builtin_amdgcn_mfma_f32_16x16x32_bf16(aa, ba[ks], ca, 0, 0, 0);
        }
#pragma unroll
        for (int jj = 0; jj < 4; ++jj) {
          WR[(wm * 16 + fq * 4 + jj) * 64 + wn * 16 + fr] = cw[jj];
          AP[(wm * 16 + fq * 4 + jj) * 64 + wn * 16 + fr] = ca[jj];
        }
      }
      __syncthreads();
      {
        const float inv = NRM[pn];
        float bsum = 0.f;
        const f32x4 wr_ = *(const f32x4*)(WR + pn * 64 + j0) + *(const f32x4*)(CST + j0);
        const f32x4 ap_ = *(const f32x4*)(AP + pn * 64 + j0) + *(const f32x4*)(CST + 64 + j0);
        const f32x4 kr = *(const f32x4*)(OPS + 3 * 2048 + pn * 64 + j0);
        const f32x4 rr = *(const f32x4*)(OPS + 4 * 2048 + pn * 64 + j0);
        const f32x4 kkw = *(const f32x4*)(CST + 128 + j0), kaw = *(const f32x4*)(CST + 192 + j0), rkw = *(const f32x4*)(CST + 256 + j0);
        f32x4 o0, o1, o2, o3;
#pragma unroll
        for (int e = 0; e < 4; ++e) {
          const float sw = sigm(wr_[e]);
          const float dec = __expf(-0.6065306597126334f * sw);
          const float av = sigm(ap_[e]);
          const float kn = kr[e] * kkw[e] * inv;
          const float kd = kr[e] * (1.f + (av - 1.f) * kaw[e]);
          bsum += rr[e] * kd * rkw[e];
          o0[e] = -kn; o1[e] = dec; o2[e] = kn * av; o3[e] = kd;
        }
        *(f32x4*)(OPS + 0 * 2048 + pn * 64 + j0) = o0;
        *(f32x4*)(OPS + 1 * 2048 + pn * 64 + j0) = o1;
        *(f32x4*)(OPS + 2 * 2048 + pn * 64 + j0) = o2;
        *(f32x4*)(OPS + 3 * 2048 + pn * 64 + j0) = o3;
        bsum = red16d(bsum);
        if ((tid & 15) == 0) BON[(tok * 8 + h) * 2 + d] = bsum;
      }
      __syncthreads();
      {
        ScanOps1 oa, ob;
        scan_load1(oa, OPS, VV, 0, jg, i0);
#pragma unroll 1
        for (int nn = 0; nn < 32; nn += 2) {
          scan_load1(ob, OPS, VV, nn + 1, jg, i0);
          scan_step1(oa, S0, YL, nn, jg, i0);
          scan_load1(oa, OPS, VV, (nn + 2) & 31, jg, i0);
          scan_step1(ob, S0, YL, nn + 1, jg, i0);
        }
      }
      __syncthreads();
      {
        typedef __attribute__((ext_vector_type(4))) _Float16 h16x4;
        h16x4 o;
#pragma unroll
        for (int e = 0; e < 4; ++e) o[e] = (_Float16)YL[pn * 64 + j0 + e];
        *(h16x4*)(Y + tok * 512 + h * 64 + j0) = o;
      }
    }
    __syncthreads();
  }
}

constexpr int PC_OPS = 0;
constexpr int PC_BUF = 49152;
constexpr int PC_RAW = 98304;
constexpr int PC_WR = 98304;
constexpr int PC_AP = 106496;
constexpr int PC_TW = 120064;
constexpr int PC_AD = 124672;
constexpr int PC_NRM = 129280;
constexpr int PC_MU = 129408;
constexpr int PC_CST = 131968;
constexpr int PC_YL = 133248;

DEVI void phase_scan_pc(int tid_, const Params& p, int l, char* smem, int bfirst, int bstride) {
  const u16* PR = (const u16*)(p.ws + OFF_PR);
  _Float16* YF = (_Float16*)(p.ws + OFF_H);
  _Float16* YB = (_Float16*)(p.ws + OFF_H + (size_t)NTOK * 512 * 2);
  float* BON = (float*)(p.ws + OFF_BONUS);
  const u16* WB = (const u16*)(p.ws + OFF_WB);
  u16* RAW = (u16*)(smem + PC_RAW);
  float* WR = (float*)(smem + PC_WR);
  float* AP = (float*)(smem + PC_AP);
  u16* TWb = (u16*)(smem + PC_TW);
  u16* ADb = (u16*)(smem + PC_AD);
  float* NRM = (float*)(smem + PC_NRM);
  float* MU = (float*)(smem + PC_MU);
  float* CST = (float*)(smem + PC_CST);
  const float* mu_p = p.in[I_MU_PREV] + (size_t)l * 1920;
  const float* mu_n = p.in[I_MU_NEXT] + (size_t)l * 1920;
  const bool is_prep = tid_ >= 256;
  const int tid = tid_ & 255, lane = tid & 63, w = tid >> 6, fr = lane & 15, fq = lane >> 4;
  const int pn = tid >> 3, j0 = (tid & 7) * 8;
  const int jg = lane & 7, i0 = w * 16 + (lane >> 3);
  const int hr = (tid >= 40) ? 1 : 0, hc = tid - hr * 40;
  for (int blk = bfirst; blk < 192; blk += bstride) {
    const int s = blk >> 4, h = (blk >> 1) & 7, d = blk & 1;
    __syncthreads();
    for (int i = tid_; i < 640; i += 512) {
      const int which = (i >= 320) ? 1 : 0, c = i - which * 320;
      const int g = c >> 6, e = c & 63;
      const int col = (g < 3) ? (g * 512 + h * 64 + e) : (1536 + (g - 3) * 128 + d * 64 + e);
      MU[i] = which ? mu_n[col] : mu_p[col];
    }
    if (tid_ < 320) {
      const int which = tid_ >> 6, e = tid_ & 63;
      float v;
      if (which == 0) v = p.in[I_W0][(size_t)(l * 2 + d) * 512 + h * 64 + e];
      else if (which == 1) v = p.in[I_A0][(size_t)(l * 2 + d) * 512 + h * 64 + e];
      else if (which == 2) v = p.in[I_K_K][(size_t)l * 512 + h * 64 + e];
      else if (which == 3) v = p.in[I_K_A][(size_t)l * 512 + h * 64 + e];
      else v = p.in[I_R_K][(size_t)(l * 8 + h) * 64 + e];
      CST[tid_] = v;
    }
    _Float16* Y = d ? YB : YF;
    if (is_prep) {
      bf16x8 bw[2], ba[2];
#pragma unroll
      for (int ks = 0; ks < 2; ++ks) {
        bw[ks] = *(const bf16x8*)(WB + W_WUP + (size_t)(d * 512 + h * 64 + w * 16 + fr) * 64 + ks * 32 + fq * 8);
        ba[ks] = *(const bf16x8*)(WB + W_AUP + (size_t)(d * 512 + h * 64 + w * 16 + fr) * 64 + ks * 32 + fq * 8);
      }
      u32x4 G[5], GH;
      {
        const int t = d ? (4095 - pn) : pn;
        const size_t tok = (size_t)s * 4096 + t;
#pragma unroll
        for (int g = 0; g < 5; ++g) {
          const int col = (g < 3) ? (g * 512 + h * 64) : (1536 + (g - 3) * 128 + d * 64);
          G[g] = *(const u32x4*)(PR + tok * PRW + col + j0);
        }
        GH = (u32x4){0u, 0u, 0u, 0u};
        if (tid < 80) {
          const int tlo = d ? (4095 - 31) : 0;
          const int th = hr ? (tlo + 32) : (tlo - 1);
          const int g = hc >> 3;
          const int col = (g < 3) ? (g * 512 + h * 64) : (1536 + (g - 3) * 128 + d * 64);
          if (th >= 0 && th <= 4095) GH = *(const u32x4*)(PR + ((size_t)s * 4096 + th) * PRW + col + (hc & 7) * 8);
        }
      }
#pragma unroll 1
      for (int ch = -1; ch < 128; ++ch) {
        const int c = ch + 1;
        const bool doprep = c < 128;
        float* OPS = (float*)(smem + PC_OPS + (c & 1) * PC_BUF);
        float* VV = OPS + 5 * 2048;
        const int n = c * 32 + pn;
        const int t = d ? (4095 - n) : n;
        const size_t tok = (size_t)s * 4096 + t;
        const int tlo = d ? (4095 - (c * 32 + 31)) : (c * 32);
        const int rrow = t - tlo + 1;
        __syncthreads();
        if (ch >= 1) {
          const float* YL = (const float*)(smem + PC_YL + ((ch - 1) & 1) * 8192);
          const int n1 = (ch - 1) * 32 + pn;
          const int t1 = d ? (4095 - n1) : n1;
          h16x8 o;
#pragma unroll
          for (int e = 0; e < 8; ++e) o[e] = (_Float16)YL[pn * 64 + j0 + e];
          *(h16x8*)(Y + ((size_t)s * 4096 + t1) * 512 + h * 64 + j0) = o;
        }
        if (doprep) {
#pragma unroll
          for (int g = 0; g < 5; ++g) *(u32x4*)(RAW + rrow * 320 + g * 64 + j0) = G[g];
          if (tid < 80) *(u32x4*)(RAW + (hr ? 33 : 0) * 320 + (hc >> 3) * 64 + (hc & 7) * 8) = GH;
        }
        __syncthreads();
        if (doprep) {
          if (c + 1 < 128) {
            const int n2 = n + 32;
            const int t2 = d ? (4095 - n2) : n2;
            const size_t tok2 = (size_t)s * 4096 + t2;
#pragma unroll
            for (int g = 0; g < 5; ++g) {
              const int col = (g < 3) ? (g * 512 + h * 64) : (1536 + (g - 3) * 128 + d * 64);
              G[g] = *(const u32x4*)(PR + tok2 * PRW + col + j0);
            }
            GH = (u32x4){0u, 0u, 0u, 0u};
            if (tid < 80) {
              const int tlo2 = d ? (tlo - 32) : (tlo + 32);
              const int th = hr ? (tlo2 + 32) : (tlo2 - 1);
              const int g = hc >> 3;
              const int col = (g < 3) ? (g * 512 + h * 64) : (1536 + (g - 3) * 128 + d * 64);
              if (th >= 0 && th <= 4095) GH = *(const u32x4*)(PR + ((size_t)s * 4096 + th) * PRW + col + (hc & 7) * 8);
            }
          }
#pragma unroll
          for (int g = 0; g < 5; ++g) {
            float cur[8], prv[8], nxt[8];
            load8bf(RAW + rrow * 320 + g * 64 + j0, cur);
            load8bf(RAW + (rrow - 1) * 320 + g * 64 + j0, prv);
            load8bf(RAW + (rrow + 1) * 320 + g * 64 + j0, nxt);
            const f32x4 mp0 = *(const f32x4*)(MU + g * 64 + j0), mp1 = *(const f32x4*)(MU + g * 64 + j0 + 4);
            const f32x4 mn0 = *(const f32x4*)(MU + 320 + g * 64 + j0), mn1 = *(const f32x4*)(MU + 320 + g * 64 + j0 + 4);
            f32x4 x0, x1;
#pragma unroll
            for (int e = 0; e < 4; ++e) {
              x0[e] = cur[e] + mp0[e] * (prv[e] - cur[e]) + mn0[e] * (nxt[e] - cur[e]);
              x1[e] = cur[4 + e] + mp1[e] * (prv[4 + e] - cur[4 + e]) + mn1[e] * (nxt[4 + e] - cur[4 + e]);
            }
            if (g == 0) {
              *(f32x4*)(OPS + 4 * 2048 + pn * 64 + j0) = x0; *(f32x4*)(OPS + 4 * 2048 + pn * 64 + j0 + 4) = x1;
            } else if (g == 1) {
              *(f32x4*)(OPS + 3 * 2048 + pn * 64 + j0) = x0; *(f32x4*)(OPS + 3 * 2048 + pn * 64 + j0 + 4) = x1;
              const f32x4 kk0 = *(const f32x4*)(CST + 128 + j0), kk1 = *(const f32x4*)(CST + 128 + j0 + 4);
              float ss = 0.f;
#pragma unroll
              for (int e = 0; e < 4; ++e) { const float a_ = x0[e] * kk0[e], b_ = x1[e] * kk1[e]; ss += a_ * a_ + b_ * b_; }
              ss = red8(ss);
              if ((tid & 7) == 0) NRM[pn] = frcp(fmaxf(__builtin_amdgcn_sqrtf(ss), 1e-12f));
            } else if (g == 2) {
              *(f32x4*)(VV + pn * 64 + j0) = x0; *(f32x4*)(VV + pn * 64 + j0 + 4) = x1;
            } else if (g == 3) {
              u32x4 pk;
              pk.x = pack2(ftanh(x0[0]), ftanh(x0[1])); pk.y = pack2(ftanh(x0[2]), ftanh(x0[3]));
              pk.z = pack2(ftanh(x1[0]), ftanh(x1[1])); pk.w = pack2(ftanh(x1[2]), ftanh(x1[3]));
              *(u32x4*)(TWb + pn * 72 + j0) = pk;
            } else {
              u32x4 pk;
              pk.x = pack2(x0[0], x0[1]); pk.y = pack2(x0[2], x0[3]);
              pk.z = pack2(x1[0], x1[1]); pk.w = pack2(x1[2], x1[3]);
              *(u32x4*)(ADb + pn * 72 + j0) = pk;
            }
          }
        }
        __syncthreads();
        if (doprep) {
#pragma unroll
          for (int m = 0; m < 2; ++m) {
            f32x4 cw = {0.f, 0.f, 0.f, 0.f}, ca = {0.f, 0.f, 0.f, 0.f};
#pragma unroll
            for (int ks = 0; ks < 2; ++ks) {
              const bf16x8 aw = *(const bf16x8*)(TWb + (m * 16 + fr) * 72 + ks * 32 + fq * 8);
              const bf16x8 aa = *(const bf16x8*)(ADb + (m * 16 + fr) * 72 + ks * 32 + fq * 8);
              cw = __builtin_amdgcn_mfma_f32_16x16x32_bf16(aw, bw[ks], cw, 0, 0, 0);
              ca = __builtin_amdgcn_mfma_f32_16x16x32_bf16(aa, ba[ks], ca, 0, 0, 0);
            }
#pragma unroll
            for (int jj = 0; jj < 4; ++jj) {
              WR[(m * 16 + fq * 4 + jj) * 64 + w * 16 + fr] = cw[jj];
              AP[(m * 16 + fq * 4 + jj) * 64 + w * 16 + fr] = ca[jj];
            }
          }
        }
        __syncthreads();
        if (doprep) {
          const float inv = NRM[pn];
          float bsum = 0.f;
#pragma unroll
          for (int hq = 0; hq < 2; ++hq) {
            const int jb = j0 + hq * 4;
            const f32x4 wr_ = *(const f32x4*)(WR + pn * 64 + jb) + *(const f32x4*)(CST + jb);
            const f32x4 ap_ = *(const f32x4*)(AP + pn * 64 + jb) + *(const f32x4*)(CST + 64 + jb);
            const f32x4 kr = *(const f32x4*)(OPS + 3 * 2048 + pn * 64 + jb);
            const f32x4 rr = *(const f32x4*)(OPS + 4 * 2048 + pn * 64 + jb);
            const f32x4 kkw = *(const f32x4*)(CST + 128 + jb), kaw = *(const f32x4*)(CST + 192 + jb), rkw = *(const f32x4*)(CST + 256 + jb);
            f32x4 o0, o1, o2, o3;
#pragma unroll
            for (int e = 0; e < 4; ++e) {
              const float sw = sigm(wr_[e]);
              const float dec = __expf(-0.6065306597126334f * sw);
              const float av = sigm(ap_[e]);
              const float kn = kr[e] * kkw[e] * inv;
              const float kd = kr[e] * (1.f + (av - 1.f) * kaw[e]);
              bsum += rr[e] * kd * rkw[e];
              o0[e] = -kn; o1[e] = dec; o2[e] = kn * av; o3[e] = kd;
            }
            *(f32x4*)(OPS + 0 * 2048 + pn * 64 + jb) = o0;
            *(f32x4*)(OPS + 1 * 2048 + pn * 64 + jb) = o1;
            *(f32x4*)(OPS + 2 * 2048 + pn * 64 + jb) = o2;
            *(f32x4*)(OPS + 3 * 2048 + pn * 64 + jb) = o3;
          }
          bsum = red8(bsum);
          if ((tid & 7) == 0) BON[(tok * 8 + h) * 2 + d] = bsum;
        }
      }
      __syncthreads();
      {
        const float* YL = (const float*)(smem + PC_YL + (127 & 1) * 8192);
        const int n1 = 127 * 32 + pn;
        const int t1 = d ? (4095 - n1) : n1;
        h16x8 o;
#pragma unroll
        for (int e = 0; e < 8; ++e) o[e] = (_Float16)YL[pn * 64 + j0 + e];
        *(h16x8*)(Y + ((size_t)s * 4096 + t1) * 512 + h * 64 + j0) = o;
      }
    } else {
      f32x2 S0[4], S1[4];
#pragma unroll
      for (int q = 0; q < 4; ++q) { S0[q] = (f32x2){0.f, 0.f}; S1[q] = (f32x2){0.f, 0.f}; }
#pragma unroll 1
      for (int ch = -1; ch < 128; ++ch) {
        const float* OPS = (const float*)(smem + PC_OPS + (ch & 1) * PC_BUF);
        const float* VV = OPS + 5 * 2048;
        float* YL = (float*)(smem + PC_YL + (ch & 1) * 8192);
        __syncthreads();
        if (ch < 0) {
          __syncthreads(); __syncthreads(); __syncthreads();
        } else {
          ScanOps oa, ob;
          scan_load(oa, OPS, VV, 0, jg, i0);
#pragma unroll 1
          for (int seg = 0; seg < 4; ++seg) {
            if (seg > 0) __syncthreads();
#pragma unroll 1
            for (int nn = seg * 8; nn < seg * 8 + 8; nn += 2) {
              scan_load(ob, OPS, VV, nn + 1, jg, i0);
              scan_step(oa, S0, S1, YL, nn, jg, i0);
              scan_load(oa, OPS, VV, (nn + 2) & 31, jg, i0);
              scan_step(ob, S0, S1, YL, nn + 1, jg, i0);
            }
          }
        }
      }
      __syncthreads();
    }
    __syncthreads();
  }
}

DEVI void phase_rwkv_post(int tid_, int vb_, int vg_, const Params& p, int l, char* smem) {
  u16* PR = (u16*)(p.ws + OFF_PR);
  const _Float16* YF = (const _Float16*)(p.ws + OFF_H);
  const _Float16* YB = (const _Float16*)(p.ws + OFF_H + (size_t)NTOK * 512 * 2);
  const float* BON = (const float*)(p.ws + OFF_BONUS);
  const u16* GUPT = (const u16*)(p.ws + OFF_WB) + W_GUP;
  const float* mu_p = p.in[I_MU_PREV] + (size_t)l * 1920;
  const float* mu_n = p.in[I_MU_NEXT] + (size_t)l * 1920;
  const float* gng = p.in[I_GN_G] + (size_t)l * 512;
  const float* gnb = p.in[I_GN_B] + (size_t)l * 512;
  u16* As = (u16*)smem;
  const int tid = tid_, lane = tid & 63, w = tid >> 6, fr = lane & 15, fq = lane >> 4;
  for (int tile = vb_; tile < NTOK / 64; tile += vg_) {
    const size_t tok0 = (size_t)tile * 64;
    {
      const int row = tid >> 2, part = tid & 3;
      const size_t tok = tok0 + row;
      const int t = (int)(tok & 4095);
#pragma unroll
      for (int q = 0; q < 4; ++q) {
        const int col = 1792 + part * 32 + q * 8;
        float cur[8], prv[8], nxt[8];
        load8bf(PR + tok * PRW + col, cur);
        if (t > 0) load8bf(PR + (tok - 1) * PRW + col, prv);
        else {
#pragma unroll
          for (int e = 0; e < 8; ++e) prv[e] = 0.f;
        }
        if (t < 4095) load8bf(PR + (tok + 1) * PRW + col, nxt);
        else {
#pragma unroll
          for (int e = 0; e < 8; ++e) nxt[e] = 0.f;
        }
        float o[8];
#pragma unroll
        for (int e = 0; e < 8; ++e) {
          const float x = cur[e] + mu_p[col + e] * (prv[e] - cur[e]) + mu_n[col + e] * (nxt[e] - cur[e]);
          o[e] = sigm(x);
        }
        u32x4 pk;
        pk.x = pack2(o[0], o[1]); pk.y = pack2(o[2], o[3]); pk.z = pack2(o[4], o[5]); pk.w = pack2(o[6], o[7]);
        *(u32x4*)(As + row * 136 + part * 32 + q * 8) = pk;
      }
    }
    asm volatile("" ::: "memory");
#pragma unroll 1
    for (int chh = 0; chh < 2; ++chh) {
      f32x4 acc[16];
#pragma unroll
      for (int n = 0; n < 16; ++n) acc[n] = (f32x4){0.f, 0.f, 0.f, 0.f};
#pragma unroll
      for (int ks = 0; ks < 4; ++ks) {
        bf16x8 af = *(const bf16x8*)(As + (w * 16 + fr) * 136 + ks * 32 + fq * 8);
#pragma unroll
        for (int n = 0; n < 16; ++n) {
          bf16x8 bg = *(const bf16x8*)(GUPT + (size_t)(chh * 256 + n * 16 + fr) * 128 + ks * 32 + fq * 8);
          acc[n] = __builtin_amdgcn_mfma_f32_16x16x32_bf16(af, bg, acc[n], 0, 0, 0);
        }
      }
#pragma unroll
      for (int hl = 0; hl < 4; ++hl) {
        const int head = chh * 4 + hl;
        asm volatile("" ::: "memory");
#pragma unroll
        for (int j = 0; j < 4; ++j) {
          const size_t tok = tok0 + w * 16 + fq * 4 + j;
          const int t = (int)(tok & 4095);
          float o[4], sum = 0.f;
#pragma unroll
          for (int q = 0; q < 4; ++q) {
            const int col = head * 64 + q * 16 + fr;
            o[q] = (float)YF[tok * 512 + col] + (float)YB[tok * 512 + col];
            sum += o[q];
          }
          const float mean = red16_sum(sum) * (1.f / 64.f);
          float vs = 0.f;
#pragma unroll
          for (int q = 0; q < 4; ++q) { const float dlt = o[q] - mean; vs += dlt * dlt; }
          const float var = red16_sum(vs) * (1.f / 64.f);
          const float rstd = rsqrtf(var + 64e-5f);
          const float bon = BON[(tok * 8 + head) * 2] + BON[(tok * 8 + head) * 2 + 1];
#pragma unroll
          for (int q = 0; q < 4; ++q) {
            const int col = head * 64 + q * 16 + fr;
            const int vc = 1024 + col;
            const float cur = bf2f(PR[tok * PRW + vc]);
            const float prv = (t > 0) ? bf2f(PR[(tok - 1) * PRW + vc]) : 0.f;
            const float nxt = (t < 4095) ? bf2f(PR[(tok + 1) * PRW + vc]) : 0.f;
            const float vsh = cur + mu_p[vc] * (prv - cur) + mu_n[vc] * (nxt - cur);
            const float yv = ((o[q] - mean) * rstd * gng[col] + gnb[col] + bon * vsh) * acc[hl * 4 + q][j];
            PR[tok * PRW + col] = f2bf(yv);
          }
        }
      }
    }
  }
}

DEVI f32x4 ld4bf(const u16* p) {
  const u32x2 u = *(const u32x2*)p;
  f32x4 o;
  o[0] = __uint_as_float(u.x << 16); o[1] = __uint_as_float(u.x & 0xffff0000u);
  o[2] = __uint_as_float(u.y << 16); o[3] = __uint_as_float(u.y & 0xffff0000u);
  return o;
}

DEVI void phase_merge(int tid_, const Params& p, char* smem) {
  const u16* WB = (const u16*)(p.ws + OFF_WB);
  const u16* H = (const u16*)(p.ws + OFF_NK);
  u16* PR = (u16*)(p.ws + OFF_PR);
  const u16* NQ = (const u16*)(p.ws + OFF_NQ);
  u16* TMP = (u16*)(p.ws + OFF_H);
  const int lane = tid_ & 63, wid = tid_ >> 6;
  const int wr = wid >> 2, wc = wid & 3, fr = lane & 15, fq = lane >> 4;
  const bool xmap = (gridDim.x & 7) == 0;
  const int xcd = blockIdx.x & 7;
  const int first = xmap ? (int)(blockIdx.x >> 3) : (int)blockIdx.x;
  const int stride = xmap ? (int)(gridDim.x >> 3) : (int)gridDim.x;
  const int count = xmap ? 24 * 4 : 192 * 4;
  for (int it = first; it < count; it += stride) {
    const int tm = xmap ? (it >> 2) * 8 + xcd : (it >> 2), tn = it & 3;
    const int m0 = tm << 8, n0 = tn << 8;
    f32x4 acc[8][4];
#define MERGE_ZERO() _Pragma("unroll") for (int m = 0; m < 8; ++m) _Pragma("unroll") for (int n = 0; n < 4; ++n) acc[m][n] = (f32x4){0.f, 0.f, 0.f, 0.f}
#define MERGE_RC() const int r = m0 + wr * 128 + m * 16 + fr, c0 = n0 + wc * 64 + n * 16 + fq * 4
    MERGE_ZERO();
    gemm_kloop8<true>(launder(tid_), acc, H + (size_t)m0 * 1024, 1024, WB + W_IN + (size_t)(3456 + n0) * 1024, 1024, 1024, smem);
#pragma unroll
    for (int m = 0; m < 8; ++m)
#pragma unroll
      for (int n = 0; n < 4; ++n) {
        MERGE_RC();
        f32x4 o;
#pragma unroll
        for (int j = 0; j < 4; ++j) o[j] = sigm(acc[m][n][j]);
        store4bf(PR + (size_t)r * PRW + 512 + c0, o);
      }
    MERGE_ZERO();
    gemm_kloop8<true>(launder(tid_), acc, PR + (size_t)m0 * PRW, PRW, WB + W_BRR + (size_t)n0 * 512, 512, 512, smem);
#pragma unroll
    for (int m = 0; m < 8; ++m)
#pragma unroll
      for (int n = 0; n < 4; ++n) {
        MERGE_RC();
        u16* dst = PR + (size_t)r * PRW + 512 + c0;
        store4bf(dst, ld4bf(dst) * acc[m][n]);
      }
    MERGE_ZERO();
    gemm_kloop8<true>(launder(tid_), acc, H + (size_t)m0 * 1024, 1024, WB + W_IN + (size_t)(4480 + n0) * 1024, 1024, 1024, smem);
#pragma unroll
    for (int m = 0; m < 8; ++m)
#pragma unroll
      for (int n = 0; n < 4; ++n) {
        MERGE_RC();
        f32x4 o;
#pragma unroll
        for (int j = 0; j < 4; ++j) o[j] = sigm(acc[m][n][j]);
        store4bf(TMP + (size_t)r * 1024 + c0, o);
      }
    MERGE_ZERO();
    gemm_kloop8<true>(launder(tid_), acc, NQ + (size_t)m0 * 512, 512, WB + W_BRN + (size_t)n0 * 512, 512, 512, smem);
#pragma unroll
    for (int m = 0; m < 8; ++m)
#pragma unroll
      for (int n = 0; n < 4; ++n) {
        MERGE_RC();
        u16* dst = PR + (size_t)r * PRW + 512 + c0;
        store4bf(dst, ld4bf(dst) + ld4bf(TMP + (size_t)r * 1024 + c0) * acc[m][n]);
      }
#undef MERGE_ZERO
#undef MERGE_RC
  }
}


DEVI void phase_xattn(int tid_, int vb_, int vg_, const Params& p, char* smem) {
  const u16* Q = (const u16*)(p.ws + OFF_PR);
  u16* O = (u16*)(p.ws + OFF_NQ);
  const u16* KVK = (const u16*)(p.ws + OFF_KVK);
  const u16* KVT = (const u16*)(p.ws + OFF_KVT);
  const int lane = tid_ & 63, w = tid_ >> 6, fr = lane & 15, fq = lane >> 4;
  u16* Pw = (u16*)smem + w * (32 * 264);
  for (int t = vb_; t < (NTOK / 128) * 4; t += vg_) {
    const int hh = t & 3;
    const size_t tok0 = (size_t)(t >> 2) * 128 + w * 32;
    const int s = (int)(tok0 >> 12);
    f32x4 acc[2][16];
#pragma unroll
    for (int mt = 0; mt < 2; ++mt)
#pragma unroll
      for (int n = 0; n < 16; ++n) acc[mt][n] = (f32x4){0.f, 0.f, 0.f, 0.f};
#pragma unroll 1
    for (int ks = 0; ks < 8; ++ks) {
      const bf16x8 aq0 = *(const bf16x8*)(Q + (tok0 + fr) * 1024 + hh * 256 + ks * 32 + fq * 8);
      const bf16x8 aq1 = *(const bf16x8*)(Q + (tok0 + 16 + fr) * 1024 + hh * 256 + ks * 32 + fq * 8);
#pragma unroll
      for (int n = 0; n < 16; ++n) {
        const bf16x8 bk = *(const bf16x8*)(KVK + (size_t)(s * 256 + n * 16 + fr) * 1024 + hh * 256 + ks * 32 + fq * 8);
        acc[0][n] = __builtin_amdgcn_mfma_f32_16x16x32_bf16(bk, aq0, acc[0][n], 0, 0, 0);
        acc[1][n] = __builtin_amdgcn_mfma_f32_16x16x32_bf16(bk, aq1, acc[1][n], 0, 0, 0);
      }
    }
    float sm[2];
#pragma unroll
    for (int mt = 0; mt < 2; ++mt) {
      float m = -1e30f;
#pragma unroll
      for (int n = 0; n < 16; ++n)
#pragma unroll
        for (int j = 0; j < 4; ++j) m = fmaxf(m, acc[mt][n][j]);
      m = red4x_max(m) * 0.0625f;
      float ssum = 0.f;
#pragma unroll
      for (int n = 0; n < 16; ++n) {
        f32x4 e;
#pragma unroll
        for (int j = 0; j < 4; ++j) { e[j] = __expf(acc[mt][n][j] * 0.0625f - m); ssum += e[j]; }
        store4bf(Pw + (mt * 16 + fr) * 264 + n * 16 + fq * 4, e);
      }
      sm[mt] = 1.f / red4x_sum(ssum);
    }
#pragma unroll
    for (int mt = 0; mt < 2; ++mt)
#pragma unroll
      for (int n = 0; n < 16; ++n) acc[mt][n] = (f32x4){0.f, 0.f, 0.f, 0.f};
#pragma unroll 1
    for (int ks = 0; ks < 8; ++ks) {
      const bf16x8 ap0 = *(const bf16x8*)(Pw + fr * 264 + ks * 32 + fq * 8);
      const bf16x8 ap1 = *(const bf16x8*)(Pw + (16 + fr) * 264 + ks * 32 + fq * 8);
#pragma unroll
      for (int n = 0; n < 16; ++n) {
        const bf16x8 bv = *(const bf16x8*)(KVT + (size_t)(s * 1024 + hh * 256 + n * 16 + fr) * 256 + ks * 32 + fq * 8);
        acc[0][n] = __builtin_amdgcn_mfma_f32_16x16x32_bf16(bv, ap0, acc[0][n], 0, 0, 0);
        acc[1][n] = __builtin_amdgcn_mfma_f32_16x16x32_bf16(bv, ap1, acc[1][n], 0, 0, 0);
      }
    }
#pragma unroll
    for (int mt = 0; mt < 2; ++mt)
#pragma unroll
      for (int n = 0; n < 16; ++n)
        store4bf(O + (tok0 + mt * 16 + fr) * 1024 + hh * 256 + n * 16 + fq * 4, acc[mt][n] * sm[mt]);
  }
}

constexpr int HALF_SMEM = 78720;

DEVI void run_phase(int tid_, const Params& p, int ph, char* smem) {
  const int half = tid_ >> 8, vt = tid_ & 255;
  const int vb_ = blockIdx.x * 2 + half, vg_ = gridDim.x * 2;
  char* smh = smem + half * HALF_SMEM;
  if (ph == 2 * NPH_LAYER) { phase_final_norm(vt, vb_, vg_, p); return; }
  const int l = ph / NPH_LAYER, q = ph % NPH_LAYER;
  u16* WB = (u16*)(p.ws + OFF_WB);
  u16* H = (u16*)(p.ws + OFF_H);
  u16* PR = (u16*)(p.ws + OFF_PR);
  u16* NQ = (u16*)(p.ws + OFF_NQ);
  float* X = p.X;
  auto epi_res = [&](int r, int c0, f32x4 v) {
    f32x4* px = (f32x4*)(X + (size_t)r * 1024 + c0);
    *px = *px + v;
  };
  constexpr int NONS = 1 << 30;
  switch (q) {
    case 0:
      phase_conv(vt, vb_, vg_, p, l, smh);
      phase_norm(vt, vb_, vg_, p, p.in[I_NORM_MIX] + (size_t)l * 1024, l == 0);
      phase_norm_mem(vt, vb_, vg_, p, p.in[I_NORM_MEM] + (size_t)l * 1024);
      break;
    case 1: phase_p_gemm(tid_, p, smem); break;
    case 2:
      if (gridDim.x >= 224) {
        if (blockIdx.x < 192) phase_scan_pc(tid_, p, l, smem, blockIdx.x, gridDim.x);
        else phase_nat(vt, p, l, smh, vb_ - 384, vg_ - 384);
      } else {
        phase_scan(vt, p, l, smh, vb_, vg_);
        __syncthreads();
        phase_nat(vt, p, l, smh, vb_, vg_);
      }
      break;
    case 3:
      phase_rwkv_post(vt, vb_, vg_, p, l, smh);
      phase_norm(vt, vb_, vg_, p, p.in[I_NORM_MIX] + (size_t)l * 1024, false, OFF_NK);
      break;
    case 4: phase_merge(tid_, p, smem); break;
    case 5: gemm_phase8(tid_, PR + 512, PRW, WB + W_OUT, 1024, 1024, NTOK, 1024, smem, NONS, epi_res, NoEpi()); break;
    case 6: phase_norm(vt, vb_, vg_, p, p.in[I_NORM_X] + (size_t)l * 1024, false); break;
    case 7:
      gemm_phase8(tid_, H, 1024, WB + W_XQ, 1024, 1024, NTOK, 1024, smem, NONS,
                 [&](int r, int c0, f32x4 v) { store4bf(PR + (size_t)r * 1024 + c0, v); }, NoEpi());
      break;
    case 8: phase_xattn(vt, vb_, vg_, p, smh); break;
    case 9: gemm_phase8(tid_, NQ, 1024, WB + W_XO, 1024, 1024, NTOK, 1024, smem, NONS, epi_res, NoEpi()); break;
    case 10: phase_norm(vt, vb_, vg_, p, p.in[I_NORM_FF] + (size_t)l * 1024, false); break;
    case 11:
    case 13: {
      const int hf = (q == 13);
      gemm_phase8(tid_, H, 1024, WB + W_FF1 + (size_t)hf * 2048 * 1024, 1024, 1024, NTOK, 2048, smem, NONS,
                 [&](int r, int c0, f32x4 v) {
                   f32x4 o;
#pragma unroll
                   for (int j = 0; j < 4; ++j) { const float x = fmaxf(v[j], 0.f); o[j] = x * x; }
                   store4bf(PR + (size_t)r * 2048 + c0, o);
                 }, NoEpi());
    } break;
    case 12:
    case 14: {
      const int hf = (q == 14);
      gemm_phase8(tid_, PR, 2048, WB + W_FF2 + (size_t)hf * 2048, 4096, 2048, NTOK, 1024, smem, NONS, epi_res, NoEpi());
    } break;
  }
}

#define XB_TMO      128
#define XB_XCNT(j)  (256  + 64 * (j))
#define XB_XSUB(j)  (1280 + 64 * (j))
#define XB_XGEN(j)  (2304 + 64 * (j))
#define XB_TOP      3328
#define XB_TOPGEN   3392
#define XCD_BAR_WORDS 3456
#define XB_SPIN_CAP (1u << 20)
#define LAS __attribute__((address_space(3)))

DEVI unsigned xb_ld(unsigned* p) { return __hip_atomic_load(p, __ATOMIC_RELAXED, __HIP_MEMORY_SCOPE_AGENT); }
DEVI unsigned xb_add(unsigned* p, unsigned v) { return __hip_atomic_fetch_add(p, v, __ATOMIC_RELAXED, __HIP_MEMORY_SCOPE_AGENT); }
DEVI unsigned xb_xcc_id() { return (unsigned)__builtin_amdgcn_s_getreg((3 << 11) | 20) & 0xFu; }
#define XB_SPIN(cond, bar) do { unsigned _sp = 0; while (cond) { __builtin_amdgcn_s_sleep(1); \
    if ((++_sp & 255u) == 0u) { if (xb_ld(&(bar)[XB_TMO])) break; if (_sp > XB_SPIN_CAP) { atomicAdd(&(bar)[XB_TMO], 1u); break; } } } } while (0)

struct XcdBarrier {
  unsigned* bar; unsigned x;
  volatile LAS unsigned* st;
};
DEVI XcdBarrier xcd_barrier_post(unsigned* bar, volatile LAS unsigned* st) {
  XcdBarrier b; b.bar = bar; b.x = xb_xcc_id(); b.st = st;
  if (threadIdx.x == 0) (void)xb_add(&bar[XB_XCNT(b.x)], 1u);
  return b;
}
DEVI void xcd_barrier_complete(unsigned* bar, unsigned x, unsigned& nloc, unsigned& nx) {
  const unsigned G = gridDim.x * gridDim.y * gridDim.z;
  unsigned sum, cnt, mine, sp = 0u;
  for (;;) {
    sum = 0u; cnt = 0u; mine = 0u;
#pragma unroll
    for (unsigned j = 0; j < 16; ++j) { const unsigned c = xb_ld(&bar[XB_XCNT(j)]); sum += c; cnt += (c > 0u) ? 1u : 0u; mine = (j == x) ? c : mine; }
    if (sum == G) break;
    __builtin_amdgcn_s_sleep(1);
    if ((++sp & 255u) == 0u) { if (xb_ld(&bar[XB_TMO])) break; if (sp > XB_SPIN_CAP) { atomicAdd(&bar[XB_TMO], 1u); break; } }
  }
  nloc = mine > 0u ? mine : 1u; nx = cnt > 0u ? cnt : 1u;
}
DEVI void xcd_barrier(const XcdBarrier& b) {
  asm volatile("s_waitcnt vmcnt(0)" ::: "memory");
  __syncthreads();
  if (threadIdx.x == 0) {
    unsigned* bar = b.bar;
    __builtin_amdgcn_s_waitcnt(0);
    unsigned nloc = b.st[0], nx = b.st[1];
    if (nloc == 0u) { xcd_barrier_complete(bar, b.x, nloc, nx); b.st[0] = nloc; b.st[1] = nx; }
    const unsigned old = xb_add(&bar[XB_XSUB(b.x)], 1u);
    const unsigned gen = old / nloc;
    if (old + 1u == (gen + 1u) * nloc) {
      __builtin_amdgcn_fence(__ATOMIC_RELEASE, "agent");
      asm volatile("s_waitcnt vmcnt(0)" ::: "memory");
      const unsigned og = xb_add(&bar[XB_TOP], 1u);
      const unsigned tg = og / nx;
      if (og + 1u == (tg + 1u) * nx) xb_add(&bar[XB_TOPGEN], 1u);
      else XB_SPIN(xb_ld(&bar[XB_TOPGEN]) == tg, bar);
      __builtin_amdgcn_fence(__ATOMIC_ACQUIRE, "agent");
      xb_add(&bar[XB_XGEN(b.x)], 1u);
      asm volatile("s_waitcnt vmcnt(0)" ::: "memory");
    } else {
      XB_SPIN(xb_ld(&bar[XB_XGEN(b.x)]) == gen, bar);
      __builtin_amdgcn_fence(__ATOMIC_ACQUIRE, "agent");
      asm volatile("s_waitcnt vmcnt(0)" ::: "memory");
    }
  }
  __syncthreads();
}

__global__ void __launch_bounds__(512, 2) mega_kernel(Params p, int ph0, int ph1) {
  __shared__ __attribute__((aligned(16))) char smem[2 * HALF_SMEM];
  __shared__ __attribute__((aligned(16))) unsigned xb_words[4];
  if (threadIdx.x == 0) { xb_words[0] = 0u; xb_words[1] = 0u; xb_words[2] = 0u; xb_words[3] = 0u; }
  __syncthreads();
  XcdBarrier xb = xcd_barrier_post((unsigned*)(p.ws + OFF_BAR), (volatile LAS unsigned*)xb_words);
  for (int ph = ph0; ph < ph1; ++ph) {
    if (ph == ph0 + 1) cg::this_grid().sync();
    else if (ph > ph0) xcd_barrier(xb);
    int tid_ = threadIdx.x;
    asm volatile("" : "+v"(tid_));
    run_phase(tid_, p, ph, smem);
  }
}

extern "C" void kernel_launch(void* const* d_in, const int* in_sizes, int n_in, void* d_out, int out_size, void* d_ws,
                              size_t ws_size, hipStream_t stream) {
  if (ws_size < WS_NEED || n_in < 31) return;
  Params p{};
  for (int i = 0; i < 31; ++i) p.in[i] = (const float*)d_in[i];
  p.X = (float*)d_out;
  p.ws = (char*)d_ws;
  static int grid_blocks = 0;
  if (!grid_blocks) {
    int dev = 0, cus = 0, per_cu = 0;
    hipGetDevice(&dev);
    hipDeviceGetAttribute(&cus, hipDeviceAttributeMultiprocessorCount, dev);
    hipOccupancyMaxActiveBlocksPerMultiprocessor(&per_cu, mega_kernel, 512, 0);
    if (per_cu > 1) per_cu = 1;
    if (per_cu < 1) per_cu = 1;
    grid_blocks = cus * per_cu;
  }
  hipMemsetAsync((char*)d_ws + OFF_BAR, 0, 16384, stream);
  int ph0 = 0, ph1 = NPHASES;
  void* args[] = {&p, &ph0, &ph1};
  hipLaunchCooperativeKernel((void*)mega_kernel, dim3(grid_blocks), dim3(512), args, 0, stream);
}
```

```cpp
#include <hip/hip_runtime.h>
#include <hip/hip_cooperative_groups.h>
#include <stdint.h>
namespace cg = cooperative_groups;

typedef unsigned short u16;
typedef __attribute__((ext_vector_type(8))) short bf16x8;
typedef __attribute__((ext_vector_type(4))) float f32x4;
typedef __attribute__((ext_vector_type(8))) _Float16 h16x8;
typedef __attribute__((ext_vector_type(4))) unsigned int u32x4;
typedef __attribute__((ext_vector_type(2))) unsigned int u32x2;

#define DEVI __device__ __forceinline__

constexpr int NTOK = 49152;
constexpr int SEQ_T = 4096;
constexpr int PRW = 1920;
constexpr int NPH_LAYER = 15;
constexpr int NPHASES = 2 * NPH_LAYER + 1;
constexpr int SMEM_BYTES = 78720;

constexpr size_t OFF_WB = 0;
constexpr size_t WB_BYTES = 20512768ull * 2;
constexpr size_t OFF_H = OFF_WB + WB_BYTES;
constexpr size_t OFF_PR = OFF_H + (size_t)NTOK * 1024 * 2;
constexpr size_t OFF_NQ = OFF_PR + (size_t)NTOK * PRW * 2;
constexpr size_t OFF_NK = OFF_NQ + (size_t)NTOK * 512 * 2;
constexpr size_t OFF_NV = OFF_NK + (size_t)NTOK * 512 * 2;
constexpr size_t OFF_KVK = OFF_NV + (size_t)NTOK * 512 * 2;
constexpr size_t OFF_KVT = OFF_KVK + (size_t)3072 * 1024 * 2;
constexpr size_t OFF_MEMH = OFF_KVT + (size_t)3072 * 1024 * 2;
constexpr size_t OFF_BONUS = OFF_MEMH + (size_t)3072 * 1024 * 2;
constexpr size_t OFF_BAR = OFF_BONUS + (size_t)NTOK * 16 * 4;
constexpr size_t WS_NEED = OFF_BAR + 16384;

constexpr size_t W_IN = 0;
constexpr size_t W_BRR = W_IN + (size_t)5504 * 1024;
constexpr size_t W_BRN = W_BRR + (size_t)1024 * 512;
constexpr size_t W_OUT = W_BRN + (size_t)1024 * 512;
constexpr size_t W_XQ = W_OUT + (size_t)1024 * 1024;
constexpr size_t W_XKV = W_XQ + (size_t)1024 * 1024;
constexpr size_t W_XO = W_XKV + (size_t)2048 * 1024;
constexpr size_t W_FF1 = W_XO + (size_t)1024 * 1024;
constexpr size_t W_FF2 = W_FF1 + (size_t)4096 * 1024;
constexpr size_t W_GUP = W_FF2 + (size_t)4096 * 1024;
constexpr size_t W_WUP = W_GUP + (size_t)512 * 128;
constexpr size_t W_AUP = W_WUP + (size_t)2 * 512 * 64;

enum { I_XP = 0, I_XS, I_MP, I_MS, I_NORM_MIX, I_W_IN, I_MU_PREV, I_MU_NEXT, I_W0, I_W_UP, I_A0, I_A_UP,
       I_G_UP, I_K_K, I_K_A, I_R_K, I_GN_G, I_GN_B, I_RPB, I_W_BR_RWKV, I_W_BR_NAT, I_W_OUT, I_NORM_X,
       I_NORM_MEM, I_W_XQ, I_W_XKV, I_W_XO, I_NORM_FF, I_W_FF1, I_W_FF2, I_NORM_FINAL };

struct Params {
  const float* in[31];
  float* X;
  char* ws;
};

DEVI u16 f2bf(float f) {
  uint32_t u = __float_as_uint(f);
  u += 0x7FFFu + ((u >> 16) & 1u);
  return (u16)(u >> 16);
}
DEVI float bf2f(u16 h) { return __uint_as_float(((uint32_t)h) << 16); }
DEVI uint32_t pack2(float a, float b) { return (uint32_t)f2bf(a) | ((uint32_t)f2bf(b) << 16); }
DEVI float frcp(float x) { return __builtin_amdgcn_rcpf(x); }
DEVI float sigm(float x) { return frcp(1.f + __expf(-x)); }
DEVI float ftanh(float x) { return 1.f - 2.f * frcp(__expf(2.f * x) + 1.f); }
DEVI void unpack8(u32x4 u, float* o) {
  o[0] = __uint_as_float(u.x << 16); o[1] = __uint_as_float(u.x & 0xffff0000u);
  o[2] = __uint_as_float(u.y << 16); o[3] = __uint_as_float(u.y & 0xffff0000u);
  o[4] = __uint_as_float(u.z << 16); o[5] = __uint_as_float(u.z & 0xffff0000u);
  o[6] = __uint_as_float(u.w << 16); o[7] = __uint_as_float(u.w & 0xffff0000u);
}
DEVI void load8bf(const u16* p, float* o) { unpack8(*(const u32x4*)p, o); }
DEVI float wave_sum(float v) {
  v += __shfl_xor(v, 32); v += __shfl_xor(v, 16); v += __shfl_xor(v, 8);
  v += __shfl_xor(v, 4); v += __shfl_xor(v, 2); v += __shfl_xor(v, 1);
  return v;
}
DEVI float red4x_sum(float v) { v += __shfl_xor(v, 16); v += __shfl_xor(v, 32); return v; }
DEVI float red4x_max(float v) { v = fmaxf(v, __shfl_xor(v, 16)); v = fmaxf(v, __shfl_xor(v, 32)); return v; }
DEVI float red16_sum(float v) {
  v += __shfl_xor(v, 1); v += __shfl_xor(v, 2); v += __shfl_xor(v, 4); v += __shfl_xor(v, 8);
  return v;
}
DEVI float red16_max(float v) {
  v = fmaxf(v, __shfl_xor(v, 1)); v = fmaxf(v, __shfl_xor(v, 2));
  v = fmaxf(v, __shfl_xor(v, 4)); v = fmaxf(v, __shfl_xor(v, 8));
  return v;
}

DEVI void conv_tile(int tid_, const float* src, int K, int N, u16* dst, int tile, char* smem) {
  float (*s)[65] = (float (*)[65])smem;
  const int nN = N >> 6;
  const int tk = tile / nN, tn = tile - tk * nN;
  const int tx = tid_ & 63, ty = tid_ >> 6;
  for (int r = ty; r < 64; r += 4) s[r][tx] = src[(size_t)(tk * 64 + r) * N + tn * 64 + tx];
  __syncthreads();
  for (int r = ty; r < 64; r += 4) dst[(size_t)(tn * 64 + r) * K + tk * 64 + tx] = f2bf(s[tx][r]);
  __syncthreads();
}

DEVI void phase_conv(int tid_, int vb_, int vg_, const Params& p, int l, char* smem) {
  u16* WB = (u16*)(p.ws + OFF_WB);
  const int c0 = 1376, c1 = c0 + 128, c2 = c1 + 128, c3 = c2 + 256, c4 = c3 + 256, c5 = c4 + 512,
            c6 = c5 + 256, c7 = c6 + 1024, c8 = c7 + 1024, c9 = c8 + 16, c10 = c9 + 16, c11 = c10 + 16;
  for (int t = vb_; t < c11; t += vg_) {
    if (t < c0) conv_tile(tid_, p.in[I_W_IN] + (size_t)l * 1024 * 5504, 1024, 5504, WB + W_IN, t, smem);
    else if (t < c1) conv_tile(tid_, p.in[I_W_BR_RWKV] + (size_t)l * 512 * 1024, 512, 1024, WB + W_BRR, t - c0, smem);
    else if (t < c2) conv_tile(tid_, p.in[I_W_BR_NAT] + (size_t)l * 512 * 1024, 512, 1024, WB + W_BRN, t - c1, smem);
    else if (t < c3) conv_tile(tid_, p.in[I_W_OUT] + (size_t)l * 1024 * 1024, 1024, 1024, WB + W_OUT, t - c2, smem);
    else if (t < c4) conv_tile(tid_, p.in[I_W_XQ] + (size_t)l * 1024 * 1024, 1024, 1024, WB + W_XQ, t - c3, smem);
    else if (t < c5) conv_tile(tid_, p.in[I_W_XKV] + (size_t)l * 1024 * 2048, 1024, 2048, WB + W_XKV, t - c4, smem);
    else if (t < c6) conv_tile(tid_, p.in[I_W_XO] + (size_t)l * 1024 * 1024, 1024, 1024, WB + W_XO, t - c5, smem);
    else if (t < c7) conv_tile(tid_, p.in[I_W_FF1] + (size_t)l * 1024 * 4096, 1024, 4096, WB + W_FF1, t - c6, smem);
    else if (t < c8) conv_tile(tid_, p.in[I_W_FF2] + (size_t)l * 4096 * 1024, 4096, 1024, WB + W_FF2, t - c7, smem);
    else if (t < c9) conv_tile(tid_, p.in[I_G_UP] + (size_t)l * 128 * 512, 128, 512, WB + W_GUP, t - c8, smem);
    else if (t < c10) { const int dd = (t - c9) >> 3; conv_tile(tid_, p.in[I_W_UP] + (size_t)(l * 2 + dd) * 64 * 512, 64, 512, WB + W_WUP + (size_t)dd * 512 * 64, (t - c9) & 7, smem); }
    else { const int dd = (t - c10) >> 3; conv_tile(tid_, p.in[I_A_UP] + (size_t)(l * 2 + dd) * 64 * 512, 64, 512, WB + W_AUP + (size_t)dd * 512 * 64, (t - c10) & 7, smem); }
  }
}

DEVI void norm_row_bf16(int tid_, const float* src, const float* g, u16* dst, float* xcopy) {
  const int lane = tid_ & 63;
  float4 v[4];
  float ss = 0.f;
#pragma unroll
  for (int i = 0; i < 4; ++i) {
    v[i] = ((const float4*)src)[lane + i * 64];
    ss += v[i].x * v[i].x + v[i].y * v[i].y + v[i].z * v[i].z + v[i].w * v[i].w;
  }
  ss = wave_sum(ss);
  const float rs = rsqrtf(ss * (1.f / 1024.f) + 1e-6f);
#pragma unroll
  for (int i = 0; i < 4; ++i) {
    float4 gg = ((const float4*)g)[lane + i * 64];
    u32x2 o;
    o.x = pack2(v[i].x * rs * gg.x, v[i].y * rs * gg.y);
    o.y = pack2(v[i].z * rs * gg.z, v[i].w * rs * gg.w);
    ((u32x2*)dst)[lane + i * 64] = o;
    if (xcopy) ((float4*)xcopy)[lane + i * 64] = v[i];
  }
}

DEVI void phase_norm(int tid_, int vb_, int vg_, const Params& p, const float* g, bool from_input, size_t hoff = OFF_H) {
  u16* H = (u16*)(p.ws + hoff);
  const int wid = tid_ >> 6;
  for (int r = vb_ * 4 + wid; r < NTOK; r += vg_ * 4) {
    const float* src;
    if (from_input) src = (r < 32768) ? p.in[I_XP] + (size_t)r * 1024 : p.in[I_XS] + (size_t)(r - 32768) * 1024;
    else src = p.X + (size_t)r * 1024;
    norm_row_bf16(tid_, src, g, H + (size_t)r * 1024, from_input ? p.X + (size_t)r * 1024 : nullptr);
  }
}
DEVI void phase_norm_mem(int tid_, int vb_, int vg_, const Params& p, const float* g) {
  u16* MH = (u16*)(p.ws + OFF_MEMH);
  const int wid = tid_ >> 6;
  for (int r = vb_ * 4 + wid; r < 3072; r += vg_ * 4) {
    const float* src = (r < 2048) ? p.in[I_MP] + (size_t)r * 1024 : p.in[I_MS] + (size_t)(r - 2048) * 1024;
    norm_row_bf16(tid_, src, g, MH + (size_t)r * 1024, nullptr);
  }
}
DEVI void phase_final_norm(int tid_, int vb_, int vg_, const Params& p) {
  const float* g = p.in[I_NORM_FINAL];
  const int wid = tid_ >> 6, lane = tid_ & 63;
  for (int r = vb_ * 4 + wid; r < NTOK; r += vg_ * 4) {
    float* row = p.X + (size_t)r * 1024;
    float4 v[4];
    float ss = 0.f;
#pragma unroll
    for (int i = 0; i < 4; ++i) {
      v[i] = ((const float4*)row)[lane + i * 64];
      ss += v[i].x * v[i].x + v[i].y * v[i].y + v[i].z * v[i].z + v[i].w * v[i].w;
    }
    ss = wave_sum(ss);
    const float rs = rsqrtf(ss * (1.f / 1024.f) + 1e-6f);
#pragma unroll
    for (int i = 0; i < 4; ++i) {
      float4 gg = ((const float4*)g)[lane + i * 64];
      float4 o;
      o.x = v[i].x * rs * gg.x; o.y = v[i].y * rs * gg.y; o.z = v[i].z * rs * gg.z; o.w = v[i].w * rs * gg.w;
      ((float4*)row)[lane + i * 64] = o;
    }
  }
}

template <int OFF>
DEVI bf16x8 lds_rd128(uint32_t addr) {
  bf16x8 r;
  asm volatile("ds_read_b128 %0, %1 offset:%2" : "=v"(r) : "v"(addr), "n"(OFF));
  return r;
}

template <int NW, bool SWAP>
DEVI void gemm_kloop(int tid_, f32x4 (&acc)[4][NW], const u16* __restrict__ A, int lda, const u16* __restrict__ Bt, int ldb,
                     int K, char* smem) {
  constexpr int STG = 8192 + NW * 2048;
  constexpr int NB = NW / 2;
  const int tid = tid_, lane = tid & 63, wid = tid >> 6;
  const int wr = wid >> 1, wc = wid & 1, fr = lane & 15, fq = lane >> 4;
  const int lrow = lane >> 2, lphys = lane & 3, lhi = lane >> 4;
  const int gsw = (4 - lhi) & 3;
  const u16* ga[2];
  const u16* gb[NB];
#pragma unroll
  for (int q = 0; q < 2; ++q) ga[q] = A + (size_t)((wid * 2 + q) * 16 + lrow) * lda + (lphys ^ gsw) * 8;
#pragma unroll
  for (int q = 0; q < NB; ++q) gb[q] = Bt + (size_t)((wid * NB + q) * 16 + lrow) * ldb + (lphys ^ gsw) * 8;
  const int rsw = (4 - ((fr >> 2) & 3)) & 3;
  const int ch = (fq ^ rsw) * 16;
  const int nk = K >> 5;
  const uint32_t lds_base = (uint32_t)(size_t)(__attribute__((address_space(3))) char*)smem;
  const uint32_t aoff = (uint32_t)((wr * 64 + fr) * 64 + ch);
  const uint32_t boff = (uint32_t)(8192 + (wc * 16 * NW + fr) * 64 + ch);
  asm volatile("s_waitcnt vmcnt(0)" ::: "memory");
  __syncthreads();
#define GEMM_ISSUE(kt_)                                                                                              \
  do {                                                                                                               \
    char* nb_ = smem + ((kt_) & 3) * STG;                                                                            \
    _Pragma("unroll") for (int q = 0; q < 2; ++q) __builtin_amdgcn_global_load_lds(                                  \
        (const unsigned*)(ga[q] + (kt_) * 32),                                                                       \
        (__attribute__((address_space(3))) unsigned*)(nb_ + (wid * 2 + q) * 1024 + lane * 16), 16, 0, 0);            \
    _Pragma("unroll") for (int q = 0; q < NB; ++q) __builtin_amdgcn_global_load_lds(                                 \
        (const unsigned*)(gb[q] + (kt_) * 32),                                                                       \
        (__attribute__((address_space(3))) unsigned*)(nb_ + 8192 + (wid * NB + q) * 1024 + lane * 16), 16, 0, 0);    \
  } while (0)
  GEMM_ISSUE(0);
  if (nk > 1) GEMM_ISSUE(1);
  if (nk > 2) GEMM_ISSUE(2);
  for (int kt = 0; kt < nk; ++kt) {
    if (kt + 2 < nk) {
      if (NW == 4) asm volatile("s_waitcnt vmcnt(8)" ::: "memory");
      else asm volatile("s_waitcnt vmcnt(6)" ::: "memory");
    } else if (kt + 1 < nk) {
      if (NW == 4) asm volatile("s_waitcnt vmcnt(4)" ::: "memory");
      else asm volatile("s_waitcnt vmcnt(3)" ::: "memory");
    } else {
      asm volatile("s_waitcnt vmcnt(0)" ::: "memory");
    }
    __builtin_amdgcn_s_barrier();
    asm volatile("" ::: "memory");
    if (kt + 3 < nk) GEMM_ISSUE(kt + 3);
    const uint32_t sb = lds_base + (kt & 3) * STG;
    bf16x8 af[4], bfr[4];
    af[0] = lds_rd128<0>(sb + aoff); af[1] = lds_rd128<1024>(sb + aoff);
    af[2] = lds_rd128<2048>(sb + aoff); af[3] = lds_rd128<3072>(sb + aoff);
    bfr[0] = lds_rd128<0>(sb + boff); bfr[1] = lds_rd128<1024>(sb + boff);
    if (NW == 4) {
      bfr[2] = lds_rd128<2048>(sb + boff); bfr[3] = lds_rd128<3072>(sb + boff);
      asm volatile("s_waitcnt lgkmcnt(0)" : "+v"(af[0]), "+v"(af[1]), "+v"(af[2]), "+v"(af[3]),
                   "+v"(bfr[0]), "+v"(bfr[1]), "+v"(bfr[2]), "+v"(bfr[3]));
    } else {
      asm volatile("s_waitcnt lgkmcnt(0)" : "+v"(af[0]), "+v"(af[1]), "+v"(af[2]), "+v"(af[3]), "+v"(bfr[0]), "+v"(bfr[1]));
    }
#pragma unroll
    for (int m = 0; m < 4; ++m)
#pragma unroll
      for (int n = 0; n < NW; ++n) {
        if (SWAP) acc[m][n] = __builtin_amdgcn_mfma_f32_16x16x32_bf16(bfr[n], af[m], acc[m][n], 0, 0, 0);
        else acc[m][n] = __builtin_amdgcn_mfma_f32_16x16x32_bf16(af[m], bfr[n], acc[m][n], 0, 0, 0);
      }
  }
#undef GEMM_ISSUE
}

DEVI int launder(int x) { asm volatile("" : "+v"(x)); return x; }

template <int NW>
DEVI void zero_acc(f32x4 (&acc)[4][NW]) {
#pragma unroll
  for (int m = 0; m < 4; ++m)
#pragma unroll
    for (int n = 0; n < NW; ++n) acc[m][n] = (f32x4){0.f, 0.f, 0.f, 0.f};
}

struct NoEpi { DEVI void operator()(int, int, f32x4) const {} };

template <class EpiS, class EpiN>
DEVI void gemm_phase(int tid_, const u16* A, int lda, const u16* Bt, int ldb, int K, int M, int N, char* smem, int ns_from,
                     EpiS epiS, EpiN epiN) {
  const int nN = N >> 7, nM = M >> 7;
  const int lane = tid_ & 63, wid = tid_ >> 6;
  const int wr = wid >> 1, wc = wid & 1, fr = lane & 15, fq = lane >> 4;
  const int xcd = blockIdx.x & 7, jloc = blockIdx.x >> 3, nloc = gridDim.x >> 3;
  for (int lt = jloc; lt < (nM >> 3) * nN; lt += nloc) {
    const int tml = lt / nN, tn = lt - tml * nN;
    const int tm = tml * 8 + xcd;
    const int m0 = tm << 7, n0 = tn << 7;
    f32x4 acc[4][4];
    zero_acc(acc);
    if (n0 < ns_from) {
      gemm_kloop<4, true>(tid_, acc, A + (size_t)m0 * lda, lda, Bt + (size_t)n0 * ldb, ldb, K, smem);
#pragma unroll
      for (int m = 0; m < 4; ++m)
#pragma unroll
        for (int n = 0; n < 4; ++n) epiS(m0 + wr * 64 + m * 16 + fr, n0 + wc * 64 + n * 16 + fq * 4, acc[m][n]);
    } else {
      gemm_kloop<4, false>(tid_, acc, A + (size_t)m0 * lda, lda, Bt + (size_t)n0 * ldb, ldb, K, smem);
#pragma unroll
      for (int m = 0; m < 4; ++m)
#pragma unroll
        for (int n = 0; n < 4; ++n) epiN(m0 + wr * 64 + m * 16 + fq * 4, n0 + wc * 64 + n * 16 + fr, acc[m][n]);
    }
  }
}


template <bool SWAP>
DEVI void gemm_kloop_big(int tid_, f32x4 (&acc)[8][4], const u16* __restrict__ A, int lda, const u16* __restrict__ Bt,
                         int ldb, int K, char* smem) {
  constexpr int STG = 16384 + 8192;
  const int tid = tid_, lane = tid & 63, wid = tid >> 6;
  const int wr = wid >> 1, wc = wid & 1, fr = lane & 15, fq = lane >> 4;
  const int lrow = lane >> 2, lphys = lane & 3, lhi = lane >> 4;
  const int gsw = (4 - lhi) & 3;
  const u16* ga = A + (size_t)(wid * 64 + lrow) * lda + (lphys ^ gsw) * 8;
  const u16* gb = Bt + (size_t)(wid * 32 + lrow) * ldb + (lphys ^ gsw) * 8;
  const size_t a16 = (size_t)16 * lda, b16 = (size_t)16 * ldb;
  const int rsw = (4 - ((fr >> 2) & 3)) & 3;
  const int ch = (fq ^ rsw) * 16;
  const int nk = K >> 5;
  const uint32_t lds_base = (uint32_t)(size_t)(__attribute__((address_space(3))) char*)smem;
  const uint32_t aoff = (uint32_t)((wr * 128 + fr) * 64 + ch);
  const uint32_t boff = (uint32_t)(16384 + (wc * 64 + fr) * 64 + ch);
  asm volatile("s_waitcnt vmcnt(0)" ::: "memory");
  __syncthreads();
#define GEMMB_ISSUE(kt_, buf_)                                                                                       \
  do {                                                                                                               \
    char* nb_ = smem + (buf_) * STG;                                                                                 \
    _Pragma("unroll") for (int q = 0; q < 4; ++q) __builtin_amdgcn_global_load_lds(                                  \
        (const unsigned*)(ga + q * a16 + (kt_) * 32),                                                                \
        (__attribute__((address_space(3))) unsigned*)(nb_ + (wid * 4 + q) * 1024 + lane * 16), 16, 0, 0);            \
    _Pragma("unroll") for (int q = 0; q < 2; ++q) __builtin_amdgcn_global_load_lds(                                  \
        (const unsigned*)(gb + q * b16 + (kt_) * 32),                                                                \
        (__attribute__((address_space(3))) unsigned*)(nb_ + 16384 + (wid * 2 + q) * 1024 + lane * 16), 16, 0, 0);   \
  } while (0)
  GEMMB_ISSUE(0, 0);
  if (nk > 1) GEMMB_ISSUE(1, 1);
  int cb = 0;
  for (int kt = 0; kt < nk; ++kt) {
    if (kt + 1 < nk) asm volatile("s_waitcnt vmcnt(6)" ::: "memory");
    else asm volatile("s_waitcnt vmcnt(0)" ::: "memory");
    __builtin_amdgcn_s_barrier();
    asm volatile("" ::: "memory");
    const int nbuf = (cb == 0) ? 2 : cb - 1;
    if (kt + 2 < nk) GEMMB_ISSUE(kt + 2, nbuf);
    const uint32_t sb = lds_base + cb * STG;
    bf16x8 a0[4], a1[4], bb[4];
    a0[0] = lds_rd128<0>(sb + aoff); a0[1] = lds_rd128<1024>(sb + aoff);
    a0[2] = lds_rd128<2048>(sb + aoff); a0[3] = lds_rd128<3072>(sb + aoff);
    bb[0] = lds_rd128<0>(sb + boff); bb[1] = lds_rd128<1024>(sb + boff);
    bb[2] = lds_rd128<2048>(sb + boff); bb[3] = lds_rd128<3072>(sb + boff);
    a1[0] = lds_rd128<4096>(sb + aoff); a1[1] = lds_rd128<5120>(sb + aoff);
    a1[2] = lds_rd128<6144>(sb + aoff); a1[3] = lds_rd128<7168>(sb + aoff);
    asm volatile("s_waitcnt lgkmcnt(4)" : "+v"(a0[0]), "+v"(a0[1]), "+v"(a0[2]), "+v"(a0[3]),
                 "+v"(bb[0]), "+v"(bb[1]), "+v"(bb[2]), "+v"(bb[3]));
#pragma unroll
    for (int m = 0; m < 4; ++m)
#pragma unroll
      for (int n = 0; n < 4; ++n) {
        if (SWAP) acc[m][n] = __builtin_amdgcn_mfma_f32_16x16x32_bf16(bb[n], a0[m], acc[m][n], 0, 0, 0);
        else acc[m][n] = __builtin_amdgcn_mfma_f32_16x16x32_bf16(a0[m], bb[n], acc[m][n], 0, 0, 0);
      }
    asm volatile("s_waitcnt lgkmcnt(0)" : "+v"(a1[0]), "+v"(a1[1]), "+v"(a1[2]), "+v"(a1[3]));
#pragma unroll
    for (int m = 0; m < 4; ++m)
#pragma unroll
      for (int n = 0; n < 4; ++n) {
        if (SWAP) acc[4 + m][n] = __builtin_amdgcn_mfma_f32_16x16x32_bf16(bb[n], a1[m], acc[4 + m][n], 0, 0, 0);
        else acc[4 + m][n] = __builtin_amdgcn_mfma_f32_16x16x32_bf16(a1[m], bb[n], acc[4 + m][n], 0, 0, 0);
      }
    cb = (cb == 2) ? 0 : cb + 1;
  }
#undef GEMMB_ISSUE
}

template <class EpiS, class EpiN>
DEVI void gemm_phase_big(int tid_, const u16* A, int lda, const u16* Bt, int ldb, int K, int M, int N, char* smem,
                         int ns_from, EpiS epiS, EpiN epiN) {
  const int nN = N >> 7, nM = M >> 8;
  const int lane = tid_ & 63, wid = tid_ >> 6;
  const int wr = wid >> 1, wc = wid & 1, fr = lane & 15, fq = lane >> 4;
  const int xcd = blockIdx.x & 7, jloc = blockIdx.x >> 3, nloc = gridDim.x >> 3;
  for (int lt = jloc; lt < (nM >> 3) * nN; lt += nloc) {
    const int tml = lt / nN, tn = lt - tml * nN;
    const int tm = tml * 8 + xcd;
    const int m0 = tm << 8, n0 = tn << 7;
    f32x4 acc[8][4];
#pragma unroll
    for (int m = 0; m < 8; ++m)
#pragma unroll
      for (int n = 0; n < 4; ++n) acc[m][n] = (f32x4){0.f, 0.f, 0.f, 0.f};
    if (n0 < ns_from) {
      gemm_kloop_big<true>(launder(tid_), acc, A + (size_t)m0 * lda, lda, Bt + (size_t)n0 * ldb, ldb, K, smem);
#pragma unroll
      for (int m = 0; m < 8; ++m)
#pragma unroll
        for (int n = 0; n < 4; ++n) epiS(m0 + wr * 128 + m * 16 + fr, n0 + wc * 64 + n * 16 + fq * 4, acc[m][n]);
    } else {
      gemm_kloop_big<false>(launder(tid_), acc, A + (size_t)m0 * lda, lda, Bt + (size_t)n0 * ldb, ldb, K, smem);
#pragma unroll
      for (int m = 0; m < 8; ++m)
#pragma unroll
        for (int n = 0; n < 4; ++n) epiN(m0 + wr * 128 + m * 16 + fq * 4, n0 + wc * 64 + n * 16 + fr, acc[m][n]);
    }
  }
}


template <bool SWAP>
DEVI void gemm_kloop8(int tid_, f32x4 (&acc)[8][4], const u16* __restrict__ A, int lda, const u16* __restrict__ Bt,
                      int ldb, int K, char* smem) {
  constexpr int STG = 65536;
  const int tid = tid_, lane = tid & 63, wid = tid >> 6;
  const int wr = wid >> 2, wc = wid & 3, fr = lane & 15, fq = lane >> 4;
  const int lrow = lane >> 3, lphys = lane & 7, lhi = lane >> 4;
  const u16* ga[4];
  const u16* gb[4];
#pragma unroll
  for (int q = 0; q < 4; ++q) {
    const int kc = lphys ^ ((4 * (q & 1) + lhi) & 7);
    ga[q] = A + (size_t)((wid * 4 + q) * 8 + lrow) * lda + kc * 8;
    gb[q] = Bt + (size_t)((wid * 4 + q) * 8 + lrow) * ldb + kc * 8;
  }
  const int swz = (fr >> 1) & 7;
  const int nk = K >> 6;
  const uint32_t lds_base = (uint32_t)(size_t)(__attribute__((address_space(3))) char*)smem;
  const uint32_t arow = (uint32_t)((wr * 128 + fr) * 128);
  const uint32_t brow = (uint32_t)(32768 + (wc * 64 + fr) * 128);
  asm volatile("s_waitcnt vmcnt(0)" ::: "memory");
  __syncthreads();
#define GEMM8_ISSUE(kt_)                                                                                             \
  do {                                                                                                               \
    char* nb_ = smem + ((kt_) & 1) * STG;                                                                            \
    _Pragma("unroll") for (int q = 0; q < 4; ++q) __builtin_amdgcn_global_load_lds(                                  \
        (const unsigned*)(ga[q] + (kt_) * 64),                                                                       \
        (__attribute__((address_space(3))) unsigned*)(nb_ + (wid * 4 + q) * 1024 + lane * 16), 16, 0, 0);            \
    _Pragma("unroll") for (int q = 0; q < 4; ++q) __builtin_amdgcn_global_load_lds(                                  \
        (const unsigned*)(gb[q] + (kt_) * 64),                                                                       \
        (__attribute__((address_space(3))) unsigned*)(nb_ + 32768 + (wid * 4 + q) * 1024 + lane * 16), 16, 0, 0);    \
  } while (0)
  GEMM8_ISSUE(0);
  for (int kt = 0; kt < nk; ++kt) {
    asm volatile("s_waitcnt vmcnt(0)" ::: "memory");
    __builtin_amdgcn_s_barrier();
    asm volatile("" ::: "memory");
    if (kt + 1 < nk) GEMM8_ISSUE(kt + 1);
    const uint32_t sb = lds_base + (kt & 1) * STG;
#pragma unroll
    for (int ks = 0; ks < 2; ++ks) {
      const uint32_t chb = (uint32_t)(((ks * 4 + fq) ^ swz) * 16);
      const uint32_t aoff = sb + arow + chb, boff = sb + brow + chb;
      bf16x8 a0[4], a1[4], bb[4];
      a0[0] = lds_rd128<0>(aoff); a0[1] = lds_rd128<2048>(aoff);
      a0[2] = lds_rd128<4096>(aoff); a0[3] = lds_rd128<6144>(aoff);
      bb[0] = lds_rd128<0>(boff); bb[1] = lds_rd128<2048>(boff);
      bb[2] = lds_rd128<4096>(boff); bb[3] = lds_rd128<6144>(boff);
      a1[0] = lds_rd128<8192>(aoff); a1[1] = lds_rd128<10240>(aoff);
      a1[2] = lds_rd128<12288>(aoff); a1[3] = lds_rd128<14336>(aoff);
      asm volatile("s_waitcnt lgkmcnt(4)" : "+v"(a0[0]), "+v"(a0[1]), "+v"(a0[2]), "+v"(a0[3]),
                   "+v"(bb[0]), "+v"(bb[1]), "+v"(bb[2]), "+v"(bb[3]));
#pragma unroll
      for (int m = 0; m < 4; ++m)
#pragma unroll
        for (int n = 0; n < 4; ++n) {
          if (SWAP) acc[m][n] = __builtin_amdgcn_mfma_f32_16x16x32_bf16(bb[n], a0[m], acc[m][n], 0, 0, 0);
          else acc[m][n] = __builtin_amdgcn_mfma_f32_16x16x32_bf16(a0[m], bb[n], acc[m][n], 0, 0, 0);
        }
      asm volatile("s_waitcnt lgkmcnt(0)" : "+v"(a1[0]), "+v"(a1[1]), "+v"(a1[2]), "+v"(a1[3]));
#pragma unroll
      for (int m = 0; m < 4; ++m)
#pragma unroll
        for (int n = 0; n < 4; ++n) {
          if (SWAP) acc[4 + m][n] = __builtin_amdgcn_mfma_f32_16x16x32_bf16(bb[n], a1[m], acc[4 + m][n], 0, 0, 0);
          else acc[4 + m][n] = __builtin_amdgcn_mfma_f32_16x16x32_bf16(a1[m], bb[n], acc[4 + m][n], 0, 0, 0);
        }
    }
  }
#undef GEMM8_ISSUE
}

template <class EpiS, class EpiN>
DEVI void gemm_phase8(int tid_, const u16* A, int lda, const u16* Bt, int ldb, int K, int M, int N, char* smem,
                      int ns_from, EpiS epiS, EpiN epiN) {
  const int nN = (N + 255) >> 8, nM = M >> 8;
  const int lane = tid_ & 63, wid = tid_ >> 6;
  const int wr = wid >> 2, wc = wid & 3, fr = lane & 15, fq = lane >> 4;
  const bool xmap = ((gridDim.x & 7) == 0) && ((nM & 7) == 0);
  const int xcd = blockIdx.x & 7;
  const int first = xmap ? (int)(blockIdx.x >> 3) : (int)blockIdx.x;
  const int stride = xmap ? (int)(gridDim.x >> 3) : (int)gridDim.x;
  const int count = xmap ? (nM >> 3) * nN : nM * nN;
  for (int it = first; it < count; it += stride) {
    const int tq = it / nN, tn = it - tq * nN;
    const int tm = xmap ? tq * 8 + xcd : tq;
    const int m0 = tm << 8, n0 = tn << 8;
    const int colb = n0 + wc * 64;
    f32x4 acc[8][4];
#pragma unroll
    for (int m = 0; m < 8; ++m)
#pragma unroll
      for (int n = 0; n < 4; ++n) acc[m][n] = (f32x4){0.f, 0.f, 0.f, 0.f};
    if (colb < ns_from) {
      gemm_kloop8<true>(launder(tid_), acc, A + (size_t)m0 * lda, lda, Bt + (size_t)n0 * ldb, ldb, K, smem);
      if (colb < N) {
#pragma unroll
        for (int m = 0; m < 8; ++m)
#pragma unroll
          for (int n = 0; n < 4; ++n) epiS(m0 + wr * 128 + m * 16 + fr, colb + n * 16 + fq * 4, acc[m][n]);
      }
    } else {
      gemm_kloop8<false>(launder(tid_), acc, A + (size_t)m0 * lda, lda, Bt + (size_t)n0 * ldb, ldb, K, smem);
      if (colb < N) {
#pragma unroll
        for (int m = 0; m < 8; ++m)
#pragma unroll
          for (int n = 0; n < 4; ++n) epiN(m0 + wr * 128 + m * 16 + fq * 4, colb + n * 16 + fr, acc[m][n]);
      }
    }
  }
}

DEVI void store4bf(u16* dst, f32x4 v) {
  u32x2 o;
  o.x = pack2(v[0], v[1]); o.y = pack2(v[2], v[3]);
  *(u32x2*)dst = o;
}

DEVI void phase_p_gemm(int tid_, const Params& p, char* smem) {
  u16* WB = (u16*)(p.ws + OFF_WB);
  const u16* H = (const u16*)(p.ws + OFF_H);
  u16* PR = (u16*)(p.ws + OFF_PR);
  u16* NQ = (u16*)(p.ws + OFF_NQ);
  u16* NK = (u16*)(p.ws + OFF_NK);
  u16* NVT = (u16*)(p.ws + OFF_NV);
  gemm_phase8(tid_, H, 1024, WB + W_IN, 1024, 1024, NTOK, 3456, smem, 2944,
    [&](int r, int c0, f32x4 v) {
      if (c0 < 1920) store4bf(PR + (size_t)r * PRW + c0, v);
      else if (c0 < 2432) store4bf(NQ + (size_t)r * 512 + (c0 - 1920), v);
      else store4bf(NK + (size_t)r * 512 + (c0 - 2432), v);
    },
    [&](int r0, int c, f32x4 v) {
      const int cc = c - 2944;
      const int s = r0 >> 12, t = r0 & 4095;
      store4bf(NVT + ((size_t)(s * 512 + cc)) * 4096 + t, v);
    });
  const u16* MH = (const u16*)(p.ws + OFF_MEMH);
  u16* KVK = (u16*)(p.ws + OFF_KVK);
  u16* KVT = (u16*)(p.ws + OFF_KVT);
  gemm_phase8(tid_, MH, 1024, WB + W_XKV, 1024, 1024, 3072, 2048, smem, 1024,
    [&](int r, int c0, f32x4 v) { store4bf(KVK + (size_t)r * 1024 + c0, v); },
    [&](int r0, int c, f32x4 v) {
      const int cc = c - 1024;
      const int s = r0 >> 8, m = r0 & 255;
      store4bf(KVT + ((size_t)(s * 1024 + cc)) * 256 + m, v);
    });
}

DEVI void phase_nat(int tid_, const Params& p, int l, char* smem, int bfirst, int bstride) {
  u16* NQ = (u16*)(p.ws + OFF_NQ);
  const u16* NK = (const u16*)(p.ws + OFF_NK);
  const u16* NVT = (const u16*)(p.ws + OFF_NV);
  const float* rpb = p.in[I_RPB] + (size_t)l * 8 * 15 * 31;
  const int lane = tid_ & 63, g = tid_ >> 6, fr = lane & 15, fq = lane >> 4;
  u16* Pw = (u16*)smem + g * (16 * 264);
  const int cb = (g == 0) ? 0 : (g == 1) ? 8 : (g == 2) ? 24 : 32;
  const int c = g * 16 + fr;
  int cs = c - 8; cs = cs < 0 ? 0 : (cs > 48 ? 48 : cs);
  for (int t = bfirst; t < 12 * 64 * 8; t += bstride) {
    const int h = t & 7, ri = (t >> 3) & 63, s = t >> 9;
    int rs = ri - 4; rs = rs < 0 ? 0 : (rs > 56 ? 56 : rs);
    const size_t tokq = (size_t)s * 4096 + ri * 64 + g * 16;
    bf16x8 aq[2];
    aq[0] = *(const bf16x8*)(NQ + (tokq + fr) * 512 + h * 64 + fq * 8);
    aq[1] = *(const bf16x8*)(NQ + (tokq + fr) * 512 + h * 64 + 32 + fq * 8);
    f32x4 acc[16];
#pragma unroll
    for (int n = 0; n < 16; ++n) {
      acc[n] = (f32x4){0.f, 0.f, 0.f, 0.f};
      const int r = n >> 1, col = cb + (n & 1) * 16 + fr;
      const u16* kp = NK + ((size_t)s * 4096 + (rs + r) * 64 + col) * 512 + h * 64 + fq * 8;
      const bf16x8 b0 = *(const bf16x8*)kp;
      const bf16x8 b1 = *(const bf16x8*)(kp + 32);
      acc[n] = __builtin_amdgcn_mfma_f32_16x16x32_bf16(b0, aq[0], acc[n], 0, 0, 0);
      acc[n] = __builtin_amdgcn_mfma_f32_16x16x32_bf16(b1, aq[1], acc[n], 0, 0, 0);
    }
    float m = -1e30f;
#pragma unroll
    for (int n = 0; n < 16; ++n) {
      const int di = rs + (n >> 1) - ri + 7;
      const float* brow = rpb + (h * 15 + di) * 31 + 15 - c;
#pragma unroll
      for (int j = 0; j < 4; ++j) {
        const int kc = cb + (n & 1) * 16 + fq * 4 + j;
        float sc = -1e30f;
        if (kc >= cs && kc < cs + 16) sc = acc[n][j] * 0.125f + brow[kc];
        acc[n][j] = sc;
        m = fmaxf(m, sc);
      }
    }
    m = red4x_max(m);
    float ssum = 0.f;
#pragma unroll
    for (int n = 0; n < 16; ++n) {
      f32x4 e;
#pragma unroll
      for (int j = 0; j < 4; ++j) { e[j] = __expf(acc[n][j] - m); ssum += e[j]; }
      store4bf(Pw + fr * 264 + n * 16 + fq * 4, e);
    }
    const float sm = 1.f / red4x_sum(ssum);
    f32x4 o[4];
#pragma unroll
    for (int n = 0; n < 4; ++n) o[n] = (f32x4){0.f, 0.f, 0.f, 0.f};
#pragma unroll
    for (int ks = 0; ks < 8; ++ks) {
      const bf16x8 ap = *(const bf16x8*)(Pw + fr * 264 + ks * 32 + fq * 8);
#pragma unroll
      for (int n = 0; n < 4; ++n) {
        const bf16x8 bv = *(const bf16x8*)(NVT + ((size_t)(s * 512 + h * 64 + n * 16 + fr)) * 4096 + (rs + ks) * 64 + cb + fq * 8);
        o[n] = __builtin_amdgcn_mfma_f32_16x16x32_bf16(bv, ap, o[n], 0, 0, 0);
      }
    }
#pragma unroll
    for (int n = 0; n < 4; ++n) store4bf(NQ + (tokq + fr) * 512 + h * 64 + n * 16 + fq * 4, o[n] * sm);
  }
}

constexpr int SC_OPS = 0;
constexpr int SC_VV = 40960;
constexpr int SC_WR = 49152;
constexpr int SC_AP = 57344;
constexpr int SC_TW = 65536;
constexpr int SC_AD = 70144;
constexpr int SC_NRM = 74752;
constexpr int SC_MU = 74880;
constexpr int SC_CST = 77440;

typedef __attribute__((ext_vector_type(2))) float f32x2;

template <int CTRL>
DEVI float dpp_mov(float x) {
  return __int_as_float(__builtin_amdgcn_update_dpp(0, __float_as_int(x), CTRL, 0xF, 0xF, true));
}
DEVI float red8(float x) {
  x += dpp_mov<0xB1>(x);
  x += dpp_mov<0x4E>(x);
  x += dpp_mov<0x141>(x);
  return x;
}
DEVI f32x2 lo2(f32x4 v) { return __builtin_shufflevector(v, v, 0, 1); }
DEVI f32x2 hi2(f32x4 v) { return __builtin_shufflevector(v, v, 2, 3); }

struct ScanOps {
  f32x2 a[4], w[4], b[4], k[4], r[4];
  float v0, v1;
};
DEVI void scan_load(ScanOps& o, const float* OPS, const float* VV, int nn, int jg, int i0) {
  const float* base = OPS + nn * 64 + jg * 8;
  f32x4 t0, t1;
  t0 = *(const f32x4*)(base); t1 = *(const f32x4*)(base + 4);
  o.a[0] = lo2(t0); o.a[1] = hi2(t0); o.a[2] = lo2(t1); o.a[3] = hi2(t1);
  t0 = *(const f32x4*)(base + 2048); t1 = *(const f32x4*)(base + 2048 + 4);
  o.w[0] = lo2(t0); o.w[1] = hi2(t0); o.w[2] = lo2(t1); o.w[3] = hi2(t1);
  t0 = *(const f32x4*)(base + 4096); t1 = *(const f32x4*)(base + 4096 + 4);
  o.b[0] = lo2(t0); o.b[1] = hi2(t0); o.b[2] = lo2(t1); o.b[3] = hi2(t1);
  t0 = *(const f32x4*)(base + 6144); t1 = *(const f32x4*)(base + 6144 + 4);
  o.k[0] = lo2(t0); o.k[1] = hi2(t0); o.k[2] = lo2(t1); o.k[3] = hi2(t1);
  t0 = *(const f32x4*)(base + 8192); t1 = *(const f32x4*)(base + 8192 + 4);
  o.r[0] = lo2(t0); o.r[1] = hi2(t0); o.r[2] = lo2(t1); o.r[3] = hi2(t1);
  o.v0 = VV[nn * 64 + i0];
  o.v1 = VV[nn * 64 + i0 + 8];
}
DEVI void scan_step(const ScanOps& o, f32x2 (&S0)[4], f32x2 (&S1)[4], float* YL, int nn, int jg, int i0) {
  f32x2 d0 = S0[0] * o.a[0], d0b = S0[2] * o.a[2];
  f32x2 d1 = S1[0] * o.a[0], d1b = S1[2] * o.a[2];
  d0 = S0[1] * o.a[1] + d0; d0b = S0[3] * o.a[3] + d0b;
  d1 = S1[1] * o.a[1] + d1; d1b = S1[3] * o.a[3] + d1b;
  d0 += d0b; d1 += d1b;
  const float sa0 = red8(d0.x + d0.y);
  const float sa1 = red8(d1.x + d1.y);
  f32x2 e0 = {0.f, 0.f}, e1 = {0.f, 0.f};
#pragma unroll
  for (int q = 0; q < 4; ++q) {
    const f32x2 u0 = sa0 * o.b[q] + o.v0 * o.k[q];
    const f32x2 u1 = sa1 * o.b[q] + o.v1 * o.k[q];
    S0[q] = S0[q] * o.w[q] + u0;
    S1[q] = S1[q] * o.w[q] + u1;
    e0 = S0[q] * o.r[q] + e0;
    e1 = S1[q] * o.r[q] + e1;
  }
  const float y0 = red8(e0.x + e0.y);
  const float y1 = red8(e1.x + e1.y);
  YL[nn * 64 + i0] = y0; YL[nn * 64 + i0 + 8] = y1;
}

DEVI void phase_scan(int tid_, const Params& p, int l, char* smem, int bfirst, int bstride) {
  const u16* PR = (const u16*)(p.ws + OFF_PR);
  _Float16* YF = (_Float16*)(p.ws + OFF_H);
  _Float16* YB = (_Float16*)(p.ws + OFF_H + (size_t)NTOK * 512 * 2);
  float* BON = (float*)(p.ws + OFF_BONUS);
  const u16* WB = (const u16*)(p.ws + OFF_WB);
  float* OPS = (float*)(smem + SC_OPS);
  u16* RAW = (u16*)(smem + SC_OPS);
  float* VV = (float*)(smem + SC_VV);
  float* WR = (float*)(smem + SC_WR);
  float* AP = (float*)(smem + SC_AP);
  float* YL = WR;
  u16* TWb = (u16*)(smem + SC_TW);
  u16* ADb = (u16*)(smem + SC_AD);
  float* NRM = (float*)(smem + SC_NRM);
  float* MU = (float*)(smem + SC_MU);
  float* CST = (float*)(smem + SC_CST);
  const float* mu_p = p.in[I_MU_PREV] + (size_t)l * 1920;
  const float* mu_n = p.in[I_MU_NEXT] + (size_t)l * 1920;
  const int tid = tid_, lane = tid & 63, w = tid >> 6, fr = lane & 15, fq = lane >> 4;
  const int pn = tid >> 3, j0 = (tid & 7) * 8;
  const int jg = lane & 7, i0 = w * 16 + (lane >> 3);
  const int hr = (tid >= 40) ? 1 : 0, hc = tid - hr * 40;
  for (int blk = bfirst; blk < 192; blk += bstride) {
    const int s = blk >> 4, h = (blk >> 1) & 7, d = blk & 1;
    __syncthreads();
    for (int i = tid; i < 640; i += 256) {
      const int which = (i >= 320) ? 1 : 0, c = i - which * 320;
      const int g = c >> 6, e = c & 63;
      const int col = (g < 3) ? (g * 512 + h * 64 + e) : (1536 + (g - 3) * 128 + d * 64 + e);
      MU[i] = which ? mu_n[col] : mu_p[col];
    }
    for (int i = tid; i < 320; i += 256) {
      const int which = i >> 6, e = i & 63;
      float v;
      if (which == 0) v = p.in[I_W0][(size_t)(l * 2 + d) * 512 + h * 64 + e];
      else if (which == 1) v = p.in[I_A0][(size_t)(l * 2 + d) * 512 + h * 64 + e];
      else if (which == 2) v = p.in[I_K_K][(size_t)l * 512 + h * 64 + e];
      else if (which == 3) v = p.in[I_K_A][(size_t)l * 512 + h * 64 + e];
      else v = p.in[I_R_K][(size_t)(l * 8 + h) * 64 + e];
      CST[i] = v;
    }
    bf16x8 bw[2], ba[2];
#pragma unroll
    for (int ks = 0; ks < 2; ++ks) {
      bw[ks] = *(const bf16x8*)(WB + W_WUP + (size_t)(d * 512 + h * 64 + w * 16 + fr) * 64 + ks * 32 + fq * 8);
      ba[ks] = *(const bf16x8*)(WB + W_AUP + (size_t)(d * 512 + h * 64 + w * 16 + fr) * 64 + ks * 32 + fq * 8);
    }
    _Float16* Y = d ? YB : YF;
    f32x2 S0[4], S1[4];
#pragma unroll
    for (int q = 0; q < 4; ++q) { S0[q] = (f32x2){0.f, 0.f}; S1[q] = (f32x2){0.f, 0.f}; }
    u32x4 G[5], GH;
    {
      const int t = d ? (4095 - pn) : pn;
      const size_t tok = (size_t)s * 4096 + t;
#pragma unroll
      for (int g = 0; g < 5; ++g) {
        const int col = (g < 3) ? (g * 512 + h * 64) : (1536 + (g - 3) * 128 + d * 64);
        G[g] = *(const u32x4*)(PR + tok * PRW + col + j0);
      }
      GH = (u32x4){0u, 0u, 0u, 0u};
      if (tid < 80) {
        const int tlo = d ? (4095 - 31) : 0;
        const int th = hr ? (tlo + 32) : (tlo - 1);
        const int g = hc >> 3;
        const int col = (g < 3) ? (g * 512 + h * 64) : (1536 + (g - 3) * 128 + d * 64);
        if (th >= 0 && th <= 4095) GH = *(const u32x4*)(PR + ((size_t)s * 4096 + th) * PRW + col + (hc & 7) * 8);
      }
    }
#pragma unroll 1
    for (int ch = 0; ch < 128; ++ch) {
      const int n = ch * 32 + pn;
      const int t = d ? (4095 - n) : n;
      const size_t tok = (size_t)s * 4096 + t;
      const int tlo = d ? (4095 - (ch * 32 + 31)) : (ch * 32);
      const int rrow = t - tlo + 1;
#pragma unroll
      for (int g = 0; g < 5; ++g) *(u32x4*)(RAW + rrow * 320 + g * 64 + j0) = G[g];
      if (tid < 80) *(u32x4*)(RAW + (hr ? 33 : 0) * 320 + (hc >> 3) * 64 + (hc & 7) * 8) = GH;
      __syncthreads();
      if (ch + 1 < 128) {
        const int n2 = n + 32;
        const int t2 = d ? (4095 - n2) : n2;
        const size_t tok2 = (size_t)s * 4096 + t2;
#pragma unroll
        for (int g = 0; g < 5; ++g) {
          const int col = (g < 3) ? (g * 512 + h * 64) : (1536 + (g - 3) * 128 + d * 64);
          G[g] = *(const u32x4*)(PR + tok2 * PRW + col + j0);
        }
        GH = (u32x4){0u, 0u, 0u, 0u};
        if (tid < 80) {
          const int tlo2 = d ? (tlo - 32) : (tlo + 32);
          const int th = hr ? (tlo2 + 32) : (tlo2 - 1);
          const int g = hc >> 3;
          const int col = (g < 3) ? (g * 512 + h * 64) : (1536 + (g - 3) * 128 + d * 64);
          if (th >= 0 && th <= 4095) GH = *(const u32x4*)(PR + ((size_t)s * 4096 + th) * PRW + col + (hc & 7) * 8);
        }
      }
#pragma unroll
      for (int g = 0; g < 5; ++g) {
        float cur[8], prv[8], nxt[8];
        load8bf(RAW + rrow * 320 + g * 64 + j0, cur);
        load8bf(RAW + (rrow - 1) * 320 + g * 64 + j0, prv);
        load8bf(RAW + (rrow + 1) * 320 + g * 64 + j0, nxt);
        const f32x4 mp0 = *(const f32x4*)(MU + g * 64 + j0), mp1 = *(const f32x4*)(MU + g * 64 + j0 + 4);
        const f32x4 mn0 = *(const f32x4*)(MU + 320 + g * 64 + j0), mn1 = *(const f32x4*)(MU + 320 + g * 64 + j0 + 4);
        f32x4 x0, x1;
#pragma unroll
        for (int e = 0; e < 4; ++e) {
          x0[e] = cur[e] + mp0[e] * (prv[e] - cur[e]) + mn0[e] * (nxt[e] - cur[e]);
          x1[e] = cur[4 + e] + mp1[e] * (prv[4 + e] - cur[4 + e]) + mn1[e] * (nxt[4 + e] - cur[4 + e]);
        }
        if (g == 0) {
          *(f32x4*)(OPS + 4 * 2048 + pn * 64 + j0) = x0; *(f32x4*)(OPS + 4 * 2048 + pn * 64 + j0 + 4) = x1;
        } else if (g == 1) {
          *(f32x4*)(OPS + 3 * 2048 + pn * 64 + j0) = x0; *(f32x4*)(OPS + 3 * 2048 + pn * 64 + j0 + 4) = x1;
          const f32x4 kk0 = *(const f32x4*)(CST + 128 + j0), kk1 = *(const f32x4*)(CST + 128 + j0 + 4);
          float ss = 0.f;
#pragma unroll
          for (int e = 0; e < 4; ++e) { const float a_ = x0[e] * kk0[e], b_ = x1[e] * kk1[e]; ss += a_ * a_ + b_ * b_; }
          ss = red8(ss);
          if ((tid & 7) == 0) NRM[pn] = frcp(fmaxf(__builtin_amdgcn_sqrtf(ss), 1e-12f));
        } else if (g == 2) {
          *(f32x4*)(VV + pn * 64 + j0) = x0; *(f32x4*)(VV + pn * 64 + j0 + 4) = x1;
        } else if (g == 3) {
          u32x4 pk;
          pk.x = pack2(ftanh(x0[0]), ftanh(x0[1])); pk.y = pack2(ftanh(x0[2]), ftanh(x0[3]));
          pk.z = pack2(ftanh(x1[0]), ftanh(x1[1])); pk.w = pack2(ftanh(x1[2]), ftanh(x1[3]));
          *(u32x4*)(TWb + pn * 72 + j0) = pk;
        } else {
          u32x4 pk;
          pk.x = pack2(x0[0], x0[1]); pk.y = pack2(x0[2], x0[3]);
          pk.z = pack2(x1[0], x1[1]); pk.w = pack2(x1[2], x1[3]);
          *(u32x4*)(ADb + pn * 72 + j0) = pk;
        }
      }
      __syncthreads();
#pragma unroll
      for (int m = 0; m < 2; ++m) {
        f32x4 cw = {0.f, 0.f, 0.f, 0.f}, ca = {0.f, 0.f, 0.f, 0.f};
#pragma unroll
        for (int ks = 0; ks < 2; ++ks) {
          const bf16x8 aw = *(const bf16x8*)(TWb + (m * 16 + fr) * 72 + ks * 32 + fq * 8);
          const bf16x8 aa = *(const bf16x8*)(ADb + (m * 16 + fr) * 72 + ks * 32 + fq * 8);
          cw = __builtin_amdgcn_mfma_f32_16x16x32_bf16(aw, bw[ks], cw, 0, 0, 0);
          ca = __builtin_amdgcn_mfma_f32_16x16x32_bf16(aa, ba[ks], ca, 0, 0, 0);
        }
#pragma unroll
        for (int jj = 0; jj < 4; ++jj) {
          WR[(m * 16 + fq * 4 + jj) * 64 + w * 16 + fr] = cw[jj];
          AP[(m * 16 + fq * 4 + jj) * 64 + w * 16 + fr] = ca[jj];
        }
      }
      __syncthreads();
      {
        const float inv = NRM[pn];
        float bsum = 0.f;
#pragma unroll
        for (int hq = 0; hq < 2; ++hq) {
          const int jb = j0 + hq * 4;
          const f32x4 wr_ = *(const f32x4*)(WR + pn * 64 + jb) + *(const f32x4*)(CST + jb);
          const f32x4 ap_ = *(const f32x4*)(AP + pn * 64 + jb) + *(const f32x4*)(CST + 64 + jb);
          const f32x4 kr = *(const f32x4*)(OPS + 3 * 2048 + pn * 64 + jb);
          const f32x4 rr = *(const f32x4*)(OPS + 4 * 2048 + pn * 64 + jb);
          const f32x4 kkw = *(const f32x4*)(CST + 128 + jb), kaw = *(const f32x4*)(CST + 192 + jb), rkw = *(const f32x4*)(CST + 256 + jb);
          f32x4 o0, o1, o2, o3;
#pragma unroll
          for (int e = 0; e < 4; ++e) {
            const float sw = sigm(wr_[e]);
            const float dec = __expf(-0.6065306597126334f * sw);
            const float av = sigm(ap_[e]);
            const float kn = kr[e] * kkw[e] * inv;
            const float kd = kr[e] * (1.f + (av - 1.f) * kaw[e]);
            bsum += rr[e] * kd * rkw[e];
            o0[e] = -kn; o1[e] = dec; o2[e] = kn * av; o3[e] = kd;
          }
          *(f32x4*)(OPS + 0 * 2048 + pn * 64 + jb) = o0;
          *(f32x4*)(OPS + 1 * 2048 + pn * 64 + jb) = o1;
          *(f32x4*)(OPS + 2 * 2048 + pn * 64 + jb) = o2;
          *(f32x4*)(OPS + 3 * 2048 + pn * 64 + jb) = o3;
        }
        bsum = red8(bsum);
        if ((tid & 7) == 0) BON[(tok * 8 + h) * 2 + d] = bsum;
      }
      __syncthreads();
      {
        ScanOps oa, ob;
        scan_load(oa, OPS, VV, 0, jg, i0);
#pragma unroll 1
        for (int nn = 0; nn < 32; nn += 2) {
          scan_load(ob, OPS, VV, nn + 1, jg, i0);
          scan_step(oa, S0, S1, YL, nn, jg, i0);
          scan_load(oa, OPS, VV, (nn + 2) & 31, jg, i0);
          scan_step(ob, S0, S1, YL, nn + 1, jg, i0);
        }
      }
      __syncthreads();
      {
        h16x8 o;
#pragma unroll
        for (int e = 0; e < 8; ++e) o[e] = (_Float16)YL[pn * 64 + j0 + e];
        *(h16x8*)(Y + tok * 512 + h * 64 + j0) = o;
      }
    }
    __syncthreads();
  }
}

struct ScanOps1 {
  f32x2 a[4], w[4], b[4], k[4], r[4];
  float v0;
};
DEVI void scan_load1(ScanOps1& o, const float* OPS, const float* VV, int nn, int jg, int i0) {
  const float* base = OPS + nn * 64 + jg * 8;
  f32x4 t0, t1;
  t0 = *(const f32x4*)(base); t1 = *(const f32x4*)(base + 4);
  o.a[0] = lo2(t0); o.a[1] = hi2(t0); o.a[2] = lo2(t1); o.a[3] = hi2(t1);
  t0 = *(const f32x4*)(base + 2048); t1 = *(const f32x4*)(base + 2048 + 4);
  o.w[0] = lo2(t0); o.w[1] = hi2(t0); o.w[2] = lo2(t1); o.w[3] = hi2(t1);
  t0 = *(const f32x4*)(base + 4096); t1 = *(const f32x4*)(base + 4096 + 4);
  o.b[0] = lo2(t0); o.b[1] = hi2(t0); o.b[2] = lo2(t1); o.b[3] = hi2(t1);
  t0 = *(const f32x4*)(base + 6144); t1 = *(const f32x4*)(base + 6144 + 4);
  o.k[0] = lo2(t0); o.k[1] = hi2(t0); o.k[2] = lo2(t1); o.k[3] = hi2(t1);
  t0 = *(const f32x4*)(base + 8192); t1 = *(const f32x4*)(base + 8192 + 4);
  o.r[0] = lo2(t0); o.r[1] = hi2(t0); o.r[2] = lo2(t1); o.r[3] = hi2(t1);
  o.v0 = VV[nn * 64 + i0];
}
DEVI void scan_step1(const ScanOps1& o, f32x2 (&S0)[4], float* YL, int nn, int jg, int i0) {
  f32x2 d0 = S0[0] * o.a[0], d0b = S0[2] * o.a[2];
  d0 = S0[1] * o.a[1] + d0; d0b = S0[3] * o.a[3] + d0b;
  d0 += d0b;
  const float sa0 = red8(d0.x + d0.y);
  f32x2 e0 = {0.f, 0.f};
#pragma unroll
  for (int q = 0; q < 4; ++q) {
    const f32x2 u0 = sa0 * o.b[q] + o.v0 * o.k[q];
    S0[q] = S0[q] * o.w[q] + u0;
    e0 = S0[q] * o.r[q] + e0;
  }
  const float y0 = red8(e0.x + e0.y);
  if (jg == 0) YL[nn * 64 + i0] = y0;
}
DEVI float red16d(float x) {
  x += dpp_mov<0xB1>(x);
  x += dpp_mov<0x4E>(x);
  x += dpp_mov<0x141>(x);
  x += dpp_mov<0x140>(x);
  return x;
}
DEVI void unpack4(u32x2 u, float* o) {
  o[0] = __uint_as_float(u.x << 16); o[1] = __uint_as_float(u.x & 0xffff0000u);
  o[2] = __uint_as_float(u.y << 16); o[3] = __uint_as_float(u.y & 0xffff0000u);
}

DEVI void phase_scan8(int tid_, const Params& p, int l, char* smem, int bfirst, int bstride) {
  const u16* PR = (const u16*)(p.ws + OFF_PR);
  _Float16* YF = (_Float16*)(p.ws + OFF_H);
  _Float16* YB = (_Float16*)(p.ws + OFF_H + (size_t)NTOK * 512 * 2);
  float* BON = (float*)(p.ws + OFF_BONUS);
  const u16* WB = (const u16*)(p.ws + OFF_WB);
  float* OPS = (float*)(smem + SC_OPS);
  u16* RAW = (u16*)(smem + SC_OPS);
  float* VV = (float*)(smem + SC_VV);
  float* WR = (float*)(smem + SC_WR);
  float* AP = (float*)(smem + SC_AP);
  float* YL = WR;
  u16* TWb = (u16*)(smem + SC_TW);
  u16* ADb = (u16*)(smem + SC_AD);
  float* NRM = (float*)(smem + SC_NRM);
  float* MU = (float*)(smem + SC_MU);
  float* CST = (float*)(smem + SC_CST);
  const float* mu_p = p.in[I_MU_PREV] + (size_t)l * 1920;
  const float* mu_n = p.in[I_MU_NEXT] + (size_t)l * 1920;
  const int tid = tid_, lane = tid & 63, w = tid >> 6, fr = lane & 15, fq = lane >> 4;
  const int pn = tid >> 4, j0 = (tid & 15) * 4;
  const int jg = lane & 7, i0 = w * 8 + (lane >> 3);
  const int hr = (tid >= 80) ? 1 : 0, hc = tid - hr * 80;
  const int wm = w >> 2, wn = w & 3;
  for (int blk = bfirst; blk < 192; blk += bstride) {
    const int s = blk >> 4, h = (blk >> 1) & 7, d = blk & 1;
    __syncthreads();
    for (int i = tid; i < 640; i += 512) {
      const int which = (i >= 320) ? 1 : 0, c = i - which * 320;
      const int g = c >> 6, e = c & 63;
      const int col = (g < 3) ? (g * 512 + h * 64 + e) : (1536 + (g - 3) * 128 + d * 64 + e);
      MU[i] = which ? mu_n[col] : mu_p[col];
    }
    if (tid < 320) {
      const int which = tid >> 6, e = tid & 63;
      float v;
      if (which == 0) v = p.in[I_W0][(size_t)(l * 2 + d) * 512 + h * 64 + e];
      else if (which == 1) v = p.in[I_A0][(size_t)(l * 2 + d) * 512 + h * 64 + e];
      else if (which == 2) v = p.in[I_K_K][(size_t)l * 512 + h * 64 + e];
      else if (which == 3) v = p.in[I_K_A][(size_t)l * 512 + h * 64 + e];
      else v = p.in[I_R_K][(size_t)(l * 8 + h) * 64 + e];
      CST[tid] = v;
    }
    bf16x8 bw[2], ba[2];
#pragma unroll
    for (int ks = 0; ks < 2; ++ks) {
      bw[ks] = *(const bf16x8*)(WB + W_WUP + (size_t)(d * 512 + h * 64 + wn * 16 + fr) * 64 + ks * 32 + fq * 8);
      ba[ks] = *(const bf16x8*)(WB + W_AUP + (size_t)(d * 512 + h * 64 + wn * 16 + fr) * 64 + ks * 32 + fq * 8);
    }
    _Float16* Y = d ? YB : YF;
    f32x2 S0[4];
#pragma unroll
    for (int q = 0; q < 4; ++q) S0[q] = (f32x2){0.f, 0.f};
    u32x2 G[5], GH;
    {
      const int t = d ? (4095 - pn) : pn;
      const size_t tok = (size_t)s * 4096 + t;
#pragma unroll
      for (int g = 0; g < 5; ++g) {
        const int col = (g < 3) ? (g * 512 + h * 64) : (1536 + (g - 3) * 128 + d * 64);
        G[g] = *(const u32x2*)(PR + tok * PRW + col + j0);
      }
      GH = (u32x2){0u, 0u};
      if (tid < 160) {
        const int tlo = d ? (4095 - 31) : 0;
        const int th = hr ? (tlo + 32) : (tlo - 1);
        const int g = hc >> 4;
        const int col = (g < 3) ? (g * 512 + h * 64) : (1536 + (g - 3) * 128 + d * 64);
        if (th >= 0 && th <= 4095) GH = *(const u32x2*)(PR + ((size_t)s * 4096 + th) * PRW + col + (hc & 15) * 4);
      }
    }
#pragma unroll 1
    for (int ch = 0; ch < 128; ++ch) {
      const int n = ch * 32 + pn;
      const int t = d ? (4095 - n) : n;
      const size_t tok = (size_t)s * 4096 + t;
      const int tlo = d ? (4095 - (ch * 32 + 31)) : (ch * 32);
      const int rrow = t - tlo + 1;
#pragma unroll
      for (int g = 0; g < 5; ++g) *(u32x2*)(RAW + rrow * 320 + g * 64 + j0) = G[g];
      if (tid < 160) *(u32x2*)(RAW + (hr ? 33 : 0) * 320 + (hc >> 4) * 64 + (hc & 15) * 4) = GH;
      __syncthreads();
      if (ch + 1 < 128) {
        const int n2 = n + 32;
        const int t2 = d ? (4095 - n2) : n2;
        const size_t tok2 = (size_t)s * 4096 + t2;
#pragma unroll
        for (int g = 0; g < 5; ++g) {
          const int col = (g < 3) ? (g * 512 + h * 64) : (1536 + (g - 3) * 128 + d * 64);
          G[g] = *(const u32x2*)(PR + tok2 * PRW + col + j0);
        }
        GH = (u32x2){0u, 0u};
        if (tid < 160) {
          const int tlo2 = d ? (tlo - 32) : (tlo + 32);
          const int th = hr ? (tlo2 + 32) : (tlo2 - 1);
          const int g = hc >> 4;
          const int col = (g < 3) ? (g * 512 + h * 64) : (1536 + (g - 3) * 128 + d * 64);
          if (th >= 0 && th <= 4095) GH = *(const u32x2*)(PR + ((size_t)s * 4096 + th) * PRW + col + (hc & 15) * 4);
        }
      }
#pragma unroll
      for (int g = 0; g < 5; ++g) {
        float cur[4], prv[4], nxt[4];
        unpack4(*(const u32x2*)(RAW + rrow * 320 + g * 64 + j0), cur);
        unpack4(*(const u32x2*)(RAW + (rrow - 1) * 320 + g * 64 + j0), prv);
        unpack4(*(const u32x2*)(RAW + (rrow + 1) * 320 + g * 64 + j0), nxt);
        const f32x4 mp0 = *(const f32x4*)(MU + g * 64 + j0);
        const f32x4 mn0 = *(const f32x4*)(MU + 320 + g * 64 + j0);
        f32x4 x0;
#pragma unroll
        for (int e = 0; e < 4; ++e) x0[e] = cur[e] + mp0[e] * (prv[e] - cur[e]) + mn0[e] * (nxt[e] - cur[e]);
        if (g == 0) {
          *(f32x4*)(OPS + 4 * 2048 + pn * 64 + j0) = x0;
        } else if (g == 1) {
          *(f32x4*)(OPS + 3 * 2048 + pn * 64 + j0) = x0;
          const f32x4 kk0 = *(const f32x4*)(CST + 128 + j0);
          float ss = 0.f;
#pragma unroll
          for (int e = 0; e < 4; ++e) { const float a_ = x0[e] * kk0[e]; ss += a_ * a_; }
          ss = red16d(ss);
          if ((tid & 15) == 0) NRM[pn] = frcp(fmaxf(__builtin_amdgcn_sqrtf(ss), 1e-12f));
        } else if (g == 2) {
          *(f32x4*)(VV + pn * 64 + j0) = x0;
        } else if (g == 3) {
          u32x2 pk;
          pk.x = pack2(ftanh(x0[0]), ftanh(x0[1])); pk.y = pack2(ftanh(x0[2]), ftanh(x0[3]));
          *(u32x2*)(TWb + pn * 72 + j0) = pk;
        } else {
          u32x2 pk;
          pk.x = pack2(x0[0], x0[1]); pk.y = pack2(x0[2], x0[3]);
          *(u32x2*)(ADb + pn * 72 + j0) = pk;
        }
      }
      __syncthreads();
      {
        f32x4 cw = {0.f, 0.f, 0.f, 0.f}, ca = {0.f, 0.f, 0.f, 0.f};
#pragma unroll
        for (int ks = 0; ks < 2; ++ks) {
          const bf16x8 aw = *(const bf16x8*)(TWb + (wm * 16 + fr) * 72 + ks * 32 + fq * 8);
          const bf16x8 aa = *(const bf16x8*)(ADb + (wm * 16 + fr) * 72 + ks * 32 + fq * 8);
          cw = __builtin_amdgcn_mfma_f32_16x16x32_bf16(aw, bw[ks], cw, 0, 0, 0);
          ca = __builtin_amdgcn_mfma_f32_16x16x32_bf16(aa, ba[ks], ca, 0, 0, 0);
        }
#pragma unroll
        for (int jj = 0; jj < 4; ++jj) {
          WR[(wm * 16 + fq * 4 + jj) * 64 + wn * 16 + fr] = cw[jj];
          AP[(wm * 16 + fq * 4 + jj) * 64 + wn * 16 + fr] = ca[jj];
        }
      }
      __syncthreads();
      {
        const float inv = NRM[pn];
        float bsum = 0.f;
        const f32x4 wr_ = *(const f32x4*)(WR + pn * 64 + j0) + *(const f32x4*)(CST + j0);
        const f32x4 ap_ = *(const f32x4*)(AP + pn * 64 + j0) + *(const f32x4*)(CST + 64 + j0);
        const f32x4 kr = *(const f32x4*)(OPS + 3 * 2048 + pn * 64 + j0);
        const f32x4 rr = *(const f32x4*)(OPS + 4 * 2048 + pn * 64 + j0);
        const f32x4 kkw = *(const f32x4*)(CST + 128 + j0), kaw = *(const f32x4*)(CST + 192 + j0), rkw = *(const f32x4*)(CST + 256 + j0);
        f32x4 o0, o1, o2, o3;
#pragma unroll
        for (int e = 0; e < 4; ++e) {
          const float sw = sigm(wr_[e]);
          const float dec = __expf(-0.6065306597126334f * sw);
          const float av = sigm(ap_[e]);
          const float kn = kr[e] * kkw[e] * inv;
          const float kd = kr[e] * (1.f + (av - 1.f) * kaw[e]);
          bsum += rr[e] * kd * rkw[e];
          o0[e] = -kn; o1[e] = dec; o2[e] = kn * av; o3[e] = kd;
        }
        *(f32x4*)(OPS + 0 * 2048 + pn * 64 + j0) = o0;
        *(f32x4*)(OPS + 1 * 2048 + pn * 64 + j0) = o1;
        *(f32x4*)(OPS + 2 * 2048 + pn * 64 + j0) = o2;
        *(f32x4*)(OPS + 3 * 2048 + pn * 64 + j0) = o3;
        bsum = red16d(bsum);
        if ((tid & 15) == 0) BON[(tok * 8 + h) * 2 + d] = bsum;
      }
      __syncthreads();
      {
        ScanOps1 oa, ob;
        scan_load1(oa, OPS, VV, 0, jg, i0);
#pragma unroll 1
        for (int nn = 0; nn < 32; nn += 2) {
          scan_load1(ob, OPS, VV, nn + 1, jg, i0);
          scan_step1(oa, S0, YL, nn, jg, i0);
          scan_load1(oa, OPS, VV, (nn + 2) & 31, jg, i0);
          scan_step1(ob, S0, YL, nn + 1, jg, i0);
        }
      }
      __syncthreads();
      {
        typedef __attribute__((ext_vector_type(4))) _Float16 h16x4;
        h16x4 o;
#pragma unroll
        for (int e = 0; e < 4; ++e) o[e] = (_Float16)YL[pn * 64 + j0 + e];
        *(h16x4*)(Y + tok * 512 + h * 64 + j0) = o;
      }
    }
    __syncthreads();
  }
}

constexpr int PC_OPS = 0;
constexpr int PC_BUF = 49152;
constexpr int PC_RAW = 98304;
constexpr int PC_WR = 98304;
constexpr int PC_AP = 106496;
constexpr int PC_TW = 120064;
constexpr int PC_AD = 124672;
constexpr int PC_NRM = 129280;
constexpr int PC_MU = 129408;
constexpr int PC_CST = 131968;
constexpr int PC_YL = 133248;

DEVI void phase_scan_pc(int tid_, const Params& p, int l, char* smem, int bfirst, int bstride) {
  const u16* PR = (const u16*)(p.ws + OFF_PR);
  _Float16* YF = (_Float16*)(p.ws + OFF_H);
  _Float16* YB = (_Float16*)(p.ws + OFF_H + (size_t)NTOK * 512 * 2);
  float* BON = (float*)(p.ws + OFF_BONUS);
  const u16* WB = (const u16*)(p.ws + OFF_WB);
  u16* RAW = (u16*)(smem + PC_RAW);
  float* WR = (float*)(smem + PC_WR);
  float* AP = (float*)(smem + PC_AP);
  u16* TWb = (u16*)(smem + PC_TW);
  u16* ADb = (u16*)(smem + PC_AD);
  float* NRM = (float*)(smem + PC_NRM);
  float* MU = (float*)(smem + PC_MU);
  float* CST = (float*)(smem + PC_CST);
  const float* mu_p = p.in[I_MU_PREV] + (size_t)l * 1920;
  const float* mu_n = p.in[I_MU_NEXT] + (size_t)l * 1920;
  const bool is_prep = tid_ >= 256;
  const int tid = tid_ & 255, lane = tid & 63, w = tid >> 6, fr = lane & 15, fq = lane >> 4;
  const int pn = tid >> 3, j0 = (tid & 7) * 8;
  const int jg = lane & 7, i0 = w * 16 + (lane >> 3);
  const int hr = (tid >= 40) ? 1 : 0, hc = tid - hr * 40;
  for (int blk = bfirst; blk < 192; blk += bstride) {
    const int s = blk >> 4, h = (blk >> 1) & 7, d = blk & 1;
    __syncthreads();
    for (int i = tid_; i < 640; i += 512) {
      const int which = (i >= 320) ? 1 : 0, c = i - which * 320;
      const int g = c >> 6, e = c & 63;
      const int col = (g < 3) ? (g * 512 + h * 64 + e) : (1536 + (g - 3) * 128 + d * 64 + e);
      MU[i] = which ? mu_n[col] : mu_p[col];
    }
    if (tid_ < 320) {
      const int which = tid_ >> 6, e = tid_ & 63;
      float v;
      if (which == 0) v = p.in[I_W0][(size_t)(l * 2 + d) * 512 + h * 64 + e];
      else if (which == 1) v = p.in[I_A0][(size_t)(l * 2 + d) * 512 + h * 64 + e];
      else if (which == 2) v = p.in[I_K_K][(size_t)l * 512 + h * 64 + e];
      else if (which == 3) v = p.in[I_K_A][(size_t)l * 512 + h * 64 + e];
      else v = p.in[I_R_K][(size_t)(l * 8 + h) * 64 + e];
      CST[tid_] = v;
    }
    _Float16* Y = d ? YB : YF;
    if (is_prep) {
      bf16x8 bw[2], ba[2];
#pragma unroll
      for (int ks = 0; ks < 2; ++ks) {
        bw[ks] = *(const bf16x8*)(WB + W_WUP + (size_t)(d * 512 + h * 64 + w * 16 + fr) * 64 + ks * 32 + fq * 8);
        ba[ks] = *(const bf16x8*)(WB + W_AUP + (size_t)(d * 512 + h * 64 + w * 16 + fr) * 64 + ks * 32 + fq * 8);
      }
      u32x4 G[5], GH;
      {
        const int t = d ? (4095 - pn) : pn;
        const size_t tok = (size_t)s * 4096 + t;
#pragma unroll
        for (int g = 0; g < 5; ++g) {
          const int col = (g < 3) ? (g * 512 + h * 64) : (1536 + (g - 3) * 128 + d * 64);
          G[g] = *(const u32x4*)(PR + tok * PRW + col + j0);
        }
        GH = (u32x4){0u, 0u, 0u, 0u};
        if (tid < 80) {
          const int tlo = d ? (4095 - 31) : 0;
          const int th = hr ? (tlo + 32) : (tlo - 1);
          const int g = hc >> 3;
          const int col = (g < 3) ? (g * 512 + h * 64) : (1536 + (g - 3) * 128 + d * 64);
          if (th >= 0 && th <= 4095) GH = *(const u32x4*)(PR + ((size_t)s * 4096 + th) * PRW + col + (hc & 7) * 8);
        }
      }
#pragma unroll 1
      for (int ch = -1; ch < 128; ++ch) {
        const int c = ch + 1;
        const bool doprep = c < 128;
        float* OPS = (float*)(smem + PC_OPS + (c & 1) * PC_BUF);
        float* VV = OPS + 5 * 2048;
        const int n = c * 32 + pn;
        const int t = d ? (4095 - n) : n;
        const size_t tok = (size_t)s * 4096 + t;
        const int tlo = d ? (4095 - (c * 32 + 31)) : (c * 32);
        const int rrow = t - tlo + 1;
        __syncthreads();
        if (ch >= 1) {
          const float* YL = (const float*)(smem + PC_YL + ((ch - 1) & 1) * 8192);
          const int n1 = (ch - 1) * 32 + pn;
          const int t1 = d ? (4095 - n1) : n1;
          h16x8 o;
#pragma unroll
          for (int e = 0; e < 8; ++e) o[e] = (_Float16)YL[pn * 64 + j0 + e];
          *(h16x8*)(Y + ((size_t)s * 4096 + t1) * 512 + h * 64 + j0) = o;
        }
        if (doprep) {
#pragma unroll
          for (int g = 0; g < 5; ++g) *(u32x4*)(RAW + rrow * 320 + g * 64 + j0) = G[g];
          if (tid < 80) *(u32x4*)(RAW + (hr ? 33 : 0) * 320 + (hc >> 3) * 64 + (hc & 7) * 8) = GH;
        }
        __syncthreads();
        if (doprep) {
          if (c + 1 < 128) {
            const int n2 = n + 32;
            const int t2 = d ? (4095 - n2) : n2;
            const size_t tok2 = (size_t)s * 4096 + t2;
#pragma unroll
            for (int g = 0; g < 5; ++g) {
              const int col = (g < 3) ? (g * 512 + h * 64) : (1536 + (g - 3) * 128 + d * 64);
              G[g] = *(const u32x4*)(PR + tok2 * PRW + col + j0);
            }
            GH = (u32x4){0u, 0u, 0u, 0u};
            if (tid < 80) {
              const int tlo2 = d ? (tlo - 32) : (tlo + 32);
              const int th = hr ? (tlo2 + 32) : (tlo2 - 1);
              const int g = hc >> 3;
              const int col = (g < 3) ? (g * 512 + h * 64) : (1536 + (g - 3) * 128 + d * 64);
              if (th >= 0 && th <= 4095) GH = *(const u32x4*)(PR + ((size_t)s * 4096 + th) * PRW + col + (hc & 7) * 8);
            }
          }
#pragma unroll
          for (int g = 0; g < 5; ++g) {
            float cur[8], prv[8], nxt[8];
            load8bf(RAW + rrow * 320 + g * 64 + j0, cur);
            load8bf(RAW + (rrow - 1) * 320 + g * 64 + j0, prv);
            load8bf(RAW + (rrow + 1) * 320 + g * 64 + j0, nxt);
            const f32x4 mp0 = *(const f32x4*)(MU + g * 64 + j0), mp1 = *(const f32x4*)(MU + g * 64 + j0 + 4);
            const f32x4 mn0 = *(const f32x4*)(MU + 320 + g * 64 + j0), mn1 = *(const f32x4*)(MU + 320 + g * 64 + j0 + 4);
            f32x4 x0, x1;
#pragma unroll
            for (int e = 0; e < 4; ++e) {
              x0[e] = cur[e] + mp0[e] * (prv[e] - cur[e]) + mn0[e] * (nxt[e] - cur[e]);
              x1[e] = cur[4 + e] + mp1[e] * (prv[4 + e] - cur[4 + e]) + mn1[e] * (nxt[4 + e] - cur[4 + e]);
            }
            if (g == 0) {
              *(f32x4*)(OPS + 4 * 2048 + pn * 64 + j0) = x0; *(f32x4*)(OPS + 4 * 2048 + pn * 64 + j0 + 4) = x1;
            } else if (g == 1) {
              *(f32x4*)(OPS + 3 * 2048 + pn * 64 + j0) = x0; *(f32x4*)(OPS + 3 * 2048 + pn * 64 + j0 + 4) = x1;
              const f32x4 kk0 = *(const f32x4*)(CST + 128 + j0), kk1 = *(const f32x4*)(CST + 128 + j0 + 4);
              float ss = 0.f;
#pragma unroll
              for (int e = 0; e < 4; ++e) { const float a_ = x0[e] * kk0[e], b_ = x1[e] * kk1[e]; ss += a_ * a_ + b_ * b_; }
              ss = red8(ss);
              if ((tid & 7) == 0) NRM[pn] = frcp(fmaxf(__builtin_amdgcn_sqrtf(ss), 1e-12f));
            } else if (g == 2) {
              *(f32x4*)(VV + pn * 64 + j0) = x0; *(f32x4*)(VV + pn * 64 + j0 + 4) = x1;
            } else if (g == 3) {
              u32x4 pk;
              pk.x = pack2(ftanh(x0[0]), ftanh(x0[1])); pk.y = pack2(ftanh(x0[2]), ftanh(x0[3]));
              pk.z = pack2(ftanh(x1[0]), ftanh(x1[1])); pk.w = pack2(ftanh(x1[2]), ftanh(x1[3]));
              *(u32x4*)(TWb + pn * 72 + j0) = pk;
            } else {
              u32x4 pk;
              pk.x = pack2(x0[0], x0[1]); pk.y = pack2(x0[2], x0[3]);
              pk.z = pack2(x1[0], x1[1]); pk.w = pack2(x1[2], x1[3]);
              *(u32x4*)(ADb + pn * 72 + j0) = pk;
            }
          }
        }
        __syncthreads();
        if (doprep) {
#pragma unroll
          for (int m = 0; m < 2; ++m) {
            f32x4 cw = {0.f, 0.f, 0.f, 0.f}, ca = {0.f, 0.f, 0.f, 0.f};
#pragma unroll
            for (int ks = 0; ks < 2; ++ks) {
              const bf16x8 aw = *(const bf16x8*)(TWb + (m * 16 + fr) * 72 + ks * 32 + fq * 8);
              const bf16x8 aa = *(const bf16x8*)(ADb + (m * 16 + fr) * 72 + ks * 32 + fq * 8);
              cw = __builtin_amdgcn_mfma_f32_16x16x32_bf16(aw, bw[ks], cw, 0, 0, 0);
              ca = __builtin_amdgcn_mfma_f32_16x16x32_bf16(aa, ba[ks], ca, 0, 0, 0);
            }
#pragma unroll
            for (int jj = 0; jj < 4; ++jj) {
              WR[(m * 16 + fq * 4 + jj) * 64 + w * 16 + fr] = cw[jj];
              AP[(m * 16 + fq * 4 + jj) * 64 + w * 16 + fr] = ca[jj];
            }
          }
        }
        __syncthreads();
        if (doprep) {
          const float inv = NRM[pn];
          float bsum = 0.f;
#pragma unroll
          for (int hq = 0; hq < 2; ++hq) {
            const int jb = j0 + hq * 4;
            const f32x4 wr_ = *(const f32x4*)(WR + pn * 64 + jb) + *(const f32x4*)(CST + jb);
            const f32x4 ap_ = *(const f32x4*)(AP + pn * 64 + jb) + *(const f32x4*)(CST + 64 + jb);
            const f32x4 kr = *(const f32x4*)(OPS + 3 * 2048 + pn * 64 + jb);
            const f32x4 rr = *(const f32x4*)(OPS + 4 * 2048 + pn * 64 + jb);
            const f32x4 kkw = *(const f32x4*)(CST + 128 + jb), kaw = *(const f32x4*)(CST + 192 + jb), rkw = *(const f32x4*)(CST + 256 + jb);
            f32x4 o0, o1, o2, o3;
#pragma unroll
            for (int e = 0; e < 4; ++e) {
              const float sw = sigm(wr_[e]);
              const float dec = __expf(-0.6065306597126334f * sw);
              const float av = sigm(ap_[e]);
              const float kn = kr[e] * kkw[e] * inv;
              const float kd = kr[e] * (1.f + (av - 1.f) * kaw[e]);
              bsum += rr[e] * kd * rkw[e];
              o0[e] = -kn; o1[e] = dec; o2[e] = kn * av; o3[e] = kd;
            }
            *(f32x4*)(OPS + 0 * 2048 + pn * 64 + jb) = o0;
            *(f32x4*)(OPS + 1 * 2048 + pn * 64 + jb) = o1;
            *(f32x4*)(OPS + 2 * 2048 + pn * 64 + jb) = o2;
            *(f32x4*)(OPS + 3 * 2048 + pn * 64 + jb) = o3;
          }
          bsum = red8(bsum);
          if ((tid & 7) == 0) BON[(tok * 8 + h) * 2 + d] = bsum;
        }
      }
      __syncthreads();
      {
        const float* YL = (const float*)(smem + PC_YL + (127 & 1) * 8192);
        const int n1 = 127 * 32 + pn;
        const int t1 = d ? (4095 - n1) : n1;
        h16x8 o;
#pragma unroll
        for (int e = 0; e < 8; ++e) o[e] = (_Float16)YL[pn * 64 + j0 + e];
        *(h16x8*)(Y + ((size_t)s * 4096 + t1) * 512 + h * 64 + j0) = o;
      }
    } else {
      f32x2 S0[4], S1[4];
#pragma unroll
      for (int q = 0; q < 4; ++q) { S0[q] = (f32x2){0.f, 0.f}; S1[q] = (f32x2){0.f, 0.f}; }
#pragma unroll 1
      for (int ch = -1; ch < 128; ++ch) {
        const float* OPS = (const float*)(smem + PC_OPS + (ch & 1) * PC_BUF);
        const float* VV = OPS + 5 * 2048;
        float* YL = (float*)(smem + PC_YL + (ch & 1) * 8192);
        __syncthreads();
        if (ch < 0) {
          __syncthreads(); __syncthreads(); __syncthreads();
        } else {
          ScanOps oa, ob;
          scan_load(oa, OPS, VV, 0, jg, i0);
#pragma unroll 1
          for (int seg = 0; seg < 4; ++seg) {
            if (seg > 0) __syncthreads();
#pragma unroll 1
            for (int nn = seg * 8; nn < seg * 8 + 8; nn += 2) {
              scan_load(ob, OPS, VV, nn + 1, jg, i0);
              scan_step(oa, S0, S1, YL, nn, jg, i0);
              scan_load(oa, OPS, VV, (nn + 2) & 31, jg, i0);
              scan_step(ob, S0, S1, YL, nn + 1, jg, i0);
            }
          }
        }
      }
      __syncthreads();
    }
    __syncthreads();
  }
}

DEVI void phase_rwkv_post(int tid_, int vb_, int vg_, const Params& p, int l, char* smem) {
  u16* PR = (u16*)(p.ws + OFF_PR);
  const _Float16* YF = (const _Float16*)(p.ws + OFF_H);
  const _Float16* YB = (const _Float16*)(p.ws + OFF_H + (size_t)NTOK * 512 * 2);
  const float* BON = (const float*)(p.ws + OFF_BONUS);
  const u16* GUPT = (const u16*)(p.ws + OFF_WB) + W_GUP;
  const float* mu_p = p.in[I_MU_PREV] + (size_t)l * 1920;
  const float* mu_n = p.in[I_MU_NEXT] + (size_t)l * 1920;
  const float* gng = p.in[I_GN_G] + (size_t)l * 512;
  const float* gnb = p.in[I_GN_B] + (size_t)l * 512;
  u16* As = (u16*)smem;
  const int tid = tid_, lane = tid & 63, w = tid >> 6, fr = lane & 15, fq = lane >> 4;
  for (int tile = vb_; tile < NTOK / 64; tile += vg_) {
    const size_t tok0 = (size_t)tile * 64;
    {
      const int row = tid >> 2, part = tid & 3;
      const size_t tok = tok0 + row;
      const int t = (int)(tok & 4095);
#pragma unroll
      for (int q = 0; q < 4; ++q) {
        const int col = 1792 + part * 32 + q * 8;
        float cur[8], prv[8], nxt[8];
        load8bf(PR + tok * PRW + col, cur);
        if (t > 0) load8bf(PR + (tok - 1) * PRW + col, prv);
        else {
#pragma unroll
          for (int e = 0; e < 8; ++e) prv[e] = 0.f;
        }
        if (t < 4095) load8bf(PR + (tok + 1) * PRW + col, nxt);
        else {
#pragma unroll
          for (int e = 0; e < 8; ++e) nxt[e] = 0.f;
        }
        float o[8];
#pragma unroll
        for (int e = 0; e < 8; ++e) {
          const float x = cur[e] + mu_p[col + e] * (prv[e] - cur[e]) + mu_n[col + e] * (nxt[e] - cur[e]);
          o[e] = sigm(x);
        }
        u32x4 pk;
        pk.x = pack2(o[0], o[1]); pk.y = pack2(o[2], o[3]); pk.z = pack2(o[4], o[5]); pk.w = pack2(o[6], o[7]);
        *(u32x4*)(As + row * 136 + part * 32 + q * 8) = pk;
      }
    }
    asm volatile("" ::: "memory");
#pragma unroll 1
    for (int chh = 0; chh < 2; ++chh) {
      f32x4 acc[16];
#pragma unroll
      for (int n = 0; n < 16; ++n) acc[n] = (f32x4){0.f, 0.f, 0.f, 0.f};
#pragma unroll
      for (int ks = 0; ks < 4; ++ks) {
        bf16x8 af = *(const bf16x8*)(As + (w * 16 + fr) * 136 + ks * 32 + fq * 8);
#pragma unroll
        for (int n = 0; n < 16; ++n) {
          bf16x8 bg = *(const bf16x8*)(GUPT + (size_t)(chh * 256 + n * 16 + fr) * 128 + ks * 32 + fq * 8);
          acc[n] = __builtin_amdgcn_mfma_f32_16x16x32_bf16(af, bg, acc[n], 0, 0, 0);
        }
      }
#pragma unroll
      for (int hl = 0; hl < 4; ++hl) {
        const int head = chh * 4 + hl;
        asm volatile("" ::: "memory");
#pragma unroll
        for (int j = 0; j < 4; ++j) {
          const size_t tok = tok0 + w * 16 + fq * 4 + j;
          const int t = (int)(tok & 4095);
          float o[4], sum = 0.f;
#pragma unroll
          for (int q = 0; q < 4; ++q) {
            const int col = head * 64 + q * 16 + fr;
            o[q] = (float)YF[tok * 512 + col] + (float)YB[tok * 512 + col];
            sum += o[q];
          }
          const float mean = red16_sum(sum) * (1.f / 64.f);
          float vs = 0.f;
#pragma unroll
          for (int q = 0; q < 4; ++q) { const float dlt = o[q] - mean; vs += dlt * dlt; }
          const float var = red16_sum(vs) * (1.f / 64.f);
          const float rstd = rsqrtf(var + 64e-5f);
          const float bon = BON[(tok * 8 + head) * 2] + BON[(tok * 8 + head) * 2 + 1];
#pragma unroll
          for (int q = 0; q < 4; ++q) {
            const int col = head * 64 + q * 16 + fr;
            const int vc = 1024 + col;
            const float cur = bf2f(PR[tok * PRW + vc]);
            const float prv = (t > 0) ? bf2f(PR[(tok - 1) * PRW + vc]) : 0.f;
            const float nxt = (t < 4095) ? bf2f(PR[(tok + 1) * PRW + vc]) : 0.f;
            const float vsh = cur + mu_p[vc] * (prv - cur) + mu_n[vc] * (nxt - cur);
            const float yv = ((o[q] - mean) * rstd * gng[col] + gnb[col] + bon * vsh) * acc[hl * 4 + q][j];
            PR[tok * PRW + col] = f2bf(yv);
          }
        }
      }
    }
  }
}

DEVI f32x4 ld4bf(const u16* p) {
  const u32x2 u = *(const u32x2*)p;
  f32x4 o;
  o[0] = __uint_as_float(u.x << 16); o[1] = __uint_as_float(u.x & 0xffff0000u);
  o[2] = __uint_as_float(u.y << 16); o[3] = __uint_as_float(u.y & 0xffff0000u);
  return o;
}

DEVI void phase_merge(int tid_, const Params& p, char* smem) {
  const u16* WB = (const u16*)(p.ws + OFF_WB);
  const u16* H = (const u16*)(p.ws + OFF_NK);
  u16* PR = (u16*)(p.ws + OFF_PR);
  const u16* NQ = (const u16*)(p.ws + OFF_NQ);
  u16* TMP = (u16*)(p.ws + OFF_H);
  const int lane = tid_ & 63, wid = tid_ >> 6;
  const int wr = wid >> 2, wc = wid & 3, fr = lane & 15, fq = lane >> 4;
  const bool xmap = (gridDim.x & 7) == 0;
  const int xcd = blockIdx.x & 7;
  const int first = xmap ? (int)(blockIdx.x >> 3) : (int)blockIdx.x;
  const int stride = xmap ? (int)(gridDim.x >> 3) : (int)gridDim.x;
  const int count = xmap ? 24 * 4 : 192 * 4;
  for (int it = first; it < count; it += stride) {
    const int tm = xmap ? (it >> 2) * 8 + xcd : (it >> 2), tn = it & 3;
    const int m0 = tm << 8, n0 = tn << 8;
    f32x4 acc[8][4];
#define MERGE_ZERO() _Pragma("unroll") for (int m = 0; m < 8; ++m) _Pragma("unroll") for (int n = 0; n < 4; ++n) acc[m][n] = (f32x4){0.f, 0.f, 0.f, 0.f}
#define MERGE_RC() const int r = m0 + wr * 128 + m * 16 + fr, c0 = n0 + wc * 64 + n * 16 + fq * 4
    MERGE_ZERO();
    gemm_kloop8<true>(launder(tid_), acc, H + (size_t)m0 * 1024, 1024, WB + W_IN + (size_t)(3456 + n0) * 1024, 1024, 1024, smem);
#pragma unroll
    for (int m = 0; m < 8; ++m)
#pragma unroll
      for (int n = 0; n < 4; ++n) {
        MERGE_RC();
        f32x4 o;
#pragma unroll
        for (int j = 0; j < 4; ++j) o[j] = sigm(acc[m][n][j]);
        store4bf(PR + (size_t)r * PRW + 512 + c0, o);
      }
    MERGE_ZERO();
    gemm_kloop8<true>(launder(tid_), acc, PR + (size_t)m0 * PRW, PRW, WB + W_BRR + (size_t)n0 * 512, 512, 512, smem);
#pragma unroll
    for (int m = 0; m < 8; ++m)
#pragma unroll
      for (int n = 0; n < 4; ++n) {
        MERGE_RC();
        u16* dst = PR + (size_t)r * PRW + 512 + c0;
        store4bf(dst, ld4bf(dst) * acc[m][n]);
      }
    MERGE_ZERO();
    gemm_kloop8<true>(launder(tid_), acc, H + (size_t)m0 * 1024, 1024, WB + W_IN + (size_t)(4480 + n0) * 1024, 1024, 1024, smem);
#pragma unroll
    for (int m = 0; m < 8; ++m)
#pragma unroll
      for (int n = 0; n < 4; ++n) {
        MERGE_RC();
        f32x4 o;
#pragma unroll
        for (int j = 0; j < 4; ++j) o[j] = sigm(acc[m][n][j]);
        store4bf(TMP + (size_t)r * 1024 + c0, o);
      }
    MERGE_ZERO();
    gemm_kloop8<true>(launder(tid_), acc, NQ + (size_t)m0 * 512, 512, WB + W_BRN + (size_t)n0 * 512, 512, 512, smem);
#pragma unroll
    for (int m = 0; m < 8; ++m)
#pragma unroll
      for (int n = 0; n < 4; ++n) {
        MERGE_RC();
        u16* dst = PR + (size_t)r * PRW + 512 + c0;
        store4bf(dst, ld4bf(dst) + ld4bf(TMP + (size_t)r * 1024 + c0) * acc[m][n]);
      }
#undef MERGE_ZERO
#undef MERGE_RC
  }
}


DEVI void phase_xattn(int tid_, int vb_, int vg_, const Params& p, char* smem) {
  const u16* Q = (const u16*)(p.ws + OFF_PR);
  u16* O = (u16*)(p.ws + OFF_NQ);
  const u16* KVK = (const u16*)(p.ws + OFF_KVK);
  const u16* KVT = (const u16*)(p.ws + OFF_KVT);
  const int lane = tid_ & 63, w = tid_ >> 6, fr = lane & 15, fq = lane >> 4;
  u16* Pw = (u16*)smem + w * (32 * 264);
  for (int t = vb_; t < (NTOK / 128) * 4; t += vg_) {
    const int hh = t & 3;
    const size_t tok0 = (size_t)(t >> 2) * 128 + w * 32;
    const int s = (int)(tok0 >> 12);
    f32x4 acc[2][16];
#pragma unroll
    for (int mt = 0; mt < 2; ++mt)
#pragma unroll
      for (int n = 0; n < 16; ++n) acc[mt][n] = (f32x4){0.f, 0.f, 0.f, 0.f};
#pragma unroll 1
    for (int ks = 0; ks < 8; ++ks) {
      const bf16x8 aq0 = *(const bf16x8*)(Q + (tok0 + fr) * 1024 + hh * 256 + ks * 32 + fq * 8);
      const bf16x8 aq1 = *(const bf16x8*)(Q + (tok0 + 16 + fr) * 1024 + hh * 256 + ks * 32 + fq * 8);
#pragma unroll
      for (int n = 0; n < 16; ++n) {
        const bf16x8 bk = *(const bf16x8*)(KVK + (size_t)(s * 256 + n * 16 + fr) * 1024 + hh * 256 + ks * 32 + fq * 8);
        acc[0][n] = __builtin_amdgcn_mfma_f32_16x16x32_bf16(bk, aq0, acc[0][n], 0, 0, 0);
        acc[1][n] = __builtin_amdgcn_mfma_f32_16x16x32_bf16(bk, aq1, acc[1][n], 0, 0, 0);
      }
    }
    float sm[2];
#pragma unroll
    for (int mt = 0; mt < 2; ++mt) {
      float m = -1e30f;
#pragma unroll
      for (int n = 0; n < 16; ++n)
#pragma unroll
        for (int j = 0; j < 4; ++j) m = fmaxf(m, acc[mt][n][j]);
      m = red4x_max(m) * 0.0625f;
      float ssum = 0.f;
#pragma unroll
      for (int n = 0; n < 16; ++n) {
        f32x4 e;
#pragma unroll
        for (int j = 0; j < 4; ++j) { e[j] = __expf(acc[mt][n][j] * 0.0625f - m); ssum += e[j]; }
        store4bf(Pw + (mt * 16 + fr) * 264 + n * 16 + fq * 4, e);
      }
      sm[mt] = 1.f / red4x_sum(ssum);
    }
#pragma unroll
    for (int mt = 0; mt < 2; ++mt)
#pragma unroll
      for (int n = 0; n < 16; ++n) acc[mt][n] = (f32x4){0.f, 0.f, 0.f, 0.f};
#pragma unroll 1
    for (int ks = 0; ks < 8; ++ks) {
      const bf16x8 ap0 = *(const bf16x8*)(Pw + fr * 264 + ks * 32 + fq * 8);
      const bf16x8 ap1 = *(const bf16x8*)(Pw + (16 + fr) * 264 + ks * 32 + fq * 8);
#pragma unroll
      for (int n = 0; n < 16; ++n) {
        const bf16x8 bv = *(const bf16x8*)(KVT + (size_t)(s * 1024 + hh * 256 + n * 16 + fr) * 256 + ks * 32 + fq * 8);
        acc[0][n] = __builtin_amdgcn_mfma_f32_16x16x32_bf16(bv, ap0, acc[0][n], 0, 0, 0);
        acc[1][n] = __builtin_amdgcn_mfma_f32_16x16x32_bf16(bv, ap1, acc[1][n], 0, 0, 0);
      }
    }
#pragma unroll
    for (int mt = 0; mt < 2; ++mt)
#pragma unroll
      for (int n = 0; n < 16; ++n)
        store4bf(O + (tok0 + mt * 16 + fr) * 1024 + hh * 256 + n * 16 + fq * 4, acc[mt][n] * sm[mt]);
  }
}

constexpr int HALF_SMEM = 78720;

DEVI void run_phase(int tid_, const Params& p, int ph, char* smem) {
  const int half = tid_ >> 8, vt = tid_ & 255;
  const int vb_ = blockIdx.x * 2 + half, vg_ = gridDim.x * 2;
  char* smh = smem + half * HALF_SMEM;
  if (ph == 2 * NPH_LAYER) { phase_final_norm(vt, vb_, vg_, p); return; }
  const int l = ph / NPH_LAYER, q = ph % NPH_LAYER;
  u16* WB = (u16*)(p.ws + OFF_WB);
  u16* H = (u16*)(p.ws + OFF_H);
  u16* PR = (u16*)(p.ws + OFF_PR);
  u16* NQ = (u16*)(p.ws + OFF_NQ);
  float* X = p.X;
  auto epi_res = [&](int r, int c0, f32x4 v) {
    f32x4* px = (f32x4*)(X + (size_t)r * 1024 + c0);
    *px = *px + v;
  };
  constexpr int NONS = 1 << 30;
  switch (q) {
    case 0:
      phase_conv(vt, vb_, vg_, p, l, smh);
      phase_norm(vt, vb_, vg_, p, p.in[I_NORM_MIX] + (size_t)l * 1024, l == 0);
      phase_norm_mem(vt, vb_, vg_, p, p.in[I_NORM_MEM] + (size_t)l * 1024);
      break;
    case 1: phase_p_gemm(tid_, p, smem); break;
    case 2:
      if (gridDim.x >= 224) {
        if (blockIdx.x < 192) phase_scan_pc(tid_, p, l, smem, blockIdx.x, gridDim.x);
        else phase_nat(vt, p, l, smh, vb_ - 384, vg_ - 384);
      } else {
        phase_scan(vt, p, l, smh, vb_, vg_);
        __syncthreads();
        phase_nat(vt, p, l, smh, vb_, vg_);
      }
      break;
    case 3:
      phase_rwkv_post(vt, vb_, vg_, p, l, smh);
      phase_norm(vt, vb_, vg_, p, p.in[I_NORM_MIX] + (size_t)l * 1024, false, OFF_NK);
      break;
    case 4: phase_merge(tid_, p, smem); break;
    case 5: gemm_phase8(tid_, PR + 512, PRW, WB + W_OUT, 1024, 1024, NTOK, 1024, smem, NONS, epi_res, NoEpi()); break;
    case 6: phase_norm(vt, vb_, vg_, p, p.in[I_NORM_X] + (size_t)l * 1024, false); break;
    case 7:
      gemm_phase8(tid_, H, 1024, WB + W_XQ, 1024, 1024, NTOK, 1024, smem, NONS,
                 [&](int r, int c0, f32x4 v) { store4bf(PR + (size_t)r * 1024 + c0, v); }, NoEpi());
      break;
    case 8: phase_xattn(vt, vb_, vg_, p, smh); break;
    case 9: gemm_phase8(tid_, NQ, 1024, WB + W_XO, 1024, 1024, NTOK, 1024, smem, NONS, epi_res, NoEpi()); break;
    case 10: phase_norm(vt, vb_, vg_, p, p.in[I_NORM_FF] + (size_t)l * 1024, false); break;
    case 11:
    case 13: {
      const int hf = (q == 13);
      gemm_phase8(tid_, H, 1024, WB + W_FF1 + (size_t)hf * 2048 * 1024, 1024, 1024, NTOK, 2048, smem, NONS,
                 [&](int r, int c0, f32x4 v) {
                   f32x4 o;
#pragma unroll
                   for (int j = 0; j < 4; ++j) { const float x = fmaxf(v[j], 0.f); o[j] = x * x; }
                   store4bf(PR + (size_t)r * 2048 + c0, o);
                 }, NoEpi());
    } break;
    case 12:
    case 14: {
      const int hf = (q == 14);
      gemm_phase8(tid_, PR, 2048, WB + W_FF2 + (size_t)hf * 2048, 4096, 2048, NTOK, 1024, smem, NONS, epi_res, NoEpi());
    } break;
  }
}

#define XB_TMO      128
#define XB_XCNT(j)  (256  + 64 * (j))
#define XB_XSUB(j)  (1280 + 64 * (j))
#define XB_XGEN(j)  (2304 + 64 * (j))
#define XB_TOP      3328
#define XB_TOPGEN   3392
#define XCD_BAR_WORDS 3456
#define XB_SPIN_CAP (1u << 20)
#define LAS __attribute__((address_space(3)))

DEVI unsigned xb_ld(unsigned* p) { return __hip_atomic_load(p, __ATOMIC_RELAXED, __HIP_MEMORY_SCOPE_AGENT); }
DEVI unsigned xb_add(unsigned* p, unsigned v) { return __hip_atomic_fetch_add(p, v, __ATOMIC_RELAXED, __HIP_MEMORY_SCOPE_AGENT); }
DEVI unsigned xb_xcc_id() { return (unsigned)__builtin_amdgcn_s_getreg((3 << 11) | 20) & 0xFu; }
#define XB_SPIN(cond, bar) do { unsigned _sp = 0; while (cond) { __builtin_amdgcn_s_sleep(1); \
    if ((++_sp & 255u) == 0u) { if (xb_ld(&(bar)[XB_TMO])) break; if (_sp > XB_SPIN_CAP) { atomicAdd(&(bar)[XB_TMO], 1u); break; } } } } while (0)

struct XcdBarrier {
  unsigned* bar; unsigned x;
  volatile LAS unsigned* st;
};
DEVI XcdBarrier xcd_barrier_post(unsigned* bar, volatile LAS unsigned* st) {
  XcdBarrier b; b.bar = bar; b.x = xb_xcc_id(); b.st = st;
  if (threadIdx.x == 0) (void)xb_add(&bar[XB_XCNT(b.x)], 1u);
  return b;
}
DEVI void xcd_barrier_complete(unsigned* bar, unsigned x, unsigned& nloc, unsigned& nx) {
  const unsigned G = gridDim.x * gridDim.y * gridDim.z;
  unsigned sum, cnt, mine, sp = 0u;
  for (;;) {
    sum = 0u; cnt = 0u; mine = 0u;
#pragma unroll
    for (unsigned j = 0; j < 16; ++j) { const unsigned c = xb_ld(&bar[XB_XCNT(j)]); sum += c; cnt += (c > 0u) ? 1u : 0u; mine = (j == x) ? c : mine; }
    if (sum == G) break;
    __builtin_amdgcn_s_sleep(1);
    if ((++sp & 255u) == 0u) { if (xb_ld(&bar[XB_TMO])) break; if (sp > XB_SPIN_CAP) { atomicAdd(&bar[XB_TMO], 1u); break; } }
  }
  nloc = mine > 0u ? mine : 1u; nx = cnt > 0u ? cnt : 1u;
}
DEVI void xcd_barrier(const XcdBarrier& b) {
  asm volatile("s_waitcnt vmcnt(0)" ::: "memory");
  __syncthreads();
  if (threadIdx.x == 0) {
    unsigned* bar = b.bar;
    __builtin_amdgcn_s_waitcnt(0);
    unsigned nloc = b.st[0], nx = b.st[1];
    if (nloc == 0u) { xcd_barrier_complete(bar, b.x, nloc, nx); b.st[0] = nloc; b.st[1] = nx; }
    const unsigned old = xb_add(&bar[XB_XSUB(b.x)], 1u);
    const unsigned gen = old / nloc;
    if (old + 1u == (gen + 1u) * nloc) {
      __builtin_amdgcn_fence(__ATOMIC_RELEASE, "agent");
      asm volatile("s_waitcnt vmcnt(0)" ::: "memory");
      const unsigned og = xb_add(&bar[XB_TOP], 1u);
      const unsigned tg = og / nx;
      if (og + 1u == (tg + 1u) * nx) xb_add(&bar[XB_TOPGEN], 1u);
      else XB_SPIN(xb_ld(&bar[XB_TOPGEN]) == tg, bar);
      __builtin_amdgcn_fence(__ATOMIC_ACQUIRE, "agent");
      xb_add(&bar[XB_XGEN(b.x)], 1u);
      asm volatile("s_waitcnt vmcnt(0)" ::: "memory");
    } else {
      XB_SPIN(xb_ld(&bar[XB_XGEN(b.x)]) == gen, bar);
      __builtin_amdgcn_fence(__ATOMIC_ACQUIRE, "agent");
      asm volatile("s_waitcnt vmcnt(0)" ::: "memory");
    }
  }
  __syncthreads();
}

__global__ void __launch_bounds__(512, 2) mega_kernel(Params p, int ph0, int ph1) {
  __shared__ __attribute__((aligned(16))) char smem[2 * HALF_SMEM];
  __shared__ __attribute__((aligned(16))) unsigned xb_words[4];
  if (threadIdx.x == 0) { xb_words[0] = 0u; xb_words[1] = 0u; xb_words[2] = 0u; xb_words[3] = 0u; }
  __syncthreads();
  XcdBarrier xb = xcd_barrier_post((unsigned*)(p.ws + OFF_BAR), (volatile LAS unsigned*)xb_words);
  for (int ph = ph0; ph < ph1; ++ph) {
    if (ph == ph0 + 1) cg::this_grid().sync();
    else if (ph > ph0) xcd_barrier(xb);
    int tid_ = threadIdx.x;
    asm volatile("" : "+v"(tid_));
    run_phase(tid_, p, ph, smem);
  }
}

extern "C" void kernel_launch(void* const* d_in, const int* in_sizes, int n_in, void* d_out, int out_size, void* d_ws,
                              size_t ws_size, hipStream_t stream) {
  if (ws_size < WS_NEED || n_in < 31) return;
  Params p{};
  for (int i = 0; i < 31; ++i) p.in[i] = (const float*)d_in[i];
  p.X = (float*)d_out;
  p.ws = (char*)d_ws;
  static int grid_blocks = 0;
  if (!grid_blocks) {
    int dev = 0, cus = 0, per_cu = 0;
    hipGetDevice(&dev);
    hipDeviceGetAttribute(&cus, hipDeviceAttributeMultiprocessorCount, dev);
    hipOccupancyMaxActiveBlocksPerMultiprocessor(&per_cu, mega_kernel, 512, 0);
    if (per_cu > 1) per_cu = 1;
    if (per_cu < 1) per_cu = 1;
    grid_blocks = cus * per_cu;
  }
  hipMemsetAsync((char*)d_ws + OFF_BAR, 0, 16384, stream);
  int ph0 = 0, ph1 = NPHASES;
  void* args[] = {&p, &ph0, &ph1};
  hipLaunchCooperativeKernel((void*)mega_kernel, dim3(grid_blocks), dim3(512), args, 0, stream);
}
```

```cpp
#include <hip/hip_runtime.h>
#include <hip/hip_cooperative_groups.h>
#include <stdint.h>
namespace cg = cooperative_groups;

typedef unsigned short u16;
typedef __attribute__((ext_vector_type(8))) short bf16x8;
typedef __attribute__((ext_vector_type(4))) float f32x4;
typedef __attribute__((ext_vector_type(8))) _Float16 h16x8;
typedef __attribute__((ext_vector_type(4))) unsigned int u32x4;
typedef __attribute__((ext_vector_type(2))) unsigned int u32x2;

#define DEVI __device__ __forceinline__

constexpr int NTOK = 49152;
constexpr int SEQ_T = 4096;
constexpr int PRW = 1920;
constexpr int NPH_LAYER = 13;
constexpr int NPHASES = 2 * NPH_LAYER + 1;
constexpr int SMEM_BYTES = 78720;

constexpr size_t OFF_WB = 0;
constexpr size_t WB_BYTES = 20512768ull * 2;
constexpr size_t OFF_H = OFF_WB + WB_BYTES;
constexpr size_t OFF_PR = OFF_H + (size_t)NTOK * 1024 * 2;
constexpr size_t OFF_NQ = OFF_PR + (size_t)NTOK * PRW * 2;
constexpr size_t OFF_NK = OFF_NQ + (size_t)NTOK * 512 * 2;
constexpr size_t OFF_NV = OFF_NK + (size_t)NTOK * 512 * 2;
constexpr size_t OFF_KVK = OFF_NV + (size_t)NTOK * 512 * 2;
constexpr size_t OFF_KVT = OFF_KVK + (size_t)3072 * 1024 * 2;
constexpr size_t OFF_MEMH = OFF_KVT + (size_t)3072 * 1024 * 2;
constexpr size_t OFF_BONUS = OFF_MEMH + (size_t)3072 * 1024 * 2;
constexpr size_t OFF_BAR = OFF_BONUS + (size_t)NTOK * 16 * 4;
constexpr size_t OFF_SSQ = OFF_BAR + 16384;
constexpr size_t WS_NEED = OFF_SSQ + (size_t)7 * NTOK * 4;

constexpr size_t W_IN = 0;
constexpr size_t W_BRR = W_IN + (size_t)5504 * 1024;
constexpr size_t W_BRN = W_BRR + (size_t)1024 * 512;
constexpr size_t W_OUT = W_BRN + (size_t)1024 * 512;
constexpr size_t W_XQ = W_OUT + (size_t)1024 * 1024;
constexpr size_t W_XKV = W_XQ + (size_t)1024 * 1024;
constexpr size_t W_XO = W_XKV + (size_t)2048 * 1024;
constexpr size_t W_FF1 = W_XO + (size_t)1024 * 1024;
constexpr size_t W_FF2 = W_FF1 + (size_t)4096 * 1024;
constexpr size_t W_GUP = W_FF2 + (size_t)4096 * 1024;
constexpr size_t W_WUP = W_GUP + (size_t)512 * 128;
constexpr size_t W_AUP = W_WUP + (size_t)2 * 512 * 64;

enum { I_XP = 0, I_XS, I_MP, I_MS, I_NORM_MIX, I_W_IN, I_MU_PREV, I_MU_NEXT, I_W0, I_W_UP, I_A0, I_A_UP,
       I_G_UP, I_K_K, I_K_A, I_R_K, I_GN_G, I_GN_B, I_RPB, I_W_BR_RWKV, I_W_BR_NAT, I_W_OUT, I_NORM_X,
       I_NORM_MEM, I_W_XQ, I_W_XKV, I_W_XO, I_NORM_FF, I_W_FF1, I_W_FF2, I_NORM_FINAL };

struct Params {
  const float* in[31];
  float* X;
  char* ws;
};

DEVI u16 f2bf(float f) {
  uint32_t u = __float_as_uint(f);
  u += 0x7FFFu + ((u >> 16) & 1u);
  return (u16)(u >> 16);
}
DEVI float bf2f(u16 h) { return __uint_as_float(((uint32_t)h) << 16); }
DEVI uint32_t pack2(float a, float b) { return (uint32_t)f2bf(a) | ((uint32_t)f2bf(b) << 16); }
DEVI float frcp(float x) { return __builtin_amdgcn_rcpf(x); }
DEVI float sigm(float x) { return frcp(1.f + __expf(-x)); }
DEVI float ftanh(float x) { return 1.f - 2.f * frcp(__expf(2.f * x) + 1.f); }
DEVI void unpack8(u32x4 u, float* o) {
  o[0] = __uint_as_float(u.x << 16); o[1] = __uint_as_float(u.x & 0xffff0000u);
  o[2] = __uint_as_float(u.y << 16); o[3] = __uint_as_float(u.y & 0xffff0000u);
  o[4] = __uint_as_float(u.z << 16); o[5] = __uint_as_float(u.z & 0xffff0000u);
  o[6] = __uint_as_float(u.w << 16); o[7] = __uint_as_float(u.w & 0xffff0000u);
}
DEVI void load8bf(const u16* p, float* o) { unpack8(*(const u32x4*)p, o); }
DEVI float wave_sum(float v) {
  v += __shfl_xor(v, 32); v += __shfl_xor(v, 16); v += __shfl_xor(v, 8);
  v += __shfl_xor(v, 4); v += __shfl_xor(v, 2); v += __shfl_xor(v, 1);
  return v;
}
DEVI float red4x_sum(float v) { v += __shfl_xor(v, 16); v += __shfl_xor(v, 32); return v; }
DEVI float red4x_max(float v) { v = fmaxf(v, __shfl_xor(v, 16)); v = fmaxf(v, __shfl_xor(v, 32)); return v; }
DEVI float red16_sum(float v) {
  v += __shfl_xor(v, 1); v += __shfl_xor(v, 2); v += __shfl_xor(v, 4); v += __shfl_xor(v, 8);
  return v;
}
DEVI float red16_max(float v) {
  v = fmaxf(v, __shfl_xor(v, 1)); v = fmaxf(v, __shfl_xor(v, 2));
  v = fmaxf(v, __shfl_xor(v, 4)); v = fmaxf(v, __shfl_xor(v, 8));
  return v;
}

DEVI void conv_tile(int tid_, const float* src, int K, int N, u16* dst, int tile, char* smem, const float* gain = nullptr) {
  float (*s)[65] = (float (*)[65])smem;
  const int nN = N >> 6;
  const int tk = tile / nN, tn = tile - tk * nN;
  const int tx = tid_ & 63, ty = tid_ >> 6;
  for (int r = ty; r < 64; r += 4) s[r][tx] = src[(size_t)(tk * 64 + r) * N + tn * 64 + tx];
  __syncthreads();
  const float gk = gain ? gain[tk * 64 + tx] : 1.f;
  for (int r = ty; r < 64; r += 4) dst[(size_t)(tn * 64 + r) * K + tk * 64 + tx] = f2bf(s[tx][r] * gk);
  __syncthreads();
}

DEVI void phase_conv(int tid_, int vb_, int vg_, const Params& p, int l, char* smem) {
  u16* WB = (u16*)(p.ws + OFF_WB);
  const int c0 = 1376, c1 = c0 + 128, c2 = c1 + 128, c3 = c2 + 256, c4 = c3 + 256, c5 = c4 + 512,
            c6 = c5 + 256, c7 = c6 + 1024, c8 = c7 + 1024, c9 = c8 + 16, c10 = c9 + 16, c11 = c10 + 16;
  for (int t = vb_; t < c11; t += vg_) {
    if (t < c0) conv_tile(tid_, p.in[I_W_IN] + (size_t)l * 1024 * 5504, 1024, 5504, WB + W_IN, t, smem, p.in[I_NORM_MIX] + (size_t)l * 1024);
    else if (t < c1) conv_tile(tid_, p.in[I_W_BR_RWKV] + (size_t)l * 512 * 1024, 512, 1024, WB + W_BRR, t - c0, smem);
    else if (t < c2) conv_tile(tid_, p.in[I_W_BR_NAT] + (size_t)l * 512 * 1024, 512, 1024, WB + W_BRN, t - c1, smem);
    else if (t < c3) conv_tile(tid_, p.in[I_W_OUT] + (size_t)l * 1024 * 1024, 1024, 1024, WB + W_OUT, t - c2, smem);
    else if (t < c4) conv_tile(tid_, p.in[I_W_XQ] + (size_t)l * 1024 * 1024, 1024, 1024, WB + W_XQ, t - c3, smem, p.in[I_NORM_X] + (size_t)l * 1024);
    else if (t < c5) conv_tile(tid_, p.in[I_W_XKV] + (size_t)l * 1024 * 2048, 1024, 2048, WB + W_XKV, t - c4, smem);
    else if (t < c6) conv_tile(tid_, p.in[I_W_XO] + (size_t)l * 1024 * 1024, 1024, 1024, WB + W_XO, t - c5, smem);
    else if (t < c7) conv_tile(tid_, p.in[I_W_FF1] + (size_t)l * 1024 * 4096, 1024, 4096, WB + W_FF1, t - c6, smem, p.in[I_NORM_FF] + (size_t)l * 1024);
    else if (t < c8) conv_tile(tid_, p.in[I_W_FF2] + (size_t)l * 4096 * 1024, 4096, 1024, WB + W_FF2, t - c7, smem);
    else if (t < c9) conv_tile(tid_, p.in[I_G_UP] + (size_t)l * 128 * 512, 128, 512, WB + W_GUP, t - c8, smem);
    else if (t < c10) { const int dd = (t - c9) >> 3; conv_tile(tid_, p.in[I_W_UP] + (size_t)(l * 2 + dd) * 64 * 512, 64, 512, WB + W_WUP + (size_t)dd * 512 * 64, (t - c9) & 7, smem); }
    else { const int dd = (t - c10) >> 3; conv_tile(tid_, p.in[I_A_UP] + (size_t)(l * 2 + dd) * 64 * 512, 64, 512, WB + W_AUP + (size_t)dd * 512 * 64, (t - c10) & 7, smem); }
  }
}

DEVI void norm_row_bf16(int tid_, const float* src, const float* g, u16* dst, float* xcopy) {
  const int lane = tid_ & 63;
  float4 v[4];
  float ss = 0.f;
#pragma unroll
  for (int i = 0; i < 4; ++i) {
    v[i] = ((const float4*)src)[lane + i * 64];
    ss += v[i].x * v[i].x + v[i].y * v[i].y + v[i].z * v[i].z + v[i].w * v[i].w;
  }
  ss = wave_sum(ss);
  const float rs = rsqrtf(ss * (1.f / 1024.f) + 1e-6f);
#pragma unroll
  for (int i = 0; i < 4; ++i) {
    float4 gg = ((const float4*)g)[lane + i * 64];
    u32x2 o;
    o.x = pack2(v[i].x * rs * gg.x, v[i].y * rs * gg.y);
    o.y = pack2(v[i].z * rs * gg.z, v[i].w * rs * gg.w);
    ((u32x2*)dst)[lane + i * 64] = o;
    if (xcopy) ((float4*)xcopy)[lane + i * 64] = v[i];
  }
}

DEVI void phase_xb(int tid_, int vb_, int vg_, const Params& p, bool from_input, size_t hoff, float* ssq) {
  u16* H = (u16*)(p.ws + hoff);
  const int wid = tid_ >> 6, lane = tid_ & 63;
  for (int r = vb_ * 4 + wid; r < NTOK; r += vg_ * 4) {
    const float* src;
    if (from_input) src = (r < 32768) ? p.in[I_XP] + (size_t)r * 1024 : p.in[I_XS] + (size_t)(r - 32768) * 1024;
    else src = p.X + (size_t)r * 1024;
    float ss = 0.f;
#pragma unroll
    for (int i = 0; i < 4; ++i) {
      const float4 v = ((const float4*)src)[lane + i * 64];
      ss += v.x * v.x + v.y * v.y + v.z * v.z + v.w * v.w;
      u32x2 o;
      o.x = pack2(v.x, v.y); o.y = pack2(v.z, v.w);
      ((u32x2*)(H + (size_t)r * 1024))[lane + i * 64] = o;
      if (from_input) ((float4*)(p.X + (size_t)r * 1024))[lane + i * 64] = v;
    }
    if (from_input) {
      ss = wave_sum(ss);
      if (lane == 0) ssq[r] = ss;
    }
  }
}
DEVI void phase_norm_mem(int tid_, int vb_, int vg_, const Params& p, const float* g) {
  u16* MH = (u16*)(p.ws + OFF_MEMH);
  const int wid = tid_ >> 6;
  for (int r = vb_ * 4 + wid; r < 3072; r += vg_ * 4) {
    const float* src = (r < 2048) ? p.in[I_MP] + (size_t)r * 1024 : p.in[I_MS] + (size_t)(r - 2048) * 1024;
    norm_row_bf16(tid_, src, g, MH + (size_t)r * 1024, nullptr);
  }
}
DEVI void phase_final_norm(int tid_, int vb_, int vg_, const Params& p) {
  const float* g = p.in[I_NORM_FINAL];
  const float* ssq = (const float*)(p.ws + OFF_SSQ) + (size_t)6 * NTOK;
  const int wid = tid_ >> 6, lane = tid_ & 63;
  for (int r = vb_ * 4 + wid; r < NTOK; r += vg_ * 4) {
    float* row = p.X + (size_t)r * 1024;
    const float rs = rsqrtf(ssq[r] * (1.f / 1024.f) + 1e-6f);
#pragma unroll
    for (int i = 0; i < 4; ++i) {
      const float4 v = ((const float4*)row)[lane + i * 64];
      const float4 gg = ((const float4*)g)[lane + i * 64];
      float4 o;
      o.x = v.x * rs * gg.x; o.y = v.y * rs * gg.y; o.z = v.z * rs * gg.z; o.w = v.w * rs * gg.w;
      ((float4*)row)[lane + i * 64] = o;
    }
  }
}

template <int OFF>
DEVI bf16x8 lds_rd128(uint32_t addr) {
  bf16x8 r;
  asm volatile("ds_read_b128 %0, %1 offset:%2" : "=v"(r) : "v"(addr), "n"(OFF));
  return r;
}

template <int NW, bool SWAP>
DEVI void gemm_kloop(int tid_, f32x4 (&acc)[4][NW], const u16* __restrict__ A, int lda, const u16* __restrict__ Bt, int ldb,
                     int K, char* smem) {
  constexpr int STG = 8192 + NW * 2048;
  constexpr int NB = NW / 2;
  const int tid = tid_, lane = tid & 63, wid = tid >> 6;
  const int wr = wid >> 1, wc = wid & 1, fr = lane & 15, fq = lane >> 4;
  const int lrow = lane >> 2, lphys = lane & 3, lhi = lane >> 4;
  const int gsw = (4 - lhi) & 3;
  const u16* ga[2];
  const u16* gb[NB];
#pragma unroll
  for (int q = 0; q < 2; ++q) ga[q] = A + (size_t)((wid * 2 + q) * 16 + lrow) * lda + (lphys ^ gsw) * 8;
#pragma unroll
  for (int q = 0; q < NB; ++q) gb[q] = Bt + (size_t)((wid * NB + q) * 16 + lrow) * ldb + (lphys ^ gsw) * 8;
  const int rsw = (4 - ((fr >> 2) & 3)) & 3;
  const int ch = (fq ^ rsw) * 16;
  const int nk = K >> 5;
  const uint32_t lds_base = (uint32_t)(size_t)(__attribute__((address_space(3))) char*)smem;
  const uint32_t aoff = (uint32_t)((wr * 64 + fr) * 64 + ch);
  const uint32_t boff = (uint32_t)(8192 + (wc * 16 * NW + fr) * 64 + ch);
  asm volatile("s_waitcnt vmcnt(0)" ::: "memory");
  __syncthreads();
#define GEMM_ISSUE(kt_)                                                                                              \
  do {                                                                                                               \
    char* nb_ = smem + ((kt_) & 3) * STG;                                                                            \
    _Pragma("unroll") for (int q = 0; q < 2; ++q) __builtin_amdgcn_global_load_lds(                                  \
        (const unsigned*)(ga[q] + (kt_) * 32),                                                                       \
        (__attribute__((address_space(3))) unsigned*)(nb_ + (wid * 2 + q) * 1024 + lane * 16), 16, 0, 0);            \
    _Pragma("unroll") for (int q = 0; q < NB; ++q) __builtin_amdgcn_global_load_lds(                                 \
        (const unsigned*)(gb[q] + (kt_) * 32),                                                                       \
        (__attribute__((address_space(3))) unsigned*)(nb_ + 8192 + (wid * NB + q) * 1024 + lane * 16), 16, 0, 0);    \
  } while (0)
  GEMM_ISSUE(0);
  if (nk > 1) GEMM_ISSUE(1);
  if (nk > 2) GEMM_ISSUE(2);
  for (int kt = 0; kt < nk; ++kt) {
    if (kt + 2 < nk) {
      if (NW == 4) asm volatile("s_waitcnt vmcnt(8)" ::: "memory");
      else asm volatile("s_waitcnt vmcnt(6)" ::: "memory");
    } else if (kt + 1 < nk) {
      if (NW == 4) asm volatile("s_waitcnt vmcnt(4)" ::: "memory");
      else asm volatile("s_waitcnt vmcnt(3)" ::: "memory");
    } else {
      asm volatile("s_waitcnt vmcnt(0)" ::: "memory");
    }
    __builtin_amdgcn_s_barrier();
    asm volatile("" ::: "memory");
    if (kt + 3 < nk) GEMM_ISSUE(kt + 3);
    const uint32_t sb = lds_base + (kt & 3) * STG;
    bf16x8 af[4], bfr[4];
    af[0] = lds_rd128<0>(sb + aoff); af[1] = lds_rd128<1024>(sb + aoff);
    af[2] = lds_rd128<2048>(sb + aoff); af[3] = lds_rd128<3072>(sb + aoff);
    bfr[0] = lds_rd128<0>(sb + boff); bfr[1] = lds_rd128<1024>(sb + boff);
    if (NW == 4) {
      bfr[2] = lds_rd128<2048>(sb + boff); bfr[3] = lds_rd128<3072>(sb + boff);
      asm volatile("s_waitcnt lgkmcnt(0)" : "+v"(af[0]), "+v"(af[1]), "+v"(af[2]), "+v"(af[3]),
                   "+v"(bfr[0]), "+v"(bfr[1]), "+v"(bfr[2]), "+v"(bfr[3]));
    } else {
      asm volatile("s_waitcnt lgkmcnt(0)" : "+v"(af[0]), "+v"(af[1]), "+v"(af[2]), "+v"(af[3]), "+v"(bfr[0]), "+v"(bfr[1]));
    }
#pragma unroll
    for (int m = 0; m < 4; ++m)
#pragma unroll
      for (int n = 0; n < NW; ++n) {
        if (SWAP) acc[m][n] = __builtin_amdgcn_mfma_f32_16x16x32_bf16(bfr[n], af[m], acc[m][n], 0, 0, 0);
        else acc[m][n] = __builtin_amdgcn_mfma_f32_16x16x32_bf16(af[m], bfr[n], acc[m][n], 0, 0, 0);
      }
  }
#undef GEMM_ISSUE
}

DEVI int launder(int x) { asm volatile("" : "+v"(x)); return x; }

template <int NW>
DEVI void zero_acc(f32x4 (&acc)[4][NW]) {
#pragma unroll
  for (int m = 0; m < 4; ++m)
#pragma unroll
    for (int n = 0; n < NW; ++n) acc[m][n] = (f32x4){0.f, 0.f, 0.f, 0.f};
}

struct NoEpi { DEVI void operator()(int, int, f32x4) const {} };

template <class EpiS, class EpiN>
DEVI void gemm_phase(int tid_, const u16* A, int lda, const u16* Bt, int ldb, int K, int M, int N, char* smem, int ns_from,
                     EpiS epiS, EpiN epiN) {
  const int nN = N >> 7, nM = M >> 7;
  const int lane = tid_ & 63, wid = tid_ >> 6;
  const int wr = wid >> 1, wc = wid & 1, fr = lane & 15, fq = lane >> 4;
  const int xcd = blockIdx.x & 7, jloc = blockIdx.x >> 3, nloc = gridDim.x >> 3;
  for (int lt = jloc; lt < (nM >> 3) * nN; lt += nloc) {
    const int tml = lt / nN, tn = lt - tml * nN;
    const int tm = tml * 8 + xcd;
    const int m0 = tm << 7, n0 = tn << 7;
    f32x4 acc[4][4];
    zero_acc(acc);
    if (n0 < ns_from) {
      gemm_kloop<4, true>(tid_, acc, A + (size_t)m0 * lda, lda, Bt + (size_t)n0 * ldb, ldb, K, smem);
#pragma unroll
      for (int m = 0; m < 4; ++m)
#pragma unroll
        for (int n = 0; n < 4; ++n) epiS(m0 + wr * 64 + m * 16 + fr, n0 + wc * 64 + n * 16 + fq * 4, acc[m][n]);
    } else {
      gemm_kloop<4, false>(tid_, acc, A + (size_t)m0 * lda, lda, Bt + (size_t)n0 * ldb, ldb, K, smem);
#pragma unroll
      for (int m = 0; m < 4; ++m)
#pragma unroll
        for (int n = 0; n < 4; ++n) epiN(m0 + wr * 64 + m * 16 + fq * 4, n0 + wc * 64 + n * 16 + fr, acc[m][n]);
    }
  }
}


template <bool SWAP>
DEVI void gemm_kloop_big(int tid_, f32x4 (&acc)[8][4], const u16* __restrict__ A, int lda, const u16* __restrict__ Bt,
                         int ldb, int K, char* smem) {
  constexpr int STG = 16384 + 8192;
  const int tid = tid_, lane = tid & 63, wid = tid >> 6;
  const int wr = wid >> 1, wc = wid & 1, fr = lane & 15, fq = lane >> 4;
  const int lrow = lane >> 2, lphys = lane & 3, lhi = lane >> 4;
  const int gsw = (4 - lhi) & 3;
  const u16* ga = A + (size_t)(wid * 64 + lrow) * lda + (lphys ^ gsw) * 8;
  const u16* gb = Bt + (size_t)(wid * 32 + lrow) * ldb + (lphys ^ gsw) * 8;
  const size_t a16 = (size_t)16 * lda, b16 = (size_t)16 * ldb;
  const int rsw = (4 - ((fr >> 2) & 3)) & 3;
  const int ch = (fq ^ rsw) * 16;
  const int nk = K >> 5;
  const uint32_t lds_base = (uint32_t)(size_t)(__attribute__((address_space(3))) char*)smem;
  const uint32_t aoff = (uint32_t)((wr * 128 + fr) * 64 + ch);
  const uint32_t boff = (uint32_t)(16384 + (wc * 64 + fr) * 64 + ch);
  asm volatile("s_waitcnt vmcnt(0)" ::: "memory");
  __syncthreads();
#define GEMMB_ISSUE(kt_, buf_)                                                                                       \
  do {                                                                                                               \
    char* nb_ = smem + (buf_) * STG;                                                                                 \
    _Pragma("unroll") for (int q = 0; q < 4; ++q) __builtin_amdgcn_global_load_lds(                                  \
        (const unsigned*)(ga + q * a16 + (kt_) * 32),                                                                \
        (__attribute__((address_space(3))) unsigned*)(nb_ + (wid * 4 + q) * 1024 + lane * 16), 16, 0, 0);            \
    _Pragma("unroll") for (int q = 0; q < 2; ++q) __builtin_amdgcn_global_load_lds(                                  \
        (const unsigned*)(gb + q * b16 + (kt_) * 32),                                                                \
        (__attribute__((address_space(3))) unsigned*)(nb_ + 16384 + (wid * 2 + q) * 1024 + lane * 16), 16, 0, 0);   \
  } while (0)
  GEMMB_ISSUE(0, 0);
  if (nk > 1) GEMMB_ISSUE(1, 1);
  int cb = 0;
  for (int kt = 0; kt < nk; ++kt) {
    if (kt + 1 < nk) asm volatile("s_waitcnt vmcnt(6)" ::: "memory");
    else asm volatile("s_waitcnt vmcnt(0)" ::: "memory");
    __builtin_amdgcn_s_barrier();
    asm volatile("" ::: "memory");
    const int nbuf = (cb == 0) ? 2 : cb - 1;
    if (kt + 2 < nk) GEMMB_ISSUE(kt + 2, nbuf);
    const uint32_t sb = lds_base + cb * STG;
    bf16x8 a0[4], a1[4], bb[4];
    a0[0] = lds_rd128<0>(sb + aoff); a0[1] = lds_rd128<1024>(sb + aoff);
    a0[2] = lds_rd128<2048>(sb + aoff); a0[3] = lds_rd128<3072>(sb + aoff);
    bb[0] = lds_rd128<0>(sb + boff); bb[1] = lds_rd128<1024>(sb + boff);
    bb[2] = lds_rd128<2048>(sb + boff); bb[3] = lds_rd128<3072>(sb + boff);
    a1[0] = lds_rd128<4096>(sb + aoff); a1[1] = lds_rd128<5120>(sb + aoff);
    a1[2] = lds_rd128<6144>(sb + aoff); a1[3] = lds_rd128<7168>(sb + aoff);
    asm volatile("s_waitcnt lgkmcnt(4)" : "+v"(a0[0]), "+v"(a0[1]), "+v"(a0[2]), "+v"(a0[3]),
                 "+v"(bb[0]), "+v"(bb[1]), "+v"(bb[2]), "+v"(bb[3]));
#pragma unroll
    for (int m = 0; m < 4; ++m)
#pragma unroll
      for (int n = 0; n < 4; ++n) {
        if (SWAP) acc[m][n] = __builtin_amdgcn_mfma_f32_16x16x32_bf16(bb[n], a0[m], acc[m][n], 0, 0, 0);
        else acc[m][n] = __builtin_amdgcn_mfma_f32_16x16x32_bf16(a0[m], bb[n], acc[m][n], 0, 0, 0);
      }
    asm volatile("s_waitcnt lgkmcnt(0)" : "+v"(a1[0]), "+v"(a1[1]), "+v"(a1[2]), "+v"(a1[3]));
#pragma unroll
    for (int m = 0; m < 4; ++m)
#pragma unroll
      for (int n = 0; n < 4; ++n) {
        if (SWAP) acc[4 + m][n] = __builtin_amdgcn_mfma_f32_16x16x32_bf16(bb[n], a1[m], acc[4 + m][n], 0, 0, 0);
        else acc[4 + m][n] = __builtin_amdgcn_mfma_f32_16x16x32_bf16(a1[m], bb[n], acc[4 + m][n], 0, 0, 0);
      }
    cb = (cb == 2) ? 0 : cb + 1;
  }
#undef GEMMB_ISSUE
}

template <class EpiS, class EpiN>
DEVI void gemm_phase_big(int tid_, const u16* A, int lda, const u16* Bt, int ldb, int K, int M, int N, char* smem,
                         int ns_from, EpiS epiS, EpiN epiN) {
  const int nN = N >> 7, nM = M >> 8;
  const int lane = tid_ & 63, wid = tid_ >> 6;
  const int wr = wid >> 1, wc = wid & 1, fr = lane & 15, fq = lane >> 4;
  const int xcd = blockIdx.x & 7, jloc = blockIdx.x >> 3, nloc = gridDim.x >> 3;
  for (int lt = jloc; lt < (nM >> 3) * nN; lt += nloc) {
    const int tml = lt / nN, tn = lt - tml * nN;
    const int tm = tml * 8 + xcd;
    const int m0 = tm << 8, n0 = tn << 7;
    f32x4 acc[8][4];
#pragma unroll
    for (int m = 0; m < 8; ++m)
#pragma unroll
      for (int n = 0; n < 4; ++n) acc[m][n] = (f32x4){0.f, 0.f, 0.f, 0.f};
    if (n0 < ns_from) {
      gemm_kloop_big<true>(launder(tid_), acc, A + (size_t)m0 * lda, lda, Bt + (size_t)n0 * ldb, ldb, K, smem);
#pragma unroll
      for (int m = 0; m < 8; ++m)
#pragma unroll
        for (int n = 0; n < 4; ++n) epiS(m0 + wr * 128 + m * 16 + fr, n0 + wc * 64 + n * 16 + fq * 4, acc[m][n]);
    } else {
      gemm_kloop_big<false>(launder(tid_), acc, A + (size_t)m0 * lda, lda, Bt + (size_t)n0 * ldb, ldb, K, smem);
#pragma unroll
      for (int m = 0; m < 8; ++m)
#pragma unroll
        for (int n = 0; n < 4; ++n) epiN(m0 + wr * 128 + m * 16 + fq * 4, n0 + wc * 64 + n * 16 + fr, acc[m][n]);
    }
  }
}


template <bool SWAP>
DEVI void gemm_kloop8(int tid_, f32x4 (&acc)[8][4], const u16* __restrict__ A, int lda, const u16* __restrict__ Bt,
                      int ldb, int K, char* smem) {
  constexpr int STG = 65536;
  const int tid = tid_, lane = tid & 63, wid = tid >> 6;
  const int wr = wid >> 2, wc = wid & 3, fr = lane & 15, fq = lane >> 4;
  const int lrow = lane >> 3, lphys = lane & 7, lhi = lane >> 4;
  const u16* ga[4];
  const u16* gb[4];
#pragma unroll
  for (int q = 0; q < 4; ++q) {
    const int kc = lphys ^ ((4 * (q & 1) + lhi) & 7);
    ga[q] = A + (size_t)((wid * 4 + q) * 8 + lrow) * lda + kc * 8;
    gb[q] = Bt + (size_t)((wid * 4 + q) * 8 + lrow) * ldb + kc * 8;
  }
  const int swz = (fr >> 1) & 7;
  const int nk = K >> 6;
  const uint32_t lds_base = (uint32_t)(size_t)(__attribute__((address_space(3))) char*)smem;
  const uint32_t arow = (uint32_t)((wr * 128 + fr) * 128);
  const uint32_t brow = (uint32_t)(32768 + (wc * 64 + fr) * 128);
  asm volatile("s_waitcnt vmcnt(0)" ::: "memory");
  __syncthreads();
#define GEMM8_ISSUE(kt_)                                                                                             \
  do {                                                                                                               \
    char* nb_ = smem + ((kt_) & 1) * STG;                                                                            \
    _Pragma("unroll") for (int q = 0; q < 4; ++q) __builtin_amdgcn_global_load_lds(                                  \
        (const unsigned*)(ga[q] + (kt_) * 64),                                                                       \
        (__attribute__((address_space(3))) unsigned*)(nb_ + (wid * 4 + q) * 1024 + lane * 16), 16, 0, 0);            \
    _Pragma("unroll") for (int q = 0; q < 4; ++q) __builtin_amdgcn_global_load_lds(                                  \
        (const unsigned*)(gb[q] + (kt_) * 64),                                                                       \
        (__attribute__((address_space(3))) unsigned*)(nb_ + 32768 + (wid * 4 + q) * 1024 + lane * 16), 16, 0, 0);    \
  } while (0)
  GEMM8_ISSUE(0);
  for (int kt = 0; kt < nk; ++kt) {
    asm volatile("s_waitcnt vmcnt(0)" ::: "memory");
    __builtin_amdgcn_s_barrier();
    asm volatile("" ::: "memory");
    if (kt + 1 < nk) GEMM8_ISSUE(kt + 1);
    const uint32_t sb = lds_base + (kt & 1) * STG;
#pragma unroll
    for (int ks = 0; ks < 2; ++ks) {
      const uint32_t chb = (uint32_t)(((ks * 4 + fq) ^ swz) * 16);
      const uint32_t aoff = sb + arow + chb, boff = sb + brow + chb;
      bf16x8 a0[4], a1[4], bb[4];
      a0[0] = lds_rd128<0>(aoff); a0[1] = lds_rd128<2048>(aoff);
      a0[2] = lds_rd128<4096>(aoff); a0[3] = lds_rd128<6144>(aoff);
      bb[0] = lds_rd128<0>(boff); bb[1] = lds_rd128<2048>(boff);
      bb[2] = lds_rd128<4096>(boff); bb[3] = lds_rd128<6144>(boff);
      a1[0] = lds_rd128<8192>(aoff); a1[1] = lds_rd128<10240>(aoff);
      a1[2] = lds_rd128<12288>(aoff); a1[3] = lds_rd128<14336>(aoff);
      asm volatile("s_waitcnt lgkmcnt(4)" : "+v"(a0[0]), "+v"(a0[1]), "+v"(a0[2]), "+v"(a0[3]),
                   "+v"(bb[0]), "+v"(bb[1]), "+v"(bb[2]), "+v"(bb[3]));
#pragma unroll
      for (int m = 0; m < 4; ++m)
#pragma unroll
        for (int n = 0; n < 4; ++n) {
          if (SWAP) acc[m][n] = __builtin_amdgcn_mfma_f32_16x16x32_bf16(bb[n], a0[m], acc[m][n], 0, 0, 0);
          else acc[m][n] = __builtin_amdgcn_mfma_f32_16x16x32_bf16(a0[m], bb[n], acc[m][n], 0, 0, 0);
        }
      asm volatile("s_waitcnt lgkmcnt(0)" : "+v"(a1[0]), "+v"(a1[1]), "+v"(a1[2]), "+v"(a1[3]));
#pragma unroll
      for (int m = 0; m < 4; ++m)
#pragma unroll
        for (int n = 0; n < 4; ++n) {
          if (SWAP) acc[4 + m][n] = __builtin_amdgcn_mfma_f32_16x16x32_bf16(bb[n], a1[m], acc[4 + m][n], 0, 0, 0);
          else acc[4 + m][n] = __builtin_amdgcn_mfma_f32_16x16x32_bf16(a1[m], bb[n], acc[4 + m][n], 0, 0, 0);
        }
    }
  }
#undef GEMM8_ISSUE
}

struct NoRow { DEVI void operator()(int) const {} };

template <class EpiS, class EpiN, class RowEnd = NoRow>
DEVI void gemm_phase8(int tid_, const u16* A, int lda, const u16* Bt, int ldb, int K, int M, int N, char* smem,
                      int ns_from, EpiS epiS, EpiN epiN, RowEnd rowEnd = NoRow()) {
  const int nN = (N + 255) >> 8, nM = M >> 8;
  const int lane = tid_ & 63, wid = tid_ >> 6;
  const int wr = wid >> 2, wc = wid & 3, fr = lane & 15, fq = lane >> 4;
  const bool xmap = ((gridDim.x & 7) == 0) && ((nM & 7) == 0);
  const int xcd = blockIdx.x & 7;
  const int first = xmap ? (int)(blockIdx.x >> 3) : (int)blockIdx.x;
  const int stride = xmap ? (int)(gridDim.x >> 3) : (int)gridDim.x;
  const int count = xmap ? (nM >> 3) * nN : nM * nN;
  for (int it = first; it < count; it += stride) {
    const int tq = it / nN, tn = it - tq * nN;
    const int tm = xmap ? tq * 8 + xcd : tq;
    const int m0 = tm << 8, n0 = tn << 8;
    const int colb = n0 + wc * 64;
    f32x4 acc[8][4];
#pragma unroll
    for (int m = 0; m < 8; ++m)
#pragma unroll
      for (int n = 0; n < 4; ++n) acc[m][n] = (f32x4){0.f, 0.f, 0.f, 0.f};
    if (colb < ns_from) {
      gemm_kloop8<true>(launder(tid_), acc, A + (size_t)m0 * lda, lda, Bt + (size_t)n0 * ldb, ldb, K, smem);
      if (colb < N) {
#pragma unroll
        for (int m = 0; m < 8; ++m) {
#pragma unroll
          for (int n = 0; n < 4; ++n) epiS(m0 + wr * 128 + m * 16 + fr, colb + n * 16 + fq * 4, acc[m][n]);
          rowEnd(m0 + wr * 128 + m * 16 + fr);
        }
      }
    } else {
      gemm_kloop8<false>(launder(tid_), acc, A + (size_t)m0 * lda, lda, Bt + (size_t)n0 * ldb, ldb, K, smem);
      if (colb < N) {
#pragma unroll
        for (int m = 0; m < 8; ++m)
#pragma unroll
          for (int n = 0; n < 4; ++n) epiN(m0 + wr * 128 + m * 16 + fq * 4, colb + n * 16 + fr, acc[m][n]);
      }
    }
  }
}

DEVI void store4bf(u16* dst, f32x4 v) {
  u32x2 o;
  o.x = pack2(v[0], v[1]); o.y = pack2(v[2], v[3]);
  *(u32x2*)dst = o;
}

DEVI float rstd_of(const float* ssq, int r) { return rsqrtf(ssq[r] * (1.f / 1024.f) + 1e-6f); }

DEVI void phase_p_gemm(int tid_, const Params& p, char* smem, const float* ssq) {
  u16* WB = (u16*)(p.ws + OFF_WB);
  const u16* H = (const u16*)(p.ws + OFF_H);
  u16* PR = (u16*)(p.ws + OFF_PR);
  u16* NQ = (u16*)(p.ws + OFF_NQ);
  u16* NK = (u16*)(p.ws + OFF_NK);
  u16* NVT = (u16*)(p.ws + OFF_NV);
  gemm_phase8(tid_, H, 1024, WB + W_IN, 1024, 1024, NTOK, 3456, smem, 2944,
    [&](int r, int c0, f32x4 v) {
      v = v * rstd_of(ssq, r);
      if (c0 < 1920) store4bf(PR + (size_t)r * PRW + c0, v);
      else if (c0 < 2432) store4bf(NQ + (size_t)r * 512 + (c0 - 1920), v);
      else store4bf(NK + (size_t)r * 512 + (c0 - 2432), v);
    },
    [&](int r0, int c, f32x4 v) {
      const int cc = c - 2944;
      const int s = r0 >> 12, t = r0 & 4095;
      const f32x4 q = *(const f32x4*)(ssq + r0);
#pragma unroll
      for (int j = 0; j < 4; ++j) v[j] *= rsqrtf(q[j] * (1.f / 1024.f) + 1e-6f);
      store4bf(NVT + ((size_t)(s * 512 + cc)) * 4096 + t, v);
    });
  const u16* MH = (const u16*)(p.ws + OFF_MEMH);
  u16* KVK = (u16*)(p.ws + OFF_KVK);
  u16* KVT = (u16*)(p.ws + OFF_KVT);
  gemm_phase8(tid_, MH, 1024, WB + W_XKV, 1024, 1024, 3072, 2048, smem, 1024,
    [&](int r, int c0, f32x4 v) { store4bf(KVK + (size_t)r * 1024 + c0, v); },
    [&](int r0, int c, f32x4 v) {
      const int cc = c - 1024;
      const int s = r0 >> 8, m = r0 & 255;
      store4bf(KVT + ((size_t)(s * 1024 + cc)) * 256 + m, v);
    });
}

DEVI void phase_nat(int tid_, const Params& p, int l, char* smem, int bfirst, int bstride) {
  u16* NQ = (u16*)(p.ws + OFF_NQ);
  const u16* NK = (const u16*)(p.ws + OFF_NK);
  const u16* NVT = (const u16*)(p.ws + OFF_NV);
  const float* rpb = p.in[I_RPB] + (size_t)l * 8 * 15 * 31;
  const int lane = tid_ & 63, g = tid_ >> 6, fr = lane & 15, fq = lane >> 4;
  u16* Pw = (u16*)smem + g * (16 * 264);
  const int cb = (g == 0) ? 0 : (g == 1) ? 8 : (g == 2) ? 24 : 32;
  const int c = g * 16 + fr;
  int cs = c - 8; cs = cs < 0 ? 0 : (cs > 48 ? 48 : cs);
  for (int t = bfirst; t < 12 * 64 * 8; t += bstride) {
    const int h = t & 7, ri = (t >> 3) & 63, s = t >> 9;
    int rs = ri - 4; rs = rs < 0 ? 0 : (rs > 56 ? 56 : rs);
    const size_t tokq = (size_t)s * 4096 + ri * 64 + g * 16;
    bf16x8 aq[2];
    aq[0] = *(const bf16x8*)(NQ + (tokq + fr) * 512 + h * 64 + fq * 8);
    aq[1] = *(const bf16x8*)(NQ + (tokq + fr) * 512 + h * 64 + 32 + fq * 8);
    f32x4 acc[16];
#pragma unroll
    for (int n = 0; n < 16; ++n) {
      acc[n] = (f32x4){0.f, 0.f, 0.f, 0.f};
      const int r = n >> 1, col = cb + (n & 1) * 16 + fr;
      const u16* kp = NK + ((size_t)s * 4096 + (rs + r) * 64 + col) * 512 + h * 64 + fq * 8;
      const bf16x8 b0 = *(const bf16x8*)kp;
      const bf16x8 b1 = *(const bf16x8*)(kp + 32);
      acc[n] = __builtin_amdgcn_mfma_f32_16x16x32_bf16(b0, aq[0], acc[n], 0, 0, 0);
      acc[n] = __builtin_amdgcn_mfma_f32_16x16x32_bf16(b1, aq[1], acc[n], 0, 0, 0);
    }
    float m = -1e30f;
#pragma unroll
    for (int n = 0; n < 16; ++n) {
      const int di = rs + (n >> 1) - ri + 7;
      const float* brow = rpb + (h * 15 + di) * 31 + 15 - c;
#pragma unroll
      for (int j = 0; j < 4; ++j) {
        const int kc = cb + (n & 1) * 16 + fq * 4 + j;
        float sc = -1e30f;
        if (kc >= cs && kc < cs + 16) sc = acc[n][j] * 0.125f + brow[kc];
        acc[n][j] = sc;
        m = fmaxf(m, sc);
      }
    }
    m = red4x_max(m);
    float ssum = 0.f;
#pragma unroll
    for (int n = 0; n < 16; ++n) {
      f32x4 e;
#pragma unroll
      for (int j = 0; j < 4; ++j) { e[j] = __expf(acc[n][j] - m); ssum += e[j]; }
      store4bf(Pw + fr * 264 + n * 16 + fq * 4, e);
    }
    const float sm = 1.f / red4x_sum(ssum);
    f32x4 o[4];
#pragma unroll
    for (int n = 0; n < 4; ++n) o[n] = (f32x4){0.f, 0.f, 0.f, 0.f};
#pragma unroll
    for (int ks = 0; ks < 8; ++ks) {
      const bf16x8 ap = *(const bf16x8*)(Pw + fr * 264 + ks * 32 + fq * 8);
#pragma unroll
      for (int n = 0; n < 4; ++n) {
        const bf16x8 bv = *(const bf16x8*)(NVT + ((size_t)(s * 512 + h * 64 + n * 16 + fr)) * 4096 + (rs + ks) * 64 + cb + fq * 8);
        o[n] = __builtin_amdgcn_mfma_f32_16x16x32_bf16(bv, ap, o[n], 0, 0, 0);
      }
    }
#pragma unroll
    for (int n = 0; n < 4; ++n) store4bf(NQ + (tokq + fr) * 512 + h * 64 + n * 16 + fq * 4, o[n] * sm);
  }
}

constexpr int SC_OPS = 0;
constexpr int SC_VV = 40960;
constexpr int SC_WR = 49152;
constexpr int SC_AP = 57344;
constexpr int SC_TW = 65536;
constexpr int SC_AD = 70144;
constexpr int SC_NRM = 74752;
constexpr int SC_MU = 74880;
constexpr int SC_CST = 77440;

typedef __attribute__((ext_vector_type(2))) float f32x2;

template <int CTRL>
DEVI float dpp_mov(float x) {
  return __int_as_float(__builtin_amdgcn_update_dpp(0, __float_as_int(x), CTRL, 0xF, 0xF, true));
}
DEVI float red8(float x) {
  x += dpp_mov<0xB1>(x);
  x += dpp_mov<0x4E>(x);
  x += dpp_mov<0x141>(x);
  return x;
}
DEVI f32x2 lo2(f32x4 v) { return __builtin_shufflevector(v, v, 0, 1); }
DEVI f32x2 hi2(f32x4 v) { return __builtin_shufflevector(v, v, 2, 3); }

struct ScanOps {
  f32x2 a[4], w[4], b[4], k[4], r[4];
  float v0, v1;
};
DEVI void scan_load(ScanOps& o, const float* OPS, const float* VV, int nn, int jg, int i0) {
  const float* base = OPS + nn * 64 + jg * 8;
  f32x4 t0, t1;
  t0 = *(const f32x4*)(base); t1 = *(const f32x4*)(base + 4);
  o.a[0] = lo2(t0); o.a[1] = hi2(t0); o.a[2] = lo2(t1); o.a[3] = hi2(t1);
  t0 = *(const f32x4*)(base + 2048); t1 = *(const f32x4*)(base + 2048 + 4);
  o.w[0] = lo2(t0); o.w[1] = hi2(t0); o.w[2] = lo2(t1); o.w[3] = hi2(t1);
  t0 = *(const f32x4*)(base + 4096); t1 = *(const f32x4*)(base + 4096 + 4);
  o.b[0] = lo2(t0); o.b[1] = hi2(t0); o.b[2] = lo2(t1); o.b[3] = hi2(t1);
  t0 = *(const f32x4*)(base + 6144); t1 = *(const f32x4*)(base + 6144 + 4);
  o.k[0] = lo2(t0); o.k[1] = hi2(t0); o.k[2] = lo2(t1); o.k[3] = hi2(t1);
  t0 = *(const f32x4*)(base + 8192); t1 = *(const f32x4*)(base + 8192 + 4);
  o.r[0] = lo2(t0); o.r[1] = hi2(t0); o.r[2] = lo2(t1); o.r[3] = hi2(t1);
  o.v0 = VV[nn * 64 + i0];
  o.v1 = VV[nn * 64 + i0 + 8];
}
DEVI void scan_step(const ScanOps& o, f32x2 (&S0)[4], f32x2 (&S1)[4], float* YL, int nn, int jg, int i0) {
  f32x2 d0 = S0[0] * o.a[0], d0b = S0[2] * o.a[2];
  f32x2 d1 = S1[0] * o.a[0], d1b = S1[2] * o.a[2];
  d0 = S0[1] * o.a[1] + d0; d0b = S0[3] * o.a[3] + d0b;
  d1 = S1[1] * o.a[1] + d1; d1b = S1[3] * o.a[3] + d1b;
  d0 += d0b; d1 += d1b;
  const float sa0 = red8(d0.x + d0.y);
  const float sa1 = red8(d1.x + d1.y);
  f32x2 e0 = {0.f, 0.f}, e1 = {0.f, 0.f};
#pragma unroll
  for (int q = 0; q < 4; ++q) {
    const f32x2 u0 = sa0 * o.b[q] + o.v0 * o.k[q];
    const f32x2 u1 = sa1 * o.b[q] + o.v1 * o.k[q];
    S0[q] = S0[q] * o.w[q] + u0;
    S1[q] = S1[q] * o.w[q] + u1;
    e0 = S0[q] * o.r[q] + e0;
    e1 = S1[q] * o.r[q] + e1;
  }
  const float y0 = red8(e0.x + e0.y);
  const float y1 = red8(e1.x + e1.y);
  YL[nn * 64 + i0] = y0; YL[nn * 64 + i0 + 8] = y1;
}

DEVI void phase_scan(int tid_, const Params& p, int l, char* smem, int bfirst, int bstride) {
  const u16* PR = (const u16*)(p.ws + OFF_PR);
  _Float16* YF = (_Float16*)(p.ws + OFF_H);
  _Float16* YB = (_Float16*)(p.ws + OFF_H + (size_t)NTOK * 512 * 2);
  float* BON = (float*)(p.ws + OFF_BONUS);
  const u16* WB = (const u16*)(p.ws + OFF_WB);
  float* OPS = (float*)(smem + SC_OPS);
  u16* RAW = (u16*)(smem + SC_OPS);
  float* VV = (float*)(smem + SC_VV);
  float* WR = (float*)(smem + SC_WR);
  float* AP = (float*)(smem + SC_AP);
  float* YL = WR;
  u16* TWb = (u16*)(smem + SC_TW);
  u16* ADb = (u16*)(smem + SC_AD);
  float* NRM = (float*)(smem + SC_NRM);
  float* MU = (float*)(smem + SC_MU);
  float* CST = (float*)(smem + SC_CST);
  const float* mu_p = p.in[I_MU_PREV] + (size_t)l * 1920;
  const float* mu_n = p.in[I_MU_NEXT] + (size_t)l * 1920;
  const int tid = tid_, lane = tid & 63, w = tid >> 6, fr = lane & 15, fq = lane >> 4;
  const int pn = tid >> 3, j0 = (tid & 7) * 8;
  const int jg = lane & 7, i0 = w * 16 + (lane >> 3);
  const int hr = (tid >= 40) ? 1 : 0, hc = tid - hr * 40;
  for (int blk = bfirst; blk < 192; blk += bstride) {
    const int s = blk >> 4, h = (blk >> 1) & 7, d = blk & 1;
    __syncthreads();
    for (int i = tid; i < 640; i += 256) {
      const int which = (i >= 320) ? 1 : 0, c = i - which * 320;
      const int g = c >> 6, e = c & 63;
      const int col = (g < 3) ? (g * 512 + h * 64 + e) : (1536 + (g - 3) * 128 + d * 64 + e);
      MU[i] = which ? mu_n[col] : mu_p[col];
    }
    for (int i = tid; i < 320; i += 256) {
      const int which = i >> 6, e = i & 63;
      float v;
      if (which == 0) v = p.in[I_W0][(size_t)(l * 2 + d) * 512 + h * 64 + e];
      else if (which == 1) v = p.in[I_A0][(size_t)(l * 2 + d) * 512 + h * 64 + e];
      else if (which == 2) v = p.in[I_K_K][(size_t)l * 512 + h * 64 + e];
      else if (which == 3) v = p.in[I_K_A][(size_t)l * 512 + h * 64 + e];
      else v = p.in[I_R_K][(size_t)(l * 8 + h) * 64 + e];
      CST[i] = v;
    }
    bf16x8 bw[2], ba[2];
#pragma unroll
    for (int ks = 0; ks < 2; ++ks) {
      bw[ks] = *(const bf16x8*)(WB + W_WUP + (size_t)(d * 512 + h * 64 + w * 16 + fr) * 64 + ks * 32 + fq * 8);
      ba[ks] = *(const bf16x8*)(WB + W_AUP + (size_t)(d * 512 + h * 64 + w * 16 + fr) * 64 + ks * 32 + fq * 8);
    }
    _Float16* Y = d ? YB : YF;
    f32x2 S0[4], S1[4];
#pragma unroll
    for (int q = 0; q < 4; ++q) { S0[q] = (f32x2){0.f, 0.f}; S1[q] = (f32x2){0.f, 0.f}; }
    u32x4 G[5], GH;
    {
      const int t = d ? (4095 - pn) : pn;
      const size_t tok = (size_t)s * 4096 + t;
#pragma unroll
      for (int g = 0; g < 5; ++g) {
        const int col = (g < 3) ? (g * 512 + h * 64) : (1536 + (g - 3) * 128 + d * 64);
        G[g] = *(const u32x4*)(PR + tok * PRW + col + j0);
      }
      GH = (u32x4){0u, 0u, 0u, 0u};
      if (tid < 80) {
        const int tlo = d ? (4095 - 31) : 0;
        const int th = hr ? (tlo + 32) : (tlo - 1);
        const int g = hc >> 3;
        const int col = (g < 3) ? (g * 512 + h * 64) : (1536 + (g - 3) * 128 + d * 64);
        if (th >= 0 && th <= 4095) GH = *(const u32x4*)(PR + ((size_t)s * 4096 + th) * PRW + col + (hc & 7) * 8);
      }
    }
#pragma unroll 1
    for (int ch = 0; ch < 128; ++ch) {
      const int n = ch * 32 + pn;
      const int t = d ? (4095 - n) : n;
      const size_t tok = (size_t)s * 4096 + t;
      const int tlo = d ? (4095 - (ch * 32 + 31)) : (ch * 32);
      const int rrow = t - tlo + 1;
#pragma unroll
      for (int g = 0; g < 5; ++g) *(u32x4*)(RAW + rrow * 320 + g * 64 + j0) = G[g];
      if (tid < 80) *(u32x4*)(RAW + (hr ? 33 : 0) * 320 + (hc >> 3) * 64 + (hc & 7) * 8) = GH;
      __syncthreads();
      if (ch + 1 < 128) {
        const int n2 = n + 32;
        const int t2 = d ? (4095 - n2) : n2;
        const size_t tok2 = (size_t)s * 4096 + t2;
#pragma unroll
        for (int g = 0; g < 5; ++g) {
          const int col = (g < 3) ? (g * 512 + h * 64) : (1536 + (g - 3) * 128 + d * 64);
          G[g] = *(const u32x4*)(PR + tok2 * PRW + col + j0);
        }
        GH = (u32x4){0u, 0u, 0u, 0u};
        if (tid < 80) {
          const int tlo2 = d ? (tlo - 32) : (tlo + 32);
          const int th = hr ? (tlo2 + 32) : (tlo2 - 1);
          const int g = hc >> 3;
          const int col = (g < 3) ? (g * 512 + h * 64) : (1536 + (g - 3) * 128 + d * 64);
          if (th >= 0 && th <= 4095) GH = *(const u32x4*)(PR + ((size_t)s * 4096 + th) * PRW + col + (hc & 7) * 8);
        }
      }
#pragma unroll
      for (int g = 0; g < 5; ++g) {
        float cur[8], prv[8], nxt[8];
        load8bf(RAW + rrow * 320 + g * 64 + j0, cur);
        load8bf(RAW + (rrow - 1) * 320 + g * 64 + j0, prv);
        load8bf(RAW + (rrow + 1) * 320 + g * 64 + j0, nxt);
        const f32x4 mp0 = *(const f32x4*)(MU + g * 64 + j0), mp1 = *(const f32x4*)(MU + g * 64 + j0 + 4);
        const f32x4 mn0 = *(const f32x4*)(MU + 320 + g * 64 + j0), mn1 = *(const f32x4*)(MU + 320 + g * 64 + j0 + 4);
        f32x4 x0, x1;
#pragma unroll
        for (int e = 0; e < 4; ++e) {
          x0[e] = cur[e] + mp0[e] * (prv[e] - cur[e]) + mn0[e] * (nxt[e] - cur[e]);
          x1[e] = cur[4 + e] + mp1[e] * (prv[4 + e] - cur[4 + e]) + mn1[e] * (nxt[4 + e] - cur[4 + e]);
        }
        if (g == 0) {
          *(f32x4*)(OPS + 4 * 2048 + pn * 64 + j0) = x0; *(f32x4*)(OPS + 4 * 2048 + pn * 64 + j0 + 4) = x1;
        } else if (g == 1) {
          *(f32x4*)(OPS + 3 * 2048 + pn * 64 + j0) = x0; *(f32x4*)(OPS + 3 * 2048 + pn * 64 + j0 + 4) = x1;
          const f32x4 kk0 = *(const f32x4*)(CST + 128 + j0), kk1 = *(const f32x4*)(CST + 128 + j0 + 4);
          float ss = 0.f;
#pragma unroll
          for (int e = 0; e < 4; ++e) { const float a_ = x0[e] * kk0[e], b_ = x1[e] * kk1[e]; ss += a_ * a_ + b_ * b_; }
          ss = red8(ss);
          if ((tid & 7) == 0) NRM[pn] = frcp(fmaxf(__builtin_amdgcn_sqrtf(ss), 1e-12f));
        } else if (g == 2) {
          *(f32x4*)(VV + pn * 64 + j0) = x0; *(f32x4*)(VV + pn * 64 + j0 + 4) = x1;
        } else if (g == 3) {
          u32x4 pk;
          pk.x = pack2(ftanh(x0[0]), ftanh(x0[1])); pk.y = pack2(ftanh(x0[2]), ftanh(x0[3]));
          pk.z = pack2(ftanh(x1[0]), ftanh(x1[1])); pk.w = pack2(ftanh(x1[2]), ftanh(x1[3]));
          *(u32x4*)(TWb + pn * 72 + j0) = pk;
        } else {
          u32x4 pk;
          pk.x = pack2(x0[0], x0[1]); pk.y = pack2(x0[2], x0[3]);
          pk.z = pack2(x1[0], x1[1]); pk.w = pack2(x1[2], x1[3]);
          *(u32x4*)(ADb + pn * 72 + j0) = pk;
        }
      }
      __syncthreads();
#pragma unroll
      for (int m = 0; m < 2; ++m) {
        f32x4 cw = {0.f, 0.f, 0.f, 0.f}, ca = {0.f, 0.f, 0.f, 0.f};
#pragma unroll
        for (int ks = 0; ks < 2; ++ks) {
          const bf16x8 aw = *(const bf16x8*)(TWb + (m * 16 + fr) * 72 + ks * 32 + fq * 8);
          const bf16x8 aa = *(const bf16x8*)(ADb + (m * 16 + fr) * 72 + ks * 32 + fq * 8);
          cw = __builtin_amdgcn_mfma_f32_16x16x32_bf16(aw, bw[ks], cw, 0, 0, 0);
          ca = __builtin_amdgcn_mfma_f32_16x16x32_bf16(aa, ba[ks], ca, 0, 0, 0);
        }
#pragma unroll
        for (int jj = 0; jj < 4; ++jj) {
          WR[(m * 16 + fq * 4 + jj) * 64 + w * 16 + fr] = cw[jj];
          AP[(m * 16 + fq * 4 + jj) * 64 + w * 16 + fr] = ca[jj];
        }
      }
      __syncthreads();
      {
        const float inv = NRM[pn];
        float bsum = 0.f;
#pragma unroll
        for (int hq = 0; hq < 2; ++hq) {
          const int jb = j0 + hq * 4;
          const f32x4 wr_ = *(const f32x4*)(WR + pn * 64 + jb) + *(const f32x4*)(CST + jb);
          const f32x4 ap_ = *(const f32x4*)(AP + pn * 64 + jb) + *(const f32x4*)(CST + 64 + jb);
          const f32x4 kr = *(const f32x4*)(OPS + 3 * 2048 + pn * 64 + jb);
          const f32x4 rr = *(const f32x4*)(OPS + 4 * 2048 + pn * 64 + jb);
          const f32x4 kkw = *(const f32x4*)(CST + 128 + jb), kaw = *(const f32x4*)(CST + 192 + jb), rkw = *(const f32x4*)(CST + 256 + jb);
          f32x4 o0, o1, o2, o3;
#pragma unroll
          for (int e = 0; e < 4; ++e) {
            const float sw = sigm(wr_[e]);
            const float dec = __expf(-0.6065306597126334f * sw);
            const float av = sigm(ap_[e]);
            const float kn = kr[e] * kkw[e] * inv;
            const float kd = kr[e] * (1.f + (av - 1.f) * kaw[e]);
            bsum += rr[e] * kd * rkw[e];
            o0[e] = -kn; o1[e] = dec; o2[e] = kn * av; o3[e] = kd;
          }
          *(f32x4*)(OPS + 0 * 2048 + pn * 64 + jb) = o0;
          *(f32x4*)(OPS + 1 * 2048 + pn * 64 + jb) = o1;
          *(f32x4*)(OPS + 2 * 2048 + pn * 64 + jb) = o2;
          *(f32x4*)(OPS + 3 * 2048 + pn * 64 + jb) = o3;
        }
        bsum = red8(bsum);
        if ((tid & 7) == 0) BON[(tok * 8 + h) * 2 + d] = bsum;
      }
      __syncthreads();
      {
        ScanOps oa, ob;
        scan_load(oa, OPS, VV, 0, jg, i0);
#pragma unroll 1
        for (int nn = 0; nn < 32; nn += 2) {
          scan_load(ob, OPS, VV, nn + 1, jg, i0);
          scan_step(oa, S0, S1, YL, nn, jg, i0);
          scan_load(oa, OPS, VV, (nn + 2) & 31, jg, i0);
          scan_step(ob, S0, S1, YL, nn + 1, jg, i0);
        }
      }
      __syncthreads();
      {
        h16x8 o;
#pragma unroll
        for (int e = 0; e < 8; ++e) o[e] = (_Float16)YL[pn * 64 + j0 + e];
        *(h16x8*)(Y + tok * 512 + h * 64 + j0) = o;
      }
    }
    __syncthreads();
  }
}

struct ScanOps1 {
  f32x2 a[4], w[4], b[4], k[4], r[4];
  float v0;
};
DEVI void scan_load1(ScanOps1& o, const float* OPS, const float* VV, int nn, int jg, int i0) {
  const float* base = OPS + nn * 64 + jg * 8;
  f32x4 t0, t1;
  t0 = *(const f32x4*)(base); t1 = *(const f32x4*)(base + 4);
  o.a[0] = lo2(t0); o.a[1] = hi2(t0); o.a[2] = lo2(t1); o.a[3] = hi2(t1);
  t0 = *(const f32x4*)(base + 2048); t1 = *(const f32x4*)(base + 2048 + 4);
  o.w[0] = lo2(t0); o.w[1] = hi2(t0); o.w[2] = lo2(t1); o.w[3] = hi2(t1);
  t0 = *(const f32x4*)(base + 4096); t1 = *(const f32x4*)(base + 4096 + 4);
  o.b[0] = lo2(t0); o.b[1] = hi2(t0); o.b[2] = lo2(t1); o.b[3] = hi2(t1);
  t0 = *(const f32x4*)(base + 6144); t1 = *(const f32x4*)(base + 6144 + 4);
  o.k[0] = lo2(t0); o.k[1] = hi2(t0); o.k[2] = lo2(t1); o.k[3] = hi2(t1);
  t0 = *(const f32x4*)(base + 8192); t1 = *(const f32x4*)(base + 8192 + 4);
  o.r[0] = lo2(t0); o.r[1] = hi2(t0); o.r[2] = lo2(t1); o.r[3] = hi2(t1);
  o.v0 = VV[nn * 64 + i0];
}
DEVI void scan_step1(const ScanOps1& o, f32x2 (&S0)[4], float* YL, int nn, int jg, int i0) {
  f32x2 d0 = S0[0] * o.a[0], d0b = S0[2] * o.a[2];
  d0 = S0[1] * o.a[1] + d0; d0b = S0[3] * o.a[3] + d0b;
  d0 += d0b;
  const float sa0 = red8(d0.x + d0.y);
  f32x2 e0 = {0.f, 0.f};
#pragma unroll
  for (int q = 0; q < 4; ++q) {
    const f32x2 u0 = sa0 * o.b[q] + o.v0 * o.k[q];
    S0[q] = S0[q] * o.w[q] + u0;
    e0 = S0[q] * o.r[q] + e0;
  }
  const float y0 = red8(e0.x + e0.y);
  if (jg == 0) YL[nn * 64 + i0] = y0;
}
DEVI float red16d(float x) {
  x += dpp_mov<0xB1>(x);
  x += dpp_mov<0x4E>(x);
  x += dpp_mov<0x141>(x);
  x += dpp_mov<0x140>(x);
  return x;
}
DEVI void unpack4(u32x2 u, float* o) {
  o[0] = __uint_as_float(u.x << 16); o[1] = __uint_as_float(u.x & 0xffff0000u);
  o[2] = __uint_as_float(u.y << 16); o[3] = __uint_as_float(u.y & 0xffff0000u);
}

DEVI void phase_scan8(int tid_, const Params& p, int l, char* smem, int bfirst, int bstride) {
  const u16* PR = (const u16*)(p.ws + OFF_PR);
  _Float16* YF = (_Float16*)(p.ws + OFF_H);
  _Float16* YB = (_Float16*)(p.ws + OFF_H + (size_t)NTOK * 512 * 2);
  float* BON = (float*)(p.ws + OFF_BONUS);
  const u16* WB = (const u16*)(p.ws + OFF_WB);
  float* OPS = (float*)(smem + SC_OPS);
  u16* RAW = (u16*)(smem + SC_OPS);
  float* VV = (float*)(smem + SC_VV);
  float* WR = (float*)(smem + SC_WR);
  float* AP = (float*)(smem + SC_AP);
  float* YL = WR;
  u16* TWb = (u16*)(smem + SC_TW);
  u16* ADb = (u16*)(smem + SC_AD);
  float* NRM = (float*)(smem + SC_NRM);
  float* MU = (float*)(smem + SC_MU);
  float* CST = (float*)(smem + SC_CST);
  const float* mu_p = p.in[I_MU_PREV] + (size_t)l * 1920;
  const float* mu_n = p.in[I_MU_NEXT] + (size_t)l * 1920;
  const int tid = tid_, lane = tid & 63, w = tid >> 6, fr = lane & 15, fq = lane >> 4;
  const int pn = tid >> 4, j0 = (tid & 15) * 4;
  const int jg = lane & 7, i0 = w * 8 + (lane >> 3);
  const int hr = (tid >= 80) ? 1 : 0, hc = tid - hr * 80;
  const int wm = w >> 2, wn = w & 3;
  for (int blk = bfirst; blk < 192; blk += bstride) {
    const int s = blk >> 4, h = (blk >> 1) & 7, d = blk & 1;
    __syncthreads();
    for (int i = tid; i < 640; i += 512) {
      const int which = (i >= 320) ? 1 : 0, c = i - which * 320;
      const int g = c >> 6, e = c & 63;
      const int col = (g < 3) ? (g * 512 + h * 64 + e) : (1536 + (g - 3) * 128 + d * 64 + e);
      MU[i] = which ? mu_n[col] : mu_p[col];
    }
    if (tid < 320) {
      const int which = tid >> 6, e = tid & 63;
      float v;
      if (which == 0) v = p.in[I_W0][(size_t)(l * 2 + d) * 512 + h * 64 + e];
      else if (which == 1) v = p.in[I_A0][(size_t)(l * 2 + d) * 512 + h * 64 + e];
      else if (which == 2) v = p.in[I_K_K][(size_t)l * 512 + h * 64 + e];
      else if (which == 3) v = p.in[I_K_A][(size_t)l * 512 + h * 64 + e];
      else v = p.in[I_R_K][(size_t)(l * 8 + h) * 64 + e];
      CST[tid] = v;
    }
    bf16x8 bw[2], ba[2];
#pragma unroll
    for (int ks = 0; ks < 2; ++ks) {
      bw[ks] = *(const bf16x8*)(WB + W_WUP + (size_t)(d * 512 + h * 64 + wn * 16 + fr) * 64 + ks * 32 + fq * 8);
      ba[ks] = *(const bf16x8*)(WB + W_AUP + (size_t)(d * 512 + h * 64 + wn * 16 + fr) * 64 + ks * 32 + fq * 8);
    }
    _Float16* Y = d ? YB : YF;
    f32x2 S0[4];
#pragma unroll
    for (int q = 0; q < 4; ++q) S0[q] = (f32x2){0.f, 0.f};
    u32x2 G[5], GH;
    {
      const int t = d ? (4095 - pn) : pn;
      const size_t tok = (size_t)s * 4096 + t;
#pragma unroll
      for (int g = 0; g < 5; ++g) {
        const int col = (g < 3) ? (g * 512 + h * 64) : (1536 + (g - 3) * 128 + d * 64);
        G[g] = *(const u32x2*)(PR + tok * PRW + col + j0);
      }
      GH = (u32x2){0u, 0u};
      if (tid < 160) {
        const int tlo = d ? (4095 - 31) : 0;
        const int th = hr ? (tlo + 32) : (tlo - 1);
        const int g = hc >> 4;
        const int col = (g < 3) ? (g * 512 + h * 64) : (1536 + (g - 3) * 128 + d * 64);
        if (th >= 0 && th <= 4095) GH = *(const u32x2*)(PR + ((size_t)s * 4096 + th) * PRW + col + (hc & 15) * 4);
      }
    }
#pragma unroll 1
    for (int ch = 0; ch < 128; ++ch) {
      const int n = ch * 32 + pn;
      const int t = d ? (4095 - n) : n;
      const size_t tok = (size_t)s * 4096 + t;
      const int tlo = d ? (4095 - (ch * 32 + 31)) : (ch * 32);
      const int rrow = t - tlo + 1;
#pragma unroll
      for (int g = 0; g < 5; ++g) *(u32x2*)(RAW + rrow * 320 + g * 64 + j0) = G[g];
      if (tid < 160) *(u32x2*)(RAW + (hr ? 33 : 0) * 320 + (hc >> 4) * 64 + (hc & 15) * 4) = GH;
      __syncthreads();
      if (ch + 1 < 128) {
        const int n2 = n + 32;
        const int t2 = d ? (4095 - n2) : n2;
        const size_t tok2 = (size_t)s * 4096 + t2;
#pragma unroll
        for (int g = 0; g < 5; ++g) {
          const int col = (g < 3) ? (g * 512 + h * 64) : (1536 + (g - 3) * 128 + d * 64);
          G[g] = *(const u32x2*)(PR + tok2 * PRW + col + j0);
        }
        GH = (u32x2){0u, 0u};
        if (tid < 160) {
          const int tlo2 = d ? (tlo - 32) : (tlo + 32);
          const int th = hr ? (tlo2 + 32) : (tlo2 - 1);
          const int g = hc >> 4;
          const int col = (g < 3) ? (g * 512 + h * 64) : (1536 + (g - 3) * 128 + d * 64);
          if (th >= 0 && th <= 4095) GH = *(const u32x2*)(PR + ((size_t)s * 4096 + th) * PRW + col + (hc & 15) * 4);
        }
      }
#pragma unroll
      for (int g = 0; g < 5; ++g) {
        float cur[4], prv[4], nxt[4];
        unpack4(*(const u32x2*)(RAW + rrow * 320 + g * 64 + j0), cur);
        unpack4(*(const u32x2*)(RAW + (rrow - 1) * 320 + g * 64 + j0), prv);
        unpack4(*(const u32x2*)(RAW + (rrow + 1) * 320 + g * 64 + j0), nxt);
        const f32x4 mp0 = *(const f32x4*)(MU + g * 64 + j0);
        const f32x4 mn0 = *(const f32x4*)(MU + 320 + g * 64 + j0);
        f32x4 x0;
#pragma unroll
        for (int e = 0; e < 4; ++e) x0[e] = cur[e] + mp0[e] * (prv[e] - cur[e]) + mn0[e] * (nxt[e] - cur[e]);
        if (g == 0) {
          *(f32x4*)(OPS + 4 * 2048 + pn * 64 + j0) = x0;
        } else if (g == 1) {
          *(f32x4*)(OPS + 3 * 2048 + pn * 64 + j0) = x0;
          const f32x4 kk0 = *(const f32x4*)(CST + 128 + j0);
          float ss = 0.f;
#pragma unroll
          for (int e = 0; e < 4; ++e) { const float a_ = x0[e] * kk0[e]; ss += a_ * a_; }
          ss = red16d(ss);
          if ((tid & 15) == 0) NRM[pn] = frcp(fmaxf(__builtin_amdgcn_sqrtf(ss), 1e-12f));
        } else if (g == 2) {
          *(f32x4*)(VV + pn * 64 + j0) = x0;
        } else if (g == 3) {
          u32x2 pk;
          pk.x = pack2(ftanh(x0[0]), ftanh(x0[1])); pk.y = pack2(ftanh(x0[2]), ftanh(x0[3]));
          *(u32x2*)(TWb + pn * 72 + j0) = pk;
        } else {
          u32x2 pk;
          pk.x = pack2(x0[0], x0[1]); pk.y = pack2(x0[2], x0[3]);
          *(u32x2*)(ADb + pn * 72 + j0) = pk;
        }
      }
      __syncthreads();
      {
        f32x4 cw = {0.f, 0.f, 0.f, 0.f}, ca = {0.f, 0.f, 0.f, 0.f};
#pragma unroll
        for (int ks = 0; ks < 2; ++ks) {
          const bf16x8 aw = *(const bf16x8*)(TWb + (wm * 16 + fr) * 72 + ks * 32 + fq * 8);
          const bf16x8 aa = *(const bf16x8*)(ADb + (wm * 16 + fr) * 72 + ks * 32 + fq * 8);
          cw = __builtin_amdgcn_mfma_f32_16x16x32_bf16(aw, bw[ks], cw, 0, 0, 0);
          ca = __builtin_amdgcn_mfma_f32_16x16x32_bf16(aa, ba[ks], ca, 0, 0, 0);
        }
#pragma unroll
        for (int jj = 0; jj < 4; ++jj) {
          WR[(wm * 16 + fq * 4 + jj) * 64 + wn * 16 + fr] = cw[jj];
          AP[(wm * 16 + fq * 4 + jj) * 64 + wn * 16 + fr] = ca[jj];
        }
      }
      __syncthreads();
      {
        const float inv = NRM[pn];
        float bsum = 0.f;
        const f32x4 wr_ = *(const f32x4*)(WR + pn * 64 + j0) + *(const f32x4*)(CST + j0);
        const f32x4 ap_ = *(const f32x4*)(AP + pn * 64 + j0) + *(const f32x4*)(CST + 64 + j0);
        const f32x4 kr = *(const f32x4*)(OPS + 3 * 2048 + pn * 64 + j0);
        const f32x4 rr = *(const f32x4*)(OPS + 4 * 2048 + pn * 64 + j0);
        const f32x4 kkw = *(const f32x4*)(CST + 128 + j0), kaw = *(const f32x4*)(CST + 192 + j0), rkw = *(const f32x4*)(CST + 256 + j0);
        f32x4 o0, o1, o2, o3;
#pragma unroll
        for (int e = 0; e < 4; ++e) {
          const float sw = sigm(wr_[e]);
          const float dec = __expf(-0.6065306597126334f * sw);
          const float av = sigm(ap_[e]);
          const float kn = kr[e] * kkw[e] * inv;
          const float kd = kr[e] * (1.f + (av - 1.f) * kaw[e]);
          bsum += rr[e] * kd * rkw[e];
          o0[e] = -kn; o1[e] = dec; o2[e] = kn * av; o3[e] = kd;
        }
        *(f32x4*)(OPS + 0 * 2048 + pn * 64 + j0) = o0;
        *(f32x4*)(OPS + 1 * 2048 + pn * 64 + j0) = o1;
        *(f32x4*)(OPS + 2 * 2048 + pn * 64 + j0) = o2;
        *(f32x4*)(OPS + 3 * 2048 + pn * 64 + j0) = o3;
        bsum = red16d(bsum);
        if ((tid & 15) == 0) BON[(tok * 8 + h) * 2 + d] = bsum;
      }
      __syncthreads();
      {
        ScanOps1 oa, ob;
        scan_load1(oa, OPS, VV, 0, jg, i0);
#pragma unroll 1
        for (int nn = 0; nn < 32; nn += 2) {
          scan_load1(ob, OPS, VV, nn + 1, jg, i0);
          scan_step1(oa, S0, YL, nn, jg, i0);
          scan_load1(oa, OPS, VV, (nn + 2) & 31, jg, i0);
          scan_step1(ob, S0, YL, nn + 1, jg, i0);
        }
      }
      __syncthreads();
      {
        typedef __attribute__((ext_vector_type(4))) _Float16 h16x4;
        h16x4 o;
#pragma unroll
        for (int e = 0; e < 4; ++e) o[e] = (_Float16)YL[pn * 64 + j0 + e];
        *(h16x4*)(Y + tok * 512 + h * 64 + j0) = o;
      }
    }
    __syncthreads();
  }
}

constexpr int PC_OPS = 0;
constexpr int PC_BUF = 49152;
constexpr int PC_RAW = 98304;
constexpr int PC_WR = 98304;
constexpr int PC_AP = 106496;
constexpr int PC_TW = 120064;
constexpr int PC_AD = 124672;
constexpr int PC_NRM = 129280;
constexpr int PC_MU = 129408;
constexpr int PC_CST = 131968;
constexpr int PC_YL = 133248;

DEVI void phase_scan_pc(int tid_, const Params& p, int l, char* smem, int bfirst, int bstride) {
  const u16* PR = (const u16*)(p.ws + OFF_PR);
  _Float16* YF = (_Float16*)(p.ws + OFF_H);
  _Float16* YB = (_Float16*)(p.ws + OFF_H + (size_t)NTOK * 512 * 2);
  float* BON = (float*)(p.ws + OFF_BONUS);
  const u16* WB = (const u16*)(p.ws + OFF_WB);
  u16* RAW = (u16*)(smem + PC_RAW);
  float* WR = (float*)(smem + PC_WR);
  float* AP = (float*)(smem + PC_AP);
  u16* TWb = (u16*)(smem + PC_TW);
  u16* ADb = (u16*)(smem + PC_AD);
  float* NRM = (float*)(smem + PC_NRM);
  float* MU = (float*)(smem + PC_MU);
  float* CST = (float*)(smem + PC_CST);
  const float* mu_p = p.in[I_MU_PREV] + (size_t)l * 1920;
  const float* mu_n = p.in[I_MU_NEXT] + (size_t)l * 1920;
  const bool is_prep = tid_ >= 256;
  const int tid = tid_ & 255, lane = tid & 63, w = tid >> 6, fr = lane & 15, fq = lane >> 4;
  const int pn = tid >> 3, j0 = (tid & 7) * 8;
  const int jg = lane & 7, i0 = w * 16 + (lane >> 3);
  const int hr = (tid >= 40) ? 1 : 0, hc = tid - hr * 40;
  for (int blk = bfirst; blk < 192; blk += bstride) {
    const int s = blk >> 4, h = (blk >> 1) & 7, d = blk & 1;
    __syncthreads();
    for (int i = tid_; i < 640; i += 512) {
      const int which = (i >= 320) ? 1 : 0, c = i - which * 320;
      const int g = c >> 6, e = c & 63;
      const int col = (g < 3) ? (g * 512 + h * 64 + e) : (1536 + (g - 3) * 128 + d * 64 + e);
      MU[i] = which ? mu_n[col] : mu_p[col];
    }
    if (tid_ < 320) {
      const int which = tid_ >> 6, e = tid_ & 63;
      float v;
      if (which == 0) v = p.in[I_W0][(size_t)(l * 2 + d) * 512 + h * 64 + e];
      else if (which == 1) v = p.in[I_A0][(size_t)(l * 2 + d) * 512 + h * 64 + e];
      else if (which == 2) v = p.in[I_K_K][(size_t)l * 512 + h * 64 + e];
      else if (which == 3) v = p.in[I_K_A][(size_t)l * 512 + h * 64 + e];
      else v = p.in[I_R_K][(size_t)(l * 8 + h) * 64 + e];
      CST[tid_] = v;
    }
    _Float16* Y = d ? YB : YF;
    if (is_prep) {
      bf16x8 bw[2], ba[2];
#pragma unroll
      for (int ks = 0; ks < 2; ++ks) {
        bw[ks] = *(const bf16x8*)(WB + W_WUP + (size_t)(d * 512 + h * 64 + w * 16 + fr) * 64 + ks * 32 + fq * 8);
        ba[ks] = *(const bf16x8*)(WB + W_AUP + (size_t)(d * 512 + h * 64 + w * 16 + fr) * 64 + ks * 32 + fq * 8);
      }
      u32x4 G[5], GH;
      {
        const int t = d ? (4095 - pn) : pn;
        const size_t tok = (size_t)s * 4096 + t;
#pragma unroll
        for (int g = 0; g < 5; ++g) {
          const int col = (g < 3) ? (g * 512 + h * 64) : (1536 + (g - 3) * 128 + d * 64);
          G[g] = *(const u32x4*)(PR + tok * PRW + col + j0);
        }
        GH = (u32x4){0u, 0u, 0u, 0u};
        if (tid < 80) {
          const int tlo = d ? (4095 - 31) : 0;
          const int th = hr ? (tlo + 32) : (tlo - 1);
          const int g = hc >> 3;
          const int col = (g < 3) ? (g * 512 + h * 64) : (1536 + (g - 3) * 128 + d * 64);
          if (th >= 0 && th <= 4095) GH = *(const u32x4*)(PR + ((size_t)s * 4096 + th) * PRW + col + (hc & 7) * 8);
        }
      }
#pragma unroll 1
      for (int ch = -1; ch < 128; ++ch) {
        const int c = ch + 1;
        const bool doprep = c < 128;
        float* OPS = (float*)(smem + PC_OPS + (c & 1) * PC_BUF);
        float* VV = OPS + 5 * 2048;
        const int n = c * 32 + pn;
        const int t = d ? (4095 - n) : n;
        const size_t tok = (size_t)s * 4096 + t;
        const int tlo = d ? (4095 - (c * 32 + 31)) : (c * 32);
        const int rrow = t - tlo + 1;
        __syncthreads();
        if (ch >= 1) {
          const float* YL = (const float*)(smem + PC_YL + ((ch - 1) & 1) * 8192);
          const int n1 = (ch - 1) * 32 + pn;
          const int t1 = d ? (4095 - n1) : n1;
          h16x8 o;
#pragma unroll
          for (int e = 0; e < 8; ++e) o[e] = (_Float16)YL[pn * 64 + j0 + e];
          *(h16x8*)(Y + ((size_t)s * 4096 + t1) * 512 + h * 64 + j0) = o;
        }
        if (doprep) {
#pragma unroll
          for (int g = 0; g < 5; ++g) *(u32x4*)(RAW + rrow * 320 + g * 64 + j0) = G[g];
          if (tid < 80) *(u32x4*)(RAW + (hr ? 33 : 0) * 320 + (hc >> 3) * 64 + (hc & 7) * 8) = GH;
        }
        __syncthreads();
        if (doprep) {
          if (c + 1 < 128) {
            const int n2 = n + 32;
            const int t2 = d ? (4095 - n2) : n2;
            const size_t tok2 = (size_t)s * 4096 + t2;
#pragma unroll
            for (int g = 0; g < 5; ++g) {
              const int col = (g < 3) ? (g * 512 + h * 64) : (1536 + (g - 3) * 128 + d * 64);
              G[g] = *(const u32x4*)(PR + tok2 * PRW + col + j0);
            }
            GH = (u32x4){0u, 0u, 0u, 0u};
            if (tid < 80) {
              const int tlo2 = d ? (tlo - 32) : (tlo + 32);
              const int th = hr ? (tlo2 + 32) : (tlo2 - 1);
              const int g = hc >> 3;
              const int col = (g < 3) ? (g * 512 + h * 64) : (1536 + (g - 3) * 128 + d * 64);
              if (th >= 0 && th <= 4095) GH = *(const u32x4*)(PR + ((size_t)s * 4096 + th) * PRW + col + (hc & 7) * 8);
            }
          }
#pragma unroll
          for (int g = 0; g < 5; ++g) {
            float cur[8], prv[8], nxt[8];
            load8bf(RAW + rrow * 320 + g * 64 + j0, cur);
            load8bf(RAW + (rrow - 1) * 320 + g * 64 + j0, prv);
            load8bf(RAW + (rrow + 1) * 320 + g * 64 + j0, nxt);
            const f32x4 mp0 = *(const f32x4*)(MU + g * 64 + j0), mp1 = *(const f32x4*)(MU + g * 64 + j0 + 4);
            const f32x4 mn0 = *(const f32x4*)(MU + 320 + g * 64 + j0), mn1 = *(const f32x4*)(MU + 320 + g * 64 + j0 + 4);
            f32x4 x0, x1;
#pragma unroll
            for (int e = 0; e < 4; ++e) {
              x0[e] = cur[e] + mp0[e] * (prv[e] - cur[e]) + mn0[e] * (nxt[e] - cur[e]);
              x1[e] = cur[4 + e] + mp1[e] * (prv[4 + e] - cur[4 + e]) + mn1[e] * (nxt[4 + e] - cur[4 + e]);
            }
            if (g == 0) {
              *(f32x4*)(OPS + 4 * 2048 + pn * 64 + j0) = x0; *(f32x4*)(OPS + 4 * 2048 + pn * 64 + j0 + 4) = x1;
            } else if (g == 1) {
              *(f32x4*)(OPS + 3 * 2048 + pn * 64 + j0) = x0; *(f32x4*)(OPS + 3 * 2048 + pn * 64 + j0 + 4) = x1;
              const f32x4 kk0 = *(const f32x4*)(CST + 128 + j0), kk1 = *(const f32x4*)(CST + 128 + j0 + 4);
              float ss = 0.f;
#pragma unroll
              for (int e = 0; e < 4; ++e) { const float a_ = x0[e] * kk0[e], b_ = x1[e] * kk1[e]; ss += a_ * a_ + b_ * b_; }
              ss = red8(ss);
              if ((tid & 7) == 0) NRM[pn] = frcp(fmaxf(__builtin_amdgcn_sqrtf(ss), 1e-12f));
            } else if (g == 2) {
              *(f32x4*)(VV + pn * 64 + j0) = x0; *(f32x4*)(VV + pn * 64 + j0 + 4) = x1;
            } else if (g == 3) {
              u32x4 pk;
              pk.x = pack2(ftanh(x0[0]), ftanh(x0[1])); pk.y = pack2(ftanh(x0[2]), ftanh(x0[3]));
              pk.z = pack2(ftanh(x1[0]), ftanh(x1[1])); pk.w = pack2(ftanh(x1[2]), ftanh(x1[3]));
              *(u32x4*)(TWb + pn * 72 + j0) = pk;
            } else {
              u32x4 pk;
              pk.x = pack2(x0[0], x0[1]); pk.y = pack2(x0[2], x0[3]);
              pk.z = pack2(x1[0], x1[1]); pk.w = pack2(x1[2], x1[3]);
              *(u32x4*)(ADb + pn * 72 + j0) = pk;
            }
          }
        }
        __syncthreads();
        if (doprep) {
#pragma unroll
          for (int m = 0; m < 2; ++m) {
            f32x4 cw = {0.f, 0.f, 0.f, 0.f}, ca = {0.f, 0.f, 0.f, 0.f};
#pragma unroll
            for (int ks = 0; ks < 2; ++ks) {
              const bf16x8 aw = *(const bf16x8*)(TWb + (m * 16 + fr) * 72 + ks * 32 + fq * 8);
              const bf16x8 aa = *(const bf16x8*)(ADb + (m * 16 + fr) * 72 + ks * 32 + fq * 8);
              cw = __builtin_amdgcn_mfma_f32_16x16x32_bf16(aw, bw[ks], cw, 0, 0, 0);
              ca = __builtin_amdgcn_mfma_f32_16x16x32_bf16(aa, ba[ks], ca, 0, 0, 0);
            }
#pragma unroll
            for (int jj = 0; jj < 4; ++jj) {
              WR[(m * 16 + fq * 4 + jj) * 64 + w * 16 + fr] = cw[jj];
              AP[(m * 16 + fq * 4 + jj) * 64 + w * 16 + fr] = ca[jj];
            }
          }
        }
        __syncthreads();
        if (doprep) {
          const float inv = NRM[pn];
          float bsum = 0.f;
#pragma unroll
          for (int hq = 0; hq < 2; ++hq) {
            const int jb = j0 + hq * 4;
            const f32x4 wr_ = *(const f32x4*)(WR + pn * 64 + jb) + *(const f32x4*)(CST + jb);
            const f32x4 ap_ = *(const f32x4*)(AP + pn * 64 + jb) + *(const f32x4*)(CST + 64 + jb);
            const f32x4 kr = *(const f32x4*)(OPS + 3 * 2048 + pn * 64 + jb);
            const f32x4 rr = *(const f32x4*)(OPS + 4 * 2048 + pn * 64 + jb);
            const f32x4 kkw = *(const f32x4*)(CST + 128 + jb), kaw = *(const f32x4*)(CST + 192 + jb), rkw = *(const f32x4*)(CST + 256 + jb);
            f32x4 o0, o1, o2, o3;
#pragma unroll
            for (int e = 0; e < 4; ++e) {
              const float sw = sigm(wr_[e]);
              const float dec = __expf(-0.6065306597126334f * sw);
              const float av = sigm(ap_[e]);
              const float kn = kr[e] * kkw[e] * inv;
              const float kd = kr[e] * (1.f + (av - 1.f) * kaw[e]);
              bsum += rr[e] * kd * rkw[e];
              o0[e] = -kn; o1[e] = dec; o2[e] = kn * av; o3[e] = kd;
            }
            *(f32x4*)(OPS + 0 * 2048 + pn * 64 + jb) = o0;
            *(f32x4*)(OPS + 1 * 2048 + pn * 64 + jb) = o1;
            *(f32x4*)(OPS + 2 * 2048 + pn * 64 + jb) = o2;
            *(f32x4*)(OPS + 3 * 2048 + pn * 64 + jb) = o3;
          }
          bsum = red8(bsum);
          if ((tid & 7) == 0) BON[(tok * 8 + h) * 2 + d] = bsum;
        }
      }
      __syncthreads();
      {
        const float* YL = (const float*)(smem + PC_YL + (127 & 1) * 8192);
        const int n1 = 127 * 32 + pn;
        const int t1 = d ? (4095 - n1) : n1;
        h16x8 o;
#pragma unroll
        for (int e = 0; e < 8; ++e) o[e] = (_Float16)YL[pn * 64 + j0 + e];
        *(h16x8*)(Y + ((size_t)s * 4096 + t1) * 512 + h * 64 + j0) = o;
      }
    } else {
      f32x2 S0[4], S1[4];
#pragma unroll
      for (int q = 0; q < 4; ++q) { S0[q] = (f32x2){0.f, 0.f}; S1[q] = (f32x2){0.f, 0.f}; }
#pragma unroll 1
      for (int ch = -1; ch < 128; ++ch) {
        const float* OPS = (const float*)(smem + PC_OPS + (ch & 1) * PC_BUF);
        const float* VV = OPS + 5 * 2048;
        float* YL = (float*)(smem + PC_YL + (ch & 1) * 8192);
        __syncthreads();
        if (ch < 0) {
          __syncthreads(); __syncthreads(); __syncthreads();
        } else {
          ScanOps oa, ob;
          scan_load(oa, OPS, VV, 0, jg, i0);
#pragma unroll 1
          for (int seg = 0; seg < 4; ++seg) {
            if (seg > 0) __syncthreads();
#pragma unroll 1
            for (int nn = seg * 8; nn < seg * 8 + 8; nn += 2) {
              scan_load(ob, OPS, VV, nn + 1, jg, i0);
              scan_step(oa, S0, S1, YL, nn, jg, i0);
              scan_load(oa, OPS, VV, (nn + 2) & 31, jg, i0);
              scan_step(ob, S0, S1, YL, nn + 1, jg, i0);
            }
          }
        }
      }
      __syncthreads();
    }
    __syncthreads();
  }
}

DEVI void phase_rwkv_post(int tid_, int vb_, int vg_, const Params& p, int l, char* smem) {
  u16* PR = (u16*)(p.ws + OFF_PR);
  const _Float16* YF = (const _Float16*)(p.ws + OFF_H);
  const _Float16* YB = (const _Float16*)(p.ws + OFF_H + (size_t)NTOK * 512 * 2);
  const float* BON = (const float*)(p.ws + OFF_BONUS);
  const u16* GUPT = (const u16*)(p.ws + OFF_WB) + W_GUP;
  const float* mu_p = p.in[I_MU_PREV] + (size_t)l * 1920;
  const float* mu_n = p.in[I_MU_NEXT] + (size_t)l * 1920;
  const float* gng = p.in[I_GN_G] + (size_t)l * 512;
  const float* gnb = p.in[I_GN_B] + (size_t)l * 512;
  u16* As = (u16*)smem;
  const int tid = tid_, lane = tid & 63, w = tid >> 6, fr = lane & 15, fq = lane >> 4;
  for (int tile = vb_; tile < NTOK / 64; tile += vg_) {
    const size_t tok0 = (size_t)tile * 64;
    {
      const int row = tid >> 2, part = tid & 3;
      const size_t tok = tok0 + row;
      const int t = (int)(tok & 4095);
#pragma unroll
      for (int q = 0; q < 4; ++q) {
        const int col = 1792 + part * 32 + q * 8;
        float cur[8], prv[8], nxt[8];
        load8bf(PR + tok * PRW + col, cur);
        if (t > 0) load8bf(PR + (tok - 1) * PRW + col, prv);
        else {
#pragma unroll
          for (int e = 0; e < 8; ++e) prv[e] = 0.f;
        }
        if (t < 4095) load8bf(PR + (tok + 1) * PRW + col, nxt);
        else {
#pragma unroll
          for (int e = 0; e < 8; ++e) nxt[e] = 0.f;
        }
        float o[8];
#pragma unroll
        for (int e = 0; e < 8; ++e) {
          const float x = cur[e] + mu_p[col + e] * (prv[e] - cur[e]) + mu_n[col + e] * (nxt[e] - cur[e]);
          o[e] = sigm(x);
        }
        u32x4 pk;
        pk.x = pack2(o[0], o[1]); pk.y = pack2(o[2], o[3]); pk.z = pack2(o[4], o[5]); pk.w = pack2(o[6], o[7]);
        *(u32x4*)(As + row * 136 + part * 32 + q * 8) = pk;
      }
    }
    asm volatile("" ::: "memory");
#pragma unroll 1
    for (int chh = 0; chh < 2; ++chh) {
      f32x4 acc[16];
#pragma unroll
      for (int n = 0; n < 16; ++n) acc[n] = (f32x4){0.f, 0.f, 0.f, 0.f};
#pragma unroll
      for (int ks = 0; ks < 4; ++ks) {
        bf16x8 af = *(const bf16x8*)(As + (w * 16 + fr) * 136 + ks * 32 + fq * 8);
#pragma unroll
        for (int n = 0; n < 16; ++n) {
          bf16x8 bg = *(const bf16x8*)(GUPT + (size_t)(chh * 256 + n * 16 + fr) * 128 + ks * 32 + fq * 8);
          acc[n] = __builtin_amdgcn_mfma_f32_16x16x32_bf16(af, bg, acc[n], 0, 0, 0);
        }
      }
#pragma unroll
      for (int hl = 0; hl < 4; ++hl) {
        const int head = chh * 4 + hl;
        asm volatile("" ::: "memory");
#pragma unroll
        for (int j = 0; j < 4; ++j) {
          const size_t tok = tok0 + w * 16 + fq * 4 + j;
          const int t = (int)(tok & 4095);
          float o[4], sum = 0.f;
#pragma unroll
          for (int q = 0; q < 4; ++q) {
            const int col = head * 64 + q * 16 + fr;
            o[q] = (float)YF[tok * 512 + col] + (float)YB[tok * 512 + col];
            sum += o[q];
          }
          const float mean = red16_sum(sum) * (1.f / 64.f);
          float vs = 0.f;
#pragma unroll
          for (int q = 0; q < 4; ++q) { const float dlt = o[q] - mean; vs += dlt * dlt; }
          const float var = red16_sum(vs) * (1.f / 64.f);
          const float rstd = rsqrtf(var + 64e-5f);
          const float bon = BON[(tok * 8 + head) * 2] + BON[(tok * 8 + head) * 2 + 1];
#pragma unroll
          for (int q = 0; q < 4; ++q) {
            const int col = head * 64 + q * 16 + fr;
            const int vc = 1024 + col;
            const float cur = bf2f(PR[tok * PRW + vc]);
            const float prv = (t > 0) ? bf2f(PR[(tok - 1) * PRW + vc]) : 0.f;
            const float nxt = (t < 4095) ? bf2f(PR[(tok + 1) * PRW + vc]) : 0.f;
            const float vsh = cur + mu_p[vc] * (prv - cur) + mu_n[vc] * (nxt - cur);
            const float yv = ((o[q] - mean) * rstd * gng[col] + gnb[col] + bon * vsh) * acc[hl * 4 + q][j];
            PR[tok * PRW + col] = f2bf(yv);
          }
        }
      }
    }
  }
}

DEVI f32x4 ld4bf(const u16* p) {
  const u32x2 u = *(const u32x2*)p;
  f32x4 o;
  o[0] = __uint_as_float(u.x << 16); o[1] = __uint_as_float(u.x & 0xffff0000u);
  o[2] = __uint_as_float(u.y << 16); o[3] = __uint_as_float(u.y & 0xffff0000u);
  return o;
}

DEVI void phase_merge(int tid_, const Params& p, char* smem, const float* ssq) {
  const u16* WB = (const u16*)(p.ws + OFF_WB);
  const u16* H = (const u16*)(p.ws + OFF_NK);
  u16* PR = (u16*)(p.ws + OFF_PR);
  const u16* NQ = (const u16*)(p.ws + OFF_NQ);
  u16* TMP = (u16*)(p.ws + OFF_H);
  const int lane = tid_ & 63, wid = tid_ >> 6;
  const int wr = wid >> 2, wc = wid & 3, fr = lane & 15, fq = lane >> 4;
  const bool xmap = (gridDim.x & 7) == 0;
  const int xcd = blockIdx.x & 7;
  const int first = xmap ? (int)(blockIdx.x >> 3) : (int)blockIdx.x;
  const int stride = xmap ? (int)(gridDim.x >> 3) : (int)gridDim.x;
  const int count = xmap ? 24 * 4 : 192 * 4;
  for (int it = first; it < count; it += stride) {
    const int tm = xmap ? (it >> 2) * 8 + xcd : (it >> 2), tn = it & 3;
    const int m0 = tm << 8, n0 = tn << 8;
    f32x4 acc[8][4];
#define MERGE_ZERO() _Pragma("unroll") for (int m = 0; m < 8; ++m) _Pragma("unroll") for (int n = 0; n < 4; ++n) acc[m][n] = (f32x4){0.f, 0.f, 0.f, 0.f}
#define MERGE_RC() const int r = m0 + wr * 128 + m * 16 + fr, c0 = n0 + wc * 64 + n * 16 + fq * 4
    MERGE_ZERO();
    gemm_kloop8<true>(launder(tid_), acc, H + (size_t)m0 * 1024, 1024, WB + W_IN + (size_t)(3456 + n0) * 1024, 1024, 1024, smem);
#pragma unroll
    for (int m = 0; m < 8; ++m)
#pragma unroll
      for (int n = 0; n < 4; ++n) {
        MERGE_RC();
        const float rs = rstd_of(ssq, r);
        f32x4 o;
#pragma unroll
        for (int j = 0; j < 4; ++j) o[j] = sigm(acc[m][n][j] * rs);
        store4bf(PR + (size_t)r * PRW + 512 + c0, o);
      }
    MERGE_ZERO();
    gemm_kloop8<true>(launder(tid_), acc, PR + (size_t)m0 * PRW, PRW, WB + W_BRR + (size_t)n0 * 512, 512, 512, smem);
#pragma unroll
    for (int m = 0; m < 8; ++m)
#pragma unroll
      for (int n = 0; n < 4; ++n) {
        MERGE_RC();
        u16* dst = PR + (size_t)r * PRW + 512 + c0;
        store4bf(dst, ld4bf(dst) * acc[m][n]);
      }
    MERGE_ZERO();
    gemm_kloop8<true>(launder(tid_), acc, H + (size_t)m0 * 1024, 1024, WB + W_IN + (size_t)(4480 + n0) * 1024, 1024, 1024, smem);
#pragma unroll
    for (int m = 0; m < 8; ++m)
#pragma unroll
      for (int n = 0; n < 4; ++n) {
        MERGE_RC();
        const float rs = rstd_of(ssq, r);
        f32x4 o;
#pragma unroll
        for (int j = 0; j < 4; ++j) o[j] = sigm(acc[m][n][j] * rs);
        store4bf(TMP + (size_t)r * 1024 + c0, o);
      }
    MERGE_ZERO();
    gemm_kloop8<true>(launder(tid_), acc, NQ + (size_t)m0 * 512, 512, WB + W_BRN + (size_t)n0 * 512, 512, 512, smem);
#pragma unroll
    for (int m = 0; m < 8; ++m)
#pragma unroll
      for (int n = 0; n < 4; ++n) {
        MERGE_RC();
        u16* dst = PR + (size_t)r * PRW + 512 + c0;
        store4bf(dst, ld4bf(dst) + ld4bf(TMP + (size_t)r * 1024 + c0) * acc[m][n]);
      }
#undef MERGE_ZERO
#undef MERGE_RC
  }
}


DEVI void phase_xattn(int tid_, int vb_, int vg_, const Params& p, char* smem) {
  const u16* Q = (const u16*)(p.ws + OFF_PR);
  u16* O = (u16*)(p.ws + OFF_NQ);
  const u16* KVK = (const u16*)(p.ws + OFF_KVK);
  const u16* KVT = (const u16*)(p.ws + OFF_KVT);
  const int lane = tid_ & 63, w = tid_ >> 6, fr = lane & 15, fq = lane >> 4;
  u16* Pw = (u16*)smem + w * (32 * 264);
  for (int t = vb_; t < (NTOK / 128) * 4; t += vg_) {
    const int hh = t & 3;
    const size_t tok0 = (size_t)(t >> 2) * 128 + w * 32;
    const int s = (int)(tok0 >> 12);
    f32x4 acc[2][16];
#pragma unroll
    for (int mt = 0; mt < 2; ++mt)
#pragma unroll
      for (int n = 0; n < 16; ++n) acc[mt][n] = (f32x4){0.f, 0.f, 0.f, 0.f};
#pragma unroll 1
    for (int ks = 0; ks < 8; ++ks) {
      const bf16x8 aq0 = *(const bf16x8*)(Q + (tok0 + fr) * 1024 + hh * 256 + ks * 32 + fq * 8);
      const bf16x8 aq1 = *(const bf16x8*)(Q + (tok0 + 16 + fr) * 1024 + hh * 256 + ks * 32 + fq * 8);
#pragma unroll
      for (int n = 0; n < 16; ++n) {
        const bf16x8 bk = *(const bf16x8*)(KVK + (size_t)(s * 256 + n * 16 + fr) * 1024 + hh * 256 + ks * 32 + fq * 8);
        acc[0][n] = __builtin_amdgcn_mfma_f32_16x16x32_bf16(bk, aq0, acc[0][n], 0, 0, 0);
        acc[1][n] = __builtin_amdgcn_mfma_f32_16x16x32_bf16(bk, aq1, acc[1][n], 0, 0, 0);
      }
    }
    float sm[2];
#pragma unroll
    for (int mt = 0; mt < 2; ++mt) {
      float m = -1e30f;
#pragma unroll
      for (int n = 0; n < 16; ++n)
#pragma unroll
        for (int j = 0; j < 4; ++j) m = fmaxf(m, acc[mt][n][j]);
      m = red4x_max(m) * 0.0625f;
      float ssum = 0.f;
#pragma unroll
      for (int n = 0; n < 16; ++n) {
        f32x4 e;
#pragma unroll
        for (int j = 0; j < 4; ++j) { e[j] = __expf(acc[mt][n][j] * 0.0625f - m); ssum += e[j]; }
        store4bf(Pw + (mt * 16 + fr) * 264 + n * 16 + fq * 4, e);
      }
      sm[mt] = 1.f / red4x_sum(ssum);
    }
#pragma unroll
    for (int mt = 0; mt < 2; ++mt)
#pragma unroll
      for (int n = 0; n < 16; ++n) acc[mt][n] = (f32x4){0.f, 0.f, 0.f, 0.f};
#pragma unroll 1
    for (int ks = 0; ks < 8; ++ks) {
      const bf16x8 ap0 = *(const bf16x8*)(Pw + fr * 264 + ks * 32 + fq * 8);
      const bf16x8 ap1 = *(const bf16x8*)(Pw + (16 + fr) * 264 + ks * 32 + fq * 8);
#pragma unroll
      for (int n = 0; n < 16; ++n) {
        const bf16x8 bv = *(const bf16x8*)(KVT + (size_t)(s * 1024 + hh * 256 + n * 16 + fr) * 256 + ks * 32 + fq * 8);
        acc[0][n] = __builtin_amdgcn_mfma_f32_16x16x32_bf16(bv, ap0, acc[0][n], 0, 0, 0);
        acc[1][n] = __builtin_amdgcn_mfma_f32_16x16x32_bf16(bv, ap1, acc[1][n], 0, 0, 0);
      }
    }
#pragma unroll
    for (int mt = 0; mt < 2; ++mt)
#pragma unroll
      for (int n = 0; n < 16; ++n)
        store4bf(O + (tok0 + mt * 16 + fr) * 1024 + hh * 256 + n * 16 + fq * 4, acc[mt][n] * sm[mt]);
  }
}

constexpr int HALF_SMEM = 78720;

DEVI void run_phase(int tid_, const Params& p, int ph, char* smem) {
  const int half = tid_ >> 8, vt = tid_ & 255;
  const int vb_ = blockIdx.x * 2 + half, vg_ = gridDim.x * 2;
  char* smh = smem + half * HALF_SMEM;
  if (ph == 2 * NPH_LAYER) { phase_final_norm(vt, vb_, vg_, p); return; }
  const int l = ph / NPH_LAYER, q = ph % NPH_LAYER;
  u16* WB = (u16*)(p.ws + OFF_WB);
  u16* H = (u16*)(p.ws + OFF_H);
  u16* PR = (u16*)(p.ws + OFF_PR);
  u16* NQ = (u16*)(p.ws + OFF_NQ);
  float* X = p.X;
  float* SSQ = (float*)(p.ws + OFF_SSQ);
  auto epi_res = [&](int r, int c0, f32x4 v) {
    f32x4* px = (f32x4*)(X + (size_t)r * 1024 + c0);
    *px = *px + v;
  };
  float rowacc = 0.f;
  float* ssq_out = SSQ;
  auto epi_res_n = [&](int r, int c0, f32x4 v) {
    f32x4* px = (f32x4*)(X + (size_t)r * 1024 + c0);
    const f32x4 xn = *px + v;
    *px = xn;
    store4bf(H + (size_t)r * 1024 + c0, xn);
    rowacc += xn[0] * xn[0] + xn[1] * xn[1] + xn[2] * xn[2] + xn[3] * xn[3];
  };
  auto row_end = [&](int r) {
    float t = rowacc;
    t += __shfl_xor(t, 16);
    t += __shfl_xor(t, 32);
    if ((tid_ & 48) == 0) atomicAdd(ssq_out + r, t);
    rowacc = 0.f;
  };
  constexpr int NONS = 1 << 30;
  switch (q) {
    case 0:
      phase_conv(vt, vb_, vg_, p, l, smh);
      phase_norm_mem(vt, vb_, vg_, p, p.in[I_NORM_MEM] + (size_t)l * 1024);
      if (l == 0) {
        phase_xb(vt, vb_, vg_, p, true, OFF_H, SSQ);
        for (int i = vb_ * 256 + vt; i < 6 * NTOK; i += vg_ * 256) SSQ[NTOK + i] = 0.f;
      }
      break;
    case 1: phase_p_gemm(tid_, p, smem, SSQ + (size_t)(3 * l) * NTOK); break;
    case 2:
      if (gridDim.x >= 224) {
        if (blockIdx.x < 192) phase_scan_pc(tid_, p, l, smem, blockIdx.x, gridDim.x);
        else phase_nat(vt, p, l, smh, vb_ - 384, vg_ - 384);
      } else {
        phase_scan(vt, p, l, smh, vb_, vg_);
        __syncthreads();
        phase_nat(vt, p, l, smh, vb_, vg_);
      }
      break;
    case 3:
      phase_rwkv_post(vt, vb_, vg_, p, l, smh);
      phase_xb(vt, vb_, vg_, p, false, OFF_NK, nullptr);
      break;
    case 4: phase_merge(tid_, p, smem, SSQ + (size_t)(3 * l) * NTOK); break;
    case 5:
      ssq_out = SSQ + (size_t)(3 * l + 1) * NTOK;
      gemm_phase8(tid_, PR + 512, PRW, WB + W_OUT, 1024, 1024, NTOK, 1024, smem, NONS, epi_res_n, NoEpi(), row_end);
      break;
    case 6: {
      const float* ssq = SSQ + (size_t)(3 * l + 1) * NTOK;
      gemm_phase8(tid_, H, 1024, WB + W_XQ, 1024, 1024, NTOK, 1024, smem, NONS,
                 [&](int r, int c0, f32x4 v) { store4bf(PR + (size_t)r * 1024 + c0, v * rstd_of(ssq, r)); }, NoEpi());
    } break;
    case 7: phase_xattn(vt, vb_, vg_, p, smh); break;
    case 8:
      ssq_out = SSQ + (size_t)(3 * l + 2) * NTOK;
      gemm_phase8(tid_, NQ, 1024, WB + W_XO, 1024, 1024, NTOK, 1024, smem, NONS, epi_res_n, NoEpi(), row_end);
      break;
    case 9:
    case 11: {
      const int hf = (q == 11);
      const float* ssq = SSQ + (size_t)(3 * l + 2) * NTOK;
      gemm_phase8(tid_, H, 1024, WB + W_FF1 + (size_t)hf * 2048 * 1024, 1024, 1024, NTOK, 2048, smem, NONS,
                 [&](int r, int c0, f32x4 v) {
                   const float rs = rstd_of(ssq, r);
                   f32x4 o;
#pragma unroll
                   for (int j = 0; j < 4; ++j) { const float x = fmaxf(v[j] * rs, 0.f); o[j] = x * x; }
                   store4bf(PR + (size_t)r * 2048 + c0, o);
                 }, NoEpi());
    } break;
    case 10:
      gemm_phase8(tid_, PR, 2048, WB + W_FF2, 4096, 2048, NTOK, 1024, smem, NONS, epi_res, NoEpi());
      break;
    case 12:
      ssq_out = SSQ + (size_t)(3 * l + 3) * NTOK;
      gemm_phase8(tid_, PR, 2048, WB + W_FF2 + 2048, 4096, 2048, NTOK, 1024, smem, NONS, epi_res_n, NoEpi(), row_end);
      break;
  }
}

#define XB_TMO      128
#define XB_XCNT(j)  (256  + 64 * (j))
#define XB_XSUB(j)  (1280 + 64 * (j))
#define XB_XGEN(j)  (2304 + 64 * (j))
#define XB_TOP      3328
#define XB_TOPGEN   3392
#define XCD_BAR_WORDS 3456
#define XB_SPIN_CAP (1u << 20)
#define LAS __attribute__((address_space(3)))

DEVI unsigned xb_ld(unsigned* p) { return __hip_atomic_load(p, __ATOMIC_RELAXED, __HIP_MEMORY_SCOPE_AGENT); }
DEVI unsigned xb_add(unsigned* p, unsigned v) { return __hip_atomic_fetch_add(p, v, __ATOMIC_RELAXED, __HIP_MEMORY_SCOPE_AGENT); }
DEVI unsigned xb_xcc_id() { return (unsigned)__builtin_amdgcn_s_getreg((3 << 11) | 20) & 0xFu; }
#define XB_SPIN(cond, bar) do { unsigned _sp = 0; while (cond) { __builtin_amdgcn_s_sleep(1); \
    if ((++_sp & 255u) == 0u) { if (xb_ld(&(bar)[XB_TMO])) break; if (_sp > XB_SPIN_CAP) { atomicAdd(&(bar)[XB_TMO], 1u); break; } } } } while (0)

struct XcdBarrier {
  unsigned* bar; unsigned x;
  volatile LAS unsigned* st;
};
DEVI XcdBarrier xcd_barrier_post(unsigned* bar, volatile LAS unsigned* st) {
  XcdBarrier b; b.bar = bar; b.x = xb_xcc_id(); b.st = st;
  if (threadIdx.x == 0) (void)xb_add(&bar[XB_XCNT(b.x)], 1u);
  return b;
}
DEVI void xcd_barrier_complete(unsigned* bar, unsigned x, unsigned& nloc, unsigned& nx) {
  const unsigned G = gridDim.x * gridDim.y * gridDim.z;
  unsigned sum, cnt, mine, sp = 0u;
  for (;;) {
    sum = 0u; cnt = 0u; mine = 0u;
#pragma unroll
    for (unsigned j = 0; j < 16; ++j) { const unsigned c = xb_ld(&bar[XB_XCNT(j)]); sum += c; cnt += (c > 0u) ? 1u : 0u; mine = (j == x) ? c : mine; }
    if (sum == G) break;
    __builtin_amdgcn_s_sleep(1);
    if ((++sp & 255u) == 0u) { if (xb_ld(&bar[XB_TMO])) break; if (sp > XB_SPIN_CAP) { atomicAdd(&bar[XB_TMO], 1u); break; } }
  }
  nloc = mine > 0u ? mine : 1u; nx = cnt > 0u ? cnt : 1u;
}
DEVI void xcd_barrier(const XcdBarrier& b) {
  asm volatile("s_waitcnt vmcnt(0)" ::: "memory");
  __syncthreads();
  if (threadIdx.x == 0) {
    unsigned* bar = b.bar;
    __builtin_amdgcn_s_waitcnt(0);
    unsigned nloc = b.st[0], nx = b.st[1];
    if (nloc == 0u) { xcd_barrier_complete(bar, b.x, nloc, nx); b.st[0] = nloc; b.st[1] = nx; }
    const unsigned old = xb_add(&bar[XB_XSUB(b.x)], 1u);
    const unsigned gen = old / nloc;
    if (old + 1u == (gen + 1u) * nloc) {
      __builtin_amdgcn_fence(__ATOMIC_RELEASE, "agent");
      asm volatile("s_waitcnt vmcnt(0)" ::: "memory");
      const unsigned og = xb_add(&bar[XB_TOP], 1u);
      const unsigned tg = og / nx;
      if (og + 1u == (tg + 1u) * nx) xb_add(&bar[XB_TOPGEN], 1u);
      else XB_SPIN(xb_ld(&bar[XB_TOPGEN]) == tg, bar);
      __builtin_amdgcn_fence(__ATOMIC_ACQUIRE, "agent");
      xb_add(&bar[XB_XGEN(b.x)], 1u);
      asm volatile("s_waitcnt vmcnt(0)" ::: "memory");
    } else {
      XB_SPIN(xb_ld(&bar[XB_XGEN(b.x)]) == gen, bar);
      __builtin_amdgcn_fence(__ATOMIC_ACQUIRE, "agent");
      asm volatile("s_waitcnt vmcnt(0)" ::: "memory");
    }
  }
  __syncthreads();
}

__global__ void __launch_bounds__(512, 2) mega_kernel(Params p, int ph0, int ph1) {
  __shared__ __attribute__((aligned(16))) char smem[2 * HALF_SMEM];
  __shared__ __attribute__((aligned(16))) unsigned xb_words[4];
  if (threadIdx.x == 0) { xb_words[0] = 0u; xb_words[1] = 0u; xb_words[2] = 0u; xb_words[3] = 0u; }
  __syncthreads();
  XcdBarrier xb = xcd_barrier_post((unsigned*)(p.ws + OFF_BAR), (volatile LAS unsigned*)xb_words);
  for (int ph = ph0; ph < ph1; ++ph) {
    if (ph == ph0 + 1) cg::this_grid().sync();
    else if (ph > ph0) xcd_barrier(xb);
    int tid_ = threadIdx.x;
    asm volatile("" : "+v"(tid_));
    run_phase(tid_, p, ph, smem);
  }
}

extern "C" void kernel_launch(void* const* d_in, const int* in_sizes, int n_in, void* d_out, int out_size, void* d_ws,
                              size_t ws_size, hipStream_t stream) {
  if (ws_size < WS_NEED || n_in < 31) return;
  Params p{};
  for (int i = 0; i < 31; ++i) p.in[i] = (const float*)d_in[i];
  p.X = (float*)d_out;
  p.ws = (char*)d_ws;
  static int grid_blocks = 0;
  if (!grid_blocks) {
    int dev = 0, cus = 0, per_cu = 0;
    hipGetDevice(&dev);
    hipDeviceGetAttribute(&cus, hipDeviceAttributeMultiprocessorCount, dev);
    hipOccupancyMaxActiveBlocksPerMultiprocessor(&per_cu, mega_kernel, 512, 0);
    if (per_cu > 1) per_cu = 1;
    if (per_cu < 1) per_cu = 1;
    grid_blocks = cus * per_cu;
  }
  hipMemsetAsync((char*)d_ws + OFF_BAR, 0, 16384, stream);
  int ph0 = 0, ph1 = NPHASES;
  void* args[] = {&p, &ph0, &ph1};
  hipLaunchCooperativeKernel((void*)mega_kernel, dim3(grid_blocks), dim3(512), args, 0, stream);
}
```

```cpp
#include <hip/hip_runtime.h>
#include <hip/hip_cooperative_groups.h>
#include <stdint.h>
namespace cg = cooperative_groups;

typedef unsigned short u16;
typedef __attribute__((ext_vector_type(8))) short bf16x8;
typedef __attribute__((ext_vector_type(4))) float f32x4;
typedef __attribute__((ext_vector_type(8))) _Float16 h16x8;
typedef __attribute__((ext_vector_type(4))) unsigned int u32x4;
typedef __attribute__((ext_vector_type(2))) unsigned int u32x2;

#define DEVI __device__ __forceinline__

constexpr int NTOK = 49152;
constexpr int SEQ_T = 4096;
constexpr int PRW = 1920;
constexpr int NPH_LAYER = 13;
constexpr int NPHASES = 2 * NPH_LAYER + 1;
constexpr int SMEM_BYTES = 78720;

constexpr size_t OFF_WB = 0;
constexpr size_t WB_BYTES = 20512768ull * 2;
constexpr size_t OFF_H = OFF_WB + WB_BYTES;
constexpr size_t OFF_PR = OFF_H + (size_t)NTOK * 1024 * 2;
constexpr size_t OFF_NQ = OFF_PR + (size_t)NTOK * PRW * 2;
constexpr size_t OFF_NK = OFF_NQ + (size_t)NTOK * 512 * 2;
constexpr size_t OFF_NV = OFF_NK + (size_t)NTOK * 512 * 2;
constexpr size_t OFF_KVK = OFF_NV + (size_t)NTOK * 512 * 2;
constexpr size_t OFF_KVT = OFF_KVK + (size_t)3072 * 1024 * 2;
constexpr size_t OFF_MEMH = OFF_KVT + (size_t)3072 * 1024 * 2;
constexpr size_t OFF_BONUS = OFF_MEMH + (size_t)3072 * 1024 * 2;
constexpr size_t OFF_BAR = OFF_BONUS + (size_t)NTOK * 16 * 4;
constexpr size_t OFF_SSQ = OFF_BAR + 16384;
constexpr size_t WS_NEED = OFF_SSQ + (size_t)7 * NTOK * 4;

constexpr size_t W_IN = 0;
constexpr size_t W_BRR = W_IN + (size_t)5504 * 1024;
constexpr size_t W_BRN = W_BRR + (size_t)1024 * 512;
constexpr size_t W_OUT = W_BRN + (size_t)1024 * 512;
constexpr size_t W_XQ = W_OUT + (size_t)1024 * 1024;
constexpr size_t W_XKV = W_XQ + (size_t)1024 * 1024;
constexpr size_t W_XO = W_XKV + (size_t)2048 * 1024;
constexpr size_t W_FF1 = W_XO + (size_t)1024 * 1024;
constexpr size_t W_FF2 = W_FF1 + (size_t)4096 * 1024;
constexpr size_t W_GUP = W_FF2 + (size_t)4096 * 1024;
constexpr size_t W_WUP = W_GUP + (size_t)512 * 128;
constexpr size_t W_AUP = W_WUP + (size_t)2 * 512 * 64;

enum { I_XP = 0, I_XS, I_MP, I_MS, I_NORM_MIX, I_W_IN, I_MU_PREV, I_MU_NEXT, I_W0, I_W_UP, I_A0, I_A_UP,
       I_G_UP, I_K_K, I_K_A, I_R_K, I_GN_G, I_GN_B, I_RPB, I_W_BR_RWKV, I_W_BR_NAT, I_W_OUT, I_NORM_X,
       I_NORM_MEM, I_W_XQ, I_W_XKV, I_W_XO, I_NORM_FF, I_W_FF1, I_W_FF2, I_NORM_FINAL };

struct Params {
  const float* in[31];
  float* X;
  char* ws;
};

DEVI u16 f2bf(float f) {
  uint32_t u = __float_as_uint(f);
  u += 0x7FFFu + ((u >> 16) & 1u);
  return (u16)(u >> 16);
}
DEVI float bf2f(u16 h) { return __uint_as_float(((uint32_t)h) << 16); }
DEVI uint32_t pack2(float a, float b) { return (uint32_t)f2bf(a) | ((uint32_t)f2bf(b) << 16); }
DEVI float frcp(float x) { return __builtin_amdgcn_rcpf(x); }
DEVI float sigm(float x) { return frcp(1.f + __expf(-x)); }
DEVI float ftanh(float x) { return 1.f - 2.f * frcp(__expf(2.f * x) + 1.f); }
DEVI void unpack8(u32x4 u, float* o) {
  o[0] = __uint_as_float(u.x << 16); o[1] = __uint_as_float(u.x & 0xffff0000u);
  o[2] = __uint_as_float(u.y << 16); o[3] = __uint_as_float(u.y & 0xffff0000u);
  o[4] = __uint_as_float(u.z << 16); o[5] = __uint_as_float(u.z & 0xffff0000u);
  o[6] = __uint_as_float(u.w << 16); o[7] = __uint_as_float(u.w & 0xffff0000u);
}
DEVI void load8bf(const u16* p, float* o) { unpack8(*(const u32x4*)p, o); }
DEVI float wave_sum(float v) {
  v += __shfl_xor(v, 32); v += __shfl_xor(v, 16); v += __shfl_xor(v, 8);
  v += __shfl_xor(v, 4); v += __shfl_xor(v, 2); v += __shfl_xor(v, 1);
  return v;
}
DEVI float red4x_sum(float v) { v += __shfl_xor(v, 16); v += __shfl_xor(v, 32); return v; }
DEVI float red4x_max(float v) { v = fmaxf(v, __shfl_xor(v, 16)); v = fmaxf(v, __shfl_xor(v, 32)); return v; }
DEVI float red16_sum(float v) {
  v += __shfl_xor(v, 1); v += __shfl_xor(v, 2); v += __shfl_xor(v, 4); v += __shfl_xor(v, 8);
  return v;
}
DEVI float red16_max(float v) {
  v = fmaxf(v, __shfl_xor(v, 1)); v = fmaxf(v, __shfl_xor(v, 2));
  v = fmaxf(v, __shfl_xor(v, 4)); v = fmaxf(v, __shfl_xor(v, 8));
  return v;
}

DEVI void conv_tile(int tid_, const float* src, int K, int N, u16* dst, int tile, char* smem, const float* gain = nullptr) {
  float (*s)[65] = (float (*)[65])smem;
  const int nN = N >> 6;
  const int tk = tile / nN, tn = tile - tk * nN;
  const int tx = tid_ & 63, ty = tid_ >> 6;
  for (int r = ty; r < 64; r += 4) s[r][tx] = src[(size_t)(tk * 64 + r) * N + tn * 64 + tx];
  __syncthreads();
  const float gk = gain ? gain[tk * 64 + tx] : 1.f;
  for (int r = ty; r < 64; r += 4) dst[(size_t)(tn * 64 + r) * K + tk * 64 + tx] = f2bf(s[tx][r] * gk);
  __syncthreads();
}

DEVI void phase_conv(int tid_, int vb_, int vg_, const Params& p, int l, char* smem) {
  u16* WB = (u16*)(p.ws + OFF_WB);
  const int c0 = 1376, c1 = c0 + 128, c2 = c1 + 128, c3 = c2 + 256, c4 = c3 + 256, c5 = c4 + 512,
            c6 = c5 + 256, c7 = c6 + 1024, c8 = c7 + 1024, c9 = c8 + 16, c10 = c9 + 16, c11 = c10 + 16;
  for (int t = vb_; t < c11; t += vg_) {
    if (t < c0) conv_tile(tid_, p.in[I_W_IN] + (size_t)l * 1024 * 5504, 1024, 5504, WB + W_IN, t, smem, p.in[I_NORM_MIX] + (size_t)l * 1024);
    else if (t < c1) conv_tile(tid_, p.in[I_W_BR_RWKV] + (size_t)l * 512 * 1024, 512, 1024, WB + W_BRR, t - c0, smem);
    else if (t < c2) conv_tile(tid_, p.in[I_W_BR_NAT] + (size_t)l * 512 * 1024, 512, 1024, WB + W_BRN, t - c1, smem);
    else if (t < c3) conv_tile(tid_, p.in[I_W_OUT] + (size_t)l * 1024 * 1024, 1024, 1024, WB + W_OUT, t - c2, smem);
    else if (t < c4) conv_tile(tid_, p.in[I_W_XQ] + (size_t)l * 1024 * 1024, 1024, 1024, WB + W_XQ, t - c3, smem, p.in[I_NORM_X] + (size_t)l * 1024);
    else if (t < c5) conv_tile(tid_, p.in[I_W_XKV] + (size_t)l * 1024 * 2048, 1024, 2048, WB + W_XKV, t - c4, smem);
    else if (t < c6) conv_tile(tid_, p.in[I_W_XO] + (size_t)l * 1024 * 1024, 1024, 1024, WB + W_XO, t - c5, smem);
    else if (t < c7) conv_tile(tid_, p.in[I_W_FF1] + (size_t)l * 1024 * 4096, 1024, 4096, WB + W_FF1, t - c6, smem, p.in[I_NORM_FF] + (size_t)l * 1024);
    else if (t < c8) conv_tile(tid_, p.in[I_W_FF2] + (size_t)l * 4096 * 1024, 4096, 1024, WB + W_FF2, t - c7, smem);
    else if (t < c9) conv_tile(tid_, p.in[I_G_UP] + (size_t)l * 128 * 512, 128, 512, WB + W_GUP, t - c8, smem);
    else if (t < c10) { const int dd = (t - c9) >> 3; conv_tile(tid_, p.in[I_W_UP] + (size_t)(l * 2 + dd) * 64 * 512, 64, 512, WB + W_WUP + (size_t)dd * 512 * 64, (t - c9) & 7, smem); }
    else { const int dd = (t - c10) >> 3; conv_tile(tid_, p.in[I_A_UP] + (size_t)(l * 2 + dd) * 64 * 512, 64, 512, WB + W_AUP + (size_t)dd * 512 * 64, (t - c10) & 7, smem); }
  }
}

DEVI void norm_row_bf16(int tid_, const float* src, const float* g, u16* dst, float* xcopy) {
  const int lane = tid_ & 63;
  float4 v[4];
  float ss = 0.f;
#pragma unroll
  for (int i = 0; i < 4; ++i) {
    v[i] = ((const float4*)src)[lane + i * 64];
    ss += v[i].x * v[i].x + v[i].y * v[i].y + v[i].z * v[i].z + v[i].w * v[i].w;
  }
  ss = wave_sum(ss);
  const float rs = rsqrtf(ss * (1.f / 1024.f) + 1e-6f);
#pragma unroll
  for (int i = 0; i < 4; ++i) {
    float4 gg = ((const float4*)g)[lane + i * 64];
    u32x2 o;
    o.x = pack2(v[i].x * rs * gg.x, v[i].y * rs * gg.y);
    o.y = pack2(v[i].z * rs * gg.z, v[i].w * rs * gg.w);
    ((u32x2*)dst)[lane + i * 64] = o;
    if (xcopy) ((float4*)xcopy)[lane + i * 64] = v[i];
  }
}

DEVI void phase_xb(int tid_, int vb_, int vg_, const Params& p, bool from_input, size_t hoff, float* ssq) {
  u16* H = (u16*)(p.ws + hoff);
  const int wid = tid_ >> 6, lane = tid_ & 63;
  for (int r = vb_ * 4 + wid; r < NTOK; r += vg_ * 4) {
    const float* src;
    if (from_input) src = (r < 32768) ? p.in[I_XP] + (size_t)r * 1024 : p.in[I_XS] + (size_t)(r - 32768) * 1024;
    else src = p.X + (size_t)r * 1024;
    float ss = 0.f;
#pragma unroll
    for (int i = 0; i < 4; ++i) {
      const float4 v = ((const float4*)src)[lane + i * 64];
      ss += v.x * v.x + v.y * v.y + v.z * v.z + v.w * v.w;
      u32x2 o;
      o.x = pack2(v.x, v.y); o.y = pack2(v.z, v.w);
      ((u32x2*)(H + (size_t)r * 1024))[lane + i * 64] = o;
      if (from_input) ((float4*)(p.X + (size_t)r * 1024))[lane + i * 64] = v;
    }
    if (from_input) {
      ss = wave_sum(ss);
      if (lane == 0) ssq[r] = ss;
    }
  }
}
DEVI void phase_norm_mem(int tid_, int vb_, int vg_, const Params& p, const float* g) {
  u16* MH = (u16*)(p.ws + OFF_MEMH);
  const int wid = tid_ >> 6;
  for (int r = vb_ * 4 + wid; r < 3072; r += vg_ * 4) {
    const float* src = (r < 2048) ? p.in[I_MP] + (size_t)r * 1024 : p.in[I_MS] + (size_t)(r - 2048) * 1024;
    norm_row_bf16(tid_, src, g, MH + (size_t)r * 1024, nullptr);
  }
}
DEVI void phase_final_norm(int tid_, int vb_, int vg_, const Params& p) {
  const float* g = p.in[I_NORM_FINAL];
  const float* ssq = (const float*)(p.ws + OFF_SSQ) + (size_t)6 * NTOK;
  const int wid = tid_ >> 6, lane = tid_ & 63;
  for (int r = vb_ * 4 + wid; r < NTOK; r += vg_ * 4) {
    float* row = p.X + (size_t)r * 1024;
    const float rs = rsqrtf(ssq[r] * (1.f / 1024.f) + 1e-6f);
#pragma unroll
    for (int i = 0; i < 4; ++i) {
      const float4 v = ((const float4*)row)[lane + i * 64];
      const float4 gg = ((const float4*)g)[lane + i * 64];
      float4 o;
      o.x = v.x * rs * gg.x; o.y = v.y * rs * gg.y; o.z = v.z * rs * gg.z; o.w = v.w * rs * gg.w;
      ((float4*)row)[lane + i * 64] = o;
    }
  }
}

template <int OFF>
DEVI bf16x8 lds_rd128(uint32_t addr) {
  bf16x8 r;
  asm volatile("ds_read_b128 %0, %1 offset:%2" : "=v"(r) : "v"(addr), "n"(OFF));
  return r;
}

template <int NW, bool SWAP>
DEVI void gemm_kloop(int tid_, f32x4 (&acc)[4][NW], const u16* __restrict__ A, int lda, const u16* __restrict__ Bt, int ldb,
                     int K, char* smem) {
  constexpr int STG = 8192 + NW * 2048;
  constexpr int NB = NW / 2;
  const int tid = tid_, lane = tid & 63, wid = tid >> 6;
  const int wr = wid >> 1, wc = wid & 1, fr = lane & 15, fq = lane >> 4;
  const int lrow = lane >> 2, lphys = lane & 3, lhi = lane >> 4;
  const int gsw = (4 - lhi) & 3;
  const u16* ga[2];
  const u16* gb[NB];
#pragma unroll
  for (int q = 0; q < 2; ++q) ga[q] = A + (size_t)((wid * 2 + q) * 16 + lrow) * lda + (lphys ^ gsw) * 8;
#pragma unroll
  for (int q = 0; q < NB; ++q) gb[q] = Bt + (size_t)((wid * NB + q) * 16 + lrow) * ldb + (lphys ^ gsw) * 8;
  const int rsw = (4 - ((fr >> 2) & 3)) & 3;
  const int ch = (fq ^ rsw) * 16;
  const int nk = K >> 5;
  const uint32_t lds_base = (uint32_t)(size_t)(__attribute__((address_space(3))) char*)smem;
  const uint32_t aoff = (uint32_t)((wr * 64 + fr) * 64 + ch);
  const uint32_t boff = (uint32_t)(8192 + (wc * 16 * NW + fr) * 64 + ch);
  asm volatile("s_waitcnt vmcnt(0)" ::: "memory");
  __syncthreads();
#define GEMM_ISSUE(kt_)                                                                                              \
  do {                                                                                                               \
    char* nb_ = smem + ((kt_) & 3) * STG;                                                                            \
    _Pragma("unroll") for (int q = 0; q < 2; ++q) __builtin_amdgcn_global_load_lds(                                  \
        (const unsigned*)(ga[q] + (kt_) * 32),                                                                       \
        (__attribute__((address_space(3))) unsigned*)(nb_ + (wid * 2 + q) * 1024 + lane * 16), 16, 0, 0);            \
    _Pragma("unroll") for (int q = 0; q < NB; ++q) __builtin_amdgcn_global_load_lds(                                 \
        (const unsigned*)(gb[q] + (kt_) * 32),                                                                       \
        (__attribute__((address_space(3))) unsigned*)(nb_ + 8192 + (wid * NB + q) * 1024 + lane * 16), 16, 0, 0);    \
  } while (0)
  GEMM_ISSUE(0);
  if (nk > 1) GEMM_ISSUE(1);
  if (nk > 2) GEMM_ISSUE(2);
  for (int kt = 0; kt < nk; ++kt) {
    if (kt + 2 < nk) {
      if (NW == 4) asm volatile("s_waitcnt vmcnt(8)" ::: "memory");
      else asm volatile("s_waitcnt vmcnt(6)" ::: "memory");
    } else if (kt + 1 < nk) {
      if (NW == 4) asm volatile("s_waitcnt vmcnt(4)" ::: "memory");
      else asm volatile("s_waitcnt vmcnt(3)" ::: "memory");
    } else {
      asm volatile("s_waitcnt vmcnt(0)" ::: "memory");
    }
    __builtin_amdgcn_s_barrier();
    asm volatile("" ::: "memory");
    if (kt + 3 < nk) GEMM_ISSUE(kt + 3);
    const uint32_t sb = lds_base + (kt & 3) * STG;
    bf16x8 af[4], bfr[4];
    af[0] = lds_rd128<0>(sb + aoff); af[1] = lds_rd128<1024>(sb + aoff);
    af[2] = lds_rd128<2048>(sb + aoff); af[3] = lds_rd128<3072>(sb + aoff);
    bfr[0] = lds_rd128<0>(sb + boff); bfr[1] = lds_rd128<1024>(sb + boff);
    if (NW == 4) {
      bfr[2] = lds_rd128<2048>(sb + boff); bfr[3] = lds_rd128<3072>(sb + boff);
      asm volatile("s_waitcnt lgkmcnt(0)" : "+v"(af[0]), "+v"(af[1]), "+v"(af[2]), "+v"(af[3]),
                   "+v"(bfr[0]), "+v"(bfr[1]), "+v"(bfr[2]), "+v"(bfr[3]));
    } else {
      asm volatile("s_waitcnt lgkmcnt(0)" : "+v"(af[0]), "+v"(af[1]), "+v"(af[2]), "+v"(af[3]), "+v"(bfr[0]), "+v"(bfr[1]));
    }
#pragma unroll
    for (int m = 0; m < 4; ++m)
#pragma unroll
      for (int n = 0; n < NW; ++n) {
        if (SWAP) acc[m][n] = __builtin_amdgcn_mfma_f32_16x16x32_bf16(bfr[n], af[m], acc[m][n], 0, 0, 0);
        else acc[m][n] = __builtin_amdgcn_mfma_f32_16x16x32_bf16(af[m], bfr[n], acc[m][n], 0, 0, 0);
      }
  }
#undef GEMM_ISSUE
}

DEVI int launder(int x) { asm volatile("" : "+v"(x)); return x; }

template <int NW>
DEVI void zero_acc(f32x4 (&acc)[4][NW]) {
#pragma unroll
  for (int m = 0; m < 4; ++m)
#pragma unroll
    for (int n = 0; n < NW; ++n) acc[m][n] = (f32x4){0.f, 0.f, 0.f, 0.f};
}

struct NoEpi { DEVI void operator()(int, int, f32x4) const {} };

template <class EpiS, class EpiN>
DEVI void gemm_phase(int tid_, const u16* A, int lda, const u16* Bt, int ldb, int K, int M, int N, char* smem, int ns_from,
                     EpiS epiS, EpiN epiN) {
  const int nN = N >> 7, nM = M >> 7;
  const int lane = tid_ & 63, wid = tid_ >> 6;
  const int wr = wid >> 1, wc = wid & 1, fr = lane & 15, fq = lane >> 4;
  const int xcd = blockIdx.x & 7, jloc = blockIdx.x >> 3, nloc = gridDim.x >> 3;
  for (int lt = jloc; lt < (nM >> 3) * nN; lt += nloc) {
    const int tml = lt / nN, tn = lt - tml * nN;
    const int tm = tml * 8 + xcd;
    const int m0 = tm << 7, n0 = tn << 7;
    f32x4 acc[4][4];
    zero_acc(acc);
    if (n0 < ns_from) {
      gemm_kloop<4, true>(tid_, acc, A + (size_t)m0 * lda, lda, Bt + (size_t)n0 * ldb, ldb, K, smem);
#pragma unroll
      for (int m = 0; m < 4; ++m)
#pragma unroll
        for (int n = 0; n < 4; ++n) epiS(m0 + wr * 64 + m * 16 + fr, n0 + wc * 64 + n * 16 + fq * 4, acc[m][n]);
    } else {
      gemm_kloop<4, false>(tid_, acc, A + (size_t)m0 * lda, lda, Bt + (size_t)n0 * ldb, ldb, K, smem);
#pragma unroll
      for (int m = 0; m < 4; ++m)
#pragma unroll
        for (int n = 0; n < 4; ++n) epiN(m0 + wr * 64 + m * 16 + fq * 4, n0 + wc * 64 + n * 16 + fr, acc[m][n]);
    }
  }
}


template <bool SWAP>
DEVI void gemm_kloop_big(int tid_, f32x4 (&acc)[8][4], const u16* __restrict__ A, int lda, const u16* __restrict__ Bt,
                         int ldb, int K, char* smem) {
  constexpr int STG = 16384 + 8192;
  const int tid = tid_, lane = tid & 63, wid = tid >> 6;
  const int wr = wid >> 1, wc = wid & 1, fr = lane & 15, fq = lane >> 4;
  const int lrow = lane >> 2, lphys = lane & 3, lhi = lane >> 4;
  const int gsw = (4 - lhi) & 3;
  const u16* ga = A + (size_t)(wid * 64 + lrow) * lda + (lphys ^ gsw) * 8;
  const u16* gb = Bt + (size_t)(wid * 32 + lrow) * ldb + (lphys ^ gsw) * 8;
  const size_t a16 = (size_t)16 * lda, b16 = (size_t)16 * ldb;
  const int rsw = (4 - ((fr >> 2) & 3)) & 3;
  const int ch = (fq ^ rsw) * 16;
  const int nk = K >> 5;
  const uint32_t lds_base = (uint32_t)(size_t)(__attribute__((address_space(3))) char*)smem;
  const uint32_t aoff = (uint32_t)((wr * 128 + fr) * 64 + ch);
  const uint32_t boff = (uint32_t)(16384 + (wc * 64 + fr) * 64 + ch);
  asm volatile("s_waitcnt vmcnt(0)" ::: "memory");
  __syncthreads();
#define GEMMB_ISSUE(kt_, buf_)                                                                                       \
  do {                                                                                                               \
    char* nb_ = smem + (buf_) * STG;                                                                                 \
    _Pragma("unroll") for (int q = 0; q < 4; ++q) __builtin_amdgcn_global_load_lds(                                  \
        (const unsigned*)(ga + q * a16 + (kt_) * 32),                                                                \
        (__attribute__((address_space(3))) unsigned*)(nb_ + (wid * 4 + q) * 1024 + lane * 16), 16, 0, 0);            \
    _Pragma("unroll") for (int q = 0; q < 2; ++q) __builtin_amdgcn_global_load_lds(                                  \
        (const unsigned*)(gb + q * b16 + (kt_) * 32),                                                                \
        (__attribute__((address_space(3))) unsigned*)(nb_ + 16384 + (wid * 2 + q) * 1024 + lane * 16), 16, 0, 0);   \
  } while (0)
  GEMMB_ISSUE(0, 0);
  if (nk > 1) GEMMB_ISSUE(1, 1);
  int cb = 0;
  for (int kt = 0; kt < nk; ++kt) {
    if (kt + 1 < nk) asm volatile("s_waitcnt vmcnt(6)" ::: "memory");
    else asm volatile("s_waitcnt vmcnt(0)" ::: "memory");
    __builtin_amdgcn_s_barrier();
    asm volatile("" ::: "memory");
    const int nbuf = (cb == 0) ? 2 : cb - 1;
    if (kt + 2 < nk) GEMMB_ISSUE(kt + 2, nbuf);
    const uint32_t sb = lds_base + cb * STG;
    bf16x8 a0[4], a1[4], bb[4];
    a0[0] = lds_rd128<0>(sb + aoff); a0[1] = lds_rd128<1024>(sb + aoff);
    a0[2] = lds_rd128<2048>(sb + aoff); a0[3] = lds_rd128<3072>(sb + aoff);
    bb[0] = lds_rd128<0>(sb + boff); bb[1] = lds_rd128<1024>(sb + boff);
    bb[2] = lds_rd128<2048>(sb + boff); bb[3] = lds_rd128<3072>(sb + boff);
    a1[0] = lds_rd128<4096>(sb + aoff); a1[1] = lds_rd128<5120>(sb + aoff);
    a1[2] = lds_rd128<6144>(sb + aoff); a1[3] = lds_rd128<7168>(sb + aoff);
    asm volatile("s_waitcnt lgkmcnt(4)" : "+v"(a0[0]), "+v"(a0[1]), "+v"(a0[2]), "+v"(a0[3]),
                 "+v"(bb[0]), "+v"(bb[1]), "+v"(bb[2]), "+v"(bb[3]));
#pragma unroll
    for (int m = 0; m < 4; ++m)
#pragma unroll
      for (int n = 0; n < 4; ++n) {
        if (SWAP) acc[m][n] = __builtin_amdgcn_mfma_f32_16x16x32_bf16(bb[n], a0[m], acc[m][n], 0, 0, 0);
        else acc[m][n] = __builtin_amdgcn_mfma_f32_16x16x32_bf16(a0[m], bb[n], acc[m][n], 0, 0, 0);
      }
    asm volatile("s_waitcnt lgkmcnt(0)" : "+v"(a1[0]), "+v"(a1[1]), "+v"(a1[2]), "+v"(a1[3]));
#pragma unroll
    for (int m = 0; m < 4; ++m)
#pragma unroll
      for (int n = 0; n < 4; ++n) {
        if (SWAP) acc[4 + m][n] = __builtin_amdgcn_mfma_f32_16x16x32_bf16(bb[n], a1[m], acc[4 + m][n], 0, 0, 0);
        else acc[4 + m][n] = __builtin_amdgcn_mfma_f32_16x16x32_bf16(a1[m], bb[n], acc[4 + m][n], 0, 0, 0);
      }
    cb = (cb == 2) ? 0 : cb + 1;
  }
#undef GEMMB_ISSUE
}

template <class EpiS, class EpiN>
DEVI void gemm_phase_big(int tid_, const u16* A, int lda, const u16* Bt, int ldb, int K, int M, int N, char* smem,
                         int ns_from, EpiS epiS, EpiN epiN) {
  const int nN = N >> 7, nM = M >> 8;
  const int lane = tid_ & 63, wid = tid_ >> 6;
  const int wr = wid >> 1, wc = wid & 1, fr = lane & 15, fq = lane >> 4;
  const int xcd = blockIdx.x & 7, jloc = blockIdx.x >> 3, nloc = gridDim.x >> 3;
  for (int lt = jloc; lt < (nM >> 3) * nN; lt += nloc) {
    const int tml = lt / nN, tn = lt - tml * nN;
    const int tm = tml * 8 + xcd;
    const int m0 = tm << 8, n0 = tn << 7;
    f32x4 acc[8][4];
#pragma unroll
    for (int m = 0; m < 8; ++m)
#pragma unroll
      for (int n = 0; n < 4; ++n) acc[m][n] = (f32x4){0.f, 0.f, 0.f, 0.f};
    if (n0 < ns_from) {
      gemm_kloop_big<true>(launder(tid_), acc, A + (size_t)m0 * lda, lda, Bt + (size_t)n0 * ldb, ldb, K, smem);
#pragma unroll
      for (int m = 0; m < 8; ++m)
#pragma unroll
        for (int n = 0; n < 4; ++n) epiS(m0 + wr * 128 + m * 16 + fr, n0 + wc * 64 + n * 16 + fq * 4, acc[m][n]);
    } else {
      gemm_kloop_big<false>(launder(tid_), acc, A + (size_t)m0 * lda, lda, Bt + (size_t)n0 * ldb, ldb, K, smem);
#pragma unroll
      for (int m = 0; m < 8; ++m)
#pragma unroll
        for (int n = 0; n < 4; ++n) epiN(m0 + wr * 128 + m * 16 + fq * 4, n0 + wc * 64 + n * 16 + fr, acc[m][n]);
    }
  }
}


template <bool SWAP>
DEVI void gemm_kloop8(int tid_, f32x4 (&acc)[8][4], const u16* __restrict__ A, int lda, const u16* __restrict__ Bt,
                      int ldb, int K, char* smem) {
  constexpr int STG = 65536;
  const int tid = tid_, lane = tid & 63, wid = tid >> 6;
  const int wr = wid >> 2, wc = wid & 3, fr = lane & 15, fq = lane >> 4;
  const int lrow = lane >> 3, lphys = lane & 7, lhi = lane >> 4;
  const u16* ga[4];
  const u16* gb[4];
#pragma unroll
  for (int q = 0; q < 4; ++q) {
    const int kc = lphys ^ ((4 * (q & 1) + lhi) & 7);
    ga[q] = A + (size_t)((wid * 4 + q) * 8 + lrow) * lda + kc * 8;
    gb[q] = Bt + (size_t)((wid * 4 + q) * 8 + lrow) * ldb + kc * 8;
  }
  const int swz = (fr >> 1) & 7;
  const int nk = K >> 6;
  const uint32_t lds_base = (uint32_t)(size_t)(__attribute__((address_space(3))) char*)smem;
  const uint32_t arow = (uint32_t)((wr * 128 + fr) * 128);
  const uint32_t brow = (uint32_t)(32768 + (wc * 64 + fr) * 128);
  asm volatile("s_waitcnt vmcnt(0)" ::: "memory");
  __syncthreads();
#define GEMM8_ISSUE(kt_)                                                                                             \
  do {                                                                                                               \
    char* nb_ = smem + ((kt_) & 1) * STG;                                                                            \
    _Pragma("unroll") for (int q = 0; q < 4; ++q) __builtin_amdgcn_global_load_lds(                                  \
        (const unsigned*)(ga[q] + (kt_) * 64),                                                                       \
        (__attribute__((address_space(3))) unsigned*)(nb_ + (wid * 4 + q) * 1024 + lane * 16), 16, 0, 0);            \
    _Pragma("unroll") for (int q = 0; q < 4; ++q) __builtin_amdgcn_global_load_lds(                                  \
        (const unsigned*)(gb[q] + (kt_) * 64),                                                                       \
        (__attribute__((address_space(3))) unsigned*)(nb_ + 32768 + (wid * 4 + q) * 1024 + lane * 16), 16, 0, 0);    \
  } while (0)
  GEMM8_ISSUE(0);
  for (int kt = 0; kt < nk; ++kt) {
    asm volatile("s_waitcnt vmcnt(0)" ::: "memory");
    __builtin_amdgcn_s_barrier();
    asm volatile("" ::: "memory");
    if (kt + 1 < nk) GEMM8_ISSUE(kt + 1);
    const uint32_t sb = lds_base + (kt & 1) * STG;
#pragma unroll
    for (int ks = 0; ks < 2; ++ks) {
      const uint32_t chb = (uint32_t)(((ks * 4 + fq) ^ swz) * 16);
      const uint32_t aoff = sb + arow + chb, boff = sb + brow + chb;
      bf16x8 a0[4], a1[4], bb[4];
      a0[0] = lds_rd128<0>(aoff); a0[1] = lds_rd128<2048>(aoff);
      a0[2] = lds_rd128<4096>(aoff); a0[3] = lds_rd128<6144>(aoff);
      bb[0] = lds_rd128<0>(boff); bb[1] = lds_rd128<2048>(boff);
      bb[2] = lds_rd128<4096>(boff); bb[3] = lds_rd128<6144>(boff);
      a1[0] = lds_rd128<8192>(aoff); a1[1] = lds_rd128<10240>(aoff);
      a1[2] = lds_rd128<12288>(aoff); a1[3] = lds_rd128<14336>(aoff);
      asm volatile("s_waitcnt lgkmcnt(4)" : "+v"(a0[0]), "+v"(a0[1]), "+v"(a0[2]), "+v"(a0[3]),
                   "+v"(bb[0]), "+v"(bb[1]), "+v"(bb[2]), "+v"(bb[3]));
#pragma unroll
      for (int m = 0; m < 4; ++m)
#pragma unroll
        for (int n = 0; n < 4; ++n) {
          if (SWAP) acc[m][n] = __builtin_amdgcn_mfma_f32_16x16x32_bf16(bb[n], a0[m], acc[m][n], 0, 0, 0);
          else acc[m][n] = __builtin_amdgcn_mfma_f32_16x16x32_bf16(a0[m], bb[n], acc[m][n], 0, 0, 0);
        }
      asm volatile("s_waitcnt lgkmcnt(0)" : "+v"(a1[0]), "+v"(a1[1]), "+v"(a1[2]), "+v"(a1[3]));
#pragma unroll
      for (int m = 0; m < 4; ++m)
#pragma unroll
        for (int n = 0; n < 4; ++n) {
          if (SWAP) acc[4 + m][n] = __builtin_amdgcn_mfma_f32_16x16x32_bf16(bb[n], a1[m], acc[4 + m][n], 0, 0, 0);
          else acc[4 + m][n] = __builtin_amdgcn_mfma_f32_16x16x32_bf16(a1[m], bb[n], acc[4 + m][n], 0, 0, 0);
        }
    }
  }
#undef GEMM8_ISSUE
}

struct NoRow { DEVI void operator()(int) const {} };

template <class EpiS, class EpiN, class RowEnd = NoRow>
DEVI void gemm_phase8(int tid_, const u16* A, int lda, const u16* Bt, int ldb, int K, int M, int N, char* smem,
                      int ns_from, EpiS epiS, EpiN epiN, RowEnd rowEnd = NoRow(), int rot = 0) {
  const int nN = (N + 255) >> 8, nM = M >> 8;
  const int lane = tid_ & 63, wid = tid_ >> 6;
  const int wr = wid >> 2, wc = wid & 3, fr = lane & 15, fq = lane >> 4;
  const bool xmap = ((gridDim.x & 7) == 0) && ((nM & 7) == 0);
  const int xcd = blockIdx.x & 7;
  const int first = xmap ? (int)(blockIdx.x >> 3) : (int)((blockIdx.x + gridDim.x - rot) % gridDim.x);
  const int stride = xmap ? (int)(gridDim.x >> 3) : (int)gridDim.x;
  const int count = xmap ? (nM >> 3) * nN : nM * nN;
  for (int it = first; it < count; it += stride) {
    const int tq = it / nN, tn = it - tq * nN;
    const int tm = xmap ? tq * 8 + xcd : tq;
    const int m0 = tm << 8, n0 = tn << 8;
    const int colb = n0 + wc * 64;
    f32x4 acc[8][4];
#pragma unroll
    for (int m = 0; m < 8; ++m)
#pragma unroll
      for (int n = 0; n < 4; ++n) acc[m][n] = (f32x4){0.f, 0.f, 0.f, 0.f};
    if (colb < ns_from) {
      gemm_kloop8<true>(launder(tid_), acc, A + (size_t)m0 * lda, lda, Bt + (size_t)n0 * ldb, ldb, K, smem);
      if (colb < N) {
#pragma unroll
        for (int m = 0; m < 8; ++m) {
#pragma unroll
          for (int n = 0; n < 4; ++n) epiS(m0 + wr * 128 + m * 16 + fr, colb + n * 16 + fq * 4, acc[m][n]);
          rowEnd(m0 + wr * 128 + m * 16 + fr);
        }
      }
    } else {
      gemm_kloop8<false>(launder(tid_), acc, A + (size_t)m0 * lda, lda, Bt + (size_t)n0 * ldb, ldb, K, smem);
      if (colb < N) {
#pragma unroll
        for (int m = 0; m < 8; ++m)
#pragma unroll
          for (int n = 0; n < 4; ++n) epiN(m0 + wr * 128 + m * 16 + fq * 4, colb + n * 16 + fr, acc[m][n]);
      }
    }
  }
}

DEVI void store4bf(u16* dst, f32x4 v) {
  u32x2 o;
  o.x = pack2(v[0], v[1]); o.y = pack2(v[2], v[3]);
  *(u32x2*)dst = o;
}

DEVI float rstd_of(const float* ssq, int r) { return rsqrtf(ssq[r] * (1.f / 1024.f) + 1e-6f); }

DEVI void phase_p_gemm(int tid_, const Params& p, char* smem, const float* ssq) {
  u16* WB = (u16*)(p.ws + OFF_WB);
  const u16* H = (const u16*)(p.ws + OFF_H);
  u16* PR = (u16*)(p.ws + OFF_PR);
  u16* NQ = (u16*)(p.ws + OFF_NQ);
  u16* NK = (u16*)(p.ws + OFF_NK);
  u16* NVT = (u16*)(p.ws + OFF_NV);
  gemm_phase8(tid_, H, 1024, WB + W_IN, 1024, 1024, NTOK, 3456, smem, 2944,
    [&](int r, int c0, f32x4 v) {
      v = v * rstd_of(ssq, r);
      if (c0 < 1920) store4bf(PR + (size_t)r * PRW + c0, v);
      else if (c0 < 2432) store4bf(NQ + (size_t)r * 512 + (c0 - 1920), v);
      else store4bf(NK + (size_t)r * 512 + (c0 - 2432), v);
    },
    [&](int r0, int c, f32x4 v) {
      const int cc = c - 2944;
      const int s = r0 >> 12, t = r0 & 4095;
      const f32x4 q = *(const f32x4*)(ssq + r0);
#pragma unroll
      for (int j = 0; j < 4; ++j) v[j] *= rsqrtf(q[j] * (1.f / 1024.f) + 1e-6f);
      store4bf(NVT + ((size_t)(s * 512 + cc)) * 4096 + t, v);
    });
  const u16* MH = (const u16*)(p.ws + OFF_MEMH);
  u16* KVK = (u16*)(p.ws + OFF_KVK);
  u16* KVT = (u16*)(p.ws + OFF_KVT);
  gemm_phase8(tid_, MH, 1024, WB + W_XKV, 1024, 1024, 3072, 2048, smem, 1024,
    [&](int r, int c0, f32x4 v) { store4bf(KVK + (size_t)r * 1024 + c0, v); },
    [&](int r0, int c, f32x4 v) {
      const int cc = c - 1024;
      const int s = r0 >> 8, m = r0 & 255;
      store4bf(KVT + ((size_t)(s * 1024 + cc)) * 256 + m, v);
    }, NoRow(), 128);
}

DEVI void phase_nat(int tid_, const Params& p, int l, char* smem, int bfirst, int bstride) {
  u16* NQ = (u16*)(p.ws + OFF_NQ);
  const u16* NK = (const u16*)(p.ws + OFF_NK);
  const u16* NVT = (const u16*)(p.ws + OFF_NV);
  const float* rpb = p.in[I_RPB] + (size_t)l * 8 * 15 * 31;
  const int lane = tid_ & 63, g = tid_ >> 6, fr = lane & 15, fq = lane >> 4;
  u16* Pw = (u16*)smem + g * (16 * 264);
  const int cb = (g == 0) ? 0 : (g == 1) ? 8 : (g == 2) ? 24 : 32;
  const int c = g * 16 + fr;
  int cs = c - 8; cs = cs < 0 ? 0 : (cs > 48 ? 48 : cs);
  for (int t = bfirst; t < 12 * 64 * 8; t += bstride) {
    const int h = t & 7, ri = (t >> 3) & 63, s = t >> 9;
    int rs = ri - 4; rs = rs < 0 ? 0 : (rs > 56 ? 56 : rs);
    const size_t tokq = (size_t)s * 4096 + ri * 64 + g * 16;
    bf16x8 aq[2];
    aq[0] = *(const bf16x8*)(NQ + (tokq + fr) * 512 + h * 64 + fq * 8);
    aq[1] = *(const bf16x8*)(NQ + (tokq + fr) * 512 + h * 64 + 32 + fq * 8);
    f32x4 acc[16];
#pragma unroll
    for (int n = 0; n < 16; ++n) {
      acc[n] = (f32x4){0.f, 0.f, 0.f, 0.f};
      const int r = n >> 1, col = cb + (n & 1) * 16 + fr;
      const u16* kp = NK + ((size_t)s * 4096 + (rs + r) * 64 + col) * 512 + h * 64 + fq * 8;
      const bf16x8 b0 = *(const bf16x8*)kp;
      const bf16x8 b1 = *(const bf16x8*)(kp + 32);
      acc[n] = __builtin_amdgcn_mfma_f32_16x16x32_bf16(b0, aq[0], acc[n], 0, 0, 0);
      acc[n] = __builtin_amdgcn_mfma_f32_16x16x32_bf16(b1, aq[1], acc[n], 0, 0, 0);
    }
    float m = -1e30f;
#pragma unroll
    for (int n = 0; n < 16; ++n) {
      const int di = rs + (n >> 1) - ri + 7;
      const float* brow = rpb + (h * 15 + di) * 31 + 15 - c;
#pragma unroll
      for (int j = 0; j < 4; ++j) {
        const int kc = cb + (n & 1) * 16 + fq * 4 + j;
        float sc = -1e30f;
        if (kc >= cs && kc < cs + 16) sc = acc[n][j] * 0.125f + brow[kc];
        acc[n][j] = sc;
        m = fmaxf(m, sc);
      }
    }
    m = red4x_max(m);
    float ssum = 0.f;
#pragma unroll
    for (int n = 0; n < 16; ++n) {
      f32x4 e;
#pragma unroll
      for (int j = 0; j < 4; ++j) { e[j] = __expf(acc[n][j] - m); ssum += e[j]; }
      store4bf(Pw + fr * 264 + n * 16 + fq * 4, e);
    }
    const float sm = 1.f / red4x_sum(ssum);
    f32x4 o[4];
#pragma unroll
    for (int n = 0; n < 4; ++n) o[n] = (f32x4){0.f, 0.f, 0.f, 0.f};
#pragma unroll
    for (int ks = 0; ks < 8; ++ks) {
      const bf16x8 ap = *(const bf16x8*)(Pw + fr * 264 + ks * 32 + fq * 8);
#pragma unroll
      for (int n = 0; n < 4; ++n) {
        const bf16x8 bv = *(const bf16x8*)(NVT + ((size_t)(s * 512 + h * 64 + n * 16 + fr)) * 4096 + (rs + ks) * 64 + cb + fq * 8);
        o[n] = __builtin_amdgcn_mfma_f32_16x16x32_bf16(bv, ap, o[n], 0, 0, 0);
      }
    }
#pragma unroll
    for (int n = 0; n < 4; ++n) store4bf(NQ + (tokq + fr) * 512 + h * 64 + n * 16 + fq * 4, o[n] * sm);
  }
}

constexpr int SC_OPS = 0;
constexpr int SC_VV = 40960;
constexpr int SC_WR = 49152;
constexpr int SC_AP = 57344;
constexpr int SC_TW = 65536;
constexpr int SC_AD = 70144;
constexpr int SC_NRM = 74752;
constexpr int SC_MU = 74880;
constexpr int SC_CST = 77440;

typedef __attribute__((ext_vector_type(2))) float f32x2;

template <int CTRL>
DEVI float dpp_mov(float x) {
  return __int_as_float(__builtin_amdgcn_update_dpp(0, __float_as_int(x), CTRL, 0xF, 0xF, true));
}
DEVI float red8(float x) {
  x += dpp_mov<0xB1>(x);
  x += dpp_mov<0x4E>(x);
  x += dpp_mov<0x141>(x);
  return x;
}
DEVI f32x2 lo2(f32x4 v) { return __builtin_shufflevector(v, v, 0, 1); }
DEVI f32x2 hi2(f32x4 v) { return __builtin_shufflevector(v, v, 2, 3); }

struct ScanOps {
  f32x2 a[4], w[4], b[4], k[4], r[4];
  float v0, v1;
};
DEVI void scan_load(ScanOps& o, const float* OPS, const float* VV, int nn, int jg, int i0) {
  const float* base = OPS + nn * 64 + jg * 8;
  f32x4 t0, t1;
  t0 = *(const f32x4*)(base); t1 = *(const f32x4*)(base + 4);
  o.a[0] = lo2(t0); o.a[1] = hi2(t0); o.a[2] = lo2(t1); o.a[3] = hi2(t1);
  t0 = *(const f32x4*)(base + 2048); t1 = *(const f32x4*)(base + 2048 + 4);
  o.w[0] = lo2(t0); o.w[1] = hi2(t0); o.w[2] = lo2(t1); o.w[3] = hi2(t1);
  t0 = *(const f32x4*)(base + 4096); t1 = *(const f32x4*)(base + 4096 + 4);
  o.b[0] = lo2(t0); o.b[1] = hi2(t0); o.b[2] = lo2(t1); o.b[3] = hi2(t1);
  t0 = *(const f32x4*)(base + 6144); t1 = *(const f32x4*)(base + 6144 + 4);
  o.k[0] = lo2(t0); o.k[1] = hi2(t0); o.k[2] = lo2(t1); o.k[3] = hi2(t1);
  t0 = *(const f32x4*)(base + 8192); t1 = *(const f32x4*)(base + 8192 + 4);
  o.r[0] = lo2(t0); o.r[1] = hi2(t0); o.r[2] = lo2(t1); o.r[3] = hi2(t1);
  o.v0 = VV[nn * 64 + i0];
  o.v1 = VV[nn * 64 + i0 + 8];
}
DEVI void scan_step(const ScanOps& o, f32x2 (&S0)[4], f32x2 (&S1)[4], float* YL, int nn, int jg, int i0) {
  f32x2 d0 = S0[0] * o.a[0], d0b = S0[2] * o.a[2];
  f32x2 d1 = S1[0] * o.a[0], d1b = S1[2] * o.a[2];
  d0 = S0[1] * o.a[1] + d0; d0b = S0[3] * o.a[3] + d0b;
  d1 = S1[1] * o.a[1] + d1; d1b = S1[3] * o.a[3] + d1b;
  d0 += d0b; d1 += d1b;
  const float sa0 = red8(d0.x + d0.y);
  const float sa1 = red8(d1.x + d1.y);
  f32x2 e0 = {0.f, 0.f}, e1 = {0.f, 0.f};
#pragma unroll
  for (int q = 0; q < 4; ++q) {
    const f32x2 u0 = sa0 * o.b[q] + o.v0 * o.k[q];
    const f32x2 u1 = sa1 * o.b[q] + o.v1 * o.k[q];
    S0[q] = S0[q] * o.w[q] + u0;
    S1[q] = S1[q] * o.w[q] + u1;
    e0 = S0[q] * o.r[q] + e0;
    e1 = S1[q] * o.r[q] + e1;
  }
  const float y0 = red8(e0.x + e0.y);
  const float y1 = red8(e1.x + e1.y);
  YL[nn * 64 + i0] = y0; YL[nn * 64 + i0 + 8] = y1;
}

DEVI void phase_scan(int tid_, const Params& p, int l, char* smem, int bfirst, int bstride) {
  const u16* PR = (const u16*)(p.ws + OFF_PR);
  _Float16* YF = (_Float16*)(p.ws + OFF_H);
  _Float16* YB = (_Float16*)(p.ws + OFF_H + (size_t)NTOK * 512 * 2);
  float* BON = (float*)(p.ws + OFF_BONUS);
  const u16* WB = (const u16*)(p.ws + OFF_WB);
  float* OPS = (float*)(smem + SC_OPS);
  u16* RAW = (u16*)(smem + SC_OPS);
  float* VV = (float*)(smem + SC_VV);
  float* WR = (float*)(smem + SC_WR);
  float* AP = (float*)(smem + SC_AP);
  float* YL = WR;
  u16* TWb = (u16*)(smem + SC_TW);
  u16* ADb = (u16*)(smem + SC_AD);
  float* NRM = (float*)(smem + SC_NRM);
  float* MU = (float*)(smem + SC_MU);
  float* CST = (float*)(smem + SC_CST);
  const float* mu_p = p.in[I_MU_PREV] + (size_t)l * 1920;
  const float* mu_n = p.in[I_MU_NEXT] + (size_t)l * 1920;
  const int tid = tid_, lane = tid & 63, w = tid >> 6, fr = lane & 15, fq = lane >> 4;
  const int pn = tid >> 3, j0 = (tid & 7) * 8;
  const int jg = lane & 7, i0 = w * 16 + (lane >> 3);
  const int hr = (tid >= 40) ? 1 : 0, hc = tid - hr * 40;
  for (int blk = bfirst; blk < 192; blk += bstride) {
    const int s = blk >> 4, h = (blk >> 1) & 7, d = blk & 1;
    __syncthreads();
    for (int i = tid; i < 640; i += 256) {
      const int which = (i >= 320) ? 1 : 0, c = i - which * 320;
      const int g = c >> 6, e = c & 63;
      const int col = (g < 3) ? (g * 512 + h * 64 + e) : (1536 + (g - 3) * 128 + d * 64 + e);
      MU[i] = which ? mu_n[col] : mu_p[col];
    }
    for (int i = tid; i < 320; i += 256) {
      const int which = i >> 6, e = i & 63;
      float v;
      if (which == 0) v = p.in[I_W0][(size_t)(l * 2 + d) * 512 + h * 64 + e];
      else if (which == 1) v = p.in[I_A0][(size_t)(l * 2 + d) * 512 + h * 64 + e];
      else if (which == 2) v = p.in[I_K_K][(size_t)l * 512 + h * 64 + e];
      else if (which == 3) v = p.in[I_K_A][(size_t)l * 512 + h * 64 + e];
      else v = p.in[I_R_K][(size_t)(l * 8 + h) * 64 + e];
      CST[i] = v;
    }
    bf16x8 bw[2], ba[2];
#pragma unroll
    for (int ks = 0; ks < 2; ++ks) {
      bw[ks] = *(const bf16x8*)(WB + W_WUP + (size_t)(d * 512 + h * 64 + w * 16 + fr) * 64 + ks * 32 + fq * 8);
      ba[ks] = *(const bf16x8*)(WB + W_AUP + (size_t)(d * 512 + h * 64 + w * 16 + fr) * 64 + ks * 32 + fq * 8);
    }
    _Float16* Y = d ? YB : YF;
    f32x2 S0[4], S1[4];
#pragma unroll
    for (int q = 0; q < 4; ++q) { S0[q] = (f32x2){0.f, 0.f}; S1[q] = (f32x2){0.f, 0.f}; }
    u32x4 G[5], GH;
    {
      const int t = d ? (4095 - pn) : pn;
      const size_t tok = (size_t)s * 4096 + t;
#pragma unroll
      for (int g = 0; g < 5; ++g) {
        const int col = (g < 3) ? (g * 512 + h * 64) : (1536 + (g - 3) * 128 + d * 64);
        G[g] = *(const u32x4*)(PR + tok * PRW + col + j0);
      }
      GH = (u32x4){0u, 0u, 0u, 0u};
      if (tid < 80) {
        const int tlo = d ? (4095 - 31) : 0;
        const int th = hr ? (tlo + 32) : (tlo - 1);
        const int g = hc >> 3;
        const int col = (g < 3) ? (g * 512 + h * 64) : (1536 + (g - 3) * 128 + d * 64);
        if (th >= 0 && th <= 4095) GH = *(const u32x4*)(PR + ((size_t)s * 4096 + th) * PRW + col + (hc & 7) * 8);
      }
    }
#pragma unroll 1
    for (int ch = 0; ch < 128; ++ch) {
      const int n = ch * 32 + pn;
      const int t = d ? (4095 - n) : n;
      const size_t tok = (size_t)s * 4096 + t;
      const int tlo = d ? (4095 - (ch * 32 + 31)) : (ch * 32);
      const int rrow = t - tlo + 1;
#pragma unroll
      for (int g = 0; g < 5; ++g) *(u32x4*)(RAW + rrow * 320 + g * 64 + j0) = G[g];
      if (tid < 80) *(u32x4*)(RAW + (hr ? 33 : 0) * 320 + (hc >> 3) * 64 + (hc & 7) * 8) = GH;
      __syncthreads();
      if (ch + 1 < 128) {
        const int n2 = n + 32;
        const int t2 = d ? (4095 - n2) : n2;
        const size_t tok2 = (size_t)s * 4096 + t2;
#pragma unroll
        for (int g = 0; g < 5; ++g) {
          const int col = (g < 3) ? (g * 512 + h * 64) : (1536 + (g - 3) * 128 + d * 64);
          G[g] = *(const u32x4*)(PR + tok2 * PRW + col + j0);
        }
        GH = (u32x4){0u, 0u, 0u, 0u};
        if (tid < 80) {
          const int tlo2 = d ? (tlo - 32) : (tlo + 32);
          const int th = hr ? (tlo2 + 32) : (tlo2 - 1);
          const int g = hc >> 3;
          const int col = (g < 3) ? (g * 512 + h * 64) : (1536 + (g - 3) * 128 + d * 64);
          if (th >= 0 && th <= 4095) GH = *(const u32x4*)(PR + ((size_t)s * 4096 + th) * PRW + col + (hc & 7) * 8);
        }
      }
#pragma unroll
      for (int g = 0; g < 5; ++g) {
        float cur[8], prv[8], nxt[8];
        load8bf(RAW + rrow * 320 + g * 64 + j0, cur);
        load8bf(RAW + (rrow - 1) * 320 + g * 64 + j0, prv);
        load8bf(RAW + (rrow + 1) * 320 + g * 64 + j0, nxt);
        const f32x4 mp0 = *(const f32x4*)(MU + g * 64 + j0), mp1 = *(const f32x4*)(MU + g * 64 + j0 + 4);
        const f32x4 mn0 = *(const f32x4*)(MU + 320 + g * 64 + j0), mn1 = *(const f32x4*)(MU + 320 + g * 64 + j0 + 4);
        f32x4 x0, x1;
#pragma unroll
        for (int e = 0; e < 4; ++e) {
          x0[e] = cur[e] + mp0[e] * (prv[e] - cur[e]) + mn0[e] * (nxt[e] - cur[e]);
          x1[e] = cur[4 + e] + mp1[e] * (prv[4 + e] - cur[4 + e]) + mn1[e] * (nxt[4 + e] - cur[4 + e]);
        }
        if (g == 0) {
          *(f32x4*)(OPS + 4 * 2048 + pn * 64 + j0) = x0; *(f32x4*)(OPS + 4 * 2048 + pn * 64 + j0 + 4) = x1;
        } else if (g == 1) {
          *(f32x4*)(OPS + 3 * 2048 + pn * 64 + j0) = x0; *(f32x4*)(OPS + 3 * 2048 + pn * 64 + j0 + 4) = x1;
          const f32x4 kk0 = *(const f32x4*)(CST + 128 + j0), kk1 = *(const f32x4*)(CST + 128 + j0 + 4);
          float ss = 0.f;
#pragma unroll
          for (int e = 0; e < 4; ++e) { const float a_ = x0[e] * kk0[e], b_ = x1[e] * kk1[e]; ss += a_ * a_ + b_ * b_; }
          ss = red8(ss);
          if ((tid & 7) == 0) NRM[pn] = frcp(fmaxf(__builtin_amdgcn_sqrtf(ss), 1e-12f));
        } else if (g == 2) {
          *(f32x4*)(VV + pn * 64 + j0) = x0; *(f32x4*)(VV + pn * 64 + j0 + 4) = x1;
        } else if (g == 3) {
          u32x4 pk;
          pk.x = pack2(ftanh(x0[0]), ftanh(x0[1])); pk.y = pack2(ftanh(x0[2]), ftanh(x0[3]));
          pk.z = pack2(ftanh(x1[0]), ftanh(x1[1])); pk.w = pack2(ftanh(x1[2]), ftanh(x1[3]));
          *(u32x4*)(TWb + pn * 72 + j0) = pk;
        } else {
          u32x4 pk;
          pk.x = pack2(x0[0], x0[1]); pk.y = pack2(x0[2], x0[3]);
          pk.z = pack2(x1[0], x1[1]); pk.w = pack2(x1[2], x1[3]);
          *(u32x4*)(ADb + pn * 72 + j0) = pk;
        }
      }
      __syncthreads();
#pragma unroll
      for (int m = 0; m < 2; ++m) {
        f32x4 cw = {0.f, 0.f, 0.f, 0.f}, ca = {0.f, 0.f, 0.f, 0.f};
#pragma unroll
        for (int ks = 0; ks < 2; ++ks) {
          const bf16x8 aw = *(const bf16x8*)(TWb + (m * 16 + fr) * 72 + ks * 32 + fq * 8);
          const bf16x8 aa = *(const bf16x8*)(ADb + (m * 16 + fr) * 72 + ks * 32 + fq * 8);
          cw = __builtin_amdgcn_mfma_f32_16x16x32_bf16(aw, bw[ks], cw, 0, 0, 0);
          ca = __builtin_amdgcn_mfma_f32_16x16x32_bf16(aa, ba[ks], ca, 0, 0, 0);
        }
#pragma unroll
        for (int jj = 0; jj < 4; ++jj) {
          WR[(m * 16 + fq * 4 + jj) * 64 + w * 16 + fr] = cw[jj];
          AP[(m * 16 + fq * 4 + jj) * 64 + w * 16 + fr] = ca[jj];
        }
      }
      __syncthreads();
      {
        const float inv = NRM[pn];
        float bsum = 0.f;
#pragma unroll
        for (int hq = 0; hq < 2; ++hq) {
          const int jb = j0 + hq * 4;
          const f32x4 wr_ = *(const f32x4*)(WR + pn * 64 + jb) + *(const f32x4*)(CST + jb);
          const f32x4 ap_ = *(const f32x4*)(AP + pn * 64 + jb) + *(const f32x4*)(CST + 64 + jb);
          const f32x4 kr = *(const f32x4*)(OPS + 3 * 2048 + pn * 64 + jb);
          const f32x4 rr = *(const f32x4*)(OPS + 4 * 2048 + pn * 64 + jb);
          const f32x4 kkw = *(const f32x4*)(CST + 128 + jb), kaw = *(const f32x4*)(CST + 192 + jb), rkw = *(const f32x4*)(CST + 256 + jb);
          f32x4 o0, o1, o2, o3;
#pragma unroll
          for (int e = 0; e < 4; ++e) {
            const float sw = sigm(wr_[e]);
            const float dec = __expf(-0.6065306597126334f * sw);
            const float av = sigm(ap_[e]);
            const float kn = kr[e] * kkw[e] * inv;
            const float kd = kr[e] * (1.f + (av - 1.f) * kaw[e]);
            bsum += rr[e] * kd * rkw[e];
            o0[e] = -kn; o1[e] = dec; o2[e] = kn * av; o3[e] = kd;
          }
          *(f32x4*)(OPS + 0 * 2048 + pn * 64 + jb) = o0;
          *(f32x4*)(OPS + 1 * 2048 + pn * 64 + jb) = o1;
          *(f32x4*)(OPS + 2 * 2048 + pn * 64 + jb) = o2;
          *(f32x4*)(OPS + 3 * 2048 + pn * 64 + jb) = o3;
        }
        bsum = red8(bsum);
        if ((tid & 7) == 0) BON[(tok * 8 + h) * 2 + d] = bsum;
      }
      __syncthreads();
      {
        ScanOps oa, ob;
        scan_load(oa, OPS, VV, 0, jg, i0);
#pragma unroll 1
        for (int nn = 0; nn < 32; nn += 2) {
          scan_load(ob, OPS, VV, nn + 1, jg, i0);
          scan_step(oa, S0, S1, YL, nn, jg, i0);
          scan_load(oa, OPS, VV, (nn + 2) & 31, jg, i0);
          scan_step(ob, S0, S1, YL, nn + 1, jg, i0);
        }
      }
      __syncthreads();
      {
        h16x8 o;
#pragma unroll
        for (int e = 0; e < 8; ++e) o[e] = (_Float16)YL[pn * 64 + j0 + e];
        *(h16x8*)(Y + tok * 512 + h * 64 + j0) = o;
      }
    }
    __syncthreads();
  }
}

struct ScanOps1 {
  f32x2 a[4], w[4], b[4], k[4], r[4];
  float v0;
};
DEVI void scan_load1(ScanOps1& o, const float* OPS, const float* VV, int nn, int jg, int i0) {
  const float* base = OPS + nn * 64 + jg * 8;
  f32x4 t0, t1;
  t0 = *(const f32x4*)(base); t1 = *(const f32x4*)(base + 4);
  o.a[0] = lo2(t0); o.a[1] = hi2(t0); o.a[2] = lo2(t1); o.a[3] = hi2(t1);
  t0 = *(const f32x4*)(base + 2048); t1 = *(const f32x4*)(base + 2048 + 4);
  o.w[0] = lo2(t0); o.w[1] = hi2(t0); o.w[2] = lo2(t1); o.w[3] = hi2(t1);
  t0 = *(const f32x4*)(base + 4096); t1 = *(const f32x4*)(base + 4096 + 4);
  o.b[0] = lo2(t0); o.b[1] = hi2(t0); o.b[2] = lo2(t1); o.b[3] = hi2(t1);
  t0 = *(const f32x4*)(base + 6144); t1 = *(const f32x4*)(base + 6144 + 4);
  o.k[0] = lo2(t0); o.k[1] = hi2(t0); o.k[2] = lo2(t1); o.k[3] = hi2(t1);
  t0 = *(const f32x4*)(base + 8192); t1 = *(const f32x4*)(base + 8192 + 4);
  o.r[0] = lo2(t0); o.r[1] = hi2(t0); o.r[2] = lo2(t1); o.r[3] = hi2(t1);
  o.v0 = VV[nn * 64 + i0];
}
DEVI void scan_step1(const ScanOps1& o, f32x2 (&S0)[4], float* YL, int nn, int jg, int i0) {
  f32x2 d0 = S0[0] * o.a[0], d0b = S0[2] * o.a[2];
  d0 = S0[1] * o.a[1] + d0; d0b = S0[3] * o.a[3] + d0b;
  d0 += d0b;
  const float sa0 = red8(d0.x + d0.y);
  f32x2 e0 = {0.f, 0.f};
#pragma unroll
  for (int q = 0; q < 4; ++q) {
    const f32x2 u0 = sa0 * o.b[q] + o.v0 * o.k[q];
    S0[q] = S0[q] * o.w[q] + u0;
    e0 = S0[q] * o.r[q] + e0;
  }
  const float y0 = red8(e0.x + e0.y);
  if (jg == 0) YL[nn * 64 + i0] = y0;
}
DEVI float red16d(float x) {
  x += dpp_mov<0xB1>(x);
  x += dpp_mov<0x4E>(x);
  x += dpp_mov<0x141>(x);
  x += dpp_mov<0x140>(x);
  return x;
}
DEVI void unpack4(u32x2 u, float* o) {
  o[0] = __uint_as_float(u.x << 16); o[1] = __uint_as_float(u.x & 0xffff0000u);
  o[2] = __uint_as_float(u.y << 16); o[3] = __uint_as_float(u.y & 0xffff0000u);
}

DEVI void phase_scan8(int tid_, const Params& p, int l, char* smem, int bfirst, int bstride) {
  const u16* PR = (const u16*)(p.ws + OFF_PR);
  _Float16* YF = (_Float16*)(p.ws + OFF_H);
  _Float16* YB = (_Float16*)(p.ws + OFF_H + (size_t)NTOK * 512 * 2);
  float* BON = (float*)(p.ws + OFF_BONUS);
  const u16* WB = (const u16*)(p.ws + OFF_WB);
  float* OPS = (float*)(smem + SC_OPS);
  u16* RAW = (u16*)(smem + SC_OPS);
  float* VV = (float*)(smem + SC_VV);
  float* WR = (float*)(smem + SC_WR);
  float* AP = (float*)(smem + SC_AP);
  float* YL = WR;
  u16* TWb = (u16*)(smem + SC_TW);
  u16* ADb = (u16*)(smem + SC_AD);
  float* NRM = (float*)(smem + SC_NRM);
  float* MU = (float*)(smem + SC_MU);
  float* CST = (float*)(smem + SC_CST);
  const float* mu_p = p.in[I_MU_PREV] + (size_t)l * 1920;
  const float* mu_n = p.in[I_MU_NEXT] + (size_t)l * 1920;
  const int tid = tid_, lane = tid & 63, w = tid >> 6, fr = lane & 15, fq = lane >> 4;
  const int pn = tid >> 4, j0 = (tid & 15) * 4;
  const int jg = lane & 7, i0 = w * 8 + (lane >> 3);
  const int hr = (tid >= 80) ? 1 : 0, hc = tid - hr * 80;
  const int wm = w >> 2, wn = w & 3;
  for (int blk = bfirst; blk < 192; blk += bstride) {
    const int s = blk >> 4, h = (blk >> 1) & 7, d = blk & 1;
    __syncthreads();
    for (int i = tid; i < 640; i += 512) {
      const int which = (i >= 320) ? 1 : 0, c = i - which * 320;
      const int g = c >> 6, e = c & 63;
      const int col = (g < 3) ? (g * 512 + h * 64 + e) : (1536 + (g - 3) * 128 + d * 64 + e);
      MU[i] = which ? mu_n[col] : mu_p[col];
    }
    if (tid < 320) {
      const int which = tid >> 6, e = tid & 63;
      float v;
      if (which == 0) v = p.in[I_W0][(size_t)(l * 2 + d) * 512 + h * 64 + e];
      else if (which == 1) v = p.in[I_A0][(size_t)(l * 2 + d) * 512 + h * 64 + e];
      else if (which == 2) v = p.in[I_K_K][(size_t)l * 512 + h * 64 + e];
      else if (which == 3) v = p.in[I_K_A][(size_t)l * 512 + h * 64 + e];
      else v = p.in[I_R_K][(size_t)(l * 8 + h) * 64 + e];
      CST[tid] = v;
    }
    bf16x8 bw[2], ba[2];
#pragma unroll
    for (int ks = 0; ks < 2; ++ks) {
      bw[ks] = *(const bf16x8*)(WB + W_WUP + (size_t)(d * 512 + h * 64 + wn * 16 + fr) * 64 + ks * 32 + fq * 8);
      ba[ks] = *(const bf16x8*)(WB + W_AUP + (size_t)(d * 512 + h * 64 + wn * 16 + fr) * 64 + ks * 32 + fq * 8);
    }
    _Float16* Y = d ? YB : YF;
    f32x2 S0[4];
#pragma unroll
    for (int q = 0; q < 4; ++q) S0[q] = (f32x2){0.f, 0.f};
    u32x2 G[5], GH;
    {
      const int t = d ? (4095 - pn) : pn;
      const size_t tok = (size_t)s * 4096 + t;
#pragma unroll
      for (int g = 0; g < 5; ++g) {
        const int col = (g < 3) ? (g * 512 + h * 64) : (1536 + (g - 3) * 128 + d * 64);
        G[g] = *(const u32x2*)(PR + tok * PRW + col + j0);
      }
      GH = (u32x2){0u, 0u};
      if (tid < 160) {
        const int tlo = d ? (4095 - 31) : 0;
        const int th = hr ? (tlo + 32) : (tlo - 1);
        const int g = hc >> 4;
        const int col = (g < 3) ? (g * 512 + h * 64) : (1536 + (g - 3) * 128 + d * 64);
        if (th >= 0 && th <= 4095) GH = *(const u32x2*)(PR + ((size_t)s * 4096 + th) * PRW + col + (hc & 15) * 4);
      }
    }
#pragma unroll 1
    for (int ch = 0; ch < 128; ++ch) {
      const int n = ch * 32 + pn;
      const int t = d ? (4095 - n) : n;
      const size_t tok = (size_t)s * 4096 + t;
      const int tlo = d ? (4095 - (ch * 32 + 31)) : (ch * 32);
      const int rrow = t - tlo + 1;
#pragma unroll
      for (int g = 0; g < 5; ++g) *(u32x2*)(RAW + rrow * 320 + g * 64 + j0) = G[g];
      if (tid < 160) *(u32x2*)(RAW + (hr ? 33 : 0) * 320 + (hc >> 4) * 64 + (hc & 15) * 4) = GH;
      __syncthreads();
      if (ch + 1 < 128) {
        const int n2 = n + 32;
        const int t2 = d ? (4095 - n2) : n2;
        const size_t tok2 = (size_t)s * 4096 + t2;
#pragma unroll
        for (int g = 0; g < 5; ++g) {
          const int col = (g < 3) ? (g * 512 + h * 64) : (1536 + (g - 3) * 128 + d * 64);
          G[g] = *(const u32x2*)(PR + tok2 * PRW + col + j0);
        }
        GH = (u32x2){0u, 0u};
        if (tid < 160) {
          const int tlo2 = d ? (tlo - 32) : (tlo + 32);
          const int th = hr ? (tlo2 + 32) : (tlo2 - 1);
          const int g = hc >> 4;
          const int col = (g < 3) ? (g * 512 + h * 64) : (1536 + (g - 3) * 128 + d * 64);
          if (th >= 0 && th <= 4095) GH = *(const u32x2*)(PR + ((size_t)s * 4096 + th) * PRW + col + (hc & 15) * 4);
        }
      }
#pragma unroll
      for (int g = 0; g < 5; ++g) {
        float cur[4], prv[4], nxt[4];
        unpack4(*(const u32x2*)(RAW + rrow * 320 + g * 64 + j0), cur);
        unpack4(*(const u32x2*)(RAW + (rrow - 1) * 320 + g * 64 + j0), prv);
        unpack4(*(const u32x2*)(RAW + (rrow + 1) * 320 + g * 64 + j0), nxt);
        const f32x4 mp0 = *(const f32x4*)(MU + g * 64 + j0);
        const f32x4 mn0 = *(const f32x4*)(MU + 320 + g * 64 + j0);
        f32x4 x0;
#pragma unroll
        for (int e = 0; e < 4; ++e) x0[e] = cur[e] + mp0[e] * (prv[e] - cur[e]) + mn0[e] * (nxt[e] - cur[e]);
        if (g == 0) {
          *(f32x4*)(OPS + 4 * 2048 + pn * 64 + j0) = x0;
        } else if (g == 1) {
          *(f32x4*)(OPS + 3 * 2048 + pn * 64 + j0) = x0;
          const f32x4 kk0 = *(const f32x4*)(CST + 128 + j0);
          float ss = 0.f;
#pragma unroll
          for (int e = 0; e < 4; ++e) { const float a_ = x0[e] * kk0[e]; ss += a_ * a_; }
          ss = red16d(ss);
          if ((tid & 15) == 0) NRM[pn] = frcp(fmaxf(__builtin_amdgcn_sqrtf(ss), 1e-12f));
        } else if (g == 2) {
          *(f32x4*)(VV + pn * 64 + j0) = x0;
        } else if (g == 3) {
          u32x2 pk;
          pk.x = pack2(ftanh(x0[0]), ftanh(x0[1])); pk.y = pack2(ftanh(x0[2]), ftanh(x0[3]));
          *(u32x2*)(TWb + pn * 72 + j0) = pk;
        } else {
          u32x2 pk;
          pk.x = pack2(x0[0], x0[1]); pk.y = pack2(x0[2], x0[3]);
          *(u32x2*)(ADb + pn * 72 + j0) = pk;
        }
      }
      __syncthreads();
      {
        f32x4 cw = {0.f, 0.f, 0.f, 0.f}, ca = {0.f, 0.f, 0.f, 0.f};
#pragma unroll
        for (int ks = 0; ks < 2; ++ks) {
          const bf16x8 aw = *(const bf16x8*)(TWb + (wm * 16 + fr) * 72 + ks * 32 + fq * 8);
          const bf16x8 aa = *(const bf16x8*)(ADb + (wm * 16 + fr) * 72 + ks * 32 + fq * 8);
          cw = __builtin_amdgcn_mfma_f32_16x16x32_bf16(aw, bw[ks], cw, 0, 0, 0);
          ca = __builtin_amdgcn_mfma_f32_16x16x32_bf16(aa, ba[ks], ca, 0, 0, 0);
        }
#pragma unroll
        for (int jj = 0; jj < 4; ++jj) {
          WR[(wm * 16 + fq * 4 + jj) * 64 + wn * 16 + fr] = cw[jj];
          AP[(wm * 16 + fq * 4 + jj) * 64 + wn * 16 + fr] = ca[jj];
        }
      }
      __syncthreads();
      {
        const float inv = NRM[pn];
        float bsum = 0.f;
        const f32x4 wr_ = *(const f32x4*)(WR + pn * 64 + j0) + *(const f32x4*)(CST + j0);
        const f32x4 ap_ = *(const f32x4*)(AP + pn * 64 + j0) + *(const f32x4*)(CST + 64 + j0);
        const f32x4 kr = *(const f32x4*)(OPS + 3 * 2048 + pn * 64 + j0);
        const f32x4 rr = *(const f32x4*)(OPS + 4 * 2048 + pn * 64 + j0);
        const f32x4 kkw = *(const f32x4*)(CST + 128 + j0), kaw = *(const f32x4*)(CST + 192 + j0), rkw = *(const f32x4*)(CST + 256 + j0);
        f32x4 o0, o1, o2, o3;
#pragma unroll
        for (int e = 0; e < 4; ++e) {
          const float sw = sigm(wr_[e]);
          const float dec = __expf(-0.6065306597126334f * sw);
          const float av = sigm(ap_[e]);
          const float kn = kr[e] * kkw[e] * inv;
          const float kd = kr[e] * (1.f + (av - 1.f) * kaw[e]);
          bsum += rr[e] * kd * rkw[e];
          o0[e] = -kn; o1[e] = dec; o2[e] = kn * av; o3[e] = kd;
        }
        *(f32x4*)(OPS + 0 * 2048 + pn * 64 + j0) = o0;
        *(f32x4*)(OPS + 1 * 2048 + pn * 64 + j0) = o1;
        *(f32x4*)(OPS + 2 * 2048 + pn * 64 + j0) = o2;
        *(f32x4*)(OPS + 3 * 2048 + pn * 64 + j0) = o3;
        bsum = red16d(bsum);
        if ((tid & 15) == 0) BON[(tok * 8 + h) * 2 + d] = bsum;
      }
      __syncthreads();
      {
        ScanOps1 oa, ob;
        scan_load1(oa, OPS, VV, 0, jg, i0);
#pragma unroll 1
        for (int nn = 0; nn < 32; nn += 2) {
          scan_load1(ob, OPS, VV, nn + 1, jg, i0);
          scan_step1(oa, S0, YL, nn, jg, i0);
          scan_load1(oa, OPS, VV, (nn + 2) & 31, jg, i0);
          scan_step1(ob, S0, YL, nn + 1, jg, i0);
        }
      }
      __syncthreads();
      {
        typedef __attribute__((ext_vector_type(4))) _Float16 h16x4;
        h16x4 o;
#pragma unroll
        for (int e = 0; e < 4; ++e) o[e] = (_Float16)YL[pn * 64 + j0 + e];
        *(h16x4*)(Y + tok * 512 + h * 64 + j0) = o;
      }
    }
    __syncthreads();
  }
}

constexpr int PC_OPS = 0;
constexpr int PC_BUF = 49152;
constexpr int PC_RAW = 98304;
constexpr int PC_WR = 98304;
constexpr int PC_AP = 106496;
constexpr int PC_TW = 120064;
constexpr int PC_AD = 124672;
constexpr int PC_NRM = 129280;
constexpr int PC_MU = 129408;
constexpr int PC_CST = 131968;
constexpr int PC_YL = 133248;

DEVI void phase_scan_pc(int tid_, const Params& p, int l, char* smem, int bfirst, int bstride) {
  const u16* PR = (const u16*)(p.ws + OFF_PR);
  _Float16* YF = (_Float16*)(p.ws + OFF_H);
  _Float16* YB = (_Float16*)(p.ws + OFF_H + (size_t)NTOK * 512 * 2);
  float* BON = (float*)(p.ws + OFF_BONUS);
  const u16* WB = (const u16*)(p.ws + OFF_WB);
  u16* RAW = (u16*)(smem + PC_RAW);
  float* WR = (float*)(smem + PC_WR);
  float* AP = (float*)(smem + PC_AP);
  u16* TWb = (u16*)(smem + PC_TW);
  u16* ADb = (u16*)(smem + PC_AD);
  float* NRM = (float*)(smem + PC_NRM);
  float* MU = (float*)(smem + PC_MU);
  float* CST = (float*)(smem + PC_CST);
  const float* mu_p = p.in[I_MU_PREV] + (size_t)l * 1920;
  const float* mu_n = p.in[I_MU_NEXT] + (size_t)l * 1920;
  const bool is_prep = tid_ >= 256;
  const int tid = tid_ & 255, lane = tid & 63, w = tid >> 6, fr = lane & 15, fq = lane >> 4;
  const int pn = tid >> 3, j0 = (tid & 7) * 8;
  const int jg = lane & 7, i0 = w * 16 + (lane >> 3);
  const int hr = (tid >= 40) ? 1 : 0, hc = tid - hr * 40;
  for (int blk = bfirst; blk < 192; blk += bstride) {
    const int s = blk >> 4, h = (blk >> 1) & 7, d = blk & 1;
    __syncthreads();
    for (int i = tid_; i < 640; i += 512) {
      const int which = (i >= 320) ? 1 : 0, c = i - which * 320;
      const int g = c >> 6, e = c & 63;
      const int col = (g < 3) ? (g * 512 + h * 64 + e) : (1536 + (g - 3) * 128 + d * 64 + e);
      MU[i] = which ? mu_n[col] : mu_p[col];
    }
    if (tid_ < 320) {
      const int which = tid_ >> 6, e = tid_ & 63;
      float v;
      if (which == 0) v = p.in[I_W0][(size_t)(l * 2 + d) * 512 + h * 64 + e];
      else if (which == 1) v = p.in[I_A0][(size_t)(l * 2 + d) * 512 + h * 64 + e];
      else if (which == 2) v = p.in[I_K_K][(size_t)l * 512 + h * 64 + e];
      else if (which == 3) v = p.in[I_K_A][(size_t)l * 512 + h * 64 + e];
      else v = p.in[I_R_K][(size_t)(l * 8 + h) * 64 + e];
      CST[tid_] = v;
    }
    _Float16* Y = d ? YB : YF;
    if (is_prep) {
      bf16x8 bw[2], ba[2];
#pragma unroll
      for (int ks = 0; ks < 2; ++ks) {
        bw[ks] = *(const bf16x8*)(WB + W_WUP + (size_t)(d * 512 + h * 64 + w * 16 + fr) * 64 + ks * 32 + fq * 8);
        ba[ks] = *(const bf16x8*)(WB + W_AUP + (size_t)(d * 512 + h * 64 + w * 16 + fr) * 64 + ks * 32 + fq * 8);
      }
      u32x4 G[5], GH;
      {
        const int t = d ? (4095 - pn) : pn;
        const size_t tok = (size_t)s * 4096 + t;
#pragma unroll
        for (int g = 0; g < 5; ++g) {
          const int col = (g < 3) ? (g * 512 + h * 64) : (1536 + (g - 3) * 128 + d * 64);
          G[g] = *(const u32x4*)(PR + tok * PRW + col + j0);
        }
        GH = (u32x4){0u, 0u, 0u, 0u};
        if (tid < 80) {
          const int tlo = d ? (4095 - 31) : 0;
          const int th = hr ? (tlo + 32) : (tlo - 1);
          const int g = hc >> 3;
          const int col = (g < 3) ? (g * 512 + h * 64) : (1536 + (g - 3) * 128 + d * 64);
          if (th >= 0 && th <= 4095) GH = *(const u32x4*)(PR + ((size_t)s * 4096 + th) * PRW + col + (hc & 7) * 8);
        }
      }
#pragma unroll 1
      for (int ch = -1; ch < 128; ++ch) {
        const int c = ch + 1;
        const bool doprep = c < 128;
        float* OPS = (float*)(smem + PC_OPS + (c & 1) * PC_BUF);
        float* VV = OPS + 5 * 2048;
        const int n = c * 32 + pn;
        const int t = d ? (4095 - n) : n;
        const size_t tok = (size_t)s * 4096 + t;
        const int tlo = d ? (4095 - (c * 32 + 31)) : (c * 32);
        const int rrow = t - tlo + 1;
        __syncthreads();
        if (ch >= 1) {
          const float* YL = (const float*)(smem + PC_YL + ((ch - 1) & 1) * 8192);
          const int n1 = (ch - 1) * 32 + pn;
          const int t1 = d ? (4095 - n1) : n1;
          h16x8 o;
#pragma unroll
          for (int e = 0; e < 8; ++e) o[e] = (_Float16)YL[pn * 64 + j0 + e];
          *(h16x8*)(Y + ((size_t)s * 4096 + t1) * 512 + h * 64 + j0) = o;
        }
        if (doprep) {
#pragma unroll
          for (int g = 0; g < 5; ++g) *(u32x4*)(RAW + rrow * 320 + g * 64 + j0) = G[g];
          if (tid < 80) *(u32x4*)(RAW + (hr ? 33 : 0) * 320 + (hc >> 3) * 64 + (hc & 7) * 8) = GH;
        }
        __syncthreads();
        if (doprep) {
          if (c + 1 < 128) {
            const int n2 = n + 32;
            const int t2 = d ? (4095 - n2) : n2;
            const size_t tok2 = (size_t)s * 4096 + t2;
#pragma unroll
            for (int g = 0; g < 5; ++g) {
              const int col = (g < 3) ? (g * 512 + h * 64) : (1536 + (g - 3) * 128 + d * 64);
              G[g] = *(const u32x4*)(PR + tok2 * PRW + col + j0);
            }
            GH = (u32x4){0u, 0u, 0u, 0u};
            if (tid < 80) {
              const int tlo2 = d ? (tlo - 32) : (tlo + 32);
              const int th = hr ? (tlo2 + 32) : (tlo2 - 1);
              const int g = hc >> 3;
              const int col = (g < 3) ? (g * 512 + h * 64) : (1536 + (g - 3) * 128 + d * 64);
              if (th >= 0 && th <= 4095) GH = *(const u32x4*)(PR + ((size_t)s * 4096 + th) * PRW + col + (hc & 7) * 8);
            }
          }
#pragma unroll
          for (int g = 0; g < 5; ++g) {
            float cur[8], prv[8], nxt[8];
            load8bf(RAW + rrow * 320 + g * 64 + j0, cur);
            load8bf(RAW + (rrow - 1) * 320 + g * 64 + j0, prv);
            load8bf(RAW + (rrow + 1) * 320 + g * 64 + j0, nxt);
            const f32x4 mp0 = *(const f32x4*)(MU + g * 64 + j0), mp1 = *(const f32x4*)(MU + g * 64 + j0 + 4);
            const f32x4 mn0 = *(const f32x4*)(MU + 320 + g * 64 + j0), mn1 = *(const f32x4*)(MU + 320 + g * 64 + j0 + 4);
            f32x4 x0, x1;
#pragma unroll
            for (int e = 0; e < 4; ++e) {
              x0[e] = cur[e] + mp0[e] * (prv[e] - cur[e]) + mn0[e] * (nxt[e] - cur[e]);
              x1[e] = cur[4 + e] + mp1[e] * (prv[4 + e] - cur[4 + e]) + mn1[e] * (nxt[4 + e] - cur[4 + e]);
            }
            if (g == 0) {
              *(f32x4*)(OPS + 4 * 2048 + pn * 64 + j0) = x0; *(f32x4*)(OPS + 4 * 2048 + pn * 64 + j0 + 4) = x1;
            } else if (g == 1) {
              *(f32x4*)(OPS + 3 * 2048 + pn * 64 + j0) = x0; *(f32x4*)(OPS + 3 * 2048 + pn * 64 + j0 + 4) = x1;
              const f32x4 kk0 = *(const f32x4*)(CST + 128 + j0), kk1 = *(const f32x4*)(CST + 128 + j0 + 4);
              float ss = 0.f;
#pragma unroll
              for (int e = 0; e < 4; ++e) { const float a_ = x0[e] * kk0[e], b_ = x1[e] * kk1[e]; ss += a_ * a_ + b_ * b_; }
              ss = red8(ss);
              if ((tid & 7) == 0) NRM[pn] = frcp(fmaxf(__builtin_amdgcn_sqrtf(ss), 1e-12f));
            } else if (g == 2) {
              *(f32x4*)(VV + pn * 64 + j0) = x0; *(f32x4*)(VV + pn * 64 + j0 + 4) = x1;
            } else if (g == 3) {
              u32x4 pk;
              pk.x = pack2(ftanh(x0[0]), ftanh(x0[1])); pk.y = pack2(ftanh(x0[2]), ftanh(x0[3]));
              pk.z = pack2(ftanh(x1[0]), ftanh(x1[1])); pk.w = pack2(ftanh(x1[2]), ftanh(x1[3]));
              *(u32x4*)(TWb + pn * 72 + j0) = pk;
            } else {
              u32x4 pk;
              pk.x = pack2(x0[0], x0[1]); pk.y = pack2(x0[2], x0[3]);
              pk.z = pack2(x1[0], x1[1]); pk.w = pack2(x1[2], x1[3]);
              *(u32x4*)(ADb + pn * 72 + j0) = pk;
            }
          }
        }
        __syncthreads();
        if (doprep) {
#pragma unroll
          for (int m = 0; m < 2; ++m) {
            f32x4 cw = {0.f, 0.f, 0.f, 0.f}, ca = {0.f, 0.f, 0.f, 0.f};
#pragma unroll
            for (int ks = 0; ks < 2; ++ks) {
              const bf16x8 aw = *(const bf16x8*)(TWb + (m * 16 + fr) * 72 + ks * 32 + fq * 8);
              const bf16x8 aa = *(const bf16x8*)(ADb + (m * 16 + fr) * 72 + ks * 32 + fq * 8);
              cw = __builtin_amdgcn_mfma_f32_16x16x32_bf16(aw, bw[ks], cw, 0, 0, 0);
              ca = __builtin_amdgcn_mfma_f32_16x16x32_bf16(aa, ba[ks], ca, 0, 0, 0);
            }
#pragma unroll
            for (int jj = 0; jj < 4; ++jj) {
              WR[(m * 16 + fq * 4 + jj) * 64 + w * 16 + fr] = cw[jj];
              AP[(m * 16 + fq * 4 + jj) * 64 + w * 16 + fr] = ca[jj];
            }
          }
        }
        __syncthreads();
        if (doprep) {
          const float inv = NRM[pn];
          float bsum = 0.f;
#pragma unroll
          for (int hq = 0; hq < 2; ++hq) {
            const int jb = j0 + hq * 4;
            const f32x4 wr_ = *(const f32x4*)(WR + pn * 64 + jb) + *(const f32x4*)(CST + jb);
            const f32x4 ap_ = *(const f32x4*)(AP + pn * 64 + jb) + *(const f32x4*)(CST + 64 + jb);
            const f32x4 kr = *(const f32x4*)(OPS + 3 * 2048 + pn * 64 + jb);
            const f32x4 rr = *(const f32x4*)(OPS + 4 * 2048 + pn * 64 + jb);
            const f32x4 kkw = *(const f32x4*)(CST + 128 + jb), kaw = *(const f32x4*)(CST + 192 + jb), rkw = *(const f32x4*)(CST + 256 + jb);
            f32x4 o0, o1, o2, o3;
#pragma unroll
            for (int e = 0; e < 4; ++e) {
              const float sw = sigm(wr_[e]);
              const float dec = __expf(-0.6065306597126334f * sw);
              const float av = sigm(ap_[e]);
              const float kn = kr[e] * kkw[e] * inv;
              const float kd = kr[e] * (1.f + (av - 1.f) * kaw[e]);
              bsum += rr[e] * kd * rkw[e];
              o0[e] = -kn; o1[e] = dec; o2[e] = kn * av; o3[e] = kd;
            }
            *(f32x4*)(OPS + 0 * 2048 + pn * 64 + jb) = o0;
            *(f32x4*)(OPS + 1 * 2048 + pn * 64 + jb) = o1;
            *(f32x4*)(OPS + 2 * 2048 + pn * 64 + jb) = o2;
            *(f32x4*)(OPS + 3 * 2048 + pn * 64 + jb) = o3;
          }
          bsum = red8(bsum);
          if ((tid & 7) == 0) BON[(tok * 8 + h) * 2 + d] = bsum;
        }
      }
      __syncthreads();
      {
        const float* YL = (const float*)(smem + PC_YL + (127 & 1) * 8192);
        const int n1 = 127 * 32 + pn;
        const int t1 = d ? (4095 - n1) : n1;
        h16x8 o;
#pragma unroll
        for (int e = 0; e < 8; ++e) o[e] = (_Float16)YL[pn * 64 + j0 + e];
        *(h16x8*)(Y + ((size_t)s * 4096 + t1) * 512 + h * 64 + j0) = o;
      }
    } else {
      f32x2 S0[4], S1[4];
#pragma unroll
      for (int q = 0; q < 4; ++q) { S0[q] = (f32x2){0.f, 0.f}; S1[q] = (f32x2){0.f, 0.f}; }
#pragma unroll 1
      for (int ch = -1; ch < 128; ++ch) {
        const float* OPS = (const float*)(smem + PC_OPS + (ch & 1) * PC_BUF);
        const float* VV = OPS + 5 * 2048;
        float* YL = (float*)(smem + PC_YL + (ch & 1) * 8192);
        __syncthreads();
        if (ch < 0) {
          __syncthreads(); __syncthreads(); __syncthreads();
        } else {
          ScanOps oa, ob;
          scan_load(oa, OPS, VV, 0, jg, i0);
#pragma unroll 1
          for (int seg = 0; seg < 4; ++seg) {
            if (seg > 0) __syncthreads();
#pragma unroll 1
            for (int nn = seg * 8; nn < seg * 8 + 8; nn += 2) {
              scan_load(ob, OPS, VV, nn + 1, jg, i0);
              scan_step(oa, S0, S1, YL, nn, jg, i0);
              scan_load(oa, OPS, VV, (nn + 2) & 31, jg, i0);
              scan_step(ob, S0, S1, YL, nn + 1, jg, i0);
            }
          }
        }
      }
      __syncthreads();
    }
    __syncthreads();
  }
}

DEVI void phase_rwkv_post(int tid_, int vb_, int vg_, const Params& p, int l, char* smem) {
  u16* PR = (u16*)(p.ws + OFF_PR);
  const _Float16* YF = (const _Float16*)(p.ws + OFF_H);
  const _Float16* YB = (const _Float16*)(p.ws + OFF_H + (size_t)NTOK * 512 * 2);
  const float* BON = (const float*)(p.ws + OFF_BONUS);
  const u16* GUPT = (const u16*)(p.ws + OFF_WB) + W_GUP;
  const float* mu_p = p.in[I_MU_PREV] + (size_t)l * 1920;
  const float* mu_n = p.in[I_MU_NEXT] + (size_t)l * 1920;
  const float* gng = p.in[I_GN_G] + (size_t)l * 512;
  const float* gnb = p.in[I_GN_B] + (size_t)l * 512;
  u16* As = (u16*)smem;
  const int tid = tid_, lane = tid & 63, w = tid >> 6, fr = lane & 15, fq = lane >> 4;
  for (int tile = vb_; tile < NTOK / 64; tile += vg_) {
    const size_t tok0 = (size_t)tile * 64;
    {
      const int row = tid >> 2, part = tid & 3;
      const size_t tok = tok0 + row;
      const int t = (int)(tok & 4095);
#pragma unroll
      for (int q = 0; q < 4; ++q) {
        const int col = 1792 + part * 32 + q * 8;
        float cur[8], prv[8], nxt[8];
        load8bf(PR + tok * PRW + col, cur);
        if (t > 0) load8bf(PR + (tok - 1) * PRW + col, prv);
        else {
#pragma unroll
          for (int e = 0; e < 8; ++e) prv[e] = 0.f;
        }
        if (t < 4095) load8bf(PR + (tok + 1) * PRW + col, nxt);
        else {
#pragma unroll
          for (int e = 0; e < 8; ++e) nxt[e] = 0.f;
        }
        float o[8];
#pragma unroll
        for (int e = 0; e < 8; ++e) {
          const float x = cur[e] + mu_p[col + e] * (prv[e] - cur[e]) + mu_n[col + e] * (nxt[e] - cur[e]);
          o[e] = sigm(x);
        }
        u32x4 pk;
        pk.x = pack2(o[0], o[1]); pk.y = pack2(o[2], o[3]); pk.z = pack2(o[4], o[5]); pk.w = pack2(o[6], o[7]);
        *(u32x4*)(As + row * 136 + part * 32 + q * 8) = pk;
      }
    }
    asm volatile("" ::: "memory");
#pragma unroll 1
    for (int chh = 0; chh < 2; ++chh) {
      f32x4 acc[16];
#pragma unroll
      for (int n = 0; n < 16; ++n) acc[n] = (f32x4){0.f, 0.f, 0.f, 0.f};
#pragma unroll
      for (int ks = 0; ks < 4; ++ks) {
        bf16x8 af = *(const bf16x8*)(As + (w * 16 + fr) * 136 + ks * 32 + fq * 8);
#pragma unroll
        for (int n = 0; n < 16; ++n) {
          bf16x8 bg = *(const bf16x8*)(GUPT + (size_t)(chh * 256 + n * 16 + fr) * 128 + ks * 32 + fq * 8);
          acc[n] = __builtin_amdgcn_mfma_f32_16x16x32_bf16(af, bg, acc[n], 0, 0, 0);
        }
      }
#pragma unroll
      for (int hl = 0; hl < 4; ++hl) {
        const int head = chh * 4 + hl;
        asm volatile("" ::: "memory");
#pragma unroll
        for (int j = 0; j < 4; ++j) {
          const size_t tok = tok0 + w * 16 + fq * 4 + j;
          const int t = (int)(tok & 4095);
          float o[4], sum = 0.f;
#pragma unroll
          for (int q = 0; q < 4; ++q) {
            const int col = head * 64 + q * 16 + fr;
            o[q] = (float)YF[tok * 512 + col] + (float)YB[tok * 512 + col];
            sum += o[q];
          }
          const float mean = red16_sum(sum) * (1.f / 64.f);
          float vs = 0.f;
#pragma unroll
          for (int q = 0; q < 4; ++q) { const float dlt = o[q] - mean; vs += dlt * dlt; }
          const float var = red16_sum(vs) * (1.f / 64.f);
          const float rstd = rsqrtf(var + 64e-5f);
          const float bon = BON[(tok * 8 + head) * 2] + BON[(tok * 8 + head) * 2 + 1];
#pragma unroll
          for (int q = 0; q < 4; ++q) {
            const int col = head * 64 + q * 16 + fr;
            const int vc = 1024 + col;
            const float cur = bf2f(PR[tok * PRW + vc]);
            const float prv = (t > 0) ? bf2f(PR[(tok - 1) * PRW + vc]) : 0.f;
            const float nxt = (t < 4095) ? bf2f(PR[(tok + 1) * PRW + vc]) : 0.f;
            const float vsh = cur + mu_p[vc] * (prv - cur) + mu_n[vc] * (nxt - cur);
            const float yv = ((o[q] - mean) * rstd * gng[col] + gnb[col] + bon * vsh) * acc[hl * 4 + q][j];
            PR[tok * PRW + col] = f2bf(yv);
          }
        }
      }
    }
  }
}

DEVI f32x4 ld4bf(const u16* p) {
  const u32x2 u = *(const u32x2*)p;
  f32x4 o;
  o[0] = __uint_as_float(u.x << 16); o[1] = __uint_as_float(u.x & 0xffff0000u);
  o[2] = __uint_as_float(u.y << 16); o[3] = __uint_as_float(u.y & 0xffff0000u);
  return o;
}

DEVI void phase_merge(int tid_, const Params& p, char* smem, const float* ssq) {
  const u16* WB = (const u16*)(p.ws + OFF_WB);
  const u16* H = (const u16*)(p.ws + OFF_NK);
  u16* PR = (u16*)(p.ws + OFF_PR);
  const u16* NQ = (const u16*)(p.ws + OFF_NQ);
  u16* TMP = (u16*)(p.ws + OFF_H);
  const int lane = tid_ & 63, wid = tid_ >> 6;
  const int wr = wid >> 2, wc = wid & 3, fr = lane & 15, fq = lane >> 4;
  const bool xmap = (gridDim.x & 7) == 0;
  const int xcd = blockIdx.x & 7;
  const int first = xmap ? (int)(blockIdx.x >> 3) : (int)blockIdx.x;
  const int stride = xmap ? (int)(gridDim.x >> 3) : (int)gridDim.x;
  const int count = xmap ? 24 * 4 : 192 * 4;
  for (int it = first; it < count; it += stride) {
    const int tm = xmap ? (it >> 2) * 8 + xcd : (it >> 2), tn = it & 3;
    const int m0 = tm << 8, n0 = tn << 8;
    f32x4 acc[8][4];
#define MERGE_ZERO() _Pragma("unroll") for (int m = 0; m < 8; ++m) _Pragma("unroll") for (int n = 0; n < 4; ++n) acc[m][n] = (f32x4){0.f, 0.f, 0.f, 0.f}
#define MERGE_RC() const int r = m0 + wr * 128 + m * 16 + fr, c0 = n0 + wc * 64 + n * 16 + fq * 4
    MERGE_ZERO();
    gemm_kloop8<true>(launder(tid_), acc, H + (size_t)m0 * 1024, 1024, WB + W_IN + (size_t)(3456 + n0) * 1024, 1024, 1024, smem);
#pragma unroll
    for (int m = 0; m < 8; ++m)
#pragma unroll
      for (int n = 0; n < 4; ++n) {
        MERGE_RC();
        const float rs = rstd_of(ssq, r);
        f32x4 o;
#pragma unroll
        for (int j = 0; j < 4; ++j) o[j] = sigm(acc[m][n][j] * rs);
        store4bf(PR + (size_t)r * PRW + 512 + c0, o);
      }
    MERGE_ZERO();
    gemm_kloop8<true>(launder(tid_), acc, PR + (size_t)m0 * PRW, PRW, WB + W_BRR + (size_t)n0 * 512, 512, 512, smem);
#pragma unroll
    for (int m = 0; m < 8; ++m)
#pragma unroll
      for (int n = 0; n < 4; ++n) {
        MERGE_RC();
        u16* dst = PR + (size_t)r * PRW + 512 + c0;
        store4bf(dst, ld4bf(dst) * acc[m][n]);
      }
    MERGE_ZERO();
    gemm_kloop8<true>(launder(tid_), acc, H + (size_t)m0 * 1024, 1024, WB + W_IN + (size_t)(4480 + n0) * 1024, 1024, 1024, smem);
#pragma unroll
    for (int m = 0; m < 8; ++m)
#pragma unroll
      for (int n = 0; n < 4; ++n) {
        MERGE_RC();
        const float rs = rstd_of(ssq, r);
        f32x4 o;
#pragma unroll
        for (int j = 0; j < 4; ++j) o[j] = sigm(acc[m][n][j] * rs);
        store4bf(TMP + (size_t)r * 1024 + c0, o);
      }
    MERGE_ZERO();
    gemm_kloop8<true>(launder(tid_), acc, NQ + (size_t)m0 * 512, 512, WB + W_BRN + (size_t)n0 * 512, 512, 512, smem);
#pragma unroll
    for (int m = 0; m < 8; ++m)
#pragma unroll
      for (int n = 0; n < 4; ++n) {
        MERGE_RC();
        u16* dst = PR + (size_t)r * PRW + 512 + c0;
        store4bf(dst, ld4bf(dst) + ld4bf(TMP + (size_t)r * 1024 + c0) * acc[m][n]);
      }
#undef MERGE_ZERO
#undef MERGE_RC
  }
}


DEVI void phase_xattn(int tid_, int vb_, int vg_, const Params& p, char* smem) {
  const u16* Q = (const u16*)(p.ws + OFF_PR);
  u16* O = (u16*)(p.ws + OFF_NQ);
  const u16* KVK = (const u16*)(p.ws + OFF_KVK);
  const u16* KVT = (const u16*)(p.ws + OFF_KVT);
  const int lane = tid_ & 63, w = tid_ >> 6, fr = lane & 15, fq = lane >> 4;
  u16* Pw = (u16*)smem + w * (32 * 264);
  for (int t = vb_; t < (NTOK / 128) * 4; t += vg_) {
    const int hh = t & 3;
    const size_t tok0 = (size_t)(t >> 2) * 128 + w * 32;
    const int s = (int)(tok0 >> 12);
    f32x4 acc[2][16];
#pragma unroll
    for (int mt = 0; mt < 2; ++mt)
#pragma unroll
      for (int n = 0; n < 16; ++n) acc[mt][n] = (f32x4){0.f, 0.f, 0.f, 0.f};
#pragma unroll 1
    for (int ks = 0; ks < 8; ++ks) {
      const bf16x8 aq0 = *(const bf16x8*)(Q + (tok0 + fr) * 1024 + hh * 256 + ks * 32 + fq * 8);
      const bf16x8 aq1 = *(const bf16x8*)(Q + (tok0 + 16 + fr) * 1024 + hh * 256 + ks * 32 + fq * 8);
#pragma unroll
      for (int n = 0; n < 16; ++n) {
        const bf16x8 bk = *(const bf16x8*)(KVK + (size_t)(s * 256 + n * 16 + fr) * 1024 + hh * 256 + ks * 32 + fq * 8);
        acc[0][n] = __builtin_amdgcn_mfma_f32_16x16x32_bf16(bk, aq0, acc[0][n], 0, 0, 0);
        acc[1][n] = __builtin_amdgcn_mfma_f32_16x16x32_bf16(bk, aq1, acc[1][n], 0, 0, 0);
      }
    }
    float sm[2];
#pragma unroll
    for (int mt = 0; mt < 2; ++mt) {
      float m = -1e30f;
#pragma unroll
      for (int n = 0; n < 16; ++n)
#pragma unroll
        for (int j = 0; j < 4; ++j) m = fmaxf(m, acc[mt][n][j]);
      m = red4x_max(m) * 0.0625f;
      float ssum = 0.f;
#pragma unroll
      for (int n = 0; n < 16; ++n) {
        f32x4 e;
#pragma unroll
        for (int j = 0; j < 4; ++j) { e[j] = __expf(acc[mt][n][j] * 0.0625f - m); ssum += e[j]; }
        store4bf(Pw + (mt * 16 + fr) * 264 + n * 16 + fq * 4, e);
      }
      sm[mt] = 1.f / red4x_sum(ssum);
    }
#pragma unroll
    for (int mt = 0; mt < 2; ++mt)
#pragma unroll
      for (int n = 0; n < 16; ++n) acc[mt][n] = (f32x4){0.f, 0.f, 0.f, 0.f};
#pragma unroll 1
    for (int ks = 0; ks < 8; ++ks) {
      const bf16x8 ap0 = *(const bf16x8*)(Pw + fr * 264 + ks * 32 + fq * 8);
      const bf16x8 ap1 = *(const bf16x8*)(Pw + (16 + fr) * 264 + ks * 32 + fq * 8);
#pragma unroll
      for (int n = 0; n < 16; ++n) {
        const bf16x8 bv = *(const bf16x8*)(KVT + (size_t)(s * 1024 + hh * 256 + n * 16 + fr) * 256 + ks * 32 + fq * 8);
        acc[0][n] = __builtin_amdgcn_mfma_f32_16x16x32_bf16(bv, ap0, acc[0][n], 0, 0, 0);
        acc[1][n] = __builtin_amdgcn_mfma_f32_16x16x32_bf16(bv, ap1, acc[1][n], 0, 0, 0);
      }
    }
#pragma unroll
    for (int mt = 0; mt < 2; ++mt)
#pragma unroll
      for (int n = 0; n < 16; ++n)
        store4bf(O + (tok0 + mt * 16 + fr) * 1024 + hh * 256 + n * 16 + fq * 4, acc[mt][n] * sm[mt]);
  }
}

constexpr int HALF_SMEM = 78720;

DEVI void run_phase(int tid_, const Params& p, int ph, char* smem) {
  const int half = tid_ >> 8, vt = tid_ & 255;
  const int vb_ = blockIdx.x * 2 + half, vg_ = gridDim.x * 2;
  char* smh = smem + half * HALF_SMEM;
  if (ph == 2 * NPH_LAYER) { phase_final_norm(vt, vb_, vg_, p); return; }
  const int l = ph / NPH_LAYER, q = ph % NPH_LAYER;
  u16* WB = (u16*)(p.ws + OFF_WB);
  u16* H = (u16*)(p.ws + OFF_H);
  u16* PR = (u16*)(p.ws + OFF_PR);
  u16* NQ = (u16*)(p.ws + OFF_NQ);
  float* X = p.X;
  float* SSQ = (float*)(p.ws + OFF_SSQ);
  auto epi_res = [&](int r, int c0, f32x4 v) {
    f32x4* px = (f32x4*)(X + (size_t)r * 1024 + c0);
    *px = *px + v;
  };
  float rowacc = 0.f;
  float* ssq_out = SSQ;
  auto epi_res_n = [&](int r, int c0, f32x4 v) {
    f32x4* px = (f32x4*)(X + (size_t)r * 1024 + c0);
    const f32x4 xn = *px + v;
    *px = xn;
    store4bf(H + (size_t)r * 1024 + c0, xn);
    rowacc += xn[0] * xn[0] + xn[1] * xn[1] + xn[2] * xn[2] + xn[3] * xn[3];
  };
  auto row_end = [&](int r) {
    float t = rowacc;
    t += __shfl_xor(t, 16);
    t += __shfl_xor(t, 32);
    if ((tid_ & 48) == 0) atomicAdd(ssq_out + r, t);
    rowacc = 0.f;
  };
  constexpr int NONS = 1 << 30;
  switch (q) {
    case 0:
      phase_conv(vt, vb_, vg_, p, l, smh);
      phase_norm_mem(vt, vb_, vg_, p, p.in[I_NORM_MEM] + (size_t)l * 1024);
      if (l == 0) {
        phase_xb(vt, vb_, vg_, p, true, OFF_H, SSQ);
        for (int i = vb_ * 256 + vt; i < 6 * NTOK; i += vg_ * 256) SSQ[NTOK + i] = 0.f;
      }
      break;
    case 1: phase_p_gemm(tid_, p, smem, SSQ + (size_t)(3 * l) * NTOK); break;
    case 2:
      if (gridDim.x >= 224) {
        if (blockIdx.x < 192) phase_scan_pc(tid_, p, l, smem, blockIdx.x, gridDim.x);
        else phase_nat(vt, p, l, smh, vb_ - 384, vg_ - 384);
      } else {
        phase_scan(vt, p, l, smh, vb_, vg_);
        __syncthreads();
        phase_nat(vt, p, l, smh, vb_, vg_);
      }
      break;
    case 3:
      phase_rwkv_post(vt, vb_, vg_, p, l, smh);
      phase_xb(vt, vb_, vg_, p, false, OFF_NK, nullptr);
      break;
    case 4: phase_merge(tid_, p, smem, SSQ + (size_t)(3 * l) * NTOK); break;
    case 5:
      ssq_out = SSQ + (size_t)(3 * l + 1) * NTOK;
      gemm_phase8(tid_, PR + 512, PRW, WB + W_OUT, 1024, 1024, NTOK, 1024, smem, NONS, epi_res_n, NoEpi(), row_end);
      break;
    case 6: {
      const float* ssq = SSQ + (size_t)(3 * l + 1) * NTOK;
      gemm_phase8(tid_, H, 1024, WB + W_XQ, 1024, 1024, NTOK, 1024, smem, NONS,
                 [&](int r, int c0, f32x4 v) { store4bf(PR + (size_t)r * 1024 + c0, v * rstd_of(ssq, r)); }, NoEpi());
    } break;
    case 7: phase_xattn(vt, vb_, vg_, p, smh); break;
    case 8:
      ssq_out = SSQ + (size_t)(3 * l + 2) * NTOK;
      gemm_phase8(tid_, NQ, 1024, WB + W_XO, 1024, 1024, NTOK, 1024, smem, NONS, epi_res_n, NoEpi(), row_end);
      break;
    case 9:
    case 11: {
      const int hf = (q == 11);
      const float* ssq = SSQ + (size_t)(3 * l + 2) * NTOK;
      gemm_phase8(tid_, H, 1024, WB + W_FF1 + (size_t)hf * 2048 * 1024, 1024, 1024, NTOK, 2048, smem, NONS,
                 [&](int r, int c0, f32x4 v) {
                   const float rs = rstd_of(ssq, r);
                   f32x4 o;
#pragma unroll
                   for (int j = 0; j < 4; ++j) { const float x = fmaxf(v[j] * rs, 0.f); o[j] = x * x; }
                   store4bf(PR + (size_t)r * 2048 + c0, o);
                 }, NoEpi());
    } break;
    case 10:
      gemm_phase8(tid_, PR, 2048, WB + W_FF2, 4096, 2048, NTOK, 1024, smem, NONS, epi_res, NoEpi());
      break;
    case 12:
      ssq_out = SSQ + (size_t)(3 * l + 3) * NTOK;
      gemm_phase8(tid_, PR, 2048, WB + W_FF2 + 2048, 4096, 2048, NTOK, 1024, smem, NONS, epi_res_n, NoEpi(), row_end);
      break;
  }
}

#define XB_TMO      128
#define XB_XCNT(j)  (256  + 64 * (j))
#define XB_XSUB(j)  (1280 + 64 * (j))
#define XB_XGEN(j)  (2304 + 64 * (j))
#define XB_TOP      3328
#define XB_TOPGEN   3392
#define XCD_BAR_WORDS 3456
#define XB_SPIN_CAP (1u << 20)
#define LAS __attribute__((address_space(3)))

DEVI unsigned xb_ld(unsigned* p) { return __hip_atomic_load(p, __ATOMIC_RELAXED, __HIP_MEMORY_SCOPE_AGENT); }
DEVI unsigned xb_add(unsigned* p, unsigned v) { return __hip_atomic_fetch_add(p, v, __ATOMIC_RELAXED, __HIP_MEMORY_SCOPE_AGENT); }
DEVI unsigned xb_xcc_id() { return (unsigned)__builtin_amdgcn_s_getreg((3 << 11) | 20) & 0xFu; }
#define XB_SPIN(cond, bar) do { unsigned _sp = 0; while (cond) { __builtin_amdgcn_s_sleep(1); \
    if ((++_sp & 255u) == 0u) { if (xb_ld(&(bar)[XB_TMO])) break; if (_sp > XB_SPIN_CAP) { atomicAdd(&(bar)[XB_TMO], 1u); break; } } } } while (0)

struct XcdBarrier {
  unsigned* bar; unsigned x;
  volatile LAS unsigned* st;
};
DEVI XcdBarrier xcd_barrier_post(unsigned* bar, volatile LAS unsigned* st) {
  XcdBarrier b; b.bar = bar; b.x = xb_xcc_id(); b.st = st;
  if (threadIdx.x == 0) (void)xb_add(&bar[XB_XCNT(b.x)], 1u);
  return b;
}
DEVI void xcd_barrier_complete(unsigned* bar, unsigned x, unsigned& nloc, unsigned& nx) {
  const unsigned G = gridDim.x * gridDim.y * gridDim.z;
  unsigned sum, cnt, mine, sp = 0u;
  for (;;) {
    sum = 0u; cnt = 0u; mine = 0u;
#pragma unroll
    for (unsigned j = 0; j < 16; ++j) { const unsigned c = xb_ld(&bar[XB_XCNT(j)]); sum += c; cnt += (c > 0u) ? 1u : 0u; mine = (j == x) ? c : mine; }
    if (sum == G) break;
    __builtin_amdgcn_s_sleep(1);
    if ((++sp & 255u) == 0u) { if (xb_ld(&bar[XB_TMO])) break; if (sp > XB_SPIN_CAP) { atomicAdd(&bar[XB_TMO], 1u); break; } }
  }
  nloc = mine > 0u ? mine : 1u; nx = cnt > 0u ? cnt : 1u;
}
DEVI void xcd_barrier(const XcdBarrier& b) {
  asm volatile("s_waitcnt vmcnt(0)" ::: "memory");
  __syncthreads();
  if (threadIdx.x == 0) {
    unsigned* bar = b.bar;
    __builtin_amdgcn_s_waitcnt(0);
    unsigned nloc = b.st[0], nx = b.st[1];
    if (nloc == 0u) { xcd_barrier_complete(bar, b.x, nloc, nx); b.st[0] = nloc; b.st[1] = nx; }
    const unsigned old = xb_add(&bar[XB_XSUB(b.x)], 1u);
    const unsigned gen = old / nloc;
    if (old + 1u == (gen + 1u) * nloc) {
      __builtin_amdgcn_fence(__ATOMIC_RELEASE, "agent");
      asm volatile("s_waitcnt vmcnt(0)" ::: "memory");
      const unsigned og = xb_add(&bar[XB_TOP], 1u);
      const unsigned tg = og / nx;
      if (og + 1u == (tg + 1u) * nx) xb_add(&bar[XB_TOPGEN], 1u);
      else XB_SPIN(xb_ld(&bar[XB_TOPGEN]) == tg, bar);
      __builtin_amdgcn_fence(__ATOMIC_ACQUIRE, "agent");
      xb_add(&bar[XB_XGEN(b.x)], 1u);
      asm volatile("s_waitcnt vmcnt(0)" ::: "memory");
    } else {
      XB_SPIN(xb_ld(&bar[XB_XGEN(b.x)]) == gen, bar);
      __builtin_amdgcn_fence(__ATOMIC_ACQUIRE, "agent");
      asm volatile("s_waitcnt vmcnt(0)" ::: "memory");
    }
  }
  __syncthreads();
}

__global__ void __launch_bounds__(512, 2) mega_kernel(Params p, int ph0, int ph1) {
  __shared__ __attribute__((aligned(16))) char smem[2 * HALF_SMEM];
  __shared__ __attribute__((aligned(16))) unsigned xb_words[4];
  if (threadIdx.x == 0) { xb_words[0] = 0u; xb_words[1] = 0u; xb_words[2] = 0u; xb_words[3] = 0u; }
  __syncthreads();
  XcdBarrier xb = xcd_barrier_post((unsigned*)(p.ws + OFF_BAR), (volatile LAS unsigned*)xb_words);
  for (int ph = ph0; ph < ph1; ++ph) {
    if (ph == ph0 + 1) cg::this_grid().sync();
    else if (ph > ph0) xcd_barrier(xb);
    int tid_ = threadIdx.x;
    asm volatile("" : "+v"(tid_));
    run_phase(tid_, p, ph, smem);
  }
}

extern "C" void kernel_launch(void* const* d_in, const int* in_sizes, int n_in, void* d_out, int out_size, void* d_ws,
                              size_t ws_size, hipStream_t stream) {
  if (ws_size < WS_NEED || n_in < 31) return;
  Params p{};
  for (int i = 0; i < 31; ++i) p.in[i] = (const float*)d_in[i];
  p.X = (float*)d_out;
  p.ws = (char*)d_ws;
  static int grid_blocks = 0;
  if (!grid_blocks) {
    int dev = 0, cus = 0, per_cu = 0;
    hipGetDevice(&dev);
    hipDeviceGetAttribute(&cus, hipDeviceAttributeMultiprocessorCount, dev);
    hipOccupancyMaxActiveBlocksPerMultiprocessor(&per_cu, mega_kernel, 512, 0);
    if (per_cu > 1) per_cu = 1;
    if (per_cu < 1) per_cu = 1;
    grid_blocks = cus * per_cu;
  }
  hipMemsetAsync((char*)d_ws + OFF_BAR, 0, 16384, stream);
  int ph0 = 0, ph1 = NPHASES;
  void* args[] = {&p, &ph0, &ph1};
  hipLaunchCooperativeKernel((void*)mega_kernel, dim3(grid_blocks), dim3(512), args, 0, stream);
}
```

```cpp
#include <hip/hip_runtime.h>
#include <hip/hip_cooperative_groups.h>
#include <stdint.h>
namespace cg = cooperative_groups;

typedef unsigned short u16;
typedef __attribute__((ext_vector_type(8))) short bf16x8;
typedef __attribute__((ext_vector_type(4))) float f32x4;
typedef __attribute__((ext_vector_type(8))) _Float16 h16x8;
typedef __attribute__((ext_vector_type(4))) unsigned int u32x4;
typedef __attribute__((ext_vector_type(2))) unsigned int u32x2;

#define DEVI __device__ __forceinline__

constexpr int NTOK = 49152;
constexpr int SEQ_T = 4096;
constexpr int PRW = 1920;
constexpr int NPH_LAYER = 13;
constexpr int NPHASES = 2 * NPH_LAYER + 1;
constexpr int SMEM_BYTES = 78720;

constexpr size_t OFF_WB = 0;
constexpr size_t WB_BYTES = 20512768ull * 2;
constexpr size_t OFF_H = OFF_WB + WB_BYTES;
constexpr size_t OFF_PR = OFF_H + (size_t)NTOK * 1024 * 2;
constexpr size_t OFF_NQ = OFF_PR + (size_t)NTOK * PRW * 2;
constexpr size_t OFF_NK = OFF_NQ + (size_t)NTOK * 512 * 2;
constexpr size_t OFF_NV = OFF_NK + (size_t)NTOK * 512 * 2;
constexpr size_t OFF_KVK = OFF_NV + (size_t)NTOK * 512 * 2;
constexpr size_t OFF_KVT = OFF_KVK + (size_t)3072 * 1024 * 2;
constexpr size_t OFF_MEMH = OFF_KVT + (size_t)3072 * 1024 * 2;
constexpr size_t OFF_BONUS = OFF_MEMH + (size_t)3072 * 1024 * 2;
constexpr size_t OFF_BAR = OFF_BONUS + (size_t)NTOK * 16 * 4;
constexpr size_t OFF_SSQ = OFF_BAR + 16384;
constexpr size_t WS_NEED = OFF_SSQ + (size_t)7 * NTOK * 4;

constexpr size_t W_IN = 0;
constexpr size_t W_BRR = W_IN + (size_t)5504 * 1024;
constexpr size_t W_BRN = W_BRR + (size_t)1024 * 512;
constexpr size_t W_OUT = W_BRN + (size_t)1024 * 512;
constexpr size_t W_XQ = W_OUT + (size_t)1024 * 1024;
constexpr size_t W_XKV = W_XQ + (size_t)1024 * 1024;
constexpr size_t W_XO = W_XKV + (size_t)2048 * 1024;
constexpr size_t W_FF1 = W_XO + (size_t)1024 * 1024;
constexpr size_t W_FF2 = W_FF1 + (size_t)4096 * 1024;
constexpr size_t W_GUP = W_FF2 + (size_t)4096 * 1024;
constexpr size_t W_WUP = W_GUP + (size_t)512 * 128;
constexpr size_t W_AUP = W_WUP + (size_t)2 * 512 * 64;

enum { I_XP = 0, I_XS, I_MP, I_MS, I_NORM_MIX, I_W_IN, I_MU_PREV, I_MU_NEXT, I_W0, I_W_UP, I_A0, I_A_UP,
       I_G_UP, I_K_K, I_K_A, I_R_K, I_GN_G, I_GN_B, I_RPB, I_W_BR_RWKV, I_W_BR_NAT, I_W_OUT, I_NORM_X,
       I_NORM_MEM, I_W_XQ, I_W_XKV, I_W_XO, I_NORM_FF, I_W_FF1, I_W_FF2, I_NORM_FINAL };

struct Params {
  const float* in[31];
  float* X;
  char* ws;
};

DEVI u16 f2bf(float f) {
  uint32_t u = __float_as_uint(f);
  u += 0x7FFFu + ((u >> 16) & 1u);
  return (u16)(u >> 16);
}
DEVI float bf2f(u16 h) { return __uint_as_float(((uint32_t)h) << 16); }
DEVI uint32_t pack2(float a, float b) { return (uint32_t)f2bf(a) | ((uint32_t)f2bf(b) << 16); }
DEVI float frcp(float x) { return __builtin_amdgcn_rcpf(x); }
DEVI float sigm(float x) { return frcp(1.f + __expf(-x)); }
DEVI float ftanh(float x) { return 1.f - 2.f * frcp(__expf(2.f * x) + 1.f); }
DEVI void unpack8(u32x4 u, float* o) {
  o[0] = __uint_as_float(u.x << 16); o[1] = __uint_as_float(u.x & 0xffff0000u);
  o[2] = __uint_as_float(u.y << 16); o[3] = __uint_as_float(u.y & 0xffff0000u);
  o[4] = __uint_as_float(u.z << 16); o[5] = __uint_as_float(u.z & 0xffff0000u);
  o[6] = __uint_as_float(u.w << 16); o[7] = __uint_as_float(u.w & 0xffff0000u);
}
DEVI void load8bf(const u16* p, float* o) { unpack8(*(const u32x4*)p, o); }
DEVI float wave_sum(float v) {
  v += __shfl_xor(v, 32); v += __shfl_xor(v, 16); v += __shfl_xor(v, 8);
  v += __shfl_xor(v, 4); v += __shfl_xor(v, 2); v += __shfl_xor(v, 1);
  return v;
}
DEVI float red4x_sum(float v) { v += __shfl_xor(v, 16); v += __shfl_xor(v, 32); return v; }
DEVI float red4x_max(float v) { v = fmaxf(v, __shfl_xor(v, 16)); v = fmaxf(v, __shfl_xor(v, 32)); return v; }
DEVI float red16_sum(float v) {
  v += __shfl_xor(v, 1); v += __shfl_xor(v, 2); v += __shfl_xor(v, 4); v += __shfl_xor(v, 8);
  return v;
}
DEVI float red16_max(float v) {
  v = fmaxf(v, __shfl_xor(v, 1)); v = fmaxf(v, __shfl_xor(v, 2));
  v = fmaxf(v, __shfl_xor(v, 4)); v = fmaxf(v, __shfl_xor(v, 8));
  return v;
}

DEVI void conv_tile(int tid_, const float* src, int K, int N, u16* dst, int tile, char* smem, const float* gain = nullptr) {
  float (*s)[65] = (float (*)[65])smem;
  const int nN = N >> 6;
  const int tk = tile / nN, tn = tile - tk * nN;
  const int tx = tid_ & 63, ty = tid_ >> 6;
  for (int r = ty; r < 64; r += 4) s[r][tx] = src[(size_t)(tk * 64 + r) * N + tn * 64 + tx];
  __syncthreads();
  const float gk = gain ? gain[tk * 64 + tx] : 1.f;
  for (int r = ty; r < 64; r += 4) dst[(size_t)(tn * 64 + r) * K + tk * 64 + tx] = f2bf(s[tx][r] * gk);
  __syncthreads();
}

DEVI void phase_conv(int tid_, int vb_, int vg_, const Params& p, int l, char* smem) {
  u16* WB = (u16*)(p.ws + OFF_WB);
  const int c0 = 1376, c1 = c0 + 128, c2 = c1 + 128, c3 = c2 + 256, c4 = c3 + 256, c5 = c4 + 512,
            c6 = c5 + 256, c7 = c6 + 1024, c8 = c7 + 1024, c9 = c8 + 16, c10 = c9 + 16, c11 = c10 + 16;
  for (int t = vb_; t < c11; t += vg_) {
    if (t < c0) conv_tile(tid_, p.in[I_W_IN] + (size_t)l * 1024 * 5504, 1024, 5504, WB + W_IN, t, smem, p.in[I_NORM_MIX] + (size_t)l * 1024);
    else if (t < c1) conv_tile(tid_, p.in[I_W_BR_RWKV] + (size_t)l * 512 * 1024, 512, 1024, WB + W_BRR, t - c0, smem);
    else if (t < c2) conv_tile(tid_, p.in[I_W_BR_NAT] + (size_t)l * 512 * 1024, 512, 1024, WB + W_BRN, t - c1, smem);
    else if (t < c3) conv_tile(tid_, p.in[I_W_OUT] + (size_t)l * 1024 * 1024, 1024, 1024, WB + W_OUT, t - c2, smem);
    else if (t < c4) conv_tile(tid_, p.in[I_W_XQ] + (size_t)l * 1024 * 1024, 1024, 1024, WB + W_XQ, t - c3, smem, p.in[I_NORM_X] + (size_t)l * 1024);
    else if (t < c5) conv_tile(tid_, p.in[I_W_XKV] + (size_t)l * 1024 * 2048, 1024, 2048, WB + W_XKV, t - c4, smem);
    else if (t < c6) conv_tile(tid_, p.in[I_W_XO] + (size_t)l * 1024 * 1024, 1024, 1024, WB + W_XO, t - c5, smem);
    else if (t < c7) conv_tile(tid_, p.in[I_W_FF1] + (size_t)l * 1024 * 4096, 1024, 4096, WB + W_FF1, t - c6, smem, p.in[I_NORM_FF] + (size_t)l * 1024);
    else if (t < c8) conv_tile(tid_, p.in[I_W_FF2] + (size_t)l * 4096 * 1024, 4096, 1024, WB + W_FF2, t - c7, smem);
    else if (t < c9) conv_tile(tid_, p.in[I_G_UP] + (size_t)l * 128 * 512, 128, 512, WB + W_GUP, t - c8, smem);
    else if (t < c10) { const int dd = (t - c9) >> 3; conv_tile(tid_, p.in[I_W_UP] + (size_t)(l * 2 + dd) * 64 * 512, 64, 512, WB + W_WUP + (size_t)dd * 512 * 64, (t - c9) & 7, smem); }
    else { const int dd = (t - c10) >> 3; conv_tile(tid_, p.in[I_A_UP] + (size_t)(l * 2 + dd) * 64 * 512, 64, 512, WB + W_AUP + (size_t)dd * 512 * 64, (t - c10) & 7, smem); }
  }
}

DEVI void norm_row_bf16(int tid_, const float* src, const float* g, u16* dst, float* xcopy) {
  const int lane = tid_ & 63;
  float4 v[4];
  float ss = 0.f;
#pragma unroll
  for (int i = 0; i < 4; ++i) {
    v[i] = ((const float4*)src)[lane + i * 64];
    ss += v[i].x * v[i].x + v[i].y * v[i].y + v[i].z * v[i].z + v[i].w * v[i].w;
  }
  ss = wave_sum(ss);
  const float rs = rsqrtf(ss * (1.f / 1024.f) + 1e-6f);
#pragma unroll
  for (int i = 0; i < 4; ++i) {
    float4 gg = ((const float4*)g)[lane + i * 64];
    u32x2 o;
    o.x = pack2(v[i].x * rs * gg.x, v[i].y * rs * gg.y);
    o.y = pack2(v[i].z * rs * gg.z, v[i].w * rs * gg.w);
    ((u32x2*)dst)[lane + i * 64] = o;
    if (xcopy) ((float4*)xcopy)[lane + i * 64] = v[i];
  }
}

DEVI void phase_xb(int tid_, int vb_, int vg_, const Params& p, bool from_input, size_t hoff, float* ssq) {
  u16* H = (u16*)(p.ws + hoff);
  const int wid = tid_ >> 6, lane = tid_ & 63;
  for (int r = vb_ * 4 + wid; r < NTOK; r += vg_ * 4) {
    const float* src;
    if (from_input) src = (r < 32768) ? p.in[I_XP] + (size_t)r * 1024 : p.in[I_XS] + (size_t)(r - 32768) * 1024;
    else src = p.X + (size_t)r * 1024;
    float ss = 0.f;
#pragma unroll
    for (int i = 0; i < 4; ++i) {
      const float4 v = ((const float4*)src)[lane + i * 64];
      ss += v.x * v.x + v.y * v.y + v.z * v.z + v.w * v.w;
      u32x2 o;
      o.x = pack2(v.x, v.y); o.y = pack2(v.z, v.w);
      ((u32x2*)(H + (size_t)r * 1024))[lane + i * 64] = o;
    }
    if (ssq) {
      ss = wave_sum(ss);
      if (lane == 0) ssq[r] = ss;
    }
  }
}
DEVI void phase_norm_mem(int tid_, int vb_, int vg_, const Params& p, const float* g) {
  u16* MH = (u16*)(p.ws + OFF_MEMH);
  const int wid = tid_ >> 6;
  for (int r = vb_ * 4 + wid; r < 3072; r += vg_ * 4) {
    const float* src = (r < 2048) ? p.in[I_MP] + (size_t)r * 1024 : p.in[I_MS] + (size_t)(r - 2048) * 1024;
    norm_row_bf16(tid_, src, g, MH + (size_t)r * 1024, nullptr);
  }
}
DEVI void phase_final_norm(int tid_, int vb_, int vg_, const Params& p) {
  const float* g = p.in[I_NORM_FINAL];
  const float* ssq = (const float*)(p.ws + OFF_SSQ) + (size_t)6 * NTOK;
  const int wid = tid_ >> 6, lane = tid_ & 63;
  for (int r = vb_ * 4 + wid; r < NTOK; r += vg_ * 4) {
    float* row = p.X + (size_t)r * 1024;
    const float rs = rsqrtf(ssq[r] * (1.f / 1024.f) + 1e-6f);
#pragma unroll
    for (int i = 0; i < 4; ++i) {
      const float4 v = ((const float4*)row)[lane + i * 64];
      const float4 gg = ((const float4*)g)[lane + i * 64];
      float4 o;
      o.x = v.x * rs * gg.x; o.y = v.y * rs * gg.y; o.z = v.z * rs * gg.z; o.w = v.w * rs * gg.w;
      ((float4*)row)[lane + i * 64] = o;
    }
  }
}

template <int OFF>
DEVI bf16x8 lds_rd128(uint32_t addr) {
  bf16x8 r;
  asm volatile("ds_read_b128 %0, %1 offset:%2" : "=v"(r) : "v"(addr), "n"(OFF));
  return r;
}

template <int NW, bool SWAP>
DEVI void gemm_kloop(int tid_, f32x4 (&acc)[4][NW], const u16* __restrict__ A, int lda, const u16* __restrict__ Bt, int ldb,
                     int K, char* smem) {
  constexpr int STG = 8192 + NW * 2048;
  constexpr int NB = NW / 2;
  const int tid = tid_, lane = tid & 63, wid = tid >> 6;
  const int wr = wid >> 1, wc = wid & 1, fr = lane & 15, fq = lane >> 4;
  const int lrow = lane >> 2, lphys = lane & 3, lhi = lane >> 4;
  const int gsw = (4 - lhi) & 3;
  const u16* ga[2];
  const u16* gb[NB];
#pragma unroll
  for (int q = 0; q < 2; ++q) ga[q] = A + (size_t)((wid * 2 + q) * 16 + lrow) * lda + (lphys ^ gsw) * 8;
#pragma unroll
  for (int q = 0; q < NB; ++q) gb[q] = Bt + (size_t)((wid * NB + q) * 16 + lrow) * ldb + (lphys ^ gsw) * 8;
  const int rsw = (4 - ((fr >> 2) & 3)) & 3;
  const int ch = (fq ^ rsw) * 16;
  const int nk = K >> 5;
  const uint32_t lds_base = (uint32_t)(size_t)(__attribute__((address_space(3))) char*)smem;
  const uint32_t aoff = (uint32_t)((wr * 64 + fr) * 64 + ch);
  const uint32_t boff = (uint32_t)(8192 + (wc * 16 * NW + fr) * 64 + ch);
  asm volatile("s_waitcnt vmcnt(0)" ::: "memory");
  __syncthreads();
#define GEMM_ISSUE(kt_)                                                                                              \
  do {                                                                                                               \
    char* nb_ = smem + ((kt_) & 3) * STG;                                                                            \
    _Pragma("unroll") for (int q = 0; q < 2; ++q) __builtin_amdgcn_global_load_lds(                                  \
        (const unsigned*)(ga[q] + (kt_) * 32),                                                                       \
        (__attribute__((address_space(3))) unsigned*)(nb_ + (wid * 2 + q) * 1024 + lane * 16), 16, 0, 0);            \
    _Pragma("unroll") for (int q = 0; q < NB; ++q) __builtin_amdgcn_global_load_lds(                                 \
        (const unsigned*)(gb[q] + (kt_) * 32),                                                                       \
        (__attribute__((address_space(3))) unsigned*)(nb_ + 8192 + (wid * NB + q) * 1024 + lane * 16), 16, 0, 0);    \
  } while (0)
  GEMM_ISSUE(0);
  if (nk > 1) GEMM_ISSUE(1);
  if (nk > 2) GEMM_ISSUE(2);
  for (int kt = 0; kt < nk; ++kt) {
    if (kt + 2 < nk) {
      if (NW == 4) asm volatile("s_waitcnt vmcnt(8)" ::: "memory");
      else asm volatile("s_waitcnt vmcnt(6)" ::: "memory");
    } else if (kt + 1 < nk) {
      if (NW == 4) asm volatile("s_waitcnt vmcnt(4)" ::: "memory");
      else asm volatile("s_waitcnt vmcnt(3)" ::: "memory");
    } else {
      asm volatile("s_waitcnt vmcnt(0)" ::: "memory");
    }
    __builtin_amdgcn_s_barrier();
    asm volatile("" ::: "memory");
    if (kt + 3 < nk) GEMM_ISSUE(kt + 3);
    const uint32_t sb = lds_base + (kt & 3) * STG;
    bf16x8 af[4], bfr[4];
    af[0] = lds_rd128<0>(sb + aoff); af[1] = lds_rd128<1024>(sb + aoff);
    af[2] = lds_rd128<2048>(sb + aoff); af[3] = lds_rd128<3072>(sb + aoff);
    bfr[0] = lds_rd128<0>(sb + boff); bfr[1] = lds_rd128<1024>(sb + boff);
    if (NW == 4) {
      bfr[2] = lds_rd128<2048>(sb + boff); bfr[3] = lds_rd128<3072>(sb + boff);
      asm volatile("s_waitcnt lgkmcnt(0)" : "+v"(af[0]), "+v"(af[1]), "+v"(af[2]), "+v"(af[3]),
                   "+v"(bfr[0]), "+v"(bfr[1]), "+v"(bfr[2]), "+v"(bfr[3]));
    } else {
      asm volatile("s_waitcnt lgkmcnt(0)" : "+v"(af[0]), "+v"(af[1]), "+v"(af[2]), "+v"(af[3]), "+v"(bfr[0]), "+v"(bfr[1]));
    }
#pragma unroll
    for (int m = 0; m < 4; ++m)
#pragma unroll
      for (int n = 0; n < NW; ++n) {
        if (SWAP) acc[m][n] = __builtin_amdgcn_mfma_f32_16x16x32_bf16(bfr[n], af[m], acc[m][n], 0, 0, 0);
        else acc[m][n] = __builtin_amdgcn_mfma_f32_16x16x32_bf16(af[m], bfr[n], acc[m][n], 0, 0, 0);
      }
  }
#undef GEMM_ISSUE
}

DEVI int launder(int x) { asm volatile("" : "+v"(x)); return x; }

template <int NW>
DEVI void zero_acc(f32x4 (&acc)[4][NW]) {
#pragma unroll
  for (int m = 0; m < 4; ++m)
#pragma unroll
    for (int n = 0; n < NW; ++n) acc[m][n] = (f32x4){0.f, 0.f, 0.f, 0.f};
}

struct NoEpi { DEVI void operator()(int, int, f32x4) const {} };

template <class EpiS, class EpiN>
DEVI void gemm_phase(int tid_, const u16* A, int lda, const u16* Bt, int ldb, int K, int M, int N, char* smem, int ns_from,
                     EpiS epiS, EpiN epiN) {
  const int nN = N >> 7, nM = M >> 7;
  const int lane = tid_ & 63, wid = tid_ >> 6;
  const int wr = wid >> 1, wc = wid & 1, fr = lane & 15, fq = lane >> 4;
  const int xcd = blockIdx.x & 7, jloc = blockIdx.x >> 3, nloc = gridDim.x >> 3;
  for (int lt = jloc; lt < (nM >> 3) * nN; lt += nloc) {
    const int tml = lt / nN, tn = lt - tml * nN;
    const int tm = tml * 8 + xcd;
    const int m0 = tm << 7, n0 = tn << 7;
    f32x4 acc[4][4];
    zero_acc(acc);
    if (n0 < ns_from) {
      gemm_kloop<4, true>(tid_, acc, A + (size_t)m0 * lda, lda, Bt + (size_t)n0 * ldb, ldb, K, smem);
#pragma unroll
      for (int m = 0; m < 4; ++m)
#pragma unroll
        for (int n = 0; n < 4; ++n) epiS(m0 + wr * 64 + m * 16 + fr, n0 + wc * 64 + n * 16 + fq * 4, acc[m][n]);
    } else {
      gemm_kloop<4, false>(tid_, acc, A + (size_t)m0 * lda, lda, Bt + (size_t)n0 * ldb, ldb, K, smem);
#pragma unroll
      for (int m = 0; m < 4; ++m)
#pragma unroll
        for (int n = 0; n < 4; ++n) epiN(m0 + wr * 64 + m * 16 + fq * 4, n0 + wc * 64 + n * 16 + fr, acc[m][n]);
    }
  }
}


template <bool SWAP>
DEVI void gemm_kloop_big(int tid_, f32x4 (&acc)[8][4], const u16* __restrict__ A, int lda, const u16* __restrict__ Bt,
                         int ldb, int K, char* smem) {
  constexpr int STG = 16384 + 8192;
  const int tid = tid_, lane = tid & 63, wid = tid >> 6;
  const int wr = wid >> 1, wc = wid & 1, fr = lane & 15, fq = lane >> 4;
  const int lrow = lane >> 2, lphys = lane & 3, lhi = lane >> 4;
  const int gsw = (4 - lhi) & 3;
  const u16* ga = A + (size_t)(wid * 64 + lrow) * lda + (lphys ^ gsw) * 8;
  const u16* gb = Bt + (size_t)(wid * 32 + lrow) * ldb + (lphys ^ gsw) * 8;
  const size_t a16 = (size_t)16 * lda, b16 = (size_t)16 * ldb;
  const int rsw = (4 - ((fr >> 2) & 3)) & 3;
  const int ch = (fq ^ rsw) * 16;
  const int nk = K >> 5;
  const uint32_t lds_base = (uint32_t)(size_t)(__attribute__((address_space(3))) char*)smem;
  const uint32_t aoff = (uint32_t)((wr * 128 + fr) * 64 + ch);
  const uint32_t boff = (uint32_t)(16384 + (wc * 64 + fr) * 64 + ch);
  asm volatile("s_waitcnt vmcnt(0)" ::: "memory");
  __syncthreads();
#define GEMMB_ISSUE(kt_, buf_)                                                                                       \
  do {                                                                                                               \
    char* nb_ = smem + (buf_) * STG;                                                                                 \
    _Pragma("unroll") for (int q = 0; q < 4; ++q) __builtin_amdgcn_global_load_lds(                                  \
        (const unsigned*)(ga + q * a16 + (kt_) * 32),                                                                \
        (__attribute__((address_space(3))) unsigned*)(nb_ + (wid * 4 + q) * 1024 + lane * 16), 16, 0, 0);            \
    _Pragma("unroll") for (int q = 0; q < 2; ++q) __builtin_amdgcn_global_load_lds(                                  \
        (const unsigned*)(gb + q * b16 + (kt_) * 32),                                                                \
        (__attribute__((address_space(3))) unsigned*)(nb_ + 16384 + (wid * 2 + q) * 1024 + lane * 16), 16, 0, 0);   \
  } while (0)
  GEMMB_ISSUE(0, 0);
  if (nk > 1) GEMMB_ISSUE(1, 1);
  int cb = 0;
  for (int kt = 0; kt < nk; ++kt) {
    if (kt + 1 < nk) asm volatile("s_waitcnt vmcnt(6)" ::: "memory");
    else asm volatile("s_waitcnt vmcnt(0)" ::: "memory");
    __builtin_amdgcn_s_barrier();
    asm volatile("" ::: "memory");
    const int nbuf = (cb == 0) ? 2 : cb - 1;
    if (kt + 2 < nk) GEMMB_ISSUE(kt + 2, nbuf);
    const uint32_t sb = lds_base + cb * STG;
    bf16x8 a0[4], a1[4], bb[4];
    a0[0] = lds_rd128<0>(sb + aoff); a0[1] = lds_rd128<1024>(sb + aoff);
    a0[2] = lds_rd128<2048>(sb + aoff); a0[3] = lds_rd128<3072>(sb + aoff);
    bb[0] = lds_rd128<0>(sb + boff); bb[1] = lds_rd128<1024>(sb + boff);
    bb[2] = lds_rd128<2048>(sb + boff); bb[3] = lds_rd128<3072>(sb + boff);
    a1[0] = lds_rd128<4096>(sb + aoff); a1[1] = lds_rd128<5120>(sb + aoff);
    a1[2] = lds_rd128<6144>(sb + aoff); a1[3] = lds_rd128<7168>(sb + aoff);
    asm volatile("s_waitcnt lgkmcnt(4)" : "+v"(a0[0]), "+v"(a0[1]), "+v"(a0[2]), "+v"(a0[3]),
                 "+v"(bb[0]), "+v"(bb[1]), "+v"(bb[2]), "+v"(bb[3]));
#pragma unroll
    for (int m = 0; m < 4; ++m)
#pragma unroll
      for (int n = 0; n < 4; ++n) {
        if (SWAP) acc[m][n] = __builtin_amdgcn_mfma_f32_16x16x32_bf16(bb[n], a0[m], acc[m][n], 0, 0, 0);
        else acc[m][n] = __builtin_amdgcn_mfma_f32_16x16x32_bf16(a0[m], bb[n], acc[m][n], 0, 0, 0);
      }
    asm volatile("s_waitcnt lgkmcnt(0)" : "+v"(a1[0]), "+v"(a1[1]), "+v"(a1[2]), "+v"(a1[3]));
#pragma unroll
    for (int m = 0; m < 4; ++m)
#pragma unroll
      for (int n = 0; n < 4; ++n) {
        if (SWAP) acc[4 + m][n] = __builtin_amdgcn_mfma_f32_16x16x32_bf16(bb[n], a1[m], acc[4 + m][n], 0, 0, 0);
        else acc[4 + m][n] = __builtin_amdgcn_mfma_f32_16x16x32_bf16(a1[m], bb[n], acc[4 + m][n], 0, 0, 0);
      }
    cb = (cb == 2) ? 0 : cb + 1;
  }
#undef GEMMB_ISSUE
}

template <class EpiS, class EpiN>
DEVI void gemm_phase_big(int tid_, const u16* A, int lda, const u16* Bt, int ldb, int K, int M, int N, char* smem,
                         int ns_from, EpiS epiS, EpiN epiN) {
  const int nN = N >> 7, nM = M >> 8;
  const int lane = tid_ & 63, wid = tid_ >> 6;
  const int wr = wid >> 1, wc = wid & 1, fr = lane & 15, fq = lane >> 4;
  const int xcd = blockIdx.x & 7, jloc = blockIdx.x >> 3, nloc = gridDim.x >> 3;
  for (int lt = jloc; lt < (nM >> 3) * nN; lt += nloc) {
    const int tml = lt / nN, tn = lt - tml * nN;
    const int tm = tml * 8 + xcd;
    const int m0 = tm << 8, n0 = tn << 7;
    f32x4 acc[8][4];
#pragma unroll
    for (int m = 0; m < 8; ++m)
#pragma unroll
      for (int n = 0; n < 4; ++n) acc[m][n] = (f32x4){0.f, 0.f, 0.f, 0.f};
    if (n0 < ns_from) {
      gemm_kloop_big<true>(launder(tid_), acc, A + (size_t)m0 * lda, lda, Bt + (size_t)n0 * ldb, ldb, K, smem);
#pragma unroll
      for (int m = 0; m < 8; ++m)
#pragma unroll
        for (int n = 0; n < 4; ++n) epiS(m0 + wr * 128 + m * 16 + fr, n0 + wc * 64 + n * 16 + fq * 4, acc[m][n]);
    } else {
      gemm_kloop_big<false>(launder(tid_), acc, A + (size_t)m0 * lda, lda, Bt + (size_t)n0 * ldb, ldb, K, smem);
#pragma unroll
      for (int m = 0; m < 8; ++m)
#pragma unroll
        for (int n = 0; n < 4; ++n) epiN(m0 + wr * 128 + m * 16 + fq * 4, n0 + wc * 64 + n * 16 + fr, acc[m][n]);
    }
  }
}


template <bool SWAP>
DEVI void gemm_kloop8(int tid_, f32x4 (&acc)[8][4], const u16* __restrict__ A, int lda, const u16* __restrict__ Bt,
                      int ldb, int K, char* smem) {
  constexpr int STG = 65536;
  const int tid = tid_, lane = tid & 63, wid = tid >> 6;
  const int wr = wid >> 2, wc = wid & 3, fr = lane & 15, fq = lane >> 4;
  const int lrow = lane >> 3, lphys = lane & 7, lhi = lane >> 4;
  const u16* ga[4];
  const u16* gb[4];
#pragma unroll
  for (int q = 0; q < 4; ++q) {
    const int kc = lphys ^ ((4 * (q & 1) + lhi) & 7);
    ga[q] = A + (size_t)((wid * 4 + q) * 8 + lrow) * lda + kc * 8;
    gb[q] = Bt + (size_t)((wid * 4 + q) * 8 + lrow) * ldb + kc * 8;
  }
  const int swz = (fr >> 1) & 7;
  const int nk = K >> 6;
  const uint32_t lds_base = (uint32_t)(size_t)(__attribute__((address_space(3))) char*)smem;
  const uint32_t arow = (uint32_t)((wr * 128 + fr) * 128);
  const uint32_t brow = (uint32_t)(32768 + (wc * 64 + fr) * 128);
  asm volatile("s_waitcnt vmcnt(0)" ::: "memory");
  __syncthreads();
#define GEMM8_ISSUE(kt_)                                                                                             \
  do {                                                                                                               \
    char* nb_ = smem + ((kt_) & 1) * STG;                                                                            \
    _Pragma("unroll") for (int q = 0; q < 4; ++q) __builtin_amdgcn_global_load_lds(                                  \
        (const unsigned*)(ga[q] + (kt_) * 64),                                                                       \
        (__attribute__((address_space(3))) unsigned*)(nb_ + (wid * 4 + q) * 1024 + lane * 16), 16, 0, 0);            \
    _Pragma("unroll") for (int q = 0; q < 4; ++q) __builtin_amdgcn_global_load_lds(                                  \
        (const unsigned*)(gb[q] + (kt_) * 64),                                                                       \
        (__attribute__((address_space(3))) unsigned*)(nb_ + 32768 + (wid * 4 + q) * 1024 + lane * 16), 16, 0, 0);    \
  } while (0)
  GEMM8_ISSUE(0);
  for (int kt = 0; kt < nk; ++kt) {
    asm volatile("s_waitcnt vmcnt(0)" ::: "memory");
    __builtin_amdgcn_s_barrier();
    asm volatile("" ::: "memory");
    if (kt + 1 < nk) GEMM8_ISSUE(kt + 1);
    const uint32_t sb = lds_base + (kt & 1) * STG;
#pragma unroll
    for (int ks = 0; ks < 2; ++ks) {
      const uint32_t chb = (uint32_t)(((ks * 4 + fq) ^ swz) * 16);
      const uint32_t aoff = sb + arow + chb, boff = sb + brow + chb;
      bf16x8 a0[4], a1[4], bb[4];
      a0[0] = lds_rd128<0>(aoff); a0[1] = lds_rd128<2048>(aoff);
      a0[2] = lds_rd128<4096>(aoff); a0[3] = lds_rd128<6144>(aoff);
      bb[0] = lds_rd128<0>(boff); bb[1] = lds_rd128<2048>(boff);
      bb[2] = lds_rd128<4096>(boff); bb[3] = lds_rd128<6144>(boff);
      a1[0] = lds_rd128<8192>(aoff); a1[1] = lds_rd128<10240>(aoff);
      a1[2] = lds_rd128<12288>(aoff); a1[3] = lds_rd128<14336>(aoff);
      asm volatile("s_waitcnt lgkmcnt(4)" : "+v"(a0[0]), "+v"(a0[1]), "+v"(a0[2]), "+v"(a0[3]),
                   "+v"(bb[0]), "+v"(bb[1]), "+v"(bb[2]), "+v"(bb[3]));
#pragma unroll
      for (int m = 0; m < 4; ++m)
#pragma unroll
        for (int n = 0; n < 4; ++n) {
          if (SWAP) acc[m][n] = __builtin_amdgcn_mfma_f32_16x16x32_bf16(bb[n], a0[m], acc[m][n], 0, 0, 0);
          else acc[m][n] = __builtin_amdgcn_mfma_f32_16x16x32_bf16(a0[m], bb[n], acc[m][n], 0, 0, 0);
        }
      asm volatile("s_waitcnt lgkmcnt(0)" : "+v"(a1[0]), "+v"(a1[1]), "+v"(a1[2]), "+v"(a1[3]));
#pragma unroll
      for (int m = 0; m < 4; ++m)
#pragma unroll
        for (int n = 0; n < 4; ++n) {
          if (SWAP) acc[4 + m][n] = __builtin_amdgcn_mfma_f32_16x16x32_bf16(bb[n], a1[m], acc[4 + m][n], 0, 0, 0);
          else acc[4 + m][n] = __builtin_amdgcn_mfma_f32_16x16x32_bf16(a1[m], bb[n], acc[4 + m][n], 0, 0, 0);
        }
    }
  }
#undef GEMM8_ISSUE
}

struct NoRow { DEVI void operator()(int) const {} };

template <class EpiS, class EpiN, class RowEnd = NoRow>
DEVI void gemm_phase8(int tid_, const u16* A, int lda, const u16* Bt, int ldb, int K, int M, int N, char* smem,
                      int ns_from, EpiS epiS, EpiN epiN, RowEnd rowEnd = NoRow(), int rot = 0) {
  const int nN = (N + 255) >> 8, nM = M >> 8;
  const int lane = tid_ & 63, wid = tid_ >> 6;
  const int wr = wid >> 2, wc = wid & 3, fr = lane & 15, fq = lane >> 4;
  const bool xmap = ((gridDim.x & 7) == 0) && ((nM & 7) == 0);
  const int xcd = blockIdx.x & 7;
  const int first = xmap ? (int)(blockIdx.x >> 3) : (int)((blockIdx.x + gridDim.x - rot) % gridDim.x);
  const int stride = xmap ? (int)(gridDim.x >> 3) : (int)gridDim.x;
  const int count = xmap ? (nM >> 3) * nN : nM * nN;
  for (int it = first; it < count; it += stride) {
    const int tq = it / nN, tn = it - tq * nN;
    const int tm = xmap ? tq * 8 + xcd : tq;
    const int m0 = tm << 8, n0 = tn << 8;
    const int colb = n0 + wc * 64;
    f32x4 acc[8][4];
#pragma unroll
    for (int m = 0; m < 8; ++m)
#pragma unroll
      for (int n = 0; n < 4; ++n) acc[m][n] = (f32x4){0.f, 0.f, 0.f, 0.f};
    if (colb < ns_from) {
      gemm_kloop8<true>(launder(tid_), acc, A + (size_t)m0 * lda, lda, Bt + (size_t)n0 * ldb, ldb, K, smem);
      if (colb < N) {
#pragma unroll
        for (int m = 0; m < 8; ++m) {
#pragma unroll
          for (int n = 0; n < 4; ++n) epiS(m0 + wr * 128 + m * 16 + fr, colb + n * 16 + fq * 4, acc[m][n]);
          rowEnd(m0 + wr * 128 + m * 16 + fr);
        }
      }
    } else {
      gemm_kloop8<false>(launder(tid_), acc, A + (size_t)m0 * lda, lda, Bt + (size_t)n0 * ldb, ldb, K, smem);
      if (colb < N) {
#pragma unroll
        for (int m = 0; m < 8; ++m)
#pragma unroll
          for (int n = 0; n < 4; ++n) epiN(m0 + wr * 128 + m * 16 + fq * 4, colb + n * 16 + fr, acc[m][n]);
      }
    }
  }
}

DEVI void store4bf(u16* dst, f32x4 v) {
  u32x2 o;
  o.x = pack2(v[0], v[1]); o.y = pack2(v[2], v[3]);
  *(u32x2*)dst = o;
}

DEVI float rstd_of(const float* ssq, int r) { return rsqrtf(ssq[r] * (1.f / 1024.f) + 1e-6f); }

DEVI void phase_p_gemm(int tid_, const Params& p, char* smem, const float* ssq) {
  u16* WB = (u16*)(p.ws + OFF_WB);
  const u16* H = (const u16*)(p.ws + OFF_H);
  u16* PR = (u16*)(p.ws + OFF_PR);
  u16* NQ = (u16*)(p.ws + OFF_NQ);
  u16* NK = (u16*)(p.ws + OFF_NK);
  u16* NVT = (u16*)(p.ws + OFF_NV);
  gemm_phase8(tid_, H, 1024, WB + W_IN, 1024, 1024, NTOK, 3456, smem, 2944,
    [&](int r, int c0, f32x4 v) {
      v = v * rstd_of(ssq, r);
      if (c0 < 1920) store4bf(PR + (size_t)r * PRW + c0, v);
      else if (c0 < 2432) store4bf(NQ + (size_t)r * 512 + (c0 - 1920), v);
      else store4bf(NK + (size_t)r * 512 + (c0 - 2432), v);
    },
    [&](int r0, int c, f32x4 v) {
      const int cc = c - 2944;
      const int s = r0 >> 12, t = r0 & 4095;
      const f32x4 q = *(const f32x4*)(ssq + r0);
#pragma unroll
      for (int j = 0; j < 4; ++j) v[j] *= rsqrtf(q[j] * (1.f / 1024.f) + 1e-6f);
      store4bf(NVT + ((size_t)(s * 512 + cc)) * 4096 + t, v);
    });
  const u16* MH = (const u16*)(p.ws + OFF_MEMH);
  u16* KVK = (u16*)(p.ws + OFF_KVK);
  u16* KVT = (u16*)(p.ws + OFF_KVT);
  gemm_phase8(tid_, MH, 1024, WB + W_XKV, 1024, 1024, 3072, 2048, smem, 1024,
    [&](int r, int c0, f32x4 v) { store4bf(KVK + (size_t)r * 1024 + c0, v); },
    [&](int r0, int c, f32x4 v) {
      const int cc = c - 1024;
      const int s = r0 >> 8, m = r0 & 255;
      store4bf(KVT + ((size_t)(s * 1024 + cc)) * 256 + m, v);
    }, NoRow(), 128);
}

DEVI void phase_nat(int tid_, const Params& p, int l, char* smem, int bfirst, int bstride) {
  u16* NQ = (u16*)(p.ws + OFF_NQ);
  const u16* NK = (const u16*)(p.ws + OFF_NK);
  const u16* NVT = (const u16*)(p.ws + OFF_NV);
  const float* rpb = p.in[I_RPB] + (size_t)l * 8 * 15 * 31;
  const int lane = tid_ & 63, g = tid_ >> 6, fr = lane & 15, fq = lane >> 4;
  u16* Pw = (u16*)smem + g * (16 * 264);
  const int cb = (g == 0) ? 0 : (g == 1) ? 8 : (g == 2) ? 24 : 32;
  const int c = g * 16 + fr;
  int cs = c - 8; cs = cs < 0 ? 0 : (cs > 48 ? 48 : cs);
  for (int t = bfirst; t < 12 * 64 * 8; t += bstride) {
    const int h = t & 7, ri = (t >> 3) & 63, s = t >> 9;
    int rs = ri - 4; rs = rs < 0 ? 0 : (rs > 56 ? 56 : rs);
    const size_t tokq = (size_t)s * 4096 + ri * 64 + g * 16;
    bf16x8 aq[2];
    aq[0] = *(const bf16x8*)(NQ + (tokq + fr) * 512 + h * 64 + fq * 8);
    aq[1] = *(const bf16x8*)(NQ + (tokq + fr) * 512 + h * 64 + 32 + fq * 8);
    f32x4 acc[16];
#pragma unroll
    for (int n = 0; n < 16; ++n) {
      acc[n] = (f32x4){0.f, 0.f, 0.f, 0.f};
      const int r = n >> 1, col = cb + (n & 1) * 16 + fr;
      const u16* kp = NK + ((size_t)s * 4096 + (rs + r) * 64 + col) * 512 + h * 64 + fq * 8;
      const bf16x8 b0 = *(const bf16x8*)kp;
      const bf16x8 b1 = *(const bf16x8*)(kp + 32);
      acc[n] = __builtin_amdgcn_mfma_f32_16x16x32_bf16(b0, aq[0], acc[n], 0, 0, 0);
      acc[n] = __builtin_amdgcn_mfma_f32_16x16x32_bf16(b1, aq[1], acc[n], 0, 0, 0);
    }
    float m = -1e30f;
#pragma unroll
    for (int n = 0; n < 16; ++n) {
      const int di = rs + (n >> 1) - ri + 7;
      const float* brow = rpb + (h * 15 + di) * 31 + 15 - c;
#pragma unroll
      for (int j = 0; j < 4; ++j) {
        const int kc = cb + (n & 1) * 16 + fq * 4 + j;
        float sc = -1e30f;
        if (kc >= cs && kc < cs + 16) sc = acc[n][j] * 0.125f + brow[kc];
        acc[n][j] = sc;
        m = fmaxf(m, sc);
      }
    }
    m = red4x_max(m);
    float ssum = 0.f;
#pragma unroll
    for (int n = 0; n < 16; ++n) {
      f32x4 e;
#pragma unroll
      for (int j = 0; j < 4; ++j) { e[j] = __expf(acc[n][j] - m); ssum += e[j]; }
      store4bf(Pw + fr * 264 + n * 16 + fq * 4, e);
    }
    const float sm = 1.f / red4x_sum(ssum);
    f32x4 o[4];
#pragma unroll
    for (int n = 0; n < 4; ++n) o[n] = (f32x4){0.f, 0.f, 0.f, 0.f};
#pragma unroll
    for (int ks = 0; ks < 8; ++ks) {
      const bf16x8 ap = *(const bf16x8*)(Pw + fr * 264 + ks * 32 + fq * 8);
#pragma unroll
      for (int n = 0; n < 4; ++n) {
        const bf16x8 bv = *(const bf16x8*)(NVT + ((size_t)(s * 512 + h * 64 + n * 16 + fr)) * 4096 + (rs + ks) * 64 + cb + fq * 8);
        o[n] = __builtin_amdgcn_mfma_f32_16x16x32_bf16(bv, ap, o[n], 0, 0, 0);
      }
    }
#pragma unroll
    for (int n = 0; n < 4; ++n) store4bf(NQ + (tokq + fr) * 512 + h * 64 + n * 16 + fq * 4, o[n] * sm);
  }
}

constexpr int SC_OPS = 0;
constexpr int SC_VV = 40960;
constexpr int SC_WR = 49152;
constexpr int SC_AP = 57344;
constexpr int SC_TW = 65536;
constexpr int SC_AD = 70144;
constexpr int SC_NRM = 74752;
constexpr int SC_MU = 74880;
constexpr int SC_CST = 77440;

typedef __attribute__((ext_vector_type(2))) float f32x2;

template <int CTRL>
DEVI float dpp_mov(float x) {
  return __int_as_float(__builtin_amdgcn_update_dpp(0, __float_as_int(x), CTRL, 0xF, 0xF, true));
}
DEVI float red8(float x) {
  x += dpp_mov<0xB1>(x);
  x += dpp_mov<0x4E>(x);
  x += dpp_mov<0x141>(x);
  return x;
}
DEVI f32x2 lo2(f32x4 v) { return __builtin_shufflevector(v, v, 0, 1); }
DEVI f32x2 hi2(f32x4 v) { return __builtin_shufflevector(v, v, 2, 3); }

struct ScanOps {
  f32x2 a[4], w[4], b[4], k[4], r[4];
  float v0, v1;
};
DEVI void scan_load(ScanOps& o, const float* OPS, const float* VV, int nn, int jg, int i0) {
  const float* base = OPS + nn * 64 + jg * 8;
  f32x4 t0, t1;
  t0 = *(const f32x4*)(base); t1 = *(const f32x4*)(base + 4);
  o.a[0] = lo2(t0); o.a[1] = hi2(t0); o.a[2] = lo2(t1); o.a[3] = hi2(t1);
  t0 = *(const f32x4*)(base + 2048); t1 = *(const f32x4*)(base + 2048 + 4);
  o.w[0] = lo2(t0); o.w[1] = hi2(t0); o.w[2] = lo2(t1); o.w[3] = hi2(t1);
  t0 = *(const f32x4*)(base + 4096); t1 = *(const f32x4*)(base + 4096 + 4);
  o.b[0] = lo2(t0); o.b[1] = hi2(t0); o.b[2] = lo2(t1); o.b[3] = hi2(t1);
  t0 = *(const f32x4*)(base + 6144); t1 = *(const f32x4*)(base + 6144 + 4);
  o.k[0] = lo2(t0); o.k[1] = hi2(t0); o.k[2] = lo2(t1); o.k[3] = hi2(t1);
  t0 = *(const f32x4*)(base + 8192); t1 = *(const f32x4*)(base + 8192 + 4);
  o.r[0] = lo2(t0); o.r[1] = hi2(t0); o.r[2] = lo2(t1); o.r[3] = hi2(t1);
  o.v0 = VV[nn * 64 + i0];
  o.v1 = VV[nn * 64 + i0 + 8];
}
DEVI void scan_step(const ScanOps& o, f32x2 (&S0)[4], f32x2 (&S1)[4], float* YL, int nn, int jg, int i0) {
  f32x2 d0 = S0[0] * o.a[0], d0b = S0[2] * o.a[2];
  f32x2 d1 = S1[0] * o.a[0], d1b = S1[2] * o.a[2];
  d0 = S0[1] * o.a[1] + d0; d0b = S0[3] * o.a[3] + d0b;
  d1 = S1[1] * o.a[1] + d1; d1b = S1[3] * o.a[3] + d1b;
  d0 += d0b; d1 += d1b;
  const float sa0 = red8(d0.x + d0.y);
  const float sa1 = red8(d1.x + d1.y);
  f32x2 e0 = {0.f, 0.f}, e1 = {0.f, 0.f};
#pragma unroll
  for (int q = 0; q < 4; ++q) {
    const f32x2 u0 = sa0 * o.b[q] + o.v0 * o.k[q];
    const f32x2 u1 = sa1 * o.b[q] + o.v1 * o.k[q];
    S0[q] = S0[q] * o.w[q] + u0;
    S1[q] = S1[q] * o.w[q] + u1;
    e0 = S0[q] * o.r[q] + e0;
    e1 = S1[q] * o.r[q] + e1;
  }
  const float y0 = red8(e0.x + e0.y);
  const float y1 = red8(e1.x + e1.y);
  YL[nn * 64 + i0] = y0; YL[nn * 64 + i0 + 8] = y1;
}

DEVI void phase_scan(int tid_, const Params& p, int l, char* smem, int bfirst, int bstride) {
  const u16* PR = (const u16*)(p.ws + OFF_PR);
  _Float16* YF = (_Float16*)(p.ws + OFF_H);
  _Float16* YB = (_Float16*)(p.ws + OFF_H + (size_t)NTOK * 512 * 2);
  float* BON = (float*)(p.ws + OFF_BONUS);
  const u16* WB = (const u16*)(p.ws + OFF_WB);
  float* OPS = (float*)(smem + SC_OPS);
  u16* RAW = (u16*)(smem + SC_OPS);
  float* VV = (float*)(smem + SC_VV);
  float* WR = (float*)(smem + SC_WR);
  float* AP = (float*)(smem + SC_AP);
  float* YL = WR;
  u16* TWb = (u16*)(smem + SC_TW);
  u16* ADb = (u16*)(smem + SC_AD);
  float* NRM = (float*)(smem + SC_NRM);
  float* MU = (float*)(smem + SC_MU);
  float* CST = (float*)(smem + SC_CST);
  const float* mu_p = p.in[I_MU_PREV] + (size_t)l * 1920;
  const float* mu_n = p.in[I_MU_NEXT] + (size_t)l * 1920;
  const int tid = tid_, lane = tid & 63, w = tid >> 6, fr = lane & 15, fq = lane >> 4;
  const int pn = tid >> 3, j0 = (tid & 7) * 8;
  const int jg = lane & 7, i0 = w * 16 + (lane >> 3);
  const int hr = (tid >= 40) ? 1 : 0, hc = tid - hr * 40;
  for (int blk = bfirst; blk < 192; blk += bstride) {
    const int s = blk >> 4, h = (blk >> 1) & 7, d = blk & 1;
    __syncthreads();
    for (int i = tid; i < 640; i += 256) {
      const int which = (i >= 320) ? 1 : 0, c = i - which * 320;
      const int g = c >> 6, e = c & 63;
      const int col = (g < 3) ? (g * 512 + h * 64 + e) : (1536 + (g - 3) * 128 + d * 64 + e);
      MU[i] = which ? mu_n[col] : mu_p[col];
    }
    for (int i = tid; i < 320; i += 256) {
      const int which = i >> 6, e = i & 63;
      float v;
      if (which == 0) v = p.in[I_W0][(size_t)(l * 2 + d) * 512 + h * 64 + e];
      else if (which == 1) v = p.in[I_A0][(size_t)(l * 2 + d) * 512 + h * 64 + e];
      else if (which == 2) v = p.in[I_K_K][(size_t)l * 512 + h * 64 + e];
      else if (which == 3) v = p.in[I_K_A][(size_t)l * 512 + h * 64 + e];
      else v = p.in[I_R_K][(size_t)(l * 8 + h) * 64 + e];
      CST[i] = v;
    }
    bf16x8 bw[2], ba[2];
#pragma unroll
    for (int ks = 0; ks < 2; ++ks) {
      bw[ks] = *(const bf16x8*)(WB + W_WUP + (size_t)(d * 512 + h * 64 + w * 16 + fr) * 64 + ks * 32 + fq * 8);
      ba[ks] = *(const bf16x8*)(WB + W_AUP + (size_t)(d * 512 + h * 64 + w * 16 + fr) * 64 + ks * 32 + fq * 8);
    }
    _Float16* Y = d ? YB : YF;
    f32x2 S0[4], S1[4];
#pragma unroll
    for (int q = 0; q < 4; ++q) { S0[q] = (f32x2){0.f, 0.f}; S1[q] = (f32x2){0.f, 0.f}; }
    u32x4 G[5], GH;
    {
      const int t = d ? (4095 - pn) : pn;
      const size_t tok = (size_t)s * 4096 + t;
#pragma unroll
      for (int g = 0; g < 5; ++g) {
        const int col = (g < 3) ? (g * 512 + h * 64) : (1536 + (g - 3) * 128 + d * 64);
        G[g] = *(const u32x4*)(PR + tok * PRW + col + j0);
      }
      GH = (u32x4){0u, 0u, 0u, 0u};
      if (tid < 80) {
        const int tlo = d ? (4095 - 31) : 0;
        const int th = hr ? (tlo + 32) : (tlo - 1);
        const int g = hc >> 3;
        const int col = (g < 3) ? (g * 512 + h * 64) : (1536 + (g - 3) * 128 + d * 64);
        if (th >= 0 && th <= 4095) GH = *(const u32x4*)(PR + ((size_t)s * 4096 + th) * PRW + col + (hc & 7) * 8);
      }
    }
#pragma unroll 1
    for (int ch = 0; ch < 128; ++ch) {
      const int n = ch * 32 + pn;
      const int t = d ? (4095 - n) : n;
      const size_t tok = (size_t)s * 4096 + t;
      const int tlo = d ? (4095 - (ch * 32 + 31)) : (ch * 32);
      const int rrow = t - tlo + 1;
#pragma unroll
      for (int g = 0; g < 5; ++g) *(u32x4*)(RAW + rrow * 320 + g * 64 + j0) = G[g];
      if (tid < 80) *(u32x4*)(RAW + (hr ? 33 : 0) * 320 + (hc >> 3) * 64 + (hc & 7) * 8) = GH;
      __syncthreads();
      if (ch + 1 < 128) {
        const int n2 = n + 32;
        const int t2 = d ? (4095 - n2) : n2;
        const size_t tok2 = (size_t)s * 4096 + t2;
#pragma unroll
        for (int g = 0; g < 5; ++g) {
          const int col = (g < 3) ? (g * 512 + h * 64) : (1536 + (g - 3) * 128 + d * 64);
          G[g] = *(const u32x4*)(PR + tok2 * PRW + col + j0);
        }
        GH = (u32x4){0u, 0u, 0u, 0u};
        if (tid < 80) {
          const int tlo2 = d ? (tlo - 32) : (tlo + 32);
          const int th = hr ? (tlo2 + 32) : (tlo2 - 1);
          const int g = hc >> 3;
          const int col = (g < 3) ? (g * 512 + h * 64) : (1536 + (g - 3) * 128 + d * 64);
          if (th >= 0 && th <= 4095) GH = *(const u32x4*)(PR + ((size_t)s * 4096 + th) * PRW + col + (hc & 7) * 8);
        }
      }
#pragma unroll
      for (int g = 0; g < 5; ++g) {
        float cur[8], prv[8], nxt[8];
        load8bf(RAW + rrow * 320 + g * 64 + j0, cur);
        load8bf(RAW + (rrow - 1) * 320 + g * 64 + j0, prv);
        load8bf(RAW + (rrow + 1) * 320 + g * 64 + j0, nxt);
        const f32x4 mp0 = *(const f32x4*)(MU + g * 64 + j0), mp1 = *(const f32x4*)(MU + g * 64 + j0 + 4);
        const f32x4 mn0 = *(const f32x4*)(MU + 320 + g * 64 + j0), mn1 = *(const f32x4*)(MU + 320 + g * 64 + j0 + 4);
        f32x4 x0, x1;
#pragma unroll
        for (int e = 0; e < 4; ++e) {
          x0[e] = cur[e] + mp0[e] * (prv[e] - cur[e]) + mn0[e] * (nxt[e] - cur[e]);
          x1[e] = cur[4 + e] + mp1[e] * (prv[4 + e] - cur[4 + e]) + mn1[e] * (nxt[4 + e] - cur[4 + e]);
        }
        if (g == 0) {
          *(f32x4*)(OPS + 4 * 2048 + pn * 64 + j0) = x0; *(f32x4*)(OPS + 4 * 2048 + pn * 64 + j0 + 4) = x1;
        } else if (g == 1) {
          *(f32x4*)(OPS + 3 * 2048 + pn * 64 + j0) = x0; *(f32x4*)(OPS + 3 * 2048 + pn * 64 + j0 + 4) = x1;
          const f32x4 kk0 = *(const f32x4*)(CST + 128 + j0), kk1 = *(const f32x4*)(CST + 128 + j0 + 4);
          float ss = 0.f;
#pragma unroll
          for (int e = 0; e < 4; ++e) { const float a_ = x0[e] * kk0[e], b_ = x1[e] * kk1[e]; ss += a_ * a_ + b_ * b_; }
          ss = red8(ss);
          if ((tid & 7) == 0) NRM[pn] = frcp(fmaxf(__builtin_amdgcn_sqrtf(ss), 1e-12f));
        } else if (g == 2) {
          *(f32x4*)(VV + pn * 64 + j0) = x0; *(f32x4*)(VV + pn * 64 + j0 + 4) = x1;
        } else if (g == 3) {
          u32x4 pk;
          pk.x = pack2(ftanh(x0[0]), ftanh(x0[1])); pk.y = pack2(ftanh(x0[2]), ftanh(x0[3]));
          pk.z = pack2(ftanh(x1[0]), ftanh(x1[1])); pk.w = pack2(ftanh(x1[2]), ftanh(x1[3]));
          *(u32x4*)(TWb + pn * 72 + j0) = pk;
        } else {
          u32x4 pk;
          pk.x = pack2(x0[0], x0[1]); pk.y = pack2(x0[2], x0[3]);
          pk.z = pack2(x1[0], x1[1]); pk.w = pack2(x1[2], x1[3]);
          *(u32x4*)(ADb + pn * 72 + j0) = pk;
        }
      }
      __syncthreads();
#pragma unroll
      for (int m = 0; m < 2; ++m) {
        f32x4 cw = {0.f, 0.f, 0.f, 0.f}, ca = {0.f, 0.f, 0.f, 0.f};
#pragma unroll
        for (int ks = 0; ks < 2; ++ks) {
          const bf16x8 aw = *(const bf16x8*)(TWb + (m * 16 + fr) * 72 + ks * 32 + fq * 8);
          const bf16x8 aa = *(const bf16x8*)(ADb + (m * 16 + fr) * 72 + ks * 32 + fq * 8);
          cw = __builtin_amdgcn_mfma_f32_16x16x32_bf16(aw, bw[ks], cw, 0, 0, 0);
          ca = __builtin_amdgcn_mfma_f32_16x16x32_bf16(aa, ba[ks], ca, 0, 0, 0);
        }
#pragma unroll
        for (int jj = 0; jj < 4; ++jj) {
          WR[(m * 16 + fq * 4 + jj) * 64 + w * 16 + fr] = cw[jj];
          AP[(m * 16 + fq * 4 + jj) * 64 + w * 16 + fr] = ca[jj];
        }
      }
      __syncthreads();
      {
        const float inv = NRM[pn];
        float bsum = 0.f;
#pragma unroll
        for (int hq = 0; hq < 2; ++hq) {
          const int jb = j0 + hq * 4;
          const f32x4 wr_ = *(const f32x4*)(WR + pn * 64 + jb) + *(const f32x4*)(CST + jb);
          const f32x4 ap_ = *(const f32x4*)(AP + pn * 64 + jb) + *(const f32x4*)(CST + 64 + jb);
          const f32x4 kr = *(const f32x4*)(OPS + 3 * 2048 + pn * 64 + jb);
          const f32x4 rr = *(const f32x4*)(OPS + 4 * 2048 + pn * 64 + jb);
          const f32x4 kkw = *(const f32x4*)(CST + 128 + jb), kaw = *(const f32x4*)(CST + 192 + jb), rkw = *(const f32x4*)(CST + 256 + jb);
          f32x4 o0, o1, o2, o3;
#pragma unroll
          for (int e = 0; e < 4; ++e) {
            const float sw = sigm(wr_[e]);
            const float dec = __expf(-0.6065306597126334f * sw);
            const float av = sigm(ap_[e]);
            const float kn = kr[e] * kkw[e] * inv;
            const float kd = kr[e] * (1.f + (av - 1.f) * kaw[e]);
            bsum += rr[e] * kd * rkw[e];
            o0[e] = -kn; o1[e] = dec; o2[e] = kn * av; o3[e] = kd;
          }
          *(f32x4*)(OPS + 0 * 2048 + pn * 64 + jb) = o0;
          *(f32x4*)(OPS + 1 * 2048 + pn * 64 + jb) = o1;
          *(f32x4*)(OPS + 2 * 2048 + pn * 64 + jb) = o2;
          *(f32x4*)(OPS + 3 * 2048 + pn * 64 + jb) = o3;
        }
        bsum = red8(bsum);
        if ((tid & 7) == 0) BON[(tok * 8 + h) * 2 + d] = bsum;
      }
      __syncthreads();
      {
        ScanOps oa, ob;
        scan_load(oa, OPS, VV, 0, jg, i0);
#pragma unroll 1
        for (int nn = 0; nn < 32; nn += 2) {
          scan_load(ob, OPS, VV, nn + 1, jg, i0);
          scan_step(oa, S0, S1, YL, nn, jg, i0);
          scan_load(oa, OPS, VV, (nn + 2) & 31, jg, i0);
          scan_step(ob, S0, S1, YL, nn + 1, jg, i0);
        }
      }
      __syncthreads();
      {
        h16x8 o;
#pragma unroll
        for (int e = 0; e < 8; ++e) o[e] = (_Float16)YL[pn * 64 + j0 + e];
        *(h16x8*)(Y + tok * 512 + h * 64 + j0) = o;
      }
    }
    __syncthreads();
  }
}

struct ScanOps1 {
  f32x2 a[4], w[4], b[4], k[4], r[4];
  float v0;
};
DEVI void scan_load1(ScanOps1& o, const float* OPS, const float* VV, int nn, int jg, int i0) {
  const float* base = OPS + nn * 64 + jg * 8;
  f32x4 t0, t1;
  t0 = *(const f32x4*)(base); t1 = *(const f32x4*)(base + 4);
  o.a[0] = lo2(t0); o.a[1] = hi2(t0); o.a[2] = lo2(t1); o.a[3] = hi2(t1);
  t0 = *(const f32x4*)(base + 2048); t1 = *(const f32x4*)(base + 2048 + 4);
  o.w[0] = lo2(t0); o.w[1] = hi2(t0); o.w[2] = lo2(t1); o.w[3] = hi2(t1);
  t0 = *(const f32x4*)(base + 4096); t1 = *(const f32x4*)(base + 4096 + 4);
  o.b[0] = lo2(t0); o.b[1] = hi2(t0); o.b[2] = lo2(t1); o.b[3] = hi2(t1);
  t0 = *(const f32x4*)(base + 6144); t1 = *(const f32x4*)(base + 6144 + 4);
  o.k[0] = lo2(t0); o.k[1] = hi2(t0); o.k[2] = lo2(t1); o.k[3] = hi2(t1);
  t0 = *(const f32x4*)(base + 8192); t1 = *(const f32x4*)(base + 8192 + 4);
  o.r[0] = lo2(t0); o.r[1] = hi2(t0); o.r[2] = lo2(t1); o.r[3] = hi2(t1);
  o.v0 = VV[nn * 64 + i0];
}
DEVI void scan_step1(const ScanOps1& o, f32x2 (&S0)[4], float* YL, int nn, int jg, int i0) {
  f32x2 d0 = S0[0] * o.a[0], d0b = S0[2] * o.a[2];
  d0 = S0[1] * o.a[1] + d0; d0b = S0[3] * o.a[3] + d0b;
  d0 += d0b;
  const float sa0 = red8(d0.x + d0.y);
  f32x2 e0 = {0.f, 0.f};
#pragma unroll
  for (int q = 0; q < 4; ++q) {
    const f32x2 u0 = sa0 * o.b[q] + o.v0 * o.k[q];
    S0[q] = S0[q] * o.w[q] + u0;
    e0 = S0[q] * o.r[q] + e0;
  }
  const float y0 = red8(e0.x + e0.y);
  if (jg == 0) YL[nn * 64 + i0] = y0;
}
DEVI float red16d(float x) {
  x += dpp_mov<0xB1>(x);
  x += dpp_mov<0x4E>(x);
  x += dpp_mov<0x141>(x);
  x += dpp_mov<0x140>(x);
  return x;
}
DEVI void unpack4(u32x2 u, float* o) {
  o[0] = __uint_as_float(u.x << 16); o[1] = __uint_as_float(u.x & 0xffff0000u);
  o[2] = __uint_as_float(u.y << 16); o[3] = __uint_as_float(u.y & 0xffff0000u);
}

DEVI void phase_scan8(int tid_, const Params& p, int l, char* smem, int bfirst, int bstride) {
  const u16* PR = (const u16*)(p.ws + OFF_PR);
  _Float16* YF = (_Float16*)(p.ws + OFF_H);
  _Float16* YB = (_Float16*)(p.ws + OFF_H + (size_t)NTOK * 512 * 2);
  float* BON = (float*)(p.ws + OFF_BONUS);
  const u16* WB = (const u16*)(p.ws + OFF_WB);
  float* OPS = (float*)(smem + SC_OPS);
  u16* RAW = (u16*)(smem + SC_OPS);
  float* VV = (float*)(smem + SC_VV);
  float* WR = (float*)(smem + SC_WR);
  float* AP = (float*)(smem + SC_AP);
  float* YL = WR;
  u16* TWb = (u16*)(smem + SC_TW);
  u16* ADb = (u16*)(smem + SC_AD);
  float* NRM = (float*)(smem + SC_NRM);
  float* MU = (float*)(smem + SC_MU);
  float* CST = (float*)(smem + SC_CST);
  const float* mu_p = p.in[I_MU_PREV] + (size_t)l * 1920;
  const float* mu_n = p.in[I_MU_NEXT] + (size_t)l * 1920;
  const int tid = tid_, lane = tid & 63, w = tid >> 6, fr = lane & 15, fq = lane >> 4;
  const int pn = tid >> 4, j0 = (tid & 15) * 4;
  const int jg = lane & 7, i0 = w * 8 + (lane >> 3);
  const int hr = (tid >= 80) ? 1 : 0, hc = tid - hr * 80;
  const int wm = w >> 2, wn = w & 3;
  for (int blk = bfirst; blk < 192; blk += bstride) {
    const int s = blk >> 4, h = (blk >> 1) & 7, d = blk & 1;
    __syncthreads();
    for (int i = tid; i < 640; i += 512) {
      const int which = (i >= 320) ? 1 : 0, c = i - which * 320;
      const int g = c >> 6, e = c & 63;
      const int col = (g < 3) ? (g * 512 + h * 64 + e) : (1536 + (g - 3) * 128 + d * 64 + e);
      MU[i] = which ? mu_n[col] : mu_p[col];
    }
    if (tid < 320) {
      const int which = tid >> 6, e = tid & 63;
      float v;
      if (which == 0) v = p.in[I_W0][(size_t)(l * 2 + d) * 512 + h * 64 + e];
      else if (which == 1) v = p.in[I_A0][(size_t)(l * 2 + d) * 512 + h * 64 + e];
      else if (which == 2) v = p.in[I_K_K][(size_t)l * 512 + h * 64 + e];
      else if (which == 3) v = p.in[I_K_A][(size_t)l * 512 + h * 64 + e];
      else v = p.in[I_R_K][(size_t)(l * 8 + h) * 64 + e];
      CST[tid] = v;
    }
    bf16x8 bw[2], ba[2];
#pragma unroll
    for (int ks = 0; ks < 2; ++ks) {
      bw[ks] = *(const bf16x8*)(WB + W_WUP + (size_t)(d * 512 + h * 64 + wn * 16 + fr) * 64 + ks * 32 + fq * 8);
      ba[ks] = *(const bf16x8*)(WB + W_AUP + (size_t)(d * 512 + h * 64 + wn * 16 + fr) * 64 + ks * 32 + fq * 8);
    }
    _Float16* Y = d ? YB : YF;
    f32x2 S0[4];
#pragma unroll
    for (int q = 0; q < 4; ++q) S0[q] = (f32x2){0.f, 0.f};
    u32x2 G[5], GH;
    {
      const int t = d ? (4095 - pn) : pn;
      const size_t tok = (size_t)s * 4096 + t;
#pragma unroll
      for (int g = 0; g < 5; ++g) {
        const int col = (g < 3) ? (g * 512 + h * 64) : (1536 + (g - 3) * 128 + d * 64);
        G[g] = *(const u32x2*)(PR + tok * PRW + col + j0);
      }
      GH = (u32x2){0u, 0u};
      if (tid < 160) {
        const int tlo = d ? (4095 - 31) : 0;
        const int th = hr ? (tlo + 32) : (tlo - 1);
        const int g = hc >> 4;
        const int col = (g < 3) ? (g * 512 + h * 64) : (1536 + (g - 3) * 128 + d * 64);
        if (th >= 0 && th <= 4095) GH = *(const u32x2*)(PR + ((size_t)s * 4096 + th) * PRW + col + (hc & 15) * 4);
      }
    }
#pragma unroll 1
    for (int ch = 0; ch < 128; ++ch) {
      const int n = ch * 32 + pn;
      const int t = d ? (4095 - n) : n;
      const size_t tok = (size_t)s * 4096 + t;
      const int tlo = d ? (4095 - (ch * 32 + 31)) : (ch * 32);
      const int rrow = t - tlo + 1;
#pragma unroll
      for (int g = 0; g < 5; ++g) *(u32x2*)(RAW + rrow * 320 + g * 64 + j0) = G[g];
      if (tid < 160) *(u32x2*)(RAW + (hr ? 33 : 0) * 320 + (hc >> 4) * 64 + (hc & 15) * 4) = GH;
      __syncthreads();
      if (ch + 1 < 128) {
        const int n2 = n + 32;
        const int t2 = d ? (4095 - n2) : n2;
        const size_t tok2 = (size_t)s * 4096 + t2;
#pragma unroll
        for (int g = 0; g < 5; ++g) {
          const int col = (g < 3) ? (g * 512 + h * 64) : (1536 + (g - 3) * 128 + d * 64);
          G[g] = *(const u32x2*)(PR + tok2 * PRW + col + j0);
        }
        GH = (u32x2){0u, 0u};
        if (tid < 160) {
          const int tlo2 = d ? (tlo - 32) : (tlo + 32);
          const int th = hr ? (tlo2 + 32) : (tlo2 - 1);
          const int g = hc >> 4;
          const int col = (g < 3) ? (g * 512 + h * 64) : (1536 + (g - 3) * 128 + d * 64);
          if (th >= 0 && th <= 4095) GH = *(const u32x2*)(PR + ((size_t)s * 4096 + th) * PRW + col + (hc & 15) * 4);
        }
      }
#pragma unroll
      for (int g = 0; g < 5; ++g) {
        float cur[4], prv[4], nxt[4];
        unpack4(*(const u32x2*)(RAW + rrow * 320 + g * 64 + j0), cur);
        unpack4(*(const u32x2*)(RAW + (rrow - 1) * 320 + g * 64 + j0), prv);
        unpack4(*(const u32x2*)(RAW + (rrow + 1) * 320 + g * 64 + j0), nxt);
        const f32x4 mp0 = *(const f32x4*)(MU + g * 64 + j0);
        const f32x4 mn0 = *(const f32x4*)(MU + 320 + g * 64 + j0);
        f32x4 x0;
#pragma unroll
        for (int e = 0; e < 4; ++e) x0[e] = cur[e] + mp0[e] * (prv[e] - cur[e]) + mn0[e] * (nxt[e] - cur[e]);
        if (g == 0) {
          *(f32x4*)(OPS + 4 * 2048 + pn * 64 + j0) = x0;
        } else if (g == 1) {
          *(f32x4*)(OPS + 3 * 2048 + pn * 64 + j0) = x0;
          const f32x4 kk0 = *(const f32x4*)(CST + 128 + j0);
          float ss = 0.f;
#pragma unroll
          for (int e = 0; e < 4; ++e) { const float a_ = x0[e] * kk0[e]; ss += a_ * a_; }
          ss = red16d(ss);
          if ((tid & 15) == 0) NRM[pn] = frcp(fmaxf(__builtin_amdgcn_sqrtf(ss), 1e-12f));
        } else if (g == 2) {
          *(f32x4*)(VV + pn * 64 + j0) = x0;
        } else if (g == 3) {
          u32x2 pk;
          pk.x = pack2(ftanh(x0[0]), ftanh(x0[1])); pk.y = pack2(ftanh(x0[2]), ftanh(x0[3]));
          *(u32x2*)(TWb + pn * 72 + j0) = pk;
        } else {
          u32x2 pk;
          pk.x = pack2(x0[0], x0[1]); pk.y = pack2(x0[2], x0[3]);
          *(u32x2*)(ADb + pn * 72 + j0) = pk;
        }
      }
      __syncthreads();
      {
        f32x4 cw = {0.f, 0.f, 0.f, 0.f}, ca = {0.f, 0.f, 0.f, 0.f};
#pragma unroll
        for (int ks = 0; ks < 2; ++ks) {
          const bf16x8 aw = *(const bf16x8*)(TWb + (wm * 16 + fr) * 72 + ks * 32 + fq * 8);
          const bf16x8 aa = *(const bf16x8*)(ADb + (wm * 16 + fr) * 72 + ks * 32 + fq * 8);
          cw = __builtin_amdgcn_mfma_f32_16x16x32_bf16(aw, bw[ks], cw, 0, 0, 0);
          ca = __builtin_amdgcn_mfma_f32_16x16x32_bf16(aa, ba[ks], ca, 0, 0, 0);
        }
#pragma unroll
        for (int jj = 0; jj < 4; ++jj) {
          WR[(wm * 16 + fq * 4 + jj) * 64 + wn * 16 + fr] = cw[jj];
          AP[(wm * 16 + fq * 4 + jj) * 64 + wn * 16 + fr] = ca[jj];
        }
      }
      __syncthreads();
      {
        const float inv = NRM[pn];
        float bsum = 0.f;
        const f32x4 wr_ = *(const f32x4*)(WR + pn * 64 + j0) + *(const f32x4*)(CST + j0);
        const f32x4 ap_ = *(const f32x4*)(AP + pn * 64 + j0) + *(const f32x4*)(CST + 64 + j0);
        const f32x4 kr = *(const f32x4*)(OPS + 3 * 2048 + pn * 64 + j0);
        const f32x4 rr = *(const f32x4*)(OPS + 4 * 2048 + pn * 64 + j0);
        const f32x4 kkw = *(const f32x4*)(CST + 128 + j0), kaw = *(const f32x4*)(CST + 192 + j0), rkw = *(const f32x4*)(CST + 256 + j0);
        f32x4 o0, o1, o2, o3;
#pragma unroll
        for (int e = 0; e < 4; ++e) {
          const float sw = sigm(wr_[e]);
          const float dec = __expf(-0.6065306597126334f * sw);
          const float av = sigm(ap_[e]);
          const float kn = kr[e] * kkw[e] * inv;
          const float kd = kr[e] * (1.f + (av - 1.f) * kaw[e]);
          bsum += rr[e] * kd * rkw[e];
          o0[e] = -kn; o1[e] = dec; o2[e] = kn * av; o3[e] = kd;
        }
        *(f32x4*)(OPS + 0 * 2048 + pn * 64 + j0) = o0;
        *(f32x4*)(OPS + 1 * 2048 + pn * 64 + j0) = o1;
        *(f32x4*)(OPS + 2 * 2048 + pn * 64 + j0) = o2;
        *(f32x4*)(OPS + 3 * 2048 + pn * 64 + j0) = o3;
        bsum = red16d(bsum);
        if ((tid & 15) == 0) BON[(tok * 8 + h) * 2 + d] = bsum;
      }
      __syncthreads();
      {
        ScanOps1 oa, ob;
        scan_load1(oa, OPS, VV, 0, jg, i0);
#pragma unroll 1
        for (int nn = 0; nn < 32; nn += 2) {
          scan_load1(ob, OPS, VV, nn + 1, jg, i0);
          scan_step1(oa, S0, YL, nn, jg, i0);
          scan_load1(oa, OPS, VV, (nn + 2) & 31, jg, i0);
          scan_step1(ob, S0, YL, nn + 1, jg, i0);
        }
      }
      __syncthreads();
      {
        typedef __attribute__((ext_vector_type(4))) _Float16 h16x4;
        h16x4 o;
#pragma unroll
        for (int e = 0; e < 4; ++e) o[e] = (_Float16)YL[pn * 64 + j0 + e];
        *(h16x4*)(Y + tok * 512 + h * 64 + j0) = o;
      }
    }
    __syncthreads();
  }
}

constexpr int PC_OPS = 0;
constexpr int PC_BUF = 49152;
constexpr int PC_RAW = 98304;
constexpr int PC_WR = 98304;
constexpr int PC_AP = 106496;
constexpr int PC_TW = 120064;
constexpr int PC_AD = 124672;
constexpr int PC_NRM = 129280;
constexpr int PC_MU = 129408;
constexpr int PC_CST = 131968;
constexpr int PC_YL = 133248;

DEVI void phase_scan_pc(int tid_, const Params& p, int l, char* smem, int bfirst, int bstride) {
  const u16* PR = (const u16*)(p.ws + OFF_PR);
  _Float16* YF = (_Float16*)(p.ws + OFF_H);
  _Float16* YB = (_Float16*)(p.ws + OFF_H + (size_t)NTOK * 512 * 2);
  float* BON = (float*)(p.ws + OFF_BONUS);
  const u16* WB = (const u16*)(p.ws + OFF_WB);
  u16* RAW = (u16*)(smem + PC_RAW);
  float* WR = (float*)(smem + PC_WR);
  float* AP = (float*)(smem + PC_AP);
  u16* TWb = (u16*)(smem + PC_TW);
  u16* ADb = (u16*)(smem + PC_AD);
  float* NRM = (float*)(smem + PC_NRM);
  float* MU = (float*)(smem + PC_MU);
  float* CST = (float*)(smem + PC_CST);
  const float* mu_p = p.in[I_MU_PREV] + (size_t)l * 1920;
  const float* mu_n = p.in[I_MU_NEXT] + (size_t)l * 1920;
  const bool is_prep = tid_ >= 256;
  const int tid = tid_ & 255, lane = tid & 63, w = tid >> 6, fr = lane & 15, fq = lane >> 4;
  const int pn = tid >> 3, j0 = (tid & 7) * 8;
  const int jg = lane & 7, i0 = w * 16 + (lane >> 3);
  const int hr = (tid >= 40) ? 1 : 0, hc = tid - hr * 40;
  for (int blk = bfirst; blk < 192; blk += bstride) {
    const int s = blk >> 4, h = (blk >> 1) & 7, d = blk & 1;
    __syncthreads();
    for (int i = tid_; i < 640; i += 512) {
      const int which = (i >= 320) ? 1 : 0, c = i - which * 320;
      const int g = c >> 6, e = c & 63;
      const int col = (g < 3) ? (g * 512 + h * 64 + e) : (1536 + (g - 3) * 128 + d * 64 + e);
      MU[i] = which ? mu_n[col] : mu_p[col];
    }
    if (tid_ < 320) {
      const int which = tid_ >> 6, e = tid_ & 63;
      float v;
      if (which == 0) v = p.in[I_W0][(size_t)(l * 2 + d) * 512 + h * 64 + e];
      else if (which == 1) v = p.in[I_A0][(size_t)(l * 2 + d) * 512 + h * 64 + e];
      else if (which == 2) v = p.in[I_K_K][(size_t)l * 512 + h * 64 + e];
      else if (which == 3) v = p.in[I_K_A][(size_t)l * 512 + h * 64 + e];
      else v = p.in[I_R_K][(size_t)(l * 8 + h) * 64 + e];
      CST[tid_] = v;
    }
    _Float16* Y = d ? YB : YF;
    if (is_prep) {
      bf16x8 bw[2], ba[2];
#pragma unroll
      for (int ks = 0; ks < 2; ++ks) {
        bw[ks] = *(const bf16x8*)(WB + W_WUP + (size_t)(d * 512 + h * 64 + w * 16 + fr) * 64 + ks * 32 + fq * 8);
        ba[ks] = *(const bf16x8*)(WB + W_AUP + (size_t)(d * 512 + h * 64 + w * 16 + fr) * 64 + ks * 32 + fq * 8);
      }
      u32x4 G[5], GH;
      {
        const int t = d ? (4095 - pn) : pn;
        const size_t tok = (size_t)s * 4096 + t;
#pragma unroll
        for (int g = 0; g < 5; ++g) {
          const int col = (g < 3) ? (g * 512 + h * 64) : (1536 + (g - 3) * 128 + d * 64);
          G[g] = *(const u32x4*)(PR + tok * PRW + col + j0);
        }
        GH = (u32x4){0u, 0u, 0u, 0u};
        if (tid < 80) {
          const int tlo = d ? (4095 - 31) : 0;
          const int th = hr ? (tlo + 32) : (tlo - 1);
          const int g = hc >> 3;
          const int col = (g < 3) ? (g * 512 + h * 64) : (1536 + (g - 3) * 128 + d * 64);
          if (th >= 0 && th <= 4095) GH = *(const u32x4*)(PR + ((size_t)s * 4096 + th) * PRW + col + (hc & 7) * 8);
        }
      }
#pragma unroll 1
      for (int ch = -1; ch < 128; ++ch) {
        const int c = ch + 1;
        const bool doprep = c < 128;
        float* OPS = (float*)(smem + PC_OPS + (c & 1) * PC_BUF);
        float* VV = OPS + 5 * 2048;
        const int n = c * 32 + pn;
        const int t = d ? (4095 - n) : n;
        const size_t tok = (size_t)s * 4096 + t;
        const int tlo = d ? (4095 - (c * 32 + 31)) : (c * 32);
        const int rrow = t - tlo + 1;
        __syncthreads();
        if (ch >= 1) {
          const float* YL = (const float*)(smem + PC_YL + ((ch - 1) & 1) * 8192);
          const int n1 = (ch - 1) * 32 + pn;
          const int t1 = d ? (4095 - n1) : n1;
          h16x8 o;
#pragma unroll
          for (int e = 0; e < 8; ++e) o[e] = (_Float16)YL[pn * 64 + j0 + e];
          *(h16x8*)(Y + ((size_t)s * 4096 + t1) * 512 + h * 64 + j0) = o;
        }
        if (doprep) {
#pragma unroll
          for (int g = 0; g < 5; ++g) *(u32x4*)(RAW + rrow * 320 + g * 64 + j0) = G[g];
          if (tid < 80) *(u32x4*)(RAW + (hr ? 33 : 0) * 320 + (hc >> 3) * 64 + (hc & 7) * 8) = GH;
        }
        __syncthreads();
        if (doprep) {
          if (c + 1 < 128) {
            const int n2 = n + 32;
            const int t2 = d ? (4095 - n2) : n2;
            const size_t tok2 = (size_t)s * 4096 + t2;
#pragma unroll
            for (int g = 0; g < 5; ++g) {
              const int col = (g < 3) ? (g * 512 + h * 64) : (1536 + (g - 3) * 128 + d * 64);
              G[g] = *(const u32x4*)(PR + tok2 * PRW + col + j0);
            }
            GH = (u32x4){0u, 0u, 0u, 0u};
            if (tid < 80) {
              const int tlo2 = d ? (tlo - 32) : (tlo + 32);
              const int th = hr ? (tlo2 + 32) : (tlo2 - 1);
              const int g = hc >> 3;
              const int col = (g < 3) ? (g * 512 + h * 64) : (1536 + (g - 3) * 128 + d * 64);
              if (th >= 0 && th <= 4095) GH = *(const u32x4*)(PR + ((size_t)s * 4096 + th) * PRW + col + (hc & 7) * 8);
            }
          }
#pragma unroll
          for (int g = 0; g < 5; ++g) {
            float cur[8], prv[8], nxt[8];
            load8bf(RAW + rrow * 320 + g * 64 + j0, cur);
            load8bf(RAW + (rrow - 1) * 320 + g * 64 + j0, prv);
            load8bf(RAW + (rrow + 1) * 320 + g * 64 + j0, nxt);
            const f32x4 mp0 = *(const f32x4*)(MU + g * 64 + j0), mp1 = *(const f32x4*)(MU + g * 64 + j0 + 4);
            const f32x4 mn0 = *(const f32x4*)(MU + 320 + g * 64 + j0), mn1 = *(const f32x4*)(MU + 320 + g * 64 + j0 + 4);
            f32x4 x0, x1;
#pragma unroll
            for (int e = 0; e < 4; ++e) {
              x0[e] = cur[e] + mp0[e] * (prv[e] - cur[e]) + mn0[e] * (nxt[e] - cur[e]);
              x1[e] = cur[4 + e] + mp1[e] * (prv[4 + e] - cur[4 + e]) + mn1[e] * (nxt[4 + e] - cur[4 + e]);
            }
            if (g == 0) {
              *(f32x4*)(OPS + 4 * 2048 + pn * 64 + j0) = x0; *(f32x4*)(OPS + 4 * 2048 + pn * 64 + j0 + 4) = x1;
            } else if (g == 1) {
              *(f32x4*)(OPS + 3 * 2048 + pn * 64 + j0) = x0; *(f32x4*)(OPS + 3 * 2048 + pn * 64 + j0 + 4) = x1;
              const f32x4 kk0 = *(const f32x4*)(CST + 128 + j0), kk1 = *(const f32x4*)(CST + 128 + j0 + 4);
              float ss = 0.f;
#pragma unroll
              for (int e = 0; e < 4; ++e) { const float a_ = x0[e] * kk0[e], b_ = x1[e] * kk1[e]; ss += a_ * a_ + b_ * b_; }
              ss = red8(ss);
              if ((tid & 7) == 0) NRM[pn] = frcp(fmaxf(__builtin_amdgcn_sqrtf(ss), 1e-12f));
            } else if (g == 2) {
              *(f32x4*)(VV + pn * 64 + j0) = x0; *(f32x4*)(VV + pn * 64 + j0 + 4) = x1;
            } else if (g == 3) {
              u32x4 pk;
              pk.x = pack2(ftanh(x0[0]), ftanh(x0[1])); pk.y = pack2(ftanh(x0[2]), ftanh(x0[3]));
              pk.z = pack2(ftanh(x1[0]), ftanh(x1[1])); pk.w = pack2(ftanh(x1[2]), ftanh(x1[3]));
              *(u32x4*)(TWb + pn * 72 + j0) = pk;
            } else {
              u32x4 pk;
              pk.x = pack2(x0[0], x0[1]); pk.y = pack2(x0[2], x0[3]);
              pk.z = pack2(x1[0], x1[1]); pk.w = pack2(x1[2], x1[3]);
              *(u32x4*)(ADb + pn * 72 + j0) = pk;
            }
          }
        }
        __syncthreads();
        if (doprep) {
#pragma unroll
          for (int m = 0; m < 2; ++m) {
            f32x4 cw = {0.f, 0.f, 0.f, 0.f}, ca = {0.f, 0.f, 0.f, 0.f};
#pragma unroll
            for (int ks = 0; ks < 2; ++ks) {
              const bf16x8 aw = *(const bf16x8*)(TWb + (m * 16 + fr) * 72 + ks * 32 + fq * 8);
              const bf16x8 aa = *(const bf16x8*)(ADb + (m * 16 + fr) * 72 + ks * 32 + fq * 8);
              cw = __builtin_amdgcn_mfma_f32_16x16x32_bf16(aw, bw[ks], cw, 0, 0, 0);
              ca = __builtin_amdgcn_mfma_f32_16x16x32_bf16(aa, ba[ks], ca, 0, 0, 0);
            }
#pragma unroll
            for (int jj = 0; jj < 4; ++jj) {
              WR[(m * 16 + fq * 4 + jj) * 64 + w * 16 + fr] = cw[jj];
              AP[(m * 16 + fq * 4 + jj) * 64 + w * 16 + fr] = ca[jj];
            }
          }
        }
        __syncthreads();
        if (doprep) {
          const float inv = NRM[pn];
          float bsum = 0.f;
#pragma unroll
          for (int hq = 0; hq < 2; ++hq) {
            const int jb = j0 + hq * 4;
            const f32x4 wr_ = *(const f32x4*)(WR + pn * 64 + jb) + *(const f32x4*)(CST + jb);
            const f32x4 ap_ = *(const f32x4*)(AP + pn * 64 + jb) + *(const f32x4*)(CST + 64 + jb);
            const f32x4 kr = *(const f32x4*)(OPS + 3 * 2048 + pn * 64 + jb);
            const f32x4 rr = *(const f32x4*)(OPS + 4 * 2048 + pn * 64 + jb);
            const f32x4 kkw = *(const f32x4*)(CST + 128 + jb), kaw = *(const f32x4*)(CST + 192 + jb), rkw = *(const f32x4*)(CST + 256 + jb);
            f32x4 o0, o1, o2, o3;
#pragma unroll
            for (int e = 0; e < 4; ++e) {
              const float sw = sigm(wr_[e]);
              const float dec = __expf(-0.6065306597126334f * sw);
              const float av = sigm(ap_[e]);
              const float kn = kr[e] * kkw[e] * inv;
              const float kd = kr[e] * (1.f + (av - 1.f) * kaw[e]);
              bsum += rr[e] * kd * rkw[e];
              o0[e] = -kn; o1[e] = dec; o2[e] = kn * av; o3[e] = kd;
            }
            *(f32x4*)(OPS + 0 * 2048 + pn * 64 + jb) = o0;
            *(f32x4*)(OPS + 1 * 2048 + pn * 64 + jb) = o1;
            *(f32x4*)(OPS + 2 * 2048 + pn * 64 + jb) = o2;
            *(f32x4*)(OPS + 3 * 2048 + pn * 64 + jb) = o3;
          }
          bsum = red8(bsum);
          if ((tid & 7) == 0) BON[(tok * 8 + h) * 2 + d] = bsum;
        }
      }
      __syncthreads();
      {
        const float* YL = (const float*)(smem + PC_YL + (127 & 1) * 8192);
        const int n1 = 127 * 32 + pn;
        const int t1 = d ? (4095 - n1) : n1;
        h16x8 o;
#pragma unroll
        for (int e = 0; e < 8; ++e) o[e] = (_Float16)YL[pn * 64 + j0 + e];
        *(h16x8*)(Y + ((size_t)s * 4096 + t1) * 512 + h * 64 + j0) = o;
      }
    } else {
      f32x2 S0[4], S1[4];
#pragma unroll
      for (int q = 0; q < 4; ++q) { S0[q] = (f32x2){0.f, 0.f}; S1[q] = (f32x2){0.f, 0.f}; }
#pragma unroll 1
      for (int ch = -1; ch < 128; ++ch) {
        const float* OPS = (const float*)(smem + PC_OPS + (ch & 1) * PC_BUF);
        const float* VV = OPS + 5 * 2048;
        float* YL = (float*)(smem + PC_YL + (ch & 1) * 8192);
        __syncthreads();
        if (ch < 0) {
          __syncthreads(); __syncthreads(); __syncthreads();
        } else {
          ScanOps oa, ob;
          scan_load(oa, OPS, VV, 0, jg, i0);
#pragma unroll 1
          for (int seg = 0; seg < 4; ++seg) {
            if (seg > 0) __syncthreads();
#pragma unroll 1
            for (int nn = seg * 8; nn < seg * 8 + 8; nn += 2) {
              scan_load(ob, OPS, VV, nn + 1, jg, i0);
              scan_step(oa, S0, S1, YL, nn, jg, i0);
              scan_load(oa, OPS, VV, (nn + 2) & 31, jg, i0);
              scan_step(ob, S0, S1, YL, nn + 1, jg, i0);
            }
          }
        }
      }
      __syncthreads();
    }
    __syncthreads();
  }
}

DEVI void phase_rwkv_post(int tid_, int vb_, int vg_, const Params& p, int l, char* smem) {
  u16* PR = (u16*)(p.ws + OFF_PR);
  const _Float16* YF = (const _Float16*)(p.ws + OFF_H);
  const _Float16* YB = (const _Float16*)(p.ws + OFF_H + (size_t)NTOK * 512 * 2);
  const float* BON = (const float*)(p.ws + OFF_BONUS);
  const u16* GUPT = (const u16*)(p.ws + OFF_WB) + W_GUP;
  const float* mu_p = p.in[I_MU_PREV] + (size_t)l * 1920;
  const float* mu_n = p.in[I_MU_NEXT] + (size_t)l * 1920;
  const float* gng = p.in[I_GN_G] + (size_t)l * 512;
  const float* gnb = p.in[I_GN_B] + (size_t)l * 512;
  u16* As = (u16*)smem;
  const int tid = tid_, lane = tid & 63, w = tid >> 6, fr = lane & 15, fq = lane >> 4;
  for (int tile = vb_; tile < NTOK / 64; tile += vg_) {
    const size_t tok0 = (size_t)tile * 64;
    {
      const int row = tid >> 2, part = tid & 3;
      const size_t tok = tok0 + row;
      const int t = (int)(tok & 4095);
#pragma unroll
      for (int q = 0; q < 4; ++q) {
        const int col = 1792 + part * 32 + q * 8;
        float cur[8], prv[8], nxt[8];
        load8bf(PR + tok * PRW + col, cur);
        if (t > 0) load8bf(PR + (tok - 1) * PRW + col, prv);
        else {
#pragma unroll
          for (int e = 0; e < 8; ++e) prv[e] = 0.f;
        }
        if (t < 4095) load8bf(PR + (tok + 1) * PRW + col, nxt);
        else {
#pragma unroll
          for (int e = 0; e < 8; ++e) nxt[e] = 0.f;
        }
        float o[8];
#pragma unroll
        for (int e = 0; e < 8; ++e) {
          const float x = cur[e] + mu_p[col + e] * (prv[e] - cur[e]) + mu_n[col + e] * (nxt[e] - cur[e]);
          o[e] = sigm(x);
        }
        u32x4 pk;
        pk.x = pack2(o[0], o[1]); pk.y = pack2(o[2], o[3]); pk.z = pack2(o[4], o[5]); pk.w = pack2(o[6], o[7]);
        *(u32x4*)(As + row * 136 + part * 32 + q * 8) = pk;
      }
    }
    asm volatile("" ::: "memory");
#pragma unroll 1
    for (int chh = 0; chh < 2; ++chh) {
      f32x4 acc[16];
#pragma unroll
      for (int n = 0; n < 16; ++n) acc[n] = (f32x4){0.f, 0.f, 0.f, 0.f};
#pragma unroll
      for (int ks = 0; ks < 4; ++ks) {
        bf16x8 af = *(const bf16x8*)(As + (w * 16 + fr) * 136 + ks * 32 + fq * 8);
#pragma unroll
        for (int n = 0; n < 16; ++n) {
          bf16x8 bg = *(const bf16x8*)(GUPT + (size_t)(chh * 256 + n * 16 + fr) * 128 + ks * 32 + fq * 8);
          acc[n] = __builtin_amdgcn_mfma_f32_16x16x32_bf16(af, bg, acc[n], 0, 0, 0);
        }
      }
#pragma unroll
      for (int hl = 0; hl < 4; ++hl) {
        const int head = chh * 4 + hl;
        asm volatile("" ::: "memory");
#pragma unroll
        for (int j = 0; j < 4; ++j) {
          const size_t tok = tok0 + w * 16 + fq * 4 + j;
          const int t = (int)(tok & 4095);
          float o[4], sum = 0.f;
#pragma unroll
          for (int q = 0; q < 4; ++q) {
            const int col = head * 64 + q * 16 + fr;
            o[q] = (float)YF[tok * 512 + col] + (float)YB[tok * 512 + col];
            sum += o[q];
          }
          const float mean = red16_sum(sum) * (1.f / 64.f);
          float vs = 0.f;
#pragma unroll
          for (int q = 0; q < 4; ++q) { const float dlt = o[q] - mean; vs += dlt * dlt; }
          const float var = red16_sum(vs) * (1.f / 64.f);
          const float rstd = rsqrtf(var + 64e-5f);
          const float bon = BON[(tok * 8 + head) * 2] + BON[(tok * 8 + head) * 2 + 1];
#pragma unroll
          for (int q = 0; q < 4; ++q) {
            const int col = head * 64 + q * 16 + fr;
            const int vc = 1024 + col;
            const float cur = bf2f(PR[tok * PRW + vc]);
            const float prv = (t > 0) ? bf2f(PR[(tok - 1) * PRW + vc]) : 0.f;
            const float nxt = (t < 4095) ? bf2f(PR[(tok + 1) * PRW + vc]) : 0.f;
            const float vsh = cur + mu_p[vc] * (prv - cur) + mu_n[vc] * (nxt - cur);
            const float yv = ((o[q] - mean) * rstd * gng[col] + gnb[col] + bon * vsh) * acc[hl * 4 + q][j];
            PR[tok * PRW + col] = f2bf(yv);
          }
        }
      }
    }
  }
}

DEVI f32x4 ld4bf(const u16* p) {
  const u32x2 u = *(const u32x2*)p;
  f32x4 o;
  o[0] = __uint_as_float(u.x << 16); o[1] = __uint_as_float(u.x & 0xffff0000u);
  o[2] = __uint_as_float(u.y << 16); o[3] = __uint_as_float(u.y & 0xffff0000u);
  return o;
}

DEVI void phase_merge(int tid_, const Params& p, char* smem, const float* ssq) {
  const u16* WB = (const u16*)(p.ws + OFF_WB);
  const u16* H = (const u16*)(p.ws + OFF_NK);
  u16* PR = (u16*)(p.ws + OFF_PR);
  const u16* NQ = (const u16*)(p.ws + OFF_NQ);
  u16* TMP = (u16*)(p.ws + OFF_H);
  const int lane = tid_ & 63, wid = tid_ >> 6;
  const int wr = wid >> 2, wc = wid & 3, fr = lane & 15, fq = lane >> 4;
  const bool xmap = (gridDim.x & 7) == 0;
  const int xcd = blockIdx.x & 7;
  const int first = xmap ? (int)(blockIdx.x >> 3) : (int)blockIdx.x;
  const int stride = xmap ? (int)(gridDim.x >> 3) : (int)gridDim.x;
  const int count = xmap ? 24 * 4 : 192 * 4;
  for (int it = first; it < count; it += stride) {
    const int tm = xmap ? (it >> 2) * 8 + xcd : (it >> 2), tn = it & 3;
    const int m0 = tm << 8, n0 = tn << 8;
    f32x4 acc[8][4];
#define MERGE_ZERO() _Pragma("unroll") for (int m = 0; m < 8; ++m) _Pragma("unroll") for (int n = 0; n < 4; ++n) acc[m][n] = (f32x4){0.f, 0.f, 0.f, 0.f}
#define MERGE_RC() const int r = m0 + wr * 128 + m * 16 + fr, c0 = n0 + wc * 64 + n * 16 + fq * 4
    MERGE_ZERO();
    gemm_kloop8<true>(launder(tid_), acc, H + (size_t)m0 * 1024, 1024, WB + W_IN + (size_t)(3456 + n0) * 1024, 1024, 1024, smem);
#pragma unroll
    for (int m = 0; m < 8; ++m)
#pragma unroll
      for (int n = 0; n < 4; ++n) {
        MERGE_RC();
        const float rs = rstd_of(ssq, r);
        f32x4 o;
#pragma unroll
        for (int j = 0; j < 4; ++j) o[j] = sigm(acc[m][n][j] * rs);
        store4bf(PR + (size_t)r * PRW + 512 + c0, o);
      }
    MERGE_ZERO();
    gemm_kloop8<true>(launder(tid_), acc, PR + (size_t)m0 * PRW, PRW, WB + W_BRR + (size_t)n0 * 512, 512, 512, smem);
#pragma unroll
    for (int m = 0; m < 8; ++m)
#pragma unroll
      for (int n = 0; n < 4; ++n) {
        MERGE_RC();
        u16* dst = PR + (size_t)r * PRW + 512 + c0;
        store4bf(dst, ld4bf(dst) * acc[m][n]);
      }
    MERGE_ZERO();
    gemm_kloop8<true>(launder(tid_), acc, H + (size_t)m0 * 1024, 1024, WB + W_IN + (size_t)(4480 + n0) * 1024, 1024, 1024, smem);
#pragma unroll
    for (int m = 0; m < 8; ++m)
#pragma unroll
      for (int n = 0; n < 4; ++n) {
        MERGE_RC();
        const float rs = rstd_of(ssq, r);
        f32x4 o;
#pragma unroll
        for (int j = 0; j < 4; ++j) o[j] = sigm(acc[m][n][j] * rs);
        store4bf(TMP + (size_t)r * 1024 + c0, o);
      }
    MERGE_ZERO();
    gemm_kloop8<true>(launder(tid_), acc, NQ + (size_t)m0 * 512, 512, WB + W_BRN + (size_t)n0 * 512, 512, 512, smem);
#pragma unroll
    for (int m = 0; m < 8; ++m)
#pragma unroll
      for (int n = 0; n < 4; ++n) {
        MERGE_RC();
        u16* dst = PR + (size_t)r * PRW + 512 + c0;
        store4bf(dst, ld4bf(dst) + ld4bf(TMP + (size_t)r * 1024 + c0) * acc[m][n]);
      }
#undef MERGE_ZERO
#undef MERGE_RC
  }
}


DEVI void phase_xattn(int tid_, int vb_, int vg_, const Params& p, char* smem) {
  const u16* Q = (const u16*)(p.ws + OFF_PR);
  u16* O = (u16*)(p.ws + OFF_NQ);
  const u16* KVK = (const u16*)(p.ws + OFF_KVK);
  const u16* KVT = (const u16*)(p.ws + OFF_KVT);
  const int lane = tid_ & 63, w = tid_ >> 6, fr = lane & 15, fq = lane >> 4;
  u16* Pw = (u16*)smem + w * (32 * 264);
  for (int t = vb_; t < (NTOK / 128) * 4; t += vg_) {
    const int hh = t & 3;
    const size_t tok0 = (size_t)(t >> 2) * 128 + w * 32;
    const int s = (int)(tok0 >> 12);
    f32x4 acc[2][16];
#pragma unroll
    for (int mt = 0; mt < 2; ++mt)
#pragma unroll
      for (int n = 0; n < 16; ++n) acc[mt][n] = (f32x4){0.f, 0.f, 0.f, 0.f};
#pragma unroll 1
    for (int ks = 0; ks < 8; ++ks) {
      const bf16x8 aq0 = *(const bf16x8*)(Q + (tok0 + fr) * 1024 + hh * 256 + ks * 32 + fq * 8);
      const bf16x8 aq1 = *(const bf16x8*)(Q + (tok0 + 16 + fr) * 1024 + hh * 256 + ks * 32 + fq * 8);
#pragma unroll
      for (int n = 0; n < 16; ++n) {
        const bf16x8 bk = *(const bf16x8*)(KVK + (size_t)(s * 256 + n * 16 + fr) * 1024 + hh * 256 + ks * 32 + fq * 8);
        acc[0][n] = __builtin_amdgcn_mfma_f32_16x16x32_bf16(bk, aq0, acc[0][n], 0, 0, 0);
        acc[1][n] = __builtin_amdgcn_mfma_f32_16x16x32_bf16(bk, aq1, acc[1][n], 0, 0, 0);
      }
    }
    float sm[2];
#pragma unroll
    for (int mt = 0; mt < 2; ++mt) {
      float m = -1e30f;
#pragma unroll
      for (int n = 0; n < 16; ++n)
#pragma unroll
        for (int j = 0; j < 4; ++j) m = fmaxf(m, acc[mt][n][j]);
      m = red4x_max(m) * 0.0625f;
      float ssum = 0.f;
#pragma unroll
      for (int n = 0; n < 16; ++n) {
        f32x4 e;
#pragma unroll
        for (int j = 0; j < 4; ++j) { e[j] = __expf(acc[mt][n][j] * 0.0625f - m); ssum += e[j]; }
        store4bf(Pw + (mt * 16 + fr) * 264 + n * 16 + fq * 4, e);
      }
      sm[mt] = 1.f / red4x_sum(ssum);
    }
#pragma unroll
    for (int mt = 0; mt < 2; ++mt)
#pragma unroll
      for (int n = 0; n < 16; ++n) acc[mt][n] = (f32x4){0.f, 0.f, 0.f, 0.f};
#pragma unroll 1
    for (int ks = 0; ks < 8; ++ks) {
      const bf16x8 ap0 = *(const bf16x8*)(Pw + fr * 264 + ks * 32 + fq * 8);
      const bf16x8 ap1 = *(const bf16x8*)(Pw + (16 + fr) * 264 + ks * 32 + fq * 8);
#pragma unroll
      for (int n = 0; n < 16; ++n) {
        const bf16x8 bv = *(const bf16x8*)(KVT + (size_t)(s * 1024 + hh * 256 + n * 16 + fr) * 256 + ks * 32 + fq * 8);
        acc[0][n] = __builtin_amdgcn_mfma_f32_16x16x32_bf16(bv, ap0, acc[0][n], 0, 0, 0);
        acc[1][n] = __builtin_amdgcn_mfma_f32_16x16x32_bf16(bv, ap1, acc[1][n], 0, 0, 0);
      }
    }
#pragma unroll
    for (int mt = 0; mt < 2; ++mt)
#pragma unroll
      for (int n = 0; n < 16; ++n)
        store4bf(O + (tok0 + mt * 16 + fr) * 1024 + hh * 256 + n * 16 + fq * 4, acc[mt][n] * sm[mt]);
  }
}

constexpr int HALF_SMEM = 78720;

DEVI void run_phase(int tid_, const Params& p, int ph, char* smem) {
  const int half = tid_ >> 8, vt = tid_ & 255;
  const int vb_ = blockIdx.x * 2 + half, vg_ = gridDim.x * 2;
  char* smh = smem + half * HALF_SMEM;
  if (ph == 2 * NPH_LAYER) { phase_final_norm(vt, vb_, vg_, p); return; }
  const int l = ph / NPH_LAYER, q = ph % NPH_LAYER;
  u16* WB = (u16*)(p.ws + OFF_WB);
  u16* H = (u16*)(p.ws + OFF_H);
  u16* PR = (u16*)(p.ws + OFF_PR);
  u16* NQ = (u16*)(p.ws + OFF_NQ);
  float* X = p.X;
  float* SSQ = (float*)(p.ws + OFF_SSQ);
  auto epi_res = [&](int r, int c0, f32x4 v) {
    f32x4* px = (f32x4*)(X + (size_t)r * 1024 + c0);
    *px = *px + v;
  };
  float rowacc = 0.f;
  float* ssq_out = SSQ;
  const bool x_from_input = (l == 0 && q <= 5);
  const bool need_xb = !(l == 1 && q == 12);
  auto epi_res_n = [&](int r, int c0, f32x4 v) {
    f32x4* px = (f32x4*)(X + (size_t)r * 1024 + c0);
    const float* srow = x_from_input ? ((r < 32768) ? p.in[I_XP] + (size_t)r * 1024 : p.in[I_XS] + (size_t)(r - 32768) * 1024)
                                     : X + (size_t)r * 1024;
    const f32x4 xn = *(const f32x4*)(srow + c0) + v;
    *px = xn;
    if (need_xb) store4bf(H + (size_t)r * 1024 + c0, xn);
    rowacc += xn[0] * xn[0] + xn[1] * xn[1] + xn[2] * xn[2] + xn[3] * xn[3];
  };
  auto row_end = [&](int r) {
    float t = rowacc;
    t += __shfl_xor(t, 16);
    t += __shfl_xor(t, 32);
    if ((tid_ & 48) == 0) atomicAdd(ssq_out + r, t);
    rowacc = 0.f;
  };
  constexpr int NONS = 1 << 30;
  switch (q) {
    case 0:
      phase_conv(vt, vb_, vg_, p, l, smh);
      phase_norm_mem(vt, vb_, vg_, p, p.in[I_NORM_MEM] + (size_t)l * 1024);
      if (l == 0) {
        phase_xb(vt, vb_, vg_, p, true, OFF_H, SSQ);
        for (int i = vb_ * 256 + vt; i < 6 * NTOK; i += vg_ * 256) SSQ[NTOK + i] = 0.f;
      }
      break;
    case 1: phase_p_gemm(tid_, p, smem, SSQ + (size_t)(3 * l) * NTOK); break;
    case 2:
      if (gridDim.x >= 224) {
        if (blockIdx.x < 192) phase_scan_pc(tid_, p, l, smem, blockIdx.x, gridDim.x);
        else phase_nat(vt, p, l, smh, vb_ - 384, vg_ - 384);
      } else {
        phase_scan(vt, p, l, smh, vb_, vg_);
        __syncthreads();
        phase_nat(vt, p, l, smh, vb_, vg_);
      }
      break;
    case 3:
      phase_rwkv_post(vt, vb_, vg_, p, l, smh);
      phase_xb(vt, vb_, vg_, p, l == 0, OFF_NK, nullptr);
      break;
    case 4: phase_merge(tid_, p, smem, SSQ + (size_t)(3 * l) * NTOK); break;
    case 5:
      ssq_out = SSQ + (size_t)(3 * l + 1) * NTOK;
      gemm_phase8(tid_, PR + 512, PRW, WB + W_OUT, 1024, 1024, NTOK, 1024, smem, NONS, epi_res_n, NoEpi(), row_end);
      break;
    case 6: {
      const float* ssq = SSQ + (size_t)(3 * l + 1) * NTOK;
      gemm_phase8(tid_, H, 1024, WB + W_XQ, 1024, 1024, NTOK, 1024, smem, NONS,
                 [&](int r, int c0, f32x4 v) { store4bf(PR + (size_t)r * 1024 + c0, v * rstd_of(ssq, r)); }, NoEpi());
    } break;
    case 7: phase_xattn(vt, vb_, vg_, p, smh); break;
    case 8:
      ssq_out = SSQ + (size_t)(3 * l + 2) * NTOK;
      gemm_phase8(tid_, NQ, 1024, WB + W_XO, 1024, 1024, NTOK, 1024, smem, NONS, epi_res_n, NoEpi(), row_end);
      break;
    case 9:
    case 11: {
      const int hf = (q == 11);
      const float* ssq = SSQ + (size_t)(3 * l + 2) * NTOK;
      gemm_phase8(tid_, H, 1024, WB + W_FF1 + (size_t)hf * 2048 * 1024, 1024, 1024, NTOK, 2048, smem, NONS,
                 [&](int r, int c0, f32x4 v) {
                   const float rs = rstd_of(ssq, r);
                   f32x4 o;
#pragma unroll
                   for (int j = 0; j < 4; ++j) { const float x = fmaxf(v[j] * rs, 0.f); o[j] = x * x; }
                   store4bf(PR + (size_t)r * 2048 + c0, o);
                 }, NoEpi());
    } break;
    case 10:
      gemm_phase8(tid_, PR, 2048, WB + W_FF2, 4096, 2048, NTOK, 1024, smem, NONS, epi_res, NoEpi());
      break;
    case 12:
      ssq_out = SSQ + (size_t)(3 * l + 3) * NTOK;
      gemm_phase8(tid_, PR, 2048, WB + W_FF2 + 2048, 4096, 2048, NTOK, 1024, smem, NONS, epi_res_n, NoEpi(), row_end);
      break;
  }
}

#define XB_TMO      128
#define XB_XCNT(j)  (256  + 64 * (j))
#define XB_XSUB(j)  (1280 + 64 * (j))
#define XB_XGEN(j)  (2304 + 64 * (j))
#define XB_TOP      3328
#define XB_TOPGEN   3392
#define XCD_BAR_WORDS 3456
#define XB_SPIN_CAP (1u << 20)
#define LAS __attribute__((address_space(3)))

DEVI unsigned xb_ld(unsigned* p) { return __hip_atomic_load(p, __ATOMIC_RELAXED, __HIP_MEMORY_SCOPE_AGENT); }
DEVI unsigned xb_add(unsigned* p, unsigned v) { return __hip_atomic_fetch_add(p, v, __ATOMIC_RELAXED, __HIP_MEMORY_SCOPE_AGENT); }
DEVI unsigned xb_xcc_id() { return (unsigned)__builtin_amdgcn_s_getreg((3 << 11) | 20) & 0xFu; }
#define XB_SPIN(cond, bar) do { unsigned _sp = 0; while (cond) { __builtin_amdgcn_s_sleep(1); \
    if ((++_sp & 255u) == 0u) { if (xb_ld(&(bar)[XB_TMO])) break; if (_sp > XB_SPIN_CAP) { atomicAdd(&(bar)[XB_TMO], 1u); break; } } } } while (0)

struct XcdBarrier {
  unsigned* bar; unsigned x;
  volatile LAS unsigned* st;
};
DEVI XcdBarrier xcd_barrier_post(unsigned* bar, volatile LAS unsigned* st) {
  XcdBarrier b; b.bar = bar; b.x = xb_xcc_id(); b.st = st;
  if (threadIdx.x == 0) (void)xb_add(&bar[XB_XCNT(b.x)], 1u);
  return b;
}
DEVI void xcd_barrier_complete(unsigned* bar, unsigned x, unsigned& nloc, unsigned& nx) {
  const unsigned G = gridDim.x * gridDim.y * gridDim.z;
  unsigned sum, cnt, mine, sp = 0u;
  for (;;) {
    sum = 0u; cnt = 0u; mine = 0u;
#pragma unroll
    for (unsigned j = 0; j < 16; ++j) { const unsigned c = xb_ld(&bar[XB_XCNT(j)]); sum += c; cnt += (c > 0u) ? 1u : 0u; mine = (j == x) ? c : mine; }
    if (sum == G) break;
    __builtin_amdgcn_s_sleep(1);
    if ((++sp & 255u) == 0u) { if (xb_ld(&bar[XB_TMO])) break; if (sp > XB_SPIN_CAP) { atomicAdd(&bar[XB_TMO], 1u); break; } }
  }
  nloc = mine > 0u ? mine : 1u; nx = cnt > 0u ? cnt : 1u;
}
DEVI void xcd_barrier(const XcdBarrier& b) {
  asm volatile("s_waitcnt vmcnt(0)" ::: "memory");
  __syncthreads();
  if (threadIdx.x == 0) {
    unsigned* bar = b.bar;
    __builtin_amdgcn_s_waitcnt(0);
    unsigned nloc = b.st[0], nx = b.st[1];
    if (nloc == 0u) { xcd_barrier_complete(bar, b.x, nloc, nx); b.st[0] = nloc; b.st[1] = nx; }
    const unsigned old = xb_add(&bar[XB_XSUB(b.x)], 1u);
    const unsigned gen = old / nloc;
    if (old + 1u == (gen + 1u) * nloc) {
      __builtin_amdgcn_fence(__ATOMIC_RELEASE, "agent");
      asm volatile("s_waitcnt vmcnt(0)" ::: "memory");
      const unsigned og = xb_add(&bar[XB_TOP], 1u);
      const unsigned tg = og / nx;
      if (og + 1u == (tg + 1u) * nx) xb_add(&bar[XB_TOPGEN], 1u);
      else XB_SPIN(xb_ld(&bar[XB_TOPGEN]) == tg, bar);
      __builtin_amdgcn_fence(__ATOMIC_ACQUIRE, "agent");
      xb_add(&bar[XB_XGEN(b.x)], 1u);
      asm volatile("s_waitcnt vmcnt(0)" ::: "memory");
    } else {
      XB_SPIN(xb_ld(&bar[XB_XGEN(b.x)]) == gen, bar);
      __builtin_amdgcn_fence(__ATOMIC_ACQUIRE, "agent");
      asm volatile("s_waitcnt vmcnt(0)" ::: "memory");
    }
  }
  __syncthreads();
}

__global__ void __launch_bounds__(512, 2) mega_kernel(Params p, int ph0, int ph1) {
  __shared__ __attribute__((aligned(16))) char smem[2 * HALF_SMEM];
  __shared__ __attribute__((aligned(16))) unsigned xb_words[4];
  if (threadIdx.x == 0) { xb_words[0] = 0u; xb_words[1] = 0u; xb_words[2] = 0u; xb_words[3] = 0u; }
  __syncthreads();
  XcdBarrier xb = xcd_barrier_post((unsigned*)(p.ws + OFF_BAR), (volatile LAS unsigned*)xb_words);
  for (int ph = ph0; ph < ph1; ++ph) {
    if (ph == ph0 + 1) cg::this_grid().sync();
    else if (ph > ph0) xcd_barrier(xb);
    int tid_ = threadIdx.x;
    asm volatile("" : "+v"(tid_));
    run_phase(tid_, p, ph, smem);
  }
}

extern "C" void kernel_launch(void* const* d_in, const int* in_sizes, int n_in, void* d_out, int out_size, void* d_ws,
                              size_t ws_size, hipStream_t stream) {
  if (ws_size < WS_NEED || n_in < 31) return;
  Params p{};
  for (int i = 0; i < 31; ++i) p.in[i] = (const float*)d_in[i];
  p.X = (float*)d_out;
  p.ws = (char*)d_ws;
  static int grid_blocks = 0;
  if (!grid_blocks) {
    int dev = 0, cus = 0, per_cu = 0;
    hipGetDevice(&dev);
    hipDeviceGetAttribute(&cus, hipDeviceAttributeMultiprocessorCount, dev);
    hipOccupancyMaxActiveBlocksPerMultiprocessor(&per_cu, mega_kernel, 512, 0);
    if (per_cu > 1) per_cu = 1;
    if (per_cu < 1) per_cu = 1;
    grid_blocks = cus * per_cu;
  }
  hipMemsetAsync((char*)d_ws + OFF_BAR, 0, 16384, stream);
  int ph0 = 0, ph1 = NPHASES;
  void* args[] = {&p, &ph0, &ph1};
  hipLaunchCooperativeKernel((void*)mega_kernel, dim3(grid_blocks), dim3(512), args, 0, stream);
}
```

```cpp
#include <hip/hip_runtime.h>
#include <hip/hip_cooperative_groups.h>
#include <stdint.h>
namespace cg = cooperative_groups;

typedef unsigned short u16;
typedef __attribute__((ext_vector_type(8))) short bf16x8;
typedef __attribute__((ext_vector_type(4))) float f32x4;
typedef __attribute__((ext_vector_type(8))) _Float16 h16x8;
typedef __attribute__((ext_vector_type(4))) unsigned int u32x4;
typedef __attribute__((ext_vector_type(2))) unsigned int u32x2;

#define DEVI __device__ __forceinline__

constexpr int NTOK = 49152;
constexpr int SEQ_T = 4096;
constexpr int PRW = 1920;
constexpr int NPH_LAYER = 13;
constexpr int NPHASES = 2 * NPH_LAYER + 1;
constexpr int SMEM_BYTES = 78720;

constexpr size_t OFF_WB = 0;
constexpr size_t WB_BYTES = 20512768ull * 2;
constexpr size_t OFF_H = OFF_WB + WB_BYTES;
constexpr size_t OFF_PR = OFF_H + (size_t)NTOK * 1024 * 2;
constexpr size_t OFF_NQ = OFF_PR + (size_t)NTOK * PRW * 2;
constexpr size_t OFF_NK = OFF_NQ + (size_t)NTOK * 512 * 2;
constexpr size_t OFF_NV = OFF_NK + (size_t)NTOK * 512 * 2;
constexpr size_t OFF_KVK = OFF_NV + (size_t)NTOK * 512 * 2;
constexpr size_t OFF_KVT = OFF_KVK + (size_t)3072 * 1024 * 2;
constexpr size_t OFF_MEMH = OFF_KVT + (size_t)3072 * 1024 * 2;
constexpr size_t OFF_BONUS = OFF_MEMH + (size_t)3072 * 1024 * 2;
constexpr size_t OFF_BAR = OFF_BONUS + (size_t)NTOK * 16 * 4;
constexpr size_t OFF_SSQ = OFF_BAR + 16384;
constexpr size_t WS_NEED = OFF_SSQ + (size_t)7 * NTOK * 4;

constexpr size_t W_IN = 0;
constexpr size_t W_BRR = W_IN + (size_t)5504 * 1024;
constexpr size_t W_BRN = W_BRR + (size_t)1024 * 512;
constexpr size_t W_OUT = W_BRN + (size_t)1024 * 512;
constexpr size_t W_XQ = W_OUT + (size_t)1024 * 1024;
constexpr size_t W_XKV = W_XQ + (size_t)1024 * 1024;
constexpr size_t W_XO = W_XKV + (size_t)2048 * 1024;
constexpr size_t W_FF1 = W_XO + (size_t)1024 * 1024;
constexpr size_t W_FF2 = W_FF1 + (size_t)4096 * 1024;
constexpr size_t W_GUP = W_FF2 + (size_t)4096 * 1024;
constexpr size_t W_WUP = W_GUP + (size_t)512 * 128;
constexpr size_t W_AUP = W_WUP + (size_t)2 * 512 * 64;

enum { I_XP = 0, I_XS, I_MP, I_MS, I_NORM_MIX, I_W_IN, I_MU_PREV, I_MU_NEXT, I_W0, I_W_UP, I_A0, I_A_UP,
       I_G_UP, I_K_K, I_K_A, I_R_K, I_GN_G, I_GN_B, I_RPB, I_W_BR_RWKV, I_W_BR_NAT, I_W_OUT, I_NORM_X,
       I_NORM_MEM, I_W_XQ, I_W_XKV, I_W_XO, I_NORM_FF, I_W_FF1, I_W_FF2, I_NORM_FINAL };

struct Params {
  const float* in[31];
  float* X;
  char* ws;
};

DEVI u16 f2bf(float f) {
  uint32_t u = __float_as_uint(f);
  u += 0x7FFFu + ((u >> 16) & 1u);
  return (u16)(u >> 16);
}
DEVI float bf2f(u16 h) { return __uint_as_float(((uint32_t)h) << 16); }
DEVI uint32_t pack2(float a, float b) { return (uint32_t)f2bf(a) | ((uint32_t)f2bf(b) << 16); }
DEVI float frcp(float x) { return __builtin_amdgcn_rcpf(x); }
DEVI float sigm(float x) { return frcp(1.f + __expf(-x)); }
DEVI float ftanh(float x) { return 1.f - 2.f * frcp(__expf(2.f * x) + 1.f); }
DEVI void unpack8(u32x4 u, float* o) {
  o[0] = __uint_as_float(u.x << 16); o[1] = __uint_as_float(u.x & 0xffff0000u);
  o[2] = __uint_as_float(u.y << 16); o[3] = __uint_as_float(u.y & 0xffff0000u);
  o[4] = __uint_as_float(u.z << 16); o[5] = __uint_as_float(u.z & 0xffff0000u);
  o[6] = __uint_as_float(u.w << 16); o[7] = __uint_as_float(u.w & 0xffff0000u);
}
DEVI void load8bf(const u16* p, float* o) { unpack8(*(const u32x4*)p, o); }
DEVI float wave_sum(float v) {
  v += __shfl_xor(v, 32); v += __shfl_xor(v, 16); v += __shfl_xor(v, 8);
  v += __shfl_xor(v, 4); v += __shfl_xor(v, 2); v += __shfl_xor(v, 1);
  return v;
}
DEVI float red4x_sum(float v) { v += __shfl_xor(v, 16); v += __shfl_xor(v, 32); return v; }
DEVI float red4x_max(float v) { v = fmaxf(v, __shfl_xor(v, 16)); v = fmaxf(v, __shfl_xor(v, 32)); return v; }
DEVI float red16_sum(float v) {
  v += __shfl_xor(v, 1); v += __shfl_xor(v, 2); v += __shfl_xor(v, 4); v += __shfl_xor(v, 8);
  return v;
}
DEVI float red16_max(float v) {
  v = fmaxf(v, __shfl_xor(v, 1)); v = fmaxf(v, __shfl_xor(v, 2));
  v = fmaxf(v, __shfl_xor(v, 4)); v = fmaxf(v, __shfl_xor(v, 8));
  return v;
}

DEVI void conv_tile(int tid_, const float* src, int K, int N, u16* dst, int tile, char* smem, const float* gain = nullptr) {
  float (*s)[65] = (float (*)[65])smem;
  const int nN = N >> 6;
  const int tk = tile / nN, tn = tile - tk * nN;
  const int tx = tid_ & 63, ty = tid_ >> 6;
  for (int r = ty; r < 64; r += 4) s[r][tx] = src[(size_t)(tk * 64 + r) * N + tn * 64 + tx];
  __syncthreads();
  const float gk = gain ? gain[tk * 64 + tx] : 1.f;
  for (int r = ty; r < 64; r += 4) dst[(size_t)(tn * 64 + r) * K + tk * 64 + tx] = f2bf(s[tx][r] * gk);
  __syncthreads();
}

DEVI void phase_conv(int tid_, int vb_, int vg_, const Params& p, int l, char* smem) {
  u16* WB = (u16*)(p.ws + OFF_WB);
  const int c0 = 1376, c1 = c0 + 128, c2 = c1 + 128, c3 = c2 + 256, c4 = c3 + 256, c5 = c4 + 512,
            c6 = c5 + 256, c7 = c6 + 1024, c8 = c7 + 1024, c9 = c8 + 16, c10 = c9 + 16, c11 = c10 + 16;
  for (int t = vb_; t < c11; t += vg_) {
    if (t < c0) conv_tile(tid_, p.in[I_W_IN] + (size_t)l * 1024 * 5504, 1024, 5504, WB + W_IN, t, smem, p.in[I_NORM_MIX] + (size_t)l * 1024);
    else if (t < c1) conv_tile(tid_, p.in[I_W_BR_RWKV] + (size_t)l * 512 * 1024, 512, 1024, WB + W_BRR, t - c0, smem);
    else if (t < c2) conv_tile(tid_, p.in[I_W_BR_NAT] + (size_t)l * 512 * 1024, 512, 1024, WB + W_BRN, t - c1, smem);
    else if (t < c3) conv_tile(tid_, p.in[I_W_OUT] + (size_t)l * 1024 * 1024, 1024, 1024, WB + W_OUT, t - c2, smem);
    else if (t < c4) conv_tile(tid_, p.in[I_W_XQ] + (size_t)l * 1024 * 1024, 1024, 1024, WB + W_XQ, t - c3, smem, p.in[I_NORM_X] + (size_t)l * 1024);
    else if (t < c5) conv_tile(tid_, p.in[I_W_XKV] + (size_t)l * 1024 * 2048, 1024, 2048, WB + W_XKV, t - c4, smem);
    else if (t < c6) conv_tile(tid_, p.in[I_W_XO] + (size_t)l * 1024 * 1024, 1024, 1024, WB + W_XO, t - c5, smem);
    else if (t < c7) conv_tile(tid_, p.in[I_W_FF1] + (size_t)l * 1024 * 4096, 1024, 4096, WB + W_FF1, t - c6, smem, p.in[I_NORM_FF] + (size_t)l * 1024);
    else if (t < c8) conv_tile(tid_, p.in[I_W_FF2] + (size_t)l * 4096 * 1024, 4096, 1024, WB + W_FF2, t - c7, smem);
    else if (t < c9) conv_tile(tid_, p.in[I_G_UP] + (size_t)l * 128 * 512, 128, 512, WB + W_GUP, t - c8, smem);
    else if (t < c10) { const int dd = (t - c9) >> 3; conv_tile(tid_, p.in[I_W_UP] + (size_t)(l * 2 + dd) * 64 * 512, 64, 512, WB + W_WUP + (size_t)dd * 512 * 64, (t - c9) & 7, smem); }
    else { const int dd = (t - c10) >> 3; conv_tile(tid_, p.in[I_A_UP] + (size_t)(l * 2 + dd) * 64 * 512, 64, 512, WB + W_AUP + (size_t)dd * 512 * 64, (t - c10) & 7, smem); }
  }
}

DEVI void norm_row_bf16(int tid_, const float* src, const float* g, u16* dst, float* xcopy) {
  const int lane = tid_ & 63;
  float4 v[4];
  float ss = 0.f;
#pragma unroll
  for (int i = 0; i < 4; ++i) {
    v[i] = ((const float4*)src)[lane + i * 64];
    ss += v[i].x * v[i].x + v[i].y * v[i].y + v[i].z * v[i].z + v[i].w * v[i].w;
  }
  ss = wave_sum(ss);
  const float rs = rsqrtf(ss * (1.f / 1024.f) + 1e-6f);
#pragma unroll
  for (int i = 0; i < 4; ++i) {
    float4 gg = ((const float4*)g)[lane + i * 64];
    u32x2 o;
    o.x = pack2(v[i].x * rs * gg.x, v[i].y * rs * gg.y);
    o.y = pack2(v[i].z * rs * gg.z, v[i].w * rs * gg.w);
    ((u32x2*)dst)[lane + i * 64] = o;
    if (xcopy) ((float4*)xcopy)[lane + i * 64] = v[i];
  }
}

DEVI void phase_xb(int tid_, int vb_, int vg_, const Params& p, bool from_input, size_t hoff, float* ssq) {
  u16* H = (u16*)(p.ws + hoff);
  const int wid = tid_ >> 6, lane = tid_ & 63;
  for (int r = vb_ * 4 + wid; r < NTOK; r += vg_ * 4) {
    const float* src;
    if (from_input) src = (r < 32768) ? p.in[I_XP] + (size_t)r * 1024 : p.in[I_XS] + (size_t)(r - 32768) * 1024;
    else src = p.X + (size_t)r * 1024;
    float ss = 0.f;
#pragma unroll
    for (int i = 0; i < 4; ++i) {
      const float4 v = ((const float4*)src)[lane + i * 64];
      ss += v.x * v.x + v.y * v.y + v.z * v.z + v.w * v.w;
      u32x2 o;
      o.x = pack2(v.x, v.y); o.y = pack2(v.z, v.w);
      ((u32x2*)(H + (size_t)r * 1024))[lane + i * 64] = o;
    }
    if (ssq) {
      ss = wave_sum(ss);
      if (lane == 0) ssq[r] = ss;
    }
  }
}
DEVI void phase_norm_mem(int tid_, int vb_, int vg_, const Params& p, const float* g) {
  u16* MH = (u16*)(p.ws + OFF_MEMH);
  const int wid = tid_ >> 6;
  for (int r = vb_ * 4 + wid; r < 3072; r += vg_ * 4) {
    const float* src = (r < 2048) ? p.in[I_MP] + (size_t)r * 1024 : p.in[I_MS] + (size_t)(r - 2048) * 1024;
    norm_row_bf16(tid_, src, g, MH + (size_t)r * 1024, nullptr);
  }
}
DEVI void phase_final_norm(int tid_, int vb_, int vg_, const Params& p) {
  const float* g = p.in[I_NORM_FINAL];
  const float* ssq = (const float*)(p.ws + OFF_SSQ) + (size_t)6 * NTOK;
  const int wid = tid_ >> 6, lane = tid_ & 63;
  for (int r = vb_ * 4 + wid; r < NTOK; r += vg_ * 4) {
    float* row = p.X + (size_t)r * 1024;
    const float rs = rsqrtf(ssq[r] * (1.f / 1024.f) + 1e-6f);
#pragma unroll
    for (int i = 0; i < 4; ++i) {
      const float4 v = ((const float4*)row)[lane + i * 64];
      const float4 gg = ((const float4*)g)[lane + i * 64];
      float4 o;
      o.x = v.x * rs * gg.x; o.y = v.y * rs * gg.y; o.z = v.z * rs * gg.z; o.w = v.w * rs * gg.w;
      ((float4*)row)[lane + i * 64] = o;
    }
  }
}

template <int OFF>
DEVI bf16x8 lds_rd128(uint32_t addr) {
  bf16x8 r;
  asm volatile("ds_read_b128 %0, %1 offset:%2" : "=v"(r) : "v"(addr), "n"(OFF));
  return r;
}

template <int NW, bool SWAP>
DEVI void gemm_kloop(int tid_, f32x4 (&acc)[4][NW], const u16* __restrict__ A, int lda, const u16* __restrict__ Bt, int ldb,
                     int K, char* smem) {
  constexpr int STG = 8192 + NW * 2048;
  constexpr int NB = NW / 2;
  const int tid = tid_, lane = tid & 63, wid = tid >> 6;
  const int wr = wid >> 1, wc = wid & 1, fr = lane & 15, fq = lane >> 4;
  const int lrow = lane >> 2, lphys = lane & 3, lhi = lane >> 4;
  const int gsw = (4 - lhi) & 3;
  const u16* ga[2];
  const u16* gb[NB];
#pragma unroll
  for (int q = 0; q < 2; ++q) ga[q] = A + (size_t)((wid * 2 + q) * 16 + lrow) * lda + (lphys ^ gsw) * 8;
#pragma unroll
  for (int q = 0; q < NB; ++q) gb[q] = Bt + (size_t)((wid * NB + q) * 16 + lrow) * ldb + (lphys ^ gsw) * 8;
  const int rsw = (4 - ((fr >> 2) & 3)) & 3;
  const int ch = (fq ^ rsw) * 16;
  const int nk = K >> 5;
  const uint32_t lds_base = (uint32_t)(size_t)(__attribute__((address_space(3))) char*)smem;
  const uint32_t aoff = (uint32_t)((wr * 64 + fr) * 64 + ch);
  const uint32_t boff = (uint32_t)(8192 + (wc * 16 * NW + fr) * 64 + ch);
  asm volatile("s_waitcnt vmcnt(0)" ::: "memory");
  __syncthreads();
#define GEMM_ISSUE(kt_)                                                                                              \
  do {                                                                                                               \
    char* nb_ = smem + ((kt_) & 3) * STG;                                                                            \
    _Pragma("unroll") for (int q = 0; q < 2; ++q) __builtin_amdgcn_global_load_lds(                                  \
        (const unsigned*)(ga[q] + (kt_) * 32),                                                                       \
        (__attribute__((address_space(3))) unsigned*)(nb_ + (wid * 2 + q) * 1024 + lane * 16), 16, 0, 0);            \
    _Pragma("unroll") for (int q = 0; q < NB; ++q) __builtin_amdgcn_global_load_lds(                                 \
        (const unsigned*)(gb[q] + (kt_) * 32),                                                                       \
        (__attribute__((address_space(3))) unsigned*)(nb_ + 8192 + (wid * NB + q) * 1024 + lane * 16), 16, 0, 0);    \
  } while (0)
  GEMM_ISSUE(0);
  if (nk > 1) GEMM_ISSUE(1);
  if (nk > 2) GEMM_ISSUE(2);
  for (int kt = 0; kt < nk; ++kt) {
    if (kt + 2 < nk) {
      if (NW == 4) asm volatile("s_waitcnt vmcnt(8)" ::: "memory");
      else asm volatile("s_waitcnt vmcnt(6)" ::: "memory");
    } else if (kt + 1 < nk) {
      if (NW == 4) asm volatile("s_waitcnt vmcnt(4)" ::: "memory");
      else asm volatile("s_waitcnt vmcnt(3)" ::: "memory");
    } else {
      asm volatile("s_waitcnt vmcnt(0)" ::: "memory");
    }
    __builtin_amdgcn_s_barrier();
    asm volatile("" ::: "memory");
    if (kt + 3 < nk) GEMM_ISSUE(kt + 3);
    const uint32_t sb = lds_base + (kt & 3) * STG;
    bf16x8 af[4], bfr[4];
    af[0] = lds_rd128<0>(sb + aoff); af[1] = lds_rd128<1024>(sb + aoff);
    af[2] = lds_rd128<2048>(sb + aoff); af[3] = lds_rd128<3072>(sb + aoff);
    bfr[0] = lds_rd128<0>(sb + boff); bfr[1] = lds_rd128<1024>(sb + boff);
    if (NW == 4) {
      bfr[2] = lds_rd128<2048>(sb + boff); bfr[3] = lds_rd128<3072>(sb + boff);
      asm volatile("s_waitcnt lgkmcnt(0)" : "+v"(af[0]), "+v"(af[1]), "+v"(af[2]), "+v"(af[3]),
                   "+v"(bfr[0]), "+v"(bfr[1]), "+v"(bfr[2]), "+v"(bfr[3]));
    } else {
      asm volatile("s_waitcnt lgkmcnt(0)" : "+v"(af[0]), "+v"(af[1]), "+v"(af[2]), "+v"(af[3]), "+v"(bfr[0]), "+v"(bfr[1]));
    }
#pragma unroll
    for (int m = 0; m < 4; ++m)
#pragma unroll
      for (int n = 0; n < NW; ++n) {
        if (SWAP) acc[m][n] = __builtin_amdgcn_mfma_f32_16x16x32_bf16(bfr[n], af[m], acc[m][n], 0, 0, 0);
        else acc[m][n] = __builtin_amdgcn_mfma_f32_16x16x32_bf16(af[m], bfr[n], acc[m][n], 0, 0, 0);
      }
  }
#undef GEMM_ISSUE
}

DEVI int launder(int x) { asm volatile("" : "+v"(x)); return x; }

template <int NW>
DEVI void zero_acc(f32x4 (&acc)[4][NW]) {
#pragma unroll
  for (int m = 0; m < 4; ++m)
#pragma unroll
    for (int n = 0; n < NW; ++n) acc[m][n] = (f32x4){0.f, 0.f, 0.f, 0.f};
}

struct NoEpi { DEVI void operator()(int, int, f32x4) const {} };

template <class EpiS, class EpiN>
DEVI void gemm_phase(int tid_, const u16* A, int lda, const u16* Bt, int ldb, int K, int M, int N, char* smem, int ns_from,
                     EpiS epiS, EpiN epiN) {
  const int nN = N >> 7, nM = M >> 7;
  const int lane = tid_ & 63, wid = tid_ >> 6;
  const int wr = wid >> 1, wc = wid & 1, fr = lane & 15, fq = lane >> 4;
  const int xcd = blockIdx.x & 7, jloc = blockIdx.x >> 3, nloc = gridDim.x >> 3;
  for (int lt = jloc; lt < (nM >> 3) * nN; lt += nloc) {
    const int tml = lt / nN, tn = lt - tml * nN;
    const int tm = tml * 8 + xcd;
    const int m0 = tm << 7, n0 = tn << 7;
    f32x4 acc[4][4];
    zero_acc(acc);
    if (n0 < ns_from) {
      gemm_kloop<4, true>(tid_, acc, A + (size_t)m0 * lda, lda, Bt + (size_t)n0 * ldb, ldb, K, smem);
#pragma unroll
      for (int m = 0; m < 4; ++m)
#pragma unroll
        for (int n = 0; n < 4; ++n) epiS(m0 + wr * 64 + m * 16 + fr, n0 + wc * 64 + n * 16 + fq * 4, acc[m][n]);
    } else {
      gemm_kloop<4, false>(tid_, acc, A + (size_t)m0 * lda, lda, Bt + (size_t)n0 * ldb, ldb, K, smem);
#pragma unroll
      for (int m = 0; m < 4; ++m)
#pragma unroll
        for (int n = 0; n < 4; ++n) epiN(m0 + wr * 64 + m * 16 + fq * 4, n0 + wc * 64 + n * 16 + fr, acc[m][n]);
    }
  }
}


template <bool SWAP>
DEVI void gemm_kloop_big(int tid_, f32x4 (&acc)[8][4], const u16* __restrict__ A, int lda, const u16* __restrict__ Bt,
                         int ldb, int K, char* smem) {
  constexpr int STG = 16384 + 8192;
  const int tid = tid_, lane = tid & 63, wid = tid >> 6;
  const int wr = wid >> 1, wc = wid & 1, fr = lane & 15, fq = lane >> 4;
  const int lrow = lane >> 2, lphys = lane & 3, lhi = lane >> 4;
  const int gsw = (4 - lhi) & 3;
  const u16* ga = A + (size_t)(wid * 64 + lrow) * lda + (lphys ^ gsw) * 8;
  const u16* gb = Bt + (size_t)(wid * 32 + lrow) * ldb + (lphys ^ gsw) * 8;
  const size_t a16 = (size_t)16 * lda, b16 = (size_t)16 * ldb;
  const int rsw = (4 - ((fr >> 2) & 3)) & 3;
  const int ch = (fq ^ rsw) * 16;
  const int nk = K >> 5;
  const uint32_t lds_base = (uint32_t)(size_t)(__attribute__((address_space(3))) char*)smem;
  const uint32_t aoff = (uint32_t)((wr * 128 + fr) * 64 + ch);
  const uint32_t boff = (uint32_t)(16384 + (wc * 64 + fr) * 64 + ch);
  asm volatile("s_waitcnt vmcnt(0)" ::: "memory");
  __syncthreads();
#define GEMMB_ISSUE(kt_, buf_)                                                                                       \
  do {                                                                                                               \
    char* nb_ = smem + (buf_) * STG;                                                                                 \
    _Pragma("unroll") for (int q = 0; q < 4; ++q) __builtin_amdgcn_global_load_lds(                                  \
        (const unsigned*)(ga + q * a16 + (kt_) * 32),                                                                \
        (__attribute__((address_space(3))) unsigned*)(nb_ + (wid * 4 + q) * 1024 + lane * 16), 16, 0, 0);            \
    _Pragma("unroll") for (int q = 0; q < 2; ++q) __builtin_amdgcn_global_load_lds(                                  \
        (const unsigned*)(gb + q * b16 + (kt_) * 32),                                                                \
        (__attribute__((address_space(3))) unsigned*)(nb_ + 16384 + (wid * 2 + q) * 1024 + lane * 16), 16, 0, 0);   \
  } while (0)
  GEMMB_ISSUE(0, 0);
  if (nk > 1) GEMMB_ISSUE(1, 1);
  int cb = 0;
  for (int kt = 0; kt < nk; ++kt) {
    if (kt + 1 < nk) asm volatile("s_waitcnt vmcnt(6)" ::: "memory");
    else asm volatile("s_waitcnt vmcnt(0)" ::: "memory");
    __builtin_amdgcn_s_barrier();
    asm volatile("" ::: "memory");
    const int nbuf = (cb == 0) ? 2 : cb - 1;
    if (kt + 2 < nk) GEMMB_ISSUE(kt + 2, nbuf);
    const uint32_t sb = lds_base + cb * STG;
    bf16x8 a0[4], a1[4], bb[4];
    a0[0] = lds_rd128<0>(sb + aoff); a0[1] = lds_rd128<1024>(sb + aoff);
    a0[2] = lds_rd128<2048>(sb + aoff); a0[3] = lds_rd128<3072>(sb + aoff);
    bb[0] = lds_rd128<0>(sb + boff); bb[1] = lds_rd128<1024>(sb + boff);
    bb[2] = lds_rd128<2048>(sb + boff); bb[3] = lds_rd128<3072>(sb + boff);
    a1[0] = lds_rd128<4096>(sb + aoff); a1[1] = lds_rd128<5120>(sb + aoff);
    a1[2] = lds_rd128<6144>(sb + aoff); a1[3] = lds_rd128<7168>(sb + aoff);
    asm volatile("s_waitcnt lgkmcnt(4)" : "+v"(a0[0]), "+v"(a0[1]), "+v"(a0[2]), "+v"(a0[3]),
                 "+v"(bb[0]), "+v"(bb[1]), "+v"(bb[2]), "+v"(bb[3]));
#pragma unroll
    for (int m = 0; m < 4; ++m)
#pragma unroll
      for (int n = 0; n < 4; ++n) {
        if (SWAP) acc[m][n] = __builtin_amdgcn_mfma_f32_16x16x32_bf16(bb[n], a0[m], acc[m][n], 0, 0, 0);
        else acc[m][n] = __builtin_amdgcn_mfma_f32_16x16x32_bf16(a0[m], bb[n], acc[m][n], 0, 0, 0);
      }
    asm volatile("s_waitcnt lgkmcnt(0)" : "+v"(a1[0]), "+v"(a1[1]), "+v"(a1[2]), "+v"(a1[3]));
#pragma unroll
    for (int m = 0; m < 4; ++m)
#pragma unroll
      for (int n = 0; n < 4; ++n) {
        if (SWAP) acc[4 + m][n] = __builtin_amdgcn_mfma_f32_16x16x32_bf16(bb[n], a1[m], acc[4 + m][n], 0, 0, 0);
        else acc[4 + m][n] = __builtin_amdgcn_mfma_f32_16x16x32_bf16(a1[m], bb[n], acc[4 + m][n], 0, 0, 0);
      }
    cb = (cb == 2) ? 0 : cb + 1;
  }
#undef GEMMB_ISSUE
}

template <class EpiS, class EpiN>
DEVI void gemm_phase_big(int tid_, const u16* A, int lda, const u16* Bt, int ldb, int K, int M, int N, char* smem,
                         int ns_from, EpiS epiS, EpiN epiN) {
  const int nN = N >> 7, nM = M >> 8;
  const int lane = tid_ & 63, wid = tid_ >> 6;
  const int wr = wid >> 1, wc = wid & 1, fr = lane & 15, fq = lane >> 4;
  const int xcd = blockIdx.x & 7, jloc = blockIdx.x >> 3, nloc = gridDim.x >> 3;
  for (int lt = jloc; lt < (nM >> 3) * nN; lt += nloc) {
    const int tml = lt / nN, tn = lt - tml * nN;
    const int tm = tml * 8 + xcd;
    const int m0 = tm << 8, n0 = tn << 7;
    f32x4 acc[8][4];
#pragma unroll
    for (int m = 0; m < 8; ++m)
#pragma unroll
      for (int n = 0; n < 4; ++n) acc[m][n] = (f32x4){0.f, 0.f, 0.f, 0.f};
    if (n0 < ns_from) {
      gemm_kloop_big<true>(launder(tid_), acc, A + (size_t)m0 * lda, lda, Bt + (size_t)n0 * ldb, ldb, K, smem);
#pragma unroll
      for (int m = 0; m < 8; ++m)
#pragma unroll
        for (int n = 0; n < 4; ++n) epiS(m0 + wr * 128 + m * 16 + fr, n0 + wc * 64 + n * 16 + fq * 4, acc[m][n]);
    } else {
      gemm_kloop_big<false>(launder(tid_), acc, A + (size_t)m0 * lda, lda, Bt + (size_t)n0 * ldb, ldb, K, smem);
#pragma unroll
      for (int m = 0; m < 8; ++m)
#pragma unroll
        for (int n = 0; n < 4; ++n) epiN(m0 + wr * 128 + m * 16 + fq * 4, n0 + wc * 64 + n * 16 + fr, acc[m][n]);
    }
  }
}


template <bool SWAP>
DEVI void gemm_kloop8(int tid_, f32x4 (&acc)[8][4], const u16* __restrict__ A, int lda, const u16* __restrict__ Bt,
                      int ldb, int K, char* smem, bool have_pref = false, const u16* An = nullptr, int lda_n = 0,
                      const u16* Bn = nullptr, int ldb_n = 0) {
  constexpr int STG = 65536;
  const int tid = tid_, lane = tid & 63, wid = tid >> 6;
  const int wr = wid >> 2, wc = wid & 3, fr = lane & 15, fq = lane >> 4;
  const int lrow = lane >> 3, lphys = lane & 7, lhi = lane >> 4;
  const u16* ga[4];
  const u16* gb[4];
#pragma unroll
  for (int q = 0; q < 4; ++q) {
    const int kc = lphys ^ ((4 * (q & 1) + lhi) & 7);
    ga[q] = A + (size_t)((wid * 4 + q) * 8 + lrow) * lda + kc * 8;
    gb[q] = Bt + (size_t)((wid * 4 + q) * 8 + lrow) * ldb + kc * 8;
  }
  const int swz = (fr >> 1) & 7;
  const int nk = K >> 6;
  const uint32_t lds_base = (uint32_t)(size_t)(__attribute__((address_space(3))) char*)smem;
  const uint32_t arow = (uint32_t)((wr * 128 + fr) * 128);
  const uint32_t brow = (uint32_t)(32768 + (wc * 64 + fr) * 128);
  if (!have_pref) {
    asm volatile("s_waitcnt vmcnt(0)" ::: "memory");
    __syncthreads();
  }
#define GEMM8_ISSUE(kt_)                                                                                             \
  do {                                                                                                               \
    char* nb_ = smem + ((kt_) & 1) * STG;                                                                            \
    _Pragma("unroll") for (int q = 0; q < 4; ++q) __builtin_amdgcn_global_load_lds(                                  \
        (const unsigned*)(ga[q] + (kt_) * 64),                                                                       \
        (__attribute__((address_space(3))) unsigned*)(nb_ + (wid * 4 + q) * 1024 + lane * 16), 16, 0, 0);            \
    _Pragma("unroll") for (int q = 0; q < 4; ++q) __builtin_amdgcn_global_load_lds(                                  \
        (const unsigned*)(gb[q] + (kt_) * 64),                                                                       \
        (__attribute__((address_space(3))) unsigned*)(nb_ + 32768 + (wid * 4 + q) * 1024 + lane * 16), 16, 0, 0);    \
  } while (0)
  if (!have_pref) GEMM8_ISSUE(0);
  for (int kt = 0; kt < nk; ++kt) {
    asm volatile("s_waitcnt vmcnt(0)" ::: "memory");
    __builtin_amdgcn_s_barrier();
    asm volatile("" ::: "memory");
    if (kt + 1 < nk) GEMM8_ISSUE(kt + 1);
    else if (An) {
#pragma unroll
      for (int q = 0; q < 4; ++q) {
        const int kc = lphys ^ ((4 * (q & 1) + lhi) & 7);
        __builtin_amdgcn_global_load_lds((const unsigned*)(An + (size_t)((wid * 4 + q) * 8 + lrow) * lda_n + kc * 8),
            (__attribute__((address_space(3))) unsigned*)(smem + (wid * 4 + q) * 1024 + lane * 16), 16, 0, 0);
        __builtin_amdgcn_global_load_lds((const unsigned*)(Bn + (size_t)((wid * 4 + q) * 8 + lrow) * ldb_n + kc * 8),
            (__attribute__((address_space(3))) unsigned*)(smem + 32768 + (wid * 4 + q) * 1024 + lane * 16), 16, 0, 0);
      }
    }
    const uint32_t sb = lds_base + (kt & 1) * STG;
#pragma unroll
    for (int ks = 0; ks < 2; ++ks) {
      const uint32_t chb = (uint32_t)(((ks * 4 + fq) ^ swz) * 16);
      const uint32_t aoff = sb + arow + chb, boff = sb + brow + chb;
      bf16x8 a0[4], a1[4], bb[4];
      a0[0] = lds_rd128<0>(aoff); a0[1] = lds_rd128<2048>(aoff);
      a0[2] = lds_rd128<4096>(aoff); a0[3] = lds_rd128<6144>(aoff);
      bb[0] = lds_rd128<0>(boff); bb[1] = lds_rd128<2048>(boff);
      bb[2] = lds_rd128<4096>(boff); bb[3] = lds_rd128<6144>(boff);
      a1[0] = lds_rd128<8192>(aoff); a1[1] = lds_rd128<10240>(aoff);
      a1[2] = lds_rd128<12288>(aoff); a1[3] = lds_rd128<14336>(aoff);
      asm volatile("s_waitcnt lgkmcnt(4)" : "+v"(a0[0]), "+v"(a0[1]), "+v"(a0[2]), "+v"(a0[3]),
                   "+v"(bb[0]), "+v"(bb[1]), "+v"(bb[2]), "+v"(bb[3]));
#pragma unroll
      for (int m = 0; m < 4; ++m)
#pragma unroll
        for (int n = 0; n < 4; ++n) {
          if (SWAP) acc[m][n] = __builtin_amdgcn_mfma_f32_16x16x32_bf16(bb[n], a0[m], acc[m][n], 0, 0, 0);
          else acc[m][n] = __builtin_amdgcn_mfma_f32_16x16x32_bf16(a0[m], bb[n], acc[m][n], 0, 0, 0);
        }
      asm volatile("s_waitcnt lgkmcnt(0)" : "+v"(a1[0]), "+v"(a1[1]), "+v"(a1[2]), "+v"(a1[3]));
#pragma unroll
      for (int m = 0; m < 4; ++m)
#pragma unroll
        for (int n = 0; n < 4; ++n) {
          if (SWAP) acc[4 + m][n] = __builtin_amdgcn_mfma_f32_16x16x32_bf16(bb[n], a1[m], acc[4 + m][n], 0, 0, 0);
          else acc[4 + m][n] = __builtin_amdgcn_mfma_f32_16x16x32_bf16(a1[m], bb[n], acc[4 + m][n], 0, 0, 0);
        }
    }
  }
#undef GEMM8_ISSUE
}

struct NoRow { DEVI void operator()(int) const {} };

template <class EpiS, class EpiN, class RowEnd = NoRow>
DEVI void gemm_phase8(int tid_, const u16* A, int lda, const u16* Bt, int ldb, int K, int M, int N, char* smem,
                      int ns_from, EpiS epiS, EpiN epiN, RowEnd rowEnd = NoRow(), int rot = 0) {
  const int nN = (N + 255) >> 8, nM = M >> 8;
  const int lane = tid_ & 63, wid = tid_ >> 6;
  const int wr = wid >> 2, wc = wid & 3, fr = lane & 15, fq = lane >> 4;
  const bool xmap = ((gridDim.x & 7) == 0) && ((nM & 7) == 0);
  const int xcd = blockIdx.x & 7;
  const int first = xmap ? (int)(blockIdx.x >> 3) : (int)((blockIdx.x + gridDim.x - rot) % gridDim.x);
  const int stride = xmap ? (int)(gridDim.x >> 3) : (int)gridDim.x;
  const int count = xmap ? (nM >> 3) * nN : nM * nN;
  bool pref = false;
  for (int it = first; it < count; it += stride) {
    const int tq = it / nN, tn = it - tq * nN;
    const int tm = xmap ? tq * 8 + xcd : tq;
    const int m0 = tm << 8, n0 = tn << 8;
    const int colb = n0 + wc * 64;
    const u16* An = nullptr; const u16* Bn = nullptr;
    if (it + stride < count) {
      const int it2 = it + stride;
      const int tq2 = it2 / nN, tn2 = it2 - tq2 * nN;
      An = A + (size_t)((xmap ? tq2 * 8 + xcd : tq2) << 8) * lda;
      Bn = Bt + (size_t)(tn2 << 8) * ldb;
    }
    f32x4 acc[8][4];
#pragma unroll
    for (int m = 0; m < 8; ++m)
#pragma unroll
      for (int n = 0; n < 4; ++n) acc[m][n] = (f32x4){0.f, 0.f, 0.f, 0.f};
    if (colb < ns_from) {
      gemm_kloop8<true>(launder(tid_), acc, A + (size_t)m0 * lda, lda, Bt + (size_t)n0 * ldb, ldb, K, smem, pref, An, lda, Bn, ldb);
      if (colb < N) {
#pragma unroll
        for (int m = 0; m < 8; ++m) {
#pragma unroll
          for (int n = 0; n < 4; ++n) epiS(m0 + wr * 128 + m * 16 + fr, colb + n * 16 + fq * 4, acc[m][n]);
          rowEnd(m0 + wr * 128 + m * 16 + fr);
        }
      }
    } else {
      gemm_kloop8<false>(launder(tid_), acc, A + (size_t)m0 * lda, lda, Bt + (size_t)n0 * ldb, ldb, K, smem, pref, An, lda, Bn, ldb);
      if (colb < N) {
#pragma unroll
        for (int m = 0; m < 8; ++m)
#pragma unroll
          for (int n = 0; n < 4; ++n) epiN(m0 + wr * 128 + m * 16 + fq * 4, colb + n * 16 + fr, acc[m][n]);
      }
    }
    pref = (An != nullptr);
  }
  asm volatile("s_waitcnt vmcnt(0)" ::: "memory");
}

DEVI void store4bf(u16* dst, f32x4 v) {
  u32x2 o;
  o.x = pack2(v[0], v[1]); o.y = pack2(v[2], v[3]);
  *(u32x2*)dst = o;
}

DEVI float rstd_of(const float* ssq, int r) { return rsqrtf(ssq[r] * (1.f / 1024.f) + 1e-6f); }

DEVI void phase_p_gemm(int tid_, const Params& p, char* smem, const float* ssq) {
  u16* WB = (u16*)(p.ws + OFF_WB);
  const u16* H = (const u16*)(p.ws + OFF_H);
  u16* PR = (u16*)(p.ws + OFF_PR);
  u16* NQ = (u16*)(p.ws + OFF_NQ);
  u16* NK = (u16*)(p.ws + OFF_NK);
  u16* NVT = (u16*)(p.ws + OFF_NV);
  gemm_phase8(tid_, H, 1024, WB + W_IN, 1024, 1024, NTOK, 3456, smem, 2944,
    [&](int r, int c0, f32x4 v) {
      v = v * rstd_of(ssq, r);
      if (c0 < 1920) store4bf(PR + (size_t)r * PRW + c0, v);
      else if (c0 < 2432) store4bf(NQ + (size_t)r * 512 + (c0 - 1920), v);
      else store4bf(NK + (size_t)r * 512 + (c0 - 2432), v);
    },
    [&](int r0, int c, f32x4 v) {
      const int cc = c - 2944;
      const int s = r0 >> 12, t = r0 & 4095;
      const f32x4 q = *(const f32x4*)(ssq + r0);
#pragma unroll
      for (int j = 0; j < 4; ++j) v[j] *= rsqrtf(q[j] * (1.f / 1024.f) + 1e-6f);
      store4bf(NVT + ((size_t)(s * 512 + cc)) * 4096 + t, v);
    });
  const u16* MH = (const u16*)(p.ws + OFF_MEMH);
  u16* KVK = (u16*)(p.ws + OFF_KVK);
  u16* KVT = (u16*)(p.ws + OFF_KVT);
  gemm_phase8(tid_, MH, 1024, WB + W_XKV, 1024, 1024, 3072, 2048, smem, 1024,
    [&](int r, int c0, f32x4 v) { store4bf(KVK + (size_t)r * 1024 + c0, v); },
    [&](int r0, int c, f32x4 v) {
      const int cc = c - 1024;
      const int s = r0 >> 8, m = r0 & 255;
      store4bf(KVT + ((size_t)(s * 1024 + cc)) * 256 + m, v);
    }, NoRow(), 128);
}

DEVI void phase_nat(int tid_, const Params& p, int l, char* smem, int bfirst, int bstride) {
  u16* NQ = (u16*)(p.ws + OFF_NQ);
  const u16* NK = (const u16*)(p.ws + OFF_NK);
  const u16* NVT = (const u16*)(p.ws + OFF_NV);
  const float* rpb = p.in[I_RPB] + (size_t)l * 8 * 15 * 31;
  const int lane = tid_ & 63, g = tid_ >> 6, fr = lane & 15, fq = lane >> 4;
  u16* Pw = (u16*)smem + g * (16 * 264);
  const int cb = (g == 0) ? 0 : (g == 1) ? 8 : (g == 2) ? 24 : 32;
  const int c = g * 16 + fr;
  int cs = c - 8; cs = cs < 0 ? 0 : (cs > 48 ? 48 : cs);
  for (int t = bfirst; t < 12 * 64 * 8; t += bstride) {
    const int h = t & 7, ri = (t >> 3) & 63, s = t >> 9;
    int rs = ri - 4; rs = rs < 0 ? 0 : (rs > 56 ? 56 : rs);
    const size_t tokq = (size_t)s * 4096 + ri * 64 + g * 16;
    bf16x8 aq[2];
    aq[0] = *(const bf16x8*)(NQ + (tokq + fr) * 512 + h * 64 + fq * 8);
    aq[1] = *(const bf16x8*)(NQ + (tokq + fr) * 512 + h * 64 + 32 + fq * 8);
    f32x4 acc[16];
#pragma unroll
    for (int n = 0; n < 16; ++n) {
      acc[n] = (f32x4){0.f, 0.f, 0.f, 0.f};
      const int r = n >> 1, col = cb + (n & 1) * 16 + fr;
      const u16* kp = NK + ((size_t)s * 4096 + (rs + r) * 64 + col) * 512 + h * 64 + fq * 8;
      const bf16x8 b0 = *(const bf16x8*)kp;
      const bf16x8 b1 = *(const bf16x8*)(kp + 32);
      acc[n] = __builtin_amdgcn_mfma_f32_16x16x32_bf16(b0, aq[0], acc[n], 0, 0, 0);
      acc[n] = __builtin_amdgcn_mfma_f32_16x16x32_bf16(b1, aq[1], acc[n], 0, 0, 0);
    }
    float m = -1e30f;
#pragma unroll
    for (int n = 0; n < 16; ++n) {
      const int di = rs + (n >> 1) - ri + 7;
      const float* brow = rpb + (h * 15 + di) * 31 + 15 - c;
#pragma unroll
      for (int j = 0; j < 4; ++j) {
        const int kc = cb + (n & 1) * 16 + fq * 4 + j;
        float sc = -1e30f;
        if (kc >= cs && kc < cs + 16) sc = acc[n][j] * 0.125f + brow[kc];
        acc[n][j] = sc;
        m = fmaxf(m, sc);
      }
    }
    m = red4x_max(m);
    float ssum = 0.f;
#pragma unroll
    for (int n = 0; n < 16; ++n) {
      f32x4 e;
#pragma unroll
      for (int j = 0; j < 4; ++j) { e[j] = __expf(acc[n][j] - m); ssum += e[j]; }
      store4bf(Pw + fr * 264 + n * 16 + fq * 4, e);
    }
    const float sm = 1.f / red4x_sum(ssum);
    f32x4 o[4];
#pragma unroll
    for (int n = 0; n < 4; ++n) o[n] = (f32x4){0.f, 0.f, 0.f, 0.f};
#pragma unroll
    for (int ks = 0; ks < 8; ++ks) {
      const bf16x8 ap = *(const bf16x8*)(Pw + fr * 264 + ks * 32 + fq * 8);
#pragma unroll
      for (int n = 0; n < 4; ++n) {
        const bf16x8 bv = *(const bf16x8*)(NVT + ((size_t)(s * 512 + h * 64 + n * 16 + fr)) * 4096 + (rs + ks) * 64 + cb + fq * 8);
        o[n] = __builtin_amdgcn_mfma_f32_16x16x32_bf16(bv, ap, o[n], 0, 0, 0);
      }
    }
#pragma unroll
    for (int n = 0; n < 4; ++n) store4bf(NQ + (tokq + fr) * 512 + h * 64 + n * 16 + fq * 4, o[n] * sm);
  }
}

constexpr int SC_OPS = 0;
constexpr int SC_VV = 40960;
constexpr int SC_WR = 49152;
constexpr int SC_AP = 57344;
constexpr int SC_TW = 65536;
constexpr int SC_AD = 70144;
constexpr int SC_NRM = 74752;
constexpr int SC_MU = 74880;
constexpr int SC_CST = 77440;

typedef __attribute__((ext_vector_type(2))) float f32x2;

template <int CTRL>
DEVI float dpp_mov(float x) {
  return __int_as_float(__builtin_amdgcn_update_dpp(0, __float_as_int(x), CTRL, 0xF, 0xF, true));
}
DEVI float red8(float x) {
  x += dpp_mov<0xB1>(x);
  x += dpp_mov<0x4E>(x);
  x += dpp_mov<0x141>(x);
  return x;
}
DEVI f32x2 lo2(f32x4 v) { return __builtin_shufflevector(v, v, 0, 1); }
DEVI f32x2 hi2(f32x4 v) { return __builtin_shufflevector(v, v, 2, 3); }

struct ScanOps {
  f32x2 a[4], w[4], b[4], k[4], r[4];
  float v0, v1;
};
DEVI void scan_load(ScanOps& o, const float* OPS, const float* VV, int nn, int jg, int i0) {
  const float* base = OPS + nn * 64 + jg * 8;
  f32x4 t0, t1;
  t0 = *(const f32x4*)(base); t1 = *(const f32x4*)(base + 4);
  o.a[0] = lo2(t0); o.a[1] = hi2(t0); o.a[2] = lo2(t1); o.a[3] = hi2(t1);
  t0 = *(const f32x4*)(base + 2048); t1 = *(const f32x4*)(base + 2048 + 4);
  o.w[0] = lo2(t0); o.w[1] = hi2(t0); o.w[2] = lo2(t1); o.w[3] = hi2(t1);
  t0 = *(const f32x4*)(base + 4096); t1 = *(const f32x4*)(base + 4096 + 4);
  o.b[0] = lo2(t0); o.b[1] = hi2(t0); o.b[2] = lo2(t1); o.b[3] = hi2(t1);
  t0 = *(const f32x4*)(base + 6144); t1 = *(const f32x4*)(base + 6144 + 4);
  o.k[0] = lo2(t0); o.k[1] = hi2(t0); o.k[2] = lo2(t1); o.k[3] = hi2(t1);
  t0 = *(const f32x4*)(base + 8192); t1 = *(const f32x4*)(base + 8192 + 4);
  o.r[0] = lo2(t0); o.r[1] = hi2(t0); o.r[2] = lo2(t1); o.r[3] = hi2(t1);
  o.v0 = VV[nn * 64 + i0];
  o.v1 = VV[nn * 64 + i0 + 8];
}
DEVI void scan_step(const ScanOps& o, f32x2 (&S0)[4], f32x2 (&S1)[4], float* YL, int nn, int jg, int i0) {
  f32x2 d0 = S0[0] * o.a[0], d0b = S0[2] * o.a[2];
  f32x2 d1 = S1[0] * o.a[0], d1b = S1[2] * o.a[2];
  d0 = S0[1] * o.a[1] + d0; d0b = S0[3] * o.a[3] + d0b;
  d1 = S1[1] * o.a[1] + d1; d1b = S1[3] * o.a[3] + d1b;
  d0 += d0b; d1 += d1b;
  const float sa0 = red8(d0.x + d0.y);
  const float sa1 = red8(d1.x + d1.y);
  f32x2 e0 = {0.f, 0.f}, e1 = {0.f, 0.f};
#pragma unroll
  for (int q = 0; q < 4; ++q) {
    const f32x2 u0 = sa0 * o.b[q] + o.v0 * o.k[q];
    const f32x2 u1 = sa1 * o.b[q] + o.v1 * o.k[q];
    S0[q] = S0[q] * o.w[q] + u0;
    S1[q] = S1[q] * o.w[q] + u1;
    e0 = S0[q] * o.r[q] + e0;
    e1 = S1[q] * o.r[q] + e1;
  }
  const float y0 = red8(e0.x + e0.y);
  const float y1 = red8(e1.x + e1.y);
  YL[nn * 64 + i0] = y0; YL[nn * 64 + i0 + 8] = y1;
}

DEVI void phase_scan(int tid_, const Params& p, int l, char* smem, int bfirst, int bstride) {
  const u16* PR = (const u16*)(p.ws + OFF_PR);
  _Float16* YF = (_Float16*)(p.ws + OFF_H);
  _Float16* YB = (_Float16*)(p.ws + OFF_H + (size_t)NTOK * 512 * 2);
  float* BON = (float*)(p.ws + OFF_BONUS);
  const u16* WB = (const u16*)(p.ws + OFF_WB);
  float* OPS = (float*)(smem + SC_OPS);
  u16* RAW = (u16*)(smem + SC_OPS);
  float* VV = (float*)(smem + SC_VV);
  float* WR = (float*)(smem + SC_WR);
  float* AP = (float*)(smem + SC_AP);
  float* YL = WR;
  u16* TWb = (u16*)(smem + SC_TW);
  u16* ADb = (u16*)(smem + SC_AD);
  float* NRM = (float*)(smem + SC_NRM);
  float* MU = (float*)(smem + SC_MU);
  float* CST = (float*)(smem + SC_CST);
  const float* mu_p = p.in[I_MU_PREV] + (size_t)l * 1920;
  const float* mu_n = p.in[I_MU_NEXT] + (size_t)l * 1920;
  const int tid = tid_, lane = tid & 63, w = tid >> 6, fr = lane & 15, fq = lane >> 4;
  const int pn = tid >> 3, j0 = (tid & 7) * 8;
  const int jg = lane & 7, i0 = w * 16 + (lane >> 3);
  const int hr = (tid >= 40) ? 1 : 0, hc = tid - hr * 40;
  for (int blk = bfirst; blk < 192; blk += bstride) {
    const int s = blk >> 4, h = (blk >> 1) & 7, d = blk & 1;
    __syncthreads();
    for (int i = tid; i < 640; i += 256) {
      const int which = (i >= 320) ? 1 : 0, c = i - which * 320;
      const int g = c >> 6, e = c & 63;
      const int col = (g < 3) ? (g * 512 + h * 64 + e) : (1536 + (g - 3) * 128 + d * 64 + e);
      MU[i] = which ? mu_n[col] : mu_p[col];
    }
    for (int i = tid; i < 320; i += 256) {
      const int which = i >> 6, e = i & 63;
      float v;
      if (which == 0) v = p.in[I_W0][(size_t)(l * 2 + d) * 512 + h * 64 + e];
      else if (which == 1) v = p.in[I_A0][(size_t)(l * 2 + d) * 512 + h * 64 + e];
      else if (which == 2) v = p.in[I_K_K][(size_t)l * 512 + h * 64 + e];
      else if (which == 3) v = p.in[I_K_A][(size_t)l * 512 + h * 64 + e];
      else v = p.in[I_R_K][(size_t)(l * 8 + h) * 64 + e];
      CST[i] = v;
    }
    bf16x8 bw[2], ba[2];
#pragma unroll
    for (int ks = 0; ks < 2; ++ks) {
      bw[ks] = *(const bf16x8*)(WB + W_WUP + (size_t)(d * 512 + h * 64 + w * 16 + fr) * 64 + ks * 32 + fq * 8);
      ba[ks] = *(const bf16x8*)(WB + W_AUP + (size_t)(d * 512 + h * 64 + w * 16 + fr) * 64 + ks * 32 + fq * 8);
    }
    _Float16* Y = d ? YB : YF;
    f32x2 S0[4], S1[4];
#pragma unroll
    for (int q = 0; q < 4; ++q) { S0[q] = (f32x2){0.f, 0.f}; S1[q] = (f32x2){0.f, 0.f}; }
    u32x4 G[5], GH;
    {
      const int t = d ? (4095 - pn) : pn;
      const size_t tok = (size_t)s * 4096 + t;
#pragma unroll
      for (int g = 0; g < 5; ++g) {
        const int col = (g < 3) ? (g * 512 + h * 64) : (1536 + (g - 3) * 128 + d * 64);
        G[g] = *(const u32x4*)(PR + tok * PRW + col + j0);
      }
      GH = (u32x4){0u, 0u, 0u, 0u};
      if (tid < 80) {
        const int tlo = d ? (4095 - 31) : 0;
        const int th = hr ? (tlo + 32) : (tlo - 1);
        const int g = hc >> 3;
        const int col = (g < 3) ? (g * 512 + h * 64) : (1536 + (g - 3) * 128 + d * 64);
        if (th >= 0 && th <= 4095) GH = *(const u32x4*)(PR + ((size_t)s * 4096 + th) * PRW + col + (hc & 7) * 8);
      }
    }
#pragma unroll 1
    for (int ch = 0; ch < 128; ++ch) {
      const int n = ch * 32 + pn;
      const int t = d ? (4095 - n) : n;
      const size_t tok = (size_t)s * 4096 + t;
      const int tlo = d ? (4095 - (ch * 32 + 31)) : (ch * 32);
      const int rrow = t - tlo + 1;
#pragma unroll
      for (int g = 0; g < 5; ++g) *(u32x4*)(RAW + rrow * 320 + g * 64 + j0) = G[g];
      if (tid < 80) *(u32x4*)(RAW + (hr ? 33 : 0) * 320 + (hc >> 3) * 64 + (hc & 7) * 8) = GH;
      __syncthreads();
      if (ch + 1 < 128) {
        const int n2 = n + 32;
        const int t2 = d ? (4095 - n2) : n2;
        const size_t tok2 = (size_t)s * 4096 + t2;
#pragma unroll
        for (int g = 0; g < 5; ++g) {
          const int col = (g < 3) ? (g * 512 + h * 64) : (1536 + (g - 3) * 128 + d * 64);
          G[g] = *(const u32x4*)(PR + tok2 * PRW + col + j0);
        }
        GH = (u32x4){0u, 0u, 0u, 0u};
        if (tid < 80) {
          const int tlo2 = d ? (tlo - 32) : (tlo + 32);
          const int th = hr ? (tlo2 + 32) : (tlo2 - 1);
          const int g = hc >> 3;
          const int col = (g < 3) ? (g * 512 + h * 64) : (1536 + (g - 3) * 128 + d * 64);
          if (th >= 0 && th <= 4095) GH = *(const u32x4*)(PR + ((size_t)s * 4096 + th) * PRW + col + (hc & 7) * 8);
        }
      }
#pragma unroll
      for (int g = 0; g < 5; ++g) {
        float cur[8], prv[8], nxt[8];
        load8bf(RAW + rrow * 320 + g * 64 + j0, cur);
        load8bf(RAW + (rrow - 1) * 320 + g * 64 + j0, prv);
        load8bf(RAW + (rrow + 1) * 320 + g * 64 + j0, nxt);
        const f32x4 mp0 = *(const f32x4*)(MU + g * 64 + j0), mp1 = *(const f32x4*)(MU + g * 64 + j0 + 4);
        const f32x4 mn0 = *(const f32x4*)(MU + 320 + g * 64 + j0), mn1 = *(const f32x4*)(MU + 320 + g * 64 + j0 + 4);
        f32x4 x0, x1;
#pragma unroll
        for (int e = 0; e < 4; ++e) {
          x0[e] = cur[e] + mp0[e] * (prv[e] - cur[e]) + mn0[e] * (nxt[e] - cur[e]);
          x1[e] = cur[4 + e] + mp1[e] * (prv[4 + e] - cur[4 + e]) + mn1[e] * (nxt[4 + e] - cur[4 + e]);
        }
        if (g == 0) {
          *(f32x4*)(OPS + 4 * 2048 + pn * 64 + j0) = x0; *(f32x4*)(OPS + 4 * 2048 + pn * 64 + j0 + 4) = x1;
        } else if (g == 1) {
          *(f32x4*)(OPS + 3 * 2048 + pn * 64 + j0) = x0; *(f32x4*)(OPS + 3 * 2048 + pn * 64 + j0 + 4) = x1;
          const f32x4 kk0 = *(const f32x4*)(CST + 128 + j0), kk1 = *(const f32x4*)(CST + 128 + j0 + 4);
          float ss = 0.f;
#pragma unroll
          for (int e = 0; e < 4; ++e) { const float a_ = x0[e] * kk0[e], b_ = x1[e] * kk1[e]; ss += a_ * a_ + b_ * b_; }
          ss = red8(ss);
          if ((tid & 7) == 0) NRM[pn] = frcp(fmaxf(__builtin_amdgcn_sqrtf(ss), 1e-12f));
        } else if (g == 2) {
          *(f32x4*)(VV + pn * 64 + j0) = x0; *(f32x4*)(VV + pn * 64 + j0 + 4) = x1;
        } else if (g == 3) {
          u32x4 pk;
          pk.x = pack2(ftanh(x0[0]), ftanh(x0[1])); pk.y = pack2(ftanh(x0[2]), ftanh(x0[3]));
          pk.z = pack2(ftanh(x1[0]), ftanh(x1[1])); pk.w = pack2(ftanh(x1[2]), ftanh(x1[3]));
          *(u32x4*)(TWb + pn * 72 + j0) = pk;
        } else {
          u32x4 pk;
          pk.x = pack2(x0[0], x0[1]); pk.y = pack2(x0[2], x0[3]);
          pk.z = pack2(x1[0], x1[1]); pk.w = pack2(x1[2], x1[3]);
          *(u32x4*)(ADb + pn * 72 + j0) = pk;
        }
      }
      __syncthreads();
#pragma unroll
      for (int m = 0; m < 2; ++m) {
        f32x4 cw = {0.f, 0.f, 0.f, 0.f}, ca = {0.f, 0.f, 0.f, 0.f};
#pragma unroll
        for (int ks = 0; ks < 2; ++ks) {
          const bf16x8 aw = *(const bf16x8*)(TWb + (m * 16 + fr) * 72 + ks * 32 + fq * 8);
          const bf16x8 aa = *(const bf16x8*)(ADb + (m * 16 + fr) * 72 + ks * 32 + fq * 8);
          cw = __builtin_amdgcn_mfma_f32_16x16x32_bf16(aw, bw[ks], cw, 0, 0, 0);
          ca = __builtin_amdgcn_mfma_f32_16x16x32_bf16(aa, ba[ks], ca, 0, 0, 0);
        }
#pragma unroll
        for (int jj = 0; jj < 4; ++jj) {
          WR[(m * 16 + fq * 4 + jj) * 64 + w * 16 + fr] = cw[jj];
          AP[(m * 16 + fq * 4 + jj) * 64 + w * 16 + fr] = ca[jj];
        }
      }
      __syncthreads();
      {
        const float inv = NRM[pn];
        float bsum = 0.f;
#pragma unroll
        for (int hq = 0; hq < 2; ++hq) {
          const int jb = j0 + hq * 4;
          const f32x4 wr_ = *(const f32x4*)(WR + pn * 64 + jb) + *(const f32x4*)(CST + jb);
          const f32x4 ap_ = *(const f32x4*)(AP + pn * 64 + jb) + *(const f32x4*)(CST + 64 + jb);
          const f32x4 kr = *(const f32x4*)(OPS + 3 * 2048 + pn * 64 + jb);
          const f32x4 rr = *(const f32x4*)(OPS + 4 * 2048 + pn * 64 + jb);
          const f32x4 kkw = *(const f32x4*)(CST + 128 + jb), kaw = *(const f32x4*)(CST + 192 + jb), rkw = *(const f32x4*)(CST + 256 + jb);
          f32x4 o0, o1, o2, o3;
#pragma unroll
          for (int e = 0; e < 4; ++e) {
            const float sw = sigm(wr_[e]);
            const float dec = __expf(-0.6065306597126334f * sw);
            const float av = sigm(ap_[e]);
            const float kn = kr[e] * kkw[e] * inv;
            const float kd = kr[e] * (1.f + (av - 1.f) * kaw[e]);
            bsum += rr[e] * kd * rkw[e];
            o0[e] = -kn; o1[e] = dec; o2[e] = kn * av; o3[e] = kd;
          }
          *(f32x4*)(OPS + 0 * 2048 + pn * 64 + jb) = o0;
          *(f32x4*)(OPS + 1 * 2048 + pn * 64 + jb) = o1;
          *(f32x4*)(OPS + 2 * 2048 + pn * 64 + jb) = o2;
          *(f32x4*)(OPS + 3 * 2048 + pn * 64 + jb) = o3;
        }
        bsum = red8(bsum);
        if ((tid & 7) == 0) BON[(tok * 8 + h) * 2 + d] = bsum;
      }
      __syncthreads();
      {
        ScanOps oa, ob;
        scan_load(oa, OPS, VV, 0, jg, i0);
#pragma unroll 1
        for (int nn = 0; nn < 32; nn += 2) {
          scan_load(ob, OPS, VV, nn + 1, jg, i0);
          scan_step(oa, S0, S1, YL, nn, jg, i0);
          scan_load(oa, OPS, VV, (nn + 2) & 31, jg, i0);
          scan_step(ob, S0, S1, YL, nn + 1, jg, i0);
        }
      }
      __syncthreads();
      {
        h16x8 o;
#pragma unroll
        for (int e = 0; e < 8; ++e) o[e] = (_Float16)YL[pn * 64 + j0 + e];
        *(h16x8*)(Y + tok * 512 + h * 64 + j0) = o;
      }
    }
    __syncthreads();
  }
}

struct ScanOps1 {
  f32x2 a[4], w[4], b[4], k[4], r[4];
  float v0;
};
DEVI void scan_load1(ScanOps1& o, const float* OPS, const float* VV, int nn, int jg, int i0) {
  const float* base = OPS + nn * 64 + jg * 8;
  f32x4 t0, t1;
  t0 = *(const f32x4*)(base); t1 = *(const f32x4*)(base + 4);
  o.a[0] = lo2(t0); o.a[1] = hi2(t0); o.a[2] = lo2(t1); o.a[3] = hi2(t1);
  t0 = *(const f32x4*)(base + 2048); t1 = *(const f32x4*)(base + 2048 + 4);
  o.w[0] = lo2(t0); o.w[1] = hi2(t0); o.w[2] = lo2(t1); o.w[3] = hi2(t1);
  t0 = *(const f32x4*)(base + 4096); t1 = *(const f32x4*)(base + 4096 + 4);
  o.b[0] = lo2(t0); o.b[1] = hi2(t0); o.b[2] = lo2(t1); o.b[3] = hi2(t1);
  t0 = *(const f32x4*)(base + 6144); t1 = *(const f32x4*)(base + 6144 + 4);
  o.k[0] = lo2(t0); o.k[1] = hi2(t0); o.k[2] = lo2(t1); o.k[3] = hi2(t1);
  t0 = *(const f32x4*)(base + 8192); t1 = *(const f32x4*)(base + 8192 + 4);
  o.r[0] = lo2(t0); o.r[1] = hi2(t0); o.r[2] = lo2(t1); o.r[3] = hi2(t1);
  o.v0 = VV[nn * 64 + i0];
}
DEVI void scan_step1(const ScanOps1& o, f32x2 (&S0)[4], float* YL, int nn, int jg, int i0) {
  f32x2 d0 = S0[0] * o.a[0], d0b = S0[2] * o.a[2];
  d0 = S0[1] * o.a[1] + d0; d0b = S0[3] * o.a[3] + d0b;
  d0 += d0b;
  const float sa0 = red8(d0.x + d0.y);
  f32x2 e0 = {0.f, 0.f};
#pragma unroll
  for (int q = 0; q < 4; ++q) {
    const f32x2 u0 = sa0 * o.b[q] + o.v0 * o.k[q];
    S0[q] = S0[q] * o.w[q] + u0;
    e0 = S0[q] * o.r[q] + e0;
  }
  const float y0 = red8(e0.x + e0.y);
  if (jg == 0) YL[nn * 64 + i0] = y0;
}
DEVI float red16d(float x) {
  x += dpp_mov<0xB1>(x);
  x += dpp_mov<0x4E>(x);
  x += dpp_mov<0x141>(x);
  x += dpp_mov<0x140>(x);
  return x;
}
DEVI void unpack4(u32x2 u, float* o) {
  o[0] = __uint_as_float(u.x << 16); o[1] = __uint_as_float(u.x & 0xffff0000u);
  o[2] = __uint_as_float(u.y << 16); o[3] = __uint_as_float(u.y & 0xffff0000u);
}

DEVI void phase_scan8(int tid_, const Params& p, int l, char* smem, int bfirst, int bstride) {
  const u16* PR = (const u16*)(p.ws + OFF_PR);
  _Float16* YF = (_Float16*)(p.ws + OFF_H);
  _Float16* YB = (_Float16*)(p.ws + OFF_H + (size_t)NTOK * 512 * 2);
  float* BON = (float*)(p.ws + OFF_BONUS);
  const u16* WB = (const u16*)(p.ws + OFF_WB);
  float* OPS = (float*)(smem + SC_OPS);
  u16* RAW = (u16*)(smem + SC_OPS);
  float* VV = (float*)(smem + SC_VV);
  float* WR = (float*)(smem + SC_WR);
  float* AP = (float*)(smem + SC_AP);
  float* YL = WR;
  u16* TWb = (u16*)(smem + SC_TW);
  u16* ADb = (u16*)(smem + SC_AD);
  float* NRM = (float*)(smem + SC_NRM);
  float* MU = (float*)(smem + SC_MU);
  float* CST = (float*)(smem + SC_CST);
  const float* mu_p = p.in[I_MU_PREV] + (size_t)l * 1920;
  const float* mu_n = p.in[I_MU_NEXT] + (size_t)l * 1920;
  const int tid = tid_, lane = tid & 63, w = tid >> 6, fr = lane & 15, fq = lane >> 4;
  const int pn = tid >> 4, j0 = (tid & 15) * 4;
  const int jg = lane & 7, i0 = w * 8 + (lane >> 3);
  const int hr = (tid >= 80) ? 1 : 0, hc = tid - hr * 80;
  const int wm = w >> 2, wn = w & 3;
  for (int blk = bfirst; blk < 192; blk += bstride) {
    const int s = blk >> 4, h = (blk >> 1) & 7, d = blk & 1;
    __syncthreads();
    for (int i = tid; i < 640; i += 512) {
      const int which = (i >= 320) ? 1 : 0, c = i - which * 320;
      const int g = c >> 6, e = c & 63;
      const int col = (g < 3) ? (g * 512 + h * 64 + e) : (1536 + (g - 3) * 128 + d * 64 + e);
      MU[i] = which ? mu_n[col] : mu_p[col];
    }
    if (tid < 320) {
      const int which = tid >> 6, e = tid & 63;
      float v;
      if (which == 0) v = p.in[I_W0][(size_t)(l * 2 + d) * 512 + h * 64 + e];
      else if (which == 1) v = p.in[I_A0][(size_t)(l * 2 + d) * 512 + h * 64 + e];
      else if (which == 2) v = p.in[I_K_K][(size_t)l * 512 + h * 64 + e];
      else if (which == 3) v = p.in[I_K_A][(size_t)l * 512 + h * 64 + e];
      else v = p.in[I_R_K][(size_t)(l * 8 + h) * 64 + e];
      CST[tid] = v;
    }
    bf16x8 bw[2], ba[2];
#pragma unroll
    for (int ks = 0; ks < 2; ++ks) {
      bw[ks] = *(const bf16x8*)(WB + W_WUP + (size_t)(d * 512 + h * 64 + wn * 16 + fr) * 64 + ks * 32 + fq * 8);
      ba[ks] = *(const bf16x8*)(WB + W_AUP + (size_t)(d * 512 + h * 64 + wn * 16 + fr) * 64 + ks * 32 + fq * 8);
    }
    _Float16* Y = d ? YB : YF;
    f32x2 S0[4];
#pragma unroll
    for (int q = 0; q < 4; ++q) S0[q] = (f32x2){0.f, 0.f};
    u32x2 G[5], GH;
    {
      const int t = d ? (4095 - pn) : pn;
      const size_t tok = (size_t)s * 4096 + t;
#pragma unroll
      for (int g = 0; g < 5; ++g) {
        const int col = (g < 3) ? (g * 512 + h * 64) : (1536 + (g - 3) * 128 + d * 64);
        G[g] = *(const u32x2*)(PR + tok * PRW + col + j0);
      }
      GH = (u32x2){0u, 0u};
      if (tid < 160) {
        const int tlo = d ? (4095 - 31) : 0;
        const int th = hr ? (tlo + 32) : (tlo - 1);
        const int g = hc >> 4;
        const int col = (g < 3) ? (g * 512 + h * 64) : (1536 + (g - 3) * 128 + d * 64);
        if (th >= 0 && th <= 4095) GH = *(const u32x2*)(PR + ((size_t)s * 4096 + th) * PRW + col + (hc & 15) * 4);
      }
    }
#pragma unroll 1
    for (int ch = 0; ch < 128; ++ch) {
      const int n = ch * 32 + pn;
      const int t = d ? (4095 - n) : n;
      const size_t tok = (size_t)s * 4096 + t;
      const int tlo = d ? (4095 - (ch * 32 + 31)) : (ch * 32);
      const int rrow = t - tlo + 1;
#pragma unroll
      for (int g = 0; g < 5; ++g) *(u32x2*)(RAW + rrow * 320 + g * 64 + j0) = G[g];
      if (tid < 160) *(u32x2*)(RAW + (hr ? 33 : 0) * 320 + (hc >> 4) * 64 + (hc & 15) * 4) = GH;
      __syncthreads();
      if (ch + 1 < 128) {
        const int n2 = n + 32;
        const int t2 = d ? (4095 - n2) : n2;
        const size_t tok2 = (size_t)s * 4096 + t2;
#pragma unroll
        for (int g = 0; g < 5; ++g) {
          const int col = (g < 3) ? (g * 512 + h * 64) : (1536 + (g - 3) * 128 + d * 64);
          G[g] = *(const u32x2*)(PR + tok2 * PRW + col + j0);
        }
        GH = (u32x2){0u, 0u};
        if (tid < 160) {
          const int tlo2 = d ? (tlo - 32) : (tlo + 32);
          const int th = hr ? (tlo2 + 32) : (tlo2 - 1);
          const int g = hc >> 4;
          const int col = (g < 3) ? (g * 512 + h * 64) : (1536 + (g - 3) * 128 + d * 64);
          if (th >= 0 && th <= 4095) GH = *(const u32x2*)(PR + ((size_t)s * 4096 + th) * PRW + col + (hc & 15) * 4);
        }
      }
#pragma unroll
      for (int g = 0; g < 5; ++g) {
        float cur[4], prv[4], nxt[4];
        unpack4(*(const u32x2*)(RAW + rrow * 320 + g * 64 + j0), cur);
        unpack4(*(const u32x2*)(RAW + (rrow - 1) * 320 + g * 64 + j0), prv);
        unpack4(*(const u32x2*)(RAW + (rrow + 1) * 320 + g * 64 + j0), nxt);
        const f32x4 mp0 = *(const f32x4*)(MU + g * 64 + j0);
        const f32x4 mn0 = *(const f32x4*)(MU + 320 + g * 64 + j0);
        f32x4 x0;
#pragma unroll
        for (int e = 0; e < 4; ++e) x0[e] = cur[e] + mp0[e] * (prv[e] - cur[e]) + mn0[e] * (nxt[e] - cur[e]);
        if (g == 0) {
          *(f32x4*)(OPS + 4 * 2048 + pn * 64 + j0) = x0;
        } else if (g == 1) {
          *(f32x4*)(OPS + 3 * 2048 + pn * 64 + j0) = x0;
          const f32x4 kk0 = *(const f32x4*)(CST + 128 + j0);
          float ss = 0.f;
#pragma unroll
          for (int e = 0; e < 4; ++e) { const float a_ = x0[e] * kk0[e]; ss += a_ * a_; }
          ss = red16d(ss);
          if ((tid & 15) == 0) NRM[pn] = frcp(fmaxf(__builtin_amdgcn_sqrtf(ss), 1e-12f));
        } else if (g == 2) {
          *(f32x4*)(VV + pn * 64 + j0) = x0;
        } else if (g == 3) {
          u32x2 pk;
          pk.x = pack2(ftanh(x0[0]), ftanh(x0[1])); pk.y = pack2(ftanh(x0[2]), ftanh(x0[3]));
          *(u32x2*)(TWb + pn * 72 + j0) = pk;
        } else {
          u32x2 pk;
          pk.x = pack2(x0[0], x0[1]); pk.y = pack2(x0[2], x0[3]);
          *(u32x2*)(ADb + pn * 72 + j0) = pk;
        }
      }
      __syncthreads();
      {
        f32x4 cw = {0.f, 0.f, 0.f, 0.f}, ca = {0.f, 0.f, 0.f, 0.f};
#pragma unroll
        for (int ks = 0; ks < 2; ++ks) {
          const bf16x8 aw = *(const bf16x8*)(TWb + (wm * 16 + fr) * 72 + ks * 32 + fq * 8);
          const bf16x8 aa = *(const bf16x8*)(ADb + (wm * 16 + fr) * 72 + ks * 32 + fq * 8);
          cw = __builtin_amdgcn_mfma_f32_16x16x32_bf16(aw, bw[ks], cw, 0, 0, 0);
          ca = __builtin_amdgcn_mfma_f32_16x16x32_bf16(aa, ba[ks], ca, 0, 0, 0);
        }
#pragma unroll
        for (int jj = 0; jj < 4; ++jj) {
          WR[(wm * 16 + fq * 4 + jj) * 64 + wn * 16 + fr] = cw[jj];
          AP[(wm * 16 + fq * 4 + jj) * 64 + wn * 16 + fr] = ca[jj];
        }
      }
      __syncthreads();
      {
        const float inv = NRM[pn];
        float bsum = 0.f;
        const f32x4 wr_ = *(const f32x4*)(WR + pn * 64 + j0) + *(const f32x4*)(CST + j0);
        const f32x4 ap_ = *(const f32x4*)(AP + pn * 64 + j0) + *(const f32x4*)(CST + 64 + j0);
        const f32x4 kr = *(const f32x4*)(OPS + 3 * 2048 + pn * 64 + j0);
        const f32x4 rr = *(const f32x4*)(OPS + 4 * 2048 + pn * 64 + j0);
        const f32x4 kkw = *(const f32x4*)(CST + 128 + j0), kaw = *(const f32x4*)(CST + 192 + j0), rkw = *(const f32x4*)(CST + 256 + j0);
        f32x4 o0, o1, o2, o3;
#pragma unroll
        for (int e = 0; e < 4; ++e) {
          const float sw = sigm(wr_[e]);
          const float dec = __expf(-0.6065306597126334f * sw);
          const float av = sigm(ap_[e]);
          const float kn = kr[e] * kkw[e] * inv;
          const float kd = kr[e] * (1.f + (av - 1.f) * kaw[e]);
          bsum += rr[e] * kd * rkw[e];
          o0[e] = -kn; o1[e] = dec; o2[e] = kn * av; o3[e] = kd;
        }
        *(f32x4*)(OPS + 0 * 2048 + pn * 64 + j0) = o0;
        *(f32x4*)(OPS + 1 * 2048 + pn * 64 + j0) = o1;
        *(f32x4*)(OPS + 2 * 2048 + pn * 64 + j0) = o2;
        *(f32x4*)(OPS + 3 * 2048 + pn * 64 + j0) = o3;
        bsum = red16d(bsum);
        if ((tid & 15) == 0) BON[(tok * 8 + h) * 2 + d] = bsum;
      }
      __syncthreads();
      {
        ScanOps1 oa, ob;
        scan_load1(oa, OPS, VV, 0, jg, i0);
#pragma unroll 1
        for (int nn = 0; nn < 32; nn += 2) {
          scan_load1(ob, OPS, VV, nn + 1, jg, i0);
          scan_step1(oa, S0, YL, nn, jg, i0);
          scan_load1(oa, OPS, VV, (nn + 2) & 31, jg, i0);
          scan_step1(ob, S0, YL, nn + 1, jg, i0);
        }
      }
      __syncthreads();
      {
        typedef __attribute__((ext_vector_type(4))) _Float16 h16x4;
        h16x4 o;
#pragma unroll
        for (int e = 0; e < 4; ++e) o[e] = (_Float16)YL[pn * 64 + j0 + e];
        *(h16x4*)(Y + tok * 512 + h * 64 + j0) = o;
      }
    }
    __syncthreads();
  }
}

constexpr int PC_OPS = 0;
constexpr int PC_BUF = 49152;
constexpr int PC_RAW = 98304;
constexpr int PC_WR = 98304;
constexpr int PC_AP = 106496;
constexpr int PC_TW = 120064;
constexpr int PC_AD = 124672;
constexpr int PC_NRM = 129280;
constexpr int PC_MU = 129408;
constexpr int PC_CST = 131968;
constexpr int PC_YL = 133248;

DEVI void phase_scan_pc(int tid_, const Params& p, int l, char* smem, int bfirst, int bstride) {
  const u16* PR = (const u16*)(p.ws + OFF_PR);
  _Float16* YF = (_Float16*)(p.ws + OFF_H);
  _Float16* YB = (_Float16*)(p.ws + OFF_H + (size_t)NTOK * 512 * 2);
  float* BON = (float*)(p.ws + OFF_BONUS);
  const u16* WB = (const u16*)(p.ws + OFF_WB);
  u16* RAW = (u16*)(smem + PC_RAW);
  float* WR = (float*)(smem + PC_WR);
  float* AP = (float*)(smem + PC_AP);
  u16* TWb = (u16*)(smem + PC_TW);
  u16* ADb = (u16*)(smem + PC_AD);
  float* NRM = (float*)(smem + PC_NRM);
  float* MU = (float*)(smem + PC_MU);
  float* CST = (float*)(smem + PC_CST);
  const float* mu_p = p.in[I_MU_PREV] + (size_t)l * 1920;
  const float* mu_n = p.in[I_MU_NEXT] + (size_t)l * 1920;
  const bool is_prep = tid_ >= 256;
  const int tid = tid_ & 255, lane = tid & 63, w = tid >> 6, fr = lane & 15, fq = lane >> 4;
  const int pn = tid >> 3, j0 = (tid & 7) * 8;
  const int jg = lane & 7, i0 = w * 16 + (lane >> 3);
  const int hr = (tid >= 40) ? 1 : 0, hc = tid - hr * 40;
  for (int blk = bfirst; blk < 192; blk += bstride) {
    const int s = blk >> 4, h = (blk >> 1) & 7, d = blk & 1;
    __syncthreads();
    for (int i = tid_; i < 640; i += 512) {
      const int which = (i >= 320) ? 1 : 0, c = i - which * 320;
      const int g = c >> 6, e = c & 63;
      const int col = (g < 3) ? (g * 512 + h * 64 + e) : (1536 + (g - 3) * 128 + d * 64 + e);
      MU[i] = which ? mu_n[col] : mu_p[col];
    }
    if (tid_ < 320) {
      const int which = tid_ >> 6, e = tid_ & 63;
      float v;
      if (which == 0) v = p.in[I_W0][(size_t)(l * 2 + d) * 512 + h * 64 + e];
      else if (which == 1) v = p.in[I_A0][(size_t)(l * 2 + d) * 512 + h * 64 + e];
      else if (which == 2) v = p.in[I_K_K][(size_t)l * 512 + h * 64 + e];
      else if (which == 3) v = p.in[I_K_A][(size_t)l * 512 + h * 64 + e];
      else v = p.in[I_R_K][(size_t)(l * 8 + h) * 64 + e];
      CST[tid_] = v;
    }
    _Float16* Y = d ? YB : YF;
    if (is_prep) {
      bf16x8 bw[2], ba[2];
#pragma unroll
      for (int ks = 0; ks < 2; ++ks) {
        bw[ks] = *(const bf16x8*)(WB + W_WUP + (size_t)(d * 512 + h * 64 + w * 16 + fr) * 64 + ks * 32 + fq * 8);
        ba[ks] = *(const bf16x8*)(WB + W_AUP + (size_t)(d * 512 + h * 64 + w * 16 + fr) * 64 + ks * 32 + fq * 8);
      }
      u32x4 G[5], GH;
      {
        const int t = d ? (4095 - pn) : pn;
        const size_t tok = (size_t)s * 4096 + t;
#pragma unroll
        for (int g = 0; g < 5; ++g) {
          const int col = (g < 3) ? (g * 512 + h * 64) : (1536 + (g - 3) * 128 + d * 64);
          G[g] = *(const u32x4*)(PR + tok * PRW + col + j0);
        }
        GH = (u32x4){0u, 0u, 0u, 0u};
        if (tid < 80) {
          const int tlo = d ? (4095 - 31) : 0;
          const int th = hr ? (tlo + 32) : (tlo - 1);
          const int g = hc >> 3;
          const int col = (g < 3) ? (g * 512 + h * 64) : (1536 + (g - 3) * 128 + d * 64);
          if (th >= 0 && th <= 4095) GH = *(const u32x4*)(PR + ((size_t)s * 4096 + th) * PRW + col + (hc & 7) * 8);
        }
      }
#pragma unroll 1
      for (int ch = -1; ch < 128; ++ch) {
        const int c = ch + 1;
        const bool doprep = c < 128;
        float* OPS = (float*)(smem + PC_OPS + (c & 1) * PC_BUF);
        float* VV = OPS + 5 * 2048;
        const int n = c * 32 + pn;
        const int t = d ? (4095 - n) : n;
        const size_t tok = (size_t)s * 4096 + t;
        const int tlo = d ? (4095 - (c * 32 + 31)) : (c * 32);
        const int rrow = t - tlo + 1;
        __syncthreads();
        if (ch >= 1) {
          const float* YL = (const float*)(smem + PC_YL + ((ch - 1) & 1) * 8192);
          const int n1 = (ch - 1) * 32 + pn;
          const int t1 = d ? (4095 - n1) : n1;
          h16x8 o;
#pragma unroll
          for (int e = 0; e < 8; ++e) o[e] = (_Float16)YL[pn * 64 + j0 + e];
          *(h16x8*)(Y + ((size_t)s * 4096 + t1) * 512 + h * 64 + j0) = o;
        }
        if (doprep) {
#pragma unroll
          for (int g = 0; g < 5; ++g) *(u32x4*)(RAW + rrow * 320 + g * 64 + j0) = G[g];
          if (tid < 80) *(u32x4*)(RAW + (hr ? 33 : 0) * 320 + (hc >> 3) * 64 + (hc & 7) * 8) = GH;
        }
        __syncthreads();
        if (doprep) {
          if (c + 1 < 128) {
            const int n2 = n + 32;
            const int t2 = d ? (4095 - n2) : n2;
            const size_t tok2 = (size_t)s * 4096 + t2;
#pragma unroll
            for (int g = 0; g < 5; ++g) {
              const int col = (g < 3) ? (g * 512 + h * 64) : (1536 + (g - 3) * 128 + d * 64);
              G[g] = *(const u32x4*)(PR + tok2 * PRW + col + j0);
            }
            GH = (u32x4){0u, 0u, 0u, 0u};
            if (tid < 80) {
              const int tlo2 = d ? (tlo - 32) : (tlo + 32);
              const int th = hr ? (tlo2 + 32) : (tlo2 - 1);
              const int g = hc >> 3;
              const int col = (g < 3) ? (g * 512 + h * 64) : (1536 + (g - 3) * 128 + d * 64);
              if (th >= 0 && th <= 4095) GH = *(const u32x4*)(PR + ((size_t)s * 4096 + th) * PRW + col + (hc & 7) * 8);
            }
          }
#pragma unroll
          for (int g = 0; g < 5; ++g) {
            float cur[8], prv[8], nxt[8];
            load8bf(RAW + rrow * 320 + g * 64 + j0, cur);
            load8bf(RAW + (rrow - 1) * 320 + g * 64 + j0, prv);
            load8bf(RAW + (rrow + 1) * 320 + g * 64 + j0, nxt);
            const f32x4 mp0 = *(const f32x4*)(MU + g * 64 + j0), mp1 = *(const f32x4*)(MU + g * 64 + j0 + 4);
            const f32x4 mn0 = *(const f32x4*)(MU + 320 + g * 64 + j0), mn1 = *(const f32x4*)(MU + 320 + g * 64 + j0 + 4);
            f32x4 x0, x1;
#pragma unroll
            for (int e = 0; e < 4; ++e) {
              x0[e] = cur[e] + mp0[e] * (prv[e] - cur[e]) + mn0[e] * (nxt[e] - cur[e]);
              x1[e] = cur[4 + e] + mp1[e] * (prv[4 + e] - cur[4 + e]) + mn1[e] * (nxt[4 + e] - cur[4 + e]);
            }
            if (g == 0) {
              *(f32x4*)(OPS + 4 * 2048 + pn * 64 + j0) = x0; *(f32x4*)(OPS + 4 * 2048 + pn * 64 + j0 + 4) = x1;
            } else if (g == 1) {
              *(f32x4*)(OPS + 3 * 2048 + pn * 64 + j0) = x0; *(f32x4*)(OPS + 3 * 2048 + pn * 64 + j0 + 4) = x1;
              const f32x4 kk0 = *(const f32x4*)(CST + 128 + j0), kk1 = *(const f32x4*)(CST + 128 + j0 + 4);
              float ss = 0.f;
#pragma unroll
              for (int e = 0; e < 4; ++e) { const float a_ = x0[e] * kk0[e], b_ = x1[e] * kk1[e]; ss += a_ * a_ + b_ * b_; }
              ss = red8(ss);
              if ((tid & 7) == 0) NRM[pn] = frcp(fmaxf(__builtin_amdgcn_sqrtf(ss), 1e-12f));
            } else if (g == 2) {
              *(f32x4*)(VV + pn * 64 + j0) = x0; *(f32x4*)(VV + pn * 64 + j0 + 4) = x1;
            } else if (g == 3) {
              u32x4 pk;
              pk.x = pack2(ftanh(x0[0]), ftanh(x0[1])); pk.y = pack2(ftanh(x0[2]), ftanh(x0[3]));
              pk.z = pack2(ftanh(x1[0]), ftanh(x1[1])); pk.w = pack2(ftanh(x1[2]), ftanh(x1[3]));
              *(u32x4*)(TWb + pn * 72 + j0) = pk;
            } else {
              u32x4 pk;
              pk.x = pack2(x0[0], x0[1]); pk.y = pack2(x0[2], x0[3]);
              pk.z = pack2(x1[0], x1[1]); pk.w = pack2(x1[2], x1[3]);
              *(u32x4*)(ADb + pn * 72 + j0) = pk;
            }
          }
        }
        __syncthreads();
        if (doprep) {
#pragma unroll
          for (int m = 0; m < 2; ++m) {
            f32x4 cw = {0.f, 0.f, 0.f, 0.f}, ca = {0.f, 0.f, 0.f, 0.f};
#pragma unroll
            for (int ks = 0; ks < 2; ++ks) {
              const bf16x8 aw = *(const bf16x8*)(TWb + (m * 16 + fr) * 72 + ks * 32 + fq * 8);
              const bf16x8 aa = *(const bf16x8*)(ADb + (m * 16 + fr) * 72 + ks * 32 + fq * 8);
              cw = __builtin_amdgcn_mfma_f32_16x16x32_bf16(aw, bw[ks], cw, 0, 0, 0);
              ca = __builtin_amdgcn_mfma_f32_16x16x32_bf16(aa, ba[ks], ca, 0, 0, 0);
            }
#pragma unroll
            for (int jj = 0; jj < 4; ++jj) {
              WR[(m * 16 + fq * 4 + jj) * 64 + w * 16 + fr] = cw[jj];
              AP[(m * 16 + fq * 4 + jj) * 64 + w * 16 + fr] = ca[jj];
            }
          }
        }
        __syncthreads();
        if (doprep) {
          const float inv = NRM[pn];
          float bsum = 0.f;
#pragma unroll
          for (int hq = 0; hq < 2; ++hq) {
            const int jb = j0 + hq * 4;
            const f32x4 wr_ = *(const f32x4*)(WR + pn * 64 + jb) + *(const f32x4*)(CST + jb);
            const f32x4 ap_ = *(const f32x4*)(AP + pn * 64 + jb) + *(const f32x4*)(CST + 64 + jb);
            const f32x4 kr = *(const f32x4*)(OPS + 3 * 2048 + pn * 64 + jb);
            const f32x4 rr = *(const f32x4*)(OPS + 4 * 2048 + pn * 64 + jb);
            const f32x4 kkw = *(const f32x4*)(CST + 128 + jb), kaw = *(const f32x4*)(CST + 192 + jb), rkw = *(const f32x4*)(CST + 256 + jb);
            f32x4 o0, o1, o2, o3;
#pragma unroll
            for (int e = 0; e < 4; ++e) {
              const float sw = sigm(wr_[e]);
              const float dec = __expf(-0.6065306597126334f * sw);
              const float av = sigm(ap_[e]);
              const float kn = kr[e] * kkw[e] * inv;
              const float kd = kr[e] * (1.f + (av - 1.f) * kaw[e]);
              bsum += rr[e] * kd * rkw[e];
              o0[e] = -kn; o1[e] = dec; o2[e] = kn * av; o3[e] = kd;
            }
            *(f32x4*)(OPS + 0 * 2048 + pn * 64 + jb) = o0;
            *(f32x4*)(OPS + 1 * 2048 + pn * 64 + jb) = o1;
            *(f32x4*)(OPS + 2 * 2048 + pn * 64 + jb) = o2;
            *(f32x4*)(OPS + 3 * 2048 + pn * 64 + jb) = o3;
          }
          bsum = red8(bsum);
          if ((tid & 7) == 0) BON[(tok * 8 + h) * 2 + d] = bsum;
        }
      }
      __syncthreads();
      {
        const float* YL = (const float*)(smem + PC_YL + (127 & 1) * 8192);
        const int n1 = 127 * 32 + pn;
        const int t1 = d ? (4095 - n1) : n1;
        h16x8 o;
#pragma unroll
        for (int e = 0; e < 8; ++e) o[e] = (_Float16)YL[pn * 64 + j0 + e];
        *(h16x8*)(Y + ((size_t)s * 4096 + t1) * 512 + h * 64 + j0) = o;
      }
    } else {
      f32x2 S0[4], S1[4];
#pragma unroll
      for (int q = 0; q < 4; ++q) { S0[q] = (f32x2){0.f, 0.f}; S1[q] = (f32x2){0.f, 0.f}; }
#pragma unroll 1
      for (int ch = -1; ch < 128; ++ch) {
        const float* OPS = (const float*)(smem + PC_OPS + (ch & 1) * PC_BUF);
        const float* VV = OPS + 5 * 2048;
        float* YL = (float*)(smem + PC_YL + (ch & 1) * 8192);
        __syncthreads();
        if (ch < 0) {
          __syncthreads(); __syncthreads(); __syncthreads();
        } else {
          ScanOps oa, ob;
          scan_load(oa, OPS, VV, 0, jg, i0);
#pragma unroll 1
          for (int seg = 0; seg < 4; ++seg) {
            if (seg > 0) __syncthreads();
#pragma unroll 1
            for (int nn = seg * 8; nn < seg * 8 + 8; nn += 2) {
              scan_load(ob, OPS, VV, nn + 1, jg, i0);
              scan_step(oa, S0, S1, YL, nn, jg, i0);
              scan_load(oa, OPS, VV, (nn + 2) & 31, jg, i0);
              scan_step(ob, S0, S1, YL, nn + 1, jg, i0);
            }
          }
        }
      }
      __syncthreads();
    }
    __syncthreads();
  }
}

DEVI void phase_rwkv_post(int tid_, int vb_, int vg_, const Params& p, int l, char* smem) {
  u16* PR = (u16*)(p.ws + OFF_PR);
  const _Float16* YF = (const _Float16*)(p.ws + OFF_H);
  const _Float16* YB = (const _Float16*)(p.ws + OFF_H + (size_t)NTOK * 512 * 2);
  const float* BON = (const float*)(p.ws + OFF_BONUS);
  const u16* GUPT = (const u16*)(p.ws + OFF_WB) + W_GUP;
  const float* mu_p = p.in[I_MU_PREV] + (size_t)l * 1920;
  const float* mu_n = p.in[I_MU_NEXT] + (size_t)l * 1920;
  const float* gng = p.in[I_GN_G] + (size_t)l * 512;
  const float* gnb = p.in[I_GN_B] + (size_t)l * 512;
  u16* As = (u16*)smem;
  const int tid = tid_, lane = tid & 63, w = tid >> 6, fr = lane & 15, fq = lane >> 4;
  for (int tile = vb_; tile < NTOK / 64; tile += vg_) {
    const size_t tok0 = (size_t)tile * 64;
    {
      const int row = tid >> 2, part = tid & 3;
      const size_t tok = tok0 + row;
      const int t = (int)(tok & 4095);
#pragma unroll
      for (int q = 0; q < 4; ++q) {
        const int col = 1792 + part * 32 + q * 8;
        float cur[8], prv[8], nxt[8];
        load8bf(PR + tok * PRW + col, cur);
        if (t > 0) load8bf(PR + (tok - 1) * PRW + col, prv);
        else {
#pragma unroll
          for (int e = 0; e < 8; ++e) prv[e] = 0.f;
        }
        if (t < 4095) load8bf(PR + (tok + 1) * PRW + col, nxt);
        else {
#pragma unroll
          for (int e = 0; e < 8; ++e) nxt[e] = 0.f;
        }
        float o[8];
#pragma unroll
        for (int e = 0; e < 8; ++e) {
          const float x = cur[e] + mu_p[col + e] * (prv[e] - cur[e]) + mu_n[col + e] * (nxt[e] - cur[e]);
          o[e] = sigm(x);
        }
        u32x4 pk;
        pk.x = pack2(o[0], o[1]); pk.y = pack2(o[2], o[3]); pk.z = pack2(o[4], o[5]); pk.w = pack2(o[6], o[7]);
        *(u32x4*)(As + row * 136 + part * 32 + q * 8) = pk;
      }
    }
    asm volatile("" ::: "memory");
#pragma unroll 1
    for (int chh = 0; chh < 2; ++chh) {
      f32x4 acc[16];
#pragma unroll
      for (int n = 0; n < 16; ++n) acc[n] = (f32x4){0.f, 0.f, 0.f, 0.f};
#pragma unroll
      for (int ks = 0; ks < 4; ++ks) {
        bf16x8 af = *(const bf16x8*)(As + (w * 16 + fr) * 136 + ks * 32 + fq * 8);
#pragma unroll
        for (int n = 0; n < 16; ++n) {
          bf16x8 bg = *(const bf16x8*)(GUPT + (size_t)(chh * 256 + n * 16 + fr) * 128 + ks * 32 + fq * 8);
          acc[n] = __builtin_amdgcn_mfma_f32_16x16x32_bf16(af, bg, acc[n], 0, 0, 0);
        }
      }
#pragma unroll
      for (int hl = 0; hl < 4; ++hl) {
        const int head = chh * 4 + hl;
        asm volatile("" ::: "memory");
#pragma unroll
        for (int j = 0; j < 4; ++j) {
          const size_t tok = tok0 + w * 16 + fq * 4 + j;
          const int t = (int)(tok & 4095);
          float o[4], sum = 0.f;
#pragma unroll
          for (int q = 0; q < 4; ++q) {
            const int col = head * 64 + q * 16 + fr;
            o[q] = (float)YF[tok * 512 + col] + (float)YB[tok * 512 + col];
            sum += o[q];
          }
          const float mean = red16_sum(sum) * (1.f / 64.f);
          float vs = 0.f;
#pragma unroll
          for (int q = 0; q < 4; ++q) { const float dlt = o[q] - mean; vs += dlt * dlt; }
          const float var = red16_sum(vs) * (1.f / 64.f);
          const float rstd = rsqrtf(var + 64e-5f);
          const float bon = BON[(tok * 8 + head) * 2] + BON[(tok * 8 + head) * 2 + 1];
#pragma unroll
          for (int q = 0; q < 4; ++q) {
            const int col = head * 64 + q * 16 + fr;
            const int vc = 1024 + col;
            const float cur = bf2f(PR[tok * PRW + vc]);
            const float prv = (t > 0) ? bf2f(PR[(tok - 1) * PRW + vc]) : 0.f;
            const float nxt = (t < 4095) ? bf2f(PR[(tok + 1) * PRW + vc]) : 0.f;
            const float vsh = cur + mu_p[vc] * (prv - cur) + mu_n[vc] * (nxt - cur);
            const float yv = ((o[q] - mean) * rstd * gng[col] + gnb[col] + bon * vsh) * acc[hl * 4 + q][j];
            PR[tok * PRW + col] = f2bf(yv);
          }
        }
      }
    }
  }
}

DEVI f32x4 ld4bf(const u16* p) {
  const u32x2 u = *(const u32x2*)p;
  f32x4 o;
  o[0] = __uint_as_float(u.x << 16); o[1] = __uint_as_float(u.x & 0xffff0000u);
  o[2] = __uint_as_float(u.y << 16); o[3] = __uint_as_float(u.y & 0xffff0000u);
  return o;
}

DEVI void phase_merge(int tid_, const Params& p, char* smem, const float* ssq) {
  const u16* WB = (const u16*)(p.ws + OFF_WB);
  const u16* H = (const u16*)(p.ws + OFF_NK);
  u16* PR = (u16*)(p.ws + OFF_PR);
  const u16* NQ = (const u16*)(p.ws + OFF_NQ);
  u16* TMP = (u16*)(p.ws + OFF_H);
  const int lane = tid_ & 63, wid = tid_ >> 6;
  const int wr = wid >> 2, wc = wid & 3, fr = lane & 15, fq = lane >> 4;
  const bool xmap = (gridDim.x & 7) == 0;
  const int xcd = blockIdx.x & 7;
  const int first = xmap ? (int)(blockIdx.x >> 3) : (int)blockIdx.x;
  const int stride = xmap ? (int)(gridDim.x >> 3) : (int)gridDim.x;
  const int count = xmap ? 24 * 4 : 192 * 4;
  for (int it = first; it < count; it += stride) {
    const int tm = xmap ? (it >> 2) * 8 + xcd : (it >> 2), tn = it & 3;
    const int m0 = tm << 8, n0 = tn << 8;
    f32x4 acc[8][4];
#define MERGE_ZERO() _Pragma("unroll") for (int m = 0; m < 8; ++m) _Pragma("unroll") for (int n = 0; n < 4; ++n) acc[m][n] = (f32x4){0.f, 0.f, 0.f, 0.f}
#define MERGE_RC() const int r = m0 + wr * 128 + m * 16 + fr, c0 = n0 + wc * 64 + n * 16 + fq * 4
    MERGE_ZERO();
    gemm_kloop8<true>(launder(tid_), acc, H + (size_t)m0 * 1024, 1024, WB + W_IN + (size_t)(3456 + n0) * 1024, 1024, 1024, smem);
#pragma unroll
    for (int m = 0; m < 8; ++m)
#pragma unroll
      for (int n = 0; n < 4; ++n) {
        MERGE_RC();
        const float rs = rstd_of(ssq, r);
        f32x4 o;
#pragma unroll
        for (int j = 0; j < 4; ++j) o[j] = sigm(acc[m][n][j] * rs);
        store4bf(PR + (size_t)r * PRW + 512 + c0, o);
      }
    MERGE_ZERO();
    gemm_kloop8<true>(launder(tid_), acc, PR + (size_t)m0 * PRW, PRW, WB + W_BRR + (size_t)n0 * 512, 512, 512, smem);
#pragma unroll
    for (int m = 0; m < 8; ++m)
#pragma unroll
      for (int n = 0; n < 4; ++n) {
        MERGE_RC();
        u16* dst = PR + (size_t)r * PRW + 512 + c0;
        store4bf(dst, ld4bf(dst) * acc[m][n]);
      }
    MERGE_ZERO();
    gemm_kloop8<true>(launder(tid_), acc, H + (size_t)m0 * 1024, 1024, WB + W_IN + (size_t)(4480 + n0) * 1024, 1024, 1024, smem);
#pragma unroll
    for (int m = 0; m < 8; ++m)
#pragma unroll
      for (int n = 0; n < 4; ++n) {
        MERGE_RC();
        const float rs = rstd_of(ssq, r);
        f32x4 o;
#pragma unroll
        for (int j = 0; j < 4; ++j) o[j] = sigm(acc[m][n][j] * rs);
        store4bf(TMP + (size_t)r * 1024 + c0, o);
      }
    MERGE_ZERO();
    gemm_kloop8<true>(launder(tid_), acc, NQ + (size_t)m0 * 512, 512, WB + W_BRN + (size_t)n0 * 512, 512, 512, smem);
#pragma unroll
    for (int m = 0; m < 8; ++m)
#pragma unroll
      for (int n = 0; n < 4; ++n) {
        MERGE_RC();
        u16* dst = PR + (size_t)r * PRW + 512 + c0;
        store4bf(dst, ld4bf(dst) + ld4bf(TMP + (size_t)r * 1024 + c0) * acc[m][n]);
      }
#undef MERGE_ZERO
#undef MERGE_RC
  }
}


DEVI void phase_xattn(int tid_, int vb_, int vg_, const Params& p, char* smem) {
  const u16* Q = (const u16*)(p.ws + OFF_PR);
  u16* O = (u16*)(p.ws + OFF_NQ);
  const u16* KVK = (const u16*)(p.ws + OFF_KVK);
  const u16* KVT = (const u16*)(p.ws + OFF_KVT);
  const int lane = tid_ & 63, w = tid_ >> 6, fr = lane & 15, fq = lane >> 4;
  u16* Pw = (u16*)smem + w * (32 * 264);
  for (int t = vb_; t < (NTOK / 128) * 4; t += vg_) {
    const int hh = t & 3;
    const size_t tok0 = (size_t)(t >> 2) * 128 + w * 32;
    const int s = (int)(tok0 >> 12);
    f32x4 acc[2][16];
#pragma unroll
    for (int mt = 0; mt < 2; ++mt)
#pragma unroll
      for (int n = 0; n < 16; ++n) acc[mt][n] = (f32x4){0.f, 0.f, 0.f, 0.f};
#pragma unroll 1
    for (int ks = 0; ks < 8; ++ks) {
      const bf16x8 aq0 = *(const bf16x8*)(Q + (tok0 + fr) * 1024 + hh * 256 + ks * 32 + fq * 8);
      const bf16x8 aq1 = *(const bf16x8*)(Q + (tok0 + 16 + fr) * 1024 + hh * 256 + ks * 32 + fq * 8);
#pragma unroll
      for (int n = 0; n < 16; ++n) {
        const bf16x8 bk = *(const bf16x8*)(KVK + (size_t)(s * 256 + n * 16 + fr) * 1024 + hh * 256 + ks * 32 + fq * 8);
        acc[0][n] = __builtin_amdgcn_mfma_f32_16x16x32_bf16(bk, aq0, acc[0][n], 0, 0, 0);
        acc[1][n] = __builtin_amdgcn_mfma_f32_16x16x32_bf16(bk, aq1, acc[1][n], 0, 0, 0);
      }
    }
    float sm[2];
#pragma unroll
    for (int mt = 0; mt < 2; ++mt) {
      float m = -1e30f;
#pragma unroll
      for (int n = 0; n < 16; ++n)
#pragma unroll
        for (int j = 0; j < 4; ++j) m = fmaxf(m, acc[mt][n][j]);
      m = red4x_max(m) * 0.0625f;
      float ssum = 0.f;
#pragma unroll
      for (int n = 0; n < 16; ++n) {
        f32x4 e;
#pragma unroll
        for (int j = 0; j < 4; ++j) { e[j] = __expf(acc[mt][n][j] * 0.0625f - m); ssum += e[j]; }
        store4bf(Pw + (mt * 16 + fr) * 264 + n * 16 + fq * 4, e);
      }
      sm[mt] = 1.f / red4x_sum(ssum);
    }
#pragma unroll
    for (int mt = 0; mt < 2; ++mt)
#pragma unroll
      for (int n = 0; n < 16; ++n) acc[mt][n] = (f32x4){0.f, 0.f, 0.f, 0.f};
#pragma unroll 1
    for (int ks = 0; ks < 8; ++ks) {
      const bf16x8 ap0 = *(const bf16x8*)(Pw + fr * 264 + ks * 32 + fq * 8);
      const bf16x8 ap1 = *(const bf16x8*)(Pw + (16 + fr) * 264 + ks * 32 + fq * 8);
#pragma unroll
      for (int n = 0; n < 16; ++n) {
        const bf16x8 bv = *(const bf16x8*)(KVT + (size_t)(s * 1024 + hh * 256 + n * 16 + fr) * 256 + ks * 32 + fq * 8);
        acc[0][n] = __builtin_amdgcn_mfma_f32_16x16x32_bf16(bv, ap0, acc[0][n], 0, 0, 0);
        acc[1][n] = __builtin_amdgcn_mfma_f32_16x16x32_bf16(bv, ap1, acc[1][n], 0, 0, 0);
      }
    }
#pragma unroll
    for (int mt = 0; mt < 2; ++mt)
#pragma unroll
      for (int n = 0; n < 16; ++n)
        store4bf(O + (tok0 + mt * 16 + fr) * 1024 + hh * 256 + n * 16 + fq * 4, acc[mt][n] * sm[mt]);
  }
}

constexpr int HALF_SMEM = 78720;

DEVI void run_phase(int tid_, const Params& p, int ph, char* smem) {
  const int half = tid_ >> 8, vt = tid_ & 255;
  const int vb_ = blockIdx.x * 2 + half, vg_ = gridDim.x * 2;
  char* smh = smem + half * HALF_SMEM;
  if (ph == 2 * NPH_LAYER) { phase_final_norm(vt, vb_, vg_, p); return; }
  const int l = ph / NPH_LAYER, q = ph % NPH_LAYER;
  u16* WB = (u16*)(p.ws + OFF_WB);
  u16* H = (u16*)(p.ws + OFF_H);
  u16* PR = (u16*)(p.ws + OFF_PR);
  u16* NQ = (u16*)(p.ws + OFF_NQ);
  float* X = p.X;
  float* SSQ = (float*)(p.ws + OFF_SSQ);
  auto epi_res = [&](int r, int c0, f32x4 v) {
    f32x4* px = (f32x4*)(X + (size_t)r * 1024 + c0);
    *px = *px + v;
  };
  float rowacc = 0.f;
  float* ssq_out = SSQ;
  const bool x_from_input = (l == 0 && q <= 5);
  const bool need_xb = !(l == 1 && q == 12);
  auto epi_res_n = [&](int r, int c0, f32x4 v) {
    f32x4* px = (f32x4*)(X + (size_t)r * 1024 + c0);
    const float* srow = x_from_input ? ((r < 32768) ? p.in[I_XP] + (size_t)r * 1024 : p.in[I_XS] + (size_t)(r - 32768) * 1024)
                                     : X + (size_t)r * 1024;
    const f32x4 xn = *(const f32x4*)(srow + c0) + v;
    *px = xn;
    if (need_xb) store4bf(H + (size_t)r * 1024 + c0, xn);
    rowacc += xn[0] * xn[0] + xn[1] * xn[1] + xn[2] * xn[2] + xn[3] * xn[3];
  };
  auto row_end = [&](int r) {
    float t = rowacc;
    t += __shfl_xor(t, 16);
    t += __shfl_xor(t, 32);
    if ((tid_ & 48) == 0) atomicAdd(ssq_out + r, t);
    rowacc = 0.f;
  };
  constexpr int NONS = 1 << 30;
  switch (q) {
    case 0:
      phase_conv(vt, vb_, vg_, p, l, smh);
      phase_norm_mem(vt, vb_, vg_, p, p.in[I_NORM_MEM] + (size_t)l * 1024);
      if (l == 0) {
        phase_xb(vt, vb_, vg_, p, true, OFF_H, SSQ);
        for (int i = vb_ * 256 + vt; i < 6 * NTOK; i += vg_ * 256) SSQ[NTOK + i] = 0.f;
      }
      break;
    case 1: phase_p_gemm(tid_, p, smem, SSQ + (size_t)(3 * l) * NTOK); break;
    case 2:
      if (gridDim.x >= 224) {
        if (blockIdx.x < 192) phase_scan_pc(tid_, p, l, smem, blockIdx.x, gridDim.x);
        else phase_nat(vt, p, l, smh, vb_ - 384, vg_ - 384);
      } else {
        phase_scan(vt, p, l, smh, vb_, vg_);
        __syncthreads();
        phase_nat(vt, p, l, smh, vb_, vg_);
      }
      break;
    case 3:
      phase_rwkv_post(vt, vb_, vg_, p, l, smh);
      phase_xb(vt, vb_, vg_, p, l == 0, OFF_NK, nullptr);
      break;
    case 4: phase_merge(tid_, p, smem, SSQ + (size_t)(3 * l) * NTOK); break;
    case 5:
      ssq_out = SSQ + (size_t)(3 * l + 1) * NTOK;
      gemm_phase8(tid_, PR + 512, PRW, WB + W_OUT, 1024, 1024, NTOK, 1024, smem, NONS, epi_res_n, NoEpi(), row_end);
      break;
    case 6: {
      const float* ssq = SSQ + (size_t)(3 * l + 1) * NTOK;
      gemm_phase8(tid_, H, 1024, WB + W_XQ, 1024, 1024, NTOK, 1024, smem, NONS,
                 [&](int r, int c0, f32x4 v) { store4bf(PR + (size_t)r * 1024 + c0, v * rstd_of(ssq, r)); }, NoEpi());
    } break;
    case 7: phase_xattn(vt, vb_, vg_, p, smh); break;
    case 8:
      ssq_out = SSQ + (size_t)(3 * l + 2) * NTOK;
      gemm_phase8(tid_, NQ, 1024, WB + W_XO, 1024, 1024, NTOK, 1024, smem, NONS, epi_res_n, NoEpi(), row_end);
      break;
    case 9:
    case 11: {
      const int hf = (q == 11);
      const float* ssq = SSQ + (size_t)(3 * l + 2) * NTOK;
      gemm_phase8(tid_, H, 1024, WB + W_FF1 + (size_t)hf * 2048 * 1024, 1024, 1024, NTOK, 2048, smem, NONS,
                 [&](int r, int c0, f32x4 v) {
                   const float rs = rstd_of(ssq, r);
                   f32x4 o;
#pragma unroll
                   for (int j = 0; j < 4; ++j) { const float x = fmaxf(v[j] * rs, 0.f); o[j] = x * x; }
                   store4bf(PR + (size_t)r * 2048 + c0, o);
                 }, NoEpi());
    } break;
    case 10:
      gemm_phase8(tid_, PR, 2048, WB + W_FF2, 4096, 2048, NTOK, 1024, smem, NONS, epi_res, NoEpi());
      break;
    case 12:
      ssq_out = SSQ + (size_t)(3 * l + 3) * NTOK;
      gemm_phase8(tid_, PR, 2048, WB + W_FF2 + 2048, 4096, 2048, NTOK, 1024, smem, NONS, epi_res_n, NoEpi(), row_end);
      break;
  }
}

#define XB_TMO      128
#define XB_XCNT(j)  (256  + 64 * (j))
#define XB_XSUB(j)  (1280 + 64 * (j))
#define XB_XGEN(j)  (2304 + 64 * (j))
#define XB_TOP      3328
#define XB_TOPGEN   3392
#define XCD_BAR_WORDS 3456
#define XB_SPIN_CAP (1u << 20)
#define LAS __attribute__((address_space(3)))

DEVI unsigned xb_ld(unsigned* p) { return __hip_atomic_load(p, __ATOMIC_RELAXED, __HIP_MEMORY_SCOPE_AGENT); }
DEVI unsigned xb_add(unsigned* p, unsigned v) { return __hip_atomic_fetch_add(p, v, __ATOMIC_RELAXED, __HIP_MEMORY_SCOPE_AGENT); }
DEVI unsigned xb_xcc_id() { return (unsigned)__builtin_amdgcn_s_getreg((3 << 11) | 20) & 0xFu; }
#define XB_SPIN(cond, bar) do { unsigned _sp = 0; while (cond) { __builtin_amdgcn_s_sleep(1); \
    if ((++_sp & 255u) == 0u) { if (xb_ld(&(bar)[XB_TMO])) break; if (_sp > XB_SPIN_CAP) { atomicAdd(&(bar)[XB_TMO], 1u); break; } } } } while (0)

struct XcdBarrier {
  unsigned* bar; unsigned x;
  volatile LAS unsigned* st;
};
DEVI XcdBarrier xcd_barrier_post(unsigned* bar, volatile LAS unsigned* st) {
  XcdBarrier b; b.bar = bar; b.x = xb_xcc_id(); b.st = st;
  if (threadIdx.x == 0) (void)xb_add(&bar[XB_XCNT(b.x)], 1u);
  return b;
}
DEVI void xcd_barrier_complete(unsigned* bar, unsigned x, unsigned& nloc, unsigned& nx) {
  const unsigned G = gridDim.x * gridDim.y * gridDim.z;
  unsigned sum, cnt, mine, sp = 0u;
  for (;;) {
    sum = 0u; cnt = 0u; mine = 0u;
#pragma unroll
    for (unsigned j = 0; j < 16; ++j) { const unsigned c = xb_ld(&bar[XB_XCNT(j)]); sum += c; cnt += (c > 0u) ? 1u : 0u; mine = (j == x) ? c : mine; }
    if (sum == G) break;
    __builtin_amdgcn_s_sleep(1);
    if ((++sp & 255u) == 0u) { if (xb_ld(&bar[XB_TMO])) break; if (sp > XB_SPIN_CAP) { atomicAdd(&bar[XB_TMO], 1u); break; } }
  }
  nloc = mine > 0u ? mine : 1u; nx = cnt > 0u ? cnt : 1u;
}
DEVI void xcd_barrier(const XcdBarrier& b) {
  asm volatile("s_waitcnt vmcnt(0)" ::: "memory");
  __syncthreads();
  if (threadIdx.x == 0) {
    unsigned* bar = b.bar;
    __builtin_amdgcn_s_waitcnt(0);
    unsigned nloc = b.st[0], nx = b.st[1];
    if (nloc == 0u) { xcd_barrier_complete(bar, b.x, nloc, nx); b.st[0] = nloc; b.st[1] = nx; }
    const unsigned old = xb_add(&bar[XB_XSUB(b.x)], 1u);
    const unsigned gen = old / nloc;
    if (old + 1u == (gen + 1u) * nloc) {
      __builtin_amdgcn_fence(__ATOMIC_RELEASE, "agent");
      asm volatile("s_waitcnt vmcnt(0)" ::: "memory");
      const unsigned og = xb_add(&bar[XB_TOP], 1u);
      const unsigned tg = og / nx;
      if (og + 1u == (tg + 1u) * nx) xb_add(&bar[XB_TOPGEN], 1u);
      else XB_SPIN(xb_ld(&bar[XB_TOPGEN]) == tg, bar);
      __builtin_amdgcn_fence(__ATOMIC_ACQUIRE, "agent");
      xb_add(&bar[XB_XGEN(b.x)], 1u);
      asm volatile("s_waitcnt vmcnt(0)" ::: "memory");
    } else {
      XB_SPIN(xb_ld(&bar[XB_XGEN(b.x)]) == gen, bar);
      __builtin_amdgcn_fence(__ATOMIC_ACQUIRE, "agent");
      asm volatile("s_waitcnt vmcnt(0)" ::: "memory");
    }
  }
  __syncthreads();
}

__global__ void __launch_bounds__(512, 2) mega_kernel(Params p, int ph0, int ph1) {
  __shared__ __attribute__((aligned(16))) char smem[2 * HALF_SMEM];
  __shared__ __attribute__((aligned(16))) unsigned xb_words[4];
  if (threadIdx.x == 0) { xb_words[0] = 0u; xb_words[1] = 0u; xb_words[2] = 0u; xb_words[3] = 0u; }
  __syncthreads();
  XcdBarrier xb = xcd_barrier_post((unsigned*)(p.ws + OFF_BAR), (volatile LAS unsigned*)xb_words);
  for (int ph = ph0; ph < ph1; ++ph) {
    if (ph == ph0 + 1) cg::this_grid().sync();
    else if (ph > ph0) xcd_barrier(xb);
    int tid_ = threadIdx.x;
    asm volatile("" : "+v"(tid_));
    run_phase(tid_, p, ph, smem);
  }
}

extern "C" void kernel_launch(void* const* d_in, const int* in_sizes, int n_in, void* d_out, int out_size, void* d_ws,
                              size_t ws_size, hipStream_t stream) {
  if (ws_size < WS_NEED || n_in < 31) return;
  Params p{};
  for (int i = 0; i < 31; ++i) p.in[i] = (const float*)d_in[i];
  p.X = (float*)d_out;
  p.ws = (char*)d_ws;
  static int grid_blocks = 0;
  if (!grid_blocks) {
    int dev = 0, cus = 0, per_cu = 0;
    hipGetDevice(&dev);
    hipDeviceGetAttribute(&cus, hipDeviceAttributeMultiprocessorCount, dev);
    hipOccupancyMaxActiveBlocksPerMultiprocessor(&per_cu, mega_kernel, 512, 0);
    if (per_cu > 1) per_cu = 1;
    if (per_cu < 1) per_cu = 1;
    grid_blocks = cus * per_cu;
  }
  hipMemsetAsync((char*)d_ws + OFF_BAR, 0, 16384, stream);
  int ph0 = 0, ph1 = NPHASES;
  void* args[] = {&p, &ph0, &ph1};
  hipLaunchCooperativeKernel((void*)mega_kernel, dim3(grid_blocks), dim3(512), args, 0, stream);
}
```

```cpp
#include <hip/hip_runtime.h>
#include <hip/hip_cooperative_groups.h>
#include <stdint.h>
namespace cg = cooperative_groups;

typedef unsigned short u16;
typedef __attribute__((ext_vector_type(8))) short bf16x8;
typedef __attribute__((ext_vector_type(4))) float f32x4;
typedef __attribute__((ext_vector_type(8))) _Float16 h16x8;
typedef __attribute__((ext_vector_type(4))) unsigned int u32x4;
typedef __attribute__((ext_vector_type(2))) unsigned int u32x2;

#define DEVI __device__ __forceinline__

constexpr int NTOK = 49152;
constexpr int SEQ_T = 4096;
constexpr int PRW = 1920;
constexpr int NPH_LAYER = 13;
constexpr int NPHASES = 2 * NPH_LAYER + 1;
constexpr int SMEM_BYTES = 78720;

constexpr size_t OFF_WB = 0;
constexpr size_t WB_BYTES = 20512768ull * 2;
constexpr size_t OFF_H = OFF_WB + WB_BYTES;
constexpr size_t OFF_PR = OFF_H + (size_t)NTOK * 1024 * 2;
constexpr size_t OFF_NQ = OFF_PR + (size_t)NTOK * PRW * 2;
constexpr size_t OFF_NK = OFF_NQ + (size_t)NTOK * 512 * 2;
constexpr size_t OFF_NV = OFF_NK + (size_t)NTOK * 512 * 2;
constexpr size_t OFF_KVK = OFF_NV + (size_t)NTOK * 512 * 2;
constexpr size_t OFF_KVT = OFF_KVK + (size_t)3072 * 1024 * 2;
constexpr size_t OFF_MEMH = OFF_KVT + (size_t)3072 * 1024 * 2;
constexpr size_t OFF_BONUS = OFF_MEMH + (size_t)3072 * 1024 * 2;
constexpr size_t OFF_BAR = OFF_BONUS + (size_t)NTOK * 16 * 4;
constexpr size_t OFF_SSQ = OFF_BAR + 16384;
constexpr size_t WS_NEED = OFF_SSQ + (size_t)7 * NTOK * 4;

constexpr size_t W_IN = 0;
constexpr size_t W_BRR = W_IN + (size_t)5504 * 1024;
constexpr size_t W_BRN = W_BRR + (size_t)1024 * 512;
constexpr size_t W_OUT = W_BRN + (size_t)1024 * 512;
constexpr size_t W_XQ = W_OUT + (size_t)1024 * 1024;
constexpr size_t W_XKV = W_XQ + (size_t)1024 * 1024;
constexpr size_t W_XO = W_XKV + (size_t)2048 * 1024;
constexpr size_t W_FF1 = W_XO + (size_t)1024 * 1024;
constexpr size_t W_FF2 = W_FF1 + (size_t)4096 * 1024;
constexpr size_t W_GUP = W_FF2 + (size_t)4096 * 1024;
constexpr size_t W_WUP = W_GUP + (size_t)512 * 128;
constexpr size_t W_AUP = W_WUP + (size_t)2 * 512 * 64;

enum { I_XP = 0, I_XS, I_MP, I_MS, I_NORM_MIX, I_W_IN, I_MU_PREV, I_MU_NEXT, I_W0, I_W_UP, I_A0, I_A_UP,
       I_G_UP, I_K_K, I_K_A, I_R_K, I_GN_G, I_GN_B, I_RPB, I_W_BR_RWKV, I_W_BR_NAT, I_W_OUT, I_NORM_X,
       I_NORM_MEM, I_W_XQ, I_W_XKV, I_W_XO, I_NORM_FF, I_W_FF1, I_W_FF2, I_NORM_FINAL };

struct Params {
  const float* in[31];
  float* X;
  char* ws;
};

DEVI u16 f2bf(float f) {
  uint32_t u = __float_as_uint(f);
  u += 0x7FFFu + ((u >> 16) & 1u);
  return (u16)(u >> 16);
}
DEVI float bf2f(u16 h) { return __uint_as_float(((uint32_t)h) << 16); }
DEVI uint32_t pack2(float a, float b) { return (uint32_t)f2bf(a) | ((uint32_t)f2bf(b) << 16); }
DEVI float frcp(float x) { return __builtin_amdgcn_rcpf(x); }
DEVI float sigm(float x) { return frcp(1.f + __expf(-x)); }
DEVI float ftanh(float x) { return 1.f - 2.f * frcp(__expf(2.f * x) + 1.f); }
DEVI void unpack8(u32x4 u, float* o) {
  o[0] = __uint_as_float(u.x << 16); o[1] = __uint_as_float(u.x & 0xffff0000u);
  o[2] = __uint_as_float(u.y << 16); o[3] = __uint_as_float(u.y & 0xffff0000u);
  o[4] = __uint_as_float(u.z << 16); o[5] = __uint_as_float(u.z & 0xffff0000u);
  o[6] = __uint_as_float(u.w << 16); o[7] = __uint_as_float(u.w & 0xffff0000u);
}
DEVI void load8bf(const u16* p, float* o) { unpack8(*(const u32x4*)p, o); }
DEVI float wave_sum(float v) {
  v += __shfl_xor(v, 32); v += __shfl_xor(v, 16); v += __shfl_xor(v, 8);
  v += __shfl_xor(v, 4); v += __shfl_xor(v, 2); v += __shfl_xor(v, 1);
  return v;
}
DEVI float red4x_sum(float v) { v += __shfl_xor(v, 16); v += __shfl_xor(v, 32); return v; }
DEVI float red4x_max(float v) { v = fmaxf(v, __shfl_xor(v, 16)); v = fmaxf(v, __shfl_xor(v, 32)); return v; }
DEVI float red16_sum(float v) {
  v += __shfl_xor(v, 1); v += __shfl_xor(v, 2); v += __shfl_xor(v, 4); v += __shfl_xor(v, 8);
  return v;
}
DEVI float red16_max(float v) {
  v = fmaxf(v, __shfl_xor(v, 1)); v = fmaxf(v, __shfl_xor(v, 2));
  v = fmaxf(v, __shfl_xor(v, 4)); v = fmaxf(v, __shfl_xor(v, 8));
  return v;
}

DEVI void conv_tile(int tid_, const float* src, int K, int N, u16* dst, int tile, char* smem, const float* gain = nullptr) {
  float (*s)[65] = (float (*)[65])smem;
  const int nN = N >> 6;
  const int tk = tile / nN, tn = tile - tk * nN;
  const int tx = tid_ & 63, ty = tid_ >> 6;
  for (int r = ty; r < 64; r += 4) s[r][tx] = src[(size_t)(tk * 64 + r) * N + tn * 64 + tx];
  __syncthreads();
  const float gk = gain ? gain[tk * 64 + tx] : 1.f;
  for (int r = ty; r < 64; r += 4) dst[(size_t)(tn * 64 + r) * K + tk * 64 + tx] = f2bf(s[tx][r] * gk);
  __syncthreads();
}

DEVI void phase_conv(int tid_, int vb_, int vg_, const Params& p, int l, char* smem) {
  u16* WB = (u16*)(p.ws + OFF_WB);
  const int c0 = 1376, c1 = c0 + 128, c2 = c1 + 128, c3 = c2 + 256, c4 = c3 + 256, c5 = c4 + 512,
            c6 = c5 + 256, c7 = c6 + 1024, c8 = c7 + 1024, c9 = c8 + 16, c10 = c9 + 16, c11 = c10 + 16;
  for (int t = vb_; t < c11; t += vg_) {
    if (t < c0) conv_tile(tid_, p.in[I_W_IN] + (size_t)l * 1024 * 5504, 1024, 5504, WB + W_IN, t, smem, p.in[I_NORM_MIX] + (size_t)l * 1024);
    else if (t < c1) conv_tile(tid_, p.in[I_W_BR_RWKV] + (size_t)l * 512 * 1024, 512, 1024, WB + W_BRR, t - c0, smem);
    else if (t < c2) conv_tile(tid_, p.in[I_W_BR_NAT] + (size_t)l * 512 * 1024, 512, 1024, WB + W_BRN, t - c1, smem);
    else if (t < c3) conv_tile(tid_, p.in[I_W_OUT] + (size_t)l * 1024 * 1024, 1024, 1024, WB + W_OUT, t - c2, smem);
    else if (t < c4) conv_tile(tid_, p.in[I_W_XQ] + (size_t)l * 1024 * 1024, 1024, 1024, WB + W_XQ, t - c3, smem, p.in[I_NORM_X] + (size_t)l * 1024);
    else if (t < c5) conv_tile(tid_, p.in[I_W_XKV] + (size_t)l * 1024 * 2048, 1024, 2048, WB + W_XKV, t - c4, smem);
    else if (t < c6) conv_tile(tid_, p.in[I_W_XO] + (size_t)l * 1024 * 1024, 1024, 1024, WB + W_XO, t - c5, smem);
    else if (t < c7) conv_tile(tid_, p.in[I_W_FF1] + (size_t)l * 1024 * 4096, 1024, 4096, WB + W_FF1, t - c6, smem, p.in[I_NORM_FF] + (size_t)l * 1024);
    else if (t < c8) conv_tile(tid_, p.in[I_W_FF2] + (size_t)l * 4096 * 1024, 4096, 1024, WB + W_FF2, t - c7, smem);
    else if (t < c9) conv_tile(tid_, p.in[I_G_UP] + (size_t)l * 128 * 512, 128, 512, WB + W_GUP, t - c8, smem);
    else if (t < c10) { const int dd = (t - c9) >> 3; conv_tile(tid_, p.in[I_W_UP] + (size_t)(l * 2 + dd) * 64 * 512, 64, 512, WB + W_WUP + (size_t)dd * 512 * 64, (t - c9) & 7, smem); }
    else { const int dd = (t - c10) >> 3; conv_tile(tid_, p.in[I_A_UP] + (size_t)(l * 2 + dd) * 64 * 512, 64, 512, WB + W_AUP + (size_t)dd * 512 * 64, (t - c10) & 7, smem); }
  }
}

DEVI void norm_row_bf16(int tid_, const float* src, const float* g, u16* dst, float* xcopy) {
  const int lane = tid_ & 63;
  float4 v[4];
  float ss = 0.f;
#pragma unroll
  for (int i = 0; i < 4; ++i) {
    v[i] = ((const float4*)src)[lane + i * 64];
    ss += v[i].x * v[i].x + v[i].y * v[i].y + v[i].z * v[i].z + v[i].w * v[i].w;
  }
  ss = wave_sum(ss);
  const float rs = rsqrtf(ss * (1.f / 1024.f) + 1e-6f);
#pragma unroll
  for (int i = 0; i < 4; ++i) {
    float4 gg = ((const float4*)g)[lane + i * 64];
    u32x2 o;
    o.x = pack2(v[i].x * rs * gg.x, v[i].y * rs * gg.y);
    o.y = pack2(v[i].z * rs * gg.z, v[i].w * rs * gg.w);
    ((u32x2*)dst)[lane + i * 64] = o;
    if (xcopy) ((float4*)xcopy)[lane + i * 64] = v[i];
  }
}

DEVI void phase_xb(int tid_, int vb_, int vg_, const Params& p, bool from_input, size_t hoff, float* ssq) {
  u16* H = (u16*)(p.ws + hoff);
  const int wid = tid_ >> 6, lane = tid_ & 63;
  for (int r = vb_ * 4 + wid; r < NTOK; r += vg_ * 4) {
    const float* src;
    if (from_input) src = (r < 32768) ? p.in[I_XP] + (size_t)r * 1024 : p.in[I_XS] + (size_t)(r - 32768) * 1024;
    else src = p.X + (size_t)r * 1024;
    float ss = 0.f;
#pragma unroll
    for (int i = 0; i < 4; ++i) {
      const float4 v = ((const float4*)src)[lane + i * 64];
      ss += v.x * v.x + v.y * v.y + v.z * v.z + v.w * v.w;
      u32x2 o;
      o.x = pack2(v.x, v.y); o.y = pack2(v.z, v.w);
      ((u32x2*)(H + (size_t)r * 1024))[lane + i * 64] = o;
    }
    if (ssq) {
      ss = wave_sum(ss);
      if (lane == 0) ssq[r] = ss;
    }
  }
}
DEVI void phase_norm_mem(int tid_, int vb_, int vg_, const Params& p, const float* g) {
  u16* MH = (u16*)(p.ws + OFF_MEMH);
  const int wid = tid_ >> 6;
  for (int r = vb_ * 4 + wid; r < 3072; r += vg_ * 4) {
    const float* src = (r < 2048) ? p.in[I_MP] + (size_t)r * 1024 : p.in[I_MS] + (size_t)(r - 2048) * 1024;
    norm_row_bf16(tid_, src, g, MH + (size_t)r * 1024, nullptr);
  }
}
DEVI void phase_final_norm(int tid_, int vb_, int vg_, const Params& p) {
  const float* g = p.in[I_NORM_FINAL];
  const float* ssq = (const float*)(p.ws + OFF_SSQ) + (size_t)6 * NTOK;
  const int wid = tid_ >> 6, lane = tid_ & 63;
  for (int r = vb_ * 4 + wid; r < NTOK; r += vg_ * 4) {
    float* row = p.X + (size_t)r * 1024;
    const float rs = rsqrtf(ssq[r] * (1.f / 1024.f) + 1e-6f);
#pragma unroll
    for (int i = 0; i < 4; ++i) {
      const float4 v = ((const float4*)row)[lane + i * 64];
      const float4 gg = ((const float4*)g)[lane + i * 64];
      float4 o;
      o.x = v.x * rs * gg.x; o.y = v.y * rs * gg.y; o.z = v.z * rs * gg.z; o.w = v.w * rs * gg.w;
      ((float4*)row)[lane + i * 64] = o;
    }
  }
}

template <int OFF>
DEVI bf16x8 lds_rd128(uint32_t addr) {
  bf16x8 r;
  asm volatile("ds_read_b128 %0, %1 offset:%2" : "=v"(r) : "v"(addr), "n"(OFF));
  return r;
}

template <int NW, bool SWAP>
DEVI void gemm_kloop(int tid_, f32x4 (&acc)[4][NW], const u16* __restrict__ A, int lda, const u16* __restrict__ Bt, int ldb,
                     int K, char* smem) {
  constexpr int STG = 8192 + NW * 2048;
  constexpr int NB = NW / 2;
  const int tid = tid_, lane = tid & 63, wid = tid >> 6;
  const int wr = wid >> 1, wc = wid & 1, fr = lane & 15, fq = lane >> 4;
  const int lrow = lane >> 2, lphys = lane & 3, lhi = lane >> 4;
  const int gsw = (4 - lhi) & 3;
  const u16* ga[2];
  const u16* gb[NB];
#pragma unroll
  for (int q = 0; q < 2; ++q) ga[q] = A + (size_t)((wid * 2 + q) * 16 + lrow) * lda + (lphys ^ gsw) * 8;
#pragma unroll
  for (int q = 0; q < NB; ++q) gb[q] = Bt + (size_t)((wid * NB + q) * 16 + lrow) * ldb + (lphys ^ gsw) * 8;
  const int rsw = (4 - ((fr >> 2) & 3)) & 3;
  const int ch = (fq ^ rsw) * 16;
  const int nk = K >> 5;
  const uint32_t lds_base = (uint32_t)(size_t)(__attribute__((address_space(3))) char*)smem;
  const uint32_t aoff = (uint32_t)((wr * 64 + fr) * 64 + ch);
  const uint32_t boff = (uint32_t)(8192 + (wc * 16 * NW + fr) * 64 + ch);
  asm volatile("s_waitcnt vmcnt(0)" ::: "memory");
  __syncthreads();
#define GEMM_ISSUE(kt_)                                                                                              \
  do {                                                                                                               \
    char* nb_ = smem + ((kt_) & 3) * STG;                                                                            \
    _Pragma("unroll") for (int q = 0; q < 2; ++q) __builtin_amdgcn_global_load_lds(                                  \
        (const unsigned*)(ga[q] + (kt_) * 32),                                                                       \
        (__attribute__((address_space(3))) unsigned*)(nb_ + (wid * 2 + q) * 1024 + lane * 16), 16, 0, 0);            \
    _Pragma("unroll") for (int q = 0; q < NB; ++q) __builtin_amdgcn_global_load_lds(                                 \
        (const unsigned*)(gb[q] + (kt_) * 32),                                                                       \
        (__attribute__((address_space(3))) unsigned*)(nb_ + 8192 + (wid * NB + q) * 1024 + lane * 16), 16, 0, 0);    \
  } while (0)
  GEMM_ISSUE(0);
  if (nk > 1) GEMM_ISSUE(1);
  if (nk > 2) GEMM_ISSUE(2);
  for (int kt = 0; kt < nk; ++kt) {
    if (kt + 2 < nk) {
      if (NW == 4) asm volatile("s_waitcnt vmcnt(8)" ::: "memory");
      else asm volatile("s_waitcnt vmcnt(6)" ::: "memory");
    } else if (kt + 1 < nk) {
      if (NW == 4) asm volatile("s_waitcnt vmcnt(4)" ::: "memory");
      else asm volatile("s_waitcnt vmcnt(3)" ::: "memory");
    } else {
      asm volatile("s_waitcnt vmcnt(0)" ::: "memory");
    }
    __builtin_amdgcn_s_barrier();
    asm volatile("" ::: "memory");
    if (kt + 3 < nk) GEMM_ISSUE(kt + 3);
    const uint32_t sb = lds_base + (kt & 3) * STG;
    bf16x8 af[4], bfr[4];
    af[0] = lds_rd128<0>(sb + aoff); af[1] = lds_rd128<1024>(sb + aoff);
    af[2] = lds_rd128<2048>(sb + aoff); af[3] = lds_rd128<3072>(sb + aoff);
    bfr[0] = lds_rd128<0>(sb + boff); bfr[1] = lds_rd128<1024>(sb + boff);
    if (NW == 4) {
      bfr[2] = lds_rd128<2048>(sb + boff); bfr[3] = lds_rd128<3072>(sb + boff);
      asm volatile("s_waitcnt lgkmcnt(0)" : "+v"(af[0]), "+v"(af[1]), "+v"(af[2]), "+v"(af[3]),
                   "+v"(bfr[0]), "+v"(bfr[1]), "+v"(bfr[2]), "+v"(bfr[3]));
    } else {
      asm volatile("s_waitcnt lgkmcnt(0)" : "+v"(af[0]), "+v"(af[1]), "+v"(af[2]), "+v"(af[3]), "+v"(bfr[0]), "+v"(bfr[1]));
    }
#pragma unroll
    for (int m = 0; m < 4; ++m)
#pragma unroll
      for (int n = 0; n < NW; ++n) {
        if (SWAP) acc[m][n] = __builtin_amdgcn_mfma_f32_16x16x32_bf16(bfr[n], af[m], acc[m][n], 0, 0, 0);
        else acc[m][n] = __builtin_amdgcn_mfma_f32_16x16x32_bf16(af[m], bfr[n], acc[m][n], 0, 0, 0);
      }
  }
#undef GEMM_ISSUE
}

DEVI int launder(int x) { asm volatile("" : "+v"(x)); return x; }

template <int NW>
DEVI void zero_acc(f32x4 (&acc)[4][NW]) {
#pragma unroll
  for (int m = 0; m < 4; ++m)
#pragma unroll
    for (int n = 0; n < NW; ++n) acc[m][n] = (f32x4){0.f, 0.f, 0.f, 0.f};
}

struct NoEpi { DEVI void operator()(int, int, f32x4) const {} };

template <class EpiS, class EpiN>
DEVI void gemm_phase(int tid_, const u16* A, int lda, const u16* Bt, int ldb, int K, int M, int N, char* smem, int ns_from,
                     EpiS epiS, EpiN epiN) {
  const int nN = N >> 7, nM = M >> 7;
  const int lane = tid_ & 63, wid = tid_ >> 6;
  const int wr = wid >> 1, wc = wid & 1, fr = lane & 15, fq = lane >> 4;
  const int xcd = blockIdx.x & 7, jloc = blockIdx.x >> 3, nloc = gridDim.x >> 3;
  for (int lt = jloc; lt < (nM >> 3) * nN; lt += nloc) {
    const int tml = lt / nN, tn = lt - tml * nN;
    const int tm = tml * 8 + xcd;
    const int m0 = tm << 7, n0 = tn << 7;
    f32x4 acc[4][4];
    zero_acc(acc);
    if (n0 < ns_from) {
      gemm_kloop<4, true>(tid_, acc, A + (size_t)m0 * lda, lda, Bt + (size_t)n0 * ldb, ldb, K, smem);
#pragma unroll
      for (int m = 0; m < 4; ++m)
#pragma unroll
        for (int n = 0; n < 4; ++n) epiS(m0 + wr * 64 + m * 16 + fr, n0 + wc * 64 + n * 16 + fq * 4, acc[m][n]);
    } else {
      gemm_kloop<4, false>(tid_, acc, A + (size_t)m0 * lda, lda, Bt + (size_t)n0 * ldb, ldb, K, smem);
#pragma unroll
      for (int m = 0; m < 4; ++m)
#pragma unroll
        for (int n = 0; n < 4; ++n) epiN(m0 + wr * 64 + m * 16 + fq * 4, n0 + wc * 64 + n * 16 + fr, acc[m][n]);
    }
  }
}


template <bool SWAP>
DEVI void gemm_kloop_big(int tid_, f32x4 (&acc)[8][4], const u16* __restrict__ A, int lda, const u16* __restrict__ Bt,
                         int ldb, int K, char* smem) {
  constexpr int STG = 16384 + 8192;
  const int tid = tid_, lane = tid & 63, wid = tid >> 6;
  const int wr = wid >> 1, wc = wid & 1, fr = lane & 15, fq = lane >> 4;
  const int lrow = lane >> 2, lphys = lane & 3, lhi = lane >> 4;
  const int gsw = (4 - lhi) & 3;
  const u16* ga = A + (size_t)(wid * 64 + lrow) * lda + (lphys ^ gsw) * 8;
  const u16* gb = Bt + (size_t)(wid * 32 + lrow) * ldb + (lphys ^ gsw) * 8;
  const size_t a16 = (size_t)16 * lda, b16 = (size_t)16 * ldb;
  const int rsw = (4 - ((fr >> 2) & 3)) & 3;
  const int ch = (fq ^ rsw) * 16;
  const int nk = K >> 5;
  const uint32_t lds_base = (uint32_t)(size_t)(__attribute__((address_space(3))) char*)smem;
  const uint32_t aoff = (uint32_t)((wr * 128 + fr) * 64 + ch);
  const uint32_t boff = (uint32_t)(16384 + (wc * 64 + fr) * 64 + ch);
  asm volatile("s_waitcnt vmcnt(0)" ::: "memory");
  __syncthreads();
#define GEMMB_ISSUE(kt_, buf_)                                                                                       \
  do {                                                                                                               \
    char* nb_ = smem + (buf_) * STG;                                                                                 \
    _Pragma("unroll") for (int q = 0; q < 4; ++q) __builtin_amdgcn_global_load_lds(                                  \
        (const unsigned*)(ga + q * a16 + (kt_) * 32),                                                                \
        (__attribute__((address_space(3))) unsigned*)(nb_ + (wid * 4 + q) * 1024 + lane * 16), 16, 0, 0);            \
    _Pragma("unroll") for (int q = 0; q < 2; ++q) __builtin_amdgcn_global_load_lds(                                  \
        (const unsigned*)(gb + q * b16 + (kt_) * 32),                                                                \
        (__attribute__((address_space(3))) unsigned*)(nb_ + 16384 + (wid * 2 + q) * 1024 + lane * 16), 16, 0, 0);   \
  } while (0)
  GEMMB_ISSUE(0, 0);
  if (nk > 1) GEMMB_ISSUE(1, 1);
  int cb = 0;
  for (int kt = 0; kt < nk; ++kt) {
    if (kt + 1 < nk) asm volatile("s_waitcnt vmcnt(6)" ::: "memory");
    else asm volatile("s_waitcnt vmcnt(0)" ::: "memory");
    __builtin_amdgcn_s_barrier();
    asm volatile("" ::: "memory");
    const int nbuf = (cb == 0) ? 2 : cb - 1;
    if (kt + 2 < nk) GEMMB_ISSUE(kt + 2, nbuf);
    const uint32_t sb = lds_base + cb * STG;
    bf16x8 a0[4], a1[4], bb[4];
    a0[0] = lds_rd128<0>(sb + aoff); a0[1] = lds_rd128<1024>(sb + aoff);
    a0[2] = lds_rd128<2048>(sb + aoff); a0[3] = lds_rd128<3072>(sb + aoff);
    bb[0] = lds_rd128<0>(sb + boff); bb[1] = lds_rd128<1024>(sb + boff);
    bb[2] = lds_rd128<2048>(sb + boff); bb[3] = lds_rd128<3072>(sb + boff);
    a1[0] = lds_rd128<4096>(sb + aoff); a1[1] = lds_rd128<5120>(sb + aoff);
    a1[2] = lds_rd128<6144>(sb + aoff); a1[3] = lds_rd128<7168>(sb + aoff);
    asm volatile("s_waitcnt lgkmcnt(4)" : "+v"(a0[0]), "+v"(a0[1]), "+v"(a0[2]), "+v"(a0[3]),
                 "+v"(bb[0]), "+v"(bb[1]), "+v"(bb[2]), "+v"(bb[3]));
#pragma unroll
    for (int m = 0; m < 4; ++m)
#pragma unroll
      for (int n = 0; n < 4; ++n) {
        if (SWAP) acc[m][n] = __builtin_amdgcn_mfma_f32_16x16x32_bf16(bb[n], a0[m], acc[m][n], 0, 0, 0);
        else acc[m][n] = __builtin_amdgcn_mfma_f32_16x16x32_bf16(a0[m], bb[n], acc[m][n], 0, 0, 0);
      }
    asm volatile("s_waitcnt lgkmcnt(0)" : "+v"(a1[0]), "+v"(a1[1]), "+v"(a1[2]), "+v"(a1[3]));
#pragma unroll
    for (int m = 0; m < 4; ++m)
#pragma unroll
      for (int n = 0; n < 4; ++n) {
        if (SWAP) acc[4 + m][n] = __builtin_amdgcn_mfma_f32_16x16x32_bf16(bb[n], a1[m], acc[4 + m][n], 0, 0, 0);
        else acc[4 + m][n] = __builtin_amdgcn_mfma_f32_16x16x32_bf16(a1[m], bb[n], acc[4 + m][n], 0, 0, 0);
      }
    cb = (cb == 2) ? 0 : cb + 1;
  }
#undef GEMMB_ISSUE
}

template <class EpiS, class EpiN>
DEVI void gemm_phase_big(int tid_, const u16* A, int lda, const u16* Bt, int ldb, int K, int M, int N, char* smem,
                         int ns_from, EpiS epiS, EpiN epiN) {
  const int nN = N >> 7, nM = M >> 8;
  const int lane = tid_ & 63, wid = tid_ >> 6;
  const int wr = wid >> 1, wc = wid & 1, fr = lane & 15, fq = lane >> 4;
  const int xcd = blockIdx.x & 7, jloc = blockIdx.x >> 3, nloc = gridDim.x >> 3;
  for (int lt = jloc; lt < (nM >> 3) * nN; lt += nloc) {
    const int tml = lt / nN, tn = lt - tml * nN;
    const int tm = tml * 8 + xcd;
    const int m0 = tm << 8, n0 = tn << 7;
    f32x4 acc[8][4];
#pragma unroll
    for (int m = 0; m < 8; ++m)
#pragma unroll
      for (int n = 0; n < 4; ++n) acc[m][n] = (f32x4){0.f, 0.f, 0.f, 0.f};
    if (n0 < ns_from) {
      gemm_kloop_big<true>(launder(tid_), acc, A + (size_t)m0 * lda, lda, Bt + (size_t)n0 * ldb, ldb, K, smem);
#pragma unroll
      for (int m = 0; m < 8; ++m)
#pragma unroll
        for (int n = 0; n < 4; ++n) epiS(m0 + wr * 128 + m * 16 + fr, n0 + wc * 64 + n * 16 + fq * 4, acc[m][n]);
    } else {
      gemm_kloop_big<false>(launder(tid_), acc, A + (size_t)m0 * lda, lda, Bt + (size_t)n0 * ldb, ldb, K, smem);
#pragma unroll
      for (int m = 0; m < 8; ++m)
#pragma unroll
        for (int n = 0; n < 4; ++n) epiN(m0 + wr * 128 + m * 16 + fq * 4, n0 + wc * 64 + n * 16 + fr, acc[m][n]);
    }
  }
}


template <bool SWAP>
DEVI void gemm_kloop8(int tid_, f32x4 (&acc)[8][4], const u16* __restrict__ A, int lda, const u16* __restrict__ Bt,
                      int ldb, int K, char* smem, bool have_pref = false, const u16* An = nullptr, int lda_n = 0,
                      const u16* Bn = nullptr, int ldb_n = 0) {
  constexpr int STG = 65536;
  const int tid = tid_, lane = tid & 63, wid = tid >> 6;
  const int wr = wid >> 2, wc = wid & 3, fr = lane & 15, fq = lane >> 4;
  const int lrow = lane >> 3, lphys = lane & 7, lhi = lane >> 4;
  const u16* ga[4];
  const u16* gb[4];
#pragma unroll
  for (int q = 0; q < 4; ++q) {
    const int kc = lphys ^ ((4 * (q & 1) + lhi) & 7);
    ga[q] = A + (size_t)((wid * 4 + q) * 8 + lrow) * lda + kc * 8;
    gb[q] = Bt + (size_t)((wid * 4 + q) * 8 + lrow) * ldb + kc * 8;
  }
  const int swz = (fr >> 1) & 7;
  const int nk = K >> 6;
  const uint32_t lds_base = (uint32_t)(size_t)(__attribute__((address_space(3))) char*)smem;
  const uint32_t arow = (uint32_t)((wr * 128 + fr) * 128);
  const uint32_t brow = (uint32_t)(32768 + (wc * 64 + fr) * 128);
  if (__builtin_amdgcn_readfirstlane(tid_) >= 256) __builtin_amdgcn_s_setprio(1);
  if (!have_pref) {
    asm volatile("s_waitcnt vmcnt(0)" ::: "memory");
    __syncthreads();
  }
#define GEMM8_ISSUE(kt_)                                                                                             \
  do {                                                                                                               \
    char* nb_ = smem + ((kt_) & 1) * STG;                                                                            \
    _Pragma("unroll") for (int q = 0; q < 4; ++q) __builtin_amdgcn_global_load_lds(                                  \
        (const unsigned*)(ga[q] + (kt_) * 64),                                                                       \
        (__attribute__((address_space(3))) unsigned*)(nb_ + (wid * 4 + q) * 1024 + lane * 16), 16, 0, 0);            \
    _Pragma("unroll") for (int q = 0; q < 4; ++q) __builtin_amdgcn_global_load_lds(                                  \
        (const unsigned*)(gb[q] + (kt_) * 64),                                                                       \
        (__attribute__((address_space(3))) unsigned*)(nb_ + 32768 + (wid * 4 + q) * 1024 + lane * 16), 16, 0, 0);    \
  } while (0)
  if (!have_pref) GEMM8_ISSUE(0);
  for (int kt = 0; kt < nk; ++kt) {
    asm volatile("s_waitcnt vmcnt(0)" ::: "memory");
    __builtin_amdgcn_s_barrier();
    asm volatile("" ::: "memory");
    if (kt + 1 < nk) GEMM8_ISSUE(kt + 1);
    else if (An) {
#pragma unroll
      for (int q = 0; q < 4; ++q) {
        const int kc = lphys ^ ((4 * (q & 1) + lhi) & 7);
        __builtin_amdgcn_global_load_lds((const unsigned*)(An + (size_t)((wid * 4 + q) * 8 + lrow) * lda_n + kc * 8),
            (__attribute__((address_space(3))) unsigned*)(smem + (wid * 4 + q) * 1024 + lane * 16), 16, 0, 0);
        __builtin_amdgcn_global_load_lds((const unsigned*)(Bn + (size_t)((wid * 4 + q) * 8 + lrow) * ldb_n + kc * 8),
            (__attribute__((address_space(3))) unsigned*)(smem + 32768 + (wid * 4 + q) * 1024 + lane * 16), 16, 0, 0);
      }
    }
    const uint32_t sb = lds_base + (kt & 1) * STG;
    const uint32_t c0 = (uint32_t)(((fq) ^ swz) * 16), c1 = (uint32_t)(((4 + fq) ^ swz) * 16);
    const uint32_t aoff0 = sb + arow + c0, boff0 = sb + brow + c0, aoff1 = sb + arow + c1, boff1 = sb + brow + c1;
#define G8_MMA(AF, BF, MO)                                                                                          \
    _Pragma("unroll") for (int m = 0; m < 4; ++m) _Pragma("unroll") for (int n = 0; n < 4; ++n) {                   \
      if (SWAP) acc[MO + m][n] = __builtin_amdgcn_mfma_f32_16x16x32_bf16(BF[n], AF[m], acc[MO + m][n], 0, 0, 0);    \
      else acc[MO + m][n] = __builtin_amdgcn_mfma_f32_16x16x32_bf16(AF[m], BF[n], acc[MO + m][n], 0, 0, 0); }
    bf16x8 a00[4], b0[4], a10[4];
    a00[0] = lds_rd128<0>(aoff0); a00[1] = lds_rd128<2048>(aoff0); a00[2] = lds_rd128<4096>(aoff0); a00[3] = lds_rd128<6144>(aoff0);
    b0[0] = lds_rd128<0>(boff0); b0[1] = lds_rd128<2048>(boff0); b0[2] = lds_rd128<4096>(boff0); b0[3] = lds_rd128<6144>(boff0);
    a10[0] = lds_rd128<8192>(aoff0); a10[1] = lds_rd128<10240>(aoff0); a10[2] = lds_rd128<12288>(aoff0); a10[3] = lds_rd128<14336>(aoff0);
    asm volatile("s_waitcnt lgkmcnt(4)" : "+v"(a00[0]), "+v"(a00[1]), "+v"(a00[2]), "+v"(a00[3]),
                 "+v"(b0[0]), "+v"(b0[1]), "+v"(b0[2]), "+v"(b0[3]));
    G8_MMA(a00, b0, 0)
    bf16x8 a01[4];
    a01[0] = lds_rd128<0>(aoff1); a01[1] = lds_rd128<2048>(aoff1); a01[2] = lds_rd128<4096>(aoff1); a01[3] = lds_rd128<6144>(aoff1);
    asm volatile("s_waitcnt lgkmcnt(4)" : "+v"(a10[0]), "+v"(a10[1]), "+v"(a10[2]), "+v"(a10[3]));
    G8_MMA(a10, b0, 4)
    bf16x8 b1[4], a11[4];
    b1[0] = lds_rd128<0>(boff1); b1[1] = lds_rd128<2048>(boff1); b1[2] = lds_rd128<4096>(boff1); b1[3] = lds_rd128<6144>(boff1);
    a11[0] = lds_rd128<8192>(aoff1); a11[1] = lds_rd128<10240>(aoff1); a11[2] = lds_rd128<12288>(aoff1); a11[3] = lds_rd128<14336>(aoff1);
    asm volatile("s_waitcnt lgkmcnt(4)" : "+v"(a01[0]), "+v"(a01[1]), "+v"(a01[2]), "+v"(a01[3]),
                 "+v"(b1[0]), "+v"(b1[1]), "+v"(b1[2]), "+v"(b1[3]));
    G8_MMA(a01, b1, 0)
    asm volatile("s_waitcnt lgkmcnt(0)" : "+v"(a11[0]), "+v"(a11[1]), "+v"(a11[2]), "+v"(a11[3]));
    G8_MMA(a11, b1, 4)
#undef G8_MMA
  }
#undef GEMM8_ISSUE
  __builtin_amdgcn_s_setprio(0);
}

struct NoRow { DEVI void operator()(int) const {} };

template <class EpiS, class EpiN, class RowEnd = NoRow>
DEVI void gemm_phase8(int tid_, const u16* A, int lda, const u16* Bt, int ldb, int K, int M, int N, char* smem,
                      int ns_from, EpiS epiS, EpiN epiN, RowEnd rowEnd = NoRow(), int rot = 0) {
  const int nN = (N + 255) >> 8, nM = M >> 8;
  const int lane = tid_ & 63, wid = tid_ >> 6;
  const int wr = wid >> 2, wc = wid & 3, fr = lane & 15, fq = lane >> 4;
  const bool xmap = ((gridDim.x & 7) == 0) && ((nM & 7) == 0);
  const int xcd = blockIdx.x & 7;
  const int first = xmap ? (int)(blockIdx.x >> 3) : (int)((blockIdx.x + gridDim.x - rot) % gridDim.x);
  const int stride = xmap ? (int)(gridDim.x >> 3) : (int)gridDim.x;
  const int count = xmap ? (nM >> 3) * nN : nM * nN;
  bool pref = false;
  for (int it = first; it < count; it += stride) {
    const int tq = it / nN, tn = it - tq * nN;
    const int tm = xmap ? tq * 8 + xcd : tq;
    const int m0 = tm << 8, n0 = tn << 8;
    const int colb = n0 + wc * 64;
    const u16* An = nullptr; const u16* Bn = nullptr;
    if (it + stride < count) {
      const int it2 = it + stride;
      const int tq2 = it2 / nN, tn2 = it2 - tq2 * nN;
      An = A + (size_t)((xmap ? tq2 * 8 + xcd : tq2) << 8) * lda;
      Bn = Bt + (size_t)(tn2 << 8) * ldb;
    }
    f32x4 acc[8][4];
#pragma unroll
    for (int m = 0; m < 8; ++m)
#pragma unroll
      for (int n = 0; n < 4; ++n) acc[m][n] = (f32x4){0.f, 0.f, 0.f, 0.f};
    if (colb < ns_from) {
      gemm_kloop8<true>(launder(tid_), acc, A + (size_t)m0 * lda, lda, Bt + (size_t)n0 * ldb, ldb, K, smem, pref, An, lda, Bn, ldb);
      if (colb < N) {
#pragma unroll
        for (int m = 0; m < 8; ++m) {
#pragma unroll
          for (int n = 0; n < 4; ++n) epiS(m0 + wr * 128 + m * 16 + fr, colb + n * 16 + fq * 4, acc[m][n]);
          rowEnd(m0 + wr * 128 + m * 16 + fr);
        }
      }
    } else {
      gemm_kloop8<false>(launder(tid_), acc, A + (size_t)m0 * lda, lda, Bt + (size_t)n0 * ldb, ldb, K, smem, pref, An, lda, Bn, ldb);
      if (colb < N) {
#pragma unroll
        for (int m = 0; m < 8; ++m)
#pragma unroll
          for (int n = 0; n < 4; ++n) epiN(m0 + wr * 128 + m * 16 + fq * 4, colb + n * 16 + fr, acc[m][n]);
      }
    }
    pref = (An != nullptr);
  }
  asm volatile("s_waitcnt vmcnt(0)" ::: "memory");
}

DEVI void store4bf(u16* dst, f32x4 v) {
  u32x2 o;
  o.x = pack2(v[0], v[1]); o.y = pack2(v[2], v[3]);
  *(u32x2*)dst = o;
}

DEVI float rstd_of(const float* ssq, int r) { return rsqrtf(ssq[r] * (1.f / 1024.f) + 1e-6f); }

DEVI void phase_p_gemm(int tid_, const Params& p, char* smem, const float* ssq) {
  u16* WB = (u16*)(p.ws + OFF_WB);
  const u16* H = (const u16*)(p.ws + OFF_H);
  u16* PR = (u16*)(p.ws + OFF_PR);
  u16* NQ = (u16*)(p.ws + OFF_NQ);
  u16* NK = (u16*)(p.ws + OFF_NK);
  u16* NVT = (u16*)(p.ws + OFF_NV);
  gemm_phase8(tid_, H, 1024, WB + W_IN, 1024, 1024, NTOK, 3456, smem, 2944,
    [&](int r, int c0, f32x4 v) {
      v = v * rstd_of(ssq, r);
      if (c0 < 1920) store4bf(PR + (size_t)r * PRW + c0, v);
      else if (c0 < 2432) store4bf(NQ + (size_t)r * 512 + (c0 - 1920), v);
      else store4bf(NK + (size_t)r * 512 + (c0 - 2432), v);
    },
    [&](int r0, int c, f32x4 v) {
      const int cc = c - 2944;
      const int s = r0 >> 12, t = r0 & 4095;
      const f32x4 q = *(const f32x4*)(ssq + r0);
#pragma unroll
      for (int j = 0; j < 4; ++j) v[j] *= rsqrtf(q[j] * (1.f / 1024.f) + 1e-6f);
      store4bf(NVT + ((size_t)(s * 512 + cc)) * 4096 + t, v);
    });
  const u16* MH = (const u16*)(p.ws + OFF_MEMH);
  u16* KVK = (u16*)(p.ws + OFF_KVK);
  u16* KVT = (u16*)(p.ws + OFF_KVT);
  gemm_phase8(tid_, MH, 1024, WB + W_XKV, 1024, 1024, 3072, 2048, smem, 1024,
    [&](int r, int c0, f32x4 v) { store4bf(KVK + (size_t)r * 1024 + c0, v); },
    [&](int r0, int c, f32x4 v) {
      const int cc = c - 1024;
      const int s = r0 >> 8, m = r0 & 255;
      store4bf(KVT + ((size_t)(s * 1024 + cc)) * 256 + m, v);
    }, NoRow(), 128);
}

DEVI void phase_nat(int tid_, const Params& p, int l, char* smem, int bfirst, int bstride) {
  u16* NQ = (u16*)(p.ws + OFF_NQ);
  const u16* NK = (const u16*)(p.ws + OFF_NK);
  const u16* NVT = (const u16*)(p.ws + OFF_NV);
  const float* rpb = p.in[I_RPB] + (size_t)l * 8 * 15 * 31;
  const int lane = tid_ & 63, g = tid_ >> 6, fr = lane & 15, fq = lane >> 4;
  u16* Pw = (u16*)smem + g * (16 * 264);
  const int cb = (g == 0) ? 0 : (g == 1) ? 8 : (g == 2) ? 24 : 32;
  const int c = g * 16 + fr;
  int cs = c - 8; cs = cs < 0 ? 0 : (cs > 48 ? 48 : cs);
  for (int t = bfirst; t < 12 * 64 * 8; t += bstride) {
    const int h = t & 7, ri = (t >> 3) & 63, s = t >> 9;
    int rs = ri - 4; rs = rs < 0 ? 0 : (rs > 56 ? 56 : rs);
    const size_t tokq = (size_t)s * 4096 + ri * 64 + g * 16;
    bf16x8 aq[2];
    aq[0] = *(const bf16x8*)(NQ + (tokq + fr) * 512 + h * 64 + fq * 8);
    aq[1] = *(const bf16x8*)(NQ + (tokq + fr) * 512 + h * 64 + 32 + fq * 8);
    f32x4 acc[16];
#pragma unroll
    for (int n = 0; n < 16; ++n) {
      acc[n] = (f32x4){0.f, 0.f, 0.f, 0.f};
      const int r = n >> 1, col = cb + (n & 1) * 16 + fr;
      const u16* kp = NK + ((size_t)s * 4096 + (rs + r) * 64 + col) * 512 + h * 64 + fq * 8;
      const bf16x8 b0 = *(const bf16x8*)kp;
      const bf16x8 b1 = *(const bf16x8*)(kp + 32);
      acc[n] = __builtin_amdgcn_mfma_f32_16x16x32_bf16(b0, aq[0], acc[n], 0, 0, 0);
      acc[n] = __builtin_amdgcn_mfma_f32_16x16x32_bf16(b1, aq[1], acc[n], 0, 0, 0);
    }
    float m = -1e30f;
#pragma unroll
    for (int n = 0; n < 16; ++n) {
      const int di = rs + (n >> 1) - ri + 7;
      const float* brow = rpb + (h * 15 + di) * 31 + 15 - c;
#pragma unroll
      for (int j = 0; j < 4; ++j) {
        const int kc = cb + (n & 1) * 16 + fq * 4 + j;
        float sc = -1e30f;
        if (kc >= cs && kc < cs + 16) sc = acc[n][j] * 0.125f + brow[kc];
        acc[n][j] = sc;
        m = fmaxf(m, sc);
      }
    }
    m = red4x_max(m);
    float ssum = 0.f;
#pragma unroll
    for (int n = 0; n < 16; ++n) {
      f32x4 e;
#pragma unroll
      for (int j = 0; j < 4; ++j) { e[j] = __expf(acc[n][j] - m); ssum += e[j]; }
      store4bf(Pw + fr * 264 + n * 16 + fq * 4, e);
    }
    const float sm = 1.f / red4x_sum(ssum);
    f32x4 o[4];
#pragma unroll
    for (int n = 0; n < 4; ++n) o[n] = (f32x4){0.f, 0.f, 0.f, 0.f};
#pragma unroll
    for (int ks = 0; ks < 8; ++ks) {
      const bf16x8 ap = *(const bf16x8*)(Pw + fr * 264 + ks * 32 + fq * 8);
#pragma unroll
      for (int n = 0; n < 4; ++n) {
        const bf16x8 bv = *(const bf16x8*)(NVT + ((size_t)(s * 512 + h * 64 + n * 16 + fr)) * 4096 + (rs + ks) * 64 + cb + fq * 8);
        o[n] = __builtin_amdgcn_mfma_f32_16x16x32_bf16(bv, ap, o[n], 0, 0, 0);
      }
    }
#pragma unroll
    for (int n = 0; n < 4; ++n) store4bf(NQ + (tokq + fr) * 512 + h * 64 + n * 16 + fq * 4, o[n] * sm);
  }
}

constexpr int SC_OPS = 0;
constexpr int SC_VV = 40960;
constexpr int SC_WR = 49152;
constexpr int SC_AP = 57344;
constexpr int SC_TW = 65536;
constexpr int SC_AD = 70144;
constexpr int SC_NRM = 74752;
constexpr int SC_MU = 74880;
constexpr int SC_CST = 77440;

typedef __attribute__((ext_vector_type(2))) float f32x2;

template <int CTRL>
DEVI float dpp_mov(float x) {
  return __int_as_float(__builtin_amdgcn_update_dpp(0, __float_as_int(x), CTRL, 0xF, 0xF, true));
}
DEVI float red8(float x) {
  x += dpp_mov<0xB1>(x);
  x += dpp_mov<0x4E>(x);
  x += dpp_mov<0x141>(x);
  return x;
}
DEVI f32x2 lo2(f32x4 v) { return __builtin_shufflevector(v, v, 0, 1); }
DEVI f32x2 hi2(f32x4 v) { return __builtin_shufflevector(v, v, 2, 3); }

struct ScanOps {
  f32x2 a[4], w[4], b[4], k[4], r[4];
  float v0, v1;
};
DEVI void scan_load(ScanOps& o, const float* OPS, const float* VV, int nn, int jg, int i0) {
  const float* base = OPS + nn * 64 + jg * 8;
  f32x4 t0, t1;
  t0 = *(const f32x4*)(base); t1 = *(const f32x4*)(base + 4);
  o.a[0] = lo2(t0); o.a[1] = hi2(t0); o.a[2] = lo2(t1); o.a[3] = hi2(t1);
  t0 = *(const f32x4*)(base + 2048); t1 = *(const f32x4*)(base + 2048 + 4);
  o.w[0] = lo2(t0); o.w[1] = hi2(t0); o.w[2] = lo2(t1); o.w[3] = hi2(t1);
  t0 = *(const f32x4*)(base + 4096); t1 = *(const f32x4*)(base + 4096 + 4);
  o.b[0] = lo2(t0); o.b[1] = hi2(t0); o.b[2] = lo2(t1); o.b[3] = hi2(t1);
  t0 = *(const f32x4*)(base + 6144); t1 = *(const f32x4*)(base + 6144 + 4);
  o.k[0] = lo2(t0); o.k[1] = hi2(t0); o.k[2] = lo2(t1); o.k[3] = hi2(t1);
  t0 = *(const f32x4*)(base + 8192); t1 = *(const f32x4*)(base + 8192 + 4);
  o.r[0] = lo2(t0); o.r[1] = hi2(t0); o.r[2] = lo2(t1); o.r[3] = hi2(t1);
  o.v0 = VV[nn * 64 + i0];
  o.v1 = VV[nn * 64 + i0 + 8];
}
DEVI void scan_step(const ScanOps& o, f32x2 (&S0)[4], f32x2 (&S1)[4], float* YL, int nn, int jg, int i0) {
  f32x2 d0 = S0[0] * o.a[0], d0b = S0[2] * o.a[2];
  f32x2 d1 = S1[0] * o.a[0], d1b = S1[2] * o.a[2];
  d0 = S0[1] * o.a[1] + d0; d0b = S0[3] * o.a[3] + d0b;
  d1 = S1[1] * o.a[1] + d1; d1b = S1[3] * o.a[3] + d1b;
  d0 += d0b; d1 += d1b;
  const float sa0 = red8(d0.x + d0.y);
  const float sa1 = red8(d1.x + d1.y);
  f32x2 e0 = {0.f, 0.f}, e1 = {0.f, 0.f};
#pragma unroll
  for (int q = 0; q < 4; ++q) {
    const f32x2 u0 = sa0 * o.b[q] + o.v0 * o.k[q];
    const f32x2 u1 = sa1 * o.b[q] + o.v1 * o.k[q];
    S0[q] = S0[q] * o.w[q] + u0;
    S1[q] = S1[q] * o.w[q] + u1;
    e0 = S0[q] * o.r[q] + e0;
    e1 = S1[q] * o.r[q] + e1;
  }
  const float y0 = red8(e0.x + e0.y);
  const float y1 = red8(e1.x + e1.y);
  YL[nn * 64 + i0] = y0; YL[nn * 64 + i0 + 8] = y1;
}

DEVI void phase_scan(int tid_, const Params& p, int l, char* smem, int bfirst, int bstride) {
  const u16* PR = (const u16*)(p.ws + OFF_PR);
  _Float16* YF = (_Float16*)(p.ws + OFF_H);
  _Float16* YB = (_Float16*)(p.ws + OFF_H + (size_t)NTOK * 512 * 2);
  float* BON = (float*)(p.ws + OFF_BONUS);
  const u16* WB = (const u16*)(p.ws + OFF_WB);
  float* OPS = (float*)(smem + SC_OPS);
  u16* RAW = (u16*)(smem + SC_OPS);
  float* VV = (float*)(smem + SC_VV);
  float* WR = (float*)(smem + SC_WR);
  float* AP = (float*)(smem + SC_AP);
  float* YL = WR;
  u16* TWb = (u16*)(smem + SC_TW);
  u16* ADb = (u16*)(smem + SC_AD);
  float* NRM = (float*)(smem + SC_NRM);
  float* MU = (float*)(smem + SC_MU);
  float* CST = (float*)(smem + SC_CST);
  const float* mu_p = p.in[I_MU_PREV] + (size_t)l * 1920;
  const float* mu_n = p.in[I_MU_NEXT] + (size_t)l * 1920;
  const int tid = tid_, lane = tid & 63, w = tid >> 6, fr = lane & 15, fq = lane >> 4;
  const int pn = tid >> 3, j0 = (tid & 7) * 8;
  const int jg = lane & 7, i0 = w * 16 + (lane >> 3);
  const int hr = (tid >= 40) ? 1 : 0, hc = tid - hr * 40;
  for (int blk = bfirst; blk < 192; blk += bstride) {
    const int s = blk >> 4, h = (blk >> 1) & 7, d = blk & 1;
    __syncthreads();
    for (int i = tid; i < 640; i += 256) {
      const int which = (i >= 320) ? 1 : 0, c = i - which * 320;
      const int g = c >> 6, e = c & 63;
      const int col = (g < 3) ? (g * 512 + h * 64 + e) : (1536 + (g - 3) * 128 + d * 64 + e);
      MU[i] = which ? mu_n[col] : mu_p[col];
    }
    for (int i = tid; i < 320; i += 256) {
      const int which = i >> 6, e = i & 63;
      float v;
      if (which == 0) v = p.in[I_W0][(size_t)(l * 2 + d) * 512 + h * 64 + e];
      else if (which == 1) v = p.in[I_A0][(size_t)(l * 2 + d) * 512 + h * 64 + e];
      else if (which == 2) v = p.in[I_K_K][(size_t)l * 512 + h * 64 + e];
      else if (which == 3) v = p.in[I_K_A][(size_t)l * 512 + h * 64 + e];
      else v = p.in[I_R_K][(size_t)(l * 8 + h) * 64 + e];
      CST[i] = v;
    }
    bf16x8 bw[2], ba[2];
#pragma unroll
    for (int ks = 0; ks < 2; ++ks) {
      bw[ks] = *(const bf16x8*)(WB + W_WUP + (size_t)(d * 512 + h * 64 + w * 16 + fr) * 64 + ks * 32 + fq * 8);
      ba[ks] = *(const bf16x8*)(WB + W_AUP + (size_t)(d * 512 + h * 64 + w * 16 + fr) * 64 + ks * 32 + fq * 8);
    }
    _Float16* Y = d ? YB : YF;
    f32x2 S0[4], S1[4];
#pragma unroll
    for (int q = 0; q < 4; ++q) { S0[q] = (f32x2){0.f, 0.f}; S1[q] = (f32x2){0.f, 0.f}; }
    u32x4 G[5], GH;
    {
      const int t = d ? (4095 - pn) : pn;
      const size_t tok = (size_t)s * 4096 + t;
#pragma unroll
      for (int g = 0; g < 5; ++g) {
        const int col = (g < 3) ? (g * 512 + h * 64) : (1536 + (g - 3) * 128 + d * 64);
        G[g] = *(const u32x4*)(PR + tok * PRW + col + j0);
      }
      GH = (u32x4){0u, 0u, 0u, 0u};
      if (tid < 80) {
        const int tlo = d ? (4095 - 31) : 0;
        const int th = hr ? (tlo + 32) : (tlo - 1);
        const int g = hc >> 3;
        const int col = (g < 3) ? (g * 512 + h * 64) : (1536 + (g - 3) * 128 + d * 64);
        if (th >= 0 && th <= 4095) GH = *(const u32x4*)(PR + ((size_t)s * 4096 + th) * PRW + col + (hc & 7) * 8);
      }
    }
#pragma unroll 1
    for (int ch = 0; ch < 128; ++ch) {
      const int n = ch * 32 + pn;
      const int t = d ? (4095 - n) : n;
      const size_t tok = (size_t)s * 4096 + t;
      const int tlo = d ? (4095 - (ch * 32 + 31)) : (ch * 32);
      const int rrow = t - tlo + 1;
#pragma unroll
      for (int g = 0; g < 5; ++g) *(u32x4*)(RAW + rrow * 320 + g * 64 + j0) = G[g];
      if (tid < 80) *(u32x4*)(RAW + (hr ? 33 : 0) * 320 + (hc >> 3) * 64 + (hc & 7) * 8) = GH;
      __syncthreads();
      if (ch + 1 < 128) {
        const int n2 = n + 32;
        const int t2 = d ? (4095 - n2) : n2;
        const size_t tok2 = (size_t)s * 4096 + t2;
#pragma unroll
        for (int g = 0; g < 5; ++g) {
          const int col = (g < 3) ? (g * 512 + h * 64) : (1536 + (g - 3) * 128 + d * 64);
          G[g] = *(const u32x4*)(PR + tok2 * PRW + col + j0);
        }
        GH = (u32x4){0u, 0u, 0u, 0u};
        if (tid < 80) {
          const int tlo2 = d ? (tlo - 32) : (tlo + 32);
          const int th = hr ? (tlo2 + 32) : (tlo2 - 1);
          const int g = hc >> 3;
          const int col = (g < 3) ? (g * 512 + h * 64) : (1536 + (g - 3) * 128 + d * 64);
          if (th >= 0 && th <= 4095) GH = *(const u32x4*)(PR + ((size_t)s * 4096 + th) * PRW + col + (hc & 7) * 8);
        }
      }
#pragma unroll
      for (int g = 0; g < 5; ++g) {
        float cur[8], prv[8], nxt[8];
        load8bf(RAW + rrow * 320 + g * 64 + j0, cur);
        load8bf(RAW + (rrow - 1) * 320 + g * 64 + j0, prv);
        load8bf(RAW + (rrow + 1) * 320 + g * 64 + j0, nxt);
        const f32x4 mp0 = *(const f32x4*)(MU + g * 64 + j0), mp1 = *(const f32x4*)(MU + g * 64 + j0 + 4);
        const f32x4 mn0 = *(const f32x4*)(MU + 320 + g * 64 + j0), mn1 = *(const f32x4*)(MU + 320 + g * 64 + j0 + 4);
        f32x4 x0, x1;
#pragma unroll
        for (int e = 0; e < 4; ++e) {
          x0[e] = cur[e] + mp0[e] * (prv[e] - cur[e]) + mn0[e] * (nxt[e] - cur[e]);
          x1[e] = cur[4 + e] + mp1[e] * (prv[4 + e] - cur[4 + e]) + mn1[e] * (nxt[4 + e] - cur[4 + e]);
        }
        if (g == 0) {
          *(f32x4*)(OPS + 4 * 2048 + pn * 64 + j0) = x0; *(f32x4*)(OPS + 4 * 2048 + pn * 64 + j0 + 4) = x1;
        } else if (g == 1) {
          *(f32x4*)(OPS + 3 * 2048 + pn * 64 + j0) = x0; *(f32x4*)(OPS + 3 * 2048 + pn * 64 + j0 + 4) = x1;
          const f32x4 kk0 = *(const f32x4*)(CST + 128 + j0), kk1 = *(const f32x4*)(CST + 128 + j0 + 4);
          float ss = 0.f;
#pragma unroll
          for (int e = 0; e < 4; ++e) { const float a_ = x0[e] * kk0[e], b_ = x1[e] * kk1[e]; ss += a_ * a_ + b_ * b_; }
          ss = red8(ss);
          if ((tid & 7) == 0) NRM[pn] = frcp(fmaxf(__builtin_amdgcn_sqrtf(ss), 1e-12f));
        } else if (g == 2) {
          *(f32x4*)(VV + pn * 64 + j0) = x0; *(f32x4*)(VV + pn * 64 + j0 + 4) = x1;
        } else if (g == 3) {
          u32x4 pk;
          pk.x = pack2(ftanh(x0[0]), ftanh(x0[1])); pk.y = pack2(ftanh(x0[2]), ftanh(x0[3]));
          pk.z = pack2(ftanh(x1[0]), ftanh(x1[1])); pk.w = pack2(ftanh(x1[2]), ftanh(x1[3]));
          *(u32x4*)(TWb + pn * 72 + j0) = pk;
        } else {
          u32x4 pk;
          pk.x = pack2(x0[0], x0[1]); pk.y = pack2(x0[2], x0[3]);
          pk.z = pack2(x1[0], x1[1]); pk.w = pack2(x1[2], x1[3]);
          *(u32x4*)(ADb + pn * 72 + j0) = pk;
        }
      }
      __syncthreads();
#pragma unroll
      for (int m = 0; m < 2; ++m) {
        f32x4 cw = {0.f, 0.f, 0.f, 0.f}, ca = {0.f, 0.f, 0.f, 0.f};
#pragma unroll
        for (int ks = 0; ks < 2; ++ks) {
          const bf16x8 aw = *(const bf16x8*)(TWb + (m * 16 + fr) * 72 + ks * 32 + fq * 8);
          const bf16x8 aa = *(const bf16x8*)(ADb + (m * 16 + fr) * 72 + ks * 32 + fq * 8);
          cw = __builtin_amdgcn_mfma_f32_16x16x32_bf16(aw, bw[ks], cw, 0, 0, 0);
          ca = __builtin_amdgcn_mfma_f32_16x16x32_bf16(aa, ba[ks], ca, 0, 0, 0);
        }
#pragma unroll
        for (int jj = 0; jj < 4; ++jj) {
          WR[(m * 16 + fq * 4 + jj) * 64 + w * 16 + fr] = cw[jj];
          AP[(m * 16 + fq * 4 + jj) * 64 + w * 16 + fr] = ca[jj];
        }
      }
      __syncthreads();
      {
        const float inv = NRM[pn];
        float bsum = 0.f;
#pragma unroll
        for (int hq = 0; hq < 2; ++hq) {
          const int jb = j0 + hq * 4;
          const f32x4 wr_ = *(const f32x4*)(WR + pn * 64 + jb) + *(const f32x4*)(CST + jb);
          const f32x4 ap_ = *(const f32x4*)(AP + pn * 64 + jb) + *(const f32x4*)(CST + 64 + jb);
          const f32x4 kr = *(const f32x4*)(OPS + 3 * 2048 + pn * 64 + jb);
          const f32x4 rr = *(const f32x4*)(OPS + 4 * 2048 + pn * 64 + jb);
          const f32x4 kkw = *(const f32x4*)(CST + 128 + jb), kaw = *(const f32x4*)(CST + 192 + jb), rkw = *(const f32x4*)(CST + 256 + jb);
          f32x4 o0, o1, o2, o3;
#pragma unroll
          for (int e = 0; e < 4; ++e) {
            const float sw = sigm(wr_[e]);
            const float dec = __expf(-0.6065306597126334f * sw);
            const float av = sigm(ap_[e]);
            const float kn = kr[e] * kkw[e] * inv;
            const float kd = kr[e] * (1.f + (av - 1.f) * kaw[e]);
            bsum += rr[e] * kd * rkw[e];
            o0[e] = -kn; o1[e] = dec; o2[e] = kn * av; o3[e] = kd;
          }
          *(f32x4*)(OPS + 0 * 2048 + pn * 64 + jb) = o0;
          *(f32x4*)(OPS + 1 * 2048 + pn * 64 + jb) = o1;
          *(f32x4*)(OPS + 2 * 2048 + pn * 64 + jb) = o2;
          *(f32x4*)(OPS + 3 * 2048 + pn * 64 + jb) = o3;
        }
        bsum = red8(bsum);
        if ((tid & 7) == 0) BON[(tok * 8 + h) * 2 + d] = bsum;
      }
      __syncthreads();
      {
        ScanOps oa, ob;
        scan_load(oa, OPS, VV, 0, jg, i0);
#pragma unroll 1
        for (int nn = 0; nn < 32; nn += 2) {
          scan_load(ob, OPS, VV, nn + 1, jg, i0);
          scan_step(oa, S0, S1, YL, nn, jg, i0);
          scan_load(oa, OPS, VV, (nn + 2) & 31, jg, i0);
          scan_step(ob, S0, S1, YL, nn + 1, jg, i0);
        }
      }
      __syncthreads();
      {
        h16x8 o;
#pragma unroll
        for (int e = 0; e < 8; ++e) o[e] = (_Float16)YL[pn * 64 + j0 + e];
        *(h16x8*)(Y + tok * 512 + h * 64 + j0) = o;
      }
    }
    __syncthreads();
  }
}

struct ScanOps1 {
  f32x2 a[4], w[4], b[4], k[4], r[4];
  float v0;
};
DEVI void scan_load1(ScanOps1& o, const float* OPS, const float* VV, int nn, int jg, int i0) {
  const float* base = OPS + nn * 64 + jg * 8;
  f32x4 t0, t1;
  t0 = *(const f32x4*)(base); t1 = *(const f32x4*)(base + 4);
  o.a[0] = lo2(t0); o.a[1] = hi2(t0); o.a[2] = lo2(t1); o.a[3] = hi2(t1);
  t0 = *(const f32x4*)(base + 2048); t1 = *(const f32x4*)(base + 2048 + 4);
  o.w[0] = lo2(t0); o.w[1] = hi2(t0); o.w[2] = lo2(t1); o.w[3] = hi2(t1);
  t0 = *(const f32x4*)(base + 4096); t1 = *(const f32x4*)(base + 4096 + 4);
  o.b[0] = lo2(t0); o.b[1] = hi2(t0); o.b[2] = lo2(t1); o.b[3] = hi2(t1);
  t0 = *(const f32x4*)(base + 6144); t1 = *(const f32x4*)(base + 6144 + 4);
  o.k[0] = lo2(t0); o.k[1] = hi2(t0); o.k[2] = lo2(t1); o.k[3] = hi2(t1);
  t0 = *(const f32x4*)(base + 8192); t1 = *(const f32x4*)(base + 8192 + 4);
  o.r[0] = lo2(t0); o.r[1] = hi2(t0); o.r[2] = lo2(t1); o.r[3] = hi2(t1);
  o.v0 = VV[nn * 64 + i0];
}
DEVI void scan_step1(const ScanOps1& o, f32x2 (&S0)[4], float* YL, int nn, int jg, int i0) {
  f32x2 d0 = S0[0] * o.a[0], d0b = S0[2] * o.a[2];
  d0 = S0[1] * o.a[1] + d0; d0b = S0[3] * o.a[3] + d0b;
  d0 += d0b;
  const float sa0 = red8(d0.x + d0.y);
  f32x2 e0 = {0.f, 0.f};
#pragma unroll
  for (int q = 0; q < 4; ++q) {
    const f32x2 u0 = sa0 * o.b[q] + o.v0 * o.k[q];
    S0[q] = S0[q] * o.w[q] + u0;
    e0 = S0[q] * o.r[q] + e0;
  }
  const float y0 = red8(e0.x + e0.y);
  if (jg == 0) YL[nn * 64 + i0] = y0;
}
DEVI float red16d(float x) {
  x += dpp_mov<0xB1>(x);
  x += dpp_mov<0x4E>(x);
  x += dpp_mov<0x141>(x);
  x += dpp_mov<0x140>(x);
  return x;
}
DEVI void unpack4(u32x2 u, float* o) {
  o[0] = __uint_as_float(u.x << 16); o[1] = __uint_as_float(u.x & 0xffff0000u);
  o[2] = __uint_as_float(u.y << 16); o[3] = __uint_as_float(u.y & 0xffff0000u);
}

DEVI void phase_scan8(int tid_, const Params& p, int l, char* smem, int bfirst, int bstride) {
  const u16* PR = (const u16*)(p.ws + OFF_PR);
  _Float16* YF = (_Float16*)(p.ws + OFF_H);
  _Float16* YB = (_Float16*)(p.ws + OFF_H + (size_t)NTOK * 512 * 2);
  float* BON = (float*)(p.ws + OFF_BONUS);
  const u16* WB = (const u16*)(p.ws + OFF_WB);
  float* OPS = (float*)(smem + SC_OPS);
  u16* RAW = (u16*)(smem + SC_OPS);
  float* VV = (float*)(smem + SC_VV);
  float* WR = (float*)(smem + SC_WR);
  float* AP = (float*)(smem + SC_AP);
  float* YL = WR;
  u16* TWb = (u16*)(smem + SC_TW);
  u16* ADb = (u16*)(smem + SC_AD);
  float* NRM = (float*)(smem + SC_NRM);
  float* MU = (float*)(smem + SC_MU);
  float* CST = (float*)(smem + SC_CST);
  const float* mu_p = p.in[I_MU_PREV] + (size_t)l * 1920;
  const float* mu_n = p.in[I_MU_NEXT] + (size_t)l * 1920;
  const int tid = tid_, lane = tid & 63, w = tid >> 6, fr = lane & 15, fq = lane >> 4;
  const int pn = tid >> 4, j0 = (tid & 15) * 4;
  const int jg = lane & 7, i0 = w * 8 + (lane >> 3);
  const int hr = (tid >= 80) ? 1 : 0, hc = tid - hr * 80;
  const int wm = w >> 2, wn = w & 3;
  for (int blk = bfirst; blk < 192; blk += bstride) {
    const int s = blk >> 4, h = (blk >> 1) & 7, d = blk & 1;
    __syncthreads();
    for (int i = tid; i < 640; i += 512) {
      const int which = (i >= 320) ? 1 : 0, c = i - which * 320;
      const int g = c >> 6, e = c & 63;
      const int col = (g < 3) ? (g * 512 + h * 64 + e) : (1536 + (g - 3) * 128 + d * 64 + e);
      MU[i] = which ? mu_n[col] : mu_p[col];
    }
    if (tid < 320) {
      const int which = tid >> 6, e = tid & 63;
      float v;
      if (which == 0) v = p.in[I_W0][(size_t)(l * 2 + d) * 512 + h * 64 + e];
      else if (which == 1) v = p.in[I_A0][(size_t)(l * 2 + d) * 512 + h * 64 + e];
      else if (which == 2) v = p.in[I_K_K][(size_t)l * 512 + h * 64 + e];
      else if (which == 3) v = p.in[I_K_A][(size_t)l * 512 + h * 64 + e];
      else v = p.in[I_R_K][(size_t)(l * 8 + h) * 64 + e];
      CST[tid] = v;
    }
    bf16x8 bw[2], ba[2];
#pragma unroll
    for (int ks = 0; ks < 2; ++ks) {
      bw[ks] = *(const bf16x8*)(WB + W_WUP + (size_t)(d * 512 + h * 64 + wn * 16 + fr) * 64 + ks * 32 + fq * 8);
      ba[ks] = *(const bf16x8*)(WB + W_AUP + (size_t)(d * 512 + h * 64 + wn * 16 + fr) * 64 + ks * 32 + fq * 8);
    }
    _Float16* Y = d ? YB : YF;
    f32x2 S0[4];
#pragma unroll
    for (int q = 0; q < 4; ++q) S0[q] = (f32x2){0.f, 0.f};
    u32x2 G[5], GH;
    {
      const int t = d ? (4095 - pn) : pn;
      const size_t tok = (size_t)s * 4096 + t;
#pragma unroll
      for (int g = 0; g < 5; ++g) {
        const int col = (g < 3) ? (g * 512 + h * 64) : (1536 + (g - 3) * 128 + d * 64);
        G[g] = *(const u32x2*)(PR + tok * PRW + col + j0);
      }
      GH = (u32x2){0u, 0u};
      if (tid < 160) {
        const int tlo = d ? (4095 - 31) : 0;
        const int th = hr ? (tlo + 32) : (tlo - 1);
        const int g = hc >> 4;
        const int col = (g < 3) ? (g * 512 + h * 64) : (1536 + (g - 3) * 128 + d * 64);
        if (th >= 0 && th <= 4095) GH = *(const u32x2*)(PR + ((size_t)s * 4096 + th) * PRW + col + (hc & 15) * 4);
      }
    }
#pragma unroll 1
    for (int ch = 0; ch < 128; ++ch) {
      const int n = ch * 32 + pn;
      const int t = d ? (4095 - n) : n;
      const size_t tok = (size_t)s * 4096 + t;
      const int tlo = d ? (4095 - (ch * 32 + 31)) : (ch * 32);
      const int rrow = t - tlo + 1;
#pragma unroll
      for (int g = 0; g < 5; ++g) *(u32x2*)(RAW + rrow * 320 + g * 64 + j0) = G[g];
      if (tid < 160) *(u32x2*)(RAW + (hr ? 33 : 0) * 320 + (hc >> 4) * 64 + (hc & 15) * 4) = GH;
      __syncthreads();
      if (ch + 1 < 128) {
        const int n2 = n + 32;
        const int t2 = d ? (4095 - n2) : n2;
        const size_t tok2 = (size_t)s * 4096 + t2;
#pragma unroll
        for (int g = 0; g < 5; ++g) {
          const int col = (g < 3) ? (g * 512 + h * 64) : (1536 + (g - 3) * 128 + d * 64);
          G[g] = *(const u32x2*)(PR + tok2 * PRW + col + j0);
        }
        GH = (u32x2){0u, 0u};
        if (tid < 160) {
          const int tlo2 = d ? (tlo - 32) : (tlo + 32);
          const int th = hr ? (tlo2 + 32) : (tlo2 - 1);
          const int g = hc >> 4;
          const int col = (g < 3) ? (g * 512 + h * 64) : (1536 + (g - 3) * 128 + d * 64);
          if (th >= 0 && th <= 4095) GH = *(const u32x2*)(PR + ((size_t)s * 4096 + th) * PRW + col + (hc & 15) * 4);
        }
      }
#pragma unroll
      for (int g = 0; g < 5; ++g) {
        float cur[4], prv[4], nxt[4];
        unpack4(*(const u32x2*)(RAW + rrow * 320 + g * 64 + j0), cur);
        unpack4(*(const u32x2*)(RAW + (rrow - 1) * 320 + g * 64 + j0), prv);
        unpack4(*(const u32x2*)(RAW + (rrow + 1) * 320 + g * 64 + j0), nxt);
        const f32x4 mp0 = *(const f32x4*)(MU + g * 64 + j0);
        const f32x4 mn0 = *(const f32x4*)(MU + 320 + g * 64 + j0);
        f32x4 x0;
#pragma unroll
        for (int e = 0; e < 4; ++e) x0[e] = cur[e] + mp0[e] * (prv[e] - cur[e]) + mn0[e] * (nxt[e] - cur[e]);
        if (g == 0) {
          *(f32x4*)(OPS + 4 * 2048 + pn * 64 + j0) = x0;
        } else if (g == 1) {
          *(f32x4*)(OPS + 3 * 2048 + pn * 64 + j0) = x0;
          const f32x4 kk0 = *(const f32x4*)(CST + 128 + j0);
          float ss = 0.f;
#pragma unroll
          for (int e = 0; e < 4; ++e) { const float a_ = x0[e] * kk0[e]; ss += a_ * a_; }
          ss = red16d(ss);
          if ((tid & 15) == 0) NRM[pn] = frcp(fmaxf(__builtin_amdgcn_sqrtf(ss), 1e-12f));
        } else if (g == 2) {
          *(f32x4*)(VV + pn * 64 + j0) = x0;
        } else if (g == 3) {
          u32x2 pk;
          pk.x = pack2(ftanh(x0[0]), ftanh(x0[1])); pk.y = pack2(ftanh(x0[2]), ftanh(x0[3]));
          *(u32x2*)(TWb + pn * 72 + j0) = pk;
        } else {
          u32x2 pk;
          pk.x = pack2(x0[0], x0[1]); pk.y = pack2(x0[2], x0[3]);
          *(u32x2*)(ADb + pn * 72 + j0) = pk;
        }
      }
      __syncthreads();
      {
        f32x4 cw = {0.f, 0.f, 0.f, 0.f}, ca = {0.f, 0.f, 0.f, 0.f};
#pragma unroll
        for (int ks = 0; ks < 2; ++ks) {
          const bf16x8 aw = *(const bf16x8*)(TWb + (wm * 16 + fr) * 72 + ks * 32 + fq * 8);
          const bf16x8 aa = *(const bf16x8*)(ADb + (wm * 16 + fr) * 72 + ks * 32 + fq * 8);
          cw = __builtin_amdgcn_mfma_f32_16x16x32_bf16(aw, bw[ks], cw, 0, 0, 0);
          ca = __builtin_amdgcn_mfma_f32_16x16x32_bf16(aa, ba[ks], ca, 0, 0, 0);
        }
#pragma unroll
        for (int jj = 0; jj < 4; ++jj) {
          WR[(wm * 16 + fq * 4 + jj) * 64 + wn * 16 + fr] = cw[jj];
          AP[(wm * 16 + fq * 4 + jj) * 64 + wn * 16 + fr] = ca[jj];
        }
      }
      __syncthreads();
      {
        const float inv = NRM[pn];
        float bsum = 0.f;
        const f32x4 wr_ = *(const f32x4*)(WR + pn * 64 + j0) + *(const f32x4*)(CST + j0);
        const f32x4 ap_ = *(const f32x4*)(AP + pn * 64 + j0) + *(const f32x4*)(CST + 64 + j0);
        const f32x4 kr = *(const f32x4*)(OPS + 3 * 2048 + pn * 64 + j0);
        const f32x4 rr = *(const f32x4*)(OPS + 4 * 2048 + pn * 64 + j0);
        const f32x4 kkw = *(const f32x4*)(CST + 128 + j0), kaw = *(const f32x4*)(CST + 192 + j0), rkw = *(const f32x4*)(CST + 256 + j0);
        f32x4 o0, o1, o2, o3;
#pragma unroll
        for (int e = 0; e < 4; ++e) {
          const float sw = sigm(wr_[e]);
          const float dec = __expf(-0.6065306597126334f * sw);
          const float av = sigm(ap_[e]);
          const float kn = kr[e] * kkw[e] * inv;
          const float kd = kr[e] * (1.f + (av - 1.f) * kaw[e]);
          bsum += rr[e] * kd * rkw[e];
          o0[e] = -kn; o1[e] = dec; o2[e] = kn * av; o3[e] = kd;
        }
        *(f32x4*)(OPS + 0 * 2048 + pn * 64 + j0) = o0;
        *(f32x4*)(OPS + 1 * 2048 + pn * 64 + j0) = o1;
        *(f32x4*)(OPS + 2 * 2048 + pn * 64 + j0) = o2;
        *(f32x4*)(OPS + 3 * 2048 + pn * 64 + j0) = o3;
        bsum = red16d(bsum);
        if ((tid & 15) == 0) BON[(tok * 8 + h) * 2 + d] = bsum;
      }
      __syncthreads();
      {
        ScanOps1 oa, ob;
        scan_load1(oa, OPS, VV, 0, jg, i0);
#pragma unroll 1
        for (int nn = 0; nn < 32; nn += 2) {
          scan_load1(ob, OPS, VV, nn + 1, jg, i0);
          scan_step1(oa, S0, YL, nn, jg, i0);
          scan_load1(oa, OPS, VV, (nn + 2) & 31, jg, i0);
          scan_step1(ob, S0, YL, nn + 1, jg, i0);
        }
      }
      __syncthreads();
      {
        typedef __attribute__((ext_vector_type(4))) _Float16 h16x4;
        h16x4 o;
#pragma unroll
        for (int e = 0; e < 4; ++e) o[e] = (_Float16)YL[pn * 64 + j0 + e];
        *(h16x4*)(Y + tok * 512 + h * 64 + j0) = o;
      }
    }
    __syncthreads();
  }
}

constexpr int PC_OPS = 0;
constexpr int PC_BUF = 49152;
constexpr int PC_RAW = 98304;
constexpr int PC_WR = 98304;
constexpr int PC_AP = 106496;
constexpr int PC_TW = 120064;
constexpr int PC_AD = 124672;
constexpr int PC_NRM = 129280;
constexpr int PC_MU = 129408;
constexpr int PC_CST = 131968;
constexpr int PC_YL = 133248;

DEVI void phase_scan_pc(int tid_, const Params& p, int l, char* smem, int bfirst, int bstride) {
  const u16* PR = (const u16*)(p.ws + OFF_PR);
  _Float16* YF = (_Float16*)(p.ws + OFF_H);
  _Float16* YB = (_Float16*)(p.ws + OFF_H + (size_t)NTOK * 512 * 2);
  float* BON = (float*)(p.ws + OFF_BONUS);
  const u16* WB = (const u16*)(p.ws + OFF_WB);
  u16* RAW = (u16*)(smem + PC_RAW);
  float* WR = (float*)(smem + PC_WR);
  float* AP = (float*)(smem + PC_AP);
  u16* TWb = (u16*)(smem + PC_TW);
  u16* ADb = (u16*)(smem + PC_AD);
  float* NRM = (float*)(smem + PC_NRM);
  float* MU = (float*)(smem + PC_MU);
  float* CST = (float*)(smem + PC_CST);
  const float* mu_p = p.in[I_MU_PREV] + (size_t)l * 1920;
  const float* mu_n = p.in[I_MU_NEXT] + (size_t)l * 1920;
  const bool is_prep = tid_ >= 256;
  const int tid = tid_ & 255, lane = tid & 63, w = tid >> 6, fr = lane & 15, fq = lane >> 4;
  const int pn = tid >> 3, j0 = (tid & 7) * 8;
  const int jg = lane & 7, i0 = w * 16 + (lane >> 3);
  const int hr = (tid >= 40) ? 1 : 0, hc = tid - hr * 40;
  for (int blk = bfirst; blk < 192; blk += bstride) {
    const int s = blk >> 4, h = (blk >> 1) & 7, d = blk & 1;
    __syncthreads();
    for (int i = tid_; i < 640; i += 512) {
      const int which = (i >= 320) ? 1 : 0, c = i - which * 320;
      const int g = c >> 6, e = c & 63;
      const int col = (g < 3) ? (g * 512 + h * 64 + e) : (1536 + (g - 3) * 128 + d * 64 + e);
      MU[i] = which ? mu_n[col] : mu_p[col];
    }
    if (tid_ < 320) {
      const int which = tid_ >> 6, e = tid_ & 63;
      float v;
      if (which == 0) v = p.in[I_W0][(size_t)(l * 2 + d) * 512 + h * 64 + e];
      else if (which == 1) v = p.in[I_A0][(size_t)(l * 2 + d) * 512 + h * 64 + e];
      else if (which == 2) v = p.in[I_K_K][(size_t)l * 512 + h * 64 + e];
      else if (which == 3) v = p.in[I_K_A][(size_t)l * 512 + h * 64 + e];
      else v = p.in[I_R_K][(size_t)(l * 8 + h) * 64 + e];
      CST[tid_] = v;
    }
    _Float16* Y = d ? YB : YF;
    if (is_prep) {
      bf16x8 bw[2], ba[2];
#pragma unroll
      for (int ks = 0; ks < 2; ++ks) {
        bw[ks] = *(const bf16x8*)(WB + W_WUP + (size_t)(d * 512 + h * 64 + w * 16 + fr) * 64 + ks * 32 + fq * 8);
        ba[ks] = *(const bf16x8*)(WB + W_AUP + (size_t)(d * 512 + h * 64 + w * 16 + fr) * 64 + ks * 32 + fq * 8);
      }
      u32x4 G[5], GH;
      {
        const int t = d ? (4095 - pn) : pn;
        const size_t tok = (size_t)s * 4096 + t;
#pragma unroll
        for (int g = 0; g < 5; ++g) {
          const int col = (g < 3) ? (g * 512 + h * 64) : (1536 + (g - 3) * 128 + d * 64);
          G[g] = *(const u32x4*)(PR + tok * PRW + col + j0);
        }
        GH = (u32x4){0u, 0u, 0u, 0u};
        if (tid < 80) {
          const int tlo = d ? (4095 - 31) : 0;
          const int th = hr ? (tlo + 32) : (tlo - 1);
          const int g = hc >> 3;
          const int col = (g < 3) ? (g * 512 + h * 64) : (1536 + (g - 3) * 128 + d * 64);
          if (th >= 0 && th <= 4095) GH = *(const u32x4*)(PR + ((size_t)s * 4096 + th) * PRW + col + (hc & 7) * 8);
        }
      }
#pragma unroll 1
      for (int ch = -1; ch < 128; ++ch) {
        const int c = ch + 1;
        const bool doprep = c < 128;
        float* OPS = (float*)(smem + PC_OPS + (c & 1) * PC_BUF);
        float* VV = OPS + 5 * 2048;
        const int n = c * 32 + pn;
        const int t = d ? (4095 - n) : n;
        const size_t tok = (size_t)s * 4096 + t;
        const int tlo = d ? (4095 - (c * 32 + 31)) : (c * 32);
        const int rrow = t - tlo + 1;
        __syncthreads();
        if (ch >= 1) {
          const float* YL = (const float*)(smem + PC_YL + ((ch - 1) & 1) * 8192);
          const int n1 = (ch - 1) * 32 + pn;
          const int t1 = d ? (4095 - n1) : n1;
          h16x8 o;
#pragma unroll
          for (int e = 0; e < 8; ++e) o[e] = (_Float16)YL[pn * 64 + j0 + e];
          *(h16x8*)(Y + ((size_t)s * 4096 + t1) * 512 + h * 64 + j0) = o;
        }
        if (doprep) {
#pragma unroll
          for (int g = 0; g < 5; ++g) *(u32x4*)(RAW + rrow * 320 + g * 64 + j0) = G[g];
          if (tid < 80) *(u32x4*)(RAW + (hr ? 33 : 0) * 320 + (hc >> 3) * 64 + (hc & 7) * 8) = GH;
        }
        __syncthreads();
        if (doprep) {
          if (c + 1 < 128) {
            const int n2 = n + 32;
            const int t2 = d ? (4095 - n2) : n2;
            const size_t tok2 = (size_t)s * 4096 + t2;
#pragma unroll
            for (int g = 0; g < 5; ++g) {
              const int col = (g < 3) ? (g * 512 + h * 64) : (1536 + (g - 3) * 128 + d * 64);
              G[g] = *(const u32x4*)(PR + tok2 * PRW + col + j0);
            }
            GH = (u32x4){0u, 0u, 0u, 0u};
            if (tid < 80) {
              const int tlo2 = d ? (tlo - 32) : (tlo + 32);
              const int th = hr ? (tlo2 + 32) : (tlo2 - 1);
              const int g = hc >> 3;
              const int col = (g < 3) ? (g * 512 + h * 64) : (1536 + (g - 3) * 128 + d * 64);
              if (th >= 0 && th <= 4095) GH = *(const u32x4*)(PR + ((size_t)s * 4096 + th) * PRW + col + (hc & 7) * 8);
            }
          }
#pragma unroll
          for (int g = 0; g < 5; ++g) {
            float cur[8], prv[8], nxt[8];
            load8bf(RAW + rrow * 320 + g * 64 + j0, cur);
            load8bf(RAW + (rrow - 1) * 320 + g * 64 + j0, prv);
            load8bf(RAW + (rrow + 1) * 320 + g * 64 + j0, nxt);
            const f32x4 mp0 = *(const f32x4*)(MU + g * 64 + j0), mp1 = *(const f32x4*)(MU + g * 64 + j0 + 4);
            const f32x4 mn0 = *(const f32x4*)(MU + 320 + g * 64 + j0), mn1 = *(const f32x4*)(MU + 320 + g * 64 + j0 + 4);
            f32x4 x0, x1;
#pragma unroll
            for (int e = 0; e < 4; ++e) {
              x0[e] = cur[e] + mp0[e] * (prv[e] - cur[e]) + mn0[e] * (nxt[e] - cur[e]);
              x1[e] = cur[4 + e] + mp1[e] * (prv[4 + e] - cur[4 + e]) + mn1[e] * (nxt[4 + e] - cur[4 + e]);
            }
            if (g == 0) {
              *(f32x4*)(OPS + 4 * 2048 + pn * 64 + j0) = x0; *(f32x4*)(OPS + 4 * 2048 + pn * 64 + j0 + 4) = x1;
            } else if (g == 1) {
              *(f32x4*)(OPS + 3 * 2048 + pn * 64 + j0) = x0; *(f32x4*)(OPS + 3 * 2048 + pn * 64 + j0 + 4) = x1;
              const f32x4 kk0 = *(const f32x4*)(CST + 128 + j0), kk1 = *(const f32x4*)(CST + 128 + j0 + 4);
              float ss = 0.f;
#pragma unroll
              for (int e = 0; e < 4; ++e) { const float a_ = x0[e] * kk0[e], b_ = x1[e] * kk1[e]; ss += a_ * a_ + b_ * b_; }
              ss = red8(ss);
              if ((tid & 7) == 0) NRM[pn] = frcp(fmaxf(__builtin_amdgcn_sqrtf(ss), 1e-12f));
            } else if (g == 2) {
              *(f32x4*)(VV + pn * 64 + j0) = x0; *(f32x4*)(VV + pn * 64 + j0 + 4) = x1;
            } else if (g == 3) {
              u32x4 pk;
              pk.x = pack2(ftanh(x0[0]), ftanh(x0[1])); pk.y = pack2(ftanh(x0[2]), ftanh(x0[3]));
              pk.z = pack2(ftanh(x1[0]), ftanh(x1[1])); pk.w = pack2(ftanh(x1[2]), ftanh(x1[3]));
              *(u32x4*)(TWb + pn * 72 + j0) = pk;
            } else {
              u32x4 pk;
              pk.x = pack2(x0[0], x0[1]); pk.y = pack2(x0[2], x0[3]);
              pk.z = pack2(x1[0], x1[1]); pk.w = pack2(x1[2], x1[3]);
              *(u32x4*)(ADb + pn * 72 + j0) = pk;
            }
          }
        }
        __syncthreads();
        if (doprep) {
#pragma unroll
          for (int m = 0; m < 2; ++m) {
            f32x4 cw = {0.f, 0.f, 0.f, 0.f}, ca = {0.f, 0.f, 0.f, 0.f};
#pragma unroll
            for (int ks = 0; ks < 2; ++ks) {
              const bf16x8 aw = *(const bf16x8*)(TWb + (m * 16 + fr) * 72 + ks * 32 + fq * 8);
              const bf16x8 aa = *(const bf16x8*)(ADb + (m * 16 + fr) * 72 + ks * 32 + fq * 8);
              cw = __builtin_amdgcn_mfma_f32_16x16x32_bf16(aw, bw[ks], cw, 0, 0, 0);
              ca = __builtin_amdgcn_mfma_f32_16x16x32_bf16(aa, ba[ks], ca, 0, 0, 0);
            }
#pragma unroll
            for (int jj = 0; jj < 4; ++jj) {
              WR[(m * 16 + fq * 4 + jj) * 64 + w * 16 + fr] = cw[jj];
              AP[(m * 16 + fq * 4 + jj) * 64 + w * 16 + fr] = ca[jj];
            }
          }
        }
        __syncthreads();
        if (doprep) {
          const float inv = NRM[pn];
          float bsum = 0.f;
#pragma unroll
          for (int hq = 0; hq < 2; ++hq) {
            const int jb = j0 + hq * 4;
            const f32x4 wr_ = *(const f32x4*)(WR + pn * 64 + jb) + *(const f32x4*)(CST + jb);
            const f32x4 ap_ = *(const f32x4*)(AP + pn * 64 + jb) + *(const f32x4*)(CST + 64 + jb);
            const f32x4 kr = *(const f32x4*)(OPS + 3 * 2048 + pn * 64 + jb);
            const f32x4 rr = *(const f32x4*)(OPS + 4 * 2048 + pn * 64 + jb);
            const f32x4 kkw = *(const f32x4*)(CST + 128 + jb), kaw = *(const f32x4*)(CST + 192 + jb), rkw = *(const f32x4*)(CST + 256 + jb);
            f32x4 o0, o1, o2, o3;
#pragma unroll
            for (int e = 0; e < 4; ++e) {
              const float sw = sigm(wr_[e]);
              const float dec = __expf(-0.6065306597126334f * sw);
              const float av = sigm(ap_[e]);
              const float kn = kr[e] * kkw[e] * inv;
              const float kd = kr[e] * (1.f + (av - 1.f) * kaw[e]);
              bsum += rr[e] * kd * rkw[e];
              o0[e] = -kn; o1[e] = dec; o2[e] = kn * av; o3[e] = kd;
            }
            *(f32x4*)(OPS + 0 * 2048 + pn * 64 + jb) = o0;
            *(f32x4*)(OPS + 1 * 2048 + pn * 64 + jb) = o1;
            *(f32x4*)(OPS + 2 * 2048 + pn * 64 + jb) = o2;
            *(f32x4*)(OPS + 3 * 2048 + pn * 64 + jb) = o3;
          }
          bsum = red8(bsum);
          if ((tid & 7) == 0) BON[(tok * 8 + h) * 2 + d] = bsum;
        }
      }
      __syncthreads();
      {
        const float* YL = (const float*)(smem + PC_YL + (127 & 1) * 8192);
        const int n1 = 127 * 32 + pn;
        const int t1 = d ? (4095 - n1) : n1;
        h16x8 o;
#pragma unroll
        for (int e = 0; e < 8; ++e) o[e] = (_Float16)YL[pn * 64 + j0 + e];
        *(h16x8*)(Y + ((size_t)s * 4096 + t1) * 512 + h * 64 + j0) = o;
      }
    } else {
      f32x2 S0[4], S1[4];
#pragma unroll
      for (int q = 0; q < 4; ++q) { S0[q] = (f32x2){0.f, 0.f}; S1[q] = (f32x2){0.f, 0.f}; }
#pragma unroll 1
      for (int ch = -1; ch < 128; ++ch) {
        const float* OPS = (const float*)(smem + PC_OPS + (ch & 1) * PC_BUF);
        const float* VV = OPS + 5 * 2048;
        float* YL = (float*)(smem + PC_YL + (ch & 1) * 8192);
        __syncthreads();
        if (ch < 0) {
          __syncthreads(); __syncthreads(); __syncthreads();
        } else {
          ScanOps oa, ob;
          scan_load(oa, OPS, VV, 0, jg, i0);
#pragma unroll 1
          for (int seg = 0; seg < 4; ++seg) {
            if (seg > 0) __syncthreads();
#pragma unroll 1
            for (int nn = seg * 8; nn < seg * 8 + 8; nn += 2) {
              scan_load(ob, OPS, VV, nn + 1, jg, i0);
              scan_step(oa, S0, S1, YL, nn, jg, i0);
              scan_load(oa, OPS, VV, (nn + 2) & 31, jg, i0);
              scan_step(ob, S0, S1, YL, nn + 1, jg, i0);
            }
          }
        }
      }
      __syncthreads();
    }
    __syncthreads();
  }
}

DEVI void phase_rwkv_post(int tid_, int vb_, int vg_, const Params& p, int l, char* smem) {
  u16* PR = (u16*)(p.ws + OFF_PR);
  const _Float16* YF = (const _Float16*)(p.ws + OFF_H);
  const _Float16* YB = (const _Float16*)(p.ws + OFF_H + (size_t)NTOK * 512 * 2);
  const float* BON = (const float*)(p.ws + OFF_BONUS);
  const u16* GUPT = (const u16*)(p.ws + OFF_WB) + W_GUP;
  const float* mu_p = p.in[I_MU_PREV] + (size_t)l * 1920;
  const float* mu_n = p.in[I_MU_NEXT] + (size_t)l * 1920;
  const float* gng = p.in[I_GN_G] + (size_t)l * 512;
  const float* gnb = p.in[I_GN_B] + (size_t)l * 512;
  u16* As = (u16*)smem;
  const int tid = tid_, lane = tid & 63, w = tid >> 6, fr = lane & 15, fq = lane >> 4;
  for (int tile = vb_; tile < NTOK / 64; tile += vg_) {
    const size_t tok0 = (size_t)tile * 64;
    {
      const int row = tid >> 2, part = tid & 3;
      const size_t tok = tok0 + row;
      const int t = (int)(tok & 4095);
#pragma unroll
      for (int q = 0; q < 4; ++q) {
        const int col = 1792 + part * 32 + q * 8;
        float cur[8], prv[8], nxt[8];
        load8bf(PR + tok * PRW + col, cur);
        if (t > 0) load8bf(PR + (tok - 1) * PRW + col, prv);
        else {
#pragma unroll
          for (int e = 0; e < 8; ++e) prv[e] = 0.f;
        }
        if (t < 4095) load8bf(PR + (tok + 1) * PRW + col, nxt);
        else {
#pragma unroll
          for (int e = 0; e < 8; ++e) nxt[e] = 0.f;
        }
        float o[8];
#pragma unroll
        for (int e = 0; e < 8; ++e) {
          const float x = cur[e] + mu_p[col + e] * (prv[e] - cur[e]) + mu_n[col + e] * (nxt[e] - cur[e]);
          o[e] = sigm(x);
        }
        u32x4 pk;
        pk.x = pack2(o[0], o[1]); pk.y = pack2(o[2], o[3]); pk.z = pack2(o[4], o[5]); pk.w = pack2(o[6], o[7]);
        *(u32x4*)(As + row * 136 + part * 32 + q * 8) = pk;
      }
    }
    asm volatile("" ::: "memory");
#pragma unroll 1
    for (int chh = 0; chh < 2; ++chh) {
      f32x4 acc[16];
#pragma unroll
      for (int n = 0; n < 16; ++n) acc[n] = (f32x4){0.f, 0.f, 0.f, 0.f};
#pragma unroll
      for (int ks = 0; ks < 4; ++ks) {
        bf16x8 af = *(const bf16x8*)(As + (w * 16 + fr) * 136 + ks * 32 + fq * 8);
#pragma unroll
        for (int n = 0; n < 16; ++n) {
          bf16x8 bg = *(const bf16x8*)(GUPT + (size_t)(chh * 256 + n * 16 + fr) * 128 + ks * 32 + fq * 8);
          acc[n] = __builtin_amdgcn_mfma_f32_16x16x32_bf16(af, bg, acc[n], 0, 0, 0);
        }
      }
#pragma unroll
      for (int hl = 0; hl < 4; ++hl) {
        const int head = chh * 4 + hl;
        asm volatile("" ::: "memory");
#pragma unroll
        for (int j = 0; j < 4; ++j) {
          const size_t tok = tok0 + w * 16 + fq * 4 + j;
          const int t = (int)(tok & 4095);
          float o[4], sum = 0.f;
#pragma unroll
          for (int q = 0; q < 4; ++q) {
            const int col = head * 64 + q * 16 + fr;
            o[q] = (float)YF[tok * 512 + col] + (float)YB[tok * 512 + col];
            sum += o[q];
          }
          const float mean = red16_sum(sum) * (1.f / 64.f);
          float vs = 0.f;
#pragma unroll
          for (int q = 0; q < 4; ++q) { const float dlt = o[q] - mean; vs += dlt * dlt; }
          const float var = red16_sum(vs) * (1.f / 64.f);
          const float rstd = rsqrtf(var + 64e-5f);
          const float bon = BON[(tok * 8 + head) * 2] + BON[(tok * 8 + head) * 2 + 1];
#pragma unroll
          for (int q = 0; q < 4; ++q) {
            const int col = head * 64 + q * 16 + fr;
            const int vc = 1024 + col;
            const float cur = bf2f(PR[tok * PRW + vc]);
            const float prv = (t > 0) ? bf2f(PR[(tok - 1) * PRW + vc]) : 0.f;
            const float nxt = (t < 4095) ? bf2f(PR[(tok + 1) * PRW + vc]) : 0.f;
            const float vsh = cur + mu_p[vc] * (prv - cur) + mu_n[vc] * (nxt - cur);
            const float yv = ((o[q] - mean) * rstd * gng[col] + gnb[col] + bon * vsh) * acc[hl * 4 + q][j];
            PR[tok * PRW + col] = f2bf(yv);
          }
        }
      }
    }
  }
}

DEVI f32x4 ld4bf(const u16* p) {
  const u32x2 u = *(const u32x2*)p;
  f32x4 o;
  o[0] = __uint_as_float(u.x << 16); o[1] = __uint_as_float(u.x & 0xffff0000u);
  o[2] = __uint_as_float(u.y << 16); o[3] = __uint_as_float(u.y & 0xffff0000u);
  return o;
}

DEVI void phase_merge(int tid_, const Params& p, char* smem, const float* ssq) {
  const u16* WB = (const u16*)(p.ws + OFF_WB);
  const u16* H = (const u16*)(p.ws + OFF_NK);
  u16* PR = (u16*)(p.ws + OFF_PR);
  const u16* NQ = (const u16*)(p.ws + OFF_NQ);
  u16* TMP = (u16*)(p.ws + OFF_H);
  const int lane = tid_ & 63, wid = tid_ >> 6;
  const int wr = wid >> 2, wc = wid & 3, fr = lane & 15, fq = lane >> 4;
  const bool xmap = (gridDim.x & 7) == 0;
  const int xcd = blockIdx.x & 7;
  const int first = xmap ? (int)(blockIdx.x >> 3) : (int)blockIdx.x;
  const int stride = xmap ? (int)(gridDim.x >> 3) : (int)gridDim.x;
  const int count = xmap ? 24 * 4 : 192 * 4;
  for (int it = first; it < count; it += stride) {
    const int tm = xmap ? (it >> 2) * 8 + xcd : (it >> 2), tn = it & 3;
    const int m0 = tm << 8, n0 = tn << 8;
    f32x4 acc[8][4];
#define MERGE_ZERO() _Pragma("unroll") for (int m = 0; m < 8; ++m) _Pragma("unroll") for (int n = 0; n < 4; ++n) acc[m][n] = (f32x4){0.f, 0.f, 0.f, 0.f}
#define MERGE_RC() const int r = m0 + wr * 128 + m * 16 + fr, c0 = n0 + wc * 64 + n * 16 + fq * 4
    MERGE_ZERO();
    gemm_kloop8<true>(launder(tid_), acc, H + (size_t)m0 * 1024, 1024, WB + W_IN + (size_t)(3456 + n0) * 1024, 1024, 1024, smem);
#pragma unroll
    for (int m = 0; m < 8; ++m)
#pragma unroll
      for (int n = 0; n < 4; ++n) {
        MERGE_RC();
        const float rs = rstd_of(ssq, r);
        f32x4 o;
#pragma unroll
        for (int j = 0; j < 4; ++j) o[j] = sigm(acc[m][n][j] * rs);
        store4bf(PR + (size_t)r * PRW + 512 + c0, o);
      }
    MERGE_ZERO();
    gemm_kloop8<true>(launder(tid_), acc, PR + (size_t)m0 * PRW, PRW, WB + W_BRR + (size_t)n0 * 512, 512, 512, smem);
#pragma unroll
    for (int m = 0; m < 8; ++m)
#pragma unroll
      for (int n = 0; n < 4; ++n) {
        MERGE_RC();
        u16* dst = PR + (size_t)r * PRW + 512 + c0;
        store4bf(dst, ld4bf(dst) * acc[m][n]);
      }
    MERGE_ZERO();
    gemm_kloop8<true>(launder(tid_), acc, H + (size_t)m0 * 1024, 1024, WB + W_IN + (size_t)(4480 + n0) * 1024, 1024, 1024, smem);
#pragma unroll
    for (int m = 0; m < 8; ++m)
#pragma unroll
      for (int n = 0; n < 4; ++n) {
        MERGE_RC();
        const float rs = rstd_of(ssq, r);
        f32x4 o;
#pragma unroll
        for (int j = 0; j < 4; ++j) o[j] = sigm(acc[m][n][j] * rs);
        store4bf(TMP + (size_t)r * 1024 + c0, o);
      }
    MERGE_ZERO();
    gemm_kloop8<true>(launder(tid_), acc, NQ + (size_t)m0 * 512, 512, WB + W_BRN + (size_t)n0 * 512, 512, 512, smem);
#pragma unroll
    for (int m = 0; m < 8; ++m)
#pragma unroll
      for (int n = 0; n < 4; ++n) {
        MERGE_RC();
        u16* dst = PR + (size_t)r * PRW + 512 + c0;
        store4bf(dst, ld4bf(dst) + ld4bf(TMP + (size_t)r * 1024 + c0) * acc[m][n]);
      }
#undef MERGE_ZERO
#undef MERGE_RC
  }
}


DEVI void phase_xattn(int tid_, int vb_, int vg_, const Params& p, char* smem) {
  const u16* Q = (const u16*)(p.ws + OFF_PR);
  u16* O = (u16*)(p.ws + OFF_NQ);
  const u16* KVK = (const u16*)(p.ws + OFF_KVK);
  const u16* KVT = (const u16*)(p.ws + OFF_KVT);
  const int lane = tid_ & 63, w = tid_ >> 6, fr = lane & 15, fq = lane >> 4;
  u16* Pw = (u16*)smem + w * (32 * 264);
  for (int t = vb_; t < (NTOK / 128) * 4; t += vg_) {
    const int hh = t & 3;
    const size_t tok0 = (size_t)(t >> 2) * 128 + w * 32;
    const int s = (int)(tok0 >> 12);
    f32x4 acc[2][16];
#pragma unroll
    for (int mt = 0; mt < 2; ++mt)
#pragma unroll
      for (int n = 0; n < 16; ++n) acc[mt][n] = (f32x4){0.f, 0.f, 0.f, 0.f};
#pragma unroll 1
    for (int ks = 0; ks < 8; ++ks) {
      const bf16x8 aq0 = *(const bf16x8*)(Q + (tok0 + fr) * 1024 + hh * 256 + ks * 32 + fq * 8);
      const bf16x8 aq1 = *(const bf16x8*)(Q + (tok0 + 16 + fr) * 1024 + hh * 256 + ks * 32 + fq * 8);
#pragma unroll
      for (int n = 0; n < 16; ++n) {
        const bf16x8 bk = *(const bf16x8*)(KVK + (size_t)(s * 256 + n * 16 + fr) * 1024 + hh * 256 + ks * 32 + fq * 8);
        acc[0][n] = __builtin_amdgcn_mfma_f32_16x16x32_bf16(bk, aq0, acc[0][n], 0, 0, 0);
        acc[1][n] = __builtin_amdgcn_mfma_f32_16x16x32_bf16(bk, aq1, acc[1][n], 0, 0, 0);
      }
    }
    float sm[2];
#pragma unroll
    for (int mt = 0; mt < 2; ++mt) {
      float m = -1e30f;
#pragma unroll
      for (int n = 0; n < 16; ++n)
#pragma unroll
        for (int j = 0; j < 4; ++j) m = fmaxf(m, acc[mt][n][j]);
      m = red4x_max(m) * 0.0625f;
      float ssum = 0.f;
#pragma unroll
      for (int n = 0; n < 16; ++n) {
        f32x4 e;
#pragma unroll
        for (int j = 0; j < 4; ++j) { e[j] = __expf(acc[mt][n][j] * 0.0625f - m); ssum += e[j]; }
        store4bf(Pw + (mt * 16 + fr) * 264 + n * 16 + fq * 4, e);
      }
      sm[mt] = 1.f / red4x_sum(ssum);
    }
#pragma unroll
    for (int mt = 0; mt < 2; ++mt)
#pragma unroll
      for (int n = 0; n < 16; ++n) acc[mt][n] = (f32x4){0.f, 0.f, 0.f, 0.f};
#pragma unroll 1
    for (int ks = 0; ks < 8; ++ks) {
      const bf16x8 ap0 = *(const bf16x8*)(Pw + fr * 264 + ks * 32 + fq * 8);
      const bf16x8 ap1 = *(const bf16x8*)(Pw + (16 + fr) * 264 + ks * 32 + fq * 8);
#pragma unroll
      for (int n = 0; n < 16; ++n) {
        const bf16x8 bv = *(const bf16x8*)(KVT + (size_t)(s * 1024 + hh * 256 + n * 16 + fr) * 256 + ks * 32 + fq * 8);
        acc[0][n] = __builtin_amdgcn_mfma_f32_16x16x32_bf16(bv, ap0, acc[0][n], 0, 0, 0);
        acc[1][n] = __builtin_amdgcn_mfma_f32_16x16x32_bf16(bv, ap1, acc[1][n], 0, 0, 0);
      }
    }
#pragma unroll
    for (int mt = 0; mt < 2; ++mt)
#pragma unroll
      for (int n = 0; n < 16; ++n)
        store4bf(O + (tok0 + mt * 16 + fr) * 1024 + hh * 256 + n * 16 + fq * 4, acc[mt][n] * sm[mt]);
  }
}

constexpr int HALF_SMEM = 78720;

DEVI void run_phase(int tid_, const Params& p, int ph, char* smem) {
  const int half = tid_ >> 8, vt = tid_ & 255;
  const int vb_ = blockIdx.x * 2 + half, vg_ = gridDim.x * 2;
  char* smh = smem + half * HALF_SMEM;
  if (ph == 2 * NPH_LAYER) { phase_final_norm(vt, vb_, vg_, p); return; }
  const int l = ph / NPH_LAYER, q = ph % NPH_LAYER;
  u16* WB = (u16*)(p.ws + OFF_WB);
  u16* H = (u16*)(p.ws + OFF_H);
  u16* PR = (u16*)(p.ws + OFF_PR);
  u16* NQ = (u16*)(p.ws + OFF_NQ);
  float* X = p.X;
  float* SSQ = (float*)(p.ws + OFF_SSQ);
  auto epi_res = [&](int r, int c0, f32x4 v) {
    f32x4* px = (f32x4*)(X + (size_t)r * 1024 + c0);
    *px = *px + v;
  };
  float rowacc = 0.f;
  float* ssq_out = SSQ;
  const bool x_from_input = (l == 0 && q <= 5);
  const bool need_xb = !(l == 1 && q == 12);
  auto epi_res_n = [&](int r, int c0, f32x4 v) {
    f32x4* px = (f32x4*)(X + (size_t)r * 1024 + c0);
    const float* srow = x_from_input ? ((r < 32768) ? p.in[I_XP] + (size_t)r * 1024 : p.in[I_XS] + (size_t)(r - 32768) * 1024)
                                     : X + (size_t)r * 1024;
    const f32x4 xn = *(const f32x4*)(srow + c0) + v;
    *px = xn;
    if (need_xb) store4bf(H + (size_t)r * 1024 + c0, xn);
    rowacc += xn[0] * xn[0] + xn[1] * xn[1] + xn[2] * xn[2] + xn[3] * xn[3];
  };
  auto row_end = [&](int r) {
    float t = rowacc;
    t += __shfl_xor(t, 16);
    t += __shfl_xor(t, 32);
    if ((tid_ & 48) == 0) atomicAdd(ssq_out + r, t);
    rowacc = 0.f;
  };
  constexpr int NONS = 1 << 30;
  switch (q) {
    case 0:
      phase_conv(vt, vb_, vg_, p, l, smh);
      phase_norm_mem(vt, vb_, vg_, p, p.in[I_NORM_MEM] + (size_t)l * 1024);
      if (l == 0) {
        phase_xb(vt, vb_, vg_, p, true, OFF_H, SSQ);
        for (int i = vb_ * 256 + vt; i < 6 * NTOK; i += vg_ * 256) SSQ[NTOK + i] = 0.f;
      }
      break;
    case 1: phase_p_gemm(tid_, p, smem, SSQ + (size_t)(3 * l) * NTOK); break;
    case 2:
      if (gridDim.x >= 224) {
        if (blockIdx.x < 192) phase_scan_pc(tid_, p, l, smem, blockIdx.x, gridDim.x);
        else phase_nat(vt, p, l, smh, vb_ - 384, vg_ - 384);
      } else {
        phase_scan(vt, p, l, smh, vb_, vg_);
        __syncthreads();
        phase_nat(vt, p, l, smh, vb_, vg_);
      }
      break;
    case 3:
      phase_rwkv_post(vt, vb_, vg_, p, l, smh);
      phase_xb(vt, vb_, vg_, p, l == 0, OFF_NK, nullptr);
      break;
    case 4: phase_merge(tid_, p, smem, SSQ + (size_t)(3 * l) * NTOK); break;
    case 5:
      ssq_out = SSQ + (size_t)(3 * l + 1) * NTOK;
      gemm_phase8(tid_, PR + 512, PRW, WB + W_OUT, 1024, 1024, NTOK, 1024, smem, NONS, epi_res_n, NoEpi(), row_end);
      break;
    case 6: {
      const float* ssq = SSQ + (size_t)(3 * l + 1) * NTOK;
      gemm_phase8(tid_, H, 1024, WB + W_XQ, 1024, 1024, NTOK, 1024, smem, NONS,
                 [&](int r, int c0, f32x4 v) { store4bf(PR + (size_t)r * 1024 + c0, v * rstd_of(ssq, r)); }, NoEpi());
    } break;
    case 7: phase_xattn(vt, vb_, vg_, p, smh); break;
    case 8:
      ssq_out = SSQ + (size_t)(3 * l + 2) * NTOK;
      gemm_phase8(tid_, NQ, 1024, WB + W_XO, 1024, 1024, NTOK, 1024, smem, NONS, epi_res_n, NoEpi(), row_end);
      break;
    case 9:
    case 11: {
      const int hf = (q == 11);
      const float* ssq = SSQ + (size_t)(3 * l + 2) * NTOK;
      gemm_phase8(tid_, H, 1024, WB + W_FF1 + (size_t)hf * 2048 * 1024, 1024, 1024, NTOK, 2048, smem, NONS,
                 [&](int r, int c0, f32x4 v) {
                   const float rs = rstd_of(ssq, r);
                   f32x4 o;
#pragma unroll
                   for (int j = 0; j < 4; ++j) { const float x = fmaxf(v[j] * rs, 0.f); o[j] = x * x; }
                   store4bf(PR + (size_t)r * 2048 + c0, o);
                 }, NoEpi());
    } break;
    case 10:
      gemm_phase8(tid_, PR, 2048, WB + W_FF2, 4096, 2048, NTOK, 1024, smem, NONS, epi_res, NoEpi());
      break;
    case 12:
      ssq_out = SSQ + (size_t)(3 * l + 3) * NTOK;
      gemm_phase8(tid_, PR, 2048, WB + W_FF2 + 2048, 4096, 2048, NTOK, 1024, smem, NONS, epi_res_n, NoEpi(), row_end);
      break;
  }
}

#define XB_TMO      128
#define XB_XCNT(j)  (256  + 64 * (j))
#define XB_XSUB(j)  (1280 + 64 * (j))
#define XB_XGEN(j)  (2304 + 64 * (j))
#define XB_TOP      3328
#define XB_TOPGEN   3392
#define XCD_BAR_WORDS 3456
#define XB_SPIN_CAP (1u << 20)
#define LAS __attribute__((address_space(3)))

DEVI unsigned xb_ld(unsigned* p) { return __hip_atomic_load(p, __ATOMIC_RELAXED, __HIP_MEMORY_SCOPE_AGENT); }
DEVI unsigned xb_add(unsigned* p, unsigned v) { return __hip_atomic_fetch_add(p, v, __ATOMIC_RELAXED, __HIP_MEMORY_SCOPE_AGENT); }
DEVI unsigned xb_xcc_id() { return (unsigned)__builtin_amdgcn_s_getreg((3 << 11) | 20) & 0xFu; }
#define XB_SPIN(cond, bar) do { unsigned _sp = 0; while (cond) { __builtin_amdgcn_s_sleep(1); \
    if ((++_sp & 255u) == 0u) { if (xb_ld(&(bar)[XB_TMO])) break; if (_sp > XB_SPIN_CAP) { atomicAdd(&(bar)[XB_TMO], 1u); break; } } } } while (0)

struct XcdBarrier {
  unsigned* bar; unsigned x;
  volatile LAS unsigned* st;
};
DEVI XcdBarrier xcd_barrier_post(unsigned* bar, volatile LAS unsigned* st) {
  XcdBarrier b; b.bar = bar; b.x = xb_xcc_id(); b.st = st;
  if (threadIdx.x == 0) (void)xb_add(&bar[XB_XCNT(b.x)], 1u);
  return b;
}
DEVI void xcd_barrier_complete(unsigned* bar, unsigned x, unsigned& nloc, unsigned& nx) {
  const unsigned G = gridDim.x * gridDim.y * gridDim.z;
  unsigned sum, cnt, mine, sp = 0u;
  for (;;) {
    sum = 0u; cnt = 0u; mine = 0u;
#pragma unroll
    for (unsigned j = 0; j < 16; ++j) { const unsigned c = xb_ld(&bar[XB_XCNT(j)]); sum += c; cnt += (c > 0u) ? 1u : 0u; mine = (j == x) ? c : mine; }
    if (sum == G) break;
    __builtin_amdgcn_s_sleep(1);
    if ((++sp & 255u) == 0u) { if (xb_ld(&bar[XB_TMO])) break; if (sp > XB_SPIN_CAP) { atomicAdd(&bar[XB_TMO], 1u); break; } }
  }
  nloc = mine > 0u ? mine : 1u; nx = cnt > 0u ? cnt : 1u;
}
DEVI void xcd_barrier(const XcdBarrier& b) {
  asm volatile("s_waitcnt vmcnt(0)" ::: "memory");
  __syncthreads();
  if (threadIdx.x == 0) {
    unsigned* bar = b.bar;
    __builtin_amdgcn_s_waitcnt(0);
    unsigned nloc = b.st[0], nx = b.st[1];
    if (nloc == 0u) { xcd_barrier_complete(bar, b.x, nloc, nx); b.st[0] = nloc; b.st[1] = nx; }
    const unsigned old = xb_add(&bar[XB_XSUB(b.x)], 1u);
    const unsigned gen = old / nloc;
    if (old + 1u == (gen + 1u) * nloc) {
      __builtin_amdgcn_fence(__ATOMIC_RELEASE, "agent");
      asm volatile("s_waitcnt vmcnt(0)" ::: "memory");
      const unsigned og = xb_add(&bar[XB_TOP], 1u);
      const unsigned tg = og / nx;
      if (og + 1u == (tg + 1u) * nx) xb_add(&bar[XB_TOPGEN], 1u);
      else XB_SPIN(xb_ld(&bar[XB_TOPGEN]) == tg, bar);
      __builtin_amdgcn_fence(__ATOMIC_ACQUIRE, "agent");
      xb_add(&bar[XB_XGEN(b.x)], 1u);
      asm volatile("s_waitcnt vmcnt(0)" ::: "memory");
    } else {
      XB_SPIN(xb_ld(&bar[XB_XGEN(b.x)]) == gen, bar);
      __builtin_amdgcn_fence(__ATOMIC_ACQUIRE, "agent");
      asm volatile("s_waitcnt vmcnt(0)" ::: "memory");
    }
  }
  __syncthreads();
}

__global__ void __launch_bounds__(512, 2) mega_kernel(Params p, int ph0, int ph1) {
  __shared__ __attribute__((aligned(16))) char smem[2 * HALF_SMEM];
  __shared__ __attribute__((aligned(16))) unsigned xb_words[4];
  if (threadIdx.x == 0) { xb_words[0] = 0u; xb_words[1] = 0u; xb_words[2] = 0u; xb_words[3] = 0u; }
  __syncthreads();
  XcdBarrier xb = xcd_barrier_post((unsigned*)(p.ws + OFF_BAR), (volatile LAS unsigned*)xb_words);
  for (int ph = ph0; ph < ph1; ++ph) {
    if (ph == ph0 + 1) cg::this_grid().sync();
    else if (ph > ph0) xcd_barrier(xb);
    int tid_ = threadIdx.x;
    asm volatile("" : "+v"(tid_));
    run_phase(tid_, p, ph, smem);
  }
}

extern "C" void kernel_launch(void* const* d_in, const int* in_sizes, int n_in, void* d_out, int out_size, void* d_ws,
                              size_t ws_size, hipStream_t stream) {
  if (ws_size < WS_NEED || n_in < 31) return;
  Params p{};
  for (int i = 0; i < 31; ++i) p.in[i] = (const float*)d_in[i];
  p.X = (float*)d_out;
  p.ws = (char*)d_ws;
  static int grid_blocks = 0;
  if (!grid_blocks) {
    int dev = 0, cus = 0, per_cu = 0;
    hipGetDevice(&dev);
    hipDeviceGetAttribute(&cus, hipDeviceAttributeMultiprocessorCount, dev);
    hipOccupancyMaxActiveBlocksPerMultiprocessor(&per_cu, mega_kernel, 512, 0);
    if (per_cu > 1) per_cu = 1;
    if (per_cu < 1) per_cu = 1;
    grid_blocks = cus * per_cu;
  }
  hipMemsetAsync((char*)d_ws + OFF_BAR, 0, 16384, stream);
  int ph0 = 0, ph1 = NPHASES;
  void* args[] = {&p, &ph0, &ph1};
  hipLaunchCooperativeKernel((void*)mega_kernel, dim3(grid_blocks), dim3(512), args, 0, stream);
}
```

```cpp
#include <hip/hip_runtime.h>
#include <hip/hip_cooperative_groups.h>
#include <stdint.h>
namespace cg = cooperative_groups;

typedef unsigned short u16;
typedef __attribute__((ext_vector_type(8))) short bf16x8;
typedef __attribute__((ext_vector_type(4))) float f32x4;
typedef __attribute__((ext_vector_type(8))) _Float16 h16x8;
typedef __attribute__((ext_vector_type(4))) unsigned int u32x4;
typedef __attribute__((ext_vector_type(2))) unsigned int u32x2;

#define DEVI __device__ __forceinline__

constexpr int NTOK = 49152;
constexpr int SEQ_T = 4096;
constexpr int PRW = 1920;
constexpr int NPH_LAYER = 13;
constexpr int NPHASES = 2 * NPH_LAYER + 1;
constexpr int SMEM_BYTES = 78720;

constexpr size_t OFF_WB = 0;
constexpr size_t WB_BYTES = 20512768ull * 2;
constexpr size_t OFF_H = OFF_WB + WB_BYTES;
constexpr size_t OFF_PR = OFF_H + (size_t)NTOK * 1024 * 2;
constexpr size_t OFF_NQ = OFF_PR + (size_t)NTOK * PRW * 2;
constexpr size_t OFF_NK = OFF_NQ + (size_t)NTOK * 512 * 2;
constexpr size_t OFF_NV = OFF_NK + (size_t)NTOK * 512 * 2;
constexpr size_t OFF_KVK = OFF_NV + (size_t)NTOK * 512 * 2;
constexpr size_t OFF_KVT = OFF_KVK + (size_t)3072 * 1024 * 2;
constexpr size_t OFF_MEMH = OFF_KVT + (size_t)3072 * 1024 * 2;
constexpr size_t OFF_BONUS = OFF_MEMH + (size_t)3072 * 1024 * 2;
constexpr size_t OFF_BAR = OFF_BONUS + (size_t)NTOK * 16 * 4;
constexpr size_t OFF_SSQ = OFF_BAR + 16384;
constexpr size_t WS_NEED = OFF_SSQ + (size_t)7 * NTOK * 4;

constexpr size_t W_IN = 0;
constexpr size_t W_BRR = W_IN + (size_t)5504 * 1024;
constexpr size_t W_BRN = W_BRR + (size_t)1024 * 512;
constexpr size_t W_OUT = W_BRN + (size_t)1024 * 512;
constexpr size_t W_XQ = W_OUT + (size_t)1024 * 1024;
constexpr size_t W_XKV = W_XQ + (size_t)1024 * 1024;
constexpr size_t W_XO = W_XKV + (size_t)2048 * 1024;
constexpr size_t W_FF1 = W_XO + (size_t)1024 * 1024;
constexpr size_t W_FF2 = W_FF1 + (size_t)4096 * 1024;
constexpr size_t W_GUP = W_FF2 + (size_t)4096 * 1024;
constexpr size_t W_WUP = W_GUP + (size_t)512 * 128;
constexpr size_t W_AUP = W_WUP + (size_t)2 * 512 * 64;

enum { I_XP = 0, I_XS, I_MP, I_MS, I_NORM_MIX, I_W_IN, I_MU_PREV, I_MU_NEXT, I_W0, I_W_UP, I_A0, I_A_UP,
       I_G_UP, I_K_K, I_K_A, I_R_K, I_GN_G, I_GN_B, I_RPB, I_W_BR_RWKV, I_W_BR_NAT, I_W_OUT, I_NORM_X,
       I_NORM_MEM, I_W_XQ, I_W_XKV, I_W_XO, I_NORM_FF, I_W_FF1, I_W_FF2, I_NORM_FINAL };

struct Params {
  const float* in[31];
  float* X;
  char* ws;
};

DEVI u16 f2bf(float f) {
  uint32_t u = __float_as_uint(f);
  u += 0x7FFFu + ((u >> 16) & 1u);
  return (u16)(u >> 16);
}
DEVI float bf2f(u16 h) { return __uint_as_float(((uint32_t)h) << 16); }
DEVI uint32_t pack2(float a, float b) { return (uint32_t)f2bf(a) | ((uint32_t)f2bf(b) << 16); }
DEVI float frcp(float x) { return __builtin_amdgcn_rcpf(x); }
DEVI float sigm(float x) { return frcp(1.f + __expf(-x)); }
DEVI float ftanh(float x) { return 1.f - 2.f * frcp(__expf(2.f * x) + 1.f); }
DEVI void unpack8(u32x4 u, float* o) {
  o[0] = __uint_as_float(u.x << 16); o[1] = __uint_as_float(u.x & 0xffff0000u);
  o[2] = __uint_as_float(u.y << 16); o[3] = __uint_as_float(u.y & 0xffff0000u);
  o[4] = __uint_as_float(u.z << 16); o[5] = __uint_as_float(u.z & 0xffff0000u);
  o[6] = __uint_as_float(u.w << 16); o[7] = __uint_as_float(u.w & 0xffff0000u);
}
DEVI void load8bf(const u16* p, float* o) { unpack8(*(const u32x4*)p, o); }
DEVI float wave_sum(float v) {
  v += __shfl_xor(v, 32); v += __shfl_xor(v, 16); v += __shfl_xor(v, 8);
  v += __shfl_xor(v, 4); v += __shfl_xor(v, 2); v += __shfl_xor(v, 1);
  return v;
}
DEVI float red4x_sum(float v) { v += __shfl_xor(v, 16); v += __shfl_xor(v, 32); return v; }
DEVI float red4x_max(float v) { v = fmaxf(v, __shfl_xor(v, 16)); v = fmaxf(v, __shfl_xor(v, 32)); return v; }
DEVI float red16_sum(float v) {
  v += __shfl_xor(v, 1); v += __shfl_xor(v, 2); v += __shfl_xor(v, 4); v += __shfl_xor(v, 8);
  return v;
}
DEVI float red16_max(float v) {
  v = fmaxf(v, __shfl_xor(v, 1)); v = fmaxf(v, __shfl_xor(v, 2));
  v = fmaxf(v, __shfl_xor(v, 4)); v = fmaxf(v, __shfl_xor(v, 8));
  return v;
}

DEVI void conv_tile(int tid_, const float* src, int K, int N, u16* dst, int tile, char* smem, const float* gain = nullptr) {
  float (*s)[65] = (float (*)[65])smem;
  const int nN = N >> 6;
  const int tk = tile / nN, tn = tile - tk * nN;
  const int tx = tid_ & 63, ty = tid_ >> 6;
  for (int r = ty; r < 64; r += 4) s[r][tx] = src[(size_t)(tk * 64 + r) * N + tn * 64 + tx];
  __syncthreads();
  const float gk = gain ? gain[tk * 64 + tx] : 1.f;
  for (int r = ty; r < 64; r += 4) dst[(size_t)(tn * 64 + r) * K + tk * 64 + tx] = f2bf(s[tx][r] * gk);
  __syncthreads();
}

DEVI void phase_conv(int tid_, int vb_, int vg_, const Params& p, int l, char* smem) {
  u16* WB = (u16*)(p.ws + OFF_WB);
  const int c0 = 1376, c1 = c0 + 128, c2 = c1 + 128, c3 = c2 + 256, c4 = c3 + 256, c5 = c4 + 512,
            c6 = c5 + 256, c7 = c6 + 1024, c8 = c7 + 1024, c9 = c8 + 16, c10 = c9 + 16, c11 = c10 + 16;
  for (int t = vb_; t < c11; t += vg_) {
    if (t < c0) conv_tile(tid_, p.in[I_W_IN] + (size_t)l * 1024 * 5504, 1024, 5504, WB + W_IN, t, smem, p.in[I_NORM_MIX] + (size_t)l * 1024);
    else if (t < c1) conv_tile(tid_, p.in[I_W_BR_RWKV] + (size_t)l * 512 * 1024, 512, 1024, WB + W_BRR, t - c0, smem);
    else if (t < c2) conv_tile(tid_, p.in[I_W_BR_NAT] + (size_t)l * 512 * 1024, 512, 1024, WB + W_BRN, t - c1, smem);
    else if (t < c3) conv_tile(tid_, p.in[I_W_OUT] + (size_t)l * 1024 * 1024, 1024, 1024, WB + W_OUT, t - c2, smem);
    else if (t < c4) conv_tile(tid_, p.in[I_W_XQ] + (size_t)l * 1024 * 1024, 1024, 1024, WB + W_XQ, t - c3, smem, p.in[I_NORM_X] + (size_t)l * 1024);
    else if (t < c5) conv_tile(tid_, p.in[I_W_XKV] + (size_t)l * 1024 * 2048, 1024, 2048, WB + W_XKV, t - c4, smem);
    else if (t < c6) conv_tile(tid_, p.in[I_W_XO] + (size_t)l * 1024 * 1024, 1024, 1024, WB + W_XO, t - c5, smem);
    else if (t < c7) conv_tile(tid_, p.in[I_W_FF1] + (size_t)l * 1024 * 4096, 1024, 4096, WB + W_FF1, t - c6, smem, p.in[I_NORM_FF] + (size_t)l * 1024);
    else if (t < c8) conv_tile(tid_, p.in[I_W_FF2] + (size_t)l * 4096 * 1024, 4096, 1024, WB + W_FF2, t - c7, smem);
    else if (t < c9) conv_tile(tid_, p.in[I_G_UP] + (size_t)l * 128 * 512, 128, 512, WB + W_GUP, t - c8, smem);
    else if (t < c10) { const int dd = (t - c9) >> 3; conv_tile(tid_, p.in[I_W_UP] + (size_t)(l * 2 + dd) * 64 * 512, 64, 512, WB + W_WUP + (size_t)dd * 512 * 64, (t - c9) & 7, smem); }
    else { const int dd = (t - c10) >> 3; conv_tile(tid_, p.in[I_A_UP] + (size_t)(l * 2 + dd) * 64 * 512, 64, 512, WB + W_AUP + (size_t)dd * 512 * 64, (t - c10) & 7, smem); }
  }
}

DEVI void norm_row_bf16(int tid_, const float* src, const float* g, u16* dst, float* xcopy) {
  const int lane = tid_ & 63;
  float4 v[4];
  float ss = 0.f;
#pragma unroll
  for (int i = 0; i < 4; ++i) {
    v[i] = ((const float4*)src)[lane + i * 64];
    ss += v[i].x * v[i].x + v[i].y * v[i].y + v[i].z * v[i].z + v[i].w * v[i].w;
  }
  ss = wave_sum(ss);
  const float rs = rsqrtf(ss * (1.f / 1024.f) + 1e-6f);
#pragma unroll
  for (int i = 0; i < 4; ++i) {
    float4 gg = ((const float4*)g)[lane + i * 64];
    u32x2 o;
    o.x = pack2(v[i].x * rs * gg.x, v[i].y * rs * gg.y);
    o.y = pack2(v[i].z * rs * gg.z, v[i].w * rs * gg.w);
    ((u32x2*)dst)[lane + i * 64] = o;
    if (xcopy) ((float4*)xcopy)[lane + i * 64] = v[i];
  }
}

DEVI void phase_xb(int tid_, int vb_, int vg_, const Params& p, bool from_input, size_t hoff, float* ssq) {
  u16* H = (u16*)(p.ws + hoff);
  const int wid = tid_ >> 6, lane = tid_ & 63;
  for (int r = vb_ * 4 + wid; r < NTOK; r += vg_ * 4) {
    const float* src;
    if (from_input) src = (r < 32768) ? p.in[I_XP] + (size_t)r * 1024 : p.in[I_XS] + (size_t)(r - 32768) * 1024;
    else src = p.X + (size_t)r * 1024;
    float ss = 0.f;
#pragma unroll
    for (int i = 0; i < 4; ++i) {
      const float4 v = ((const float4*)src)[lane + i * 64];
      ss += v.x * v.x + v.y * v.y + v.z * v.z + v.w * v.w;
      u32x2 o;
      o.x = pack2(v.x, v.y); o.y = pack2(v.z, v.w);
      ((u32x2*)(H + (size_t)r * 1024))[lane + i * 64] = o;
    }
    if (ssq) {
      ss = wave_sum(ss);
      if (lane == 0) ssq[r] = ss;
    }
  }
}
DEVI void phase_norm_mem(int tid_, int vb_, int vg_, const Params& p, const float* g) {
  u16* MH = (u16*)(p.ws + OFF_MEMH);
  const int wid = tid_ >> 6;
  for (int r = vb_ * 4 + wid; r < 3072; r += vg_ * 4) {
    const float* src = (r < 2048) ? p.in[I_MP] + (size_t)r * 1024 : p.in[I_MS] + (size_t)(r - 2048) * 1024;
    norm_row_bf16(tid_, src, g, MH + (size_t)r * 1024, nullptr);
  }
}
DEVI void phase_final_norm(int tid_, int vb_, int vg_, const Params& p) {
  const float* g = p.in[I_NORM_FINAL];
  const float* ssq = (const float*)(p.ws + OFF_SSQ) + (size_t)6 * NTOK;
  const int wid = tid_ >> 6, lane = tid_ & 63;
  for (int r = vb_ * 4 + wid; r < NTOK; r += vg_ * 4) {
    float* row = p.X + (size_t)r * 1024;
    const float rs = rsqrtf(ssq[r] * (1.f / 1024.f) + 1e-6f);
#pragma unroll
    for (int i = 0; i < 4; ++i) {
      const float4 v = ((const float4*)row)[lane + i * 64];
      const float4 gg = ((const float4*)g)[lane + i * 64];
      float4 o;
      o.x = v.x * rs * gg.x; o.y = v.y * rs * gg.y; o.z = v.z * rs * gg.z; o.w = v.w * rs * gg.w;
      ((float4*)row)[lane + i * 64] = o;
    }
  }
}

template <int OFF>
DEVI bf16x8 lds_rd128(uint32_t addr) {
  bf16x8 r;
  asm volatile("ds_read_b128 %0, %1 offset:%2" : "=v"(r) : "v"(addr), "n"(OFF));
  return r;
}

template <int NW, bool SWAP>
DEVI void gemm_kloop(int tid_, f32x4 (&acc)[4][NW], const u16* __restrict__ A, int lda, const u16* __restrict__ Bt, int ldb,
                     int K, char* smem) {
  constexpr int STG = 8192 + NW * 2048;
  constexpr int NB = NW / 2;
  const int tid = tid_, lane = tid & 63, wid = tid >> 6;
  const int wr = wid >> 1, wc = wid & 1, fr = lane & 15, fq = lane >> 4;
  const int lrow = lane >> 2, lphys = lane & 3, lhi = lane >> 4;
  const int gsw = (4 - lhi) & 3;
  const u16* ga[2];
  const u16* gb[NB];
#pragma unroll
  for (int q = 0; q < 2; ++q) ga[q] = A + (size_t)((wid * 2 + q) * 16 + lrow) * lda + (lphys ^ gsw) * 8;
#pragma unroll
  for (int q = 0; q < NB; ++q) gb[q] = Bt + (size_t)((wid * NB + q) * 16 + lrow) * ldb + (lphys ^ gsw) * 8;
  const int rsw = (4 - ((fr >> 2) & 3)) & 3;
  const int ch = (fq ^ rsw) * 16;
  const int nk = K >> 5;
  const uint32_t lds_base = (uint32_t)(size_t)(__attribute__((address_space(3))) char*)smem;
  const uint32_t aoff = (uint32_t)((wr * 64 + fr) * 64 + ch);
  const uint32_t boff = (uint32_t)(8192 + (wc * 16 * NW + fr) * 64 + ch);
  asm volatile("s_waitcnt vmcnt(0)" ::: "memory");
  __syncthreads();
#define GEMM_ISSUE(kt_)                                                                                              \
  do {                                                                                                               \
    char* nb_ = smem + ((kt_) & 3) * STG;                                                                            \
    _Pragma("unroll") for (int q = 0; q < 2; ++q) __builtin_amdgcn_global_load_lds(                                  \
        (const unsigned*)(ga[q] + (kt_) * 32),                                                                       \
        (__attribute__((address_space(3))) unsigned*)(nb_ + (wid * 2 + q) * 1024 + lane * 16), 16, 0, 0);            \
    _Pragma("unroll") for (int q = 0; q < NB; ++q) __builtin_amdgcn_global_load_lds(                                 \
        (const unsigned*)(gb[q] + (kt_) * 32),                                                                       \
        (__attribute__((address_space(3))) unsigned*)(nb_ + 8192 + (wid * NB + q) * 1024 + lane * 16), 16, 0, 0);    \
  } while (0)
  GEMM_ISSUE(0);
  if (nk > 1) GEMM_ISSUE(1);
  if (nk > 2) GEMM_ISSUE(2);
  for (int kt = 0; kt < nk; ++kt) {
    if (kt + 2 < nk) {
      if (NW == 4) asm volatile("s_waitcnt vmcnt(8)" ::: "memory");
      else asm volatile("s_waitcnt vmcnt(6)" ::: "memory");
    } else if (kt + 1 < nk) {
      if (NW == 4) asm volatile("s_waitcnt vmcnt(4)" ::: "memory");
      else asm volatile("s_waitcnt vmcnt(3)" ::: "memory");
    } else {
      asm volatile("s_waitcnt vmcnt(0)" ::: "memory");
    }
    __builtin_amdgcn_s_barrier();
    asm volatile("" ::: "memory");
    if (kt + 3 < nk) GEMM_ISSUE(kt + 3);
    const uint32_t sb = lds_base + (kt & 3) * STG;
    bf16x8 af[4], bfr[4];
    af[0] = lds_rd128<0>(sb + aoff); af[1] = lds_rd128<1024>(sb + aoff);
    af[2] = lds_rd128<2048>(sb + aoff); af[3] = lds_rd128<3072>(sb + aoff);
    bfr[0] = lds_rd128<0>(sb + boff); bfr[1] = lds_rd128<1024>(sb + boff);
    if (NW == 4) {
      bfr[2] = lds_rd128<2048>(sb + boff); bfr[3] = lds_rd128<3072>(sb + boff);
      asm volatile("s_waitcnt lgkmcnt(0)" : "+v"(af[0]), "+v"(af[1]), "+v"(af[2]), "+v"(af[3]),
                   "+v"(bfr[0]), "+v"(bfr[1]), "+v"(bfr[2]), "+v"(bfr[3]));
    } else {
      asm volatile("s_waitcnt lgkmcnt(0)" : "+v"(af[0]), "+v"(af[1]), "+v"(af[2]), "+v"(af[3]), "+v"(bfr[0]), "+v"(bfr[1]));
    }
#pragma unroll
    for (int m = 0; m < 4; ++m)
#pragma unroll
      for (int n = 0; n < NW; ++n) {
        if (SWAP) acc[m][n] = __builtin_amdgcn_mfma_f32_16x16x32_bf16(bfr[n], af[m], acc[m][n], 0, 0, 0);
        else acc[m][n] = __builtin_amdgcn_mfma_f32_16x16x32_bf16(af[m], bfr[n], acc[m][n], 0, 0, 0);
      }
  }
#undef GEMM_ISSUE
}

DEVI int launder(int x) { asm volatile("" : "+v"(x)); return x; }

template <int NW>
DEVI void zero_acc(f32x4 (&acc)[4][NW]) {
#pragma unroll
  for (int m = 0; m < 4; ++m)
#pragma unroll
    for (int n = 0; n < NW; ++n) acc[m][n] = (f32x4){0.f, 0.f, 0.f, 0.f};
}

struct NoEpi { DEVI void operator()(int, int, f32x4) const {} };

template <class EpiS, class EpiN>
DEVI void gemm_phase(int tid_, const u16* A, int lda, const u16* Bt, int ldb, int K, int M, int N, char* smem, int ns_from,
                     EpiS epiS, EpiN epiN) {
  const int nN = N >> 7, nM = M >> 7;
  const int lane = tid_ & 63, wid = tid_ >> 6;
  const int wr = wid >> 1, wc = wid & 1, fr = lane & 15, fq = lane >> 4;
  const int xcd = blockIdx.x & 7, jloc = blockIdx.x >> 3, nloc = gridDim.x >> 3;
  for (int lt = jloc; lt < (nM >> 3) * nN; lt += nloc) {
    const int tml = lt / nN, tn = lt - tml * nN;
    const int tm = tml * 8 + xcd;
    const int m0 = tm << 7, n0 = tn << 7;
    f32x4 acc[4][4];
    zero_acc(acc);
    if (n0 < ns_from) {
      gemm_kloop<4, true>(tid_, acc, A + (size_t)m0 * lda, lda, Bt + (size_t)n0 * ldb, ldb, K, smem);
#pragma unroll
      for (int m = 0; m < 4; ++m)
#pragma unroll
        for (int n = 0; n < 4; ++n) epiS(m0 + wr * 64 + m * 16 + fr, n0 + wc * 64 + n * 16 + fq * 4, acc[m][n]);
    } else {
      gemm_kloop<4, false>(tid_, acc, A + (size_t)m0 * lda, lda, Bt + (size_t)n0 * ldb, ldb, K, smem);
#pragma unroll
      for (int m = 0; m < 4; ++m)
#pragma unroll
        for (int n = 0; n < 4; ++n) epiN(m0 + wr * 64 + m * 16 + fq * 4, n0 + wc * 64 + n * 16 + fr, acc[m][n]);
    }
  }
}


template <bool SWAP>
DEVI void gemm_kloop_big(int tid_, f32x4 (&acc)[8][4], const u16* __restrict__ A, int lda, const u16* __restrict__ Bt,
                         int ldb, int K, char* smem) {
  constexpr int STG = 16384 + 8192;
  const int tid = tid_, lane = tid & 63, wid = tid >> 6;
  const int wr = wid >> 1, wc = wid & 1, fr = lane & 15, fq = lane >> 4;
  const int lrow = lane >> 2, lphys = lane & 3, lhi = lane >> 4;
  const int gsw = (4 - lhi) & 3;
  const u16* ga = A + (size_t)(wid * 64 + lrow) * lda + (lphys ^ gsw) * 8;
  const u16* gb = Bt + (size_t)(wid * 32 + lrow) * ldb + (lphys ^ gsw) * 8;
  const size_t a16 = (size_t)16 * lda, b16 = (size_t)16 * ldb;
  const int rsw = (4 - ((fr >> 2) & 3)) & 3;
  const int ch = (fq ^ rsw) * 16;
  const int nk = K >> 5;
  const uint32_t lds_base = (uint32_t)(size_t)(__attribute__((address_space(3))) char*)smem;
  const uint32_t aoff = (uint32_t)((wr * 128 + fr) * 64 + ch);
  const uint32_t boff = (uint32_t)(16384 + (wc * 64 + fr) * 64 + ch);
  asm volatile("s_waitcnt vmcnt(0)" ::: "memory");
  __syncthreads();
#define GEMMB_ISSUE(kt_, buf_)                                                                                       \
  do {                                                                                                               \
    char* nb_ = smem + (buf_) * STG;                                                                                 \
    _Pragma("unroll") for (int q = 0; q < 4; ++q) __builtin_amdgcn_global_load_lds(                                  \
        (const unsigned*)(ga + q * a16 + (kt_) * 32),                                                                \
        (__attribute__((address_space(3))) unsigned*)(nb_ + (wid * 4 + q) * 1024 + lane * 16), 16, 0, 0);            \
    _Pragma("unroll") for (int q = 0; q < 2; ++q) __builtin_amdgcn_global_load_lds(                                  \
        (const unsigned*)(gb + q * b16 + (kt_) * 32),                                                                \
        (__attribute__((address_space(3))) unsigned*)(nb_ + 16384 + (wid * 2 + q) * 1024 + lane * 16), 16, 0, 0);   \
  } while (0)
  GEMMB_ISSUE(0, 0);
  if (nk > 1) GEMMB_ISSUE(1, 1);
  int cb = 0;
  for (int kt = 0; kt < nk; ++kt) {
    if (kt + 1 < nk) asm volatile("s_waitcnt vmcnt(6)" ::: "memory");
    else asm volatile("s_waitcnt vmcnt(0)" ::: "memory");
    __builtin_amdgcn_s_barrier();
    asm volatile("" ::: "memory");
    const int nbuf = (cb == 0) ? 2 : cb - 1;
    if (kt + 2 < nk) GEMMB_ISSUE(kt + 2, nbuf);
    const uint32_t sb = lds_base + cb * STG;
    bf16x8 a0[4], a1[4], bb[4];
    a0[0] = lds_rd128<0>(sb + aoff); a0[1] = lds_rd128<1024>(sb + aoff);
    a0[2] = lds_rd128<2048>(sb + aoff); a0[3] = lds_rd128<3072>(sb + aoff);
    bb[0] = lds_rd128<0>(sb + boff); bb[1] = lds_rd128<1024>(sb + boff);
    bb[2] = lds_rd128<2048>(sb + boff); bb[3] = lds_rd128<3072>(sb + boff);
    a1[0] = lds_rd128<4096>(sb + aoff); a1[1] = lds_rd128<5120>(sb + aoff);
    a1[2] = lds_rd128<6144>(sb + aoff); a1[3] = lds_rd128<7168>(sb + aoff);
    asm volatile("s_waitcnt lgkmcnt(4)" : "+v"(a0[0]), "+v"(a0[1]), "+v"(a0[2]), "+v"(a0[3]),
                 "+v"(bb[0]), "+v"(bb[1]), "+v"(bb[2]), "+v"(bb[3]));
#pragma unroll
    for (int m = 0; m < 4; ++m)
#pragma unroll
      for (int n = 0; n < 4; ++n) {
        if (SWAP) acc[m][n] = __builtin_amdgcn_mfma_f32_16x16x32_bf16(bb[n], a0[m], acc[m][n], 0, 0, 0);
        else acc[m][n] = __builtin_amdgcn_mfma_f32_16x16x32_bf16(a0[m], bb[n], acc[m][n], 0, 0, 0);
      }
    asm volatile("s_waitcnt lgkmcnt(0)" : "+v"(a1[0]), "+v"(a1[1]), "+v"(a1[2]), "+v"(a1[3]));
#pragma unroll
    for (int m = 0; m < 4; ++m)
#pragma unroll
      for (int n = 0; n < 4; ++n) {
        if (SWAP) acc[4 + m][n] = __builtin_amdgcn_mfma_f32_16x16x32_bf16(bb[n], a1[m], acc[4 + m][n], 0, 0, 0);
        else acc[4 + m][n] = __builtin_amdgcn_mfma_f32_16x16x32_bf16(a1[m], bb[n], acc[4 + m][n], 0, 0, 0);
      }
    cb = (cb == 2) ? 0 : cb + 1;
  }
#undef GEMMB_ISSUE
}

template <class EpiS, class EpiN>
DEVI void gemm_phase_big(int tid_, const u16* A, int lda, const u16* Bt, int ldb, int K, int M, int N, char* smem,
                         int ns_from, EpiS epiS, EpiN epiN) {
  const int nN = N >> 7, nM = M >> 8;
  const int lane = tid_ & 63, wid = tid_ >> 6;
  const int wr = wid >> 1, wc = wid & 1, fr = lane & 15, fq = lane >> 4;
  const int xcd = blockIdx.x & 7, jloc = blockIdx.x >> 3, nloc = gridDim.x >> 3;
  for (int lt = jloc; lt < (nM >> 3) * nN; lt += nloc) {
    const int tml = lt / nN, tn = lt - tml * nN;
    const int tm = tml * 8 + xcd;
    const int m0 = tm << 8, n0 = tn << 7;
    f32x4 acc[8][4];
#pragma unroll
    for (int m = 0; m < 8; ++m)
#pragma unroll
      for (int n = 0; n < 4; ++n) acc[m][n] = (f32x4){0.f, 0.f, 0.f, 0.f};
    if (n0 < ns_from) {
      gemm_kloop_big<true>(launder(tid_), acc, A + (size_t)m0 * lda, lda, Bt + (size_t)n0 * ldb, ldb, K, smem);
#pragma unroll
      for (int m = 0; m < 8; ++m)
#pragma unroll
        for (int n = 0; n < 4; ++n) epiS(m0 + wr * 128 + m * 16 + fr, n0 + wc * 64 + n * 16 + fq * 4, acc[m][n]);
    } else {
      gemm_kloop_big<false>(launder(tid_), acc, A + (size_t)m0 * lda, lda, Bt + (size_t)n0 * ldb, ldb, K, smem);
#pragma unroll
      for (int m = 0; m < 8; ++m)
#pragma unroll
        for (int n = 0; n < 4; ++n) epiN(m0 + wr * 128 + m * 16 + fq * 4, n0 + wc * 64 + n * 16 + fr, acc[m][n]);
    }
  }
}


template <bool SWAP>
DEVI void gemm_kloop8(int tid_, f32x4 (&acc)[8][4], const u16* __restrict__ A, int lda, const u16* __restrict__ Bt,
                      int ldb, int K, char* smem, bool have_pref = false, const u16* An = nullptr, int lda_n = 0,
                      const u16* Bn = nullptr, int ldb_n = 0) {
  constexpr int STG = 65536;
  const int tid = tid_, lane = tid & 63, wid = tid >> 6;
  const int wr = wid >> 2, wc = wid & 3, fr = lane & 15, fq = lane >> 4;
  const int lrow = lane >> 3, lphys = lane & 7, lhi = lane >> 4;
  const u16* ga[4];
  const u16* gb[4];
#pragma unroll
  for (int q = 0; q < 4; ++q) {
    const int kc = lphys ^ ((4 * (q & 1) + lhi) & 7);
    ga[q] = A + (size_t)((wid * 4 + q) * 8 + lrow) * lda + kc * 8;
    gb[q] = Bt + (size_t)((wid * 4 + q) * 8 + lrow) * ldb + kc * 8;
  }
  const int swz = (fr >> 1) & 7;
  const int nk = K >> 6;
  const uint32_t lds_base = (uint32_t)(size_t)(__attribute__((address_space(3))) char*)smem;
  const uint32_t arow = (uint32_t)((wr * 128 + fr) * 128);
  const uint32_t brow = (uint32_t)(32768 + (wc * 64 + fr) * 128);
  if (__builtin_amdgcn_readfirstlane(tid_) >= 256) __builtin_amdgcn_s_setprio(1);
  if (!have_pref) {
    asm volatile("s_waitcnt vmcnt(0)" ::: "memory");
    __syncthreads();
  }
#define GEMM8_ISSUE(kt_)                                                                                             \
  do {                                                                                                               \
    char* nb_ = smem + ((kt_) & 1) * STG;                                                                            \
    _Pragma("unroll") for (int q = 0; q < 4; ++q) __builtin_amdgcn_global_load_lds(                                  \
        (const unsigned*)(ga[q] + (kt_) * 64),                                                                       \
        (__attribute__((address_space(3))) unsigned*)(nb_ + (wid * 4 + q) * 1024 + lane * 16), 16, 0, 0);            \
    _Pragma("unroll") for (int q = 0; q < 4; ++q) __builtin_amdgcn_global_load_lds(                                  \
        (const unsigned*)(gb[q] + (kt_) * 64),                                                                       \
        (__attribute__((address_space(3))) unsigned*)(nb_ + 32768 + (wid * 4 + q) * 1024 + lane * 16), 16, 0, 0);    \
  } while (0)
  if (!have_pref) GEMM8_ISSUE(0);
  for (int kt = 0; kt < nk; ++kt) {
    asm volatile("s_waitcnt vmcnt(0)" ::: "memory");
    __builtin_amdgcn_s_barrier();
    asm volatile("" ::: "memory");
    if (kt + 1 < nk) GEMM8_ISSUE(kt + 1);
    else if (An) {
#pragma unroll
      for (int q = 0; q < 4; ++q) {
        const int kc = lphys ^ ((4 * (q & 1) + lhi) & 7);
        __builtin_amdgcn_global_load_lds((const unsigned*)(An + (size_t)((wid * 4 + q) * 8 + lrow) * lda_n + kc * 8),
            (__attribute__((address_space(3))) unsigned*)(smem + (wid * 4 + q) * 1024 + lane * 16), 16, 0, 0);
        __builtin_amdgcn_global_load_lds((const unsigned*)(Bn + (size_t)((wid * 4 + q) * 8 + lrow) * ldb_n + kc * 8),
            (__attribute__((address_space(3))) unsigned*)(smem + 32768 + (wid * 4 + q) * 1024 + lane * 16), 16, 0, 0);
      }
    }
    const uint32_t sb = lds_base + (kt & 1) * STG;
#pragma unroll
    for (int ks = 0; ks < 2; ++ks) {
      const uint32_t chb = (uint32_t)(((ks * 4 + fq) ^ swz) * 16);
      const uint32_t aoff = sb + arow + chb, boff = sb + brow + chb;
      bf16x8 a0[4], a1[4], bb[4];
      a0[0] = lds_rd128<0>(aoff); a0[1] = lds_rd128<2048>(aoff);
      a0[2] = lds_rd128<4096>(aoff); a0[3] = lds_rd128<6144>(aoff);
      bb[0] = lds_rd128<0>(boff); bb[1] = lds_rd128<2048>(boff);
      bb[2] = lds_rd128<4096>(boff); bb[3] = lds_rd128<6144>(boff);
      a1[0] = lds_rd128<8192>(aoff); a1[1] = lds_rd128<10240>(aoff);
      a1[2] = lds_rd128<12288>(aoff); a1[3] = lds_rd128<14336>(aoff);
      asm volatile("s_waitcnt lgkmcnt(4)" : "+v"(a0[0]), "+v"(a0[1]), "+v"(a0[2]), "+v"(a0[3]),
                   "+v"(bb[0]), "+v"(bb[1]), "+v"(bb[2]), "+v"(bb[3]));
#pragma unroll
      for (int m = 0; m < 4; ++m)
#pragma unroll
        for (int n = 0; n < 4; ++n) {
          if (SWAP) acc[m][n] = __builtin_amdgcn_mfma_f32_16x16x32_bf16(bb[n], a0[m], acc[m][n], 0, 0, 0);
          else acc[m][n] = __builtin_amdgcn_mfma_f32_16x16x32_bf16(a0[m], bb[n], acc[m][n], 0, 0, 0);
        }
      asm volatile("s_waitcnt lgkmcnt(0)" : "+v"(a1[0]), "+v"(a1[1]), "+v"(a1[2]), "+v"(a1[3]));
#pragma unroll
      for (int m = 0; m < 4; ++m)
#pragma unroll
        for (int n = 0; n < 4; ++n) {
          if (SWAP) acc[4 + m][n] = __builtin_amdgcn_mfma_f32_16x16x32_bf16(bb[n], a1[m], acc[4 + m][n], 0, 0, 0);
          else acc[4 + m][n] = __builtin_amdgcn_mfma_f32_16x16x32_bf16(a1[m], bb[n], acc[4 + m][n], 0, 0, 0);
        }
    }
  }
#undef GEMM8_ISSUE
  __builtin_amdgcn_s_setprio(0);
}

struct NoRow { DEVI void operator()(int) const {} };
struct NoPair { static constexpr bool enabled = false; DEVI void operator()(int, int, f32x4, f32x4) const {} };

DEVI void store_pair_bf16(u16* rowp, int c, int fq, u32x2 p0, u32x2 p1) {
  const auto sx = __builtin_amdgcn_permlane16_swap(p0.x, p1.x, false, false);
  const auto sy = __builtin_amdgcn_permlane16_swap(p0.y, p1.y, false, false);
  u32x4 o;
  o.x = sx[0]; o.y = sy[0]; o.z = sx[1]; o.w = sy[1];
  const int col = (fq & 1) ? (c + 16 + (fq - 1) * 4) : (c + fq * 4);
  *(u32x4*)(rowp + col) = o;
}
DEVI u32x2 pack4bf(f32x4 v) { u32x2 o; o.x = pack2(v[0], v[1]); o.y = pack2(v[2], v[3]); return o; }
template <class F> struct PairEpi {
  static constexpr bool enabled = true;
  F f;
  DEVI void operator()(int r, int c, f32x4 a, f32x4 b) const { f(r, c, a, b); }
};
template <class F> DEVI PairEpi<F> make_pair_epi(F f) { return PairEpi<F>{f}; }

template <class EpiS, class EpiN, class RowEnd = NoRow, class EpiP = NoPair>
DEVI void gemm_phase8(int tid_, const u16* A, int lda, const u16* Bt, int ldb, int K, int M, int N, char* smem,
                      int ns_from, EpiS epiS, EpiN epiN, RowEnd rowEnd = NoRow(), int rot = 0, EpiP epiP = NoPair()) {
  const int nN = (N + 255) >> 8, nM = M >> 8;
  const int lane = tid_ & 63, wid = tid_ >> 6;
  const int wr = wid >> 2, wc = wid & 3, fr = lane & 15, fq = lane >> 4;
  const bool xmap = ((gridDim.x & 7) == 0) && ((nM & 7) == 0);
  const int xcd = blockIdx.x & 7;
  const int first = xmap ? (int)(blockIdx.x >> 3) : (int)((blockIdx.x + gridDim.x - rot) % gridDim.x);
  const int stride = xmap ? (int)(gridDim.x >> 3) : (int)gridDim.x;
  const int count = xmap ? (nM >> 3) * nN : nM * nN;
  bool pref = false;
  for (int it = first; it < count; it += stride) {
    const int tq = it / nN, tn = it - tq * nN;
    const int tm = xmap ? tq * 8 + xcd : tq;
    const int m0 = tm << 8, n0 = tn << 8;
    const int colb = n0 + wc * 64;
    const u16* An = nullptr; const u16* Bn = nullptr;
    if (it + stride < count) {
      const int it2 = it + stride;
      const int tq2 = it2 / nN, tn2 = it2 - tq2 * nN;
      An = A + (size_t)((xmap ? tq2 * 8 + xcd : tq2) << 8) * lda;
      Bn = Bt + (size_t)(tn2 << 8) * ldb;
    }
    f32x4 acc[8][4];
#pragma unroll
    for (int m = 0; m < 8; ++m)
#pragma unroll
      for (int n = 0; n < 4; ++n) acc[m][n] = (f32x4){0.f, 0.f, 0.f, 0.f};
    if (colb < ns_from) {
      gemm_kloop8<true>(launder(tid_), acc, A + (size_t)m0 * lda, lda, Bt + (size_t)n0 * ldb, ldb, K, smem, pref, An, lda, Bn, ldb);
      if (colb < N) {
        if (EpiP::enabled) {
#pragma unroll
          for (int m = 0; m < 8; ++m) {
            epiP(m0 + wr * 128 + m * 16 + fr, colb, acc[m][0], acc[m][1]);
            epiP(m0 + wr * 128 + m * 16 + fr, colb + 32, acc[m][2], acc[m][3]);
          }
        } else {
#pragma unroll
          for (int m = 0; m < 8; ++m) {
#pragma unroll
            for (int n = 0; n < 4; ++n) epiS(m0 + wr * 128 + m * 16 + fr, colb + n * 16 + fq * 4, acc[m][n]);
            rowEnd(m0 + wr * 128 + m * 16 + fr);
          }
        }
      }
    } else {
      gemm_kloop8<false>(launder(tid_), acc, A + (size_t)m0 * lda, lda, Bt + (size_t)n0 * ldb, ldb, K, smem, pref, An, lda, Bn, ldb);
      if (colb < N) {
#pragma unroll
        for (int m = 0; m < 8; ++m)
#pragma unroll
          for (int n = 0; n < 4; ++n) epiN(m0 + wr * 128 + m * 16 + fq * 4, colb + n * 16 + fr, acc[m][n]);
      }
    }
    pref = (An != nullptr);
  }
  asm volatile("s_waitcnt vmcnt(0)" ::: "memory");
}

DEVI void store4bf(u16* dst, f32x4 v) {
  u32x2 o;
  o.x = pack2(v[0], v[1]); o.y = pack2(v[2], v[3]);
  *(u32x2*)dst = o;
}

DEVI float rstd_of(const float* ssq, int r) { return rsqrtf(ssq[r] * (1.f / 1024.f) + 1e-6f); }

DEVI void phase_p_gemm(int tid_, const Params& p, char* smem, const float* ssq) {
  u16* WB = (u16*)(p.ws + OFF_WB);
  const u16* H = (const u16*)(p.ws + OFF_H);
  u16* PR = (u16*)(p.ws + OFF_PR);
  u16* NQ = (u16*)(p.ws + OFF_NQ);
  u16* NK = (u16*)(p.ws + OFF_NK);
  u16* NVT = (u16*)(p.ws + OFF_NV);
  gemm_phase8(tid_, H, 1024, WB + W_IN, 1024, 1024, NTOK, 3456, smem, 2944,
    [&](int r, int c0, f32x4 v) {
      v = v * rstd_of(ssq, r);
      if (c0 < 1920) store4bf(PR + (size_t)r * PRW + c0, v);
      else if (c0 < 2432) store4bf(NQ + (size_t)r * 512 + (c0 - 1920), v);
      else store4bf(NK + (size_t)r * 512 + (c0 - 2432), v);
    },
    [&](int r0, int c, f32x4 v) {
      const int cc = c - 2944;
      const int s = r0 >> 12, t = r0 & 4095;
      const f32x4 q = *(const f32x4*)(ssq + r0);
#pragma unroll
      for (int j = 0; j < 4; ++j) v[j] *= rsqrtf(q[j] * (1.f / 1024.f) + 1e-6f);
      store4bf(NVT + ((size_t)(s * 512 + cc)) * 4096 + t, v);
    }, NoRow(), 0,
    make_pair_epi([&](int r, int c, f32x4 va, f32x4 vb) {
      const float rs = rstd_of(ssq, r);
      u16* rowp; int cl;
      if (c < 1920) { rowp = PR + (size_t)r * PRW; cl = c; }
      else if (c < 2432) { rowp = NQ + (size_t)r * 512; cl = c - 1920; }
      else { rowp = NK + (size_t)r * 512; cl = c - 2432; }
      store_pair_bf16(rowp, cl, (tid_ & 63) >> 4, pack4bf(va * rs), pack4bf(vb * rs));
    }));
  const u16* MH = (const u16*)(p.ws + OFF_MEMH);
  u16* KVK = (u16*)(p.ws + OFF_KVK);
  u16* KVT = (u16*)(p.ws + OFF_KVT);
  gemm_phase8(tid_, MH, 1024, WB + W_XKV, 1024, 1024, 3072, 2048, smem, 1024,
    [&](int r, int c0, f32x4 v) { store4bf(KVK + (size_t)r * 1024 + c0, v); },
    [&](int r0, int c, f32x4 v) {
      const int cc = c - 1024;
      const int s = r0 >> 8, m = r0 & 255;
      store4bf(KVT + ((size_t)(s * 1024 + cc)) * 256 + m, v);
    }, NoRow(), 128);
}

DEVI void phase_nat(int tid_, const Params& p, int l, char* smem, int bfirst, int bstride) {
  u16* NQ = (u16*)(p.ws + OFF_NQ);
  const u16* NK = (const u16*)(p.ws + OFF_NK);
  const u16* NVT = (const u16*)(p.ws + OFF_NV);
  const float* rpb = p.in[I_RPB] + (size_t)l * 8 * 15 * 31;
  const int lane = tid_ & 63, g = tid_ >> 6, fr = lane & 15, fq = lane >> 4;
  u16* Pw = (u16*)smem + g * (16 * 264);
  const int cb = (g == 0) ? 0 : (g == 1) ? 8 : (g == 2) ? 24 : 32;
  const int c = g * 16 + fr;
  int cs = c - 8; cs = cs < 0 ? 0 : (cs > 48 ? 48 : cs);
  for (int t = bfirst; t < 12 * 64 * 8; t += bstride) {
    const int h = t & 7, ri = (t >> 3) & 63, s = t >> 9;
    int rs = ri - 4; rs = rs < 0 ? 0 : (rs > 56 ? 56 : rs);
    const size_t tokq = (size_t)s * 4096 + ri * 64 + g * 16;
    bf16x8 aq[2];
    aq[0] = *(const bf16x8*)(NQ + (tokq + fr) * 512 + h * 64 + fq * 8);
    aq[1] = *(const bf16x8*)(NQ + (tokq + fr) * 512 + h * 64 + 32 + fq * 8);
    f32x4 acc[16];
#pragma unroll
    for (int n = 0; n < 16; ++n) {
      acc[n] = (f32x4){0.f, 0.f, 0.f, 0.f};
      const int r = n >> 1, col = cb + (n & 1) * 16 + fr;
      const u16* kp = NK + ((size_t)s * 4096 + (rs + r) * 64 + col) * 512 + h * 64 + fq * 8;
      const bf16x8 b0 = *(const bf16x8*)kp;
      const bf16x8 b1 = *(const bf16x8*)(kp + 32);
      acc[n] = __builtin_amdgcn_mfma_f32_16x16x32_bf16(b0, aq[0], acc[n], 0, 0, 0);
      acc[n] = __builtin_amdgcn_mfma_f32_16x16x32_bf16(b1, aq[1], acc[n], 0, 0, 0);
    }
    float m = -1e30f;
#pragma unroll
    for (int n = 0; n < 16; ++n) {
      const int di = rs + (n >> 1) - ri + 7;
      const float* brow = rpb + (h * 15 + di) * 31 + 15 - c;
#pragma unroll
      for (int j = 0; j < 4; ++j) {
        const int kc = cb + (n & 1) * 16 + fq * 4 + j;
        float sc = -1e30f;
        if (kc >= cs && kc < cs + 16) sc = acc[n][j] * 0.125f + brow[kc];
        acc[n][j] = sc;
        m = fmaxf(m, sc);
      }
    }
    m = red4x_max(m);
    float ssum = 0.f;
#pragma unroll
    for (int n = 0; n < 16; ++n) {
      f32x4 e;
#pragma unroll
      for (int j = 0; j < 4; ++j) { e[j] = __expf(acc[n][j] - m); ssum += e[j]; }
      store4bf(Pw + fr * 264 + n * 16 + fq * 4, e);
    }
    const float sm = 1.f / red4x_sum(ssum);
    f32x4 o[4];
#pragma unroll
    for (int n = 0; n < 4; ++n) o[n] = (f32x4){0.f, 0.f, 0.f, 0.f};
#pragma unroll
    for (int ks = 0; ks < 8; ++ks) {
      const bf16x8 ap = *(const bf16x8*)(Pw + fr * 264 + ks * 32 + fq * 8);
#pragma unroll
      for (int n = 0; n < 4; ++n) {
        const bf16x8 bv = *(const bf16x8*)(NVT + ((size_t)(s * 512 + h * 64 + n * 16 + fr)) * 4096 + (rs + ks) * 64 + cb + fq * 8);
        o[n] = __builtin_amdgcn_mfma_f32_16x16x32_bf16(bv, ap, o[n], 0, 0, 0);
      }
    }
#pragma unroll
    for (int n = 0; n < 4; ++n) store4bf(NQ + (tokq + fr) * 512 + h * 64 + n * 16 + fq * 4, o[n] * sm);
  }
}

constexpr int SC_OPS = 0;
constexpr int SC_VV = 40960;
constexpr int SC_WR = 49152;
constexpr int SC_AP = 57344;
constexpr int SC_TW = 65536;
constexpr int SC_AD = 70144;
constexpr int SC_NRM = 74752;
constexpr int SC_MU = 74880;
constexpr int SC_CST = 77440;

typedef __attribute__((ext_vector_type(2))) float f32x2;

template <int CTRL>
DEVI float dpp_mov(float x) {
  return __int_as_float(__builtin_amdgcn_update_dpp(0, __float_as_int(x), CTRL, 0xF, 0xF, true));
}
DEVI float red8(float x) {
  x += dpp_mov<0xB1>(x);
  x += dpp_mov<0x4E>(x);
  x += dpp_mov<0x141>(x);
  return x;
}
DEVI f32x2 lo2(f32x4 v) { return __builtin_shufflevector(v, v, 0, 1); }
DEVI f32x2 hi2(f32x4 v) { return __builtin_shufflevector(v, v, 2, 3); }

struct ScanOps {
  f32x2 a[4], w[4], b[4], k[4], r[4];
  float v0, v1;
};
DEVI void scan_load(ScanOps& o, const float* OPS, const float* VV, int nn, int jg, int i0) {
  const float* base = OPS + nn * 64 + jg * 8;
  f32x4 t0, t1;
  t0 = *(const f32x4*)(base); t1 = *(const f32x4*)(base + 4);
  o.a[0] = lo2(t0); o.a[1] = hi2(t0); o.a[2] = lo2(t1); o.a[3] = hi2(t1);
  t0 = *(const f32x4*)(base + 2048); t1 = *(const f32x4*)(base + 2048 + 4);
  o.w[0] = lo2(t0); o.w[1] = hi2(t0); o.w[2] = lo2(t1); o.w[3] = hi2(t1);
  t0 = *(const f32x4*)(base + 4096); t1 = *(const f32x4*)(base + 4096 + 4);
  o.b[0] = lo2(t0); o.b[1] = hi2(t0); o.b[2] = lo2(t1); o.b[3] = hi2(t1);
  t0 = *(const f32x4*)(base + 6144); t1 = *(const f32x4*)(base + 6144 + 4);
  o.k[0] = lo2(t0); o.k[1] = hi2(t0); o.k[2] = lo2(t1); o.k[3] = hi2(t1);
  t0 = *(const f32x4*)(base + 8192); t1 = *(const f32x4*)(base + 8192 + 4);
  o.r[0] = lo2(t0); o.r[1] = hi2(t0); o.r[2] = lo2(t1); o.r[3] = hi2(t1);
  o.v0 = VV[nn * 64 + i0];
  o.v1 = VV[nn * 64 + i0 + 8];
}
DEVI void scan_step(const ScanOps& o, f32x2 (&S0)[4], f32x2 (&S1)[4], float* YL, int nn, int jg, int i0) {
  f32x2 d0 = S0[0] * o.a[0], d0b = S0[2] * o.a[2];
  f32x2 d1 = S1[0] * o.a[0], d1b = S1[2] * o.a[2];
  d0 = S0[1] * o.a[1] + d0; d0b = S0[3] * o.a[3] + d0b;
  d1 = S1[1] * o.a[1] + d1; d1b = S1[3] * o.a[3] + d1b;
  d0 += d0b; d1 += d1b;
  const float sa0 = red8(d0.x + d0.y);
  const float sa1 = red8(d1.x + d1.y);
  f32x2 e0 = {0.f, 0.f}, e1 = {0.f, 0.f};
#pragma unroll
  for (int q = 0; q < 4; ++q) {
    const f32x2 u0 = sa0 * o.b[q] + o.v0 * o.k[q];
    const f32x2 u1 = sa1 * o.b[q] + o.v1 * o.k[q];
    S0[q] = S0[q] * o.w[q] + u0;
    S1[q] = S1[q] * o.w[q] + u1;
    e0 = S0[q] * o.r[q] + e0;
    e1 = S1[q] * o.r[q] + e1;
  }
  const float y0 = red8(e0.x + e0.y);
  const float y1 = red8(e1.x + e1.y);
  YL[nn * 64 + i0] = y0; YL[nn * 64 + i0 + 8] = y1;
}

DEVI void phase_scan(int tid_, const Params& p, int l, char* smem, int bfirst, int bstride) {
  const u16* PR = (const u16*)(p.ws + OFF_PR);
  _Float16* YF = (_Float16*)(p.ws + OFF_H);
  _Float16* YB = (_Float16*)(p.ws + OFF_H + (size_t)NTOK * 512 * 2);
  float* BON = (float*)(p.ws + OFF_BONUS);
  const u16* WB = (const u16*)(p.ws + OFF_WB);
  float* OPS = (float*)(smem + SC_OPS);
  u16* RAW = (u16*)(smem + SC_OPS);
  float* VV = (float*)(smem + SC_VV);
  float* WR = (float*)(smem + SC_WR);
  float* AP = (float*)(smem + SC_AP);
  float* YL = WR;
  u16* TWb = (u16*)(smem + SC_TW);
  u16* ADb = (u16*)(smem + SC_AD);
  float* NRM = (float*)(smem + SC_NRM);
  float* MU = (float*)(smem + SC_MU);
  float* CST = (float*)(smem + SC_CST);
  const float* mu_p = p.in[I_MU_PREV] + (size_t)l * 1920;
  const float* mu_n = p.in[I_MU_NEXT] + (size_t)l * 1920;
  const int tid = tid_, lane = tid & 63, w = tid >> 6, fr = lane & 15, fq = lane >> 4;
  const int pn = tid >> 3, j0 = (tid & 7) * 8;
  const int jg = lane & 7, i0 = w * 16 + (lane >> 3);
  const int hr = (tid >= 40) ? 1 : 0, hc = tid - hr * 40;
  for (int blk = bfirst; blk < 192; blk += bstride) {
    const int s = blk >> 4, h = (blk >> 1) & 7, d = blk & 1;
    __syncthreads();
    for (int i = tid; i < 640; i += 256) {
      const int which = (i >= 320) ? 1 : 0, c = i - which * 320;
      const int g = c >> 6, e = c & 63;
      const int col = (g < 3) ? (g * 512 + h * 64 + e) : (1536 + (g - 3) * 128 + d * 64 + e);
      MU[i] = which ? mu_n[col] : mu_p[col];
    }
    for (int i = tid; i < 320; i += 256) {
      const int which = i >> 6, e = i & 63;
      float v;
      if (which == 0) v = p.in[I_W0][(size_t)(l * 2 + d) * 512 + h * 64 + e];
      else if (which == 1) v = p.in[I_A0][(size_t)(l * 2 + d) * 512 + h * 64 + e];
      else if (which == 2) v = p.in[I_K_K][(size_t)l * 512 + h * 64 + e];
      else if (which == 3) v = p.in[I_K_A][(size_t)l * 512 + h * 64 + e];
      else v = p.in[I_R_K][(size_t)(l * 8 + h) * 64 + e];
      CST[i] = v;
    }
    bf16x8 bw[2], ba[2];
#pragma unroll
    for (int ks = 0; ks < 2; ++ks) {
      bw[ks] = *(const bf16x8*)(WB + W_WUP + (size_t)(d * 512 + h * 64 + w * 16 + fr) * 64 + ks * 32 + fq * 8);
      ba[ks] = *(const bf16x8*)(WB + W_AUP + (size_t)(d * 512 + h * 64 + w * 16 + fr) * 64 + ks * 32 + fq * 8);
    }
    _Float16* Y = d ? YB : YF;
    f32x2 S0[4], S1[4];
#pragma unroll
    for (int q = 0; q < 4; ++q) { S0[q] = (f32x2){0.f, 0.f}; S1[q] = (f32x2){0.f, 0.f}; }
    u32x4 G[5], GH;
    {
      const int t = d ? (4095 - pn) : pn;
      const size_t tok = (size_t)s * 4096 + t;
#pragma unroll
      for (int g = 0; g < 5; ++g) {
        const int col = (g < 3) ? (g * 512 + h * 64) : (1536 + (g - 3) * 128 + d * 64);
        G[g] = *(const u32x4*)(PR + tok * PRW + col + j0);
      }
      GH = (u32x4){0u, 0u, 0u, 0u};
      if (tid < 80) {
        const int tlo = d ? (4095 - 31) : 0;
        const int th = hr ? (tlo + 32) : (tlo - 1);
        const int g = hc >> 3;
        const int col = (g < 3) ? (g * 512 + h * 64) : (1536 + (g - 3) * 128 + d * 64);
        if (th >= 0 && th <= 4095) GH = *(const u32x4*)(PR + ((size_t)s * 4096 + th) * PRW + col + (hc & 7) * 8);
      }
    }
#pragma unroll 1
    for (int ch = 0; ch < 128; ++ch) {
      const int n = ch * 32 + pn;
      const int t = d ? (4095 - n) : n;
      const size_t tok = (size_t)s * 4096 + t;
      const int tlo = d ? (4095 - (ch * 32 + 31)) : (ch * 32);
      const int rrow = t - tlo + 1;
#pragma unroll
      for (int g = 0; g < 5; ++g) *(u32x4*)(RAW + rrow * 320 + g * 64 + j0) = G[g];
      if (tid < 80) *(u32x4*)(RAW + (hr ? 33 : 0) * 320 + (hc >> 3) * 64 + (hc & 7) * 8) = GH;
      __syncthreads();
      if (ch + 1 < 128) {
        const int n2 = n + 32;
        const int t2 = d ? (4095 - n2) : n2;
        const size_t tok2 = (size_t)s * 4096 + t2;
#pragma unroll
        for (int g = 0; g < 5; ++g) {
          const int col = (g < 3) ? (g * 512 + h * 64) : (1536 + (g - 3) * 128 + d * 64);
          G[g] = *(const u32x4*)(PR + tok2 * PRW + col + j0);
        }
        GH = (u32x4){0u, 0u, 0u, 0u};
        if (tid < 80) {
          const int tlo2 = d ? (tlo - 32) : (tlo + 32);
          const int th = hr ? (tlo2 + 32) : (tlo2 - 1);
          const int g = hc >> 3;
          const int col = (g < 3) ? (g * 512 + h * 64) : (1536 + (g - 3) * 128 + d * 64);
          if (th >= 0 && th <= 4095) GH = *(const u32x4*)(PR + ((size_t)s * 4096 + th) * PRW + col + (hc & 7) * 8);
        }
      }
#pragma unroll
      for (int g = 0; g < 5; ++g) {
        float cur[8], prv[8], nxt[8];
        load8bf(RAW + rrow * 320 + g * 64 + j0, cur);
        load8bf(RAW + (rrow - 1) * 320 + g * 64 + j0, prv);
        load8bf(RAW + (rrow + 1) * 320 + g * 64 + j0, nxt);
        const f32x4 mp0 = *(const f32x4*)(MU + g * 64 + j0), mp1 = *(const f32x4*)(MU + g * 64 + j0 + 4);
        const f32x4 mn0 = *(const f32x4*)(MU + 320 + g * 64 + j0), mn1 = *(const f32x4*)(MU + 320 + g * 64 + j0 + 4);
        f32x4 x0, x1;
#pragma unroll
        for (int e = 0; e < 4; ++e) {
          x0[e] = cur[e] + mp0[e] * (prv[e] - cur[e]) + mn0[e] * (nxt[e] - cur[e]);
          x1[e] = cur[4 + e] + mp1[e] * (prv[4 + e] - cur[4 + e]) + mn1[e] * (nxt[4 + e] - cur[4 + e]);
        }
        if (g == 0) {
          *(f32x4*)(OPS + 4 * 2048 + pn * 64 + j0) = x0; *(f32x4*)(OPS + 4 * 2048 + pn * 64 + j0 + 4) = x1;
        } else if (g == 1) {
          *(f32x4*)(OPS + 3 * 2048 + pn * 64 + j0) = x0; *(f32x4*)(OPS + 3 * 2048 + pn * 64 + j0 + 4) = x1;
          const f32x4 kk0 = *(const f32x4*)(CST + 128 + j0), kk1 = *(const f32x4*)(CST + 128 + j0 + 4);
          float ss = 0.f;
#pragma unroll
          for (int e = 0; e < 4; ++e) { const float a_ = x0[e] * kk0[e], b_ = x1[e] * kk1[e]; ss += a_ * a_ + b_ * b_; }
          ss = red8(ss);
          if ((tid & 7) == 0) NRM[pn] = frcp(fmaxf(__builtin_amdgcn_sqrtf(ss), 1e-12f));
        } else if (g == 2) {
          *(f32x4*)(VV + pn * 64 + j0) = x0; *(f32x4*)(VV + pn * 64 + j0 + 4) = x1;
        } else if (g == 3) {
          u32x4 pk;
          pk.x = pack2(ftanh(x0[0]), ftanh(x0[1])); pk.y = pack2(ftanh(x0[2]), ftanh(x0[3]));
          pk.z = pack2(ftanh(x1[0]), ftanh(x1[1])); pk.w = pack2(ftanh(x1[2]), ftanh(x1[3]));
          *(u32x4*)(TWb + pn * 72 + j0) = pk;
        } else {
          u32x4 pk;
          pk.x = pack2(x0[0], x0[1]); pk.y = pack2(x0[2], x0[3]);
          pk.z = pack2(x1[0], x1[1]); pk.w = pack2(x1[2], x1[3]);
          *(u32x4*)(ADb + pn * 72 + j0) = pk;
        }
      }
      __syncthreads();
#pragma unroll
      for (int m = 0; m < 2; ++m) {
        f32x4 cw = {0.f, 0.f, 0.f, 0.f}, ca = {0.f, 0.f, 0.f, 0.f};
#pragma unroll
        for (int ks = 0; ks < 2; ++ks) {
          const bf16x8 aw = *(const bf16x8*)(TWb + (m * 16 + fr) * 72 + ks * 32 + fq * 8);
          const bf16x8 aa = *(const bf16x8*)(ADb + (m * 16 + fr) * 72 + ks * 32 + fq * 8);
          cw = __builtin_amdgcn_mfma_f32_16x16x32_bf16(aw, bw[ks], cw, 0, 0, 0);
          ca = __builtin_amdgcn_mfma_f32_16x16x32_bf16(aa, ba[ks], ca, 0, 0, 0);
        }
#pragma unroll
        for (int jj = 0; jj < 4; ++jj) {
          WR[(m * 16 + fq * 4 + jj) * 64 + w * 16 + fr] = cw[jj];
          AP[(m * 16 + fq * 4 + jj) * 64 + w * 16 + fr] = ca[jj];
        }
      }
      __syncthreads();
      {
        const float inv = NRM[pn];
        float bsum = 0.f;
#pragma unroll
        for (int hq = 0; hq < 2; ++hq) {
          const int jb = j0 + hq * 4;
          const f32x4 wr_ = *(const f32x4*)(WR + pn * 64 + jb) + *(const f32x4*)(CST + jb);
          const f32x4 ap_ = *(const f32x4*)(AP + pn * 64 + jb) + *(const f32x4*)(CST + 64 + jb);
          const f32x4 kr = *(const f32x4*)(OPS + 3 * 2048 + pn * 64 + jb);
          const f32x4 rr = *(const f32x4*)(OPS + 4 * 2048 + pn * 64 + jb);
          const f32x4 kkw = *(const f32x4*)(CST + 128 + jb), kaw = *(const f32x4*)(CST + 192 + jb), rkw = *(const f32x4*)(CST + 256 + jb);
          f32x4 o0, o1, o2, o3;
#pragma unroll
          for (int e = 0; e < 4; ++e) {
            const float sw = sigm(wr_[e]);
            const float dec = __expf(-0.6065306597126334f * sw);
            const float av = sigm(ap_[e]);
            const float kn = kr[e] * kkw[e] * inv;
            const float kd = kr[e] * (1.f + (av - 1.f) * kaw[e]);
            bsum += rr[e] * kd * rkw[e];
            o0[e] = -kn; o1[e] = dec; o2[e] = kn * av; o3[e] = kd;
          }
          *(f32x4*)(OPS + 0 * 2048 + pn * 64 + jb) = o0;
          *(f32x4*)(OPS + 1 * 2048 + pn * 64 + jb) = o1;
          *(f32x4*)(OPS + 2 * 2048 + pn * 64 + jb) = o2;
          *(f32x4*)(OPS + 3 * 2048 + pn * 64 + jb) = o3;
        }
        bsum = red8(bsum);
        if ((tid & 7) == 0) BON[(tok * 8 + h) * 2 + d] = bsum;
      }
      __syncthreads();
      {
        ScanOps oa, ob;
        scan_load(oa, OPS, VV, 0, jg, i0);
#pragma unroll 1
        for (int nn = 0; nn < 32; nn += 2) {
          scan_load(ob, OPS, VV, nn + 1, jg, i0);
          scan_step(oa, S0, S1, YL, nn, jg, i0);
          scan_load(oa, OPS, VV, (nn + 2) & 31, jg, i0);
          scan_step(ob, S0, S1, YL, nn + 1, jg, i0);
        }
      }
      __syncthreads();
      {
        h16x8 o;
#pragma unroll
        for (int e = 0; e < 8; ++e) o[e] = (_Float16)YL[pn * 64 + j0 + e];
        *(h16x8*)(Y + tok * 512 + h * 64 + j0) = o;
      }
    }
    __syncthreads();
  }
}

struct ScanOps1 {
  f32x2 a[4], w[4], b[4], k[4], r[4];
  float v0;
};
DEVI void scan_load1(ScanOps1& o, const float* OPS, const float* VV, int nn, int jg, int i0) {
  const float* base = OPS + nn * 64 + jg * 8;
  f32x4 t0, t1;
  t0 = *(const f32x4*)(base); t1 = *(const f32x4*)(base + 4);
  o.a[0] = lo2(t0); o.a[1] = hi2(t0); o.a[2] = lo2(t1); o.a[3] = hi2(t1);
  t0 = *(const f32x4*)(base + 2048); t1 = *(const f32x4*)(base + 2048 + 4);
  o.w[0] = lo2(t0); o.w[1] = hi2(t0); o.w[2] = lo2(t1); o.w[3] = hi2(t1);
  t0 = *(const f32x4*)(base + 4096); t1 = *(const f32x4*)(base + 4096 + 4);
  o.b[0] = lo2(t0); o.b[1] = hi2(t0); o.b[2] = lo2(t1); o.b[3] = hi2(t1);
  t0 = *(const f32x4*)(base + 6144); t1 = *(const f32x4*)(base + 6144 + 4);
  o.k[0] = lo2(t0); o.k[1] = hi2(t0); o.k[2] = lo2(t1); o.k[3] = hi2(t1);
  t0 = *(const f32x4*)(base + 8192); t1 = *(const f32x4*)(base + 8192 + 4);
  o.r[0] = lo2(t0); o.r[1] = hi2(t0); o.r[2] = lo2(t1); o.r[3] = hi2(t1);
  o.v0 = VV[nn * 64 + i0];
}
DEVI void scan_step1(const ScanOps1& o, f32x2 (&S0)[4], float* YL, int nn, int jg, int i0) {
  f32x2 d0 = S0[0] * o.a[0], d0b = S0[2] * o.a[2];
  d0 = S0[1] * o.a[1] + d0; d0b = S0[3] * o.a[3] + d0b;
  d0 += d0b;
  const float sa0 = red8(d0.x + d0.y);
  f32x2 e0 = {0.f, 0.f};
#pragma unroll
  for (int q = 0; q < 4; ++q) {
    const f32x2 u0 = sa0 * o.b[q] + o.v0 * o.k[q];
    S0[q] = S0[q] * o.w[q] + u0;
    e0 = S0[q] * o.r[q] + e0;
  }
  const float y0 = red8(e0.x + e0.y);
  if (jg == 0) YL[nn * 64 + i0] = y0;
}
DEVI float red16d(float x) {
  x += dpp_mov<0xB1>(x);
  x += dpp_mov<0x4E>(x);
  x += dpp_mov<0x141>(x);
  x += dpp_mov<0x140>(x);
  return x;
}
DEVI void unpack4(u32x2 u, float* o) {
  o[0] = __uint_as_float(u.x << 16); o[1] = __uint_as_float(u.x & 0xffff0000u);
  o[2] = __uint_as_float(u.y << 16); o[3] = __uint_as_float(u.y & 0xffff0000u);
}

DEVI void phase_scan8(int tid_, const Params& p, int l, char* smem, int bfirst, int bstride) {
  const u16* PR = (const u16*)(p.ws + OFF_PR);
  _Float16* YF = (_Float16*)(p.ws + OFF_H);
  _Float16* YB = (_Float16*)(p.ws + OFF_H + (size_t)NTOK * 512 * 2);
  float* BON = (float*)(p.ws + OFF_BONUS);
  const u16* WB = (const u16*)(p.ws + OFF_WB);
  float* OPS = (float*)(smem + SC_OPS);
  u16* RAW = (u16*)(smem + SC_OPS);
  float* VV = (float*)(smem + SC_VV);
  float* WR = (float*)(smem + SC_WR);
  float* AP = (float*)(smem + SC_AP);
  float* YL = WR;
  u16* TWb = (u16*)(smem + SC_TW);
  u16* ADb = (u16*)(smem + SC_AD);
  float* NRM = (float*)(smem + SC_NRM);
  float* MU = (float*)(smem + SC_MU);
  float* CST = (float*)(smem + SC_CST);
  const float* mu_p = p.in[I_MU_PREV] + (size_t)l * 1920;
  const float* mu_n = p.in[I_MU_NEXT] + (size_t)l * 1920;
  const int tid = tid_, lane = tid & 63, w = tid >> 6, fr = lane & 15, fq = lane >> 4;
  const int pn = tid >> 4, j0 = (tid & 15) * 4;
  const int jg = lane & 7, i0 = w * 8 + (lane >> 3);
  const int hr = (tid >= 80) ? 1 : 0, hc = tid - hr * 80;
  const int wm = w >> 2, wn = w & 3;
  for (int blk = bfirst; blk < 192; blk += bstride) {
    const int s = blk >> 4, h = (blk >> 1) & 7, d = blk & 1;
    __syncthreads();
    for (int i = tid; i < 640; i += 512) {
      const int which = (i >= 320) ? 1 : 0, c = i - which * 320;
      const int g = c >> 6, e = c & 63;
      const int col = (g < 3) ? (g * 512 + h * 64 + e) : (1536 + (g - 3) * 128 + d * 64 + e);
      MU[i] = which ? mu_n[col] : mu_p[col];
    }
    if (tid < 320) {
      const int which = tid >> 6, e = tid & 63;
      float v;
      if (which == 0) v = p.in[I_W0][(size_t)(l * 2 + d) * 512 + h * 64 + e];
      else if (which == 1) v = p.in[I_A0][(size_t)(l * 2 + d) * 512 + h * 64 + e];
      else if (which == 2) v = p.in[I_K_K][(size_t)l * 512 + h * 64 + e];
      else if (which == 3) v = p.in[I_K_A][(size_t)l * 512 + h * 64 + e];
      else v = p.in[I_R_K][(size_t)(l * 8 + h) * 64 + e];
      CST[tid] = v;
    }
    bf16x8 bw[2], ba[2];
#pragma unroll
    for (int ks = 0; ks < 2; ++ks) {
      bw[ks] = *(const bf16x8*)(WB + W_WUP + (size_t)(d * 512 + h * 64 + wn * 16 + fr) * 64 + ks * 32 + fq * 8);
      ba[ks] = *(const bf16x8*)(WB + W_AUP + (size_t)(d * 512 + h * 64 + wn * 16 + fr) * 64 + ks * 32 + fq * 8);
    }
    _Float16* Y = d ? YB : YF;
    f32x2 S0[4];
#pragma unroll
    for (int q = 0; q < 4; ++q) S0[q] = (f32x2){0.f, 0.f};
    u32x2 G[5], GH;
    {
      const int t = d ? (4095 - pn) : pn;
      const size_t tok = (size_t)s * 4096 + t;
#pragma unroll
      for (int g = 0; g < 5; ++g) {
        const int col = (g < 3) ? (g * 512 + h * 64) : (1536 + (g - 3) * 128 + d * 64);
        G[g] = *(const u32x2*)(PR + tok * PRW + col + j0);
      }
      GH = (u32x2){0u, 0u};
      if (tid < 160) {
        const int tlo = d ? (4095 - 31) : 0;
        const int th = hr ? (tlo + 32) : (tlo - 1);
        const int g = hc >> 4;
        const int col = (g < 3) ? (g * 512 + h * 64) : (1536 + (g - 3) * 128 + d * 64);
        if (th >= 0 && th <= 4095) GH = *(const u32x2*)(PR + ((size_t)s * 4096 + th) * PRW + col + (hc & 15) * 4);
      }
    }
#pragma unroll 1
    for (int ch = 0; ch < 128; ++ch) {
      const int n = ch * 32 + pn;
      const int t = d ? (4095 - n) : n;
      const size_t tok = (size_t)s * 4096 + t;
      const int tlo = d ? (4095 - (ch * 32 + 31)) : (ch * 32);
      const int rrow = t - tlo + 1;
#pragma unroll
      for (int g = 0; g < 5; ++g) *(u32x2*)(RAW + rrow * 320 + g * 64 + j0) = G[g];
      if (tid < 160) *(u32x2*)(RAW + (hr ? 33 : 0) * 320 + (hc >> 4) * 64 + (hc & 15) * 4) = GH;
      __syncthreads();
      if (ch + 1 < 128) {
        const int n2 = n + 32;
        const int t2 = d ? (4095 - n2) : n2;
        const size_t tok2 = (size_t)s * 4096 + t2;
#pragma unroll
        for (int g = 0; g < 5; ++g) {
          const int col = (g < 3) ? (g * 512 + h * 64) : (1536 + (g - 3) * 128 + d * 64);
          G[g] = *(const u32x2*)(PR + tok2 * PRW + col + j0);
        }
        GH = (u32x2){0u, 0u};
        if (tid < 160) {
          const int tlo2 = d ? (tlo - 32) : (tlo + 32);
          const int th = hr ? (tlo2 + 32) : (tlo2 - 1);
          const int g = hc >> 4;
          const int col = (g < 3) ? (g * 512 + h * 64) : (1536 + (g - 3) * 128 + d * 64);
          if (th >= 0 && th <= 4095) GH = *(const u32x2*)(PR + ((size_t)s * 4096 + th) * PRW + col + (hc & 15) * 4);
        }
      }
#pragma unroll
      for (int g = 0; g < 5; ++g) {
        float cur[4], prv[4], nxt[4];
        unpack4(*(const u32x2*)(RAW + rrow * 320 + g * 64 + j0), cur);
        unpack4(*(const u32x2*)(RAW + (rrow - 1) * 320 + g * 64 + j0), prv);
        unpack4(*(const u32x2*)(RAW + (rrow + 1) * 320 + g * 64 + j0), nxt);
        const f32x4 mp0 = *(const f32x4*)(MU + g * 64 + j0);
        const f32x4 mn0 = *(const f32x4*)(MU + 320 + g * 64 + j0);
        f32x4 x0;
#pragma unroll
        for (int e = 0; e < 4; ++e) x0[e] = cur[e] + mp0[e] * (prv[e] - cur[e]) + mn0[e] * (nxt[e] - cur[e]);
        if (g == 0) {
          *(f32x4*)(OPS + 4 * 2048 + pn * 64 + j0) = x0;
        } else if (g == 1) {
          *(f32x4*)(OPS + 3 * 2048 + pn * 64 + j0) = x0;
          const f32x4 kk0 = *(const f32x4*)(CST + 128 + j0);
          float ss = 0.f;
#pragma unroll
          for (int e = 0; e < 4; ++e) { const float a_ = x0[e] * kk0[e]; ss += a_ * a_; }
          ss = red16d(ss);
          if ((tid & 15) == 0) NRM[pn] = frcp(fmaxf(__builtin_amdgcn_sqrtf(ss), 1e-12f));
        } else if (g == 2) {
          *(f32x4*)(VV + pn * 64 + j0) = x0;
        } else if (g == 3) {
          u32x2 pk;
          pk.x = pack2(ftanh(x0[0]), ftanh(x0[1])); pk.y = pack2(ftanh(x0[2]), ftanh(x0[3]));
          *(u32x2*)(TWb + pn * 72 + j0) = pk;
        } else {
          u32x2 pk;
          pk.x = pack2(x0[0], x0[1]); pk.y = pack2(x0[2], x0[3]);
          *(u32x2*)(ADb + pn * 72 + j0) = pk;
        }
      }
      __syncthreads();
      {
        f32x4 cw = {0.f, 0.f, 0.f, 0.f}, ca = {0.f, 0.f, 0.f, 0.f};
#pragma unroll
        for (int ks = 0; ks < 2; ++ks) {
          const bf16x8 aw = *(const bf16x8*)(TWb + (wm * 16 + fr) * 72 + ks * 32 + fq * 8);
          const bf16x8 aa = *(const bf16x8*)(ADb + (wm * 16 + fr) * 72 + ks * 32 + fq * 8);
          cw = __builtin_amdgcn_mfma_f32_16x16x32_bf16(aw, bw[ks], cw, 0, 0, 0);
          ca = __builtin_amdgcn_mfma_f32_16x16x32_bf16(aa, ba[ks], ca, 0, 0, 0);
        }
#pragma unroll
        for (int jj = 0; jj < 4; ++jj) {
          WR[(wm * 16 + fq * 4 + jj) * 64 + wn * 16 + fr] = cw[jj];
          AP[(wm * 16 + fq * 4 + jj) * 64 + wn * 16 + fr] = ca[jj];
        }
      }
      __syncthreads();
      {
        const float inv = NRM[pn];
        float bsum = 0.f;
        const f32x4 wr_ = *(const f32x4*)(WR + pn * 64 + j0) + *(const f32x4*)(CST + j0);
        const f32x4 ap_ = *(const f32x4*)(AP + pn * 64 + j0) + *(const f32x4*)(CST + 64 + j0);
        const f32x4 kr = *(const f32x4*)(OPS + 3 * 2048 + pn * 64 + j0);
        const f32x4 rr = *(const f32x4*)(OPS + 4 * 2048 + pn * 64 + j0);
        const f32x4 kkw = *(const f32x4*)(CST + 128 + j0), kaw = *(const f32x4*)(CST + 192 + j0), rkw = *(const f32x4*)(CST + 256 + j0);
        f32x4 o0, o1, o2, o3;
#pragma unroll
        for (int e = 0; e < 4; ++e) {
          const float sw = sigm(wr_[e]);
          const float dec = __expf(-0.6065306597126334f * sw);
          const float av = sigm(ap_[e]);
          const float kn = kr[e] * kkw[e] * inv;
          const float kd = kr[e] * (1.f + (av - 1.f) * kaw[e]);
          bsum += rr[e] * kd * rkw[e];
          o0[e] = -kn; o1[e] = dec; o2[e] = kn * av; o3[e] = kd;
        }
        *(f32x4*)(OPS + 0 * 2048 + pn * 64 + j0) = o0;
        *(f32x4*)(OPS + 1 * 2048 + pn * 64 + j0) = o1;
        *(f32x4*)(OPS + 2 * 2048 + pn * 64 + j0) = o2;
        *(f32x4*)(OPS + 3 * 2048 + pn * 64 + j0) = o3;
        bsum = red16d(bsum);
        if ((tid & 15) == 0) BON[(tok * 8 + h) * 2 + d] = bsum;
      }
      __syncthreads();
      {
        ScanOps1 oa, ob;
        scan_load1(oa, OPS, VV, 0, jg, i0);
#pragma unroll 1
        for (int nn = 0; nn < 32; nn += 2) {
          scan_load1(ob, OPS, VV, nn + 1, jg, i0);
          scan_step1(oa, S0, YL, nn, jg, i0);
          scan_load1(oa, OPS, VV, (nn + 2) & 31, jg, i0);
          scan_step1(ob, S0, YL, nn + 1, jg, i0);
        }
      }
      __syncthreads();
      {
        typedef __attribute__((ext_vector_type(4))) _Float16 h16x4;
        h16x4 o;
#pragma unroll
        for (int e = 0; e < 4; ++e) o[e] = (_Float16)YL[pn * 64 + j0 + e];
        *(h16x4*)(Y + tok * 512 + h * 64 + j0) = o;
      }
    }
    __syncthreads();
  }
}

constexpr int PC_OPS = 0;
constexpr int PC_BUF = 49152;
constexpr int PC_RAW = 98304;
constexpr int PC_WR = 98304;
constexpr int PC_AP = 106496;
constexpr int PC_TW = 120064;
constexpr int PC_AD = 124672;
constexpr int PC_NRM = 129280;
constexpr int PC_MU = 129408;
constexpr int PC_CST = 131968;
constexpr int PC_YL = 133248;

DEVI void phase_scan_pc(int tid_, const Params& p, int l, char* smem, int bfirst, int bstride) {
  const u16* PR = (const u16*)(p.ws + OFF_PR);
  _Float16* YF = (_Float16*)(p.ws + OFF_H);
  _Float16* YB = (_Float16*)(p.ws + OFF_H + (size_t)NTOK * 512 * 2);
  float* BON = (float*)(p.ws + OFF_BONUS);
  const u16* WB = (const u16*)(p.ws + OFF_WB);
  u16* RAW = (u16*)(smem + PC_RAW);
  float* WR = (float*)(smem + PC_WR);
  float* AP = (float*)(smem + PC_AP);
  u16* TWb = (u16*)(smem + PC_TW);
  u16* ADb = (u16*)(smem + PC_AD);
  float* NRM = (float*)(smem + PC_NRM);
  float* MU = (float*)(smem + PC_MU);
  float* CST = (float*)(smem + PC_CST);
  const float* mu_p = p.in[I_MU_PREV] + (size_t)l * 1920;
  const float* mu_n = p.in[I_MU_NEXT] + (size_t)l * 1920;
  const bool is_prep = tid_ >= 256;
  const int tid = tid_ & 255, lane = tid & 63, w = tid >> 6, fr = lane & 15, fq = lane >> 4;
  const int pn = tid >> 3, j0 = (tid & 7) * 8;
  const int jg = lane & 7, i0 = w * 16 + (lane >> 3);
  const int hr = (tid >= 40) ? 1 : 0, hc = tid - hr * 40;
  for (int blk = bfirst; blk < 192; blk += bstride) {
    const int s = blk >> 4, h = (blk >> 1) & 7, d = blk & 1;
    __syncthreads();
    for (int i = tid_; i < 640; i += 512) {
      const int which = (i >= 320) ? 1 : 0, c = i - which * 320;
      const int g = c >> 6, e = c & 63;
      const int col = (g < 3) ? (g * 512 + h * 64 + e) : (1536 + (g - 3) * 128 + d * 64 + e);
      MU[i] = which ? mu_n[col] : mu_p[col];
    }
    if (tid_ < 320) {
      const int which = tid_ >> 6, e = tid_ & 63;
      float v;
      if (which == 0) v = p.in[I_W0][(size_t)(l * 2 + d) * 512 + h * 64 + e];
      else if (which == 1) v = p.in[I_A0][(size_t)(l * 2 + d) * 512 + h * 64 + e];
      else if (which == 2) v = p.in[I_K_K][(size_t)l * 512 + h * 64 + e];
      else if (which == 3) v = p.in[I_K_A][(size_t)l * 512 + h * 64 + e];
      else v = p.in[I_R_K][(size_t)(l * 8 + h) * 64 + e];
      CST[tid_] = v;
    }
    _Float16* Y = d ? YB : YF;
    if (is_prep) {
      bf16x8 bw[2], ba[2];
#pragma unroll
      for (int ks = 0; ks < 2; ++ks) {
        bw[ks] = *(const bf16x8*)(WB + W_WUP + (size_t)(d * 512 + h * 64 + w * 16 + fr) * 64 + ks * 32 + fq * 8);
        ba[ks] = *(const bf16x8*)(WB + W_AUP + (size_t)(d * 512 + h * 64 + w * 16 + fr) * 64 + ks * 32 + fq * 8);
      }
      u32x4 G[5], GH;
      {
        const int t = d ? (4095 - pn) : pn;
        const size_t tok = (size_t)s * 4096 + t;
#pragma unroll
        for (int g = 0; g < 5; ++g) {
          const int col = (g < 3) ? (g * 512 + h * 64) : (1536 + (g - 3) * 128 + d * 64);
          G[g] = *(const u32x4*)(PR + tok * PRW + col + j0);
        }
        GH = (u32x4){0u, 0u, 0u, 0u};
        if (tid < 80) {
          const int tlo = d ? (4095 - 31) : 0;
          const int th = hr ? (tlo + 32) : (tlo - 1);
          const int g = hc >> 3;
          const int col = (g < 3) ? (g * 512 + h * 64) : (1536 + (g - 3) * 128 + d * 64);
          if (th >= 0 && th <= 4095) GH = *(const u32x4*)(PR + ((size_t)s * 4096 + th) * PRW + col + (hc & 7) * 8);
        }
      }
#pragma unroll 1
      for (int ch = -1; ch < 128; ++ch) {
        const int c = ch + 1;
        const bool doprep = c < 128;
        float* OPS = (float*)(smem + PC_OPS + (c & 1) * PC_BUF);
        float* VV = OPS + 5 * 2048;
        const int n = c * 32 + pn;
        const int t = d ? (4095 - n) : n;
        const size_t tok = (size_t)s * 4096 + t;
        const int tlo = d ? (4095 - (c * 32 + 31)) : (c * 32);
        const int rrow = t - tlo + 1;
        __syncthreads();
        if (ch >= 1) {
          const float* YL = (const float*)(smem + PC_YL + ((ch - 1) & 1) * 8192);
          const int n1 = (ch - 1) * 32 + pn;
          const int t1 = d ? (4095 - n1) : n1;
          h16x8 o;
#pragma unroll
          for (int e = 0; e < 8; ++e) o[e] = (_Float16)YL[pn * 64 + j0 + e];
          *(h16x8*)(Y + ((size_t)s * 4096 + t1) * 512 + h * 64 + j0) = o;
        }
        if (doprep) {
#pragma unroll
          for (int g = 0; g < 5; ++g) *(u32x4*)(RAW + rrow * 320 + g * 64 + j0) = G[g];
          if (tid < 80) *(u32x4*)(RAW + (hr ? 33 : 0) * 320 + (hc >> 3) * 64 + (hc & 7) * 8) = GH;
        }
        __syncthreads();
        if (doprep) {
          if (c + 1 < 128) {
            const int n2 = n + 32;
            const int t2 = d ? (4095 - n2) : n2;
            const size_t tok2 = (size_t)s * 4096 + t2;
#pragma unroll
            for (int g = 0; g < 5; ++g) {
              const int col = (g < 3) ? (g * 512 + h * 64) : (1536 + (g - 3) * 128 + d * 64);
              G[g] = *(const u32x4*)(PR + tok2 * PRW + col + j0);
            }
            GH = (u32x4){0u, 0u, 0u, 0u};
            if (tid < 80) {
              const int tlo2 = d ? (tlo - 32) : (tlo + 32);
              const int th = hr ? (tlo2 + 32) : (tlo2 - 1);
              const int g = hc >> 3;
              const int col = (g < 3) ? (g * 512 + h * 64) : (1536 + (g - 3) * 128 + d * 64);
              if (th >= 0 && th <= 4095) GH = *(const u32x4*)(PR + ((size_t)s * 4096 + th) * PRW + col + (hc & 7) * 8);
            }
          }
#pragma unroll
          for (int g = 0; g < 5; ++g) {
            float cur[8], prv[8], nxt[8];
            load8bf(RAW + rrow * 320 + g * 64 + j0, cur);
            load8bf(RAW + (rrow - 1) * 320 + g * 64 + j0, prv);
            load8bf(RAW + (rrow + 1) * 320 + g * 64 + j0, nxt);
            const f32x4 mp0 = *(const f32x4*)(MU + g * 64 + j0), mp1 = *(const f32x4*)(MU + g * 64 + j0 + 4);
            const f32x4 mn0 = *(const f32x4*)(MU + 320 + g * 64 + j0), mn1 = *(const f32x4*)(MU + 320 + g * 64 + j0 + 4);
            f32x4 x0, x1;
#pragma unroll
            for (int e = 0; e < 4; ++e) {
              x0[e] = cur[e] + mp0[e] * (prv[e] - cur[e]) + mn0[e] * (nxt[e] - cur[e]);
              x1[e] = cur[4 + e] + mp1[e] * (prv[4 + e] - cur[4 + e]) + mn1[e] * (nxt[4 + e] - cur[4 + e]);
            }
            if (g == 0) {
              *(f32x4*)(OPS + 4 * 2048 + pn * 64 + j0) = x0; *(f32x4*)(OPS + 4 * 2048 + pn * 64 + j0 + 4) = x1;
            } else if (g == 1) {
              *(f32x4*)(OPS + 3 * 2048 + pn * 64 + j0) = x0; *(f32x4*)(OPS + 3 * 2048 + pn * 64 + j0 + 4) = x1;
              const f32x4 kk0 = *(const f32x4*)(CST + 128 + j0), kk1 = *(const f32x4*)(CST + 128 + j0 + 4);
              float ss = 0.f;
#pragma unroll
              for (int e = 0; e < 4; ++e) { const float a_ = x0[e] * kk0[e], b_ = x1[e] * kk1[e]; ss += a_ * a_ + b_ * b_; }
              ss = red8(ss);
              if ((tid & 7) == 0) NRM[pn] = frcp(fmaxf(__builtin_amdgcn_sqrtf(ss), 1e-12f));
            } else if (g == 2) {
              *(f32x4*)(VV + pn * 64 + j0) = x0; *(f32x4*)(VV + pn * 64 + j0 + 4) = x1;
            } else if (g == 3) {
              u32x4 pk;
              pk.x = pack2(ftanh(x0[0]), ftanh(x0[1])); pk.y = pack2(ftanh(x0[2]), ftanh(x0[3]));
              pk.z = pack2(ftanh(x1[0]), ftanh(x1[1])); pk.w = pack2(ftanh(x1[2]), ftanh(x1[3]));
              *(u32x4*)(TWb + pn * 72 + j0) = pk;
            } else {
              u32x4 pk;
              pk.x = pack2(x0[0], x0[1]); pk.y = pack2(x0[2], x0[3]);
              pk.z = pack2(x1[0], x1[1]); pk.w = pack2(x1[2], x1[3]);
              *(u32x4*)(ADb + pn * 72 + j0) = pk;
            }
          }
        }
        __syncthreads();
        if (doprep) {
#pragma unroll
          for (int m = 0; m < 2; ++m) {
            f32x4 cw = {0.f, 0.f, 0.f, 0.f}, ca = {0.f, 0.f, 0.f, 0.f};
#pragma unroll
            for (int ks = 0; ks < 2; ++ks) {
              const bf16x8 aw = *(const bf16x8*)(TWb + (m * 16 + fr) * 72 + ks * 32 + fq * 8);
              const bf16x8 aa = *(const bf16x8*)(ADb + (m * 16 + fr) * 72 + ks * 32 + fq * 8);
              cw = __builtin_amdgcn_mfma_f32_16x16x32_bf16(aw, bw[ks], cw, 0, 0, 0);
              ca = __builtin_amdgcn_mfma_f32_16x16x32_bf16(aa, ba[ks], ca, 0, 0, 0);
            }
#pragma unroll
            for (int jj = 0; jj < 4; ++jj) {
              WR[(m * 16 + fq * 4 + jj) * 64 + w * 16 + fr] = cw[jj];
              AP[(m * 16 + fq * 4 + jj) * 64 + w * 16 + fr] = ca[jj];
            }
          }
        }
        __syncthreads();
        if (doprep) {
          const float inv = NRM[pn];
          float bsum = 0.f;
#pragma unroll
          for (int hq = 0; hq < 2; ++hq) {
            const int jb = j0 + hq * 4;
            const f32x4 wr_ = *(const f32x4*)(WR + pn * 64 + jb) + *(const f32x4*)(CST + jb);
            const f32x4 ap_ = *(const f32x4*)(AP + pn * 64 + jb) + *(const f32x4*)(CST + 64 + jb);
            const f32x4 kr = *(const f32x4*)(OPS + 3 * 2048 + pn * 64 + jb);
            const f32x4 rr = *(const f32x4*)(OPS + 4 * 2048 + pn * 64 + jb);
            const f32x4 kkw = *(const f32x4*)(CST + 128 + jb), kaw = *(const f32x4*)(CST + 192 + jb), rkw = *(const f32x4*)(CST + 256 + jb);
            f32x4 o0, o1, o2, o3;
#pragma unroll
            for (int e = 0; e < 4; ++e) {
              const float sw = sigm(wr_[e]);
              const float dec = __expf(-0.6065306597126334f * sw);
              const float av = sigm(ap_[e]);
              const float kn = kr[e] * kkw[e] * inv;
              const float kd = kr[e] * (1.f + (av - 1.f) * kaw[e]);
              bsum += rr[e] * kd * rkw[e];
              o0[e] = -kn; o1[e] = dec; o2[e] = kn * av; o3[e] = kd;
            }
            *(f32x4*)(OPS + 0 * 2048 + pn * 64 + jb) = o0;
            *(f32x4*)(OPS + 1 * 2048 + pn * 64 + jb) = o1;
            *(f32x4*)(OPS + 2 * 2048 + pn * 64 + jb) = o2;
            *(f32x4*)(OPS + 3 * 2048 + pn * 64 + jb) = o3;
          }
          bsum = red8(bsum);
          if ((tid & 7) == 0) BON[(tok * 8 + h) * 2 + d] = bsum;
        }
      }
      __syncthreads();
      {
        const float* YL = (const float*)(smem + PC_YL + (127 & 1) * 8192);
        const int n1 = 127 * 32 + pn;
        const int t1 = d ? (4095 - n1) : n1;
        h16x8 o;
#pragma unroll
        for (int e = 0; e < 8; ++e) o[e] = (_Float16)YL[pn * 64 + j0 + e];
        *(h16x8*)(Y + ((size_t)s * 4096 + t1) * 512 + h * 64 + j0) = o;
      }
    } else {
      f32x2 S0[4], S1[4];
#pragma unroll
      for (int q = 0; q < 4; ++q) { S0[q] = (f32x2){0.f, 0.f}; S1[q] = (f32x2){0.f, 0.f}; }
#pragma unroll 1
      for (int ch = -1; ch < 128; ++ch) {
        const float* OPS = (const float*)(smem + PC_OPS + (ch & 1) * PC_BUF);
        const float* VV = OPS + 5 * 2048;
        float* YL = (float*)(smem + PC_YL + (ch & 1) * 8192);
        __syncthreads();
        if (ch < 0) {
          __syncthreads(); __syncthreads(); __syncthreads();
        } else {
          ScanOps oa, ob;
          scan_load(oa, OPS, VV, 0, jg, i0);
#pragma unroll 1
          for (int seg = 0; seg < 4; ++seg) {
            if (seg > 0) __syncthreads();
#pragma unroll 1
            for (int nn = seg * 8; nn < seg * 8 + 8; nn += 2) {
              scan_load(ob, OPS, VV, nn + 1, jg, i0);
              scan_step(oa, S0, S1, YL, nn, jg, i0);
              scan_load(oa, OPS, VV, (nn + 2) & 31, jg, i0);
              scan_step(ob, S0, S1, YL, nn + 1, jg, i0);
            }
          }
        }
      }
      __syncthreads();
    }
    __syncthreads();
  }
}

DEVI void phase_rwkv_post(int tid_, int vb_, int vg_, const Params& p, int l, char* smem) {
  u16* PR = (u16*)(p.ws + OFF_PR);
  const _Float16* YF = (const _Float16*)(p.ws + OFF_H);
  const _Float16* YB = (const _Float16*)(p.ws + OFF_H + (size_t)NTOK * 512 * 2);
  const float* BON = (const float*)(p.ws + OFF_BONUS);
  const u16* GUPT = (const u16*)(p.ws + OFF_WB) + W_GUP;
  const float* mu_p = p.in[I_MU_PREV] + (size_t)l * 1920;
  const float* mu_n = p.in[I_MU_NEXT] + (size_t)l * 1920;
  const float* gng = p.in[I_GN_G] + (size_t)l * 512;
  const float* gnb = p.in[I_GN_B] + (size_t)l * 512;
  u16* As = (u16*)smem;
  const int tid = tid_, lane = tid & 63, w = tid >> 6, fr = lane & 15, fq = lane >> 4;
  for (int tile = vb_; tile < NTOK / 64; tile += vg_) {
    const size_t tok0 = (size_t)tile * 64;
    {
      const int row = tid >> 2, part = tid & 3;
      const size_t tok = tok0 + row;
      const int t = (int)(tok & 4095);
#pragma unroll
      for (int q = 0; q < 4; ++q) {
        const int col = 1792 + part * 32 + q * 8;
        float cur[8], prv[8], nxt[8];
        load8bf(PR + tok * PRW + col, cur);
        if (t > 0) load8bf(PR + (tok - 1) * PRW + col, prv);
        else {
#pragma unroll
          for (int e = 0; e < 8; ++e) prv[e] = 0.f;
        }
        if (t < 4095) load8bf(PR + (tok + 1) * PRW + col, nxt);
        else {
#pragma unroll
          for (int e = 0; e < 8; ++e) nxt[e] = 0.f;
        }
        float o[8];
#pragma unroll
        for (int e = 0; e < 8; ++e) {
          const float x = cur[e] + mu_p[col + e] * (prv[e] - cur[e]) + mu_n[col + e] * (nxt[e] - cur[e]);
          o[e] = sigm(x);
        }
        u32x4 pk;
        pk.x = pack2(o[0], o[1]); pk.y = pack2(o[2], o[3]); pk.z = pack2(o[4], o[5]); pk.w = pack2(o[6], o[7]);
        *(u32x4*)(As + row * 136 + part * 32 + q * 8) = pk;
      }
    }
    asm volatile("" ::: "memory");
#pragma unroll 1
    for (int chh = 0; chh < 2; ++chh) {
      f32x4 acc[16];
#pragma unroll
      for (int n = 0; n < 16; ++n) acc[n] = (f32x4){0.f, 0.f, 0.f, 0.f};
#pragma unroll
      for (int ks = 0; ks < 4; ++ks) {
        bf16x8 af = *(const bf16x8*)(As + (w * 16 + fr) * 136 + ks * 32 + fq * 8);
#pragma unroll
        for (int n = 0; n < 16; ++n) {
          bf16x8 bg = *(const bf16x8*)(GUPT + (size_t)(chh * 256 + n * 16 + fr) * 128 + ks * 32 + fq * 8);
          acc[n] = __builtin_amdgcn_mfma_f32_16x16x32_bf16(af, bg, acc[n], 0, 0, 0);
        }
      }
#pragma unroll
      for (int hl = 0; hl < 4; ++hl) {
        const int head = chh * 4 + hl;
        asm volatile("" ::: "memory");
#pragma unroll
        for (int j = 0; j < 4; ++j) {
          const size_t tok = tok0 + w * 16 + fq * 4 + j;
          const int t = (int)(tok & 4095);
          float o[4], sum = 0.f;
#pragma unroll
          for (int q = 0; q < 4; ++q) {
            const int col = head * 64 + q * 16 + fr;
            o[q] = (float)YF[tok * 512 + col] + (float)YB[tok * 512 + col];
            sum += o[q];
          }
          const float mean = red16_sum(sum) * (1.f / 64.f);
          float vs = 0.f;
#pragma unroll
          for (int q = 0; q < 4; ++q) { const float dlt = o[q] - mean; vs += dlt * dlt; }
          const float var = red16_sum(vs) * (1.f / 64.f);
          const float rstd = rsqrtf(var + 64e-5f);
          const float bon = BON[(tok * 8 + head) * 2] + BON[(tok * 8 + head) * 2 + 1];
#pragma unroll
          for (int q = 0; q < 4; ++q) {
            const int col = head * 64 + q * 16 + fr;
            const int vc = 1024 + col;
            const float cur = bf2f(PR[tok * PRW + vc]);
            const float prv = (t > 0) ? bf2f(PR[(tok - 1) * PRW + vc]) : 0.f;
            const float nxt = (t < 4095) ? bf2f(PR[(tok + 1) * PRW + vc]) : 0.f;
            const float vsh = cur + mu_p[vc] * (prv - cur) + mu_n[vc] * (nxt - cur);
            const float yv = ((o[q] - mean) * rstd * gng[col] + gnb[col] + bon * vsh) * acc[hl * 4 + q][j];
            PR[tok * PRW + col] = f2bf(yv);
          }
        }
      }
    }
  }
}

DEVI f32x4 ld4bf(const u16* p) {
  const u32x2 u = *(const u32x2*)p;
  f32x4 o;
  o[0] = __uint_as_float(u.x << 16); o[1] = __uint_as_float(u.x & 0xffff0000u);
  o[2] = __uint_as_float(u.y << 16); o[3] = __uint_as_float(u.y & 0xffff0000u);
  return o;
}

DEVI void phase_merge(int tid_, const Params& p, char* smem, const float* ssq) {
  const u16* WB = (const u16*)(p.ws + OFF_WB);
  const u16* H = (const u16*)(p.ws + OFF_NK);
  u16* PR = (u16*)(p.ws + OFF_PR);
  const u16* NQ = (const u16*)(p.ws + OFF_NQ);
  u16* TMP = (u16*)(p.ws + OFF_H);
  const int lane = tid_ & 63, wid = tid_ >> 6;
  const int wr = wid >> 2, wc = wid & 3, fr = lane & 15, fq = lane >> 4;
  const bool xmap = (gridDim.x & 7) == 0;
  const int xcd = blockIdx.x & 7;
  const int first = xmap ? (int)(blockIdx.x >> 3) : (int)blockIdx.x;
  const int stride = xmap ? (int)(gridDim.x >> 3) : (int)gridDim.x;
  const int count = xmap ? 24 * 4 : 192 * 4;
  for (int it = first; it < count; it += stride) {
    const int tm = xmap ? (it >> 2) * 8 + xcd : (it >> 2), tn = it & 3;
    const int m0 = tm << 8, n0 = tn << 8;
    f32x4 acc[8][4];
#define MERGE_ZERO() _Pragma("unroll") for (int m = 0; m < 8; ++m) _Pragma("unroll") for (int n = 0; n < 4; ++n) acc[m][n] = (f32x4){0.f, 0.f, 0.f, 0.f}
#define MERGE_RC() const int r = m0 + wr * 128 + m * 16 + fr, c0 = n0 + wc * 64 + n * 16 + fq * 4
    MERGE_ZERO();
    gemm_kloop8<true>(launder(tid_), acc, H + (size_t)m0 * 1024, 1024, WB + W_IN + (size_t)(3456 + n0) * 1024, 1024, 1024, smem);
#pragma unroll
    for (int m = 0; m < 8; ++m)
#pragma unroll
      for (int n = 0; n < 4; ++n) {
        MERGE_RC();
        const float rs = rstd_of(ssq, r);
        f32x4 o;
#pragma unroll
        for (int j = 0; j < 4; ++j) o[j] = sigm(acc[m][n][j] * rs);
        store4bf(PR + (size_t)r * PRW + 512 + c0, o);
      }
    MERGE_ZERO();
    gemm_kloop8<true>(launder(tid_), acc, PR + (size_t)m0 * PRW, PRW, WB + W_BRR + (size_t)n0 * 512, 512, 512, smem);
#pragma unroll
    for (int m = 0; m < 8; ++m)
#pragma unroll
      for (int n = 0; n < 4; ++n) {
        MERGE_RC();
        u16* dst = PR + (size_t)r * PRW + 512 + c0;
        store4bf(dst, ld4bf(dst) * acc[m][n]);
      }
    MERGE_ZERO();
    gemm_kloop8<true>(launder(tid_), acc, H + (size_t)m0 * 1024, 1024, WB + W_IN + (size_t)(4480 + n0) * 1024, 1024, 1024, smem);
#pragma unroll
    for (int m = 0; m < 8; ++m)
#pragma unroll
      for (int n = 0; n < 4; ++n) {
        MERGE_RC();
        const float rs = rstd_of(ssq, r);
        f32x4 o;
#pragma unroll
        for (int j = 0; j < 4; ++j) o[j] = sigm(acc[m][n][j] * rs);
        store4bf(TMP + (size_t)r * 1024 + c0, o);
      }
    MERGE_ZERO();
    gemm_kloop8<true>(launder(tid_), acc, NQ + (size_t)m0 * 512, 512, WB + W_BRN + (size_t)n0 * 512, 512, 512, smem);
#pragma unroll
    for (int m = 0; m < 8; ++m)
#pragma unroll
      for (int n = 0; n < 4; ++n) {
        MERGE_RC();
        u16* dst = PR + (size_t)r * PRW + 512 + c0;
        store4bf(dst, ld4bf(dst) + ld4bf(TMP + (size_t)r * 1024 + c0) * acc[m][n]);
      }
#undef MERGE_ZERO
#undef MERGE_RC
  }
}


DEVI void phase_xattn(int tid_, int vb_, int vg_, const Params& p, char* smem) {
  const u16* Q = (const u16*)(p.ws + OFF_PR);
  u16* O = (u16*)(p.ws + OFF_NQ);
  const u16* KVK = (const u16*)(p.ws + OFF_KVK);
  const u16* KVT = (const u16*)(p.ws + OFF_KVT);
  const int lane = tid_ & 63, w = tid_ >> 6, fr = lane & 15, fq = lane >> 4;
  u16* Pw = (u16*)smem + w * (32 * 264);
  for (int t = vb_; t < (NTOK / 128) * 4; t += vg_) {
    const int hh = t & 3;
    const size_t tok0 = (size_t)(t >> 2) * 128 + w * 32;
    const int s = (int)(tok0 >> 12);
    f32x4 acc[2][16];
#pragma unroll
    for (int mt = 0; mt < 2; ++mt)
#pragma unroll
      for (int n = 0; n < 16; ++n) acc[mt][n] = (f32x4){0.f, 0.f, 0.f, 0.f};
#pragma unroll 1
    for (int ks = 0; ks < 8; ++ks) {
      const bf16x8 aq0 = *(const bf16x8*)(Q + (tok0 + fr) * 1024 + hh * 256 + ks * 32 + fq * 8);
      const bf16x8 aq1 = *(const bf16x8*)(Q + (tok0 + 16 + fr) * 1024 + hh * 256 + ks * 32 + fq * 8);
#pragma unroll
      for (int n = 0; n < 16; ++n) {
        const bf16x8 bk = *(const bf16x8*)(KVK + (size_t)(s * 256 + n * 16 + fr) * 1024 + hh * 256 + ks * 32 + fq * 8);
        acc[0][n] = __builtin_amdgcn_mfma_f32_16x16x32_bf16(bk, aq0, acc[0][n], 0, 0, 0);
        acc[1][n] = __builtin_amdgcn_mfma_f32_16x16x32_bf16(bk, aq1, acc[1][n], 0, 0, 0);
      }
    }
    float sm[2];
#pragma unroll
    for (int mt = 0; mt < 2; ++mt) {
      float m = -1e30f;
#pragma unroll
      for (int n = 0; n < 16; ++n)
#pragma unroll
        for (int j = 0; j < 4; ++j) m = fmaxf(m, acc[mt][n][j]);
      m = red4x_max(m) * 0.0625f;
      float ssum = 0.f;
#pragma unroll
      for (int n = 0; n < 16; ++n) {
        f32x4 e;
#pragma unroll
        for (int j = 0; j < 4; ++j) { e[j] = __expf(acc[mt][n][j] * 0.0625f - m); ssum += e[j]; }
        store4bf(Pw + (mt * 16 + fr) * 264 + n * 16 + fq * 4, e);
      }
      sm[mt] = 1.f / red4x_sum(ssum);
    }
#pragma unroll
    for (int mt = 0; mt < 2; ++mt)
#pragma unroll
      for (int n = 0; n < 16; ++n) acc[mt][n] = (f32x4){0.f, 0.f, 0.f, 0.f};
#pragma unroll 1
    for (int ks = 0; ks < 8; ++ks) {
      const bf16x8 ap0 = *(const bf16x8*)(Pw + fr * 264 + ks * 32 + fq * 8);
      const bf16x8 ap1 = *(const bf16x8*)(Pw + (16 + fr) * 264 + ks * 32 + fq * 8);
#pragma unroll
      for (int n = 0; n < 16; ++n) {
        const bf16x8 bv = *(const bf16x8*)(KVT + (size_t)(s * 1024 + hh * 256 + n * 16 + fr) * 256 + ks * 32 + fq * 8);
        acc[0][n] = __builtin_amdgcn_mfma_f32_16x16x32_bf16(bv, ap0, acc[0][n], 0, 0, 0);
        acc[1][n] = __builtin_amdgcn_mfma_f32_16x16x32_bf16(bv, ap1, acc[1][n], 0, 0, 0);
      }
    }
#pragma unroll
    for (int mt = 0; mt < 2; ++mt)
#pragma unroll
      for (int n = 0; n < 16; ++n)
        store4bf(O + (tok0 + mt * 16 + fr) * 1024 + hh * 256 + n * 16 + fq * 4, acc[mt][n] * sm[mt]);
  }
}

constexpr int HALF_SMEM = 78720;

DEVI void run_phase(int tid_, const Params& p, int ph, char* smem) {
  const int half = tid_ >> 8, vt = tid_ & 255;
  const int vb_ = blockIdx.x * 2 + half, vg_ = gridDim.x * 2;
  char* smh = smem + half * HALF_SMEM;
  if (ph == 2 * NPH_LAYER) { phase_final_norm(vt, vb_, vg_, p); return; }
  const int l = ph / NPH_LAYER, q = ph % NPH_LAYER;
  u16* WB = (u16*)(p.ws + OFF_WB);
  u16* H = (u16*)(p.ws + OFF_H);
  u16* PR = (u16*)(p.ws + OFF_PR);
  u16* NQ = (u16*)(p.ws + OFF_NQ);
  float* X = p.X;
  float* SSQ = (float*)(p.ws + OFF_SSQ);
  auto epi_res = [&](int r, int c0, f32x4 v) {
    f32x4* px = (f32x4*)(X + (size_t)r * 1024 + c0);
    *px = *px + v;
  };
  float rowacc = 0.f;
  float* ssq_out = SSQ;
  const bool x_from_input = (l == 0 && q <= 5);
  const bool need_xb = !(l == 1 && q == 12);
  auto epi_res_n = [&](int r, int c0, f32x4 v) {
    f32x4* px = (f32x4*)(X + (size_t)r * 1024 + c0);
    const float* srow = x_from_input ? ((r < 32768) ? p.in[I_XP] + (size_t)r * 1024 : p.in[I_XS] + (size_t)(r - 32768) * 1024)
                                     : X + (size_t)r * 1024;
    const f32x4 xn = *(const f32x4*)(srow + c0) + v;
    *px = xn;
    if (need_xb) store4bf(H + (size_t)r * 1024 + c0, xn);
    rowacc += xn[0] * xn[0] + xn[1] * xn[1] + xn[2] * xn[2] + xn[3] * xn[3];
  };
  auto row_end = [&](int r) {
    float t = rowacc;
    t += __shfl_xor(t, 16);
    t += __shfl_xor(t, 32);
    if ((tid_ & 48) == 0) atomicAdd(ssq_out + r, t);
    rowacc = 0.f;
  };
  constexpr int NONS = 1 << 30;
  switch (q) {
    case 0:
      phase_conv(vt, vb_, vg_, p, l, smh);
      phase_norm_mem(vt, vb_, vg_, p, p.in[I_NORM_MEM] + (size_t)l * 1024);
      if (l == 0) {
        phase_xb(vt, vb_, vg_, p, true, OFF_H, SSQ);
        for (int i = vb_ * 256 + vt; i < 6 * NTOK; i += vg_ * 256) SSQ[NTOK + i] = 0.f;
      }
      break;
    case 1: phase_p_gemm(tid_, p, smem, SSQ + (size_t)(3 * l) * NTOK); break;
    case 2:
      if (gridDim.x >= 224) {
        if (blockIdx.x < 192) phase_scan_pc(tid_, p, l, smem, blockIdx.x, gridDim.x);
        else phase_nat(vt, p, l, smh, vb_ - 384, vg_ - 384);
      } else {
        phase_scan(vt, p, l, smh, vb_, vg_);
        __syncthreads();
        phase_nat(vt, p, l, smh, vb_, vg_);
      }
      break;
    case 3:
      phase_rwkv_post(vt, vb_, vg_, p, l, smh);
      phase_xb(vt, vb_, vg_, p, l == 0, OFF_NK, nullptr);
      break;
    case 4: phase_merge(tid_, p, smem, SSQ + (size_t)(3 * l) * NTOK); break;
    case 5:
      ssq_out = SSQ + (size_t)(3 * l + 1) * NTOK;
      gemm_phase8(tid_, PR + 512, PRW, WB + W_OUT, 1024, 1024, NTOK, 1024, smem, NONS, epi_res_n, NoEpi(), row_end);
      break;
    case 6: {
      const float* ssq = SSQ + (size_t)(3 * l + 1) * NTOK;
      const int fq_ = (tid_ & 63) >> 4;
      gemm_phase8(tid_, H, 1024, WB + W_XQ, 1024, 1024, NTOK, 1024, smem, NONS,
                 [&](int r, int c0, f32x4 v) { store4bf(PR + (size_t)r * 1024 + c0, v * rstd_of(ssq, r)); }, NoEpi(), NoRow(), 0,
                 make_pair_epi([&](int r, int c, f32x4 va, f32x4 vb) {
                   const float rs = rstd_of(ssq, r);
                   store_pair_bf16(PR + (size_t)r * 1024, c, fq_, pack4bf(va * rs), pack4bf(vb * rs));
                 }));
    } break;
    case 7: phase_xattn(vt, vb_, vg_, p, smh); break;
    case 8:
      ssq_out = SSQ + (size_t)(3 * l + 2) * NTOK;
      gemm_phase8(tid_, NQ, 1024, WB + W_XO, 1024, 1024, NTOK, 1024, smem, NONS, epi_res_n, NoEpi(), row_end);
      break;
    case 9:
    case 11: {
      const int hf = (q == 11);
      const float* ssq = SSQ + (size_t)(3 * l + 2) * NTOK;
      gemm_phase8(tid_, H, 1024, WB + W_FF1 + (size_t)hf * 2048 * 1024, 1024, 1024, NTOK, 2048, smem, NONS,
                 [&](int r, int c0, f32x4 v) {
                   const float rs = rstd_of(ssq, r);
                   f32x4 o;
#pragma unroll
                   for (int j = 0; j < 4; ++j) { const float x = fmaxf(v[j] * rs, 0.f); o[j] = x * x; }
                   store4bf(PR + (size_t)r * 2048 + c0, o);
                 }, NoEpi(), NoRow(), 0,
                 make_pair_epi([&](int r, int c, f32x4 va, f32x4 vb) {
                   const float rs = rstd_of(ssq, r);
                   f32x4 oa, ob;
#pragma unroll
                   for (int j = 0; j < 4; ++j) {
                     const float xa = fmaxf(va[j] * rs, 0.f), xb = fmaxf(vb[j] * rs, 0.f);
                     oa[j] = xa * xa; ob[j] = xb * xb;
                   }
                   store_pair_bf16(PR + (size_t)r * 2048, c, (tid_ & 63) >> 4, pack4bf(oa), pack4bf(ob));
                 }));
    } break;
    case 10:
      gemm_phase8(tid_, PR, 2048, WB + W_FF2, 4096, 2048, NTOK, 1024, smem, NONS, epi_res, NoEpi());
      break;
    case 12:
      ssq_out = SSQ + (size_t)(3 * l + 3) * NTOK;
      gemm_phase8(tid_, PR, 2048, WB + W_FF2 + 2048, 4096, 2048, NTOK, 1024, smem, NONS, epi_res_n, NoEpi(), row_end);
      break;
  }
}

#define XB_TMO      128
#define XB_XCNT(j)  (256  + 64 * (j))
#define XB_XSUB(j)  (1280 + 64 * (j))
#define XB_XGEN(j)  (2304 + 64 * (j))
#define XB_TOP      3328
#define XB_TOPGEN   3392
#define XCD_BAR_WORDS 3456
#define XB_SPIN_CAP (1u << 20)
#define LAS __attribute__((address_space(3)))

DEVI unsigned xb_ld(unsigned* p) { return __hip_atomic_load(p, __ATOMIC_RELAXED, __HIP_MEMORY_SCOPE_AGENT); }
DEVI unsigned xb_add(unsigned* p, unsigned v) { return __hip_atomic_fetch_add(p, v, __ATOMIC_RELAXED, __HIP_MEMORY_SCOPE_AGENT); }
DEVI unsigned xb_xcc_id() { return (unsigned)__builtin_amdgcn_s_getreg((3 << 11) | 20) & 0xFu; }
#define XB_SPIN(cond, bar) do { unsigned _sp = 0; while (cond) { __builtin_amdgcn_s_sleep(1); \
    if ((++_sp & 255u) == 0u) { if (xb_ld(&(bar)[XB_TMO])) break; if (_sp > XB_SPIN_CAP) { atomicAdd(&(bar)[XB_TMO], 1u); break; } } } } while (0)

struct XcdBarrier {
  unsigned* bar; unsigned x;
  volatile LAS unsigned* st;
};
DEVI XcdBarrier xcd_barrier_post(unsigned* bar, volatile LAS unsigned* st) {
  XcdBarrier b; b.bar = bar; b.x = xb_xcc_id(); b.st = st;
  if (threadIdx.x == 0) (void)xb_add(&bar[XB_XCNT(b.x)], 1u);
  return b;
}
DEVI void xcd_barrier_complete(unsigned* bar, unsigned x, unsigned& nloc, unsigned& nx) {
  const unsigned G = gridDim.x * gridDim.y * gridDim.z;
  unsigned sum, cnt, mine, sp = 0u;
  for (;;) {
    sum = 0u; cnt = 0u; mine = 0u;
#pragma unroll
    for (unsigned j = 0; j < 16; ++j) { const unsigned c = xb_ld(&bar[XB_XCNT(j)]); sum += c; cnt += (c > 0u) ? 1u : 0u; mine = (j == x) ? c : mine; }
    if (sum == G) break;
    __builtin_amdgcn_s_sleep(1);
    if ((++sp & 255u) == 0u) { if (xb_ld(&bar[XB_TMO])) break; if (sp > XB_SPIN_CAP) { atomicAdd(&bar[XB_TMO], 1u); break; } }
  }
  nloc = mine > 0u ? mine : 1u; nx = cnt > 0u ? cnt : 1u;
}
DEVI void xcd_barrier(const XcdBarrier& b) {
  asm volatile("s_waitcnt vmcnt(0)" ::: "memory");
  __syncthreads();
  if (threadIdx.x == 0) {
    unsigned* bar = b.bar;
    __builtin_amdgcn_s_waitcnt(0);
    unsigned nloc = b.st[0], nx = b.st[1];
    if (nloc == 0u) { xcd_barrier_complete(bar, b.x, nloc, nx); b.st[0] = nloc; b.st[1] = nx; }
    const unsigned old = xb_add(&bar[XB_XSUB(b.x)], 1u);
    const unsigned gen = old / nloc;
    if (old + 1u == (gen + 1u) * nloc) {
      __builtin_amdgcn_fence(__ATOMIC_RELEASE, "agent");
      asm volatile("s_waitcnt vmcnt(0)" ::: "memory");
      const unsigned og = xb_add(&bar[XB_TOP], 1u);
      const unsigned tg = og / nx;
      if (og + 1u == (tg + 1u) * nx) xb_add(&bar[XB_TOPGEN], 1u);
      else XB_SPIN(xb_ld(&bar[XB_TOPGEN]) == tg, bar);
      __builtin_amdgcn_fence(__ATOMIC_ACQUIRE, "agent");
      xb_add(&bar[XB_XGEN(b.x)], 1u);
      asm volatile("s_waitcnt vmcnt(0)" ::: "memory");
    } else {
      XB_SPIN(xb_ld(&bar[XB_XGEN(b.x)]) == gen, bar);
      __builtin_amdgcn_fence(__ATOMIC_ACQUIRE, "agent");
      asm volatile("s_waitcnt vmcnt(0)" ::: "memory");
    }
  }
  __syncthreads();
}

__global__ void __launch_bounds__(512, 2) mega_kernel(Params p, int ph0, int ph1) {
  __shared__ __attribute__((aligned(16))) char smem[2 * HALF_SMEM];
  __shared__ __attribute__((aligned(16))) unsigned xb_words[4];
  if (threadIdx.x == 0) { xb_words[0] = 0u; xb_words[1] = 0u; xb_words[2] = 0u; xb_words[3] = 0u; }
  __syncthreads();
  XcdBarrier xb = xcd_barrier_post((unsigned*)(p.ws + OFF_BAR), (volatile LAS unsigned*)xb_words);
  for (int ph = ph0; ph < ph1; ++ph) {
    if (ph == ph0 + 1) cg::this_grid().sync();
    else if (ph > ph0) xcd_barrier(xb);
    int tid_ = threadIdx.x;
    asm volatile("" : "+v"(tid_));
    run_phase(tid_, p, ph, smem);
  }
}

extern "C" void kernel_launch(void* const* d_in, const int* in_sizes, int n_in, void* d_out, int out_size, void* d_ws,
                              size_t ws_size, hipStream_t stream) {
  if (ws_size < WS_NEED || n_in < 31) return;
  Params p{};
  for (int i = 0; i < 31; ++i) p.in[i] = (const float*)d_in[i];
  p.X = (float*)d_out;
  p.ws = (char*)d_ws;
  static int grid_blocks = 0;
  if (!grid_blocks) {
    int dev = 0, cus = 0, per_cu = 0;
    hipGetDevice(&dev);
    hipDeviceGetAttribute(&cus, hipDeviceAttributeMultiprocessorCount, dev);
    hipOccupancyMaxActiveBlocksPerMultiprocessor(&per_cu, mega_kernel, 512, 0);
    if (per_cu > 1) per_cu = 1;
    if (per_cu < 1) per_cu = 1;
    grid_blocks = cus * per_cu;
  }
  hipMemsetAsync((char*)d_ws + OFF_BAR, 0, 16384, stream);
  int ph0 = 0, ph1 = NPHASES;
  void* args[] = {&p, &ph0, &ph1};
  hipLaunchCooperativeKernel((void*)mega_kernel, dim3(grid_blocks), dim3(512), args, 0, stream);
}
```

```cpp
#include <hip/hip_runtime.h>
#include <hip/hip_cooperative_groups.h>
#include <stdint.h>
namespace cg = cooperative_groups;

typedef unsigned short u16;
typedef __attribute__((ext_vector_type(8))) short bf16x8;
typedef __attribute__((ext_vector_type(4))) float f32x4;
typedef __attribute__((ext_vector_type(8))) _Float16 h16x8;
typedef __attribute__((ext_vector_type(4))) unsigned int u32x4;
typedef __attribute__((ext_vector_type(2))) unsigned int u32x2;

#define DEVI __device__ __forceinline__

constexpr int NTOK = 49152;
constexpr int SEQ_T = 4096;
constexpr int PRW = 1920;
constexpr int NPH_LAYER = 13;
constexpr int NPHASES = 2 * NPH_LAYER + 1;
constexpr int SMEM_BYTES = 78720;

constexpr size_t OFF_WB = 0;
constexpr size_t WB_BYTES = 20512768ull * 2;
constexpr size_t OFF_H = OFF_WB + WB_BYTES;
constexpr size_t OFF_PR = OFF_H + (size_t)NTOK * 1024 * 2;
constexpr size_t OFF_NQ = OFF_PR + (size_t)NTOK * PRW * 2;
constexpr size_t OFF_NK = OFF_NQ + (size_t)NTOK * 512 * 2;
constexpr size_t OFF_NV = OFF_NK + (size_t)NTOK * 512 * 2;
constexpr size_t OFF_KVK = OFF_NV + (size_t)NTOK * 512 * 2;
constexpr size_t OFF_KVT = OFF_KVK + (size_t)3072 * 1024 * 2;
constexpr size_t OFF_MEMH = OFF_KVT + (size_t)3072 * 1024 * 2;
constexpr size_t OFF_BONUS = OFF_MEMH + (size_t)3072 * 1024 * 2;
constexpr size_t OFF_BAR = OFF_BONUS + (size_t)NTOK * 16 * 4;
constexpr size_t OFF_SSQ = OFF_BAR + 16384;
constexpr size_t WS_NEED = OFF_SSQ + (size_t)7 * NTOK * 4;

constexpr size_t W_IN = 0;
constexpr size_t W_BRR = W_IN + (size_t)5504 * 1024;
constexpr size_t W_BRN = W_BRR + (size_t)1024 * 512;
constexpr size_t W_OUT = W_BRN + (size_t)1024 * 512;
constexpr size_t W_XQ = W_OUT + (size_t)1024 * 1024;
constexpr size_t W_XKV = W_XQ + (size_t)1024 * 1024;
constexpr size_t W_XO = W_XKV + (size_t)2048 * 1024;
constexpr size_t W_FF1 = W_XO + (size_t)1024 * 1024;
constexpr size_t W_FF2 = W_FF1 + (size_t)4096 * 1024;
constexpr size_t W_GUP = W_FF2 + (size_t)4096 * 1024;
constexpr size_t W_WUP = W_GUP + (size_t)512 * 128;
constexpr size_t W_AUP = W_WUP + (size_t)2 * 512 * 64;

enum { I_XP = 0, I_XS, I_MP, I_MS, I_NORM_MIX, I_W_IN, I_MU_PREV, I_MU_NEXT, I_W0, I_W_UP, I_A0, I_A_UP,
       I_G_UP, I_K_K, I_K_A, I_R_K, I_GN_G, I_GN_B, I_RPB, I_W_BR_RWKV, I_W_BR_NAT, I_W_OUT, I_NORM_X,
       I_NORM_MEM, I_W_XQ, I_W_XKV, I_W_XO, I_NORM_FF, I_W_FF1, I_W_FF2, I_NORM_FINAL };

struct Params {
  const float* in[31];
  float* X;
  char* ws;
};

DEVI u16 f2bf(float f) {
  uint32_t u = __float_as_uint(f);
  u += 0x7FFFu + ((u >> 16) & 1u);
  return (u16)(u >> 16);
}
DEVI float bf2f(u16 h) { return __uint_as_float(((uint32_t)h) << 16); }
DEVI uint32_t pack2(float a, float b) { return (uint32_t)f2bf(a) | ((uint32_t)f2bf(b) << 16); }
DEVI float frcp(float x) { return __builtin_amdgcn_rcpf(x); }
DEVI float sigm(float x) { return frcp(1.f + __expf(-x)); }
DEVI float ftanh(float x) { return 1.f - 2.f * frcp(__expf(2.f * x) + 1.f); }
DEVI void unpack8(u32x4 u, float* o) {
  o[0] = __uint_as_float(u.x << 16); o[1] = __uint_as_float(u.x & 0xffff0000u);
  o[2] = __uint_as_float(u.y << 16); o[3] = __uint_as_float(u.y & 0xffff0000u);
  o[4] = __uint_as_float(u.z << 16); o[5] = __uint_as_float(u.z & 0xffff0000u);
  o[6] = __uint_as_float(u.w << 16); o[7] = __uint_as_float(u.w & 0xffff0000u);
}
DEVI void load8bf(const u16* p, float* o) { unpack8(*(const u32x4*)p, o); }
DEVI float wave_sum(float v) {
  v += __shfl_xor(v, 32); v += __shfl_xor(v, 16); v += __shfl_xor(v, 8);
  v += __shfl_xor(v, 4); v += __shfl_xor(v, 2); v += __shfl_xor(v, 1);
  return v;
}
DEVI float red4x_sum(float v) { v += __shfl_xor(v, 16); v += __shfl_xor(v, 32); return v; }
DEVI float red4x_max(float v) { v = fmaxf(v, __shfl_xor(v, 16)); v = fmaxf(v, __shfl_xor(v, 32)); return v; }
DEVI float red16_sum(float v) {
  v += __shfl_xor(v, 1); v += __shfl_xor(v, 2); v += __shfl_xor(v, 4); v += __shfl_xor(v, 8);
  return v;
}
DEVI float red16_max(float v) {
  v = fmaxf(v, __shfl_xor(v, 1)); v = fmaxf(v, __shfl_xor(v, 2));
  v = fmaxf(v, __shfl_xor(v, 4)); v = fmaxf(v, __shfl_xor(v, 8));
  return v;
}

DEVI void conv_tile(int tid_, const float* src, int K, int N, u16* dst, int tile, char* smem, const float* gain = nullptr) {
  float (*s)[65] = (float (*)[65])smem;
  const int nN = N >> 6;
  const int tk = tile / nN, tn = tile - tk * nN;
  const int tx = tid_ & 63, ty = tid_ >> 6;
  for (int r = ty; r < 64; r += 4) s[r][tx] = src[(size_t)(tk * 64 + r) * N + tn * 64 + tx];
  __syncthreads();
  const float gk = gain ? gain[tk * 64 + tx] : 1.f;
  for (int r = ty; r < 64; r += 4) dst[(size_t)(tn * 64 + r) * K + tk * 64 + tx] = f2bf(s[tx][r] * gk);
  __syncthreads();
}

DEVI void phase_conv(int tid_, int vb_, int vg_, const Params& p, int l, char* smem) {
  u16* WB = (u16*)(p.ws + OFF_WB);
  const int c0 = 1376, c1 = c0 + 128, c2 = c1 + 128, c3 = c2 + 256, c4 = c3 + 256, c5 = c4 + 512,
            c6 = c5 + 256, c7 = c6 + 1024, c8 = c7 + 1024, c9 = c8 + 16, c10 = c9 + 16, c11 = c10 + 16;
  for (int t = vb_; t < c11; t += vg_) {
    if (t < c0) conv_tile(tid_, p.in[I_W_IN] + (size_t)l * 1024 * 5504, 1024, 5504, WB + W_IN, t, smem, p.in[I_NORM_MIX] + (size_t)l * 1024);
    else if (t < c1) conv_tile(tid_, p.in[I_W_BR_RWKV] + (size_t)l * 512 * 1024, 512, 1024, WB + W_BRR, t - c0, smem);
    else if (t < c2) conv_tile(tid_, p.in[I_W_BR_NAT] + (size_t)l * 512 * 1024, 512, 1024, WB + W_BRN, t - c1, smem);
    else if (t < c3) conv_tile(tid_, p.in[I_W_OUT] + (size_t)l * 1024 * 1024, 1024, 1024, WB + W_OUT, t - c2, smem);
    else if (t < c4) conv_tile(tid_, p.in[I_W_XQ] + (size_t)l * 1024 * 1024, 1024, 1024, WB + W_XQ, t - c3, smem, p.in[I_NORM_X] + (size_t)l * 1024);
    else if (t < c5) conv_tile(tid_, p.in[I_W_XKV] + (size_t)l * 1024 * 2048, 1024, 2048, WB + W_XKV, t - c4, smem);
    else if (t < c6) conv_tile(tid_, p.in[I_W_XO] + (size_t)l * 1024 * 1024, 1024, 1024, WB + W_XO, t - c5, smem);
    else if (t < c7) conv_tile(tid_, p.in[I_W_FF1] + (size_t)l * 1024 * 4096, 1024, 4096, WB + W_FF1, t - c6, smem, p.in[I_NORM_FF] + (size_t)l * 1024);
    else if (t < c8) conv_tile(tid_, p.in[I_W_FF2] + (size_t)l * 4096 * 1024, 4096, 1024, WB + W_FF2, t - c7, smem);
    else if (t < c9) conv_tile(tid_, p.in[I_G_UP] + (size_t)l * 128 * 512, 128, 512, WB + W_GUP, t - c8, smem);
    else if (t < c10) { const int dd = (t - c9) >> 3; conv_tile(tid_, p.in[I_W_UP] + (size_t)(l * 2 + dd) * 64 * 512, 64, 512, WB + W_WUP + (size_t)dd * 512 * 64, (t - c9) & 7, smem); }
    else { const int dd = (t - c10) >> 3; conv_tile(tid_, p.in[I_A_UP] + (size_t)(l * 2 + dd) * 64 * 512, 64, 512, WB + W_AUP + (size_t)dd * 512 * 64, (t - c10) & 7, smem); }
  }
}

DEVI void norm_row_bf16(int tid_, const float* src, const float* g, u16* dst, float* xcopy) {
  const int lane = tid_ & 63;
  float4 v[4];
  float ss = 0.f;
#pragma unroll
  for (int i = 0; i < 4; ++i) {
    v[i] = ((const float4*)src)[lane + i * 64];
    ss += v[i].x * v[i].x + v[i].y * v[i].y + v[i].z * v[i].z + v[i].w * v[i].w;
  }
  ss = wave_sum(ss);
  const float rs = rsqrtf(ss * (1.f / 1024.f) + 1e-6f);
#pragma unroll
  for (int i = 0; i < 4; ++i) {
    float4 gg = ((const float4*)g)[lane + i * 64];
    u32x2 o;
    o.x = pack2(v[i].x * rs * gg.x, v[i].y * rs * gg.y);
    o.y = pack2(v[i].z * rs * gg.z, v[i].w * rs * gg.w);
    ((u32x2*)dst)[lane + i * 64] = o;
    if (xcopy) ((float4*)xcopy)[lane + i * 64] = v[i];
  }
}

DEVI void phase_xb(int tid_, int vb_, int vg_, const Params& p, bool from_input, size_t hoff, float* ssq) {
  u16* H = (u16*)(p.ws + hoff);
  const int wid = tid_ >> 6, lane = tid_ & 63;
  for (int r = vb_ * 4 + wid; r < NTOK; r += vg_ * 4) {
    const float* src;
    if (from_input) src = (r < 32768) ? p.in[I_XP] + (size_t)r * 1024 : p.in[I_XS] + (size_t)(r - 32768) * 1024;
    else src = p.X + (size_t)r * 1024;
    float ss = 0.f;
#pragma unroll
    for (int i = 0; i < 4; ++i) {
      const float4 v = ((const float4*)src)[lane + i * 64];
      ss += v.x * v.x + v.y * v.y + v.z * v.z + v.w * v.w;
      u32x2 o;
      o.x = pack2(v.x, v.y); o.y = pack2(v.z, v.w);
      ((u32x2*)(H + (size_t)r * 1024))[lane + i * 64] = o;
    }
    if (ssq) {
      ss = wave_sum(ss);
      if (lane == 0) ssq[r] = ss;
    }
  }
}
DEVI void phase_norm_mem(int tid_, int vb_, int vg_, const Params& p, const float* g) {
  u16* MH = (u16*)(p.ws + OFF_MEMH);
  const int wid = tid_ >> 6;
  for (int r = vb_ * 4 + wid; r < 3072; r += vg_ * 4) {
    const float* src = (r < 2048) ? p.in[I_MP] + (size_t)r * 1024 : p.in[I_MS] + (size_t)(r - 2048) * 1024;
    norm_row_bf16(tid_, src, g, MH + (size_t)r * 1024, nullptr);
  }
}
DEVI void phase_final_norm(int tid_, int vb_, int vg_, const Params& p) {
  const float* g = p.in[I_NORM_FINAL];
  const float* ssq = (const float*)(p.ws + OFF_SSQ) + (size_t)6 * NTOK;
  const int wid = tid_ >> 6, lane = tid_ & 63;
  for (int r = vb_ * 4 + wid; r < NTOK; r += vg_ * 4) {
    float* row = p.X + (size_t)r * 1024;
    const float rs = rsqrtf(ssq[r] * (1.f / 1024.f) + 1e-6f);
#pragma unroll
    for (int i = 0; i < 4; ++i) {
      const float4 v = ((const float4*)row)[lane + i * 64];
      const float4 gg = ((const float4*)g)[lane + i * 64];
      float4 o;
      o.x = v.x * rs * gg.x; o.y = v.y * rs * gg.y; o.z = v.z * rs * gg.z; o.w = v.w * rs * gg.w;
      ((float4*)row)[lane + i * 64] = o;
    }
  }
}

template <int OFF>
DEVI bf16x8 lds_rd128(uint32_t addr) {
  bf16x8 r;
  asm volatile("ds_read_b128 %0, %1 offset:%2" : "=v"(r) : "v"(addr), "n"(OFF));
  return r;
}

template <int NW, bool SWAP>
DEVI void gemm_kloop(int tid_, f32x4 (&acc)[4][NW], const u16* __restrict__ A, int lda, const u16* __restrict__ Bt, int ldb,
                     int K, char* smem) {
  constexpr int STG = 8192 + NW * 2048;
  constexpr int NB = NW / 2;
  const int tid = tid_, lane = tid & 63, wid = tid >> 6;
  const int wr = wid >> 1, wc = wid & 1, fr = lane & 15, fq = lane >> 4;
  const int lrow = lane >> 2, lphys = lane & 3, lhi = lane >> 4;
  const int gsw = (4 - lhi) & 3;
  const u16* ga[2];
  const u16* gb[NB];
#pragma unroll
  for (int q = 0; q < 2; ++q) ga[q] = A + (size_t)((wid * 2 + q) * 16 + lrow) * lda + (lphys ^ gsw) * 8;
#pragma unroll
  for (int q = 0; q < NB; ++q) gb[q] = Bt + (size_t)((wid * NB + q) * 16 + lrow) * ldb + (lphys ^ gsw) * 8;
  const int rsw = (4 - ((fr >> 2) & 3)) & 3;
  const int ch = (fq ^ rsw) * 16;
  const int nk = K >> 5;
  const uint32_t lds_base = (uint32_t)(size_t)(__attribute__((address_space(3))) char*)smem;
  const uint32_t aoff = (uint32_t)((wr * 64 + fr) * 64 + ch);
  const uint32_t boff = (uint32_t)(8192 + (wc * 16 * NW + fr) * 64 + ch);
  asm volatile("s_waitcnt vmcnt(0)" ::: "memory");
  __syncthreads();
#define GEMM_ISSUE(kt_)                                                                                              \
  do {                                                                                                               \
    char* nb_ = smem + ((kt_) & 3) * STG;                                                                            \
    _Pragma("unroll") for (int q = 0; q < 2; ++q) __builtin_amdgcn_global_load_lds(                                  \
        (const unsigned*)(ga[q] + (kt_) * 32),                                                                       \
        (__attribute__((address_space(3))) unsigned*)(nb_ + (wid * 2 + q) * 1024 + lane * 16), 16, 0, 0);            \
    _Pragma("unroll") for (int q = 0; q < NB; ++q) __builtin_amdgcn_global_load_lds(                                 \
        (const unsigned*)(gb[q] + (kt_) * 32),                                                                       \
        (__attribute__((address_space(3))) unsigned*)(nb_ + 8192 + (wid * NB + q) * 1024 + lane * 16), 16, 0, 0);    \
  } while (0)
  GEMM_ISSUE(0);
  if (nk > 1) GEMM_ISSUE(1);
  if (nk > 2) GEMM_ISSUE(2);
  for (int kt = 0; kt < nk; ++kt) {
    if (kt + 2 < nk) {
      if (NW == 4) asm volatile("s_waitcnt vmcnt(8)" ::: "memory");
      else asm volatile("s_waitcnt vmcnt(6)" ::: "memory");
    } else if (kt + 1 < nk) {
      if (NW == 4) asm volatile("s_waitcnt vmcnt(4)" ::: "memory");
      else asm volatile("s_waitcnt vmcnt(3)" ::: "memory");
    } else {
      asm volatile("s_waitcnt vmcnt(0)" ::: "memory");
    }
    __builtin_amdgcn_s_barrier();
    asm volatile("" ::: "memory");
    if (kt + 3 < nk) GEMM_ISSUE(kt + 3);
    const uint32_t sb = lds_base + (kt & 3) * STG;
    bf16x8 af[4], bfr[4];
    af[0] = lds_rd128<0>(sb + aoff); af[1] = lds_rd128<1024>(sb + aoff);
    af[2] = lds_rd128<2048>(sb + aoff); af[3] = lds_rd128<3072>(sb + aoff);
    bfr[0] = lds_rd128<0>(sb + boff); bfr[1] = lds_rd128<1024>(sb + boff);
    if (NW == 4) {
      bfr[2] = lds_rd128<2048>(sb + boff); bfr[3] = lds_rd128<3072>(sb + boff);
      asm volatile("s_waitcnt lgkmcnt(0)" : "+v"(af[0]), "+v"(af[1]), "+v"(af[2]), "+v"(af[3]),
                   "+v"(bfr[0]), "+v"(bfr[1]), "+v"(bfr[2]), "+v"(bfr[3]));
    } else {
      asm volatile("s_waitcnt lgkmcnt(0)" : "+v"(af[0]), "+v"(af[1]), "+v"(af[2]), "+v"(af[3]), "+v"(bfr[0]), "+v"(bfr[1]));
    }
#pragma unroll
    for (int m = 0; m < 4; ++m)
#pragma unroll
      for (int n = 0; n < NW; ++n) {
        if (SWAP) acc[m][n] = __builtin_amdgcn_mfma_f32_16x16x32_bf16(bfr[n], af[m], acc[m][n], 0, 0, 0);
        else acc[m][n] = __builtin_amdgcn_mfma_f32_16x16x32_bf16(af[m], bfr[n], acc[m][n], 0, 0, 0);
      }
  }
#undef GEMM_ISSUE
}

DEVI int launder(int x) { asm volatile("" : "+v"(x)); return x; }

template <int NW>
DEVI void zero_acc(f32x4 (&acc)[4][NW]) {
#pragma unroll
  for (int m = 0; m < 4; ++m)
#pragma unroll
    for (int n = 0; n < NW; ++n) acc[m][n] = (f32x4){0.f, 0.f, 0.f, 0.f};
}

struct NoEpi { DEVI void operator()(int, int, f32x4) const {} };

template <class EpiS, class EpiN>
DEVI void gemm_phase(int tid_, const u16* A, int lda, const u16* Bt, int ldb, int K, int M, int N, char* smem, int ns_from,
                     EpiS epiS, EpiN epiN) {
  const int nN = N >> 7, nM = M >> 7;
  const int lane = tid_ & 63, wid = tid_ >> 6;
  const int wr = wid >> 1, wc = wid & 1, fr = lane & 15, fq = lane >> 4;
  const int xcd = blockIdx.x & 7, jloc = blockIdx.x >> 3, nloc = gridDim.x >> 3;
  for (int lt = jloc; lt < (nM >> 3) * nN; lt += nloc) {
    const int tml = lt / nN, tn = lt - tml * nN;
    const int tm = tml * 8 + xcd;
    const int m0 = tm << 7, n0 = tn << 7;
    f32x4 acc[4][4];
    zero_acc(acc);
    if (n0 < ns_from) {
      gemm_kloop<4, true>(tid_, acc, A + (size_t)m0 * lda, lda, Bt + (size_t)n0 * ldb, ldb, K, smem);
#pragma unroll
      for (int m = 0; m < 4; ++m)
#pragma unroll
        for (int n = 0; n < 4; ++n) epiS(m0 + wr * 64 + m * 16 + fr, n0 + wc * 64 + n * 16 + fq * 4, acc[m][n]);
    } else {
      gemm_kloop<4, false>(tid_, acc, A + (size_t)m0 * lda, lda, Bt + (size_t)n0 * ldb, ldb, K, smem);
#pragma unroll
      for (int m = 0; m < 4; ++m)
#pragma unroll
        for (int n = 0; n < 4; ++n) epiN(m0 + wr * 64 + m * 16 + fq * 4, n0 + wc * 64 + n * 16 + fr, acc[m][n]);
    }
  }
}


template <bool SWAP>
DEVI void gemm_kloop_big(int tid_, f32x4 (&acc)[8][4], const u16* __restrict__ A, int lda, const u16* __restrict__ Bt,
                         int ldb, int K, char* smem) {
  constexpr int STG = 16384 + 8192;
  const int tid = tid_, lane = tid & 63, wid = tid >> 6;
  const int wr = wid >> 1, wc = wid & 1, fr = lane & 15, fq = lane >> 4;
  const int lrow = lane >> 2, lphys = lane & 3, lhi = lane >> 4;
  const int gsw = (4 - lhi) & 3;
  const u16* ga = A + (size_t)(wid * 64 + lrow) * lda + (lphys ^ gsw) * 8;
  const u16* gb = Bt + (size_t)(wid * 32 + lrow) * ldb + (lphys ^ gsw) * 8;
  const size_t a16 = (size_t)16 * lda, b16 = (size_t)16 * ldb;
  const int rsw = (4 - ((fr >> 2) & 3)) & 3;
  const int ch = (fq ^ rsw) * 16;
  const int nk = K >> 5;
  const uint32_t lds_base = (uint32_t)(size_t)(__attribute__((address_space(3))) char*)smem;
  const uint32_t aoff = (uint32_t)((wr * 128 + fr) * 64 + ch);
  const uint32_t boff = (uint32_t)(16384 + (wc * 64 + fr) * 64 + ch);
  asm volatile("s_waitcnt vmcnt(0)" ::: "memory");
  __syncthreads();
#define GEMMB_ISSUE(kt_, buf_)                                                                                       \
  do {                                                                                                               \
    char* nb_ = smem + (buf_) * STG;                                                                                 \
    _Pragma("unroll") for (int q = 0; q < 4; ++q) __builtin_amdgcn_global_load_lds(                                  \
        (const unsigned*)(ga + q * a16 + (kt_) * 32),                                                                \
        (__attribute__((address_space(3))) unsigned*)(nb_ + (wid * 4 + q) * 1024 + lane * 16), 16, 0, 0);            \
    _Pragma("unroll") for (int q = 0; q < 2; ++q) __builtin_amdgcn_global_load_lds(                                  \
        (const unsigned*)(gb + q * b16 + (kt_) * 32),                                                                \
        (__attribute__((address_space(3))) unsigned*)(nb_ + 16384 + (wid * 2 + q) * 1024 + lane * 16), 16, 0, 0);   \
  } while (0)
  GEMMB_ISSUE(0, 0);
  if (nk > 1) GEMMB_ISSUE(1, 1);
  int cb = 0;
  for (int kt = 0; kt < nk; ++kt) {
    if (kt + 1 < nk) asm volatile("s_waitcnt vmcnt(6)" ::: "memory");
    else asm volatile("s_waitcnt vmcnt(0)" ::: "memory");
    __builtin_amdgcn_s_barrier();
    asm volatile("" ::: "memory");
    const int nbuf = (cb == 0) ? 2 : cb - 1;
    if (kt + 2 < nk) GEMMB_ISSUE(kt + 2, nbuf);
    const uint32_t sb = lds_base + cb * STG;
    bf16x8 a0[4], a1[4], bb[4];
    a0[0] = lds_rd128<0>(sb + aoff); a0[1] = lds_rd128<1024>(sb + aoff);
    a0[2] = lds_rd128<2048>(sb + aoff); a0[3] = lds_rd128<3072>(sb + aoff);
    bb[0] = lds_rd128<0>(sb + boff); bb[1] = lds_rd128<1024>(sb + boff);
    bb[2] = lds_rd128<2048>(sb + boff); bb[3] = lds_rd128<3072>(sb + boff);
    a1[0] = lds_rd128<4096>(sb + aoff); a1[1] = lds_rd128<5120>(sb + aoff);
    a1[2] = lds_rd128<6144>(sb + aoff); a1[3] = lds_rd128<7168>(sb + aoff);
    asm volatile("s_waitcnt lgkmcnt(4)" : "+v"(a0[0]), "+v"(a0[1]), "+v"(a0[2]), "+v"(a0[3]),
                 "+v"(bb[0]), "+v"(bb[1]), "+v"(bb[2]), "+v"(bb[3]));
#pragma unroll
    for (int m = 0; m < 4; ++m)
#pragma unroll
      for (int n = 0; n < 4; ++n) {
        if (SWAP) acc[m][n] = __builtin_amdgcn_mfma_f32_16x16x32_bf16(bb[n], a0[m], acc[m][n], 0, 0, 0);
        else acc[m][n] = __builtin_amdgcn_mfma_f32_16x16x32_bf16(a0[m], bb[n], acc[m][n], 0, 0, 0);
      }
    asm volatile("s_waitcnt lgkmcnt(0)" : "+v"(a1[0]), "+v"(a1[1]), "+v"(a1[2]), "+v"(a1[3]));
#pragma unroll
    for (int m = 0; m < 4; ++m)
#pragma unroll
      for (int n = 0; n < 4; ++n) {
        if (SWAP) acc[4 + m][n] = __builtin_amdgcn_mfma_f32_16x16x32_bf16(bb[n], a1[m], acc[4 + m][n], 0, 0, 0);
        else acc[4 + m][n] = __builtin_amdgcn_mfma_f32_16x16x32_bf16(a1[m], bb[n], acc[4 + m][n], 0, 0, 0);
      }
    cb = (cb == 2) ? 0 : cb + 1;
  }
#undef GEMMB_ISSUE
}

template <class EpiS, class EpiN>
DEVI void gemm_phase_big(int tid_, const u16* A, int lda, const u16* Bt, int ldb, int K, int M, int N, char* smem,
                         int ns_from, EpiS epiS, EpiN epiN) {
  const int nN = N >> 7, nM = M >> 8;
  const int lane = tid_ & 63, wid = tid_ >> 6;
  const int wr = wid >> 1, wc = wid & 1, fr = lane & 15, fq = lane >> 4;
  const int xcd = blockIdx.x & 7, jloc = blockIdx.x >> 3, nloc = gridDim.x >> 3;
  for (int lt = jloc; lt < (nM >> 3) * nN; lt += nloc) {
    const int tml = lt / nN, tn = lt - tml * nN;
    const int tm = tml * 8 + xcd;
    const int m0 = tm << 8, n0 = tn << 7;
    f32x4 acc[8][4];
#pragma unroll
    for (int m = 0; m < 8; ++m)
#pragma unroll
      for (int n = 0; n < 4; ++n) acc[m][n] = (f32x4){0.f, 0.f, 0.f, 0.f};
    if (n0 < ns_from) {
      gemm_kloop_big<true>(launder(tid_), acc, A + (size_t)m0 * lda, lda, Bt + (size_t)n0 * ldb, ldb, K, smem);
#pragma unroll
      for (int m = 0; m < 8; ++m)
#pragma unroll
        for (int n = 0; n < 4; ++n) epiS(m0 + wr * 128 + m * 16 + fr, n0 + wc * 64 + n * 16 + fq * 4, acc[m][n]);
    } else {
      gemm_kloop_big<false>(launder(tid_), acc, A + (size_t)m0 * lda, lda, Bt + (size_t)n0 * ldb, ldb, K, smem);
#pragma unroll
      for (int m = 0; m < 8; ++m)
#pragma unroll
        for (int n = 0; n < 4; ++n) epiN(m0 + wr * 128 + m * 16 + fq * 4, n0 + wc * 64 + n * 16 + fr, acc[m][n]);
    }
  }
}


template <bool SWAP>
DEVI void gemm_kloop8(int tid_, f32x4 (&acc)[8][4], const u16* __restrict__ A, int lda, const u16* __restrict__ Bt,
                      int ldb, int K, char* smem, bool have_pref = false, const u16* An = nullptr, int lda_n = 0,
                      const u16* Bn = nullptr, int ldb_n = 0) {
  constexpr int STG = 65536;
  const int tid = tid_, lane = tid & 63, wid = tid >> 6;
  const int wr = wid >> 2, wc = wid & 3, fr = lane & 15, fq = lane >> 4;
  const int lrow = lane >> 3, lphys = lane & 7, lhi = lane >> 4;
  const u16* ga[4];
  const u16* gb[4];
#pragma unroll
  for (int q = 0; q < 4; ++q) {
    const int kc = lphys ^ ((4 * (q & 1) + lhi) & 7);
    ga[q] = A + (size_t)((wid * 4 + q) * 8 + lrow) * lda + kc * 8;
    gb[q] = Bt + (size_t)((wid * 4 + q) * 8 + lrow) * ldb + kc * 8;
  }
  const int swz = (fr >> 1) & 7;
  const int nk = K >> 6;
  const uint32_t lds_base = (uint32_t)(size_t)(__attribute__((address_space(3))) char*)smem;
  const uint32_t arow = (uint32_t)((wr * 128 + fr) * 128);
  const uint32_t brow = (uint32_t)(32768 + (wc * 64 + fr) * 128);
  if (__builtin_amdgcn_readfirstlane(tid_) >= 256) __builtin_amdgcn_s_setprio(1);
  if (!have_pref) {
    asm volatile("s_waitcnt vmcnt(0)" ::: "memory");
    __syncthreads();
  }
#define GEMM8_ISSUE(kt_)                                                                                             \
  do {                                                                                                               \
    char* nb_ = smem + ((kt_) & 1) * STG;                                                                            \
    _Pragma("unroll") for (int q = 0; q < 4; ++q) __builtin_amdgcn_global_load_lds(                                  \
        (const unsigned*)(ga[q] + (kt_) * 64),                                                                       \
        (__attribute__((address_space(3))) unsigned*)(nb_ + (wid * 4 + q) * 1024 + lane * 16), 16, 0, 0);            \
    _Pragma("unroll") for (int q = 0; q < 4; ++q) __builtin_amdgcn_global_load_lds(                                  \
        (const unsigned*)(gb[q] + (kt_) * 64),                                                                       \
        (__attribute__((address_space(3))) unsigned*)(nb_ + 32768 + (wid * 4 + q) * 1024 + lane * 16), 16, 0, 0);    \
  } while (0)
  if (!have_pref) GEMM8_ISSUE(0);
  for (int kt = 0; kt < nk; ++kt) {
    asm volatile("s_waitcnt vmcnt(0)" ::: "memory");
    __builtin_amdgcn_s_barrier();
    asm volatile("" ::: "memory");
    if (kt + 1 < nk) GEMM8_ISSUE(kt + 1);
    else if (An) {
#pragma unroll
      for (int q = 0; q < 4; ++q) {
        const int kc = lphys ^ ((4 * (q & 1) + lhi) & 7);
        __builtin_amdgcn_global_load_lds((const unsigned*)(An + (size_t)((wid * 4 + q) * 8 + lrow) * lda_n + kc * 8),
            (__attribute__((address_space(3))) unsigned*)(smem + (wid * 4 + q) * 1024 + lane * 16), 16, 0, 0);
        __builtin_amdgcn_global_load_lds((const unsigned*)(Bn + (size_t)((wid * 4 + q) * 8 + lrow) * ldb_n + kc * 8),
            (__attribute__((address_space(3))) unsigned*)(smem + 32768 + (wid * 4 + q) * 1024 + lane * 16), 16, 0, 0);
      }
    }
    const uint32_t sb = lds_base + (kt & 1) * STG;
#pragma unroll
    for (int ks = 0; ks < 2; ++ks) {
      const uint32_t chb = (uint32_t)(((ks * 4 + fq) ^ swz) * 16);
      const uint32_t aoff = sb + arow + chb, boff = sb + brow + chb;
      bf16x8 a0[4], a1[4], bb[4];
      a0[0] = lds_rd128<0>(aoff); a0[1] = lds_rd128<2048>(aoff);
      a0[2] = lds_rd128<4096>(aoff); a0[3] = lds_rd128<6144>(aoff);
      bb[0] = lds_rd128<0>(boff); bb[1] = lds_rd128<2048>(boff);
      bb[2] = lds_rd128<4096>(boff); bb[3] = lds_rd128<6144>(boff);
      a1[0] = lds_rd128<8192>(aoff); a1[1] = lds_rd128<10240>(aoff);
      a1[2] = lds_rd128<12288>(aoff); a1[3] = lds_rd128<14336>(aoff);
      asm volatile("s_waitcnt lgkmcnt(4)" : "+v"(a0[0]), "+v"(a0[1]), "+v"(a0[2]), "+v"(a0[3]),
                   "+v"(bb[0]), "+v"(bb[1]), "+v"(bb[2]), "+v"(bb[3]));
#pragma unroll
      for (int m = 0; m < 4; ++m)
#pragma unroll
        for (int n = 0; n < 4; ++n) {
          if (SWAP) acc[m][n] = __builtin_amdgcn_mfma_f32_16x16x32_bf16(bb[n], a0[m], acc[m][n], 0, 0, 0);
          else acc[m][n] = __builtin_amdgcn_mfma_f32_16x16x32_bf16(a0[m], bb[n], acc[m][n], 0, 0, 0);
        }
      asm volatile("s_waitcnt lgkmcnt(0)" : "+v"(a1[0]), "+v"(a1[1]), "+v"(a1[2]), "+v"(a1[3]));
#pragma unroll
      for (int m = 0; m < 4; ++m)
#pragma unroll
        for (int n = 0; n < 4; ++n) {
          if (SWAP) acc[4 + m][n] = __builtin_amdgcn_mfma_f32_16x16x32_bf16(bb[n], a1[m], acc[4 + m][n], 0, 0, 0);
          else acc[4 + m][n] = __builtin_amdgcn_mfma_f32_16x16x32_bf16(a1[m], bb[n], acc[4 + m][n], 0, 0, 0);
        }
    }
  }
#undef GEMM8_ISSUE
  __builtin_amdgcn_s_setprio(0);
}

struct NoRow { DEVI void operator()(int) const {} };
struct NoPair { static constexpr bool enabled = false; DEVI void operator()(int, int, f32x4, f32x4) const {} };

DEVI void store_pair_bf16(u16* rowp, int c, int fq, u32x2 p0, u32x2 p1) {
  const auto sx = __builtin_amdgcn_permlane16_swap(p0.x, p1.x, false, false);
  const auto sy = __builtin_amdgcn_permlane16_swap(p0.y, p1.y, false, false);
  u32x4 o;
  o.x = sx[0]; o.y = sy[0]; o.z = sx[1]; o.w = sy[1];
  const int col = (fq & 1) ? (c + 16 + (fq - 1) * 4) : (c + fq * 4);
  *(u32x4*)(rowp + col) = o;
}
DEVI u32x2 pack4bf(f32x4 v) { u32x2 o; o.x = pack2(v[0], v[1]); o.y = pack2(v[2], v[3]); return o; }
template <class F> struct PairEpi {
  static constexpr bool enabled = true;
  F f;
  DEVI void operator()(int r, int c, f32x4 a, f32x4 b) const { f(r, c, a, b); }
};
template <class F> DEVI PairEpi<F> make_pair_epi(F f) { return PairEpi<F>{f}; }

template <class EpiS, class EpiN, class RowEnd = NoRow, class EpiP = NoPair>
DEVI void gemm_phase8(int tid_, const u16* A, int lda, const u16* Bt, int ldb, int K, int M, int N, char* smem,
                      int ns_from, EpiS epiS, EpiN epiN, RowEnd rowEnd = NoRow(), int rot = 0, EpiP epiP = NoPair()) {
  const int nN = (N + 255) >> 8, nM = M >> 8;
  const int lane = tid_ & 63, wid = tid_ >> 6;
  const int wr = wid >> 2, wc = wid & 3, fr = lane & 15, fq = lane >> 4;
  const bool xmap = ((gridDim.x & 7) == 0) && ((nM & 7) == 0);
  const int xcd = blockIdx.x & 7;
  const int first = xmap ? (int)(blockIdx.x >> 3) : (int)((blockIdx.x + gridDim.x - rot) % gridDim.x);
  const int stride = xmap ? (int)(gridDim.x >> 3) : (int)gridDim.x;
  const int count = xmap ? (nM >> 3) * nN : nM * nN;
  bool pref = false;
  for (int it = first; it < count; it += stride) {
    const int tq = it / nN, tn = it - tq * nN;
    const int tm = xmap ? tq * 8 + xcd : tq;
    const int m0 = tm << 8, n0 = tn << 8;
    const int colb = n0 + wc * 64;
    const u16* An = nullptr; const u16* Bn = nullptr;
    if (it + stride < count) {
      const int it2 = it + stride;
      const int tq2 = it2 / nN, tn2 = it2 - tq2 * nN;
      An = A + (size_t)((xmap ? tq2 * 8 + xcd : tq2) << 8) * lda;
      Bn = Bt + (size_t)(tn2 << 8) * ldb;
    }
    f32x4 acc[8][4];
#pragma unroll
    for (int m = 0; m < 8; ++m)
#pragma unroll
      for (int n = 0; n < 4; ++n) acc[m][n] = (f32x4){0.f, 0.f, 0.f, 0.f};
    if (colb < ns_from) {
      gemm_kloop8<true>(launder(tid_), acc, A + (size_t)m0 * lda, lda, Bt + (size_t)n0 * ldb, ldb, K, smem, pref, An, lda, Bn, ldb);
      if (colb < N) {
        if (EpiP::enabled) {
#pragma unroll
          for (int m = 0; m < 8; ++m) {
            epiP(m0 + wr * 128 + m * 16 + fr, colb, acc[m][0], acc[m][1]);
            epiP(m0 + wr * 128 + m * 16 + fr, colb + 32, acc[m][2], acc[m][3]);
          }
        } else {
#pragma unroll
          for (int m = 0; m < 8; ++m) {
#pragma unroll
            for (int n = 0; n < 4; ++n) epiS(m0 + wr * 128 + m * 16 + fr, colb + n * 16 + fq * 4, acc[m][n]);
            rowEnd(m0 + wr * 128 + m * 16 + fr);
          }
        }
      }
    } else {
      gemm_kloop8<false>(launder(tid_), acc, A + (size_t)m0 * lda, lda, Bt + (size_t)n0 * ldb, ldb, K, smem, pref, An, lda, Bn, ldb);
      if (colb < N) {
#pragma unroll
        for (int m = 0; m < 8; ++m)
#pragma unroll
          for (int n = 0; n < 4; ++n) epiN(m0 + wr * 128 + m * 16 + fq * 4, colb + n * 16 + fr, acc[m][n]);
      }
    }
    pref = (An != nullptr);
  }
  asm volatile("s_waitcnt vmcnt(0)" ::: "memory");
}

DEVI void store4bf(u16* dst, f32x4 v) {
  u32x2 o;
  o.x = pack2(v[0], v[1]); o.y = pack2(v[2], v[3]);
  *(u32x2*)dst = o;
}

DEVI float rstd_of(const float* ssq, int r) { return rsqrtf(ssq[r] * (1.f / 1024.f) + 1e-6f); }

DEVI void phase_p_gemm(int tid_, const Params& p, char* smem, const float* ssq) {
  u16* WB = (u16*)(p.ws + OFF_WB);
  const u16* H = (const u16*)(p.ws + OFF_H);
  u16* PR = (u16*)(p.ws + OFF_PR);
  u16* NQ = (u16*)(p.ws + OFF_NQ);
  u16* NK = (u16*)(p.ws + OFF_NK);
  u16* NVT = (u16*)(p.ws + OFF_NV);
  gemm_phase8(tid_, H, 1024, WB + W_IN, 1024, 1024, NTOK, 3456, smem, 2944,
    [&](int r, int c0, f32x4 v) {
      v = v * rstd_of(ssq, r);
      if (c0 < 1920) store4bf(PR + (size_t)r * PRW + c0, v);
      else if (c0 < 2432) store4bf(NQ + (size_t)r * 512 + (c0 - 1920), v);
      else store4bf(NK + (size_t)r * 512 + (c0 - 2432), v);
    },
    [&](int r0, int c, f32x4 v) {
      const int cc = c - 2944;
      const int s = r0 >> 12, t = r0 & 4095;
      const f32x4 q = *(const f32x4*)(ssq + r0);
#pragma unroll
      for (int j = 0; j < 4; ++j) v[j] *= rsqrtf(q[j] * (1.f / 1024.f) + 1e-6f);
      store4bf(NVT + ((size_t)(s * 512 + cc)) * 4096 + t, v);
    }, NoRow(), 0,
    make_pair_epi([&](int r, int c, f32x4 va, f32x4 vb) {
      const float rs = rstd_of(ssq, r);
      u16* rowp; int cl;
      if (c < 1920) { rowp = PR + (size_t)r * PRW; cl = c; }
      else if (c < 2432) { rowp = NQ + (size_t)r * 512; cl = c - 1920; }
      else { rowp = NK + (size_t)r * 512; cl = c - 2432; }
      store_pair_bf16(rowp, cl, (tid_ & 63) >> 4, pack4bf(va * rs), pack4bf(vb * rs));
    }));
  const u16* MH = (const u16*)(p.ws + OFF_MEMH);
  u16* KVK = (u16*)(p.ws + OFF_KVK);
  u16* KVT = (u16*)(p.ws + OFF_KVT);
  gemm_phase8(tid_, MH, 1024, WB + W_XKV, 1024, 1024, 3072, 2048, smem, 1024,
    [&](int r, int c0, f32x4 v) { store4bf(KVK + (size_t)r * 1024 + c0, v); },
    [&](int r0, int c, f32x4 v) {
      const int cc = c - 1024;
      const int s = r0 >> 8, m = r0 & 255;
      store4bf(KVT + ((size_t)(s * 1024 + cc)) * 256 + m, v);
    }, NoRow(), 128);
}

DEVI void phase_nat(int tid_, const Params& p, int l, char* smem, int bfirst, int bstride) {
  u16* NQ = (u16*)(p.ws + OFF_NQ);
  const u16* NK = (const u16*)(p.ws + OFF_NK);
  const u16* NVT = (const u16*)(p.ws + OFF_NV);
  const float* rpb = p.in[I_RPB] + (size_t)l * 8 * 15 * 31;
  const int lane = tid_ & 63, g = tid_ >> 6, fr = lane & 15, fq = lane >> 4;
  u16* Pw = (u16*)smem + g * (16 * 264);
  const int cb = (g == 0) ? 0 : (g == 1) ? 8 : (g == 2) ? 24 : 32;
  const int c = g * 16 + fr;
  int cs = c - 8; cs = cs < 0 ? 0 : (cs > 48 ? 48 : cs);
  for (int t = bfirst; t < 12 * 64 * 8; t += bstride) {
    const int h = t & 7, ri = (t >> 3) & 63, s = t >> 9;
    int rs = ri - 4; rs = rs < 0 ? 0 : (rs > 56 ? 56 : rs);
    const size_t tokq = (size_t)s * 4096 + ri * 64 + g * 16;
    bf16x8 aq[2];
    aq[0] = *(const bf16x8*)(NQ + (tokq + fr) * 512 + h * 64 + fq * 8);
    aq[1] = *(const bf16x8*)(NQ + (tokq + fr) * 512 + h * 64 + 32 + fq * 8);
    f32x4 acc[16];
#pragma unroll
    for (int n = 0; n < 16; ++n) {
      acc[n] = (f32x4){0.f, 0.f, 0.f, 0.f};
      const int r = n >> 1, col = cb + (n & 1) * 16 + fr;
      const u16* kp = NK + ((size_t)s * 4096 + (rs + r) * 64 + col) * 512 + h * 64 + fq * 8;
      const bf16x8 b0 = *(const bf16x8*)kp;
      const bf16x8 b1 = *(const bf16x8*)(kp + 32);
      acc[n] = __builtin_amdgcn_mfma_f32_16x16x32_bf16(b0, aq[0], acc[n], 0, 0, 0);
      acc[n] = __builtin_amdgcn_mfma_f32_16x16x32_bf16(b1, aq[1], acc[n], 0, 0, 0);
    }
    float m = -1e30f;
#pragma unroll
    for (int n = 0; n < 16; ++n) {
      const int di = rs + (n >> 1) - ri + 7;
      const float* brow = rpb + (h * 15 + di) * 31 + 15 - c;
#pragma unroll
      for (int j = 0; j < 4; ++j) {
        const int kc = cb + (n & 1) * 16 + fq * 4 + j;
        float sc = -1e30f;
        if (kc >= cs && kc < cs + 16) sc = acc[n][j] * 0.125f + brow[kc];
        acc[n][j] = sc;
        m = fmaxf(m, sc);
      }
    }
    m = red4x_max(m);
    float ssum = 0.f;
#pragma unroll
    for (int n = 0; n < 16; ++n) {
      f32x4 e;
#pragma unroll
      for (int j = 0; j < 4; ++j) { e[j] = __expf(acc[n][j] - m); ssum += e[j]; }
      store4bf(Pw + fr * 264 + n * 16 + fq * 4, e);
    }
    const float sm = 1.f / red4x_sum(ssum);
    f32x4 o[4];
#pragma unroll
    for (int n = 0; n < 4; ++n) o[n] = (f32x4){0.f, 0.f, 0.f, 0.f};
#pragma unroll
    for (int ks = 0; ks < 8; ++ks) {
      const bf16x8 ap = *(const bf16x8*)(Pw + fr * 264 + ks * 32 + fq * 8);
#pragma unroll
      for (int n = 0; n < 4; ++n) {
        const bf16x8 bv = *(const bf16x8*)(NVT + ((size_t)(s * 512 + h * 64 + n * 16 + fr)) * 4096 + (rs + ks) * 64 + cb + fq * 8);
        o[n] = __builtin_amdgcn_mfma_f32_16x16x32_bf16(bv, ap, o[n], 0, 0, 0);
      }
    }
#pragma unroll
    for (int n = 0; n < 4; n += 2)
      store_pair_bf16(NQ + (tokq + fr) * 512 + h * 64, n * 16, fq, pack4bf(o[n] * sm), pack4bf(o[n + 1] * sm));
  }
}

constexpr int SC_OPS = 0;
constexpr int SC_VV = 40960;
constexpr int SC_WR = 49152;
constexpr int SC_AP = 57344;
constexpr int SC_TW = 65536;
constexpr int SC_AD = 70144;
constexpr int SC_NRM = 74752;
constexpr int SC_MU = 74880;
constexpr int SC_CST = 77440;

typedef __attribute__((ext_vector_type(2))) float f32x2;

template <int CTRL>
DEVI float dpp_mov(float x) {
  return __int_as_float(__builtin_amdgcn_update_dpp(0, __float_as_int(x), CTRL, 0xF, 0xF, true));
}
DEVI float red8(float x) {
  x += dpp_mov<0xB1>(x);
  x += dpp_mov<0x4E>(x);
  x += dpp_mov<0x141>(x);
  return x;
}
DEVI f32x2 lo2(f32x4 v) { return __builtin_shufflevector(v, v, 0, 1); }
DEVI f32x2 hi2(f32x4 v) { return __builtin_shufflevector(v, v, 2, 3); }

struct ScanOps {
  f32x2 a[4], w[4], b[4], k[4], r[4];
  float v0, v1;
};
DEVI void scan_load(ScanOps& o, const float* OPS, const float* VV, int nn, int jg, int i0) {
  const float* base = OPS + nn * 64 + jg * 8;
  f32x4 t0, t1;
  t0 = *(const f32x4*)(base); t1 = *(const f32x4*)(base + 4);
  o.a[0] = lo2(t0); o.a[1] = hi2(t0); o.a[2] = lo2(t1); o.a[3] = hi2(t1);
  t0 = *(const f32x4*)(base + 2048); t1 = *(const f32x4*)(base + 2048 + 4);
  o.w[0] = lo2(t0); o.w[1] = hi2(t0); o.w[2] = lo2(t1); o.w[3] = hi2(t1);
  t0 = *(const f32x4*)(base + 4096); t1 = *(const f32x4*)(base + 4096 + 4);
  o.b[0] = lo2(t0); o.b[1] = hi2(t0); o.b[2] = lo2(t1); o.b[3] = hi2(t1);
  t0 = *(const f32x4*)(base + 6144); t1 = *(const f32x4*)(base + 6144 + 4);
  o.k[0] = lo2(t0); o.k[1] = hi2(t0); o.k[2] = lo2(t1); o.k[3] = hi2(t1);
  t0 = *(const f32x4*)(base + 8192); t1 = *(const f32x4*)(base + 8192 + 4);
  o.r[0] = lo2(t0); o.r[1] = hi2(t0); o.r[2] = lo2(t1); o.r[3] = hi2(t1);
  o.v0 = VV[nn * 64 + i0];
  o.v1 = VV[nn * 64 + i0 + 8];
}
DEVI void scan_step(const ScanOps& o, f32x2 (&S0)[4], f32x2 (&S1)[4], float* YL, int nn, int jg, int i0) {
  f32x2 d0 = S0[0] * o.a[0], d0b = S0[2] * o.a[2];
  f32x2 d1 = S1[0] * o.a[0], d1b = S1[2] * o.a[2];
  d0 = S0[1] * o.a[1] + d0; d0b = S0[3] * o.a[3] + d0b;
  d1 = S1[1] * o.a[1] + d1; d1b = S1[3] * o.a[3] + d1b;
  d0 += d0b; d1 += d1b;
  const float sa0 = red8(d0.x + d0.y);
  const float sa1 = red8(d1.x + d1.y);
  f32x2 e0 = {0.f, 0.f}, e1 = {0.f, 0.f};
#pragma unroll
  for (int q = 0; q < 4; ++q) {
    const f32x2 u0 = sa0 * o.b[q] + o.v0 * o.k[q];
    const f32x2 u1 = sa1 * o.b[q] + o.v1 * o.k[q];
    S0[q] = S0[q] * o.w[q] + u0;
    S1[q] = S1[q] * o.w[q] + u1;
    e0 = S0[q] * o.r[q] + e0;
    e1 = S1[q] * o.r[q] + e1;
  }
  const float y0 = red8(e0.x + e0.y);
  const float y1 = red8(e1.x + e1.y);
  YL[nn * 64 + i0] = y0; YL[nn * 64 + i0 + 8] = y1;
}

DEVI void phase_scan(int tid_, const Params& p, int l, char* smem, int bfirst, int bstride) {
  const u16* PR = (const u16*)(p.ws + OFF_PR);
  _Float16* YF = (_Float16*)(p.ws + OFF_H);
  _Float16* YB = (_Float16*)(p.ws + OFF_H + (size_t)NTOK * 512 * 2);
  float* BON = (float*)(p.ws + OFF_BONUS);
  const u16* WB = (const u16*)(p.ws + OFF_WB);
  float* OPS = (float*)(smem + SC_OPS);
  u16* RAW = (u16*)(smem + SC_OPS);
  float* VV = (float*)(smem + SC_VV);
  float* WR = (float*)(smem + SC_WR);
  float* AP = (float*)(smem + SC_AP);
  float* YL = WR;
  u16* TWb = (u16*)(smem + SC_TW);
  u16* ADb = (u16*)(smem + SC_AD);
  float* NRM = (float*)(smem + SC_NRM);
  float* MU = (float*)(smem + SC_MU);
  float* CST = (float*)(smem + SC_CST);
  const float* mu_p = p.in[I_MU_PREV] + (size_t)l * 1920;
  const float* mu_n = p.in[I_MU_NEXT] + (size_t)l * 1920;
  const int tid = tid_, lane = tid & 63, w = tid >> 6, fr = lane & 15, fq = lane >> 4;
  const int pn = tid >> 3, j0 = (tid & 7) * 8;
  const int jg = lane & 7, i0 = w * 16 + (lane >> 3);
  const int hr = (tid >= 40) ? 1 : 0, hc = tid - hr * 40;
  for (int blk = bfirst; blk < 192; blk += bstride) {
    const int s = blk >> 4, h = (blk >> 1) & 7, d = blk & 1;
    __syncthreads();
    for (int i = tid; i < 640; i += 256) {
      const int which = (i >= 320) ? 1 : 0, c = i - which * 320;
      const int g = c >> 6, e = c & 63;
      const int col = (g < 3) ? (g * 512 + h * 64 + e) : (1536 + (g - 3) * 128 + d * 64 + e);
      MU[i] = which ? mu_n[col] : mu_p[col];
    }
    for (int i = tid; i < 320; i += 256) {
      const int which = i >> 6, e = i & 63;
      float v;
      if (which == 0) v = p.in[I_W0][(size_t)(l * 2 + d) * 512 + h * 64 + e];
      else if (which == 1) v = p.in[I_A0][(size_t)(l * 2 + d) * 512 + h * 64 + e];
      else if (which == 2) v = p.in[I_K_K][(size_t)l * 512 + h * 64 + e];
      else if (which == 3) v = p.in[I_K_A][(size_t)l * 512 + h * 64 + e];
      else v = p.in[I_R_K][(size_t)(l * 8 + h) * 64 + e];
      CST[i] = v;
    }
    bf16x8 bw[2], ba[2];
#pragma unroll
    for (int ks = 0; ks < 2; ++ks) {
      bw[ks] = *(const bf16x8*)(WB + W_WUP + (size_t)(d * 512 + h * 64 + w * 16 + fr) * 64 + ks * 32 + fq * 8);
      ba[ks] = *(const bf16x8*)(WB + W_AUP + (size_t)(d * 512 + h * 64 + w * 16 + fr) * 64 + ks * 32 + fq * 8);
    }
    _Float16* Y = d ? YB : YF;
    f32x2 S0[4], S1[4];
#pragma unroll
    for (int q = 0; q < 4; ++q) { S0[q] = (f32x2){0.f, 0.f}; S1[q] = (f32x2){0.f, 0.f}; }
    u32x4 G[5], GH;
    {
      const int t = d ? (4095 - pn) : pn;
      const size_t tok = (size_t)s * 4096 + t;
#pragma unroll
      for (int g = 0; g < 5; ++g) {
        const int col = (g < 3) ? (g * 512 + h * 64) : (1536 + (g - 3) * 128 + d * 64);
        G[g] = *(const u32x4*)(PR + tok * PRW + col + j0);
      }
      GH = (u32x4){0u, 0u, 0u, 0u};
      if (tid < 80) {
        const int tlo = d ? (4095 - 31) : 0;
        const int th = hr ? (tlo + 32) : (tlo - 1);
        const int g = hc >> 3;
        const int col = (g < 3) ? (g * 512 + h * 64) : (1536 + (g - 3) * 128 + d * 64);
        if (th >= 0 && th <= 4095) GH = *(const u32x4*)(PR + ((size_t)s * 4096 + th) * PRW + col + (hc & 7) * 8);
      }
    }
#pragma unroll 1
    for (int ch = 0; ch < 128; ++ch) {
      const int n = ch * 32 + pn;
      const int t = d ? (4095 - n) : n;
      const size_t tok = (size_t)s * 4096 + t;
      const int tlo = d ? (4095 - (ch * 32 + 31)) : (ch * 32);
      const int rrow = t - tlo + 1;
#pragma unroll
      for (int g = 0; g < 5; ++g) *(u32x4*)(RAW + rrow * 320 + g * 64 + j0) = G[g];
      if (tid < 80) *(u32x4*)(RAW + (hr ? 33 : 0) * 320 + (hc >> 3) * 64 + (hc & 7) * 8) = GH;
      __syncthreads();
      if (ch + 1 < 128) {
        const int n2 = n + 32;
        const int t2 = d ? (4095 - n2) : n2;
        const size_t tok2 = (size_t)s * 4096 + t2;
#pragma unroll
        for (int g = 0; g < 5; ++g) {
          const int col = (g < 3) ? (g * 512 + h * 64) : (1536 + (g - 3) * 128 + d * 64);
          G[g] = *(const u32x4*)(PR + tok2 * PRW + col + j0);
        }
        GH = (u32x4){0u, 0u, 0u, 0u};
        if (tid < 80) {
          const int tlo2 = d ? (tlo - 32) : (tlo + 32);
          const int th = hr ? (tlo2 + 32) : (tlo2 - 1);
          const int g = hc >> 3;
          const int col = (g < 3) ? (g * 512 + h * 64) : (1536 + (g - 3) * 128 + d * 64);
          if (th >= 0 && th <= 4095) GH = *(const u32x4*)(PR + ((size_t)s * 4096 + th) * PRW + col + (hc & 7) * 8);
        }
      }
#pragma unroll
      for (int g = 0; g < 5; ++g) {
        float cur[8], prv[8], nxt[8];
        load8bf(RAW + rrow * 320 + g * 64 + j0, cur);
        load8bf(RAW + (rrow - 1) * 320 + g * 64 + j0, prv);
        load8bf(RAW + (rrow + 1) * 320 + g * 64 + j0, nxt);
        const f32x4 mp0 = *(const f32x4*)(MU + g * 64 + j0), mp1 = *(const f32x4*)(MU + g * 64 + j0 + 4);
        const f32x4 mn0 = *(const f32x4*)(MU + 320 + g * 64 + j0), mn1 = *(const f32x4*)(MU + 320 + g * 64 + j0 + 4);
        f32x4 x0, x1;
#pragma unroll
        for (int e = 0; e < 4; ++e) {
          x0[e] = cur[e] + mp0[e] * (prv[e] - cur[e]) + mn0[e] * (nxt[e] - cur[e]);
          x1[e] = cur[4 + e] + mp1[e] * (prv[4 + e] - cur[4 + e]) + mn1[e] * (nxt[4 + e] - cur[4 + e]);
        }
        if (g == 0) {
          *(f32x4*)(OPS + 4 * 2048 + pn * 64 + j0) = x0; *(f32x4*)(OPS + 4 * 2048 + pn * 64 + j0 + 4) = x1;
        } else if (g == 1) {
          *(f32x4*)(OPS + 3 * 2048 + pn * 64 + j0) = x0; *(f32x4*)(OPS + 3 * 2048 + pn * 64 + j0 + 4) = x1;
          const f32x4 kk0 = *(const f32x4*)(CST + 128 + j0), kk1 = *(const f32x4*)(CST + 128 + j0 + 4);
          float ss = 0.f;
#pragma unroll
          for (int e = 0; e < 4; ++e) { const float a_ = x0[e] * kk0[e], b_ = x1[e] * kk1[e]; ss += a_ * a_ + b_ * b_; }
          ss = red8(ss);
          if ((tid & 7) == 0) NRM[pn] = frcp(fmaxf(__builtin_amdgcn_sqrtf(ss), 1e-12f));
        } else if (g == 2) {
          *(f32x4*)(VV + pn * 64 + j0) = x0; *(f32x4*)(VV + pn * 64 + j0 + 4) = x1;
        } else if (g == 3) {
          u32x4 pk;
          pk.x = pack2(ftanh(x0[0]), ftanh(x0[1])); pk.y = pack2(ftanh(x0[2]), ftanh(x0[3]));
          pk.z = pack2(ftanh(x1[0]), ftanh(x1[1])); pk.w = pack2(ftanh(x1[2]), ftanh(x1[3]));
          *(u32x4*)(TWb + pn * 72 + j0) = pk;
        } else {
          u32x4 pk;
          pk.x = pack2(x0[0], x0[1]); pk.y = pack2(x0[2], x0[3]);
          pk.z = pack2(x1[0], x1[1]); pk.w = pack2(x1[2], x1[3]);
          *(u32x4*)(ADb + pn * 72 + j0) = pk;
        }
      }
      __syncthreads();
#pragma unroll
      for (int m = 0; m < 2; ++m) {
        f32x4 cw = {0.f, 0.f, 0.f, 0.f}, ca = {0.f, 0.f, 0.f, 0.f};
#pragma unroll
        for (int ks = 0; ks < 2; ++ks) {
          const bf16x8 aw = *(const bf16x8*)(TWb + (m * 16 + fr) * 72 + ks * 32 + fq * 8);
          const bf16x8 aa = *(const bf16x8*)(ADb + (m * 16 + fr) * 72 + ks * 32 + fq * 8);
          cw = __builtin_amdgcn_mfma_f32_16x16x32_bf16(aw, bw[ks], cw, 0, 0, 0);
          ca = __builtin_amdgcn_mfma_f32_16x16x32_bf16(aa, ba[ks], ca, 0, 0, 0);
        }
#pragma unroll
        for (int jj = 0; jj < 4; ++jj) {
          WR[(m * 16 + fq * 4 + jj) * 64 + w * 16 + fr] = cw[jj];
          AP[(m * 16 + fq * 4 + jj) * 64 + w * 16 + fr] = ca[jj];
        }
      }
      __syncthreads();
      {
        const float inv = NRM[pn];
        float bsum = 0.f;
#pragma unroll
        for (int hq = 0; hq < 2; ++hq) {
          const int jb = j0 + hq * 4;
          const f32x4 wr_ = *(const f32x4*)(WR + pn * 64 + jb) + *(const f32x4*)(CST + jb);
          const f32x4 ap_ = *(const f32x4*)(AP + pn * 64 + jb) + *(const f32x4*)(CST + 64 + jb);
          const f32x4 kr = *(const f32x4*)(OPS + 3 * 2048 + pn * 64 + jb);
          const f32x4 rr = *(const f32x4*)(OPS + 4 * 2048 + pn * 64 + jb);
          const f32x4 kkw = *(const f32x4*)(CST + 128 + jb), kaw = *(const f32x4*)(CST + 192 + jb), rkw = *(const f32x4*)(CST + 256 + jb);
          f32x4 o0, o1, o2, o3;
#pragma unroll
          for (int e = 0; e < 4; ++e) {
            const float sw = sigm(wr_[e]);
            const float dec = __expf(-0.6065306597126334f * sw);
            const float av = sigm(ap_[e]);
            const float kn = kr[e] * kkw[e] * inv;
            const float kd = kr[e] * (1.f + (av - 1.f) * kaw[e]);
            bsum += rr[e] * kd * rkw[e];
            o0[e] = -kn; o1[e] = dec; o2[e] = kn * av; o3[e] = kd;
          }
          *(f32x4*)(OPS + 0 * 2048 + pn * 64 + jb) = o0;
          *(f32x4*)(OPS + 1 * 2048 + pn * 64 + jb) = o1;
          *(f32x4*)(OPS + 2 * 2048 + pn * 64 + jb) = o2;
          *(f32x4*)(OPS + 3 * 2048 + pn * 64 + jb) = o3;
        }
        bsum = red8(bsum);
        if ((tid & 7) == 0) BON[(tok * 8 + h) * 2 + d] = bsum;
      }
      __syncthreads();
      {
        ScanOps oa, ob;
        scan_load(oa, OPS, VV, 0, jg, i0);
#pragma unroll 1
        for (int nn = 0; nn < 32; nn += 2) {
          scan_load(ob, OPS, VV, nn + 1, jg, i0);
          scan_step(oa, S0, S1, YL, nn, jg, i0);
          scan_load(oa, OPS, VV, (nn + 2) & 31, jg, i0);
          scan_step(ob, S0, S1, YL, nn + 1, jg, i0);
        }
      }
      __syncthreads();
      {
        h16x8 o;
#pragma unroll
        for (int e = 0; e < 8; ++e) o[e] = (_Float16)YL[pn * 64 + j0 + e];
        *(h16x8*)(Y + tok * 512 + h * 64 + j0) = o;
      }
    }
    __syncthreads();
  }
}

struct ScanOps1 {
  f32x2 a[4], w[4], b[4], k[4], r[4];
  float v0;
};
DEVI void scan_load1(ScanOps1& o, const float* OPS, const float* VV, int nn, int jg, int i0) {
  const float* base = OPS + nn * 64 + jg * 8;
  f32x4 t0, t1;
  t0 = *(const f32x4*)(base); t1 = *(const f32x4*)(base + 4);
  o.a[0] = lo2(t0); o.a[1] = hi2(t0); o.a[2] = lo2(t1); o.a[3] = hi2(t1);
  t0 = *(const f32x4*)(base + 2048); t1 = *(const f32x4*)(base + 2048 + 4);
  o.w[0] = lo2(t0); o.w[1] = hi2(t0); o.w[2] = lo2(t1); o.w[3] = hi2(t1);
  t0 = *(const f32x4*)(base + 4096); t1 = *(const f32x4*)(base + 4096 + 4);
  o.b[0] = lo2(t0); o.b[1] = hi2(t0); o.b[2] = lo2(t1); o.b[3] = hi2(t1);
  t0 = *(const f32x4*)(base + 6144); t1 = *(const f32x4*)(base + 6144 + 4);
  o.k[0] = lo2(t0); o.k[1] = hi2(t0); o.k[2] = lo2(t1); o.k[3] = hi2(t1);
  t0 = *(const f32x4*)(base + 8192); t1 = *(const f32x4*)(base + 8192 + 4);
  o.r[0] = lo2(t0); o.r[1] = hi2(t0); o.r[2] = lo2(t1); o.r[3] = hi2(t1);
  o.v0 = VV[nn * 64 + i0];
}
DEVI void scan_step1(const ScanOps1& o, f32x2 (&S0)[4], float* YL, int nn, int jg, int i0) {
  f32x2 d0 = S0[0] * o.a[0], d0b = S0[2] * o.a[2];
  d0 = S0[1] * o.a[1] + d0; d0b = S0[3] * o.a[3] + d0b;
  d0 += d0b;
  const float sa0 = red8(d0.x + d0.y);
  f32x2 e0 = {0.f, 0.f};
#pragma unroll
  for (int q = 0; q < 4; ++q) {
    const f32x2 u0 = sa0 * o.b[q] + o.v0 * o.k[q];
    S0[q] = S0[q] * o.w[q] + u0;
    e0 = S0[q] * o.r[q] + e0;
  }
  const float y0 = red8(e0.x + e0.y);
  if (jg == 0) YL[nn * 64 + i0] = y0;
}
DEVI float red16d(float x) {
  x += dpp_mov<0xB1>(x);
  x += dpp_mov<0x4E>(x);
  x += dpp_mov<0x141>(x);
  x += dpp_mov<0x140>(x);
  return x;
}
DEVI void unpack4(u32x2 u, float* o) {
  o[0] = __uint_as_float(u.x << 16); o[1] = __uint_as_float(u.x & 0xffff0000u);
  o[2] = __uint_as_float(u.y << 16); o[3] = __uint_as_float(u.y & 0xffff0000u);
}

DEVI void phase_scan8(int tid_, const Params& p, int l, char* smem, int bfirst, int bstride) {
  const u16* PR = (const u16*)(p.ws + OFF_PR);
  _Float16* YF = (_Float16*)(p.ws + OFF_H);
  _Float16* YB = (_Float16*)(p.ws + OFF_H + (size_t)NTOK * 512 * 2);
  float* BON = (float*)(p.ws + OFF_BONUS);
  const u16* WB = (const u16*)(p.ws + OFF_WB);
  float* OPS = (float*)(smem + SC_OPS);
  u16* RAW = (u16*)(smem + SC_OPS);
  float* VV = (float*)(smem + SC_VV);
  float* WR = (float*)(smem + SC_WR);
  float* AP = (float*)(smem + SC_AP);
  float* YL = WR;
  u16* TWb = (u16*)(smem + SC_TW);
  u16* ADb = (u16*)(smem + SC_AD);
  float* NRM = (float*)(smem + SC_NRM);
  float* MU = (float*)(smem + SC_MU);
  float* CST = (float*)(smem + SC_CST);
  const float* mu_p = p.in[I_MU_PREV] + (size_t)l * 1920;
  const float* mu_n = p.in[I_MU_NEXT] + (size_t)l * 1920;
  const int tid = tid_, lane = tid & 63, w = tid >> 6, fr = lane & 15, fq = lane >> 4;
  const int pn = tid >> 4, j0 = (tid & 15) * 4;
  const int jg = lane & 7, i0 = w * 8 + (lane >> 3);
  const int hr = (tid >= 80) ? 1 : 0, hc = tid - hr * 80;
  const int wm = w >> 2, wn = w & 3;
  for (int blk = bfirst; blk < 192; blk += bstride) {
    const int s = blk >> 4, h = (blk >> 1) & 7, d = blk & 1;
    __syncthreads();
    for (int i = tid; i < 640; i += 512) {
      const int which = (i >= 320) ? 1 : 0, c = i - which * 320;
      const int g = c >> 6, e = c & 63;
      const int col = (g < 3) ? (g * 512 + h * 64 + e) : (1536 + (g - 3) * 128 + d * 64 + e);
      MU[i] = which ? mu_n[col] : mu_p[col];
    }
    if (tid < 320) {
      const int which = tid >> 6, e = tid & 63;
      float v;
      if (which == 0) v = p.in[I_W0][(size_t)(l * 2 + d) * 512 + h * 64 + e];
      else if (which == 1) v = p.in[I_A0][(size_t)(l * 2 + d) * 512 + h * 64 + e];
      else if (which == 2) v = p.in[I_K_K][(size_t)l * 512 + h * 64 + e];
      else if (which == 3) v = p.in[I_K_A][(size_t)l * 512 + h * 64 + e];
      else v = p.in[I_R_K][(size_t)(l * 8 + h) * 64 + e];
      CST[tid] = v;
    }
    bf16x8 bw[2], ba[2];
#pragma unroll
    for (int ks = 0; ks < 2; ++ks) {
      bw[ks] = *(const bf16x8*)(WB + W_WUP + (size_t)(d * 512 + h * 64 + wn * 16 + fr) * 64 + ks * 32 + fq * 8);
      ba[ks] = *(const bf16x8*)(WB + W_AUP + (size_t)(d * 512 + h * 64 + wn * 16 + fr) * 64 + ks * 32 + fq * 8);
    }
    _Float16* Y = d ? YB : YF;
    f32x2 S0[4];
#pragma unroll
    for (int q = 0; q < 4; ++q) S0[q] = (f32x2){0.f, 0.f};
    u32x2 G[5], GH;
    {
      const int t = d ? (4095 - pn) : pn;
      const size_t tok = (size_t)s * 4096 + t;
#pragma unroll
      for (int g = 0; g < 5; ++g) {
        const int col = (g < 3) ? (g * 512 + h * 64) : (1536 + (g - 3) * 128 + d * 64);
        G[g] = *(const u32x2*)(PR + tok * PRW + col + j0);
      }
      GH = (u32x2){0u, 0u};
      if (tid < 160) {
        const int tlo = d ? (4095 - 31) : 0;
        const int th = hr ? (tlo + 32) : (tlo - 1);
        const int g = hc >> 4;
        const int col = (g < 3) ? (g * 512 + h * 64) : (1536 + (g - 3) * 128 + d * 64);
        if (th >= 0 && th <= 4095) GH = *(const u32x2*)(PR + ((size_t)s * 4096 + th) * PRW + col + (hc & 15) * 4);
      }
    }
#pragma unroll 1
    for (int ch = 0; ch < 128; ++ch) {
      const int n = ch * 32 + pn;
      const int t = d ? (4095 - n) : n;
      const size_t tok = (size_t)s * 4096 + t;
      const int tlo = d ? (4095 - (ch * 32 + 31)) : (ch * 32);
      const int rrow = t - tlo + 1;
#pragma unroll
      for (int g = 0; g < 5; ++g) *(u32x2*)(RAW + rrow * 320 + g * 64 + j0) = G[g];
      if (tid < 160) *(u32x2*)(RAW + (hr ? 33 : 0) * 320 + (hc >> 4) * 64 + (hc & 15) * 4) = GH;
      __syncthreads();
      if (ch + 1 < 128) {
        const int n2 = n + 32;
        const int t2 = d ? (4095 - n2) : n2;
        const size_t tok2 = (size_t)s * 4096 + t2;
#pragma unroll
        for (int g = 0; g < 5; ++g) {
          const int col = (g < 3) ? (g * 512 + h * 64) : (1536 + (g - 3) * 128 + d * 64);
          G[g] = *(const u32x2*)(PR + tok2 * PRW + col + j0);
        }
        GH = (u32x2){0u, 0u};
        if (tid < 160) {
          const int tlo2 = d ? (tlo - 32) : (tlo + 32);
          const int th = hr ? (tlo2 + 32) : (tlo2 - 1);
          const int g = hc >> 4;
          const int col = (g < 3) ? (g * 512 + h * 64) : (1536 + (g - 3) * 128 + d * 64);
          if (th >= 0 && th <= 4095) GH = *(const u32x2*)(PR + ((size_t)s * 4096 + th) * PRW + col + (hc & 15) * 4);
        }
      }
#pragma unroll
      for (int g = 0; g < 5; ++g) {
        float cur[4], prv[4], nxt[4];
        unpack4(*(const u32x2*)(RAW + rrow * 320 + g * 64 + j0), cur);
        unpack4(*(const u32x2*)(RAW + (rrow - 1) * 320 + g * 64 + j0), prv);
        unpack4(*(const u32x2*)(RAW + (rrow + 1) * 320 + g * 64 + j0), nxt);
        const f32x4 mp0 = *(const f32x4*)(MU + g * 64 + j0);
        const f32x4 mn0 = *(const f32x4*)(MU + 320 + g * 64 + j0);
        f32x4 x0;
#pragma unroll
        for (int e = 0; e < 4; ++e) x0[e] = cur[e] + mp0[e] * (prv[e] - cur[e]) + mn0[e] * (nxt[e] - cur[e]);
        if (g == 0) {
          *(f32x4*)(OPS + 4 * 2048 + pn * 64 + j0) = x0;
        } else if (g == 1) {
          *(f32x4*)(OPS + 3 * 2048 + pn * 64 + j0) = x0;
          const f32x4 kk0 = *(const f32x4*)(CST + 128 + j0);
          float ss = 0.f;
#pragma unroll
          for (int e = 0; e < 4; ++e) { const float a_ = x0[e] * kk0[e]; ss += a_ * a_; }
          ss = red16d(ss);
          if ((tid & 15) == 0) NRM[pn] = frcp(fmaxf(__builtin_amdgcn_sqrtf(ss), 1e-12f));
        } else if (g == 2) {
          *(f32x4*)(VV + pn * 64 + j0) = x0;
        } else if (g == 3) {
          u32x2 pk;
          pk.x = pack2(ftanh(x0[0]), ftanh(x0[1])); pk.y = pack2(ftanh(x0[2]), ftanh(x0[3]));
          *(u32x2*)(TWb + pn * 72 + j0) = pk;
        } else {
          u32x2 pk;
          pk.x = pack2(x0[0], x0[1]); pk.y = pack2(x0[2], x0[3]);
          *(u32x2*)(ADb + pn * 72 + j0) = pk;
        }
      }
      __syncthreads();
      {
        f32x4 cw = {0.f, 0.f, 0.f, 0.f}, ca = {0.f, 0.f, 0.f, 0.f};
#pragma unroll
        for (int ks = 0; ks < 2; ++ks) {
          const bf16x8 aw = *(const bf16x8*)(TWb + (wm * 16 + fr) * 72 + ks * 32 + fq * 8);
          const bf16x8 aa = *(const bf16x8*)(ADb + (wm * 16 + fr) * 72 + ks * 32 + fq * 8);
          cw = __builtin_amdgcn_mfma_f32_16x16x32_bf16(aw, bw[ks], cw, 0, 0, 0);
          ca = __builtin_amdgcn_mfma_f32_16x16x32_bf16(aa, ba[ks], ca, 0, 0, 0);
        }
#pragma unroll
        for (int jj = 0; jj < 4; ++jj) {
          WR[(wm * 16 + fq * 4 + jj) * 64 + wn * 16 + fr] = cw[jj];
          AP[(wm * 16 + fq * 4 + jj) * 64 + wn * 16 + fr] = ca[jj];
        }
      }
      __syncthreads();
      {
        const float inv = NRM[pn];
        float bsum = 0.f;
        const f32x4 wr_ = *(const f32x4*)(WR + pn * 64 + j0) + *(const f32x4*)(CST + j0);
        const f32x4 ap_ = *(const f32x4*)(AP + pn * 64 + j0) + *(const f32x4*)(CST + 64 + j0);
        const f32x4 kr = *(const f32x4*)(OPS + 3 * 2048 + pn * 64 + j0);
        const f32x4 rr = *(const f32x4*)(OPS + 4 * 2048 + pn * 64 + j0);
        const f32x4 kkw = *(const f32x4*)(CST + 128 + j0), kaw = *(const f32x4*)(CST + 192 + j0), rkw = *(const f32x4*)(CST + 256 + j0);
        f32x4 o0, o1, o2, o3;
#pragma unroll
        for (int e = 0; e < 4; ++e) {
          const float sw = sigm(wr_[e]);
          const float dec = __expf(-0.6065306597126334f * sw);
          const float av = sigm(ap_[e]);
          const float kn = kr[e] * kkw[e] * inv;
          const float kd = kr[e] * (1.f + (av - 1.f) * kaw[e]);
          bsum += rr[e] * kd * rkw[e];
          o0[e] = -kn; o1[e] = dec; o2[e] = kn * av; o3[e] = kd;
        }
        *(f32x4*)(OPS + 0 * 2048 + pn * 64 + j0) = o0;
        *(f32x4*)(OPS + 1 * 2048 + pn * 64 + j0) = o1;
        *(f32x4*)(OPS + 2 * 2048 + pn * 64 + j0) = o2;
        *(f32x4*)(OPS + 3 * 2048 + pn * 64 + j0) = o3;
        bsum = red16d(bsum);
        if ((tid & 15) == 0) BON[(tok * 8 + h) * 2 + d] = bsum;
      }
      __syncthreads();
      {
        ScanOps1 oa, ob;
        scan_load1(oa, OPS, VV, 0, jg, i0);
#pragma unroll 1
        for (int nn = 0; nn < 32; nn += 2) {
          scan_load1(ob, OPS, VV, nn + 1, jg, i0);
          scan_step1(oa, S0, YL, nn, jg, i0);
          scan_load1(oa, OPS, VV, (nn + 2) & 31, jg, i0);
          scan_step1(ob, S0, YL, nn + 1, jg, i0);
        }
      }
      __syncthreads();
      {
        typedef __attribute__((ext_vector_type(4))) _Float16 h16x4;
        h16x4 o;
#pragma unroll
        for (int e = 0; e < 4; ++e) o[e] = (_Float16)YL[pn * 64 + j0 + e];
        *(h16x4*)(Y + tok * 512 + h * 64 + j0) = o;
      }
    }
    __syncthreads();
  }
}

constexpr int PC_OPS = 0;
constexpr int PC_BUF = 49152;
constexpr int PC_RAW = 98304;
constexpr int PC_WR = 98304;
constexpr int PC_AP = 106496;
constexpr int PC_TW = 120064;
constexpr int PC_AD = 124672;
constexpr int PC_NRM = 129280;
constexpr int PC_MU = 129408;
constexpr int PC_CST = 131968;
constexpr int PC_YL = 133248;

DEVI void phase_scan_pc(int tid_, const Params& p, int l, char* smem, int bfirst, int bstride) {
  const u16* PR = (const u16*)(p.ws + OFF_PR);
  _Float16* YF = (_Float16*)(p.ws + OFF_H);
  _Float16* YB = (_Float16*)(p.ws + OFF_H + (size_t)NTOK * 512 * 2);
  float* BON = (float*)(p.ws + OFF_BONUS);
  const u16* WB = (const u16*)(p.ws + OFF_WB);
  u16* RAW = (u16*)(smem + PC_RAW);
  float* WR = (float*)(smem + PC_WR);
  float* AP = (float*)(smem + PC_AP);
  u16* TWb = (u16*)(smem + PC_TW);
  u16* ADb = (u16*)(smem + PC_AD);
  float* NRM = (float*)(smem + PC_NRM);
  float* MU = (float*)(smem + PC_MU);
  float* CST = (float*)(smem + PC_CST);
  const float* mu_p = p.in[I_MU_PREV] + (size_t)l * 1920;
  const float* mu_n = p.in[I_MU_NEXT] + (size_t)l * 1920;
  const bool is_prep = tid_ >= 256;
  const int tid = tid_ & 255, lane = tid & 63, w = tid >> 6, fr = lane & 15, fq = lane >> 4;
  const int pn = tid >> 3, j0 = (tid & 7) * 8;
  const int jg = lane & 7, i0 = w * 16 + (lane >> 3);
  const int hr = (tid >= 40) ? 1 : 0, hc = tid - hr * 40;
  for (int blk = bfirst; blk < 192; blk += bstride) {
    const int s = blk >> 4, h = (blk >> 1) & 7, d = blk & 1;
    __syncthreads();
    for (int i = tid_; i < 640; i += 512) {
      const int which = (i >= 320) ? 1 : 0, c = i - which * 320;
      const int g = c >> 6, e = c & 63;
      const int col = (g < 3) ? (g * 512 + h * 64 + e) : (1536 + (g - 3) * 128 + d * 64 + e);
      MU[i] = which ? mu_n[col] : mu_p[col];
    }
    if (tid_ < 320) {
      const int which = tid_ >> 6, e = tid_ & 63;
      float v;
      if (which == 0) v = p.in[I_W0][(size_t)(l * 2 + d) * 512 + h * 64 + e];
      else if (which == 1) v = p.in[I_A0][(size_t)(l * 2 + d) * 512 + h * 64 + e];
      else if (which == 2) v = p.in[I_K_K][(size_t)l * 512 + h * 64 + e];
      else if (which == 3) v = p.in[I_K_A][(size_t)l * 512 + h * 64 + e];
      else v = p.in[I_R_K][(size_t)(l * 8 + h) * 64 + e];
      CST[tid_] = v;
    }
    _Float16* Y = d ? YB : YF;
    if (is_prep) {
      bf16x8 bw[2], ba[2];
#pragma unroll
      for (int ks = 0; ks < 2; ++ks) {
        bw[ks] = *(const bf16x8*)(WB + W_WUP + (size_t)(d * 512 + h * 64 + w * 16 + fr) * 64 + ks * 32 + fq * 8);
        ba[ks] = *(const bf16x8*)(WB + W_AUP + (size_t)(d * 512 + h * 64 + w * 16 + fr) * 64 + ks * 32 + fq * 8);
      }
      u32x4 G[5], GH;
      {
        const int t = d ? (4095 - pn) : pn;
        const size_t tok = (size_t)s * 4096 + t;
#pragma unroll
        for (int g = 0; g < 5; ++g) {
          const int col = (g < 3) ? (g * 512 + h * 64) : (1536 + (g - 3) * 128 + d * 64);
          G[g] = *(const u32x4*)(PR + tok * PRW + col + j0);
        }
        GH = (u32x4){0u, 0u, 0u, 0u};
        if (tid < 80) {
          const int tlo = d ? (4095 - 31) : 0;
          const int th = hr ? (tlo + 32) : (tlo - 1);
          const int g = hc >> 3;
          const int col = (g < 3) ? (g * 512 + h * 64) : (1536 + (g - 3) * 128 + d * 64);
          if (th >= 0 && th <= 4095) GH = *(const u32x4*)(PR + ((size_t)s * 4096 + th) * PRW + col + (hc & 7) * 8);
        }
      }
#pragma unroll 1
      for (int ch = -1; ch < 128; ++ch) {
        const int c = ch + 1;
        const bool doprep = c < 128;
        float* OPS = (float*)(smem + PC_OPS + (c & 1) * PC_BUF);
        float* VV = OPS + 5 * 2048;
        const int n = c * 32 + pn;
        const int t = d ? (4095 - n) : n;
        const size_t tok = (size_t)s * 4096 + t;
        const int tlo = d ? (4095 - (c * 32 + 31)) : (c * 32);
        const int rrow = t - tlo + 1;
        __syncthreads();
        if (ch >= 1) {
          const float* YL = (const float*)(smem + PC_YL + ((ch - 1) & 1) * 8192);
          const int n1 = (ch - 1) * 32 + pn;
          const int t1 = d ? (4095 - n1) : n1;
          h16x8 o;
#pragma unroll
          for (int e = 0; e < 8; ++e) o[e] = (_Float16)YL[pn * 64 + j0 + e];
          *(h16x8*)(Y + ((size_t)s * 4096 + t1) * 512 + h * 64 + j0) = o;
        }
        if (doprep) {
#pragma unroll
          for (int g = 0; g < 5; ++g) *(u32x4*)(RAW + rrow * 320 + g * 64 + j0) = G[g];
          if (tid < 80) *(u32x4*)(RAW + (hr ? 33 : 0) * 320 + (hc >> 3) * 64 + (hc & 7) * 8) = GH;
        }
        __syncthreads();
        if (doprep) {
          if (c + 1 < 128) {
            const int n2 = n + 32;
            const int t2 = d ? (4095 - n2) : n2;
            const size_t tok2 = (size_t)s * 4096 + t2;
#pragma unroll
            for (int g = 0; g < 5; ++g) {
              const int col = (g < 3) ? (g * 512 + h * 64) : (1536 + (g - 3) * 128 + d * 64);
              G[g] = *(const u32x4*)(PR + tok2 * PRW + col + j0);
            }
            GH = (u32x4){0u, 0u, 0u, 0u};
            if (tid < 80) {
              const int tlo2 = d ? (tlo - 32) : (tlo + 32);
              const int th = hr ? (tlo2 + 32) : (tlo2 - 1);
              const int g = hc >> 3;
              const int col = (g < 3) ? (g * 512 + h * 64) : (1536 + (g - 3) * 128 + d * 64);
              if (th >= 0 && th <= 4095) GH = *(const u32x4*)(PR + ((size_t)s * 4096 + th) * PRW + col + (hc & 7) * 8);
            }
          }
#pragma unroll
          for (int g = 0; g < 5; ++g) {
            float cur[8], prv[8], nxt[8];
            load8bf(RAW + rrow * 320 + g * 64 + j0, cur);
            load8bf(RAW + (rrow - 1) * 320 + g * 64 + j0, prv);
            load8bf(RAW + (rrow + 1) * 320 + g * 64 + j0, nxt);
            const f32x4 mp0 = *(const f32x4*)(MU + g * 64 + j0), mp1 = *(const f32x4*)(MU + g * 64 + j0 + 4);
            const f32x4 mn0 = *(const f32x4*)(MU + 320 + g * 64 + j0), mn1 = *(const f32x4*)(MU + 320 + g * 64 + j0 + 4);
            f32x4 x0, x1;
#pragma unroll
            for (int e = 0; e < 4; ++e) {
              x0[e] = cur[e] + mp0[e] * (prv[e] - cur[e]) + mn0[e] * (nxt[e] - cur[e]);
              x1[e] = cur[4 + e] + mp1[e] * (prv[4 + e] - cur[4 + e]) + mn1[e] * (nxt[4 + e] - cur[4 + e]);
            }
            if (g == 0) {
              *(f32x4*)(OPS + 4 * 2048 + pn * 64 + j0) = x0; *(f32x4*)(OPS + 4 * 2048 + pn * 64 + j0 + 4) = x1;
            } else if (g == 1) {
              *(f32x4*)(OPS + 3 * 2048 + pn * 64 + j0) = x0; *(f32x4*)(OPS + 3 * 2048 + pn * 64 + j0 + 4) = x1;
              const f32x4 kk0 = *(const f32x4*)(CST + 128 + j0), kk1 = *(const f32x4*)(CST + 128 + j0 + 4);
              float ss = 0.f;
#pragma unroll
              for (int e = 0; e < 4; ++e) { const float a_ = x0[e] * kk0[e], b_ = x1[e] * kk1[e]; ss += a_ * a_ + b_ * b_; }
              ss = red8(ss);
              if ((tid & 7) == 0) NRM[pn] = frcp(fmaxf(__builtin_amdgcn_sqrtf(ss), 1e-12f));
            } else if (g == 2) {
              *(f32x4*)(VV + pn * 64 + j0) = x0; *(f32x4*)(VV + pn * 64 + j0 + 4) = x1;
            } else if (g == 3) {
              u32x4 pk;
              pk.x = pack2(ftanh(x0[0]), ftanh(x0[1])); pk.y = pack2(ftanh(x0[2]), ftanh(x0[3]));
              pk.z = pack2(ftanh(x1[0]), ftanh(x1[1])); pk.w = pack2(ftanh(x1[2]), ftanh(x1[3]));
              *(u32x4*)(TWb + pn * 72 + j0) = pk;
            } else {
              u32x4 pk;
              pk.x = pack2(x0[0], x0[1]); pk.y = pack2(x0[2], x0[3]);
              pk.z = pack2(x1[0], x1[1]); pk.w = pack2(x1[2], x1[3]);
              *(u32x4*)(ADb + pn * 72 + j0) = pk;
            }
          }
        }
        __syncthreads();
        if (doprep) {
#pragma unroll
          for (int m = 0; m < 2; ++m) {
            f32x4 cw = {0.f, 0.f, 0.f, 0.f}, ca = {0.f, 0.f, 0.f, 0.f};
#pragma unroll
            for (int ks = 0; ks < 2; ++ks) {
              const bf16x8 aw = *(const bf16x8*)(TWb + (m * 16 + fr) * 72 + ks * 32 + fq * 8);
              const bf16x8 aa = *(const bf16x8*)(ADb + (m * 16 + fr) * 72 + ks * 32 + fq * 8);
              cw = __builtin_amdgcn_mfma_f32_16x16x32_bf16(aw, bw[ks], cw, 0, 0, 0);
              ca = __builtin_amdgcn_mfma_f32_16x16x32_bf16(aa, ba[ks], ca, 0, 0, 0);
            }
#pragma unroll
            for (int jj = 0; jj < 4; ++jj) {
              WR[(m * 16 + fq * 4 + jj) * 64 + w * 16 + fr] = cw[jj];
              AP[(m * 16 + fq * 4 + jj) * 64 + w * 16 + fr] = ca[jj];
            }
          }
        }
        __syncthreads();
        if (doprep) {
          const float inv = NRM[pn];
          float bsum = 0.f;
#pragma unroll
          for (int hq = 0; hq < 2; ++hq) {
            const int jb = j0 + hq * 4;
            const f32x4 wr_ = *(const f32x4*)(WR + pn * 64 + jb) + *(const f32x4*)(CST + jb);
            const f32x4 ap_ = *(const f32x4*)(AP + pn * 64 + jb) + *(const f32x4*)(CST + 64 + jb);
            const f32x4 kr = *(const f32x4*)(OPS + 3 * 2048 + pn * 64 + jb);
            const f32x4 rr = *(const f32x4*)(OPS + 4 * 2048 + pn * 64 + jb);
            const f32x4 kkw = *(const f32x4*)(CST + 128 + jb), kaw = *(const f32x4*)(CST + 192 + jb), rkw = *(const f32x4*)(CST + 256 + jb);
            f32x4 o0, o1, o2, o3;
#pragma unroll
            for (int e = 0; e < 4; ++e) {
              const float sw = sigm(wr_[e]);
              const float dec = __expf(-0.6065306597126334f * sw);
              const float av = sigm(ap_[e]);
              const float kn = kr[e] * kkw[e] * inv;
              const float kd = kr[e] * (1.f + (av - 1.f) * kaw[e]);
              bsum += rr[e] * kd * rkw[e];
              o0[e] = -kn; o1[e] = dec; o2[e] = kn * av; o3[e] = kd;
            }
            *(f32x4*)(OPS + 0 * 2048 + pn * 64 + jb) = o0;
            *(f32x4*)(OPS + 1 * 2048 + pn * 64 + jb) = o1;
            *(f32x4*)(OPS + 2 * 2048 + pn * 64 + jb) = o2;
            *(f32x4*)(OPS + 3 * 2048 + pn * 64 + jb) = o3;
          }
          bsum = red8(bsum);
          if ((tid & 7) == 0) BON[(tok * 8 + h) * 2 + d] = bsum;
        }
      }
      __syncthreads();
      {
        const float* YL = (const float*)(smem + PC_YL + (127 & 1) * 8192);
        const int n1 = 127 * 32 + pn;
        const int t1 = d ? (4095 - n1) : n1;
        h16x8 o;
#pragma unroll
        for (int e = 0; e < 8; ++e) o[e] = (_Float16)YL[pn * 64 + j0 + e];
        *(h16x8*)(Y + ((size_t)s * 4096 + t1) * 512 + h * 64 + j0) = o;
      }
    } else {
      f32x2 S0[4], S1[4];
#pragma unroll
      for (int q = 0; q < 4; ++q) { S0[q] = (f32x2){0.f, 0.f}; S1[q] = (f32x2){0.f, 0.f}; }
#pragma unroll 1
      for (int ch = -1; ch < 128; ++ch) {
        const float* OPS = (const float*)(smem + PC_OPS + (ch & 1) * PC_BUF);
        const float* VV = OPS + 5 * 2048;
        float* YL = (float*)(smem + PC_YL + (ch & 1) * 8192);
        __syncthreads();
        if (ch < 0) {
          __syncthreads(); __syncthreads(); __syncthreads();
        } else {
          ScanOps oa, ob;
          scan_load(oa, OPS, VV, 0, jg, i0);
#pragma unroll 1
          for (int seg = 0; seg < 4; ++seg) {
            if (seg > 0) __syncthreads();
#pragma unroll 1
            for (int nn = seg * 8; nn < seg * 8 + 8; nn += 2) {
              scan_load(ob, OPS, VV, nn + 1, jg, i0);
              scan_step(oa, S0, S1, YL, nn, jg, i0);
              scan_load(oa, OPS, VV, (nn + 2) & 31, jg, i0);
              scan_step(ob, S0, S1, YL, nn + 1, jg, i0);
            }
          }
        }
      }
      __syncthreads();
    }
    __syncthreads();
  }
}

DEVI void phase_rwkv_post(int tid_, int vb_, int vg_, const Params& p, int l, char* smem) {
  u16* PR = (u16*)(p.ws + OFF_PR);
  const _Float16* YF = (const _Float16*)(p.ws + OFF_H);
  const _Float16* YB = (const _Float16*)(p.ws + OFF_H + (size_t)NTOK * 512 * 2);
  const float* BON = (const float*)(p.ws + OFF_BONUS);
  const u16* GUPT = (const u16*)(p.ws + OFF_WB) + W_GUP;
  const float* mu_p = p.in[I_MU_PREV] + (size_t)l * 1920;
  const float* mu_n = p.in[I_MU_NEXT] + (size_t)l * 1920;
  const float* gng = p.in[I_GN_G] + (size_t)l * 512;
  const float* gnb = p.in[I_GN_B] + (size_t)l * 512;
  u16* As = (u16*)smem;
  const int tid = tid_, lane = tid & 63, w = tid >> 6, fr = lane & 15, fq = lane >> 4;
  for (int tile = vb_; tile < NTOK / 64; tile += vg_) {
    const size_t tok0 = (size_t)tile * 64;
    {
      const int row = tid >> 2, part = tid & 3;
      const size_t tok = tok0 + row;
      const int t = (int)(tok & 4095);
#pragma unroll
      for (int q = 0; q < 4; ++q) {
        const int col = 1792 + part * 32 + q * 8;
        float cur[8], prv[8], nxt[8];
        load8bf(PR + tok * PRW + col, cur);
        if (t > 0) load8bf(PR + (tok - 1) * PRW + col, prv);
        else {
#pragma unroll
          for (int e = 0; e < 8; ++e) prv[e] = 0.f;
        }
        if (t < 4095) load8bf(PR + (tok + 1) * PRW + col, nxt);
        else {
#pragma unroll
          for (int e = 0; e < 8; ++e) nxt[e] = 0.f;
        }
        float o[8];
#pragma unroll
        for (int e = 0; e < 8; ++e) {
          const float x = cur[e] + mu_p[col + e] * (prv[e] - cur[e]) + mu_n[col + e] * (nxt[e] - cur[e]);
          o[e] = sigm(x);
        }
        u32x4 pk;
        pk.x = pack2(o[0], o[1]); pk.y = pack2(o[2], o[3]); pk.z = pack2(o[4], o[5]); pk.w = pack2(o[6], o[7]);
        *(u32x4*)(As + row * 136 + part * 32 + q * 8) = pk;
      }
    }
    asm volatile("" ::: "memory");
#pragma unroll 1
    for (int chh = 0; chh < 2; ++chh) {
      f32x4 acc[16];
#pragma unroll
      for (int n = 0; n < 16; ++n) acc[n] = (f32x4){0.f, 0.f, 0.f, 0.f};
#pragma unroll
      for (int ks = 0; ks < 4; ++ks) {
        bf16x8 af = *(const bf16x8*)(As + (w * 16 + fr) * 136 + ks * 32 + fq * 8);
#pragma unroll
        for (int n = 0; n < 16; ++n) {
          bf16x8 bg = *(const bf16x8*)(GUPT + (size_t)(chh * 256 + n * 16 + fr) * 128 + ks * 32 + fq * 8);
          acc[n] = __builtin_amdgcn_mfma_f32_16x16x32_bf16(af, bg, acc[n], 0, 0, 0);
        }
      }
#pragma unroll
      for (int hl = 0; hl < 4; ++hl) {
        const int head = chh * 4 + hl;
        asm volatile("" ::: "memory");
#pragma unroll
        for (int j = 0; j < 4; ++j) {
          const size_t tok = tok0 + w * 16 + fq * 4 + j;
          const int t = (int)(tok & 4095);
          float o[4], sum = 0.f;
#pragma unroll
          for (int q = 0; q < 4; ++q) {
            const int col = head * 64 + q * 16 + fr;
            o[q] = (float)YF[tok * 512 + col] + (float)YB[tok * 512 + col];
            sum += o[q];
          }
          const float mean = red16_sum(sum) * (1.f / 64.f);
          float vs = 0.f;
#pragma unroll
          for (int q = 0; q < 4; ++q) { const float dlt = o[q] - mean; vs += dlt * dlt; }
          const float var = red16_sum(vs) * (1.f / 64.f);
          const float rstd = rsqrtf(var + 64e-5f);
          const float bon = BON[(tok * 8 + head) * 2] + BON[(tok * 8 + head) * 2 + 1];
#pragma unroll
          for (int q = 0; q < 4; ++q) {
            const int col = head * 64 + q * 16 + fr;
            const int vc = 1024 + col;
            const float cur = bf2f(PR[tok * PRW + vc]);
            const float prv = (t > 0) ? bf2f(PR[(tok - 1) * PRW + vc]) : 0.f;
            const float nxt = (t < 4095) ? bf2f(PR[(tok + 1) * PRW + vc]) : 0.f;
            const float vsh = cur + mu_p[vc] * (prv - cur) + mu_n[vc] * (nxt - cur);
            const float yv = ((o[q] - mean) * rstd * gng[col] + gnb[col] + bon * vsh) * acc[hl * 4 + q][j];
            PR[tok * PRW + col] = f2bf(yv);
          }
        }
      }
    }
  }
}

DEVI f32x4 ld4bf(const u16* p) {
  const u32x2 u = *(const u32x2*)p;
  f32x4 o;
  o[0] = __uint_as_float(u.x << 16); o[1] = __uint_as_float(u.x & 0xffff0000u);
  o[2] = __uint_as_float(u.y << 16); o[3] = __uint_as_float(u.y & 0xffff0000u);
  return o;
}

DEVI void phase_merge(int tid_, const Params& p, char* smem, const float* ssq) {
  const u16* WB = (const u16*)(p.ws + OFF_WB);
  const u16* H = (const u16*)(p.ws + OFF_NK);
  u16* PR = (u16*)(p.ws + OFF_PR);
  const u16* NQ = (const u16*)(p.ws + OFF_NQ);
  u16* TMP = (u16*)(p.ws + OFF_H);
  const int lane = tid_ & 63, wid = tid_ >> 6;
  const int wr = wid >> 2, wc = wid & 3, fr = lane & 15, fq = lane >> 4;
  const bool xmap = (gridDim.x & 7) == 0;
  const int xcd = blockIdx.x & 7;
  const int first = xmap ? (int)(blockIdx.x >> 3) : (int)blockIdx.x;
  const int stride = xmap ? (int)(gridDim.x >> 3) : (int)gridDim.x;
  const int count = xmap ? 24 * 4 : 192 * 4;
  for (int it = first; it < count; it += stride) {
    const int tm = xmap ? (it >> 2) * 8 + xcd : (it >> 2), tn = it & 3;
    const int m0 = tm << 8, n0 = tn << 8;
    f32x4 acc[8][4];
#define MERGE_ZERO() _Pragma("unroll") for (int m = 0; m < 8; ++m) _Pragma("unroll") for (int n = 0; n < 4; ++n) acc[m][n] = (f32x4){0.f, 0.f, 0.f, 0.f}
#define MERGE_RC() const int r = m0 + wr * 128 + m * 16 + fr, c0 = n0 + wc * 64 + n * 16 + fq * 4
    MERGE_ZERO();
    gemm_kloop8<true>(launder(tid_), acc, H + (size_t)m0 * 1024, 1024, WB + W_IN + (size_t)(3456 + n0) * 1024, 1024, 1024, smem);
#pragma unroll
    for (int m = 0; m < 8; ++m)
#pragma unroll
      for (int n = 0; n < 4; ++n) {
        MERGE_RC();
        const float rs = rstd_of(ssq, r);
        f32x4 o;
#pragma unroll
        for (int j = 0; j < 4; ++j) o[j] = sigm(acc[m][n][j] * rs);
        store4bf(PR + (size_t)r * PRW + 512 + c0, o);
      }
    MERGE_ZERO();
    gemm_kloop8<true>(launder(tid_), acc, PR + (size_t)m0 * PRW, PRW, WB + W_BRR + (size_t)n0 * 512, 512, 512, smem);
#pragma unroll
    for (int m = 0; m < 8; ++m)
#pragma unroll
      for (int n = 0; n < 4; ++n) {
        MERGE_RC();
        u16* dst = PR + (size_t)r * PRW + 512 + c0;
        store4bf(dst, ld4bf(dst) * acc[m][n]);
      }
    MERGE_ZERO();
    gemm_kloop8<true>(launder(tid_), acc, H + (size_t)m0 * 1024, 1024, WB + W_IN + (size_t)(4480 + n0) * 1024, 1024, 1024, smem);
#pragma unroll
    for (int m = 0; m < 8; ++m)
#pragma unroll
      for (int n = 0; n < 4; ++n) {
        MERGE_RC();
        const float rs = rstd_of(ssq, r);
        f32x4 o;
#pragma unroll
        for (int j = 0; j < 4; ++j) o[j] = sigm(acc[m][n][j] * rs);
        store4bf(TMP + (size_t)r * 1024 + c0, o);
      }
    MERGE_ZERO();
    gemm_kloop8<true>(launder(tid_), acc, NQ + (size_t)m0 * 512, 512, WB + W_BRN + (size_t)n0 * 512, 512, 512, smem);
#pragma unroll
    for (int m = 0; m < 8; ++m)
#pragma unroll
      for (int n = 0; n < 4; ++n) {
        MERGE_RC();
        u16* dst = PR + (size_t)r * PRW + 512 + c0;
        store4bf(dst, ld4bf(dst) + ld4bf(TMP + (size_t)r * 1024 + c0) * acc[m][n]);
      }
#undef MERGE_ZERO
#undef MERGE_RC
  }
}


DEVI void phase_xattn(int tid_, int vb_, int vg_, const Params& p, char* smem) {
  const u16* Q = (const u16*)(p.ws + OFF_PR);
  u16* O = (u16*)(p.ws + OFF_NQ);
  const u16* KVK = (const u16*)(p.ws + OFF_KVK);
  const u16* KVT = (const u16*)(p.ws + OFF_KVT);
  const int lane = tid_ & 63, w = tid_ >> 6, fr = lane & 15, fq = lane >> 4;
  u16* Pw = (u16*)smem + w * (32 * 264);
  for (int t = vb_; t < (NTOK / 128) * 4; t += vg_) {
    const int hh = t & 3;
    const size_t tok0 = (size_t)(t >> 2) * 128 + w * 32;
    const int s = (int)(tok0 >> 12);
    f32x4 acc[2][16];
#pragma unroll
    for (int mt = 0; mt < 2; ++mt)
#pragma unroll
      for (int n = 0; n < 16; ++n) acc[mt][n] = (f32x4){0.f, 0.f, 0.f, 0.f};
#pragma unroll 1
    for (int ks = 0; ks < 8; ++ks) {
      const bf16x8 aq0 = *(const bf16x8*)(Q + (tok0 + fr) * 1024 + hh * 256 + ks * 32 + fq * 8);
      const bf16x8 aq1 = *(const bf16x8*)(Q + (tok0 + 16 + fr) * 1024 + hh * 256 + ks * 32 + fq * 8);
#pragma unroll
      for (int n = 0; n < 16; ++n) {
        const bf16x8 bk = *(const bf16x8*)(KVK + (size_t)(s * 256 + n * 16 + fr) * 1024 + hh * 256 + ks * 32 + fq * 8);
        acc[0][n] = __builtin_amdgcn_mfma_f32_16x16x32_bf16(bk, aq0, acc[0][n], 0, 0, 0);
        acc[1][n] = __builtin_amdgcn_mfma_f32_16x16x32_bf16(bk, aq1, acc[1][n], 0, 0, 0);
      }
    }
    float sm[2];
#pragma unroll
    for (int mt = 0; mt < 2; ++mt) {
      float m = -1e30f;
#pragma unroll
      for (int n = 0; n < 16; ++n)
#pragma unroll
        for (int j = 0; j < 4; ++j) m = fmaxf(m, acc[mt][n][j]);
      m = red4x_max(m) * 0.0625f;
      float ssum = 0.f;
#pragma unroll
      for (int n = 0; n < 16; ++n) {
        f32x4 e;
#pragma unroll
        for (int j = 0; j < 4; ++j) { e[j] = __expf(acc[mt][n][j] * 0.0625f - m); ssum += e[j]; }
        store4bf(Pw + (mt * 16 + fr) * 264 + n * 16 + fq * 4, e);
      }
      sm[mt] = 1.f / red4x_sum(ssum);
    }
#pragma unroll
    for (int mt = 0; mt < 2; ++mt)
#pragma unroll
      for (int n = 0; n < 16; ++n) acc[mt][n] = (f32x4){0.f, 0.f, 0.f, 0.f};
#pragma unroll 1
    for (int ks = 0; ks < 8; ++ks) {
      const bf16x8 ap0 = *(const bf16x8*)(Pw + fr * 264 + ks * 32 + fq * 8);
      const bf16x8 ap1 = *(const bf16x8*)(Pw + (16 + fr) * 264 + ks * 32 + fq * 8);
#pragma unroll
      for (int n = 0; n < 16; ++n) {
        const bf16x8 bv = *(const bf16x8*)(KVT + (size_t)(s * 1024 + hh * 256 + n * 16 + fr) * 256 + ks * 32 + fq * 8);
        acc[0][n] = __builtin_amdgcn_mfma_f32_16x16x32_bf16(bv, ap0, acc[0][n], 0, 0, 0);
        acc[1][n] = __builtin_amdgcn_mfma_f32_16x16x32_bf16(bv, ap1, acc[1][n], 0, 0, 0);
      }
    }
#pragma unroll
    for (int mt = 0; mt < 2; ++mt)
#pragma unroll
      for (int n = 0; n < 16; n += 2)
        store_pair_bf16(O + (tok0 + mt * 16 + fr) * 1024 + hh * 256, n * 16, fq, pack4bf(acc[mt][n] * sm[mt]),
                        pack4bf(acc[mt][n + 1] * sm[mt]));
  }
}

constexpr int HALF_SMEM = 78720;

DEVI void run_phase(int tid_, const Params& p, int ph, char* smem) {
  const int half = tid_ >> 8, vt = tid_ & 255;
  const int vb_ = blockIdx.x * 2 + half, vg_ = gridDim.x * 2;
  char* smh = smem + half * HALF_SMEM;
  if (ph == 2 * NPH_LAYER) { phase_final_norm(vt, vb_, vg_, p); return; }
  const int l = ph / NPH_LAYER, q = ph % NPH_LAYER;
  u16* WB = (u16*)(p.ws + OFF_WB);
  u16* H = (u16*)(p.ws + OFF_H);
  u16* PR = (u16*)(p.ws + OFF_PR);
  u16* NQ = (u16*)(p.ws + OFF_NQ);
  float* X = p.X;
  float* SSQ = (float*)(p.ws + OFF_SSQ);
  auto epi_res = [&](int r, int c0, f32x4 v) {
    f32x4* px = (f32x4*)(X + (size_t)r * 1024 + c0);
    *px = *px + v;
  };
  float rowacc = 0.f;
  float* ssq_out = SSQ;
  const bool x_from_input = (l == 0 && q <= 5);
  const bool need_xb = !(l == 1 && q == 12);
  auto epi_res_n = [&](int r, int c0, f32x4 v) {
    f32x4* px = (f32x4*)(X + (size_t)r * 1024 + c0);
    const float* srow = x_from_input ? ((r < 32768) ? p.in[I_XP] + (size_t)r * 1024 : p.in[I_XS] + (size_t)(r - 32768) * 1024)
                                     : X + (size_t)r * 1024;
    const f32x4 xn = *(const f32x4*)(srow + c0) + v;
    *px = xn;
    if (need_xb) store4bf(H + (size_t)r * 1024 + c0, xn);
    rowacc += xn[0] * xn[0] + xn[1] * xn[1] + xn[2] * xn[2] + xn[3] * xn[3];
  };
  auto row_end = [&](int r) {
    float t = rowacc;
    t += __shfl_xor(t, 16);
    t += __shfl_xor(t, 32);
    if ((tid_ & 48) == 0) atomicAdd(ssq_out + r, t);
    rowacc = 0.f;
  };
  constexpr int NONS = 1 << 30;
  switch (q) {
    case 0:
      phase_conv(vt, vb_, vg_, p, l, smh);
      phase_norm_mem(vt, vb_, vg_, p, p.in[I_NORM_MEM] + (size_t)l * 1024);
      if (l == 0) {
        phase_xb(vt, vb_, vg_, p, true, OFF_H, SSQ);
        for (int i = vb_ * 256 + vt; i < 6 * NTOK; i += vg_ * 256) SSQ[NTOK + i] = 0.f;
      }
      break;
    case 1: phase_p_gemm(tid_, p, smem, SSQ + (size_t)(3 * l) * NTOK); break;
    case 2:
      if (gridDim.x >= 224) {
        if (blockIdx.x < 192) phase_scan_pc(tid_, p, l, smem, blockIdx.x, gridDim.x);
        else phase_nat(vt, p, l, smh, vb_ - 384, vg_ - 384);
      } else {
        phase_scan(vt, p, l, smh, vb_, vg_);
        __syncthreads();
        phase_nat(vt, p, l, smh, vb_, vg_);
      }
      break;
    case 3:
      phase_rwkv_post(vt, vb_, vg_, p, l, smh);
      phase_xb(vt, vb_, vg_, p, l == 0, OFF_NK, nullptr);
      break;
    case 4: phase_merge(tid_, p, smem, SSQ + (size_t)(3 * l) * NTOK); break;
    case 5:
      ssq_out = SSQ + (size_t)(3 * l + 1) * NTOK;
      gemm_phase8(tid_, PR + 512, PRW, WB + W_OUT, 1024, 1024, NTOK, 1024, smem, NONS, epi_res_n, NoEpi(), row_end);
      break;
    case 6: {
      const float* ssq = SSQ + (size_t)(3 * l + 1) * NTOK;
      const int fq_ = (tid_ & 63) >> 4;
      gemm_phase8(tid_, H, 1024, WB + W_XQ, 1024, 1024, NTOK, 1024, smem, NONS,
                 [&](int r, int c0, f32x4 v) { store4bf(PR + (size_t)r * 1024 + c0, v * rstd_of(ssq, r)); }, NoEpi(), NoRow(), 0,
                 make_pair_epi([&](int r, int c, f32x4 va, f32x4 vb) {
                   const float rs = rstd_of(ssq, r);
                   store_pair_bf16(PR + (size_t)r * 1024, c, fq_, pack4bf(va * rs), pack4bf(vb * rs));
                 }));
    } break;
    case 7: phase_xattn(vt, vb_, vg_, p, smh); break;
    case 8:
      ssq_out = SSQ + (size_t)(3 * l + 2) * NTOK;
      gemm_phase8(tid_, NQ, 1024, WB + W_XO, 1024, 1024, NTOK, 1024, smem, NONS, epi_res_n, NoEpi(), row_end);
      break;
    case 9:
    case 11: {
      const int hf = (q == 11);
      const float* ssq = SSQ + (size_t)(3 * l + 2) * NTOK;
      gemm_phase8(tid_, H, 1024, WB + W_FF1 + (size_t)hf * 2048 * 1024, 1024, 1024, NTOK, 2048, smem, NONS,
                 [&](int r, int c0, f32x4 v) {
                   const float rs = rstd_of(ssq, r);
                   f32x4 o;
#pragma unroll
                   for (int j = 0; j < 4; ++j) { const float x = fmaxf(v[j] * rs, 0.f); o[j] = x * x; }
                   store4bf(PR + (size_t)r * 2048 + c0, o);
                 }, NoEpi(), NoRow(), 0,
                 make_pair_epi([&](int r, int c, f32x4 va, f32x4 vb) {
                   const float rs = rstd_of(ssq, r);
                   f32x4 oa, ob;
#pragma unroll
                   for (int j = 0; j < 4; ++j) {
                     const float xa = fmaxf(va[j] * rs, 0.f), xb = fmaxf(vb[j] * rs, 0.f);
                     oa[j] = xa * xa; ob[j] = xb * xb;
                   }
                   store_pair_bf16(PR + (size_t)r * 2048, c, (tid_ & 63) >> 4, pack4bf(oa), pack4bf(ob));
                 }));
    } break;
    case 10:
      gemm_phase8(tid_, PR, 2048, WB + W_FF2, 4096, 2048, NTOK, 1024, smem, NONS, epi_res, NoEpi());
      break;
    case 12:
      ssq_out = SSQ + (size_t)(3 * l + 3) * NTOK;
      gemm_phase8(tid_, PR, 2048, WB + W_FF2 + 2048, 4096, 2048, NTOK, 1024, smem, NONS, epi_res_n, NoEpi(), row_end);
      break;
  }
}

#define XB_TMO      128
#define XB_XCNT(j)  (256  + 64 * (j))
#define XB_XSUB(j)  (1280 + 64 * (j))
#define XB_XGEN(j)  (2304 + 64 * (j))
#define XB_TOP      3328
#define XB_TOPGEN   3392
#define XCD_BAR_WORDS 3456
#define XB_SPIN_CAP (1u << 20)
#define LAS __attribute__((address_space(3)))

DEVI unsigned xb_ld(unsigned* p) { return __hip_atomic_load(p, __ATOMIC_RELAXED, __HIP_MEMORY_SCOPE_AGENT); }
DEVI unsigned xb_add(unsigned* p, unsigned v) { return __hip_atomic_fetch_add(p, v, __ATOMIC_RELAXED, __HIP_MEMORY_SCOPE_AGENT); }
DEVI unsigned xb_xcc_id() { return (unsigned)__builtin_amdgcn_s_getreg((3 << 11) | 20) & 0xFu; }
#define XB_SPIN(cond, bar) do { unsigned _sp = 0; while (cond) { __builtin_amdgcn_s_sleep(1); \
    if ((++_sp & 255u) == 0u) { if (xb_ld(&(bar)[XB_TMO])) break; if (_sp > XB_SPIN_CAP) { atomicAdd(&(bar)[XB_TMO], 1u); break; } } } } while (0)

struct XcdBarrier {
  unsigned* bar; unsigned x;
  volatile LAS unsigned* st;
};
DEVI XcdBarrier xcd_barrier_post(unsigned* bar, volatile LAS unsigned* st) {
  XcdBarrier b; b.bar = bar; b.x = xb_xcc_id(); b.st = st;
  if (threadIdx.x == 0) (void)xb_add(&bar[XB_XCNT(b.x)], 1u);
  return b;
}
DEVI void xcd_barrier_complete(unsigned* bar, unsigned x, unsigned& nloc, unsigned& nx) {
  const unsigned G = gridDim.x * gridDim.y * gridDim.z;
  unsigned sum, cnt, mine, sp = 0u;
  for (;;) {
    sum = 0u; cnt = 0u; mine = 0u;
#pragma unroll
    for (unsigned j = 0; j < 16; ++j) { const unsigned c = xb_ld(&bar[XB_XCNT(j)]); sum += c; cnt += (c > 0u) ? 1u : 0u; mine = (j == x) ? c : mine; }
    if (sum == G) break;
    __builtin_amdgcn_s_sleep(1);
    if ((++sp & 255u) == 0u) { if (xb_ld(&bar[XB_TMO])) break; if (sp > XB_SPIN_CAP) { atomicAdd(&bar[XB_TMO], 1u); break; } }
  }
  nloc = mine > 0u ? mine : 1u; nx = cnt > 0u ? cnt : 1u;
}
DEVI void xcd_barrier(const XcdBarrier& b) {
  asm volatile("s_waitcnt vmcnt(0)" ::: "memory");
  __syncthreads();
  if (threadIdx.x == 0) {
    unsigned* bar = b.bar;
    __builtin_amdgcn_s_waitcnt(0);
    unsigned nloc = b.st[0], nx = b.st[1];
    if (nloc == 0u) { xcd_barrier_complete(bar, b.x, nloc, nx); b.st[0] = nloc; b.st[1] = nx; }
    const unsigned old = xb_add(&bar[XB_XSUB(b.x)], 1u);
    const unsigned gen = old / nloc;
    if (old + 1u == (gen + 1u) * nloc) {
      __builtin_amdgcn_fence(__ATOMIC_RELEASE, "agent");
      asm volatile("s_waitcnt vmcnt(0)" ::: "memory");
      const unsigned og = xb_add(&bar[XB_TOP], 1u);
      const unsigned tg = og / nx;
      if (og + 1u == (tg + 1u) * nx) xb_add(&bar[XB_TOPGEN], 1u);
      else XB_SPIN(xb_ld(&bar[XB_TOPGEN]) == tg, bar);
      __builtin_amdgcn_fence(__ATOMIC_ACQUIRE, "agent");
      xb_add(&bar[XB_XGEN(b.x)], 1u);
      asm volatile("s_waitcnt vmcnt(0)" ::: "memory");
    } else {
      XB_SPIN(xb_ld(&bar[XB_XGEN(b.x)]) == gen, bar);
      __builtin_amdgcn_fence(__ATOMIC_ACQUIRE, "agent");
      asm volatile("s_waitcnt vmcnt(0)" ::: "memory");
    }
  }
  __syncthreads();
}

__global__ void __launch_bounds__(512, 2) mega_kernel(Params p, int ph0, int ph1) {
  __shared__ __attribute__((aligned(16))) char smem[2 * HALF_SMEM];
  __shared__ __attribute__((aligned(16))) unsigned xb_words[4];
  if (threadIdx.x == 0) { xb_words[0] = 0u; xb_words[1] = 0u; xb_words[2] = 0u; xb_words[3] = 0u; }
  __syncthreads();
  XcdBarrier xb = xcd_barrier_post((unsigned*)(p.ws + OFF_BAR), (volatile LAS unsigned*)xb_words);
  for (int ph = ph0; ph < ph1; ++ph) {
    if (ph == ph0 + 1) cg::this_grid().sync();
    else if (ph > ph0) xcd_barrier(xb);
    int tid_ = threadIdx.x;
    asm volatile("" : "+v"(tid_));
    run_phase(tid_, p, ph, smem);
  }
}

extern "C" void kernel_launch(void* const* d_in, const int* in_sizes, int n_in, void* d_out, int out_size, void* d_ws,
                              size_t ws_size, hipStream_t stream) {
  if (ws_size < WS_NEED || n_in < 31) return;
  Params p{};
  for (int i = 0; i < 31; ++i) p.in[i] = (const float*)d_in[i];
  p.X = (float*)d_out;
  p.ws = (char*)d_ws;
  static int grid_blocks = 0;
  if (!grid_blocks) {
    int dev = 0, cus = 0, per_cu = 0;
    hipGetDevice(&dev);
    hipDeviceGetAttribute(&cus, hipDeviceAttributeMultiprocessorCount, dev);
    hipOccupancyMaxActiveBlocksPerMultiprocessor(&per_cu, mega_kernel, 512, 0);
    if (per_cu > 1) per_cu = 1;
    if (per_cu < 1) per_cu = 1;
    grid_blocks = cus * per_cu;
  }
  hipMemsetAsync((char*)d_ws + OFF_BAR, 0, 16384, stream);
  int ph0 = 0, ph1 = NPHASES;
  void* args[] = {&p, &ph0, &ph1};
  hipLaunchCooperativeKernel((void*)mega_kernel, dim3(grid_blocks), dim3(512), args, 0, stream);
}
```

```cpp
#include <hip/hip_runtime.h>
#include <hip/hip_cooperative_groups.h>
#include <stdint.h>
namespace cg = cooperative_groups;

typedef unsigned short u16;
typedef __attribute__((ext_vector_type(8))) short bf16x8;
typedef __attribute__((ext_vector_type(4))) float f32x4;
typedef __attribute__((ext_vector_type(8))) _Float16 h16x8;
typedef __attribute__((ext_vector_type(4))) unsigned int u32x4;
typedef __attribute__((ext_vector_type(2))) unsigned int u32x2;

#define DEVI __device__ __forceinline__

constexpr int NTOK = 49152;
constexpr int SEQ_T = 4096;
constexpr int PRW = 1920;
constexpr int NPH_LAYER = 13;
constexpr int NPHASES = 2 * NPH_LAYER + 1;
constexpr int SMEM_BYTES = 78720;

constexpr size_t OFF_WB = 0;
constexpr size_t WB_BYTES = 20512768ull * 2;
constexpr size_t OFF_H = OFF_WB + WB_BYTES;
constexpr size_t OFF_PR = OFF_H + (size_t)NTOK * 1024 * 2;
constexpr size_t OFF_NQ = OFF_PR + (size_t)NTOK * PRW * 2;
constexpr size_t OFF_NK = OFF_NQ + (size_t)NTOK * 512 * 2;
constexpr size_t OFF_NV = OFF_NK + (size_t)NTOK * 512 * 2;
constexpr size_t OFF_KVK = OFF_NV + (size_t)NTOK * 512 * 2;
constexpr size_t OFF_KVT = OFF_KVK + (size_t)3072 * 1024 * 2;
constexpr size_t OFF_MEMH = OFF_KVT + (size_t)3072 * 1024 * 2;
constexpr size_t OFF_BONUS = OFF_MEMH + (size_t)3072 * 1024 * 2;
constexpr size_t OFF_BAR = OFF_BONUS + (size_t)NTOK * 16 * 4;
constexpr size_t OFF_SSQ = OFF_BAR + 16384;
constexpr size_t WS_NEED = OFF_SSQ + (size_t)7 * NTOK * 4;

constexpr size_t W_IN = 0;
constexpr size_t W_BRR = W_IN + (size_t)5504 * 1024;
constexpr size_t W_BRN = W_BRR + (size_t)1024 * 512;
constexpr size_t W_OUT = W_BRN + (size_t)1024 * 512;
constexpr size_t W_XQ = W_OUT + (size_t)1024 * 1024;
constexpr size_t W_XKV = W_XQ + (size_t)1024 * 1024;
constexpr size_t W_XO = W_XKV + (size_t)2048 * 1024;
constexpr size_t W_FF1 = W_XO + (size_t)1024 * 1024;
constexpr size_t W_FF2 = W_FF1 + (size_t)4096 * 1024;
constexpr size_t W_GUP = W_FF2 + (size_t)4096 * 1024;
constexpr size_t W_WUP = W_GUP + (size_t)512 * 128;
constexpr size_t W_AUP = W_WUP + (size_t)2 * 512 * 64;

enum { I_XP = 0, I_XS, I_MP, I_MS, I_NORM_MIX, I_W_IN, I_MU_PREV, I_MU_NEXT, I_W0, I_W_UP, I_A0, I_A_UP,
       I_G_UP, I_K_K, I_K_A, I_R_K, I_GN_G, I_GN_B, I_RPB, I_W_BR_RWKV, I_W_BR_NAT, I_W_OUT, I_NORM_X,
       I_NORM_MEM, I_W_XQ, I_W_XKV, I_W_XO, I_NORM_FF, I_W_FF1, I_W_FF2, I_NORM_FINAL };

struct Params {
  const float* in[31];
  float* X;
  char* ws;
};

DEVI u16 f2bf(float f) {
  uint32_t u = __float_as_uint(f);
  u += 0x7FFFu + ((u >> 16) & 1u);
  return (u16)(u >> 16);
}
DEVI float bf2f(u16 h) { return __uint_as_float(((uint32_t)h) << 16); }
DEVI uint32_t pack2(float a, float b) { return (uint32_t)f2bf(a) | ((uint32_t)f2bf(b) << 16); }
DEVI float frcp(float x) { return __builtin_amdgcn_rcpf(x); }
DEVI float sigm(float x) { return frcp(1.f + __expf(-x)); }
DEVI float ftanh(float x) { return 1.f - 2.f * frcp(__expf(2.f * x) + 1.f); }
DEVI void unpack8(u32x4 u, float* o) {
  o[0] = __uint_as_float(u.x << 16); o[1] = __uint_as_float(u.x & 0xffff0000u);
  o[2] = __uint_as_float(u.y << 16); o[3] = __uint_as_float(u.y & 0xffff0000u);
  o[4] = __uint_as_float(u.z << 16); o[5] = __uint_as_float(u.z & 0xffff0000u);
  o[6] = __uint_as_float(u.w << 16); o[7] = __uint_as_float(u.w & 0xffff0000u);
}
DEVI void load8bf(const u16* p, float* o) { unpack8(*(const u32x4*)p, o); }
DEVI float wave_sum(float v) {
  v += __shfl_xor(v, 32); v += __shfl_xor(v, 16); v += __shfl_xor(v, 8);
  v += __shfl_xor(v, 4); v += __shfl_xor(v, 2); v += __shfl_xor(v, 1);
  return v;
}
DEVI float red4x_sum(float v) { v += __shfl_xor(v, 16); v += __shfl_xor(v, 32); return v; }
DEVI float red4x_max(float v) { v = fmaxf(v, __shfl_xor(v, 16)); v = fmaxf(v, __shfl_xor(v, 32)); return v; }
DEVI float red16_sum(float v) {
  v += __shfl_xor(v, 1); v += __shfl_xor(v, 2); v += __shfl_xor(v, 4); v += __shfl_xor(v, 8);
  return v;
}
DEVI float red16_max(float v) {
  v = fmaxf(v, __shfl_xor(v, 1)); v = fmaxf(v, __shfl_xor(v, 2));
  v = fmaxf(v, __shfl_xor(v, 4)); v = fmaxf(v, __shfl_xor(v, 8));
  return v;
}

DEVI void conv_tile(int tid_, const float* src, int K, int N, u16* dst, int tile, char* smem, const float* gain = nullptr) {
  float (*s)[65] = (float (*)[65])smem;
  const int nN = N >> 6;
  const int tk = tile / nN, tn = tile - tk * nN;
  const int tx = tid_ & 63, ty = tid_ >> 6;
  for (int r = ty; r < 64; r += 4) s[r][tx] = src[(size_t)(tk * 64 + r) * N + tn * 64 + tx];
  __syncthreads();
  const float gk = gain ? gain[tk * 64 + tx] : 1.f;
  for (int r = ty; r < 64; r += 4) dst[(size_t)(tn * 64 + r) * K + tk * 64 + tx] = f2bf(s[tx][r] * gk);
  __syncthreads();
}

DEVI void phase_conv(int tid_, int vb_, int vg_, const Params& p, int l, char* smem) {
  u16* WB = (u16*)(p.ws + OFF_WB);
  const int c0 = 1376, c1 = c0 + 128, c2 = c1 + 128, c3 = c2 + 256, c4 = c3 + 256, c5 = c4 + 512,
            c6 = c5 + 256, c7 = c6 + 1024, c8 = c7 + 1024, c9 = c8 + 16, c10 = c9 + 16, c11 = c10 + 16;
  for (int t = vb_; t < c11; t += vg_) {
    if (t < c0) conv_tile(tid_, p.in[I_W_IN] + (size_t)l * 1024 * 5504, 1024, 5504, WB + W_IN, t, smem, p.in[I_NORM_MIX] + (size_t)l * 1024);
    else if (t < c1) conv_tile(tid_, p.in[I_W_BR_RWKV] + (size_t)l * 512 * 1024, 512, 1024, WB + W_BRR, t - c0, smem);
    else if (t < c2) conv_tile(tid_, p.in[I_W_BR_NAT] + (size_t)l * 512 * 1024, 512, 1024, WB + W_BRN, t - c1, smem);
    else if (t < c3) conv_tile(tid_, p.in[I_W_OUT] + (size_t)l * 1024 * 1024, 1024, 1024, WB + W_OUT, t - c2, smem);
    else if (t < c4) conv_tile(tid_, p.in[I_W_XQ] + (size_t)l * 1024 * 1024, 1024, 1024, WB + W_XQ, t - c3, smem, p.in[I_NORM_X] + (size_t)l * 1024);
    else if (t < c5) conv_tile(tid_, p.in[I_W_XKV] + (size_t)l * 1024 * 2048, 1024, 2048, WB + W_XKV, t - c4, smem);
    else if (t < c6) conv_tile(tid_, p.in[I_W_XO] + (size_t)l * 1024 * 1024, 1024, 1024, WB + W_XO, t - c5, smem);
    else if (t < c7) conv_tile(tid_, p.in[I_W_FF1] + (size_t)l * 1024 * 4096, 1024, 4096, WB + W_FF1, t - c6, smem, p.in[I_NORM_FF] + (size_t)l * 1024);
    else if (t < c8) conv_tile(tid_, p.in[I_W_FF2] + (size_t)l * 4096 * 1024, 4096, 1024, WB + W_FF2, t - c7, smem);
    else if (t < c9) conv_tile(tid_, p.in[I_G_UP] + (size_t)l * 128 * 512, 128, 512, WB + W_GUP, t - c8, smem);
    else if (t < c10) { const int dd = (t - c9) >> 3; conv_tile(tid_, p.in[I_W_UP] + (size_t)(l * 2 + dd) * 64 * 512, 64, 512, WB + W_WUP + (size_t)dd * 512 * 64, (t - c9) & 7, smem); }
    else { const int dd = (t - c10) >> 3; conv_tile(tid_, p.in[I_A_UP] + (size_t)(l * 2 + dd) * 64 * 512, 64, 512, WB + W_AUP + (size_t)dd * 512 * 64, (t - c10) & 7, smem); }
  }
}

DEVI void norm_row_bf16(int tid_, const float* src, const float* g, u16* dst, float* xcopy) {
  const int lane = tid_ & 63;
  float4 v[4];
  float ss = 0.f;
#pragma unroll
  for (int i = 0; i < 4; ++i) {
    v[i] = ((const float4*)src)[lane + i * 64];
    ss += v[i].x * v[i].x + v[i].y * v[i].y + v[i].z * v[i].z + v[i].w * v[i].w;
  }
  ss = wave_sum(ss);
  const float rs = rsqrtf(ss * (1.f / 1024.f) + 1e-6f);
#pragma unroll
  for (int i = 0; i < 4; ++i) {
    float4 gg = ((const float4*)g)[lane + i * 64];
    u32x2 o;
    o.x = pack2(v[i].x * rs * gg.x, v[i].y * rs * gg.y);
    o.y = pack2(v[i].z * rs * gg.z, v[i].w * rs * gg.w);
    ((u32x2*)dst)[lane + i * 64] = o;
    if (xcopy) ((float4*)xcopy)[lane + i * 64] = v[i];
  }
}

DEVI void phase_xb(int tid_, int vb_, int vg_, const Params& p, bool from_input, size_t hoff, float* ssq) {
  u16* H = (u16*)(p.ws + hoff);
  const int wid = tid_ >> 6, lane = tid_ & 63;
  for (int r = vb_ * 4 + wid; r < NTOK; r += vg_ * 4) {
    const float* src;
    if (from_input) src = (r < 32768) ? p.in[I_XP] + (size_t)r * 1024 : p.in[I_XS] + (size_t)(r - 32768) * 1024;
    else src = p.X + (size_t)r * 1024;
    float ss = 0.f;
#pragma unroll
    for (int i = 0; i < 4; ++i) {
      const float4 v = ((const float4*)src)[lane + i * 64];
      ss += v.x * v.x + v.y * v.y + v.z * v.z + v.w * v.w;
      u32x2 o;
      o.x = pack2(v.x, v.y); o.y = pack2(v.z, v.w);
      ((u32x2*)(H + (size_t)r * 1024))[lane + i * 64] = o;
    }
    if (ssq) {
      ss = wave_sum(ss);
      if (lane == 0) ssq[r] = ss;
    }
  }
}
DEVI void phase_norm_mem(int tid_, int vb_, int vg_, const Params& p, const float* g) {
  u16* MH = (u16*)(p.ws + OFF_MEMH);
  const int wid = tid_ >> 6;
  for (int r = vb_ * 4 + wid; r < 3072; r += vg_ * 4) {
    const float* src = (r < 2048) ? p.in[I_MP] + (size_t)r * 1024 : p.in[I_MS] + (size_t)(r - 2048) * 1024;
    norm_row_bf16(tid_, src, g, MH + (size_t)r * 1024, nullptr);
  }
}
DEVI void phase_final_norm(int tid_, int vb_, int vg_, const Params& p) {
  const float* g = p.in[I_NORM_FINAL];
  const float* ssq = (const float*)(p.ws + OFF_SSQ) + (size_t)6 * NTOK;
  const int wid = tid_ >> 6, lane = tid_ & 63;
  for (int r = vb_ * 4 + wid; r < NTOK; r += vg_ * 4) {
    float* row = p.X + (size_t)r * 1024;
    const float rs = rsqrtf(ssq[r] * (1.f / 1024.f) + 1e-6f);
#pragma unroll
    for (int i = 0; i < 4; ++i) {
      const float4 v = ((const float4*)row)[lane + i * 64];
      const float4 gg = ((const float4*)g)[lane + i * 64];
      float4 o;
      o.x = v.x * rs * gg.x; o.y = v.y * rs * gg.y; o.z = v.z * rs * gg.z; o.w = v.w * rs * gg.w;
      ((float4*)row)[lane + i * 64] = o;
    }
  }
}

template <int OFF>
DEVI bf16x8 lds_rd128(uint32_t addr) {
  bf16x8 r;
  asm volatile("ds_read_b128 %0, %1 offset:%2" : "=v"(r) : "v"(addr), "n"(OFF));
  return r;
}

template <int NW, bool SWAP>
DEVI void gemm_kloop(int tid_, f32x4 (&acc)[4][NW], const u16* __restrict__ A, int lda, const u16* __restrict__ Bt, int ldb,
                     int K, char* smem) {
  constexpr int STG = 8192 + NW * 2048;
  constexpr int NB = NW / 2;
  const int tid = tid_, lane = tid & 63, wid = tid >> 6;
  const int wr = wid >> 1, wc = wid & 1, fr = lane & 15, fq = lane >> 4;
  const int lrow = lane >> 2, lphys = lane & 3, lhi = lane >> 4;
  const int gsw = (4 - lhi) & 3;
  const u16* ga[2];
  const u16* gb[NB];
#pragma unroll
  for (int q = 0; q < 2; ++q) ga[q] = A + (size_t)((wid * 2 + q) * 16 + lrow) * lda + (lphys ^ gsw) * 8;
#pragma unroll
  for (int q = 0; q < NB; ++q) gb[q] = Bt + (size_t)((wid * NB + q) * 16 + lrow) * ldb + (lphys ^ gsw) * 8;
  const int rsw = (4 - ((fr >> 2) & 3)) & 3;
  const int ch = (fq ^ rsw) * 16;
  const int nk = K >> 5;
  const uint32_t lds_base = (uint32_t)(size_t)(__attribute__((address_space(3))) char*)smem;
  const uint32_t aoff = (uint32_t)((wr * 64 + fr) * 64 + ch);
  const uint32_t boff = (uint32_t)(8192 + (wc * 16 * NW + fr) * 64 + ch);
  asm volatile("s_waitcnt vmcnt(0)" ::: "memory");
  __syncthreads();
#define GEMM_ISSUE(kt_)                                                                                              \
  do {                                                                                                               \
    char* nb_ = smem + ((kt_) & 3) * STG;                                                                            \
    _Pragma("unroll") for (int q = 0; q < 2; ++q) __builtin_amdgcn_global_load_lds(                                  \
        (const unsigned*)(ga[q] + (kt_) * 32),                                                                       \
        (__attribute__((address_space(3))) unsigned*)(nb_ + (wid * 2 + q) * 1024 + lane * 16), 16, 0, 0);            \
    _Pragma("unroll") for (int q = 0; q < NB; ++q) __builtin_amdgcn_global_load_lds(                                 \
        (const unsigned*)(gb[q] + (kt_) * 32),                                                                       \
        (__attribute__((address_space(3))) unsigned*)(nb_ + 8192 + (wid * NB + q) * 1024 + lane * 16), 16, 0, 0);    \
  } while (0)
  GEMM_ISSUE(0);
  if (nk > 1) GEMM_ISSUE(1);
  if (nk > 2) GEMM_ISSUE(2);
  for (int kt = 0; kt < nk; ++kt) {
    if (kt + 2 < nk) {
      if (NW == 4) asm volatile("s_waitcnt vmcnt(8)" ::: "memory");
      else asm volatile("s_waitcnt vmcnt(6)" ::: "memory");
    } else if (kt + 1 < nk) {
      if (NW == 4) asm volatile("s_waitcnt vmcnt(4)" ::: "memory");
      else asm volatile("s_waitcnt vmcnt(3)" ::: "memory");
    } else {
      asm volatile("s_waitcnt vmcnt(0)" ::: "memory");
    }
    __builtin_amdgcn_s_barrier();
    asm volatile("" ::: "memory");
    if (kt + 3 < nk) GEMM_ISSUE(kt + 3);
    const uint32_t sb = lds_base + (kt & 3) * STG;
    bf16x8 af[4], bfr[4];
    af[0] = lds_rd128<0>(sb + aoff); af[1] = lds_rd128<1024>(sb + aoff);
    af[2] = lds_rd128<2048>(sb + aoff); af[3] = lds_rd128<3072>(sb + aoff);
    bfr[0] = lds_rd128<0>(sb + boff); bfr[1] = lds_rd128<1024>(sb + boff);
    if (NW == 4) {
      bfr[2] = lds_rd128<2048>(sb + boff); bfr[3] = lds_rd128<3072>(sb + boff);
      asm volatile("s_waitcnt lgkmcnt(0)" : "+v"(af[0]), "+v"(af[1]), "+v"(af[2]), "+v"(af[3]),
                   "+v"(bfr[0]), "+v"(bfr[1]), "+v"(bfr[2]), "+v"(bfr[3]));
    } else {
      asm volatile("s_waitcnt lgkmcnt(0)" : "+v"(af[0]), "+v"(af[1]), "+v"(af[2]), "+v"(af[3]), "+v"(bfr[0]), "+v"(bfr[1]));
    }
#pragma unroll
    for (int m = 0; m < 4; ++m)
#pragma unroll
      for (int n = 0; n < NW; ++n) {
        if (SWAP) acc[m][n] = __builtin_amdgcn_mfma_f32_16x16x32_bf16(bfr[n], af[m], acc[m][n], 0, 0, 0);
        else acc[m][n] = __builtin_amdgcn_mfma_f32_16x16x32_bf16(af[m], bfr[n], acc[m][n], 0, 0, 0);
      }
  }
#undef GEMM_ISSUE
}

DEVI int launder(int x) { asm volatile("" : "+v"(x)); return x; }

template <int NW>
DEVI void zero_acc(f32x4 (&acc)[4][NW]) {
#pragma unroll
  for (int m = 0; m < 4; ++m)
#pragma unroll
    for (int n = 0; n < NW; ++n) acc[m][n] = (f32x4){0.f, 0.f, 0.f, 0.f};
}

struct NoEpi { DEVI void operator()(int, int, f32x4) const {} };

template <class EpiS, class EpiN>
DEVI void gemm_phase(int tid_, const u16* A, int lda, const u16* Bt, int ldb, int K, int M, int N, char* smem, int ns_from,
                     EpiS epiS, EpiN epiN) {
  const int nN = N >> 7, nM = M >> 7;
  const int lane = tid_ & 63, wid = tid_ >> 6;
  const int wr = wid >> 1, wc = wid & 1, fr = lane & 15, fq = lane >> 4;
  const int xcd = blockIdx.x & 7, jloc = blockIdx.x >> 3, nloc = gridDim.x >> 3;
  for (int lt = jloc; lt < (nM >> 3) * nN; lt += nloc) {
    const int tml = lt / nN, tn = lt - tml * nN;
    const int tm = tml * 8 + xcd;
    const int m0 = tm << 7, n0 = tn << 7;
    f32x4 acc[4][4];
    zero_acc(acc);
    if (n0 < ns_from) {
      gemm_kloop<4, true>(tid_, acc, A + (size_t)m0 * lda, lda, Bt + (size_t)n0 * ldb, ldb, K, smem);
#pragma unroll
      for (int m = 0; m < 4; ++m)
#pragma unroll
        for (int n = 0; n < 4; ++n) epiS(m0 + wr * 64 + m * 16 + fr, n0 + wc * 64 + n * 16 + fq * 4, acc[m][n]);
    } else {
      gemm_kloop<4, false>(tid_, acc, A + (size_t)m0 * lda, lda, Bt + (size_t)n0 * ldb, ldb, K, smem);
#pragma unroll
      for (int m = 0; m < 4; ++m)
#pragma unroll
        for (int n = 0; n < 4; ++n) epiN(m0 + wr * 64 + m * 16 + fq * 4, n0 + wc * 64 + n * 16 + fr, acc[m][n]);
    }
  }
}


template <bool SWAP>
DEVI void gemm_kloop_big(int tid_, f32x4 (&acc)[8][4], const u16* __restrict__ A, int lda, const u16* __restrict__ Bt,
                         int ldb, int K, char* smem) {
  constexpr int STG = 16384 + 8192;
  const int tid = tid_, lane = tid & 63, wid = tid >> 6;
  const int wr = wid >> 1, wc = wid & 1, fr = lane & 15, fq = lane >> 4;
  const int lrow = lane >> 2, lphys = lane & 3, lhi = lane >> 4;
  const int gsw = (4 - lhi) & 3;
  const u16* ga = A + (size_t)(wid * 64 + lrow) * lda + (lphys ^ gsw) * 8;
  const u16* gb = Bt + (size_t)(wid * 32 + lrow) * ldb + (lphys ^ gsw) * 8;
  const size_t a16 = (size_t)16 * lda, b16 = (size_t)16 * ldb;
  const int rsw = (4 - ((fr >> 2) & 3)) & 3;
  const int ch = (fq ^ rsw) * 16;
  const int nk = K >> 5;
  const uint32_t lds_base = (uint32_t)(size_t)(__attribute__((address_space(3))) char*)smem;
  const uint32_t aoff = (uint32_t)((wr * 128 + fr) * 64 + ch);
  const uint32_t boff = (uint32_t)(16384 + (wc * 64 + fr) * 64 + ch);
  asm volatile("s_waitcnt vmcnt(0)" ::: "memory");
  __syncthreads();
#define GEMMB_ISSUE(kt_, buf_)                                                                                       \
  do {                                                                                                               \
    char* nb_ = smem + (buf_) * STG;                                                                                 \
    _Pragma("unroll") for (int q = 0; q < 4; ++q) __builtin_amdgcn_global_load_lds(                                  \
        (const unsigned*)(ga + q * a16 + (kt_) * 32),                                                                \
        (__attribute__((address_space(3))) unsigned*)(nb_ + (wid * 4 + q) * 1024 + lane * 16), 16, 0, 0);            \
    _Pragma("unroll") for (int q = 0; q < 2; ++q) __builtin_amdgcn_global_load_lds(                                  \
        (const unsigned*)(gb + q * b16 + (kt_) * 32),                                                                \
        (__attribute__((address_space(3))) unsigned*)(nb_ + 16384 + (wid * 2 + q) * 1024 + lane * 16), 16, 0, 0);   \
  } while (0)
  GEMMB_ISSUE(0, 0);
  if (nk > 1) GEMMB_ISSUE(1, 1);
  int cb = 0;
  for (int kt = 0; kt < nk; ++kt) {
    if (kt + 1 < nk) asm volatile("s_waitcnt vmcnt(6)" ::: "memory");
    else asm volatile("s_waitcnt vmcnt(0)" ::: "memory");
    __builtin_amdgcn_s_barrier();
    asm volatile("" ::: "memory");
    const int nbuf = (cb == 0) ? 2 : cb - 1;
    if (kt + 2 < nk) GEMMB_ISSUE(kt + 2, nbuf);
    const uint32_t sb = lds_base + cb * STG;
    bf16x8 a0[4], a1[4], bb[4];
    a0[0] = lds_rd128<0>(sb + aoff); a0[1] = lds_rd128<1024>(sb + aoff);
    a0[2] = lds_rd128<2048>(sb + aoff); a0[3] = lds_rd128<3072>(sb + aoff);
    bb[0] = lds_rd128<0>(sb + boff); bb[1] = lds_rd128<1024>(sb + boff);
    bb[2] = lds_rd128<2048>(sb + boff); bb[3] = lds_rd128<3072>(sb + boff);
    a1[0] = lds_rd128<4096>(sb + aoff); a1[1] = lds_rd128<5120>(sb + aoff);
    a1[2] = lds_rd128<6144>(sb + aoff); a1[3] = lds_rd128<7168>(sb + aoff);
    asm volatile("s_waitcnt lgkmcnt(4)" : "+v"(a0[0]), "+v"(a0[1]), "+v"(a0[2]), "+v"(a0[3]),
                 "+v"(bb[0]), "+v"(bb[1]), "+v"(bb[2]), "+v"(bb[3]));
#pragma unroll
    for (int m = 0; m < 4; ++m)
#pragma unroll
      for (int n = 0; n < 4; ++n) {
        if (SWAP) acc[m][n] = __builtin_amdgcn_mfma_f32_16x16x32_bf16(bb[n], a0[m], acc[m][n], 0, 0, 0);
        else acc[m][n] = __builtin_amdgcn_mfma_f32_16x16x32_bf16(a0[m], bb[n], acc[m][n], 0, 0, 0);
      }
    asm volatile("s_waitcnt lgkmcnt(0)" : "+v"(a1[0]), "+v"(a1[1]), "+v"(a1[2]), "+v"(a1[3]));
#pragma unroll
    for (int m = 0; m < 4; ++m)
#pragma unroll
      for (int n = 0; n < 4; ++n) {
        if (SWAP) acc[4 + m][n] = __builtin_amdgcn_mfma_f32_16x16x32_bf16(bb[n], a1[m], acc[4 + m][n], 0, 0, 0);
        else acc[4 + m][n] = __builtin_amdgcn_mfma_f32_16x16x32_bf16(a1[m], bb[n], acc[4 + m][n], 0, 0, 0);
      }
    cb = (cb == 2) ? 0 : cb + 1;
  }
#undef GEMMB_ISSUE
}

template <class EpiS, class EpiN>
DEVI void gemm_phase_big(int tid_, const u16* A, int lda, const u16* Bt, int ldb, int K, int M, int N, char* smem,
                         int ns_from, EpiS epiS, EpiN epiN) {
  const int nN = N >> 7, nM = M >> 8;
  const int lane = tid_ & 63, wid = tid_ >> 6;
  const int wr = wid >> 1, wc = wid & 1, fr = lane & 15, fq = lane >> 4;
  const int xcd = blockIdx.x & 7, jloc = blockIdx.x >> 3, nloc = gridDim.x >> 3;
  for (int lt = jloc; lt < (nM >> 3) * nN; lt += nloc) {
    const int tml = lt / nN, tn = lt - tml * nN;
    const int tm = tml * 8 + xcd;
    const int m0 = tm << 8, n0 = tn << 7;
    f32x4 acc[8][4];
#pragma unroll
    for (int m = 0; m < 8; ++m)
#pragma unroll
      for (int n = 0; n < 4; ++n) acc[m][n] = (f32x4){0.f, 0.f, 0.f, 0.f};
    if (n0 < ns_from) {
      gemm_kloop_big<true>(launder(tid_), acc, A + (size_t)m0 * lda, lda, Bt + (size_t)n0 * ldb, ldb, K, smem);
#pragma unroll
      for (int m = 0; m < 8; ++m)
#pragma unroll
        for (int n = 0; n < 4; ++n) epiS(m0 + wr * 128 + m * 16 + fr, n0 + wc * 64 + n * 16 + fq * 4, acc[m][n]);
    } else {
      gemm_kloop_big<false>(launder(tid_), acc, A + (size_t)m0 * lda, lda, Bt + (size_t)n0 * ldb, ldb, K, smem);
#pragma unroll
      for (int m = 0; m < 8; ++m)
#pragma unroll
        for (int n = 0; n < 4; ++n) epiN(m0 + wr * 128 + m * 16 + fq * 4, n0 + wc * 64 + n * 16 + fr, acc[m][n]);
    }
  }
}


template <bool SWAP>
DEVI void gemm_kloop8(int tid_, f32x4 (&acc)[8][4], const u16* __restrict__ A, int lda, const u16* __restrict__ Bt,
                      int ldb, int K, char* smem, bool have_pref = false, const u16* An = nullptr, int lda_n = 0,
                      const u16* Bn = nullptr, int ldb_n = 0) {
  constexpr int STG = 65536;
  const int tid = tid_, lane = tid & 63, wid = tid >> 6;
  const int wr = wid >> 2, wc = wid & 3, fr = lane & 15, fq = lane >> 4;
  const int lrow = lane >> 3, lphys = lane & 7, lhi = lane >> 4;
  const u16* ga[4];
  const u16* gb[4];
#pragma unroll
  for (int q = 0; q < 4; ++q) {
    const int kc = lphys ^ ((4 * (q & 1) + lhi) & 7);
    ga[q] = A + (size_t)((wid * 4 + q) * 8 + lrow) * lda + kc * 8;
    gb[q] = Bt + (size_t)((wid * 4 + q) * 8 + lrow) * ldb + kc * 8;
  }
  const int swz = (fr >> 1) & 7;
  const int nk = K >> 6;
  const uint32_t lds_base = (uint32_t)(size_t)(__attribute__((address_space(3))) char*)smem;
  const uint32_t arow = (uint32_t)((wr * 128 + fr) * 128);
  const uint32_t brow = (uint32_t)(32768 + (wc * 64 + fr) * 128);
  if (__builtin_amdgcn_readfirstlane(tid_) >= 256) __builtin_amdgcn_s_setprio(1);
  if (!have_pref) {
    asm volatile("s_waitcnt vmcnt(0)" ::: "memory");
    __syncthreads();
  }
#define GEMM8_ISSUE(kt_)                                                                                             \
  do {                                                                                                               \
    char* nb_ = smem + ((kt_) & 1) * STG;                                                                            \
    _Pragma("unroll") for (int q = 0; q < 4; ++q) __builtin_amdgcn_global_load_lds(                                  \
        (const unsigned*)(ga[q] + (kt_) * 64),                                                                       \
        (__attribute__((address_space(3))) unsigned*)(nb_ + (wid * 4 + q) * 1024 + lane * 16), 16, 0, 0);            \
    _Pragma("unroll") for (int q = 0; q < 4; ++q) __builtin_amdgcn_global_load_lds(                                  \
        (const unsigned*)(gb[q] + (kt_) * 64),                                                                       \
        (__attribute__((address_space(3))) unsigned*)(nb_ + 32768 + (wid * 4 + q) * 1024 + lane * 16), 16, 0, 0);    \
  } while (0)
  if (!have_pref) GEMM8_ISSUE(0);
  for (int kt = 0; kt < nk; ++kt) {
    asm volatile("s_waitcnt vmcnt(0)" ::: "memory");
    __builtin_amdgcn_s_barrier();
    asm volatile("" ::: "memory");
    if (kt + 1 < nk) GEMM8_ISSUE(kt + 1);
    else if (An) {
#pragma unroll
      for (int q = 0; q < 4; ++q) {
        const int kc = lphys ^ ((4 * (q & 1) + lhi) & 7);
        __builtin_amdgcn_global_load_lds((const unsigned*)(An + (size_t)((wid * 4 + q) * 8 + lrow) * lda_n + kc * 8),
            (__attribute__((address_space(3))) unsigned*)(smem + (wid * 4 + q) * 1024 + lane * 16), 16, 0, 0);
        __builtin_amdgcn_global_load_lds((const unsigned*)(Bn + (size_t)((wid * 4 + q) * 8 + lrow) * ldb_n + kc * 8),
            (__attribute__((address_space(3))) unsigned*)(smem + 32768 + (wid * 4 + q) * 1024 + lane * 16), 16, 0, 0);
      }
    }
    const uint32_t sb = lds_base + (kt & 1) * STG;
#pragma unroll
    for (int ks = 0; ks < 2; ++ks) {
      const uint32_t chb = (uint32_t)(((ks * 4 + fq) ^ swz) * 16);
      const uint32_t aoff = sb + arow + chb, boff = sb + brow + chb;
      bf16x8 a0[4], a1[4], bb[4];
      a0[0] = lds_rd128<0>(aoff); a0[1] = lds_rd128<2048>(aoff);
      a0[2] = lds_rd128<4096>(aoff); a0[3] = lds_rd128<6144>(aoff);
      bb[0] = lds_rd128<0>(boff); bb[1] = lds_rd128<2048>(boff);
      bb[2] = lds_rd128<4096>(boff); bb[3] = lds_rd128<6144>(boff);
      a1[0] = lds_rd128<8192>(aoff); a1[1] = lds_rd128<10240>(aoff);
      a1[2] = lds_rd128<12288>(aoff); a1[3] = lds_rd128<14336>(aoff);
      asm volatile("s_waitcnt lgkmcnt(4)" : "+v"(a0[0]), "+v"(a0[1]), "+v"(a0[2]), "+v"(a0[3]),
                   "+v"(bb[0]), "+v"(bb[1]), "+v"(bb[2]), "+v"(bb[3]));
#pragma unroll
      for (int m = 0; m < 4; ++m)
#pragma unroll
        for (int n = 0; n < 4; ++n) {
          if (SWAP) acc[m][n] = __builtin_amdgcn_mfma_f32_16x16x32_bf16(bb[n], a0[m], acc[m][n], 0, 0, 0);
          else acc[m][n] = __builtin_amdgcn_mfma_f32_16x16x32_bf16(a0[m], bb[n], acc[m][n], 0, 0, 0);
        }
      asm volatile("s_waitcnt lgkmcnt(0)" : "+v"(a1[0]), "+v"(a1[1]), "+v"(a1[2]), "+v"(a1[3]));
#pragma unroll
      for (int m = 0; m < 4; ++m)
#pragma unroll
        for (int n = 0; n < 4; ++n) {
          if (SWAP) acc[4 + m][n] = __builtin_amdgcn_mfma_f32_16x16x32_bf16(bb[n], a1[m], acc[4 + m][n], 0, 0, 0);
          else acc[4 + m][n] = __builtin_amdgcn_mfma_f32_16x16x32_bf16(a1[m], bb[n], acc[4 + m][n], 0, 0, 0);
        }
    }
  }
#undef GEMM8_ISSUE
  __builtin_amdgcn_s_setprio(0);
}

struct NoRow { DEVI void operator()(int) const {} };
struct NoPair { static constexpr bool enabled = false; DEVI void operator()(int, int, f32x4, f32x4) const {} };

DEVI void store_pair_bf16(u16* rowp, int c, int fq, u32x2 p0, u32x2 p1) {
  const auto sx = __builtin_amdgcn_permlane16_swap(p0.x, p1.x, false, false);
  const auto sy = __builtin_amdgcn_permlane16_swap(p0.y, p1.y, false, false);
  u32x4 o;
  o.x = sx[0]; o.y = sy[0]; o.z = sx[1]; o.w = sy[1];
  const int col = (fq & 1) ? (c + 16 + (fq - 1) * 4) : (c + fq * 4);
  *(u32x4*)(rowp + col) = o;
}
DEVI u32x2 pack4bf(f32x4 v) { u32x2 o; o.x = pack2(v[0], v[1]); o.y = pack2(v[2], v[3]); return o; }
template <class F> struct PairEpi {
  static constexpr bool enabled = true;
  F f;
  DEVI void operator()(int r, int c, f32x4 a, f32x4 b) const { f(r, c, a, b); }
};
template <class F> DEVI PairEpi<F> make_pair_epi(F f) { return PairEpi<F>{f}; }

template <class EpiS, class EpiN, class RowEnd = NoRow, class EpiP = NoPair>
DEVI void gemm_phase8(int tid_, const u16* A, int lda, const u16* Bt, int ldb, int K, int M, int N, char* smem,
                      int ns_from, EpiS epiS, EpiN epiN, RowEnd rowEnd = NoRow(), int rot = 0, EpiP epiP = NoPair()) {
  const int nN = (N + 255) >> 8, nM = M >> 8;
  const int lane = tid_ & 63, wid = tid_ >> 6;
  const int wr = wid >> 2, wc = wid & 3, fr = lane & 15, fq = lane >> 4;
  const bool xmap = ((gridDim.x & 7) == 0) && ((nM & 7) == 0);
  const int xcd = blockIdx.x & 7;
  const int first = xmap ? (int)(blockIdx.x >> 3) : (int)((blockIdx.x + gridDim.x - rot) % gridDim.x);
  const int stride = xmap ? (int)(gridDim.x >> 3) : (int)gridDim.x;
  const int count = xmap ? (nM >> 3) * nN : nM * nN;
  bool pref = false;
  for (int it = first; it < count; it += stride) {
    const int tq = it / nN, tn = it - tq * nN;
    const int tm = xmap ? tq * 8 + xcd : tq;
    const int m0 = tm << 8, n0 = tn << 8;
    const int colb = n0 + wc * 64;
    const u16* An = nullptr; const u16* Bn = nullptr;
    if (it + stride < count) {
      const int it2 = it + stride;
      const int tq2 = it2 / nN, tn2 = it2 - tq2 * nN;
      An = A + (size_t)((xmap ? tq2 * 8 + xcd : tq2) << 8) * lda;
      Bn = Bt + (size_t)(tn2 << 8) * ldb;
    }
    f32x4 acc[8][4];
#pragma unroll
    for (int m = 0; m < 8; ++m)
#pragma unroll
      for (int n = 0; n < 4; ++n) acc[m][n] = (f32x4){0.f, 0.f, 0.f, 0.f};
    if (colb < ns_from) {
      gemm_kloop8<true>(launder(tid_), acc, A + (size_t)m0 * lda, lda, Bt + (size_t)n0 * ldb, ldb, K, smem, pref, An, lda, Bn, ldb);
      if (colb < N) {
        if (EpiP::enabled) {
#pragma unroll
          for (int m = 0; m < 8; ++m) {
            epiP(m0 + wr * 128 + m * 16 + fr, colb, acc[m][0], acc[m][1]);
            epiP(m0 + wr * 128 + m * 16 + fr, colb + 32, acc[m][2], acc[m][3]);
            rowEnd(m0 + wr * 128 + m * 16 + fr);
          }
        } else {
#pragma unroll
          for (int m = 0; m < 8; ++m) {
#pragma unroll
            for (int n = 0; n < 4; ++n) epiS(m0 + wr * 128 + m * 16 + fr, colb + n * 16 + fq * 4, acc[m][n]);
            rowEnd(m0 + wr * 128 + m * 16 + fr);
          }
        }
      }
    } else {
      gemm_kloop8<false>(launder(tid_), acc, A + (size_t)m0 * lda, lda, Bt + (size_t)n0 * ldb, ldb, K, smem, pref, An, lda, Bn, ldb);
      if (colb < N) {
#pragma unroll
        for (int m = 0; m < 8; ++m)
#pragma unroll
          for (int n = 0; n < 4; ++n) epiN(m0 + wr * 128 + m * 16 + fq * 4, colb + n * 16 + fr, acc[m][n]);
      }
    }
    pref = (An != nullptr);
  }
  asm volatile("s_waitcnt vmcnt(0)" ::: "memory");
}

DEVI void store4bf(u16* dst, f32x4 v) {
  u32x2 o;
  o.x = pack2(v[0], v[1]); o.y = pack2(v[2], v[3]);
  *(u32x2*)dst = o;
}

DEVI float rstd_of(const float* ssq, int r) { return rsqrtf(ssq[r] * (1.f / 1024.f) + 1e-6f); }

DEVI void phase_p_gemm(int tid_, const Params& p, char* smem, const float* ssq) {
  u16* WB = (u16*)(p.ws + OFF_WB);
  const u16* H = (const u16*)(p.ws + OFF_H);
  u16* PR = (u16*)(p.ws + OFF_PR);
  u16* NQ = (u16*)(p.ws + OFF_NQ);
  u16* NK = (u16*)(p.ws + OFF_NK);
  u16* NVT = (u16*)(p.ws + OFF_NV);
  gemm_phase8(tid_, H, 1024, WB + W_IN, 1024, 1024, NTOK, 3456, smem, 2944,
    [&](int r, int c0, f32x4 v) {
      v = v * rstd_of(ssq, r);
      if (c0 < 1920) store4bf(PR + (size_t)r * PRW + c0, v);
      else if (c0 < 2432) store4bf(NQ + (size_t)r * 512 + (c0 - 1920), v);
      else store4bf(NK + (size_t)r * 512 + (c0 - 2432), v);
    },
    [&](int r0, int c, f32x4 v) {
      const int cc = c - 2944;
      const int s = r0 >> 12, t = r0 & 4095;
      const f32x4 q = *(const f32x4*)(ssq + r0);
#pragma unroll
      for (int j = 0; j < 4; ++j) v[j] *= rsqrtf(q[j] * (1.f / 1024.f) + 1e-6f);
      store4bf(NVT + ((size_t)(s * 512 + cc)) * 4096 + t, v);
    }, NoRow(), 0,
    make_pair_epi([&](int r, int c, f32x4 va, f32x4 vb) {
      const float rs = rstd_of(ssq, r);
      u16* rowp; int cl;
      if (c < 1920) { rowp = PR + (size_t)r * PRW; cl = c; }
      else if (c < 2432) { rowp = NQ + (size_t)r * 512; cl = c - 1920; }
      else { rowp = NK + (size_t)r * 512; cl = c - 2432; }
      store_pair_bf16(rowp, cl, (tid_ & 63) >> 4, pack4bf(va * rs), pack4bf(vb * rs));
    }));
  const u16* MH = (const u16*)(p.ws + OFF_MEMH);
  u16* KVK = (u16*)(p.ws + OFF_KVK);
  u16* KVT = (u16*)(p.ws + OFF_KVT);
  gemm_phase8(tid_, MH, 1024, WB + W_XKV, 1024, 1024, 3072, 2048, smem, 1024,
    [&](int r, int c0, f32x4 v) { store4bf(KVK + (size_t)r * 1024 + c0, v); },
    [&](int r0, int c, f32x4 v) {
      const int cc = c - 1024;
      const int s = r0 >> 8, m = r0 & 255;
      store4bf(KVT + ((size_t)(s * 1024 + cc)) * 256 + m, v);
    }, NoRow(), 128);
}

DEVI void phase_nat(int tid_, const Params& p, int l, char* smem, int bfirst, int bstride) {
  u16* NQ = (u16*)(p.ws + OFF_NQ);
  const u16* NK = (const u16*)(p.ws + OFF_NK);
  const u16* NVT = (const u16*)(p.ws + OFF_NV);
  const float* rpb = p.in[I_RPB] + (size_t)l * 8 * 15 * 31;
  const int lane = tid_ & 63, g = tid_ >> 6, fr = lane & 15, fq = lane >> 4;
  u16* Pw = (u16*)smem + g * (16 * 264);
  const int cb = (g == 0) ? 0 : (g == 1) ? 8 : (g == 2) ? 24 : 32;
  const int c = g * 16 + fr;
  int cs = c - 8; cs = cs < 0 ? 0 : (cs > 48 ? 48 : cs);
  for (int t = bfirst; t < 12 * 64 * 8; t += bstride) {
    const int h = t & 7, ri = (t >> 3) & 63, s = t >> 9;
    int rs = ri - 4; rs = rs < 0 ? 0 : (rs > 56 ? 56 : rs);
    const size_t tokq = (size_t)s * 4096 + ri * 64 + g * 16;
    bf16x8 aq[2];
    aq[0] = *(const bf16x8*)(NQ + (tokq + fr) * 512 + h * 64 + fq * 8);
    aq[1] = *(const bf16x8*)(NQ + (tokq + fr) * 512 + h * 64 + 32 + fq * 8);
    f32x4 acc[16];
#pragma unroll
    for (int n = 0; n < 16; ++n) {
      acc[n] = (f32x4){0.f, 0.f, 0.f, 0.f};
      const int r = n >> 1, col = cb + (n & 1) * 16 + fr;
      const u16* kp = NK + ((size_t)s * 4096 + (rs + r) * 64 + col) * 512 + h * 64 + fq * 8;
      const bf16x8 b0 = *(const bf16x8*)kp;
      const bf16x8 b1 = *(const bf16x8*)(kp + 32);
      acc[n] = __builtin_amdgcn_mfma_f32_16x16x32_bf16(b0, aq[0], acc[n], 0, 0, 0);
      acc[n] = __builtin_amdgcn_mfma_f32_16x16x32_bf16(b1, aq[1], acc[n], 0, 0, 0);
    }
    float m = -1e30f;
#pragma unroll
    for (int n = 0; n < 16; ++n) {
      const int di = rs + (n >> 1) - ri + 7;
      const float* brow = rpb + (h * 15 + di) * 31 + 15 - c;
#pragma unroll
      for (int j = 0; j < 4; ++j) {
        const int kc = cb + (n & 1) * 16 + fq * 4 + j;
        float sc = -1e30f;
        if (kc >= cs && kc < cs + 16) sc = acc[n][j] * 0.125f + brow[kc];
        acc[n][j] = sc;
        m = fmaxf(m, sc);
      }
    }
    m = red4x_max(m);
    float ssum = 0.f;
#pragma unroll
    for (int n = 0; n < 16; ++n) {
      f32x4 e;
#pragma unroll
      for (int j = 0; j < 4; ++j) { e[j] = __expf(acc[n][j] - m); ssum += e[j]; }
      store4bf(Pw + fr * 264 + n * 16 + fq * 4, e);
    }
    const float sm = 1.f / red4x_sum(ssum);
    f32x4 o[4];
#pragma unroll
    for (int n = 0; n < 4; ++n) o[n] = (f32x4){0.f, 0.f, 0.f, 0.f};
#pragma unroll
    for (int ks = 0; ks < 8; ++ks) {
      const bf16x8 ap = *(const bf16x8*)(Pw + fr * 264 + ks * 32 + fq * 8);
#pragma unroll
      for (int n = 0; n < 4; ++n) {
        const bf16x8 bv = *(const bf16x8*)(NVT + ((size_t)(s * 512 + h * 64 + n * 16 + fr)) * 4096 + (rs + ks) * 64 + cb + fq * 8);
        o[n] = __builtin_amdgcn_mfma_f32_16x16x32_bf16(bv, ap, o[n], 0, 0, 0);
      }
    }
#pragma unroll
    for (int n = 0; n < 4; n += 2)
      store_pair_bf16(NQ + (tokq + fr) * 512 + h * 64, n * 16, fq, pack4bf(o[n] * sm), pack4bf(o[n + 1] * sm));
  }
}

constexpr int SC_OPS = 0;
constexpr int SC_VV = 40960;
constexpr int SC_WR = 49152;
constexpr int SC_AP = 57344;
constexpr int SC_TW = 65536;
constexpr int SC_AD = 70144;
constexpr int SC_NRM = 74752;
constexpr int SC_MU = 74880;
constexpr int SC_CST = 77440;

typedef __attribute__((ext_vector_type(2))) float f32x2;

template <int CTRL>
DEVI float dpp_mov(float x) {
  return __int_as_float(__builtin_amdgcn_update_dpp(0, __float_as_int(x), CTRL, 0xF, 0xF, true));
}
DEVI float red8(float x) {
  x += dpp_mov<0xB1>(x);
  x += dpp_mov<0x4E>(x);
  x += dpp_mov<0x141>(x);
  return x;
}
DEVI f32x2 lo2(f32x4 v) { return __builtin_shufflevector(v, v, 0, 1); }
DEVI f32x2 hi2(f32x4 v) { return __builtin_shufflevector(v, v, 2, 3); }

struct ScanOps {
  f32x2 a[4], w[4], b[4], k[4], r[4];
  float v0, v1;
};
DEVI void scan_load(ScanOps& o, const float* OPS, const float* VV, int nn, int jg, int i0) {
  const float* base = OPS + nn * 64 + jg * 8;
  f32x4 t0, t1;
  t0 = *(const f32x4*)(base); t1 = *(const f32x4*)(base + 4);
  o.a[0] = lo2(t0); o.a[1] = hi2(t0); o.a[2] = lo2(t1); o.a[3] = hi2(t1);
  t0 = *(const f32x4*)(base + 2048); t1 = *(const f32x4*)(base + 2048 + 4);
  o.w[0] = lo2(t0); o.w[1] = hi2(t0); o.w[2] = lo2(t1); o.w[3] = hi2(t1);
  t0 = *(const f32x4*)(base + 4096); t1 = *(const f32x4*)(base + 4096 + 4);
  o.b[0] = lo2(t0); o.b[1] = hi2(t0); o.b[2] = lo2(t1); o.b[3] = hi2(t1);
  t0 = *(const f32x4*)(base + 6144); t1 = *(const f32x4*)(base + 6144 + 4);
  o.k[0] = lo2(t0); o.k[1] = hi2(t0); o.k[2] = lo2(t1); o.k[3] = hi2(t1);
  t0 = *(const f32x4*)(base + 8192); t1 = *(const f32x4*)(base + 8192 + 4);
  o.r[0] = lo2(t0); o.r[1] = hi2(t0); o.r[2] = lo2(t1); o.r[3] = hi2(t1);
  o.v0 = VV[nn * 64 + i0];
  o.v1 = VV[nn * 64 + i0 + 8];
}
DEVI void scan_step(const ScanOps& o, f32x2 (&S0)[4], f32x2 (&S1)[4], float* YL, int nn, int jg, int i0) {
  f32x2 d0 = S0[0] * o.a[0], d0b = S0[2] * o.a[2];
  f32x2 d1 = S1[0] * o.a[0], d1b = S1[2] * o.a[2];
  d0 = S0[1] * o.a[1] + d0; d0b = S0[3] * o.a[3] + d0b;
  d1 = S1[1] * o.a[1] + d1; d1b = S1[3] * o.a[3] + d1b;
  d0 += d0b; d1 += d1b;
  const float sa0 = red8(d0.x + d0.y);
  const float sa1 = red8(d1.x + d1.y);
  f32x2 e0 = {0.f, 0.f}, e1 = {0.f, 0.f};
#pragma unroll
  for (int q = 0; q < 4; ++q) {
    const f32x2 u0 = sa0 * o.b[q] + o.v0 * o.k[q];
    const f32x2 u1 = sa1 * o.b[q] + o.v1 * o.k[q];
    S0[q] = S0[q] * o.w[q] + u0;
    S1[q] = S1[q] * o.w[q] + u1;
    e0 = S0[q] * o.r[q] + e0;
    e1 = S1[q] * o.r[q] + e1;
  }
  const float y0 = red8(e0.x + e0.y);
  const float y1 = red8(e1.x + e1.y);
  YL[nn * 64 + i0] = y0; YL[nn * 64 + i0 + 8] = y1;
}

DEVI void phase_scan(int tid_, const Params& p, int l, char* smem, int bfirst, int bstride) {
  const u16* PR = (const u16*)(p.ws + OFF_PR);
  _Float16* YF = (_Float16*)(p.ws + OFF_H);
  _Float16* YB = (_Float16*)(p.ws + OFF_H + (size_t)NTOK * 512 * 2);
  float* BON = (float*)(p.ws + OFF_BONUS);
  const u16* WB = (const u16*)(p.ws + OFF_WB);
  float* OPS = (float*)(smem + SC_OPS);
  u16* RAW = (u16*)(smem + SC_OPS);
  float* VV = (float*)(smem + SC_VV);
  float* WR = (float*)(smem + SC_WR);
  float* AP = (float*)(smem + SC_AP);
  float* YL = WR;
  u16* TWb = (u16*)(smem + SC_TW);
  u16* ADb = (u16*)(smem + SC_AD);
  float* NRM = (float*)(smem + SC_NRM);
  float* MU = (float*)(smem + SC_MU);
  float* CST = (float*)(smem + SC_CST);
  const float* mu_p = p.in[I_MU_PREV] + (size_t)l * 1920;
  const float* mu_n = p.in[I_MU_NEXT] + (size_t)l * 1920;
  const int tid = tid_, lane = tid & 63, w = tid >> 6, fr = lane & 15, fq = lane >> 4;
  const int pn = tid >> 3, j0 = (tid & 7) * 8;
  const int jg = lane & 7, i0 = w * 16 + (lane >> 3);
  const int hr = (tid >= 40) ? 1 : 0, hc = tid - hr * 40;
  for (int blk = bfirst; blk < 192; blk += bstride) {
    const int s = blk >> 4, h = (blk >> 1) & 7, d = blk & 1;
    __syncthreads();
    for (int i = tid; i < 640; i += 256) {
      const int which = (i >= 320) ? 1 : 0, c = i - which * 320;
      const int g = c >> 6, e = c & 63;
      const int col = (g < 3) ? (g * 512 + h * 64 + e) : (1536 + (g - 3) * 128 + d * 64 + e);
      MU[i] = which ? mu_n[col] : mu_p[col];
    }
    for (int i = tid; i < 320; i += 256) {
      const int which = i >> 6, e = i & 63;
      float v;
      if (which == 0) v = p.in[I_W0][(size_t)(l * 2 + d) * 512 + h * 64 + e];
      else if (which == 1) v = p.in[I_A0][(size_t)(l * 2 + d) * 512 + h * 64 + e];
      else if (which == 2) v = p.in[I_K_K][(size_t)l * 512 + h * 64 + e];
      else if (which == 3) v = p.in[I_K_A][(size_t)l * 512 + h * 64 + e];
      else v = p.in[I_R_K][(size_t)(l * 8 + h) * 64 + e];
      CST[i] = v;
    }
    bf16x8 bw[2], ba[2];
#pragma unroll
    for (int ks = 0; ks < 2; ++ks) {
      bw[ks] = *(const bf16x8*)(WB + W_WUP + (size_t)(d * 512 + h * 64 + w * 16 + fr) * 64 + ks * 32 + fq * 8);
      ba[ks] = *(const bf16x8*)(WB + W_AUP + (size_t)(d * 512 + h * 64 + w * 16 + fr) * 64 + ks * 32 + fq * 8);
    }
    _Float16* Y = d ? YB : YF;
    f32x2 S0[4], S1[4];
#pragma unroll
    for (int q = 0; q < 4; ++q) { S0[q] = (f32x2){0.f, 0.f}; S1[q] = (f32x2){0.f, 0.f}; }
    u32x4 G[5], GH;
    {
      const int t = d ? (4095 - pn) : pn;
      const size_t tok = (size_t)s * 4096 + t;
#pragma unroll
      for (int g = 0; g < 5; ++g) {
        const int col = (g < 3) ? (g * 512 + h * 64) : (1536 + (g - 3) * 128 + d * 64);
        G[g] = *(const u32x4*)(PR + tok * PRW + col + j0);
      }
      GH = (u32x4){0u, 0u, 0u, 0u};
      if (tid < 80) {
        const int tlo = d ? (4095 - 31) : 0;
        const int th = hr ? (tlo + 32) : (tlo - 1);
        const int g = hc >> 3;
        const int col = (g < 3) ? (g * 512 + h * 64) : (1536 + (g - 3) * 128 + d * 64);
        if (th >= 0 && th <= 4095) GH = *(const u32x4*)(PR + ((size_t)s * 4096 + th) * PRW + col + (hc & 7) * 8);
      }
    }
#pragma unroll 1
    for (int ch = 0; ch < 128; ++ch) {
      const int n = ch * 32 + pn;
      const int t = d ? (4095 - n) : n;
      const size_t tok = (size_t)s * 4096 + t;
      const int tlo = d ? (4095 - (ch * 32 + 31)) : (ch * 32);
      const int rrow = t - tlo + 1;
#pragma unroll
      for (int g = 0; g < 5; ++g) *(u32x4*)(RAW + rrow * 320 + g * 64 + j0) = G[g];
      if (tid < 80) *(u32x4*)(RAW + (hr ? 33 : 0) * 320 + (hc >> 3) * 64 + (hc & 7) * 8) = GH;
      __syncthreads();
      if (ch + 1 < 128) {
        const int n2 = n + 32;
        const int t2 = d ? (4095 - n2) : n2;
        const size_t tok2 = (size_t)s * 4096 + t2;
#pragma unroll
        for (int g = 0; g < 5; ++g) {
          const int col = (g < 3) ? (g * 512 + h * 64) : (1536 + (g - 3) * 128 + d * 64);
          G[g] = *(const u32x4*)(PR + tok2 * PRW + col + j0);
        }
        GH = (u32x4){0u, 0u, 0u, 0u};
        if (tid < 80) {
          const int tlo2 = d ? (tlo - 32) : (tlo + 32);
          const int th = hr ? (tlo2 + 32) : (tlo2 - 1);
          const int g = hc >> 3;
          const int col = (g < 3) ? (g * 512 + h * 64) : (1536 + (g - 3) * 128 + d * 64);
          if (th >= 0 && th <= 4095) GH = *(const u32x4*)(PR + ((size_t)s * 4096 + th) * PRW + col + (hc & 7) * 8);
        }
      }
#pragma unroll
      for (int g = 0; g < 5; ++g) {
        float cur[8], prv[8], nxt[8];
        load8bf(RAW + rrow * 320 + g * 64 + j0, cur);
        load8bf(RAW + (rrow - 1) * 320 + g * 64 + j0, prv);
        load8bf(RAW + (rrow + 1) * 320 + g * 64 + j0, nxt);
        const f32x4 mp0 = *(const f32x4*)(MU + g * 64 + j0), mp1 = *(const f32x4*)(MU + g * 64 + j0 + 4);
        const f32x4 mn0 = *(const f32x4*)(MU + 320 + g * 64 + j0), mn1 = *(const f32x4*)(MU + 320 + g * 64 + j0 + 4);
        f32x4 x0, x1;
#pragma unroll
        for (int e = 0; e < 4; ++e) {
          x0[e] = cur[e] + mp0[e] * (prv[e] - cur[e]) + mn0[e] * (nxt[e] - cur[e]);
          x1[e] = cur[4 + e] + mp1[e] * (prv[4 + e] - cur[4 + e]) + mn1[e] * (nxt[4 + e] - cur[4 + e]);
        }
        if (g == 0) {
          *(f32x4*)(OPS + 4 * 2048 + pn * 64 + j0) = x0; *(f32x4*)(OPS + 4 * 2048 + pn * 64 + j0 + 4) = x1;
        } else if (g == 1) {
          *(f32x4*)(OPS + 3 * 2048 + pn * 64 + j0) = x0; *(f32x4*)(OPS + 3 * 2048 + pn * 64 + j0 + 4) = x1;
          const f32x4 kk0 = *(const f32x4*)(CST + 128 + j0), kk1 = *(const f32x4*)(CST + 128 + j0 + 4);
          float ss = 0.f;
#pragma unroll
          for (int e = 0; e < 4; ++e) { const float a_ = x0[e] * kk0[e], b_ = x1[e] * kk1[e]; ss += a_ * a_ + b_ * b_; }
          ss = red8(ss);
          if ((tid & 7) == 0) NRM[pn] = frcp(fmaxf(__builtin_amdgcn_sqrtf(ss), 1e-12f));
        } else if (g == 2) {
          *(f32x4*)(VV + pn * 64 + j0) = x0; *(f32x4*)(VV + pn * 64 + j0 + 4) = x1;
        } else if (g == 3) {
          u32x4 pk;
          pk.x = pack2(ftanh(x0[0]), ftanh(x0[1])); pk.y = pack2(ftanh(x0[2]), ftanh(x0[3]));
          pk.z = pack2(ftanh(x1[0]), ftanh(x1[1])); pk.w = pack2(ftanh(x1[2]), ftanh(x1[3]));
          *(u32x4*)(TWb + pn * 72 + j0) = pk;
        } else {
          u32x4 pk;
          pk.x = pack2(x0[0], x0[1]); pk.y = pack2(x0[2], x0[3]);
          pk.z = pack2(x1[0], x1[1]); pk.w = pack2(x1[2], x1[3]);
          *(u32x4*)(ADb + pn * 72 + j0) = pk;
        }
      }
      __syncthreads();
#pragma unroll
      for (int m = 0; m < 2; ++m) {
        f32x4 cw = {0.f, 0.f, 0.f, 0.f}, ca = {0.f, 0.f, 0.f, 0.f};
#pragma unroll
        for (int ks = 0; ks < 2; ++ks) {
          const bf16x8 aw = *(const bf16x8*)(TWb + (m * 16 + fr) * 72 + ks * 32 + fq * 8);
          const bf16x8 aa = *(const bf16x8*)(ADb + (m * 16 + fr) * 72 + ks * 32 + fq * 8);
          cw = __builtin_amdgcn_mfma_f32_16x16x32_bf16(aw, bw[ks], cw, 0, 0, 0);
          ca = __builtin_amdgcn_mfma_f32_16x16x32_bf16(aa, ba[ks], ca, 0, 0, 0);
        }
#pragma unroll
        for (int jj = 0; jj < 4; ++jj) {
          WR[(m * 16 + fq * 4 + jj) * 64 + w * 16 + fr] = cw[jj];
          AP[(m * 16 + fq * 4 + jj) * 64 + w * 16 + fr] = ca[jj];
        }
      }
      __syncthreads();
      {
        const float inv = NRM[pn];
        float bsum = 0.f;
#pragma unroll
        for (int hq = 0; hq < 2; ++hq) {
          const int jb = j0 + hq * 4;
          const f32x4 wr_ = *(const f32x4*)(WR + pn * 64 + jb) + *(const f32x4*)(CST + jb);
          const f32x4 ap_ = *(const f32x4*)(AP + pn * 64 + jb) + *(const f32x4*)(CST + 64 + jb);
          const f32x4 kr = *(const f32x4*)(OPS + 3 * 2048 + pn * 64 + jb);
          const f32x4 rr = *(const f32x4*)(OPS + 4 * 2048 + pn * 64 + jb);
          const f32x4 kkw = *(const f32x4*)(CST + 128 + jb), kaw = *(const f32x4*)(CST + 192 + jb), rkw = *(const f32x4*)(CST + 256 + jb);
          f32x4 o0, o1, o2, o3;
#pragma unroll
          for (int e = 0; e < 4; ++e) {
            const float sw = sigm(wr_[e]);
            const float dec = __expf(-0.6065306597126334f * sw);
            const float av = sigm(ap_[e]);
            const float kn = kr[e] * kkw[e] * inv;
            const float kd = kr[e] * (1.f + (av - 1.f) * kaw[e]);
            bsum += rr[e] * kd * rkw[e];
            o0[e] = -kn; o1[e] = dec; o2[e] = kn * av; o3[e] = kd;
          }
          *(f32x4*)(OPS + 0 * 2048 + pn * 64 + jb) = o0;
          *(f32x4*)(OPS + 1 * 2048 + pn * 64 + jb) = o1;
          *(f32x4*)(OPS + 2 * 2048 + pn * 64 + jb) = o2;
          *(f32x4*)(OPS + 3 * 2048 + pn * 64 + jb) = o3;
        }
        bsum = red8(bsum);
        if ((tid & 7) == 0) BON[(tok * 8 + h) * 2 + d] = bsum;
      }
      __syncthreads();
      {
        ScanOps oa, ob;
        scan_load(oa, OPS, VV, 0, jg, i0);
#pragma unroll 1
        for (int nn = 0; nn < 32; nn += 2) {
          scan_load(ob, OPS, VV, nn + 1, jg, i0);
          scan_step(oa, S0, S1, YL, nn, jg, i0);
          scan_load(oa, OPS, VV, (nn + 2) & 31, jg, i0);
          scan_step(ob, S0, S1, YL, nn + 1, jg, i0);
        }
      }
      __syncthreads();
      {
        h16x8 o;
#pragma unroll
        for (int e = 0; e < 8; ++e) o[e] = (_Float16)YL[pn * 64 + j0 + e];
        *(h16x8*)(Y + tok * 512 + h * 64 + j0) = o;
      }
    }
    __syncthreads();
  }
}

struct ScanOps1 {
  f32x2 a[4], w[4], b[4], k[4], r[4];
  float v0;
};
DEVI void scan_load1(ScanOps1& o, const float* OPS, const float* VV, int nn, int jg, int i0) {
  const float* base = OPS + nn * 64 + jg * 8;
  f32x4 t0, t1;
  t0 = *(const f32x4*)(base); t1 = *(const f32x4*)(base + 4);
  o.a[0] = lo2(t0); o.a[1] = hi2(t0); o.a[2] = lo2(t1); o.a[3] = hi2(t1);
  t0 = *(const f32x4*)(base + 2048); t1 = *(const f32x4*)(base + 2048 + 4);
  o.w[0] = lo2(t0); o.w[1] = hi2(t0); o.w[2] = lo2(t1); o.w[3] = hi2(t1);
  t0 = *(const f32x4*)(base + 4096); t1 = *(const f32x4*)(base + 4096 + 4);
  o.b[0] = lo2(t0); o.b[1] = hi2(t0); o.b[2] = lo2(t1); o.b[3] = hi2(t1);
  t0 = *(const f32x4*)(base + 6144); t1 = *(const f32x4*)(base + 6144 + 4);
  o.k[0] = lo2(t0); o.k[1] = hi2(t0); o.k[2] = lo2(t1); o.k[3] = hi2(t1);
  t0 = *(const f32x4*)(base + 8192); t1 = *(const f32x4*)(base + 8192 + 4);
  o.r[0] = lo2(t0); o.r[1] = hi2(t0); o.r[2] = lo2(t1); o.r[3] = hi2(t1);
  o.v0 = VV[nn * 64 + i0];
}
DEVI void scan_step1(const ScanOps1& o, f32x2 (&S0)[4], float* YL, int nn, int jg, int i0) {
  f32x2 d0 = S0[0] * o.a[0], d0b = S0[2] * o.a[2];
  d0 = S0[1] * o.a[1] + d0; d0b = S0[3] * o.a[3] + d0b;
  d0 += d0b;
  const float sa0 = red8(d0.x + d0.y);
  f32x2 e0 = {0.f, 0.f};
#pragma unroll
  for (int q = 0; q < 4; ++q) {
    const f32x2 u0 = sa0 * o.b[q] + o.v0 * o.k[q];
    S0[q] = S0[q] * o.w[q] + u0;
    e0 = S0[q] * o.r[q] + e0;
  }
  const float y0 = red8(e0.x + e0.y);
  if (jg == 0) YL[nn * 64 + i0] = y0;
}
DEVI float red16d(float x) {
  x += dpp_mov<0xB1>(x);
  x += dpp_mov<0x4E>(x);
  x += dpp_mov<0x141>(x);
  x += dpp_mov<0x140>(x);
  return x;
}
DEVI void unpack4(u32x2 u, float* o) {
  o[0] = __uint_as_float(u.x << 16); o[1] = __uint_as_float(u.x & 0xffff0000u);
  o[2] = __uint_as_float(u.y << 16); o[3] = __uint_as_float(u.y & 0xffff0000u);
}

DEVI void phase_scan8(int tid_, const Params& p, int l, char* smem, int bfirst, int bstride) {
  const u16* PR = (const u16*)(p.ws + OFF_PR);
  _Float16* YF = (_Float16*)(p.ws + OFF_H);
  _Float16* YB = (_Float16*)(p.ws + OFF_H + (size_t)NTOK * 512 * 2);
  float* BON = (float*)(p.ws + OFF_BONUS);
  const u16* WB = (const u16*)(p.ws + OFF_WB);
  float* OPS = (float*)(smem + SC_OPS);
  u16* RAW = (u16*)(smem + SC_OPS);
  float* VV = (float*)(smem + SC_VV);
  float* WR = (float*)(smem + SC_WR);
  float* AP = (float*)(smem + SC_AP);
  float* YL = WR;
  u16* TWb = (u16*)(smem + SC_TW);
  u16* ADb = (u16*)(smem + SC_AD);
  float* NRM = (float*)(smem + SC_NRM);
  float* MU = (float*)(smem + SC_MU);
  float* CST = (float*)(smem + SC_CST);
  const float* mu_p = p.in[I_MU_PREV] + (size_t)l * 1920;
  const float* mu_n = p.in[I_MU_NEXT] + (size_t)l * 1920;
  const int tid = tid_, lane = tid & 63, w = tid >> 6, fr = lane & 15, fq = lane >> 4;
  const int pn = tid >> 4, j0 = (tid & 15) * 4;
  const int jg = lane & 7, i0 = w * 8 + (lane >> 3);
  const int hr = (tid >= 80) ? 1 : 0, hc = tid - hr * 80;
  const int wm = w >> 2, wn = w & 3;
  for (int blk = bfirst; blk < 192; blk += bstride) {
    const int s = blk >> 4, h = (blk >> 1) & 7, d = blk & 1;
    __syncthreads();
    for (int i = tid; i < 640; i += 512) {
      const int which = (i >= 320) ? 1 : 0, c = i - which * 320;
      const int g = c >> 6, e = c & 63;
      const int col = (g < 3) ? (g * 512 + h * 64 + e) : (1536 + (g - 3) * 128 + d * 64 + e);
      MU[i] = which ? mu_n[col] : mu_p[col];
    }
    if (tid < 320) {
      const int which = tid >> 6, e = tid & 63;
      float v;
      if (which == 0) v = p.in[I_W0][(size_t)(l * 2 + d) * 512 + h * 64 + e];
      else if (which == 1) v = p.in[I_A0][(size_t)(l * 2 + d) * 512 + h * 64 + e];
      else if (which == 2) v = p.in[I_K_K][(size_t)l * 512 + h * 64 + e];
      else if (which == 3) v = p.in[I_K_A][(size_t)l * 512 + h * 64 + e];
      else v = p.in[I_R_K][(size_t)(l * 8 + h) * 64 + e];
      CST[tid] = v;
    }
    bf16x8 bw[2], ba[2];
#pragma unroll
    for (int ks = 0; ks < 2; ++ks) {
      bw[ks] = *(const bf16x8*)(WB + W_WUP + (size_t)(d * 512 + h * 64 + wn * 16 + fr) * 64 + ks * 32 + fq * 8);
      ba[ks] = *(const bf16x8*)(WB + W_AUP + (size_t)(d * 512 + h * 64 + wn * 16 + fr) * 64 + ks * 32 + fq * 8);
    }
    _Float16* Y = d ? YB : YF;
    f32x2 S0[4];
#pragma unroll
    for (int q = 0; q < 4; ++q) S0[q] = (f32x2){0.f, 0.f};
    u32x2 G[5], GH;
    {
      const int t = d ? (4095 - pn) : pn;
      const size_t tok = (size_t)s * 4096 + t;
#pragma unroll
      for (int g = 0; g < 5; ++g) {
        const int col = (g < 3) ? (g * 512 + h * 64) : (1536 + (g - 3) * 128 + d * 64);
        G[g] = *(const u32x2*)(PR + tok * PRW + col + j0);
      }
      GH = (u32x2){0u, 0u};
      if (tid < 160) {
        const int tlo = d ? (4095 - 31) : 0;
        const int th = hr ? (tlo + 32) : (tlo - 1);
        const int g = hc >> 4;
        const int col = (g < 3) ? (g * 512 + h * 64) : (1536 + (g - 3) * 128 + d * 64);
        if (th >= 0 && th <= 4095) GH = *(const u32x2*)(PR + ((size_t)s * 4096 + th) * PRW + col + (hc & 15) * 4);
      }
    }
#pragma unroll 1
    for (int ch = 0; ch < 128; ++ch) {
      const int n = ch * 32 + pn;
      const int t = d ? (4095 - n) : n;
      const size_t tok = (size_t)s * 4096 + t;
      const int tlo = d ? (4095 - (ch * 32 + 31)) : (ch * 32);
      const int rrow = t - tlo + 1;
#pragma unroll
      for (int g = 0; g < 5; ++g) *(u32x2*)(RAW + rrow * 320 + g * 64 + j0) = G[g];
      if (tid < 160) *(u32x2*)(RAW + (hr ? 33 : 0) * 320 + (hc >> 4) * 64 + (hc & 15) * 4) = GH;
      __syncthreads();
      if (ch + 1 < 128) {
        const int n2 = n + 32;
        const int t2 = d ? (4095 - n2) : n2;
        const size_t tok2 = (size_t)s * 4096 + t2;
#pragma unroll
        for (int g = 0; g < 5; ++g) {
          const int col = (g < 3) ? (g * 512 + h * 64) : (1536 + (g - 3) * 128 + d * 64);
          G[g] = *(const u32x2*)(PR + tok2 * PRW + col + j0);
        }
        GH = (u32x2){0u, 0u};
        if (tid < 160) {
          const int tlo2 = d ? (tlo - 32) : (tlo + 32);
          const int th = hr ? (tlo2 + 32) : (tlo2 - 1);
          const int g = hc >> 4;
          const int col = (g < 3) ? (g * 512 + h * 64) : (1536 + (g - 3) * 128 + d * 64);
          if (th >= 0 && th <= 4095) GH = *(const u32x2*)(PR + ((size_t)s * 4096 + th) * PRW + col + (hc & 15) * 4);
        }
      }
#pragma unroll
      for (int g = 0; g < 5; ++g) {
        float cur[4], prv[4], nxt[4];
        unpack4(*(const u32x2*)(RAW + rrow * 320 + g * 64 + j0), cur);
        unpack4(*(const u32x2*)(RAW + (rrow - 1) * 320 + g * 64 + j0), prv);
        unpack4(*(const u32x2*)(RAW + (rrow + 1) * 320 + g * 64 + j0), nxt);
        const f32x4 mp0 = *(const f32x4*)(MU + g * 64 + j0);
        const f32x4 mn0 = *(const f32x4*)(MU + 320 + g * 64 + j0);
        f32x4 x0;
#pragma unroll
        for (int e = 0; e < 4; ++e) x0[e] = cur[e] + mp0[e] * (prv[e] - cur[e]) + mn0[e] * (nxt[e] - cur[e]);
        if (g == 0) {
          *(f32x4*)(OPS + 4 * 2048 + pn * 64 + j0) = x0;
        } else if (g == 1) {
          *(f32x4*)(OPS + 3 * 2048 + pn * 64 + j0) = x0;
          const f32x4 kk0 = *(const f32x4*)(CST + 128 + j0);
          float ss = 0.f;
#pragma unroll
          for (int e = 0; e < 4; ++e) { const float a_ = x0[e] * kk0[e]; ss += a_ * a_; }
          ss = red16d(ss);
          if ((tid & 15) == 0) NRM[pn] = frcp(fmaxf(__builtin_amdgcn_sqrtf(ss), 1e-12f));
        } else if (g == 2) {
          *(f32x4*)(VV + pn * 64 + j0) = x0;
        } else if (g == 3) {
          u32x2 pk;
          pk.x = pack2(ftanh(x0[0]), ftanh(x0[1])); pk.y = pack2(ftanh(x0[2]), ftanh(x0[3]));
          *(u32x2*)(TWb + pn * 72 + j0) = pk;
        } else {
          u32x2 pk;
          pk.x = pack2(x0[0], x0[1]); pk.y = pack2(x0[2], x0[3]);
          *(u32x2*)(ADb + pn * 72 + j0) = pk;
        }
      }
      __syncthreads();
      {
        f32x4 cw = {0.f, 0.f, 0.f, 0.f}, ca = {0.f, 0.f, 0.f, 0.f};
#pragma unroll
        for (int ks = 0; ks < 2; ++ks) {
          const bf16x8 aw = *(const bf16x8*)(TWb + (wm * 16 + fr) * 72 + ks * 32 + fq * 8);
          const bf16x8 aa = *(const bf16x8*)(ADb + (wm * 16 + fr) * 72 + ks * 32 + fq * 8);
          cw = __builtin_amdgcn_mfma_f32_16x16x32_bf16(aw, bw[ks], cw, 0, 0, 0);
          ca = __builtin_amdgcn_mfma_f32_16x16x32_bf16(aa, ba[ks], ca, 0, 0, 0);
        }
#pragma unroll
        for (int jj = 0; jj < 4; ++jj) {
          WR[(wm * 16 + fq * 4 + jj) * 64 + wn * 16 + fr] = cw[jj];
          AP[(wm * 16 + fq * 4 + jj) * 64 + wn * 16 + fr] = ca[jj];
        }
      }
      __syncthreads();
      {
        const float inv = NRM[pn];
        float bsum = 0.f;
        const f32x4 wr_ = *(const f32x4*)(WR + pn * 64 + j0) + *(const f32x4*)(CST + j0);
        const f32x4 ap_ = *(const f32x4*)(AP + pn * 64 + j0) + *(const f32x4*)(CST + 64 + j0);
        const f32x4 kr = *(const f32x4*)(OPS + 3 * 2048 + pn * 64 + j0);
        const f32x4 rr = *(const f32x4*)(OPS + 4 * 2048 + pn * 64 + j0);
        const f32x4 kkw = *(const f32x4*)(CST + 128 + j0), kaw = *(const f32x4*)(CST + 192 + j0), rkw = *(const f32x4*)(CST + 256 + j0);
        f32x4 o0, o1, o2, o3;
#pragma unroll
        for (int e = 0; e < 4; ++e) {
          const float sw = sigm(wr_[e]);
          const float dec = __expf(-0.6065306597126334f * sw);
          const float av = sigm(ap_[e]);
          const float kn = kr[e] * kkw[e] * inv;
          const float kd = kr[e] * (1.f + (av - 1.f) * kaw[e]);
          bsum += rr[e] * kd * rkw[e];
          o0[e] = -kn; o1[e] = dec; o2[e] = kn * av; o3[e] = kd;
        }
        *(f32x4*)(OPS + 0 * 2048 + pn * 64 + j0) = o0;
        *(f32x4*)(OPS + 1 * 2048 + pn * 64 + j0) = o1;
        *(f32x4*)(OPS + 2 * 2048 + pn * 64 + j0) = o2;
        *(f32x4*)(OPS + 3 * 2048 + pn * 64 + j0) = o3;
        bsum = red16d(bsum);
        if ((tid & 15) == 0) BON[(tok * 8 + h) * 2 + d] = bsum;
      }
      __syncthreads();
      {
        ScanOps1 oa, ob;
        scan_load1(oa, OPS, VV, 0, jg, i0);
#pragma unroll 1
        for (int nn = 0; nn < 32; nn += 2) {
          scan_load1(ob, OPS, VV, nn + 1, jg, i0);
          scan_step1(oa, S0, YL, nn, jg, i0);
          scan_load1(oa, OPS, VV, (nn + 2) & 31, jg, i0);
          scan_step1(ob, S0, YL, nn + 1, jg, i0);
        }
      }
      __syncthreads();
      {
        typedef __attribute__((ext_vector_type(4))) _Float16 h16x4;
        h16x4 o;
#pragma unroll
        for (int e = 0; e < 4; ++e) o[e] = (_Float16)YL[pn * 64 + j0 + e];
        *(h16x4*)(Y + tok * 512 + h * 64 + j0) = o;
      }
    }
    __syncthreads();
  }
}

constexpr int PC_OPS = 0;
constexpr int PC_BUF = 49152;
constexpr int PC_RAW = 98304;
constexpr int PC_WR = 98304;
constexpr int PC_AP = 106496;
constexpr int PC_TW = 120064;
constexpr int PC_AD = 124672;
constexpr int PC_NRM = 129280;
constexpr int PC_MU = 129408;
constexpr int PC_CST = 131968;
constexpr int PC_YL = 133248;

DEVI void phase_scan_pc(int tid_, const Params& p, int l, char* smem, int bfirst, int bstride) {
  const u16* PR = (const u16*)(p.ws + OFF_PR);
  _Float16* YF = (_Float16*)(p.ws + OFF_H);
  _Float16* YB = (_Float16*)(p.ws + OFF_H + (size_t)NTOK * 512 * 2);
  float* BON = (float*)(p.ws + OFF_BONUS);
  const u16* WB = (const u16*)(p.ws + OFF_WB);
  u16* RAW = (u16*)(smem + PC_RAW);
  float* WR = (float*)(smem + PC_WR);
  float* AP = (float*)(smem + PC_AP);
  u16* TWb = (u16*)(smem + PC_TW);
  u16* ADb = (u16*)(smem + PC_AD);
  float* NRM = (float*)(smem + PC_NRM);
  float* MU = (float*)(smem + PC_MU);
  float* CST = (float*)(smem + PC_CST);
  const float* mu_p = p.in[I_MU_PREV] + (size_t)l * 1920;
  const float* mu_n = p.in[I_MU_NEXT] + (size_t)l * 1920;
  const bool is_prep = tid_ >= 256;
  const int tid = tid_ & 255, lane = tid & 63, w = tid >> 6, fr = lane & 15, fq = lane >> 4;
  const int pn = tid >> 3, j0 = (tid & 7) * 8;
  const int jg = lane & 7, i0 = w * 16 + (lane >> 3);
  const int hr = (tid >= 40) ? 1 : 0, hc = tid - hr * 40;
  for (int blk = bfirst; blk < 192; blk += bstride) {
    const int s = blk >> 4, h = (blk >> 1) & 7, d = blk & 1;
    __syncthreads();
    for (int i = tid_; i < 640; i += 512) {
      const int which = (i >= 320) ? 1 : 0, c = i - which * 320;
      const int g = c >> 6, e = c & 63;
      const int col = (g < 3) ? (g * 512 + h * 64 + e) : (1536 + (g - 3) * 128 + d * 64 + e);
      MU[i] = which ? mu_n[col] : mu_p[col];
    }
    if (tid_ < 320) {
      const int which = tid_ >> 6, e = tid_ & 63;
      float v;
      if (which == 0) v = p.in[I_W0][(size_t)(l * 2 + d) * 512 + h * 64 + e];
      else if (which == 1) v = p.in[I_A0][(size_t)(l * 2 + d) * 512 + h * 64 + e];
      else if (which == 2) v = p.in[I_K_K][(size_t)l * 512 + h * 64 + e];
      else if (which == 3) v = p.in[I_K_A][(size_t)l * 512 + h * 64 + e];
      else v = p.in[I_R_K][(size_t)(l * 8 + h) * 64 + e];
      CST[tid_] = v;
    }
    _Float16* Y = d ? YB : YF;
    if (is_prep) {
      bf16x8 bw[2], ba[2];
#pragma unroll
      for (int ks = 0; ks < 2; ++ks) {
        bw[ks] = *(const bf16x8*)(WB + W_WUP + (size_t)(d * 512 + h * 64 + w * 16 + fr) * 64 + ks * 32 + fq * 8);
        ba[ks] = *(const bf16x8*)(WB + W_AUP + (size_t)(d * 512 + h * 64 + w * 16 + fr) * 64 + ks * 32 + fq * 8);
      }
      u32x4 G[5], GH;
      {
        const int t = d ? (4095 - pn) : pn;
        const size_t tok = (size_t)s * 4096 + t;
#pragma unroll
        for (int g = 0; g < 5; ++g) {
          const int col = (g < 3) ? (g * 512 + h * 64) : (1536 + (g - 3) * 128 + d * 64);
          G[g] = *(const u32x4*)(PR + tok * PRW + col + j0);
        }
        GH = (u32x4){0u, 0u, 0u, 0u};
        if (tid < 80) {
          const int tlo = d ? (4095 - 31) : 0;
          const int th = hr ? (tlo + 32) : (tlo - 1);
          const int g = hc >> 3;
          const int col = (g < 3) ? (g * 512 + h * 64) : (1536 + (g - 3) * 128 + d * 64);
          if (th >= 0 && th <= 4095) GH = *(const u32x4*)(PR + ((size_t)s * 4096 + th) * PRW + col + (hc & 7) * 8);
        }
      }
#pragma unroll 1
      for (int ch = -1; ch < 128; ++ch) {
        const int c = ch + 1;
        const bool doprep = c < 128;
        float* OPS = (float*)(smem + PC_OPS + (c & 1) * PC_BUF);
        float* VV = OPS + 5 * 2048;
        const int n = c * 32 + pn;
        const int t = d ? (4095 - n) : n;
        const size_t tok = (size_t)s * 4096 + t;
        const int tlo = d ? (4095 - (c * 32 + 31)) : (c * 32);
        const int rrow = t - tlo + 1;
        __syncthreads();
        if (ch >= 1) {
          const float* YL = (const float*)(smem + PC_YL + ((ch - 1) & 1) * 8192);
          const int n1 = (ch - 1) * 32 + pn;
          const int t1 = d ? (4095 - n1) : n1;
          h16x8 o;
#pragma unroll
          for (int e = 0; e < 8; ++e) o[e] = (_Float16)YL[pn * 64 + j0 + e];
          *(h16x8*)(Y + ((size_t)s * 4096 + t1) * 512 + h * 64 + j0) = o;
        }
        if (doprep) {
#pragma unroll
          for (int g = 0; g < 5; ++g) *(u32x4*)(RAW + rrow * 320 + g * 64 + j0) = G[g];
          if (tid < 80) *(u32x4*)(RAW + (hr ? 33 : 0) * 320 + (hc >> 3) * 64 + (hc & 7) * 8) = GH;
        }
        __syncthreads();
        if (doprep) {
          if (c + 1 < 128) {
            const int n2 = n + 32;
            const int t2 = d ? (4095 - n2) : n2;
            const size_t tok2 = (size_t)s * 4096 + t2;
#pragma unroll
            for (int g = 0; g < 5; ++g) {
              const int col = (g < 3) ? (g * 512 + h * 64) : (1536 + (g - 3) * 128 + d * 64);
              G[g] = *(const u32x4*)(PR + tok2 * PRW + col + j0);
            }
            GH = (u32x4){0u, 0u, 0u, 0u};
            if (tid < 80) {
              const int tlo2 = d ? (tlo - 32) : (tlo + 32);
              const int th = hr ? (tlo2 + 32) : (tlo2 - 1);
              const int g = hc >> 3;
              const int col = (g < 3) ? (g * 512 + h * 64) : (1536 + (g - 3) * 128 + d * 64);
              if (th >= 0 && th <= 4095) GH = *(const u32x4*)(PR + ((size_t)s * 4096 + th) * PRW + col + (hc & 7) * 8);
            }
          }
#pragma unroll
          for (int g = 0; g < 5; ++g) {
            float cur[8], prv[8], nxt[8];
            load8bf(RAW + rrow * 320 + g * 64 + j0, cur);
            load8bf(RAW + (rrow - 1) * 320 + g * 64 + j0, prv);
            load8bf(RAW + (rrow + 1) * 320 + g * 64 + j0, nxt);
            const f32x4 mp0 = *(const f32x4*)(MU + g * 64 + j0), mp1 = *(const f32x4*)(MU + g * 64 + j0 + 4);
            const f32x4 mn0 = *(const f32x4*)(MU + 320 + g * 64 + j0), mn1 = *(const f32x4*)(MU + 320 + g * 64 + j0 + 4);
            f32x4 x0, x1;
#pragma unroll
            for (int e = 0; e < 4; ++e) {
              x0[e] = cur[e] + mp0[e] * (prv[e] - cur[e]) + mn0[e] * (nxt[e] - cur[e]);
              x1[e] = cur[4 + e] + mp1[e] * (prv[4 + e] - cur[4 + e]) + mn1[e] * (nxt[4 + e] - cur[4 + e]);
            }
            if (g == 0) {
              *(f32x4*)(OPS + 4 * 2048 + pn * 64 + j0) = x0; *(f32x4*)(OPS + 4 * 2048 + pn * 64 + j0 + 4) = x1;
            } else if (g == 1) {
              *(f32x4*)(OPS + 3 * 2048 + pn * 64 + j0) = x0; *(f32x4*)(OPS + 3 * 2048 + pn * 64 + j0 + 4) = x1;
              const f32x4 kk0 = *(const f32x4*)(CST + 128 + j0), kk1 = *(const f32x4*)(CST + 128 + j0 + 4);
              float ss = 0.f;
#pragma unroll
              for (int e = 0; e < 4; ++e) { const float a_ = x0[e] * kk0[e], b_ = x1[e] * kk1[e]; ss += a_ * a_ + b_ * b_; }
              ss = red8(ss);
              if ((tid & 7) == 0) NRM[pn] = frcp(fmaxf(__builtin_amdgcn_sqrtf(ss), 1e-12f));
            } else if (g == 2) {
              *(f32x4*)(VV + pn * 64 + j0) = x0; *(f32x4*)(VV + pn * 64 + j0 + 4) = x1;
            } else if (g == 3) {
              u32x4 pk;
              pk.x = pack2(ftanh(x0[0]), ftanh(x0[1])); pk.y = pack2(ftanh(x0[2]), ftanh(x0[3]));
              pk.z = pack2(ftanh(x1[0]), ftanh(x1[1])); pk.w = pack2(ftanh(x1[2]), ftanh(x1[3]));
              *(u32x4*)(TWb + pn * 72 + j0) = pk;
            } else {
              u32x4 pk;
              pk.x = pack2(x0[0], x0[1]); pk.y = pack2(x0[2], x0[3]);
              pk.z = pack2(x1[0], x1[1]); pk.w = pack2(x1[2], x1[3]);
              *(u32x4*)(ADb + pn * 72 + j0) = pk;
            }
          }
        }
        __syncthreads();
        if (doprep) {
#pragma unroll
          for (int m = 0; m < 2; ++m) {
            f32x4 cw = {0.f, 0.f, 0.f, 0.f}, ca = {0.f, 0.f, 0.f, 0.f};
#pragma unroll
            for (int ks = 0; ks < 2; ++ks) {
              const bf16x8 aw = *(const bf16x8*)(TWb + (m * 16 + fr) * 72 + ks * 32 + fq * 8);
              const bf16x8 aa = *(const bf16x8*)(ADb + (m * 16 + fr) * 72 + ks * 32 + fq * 8);
              cw = __builtin_amdgcn_mfma_f32_16x16x32_bf16(aw, bw[ks], cw, 0, 0, 0);
              ca = __builtin_amdgcn_mfma_f32_16x16x32_bf16(aa, ba[ks], ca, 0, 0, 0);
            }
#pragma unroll
            for (int jj = 0; jj < 4; ++jj) {
              WR[(m * 16 + fq * 4 + jj) * 64 + w * 16 + fr] = cw[jj];
              AP[(m * 16 + fq * 4 + jj) * 64 + w * 16 + fr] = ca[jj];
            }
          }
        }
        __syncthreads();
        if (doprep) {
          const float inv = NRM[pn];
          float bsum = 0.f;
#pragma unroll
          for (int hq = 0; hq < 2; ++hq) {
            const int jb = j0 + hq * 4;
            const f32x4 wr_ = *(const f32x4*)(WR + pn * 64 + jb) + *(const f32x4*)(CST + jb);
            const f32x4 ap_ = *(const f32x4*)(AP + pn * 64 + jb) + *(const f32x4*)(CST + 64 + jb);
            const f32x4 kr = *(const f32x4*)(OPS + 3 * 2048 + pn * 64 + jb);
            const f32x4 rr = *(const f32x4*)(OPS + 4 * 2048 + pn * 64 + jb);
            const f32x4 kkw = *(const f32x4*)(CST + 128 + jb), kaw = *(const f32x4*)(CST + 192 + jb), rkw = *(const f32x4*)(CST + 256 + jb);
            f32x4 o0, o1, o2, o3;
#pragma unroll
            for (int e = 0; e < 4; ++e) {
              const float sw = sigm(wr_[e]);
              const float dec = __expf(-0.6065306597126334f * sw);
              const float av = sigm(ap_[e]);
              const float kn = kr[e] * kkw[e] * inv;
              const float kd = kr[e] * (1.f + (av - 1.f) * kaw[e]);
              bsum += rr[e] * kd * rkw[e];
              o0[e] = -kn; o1[e] = dec; o2[e] = kn * av; o3[e] = kd;
            }
            *(f32x4*)(OPS + 0 * 2048 + pn * 64 + jb) = o0;
            *(f32x4*)(OPS + 1 * 2048 + pn * 64 + jb) = o1;
            *(f32x4*)(OPS + 2 * 2048 + pn * 64 + jb) = o2;
            *(f32x4*)(OPS + 3 * 2048 + pn * 64 + jb) = o3;
          }
          bsum = red8(bsum);
          if ((tid & 7) == 0) BON[(tok * 8 + h) * 2 + d] = bsum;
        }
      }
      __syncthreads();
      {
        const float* YL = (const float*)(smem + PC_YL + (127 & 1) * 8192);
        const int n1 = 127 * 32 + pn;
        const int t1 = d ? (4095 - n1) : n1;
        h16x8 o;
#pragma unroll
        for (int e = 0; e < 8; ++e) o[e] = (_Float16)YL[pn * 64 + j0 + e];
        *(h16x8*)(Y + ((size_t)s * 4096 + t1) * 512 + h * 64 + j0) = o;
      }
    } else {
      f32x2 S0[4], S1[4];
#pragma unroll
      for (int q = 0; q < 4; ++q) { S0[q] = (f32x2){0.f, 0.f}; S1[q] = (f32x2){0.f, 0.f}; }
#pragma unroll 1
      for (int ch = -1; ch < 128; ++ch) {
        const float* OPS = (const float*)(smem + PC_OPS + (ch & 1) * PC_BUF);
        const float* VV = OPS + 5 * 2048;
        float* YL = (float*)(smem + PC_YL + (ch & 1) * 8192);
        __syncthreads();
        if (ch < 0) {
          __syncthreads(); __syncthreads(); __syncthreads();
        } else {
          ScanOps oa, ob;
          scan_load(oa, OPS, VV, 0, jg, i0);
#pragma unroll 1
          for (int seg = 0; seg < 4; ++seg) {
            if (seg > 0) __syncthreads();
#pragma unroll 1
            for (int nn = seg * 8; nn < seg * 8 + 8; nn += 2) {
              scan_load(ob, OPS, VV, nn + 1, jg, i0);
              scan_step(oa, S0, S1, YL, nn, jg, i0);
              scan_load(oa, OPS, VV, (nn + 2) & 31, jg, i0);
              scan_step(ob, S0, S1, YL, nn + 1, jg, i0);
            }
          }
        }
      }
      __syncthreads();
    }
    __syncthreads();
  }
}

DEVI void phase_rwkv_post(int tid_, int vb_, int vg_, const Params& p, int l, char* smem) {
  u16* PR = (u16*)(p.ws + OFF_PR);
  const _Float16* YF = (const _Float16*)(p.ws + OFF_H);
  const _Float16* YB = (const _Float16*)(p.ws + OFF_H + (size_t)NTOK * 512 * 2);
  const float* BON = (const float*)(p.ws + OFF_BONUS);
  const u16* GUPT = (const u16*)(p.ws + OFF_WB) + W_GUP;
  const float* mu_p = p.in[I_MU_PREV] + (size_t)l * 1920;
  const float* mu_n = p.in[I_MU_NEXT] + (size_t)l * 1920;
  const float* gng = p.in[I_GN_G] + (size_t)l * 512;
  const float* gnb = p.in[I_GN_B] + (size_t)l * 512;
  u16* As = (u16*)smem;
  const int tid = tid_, lane = tid & 63, w = tid >> 6, fr = lane & 15, fq = lane >> 4;
  for (int tile = vb_; tile < NTOK / 64; tile += vg_) {
    const size_t tok0 = (size_t)tile * 64;
    {
      const int row = tid >> 2, part = tid & 3;
      const size_t tok = tok0 + row;
      const int t = (int)(tok & 4095);
#pragma unroll
      for (int q = 0; q < 4; ++q) {
        const int col = 1792 + part * 32 + q * 8;
        float cur[8], prv[8], nxt[8];
        load8bf(PR + tok * PRW + col, cur);
        if (t > 0) load8bf(PR + (tok - 1) * PRW + col, prv);
        else {
#pragma unroll
          for (int e = 0; e < 8; ++e) prv[e] = 0.f;
        }
        if (t < 4095) load8bf(PR + (tok + 1) * PRW + col, nxt);
        else {
#pragma unroll
          for (int e = 0; e < 8; ++e) nxt[e] = 0.f;
        }
        float o[8];
#pragma unroll
        for (int e = 0; e < 8; ++e) {
          const float x = cur[e] + mu_p[col + e] * (prv[e] - cur[e]) + mu_n[col + e] * (nxt[e] - cur[e]);
          o[e] = sigm(x);
        }
        u32x4 pk;
        pk.x = pack2(o[0], o[1]); pk.y = pack2(o[2], o[3]); pk.z = pack2(o[4], o[5]); pk.w = pack2(o[6], o[7]);
        *(u32x4*)(As + row * 136 + part * 32 + q * 8) = pk;
      }
    }
    asm volatile("" ::: "memory");
#pragma unroll 1
    for (int chh = 0; chh < 2; ++chh) {
      f32x4 acc[16];
#pragma unroll
      for (int n = 0; n < 16; ++n) acc[n] = (f32x4){0.f, 0.f, 0.f, 0.f};
#pragma unroll
      for (int ks = 0; ks < 4; ++ks) {
        bf16x8 af = *(const bf16x8*)(As + (w * 16 + fr) * 136 + ks * 32 + fq * 8);
#pragma unroll
        for (int n = 0; n < 16; ++n) {
          bf16x8 bg = *(const bf16x8*)(GUPT + (size_t)(chh * 256 + n * 16 + fr) * 128 + ks * 32 + fq * 8);
          acc[n] = __builtin_amdgcn_mfma_f32_16x16x32_bf16(af, bg, acc[n], 0, 0, 0);
        }
      }
#pragma unroll
      for (int hl = 0; hl < 4; ++hl) {
        const int head = chh * 4 + hl;
        asm volatile("" ::: "memory");
#pragma unroll
        for (int j = 0; j < 4; ++j) {
          const size_t tok = tok0 + w * 16 + fq * 4 + j;
          const int t = (int)(tok & 4095);
          float o[4], sum = 0.f;
#pragma unroll
          for (int q = 0; q < 4; ++q) {
            const int col = head * 64 + q * 16 + fr;
            o[q] = (float)YF[tok * 512 + col] + (float)YB[tok * 512 + col];
            sum += o[q];
          }
          const float mean = red16_sum(sum) * (1.f / 64.f);
          float vs = 0.f;
#pragma unroll
          for (int q = 0; q < 4; ++q) { const float dlt = o[q] - mean; vs += dlt * dlt; }
          const float var = red16_sum(vs) * (1.f / 64.f);
          const float rstd = rsqrtf(var + 64e-5f);
          const float bon = BON[(tok * 8 + head) * 2] + BON[(tok * 8 + head) * 2 + 1];
#pragma unroll
          for (int q = 0; q < 4; ++q) {
            const int col = head * 64 + q * 16 + fr;
            const int vc = 1024 + col;
            const float cur = bf2f(PR[tok * PRW + vc]);
            const float prv = (t > 0) ? bf2f(PR[(tok - 1) * PRW + vc]) : 0.f;
            const float nxt = (t < 4095) ? bf2f(PR[(tok + 1) * PRW + vc]) : 0.f;
            const float vsh = cur + mu_p[vc] * (prv - cur) + mu_n[vc] * (nxt - cur);
            const float yv = ((o[q] - mean) * rstd * gng[col] + gnb[col] + bon * vsh) * acc[hl * 4 + q][j];
            PR[tok * PRW + col] = f2bf(yv);
          }
        }
      }
    }
  }
}

DEVI f32x4 ld4bf(const u16* p) {
  const u32x2 u = *(const u32x2*)p;
  f32x4 o;
  o[0] = __uint_as_float(u.x << 16); o[1] = __uint_as_float(u.x & 0xffff0000u);
  o[2] = __uint_as_float(u.y << 16); o[3] = __uint_as_float(u.y & 0xffff0000u);
  return o;
}

DEVI void phase_merge(int tid_, const Params& p, char* smem, const float* ssq) {
  const u16* WB = (const u16*)(p.ws + OFF_WB);
  const u16* H = (const u16*)(p.ws + OFF_NK);
  u16* PR = (u16*)(p.ws + OFF_PR);
  const u16* NQ = (const u16*)(p.ws + OFF_NQ);
  u16* TMP = (u16*)(p.ws + OFF_H);
  const int lane = tid_ & 63, wid = tid_ >> 6;
  const int wr = wid >> 2, wc = wid & 3, fr = lane & 15, fq = lane >> 4;
  const bool xmap = (gridDim.x & 7) == 0;
  const int xcd = blockIdx.x & 7;
  const int first = xmap ? (int)(blockIdx.x >> 3) : (int)blockIdx.x;
  const int stride = xmap ? (int)(gridDim.x >> 3) : (int)gridDim.x;
  const int count = xmap ? 24 * 4 : 192 * 4;
  for (int it = first; it < count; it += stride) {
    const int tm = xmap ? (it >> 2) * 8 + xcd : (it >> 2), tn = it & 3;
    const int m0 = tm << 8, n0 = tn << 8;
    f32x4 acc[8][4];
#define MERGE_ZERO() _Pragma("unroll") for (int m = 0; m < 8; ++m) _Pragma("unroll") for (int n = 0; n < 4; ++n) acc[m][n] = (f32x4){0.f, 0.f, 0.f, 0.f}
#define MERGE_RC() const int r = m0 + wr * 128 + m * 16 + fr, c0 = n0 + wc * 64 + n * 16 + fq * 4
    MERGE_ZERO();
    gemm_kloop8<true>(launder(tid_), acc, H + (size_t)m0 * 1024, 1024, WB + W_IN + (size_t)(3456 + n0) * 1024, 1024, 1024, smem);
#pragma unroll
    for (int m = 0; m < 8; ++m)
#pragma unroll
      for (int n = 0; n < 4; ++n) {
        MERGE_RC();
        const float rs = rstd_of(ssq, r);
        f32x4 o;
#pragma unroll
        for (int j = 0; j < 4; ++j) o[j] = sigm(acc[m][n][j] * rs);
        store4bf(PR + (size_t)r * PRW + 512 + c0, o);
      }
    MERGE_ZERO();
    gemm_kloop8<true>(launder(tid_), acc, PR + (size_t)m0 * PRW, PRW, WB + W_BRR + (size_t)n0 * 512, 512, 512, smem);
#pragma unroll
    for (int m = 0; m < 8; ++m)
#pragma unroll
      for (int n = 0; n < 4; ++n) {
        MERGE_RC();
        u16* dst = PR + (size_t)r * PRW + 512 + c0;
        store4bf(dst, ld4bf(dst) * acc[m][n]);
      }
    MERGE_ZERO();
    gemm_kloop8<true>(launder(tid_), acc, H + (size_t)m0 * 1024, 1024, WB + W_IN + (size_t)(4480 + n0) * 1024, 1024, 1024, smem);
#pragma unroll
    for (int m = 0; m < 8; ++m)
#pragma unroll
      for (int n = 0; n < 4; ++n) {
        MERGE_RC();
        const float rs = rstd_of(ssq, r);
        f32x4 o;
#pragma unroll
        for (int j = 0; j < 4; ++j) o[j] = sigm(acc[m][n][j] * rs);
        store4bf(TMP + (size_t)r * 1024 + c0, o);
      }
    MERGE_ZERO();
    gemm_kloop8<true>(launder(tid_), acc, NQ + (size_t)m0 * 512, 512, WB + W_BRN + (size_t)n0 * 512, 512, 512, smem);
#pragma unroll
    for (int m = 0; m < 8; ++m)
#pragma unroll
      for (int n = 0; n < 4; ++n) {
        MERGE_RC();
        u16* dst = PR + (size_t)r * PRW + 512 + c0;
        store4bf(dst, ld4bf(dst) + ld4bf(TMP + (size_t)r * 1024 + c0) * acc[m][n]);
      }
#undef MERGE_ZERO
#undef MERGE_RC
  }
}


DEVI void phase_xattn(int tid_, int vb_, int vg_, const Params& p, char* smem) {
  const u16* Q = (const u16*)(p.ws + OFF_PR);
  u16* O = (u16*)(p.ws + OFF_NQ);
  const u16* KVK = (const u16*)(p.ws + OFF_KVK);
  const u16* KVT = (const u16*)(p.ws + OFF_KVT);
  const int lane = tid_ & 63, w = tid_ >> 6, fr = lane & 15, fq = lane >> 4;
  u16* Pw = (u16*)smem + w * (32 * 264);
  for (int t = vb_; t < (NTOK / 128) * 4; t += vg_) {
    const int hh = t & 3;
    const size_t tok0 = (size_t)(t >> 2) * 128 + w * 32;
    const int s = (int)(tok0 >> 12);
    f32x4 acc[2][16];
#pragma unroll
    for (int mt = 0; mt < 2; ++mt)
#pragma unroll
      for (int n = 0; n < 16; ++n) acc[mt][n] = (f32x4){0.f, 0.f, 0.f, 0.f};
#pragma unroll 1
    for (int ks = 0; ks < 8; ++ks) {
      const bf16x8 aq0 = *(const bf16x8*)(Q + (tok0 + fr) * 1024 + hh * 256 + ks * 32 + fq * 8);
      const bf16x8 aq1 = *(const bf16x8*)(Q + (tok0 + 16 + fr) * 1024 + hh * 256 + ks * 32 + fq * 8);
#pragma unroll
      for (int n = 0; n < 16; ++n) {
        const bf16x8 bk = *(const bf16x8*)(KVK + (size_t)(s * 256 + n * 16 + fr) * 1024 + hh * 256 + ks * 32 + fq * 8);
        acc[0][n] = __builtin_amdgcn_mfma_f32_16x16x32_bf16(bk, aq0, acc[0][n], 0, 0, 0);
        acc[1][n] = __builtin_amdgcn_mfma_f32_16x16x32_bf16(bk, aq1, acc[1][n], 0, 0, 0);
      }
    }
    float sm[2];
#pragma unroll
    for (int mt = 0; mt < 2; ++mt) {
      float m = -1e30f;
#pragma unroll
      for (int n = 0; n < 16; ++n)
#pragma unroll
        for (int j = 0; j < 4; ++j) m = fmaxf(m, acc[mt][n][j]);
      m = red4x_max(m) * 0.0625f;
      float ssum = 0.f;
#pragma unroll
      for (int n = 0; n < 16; ++n) {
        f32x4 e;
#pragma unroll
        for (int j = 0; j < 4; ++j) { e[j] = __expf(acc[mt][n][j] * 0.0625f - m); ssum += e[j]; }
        store4bf(Pw + (mt * 16 + fr) * 264 + n * 16 + fq * 4, e);
      }
      sm[mt] = 1.f / red4x_sum(ssum);
    }
#pragma unroll
    for (int mt = 0; mt < 2; ++mt)
#pragma unroll
      for (int n = 0; n < 16; ++n) acc[mt][n] = (f32x4){0.f, 0.f, 0.f, 0.f};
#pragma unroll 1
    for (int ks = 0; ks < 8; ++ks) {
      const bf16x8 ap0 = *(const bf16x8*)(Pw + fr * 264 + ks * 32 + fq * 8);
      const bf16x8 ap1 = *(const bf16x8*)(Pw + (16 + fr) * 264 + ks * 32 + fq * 8);
#pragma unroll
      for (int n = 0; n < 16; ++n) {
        const bf16x8 bv = *(const bf16x8*)(KVT + (size_t)(s * 1024 + hh * 256 + n * 16 + fr) * 256 + ks * 32 + fq * 8);
        acc[0][n] = __builtin_amdgcn_mfma_f32_16x16x32_bf16(bv, ap0, acc[0][n], 0, 0, 0);
        acc[1][n] = __builtin_amdgcn_mfma_f32_16x16x32_bf16(bv, ap1, acc[1][n], 0, 0, 0);
      }
    }
#pragma unroll
    for (int mt = 0; mt < 2; ++mt)
#pragma unroll
      for (int n = 0; n < 16; n += 2)
        store_pair_bf16(O + (tok0 + mt * 16 + fr) * 1024 + hh * 256, n * 16, fq, pack4bf(acc[mt][n] * sm[mt]),
                        pack4bf(acc[mt][n + 1] * sm[mt]));
  }
}

constexpr int HALF_SMEM = 78720;

DEVI void run_phase(int tid_, const Params& p, int ph, char* smem) {
  const int half = tid_ >> 8, vt = tid_ & 255;
  const int vb_ = blockIdx.x * 2 + half, vg_ = gridDim.x * 2;
  char* smh = smem + half * HALF_SMEM;
  if (ph == 2 * NPH_LAYER) { phase_final_norm(vt, vb_, vg_, p); return; }
  const int l = ph / NPH_LAYER, q = ph % NPH_LAYER;
  u16* WB = (u16*)(p.ws + OFF_WB);
  u16* H = (u16*)(p.ws + OFF_H);
  u16* PR = (u16*)(p.ws + OFF_PR);
  u16* NQ = (u16*)(p.ws + OFF_NQ);
  float* X = p.X;
  float* SSQ = (float*)(p.ws + OFF_SSQ);
  auto epi_res = [&](int r, int c0, f32x4 v) {
    f32x4* px = (f32x4*)(X + (size_t)r * 1024 + c0);
    *px = *px + v;
  };
  float rowacc = 0.f;
  float* ssq_out = SSQ;
  const bool x_from_input = (l == 0 && q <= 5);
  const bool need_xb = !(l == 1 && q == 12);
  auto epi_res_n = [&](int r, int c0, f32x4 v) {
    f32x4* px = (f32x4*)(X + (size_t)r * 1024 + c0);
    const float* srow = x_from_input ? ((r < 32768) ? p.in[I_XP] + (size_t)r * 1024 : p.in[I_XS] + (size_t)(r - 32768) * 1024)
                                     : X + (size_t)r * 1024;
    const f32x4 xn = *(const f32x4*)(srow + c0) + v;
    *px = xn;
    if (need_xb) store4bf(H + (size_t)r * 1024 + c0, xn);
    rowacc += xn[0] * xn[0] + xn[1] * xn[1] + xn[2] * xn[2] + xn[3] * xn[3];
  };
  const int fq_l = (tid_ & 63) >> 4;
  auto epi_res_p = make_pair_epi([&](int r, int c, f32x4 va, f32x4 vb) {
    const float* srow = x_from_input ? ((r < 32768) ? p.in[I_XP] + (size_t)r * 1024 : p.in[I_XS] + (size_t)(r - 32768) * 1024)
                                     : X + (size_t)r * 1024;
    const int ca = c + fq_l * 4, cb = c + 16 + fq_l * 4;
    const f32x4 xa = *(const f32x4*)(srow + ca) + va;
    const f32x4 xb = *(const f32x4*)(srow + cb) + vb;
    *(f32x4*)(X + (size_t)r * 1024 + ca) = xa;
    *(f32x4*)(X + (size_t)r * 1024 + cb) = xb;
    if (need_xb) store_pair_bf16(H + (size_t)r * 1024, c, fq_l, pack4bf(xa), pack4bf(xb));
    rowacc += xa[0] * xa[0] + xa[1] * xa[1] + xa[2] * xa[2] + xa[3] * xa[3]
            + xb[0] * xb[0] + xb[1] * xb[1] + xb[2] * xb[2] + xb[3] * xb[3];
  });
  auto row_end = [&](int r) {
    float t = rowacc;
    t += __shfl_xor(t, 16);
    t += __shfl_xor(t, 32);
    if ((tid_ & 48) == 0) atomicAdd(ssq_out + r, t);
    rowacc = 0.f;
  };
  constexpr int NONS = 1 << 30;
  switch (q) {
    case 0:
      phase_conv(vt, vb_, vg_, p, l, smh);
      phase_norm_mem(vt, vb_, vg_, p, p.in[I_NORM_MEM] + (size_t)l * 1024);
      if (l == 0) {
        phase_xb(vt, vb_, vg_, p, true, OFF_H, SSQ);
        for (int i = vb_ * 256 + vt; i < 6 * NTOK; i += vg_ * 256) SSQ[NTOK + i] = 0.f;
      }
      break;
    case 1: phase_p_gemm(tid_, p, smem, SSQ + (size_t)(3 * l) * NTOK); break;
    case 2:
      if (gridDim.x >= 224) {
        if (blockIdx.x < 192) phase_scan_pc(tid_, p, l, smem, blockIdx.x, gridDim.x);
        else phase_nat(vt, p, l, smh, vb_ - 384, vg_ - 384);
      } else {
        phase_scan(vt, p, l, smh, vb_, vg_);
        __syncthreads();
        phase_nat(vt, p, l, smh, vb_, vg_);
      }
      break;
    case 3:
      phase_rwkv_post(vt, vb_, vg_, p, l, smh);
      phase_xb(vt, vb_, vg_, p, l == 0, OFF_NK, nullptr);
      break;
    case 4: phase_merge(tid_, p, smem, SSQ + (size_t)(3 * l) * NTOK); break;
    case 5:
      ssq_out = SSQ + (size_t)(3 * l + 1) * NTOK;
      gemm_phase8(tid_, PR + 512, PRW, WB + W_OUT, 1024, 1024, NTOK, 1024, smem, NONS, epi_res_n, NoEpi(), row_end, 0, epi_res_p);
      break;
    case 6: {
      const float* ssq = SSQ + (size_t)(3 * l + 1) * NTOK;
      const int fq_ = (tid_ & 63) >> 4;
      gemm_phase8(tid_, H, 1024, WB + W_XQ, 1024, 1024, NTOK, 1024, smem, NONS,
                 [&](int r, int c0, f32x4 v) { store4bf(PR + (size_t)r * 1024 + c0, v * rstd_of(ssq, r)); }, NoEpi(), NoRow(), 0,
                 make_pair_epi([&](int r, int c, f32x4 va, f32x4 vb) {
                   const float rs = rstd_of(ssq, r);
                   store_pair_bf16(PR + (size_t)r * 1024, c, fq_, pack4bf(va * rs), pack4bf(vb * rs));
                 }));
    } break;
    case 7: phase_xattn(vt, vb_, vg_, p, smh); break;
    case 8:
      ssq_out = SSQ + (size_t)(3 * l + 2) * NTOK;
      gemm_phase8(tid_, NQ, 1024, WB + W_XO, 1024, 1024, NTOK, 1024, smem, NONS, epi_res_n, NoEpi(), row_end, 0, epi_res_p);
      break;
    case 9:
    case 11: {
      const int hf = (q == 11);
      const float* ssq = SSQ + (size_t)(3 * l + 2) * NTOK;
      gemm_phase8(tid_, H, 1024, WB + W_FF1 + (size_t)hf * 2048 * 1024, 1024, 1024, NTOK, 2048, smem, NONS,
                 [&](int r, int c0, f32x4 v) {
                   const float rs = rstd_of(ssq, r);
                   f32x4 o;
#pragma unroll
                   for (int j = 0; j < 4; ++j) { const float x = fmaxf(v[j] * rs, 0.f); o[j] = x * x; }
                   store4bf(PR + (size_t)r * 2048 + c0, o);
                 }, NoEpi(), NoRow(), 0,
                 make_pair_epi([&](int r, int c, f32x4 va, f32x4 vb) {
                   const float rs = rstd_of(ssq, r);
                   f32x4 oa, ob;
#pragma unroll
                   for (int j = 0; j < 4; ++j) {
                     const float xa = fmaxf(va[j] * rs, 0.f), xb = fmaxf(vb[j] * rs, 0.f);
                     oa[j] = xa * xa; ob[j] = xb * xb;
                   }
                   store_pair_bf16(PR + (size_t)r * 2048, c, (tid_ & 63) >> 4, pack4bf(oa), pack4bf(ob));
                 }));
    } break;
    case 10:
      gemm_phase8(tid_, PR, 2048, WB + W_FF2, 4096, 2048, NTOK, 1024, smem, NONS, epi_res, NoEpi());
      break;
    case 12:
      ssq_out = SSQ + (size_t)(3 * l + 3) * NTOK;
      gemm_phase8(tid_, PR, 2048, WB + W_FF2 + 2048, 4096, 2048, NTOK, 1024, smem, NONS, epi_res_n, NoEpi(), row_end);
      break;
  }
}

#define XB_TMO      128
#define XB_XCNT(j)  (256  + 64 * (j))
#define XB_XSUB(j)  (1280 + 64 * (j))
#define XB_XGEN(j)  (2304 + 64 * (j))
#define XB_TOP      3328
#define XB_TOPGEN   3392
#define XCD_BAR_WORDS 3456
#define XB_SPIN_CAP (1u << 20)
#define LAS __attribute__((address_space(3)))

DEVI unsigned xb_ld(unsigned* p) { return __hip_atomic_load(p, __ATOMIC_RELAXED, __HIP_MEMORY_SCOPE_AGENT); }
DEVI unsigned xb_add(unsigned* p, unsigned v) { return __hip_atomic_fetch_add(p, v, __ATOMIC_RELAXED, __HIP_MEMORY_SCOPE_AGENT); }
DEVI unsigned xb_xcc_id() { return (unsigned)__builtin_amdgcn_s_getreg((3 << 11) | 20) & 0xFu; }
#define XB_SPIN(cond, bar) do { unsigned _sp = 0; while (cond) { __builtin_amdgcn_s_sleep(1); \
    if ((++_sp & 255u) == 0u) { if (xb_ld(&(bar)[XB_TMO])) break; if (_sp > XB_SPIN_CAP) { atomicAdd(&(bar)[XB_TMO], 1u); break; } } } } while (0)

struct XcdBarrier {
  unsigned* bar; unsigned x;
  volatile LAS unsigned* st;
};
DEVI XcdBarrier xcd_barrier_post(unsigned* bar, volatile LAS unsigned* st) {
  XcdBarrier b; b.bar = bar; b.x = xb_xcc_id(); b.st = st;
  if (threadIdx.x == 0) (void)xb_add(&bar[XB_XCNT(b.x)], 1u);
  return b;
}
DEVI void xcd_barrier_complete(unsigned* bar, unsigned x, unsigned& nloc, unsigned& nx) {
  const unsigned G = gridDim.x * gridDim.y * gridDim.z;
  unsigned sum, cnt, mine, sp = 0u;
  for (;;) {
    sum = 0u; cnt = 0u; mine = 0u;
#pragma unroll
    for (unsigned j = 0; j < 16; ++j) { const unsigned c = xb_ld(&bar[XB_XCNT(j)]); sum += c; cnt += (c > 0u) ? 1u : 0u; mine = (j == x) ? c : mine; }
    if (sum == G) break;
    __builtin_amdgcn_s_sleep(1);
    if ((++sp & 255u) == 0u) { if (xb_ld(&bar[XB_TMO])) break; if (sp > XB_SPIN_CAP) { atomicAdd(&bar[XB_TMO], 1u); break; } }
  }
  nloc = mine > 0u ? mine : 1u; nx = cnt > 0u ? cnt : 1u;
}
DEVI void xcd_barrier(const XcdBarrier& b) {
  asm volatile("s_waitcnt vmcnt(0)" ::: "memory");
  __syncthreads();
  if (threadIdx.x == 0) {
    unsigned* bar = b.bar;
    __builtin_amdgcn_s_waitcnt(0);
    unsigned nloc = b.st[0], nx = b.st[1];
    if (nloc == 0u) { xcd_barrier_complete(bar, b.x, nloc, nx); b.st[0] = nloc; b.st[1] = nx; }
    const unsigned old = xb_add(&bar[XB_XSUB(b.x)], 1u);
    const unsigned gen = old / nloc;
    if (old + 1u == (gen + 1u) * nloc) {
      __builtin_amdgcn_fence(__ATOMIC_RELEASE, "agent");
      asm volatile("s_waitcnt vmcnt(0)" ::: "memory");
      const unsigned og = xb_add(&bar[XB_TOP], 1u);
      const unsigned tg = og / nx;
      if (og + 1u == (tg + 1u) * nx) xb_add(&bar[XB_TOPGEN], 1u);
      else XB_SPIN(xb_ld(&bar[XB_TOPGEN]) == tg, bar);
      __builtin_amdgcn_fence(__ATOMIC_ACQUIRE, "agent");
      xb_add(&bar[XB_XGEN(b.x)], 1u);
      asm volatile("s_waitcnt vmcnt(0)" ::: "memory");
    } else {
      XB_SPIN(xb_ld(&bar[XB_XGEN(b.x)]) == gen, bar);
      __builtin_amdgcn_fence(__ATOMIC_ACQUIRE, "agent");
      asm volatile("s_waitcnt vmcnt(0)" ::: "memory");
    }
  }
  __syncthreads();
}

__global__ void __launch_bounds__(512, 2) mega_kernel(Params p, int ph0, int ph1) {
  __shared__ __attribute__((aligned(16))) char smem[2 * HALF_SMEM];
  __shared__ __attribute__((aligned(16))) unsigned xb_words[4];
  if (threadIdx.x == 0) { xb_words[0] = 0u; xb_words[1] = 0u; xb_words[2] = 0u; xb_words[3] = 0u; }
  __syncthreads();
  XcdBarrier xb = xcd_barrier_post((unsigned*)(p.ws + OFF_BAR), (volatile LAS unsigned*)xb_words);
  for (int ph = ph0; ph < ph1; ++ph) {
    if (ph == ph0 + 1) cg::this_grid().sync();
    else if (ph > ph0) xcd_barrier(xb);
    int tid_ = threadIdx.x;
    asm volatile("" : "+v"(tid_));
    run_phase(tid_, p, ph, smem);
  }
}

extern "C" void kernel_launch(void* const* d_in, const int* in_sizes, int n_in, void* d_out, int out_size, void* d_ws,
                              size_t ws_size, hipStream_t stream) {
  if (ws_size < WS_NEED || n_in < 31) return;
  Params p{};
  for (int i = 0; i < 31; ++i) p.in[i] = (const float*)d_in[i];
  p.X = (float*)d_out;
  p.ws = (char*)d_ws;
  static int grid_blocks = 0;
  if (!grid_blocks) {
    int dev = 0, cus = 0, per_cu = 0;
    hipGetDevice(&dev);
    hipDeviceGetAttribute(&cus, hipDeviceAttributeMultiprocessorCount, dev);
    hipOccupancyMaxActiveBlocksPerMultiprocessor(&per_cu, mega_kernel, 512, 0);
    if (per_cu > 1) per_cu = 1;
    if (per_cu < 1) per_cu = 1;
    grid_blocks = cus * per_cu;
  }
  hipMemsetAsync((char*)d_ws + OFF_BAR, 0, 16384, stream);
  int ph0 = 0, ph1 = NPHASES;
  void* args[] = {&p, &ph0, &ph1};
  hipLaunchCooperativeKernel((void*)mega_kernel, dim3(grid_blocks), dim3(512), args, 0, stream);
}
```

```cpp
#include <hip/hip_runtime.h>
#include <hip/hip_cooperative_groups.h>
#include <stdint.h>
namespace cg = cooperative_groups;

typedef unsigned short u16;
typedef __attribute__((ext_vector_type(8))) short bf16x8;
typedef __attribute__((ext_vector_type(4))) float f32x4;
typedef __attribute__((ext_vector_type(8))) _Float16 h16x8;
typedef __attribute__((ext_vector_type(4))) unsigned int u32x4;
typedef __attribute__((ext_vector_type(2))) unsigned int u32x2;

#define DEVI __device__ __forceinline__

constexpr int NTOK = 49152;
constexpr int SEQ_T = 4096;
constexpr int PRW = 1920;
constexpr int NPH_LAYER = 13;
constexpr int NPHASES = 2 * NPH_LAYER + 1;
constexpr int SMEM_BYTES = 78720;

constexpr size_t OFF_WB = 0;
constexpr size_t WB_BYTES = 20512768ull * 2;
constexpr size_t OFF_H = OFF_WB + WB_BYTES;
constexpr size_t OFF_PR = OFF_H + (size_t)NTOK * 1024 * 2;
constexpr size_t OFF_NQ = OFF_PR + (size_t)NTOK * PRW * 2;
constexpr size_t OFF_NK = OFF_NQ + (size_t)NTOK * 512 * 2;
constexpr size_t OFF_NV = OFF_NK + (size_t)NTOK * 512 * 2;
constexpr size_t OFF_KVK = OFF_NV + (size_t)NTOK * 512 * 2;
constexpr size_t OFF_KVT = OFF_KVK + (size_t)3072 * 1024 * 2;
constexpr size_t OFF_MEMH = OFF_KVT + (size_t)3072 * 1024 * 2;
constexpr size_t OFF_BONUS = OFF_MEMH + (size_t)3072 * 1024 * 2;
constexpr size_t OFF_BAR = OFF_BONUS + (size_t)NTOK * 16 * 4;
constexpr size_t OFF_SSQ = OFF_BAR + 16384;
constexpr size_t WS_NEED = OFF_SSQ + (size_t)7 * NTOK * 4;

constexpr size_t W_IN = 0;
constexpr size_t W_BRR = W_IN + (size_t)5504 * 1024;
constexpr size_t W_BRN = W_BRR + (size_t)1024 * 512;
constexpr size_t W_OUT = W_BRN + (size_t)1024 * 512;
constexpr size_t W_XQ = W_OUT + (size_t)1024 * 1024;
constexpr size_t W_XKV = W_XQ + (size_t)1024 * 1024;
constexpr size_t W_XO = W_XKV + (size_t)2048 * 1024;
constexpr size_t W_FF1 = W_XO + (size_t)1024 * 1024;
constexpr size_t W_FF2 = W_FF1 + (size_t)4096 * 1024;
constexpr size_t W_GUP = W_FF2 + (size_t)4096 * 1024;
constexpr size_t W_WUP = W_GUP + (size_t)512 * 128;
constexpr size_t W_AUP = W_WUP + (size_t)2 * 512 * 64;

enum { I_XP = 0, I_XS, I_MP, I_MS, I_NORM_MIX, I_W_IN, I_MU_PREV, I_MU_NEXT, I_W0, I_W_UP, I_A0, I_A_UP,
       I_G_UP, I_K_K, I_K_A, I_R_K, I_GN_G, I_GN_B, I_RPB, I_W_BR_RWKV, I_W_BR_NAT, I_W_OUT, I_NORM_X,
       I_NORM_MEM, I_W_XQ, I_W_XKV, I_W_XO, I_NORM_FF, I_W_FF1, I_W_FF2, I_NORM_FINAL };

struct Params {
  const float* in[31];
  float* X;
  char* ws;
};

DEVI u16 f2bf(float f) {
  uint32_t u = __float_as_uint(f);
  u += 0x7FFFu + ((u >> 16) & 1u);
  return (u16)(u >> 16);
}
DEVI float bf2f(u16 h) { return __uint_as_float(((uint32_t)h) << 16); }
DEVI uint32_t pack2(float a, float b) { return (uint32_t)f2bf(a) | ((uint32_t)f2bf(b) << 16); }
DEVI float frcp(float x) { return __builtin_amdgcn_rcpf(x); }
DEVI float sigm(float x) { return frcp(1.f + __expf(-x)); }
DEVI float ftanh(float x) { return 1.f - 2.f * frcp(__expf(2.f * x) + 1.f); }
DEVI void unpack8(u32x4 u, float* o) {
  o[0] = __uint_as_float(u.x << 16); o[1] = __uint_as_float(u.x & 0xffff0000u);
  o[2] = __uint_as_float(u.y << 16); o[3] = __uint_as_float(u.y & 0xffff0000u);
  o[4] = __uint_as_float(u.z << 16); o[5] = __uint_as_float(u.z & 0xffff0000u);
  o[6] = __uint_as_float(u.w << 16); o[7] = __uint_as_float(u.w & 0xffff0000u);
}
DEVI void load8bf(const u16* p, float* o) { unpack8(*(const u32x4*)p, o); }
DEVI float wave_sum(float v) {
  v += __shfl_xor(v, 32); v += __shfl_xor(v, 16); v += __shfl_xor(v, 8);
  v += __shfl_xor(v, 4); v += __shfl_xor(v, 2); v += __shfl_xor(v, 1);
  return v;
}
DEVI float red4x_sum(float v) { v += __shfl_xor(v, 16); v += __shfl_xor(v, 32); return v; }
DEVI float red4x_max(float v) { v = fmaxf(v, __shfl_xor(v, 16)); v = fmaxf(v, __shfl_xor(v, 32)); return v; }
DEVI float red16_sum(float v) {
  v += __shfl_xor(v, 1); v += __shfl_xor(v, 2); v += __shfl_xor(v, 4); v += __shfl_xor(v, 8);
  return v;
}
DEVI float red16_max(float v) {
  v = fmaxf(v, __shfl_xor(v, 1)); v = fmaxf(v, __shfl_xor(v, 2));
  v = fmaxf(v, __shfl_xor(v, 4)); v = fmaxf(v, __shfl_xor(v, 8));
  return v;
}

DEVI void conv_tile(int tid_, const float* src, int K, int N, u16* dst, int tile, char* smem, const float* gain = nullptr) {
  float (*s)[65] = (float (*)[65])smem;
  const int nN = N >> 6;
  const int tk = tile / nN, tn = tile - tk * nN;
  const int tx = tid_ & 63, ty = tid_ >> 6;
  for (int r = ty; r < 64; r += 4) s[r][tx] = src[(size_t)(tk * 64 + r) * N + tn * 64 + tx];
  __syncthreads();
  const float gk = gain ? gain[tk * 64 + tx] : 1.f;
  for (int r = ty; r < 64; r += 4) dst[(size_t)(tn * 64 + r) * K + tk * 64 + tx] = f2bf(s[tx][r] * gk);
  __syncthreads();
}

DEVI void phase_conv(int tid_, int vb_, int vg_, const Params& p, int l, char* smem) {
  u16* WB = (u16*)(p.ws + OFF_WB);
  const int c0 = 1376, c1 = c0 + 128, c2 = c1 + 128, c3 = c2 + 256, c4 = c3 + 256, c5 = c4 + 512,
            c6 = c5 + 256, c7 = c6 + 1024, c8 = c7 + 1024, c9 = c8 + 16, c10 = c9 + 16, c11 = c10 + 16;
  for (int t = vb_; t < c11; t += vg_) {
    if (t < c0) conv_tile(tid_, p.in[I_W_IN] + (size_t)l * 1024 * 5504, 1024, 5504, WB + W_IN, t, smem, p.in[I_NORM_MIX] + (size_t)l * 1024);
    else if (t < c1) conv_tile(tid_, p.in[I_W_BR_RWKV] + (size_t)l * 512 * 1024, 512, 1024, WB + W_BRR, t - c0, smem);
    else if (t < c2) conv_tile(tid_, p.in[I_W_BR_NAT] + (size_t)l * 512 * 1024, 512, 1024, WB + W_BRN, t - c1, smem);
    else if (t < c3) conv_tile(tid_, p.in[I_W_OUT] + (size_t)l * 1024 * 1024, 1024, 1024, WB + W_OUT, t - c2, smem);
    else if (t < c4) conv_tile(tid_, p.in[I_W_XQ] + (size_t)l * 1024 * 1024, 1024, 1024, WB + W_XQ, t - c3, smem, p.in[I_NORM_X] + (size_t)l * 1024);
    else if (t < c5) conv_tile(tid_, p.in[I_W_XKV] + (size_t)l * 1024 * 2048, 1024, 2048, WB + W_XKV, t - c4, smem);
    else if (t < c6) conv_tile(tid_, p.in[I_W_XO] + (size_t)l * 1024 * 1024, 1024, 1024, WB + W_XO, t - c5, smem);
    else if (t < c7) conv_tile(tid_, p.in[I_W_FF1] + (size_t)l * 1024 * 4096, 1024, 4096, WB + W_FF1, t - c6, smem, p.in[I_NORM_FF] + (size_t)l * 1024);
    else if (t < c8) conv_tile(tid_, p.in[I_W_FF2] + (size_t)l * 4096 * 1024, 4096, 1024, WB + W_FF2, t - c7, smem);
    else if (t < c9) conv_tile(tid_, p.in[I_G_UP] + (size_t)l * 128 * 512, 128, 512, WB + W_GUP, t - c8, smem);
    else if (t < c10) { const int dd = (t - c9) >> 3; conv_tile(tid_, p.in[I_W_UP] + (size_t)(l * 2 + dd) * 64 * 512, 64, 512, WB + W_WUP + (size_t)dd * 512 * 64, (t - c9) & 7, smem); }
    else { const int dd = (t - c10) >> 3; conv_tile(tid_, p.in[I_A_UP] + (size_t)(l * 2 + dd) * 64 * 512, 64, 512, WB + W_AUP + (size_t)dd * 512 * 64, (t - c10) & 7, smem); }
  }
}

DEVI void norm_row_bf16(int tid_, const float* src, const float* g, u16* dst, float* xcopy) {
  const int lane = tid_ & 63;
  float4 v[4];
  float ss = 0.f;
#pragma unroll
  for (int i = 0; i < 4; ++i) {
    v[i] = ((const float4*)src)[lane + i * 64];
    ss += v[i].x * v[i].x + v[i].y * v[i].y + v[i].z * v[i].z + v[i].w * v[i].w;
  }
  ss = wave_sum(ss);
  const float rs = rsqrtf(ss * (1.f / 1024.f) + 1e-6f);
#pragma unroll
  for (int i = 0; i < 4; ++i) {
    float4 gg = ((const float4*)g)[lane + i * 64];
    u32x2 o;
    o.x = pack2(v[i].x * rs * gg.x, v[i].y * rs * gg.y);
    o.y = pack2(v[i].z * rs * gg.z, v[i].w * rs * gg.w);
    ((u32x2*)dst)[lane + i * 64] = o;
    if (xcopy) ((float4*)xcopy)[lane + i * 64] = v[i];
  }
}

DEVI void phase_xb(int tid_, int vb_, int vg_, const Params& p, bool from_input, size_t hoff, float* ssq) {
  u16* H = (u16*)(p.ws + hoff);
  const int wid = tid_ >> 6, lane = tid_ & 63;
  for (int r = vb_ * 4 + wid; r < NTOK; r += vg_ * 4) {
    const float* src;
    if (from_input) src = (r < 32768) ? p.in[I_XP] + (size_t)r * 1024 : p.in[I_XS] + (size_t)(r - 32768) * 1024;
    else src = p.X + (size_t)r * 1024;
    float ss = 0.f;
#pragma unroll
    for (int i = 0; i < 4; ++i) {
      const float4 v = ((const float4*)src)[lane + i * 64];
      ss += v.x * v.x + v.y * v.y + v.z * v.z + v.w * v.w;
      u32x2 o;
      o.x = pack2(v.x, v.y); o.y = pack2(v.z, v.w);
      ((u32x2*)(H + (size_t)r * 1024))[lane + i * 64] = o;
    }
    if (ssq) {
      ss = wave_sum(ss);
      if (lane == 0) ssq[r] = ss;
    }
  }
}
DEVI void phase_norm_mem(int tid_, int vb_, int vg_, const Params& p, const float* g) {
  u16* MH = (u16*)(p.ws + OFF_MEMH);
  const int wid = tid_ >> 6;
  for (int r = vb_ * 4 + wid; r < 3072; r += vg_ * 4) {
    const float* src = (r < 2048) ? p.in[I_MP] + (size_t)r * 1024 : p.in[I_MS] + (size_t)(r - 2048) * 1024;
    norm_row_bf16(tid_, src, g, MH + (size_t)r * 1024, nullptr);
  }
}
DEVI void phase_final_norm(int tid_, int vb_, int vg_, const Params& p) {
  const float* g = p.in[I_NORM_FINAL];
  const float* ssq = (const float*)(p.ws + OFF_SSQ) + (size_t)6 * NTOK;
  const int wid = tid_ >> 6, lane = tid_ & 63;
  for (int r = vb_ * 4 + wid; r < NTOK; r += vg_ * 4) {
    float* row = p.X + (size_t)r * 1024;
    const float rs = rsqrtf(ssq[r] * (1.f / 1024.f) + 1e-6f);
#pragma unroll
    for (int i = 0; i < 4; ++i) {
      const float4 v = ((const float4*)row)[lane + i * 64];
      const float4 gg = ((const float4*)g)[lane + i * 64];
      float4 o;
      o.x = v.x * rs * gg.x; o.y = v.y * rs * gg.y; o.z = v.z * rs * gg.z; o.w = v.w * rs * gg.w;
      ((float4*)row)[lane + i * 64] = o;
    }
  }
}

template <int OFF>
DEVI bf16x8 lds_rd128(uint32_t addr) {
  bf16x8 r;
  asm volatile("ds_read_b128 %0, %1 offset:%2" : "=v"(r) : "v"(addr), "n"(OFF));
  return r;
}

template <int NW, bool SWAP>
DEVI void gemm_kloop(int tid_, f32x4 (&acc)[4][NW], const u16* __restrict__ A, int lda, const u16* __restrict__ Bt, int ldb,
                     int K, char* smem) {
  constexpr int STG = 8192 + NW * 2048;
  constexpr int NB = NW / 2;
  const int tid = tid_, lane = tid & 63, wid = tid >> 6;
  const int wr = wid >> 1, wc = wid & 1, fr = lane & 15, fq = lane >> 4;
  const int lrow = lane >> 2, lphys = lane & 3, lhi = lane >> 4;
  const int gsw = (4 - lhi) & 3;
  const u16* ga[2];
  const u16* gb[NB];
#pragma unroll
  for (int q = 0; q < 2; ++q) ga[q] = A + (size_t)((wid * 2 + q) * 16 + lrow) * lda + (lphys ^ gsw) * 8;
#pragma unroll
  for (int q = 0; q < NB; ++q) gb[q] = Bt + (size_t)((wid * NB + q) * 16 + lrow) * ldb + (lphys ^ gsw) * 8;
  const int rsw = (4 - ((fr >> 2) & 3)) & 3;
  const int ch = (fq ^ rsw) * 16;
  const int nk = K >> 5;
  const uint32_t lds_base = (uint32_t)(size_t)(__attribute__((address_space(3))) char*)smem;
  const uint32_t aoff = (uint32_t)((wr * 64 + fr) * 64 + ch);
  const uint32_t boff = (uint32_t)(8192 + (wc * 16 * NW + fr) * 64 + ch);
  asm volatile("s_waitcnt vmcnt(0)" ::: "memory");
  __syncthreads();
#define GEMM_ISSUE(kt_)                                                                                              \
  do {                                                                                                               \
    char* nb_ = smem + ((kt_) & 3) * STG;                                                                            \
    _Pragma("unroll") for (int q = 0; q < 2; ++q) __builtin_amdgcn_global_load_lds(                                  \
        (const unsigned*)(ga[q] + (kt_) * 32),                                                                       \
        (__attribute__((address_space(3))) unsigned*)(nb_ + (wid * 2 + q) * 1024 + lane * 16), 16, 0, 0);            \
    _Pragma("unroll") for (int q = 0; q < NB; ++q) __builtin_amdgcn_global_load_lds(                                 \
        (const unsigned*)(gb[q] + (kt_) * 32),                                                                       \
        (__attribute__((address_space(3))) unsigned*)(nb_ + 8192 + (wid * NB + q) * 1024 + lane * 16), 16, 0, 0);    \
  } while (0)
  GEMM_ISSUE(0);
  if (nk > 1) GEMM_ISSUE(1);
  if (nk > 2) GEMM_ISSUE(2);
  for (int kt = 0; kt < nk; ++kt) {
    if (kt + 2 < nk) {
      if (NW == 4) asm volatile("s_waitcnt vmcnt(8)" ::: "memory");
      else asm volatile("s_waitcnt vmcnt(6)" ::: "memory");
    } else if (kt + 1 < nk) {
      if (NW == 4) asm volatile("s_waitcnt vmcnt(4)" ::: "memory");
      else asm volatile("s_waitcnt vmcnt(3)" ::: "memory");
    } else {
      asm volatile("s_waitcnt vmcnt(0)" ::: "memory");
    }
    __builtin_amdgcn_s_barrier();
    asm volatile("" ::: "memory");
    if (kt + 3 < nk) GEMM_ISSUE(kt + 3);
    const uint32_t sb = lds_base + (kt & 3) * STG;
    bf16x8 af[4], bfr[4];
    af[0] = lds_rd128<0>(sb + aoff); af[1] = lds_rd128<1024>(sb + aoff);
    af[2] = lds_rd128<2048>(sb + aoff); af[3] = lds_rd128<3072>(sb + aoff);
    bfr[0] = lds_rd128<0>(sb + boff); bfr[1] = lds_rd128<1024>(sb + boff);
    if (NW == 4) {
      bfr[2] = lds_rd128<2048>(sb + boff); bfr[3] = lds_rd128<3072>(sb + boff);
      asm volatile("s_waitcnt lgkmcnt(0)" : "+v"(af[0]), "+v"(af[1]), "+v"(af[2]), "+v"(af[3]),
                   "+v"(bfr[0]), "+v"(bfr[1]), "+v"(bfr[2]), "+v"(bfr[3]));
    } else {
      asm volatile("s_waitcnt lgkmcnt(0)" : "+v"(af[0]), "+v"(af[1]), "+v"(af[2]), "+v"(af[3]), "+v"(bfr[0]), "+v"(bfr[1]));
    }
#pragma unroll
    for (int m = 0; m < 4; ++m)
#pragma unroll
      for (int n = 0; n < NW; ++n) {
        if (SWAP) acc[m][n] = __builtin_amdgcn_mfma_f32_16x16x32_bf16(bfr[n], af[m], acc[m][n], 0, 0, 0);
        else acc[m][n] = __builtin_amdgcn_mfma_f32_16x16x32_bf16(af[m], bfr[n], acc[m][n], 0, 0, 0);
      }
  }
#undef GEMM_ISSUE
}

DEVI int launder(int x) { asm volatile("" : "+v"(x)); return x; }

template <int NW>
DEVI void zero_acc(f32x4 (&acc)[4][NW]) {
#pragma unroll
  for (int m = 0; m < 4; ++m)
#pragma unroll
    for (int n = 0; n < NW; ++n) acc[m][n] = (f32x4){0.f, 0.f, 0.f, 0.f};
}

struct NoEpi { DEVI void operator()(int, int, f32x4) const {} };

template <class EpiS, class EpiN>
DEVI void gemm_phase(int tid_, const u16* A, int lda, const u16* Bt, int ldb, int K, int M, int N, char* smem, int ns_from,
                     EpiS epiS, EpiN epiN) {
  const int nN = N >> 7, nM = M >> 7;
  const int lane = tid_ & 63, wid = tid_ >> 6;
  const int wr = wid >> 1, wc = wid & 1, fr = lane & 15, fq = lane >> 4;
  const int xcd = blockIdx.x & 7, jloc = blockIdx.x >> 3, nloc = gridDim.x >> 3;
  for (int lt = jloc; lt < (nM >> 3) * nN; lt += nloc) {
    const int tml = lt / nN, tn = lt - tml * nN;
    const int tm = tml * 8 + xcd;
    const int m0 = tm << 7, n0 = tn << 7;
    f32x4 acc[4][4];
    zero_acc(acc);
    if (n0 < ns_from) {
      gemm_kloop<4, true>(tid_, acc, A + (size_t)m0 * lda, lda, Bt + (size_t)n0 * ldb, ldb, K, smem);
#pragma unroll
      for (int m = 0; m < 4; ++m)
#pragma unroll
        for (int n = 0; n < 4; ++n) epiS(m0 + wr * 64 + m * 16 + fr, n0 + wc * 64 + n * 16 + fq * 4, acc[m][n]);
    } else {
      gemm_kloop<4, false>(tid_, acc, A + (size_t)m0 * lda, lda, Bt + (size_t)n0 * ldb, ldb, K, smem);
#pragma unroll
      for (int m = 0; m < 4; ++m)
#pragma unroll
        for (int n = 0; n < 4; ++n) epiN(m0 + wr * 64 + m * 16 + fq * 4, n0 + wc * 64 + n * 16 + fr, acc[m][n]);
    }
  }
}


template <bool SWAP>
DEVI void gemm_kloop_big(int tid_, f32x4 (&acc)[8][4], const u16* __restrict__ A, int lda, const u16* __restrict__ Bt,
                         int ldb, int K, char* smem) {
  constexpr int STG = 16384 + 8192;
  const int tid = tid_, lane = tid & 63, wid = tid >> 6;
  const int wr = wid >> 1, wc = wid & 1, fr = lane & 15, fq = lane >> 4;
  const int lrow = lane >> 2, lphys = lane & 3, lhi = lane >> 4;
  const int gsw = (4 - lhi) & 3;
  const u16* ga = A + (size_t)(wid * 64 + lrow) * lda + (lphys ^ gsw) * 8;
  const u16* gb = Bt + (size_t)(wid * 32 + lrow) * ldb + (lphys ^ gsw) * 8;
  const size_t a16 = (size_t)16 * lda, b16 = (size_t)16 * ldb;
  const int rsw = (4 - ((fr >> 2) & 3)) & 3;
  const int ch = (fq ^ rsw) * 16;
  const int nk = K >> 5;
  const uint32_t lds_base = (uint32_t)(size_t)(__attribute__((address_space(3))) char*)smem;
  const uint32_t aoff = (uint32_t)((wr * 128 + fr) * 64 + ch);
  const uint32_t boff = (uint32_t)(16384 + (wc * 64 + fr) * 64 + ch);
  asm volatile("s_waitcnt vmcnt(0)" ::: "memory");
  __syncthreads();
#define GEMMB_ISSUE(kt_, buf_)                                                                                       \
  do {                                                                                                               \
    char* nb_ = smem + (buf_) * STG;                                                                                 \
    _Pragma("unroll") for (int q = 0; q < 4; ++q) __builtin_amdgcn_global_load_lds(                                  \
        (const unsigned*)(ga + q * a16 + (kt_) * 32),                                                                \
        (__attribute__((address_space(3))) unsigned*)(nb_ + (wid * 4 + q) * 1024 + lane * 16), 16, 0, 0);            \
    _Pragma("unroll") for (int q = 0; q < 2; ++q) __builtin_amdgcn_global_load_lds(                                  \
        (const unsigned*)(gb + q * b16 + (kt_) * 32),                                                                \
        (__attribute__((address_space(3))) unsigned*)(nb_ + 16384 + (wid * 2 + q) * 1024 + lane * 16), 16, 0, 0);   \
  } while (0)
  GEMMB_ISSUE(0, 0);
  if (nk > 1) GEMMB_ISSUE(1, 1);
  int cb = 0;
  for (int kt = 0; kt < nk; ++kt) {
    if (kt + 1 < nk) asm volatile("s_waitcnt vmcnt(6)" ::: "memory");
    else asm volatile("s_waitcnt vmcnt(0)" ::: "memory");
    __builtin_amdgcn_s_barrier();
    asm volatile("" ::: "memory");
    const int nbuf = (cb == 0) ? 2 : cb - 1;
    if (kt + 2 < nk) GEMMB_ISSUE(kt + 2, nbuf);
    const uint32_t sb = lds_base + cb * STG;
    bf16x8 a0[4], a1[4], bb[4];
    a0[0] = lds_rd128<0>(sb + aoff); a0[1] = lds_rd128<1024>(sb + aoff);
    a0[2] = lds_rd128<2048>(sb + aoff); a0[3] = lds_rd128<3072>(sb + aoff);
    bb[0] = lds_rd128<0>(sb + boff); bb[1] = lds_rd128<1024>(sb + boff);
    bb[2] = lds_rd128<2048>(sb + boff); bb[3] = lds_rd128<3072>(sb + boff);
    a1[0] = lds_rd128<4096>(sb + aoff); a1[1] = lds_rd128<5120>(sb + aoff);
    a1[2] = lds_rd128<6144>(sb + aoff); a1[3] = lds_rd128<7168>(sb + aoff);
    asm volatile("s_waitcnt lgkmcnt(4)" : "+v"(a0[0]), "+v"(a0[1]), "+v"(a0[2]), "+v"(a0[3]),
                 "+v"(bb[0]), "+v"(bb[1]), "+v"(bb[2]), "+v"(bb[3]));
#pragma unroll
    for (int m = 0; m < 4; ++m)
#pragma unroll
      for (int n = 0; n < 4; ++n) {
        if (SWAP) acc[m][n] = __builtin_amdgcn_mfma_f32_16x16x32_bf16(bb[n], a0[m], acc[m][n], 0, 0, 0);
        else acc[m][n] = __builtin_amdgcn_mfma_f32_16x16x32_bf16(a0[m], bb[n], acc[m][n], 0, 0, 0);
      }
    asm volatile("s_waitcnt lgkmcnt(0)" : "+v"(a1[0]), "+v"(a1[1]), "+v"(a1[2]), "+v"(a1[3]));
#pragma unroll
    for (int m = 0; m < 4; ++m)
#pragma unroll
      for (int n = 0; n < 4; ++n) {
        if (SWAP) acc[4 + m][n] = __builtin_amdgcn_mfma_f32_16x16x32_bf16(bb[n], a1[m], acc[4 + m][n], 0, 0, 0);
        else acc[4 + m][n] = __builtin_amdgcn_mfma_f32_16x16x32_bf16(a1[m], bb[n], acc[4 + m][n], 0, 0, 0);
      }
    cb = (cb == 2) ? 0 : cb + 1;
  }
#undef GEMMB_ISSUE
}

template <class EpiS, class EpiN>
DEVI void gemm_phase_big(int tid_, const u16* A, int lda, const u16* Bt, int ldb, int K, int M, int N, char* smem,
                         int ns_from, EpiS epiS, EpiN epiN) {
  const int nN = N >> 7, nM = M >> 8;
  const int lane = tid_ & 63, wid = tid_ >> 6;
  const int wr = wid >> 1, wc = wid & 1, fr = lane & 15, fq = lane >> 4;
  const int xcd = blockIdx.x & 7, jloc = blockIdx.x >> 3, nloc = gridDim.x >> 3;
  for (int lt = jloc; lt < (nM >> 3) * nN; lt += nloc) {
    const int tml = lt / nN, tn = lt - tml * nN;
    const int tm = tml * 8 + xcd;
    const int m0 = tm << 8, n0 = tn << 7;
    f32x4 acc[8][4];
#pragma unroll
    for (int m = 0; m < 8; ++m)
#pragma unroll
      for (int n = 0; n < 4; ++n) acc[m][n] = (f32x4){0.f, 0.f, 0.f, 0.f};
    if (n0 < ns_from) {
      gemm_kloop_big<true>(launder(tid_), acc, A + (size_t)m0 * lda, lda, Bt + (size_t)n0 * ldb, ldb, K, smem);
#pragma unroll
      for (int m = 0; m < 8; ++m)
#pragma unroll
        for (int n = 0; n < 4; ++n) epiS(m0 + wr * 128 + m * 16 + fr, n0 + wc * 64 + n * 16 + fq * 4, acc[m][n]);
    } else {
      gemm_kloop_big<false>(launder(tid_), acc, A + (size_t)m0 * lda, lda, Bt + (size_t)n0 * ldb, ldb, K, smem);
#pragma unroll
      for (int m = 0; m < 8; ++m)
#pragma unroll
        for (int n = 0; n < 4; ++n) epiN(m0 + wr * 128 + m * 16 + fq * 4, n0 + wc * 64 + n * 16 + fr, acc[m][n]);
    }
  }
}


template <bool SWAP>
DEVI void gemm_kloop8(int tid_, f32x4 (&acc)[8][4], const u16* __restrict__ A, int lda, const u16* __restrict__ Bt,
                      int ldb, int K, char* smem, bool have_pref = false, const u16* An = nullptr, int lda_n = 0,
                      const u16* Bn = nullptr, int ldb_n = 0) {
  constexpr int STG = 65536;
  const int tid = tid_, lane = tid & 63, wid = tid >> 6;
  const int wr = wid >> 2, wc = wid & 3, fr = lane & 15, fq = lane >> 4;
  const int lrow = lane >> 3, lphys = lane & 7, lhi = lane >> 4;
  const u16* ga[4];
  const u16* gb[4];
#pragma unroll
  for (int q = 0; q < 4; ++q) {
    const int kc = lphys ^ ((4 * (q & 1) + lhi) & 7);
    ga[q] = A + (size_t)((wid * 4 + q) * 8 + lrow) * lda + kc * 8;
    gb[q] = Bt + (size_t)((wid * 4 + q) * 8 + lrow) * ldb + kc * 8;
  }
  const int swz = (fr >> 1) & 7;
  const int nk = K >> 6;
  const uint32_t lds_base = (uint32_t)(size_t)(__attribute__((address_space(3))) char*)smem;
  const uint32_t arow = (uint32_t)((wr * 128 + fr) * 128);
  const uint32_t brow = (uint32_t)(32768 + (wc * 64 + fr) * 128);
  if (__builtin_amdgcn_readfirstlane(tid_) >= 256) __builtin_amdgcn_s_setprio(1);
  if (!have_pref) {
    asm volatile("s_waitcnt vmcnt(0)" ::: "memory");
    __syncthreads();
  }
#define GEMM8_ISSUE(kt_)                                                                                             \
  do {                                                                                                               \
    char* nb_ = smem + ((kt_) & 1) * STG;                                                                            \
    _Pragma("unroll") for (int q = 0; q < 4; ++q) __builtin_amdgcn_global_load_lds(                                  \
        (const unsigned*)(ga[q] + (kt_) * 64),                                                                       \
        (__attribute__((address_space(3))) unsigned*)(nb_ + (wid * 4 + q) * 1024 + lane * 16), 16, 0, 0);            \
    _Pragma("unroll") for (int q = 0; q < 4; ++q) __builtin_amdgcn_global_load_lds(                                  \
        (const unsigned*)(gb[q] + (kt_) * 64),                                                                       \
        (__attribute__((address_space(3))) unsigned*)(nb_ + 32768 + (wid * 4 + q) * 1024 + lane * 16), 16, 0, 0);    \
  } while (0)
  if (!have_pref) GEMM8_ISSUE(0);
  for (int kt = 0; kt < nk; ++kt) {
    asm volatile("s_waitcnt vmcnt(0)" ::: "memory");
    __builtin_amdgcn_s_barrier();
    asm volatile("" ::: "memory");
    if (kt + 1 < nk) GEMM8_ISSUE(kt + 1);
    else if (An) {
#pragma unroll
      for (int q = 0; q < 4; ++q) {
        const int kc = lphys ^ ((4 * (q & 1) + lhi) & 7);
        __builtin_amdgcn_global_load_lds((const unsigned*)(An + (size_t)((wid * 4 + q) * 8 + lrow) * lda_n + kc * 8),
            (__attribute__((address_space(3))) unsigned*)(smem + (wid * 4 + q) * 1024 + lane * 16), 16, 0, 0);
        __builtin_amdgcn_global_load_lds((const unsigned*)(Bn + (size_t)((wid * 4 + q) * 8 + lrow) * ldb_n + kc * 8),
            (__attribute__((address_space(3))) unsigned*)(smem + 32768 + (wid * 4 + q) * 1024 + lane * 16), 16, 0, 0);
      }
    }
    const uint32_t sb = lds_base + (kt & 1) * STG;
#pragma unroll
    for (int ks = 0; ks < 2; ++ks) {
      const uint32_t chb = (uint32_t)(((ks * 4 + fq) ^ swz) * 16);
      const uint32_t aoff = sb + arow + chb, boff = sb + brow + chb;
      bf16x8 a0[4], a1[4], bb[4];
      a0[0] = lds_rd128<0>(aoff); a0[1] = lds_rd128<2048>(aoff);
      a0[2] = lds_rd128<4096>(aoff); a0[3] = lds_rd128<6144>(aoff);
      bb[0] = lds_rd128<0>(boff); bb[1] = lds_rd128<2048>(boff);
      bb[2] = lds_rd128<4096>(boff); bb[3] = lds_rd128<6144>(boff);
      a1[0] = lds_rd128<8192>(aoff); a1[1] = lds_rd128<10240>(aoff);
      a1[2] = lds_rd128<12288>(aoff); a1[3] = lds_rd128<14336>(aoff);
      asm volatile("s_waitcnt lgkmcnt(4)" : "+v"(a0[0]), "+v"(a0[1]), "+v"(a0[2]), "+v"(a0[3]),
                   "+v"(bb[0]), "+v"(bb[1]), "+v"(bb[2]), "+v"(bb[3]));
#pragma unroll
      for (int m = 0; m < 4; ++m)
#pragma unroll
        for (int n = 0; n < 4; ++n) {
          if (SWAP) acc[m][n] = __builtin_amdgcn_mfma_f32_16x16x32_bf16(bb[n], a0[m], acc[m][n], 0, 0, 0);
          else acc[m][n] = __builtin_amdgcn_mfma_f32_16x16x32_bf16(a0[m], bb[n], acc[m][n], 0, 0, 0);
        }
      asm volatile("s_waitcnt lgkmcnt(0)" : "+v"(a1[0]), "+v"(a1[1]), "+v"(a1[2]), "+v"(a1[3]));
#pragma unroll
      for (int m = 0; m < 4; ++m)
#pragma unroll
        for (int n = 0; n < 4; ++n) {
          if (SWAP) acc[4 + m][n] = __builtin_amdgcn_mfma_f32_16x16x32_bf16(bb[n], a1[m], acc[4 + m][n], 0, 0, 0);
          else acc[4 + m][n] = __builtin_amdgcn_mfma_f32_16x16x32_bf16(a1[m], bb[n], acc[4 + m][n], 0, 0, 0);
        }
    }
  }
#undef GEMM8_ISSUE
  __builtin_amdgcn_s_setprio(0);
}

struct NoRow { DEVI void operator()(int) const {} };
struct NoPair { static constexpr bool enabled = false; DEVI void operator()(int, int, f32x4, f32x4) const {} };

DEVI void store_pair_bf16(u16* rowp, int c, int fq, u32x2 p0, u32x2 p1) {
  const auto sx = __builtin_amdgcn_permlane16_swap(p0.x, p1.x, false, false);
  const auto sy = __builtin_amdgcn_permlane16_swap(p0.y, p1.y, false, false);
  u32x4 o;
  o.x = sx[0]; o.y = sy[0]; o.z = sx[1]; o.w = sy[1];
  const int col = (fq & 1) ? (c + 16 + (fq - 1) * 4) : (c + fq * 4);
  *(u32x4*)(rowp + col) = o;
}
DEVI u32x2 pack4bf(f32x4 v) { u32x2 o; o.x = pack2(v[0], v[1]); o.y = pack2(v[2], v[3]); return o; }
template <class F> struct PairEpi {
  static constexpr bool enabled = true;
  F f;
  DEVI void operator()(int r, int c, f32x4 a, f32x4 b) const { f(r, c, a, b); }
};
template <class F> DEVI PairEpi<F> make_pair_epi(F f) { return PairEpi<F>{f}; }

template <class EpiS, class EpiN, class RowEnd = NoRow, class EpiP = NoPair>
DEVI void gemm_phase8(int tid_, const u16* A, int lda, const u16* Bt, int ldb, int K, int M, int N, char* smem,
                      int ns_from, EpiS epiS, EpiN epiN, RowEnd rowEnd = NoRow(), int rot = 0, EpiP epiP = NoPair()) {
  const int nN = (N + 255) >> 8, nM = M >> 8;
  const int lane = tid_ & 63, wid = tid_ >> 6;
  const int wr = wid >> 2, wc = wid & 3, fr = lane & 15, fq = lane >> 4;
  const bool xmap = ((gridDim.x & 7) == 0) && ((nM & 7) == 0);
  const int xcd = blockIdx.x & 7;
  const int first = xmap ? (int)(blockIdx.x >> 3) : (int)((blockIdx.x + gridDim.x - rot) % gridDim.x);
  const int stride = xmap ? (int)(gridDim.x >> 3) : (int)gridDim.x;
  const int count = xmap ? (nM >> 3) * nN : nM * nN;
  bool pref = false;
  for (int it = first; it < count; it += stride) {
    const int tq = it / nN, tn = it - tq * nN;
    const int tm = xmap ? tq * 8 + xcd : tq;
    const int m0 = tm << 8, n0 = tn << 8;
    const int colb = n0 + wc * 64;
    const u16* An = nullptr; const u16* Bn = nullptr;
    if (it + stride < count) {
      const int it2 = it + stride;
      const int tq2 = it2 / nN, tn2 = it2 - tq2 * nN;
      An = A + (size_t)((xmap ? tq2 * 8 + xcd : tq2) << 8) * lda;
      Bn = Bt + (size_t)(tn2 << 8) * ldb;
    }
    f32x4 acc[8][4];
#pragma unroll
    for (int m = 0; m < 8; ++m)
#pragma unroll
      for (int n = 0; n < 4; ++n) acc[m][n] = (f32x4){0.f, 0.f, 0.f, 0.f};
    if (colb < ns_from) {
      gemm_kloop8<true>(launder(tid_), acc, A + (size_t)m0 * lda, lda, Bt + (size_t)n0 * ldb, ldb, K, smem, pref, An, lda, Bn, ldb);
      if (colb < N) {
        if (EpiP::enabled) {
#pragma unroll
          for (int m = 0; m < 8; ++m) {
            epiP(m0 + wr * 128 + m * 16 + fr, colb, acc[m][0], acc[m][1]);
            epiP(m0 + wr * 128 + m * 16 + fr, colb + 32, acc[m][2], acc[m][3]);
            rowEnd(m0 + wr * 128 + m * 16 + fr);
          }
        } else {
#pragma unroll
          for (int m = 0; m < 8; ++m) {
#pragma unroll
            for (int n = 0; n < 4; ++n) epiS(m0 + wr * 128 + m * 16 + fr, colb + n * 16 + fq * 4, acc[m][n]);
            rowEnd(m0 + wr * 128 + m * 16 + fr);
          }
        }
      }
    } else {
      gemm_kloop8<false>(launder(tid_), acc, A + (size_t)m0 * lda, lda, Bt + (size_t)n0 * ldb, ldb, K, smem, pref, An, lda, Bn, ldb);
      if (colb < N) {
#pragma unroll
        for (int m = 0; m < 8; ++m)
#pragma unroll
          for (int n = 0; n < 4; ++n) epiN(m0 + wr * 128 + m * 16 + fq * 4, colb + n * 16 + fr, acc[m][n]);
      }
    }
    pref = (An != nullptr);
  }
  asm volatile("s_waitcnt vmcnt(0)" ::: "memory");
}

DEVI void store4bf(u16* dst, f32x4 v) {
  u32x2 o;
  o.x = pack2(v[0], v[1]); o.y = pack2(v[2], v[3]);
  *(u32x2*)dst = o;
}

DEVI float rstd_of(const float* ssq, int r) { return rsqrtf(ssq[r] * (1.f / 1024.f) + 1e-6f); }

DEVI void phase_p_gemm(int tid_, const Params& p, char* smem, const float* ssq) {
  u16* WB = (u16*)(p.ws + OFF_WB);
  const u16* H = (const u16*)(p.ws + OFF_H);
  u16* PR = (u16*)(p.ws + OFF_PR);
  u16* NQ = (u16*)(p.ws + OFF_NQ);
  u16* NK = (u16*)(p.ws + OFF_NK);
  u16* NVT = (u16*)(p.ws + OFF_NV);
  gemm_phase8(tid_, H, 1024, WB + W_IN, 1024, 1024, NTOK, 3456, smem, 2944,
    [&](int r, int c0, f32x4 v) {
      v = v * rstd_of(ssq, r);
      if (c0 < 1920) store4bf(PR + (size_t)r * PRW + c0, v);
      else if (c0 < 2432) store4bf(NQ + (size_t)r * 512 + (c0 - 1920), v);
      else store4bf(NK + (size_t)r * 512 + (c0 - 2432), v);
    },
    [&](int r0, int c, f32x4 v) {
      const int cc = c - 2944;
      const int s = r0 >> 12, t = r0 & 4095;
      const f32x4 q = *(const f32x4*)(ssq + r0);
#pragma unroll
      for (int j = 0; j < 4; ++j) v[j] *= rsqrtf(q[j] * (1.f / 1024.f) + 1e-6f);
      store4bf(NVT + ((size_t)(s * 512 + cc)) * 4096 + t, v);
    }, NoRow(), 0,
    make_pair_epi([&](int r, int c, f32x4 va, f32x4 vb) {
      const float rs = rstd_of(ssq, r);
      u16* rowp; int cl;
      if (c < 1920) { rowp = PR + (size_t)r * PRW; cl = c; }
      else if (c < 2432) { rowp = NQ + (size_t)r * 512; cl = c - 1920; }
      else { rowp = NK + (size_t)r * 512; cl = c - 2432; }
      store_pair_bf16(rowp, cl, (tid_ & 63) >> 4, pack4bf(va * rs), pack4bf(vb * rs));
    }));
  const u16* MH = (const u16*)(p.ws + OFF_MEMH);
  u16* KVK = (u16*)(p.ws + OFF_KVK);
  u16* KVT = (u16*)(p.ws + OFF_KVT);
  gemm_phase8(tid_, MH, 1024, WB + W_XKV, 1024, 1024, 3072, 2048, smem, 1024,
    [&](int r, int c0, f32x4 v) { store4bf(KVK + (size_t)r * 1024 + c0, v); },
    [&](int r0, int c, f32x4 v) {
      const int cc = c - 1024;
      const int s = r0 >> 8, m = r0 & 255;
      store4bf(KVT + ((size_t)(s * 1024 + cc)) * 256 + m, v);
    }, NoRow(), 128);
}

DEVI void phase_nat(int tid_, const Params& p, int l, char* smem, int bfirst, int bstride) {
  u16* NQ = (u16*)(p.ws + OFF_NQ);
  const u16* NK = (const u16*)(p.ws + OFF_NK);
  const u16* NVT = (const u16*)(p.ws + OFF_NV);
  const float* rpb = p.in[I_RPB] + (size_t)l * 8 * 15 * 31;
  const int lane = tid_ & 63, g = tid_ >> 6, fr = lane & 15, fq = lane >> 4;
  u16* Pw = (u16*)smem + g * (16 * 264);
  const int cb = (g == 0) ? 0 : (g == 1) ? 8 : (g == 2) ? 24 : 32;
  const int c = g * 16 + fr;
  int cs = c - 8; cs = cs < 0 ? 0 : (cs > 48 ? 48 : cs);
  for (int t = bfirst; t < 12 * 64 * 8; t += bstride) {
    const int h = t & 7, ri = (t >> 3) & 63, s = t >> 9;
    int rs = ri - 4; rs = rs < 0 ? 0 : (rs > 56 ? 56 : rs);
    const size_t tokq = (size_t)s * 4096 + ri * 64 + g * 16;
    bf16x8 aq[2];
    aq[0] = *(const bf16x8*)(NQ + (tokq + fr) * 512 + h * 64 + fq * 8);
    aq[1] = *(const bf16x8*)(NQ + (tokq + fr) * 512 + h * 64 + 32 + fq * 8);
    f32x4 acc[16];
#pragma unroll
    for (int n = 0; n < 16; ++n) {
      acc[n] = (f32x4){0.f, 0.f, 0.f, 0.f};
      const int r = n >> 1, col = cb + (n & 1) * 16 + fr;
      const u16* kp = NK + ((size_t)s * 4096 + (rs + r) * 64 + col) * 512 + h * 64 + fq * 8;
      const bf16x8 b0 = *(const bf16x8*)kp;
      const bf16x8 b1 = *(const bf16x8*)(kp + 32);
      acc[n] = __builtin_amdgcn_mfma_f32_16x16x32_bf16(b0, aq[0], acc[n], 0, 0, 0);
      acc[n] = __builtin_amdgcn_mfma_f32_16x16x32_bf16(b1, aq[1], acc[n], 0, 0, 0);
    }
    float m = -1e30f;
#pragma unroll
    for (int n = 0; n < 16; ++n) {
      const int di = rs + (n >> 1) - ri + 7;
      const float* brow = rpb + (h * 15 + di) * 31 + 15 - c;
#pragma unroll
      for (int j = 0; j < 4; ++j) {
        const int kc = cb + (n & 1) * 16 + fq * 4 + j;
        float sc = -1e30f;
        if (kc >= cs && kc < cs + 16) sc = acc[n][j] * 0.125f + brow[kc];
        acc[n][j] = sc;
        m = fmaxf(m, sc);
      }
    }
    m = red4x_max(m);
    float ssum = 0.f;
#pragma unroll
    for (int n = 0; n < 16; ++n) {
      f32x4 e;
#pragma unroll
      for (int j = 0; j < 4; ++j) { e[j] = __expf(acc[n][j] - m); ssum += e[j]; }
      store4bf(Pw + fr * 264 + n * 16 + fq * 4, e);
    }
    const float sm = 1.f / red4x_sum(ssum);
    f32x4 o[4];
#pragma unroll
    for (int n = 0; n < 4; ++n) o[n] = (f32x4){0.f, 0.f, 0.f, 0.f};
#pragma unroll
    for (int ks = 0; ks < 8; ++ks) {
      const bf16x8 ap = *(const bf16x8*)(Pw + fr * 264 + ks * 32 + fq * 8);
#pragma unroll
      for (int n = 0; n < 4; ++n) {
        const bf16x8 bv = *(const bf16x8*)(NVT + ((size_t)(s * 512 + h * 64 + n * 16 + fr)) * 4096 + (rs + ks) * 64 + cb + fq * 8);
        o[n] = __builtin_amdgcn_mfma_f32_16x16x32_bf16(bv, ap, o[n], 0, 0, 0);
      }
    }
#pragma unroll
    for (int n = 0; n < 4; n += 2)
      store_pair_bf16(NQ + (tokq + fr) * 512 + h * 64, n * 16, fq, pack4bf(o[n] * sm), pack4bf(o[n + 1] * sm));
  }
}

constexpr int SC_OPS = 0;
constexpr int SC_VV = 40960;
constexpr int SC_WR = 49152;
constexpr int SC_AP = 57344;
constexpr int SC_TW = 65536;
constexpr int SC_AD = 70144;
constexpr int SC_NRM = 74752;
constexpr int SC_MU = 74880;
constexpr int SC_CST = 77440;

typedef __attribute__((ext_vector_type(2))) float f32x2;

template <int CTRL>
DEVI float dpp_mov(float x) {
  return __int_as_float(__builtin_amdgcn_update_dpp(0, __float_as_int(x), CTRL, 0xF, 0xF, true));
}
DEVI float red8(float x) {
  x += dpp_mov<0xB1>(x);
  x += dpp_mov<0x4E>(x);
  x += dpp_mov<0x141>(x);
  return x;
}
DEVI f32x2 lo2(f32x4 v) { return __builtin_shufflevector(v, v, 0, 1); }
DEVI f32x2 hi2(f32x4 v) { return __builtin_shufflevector(v, v, 2, 3); }

struct ScanOps {
  f32x2 a[4], w[4], b[4], k[4], r[4];
  float v0, v1;
};
DEVI void scan_load(ScanOps& o, const float* OPS, const float* VV, int nn, int jg, int i0) {
  const float* base = OPS + nn * 64 + jg * 8;
  f32x4 t0, t1;
  t0 = *(const f32x4*)(base); t1 = *(const f32x4*)(base + 4);
  o.a[0] = lo2(t0); o.a[1] = hi2(t0); o.a[2] = lo2(t1); o.a[3] = hi2(t1);
  t0 = *(const f32x4*)(base + 2048); t1 = *(const f32x4*)(base + 2048 + 4);
  o.w[0] = lo2(t0); o.w[1] = hi2(t0); o.w[2] = lo2(t1); o.w[3] = hi2(t1);
  t0 = *(const f32x4*)(base + 4096); t1 = *(const f32x4*)(base + 4096 + 4);
  o.b[0] = lo2(t0); o.b[1] = hi2(t0); o.b[2] = lo2(t1); o.b[3] = hi2(t1);
  t0 = *(const f32x4*)(base + 6144); t1 = *(const f32x4*)(base + 6144 + 4);
  o.k[0] = lo2(t0); o.k[1] = hi2(t0); o.k[2] = lo2(t1); o.k[3] = hi2(t1);
  t0 = *(const f32x4*)(base + 8192); t1 = *(const f32x4*)(base + 8192 + 4);
  o.r[0] = lo2(t0); o.r[1] = hi2(t0); o.r[2] = lo2(t1); o.r[3] = hi2(t1);
  o.v0 = VV[nn * 64 + i0];
  o.v1 = VV[nn * 64 + i0 + 8];
}
DEVI void scan_step(const ScanOps& o, f32x2 (&S0)[4], f32x2 (&S1)[4], float* YL, int nn, int jg, int i0) {
  f32x2 d0 = S0[0] * o.a[0], d0b = S0[2] * o.a[2];
  f32x2 d1 = S1[0] * o.a[0], d1b = S1[2] * o.a[2];
  d0 = S0[1] * o.a[1] + d0; d0b = S0[3] * o.a[3] + d0b;
  d1 = S1[1] * o.a[1] + d1; d1b = S1[3] * o.a[3] + d1b;
  d0 += d0b; d1 += d1b;
  const float sa0 = red8(d0.x + d0.y);
  const float sa1 = red8(d1.x + d1.y);
  f32x2 e0 = {0.f, 0.f}, e1 = {0.f, 0.f};
#pragma unroll
  for (int q = 0; q < 4; ++q) {
    const f32x2 u0 = sa0 * o.b[q] + o.v0 * o.k[q];
    const f32x2 u1 = sa1 * o.b[q] + o.v1 * o.k[q];
    S0[q] = S0[q] * o.w[q] + u0;
    S1[q] = S1[q] * o.w[q] + u1;
    e0 = S0[q] * o.r[q] + e0;
    e1 = S1[q] * o.r[q] + e1;
  }
  const float y0 = red8(e0.x + e0.y);
  const float y1 = red8(e1.x + e1.y);
  YL[nn * 64 + i0] = y0; YL[nn * 64 + i0 + 8] = y1;
}

DEVI void phase_scan(int tid_, const Params& p, int l, char* smem, int bfirst, int bstride) {
  const u16* PR = (const u16*)(p.ws + OFF_PR);
  _Float16* YF = (_Float16*)(p.ws + OFF_H);
  _Float16* YB = (_Float16*)(p.ws + OFF_H + (size_t)NTOK * 512 * 2);
  float* BON = (float*)(p.ws + OFF_BONUS);
  const u16* WB = (const u16*)(p.ws + OFF_WB);
  float* OPS = (float*)(smem + SC_OPS);
  u16* RAW = (u16*)(smem + SC_OPS);
  float* VV = (float*)(smem + SC_VV);
  float* WR = (float*)(smem + SC_WR);
  float* AP = (float*)(smem + SC_AP);
  float* YL = WR;
  u16* TWb = (u16*)(smem + SC_TW);
  u16* ADb = (u16*)(smem + SC_AD);
  float* NRM = (float*)(smem + SC_NRM);
  float* MU = (float*)(smem + SC_MU);
  float* CST = (float*)(smem + SC_CST);
  const float* mu_p = p.in[I_MU_PREV] + (size_t)l * 1920;
  const float* mu_n = p.in[I_MU_NEXT] + (size_t)l * 1920;
  const int tid = tid_, lane = tid & 63, w = tid >> 6, fr = lane & 15, fq = lane >> 4;
  const int pn = tid >> 3, j0 = (tid & 7) * 8;
  const int jg = lane & 7, i0 = w * 16 + (lane >> 3);
  const int hr = (tid >= 40) ? 1 : 0, hc = tid - hr * 40;
  for (int blk = bfirst; blk < 192; blk += bstride) {
    const int s = blk >> 4, h = (blk >> 1) & 7, d = blk & 1;
    __syncthreads();
    for (int i = tid; i < 640; i += 256) {
      const int which = (i >= 320) ? 1 : 0, c = i - which * 320;
      const int g = c >> 6, e = c & 63;
      const int col = (g < 3) ? (g * 512 + h * 64 + e) : (1536 + (g - 3) * 128 + d * 64 + e);
      MU[i] = which ? mu_n[col] : mu_p[col];
    }
    for (int i = tid; i < 320; i += 256) {
      const int which = i >> 6, e = i & 63;
      float v;
      if (which == 0) v = p.in[I_W0][(size_t)(l * 2 + d) * 512 + h * 64 + e];
      else if (which == 1) v = p.in[I_A0][(size_t)(l * 2 + d) * 512 + h * 64 + e];
      else if (which == 2) v = p.in[I_K_K][(size_t)l * 512 + h * 64 + e];
      else if (which == 3) v = p.in[I_K_A][(size_t)l * 512 + h * 64 + e];
      else v = p.in[I_R_K][(size_t)(l * 8 + h) * 64 + e];
      CST[i] = v;
    }
    bf16x8 bw[2], ba[2];
#pragma unroll
    for (int ks = 0; ks < 2; ++ks) {
      bw[ks] = *(const bf16x8*)(WB + W_WUP + (size_t)(d * 512 + h * 64 + w * 16 + fr) * 64 + ks * 32 + fq * 8);
      ba[ks] = *(const bf16x8*)(WB + W_AUP + (size_t)(d * 512 + h * 64 + w * 16 + fr) * 64 + ks * 32 + fq * 8);
    }
    _Float16* Y = d ? YB : YF;
    f32x2 S0[4], S1[4];
#pragma unroll
    for (int q = 0; q < 4; ++q) { S0[q] = (f32x2){0.f, 0.f}; S1[q] = (f32x2){0.f, 0.f}; }
    u32x4 G[5], GH;
    {
      const int t = d ? (4095 - pn) : pn;
      const size_t tok = (size_t)s * 4096 + t;
#pragma unroll
      for (int g = 0; g < 5; ++g) {
        const int col = (g < 3) ? (g * 512 + h * 64) : (1536 + (g - 3) * 128 + d * 64);
        G[g] = *(const u32x4*)(PR + tok * PRW + col + j0);
      }
      GH = (u32x4){0u, 0u, 0u, 0u};
      if (tid < 80) {
        const int tlo = d ? (4095 - 31) : 0;
        const int th = hr ? (tlo + 32) : (tlo - 1);
        const int g = hc >> 3;
        const int col = (g < 3) ? (g * 512 + h * 64) : (1536 + (g - 3) * 128 + d * 64);
        if (th >= 0 && th <= 4095) GH = *(const u32x4*)(PR + ((size_t)s * 4096 + th) * PRW + col + (hc & 7) * 8);
      }
    }
#pragma unroll 1
    for (int ch = 0; ch < 128; ++ch) {
      const int n = ch * 32 + pn;
      const int t = d ? (4095 - n) : n;
      const size_t tok = (size_t)s * 4096 + t;
      const int tlo = d ? (4095 - (ch * 32 + 31)) : (ch * 32);
      const int rrow = t - tlo + 1;
#pragma unroll
      for (int g = 0; g < 5; ++g) *(u32x4*)(RAW + rrow * 320 + g * 64 + j0) = G[g];
      if (tid < 80) *(u32x4*)(RAW + (hr ? 33 : 0) * 320 + (hc >> 3) * 64 + (hc & 7) * 8) = GH;
      __syncthreads();
      if (ch + 1 < 128) {
        const int n2 = n + 32;
        const int t2 = d ? (4095 - n2) : n2;
        const size_t tok2 = (size_t)s * 4096 + t2;
#pragma unroll
        for (int g = 0; g < 5; ++g) {
          const int col = (g < 3) ? (g * 512 + h * 64) : (1536 + (g - 3) * 128 + d * 64);
          G[g] = *(const u32x4*)(PR + tok2 * PRW + col + j0);
        }
        GH = (u32x4){0u, 0u, 0u, 0u};
        if (tid < 80) {
          const int tlo2 = d ? (tlo - 32) : (tlo + 32);
          const int th = hr ? (tlo2 + 32) : (tlo2 - 1);
          const int g = hc >> 3;
          const int col = (g < 3) ? (g * 512 + h * 64) : (1536 + (g - 3) * 128 + d * 64);
          if (th >= 0 && th <= 4095) GH = *(const u32x4*)(PR + ((size_t)s * 4096 + th) * PRW + col + (hc & 7) * 8);
        }
      }
#pragma unroll
      for (int g = 0; g < 5; ++g) {
        float cur[8], prv[8], nxt[8];
        load8bf(RAW + rrow * 320 + g * 64 + j0, cur);
        load8bf(RAW + (rrow - 1) * 320 + g * 64 + j0, prv);
        load8bf(RAW + (rrow + 1) * 320 + g * 64 + j0, nxt);
        const f32x4 mp0 = *(const f32x4*)(MU + g * 64 + j0), mp1 = *(const f32x4*)(MU + g * 64 + j0 + 4);
        const f32x4 mn0 = *(const f32x4*)(MU + 320 + g * 64 + j0), mn1 = *(const f32x4*)(MU + 320 + g * 64 + j0 + 4);
        f32x4 x0, x1;
#pragma unroll
        for (int e = 0; e < 4; ++e) {
          x0[e] = cur[e] + mp0[e] * (prv[e] - cur[e]) + mn0[e] * (nxt[e] - cur[e]);
          x1[e] = cur[4 + e] + mp1[e] * (prv[4 + e] - cur[4 + e]) + mn1[e] * (nxt[4 + e] - cur[4 + e]);
        }
        if (g == 0) {
          *(f32x4*)(OPS + 4 * 2048 + pn * 64 + j0) = x0; *(f32x4*)(OPS + 4 * 2048 + pn * 64 + j0 + 4) = x1;
        } else if (g == 1) {
          *(f32x4*)(OPS + 3 * 2048 + pn * 64 + j0) = x0; *(f32x4*)(OPS + 3 * 2048 + pn * 64 + j0 + 4) = x1;
          const f32x4 kk0 = *(const f32x4*)(CST + 128 + j0), kk1 = *(const f32x4*)(CST + 128 + j0 + 4);
          float ss = 0.f;
#pragma unroll
          for (int e = 0; e < 4; ++e) { const float a_ = x0[e] * kk0[e], b_ = x1[e] * kk1[e]; ss += a_ * a_ + b_ * b_; }
          ss = red8(ss);
          if ((tid & 7) == 0) NRM[pn] = frcp(fmaxf(__builtin_amdgcn_sqrtf(ss), 1e-12f));
        } else if (g == 2) {
          *(f32x4*)(VV + pn * 64 + j0) = x0; *(f32x4*)(VV + pn * 64 + j0 + 4) = x1;
        } else if (g == 3) {
          u32x4 pk;
          pk.x = pack2(ftanh(x0[0]), ftanh(x0[1])); pk.y = pack2(ftanh(x0[2]), ftanh(x0[3]));
          pk.z = pack2(ftanh(x1[0]), ftanh(x1[1])); pk.w = pack2(ftanh(x1[2]), ftanh(x1[3]));
          *(u32x4*)(TWb + pn * 72 + j0) = pk;
        } else {
          u32x4 pk;
          pk.x = pack2(x0[0], x0[1]); pk.y = pack2(x0[2], x0[3]);
          pk.z = pack2(x1[0], x1[1]); pk.w = pack2(x1[2], x1[3]);
          *(u32x4*)(ADb + pn * 72 + j0) = pk;
        }
      }
      __syncthreads();
#pragma unroll
      for (int m = 0; m < 2; ++m) {
        f32x4 cw = {0.f, 0.f, 0.f, 0.f}, ca = {0.f, 0.f, 0.f, 0.f};
#pragma unroll
        for (int ks = 0; ks < 2; ++ks) {
          const bf16x8 aw = *(const bf16x8*)(TWb + (m * 16 + fr) * 72 + ks * 32 + fq * 8);
          const bf16x8 aa = *(const bf16x8*)(ADb + (m * 16 + fr) * 72 + ks * 32 + fq * 8);
          cw = __builtin_amdgcn_mfma_f32_16x16x32_bf16(aw, bw[ks], cw, 0, 0, 0);
          ca = __builtin_amdgcn_mfma_f32_16x16x32_bf16(aa, ba[ks], ca, 0, 0, 0);
        }
#pragma unroll
        for (int jj = 0; jj < 4; ++jj) {
          WR[(m * 16 + fq * 4 + jj) * 64 + w * 16 + fr] = cw[jj];
          AP[(m * 16 + fq * 4 + jj) * 64 + w * 16 + fr] = ca[jj];
        }
      }
      __syncthreads();
      {
        const float inv = NRM[pn];
        float bsum = 0.f;
#pragma unroll
        for (int hq = 0; hq < 2; ++hq) {
          const int jb = j0 + hq * 4;
          const f32x4 wr_ = *(const f32x4*)(WR + pn * 64 + jb) + *(const f32x4*)(CST + jb);
          const f32x4 ap_ = *(const f32x4*)(AP + pn * 64 + jb) + *(const f32x4*)(CST + 64 + jb);
          const f32x4 kr = *(const f32x4*)(OPS + 3 * 2048 + pn * 64 + jb);
          const f32x4 rr = *(const f32x4*)(OPS + 4 * 2048 + pn * 64 + jb);
          const f32x4 kkw = *(const f32x4*)(CST + 128 + jb), kaw = *(const f32x4*)(CST + 192 + jb), rkw = *(const f32x4*)(CST + 256 + jb);
          f32x4 o0, o1, o2, o3;
#pragma unroll
          for (int e = 0; e < 4; ++e) {
            const float sw = sigm(wr_[e]);
            const float dec = __expf(-0.6065306597126334f * sw);
            const float av = sigm(ap_[e]);
            const float kn = kr[e] * kkw[e] * inv;
            const float kd = kr[e] * (1.f + (av - 1.f) * kaw[e]);
            bsum += rr[e] * kd * rkw[e];
            o0[e] = -kn; o1[e] = dec; o2[e] = kn * av; o3[e] = kd;
          }
          *(f32x4*)(OPS + 0 * 2048 + pn * 64 + jb) = o0;
          *(f32x4*)(OPS + 1 * 2048 + pn * 64 + jb) = o1;
          *(f32x4*)(OPS + 2 * 2048 + pn * 64 + jb) = o2;
          *(f32x4*)(OPS + 3 * 2048 + pn * 64 + jb) = o3;
        }
        bsum = red8(bsum);
        if ((tid & 7) == 0) BON[(tok * 8 + h) * 2 + d] = bsum;
      }
      __syncthreads();
      {
        ScanOps oa, ob;
        scan_load(oa, OPS, VV, 0, jg, i0);
#pragma unroll 1
        for (int nn = 0; nn < 32; nn += 2) {
          scan_load(ob, OPS, VV, nn + 1, jg, i0);
          scan_step(oa, S0, S1, YL, nn, jg, i0);
          scan_load(oa, OPS, VV, (nn + 2) & 31, jg, i0);
          scan_step(ob, S0, S1, YL, nn + 1, jg, i0);
        }
      }
      __syncthreads();
      {
        h16x8 o;
#pragma unroll
        for (int e = 0; e < 8; ++e) o[e] = (_Float16)YL[pn * 64 + j0 + e];
        *(h16x8*)(Y + tok * 512 + h * 64 + j0) = o;
      }
    }
    __syncthreads();
  }
}

struct ScanOps1 {
  f32x2 a[4], w[4], b[4], k[4], r[4];
  float v0;
};
DEVI void scan_load1(ScanOps1& o, const float* OPS, const float* VV, int nn, int jg, int i0) {
  const float* base = OPS + nn * 64 + jg * 8;
  f32x4 t0, t1;
  t0 = *(const f32x4*)(base); t1 = *(const f32x4*)(base + 4);
  o.a[0] = lo2(t0); o.a[1] = hi2(t0); o.a[2] = lo2(t1); o.a[3] = hi2(t1);
  t0 = *(const f32x4*)(base + 2048); t1 = *(const f32x4*)(base + 2048 + 4);
  o.w[0] = lo2(t0); o.w[1] = hi2(t0); o.w[2] = lo2(t1); o.w[3] = hi2(t1);
  t0 = *(const f32x4*)(base + 4096); t1 = *(const f32x4*)(base + 4096 + 4);
  o.b[0] = lo2(t0); o.b[1] = hi2(t0); o.b[2] = lo2(t1); o.b[3] = hi2(t1);
  t0 = *(const f32x4*)(base + 6144); t1 = *(const f32x4*)(base + 6144 + 4);
  o.k[0] = lo2(t0); o.k[1] = hi2(t0); o.k[2] = lo2(t1); o.k[3] = hi2(t1);
  t0 = *(const f32x4*)(base + 8192); t1 = *(const f32x4*)(base + 8192 + 4);
  o.r[0] = lo2(t0); o.r[1] = hi2(t0); o.r[2] = lo2(t1); o.r[3] = hi2(t1);
  o.v0 = VV[nn * 64 + i0];
}
DEVI void scan_step1(const ScanOps1& o, f32x2 (&S0)[4], float* YL, int nn, int jg, int i0) {
  f32x2 d0 = S0[0] * o.a[0], d0b = S0[2] * o.a[2];
  d0 = S0[1] * o.a[1] + d0; d0b = S0[3] * o.a[3] + d0b;
  d0 += d0b;
  const float sa0 = red8(d0.x + d0.y);
  f32x2 e0 = {0.f, 0.f};
#pragma unroll
  for (int q = 0; q < 4; ++q) {
    const f32x2 u0 = sa0 * o.b[q] + o.v0 * o.k[q];
    S0[q] = S0[q] * o.w[q] + u0;
    e0 = S0[q] * o.r[q] + e0;
  }
  const float y0 = red8(e0.x + e0.y);
  if (jg == 0) YL[nn * 64 + i0] = y0;
}
DEVI float red16d(float x) {
  x += dpp_mov<0xB1>(x);
  x += dpp_mov<0x4E>(x);
  x += dpp_mov<0x141>(x);
  x += dpp_mov<0x140>(x);
  return x;
}
DEVI void unpack4(u32x2 u, float* o) {
  o[0] = __uint_as_float(u.x << 16); o[1] = __uint_as_float(u.x & 0xffff0000u);
  o[2] = __uint_as_float(u.y << 16); o[3] = __uint_as_float(u.y & 0xffff0000u);
}

DEVI void phase_scan8(int tid_, const Params& p, int l, char* smem, int bfirst, int bstride) {
  const u16* PR = (const u16*)(p.ws + OFF_PR);
  _Float16* YF = (_Float16*)(p.ws + OFF_H);
  _Float16* YB = (_Float16*)(p.ws + OFF_H + (size_t)NTOK * 512 * 2);
  float* BON = (float*)(p.ws + OFF_BONUS);
  const u16* WB = (const u16*)(p.ws + OFF_WB);
  float* OPS = (float*)(smem + SC_OPS);
  u16* RAW = (u16*)(smem + SC_OPS);
  float* VV = (float*)(smem + SC_VV);
  float* WR = (float*)(smem + SC_WR);
  float* AP = (float*)(smem + SC_AP);
  float* YL = WR;
  u16* TWb = (u16*)(smem + SC_TW);
  u16* ADb = (u16*)(smem + SC_AD);
  float* NRM = (float*)(smem + SC_NRM);
  float* MU = (float*)(smem + SC_MU);
  float* CST = (float*)(smem + SC_CST);
  const float* mu_p = p.in[I_MU_PREV] + (size_t)l * 1920;
  const float* mu_n = p.in[I_MU_NEXT] + (size_t)l * 1920;
  const int tid = tid_, lane = tid & 63, w = tid >> 6, fr = lane & 15, fq = lane >> 4;
  const int pn = tid >> 4, j0 = (tid & 15) * 4;
  const int jg = lane & 7, i0 = w * 8 + (lane >> 3);
  const int hr = (tid >= 80) ? 1 : 0, hc = tid - hr * 80;
  const int wm = w >> 2, wn = w & 3;
  for (int blk = bfirst; blk < 192; blk += bstride) {
    const int s = blk >> 4, h = (blk >> 1) & 7, d = blk & 1;
    __syncthreads();
    for (int i = tid; i < 640; i += 512) {
      const int which = (i >= 320) ? 1 : 0, c = i - which * 320;
      const int g = c >> 6, e = c & 63;
      const int col = (g < 3) ? (g * 512 + h * 64 + e) : (1536 + (g - 3) * 128 + d * 64 + e);
      MU[i] = which ? mu_n[col] : mu_p[col];
    }
    if (tid < 320) {
      const int which = tid >> 6, e = tid & 63;
      float v;
      if (which == 0) v = p.in[I_W0][(size_t)(l * 2 + d) * 512 + h * 64 + e];
      else if (which == 1) v = p.in[I_A0][(size_t)(l * 2 + d) * 512 + h * 64 + e];
      else if (which == 2) v = p.in[I_K_K][(size_t)l * 512 + h * 64 + e];
      else if (which == 3) v = p.in[I_K_A][(size_t)l * 512 + h * 64 + e];
      else v = p.in[I_R_K][(size_t)(l * 8 + h) * 64 + e];
      CST[tid] = v;
    }
    bf16x8 bw[2], ba[2];
#pragma unroll
    for (int ks = 0; ks < 2; ++ks) {
      bw[ks] = *(const bf16x8*)(WB + W_WUP + (size_t)(d * 512 + h * 64 + wn * 16 + fr) * 64 + ks * 32 + fq * 8);
      ba[ks] = *(const bf16x8*)(WB + W_AUP + (size_t)(d * 512 + h * 64 + wn * 16 + fr) * 64 + ks * 32 + fq * 8);
    }
    _Float16* Y = d ? YB : YF;
    f32x2 S0[4];
#pragma unroll
    for (int q = 0; q < 4; ++q) S0[q] = (f32x2){0.f, 0.f};
    u32x2 G[5], GH;
    {
      const int t = d ? (4095 - pn) : pn;
      const size_t tok = (size_t)s * 4096 + t;
#pragma unroll
      for (int g = 0; g < 5; ++g) {
        const int col = (g < 3) ? (g * 512 + h * 64) : (1536 + (g - 3) * 128 + d * 64);
        G[g] = *(const u32x2*)(PR + tok * PRW + col + j0);
      }
      GH = (u32x2){0u, 0u};
      if (tid < 160) {
        const int tlo = d ? (4095 - 31) : 0;
        const int th = hr ? (tlo + 32) : (tlo - 1);
        const int g = hc >> 4;
        const int col = (g < 3) ? (g * 512 + h * 64) : (1536 + (g - 3) * 128 + d * 64);
        if (th >= 0 && th <= 4095) GH = *(const u32x2*)(PR + ((size_t)s * 4096 + th) * PRW + col + (hc & 15) * 4);
      }
    }
#pragma unroll 1
    for (int ch = 0; ch < 128; ++ch) {
      const int n = ch * 32 + pn;
      const int t = d ? (4095 - n) : n;
      const size_t tok = (size_t)s * 4096 + t;
      const int tlo = d ? (4095 - (ch * 32 + 31)) : (ch * 32);
      const int rrow = t - tlo + 1;
#pragma unroll
      for (int g = 0; g < 5; ++g) *(u32x2*)(RAW + rrow * 320 + g * 64 + j0) = G[g];
      if (tid < 160) *(u32x2*)(RAW + (hr ? 33 : 0) * 320 + (hc >> 4) * 64 + (hc & 15) * 4) = GH;
      __syncthreads();
      if (ch + 1 < 128) {
        const int n2 = n + 32;
        const int t2 = d ? (4095 - n2) : n2;
        const size_t tok2 = (size_t)s * 4096 + t2;
#pragma unroll
        for (int g = 0; g < 5; ++g) {
          const int col = (g < 3) ? (g * 512 + h * 64) : (1536 + (g - 3) * 128 + d * 64);
          G[g] = *(const u32x2*)(PR + tok2 * PRW + col + j0);
        }
        GH = (u32x2){0u, 0u};
        if (tid < 160) {
          const int tlo2 = d ? (tlo - 32) : (tlo + 32);
          const int th = hr ? (tlo2 + 32) : (tlo2 - 1);
          const int g = hc >> 4;
          const int col = (g < 3) ? (g * 512 + h * 64) : (1536 + (g - 3) * 128 + d * 64);
          if (th >= 0 && th <= 4095) GH = *(const u32x2*)(PR + ((size_t)s * 4096 + th) * PRW + col + (hc & 15) * 4);
        }
      }
#pragma unroll
      for (int g = 0; g < 5; ++g) {
        float cur[4], prv[4], nxt[4];
        unpack4(*(const u32x2*)(RAW + rrow * 320 + g * 64 + j0), cur);
        unpack4(*(const u32x2*)(RAW + (rrow - 1) * 320 + g * 64 + j0), prv);
        unpack4(*(const u32x2*)(RAW + (rrow + 1) * 320 + g * 64 + j0), nxt);
        const f32x4 mp0 = *(const f32x4*)(MU + g * 64 + j0);
        const f32x4 mn0 = *(const f32x4*)(MU + 320 + g * 64 + j0);
        f32x4 x0;
#pragma unroll
        for (int e = 0; e < 4; ++e) x0[e] = cur[e] + mp0[e] * (prv[e] - cur[e]) + mn0[e] * (nxt[e] - cur[e]);
        if (g == 0) {
          *(f32x4*)(OPS + 4 * 2048 + pn * 64 + j0) = x0;
        } else if (g == 1) {
          *(f32x4*)(OPS + 3 * 2048 + pn * 64 + j0) = x0;
          const f32x4 kk0 = *(const f32x4*)(CST + 128 + j0);
          float ss = 0.f;
#pragma unroll
          for (int e = 0; e < 4; ++e) { const float a_ = x0[e] * kk0[e]; ss += a_ * a_; }
          ss = red16d(ss);
          if ((tid & 15) == 0) NRM[pn] = frcp(fmaxf(__builtin_amdgcn_sqrtf(ss), 1e-12f));
        } else if (g == 2) {
          *(f32x4*)(VV + pn * 64 + j0) = x0;
        } else if (g == 3) {
          u32x2 pk;
          pk.x = pack2(ftanh(x0[0]), ftanh(x0[1])); pk.y = pack2(ftanh(x0[2]), ftanh(x0[3]));
          *(u32x2*)(TWb + pn * 72 + j0) = pk;
        } else {
          u32x2 pk;
          pk.x = pack2(x0[0], x0[1]); pk.y = pack2(x0[2], x0[3]);
          *(u32x2*)(ADb + pn * 72 + j0) = pk;
        }
      }
      __syncthreads();
      {
        f32x4 cw = {0.f, 0.f, 0.f, 0.f}, ca = {0.f, 0.f, 0.f, 0.f};
#pragma unroll
        for (int ks = 0; ks < 2; ++ks) {
          const bf16x8 aw = *(const bf16x8*)(TWb + (wm * 16 + fr) * 72 + ks * 32 + fq * 8);
          const bf16x8 aa = *(const bf16x8*)(ADb + (wm * 16 + fr) * 72 + ks * 32 + fq * 8);
          cw = __builtin_amdgcn_mfma_f32_16x16x32_bf16(aw, bw[ks], cw, 0, 0, 0);
          ca = __builtin_amdgcn_mfma_f32_16x16x32_bf16(aa, ba[ks], ca, 0, 0, 0);
        }
#pragma unroll
        for (int jj = 0; jj < 4; ++jj) {
          WR[(wm * 16 + fq * 4 + jj) * 64 + wn * 16 + fr] = cw[jj];
          AP[(wm * 16 + fq * 4 + jj) * 64 + wn * 16 + fr] = ca[jj];
        }
      }
      __syncthreads();
      {
        const float inv = NRM[pn];
        float bsum = 0.f;
        const f32x4 wr_ = *(const f32x4*)(WR + pn * 64 + j0) + *(const f32x4*)(CST + j0);
        const f32x4 ap_ = *(const f32x4*)(AP + pn * 64 + j0) + *(const f32x4*)(CST + 64 + j0);
        const f32x4 kr = *(const f32x4*)(OPS + 3 * 2048 + pn * 64 + j0);
        const f32x4 rr = *(const f32x4*)(OPS + 4 * 2048 + pn * 64 + j0);
        const f32x4 kkw = *(const f32x4*)(CST + 128 + j0), kaw = *(const f32x4*)(CST + 192 + j0), rkw = *(const f32x4*)(CST + 256 + j0);
        f32x4 o0, o1, o2, o3;
#pragma unroll
        for (int e = 0; e < 4; ++e) {
          const float sw = sigm(wr_[e]);
          const float dec = __expf(-0.6065306597126334f * sw);
          const float av = sigm(ap_[e]);
          const float kn = kr[e] * kkw[e] * inv;
          const float kd = kr[e] * (1.f + (av - 1.f) * kaw[e]);
          bsum += rr[e] * kd * rkw[e];
          o0[e] = -kn; o1[e] = dec; o2[e] = kn * av; o3[e] = kd;
        }
        *(f32x4*)(OPS + 0 * 2048 + pn * 64 + j0) = o0;
        *(f32x4*)(OPS + 1 * 2048 + pn * 64 + j0) = o1;
        *(f32x4*)(OPS + 2 * 2048 + pn * 64 + j0) = o2;
        *(f32x4*)(OPS + 3 * 2048 + pn * 64 + j0) = o3;
        bsum = red16d(bsum);
        if ((tid & 15) == 0) BON[(tok * 8 + h) * 2 + d] = bsum;
      }
      __syncthreads();
      {
        ScanOps1 oa, ob;
        scan_load1(oa, OPS, VV, 0, jg, i0);
#pragma unroll 1
        for (int nn = 0; nn < 32; nn += 2) {
          scan_load1(ob, OPS, VV, nn + 1, jg, i0);
          scan_step1(oa, S0, YL, nn, jg, i0);
          scan_load1(oa, OPS, VV, (nn + 2) & 31, jg, i0);
          scan_step1(ob, S0, YL, nn + 1, jg, i0);
        }
      }
      __syncthreads();
      {
        typedef __attribute__((ext_vector_type(4))) _Float16 h16x4;
        h16x4 o;
#pragma unroll
        for (int e = 0; e < 4; ++e) o[e] = (_Float16)YL[pn * 64 + j0 + e];
        *(h16x4*)(Y + tok * 512 + h * 64 + j0) = o;
      }
    }
    __syncthreads();
  }
}

constexpr int PC_OPS = 0;
constexpr int PC_BUF = 49152;
constexpr int PC_RAW = 98304;
constexpr int PC_WR = 98304;
constexpr int PC_AP = 106496;
constexpr int PC_TW = 120064;
constexpr int PC_AD = 124672;
constexpr int PC_NRM = 129280;
constexpr int PC_MU = 129408;
constexpr int PC_CST = 131968;
constexpr int PC_YL = 133248;

DEVI void phase_scan_pc(int tid_, const Params& p, int l, char* smem, int bfirst, int bstride) {
  const u16* PR = (const u16*)(p.ws + OFF_PR);
  _Float16* YF = (_Float16*)(p.ws + OFF_H);
  _Float16* YB = (_Float16*)(p.ws + OFF_H + (size_t)NTOK * 512 * 2);
  float* BON = (float*)(p.ws + OFF_BONUS);
  const u16* WB = (const u16*)(p.ws + OFF_WB);
  u16* RAW = (u16*)(smem + PC_RAW);
  float* WR = (float*)(smem + PC_WR);
  float* AP = (float*)(smem + PC_AP);
  u16* TWb = (u16*)(smem + PC_TW);
  u16* ADb = (u16*)(smem + PC_AD);
  float* NRM = (float*)(smem + PC_NRM);
  float* MU = (float*)(smem + PC_MU);
  float* CST = (float*)(smem + PC_CST);
  const float* mu_p = p.in[I_MU_PREV] + (size_t)l * 1920;
  const float* mu_n = p.in[I_MU_NEXT] + (size_t)l * 1920;
  const bool is_prep = tid_ >= 256;
  const int tid = tid_ & 255, lane = tid & 63, w = tid >> 6, fr = lane & 15, fq = lane >> 4;
  const int pn = tid >> 3, j0 = (tid & 7) * 8;
  const int jg = lane & 7, i0 = w * 16 + (lane >> 3);
  const int hr = (tid >= 40) ? 1 : 0, hc = tid - hr * 40;
  for (int blk = bfirst; blk < 192; blk += bstride) {
    const int s = blk >> 4, h = (blk >> 1) & 7, d = blk & 1;
    __syncthreads();
    for (int i = tid_; i < 640; i += 512) {
      const int which = (i >= 320) ? 1 : 0, c = i - which * 320;
      const int g = c >> 6, e = c & 63;
      const int col = (g < 3) ? (g * 512 + h * 64 + e) : (1536 + (g - 3) * 128 + d * 64 + e);
      MU[i] = which ? mu_n[col] : mu_p[col];
    }
    if (tid_ < 320) {
      const int which = tid_ >> 6, e = tid_ & 63;
      float v;
      if (which == 0) v = p.in[I_W0][(size_t)(l * 2 + d) * 512 + h * 64 + e];
      else if (which == 1) v = p.in[I_A0][(size_t)(l * 2 + d) * 512 + h * 64 + e];
      else if (which == 2) v = p.in[I_K_K][(size_t)l * 512 + h * 64 + e];
      else if (which == 3) v = p.in[I_K_A][(size_t)l * 512 + h * 64 + e];
      else v = p.in[I_R_K][(size_t)(l * 8 + h) * 64 + e];
      CST[tid_] = v;
    }
    _Float16* Y = d ? YB : YF;
    if (is_prep) {
      bf16x8 bw[2], ba[2];
#pragma unroll
      for (int ks = 0; ks < 2; ++ks) {
        bw[ks] = *(const bf16x8*)(WB + W_WUP + (size_t)(d * 512 + h * 64 + w * 16 + fr) * 64 + ks * 32 + fq * 8);
        ba[ks] = *(const bf16x8*)(WB + W_AUP + (size_t)(d * 512 + h * 64 + w * 16 + fr) * 64 + ks * 32 + fq * 8);
      }
      u32x4 G[5], GH;
      {
        const int t = d ? (4095 - pn) : pn;
        const size_t tok = (size_t)s * 4096 + t;
#pragma unroll
        for (int g = 0; g < 5; ++g) {
          const int col = (g < 3) ? (g * 512 + h * 64) : (1536 + (g - 3) * 128 + d * 64);
          G[g] = *(const u32x4*)(PR + tok * PRW + col + j0);
        }
        GH = (u32x4){0u, 0u, 0u, 0u};
        if (tid < 80) {
          const int tlo = d ? (4095 - 31) : 0;
          const int th = hr ? (tlo + 32) : (tlo - 1);
          const int g = hc >> 3;
          const int col = (g < 3) ? (g * 512 + h * 64) : (1536 + (g - 3) * 128 + d * 64);
          if (th >= 0 && th <= 4095) GH = *(const u32x4*)(PR + ((size_t)s * 4096 + th) * PRW + col + (hc & 7) * 8);
        }
      }
#pragma unroll 1
      for (int ch = -1; ch < 128; ++ch) {
        const int c = ch + 1;
        const bool doprep = c < 128;
        float* OPS = (float*)(smem + PC_OPS + (c & 1) * PC_BUF);
        float* VV = OPS + 5 * 2048;
        const int n = c * 32 + pn;
        const int t = d ? (4095 - n) : n;
        const size_t tok = (size_t)s * 4096 + t;
        const int tlo = d ? (4095 - (c * 32 + 31)) : (c * 32);
        const int rrow = t - tlo + 1;
        __syncthreads();
        if (ch >= 1) {
          const float* YL = (const float*)(smem + PC_YL + ((ch - 1) & 1) * 8192);
          const int n1 = (ch - 1) * 32 + pn;
          const int t1 = d ? (4095 - n1) : n1;
          h16x8 o;
#pragma unroll
          for (int e = 0; e < 8; ++e) o[e] = (_Float16)YL[pn * 64 + j0 + e];
          *(h16x8*)(Y + ((size_t)s * 4096 + t1) * 512 + h * 64 + j0) = o;
        }
        if (doprep) {
#pragma unroll
          for (int g = 0; g < 5; ++g) *(u32x4*)(RAW + rrow * 320 + g * 64 + j0) = G[g];
          if (tid < 80) *(u32x4*)(RAW + (hr ? 33 : 0) * 320 + (hc >> 3) * 64 + (hc & 7) * 8) = GH;
        }
        __syncthreads();
        if (doprep) {
          if (c + 1 < 128) {
            const int n2 = n + 32;
            const int t2 = d ? (4095 - n2) : n2;
            const size_t tok2 = (size_t)s * 4096 + t2;
#pragma unroll
            for (int g = 0; g < 5; ++g) {
              const int col = (g < 3) ? (g * 512 + h * 64) : (1536 + (g - 3) * 128 + d * 64);
              G[g] = *(const u32x4*)(PR + tok2 * PRW + col + j0);
            }
            GH = (u32x4){0u, 0u, 0u, 0u};
            if (tid < 80) {
              const int tlo2 = d ? (tlo - 32) : (tlo + 32);
              const int th = hr ? (tlo2 + 32) : (tlo2 - 1);
              const int g = hc >> 3;
              const int col = (g < 3) ? (g * 512 + h * 64) : (1536 + (g - 3) * 128 + d * 64);
              if (th >= 0 && th <= 4095) GH = *(const u32x4*)(PR + ((size_t)s * 4096 + th) * PRW + col + (hc & 7) * 8);
            }
          }
#pragma unroll
          for (int g = 0; g < 5; ++g) {
            float cur[8], prv[8], nxt[8];
            load8bf(RAW + rrow * 320 + g * 64 + j0, cur);
            load8bf(RAW + (rrow - 1) * 320 + g * 64 + j0, prv);
            load8bf(RAW + (rrow + 1) * 320 + g * 64 + j0, nxt);
            const f32x4 mp0 = *(const f32x4*)(MU + g * 64 + j0), mp1 = *(const f32x4*)(MU + g * 64 + j0 + 4);
            const f32x4 mn0 = *(const f32x4*)(MU + 320 + g * 64 + j0), mn1 = *(const f32x4*)(MU + 320 + g * 64 + j0 + 4);
            f32x4 x0, x1;
#pragma unroll
            for (int e = 0; e < 4; ++e) {
              x0[e] = cur[e] + mp0[e] * (prv[e] - cur[e]) + mn0[e] * (nxt[e] - cur[e]);
              x1[e] = cur[4 + e] + mp1[e] * (prv[4 + e] - cur[4 + e]) + mn1[e] * (nxt[4 + e] - cur[4 + e]);
            }
            if (g == 0) {
              *(f32x4*)(OPS + 4 * 2048 + pn * 64 + j0) = x0; *(f32x4*)(OPS + 4 * 2048 + pn * 64 + j0 + 4) = x1;
            } else if (g == 1) {
              *(f32x4*)(OPS + 3 * 2048 + pn * 64 + j0) = x0; *(f32x4*)(OPS + 3 * 2048 + pn * 64 + j0 + 4) = x1;
              const f32x4 kk0 = *(const f32x4*)(CST + 128 + j0), kk1 = *(const f32x4*)(CST + 128 + j0 + 4);
              float ss = 0.f;
#pragma unroll
              for (int e = 0; e < 4; ++e) { const float a_ = x0[e] * kk0[e], b_ = x1[e] * kk1[e]; ss += a_ * a_ + b_ * b_; }
              ss = red8(ss);
              if ((tid & 7) == 0) NRM[pn] = frcp(fmaxf(__builtin_amdgcn_sqrtf(ss), 1e-12f));
            } else if (g == 2) {
              *(f32x4*)(VV + pn * 64 + j0) = x0; *(f32x4*)(VV + pn * 64 + j0 + 4) = x1;
            } else if (g == 3) {
              u32x4 pk;
              pk.x = pack2(ftanh(x0[0]), ftanh(x0[1])); pk.y = pack2(ftanh(x0[2]), ftanh(x0[3]));
              pk.z = pack2(ftanh(x1[0]), ftanh(x1[1])); pk.w = pack2(ftanh(x1[2]), ftanh(x1[3]));
              *(u32x4*)(TWb + pn * 72 + j0) = pk;
            } else {
              u32x4 pk;
              pk.x = pack2(x0[0], x0[1]); pk.y = pack2(x0[2], x0[3]);
              pk.z = pack2(x1[0], x1[1]); pk.w = pack2(x1[2], x1[3]);
              *(u32x4*)(ADb + pn * 72 + j0) = pk;
            }
          }
        }
        __syncthreads();
        if (doprep) {
#pragma unroll
          for (int m = 0; m < 2; ++m) {
            f32x4 cw = {0.f, 0.f, 0.f, 0.f}, ca = {0.f, 0.f, 0.f, 0.f};
#pragma unroll
            for (int ks = 0; ks < 2; ++ks) {
              const bf16x8 aw = *(const bf16x8*)(TWb + (m * 16 + fr) * 72 + ks * 32 + fq * 8);
              const bf16x8 aa = *(const bf16x8*)(ADb + (m * 16 + fr) * 72 + ks * 32 + fq * 8);
              cw = __builtin_amdgcn_mfma_f32_16x16x32_bf16(aw, bw[ks], cw, 0, 0, 0);
              ca = __builtin_amdgcn_mfma_f32_16x16x32_bf16(aa, ba[ks], ca, 0, 0, 0);
            }
#pragma unroll
            for (int jj = 0; jj < 4; ++jj) {
              WR[(m * 16 + fq * 4 + jj) * 64 + w * 16 + fr] = cw[jj];
              AP[(m * 16 + fq * 4 + jj) * 64 + w * 16 + fr] = ca[jj];
            }
          }
        }
        __syncthreads();
        if (doprep) {
          const float inv = NRM[pn];
          float bsum = 0.f;
#pragma unroll
          for (int hq = 0; hq < 2; ++hq) {
            const int jb = j0 + hq * 4;
            const f32x4 wr_ = *(const f32x4*)(WR + pn * 64 + jb) + *(const f32x4*)(CST + jb);
            const f32x4 ap_ = *(const f32x4*)(AP + pn * 64 + jb) + *(const f32x4*)(CST + 64 + jb);
            const f32x4 kr = *(const f32x4*)(OPS + 3 * 2048 + pn * 64 + jb);
            const f32x4 rr = *(const f32x4*)(OPS + 4 * 2048 + pn * 64 + jb);
            const f32x4 kkw = *(const f32x4*)(CST + 128 + jb), kaw = *(const f32x4*)(CST + 192 + jb), rkw = *(const f32x4*)(CST + 256 + jb);
            f32x4 o0, o1, o2, o3;
#pragma unroll
            for (int e = 0; e < 4; ++e) {
              const float sw = sigm(wr_[e]);
              const float dec = __expf(-0.6065306597126334f * sw);
              const float av = sigm(ap_[e]);
              const float kn = kr[e] * kkw[e] * inv;
              const float kd = kr[e] * (1.f + (av - 1.f) * kaw[e]);
              bsum += rr[e] * kd * rkw[e];
              o0[e] = -kn; o1[e] = dec; o2[e] = kn * av; o3[e] = kd;
            }
            *(f32x4*)(OPS + 0 * 2048 + pn * 64 + jb) = o0;
            *(f32x4*)(OPS + 1 * 2048 + pn * 64 + jb) = o1;
            *(f32x4*)(OPS + 2 * 2048 + pn * 64 + jb) = o2;
            *(f32x4*)(OPS + 3 * 2048 + pn * 64 + jb) = o3;
          }
          bsum = red8(bsum);
          if ((tid & 7) == 0) BON[(tok * 8 + h) * 2 + d] = bsum;
        }
      }
      __syncthreads();
      {
        const float* YL = (const float*)(smem + PC_YL + (127 & 1) * 8192);
        const int n1 = 127 * 32 + pn;
        const int t1 = d ? (4095 - n1) : n1;
        h16x8 o;
#pragma unroll
        for (int e = 0; e < 8; ++e) o[e] = (_Float16)YL[pn * 64 + j0 + e];
        *(h16x8*)(Y + ((size_t)s * 4096 + t1) * 512 + h * 64 + j0) = o;
      }
    } else {
      f32x2 S0[4], S1[4];
#pragma unroll
      for (int q = 0; q < 4; ++q) { S0[q] = (f32x2){0.f, 0.f}; S1[q] = (f32x2){0.f, 0.f}; }
#pragma unroll 1
      for (int ch = -1; ch < 128; ++ch) {
        const float* OPS = (const float*)(smem + PC_OPS + (ch & 1) * PC_BUF);
        const float* VV = OPS + 5 * 2048;
        float* YL = (float*)(smem + PC_YL + (ch & 1) * 8192);
        __syncthreads();
        if (ch < 0) {
          __syncthreads(); __syncthreads(); __syncthreads();
        } else {
          ScanOps oa, ob;
          scan_load(oa, OPS, VV, 0, jg, i0);
#pragma unroll 1
          for (int seg = 0; seg < 4; ++seg) {
            if (seg > 0) __syncthreads();
#pragma unroll 1
            for (int nn = seg * 8; nn < seg * 8 + 8; nn += 2) {
              scan_load(ob, OPS, VV, nn + 1, jg, i0);
              scan_step(oa, S0, S1, YL, nn, jg, i0);
              scan_load(oa, OPS, VV, (nn + 2) & 31, jg, i0);
              scan_step(ob, S0, S1, YL, nn + 1, jg, i0);
            }
          }
        }
      }
      __syncthreads();
    }
    __syncthreads();
  }
}

DEVI void phase_rwkv_post(int tid_, int vb_, int vg_, const Params& p, int l, char* smem) {
  u16* PR = (u16*)(p.ws + OFF_PR);
  const _Float16* YF = (const _Float16*)(p.ws + OFF_H);
  const _Float16* YB = (const _Float16*)(p.ws + OFF_H + (size_t)NTOK * 512 * 2);
  const float* BON = (const float*)(p.ws + OFF_BONUS);
  const u16* GUPT = (const u16*)(p.ws + OFF_WB) + W_GUP;
  const float* mu_p = p.in[I_MU_PREV] + (size_t)l * 1920;
  const float* mu_n = p.in[I_MU_NEXT] + (size_t)l * 1920;
  const float* gng = p.in[I_GN_G] + (size_t)l * 512;
  const float* gnb = p.in[I_GN_B] + (size_t)l * 512;
  u16* As = (u16*)smem;
  const int tid = tid_, lane = tid & 63, w = tid >> 6, fr = lane & 15, fq = lane >> 4;
  for (int tile = vb_; tile < NTOK / 64; tile += vg_) {
    const size_t tok0 = (size_t)tile * 64;
    {
      const int row = tid >> 2, part = tid & 3;
      const size_t tok = tok0 + row;
      const int t = (int)(tok & 4095);
#pragma unroll
      for (int q = 0; q < 4; ++q) {
        const int col = 1792 + part * 32 + q * 8;
        float cur[8], prv[8], nxt[8];
        load8bf(PR + tok * PRW + col, cur);
        if (t > 0) load8bf(PR + (tok - 1) * PRW + col, prv);
        else {
#pragma unroll
          for (int e = 0; e < 8; ++e) prv[e] = 0.f;
        }
        if (t < 4095) load8bf(PR + (tok + 1) * PRW + col, nxt);
        else {
#pragma unroll
          for (int e = 0; e < 8; ++e) nxt[e] = 0.f;
        }
        float o[8];
#pragma unroll
        for (int e = 0; e < 8; ++e) {
          const float x = cur[e] + mu_p[col + e] * (prv[e] - cur[e]) + mu_n[col + e] * (nxt[e] - cur[e]);
          o[e] = sigm(x);
        }
        u32x4 pk;
        pk.x = pack2(o[0], o[1]); pk.y = pack2(o[2], o[3]); pk.z = pack2(o[4], o[5]); pk.w = pack2(o[6], o[7]);
        *(u32x4*)(As + row * 136 + part * 32 + q * 8) = pk;
      }
    }
    asm volatile("" ::: "memory");
#pragma unroll 1
    for (int chh = 0; chh < 2; ++chh) {
      f32x4 acc[16];
#pragma unroll
      for (int n = 0; n < 16; ++n) acc[n] = (f32x4){0.f, 0.f, 0.f, 0.f};
#pragma unroll
      for (int ks = 0; ks < 4; ++ks) {
        bf16x8 af = *(const bf16x8*)(As + (w * 16 + fr) * 136 + ks * 32 + fq * 8);
#pragma unroll
        for (int n = 0; n < 16; ++n) {
          bf16x8 bg = *(const bf16x8*)(GUPT + (size_t)(chh * 256 + n * 16 + fr) * 128 + ks * 32 + fq * 8);
          acc[n] = __builtin_amdgcn_mfma_f32_16x16x32_bf16(af, bg, acc[n], 0, 0, 0);
        }
      }
#pragma unroll
      for (int hl = 0; hl < 4; ++hl) {
        const int head = chh * 4 + hl;
        asm volatile("" ::: "memory");
#pragma unroll
        for (int j = 0; j < 4; ++j) {
          const size_t tok = tok0 + w * 16 + fq * 4 + j;
          const int t = (int)(tok & 4095);
          float o[4], sum = 0.f;
#pragma unroll
          for (int q = 0; q < 4; ++q) {
            const int col = head * 64 + q * 16 + fr;
            o[q] = (float)YF[tok * 512 + col] + (float)YB[tok * 512 + col];
            sum += o[q];
          }
          const float mean = red16_sum(sum) * (1.f / 64.f);
          float vs = 0.f;
#pragma unroll
          for (int q = 0; q < 4; ++q) { const float dlt = o[q] - mean; vs += dlt * dlt; }
          const float var = red16_sum(vs) * (1.f / 64.f);
          const float rstd = rsqrtf(var + 64e-5f);
          const float bon = BON[(tok * 8 + head) * 2] + BON[(tok * 8 + head) * 2 + 1];
#pragma unroll
          for (int q = 0; q < 4; ++q) {
            const int col = head * 64 + q * 16 + fr;
            const int vc = 1024 + col;
            const float cur = bf2f(PR[tok * PRW + vc]);
            const float prv = (t > 0) ? bf2f(PR[(tok - 1) * PRW + vc]) : 0.f;
            const float nxt = (t < 4095) ? bf2f(PR[(tok + 1) * PRW + vc]) : 0.f;
            const float vsh = cur + mu_p[vc] * (prv - cur) + mu_n[vc] * (nxt - cur);
            const float yv = ((o[q] - mean) * rstd * gng[col] + gnb[col] + bon * vsh) * acc[hl * 4 + q][j];
            PR[tok * PRW + col] = f2bf(yv);
          }
        }
      }
    }
  }
}

DEVI f32x4 ld4bf(const u16* p) {
  const u32x2 u = *(const u32x2*)p;
  f32x4 o;
  o[0] = __uint_as_float(u.x << 16); o[1] = __uint_as_float(u.x & 0xffff0000u);
  o[2] = __uint_as_float(u.y << 16); o[3] = __uint_as_float(u.y & 0xffff0000u);
  return o;
}

DEVI void phase_merge(int tid_, const Params& p, char* smem, const float* ssq) {
  const u16* WB = (const u16*)(p.ws + OFF_WB);
  const u16* H = (const u16*)(p.ws + OFF_NK);
  u16* PR = (u16*)(p.ws + OFF_PR);
  const u16* NQ = (const u16*)(p.ws + OFF_NQ);
  u16* TMP = (u16*)(p.ws + OFF_H);
  const int lane = tid_ & 63, wid = tid_ >> 6;
  const int wr = wid >> 2, wc = wid & 3, fr = lane & 15, fq = lane >> 4;
  const bool xmap = (gridDim.x & 7) == 0;
  const int xcd = blockIdx.x & 7;
  const int first = xmap ? (int)(blockIdx.x >> 3) : (int)blockIdx.x;
  const int stride = xmap ? (int)(gridDim.x >> 3) : (int)gridDim.x;
  const int count = xmap ? 24 * 4 : 192 * 4;
  for (int it = first; it < count; it += stride) {
    const int tm = xmap ? (it >> 2) * 8 + xcd : (it >> 2), tn = it & 3;
    const int m0 = tm << 8, n0 = tn << 8;
    f32x4 acc[8][4];
#define MERGE_ZERO() _Pragma("unroll") for (int m = 0; m < 8; ++m) _Pragma("unroll") for (int n = 0; n < 4; ++n) acc[m][n] = (f32x4){0.f, 0.f, 0.f, 0.f}
#define MERGE_RC() const int r = m0 + wr * 128 + m * 16 + fr, c0 = n0 + wc * 64 + n * 16 + fq * 4
    MERGE_ZERO();
    gemm_kloop8<true>(launder(tid_), acc, H + (size_t)m0 * 1024, 1024, WB + W_IN + (size_t)(3456 + n0) * 1024, 1024, 1024, smem);
#pragma unroll
    for (int m = 0; m < 8; ++m)
#pragma unroll
      for (int n = 0; n < 4; ++n) {
        MERGE_RC();
        const float rs = rstd_of(ssq, r);
        f32x4 o;
#pragma unroll
        for (int j = 0; j < 4; ++j) o[j] = sigm(acc[m][n][j] * rs);
        store4bf(PR + (size_t)r * PRW + 512 + c0, o);
      }
    MERGE_ZERO();
    gemm_kloop8<true>(launder(tid_), acc, PR + (size_t)m0 * PRW, PRW, WB + W_BRR + (size_t)n0 * 512, 512, 512, smem);
#pragma unroll
    for (int m = 0; m < 8; ++m)
#pragma unroll
      for (int n = 0; n < 4; ++n) {
        MERGE_RC();
        u16* dst = PR + (size_t)r * PRW + 512 + c0;
        store4bf(dst, ld4bf(dst) * acc[m][n]);
      }
    MERGE_ZERO();
    gemm_kloop8<true>(launder(tid_), acc, H + (size_t)m0 * 1024, 1024, WB + W_IN + (size_t)(4480 + n0) * 1024, 1024, 1024, smem);
#pragma unroll
    for (int m = 0; m < 8; ++m)
#pragma unroll
      for (int n = 0; n < 4; ++n) {
        MERGE_RC();
        const float rs = rstd_of(ssq, r);
        f32x4 o;
#pragma unroll
        for (int j = 0; j < 4; ++j) o[j] = sigm(acc[m][n][j] * rs);
        store4bf(TMP + (size_t)r * 1024 + c0, o);
      }
    MERGE_ZERO();
    gemm_kloop8<true>(launder(tid_), acc, NQ + (size_t)m0 * 512, 512, WB + W_BRN + (size_t)n0 * 512, 512, 512, smem);
#pragma unroll
    for (int m = 0; m < 8; ++m)
#pragma unroll
      for (int n = 0; n < 4; ++n) {
        MERGE_RC();
        u16* dst = PR + (size_t)r * PRW + 512 + c0;
        store4bf(dst, ld4bf(dst) + ld4bf(TMP + (size_t)r * 1024 + c0) * acc[m][n]);
      }
#undef MERGE_ZERO
#undef MERGE_RC
  }
}


DEVI void phase_xattn(int tid_, int vb_, int vg_, const Params& p, char* smem) {
  const u16* Q = (const u16*)(p.ws + OFF_PR);
  u16* O = (u16*)(p.ws + OFF_NQ);
  const u16* KVK = (const u16*)(p.ws + OFF_KVK);
  const u16* KVT = (const u16*)(p.ws + OFF_KVT);
  const int lane = tid_ & 63, w = tid_ >> 6, fr = lane & 15, fq = lane >> 4;
  u16* Pw = (u16*)smem + w * (32 * 264);
  for (int t = vb_; t < (NTOK / 128) * 4; t += vg_) {
    const int hh = t & 3;
    const size_t tok0 = (size_t)(t >> 2) * 128 + w * 32;
    const int s = (int)(tok0 >> 12);
    f32x4 acc[2][16];
#pragma unroll
    for (int mt = 0; mt < 2; ++mt)
#pragma unroll
      for (int n = 0; n < 16; ++n) acc[mt][n] = (f32x4){0.f, 0.f, 0.f, 0.f};
#pragma unroll 1
    for (int ks = 0; ks < 8; ++ks) {
      const bf16x8 aq0 = *(const bf16x8*)(Q + (tok0 + fr) * 1024 + hh * 256 + ks * 32 + fq * 8);
      const bf16x8 aq1 = *(const bf16x8*)(Q + (tok0 + 16 + fr) * 1024 + hh * 256 + ks * 32 + fq * 8);
#pragma unroll
      for (int n = 0; n < 16; ++n) {
        const bf16x8 bk = *(const bf16x8*)(KVK + (size_t)(s * 256 + n * 16 + fr) * 1024 + hh * 256 + ks * 32 + fq * 8);
        acc[0][n] = __builtin_amdgcn_mfma_f32_16x16x32_bf16(bk, aq0, acc[0][n], 0, 0, 0);
        acc[1][n] = __builtin_amdgcn_mfma_f32_16x16x32_bf16(bk, aq1, acc[1][n], 0, 0, 0);
      }
    }
    float sm[2];
#pragma unroll
    for (int mt = 0; mt < 2; ++mt) {
      float m = -1e30f;
#pragma unroll
      for (int n = 0; n < 16; ++n)
#pragma unroll
        for (int j = 0; j < 4; ++j) m = fmaxf(m, acc[mt][n][j]);
      m = red4x_max(m) * 0.0625f;
      float ssum = 0.f;
#pragma unroll
      for (int n = 0; n < 16; ++n) {
        f32x4 e;
#pragma unroll
        for (int j = 0; j < 4; ++j) { e[j] = __expf(acc[mt][n][j] * 0.0625f - m); ssum += e[j]; }
        store4bf(Pw + (mt * 16 + fr) * 264 + n * 16 + fq * 4, e);
      }
      sm[mt] = 1.f / red4x_sum(ssum);
    }
#pragma unroll
    for (int mt = 0; mt < 2; ++mt)
#pragma unroll
      for (int n = 0; n < 16; ++n) acc[mt][n] = (f32x4){0.f, 0.f, 0.f, 0.f};
#pragma unroll 1
    for (int ks = 0; ks < 8; ++ks) {
      const bf16x8 ap0 = *(const bf16x8*)(Pw + fr * 264 + ks * 32 + fq * 8);
      const bf16x8 ap1 = *(const bf16x8*)(Pw + (16 + fr) * 264 + ks * 32 + fq * 8);
#pragma unroll
      for (int n = 0; n < 16; ++n) {
        const bf16x8 bv = *(const bf16x8*)(KVT + (size_t)(s * 1024 + hh * 256 + n * 16 + fr) * 256 + ks * 32 + fq * 8);
        acc[0][n] = __builtin_amdgcn_mfma_f32_16x16x32_bf16(bv, ap0, acc[0][n], 0, 0, 0);
        acc[1][n] = __builtin_amdgcn_mfma_f32_16x16x32_bf16(bv, ap1, acc[1][n], 0, 0, 0);
      }
    }
#pragma unroll
    for (int mt = 0; mt < 2; ++mt)
#pragma unroll
      for (int n = 0; n < 16; n += 2)
        store_pair_bf16(O + (tok0 + mt * 16 + fr) * 1024 + hh * 256, n * 16, fq, pack4bf(acc[mt][n] * sm[mt]),
                        pack4bf(acc[mt][n + 1] * sm[mt]));
  }
}

constexpr int HALF_SMEM = 78720;

DEVI void run_phase(int tid_, const Params& p, int ph, char* smem) {
  const int half = tid_ >> 8, vt = tid_ & 255;
  const int vb_ = blockIdx.x * 2 + half, vg_ = gridDim.x * 2;
  char* smh = smem + half * HALF_SMEM;
  if (ph == 2 * NPH_LAYER) { phase_final_norm(vt, vb_, vg_, p); return; }
  const int l = ph / NPH_LAYER, q = ph % NPH_LAYER;
  u16* WB = (u16*)(p.ws + OFF_WB);
  u16* H = (u16*)(p.ws + OFF_H);
  u16* PR = (u16*)(p.ws + OFF_PR);
  u16* NQ = (u16*)(p.ws + OFF_NQ);
  float* X = p.X;
  float* SSQ = (float*)(p.ws + OFF_SSQ);
  auto epi_res = [&](int r, int c0, f32x4 v) {
    f32x4* px = (f32x4*)(X + (size_t)r * 1024 + c0);
    *px = *px + v;
  };
  float rowacc = 0.f;
  float* ssq_out = SSQ;
  const bool x_from_input = (l == 0 && q <= 5);
  const bool need_xb = !(l == 1 && q == 12);
  auto epi_res_n = [&](int r, int c0, f32x4 v) {
    f32x4* px = (f32x4*)(X + (size_t)r * 1024 + c0);
    const float* srow = x_from_input ? ((r < 32768) ? p.in[I_XP] + (size_t)r * 1024 : p.in[I_XS] + (size_t)(r - 32768) * 1024)
                                     : X + (size_t)r * 1024;
    const f32x4 xn = *(const f32x4*)(srow + c0) + v;
    *px = xn;
    if (need_xb) store4bf(H + (size_t)r * 1024 + c0, xn);
    rowacc += xn[0] * xn[0] + xn[1] * xn[1] + xn[2] * xn[2] + xn[3] * xn[3];
  };
  const int fq_l = (tid_ & 63) >> 4;
  auto epi_res_p = make_pair_epi([&](int r, int c, f32x4 va, f32x4 vb) {
    const float* srow = x_from_input ? ((r < 32768) ? p.in[I_XP] + (size_t)r * 1024 : p.in[I_XS] + (size_t)(r - 32768) * 1024)
                                     : X + (size_t)r * 1024;
    const int ca = c + fq_l * 4, cb = c + 16 + fq_l * 4;
    const f32x4 xa = *(const f32x4*)(srow + ca) + va;
    const f32x4 xb = *(const f32x4*)(srow + cb) + vb;
    *(f32x4*)(X + (size_t)r * 1024 + ca) = xa;
    *(f32x4*)(X + (size_t)r * 1024 + cb) = xb;
    if (need_xb) store_pair_bf16(H + (size_t)r * 1024, c, fq_l, pack4bf(xa), pack4bf(xb));
    rowacc += xa[0] * xa[0] + xa[1] * xa[1] + xa[2] * xa[2] + xa[3] * xa[3]
            + xb[0] * xb[0] + xb[1] * xb[1] + xb[2] * xb[2] + xb[3] * xb[3];
  });
  auto row_end = [&](int r) {
    float t = rowacc;
    t += __shfl_xor(t, 16);
    t += __shfl_xor(t, 32);
    if ((tid_ & 48) == 0) atomicAdd(ssq_out + r, t);
    rowacc = 0.f;
  };
  constexpr int NONS = 1 << 30;
  switch (q) {
    case 0:
      phase_conv(vt, vb_, vg_, p, l, smh);
      phase_norm_mem(vt, vb_, vg_, p, p.in[I_NORM_MEM] + (size_t)l * 1024);
      if (l == 0) {
        phase_xb(vt, vb_, vg_, p, true, OFF_H, SSQ);
        for (int i = vb_ * 256 + vt; i < 6 * NTOK; i += vg_ * 256) SSQ[NTOK + i] = 0.f;
      }
      break;
    case 1: phase_p_gemm(tid_, p, smem, SSQ + (size_t)(3 * l) * NTOK); break;
    case 2:
      if (gridDim.x >= 224) {
        if (blockIdx.x < 192) phase_scan_pc(tid_, p, l, smem, blockIdx.x, gridDim.x);
        else phase_nat(vt, p, l, smh, vb_ - 384, vg_ - 384);
      } else {
        phase_scan(vt, p, l, smh, vb_, vg_);
        __syncthreads();
        phase_nat(vt, p, l, smh, vb_, vg_);
      }
      break;
    case 3:
      phase_rwkv_post(vt, vb_, vg_, p, l, smh);
      phase_xb(vt, vb_, vg_, p, l == 0, OFF_NK, nullptr);
      break;
    case 4: phase_merge(tid_, p, smem, SSQ + (size_t)(3 * l) * NTOK); break;
    case 5:
      ssq_out = SSQ + (size_t)(3 * l + 1) * NTOK;
      gemm_phase8(tid_, PR + 512, PRW, WB + W_OUT, 1024, 1024, NTOK, 1024, smem, NONS, epi_res_n, NoEpi(), row_end, 0, epi_res_p);
      break;
    case 6: {
      const float* ssq = SSQ + (size_t)(3 * l + 1) * NTOK;
      const int fq_ = (tid_ & 63) >> 4;
      gemm_phase8(tid_, H, 1024, WB + W_XQ, 1024, 1024, NTOK, 1024, smem, NONS,
                 [&](int r, int c0, f32x4 v) { store4bf(PR + (size_t)r * 1024 + c0, v * rstd_of(ssq, r)); }, NoEpi(), NoRow(), 0,
                 make_pair_epi([&](int r, int c, f32x4 va, f32x4 vb) {
                   const float rs = rstd_of(ssq, r);
                   store_pair_bf16(PR + (size_t)r * 1024, c, fq_, pack4bf(va * rs), pack4bf(vb * rs));
                 }));
    } break;
    case 7: phase_xattn(vt, vb_, vg_, p, smh); break;
    case 8:
      ssq_out = SSQ + (size_t)(3 * l + 2) * NTOK;
      gemm_phase8(tid_, NQ, 1024, WB + W_XO, 1024, 1024, NTOK, 1024, smem, NONS, epi_res_n, NoEpi(), row_end, 0, epi_res_p);
      break;
    case 9:
    case 11: {
      const int hf = (q == 11);
      const float* ssq = SSQ + (size_t)(3 * l + 2) * NTOK;
      gemm_phase8(tid_, H, 1024, WB + W_FF1 + (size_t)hf * 2048 * 1024, 1024, 1024, NTOK, 2048, smem, NONS,
                 [&](int r, int c0, f32x4 v) {
                   const float rs = rstd_of(ssq, r);
                   f32x4 o;
#pragma unroll
                   for (int j = 0; j < 4; ++j) { const float x = fmaxf(v[j] * rs, 0.f); o[j] = x * x; }
                   store4bf(PR + (size_t)r * 2048 + c0, o);
                 }, NoEpi(), NoRow(), 0,
                 make_pair_epi([&](int r, int c, f32x4 va, f32x4 vb) {
                   const float rs = rstd_of(ssq, r);
                   f32x4 oa, ob;
#pragma unroll
                   for (int j = 0; j < 4; ++j) {
                     const float xa = fmaxf(va[j] * rs, 0.f), xb = fmaxf(vb[j] * rs, 0.f);
                     oa[j] = xa * xa; ob[j] = xb * xb;
                   }
                   store_pair_bf16(PR + (size_t)r * 2048, c, (tid_ & 63) >> 4, pack4bf(oa), pack4bf(ob));
                 }));
    } break;
    case 10:
      gemm_phase8(tid_, PR, 2048, WB + W_FF2, 4096, 2048, NTOK, 1024, smem, NONS, epi_res, NoEpi());
      break;
    case 12:
      ssq_out = SSQ + (size_t)(3 * l + 3) * NTOK;
      gemm_phase8(tid_, PR, 2048, WB + W_FF2 + 2048, 4096, 2048, NTOK, 1024, smem, NONS, epi_res_n, NoEpi(), row_end, 0, epi_res_p);
      break;
  }
}

#define XB_TMO      128
#define XB_XCNT(j)  (256  + 64 * (j))
#define XB_XSUB(j)  (1280 + 64 * (j))
#define XB_XGEN(j)  (2304 + 64 * (j))
#define XB_TOP      3328
#define XB_TOPGEN   3392
#define XCD_BAR_WORDS 3456
#define XB_SPIN_CAP (1u << 20)
#define LAS __attribute__((address_space(3)))

DEVI unsigned xb_ld(unsigned* p) { return __hip_atomic_load(p, __ATOMIC_RELAXED, __HIP_MEMORY_SCOPE_AGENT); }
DEVI unsigned xb_add(unsigned* p, unsigned v) { return __hip_atomic_fetch_add(p, v, __ATOMIC_RELAXED, __HIP_MEMORY_SCOPE_AGENT); }
DEVI unsigned xb_xcc_id() { return (unsigned)__builtin_amdgcn_s_getreg((3 << 11) | 20) & 0xFu; }
#define XB_SPIN(cond, bar) do { unsigned _sp = 0; while (cond) { __builtin_amdgcn_s_sleep(1); \
    if ((++_sp & 255u) == 0u) { if (xb_ld(&(bar)[XB_TMO])) break; if (_sp > XB_SPIN_CAP) { atomicAdd(&(bar)[XB_TMO], 1u); break; } } } } while (0)

struct XcdBarrier {
  unsigned* bar; unsigned x;
  volatile LAS unsigned* st;
};
DEVI XcdBarrier xcd_barrier_post(unsigned* bar, volatile LAS unsigned* st) {
  XcdBarrier b; b.bar = bar; b.x = xb_xcc_id(); b.st = st;
  if (threadIdx.x == 0) (void)xb_add(&bar[XB_XCNT(b.x)], 1u);
  return b;
}
DEVI void xcd_barrier_complete(unsigned* bar, unsigned x, unsigned& nloc, unsigned& nx) {
  const unsigned G = gridDim.x * gridDim.y * gridDim.z;
  unsigned sum, cnt, mine, sp = 0u;
  for (;;) {
    sum = 0u; cnt = 0u; mine = 0u;
#pragma unroll
    for (unsigned j = 0; j < 16; ++j) { const unsigned c = xb_ld(&bar[XB_XCNT(j)]); sum += c; cnt += (c > 0u) ? 1u : 0u; mine = (j == x) ? c : mine; }
    if (sum == G) break;
    __builtin_amdgcn_s_sleep(1);
    if ((++sp & 255u) == 0u) { if (xb_ld(&bar[XB_TMO])) break; if (sp > XB_SPIN_CAP) { atomicAdd(&bar[XB_TMO], 1u); break; } }
  }
  nloc = mine > 0u ? mine : 1u; nx = cnt > 0u ? cnt : 1u;
}
DEVI void xcd_barrier(const XcdBarrier& b) {
  asm volatile("s_waitcnt vmcnt(0)" ::: "memory");
  __syncthreads();
  if (threadIdx.x == 0) {
    unsigned* bar = b.bar;
    __builtin_amdgcn_s_waitcnt(0);
    unsigned nloc = b.st[0], nx = b.st[1];
    if (nloc == 0u) { xcd_barrier_complete(bar, b.x, nloc, nx); b.st[0] = nloc; b.st[1] = nx; }
    const unsigned old = xb_add(&bar[XB_XSUB(b.x)], 1u);
    const unsigned gen = old / nloc;
    if (old + 1u == (gen + 1u) * nloc) {
      __builtin_amdgcn_fence(__ATOMIC_RELEASE, "agent");
      asm volatile("s_waitcnt vmcnt(0)" ::: "memory");
      const unsigned og = xb_add(&bar[XB_TOP], 1u);
      const unsigned tg = og / nx;
      if (og + 1u == (tg + 1u) * nx) xb_add(&bar[XB_TOPGEN], 1u);
      else XB_SPIN(xb_ld(&bar[XB_TOPGEN]) == tg, bar);
      __builtin_amdgcn_fence(__ATOMIC_ACQUIRE, "agent");
      xb_add(&bar[XB_XGEN(b.x)], 1u);
      asm volatile("s_waitcnt vmcnt(0)" ::: "memory");
    } else {
      XB_SPIN(xb_ld(&bar[XB_XGEN(b.x)]) == gen, bar);
      __builtin_amdgcn_fence(__ATOMIC_ACQUIRE, "agent");
      asm volatile("s_waitcnt vmcnt(0)" ::: "memory");
    }
  }
  __syncthreads();
}

__global__ void __launch_bounds__(512, 2) mega_kernel(Params p, int ph0, int ph1) {
  __shared__ __attribute__((aligned(16))) char smem[2 * HALF_SMEM];
  __shared__ __attribute__((aligned(16))) unsigned xb_words[4];
  if (threadIdx.x == 0) { xb_words[0] = 0u; xb_words[1] = 0u; xb_words[2] = 0u; xb_words[3] = 0u; }
  __syncthreads();
  XcdBarrier xb = xcd_barrier_post((unsigned*)(p.ws + OFF_BAR), (volatile LAS unsigned*)xb_words);
  for (int ph = ph0; ph < ph1; ++ph) {
    if (ph == ph0 + 1) cg::this_grid().sync();
    else if (ph > ph0) xcd_barrier(xb);
    int tid_ = threadIdx.x;
    asm volatile("" : "+v"(tid_));
    run_phase(tid_, p, ph, smem);
  }
}

extern "C" void kernel_launch(void* const* d_in, const int* in_sizes, int n_in, void* d_out, int out_size, void* d_ws,
                              size_t ws_size, hipStream_t stream) {
  if (ws_size < WS_NEED || n_in < 31) return;
  Params p{};
  for (int i = 0; i < 31; ++i) p.in[i] = (const float*)d_in[i];
  p.X = (float*)d_out;
  p.ws = (char*)d_ws;
  static int grid_blocks = 0;
  if (!grid_blocks) {
    int dev = 0, cus = 0, per_cu = 0;
    hipGetDevice(&dev);
    hipDeviceGetAttribute(&cus, hipDeviceAttributeMultiprocessorCount, dev);
    hipOccupancyMaxActiveBlocksPerMultiprocessor(&per_cu, mega_kernel, 512, 0);
    if (per_cu > 1) per_cu = 1;
    if (per_cu < 1) per_cu = 1;
    grid_blocks = cus * per_cu;
  }
  hipMemsetAsync((char*)d_ws + OFF_BAR, 0, 16384, stream);
  int ph0 = 0, ph1 = NPHASES;
  void* args[] = {&p, &ph0, &ph1};
  hipLaunchCooperativeKernel((void*)mega_kernel, dim3(grid_blocks), dim3(512), args, 0, stream);
}
```
